# Optimizing an MI355X kernel written in HIP

```python
import jax, jax.numpy as jnp
from jax import lax
import numpy as np


D_MODEL = 1024
BATCH = 8
SEQ = 2048
DEPTH = 1
DEC_BATCH = 128
DEC_SEQ = 4
PAST_LEN = 16384
PAGE_SIZE = 128

D_MIX = D_MODEL
D_A = D_MIX // 2
HEAD_A = 64
H_A = D_A // HEAD_A
D_R = D_MIX - D_A
H_R = 4
HEAD_R = D_R // H_R
LORA_W = 64
LORA_A = 64
LORA_G = 128
D_FF = 2816
RET_CHUNK = 128
ROPE_BASE = 10000.0
EPS = 1e-6
GN_EPS_A = 64e-5
GN_EPS_R = 1e-5
N_SHIFT = 3 * D_A + LORA_W + LORA_A + LORA_G
N_COLS = N_SHIFT + 4 * D_R

kernel_name = 'hymba_rwkv7_retnet_macaron_step'


def rms_norm(x, g):
    xf = x.astype(jnp.float32)
    y = xf * lax.rsqrt(jnp.mean(xf * xf, axis=-1, keepdims=True) + EPS)
    return (y * g.astype(jnp.float32)).astype(x.dtype)


def swiglu(h, wg, wu, wd):
    return (jax.nn.silu(h @ wg) * (h @ wu)) @ wd


def head_norm(y, eps):
    mu = jnp.mean(y, axis=-1, keepdims=True)
    var = jnp.mean(jnp.square(y - mu), axis=-1, keepdims=True)
    yn = (y - mu) * lax.rsqrt(var + eps)
    return yn.reshape(y.shape[0], y.shape[1], -1)


def rope(x, pos):
    half = x.shape[-1] // 2
    inv = ROPE_BASE ** (-jnp.arange(half, dtype=jnp.float32) / half)
    ang = pos.astype(jnp.float32)[:, None] * inv[None, :]
    cos = jnp.cos(ang)[None, :, None, :]
    sin = jnp.sin(ang)[None, :, None, :]
    x1, x2 = x[..., :half], x[..., half:]
    return jnp.concatenate([x1 * cos - x2 * sin, x1 * sin + x2 * cos], axis=-1)


def rwkv7_group(mixed, s0, w0, w2, a0, a2, g2, k_k, k_a, r_k, lnx_w, lnx_b):
    B, T, _ = mixed.shape
    f = mixed.astype(jnp.float32)
    o1, o2, o3 = D_A, 2 * D_A, 3 * D_A
    o4, o5 = o3 + LORA_W, o3 + LORA_W + LORA_A
    r, k, v = f[..., :o1], f[..., o1:o2], f[..., o2:o3]
    wd, ad, gd = f[..., o3:o4], f[..., o4:o5], f[..., o5:]
    w = -jax.nn.softplus(-(w0 + jnp.tanh(wd) @ w2)) - 0.5
    decay = jnp.exp(-jnp.exp(w))
    a = jax.nn.sigmoid(a0 + ad @ a2)
    g = jax.nn.sigmoid(gd) @ g2
    hd = lambda t: t.reshape(B, T, H_A, HEAD_A)
    kk = hd(k * k_k)
    kk = kk / jnp.maximum(jnp.sqrt(jnp.sum(kk * kk, axis=-1, keepdims=True)), 1e-12)
    k = k * (1.0 + (a - 1.0) * k_a)
    rh, kh, vh = hd(r), hd(k), hd(v)
    a_vec = -kk
    b_vec = kk * hd(a)
    xs = tuple(t.transpose(1, 0, 2, 3) for t in (rh, hd(decay), kh, vh, a_vec, b_vec))

    def step(S, inp):
        r_t, w_t, k_t, v_t, a_t, b_t = inp
        sa = jnp.einsum('bhij,bhj->bhi', S, a_t)
        S = S * w_t[:, :, None, :] + sa[..., None] * b_t[:, :, None, :] + v_t[..., None] * k_t[:, :, None, :]
        y = jnp.einsum('bhij,bhj->bhi', S, r_t)
        return S, y

    S, ys = lax.scan(step, s0.astype(jnp.float32), xs)
    ys = ys.transpose(1, 0, 2, 3)
    y = head_norm(ys, GN_EPS_A) * lnx_w + lnx_b
    bonus = (jnp.sum(rh * kh * r_k, axis=-1, keepdims=True) * vh).reshape(B, T, D_A)
    y = (y + bonus) * g
    return y.astype(mixed.dtype), S


def retention_chunked(q, k, v, s0):
    B, T, H, D = q.shape
    C = min(RET_CHUNK, T)
    n = T // C
    lg = jnp.log1p(-jnp.exp2(-5.0 - jnp.arange(H, dtype=jnp.float32)))
    idx = jnp.arange(C, dtype=jnp.float32)
    diff = idx[:, None] - idx[None, :]
    dmask = jnp.where(diff >= 0, jnp.exp(lg[:, None, None] * jnp.maximum(diff, 0.0)), 0.0)
    q_dec = jnp.exp(lg[:, None] * (idx + 1.0))
    k_dec = jnp.exp(lg[:, None] * (C - 1.0 - idx))
    c_dec = jnp.exp(lg * C)

    def to_chunks(t):
        return t.reshape(B, n, C, H, D).transpose(1, 0, 3, 2, 4)

    def step(S, inp):
        qc, kc, vc = inp
        inner = jnp.einsum('bhid,bhjd->bhij', qc, kc) * dmask
        y = jnp.einsum('bhij,bhje->bhie', inner, vc) + jnp.einsum('bhid,bhde->bhie', qc * q_dec[..., None], S)
        S = S * c_dec[:, None, None] + jnp.einsum('bhjd,bhje->bhde', kc * k_dec[..., None], vc)
        return S, y

    S, ys = lax.scan(step, s0.astype(jnp.float32), (to_chunks(q), to_chunks(k), to_chunks(v)))
    y = ys.transpose(1, 0, 3, 2, 4).reshape(B, T, H, D)
    return y, S


def retention_group(pr, s0, pos, gn_w):
    B, T, _ = pr.shape
    f = pr.astype(jnp.float32)
    hd = lambda t: t.reshape(B, T, H_R, HEAD_R)
    q = rope(hd(f[..., :D_R]), pos)
    k = rope(hd(f[..., D_R:2 * D_R]), pos) * (HEAD_R ** -0.5)
    v = hd(f[..., 2 * D_R:3 * D_R])
    g = f[..., 3 * D_R:]
    y, S = retention_chunked(q, k, v, s0)
    y = head_norm(y, GN_EPS_R) * gn_w
    y = jax.nn.silu(g) * y
    return y.astype(pr.dtype), S


def hybrid_layer(x, prev_h, wkv0, ret0, pos, p):
    (norm_g, f1g, f1u, f1d, w_in, mu, w0, w2, a0, a2, g2, k_k, k_a, r_k,
     lnx_w, lnx_b, gn_w, w_out, f2g, f2u, f2d) = p
    x = x + 0.5 * rms_norm(swiglu(rms_norm(x, norm_g[0]), f1g, f1u, f1d), norm_g[1])
    h = rms_norm(x, norm_g[2])
    h_ext = jnp.concatenate([prev_h[:, None, :].astype(h.dtype), h], axis=1)
    ps = h_ext @ w_in[:, :N_SHIFT]
    cur, prv = ps[:, 1:], ps[:, :-1]
    mixed = cur + (prv - cur) * mu
    ya, wkv_new = rwkv7_group(mixed, wkv0, w0, w2, a0, a2, g2, k_k, k_a, r_k, lnx_w, lnx_b)
    pr = h @ w_in[:, N_SHIFT:]
    yr, ret_new = retention_group(pr, ret0, pos, gn_w)
    mix = jnp.concatenate([ya, yr], axis=-1) @ w_out
    x = x + rms_norm(mix, norm_g[3])
    x = x + 0.5 * rms_norm(swiglu(rms_norm(x, norm_g[4]), f2g, f2u, f2d), norm_g[5])
    return x, h[:, -1], wkv_new, ret_new


def setup_inputs(seed: int = 0) -> dict:
    key = jax.random.key(seed)
    ks = jax.random.split(key, 26)
    nrm = lambda k, shape, s: s * jax.random.normal(k, shape, jnp.float32)
    return {
        'x_prompt': nrm(ks[0], (BATCH, SEQ, D_MODEL), 1.0),
        'x_sample': nrm(ks[1], (DEC_BATCH, DEC_SEQ, D_MODEL), 1.0),
        'state_shift': nrm(ks[2], (DEPTH, DEC_BATCH, D_MODEL), 1.0),
        'state_wkv': nrm(ks[3], (DEPTH, DEC_BATCH, H_A, HEAD_A, HEAD_A), 0.3),
        'state_ret': nrm(ks[4], (DEPTH, DEC_BATCH, H_R, HEAD_R, HEAD_R), 1.0),
        'norm_g': 1.0 + nrm(ks[5], (DEPTH, 6, D_MODEL), 0.05),
        'ffn1_wg': nrm(ks[6], (DEPTH, D_MODEL, D_FF), D_MODEL ** -0.5),
        'ffn1_wu': nrm(ks[7], (DEPTH, D_MODEL, D_FF), D_MODEL ** -0.5),
        'ffn1_wd': nrm(ks[8], (DEPTH, D_FF, D_MODEL), D_FF ** -0.5),
        'w_in': nrm(ks[9], (DEPTH, D_MODEL, N_COLS), D_MODEL ** -0.5),
        'mu_shift': jax.random.uniform(ks[10], (DEPTH, N_SHIFT), jnp.float32),
        'w0': jnp.linspace(-5.0, 0.5, D_A, dtype=jnp.float32)[None, :] + nrm(ks[11], (DEPTH, D_A), 0.1),
        'w2': nrm(ks[12], (DEPTH, LORA_W, D_A), LORA_W ** -0.5),
        'a0': nrm(ks[13], (DEPTH, D_A), 0.1),
        'a2': nrm(ks[14], (DEPTH, LORA_A, D_A), LORA_A ** -0.5),
        'g2': nrm(ks[15], (DEPTH, LORA_G, D_A), LORA_G ** -0.5),
        'k_k': 0.85 + nrm(ks[16], (DEPTH, D_A), 0.05),
        'k_a': 1.0 + nrm(ks[17], (DEPTH, D_A), 0.05),
        'r_k': nrm(ks[18], (DEPTH, H_A, HEAD_A), 0.1),
        'lnx_w': 1.0 + nrm(ks[19], (DEPTH, D_A), 0.05),
        'lnx_b': nrm(ks[20], (DEPTH, D_A), 0.02),
        'ret_gn_w': 1.0 + nrm(ks[21], (DEPTH, D_R), 0.05),
        'w_out': nrm(ks[22], (DEPTH, D_MIX, D_MODEL), D_MIX ** -0.5),
        'ffn2_wg': nrm(ks[23], (DEPTH, D_MODEL, D_FF), D_MODEL ** -0.5),
        'ffn2_wu': nrm(ks[24], (DEPTH, D_MODEL, D_FF), D_MODEL ** -0.5),
        'ffn2_wd': nrm(ks[25], (DEPTH, D_FF, D_MODEL), D_FF ** -0.5),
    }


def reference(x_prompt, x_sample, state_shift, state_wkv, state_ret, norm_g, ffn1_wg, ffn1_wu, ffn1_wd,
              w_in, mu_shift, w0, w2, a0, a2, g2, k_k, k_a, r_k, lnx_w, lnx_b, ret_gn_w, w_out,
              ffn2_wg, ffn2_wu, ffn2_wd):
    Bp, Tp, _ = x_prompt.shape
    Ts = x_sample.shape[1]
    pos_p = jnp.arange(Tp, dtype=jnp.int32)
    pos_s = PAST_LEN + jnp.arange(Ts, dtype=jnp.int32)
    yp, ys = x_prompt, x_sample
    sh_p, wk_p, rt_p, sh_s, wk_s, rt_s = [], [], [], [], [], []
    for l in range(DEPTH):
        p = (norm_g[l], ffn1_wg[l], ffn1_wu[l], ffn1_wd[l], w_in[l], mu_shift[l], w0[l], w2[l], a0[l],
             a2[l], g2[l], k_k[l], k_a[l], r_k[l], lnx_w[l], lnx_b[l], ret_gn_w[l], w_out[l],
             ffn2_wg[l], ffn2_wu[l], ffn2_wd[l])
        zero_shift = jnp.zeros((Bp, D_MODEL), x_prompt.dtype)
        zero_wkv = jnp.zeros((Bp, H_A, HEAD_A, HEAD_A), jnp.float32)
        zero_ret = jnp.zeros((Bp, H_R, HEAD_R, HEAD_R), jnp.float32)
        yp, a1, b1, c1 = hybrid_layer(yp, zero_shift, zero_wkv, zero_ret, pos_p, p)
        ys, a2_, b2, c2 = hybrid_layer(ys, state_shift[l], state_wkv[l], state_ret[l], pos_s, p)
        sh_p.append(a1); wk_p.append(b1); rt_p.append(c1)
        sh_s.append(a2_); wk_s.append(b2); rt_s.append(c2)
    shift_prompt = jnp.stack(sh_p)
    wkv_prompt = jnp.stack(wk_p)
    ret_prompt = jnp.stack(rt_p)
    shift_sample = jnp.stack(sh_s)
    wkv_sample = jnp.stack(wk_s)
    ret_sample = jnp.stack(rt_s)
    return (yp, ys, shift_prompt, wkv_prompt, ret_prompt, shift_sample, wkv_sample, ret_sample)
```

```cpp
#include <hip/hip_runtime.h>
#include <hip/hip_cooperative_groups.h>
#include <cstdio>
#include <cstdint>
namespace cg = cooperative_groups;

__device__ __forceinline__ int fresh_tid() { int t = threadIdx.x; asm volatile("" : "+v"(t)); return t; }
namespace pg8 {
#define PG8_LAS __attribute__((address_space(3)))
typedef unsigned short bf16_t;
typedef short bf16x8 __attribute__((ext_vector_type(8)));
typedef float f32x4 __attribute__((ext_vector_type(4)));
typedef unsigned u32x4 __attribute__((ext_vector_type(4)));
typedef unsigned u32x2 __attribute__((ext_vector_type(2)));
constexpr int BM = 256, BK = 64, HALF = 128, HTB = HALF * BK * 2, STAGE_BYTES = 8 * HTB, NXCD = 8, WGM = 8;

__host__ __device__ __forceinline__ int lds_byte(int r, int c) { const int st = (r >> 4) * 2 + (c >> 5), rr = r & 15, cc = c & 31, ob = rr * 64 + cc * 2; return st * 1024 + (ob ^ (((ob >> 9) & 1) << 5)); }
__host__ __device__ __forceinline__ void stage_rc(int b, int& R, int& C) { const int st = b / 1024, sb = b % 1024, swz = sb ^ (((sb >> 9) & 1) << 5); R = (st >> 1) * 16 + swz / 64; C = (st & 1) * 32 + (swz % 64) / 2; }
__host__ __device__ __forceinline__ int perm32(int rho) { const int n = rho >> 4, i = rho & 15; return 8 * (i >> 2) + 4 * n + (i & 3); }

struct Unit { int pm, pn; };
struct Gemm { const bf16_t* A; const bf16_t* Bt; int M, N, K; };

struct StaticOrder {
    int nM, nN, nwg, G, c;
    __host__ __device__ void init(int M, int N, int G_, int c_) { nM = M / BM; nN = N / BM; nwg = nM * nN; G = G_; c = c_; }
    __host__ __device__ bool next(int i, Unit& u) const {
        const long L = (long)i * G + c; if (L >= nwg) return false;
        int wgid = (int)L; { const int q = nwg / NXCD, r = nwg % NXCD, xcd = wgid % NXCD, off = wgid / NXCD; wgid = (xcd < r ? xcd * (q + 1) : r * (q + 1) + (xcd - r) * q) + off; }
        const int nig = WGM * nN, gid = wgid / nig, fm = gid * WGM, gsz = (nM - fm) < WGM ? (nM - fm) : WGM;
        u.pm = fm + ((wgid % nig) % gsz); u.pn = (wgid % nig) / gsz; return true;
    }
    __device__ __forceinline__ void a_ready(const Unit&) const {}
    __device__ __forceinline__ void done(const Unit&) const {}
};

__device__ __forceinline__ unsigned cvt_pk_bf16(float lo, float hi) { unsigned r; asm volatile("v_cvt_pk_bf16_f32 %0, %1, %2" : "=v"(r) : "v"(lo), "v"(hi)); return r; }

struct EpiF32 {
    static constexpr bool PERM = false;
    float* C; int ldc;
    __device__ __forceinline__ void operator()(const f32x4 (&acc)[2][2][4][2], const Unit& u, int wr, int wc, int fr, int fq) const {
        const int row0 = u.pm * BM + wr * 64 + fr, col0 = u.pn * BM + wc * 32 + 4 * fq;
#pragma unroll
        for (int ai = 0; ai < 2; ++ai)
#pragma unroll
            for (int m = 0; m < 4; ++m) { float* rowp = C + (size_t)(row0 + ai * HALF + m * 16) * ldc + col0;
#pragma unroll
                for (int bj = 0; bj < 2; ++bj)
#pragma unroll
                    for (int n = 0; n < 2; ++n) *(f32x4*)(rowp + bj * HALF + n * 16) = acc[ai][bj][m][n]; }
    }
};
struct EpiBf16 {
    static constexpr bool PERM = true;
    bf16_t* O; int ldc;
    __device__ __forceinline__ void operator()(const f32x4 (&acc)[2][2][4][2], const Unit& u, int wr, int wc, int fr, int fq) const {
        const int row0 = u.pm * BM + wr * 64 + fr; const int col0 = u.pn * BM + wc * 32 + 8 * fq;
#pragma unroll
        for (int ai = 0; ai < 2; ++ai)
#pragma unroll
            for (int m = 0; m < 4; ++m) { bf16_t* rowp = O + (size_t)(row0 + ai * HALF + m * 16) * ldc + col0;
#pragma unroll
                for (int bj = 0; bj < 2; ++bj) { const f32x4 v0 = acc[ai][bj][m][0], v1 = acc[ai][bj][m][1];
                    u32x4 w; w.x = cvt_pk_bf16(v0[0], v0[1]); w.y = cvt_pk_bf16(v0[2], v0[3]); w.z = cvt_pk_bf16(v1[0], v1[1]); w.w = cvt_pk_bf16(v1[2], v1[3]);
                    *(u32x4*)(rowp + bj * HALF) = w; } }
    }
};
__device__ __forceinline__ float silu_f(float x) { return x / (1.0f + __expf(-x)); }
struct EpiSwiGLU {
    static constexpr bool PERM = true;
    bf16_t* O; int ldc;
    __device__ __forceinline__ void operator()(const f32x4 (&acc)[2][2][4][2], const Unit& u, int wr, int wc, int fr, int fq) const {
        const int row0 = u.pm * BM + wr * 64 + fr; const int col0 = u.pn * HALF + wc * 32 + 8 * fq;
#pragma unroll
        for (int ai = 0; ai < 2; ++ai)
#pragma unroll
            for (int m = 0; m < 4; ++m) { bf16_t* rowp = O + (size_t)(row0 + ai * HALF + m * 16) * ldc + col0;
                float o[8];
#pragma unroll
                for (int n = 0; n < 2; ++n)
#pragma unroll
                    for (int j = 0; j < 4; ++j) o[n * 4 + j] = silu_f(acc[ai][0][m][n][j]) * acc[ai][1][m][n][j];
                u32x4 w; w.x = cvt_pk_bf16(o[0], o[1]); w.y = cvt_pk_bf16(o[2], o[3]); w.z = cvt_pk_bf16(o[4], o[5]); w.w = cvt_pk_bf16(o[6], o[7]);
                *(u32x4*)rowp = w; }
    }
};
struct EpiLora {
    static constexpr bool PERM = true;
    bf16_t* OMD; bf16_t* ASIG; bf16_t* G; const float* w0; const float* a0;
    template <int KIND> __device__ __forceinline__ void body(const f32x4 (&acc)[2][2][4][2], bf16_t* O, const float* bias, int row0, int ch0) const {
#pragma unroll
        for (int bj = 0; bj < 2; ++bj)
#pragma unroll
            for (int ai = 0; ai < 2; ++ai)
#pragma unroll
                for (int m = 0; m < 4; ++m) { bf16_t* rowp = O + (size_t)(row0 + ai * HALF + m * 16) * 512 + ch0 + bj * HALF;
                    float o[8];
#pragma unroll
                    for (int n = 0; n < 2; ++n)
#pragma unroll
                        for (int j = 0; j < 4; ++j) { float v = acc[ai][bj][m][n][j];
                            if (KIND == 0) { v += bias[ch0 + bj * HALF + n * 4 + j]; const float nv = -v; const float sp = fmaxf(nv, 0.f) + __logf(1.0f + __expf(-fabsf(nv)));
                                const float e = __expf(-sp - 0.5f);
                                float p = 1.0f / 40320.0f; p = -1.0f / 5040.0f + e * p; p = 1.0f / 720.0f + e * p; p = -1.0f / 120.0f + e * p; p = 1.0f / 24.0f + e * p; p = -1.0f / 6.0f + e * p; p = 0.5f + e * p; p = 1.0f - e * p;
                                v = e * p; }
                            else if (KIND == 1) { v += bias[ch0 + bj * HALF + n * 4 + j]; v = 1.0f / (1.0f + __expf(-v)); }
                            o[n * 4 + j] = v; }
                    u32x4 w; w.x = cvt_pk_bf16(o[0], o[1]); w.y = cvt_pk_bf16(o[2], o[3]); w.z = cvt_pk_bf16(o[4], o[5]); w.w = cvt_pk_bf16(o[6], o[7]);
                    *(u32x4*)rowp = w; __builtin_amdgcn_sched_barrier(0); }
    }
    __device__ __forceinline__ void operator()(const f32x4 (&acc)[2][2][4][2], const Unit& u, int wr, int wc, int fr, int fq) const {
        const int kind = u.pn >> 1;
        const int row0 = u.pm * BM + wr * 64 + fr; const int ch0 = (u.pn & 1) * BM + wc * 32 + 8 * fq;
        if (kind == 0) body<0>(acc, OMD, w0, row0, ch0); else if (kind == 1) body<1>(acc, ASIG, a0, row0, ch0); else body<2>(acc, G, a0, row0, ch0);
    }
};

template <class Epi, class Sched>
__device__ __forceinline__ void gemm_phase(PG8_LAS unsigned char* lds, const Gemm g, const Sched& S, const Epi& E) {
    const int tid = fresh_tid(), wid = __builtin_amdgcn_readfirstlane(tid >> 6), lane = tid & 63, wr = wid >> 2, wc = wid & 3, fr = lane & 15, fq = lane >> 4;
    const int K = g.K, nt = K / BK;
    unsigned voffA[2], voffB[2];
#pragma unroll
    for (int i = 0; i < 2; ++i) { int R, C; stage_rc(tid * 16 + i * 8192, R, C); const int Rb = Epi::PERM ? ((R & ~31) + perm32(R & 31)) : R;
        voffA[i] = (unsigned)(R * K + C) * 2u; voffB[i] = (unsigned)(Rb * K + C) * 2u; }
    const size_t kstep = (size_t)(BK * 2);
    const size_t hstep = (size_t)HALF * K * 2;
    const size_t tstep = 2 * hstep;
    const unsigned ldsw = (unsigned)wid * 1024u;
    const int aoff = lds_byte(wr * 64 + fr, fq * 8), boff = lds_byte(wc * 32 + fr, fq * 8);
#define PG8_SA(b, h) (((b) * 2 + (h)) * HTB)
#define PG8_SB(b, h) ((4 + (b) * 2 + (h)) * HTB)
#define PG8_STAGE(bufoff, gbase, voff) do { _Pragma("unroll") for (int _i = 0; _i < 2; ++_i) \
        __builtin_amdgcn_global_load_lds((const unsigned*)((const char*)(gbase) + (voff)[_i]), (PG8_LAS unsigned*)(lds + (bufoff) + ldsw + _i * 8192), 16, 0, 0); } while (0)
#define PG8_LDA(dst, b, h) do { _Pragma("unroll") for (int m = 0; m < 4; ++m) _Pragma("unroll") for (int k = 0; k < 2; ++k) dst[m][k] = *(const PG8_LAS bf16x8*)(lds + PG8_SA(b, h) + aoff + m * 2048 + k * 1024); } while (0)
#define PG8_LDB(dst, b, h) do { _Pragma("unroll") for (int n = 0; n < 2; ++n) _Pragma("unroll") for (int k = 0; k < 2; ++k) dst[n][k] = *(const PG8_LAS bf16x8*)(lds + PG8_SB(b, h) + boff + n * 2048 + k * 1024); } while (0)
#define PG8_MMA(ai, bj, At, Bt) do { __builtin_amdgcn_s_setprio(1); _Pragma("unroll") for (int m = 0; m < 4; ++m) _Pragma("unroll") for (int n = 0; n < 2; ++n) _Pragma("unroll") for (int k = 0; k < 2; ++k) \
        acc[ai][bj][m][n] = __builtin_amdgcn_mfma_f32_16x16x32_bf16(Bt[n][k], At[m][k], acc[ai][bj][m][n], 0, 0, 0); __builtin_amdgcn_s_setprio(0); } while (0)
#define PG8_WAIT_V(n) asm volatile("s_waitcnt vmcnt(" #n ")" ::: "memory")
#define PG8_WAIT_L(n) asm volatile("s_waitcnt lgkmcnt(" #n ")" ::: "memory")
#define PG8_BAR __builtin_amdgcn_s_barrier()
#define PG8_SCHED __builtin_amdgcn_sched_barrier(0)
    Unit cur, nxt; int ui = 0;
    if (!S.next(0, cur)) return;
    f32x4 acc[2][2][4][2];
#pragma unroll
    for (int a = 0; a < 2; ++a)
#pragma unroll
        for (int b = 0; b < 2; ++b)
#pragma unroll
            for (int m = 0; m < 4; ++m)
#pragma unroll
                for (int n = 0; n < 2; ++n) acc[a][b][m][n] = (f32x4){0.f, 0.f, 0.f, 0.f};
    bf16x8 At[4][2], B0[2][2], B1[2][2];
    const char* cA = (const char*)g.A + (size_t)cur.pm * tstep; const char* cB = (const char*)g.Bt + (size_t)cur.pn * tstep;
    S.a_ready(cur);
    PG8_STAGE(PG8_SB(0, 0), cB, voffB); PG8_STAGE(PG8_SA(0, 0), cA, voffA); PG8_STAGE(PG8_SB(0, 1), cB + hstep, voffB); PG8_STAGE(PG8_SA(0, 1), cA + hstep, voffA);
    if (wr == 1) PG8_BAR;
    PG8_WAIT_V(4); PG8_BAR;
    PG8_STAGE(PG8_SB(1, 0), cB + kstep, voffB); PG8_STAGE(PG8_SA(1, 0), cA + kstep, voffA); PG8_STAGE(PG8_SB(1, 1), cB + hstep + kstep, voffB);
    PG8_WAIT_V(6); PG8_BAR;
    for (;;) {
        const bool has_next = S.next(ui + 1, nxt);
        const char* nA = has_next ? (const char*)g.A + (size_t)nxt.pm * tstep : cA; const char* nB = has_next ? (const char*)g.Bt + (size_t)nxt.pn * tstep : cB;
        for (int t = 0; t < nt; t += 2) {
            const bool last = (t == nt - 2);
            const char* a1 = cA + (size_t)(t + 1) * kstep;
            const char* a2 = last ? nA : cA + (size_t)(t + 2) * kstep; const char* b2 = last ? nB : cB + (size_t)(t + 2) * kstep;
            const char* a3 = a2 + kstep; const char* b3 = b2 + kstep;
            if (last && has_next) S.a_ready(nxt);
            PG8_LDB(B0, 0, 0); PG8_SCHED; PG8_LDA(At, 0, 0); PG8_STAGE(PG8_SA(1, 1), a1 + hstep, voffA);
            PG8_WAIT_L(8); PG8_BAR; PG8_WAIT_L(0); PG8_MMA(0, 0, At, B0); PG8_BAR; PG8_SCHED;
            PG8_LDB(B1, 0, 1); PG8_STAGE(PG8_SB(0, 0), b2, voffB);
            PG8_BAR; PG8_WAIT_L(0); PG8_MMA(0, 1, At, B1); PG8_BAR;
            PG8_LDA(At, 0, 1); PG8_STAGE(PG8_SA(0, 0), a2, voffA);
            PG8_BAR; PG8_WAIT_L(0); PG8_MMA(1, 0, At, B0); PG8_BAR; PG8_SCHED;
            PG8_STAGE(PG8_SB(0, 1), b2 + hstep, voffB);
            PG8_WAIT_V(6); PG8_BAR; PG8_MMA(1, 1, At, B1); PG8_BAR;
            PG8_LDB(B0, 1, 0); PG8_SCHED; PG8_LDA(At, 1, 0); PG8_STAGE(PG8_SA(0, 1), a2 + hstep, voffA);
            PG8_WAIT_L(8); PG8_BAR; PG8_WAIT_L(0); PG8_MMA(0, 0, At, B0); PG8_BAR; PG8_SCHED;
            PG8_LDB(B1, 1, 1); PG8_STAGE(PG8_SB(1, 0), b3, voffB);
            PG8_BAR; PG8_WAIT_L(0); PG8_MMA(0, 1, At, B1); PG8_BAR;
            PG8_LDA(At, 1, 1); PG8_STAGE(PG8_SA(1, 0), a3, voffA);
            PG8_BAR; PG8_WAIT_L(0); PG8_MMA(1, 0, At, B0); PG8_BAR; PG8_SCHED;
            PG8_STAGE(PG8_SB(1, 1), b3 + hstep, voffB);
            PG8_WAIT_V(6); PG8_BAR; PG8_MMA(1, 1, At, B1); PG8_BAR;
        }
        E(acc, cur, wr, wc, fr, fq); S.done(cur);
        if (!has_next) break;
#pragma unroll
        for (int a = 0; a < 2; ++a)
#pragma unroll
            for (int b = 0; b < 2; ++b)
#pragma unroll
                for (int m = 0; m < 4; ++m)
#pragma unroll
                    for (int n = 0; n < 2; ++n) acc[a][b][m][n] = (f32x4){0.f, 0.f, 0.f, 0.f};
        cur = nxt; cA = nA; cB = nB; ++ui;
    }
    PG8_WAIT_V(0);
    if (wr == 0) PG8_BAR;
    PG8_BAR;
#undef PG8_SA
#undef PG8_SB
#undef PG8_STAGE
#undef PG8_LDA
#undef PG8_LDB
#undef PG8_MMA
#undef PG8_WAIT_V
#undef PG8_WAIT_L
#undef PG8_BAR
#undef PG8_SCHED
}
}

using pg8::bf16_t; using pg8::f32x4; using pg8::bf16x8; using pg8::u32x4; using pg8::u32x2;
#define LAS __attribute__((address_space(3)))

constexpr int D = 1024, DFF = 2816, NGU = 5632, NCOLS = 3840;
constexpr int MP = 16384, MS = 512, MT = 16896, MIN_ = 17152;
constexpr int LDS_BYTES = 147456;
constexpr size_t O_SHP = 17301504, O_WKP = O_SHP + 8192, O_RTP = O_WKP + 262144, O_SHS = O_RTP + 524288, O_WKS = O_SHS + 131072, O_RTS = O_WKS + 4194304;
constexpr size_t WS_ROPE = 4096;
constexpr size_t WS_WL   = WS_ROPE + 1050624;
constexpr size_t WS_WOUT = WS_WL + 786432;
constexpr size_t WS_WIN  = WS_WOUT + 2097152;
constexpr size_t WS_WGU  = WS_WIN + 7864320;
constexpr size_t WS_WD   = WS_WGU + 11534336;
constexpr size_t WS_XN   = WS_WD + 5767168;
constexpr size_t WS_BIG  = WS_XN + 35127296;
constexpr size_t WS_FO   = WS_BIG + 95158272;
constexpr size_t WS_YS   = WS_BIG + 131727360;
constexpr size_t WS_LA   = WS_YS + 17301504;
constexpr size_t WS_OMD  = WS_BIG + 164364288;
constexpr size_t WS_ASIG = WS_OMD + 17301504;
constexpr size_t WS_END  = WS_ASIG + 17301504;
static_assert(WS_LA + 8650752 <= WS_OMD, "mixer overlays");
static_assert(WS_END <= 268435456, "workspace");

struct Params {
    const float *x_prompt, *x_sample, *state_shift, *state_wkv, *state_ret, *norm_g, *f1g, *f1u, *f1d, *w_in, *mu, *w0, *w2, *a0, *a2, *g2, *k_k, *k_a, *r_k, *lnx_w, *lnx_b, *gn_w, *w_out, *f2g, *f2u, *f2d;
    float* out; unsigned char* ws;
};
#define CAS __attribute__((address_space(4)))
typedef const CAS Params& PR;

__device__ __forceinline__ float bf2f(unsigned b) { return __uint_as_float(b << 16); }
__device__ __forceinline__ bf16_t f2bf(float f) { unsigned u = __float_as_uint(f); u += 0x7FFFu + ((u >> 16) & 1u); return (bf16_t)(u >> 16); }
__device__ __forceinline__ float lo_bf(unsigned x) { return __uint_as_float(x << 16); }
__device__ __forceinline__ float hi_bf(unsigned x) { return __uint_as_float(x & 0xffff0000u); }
__device__ __forceinline__ float wave_sum(float v) {
#pragma unroll
    for (int o = 32; o > 0; o >>= 1) v += __shfl_xor(v, o, 64);
    return v; }
template <int CTRL> __device__ __forceinline__ float dppf(float v) { return __int_as_float(__builtin_amdgcn_update_dpp(0, __float_as_int(v), CTRL, 0xF, 0xF, false)); }
__device__ __forceinline__ float row16_sum(float v) { v += dppf<0xB1>(v); v += dppf<0x4E>(v); v += dppf<0x141>(v); v += dppf<0x140>(v); return v; }
__device__ __forceinline__ float quad_sum(float v) { v += dppf<0xB1>(v); v += dppf<0x4E>(v); return v; }
__device__ __forceinline__ float sigmoid_f(float x) { return 1.0f / (1.0f + __expf(-x)); }

__device__ __forceinline__ int prev_row(int r) {
    if (r < MP) return (r & 2047) == 0 ? -1 : r - 1;
    const int s = r - MP; return (s & 3) == 0 ? MT + (s >> 2) : r - 1;
}

__device__ __forceinline__ void tconv_tile(const float* __restrict__ W, int K, int N, bf16_t* __restrict__ Bt, int mode, int tile, LAS float* t) {
    const int nkt = K / 64; const int kt = tile % nkt, nt = tile / nkt; const int k0 = kt * 64, n0 = nt * 64;
    const int brow0 = mode == 0 ? n0 : ((n0 >> 7) * 256 + (n0 & 127) + (mode == 2 ? 128 : 0));
    const int tid = fresh_tid();
#pragma unroll
    for (int e = 0; e < 8; ++e) { const int idx = e * 512 + tid, r = idx >> 6, c = idx & 63; t[r * 65 + c] = W[(size_t)(k0 + r) * N + n0 + c]; }
    __syncthreads();
#pragma unroll
    for (int e = 0; e < 4; ++e) { const int idx = e * 512 + tid, n = idx >> 5, kp = idx & 31;
        const unsigned w = pg8::cvt_pk_bf16(t[(2 * kp) * 65 + n], t[(2 * kp + 1) * 65 + n]);
        *(unsigned*)(Bt + (size_t)(brow0 + n) * K + k0 + 2 * kp) = w; }
    __syncthreads();
}
__device__ __forceinline__ void ffn_weights(const float* wg, const float* wu, const float* wd, unsigned char* ws, LAS float* t) {
    for (int i = blockIdx.x; i < 2112; i += gridDim.x) {
        if (i < 704) tconv_tile(wg, 1024, DFF, (bf16_t*)(ws + WS_WGU), 1, i, t);
        else if (i < 1408) tconv_tile(wu, 1024, DFF, (bf16_t*)(ws + WS_WGU), 2, i - 704, t);
        else tconv_tile(wd, DFF, 1024, (bf16_t*)(ws + WS_WD), 0, i - 1408, t);
    }
}

__device__ __forceinline__ void rows_phase(PR P, const int mode) {
    const int tid = fresh_tid(); const int lane = tid & 63; const int gw = blockIdx.x * 8 + (tid >> 6), nw = gridDim.x * 8;
    const float* FO = (const float*)(P.ws + WS_FO); bf16_t* XN = (bf16_t*)(P.ws + WS_XN);
    const float* gpost = P.norm_g + (mode == 1 ? 1 : (mode == 2 ? 3 : 5)) * 1024;
    const float* gnext = P.norm_g + (mode == 0 ? 0 : (mode == 1 ? 2 : 4)) * 1024;
    const float scale = mode == 2 ? 1.0f : 0.5f;
    for (int row = gw; row < MT; row += nw) {
        const float* xin = mode <= 1 ? (row < MP ? P.x_prompt + (size_t)row * 1024 : P.x_sample + (size_t)(row - MP) * 1024) : P.out + (size_t)row * 1024;
        float4 xv[4];
#pragma unroll
        for (int q = 0; q < 4; ++q) xv[q] = *(const float4*)(xin + (q * 64 + lane) * 4);
        if (mode != 0) {
            float4 fo[4]; float ss = 0.f;
#pragma unroll
            for (int q = 0; q < 4; ++q) { fo[q] = *(const float4*)(FO + (size_t)row * 1024 + (q * 64 + lane) * 4); ss += fo[q].x * fo[q].x + fo[q].y * fo[q].y + fo[q].z * fo[q].z + fo[q].w * fo[q].w; }
            ss = wave_sum(ss); const float r = rsqrtf(ss * (1.0f / 1024.0f) + 1e-6f) * scale;
#pragma unroll
            for (int q = 0; q < 4; ++q) { const float4 g = *(const float4*)(gpost + (q * 64 + lane) * 4);
                xv[q].x += fo[q].x * r * g.x; xv[q].y += fo[q].y * r * g.y; xv[q].z += fo[q].z * r * g.z; xv[q].w += fo[q].w * r * g.w;
                *(float4*)(P.out + (size_t)row * 1024 + (q * 64 + lane) * 4) = xv[q]; }
            if (mode == 3) continue;
        }
        float ss2 = 0.f;
#pragma unroll
        for (int q = 0; q < 4; ++q) ss2 += xv[q].x * xv[q].x + xv[q].y * xv[q].y + xv[q].z * xv[q].z + xv[q].w * xv[q].w;
        ss2 = wave_sum(ss2); const float r2 = rsqrtf(ss2 * (1.0f / 1024.0f) + 1e-6f);
        float* sh = nullptr;
        if (mode == 1) { if (row < MP) { if ((row & 2047) == 2047) sh = P.out + O_SHP + (size_t)(row >> 11) * 1024; } else { const int s = row - MP; if ((s & 3) == 3) sh = P.out + O_SHS + (size_t)(s >> 2) * 1024; } }
#pragma unroll
        for (int q = 0; q < 4; ++q) { const float4 g = *(const float4*)(gnext + (q * 64 + lane) * 4);
            float4 hv; hv.x = xv[q].x * r2 * g.x; hv.y = xv[q].y * r2 * g.y; hv.z = xv[q].z * r2 * g.z; hv.w = xv[q].w * r2 * g.w;
            u32x2 w; w.x = pg8::cvt_pk_bf16(hv.x, hv.y); w.y = pg8::cvt_pk_bf16(hv.z, hv.w);
            *(u32x2*)(XN + (size_t)row * 1024 + (q * 64 + lane) * 4) = w;
            if (sh) *(float4*)(sh + (q * 64 + lane) * 4) = hv; }
    }
}

__device__ __forceinline__ void p0_prologue(PR P, LAS float* ldsf) {
    const int tid = fresh_tid(); const size_t gt = (size_t)blockIdx.x * 512 + tid, nth = (size_t)gridDim.x * 512;
    { float* rc = (float*)(P.ws + WS_ROPE); float* rs = rc + 2052 * 64;
      for (size_t i = gt; i < 2052 * 64; i += nth) { const int p = (int)(i >> 6), f = (int)(i & 63); const int pos = p < 2048 ? p : 16384 + (p - 2048);
          double inv = 1.0; for (int q = 0; q < f; ++q) inv *= 0.8659643233600653;
          const double ang = (double)pos * inv; const double n = rint(ang * 0.15915494309189535); const double r = ang - n * 6.283185307179586;
          const double r2 = r * r; double s = 0.0, c = 0.0;
          for (int k = 14; k >= 0; --k) { s = s * (-r2 / (double)((2 * k + 2) * (2 * k + 3))) + 1.0; c = c * (-r2 / (double)((2 * k + 1) * (2 * k + 2))) + 1.0; }
          rc[i] = (float)c; rs[i] = (float)(s * r); } }
    { bf16_t* Wl = (bf16_t*)(P.ws + WS_WL);
      for (size_t i = gt; i < 1536 * 256; i += nth) { const int n = (int)(i >> 8), k = (int)(i & 255); float v = 0.f;
          if (n < 512) { if (k < 64) v = P.w2[k * 512 + n]; } else if (n < 1024) { if (k >= 64 && k < 128) v = P.a2[(k - 64) * 512 + (n - 512)]; } else { if (k >= 128) v = P.g2[(k - 128) * 512 + (n - 1024)]; }
          Wl[i] = f2bf(v); } }
    { bf16_t* XN = (bf16_t*)(P.ws + WS_XN);
      for (size_t i = gt; i < 256 * 1024; i += nth) { const int r = (int)(i >> 10); XN[(size_t)MT * 1024 + i] = r < 128 ? f2bf(P.state_shift[i]) : (bf16_t)0; } }
    ffn_weights(P.f1g, P.f1u, P.f1d, P.ws, ldsf);
    for (int i = blockIdx.x; i < 1216; i += gridDim.x) {
        if (i < 960) tconv_tile(P.w_in, 1024, NCOLS, (bf16_t*)(P.ws + WS_WIN), 0, i, ldsf);
        else tconv_tile(P.w_out, 1024, 1024, (bf16_t*)(P.ws + WS_WOUT), 0, i - 960, ldsf);
    }
    rows_phase(P, 0);
}

__device__ __forceinline__ void lora_prep(PR P) {
    const int tid = fresh_tid(); const int lane = tid & 63; const int gw = blockIdx.x * 8 + (tid >> 6), nw = gridDim.x * 8;
    const bf16_t* PS = (const bf16_t*)(P.ws + WS_BIG); bf16_t* LA = (bf16_t*)(P.ws + WS_LA);
    const float4 mu = *(const float4*)(P.mu + 1536 + lane * 4); const int kind = lane >> 4;
    for (int row = gw; row < MT; row += nw) {
        const u32x2 c = *(const u32x2*)(PS + (size_t)row * NCOLS + 1536 + lane * 4); const int pr = prev_row(row);
        u32x2 p = (u32x2){0u, 0u}; if (pr >= 0) p = *(const u32x2*)(PS + (size_t)pr * NCOLS + 1536 + lane * 4);
        float v[4]; const float cu[4] = {lo_bf(c.x), hi_bf(c.x), lo_bf(c.y), hi_bf(c.y)}, pv[4] = {lo_bf(p.x), hi_bf(p.x), lo_bf(p.y), hi_bf(p.y)}, m4[4] = {mu.x, mu.y, mu.z, mu.w};
#pragma unroll
        for (int j = 0; j < 4; ++j) { float x = cu[j] + (pv[j] - cu[j]) * m4[j];
            if (kind == 0) x = 1.0f - 2.0f / (__expf(2.0f * x) + 1.0f); else if (kind >= 2) x = sigmoid_f(x);
            v[j] = x; }
        u32x2 w; w.x = pg8::cvt_pk_bf16(v[0], v[1]); w.y = pg8::cvt_pk_bf16(v[2], v[3]);
        *(u32x2*)(LA + (size_t)row * 256 + lane * 4) = w;
    }
}

template <bool SAMPLE>
__device__ __forceinline__ void rwkv_unit(PR P, LAS float* lds, const int b, const int h, const int half) {
    constexpr int T = SAMPLE ? 4 : 2048, TC = SAMPLE ? 4 : 32, NCH = T / TC;
    const int tid = fresh_tid(), lane = tid & 63, wid = tid >> 6;
    const bf16_t* PS = (const bf16_t*)(P.ws + WS_BIG); const bf16_t* OMD = (const bf16_t*)(P.ws + WS_OMD); const bf16_t* ASIG = (const bf16_t*)(P.ws + WS_ASIG);
    bf16_t* YS = (bf16_t*)(P.ws + WS_YS);
    const int row_base = SAMPLE ? MP + b * 4 : b * 2048;
    const int ltok = tid >> 4, lcg = tid & 15; const bool lact = ltok < TC; const int hch = h * 64 + lcg * 4;
    const float4 mur = *(const float4*)(P.mu + hch), muk = *(const float4*)(P.mu + 512 + hch), muv = *(const float4*)(P.mu + 1024 + hch);
    const float4 kk4 = *(const float4*)(P.k_k + hch), ka4 = *(const float4*)(P.k_a + hch);
    const int irow = half * 32 + wid * 4 + (lane >> 4), j0 = (lane & 15) * 4;
    float S0 = 0.f, S1 = 0.f, S2 = 0.f, S3 = 0.f;
    float* sout = P.out + (SAMPLE ? O_WKS : O_WKP) + ((size_t)(b * 8 + h) * 64 + irow) * 64 + j0;
    if (SAMPLE) { const float4 s = *(const float4*)(P.state_wkv + ((size_t)(b * 8 + h) * 64 + irow) * 64 + j0); S0 = s.x; S1 = s.y; S2 = s.z; S3 = s.w; }
    LAS float* buf0 = lds; LAS float* buf1 = lds + TC * 384;
    u32x2 cr, ck, cv, pr, pk, pv, co, ca;
#define RW_LOAD(c) do { if (lact) { const int t_ = (c) * TC + ltok; const int row_ = row_base + t_; const int prow_ = SAMPLE ? (t_ == 0 ? MT + b : row_ - 1) : row_ - 1; \
        const bf16_t* cp_ = PS + (size_t)row_ * NCOLS + hch; cr = *(const u32x2*)cp_; ck = *(const u32x2*)(cp_ + 512); cv = *(const u32x2*)(cp_ + 1024); \
        if (SAMPLE || t_ > 0) { const bf16_t* pp_ = PS + (size_t)prow_ * NCOLS + hch; pr = *(const u32x2*)pp_; pk = *(const u32x2*)(pp_ + 512); pv = *(const u32x2*)(pp_ + 1024); } \
        else { pr = (u32x2){0u, 0u}; pk = pr; pv = pr; } \
        co = *(const u32x2*)(OMD + (size_t)row_ * 512 + hch); ca = *(const u32x2*)(ASIG + (size_t)row_ * 512 + hch); } } while (0)
#define RW_MIX(cu, pv_, m) ((cu) + ((pv_) - (cu)) * (m))
#define RW_PROC(dst) do { if (lact) { LAS float* d_ = (dst) + ltok * 384 + lcg * 4; \
        f32x4 r_, k_, v_, o_, a_; \
        r_[0] = RW_MIX(lo_bf(cr.x), lo_bf(pr.x), mur.x); r_[1] = RW_MIX(hi_bf(cr.x), hi_bf(pr.x), mur.y); r_[2] = RW_MIX(lo_bf(cr.y), lo_bf(pr.y), mur.z); r_[3] = RW_MIX(hi_bf(cr.y), hi_bf(pr.y), mur.w); \
        k_[0] = RW_MIX(lo_bf(ck.x), lo_bf(pk.x), muk.x); k_[1] = RW_MIX(hi_bf(ck.x), hi_bf(pk.x), muk.y); k_[2] = RW_MIX(lo_bf(ck.y), lo_bf(pk.y), muk.z); k_[3] = RW_MIX(hi_bf(ck.y), hi_bf(pk.y), muk.w); \
        v_[0] = RW_MIX(lo_bf(cv.x), lo_bf(pv.x), muv.x); v_[1] = RW_MIX(hi_bf(cv.x), hi_bf(pv.x), muv.y); v_[2] = RW_MIX(lo_bf(cv.y), lo_bf(pv.y), muv.z); v_[3] = RW_MIX(hi_bf(cv.y), hi_bf(pv.y), muv.w); \
        o_[0] = lo_bf(co.x); o_[1] = hi_bf(co.x); o_[2] = lo_bf(co.y); o_[3] = hi_bf(co.y); a_[0] = lo_bf(ca.x); a_[1] = hi_bf(ca.x); a_[2] = lo_bf(ca.y); a_[3] = hi_bf(ca.y); \
        f32x4 kk_; kk_[0] = k_[0] * kk4.x; kk_[1] = k_[1] * kk4.y; kk_[2] = k_[2] * kk4.z; kk_[3] = k_[3] * kk4.w; \
        float ss_ = kk_[0] * kk_[0] + kk_[1] * kk_[1] + kk_[2] * kk_[2] + kk_[3] * kk_[3]; ss_ = row16_sum(ss_); \
        const float inv_ = 1.0f / fmaxf(sqrtf(ss_), 1e-12f); kk_ = kk_ * inv_; \
        f32x4 kn_; kn_[0] = k_[0] * (1.0f + (a_[0] - 1.0f) * ka4.x); kn_[1] = k_[1] * (1.0f + (a_[1] - 1.0f) * ka4.y); kn_[2] = k_[2] * (1.0f + (a_[2] - 1.0f) * ka4.z); kn_[3] = k_[3] * (1.0f + (a_[3] - 1.0f) * ka4.w); \
        *(LAS f32x4*)(d_) = r_; *(LAS f32x4*)(d_ + 64) = o_; *(LAS f32x4*)(d_ + 128) = kn_; *(LAS f32x4*)(d_ + 192) = -kk_; *(LAS f32x4*)(d_ + 256) = kk_ * a_; *(LAS f32x4*)(d_ + 320) = v_; } } while (0)
    RW_LOAD(0); RW_PROC(buf0); __syncthreads();
    for (int c = 0; c < NCH; ++c) {
        LAS float* cur = (c & 1) ? buf1 : buf0; LAS float* nxt = (c & 1) ? buf0 : buf1;
        if (c + 1 < NCH) RW_LOAD(c + 1);
#pragma unroll 4
        for (int t = 0; t < TC; ++t) {
            const LAS float* q = cur + t * 384;
            const f32x4 r4 = *(const LAS f32x4*)(q + j0), o4 = *(const LAS f32x4*)(q + 64 + j0), k4 = *(const LAS f32x4*)(q + 128 + j0), a4 = *(const LAS f32x4*)(q + 192 + j0), b4 = *(const LAS f32x4*)(q + 256 + j0);
            const float vi = q[320 + irow];
            float sa = S0 * a4[0] + S1 * a4[1] + S2 * a4[2] + S3 * a4[3]; sa = row16_sum(sa);
            S0 = fmaf(vi, k4[0], fmaf(sa, b4[0], fmaf(-o4[0], S0, S0)));
            S1 = fmaf(vi, k4[1], fmaf(sa, b4[1], fmaf(-o4[1], S1, S1)));
            S2 = fmaf(vi, k4[2], fmaf(sa, b4[2], fmaf(-o4[2], S2, S2)));
            S3 = fmaf(vi, k4[3], fmaf(sa, b4[3], fmaf(-o4[3], S3, S3)));
            float y = S0 * r4[0] + S1 * r4[1] + S2 * r4[2] + S3 * r4[3]; y = row16_sum(y);
            if ((lane & 15) == 0) YS[(size_t)(row_base + c * TC + t) * 512 + h * 64 + irow] = f2bf(y);
        }
        if (c + 1 < NCH) RW_PROC(nxt);
        __syncthreads();
    }
    *(float4*)sout = make_float4(S0, S1, S2, S3);
#undef RW_LOAD
#undef RW_PROC
#undef RW_MIX
}

__device__ __forceinline__ void ret_sample_unit(PR P, LAS float* lds, const int b, const int h) {
    const int tid = fresh_tid(), lane = tid & 63, wid = tid >> 6;
    const bf16_t* PS = (const bf16_t*)(P.ws + WS_BIG); bf16_t* Y = (bf16_t*)(P.ws + WS_XN);
    const float* rc = (const float*)(P.ws + WS_ROPE); const float* rs = rc + 2052 * 64;
    LAS float* q = lds; LAS float* k = lds + 512; LAS float* v = lds + 1024; LAS float* Pm = lds + 1536; LAS float* y2p = lds + 1600; LAS float* red = lds + 1600 + 2048;
    const float lg2 = log2f(1.0f - exp2f(-5.0f - (float)h));
    const int row0 = MP + b * 4;
    { const int t = (tid & 255) >> 6, f = tid & 63; const bf16_t* src = PS + (size_t)(row0 + t) * NCOLS + 1792 + h * 128;
      if (tid < 256) { const float cs = rc[(2048 + t) * 64 + f], sn = rs[(2048 + t) * 64 + f];
          const float q1 = bf2f(src[f]), q2 = bf2f(src[f + 64]); q[t * 128 + f] = q1 * cs - q2 * sn; q[t * 128 + f + 64] = q1 * sn + q2 * cs;
          const float k1 = bf2f(src[512 + f]), k2 = bf2f(src[512 + f + 64]); k[t * 128 + f] = (k1 * cs - k2 * sn) * 0.08838834764831845f; k[t * 128 + f + 64] = (k1 * sn + k2 * cs) * 0.08838834764831845f; }
      else { v[t * 128 + f] = bf2f(src[1024 + f]); v[t * 128 + f + 64] = bf2f(src[1024 + f + 64]); } }
    __syncthreads();
    if (wid == 0) { const int pi = lane >> 4, pj = (lane >> 2) & 3, part = lane & 3; float s = 0.f;
        for (int d = part * 32; d < part * 32 + 32; ++d) s += q[pi * 128 + d] * k[pj * 128 + d];
        s = quad_sum(s); if (part == 0) Pm[pi * 4 + pj] = pi >= pj ? s * exp2f(lg2 * (float)(pi - pj)) : 0.f; }
    { const int e = tid & 127, dg = tid >> 7; const float c4 = exp2f(lg2 * 4.0f), g3 = exp2f(lg2 * 3.0f), g2_ = exp2f(lg2 * 2.0f), g1 = exp2f(lg2);
      const float v0 = v[e] * g3, v1 = v[128 + e] * g2_, v2 = v[256 + e] * g1, v3 = v[384 + e];
      const float* S0 = P.state_ret + ((size_t)(b * 4 + h) * 128) * 128 + e; float* So = P.out + O_RTS + ((size_t)(b * 4 + h) * 128) * 128 + e;
      float a0 = 0.f, a1 = 0.f, a2 = 0.f, a3 = 0.f;
#pragma unroll 4
      for (int d = dg * 32; d < dg * 32 + 32; ++d) { const float s = S0[(size_t)d * 128];
          a0 = fmaf(q[d], s, a0); a1 = fmaf(q[128 + d], s, a1); a2 = fmaf(q[256 + d], s, a2); a3 = fmaf(q[384 + d], s, a3);
          So[(size_t)d * 128] = s * c4 + k[d] * v0 + k[128 + d] * v1 + k[256 + d] * v2 + k[384 + d] * v3; }
      y2p[(dg * 4 + 0) * 128 + e] = a0; y2p[(dg * 4 + 1) * 128 + e] = a1; y2p[(dg * 4 + 2) * 128 + e] = a2; y2p[(dg * 4 + 3) * 128 + e] = a3; }
    __syncthreads();
    { const int i = tid >> 7, e = tid & 127;
      float y = (y2p[(0 + i) * 128 + e] + y2p[(4 + i) * 128 + e] + y2p[(8 + i) * 128 + e] + y2p[(12 + i) * 128 + e]) * exp2f(lg2 * (float)(i + 1));
#pragma unroll
      for (int j = 0; j < 4; ++j) y = fmaf(Pm[i * 4 + j], v[j * 128 + e], y);
      float s = wave_sum(y); if (lane == 0) red[wid] = s; __syncthreads();
      const float mean = (red[i * 2] + red[i * 2 + 1]) * (1.0f / 128.0f); const float dlt = y - mean;
      float s2 = wave_sum(dlt * dlt); if (lane == 0) red[8 + wid] = s2; __syncthreads();
      const float var = (red[8 + i * 2] + red[8 + i * 2 + 1]) * (1.0f / 128.0f);
      const float g = bf2f(PS[(size_t)(row0 + i) * NCOLS + 1792 + 1536 + h * 128 + e]);
      const float o = dlt * rsqrtf(var + 1e-5f) * P.gn_w[h * 128 + e] * (g / (1.0f + __expf(-g)));
      Y[(size_t)(row0 + i) * 1024 + 512 + h * 128 + e] = f2bf(o); }
    __syncthreads();
}

__device__ __forceinline__ void ret_prompt_unit(PR P, LAS unsigned char* lds, const int b, const int h) {
    constexpr int RS = 136, BUFE = 128 * RS;
    LAS bf16_t* QP = (LAS bf16_t*)lds; LAS bf16_t* KB = QP + BUFE; LAS bf16_t* VT = KB + BUFE; LAS bf16_t* ST = VT + BUFE;
    LAS float* YST = (LAS float*)lds;
    const int tid = fresh_tid(), lane = tid & 63, wid = tid >> 6, wr = wid >> 1, wc = wid & 1, fr = lane & 15, fq = lane >> 4;
    const bf16_t* PS = (const bf16_t*)(P.ws + WS_BIG); bf16_t* Y = (bf16_t*)(P.ws + WS_XN);
    const float* rc = (const float*)(P.ws + WS_ROPE); const float* rs = rc + 2052 * 64;
    const float lg2 = log2f(1.0f - exp2f(-5.0f - (float)h)); const float c_dec = exp2f(lg2 * 128.0f);
    f32x4 accS[2][4];
#pragma unroll
    for (int mt = 0; mt < 2; ++mt)
#pragma unroll
        for (int nt = 0; nt < 4; ++nt) accS[mt][nt] = (f32x4){0.f, 0.f, 0.f, 0.f};
    for (int i = tid; i < BUFE / 2; i += 512) ((LAS unsigned*)ST)[i] = 0u;
    float ri[2][4], cj[4];
#pragma unroll
    for (int mt = 0; mt < 2; ++mt)
#pragma unroll
        for (int j = 0; j < 4; ++j) ri[mt][j] = exp2f(lg2 * (float)(wr * 32 + mt * 16 + fq * 4 + j));
#pragma unroll
    for (int nt = 0; nt < 4; ++nt) cj[nt] = exp2f(-lg2 * (float)(wc * 64 + nt * 16 + fr));
    const float gam = exp2f(lg2), kd0 = exp2f(lg2 * (float)(127 - (tid >> 4))), g32 = exp2f(-32.0f * lg2);
    for (int n = 0; n < 16; ++n) {
        const int row0 = b * 2048 + n * 128;
        int tidv = tid; asm volatile("" : "+v"(tidv));
        unsigned kth[4][4]; float kd = kd0;
#pragma unroll
        for (int it = 0; it < 4; ++it) { const int idx = it * 512 + tidv, i = idx >> 4, f = (idx & 15) * 4;
            const bf16_t* src = PS + (size_t)(row0 + i) * NCOLS + 1792 + h * 128;
            const u32x2 q1 = *(const u32x2*)(src + f), q2 = *(const u32x2*)(src + 64 + f), k1 = *(const u32x2*)(src + 512 + f), k2 = *(const u32x2*)(src + 576 + f);
            const float4 cs = *(const float4*)(rc + (size_t)(n * 128 + i) * 64 + f), sn = *(const float4*)(rs + (size_t)(n * 128 + i) * 64 + f);
            const float c4[4] = {cs.x, cs.y, cs.z, cs.w}, s4[4] = {sn.x, sn.y, sn.z, sn.w};
            const float qa[4] = {lo_bf(q1.x), hi_bf(q1.x), lo_bf(q1.y), hi_bf(q1.y)}, qb[4] = {lo_bf(q2.x), hi_bf(q2.x), lo_bf(q2.y), hi_bf(q2.y)};
            const float ka[4] = {lo_bf(k1.x), hi_bf(k1.x), lo_bf(k1.y), hi_bf(k1.y)}, kb[4] = {lo_bf(k2.x), hi_bf(k2.x), lo_bf(k2.y), hi_bf(k2.y)};
            float qo1[4], qo2[4], ko1[4], ko2[4];
#pragma unroll
            for (int x = 0; x < 4; ++x) { qo1[x] = qa[x] * c4[x] - qb[x] * s4[x]; qo2[x] = qa[x] * s4[x] + qb[x] * c4[x];
                ko1[x] = (ka[x] * c4[x] - kb[x] * s4[x]) * 0.08838834764831845f; ko2[x] = (ka[x] * s4[x] + kb[x] * c4[x]) * 0.08838834764831845f; }
            u32x2 w; w.x = pg8::cvt_pk_bf16(qo1[0], qo1[1]); w.y = pg8::cvt_pk_bf16(qo1[2], qo1[3]); *(LAS u32x2*)(QP + i * RS + f) = w;
            w.x = pg8::cvt_pk_bf16(qo2[0], qo2[1]); w.y = pg8::cvt_pk_bf16(qo2[2], qo2[3]); *(LAS u32x2*)(QP + i * RS + 64 + f) = w;
            w.x = pg8::cvt_pk_bf16(ko1[0], ko1[1]); w.y = pg8::cvt_pk_bf16(ko1[2], ko1[3]); *(LAS u32x2*)(KB + i * RS + f) = w;
            w.x = pg8::cvt_pk_bf16(ko2[0], ko2[1]); w.y = pg8::cvt_pk_bf16(ko2[2], ko2[3]); *(LAS u32x2*)(KB + i * RS + 64 + f) = w;
            kth[it][0] = pg8::cvt_pk_bf16(ko1[0] * kd, ko1[1] * kd); kth[it][1] = pg8::cvt_pk_bf16(ko1[2] * kd, ko1[3] * kd);
            kth[it][2] = pg8::cvt_pk_bf16(ko2[0] * kd, ko2[1] * kd); kth[it][3] = pg8::cvt_pk_bf16(ko2[2] * kd, ko2[3] * kd); kd *= g32; if (it & 1) __builtin_amdgcn_sched_barrier(0); }
#pragma unroll
        for (int it = 0; it < 4; ++it) { const int idx = it * 512 + tidv, j = idx >> 4, e = (idx & 15) * 8;
            const u32x4 vv = *(const u32x4*)(PS + (size_t)(row0 + j) * NCOLS + 1792 + 1024 + h * 128 + e);
            LAS bf16_t* d = VT + e * RS + j;
            d[0] = (bf16_t)(vv.x & 0xffffu); d[RS] = (bf16_t)(vv.x >> 16); d[2 * RS] = (bf16_t)(vv.y & 0xffffu); d[3 * RS] = (bf16_t)(vv.y >> 16);
            d[4 * RS] = (bf16_t)(vv.z & 0xffffu); d[5 * RS] = (bf16_t)(vv.z >> 16); d[6 * RS] = (bf16_t)(vv.w & 0xffffu); d[7 * RS] = (bf16_t)(vv.w >> 16); }
        __syncthreads();
        f32x4 accP[2][4], accY[2][4];
#pragma unroll
        for (int mt = 0; mt < 2; ++mt)
#pragma unroll
            for (int nt = 0; nt < 4; ++nt) { accP[mt][nt] = (f32x4){0.f, 0.f, 0.f, 0.f}; accY[mt][nt] = (f32x4){0.f, 0.f, 0.f, 0.f}; }
#pragma unroll
        for (int ks = 0; ks < 4; ++ks) { bf16x8 aq[2];
#pragma unroll
            for (int mt = 0; mt < 2; ++mt) aq[mt] = *(const LAS bf16x8*)(QP + (wr * 32 + mt * 16 + fr) * RS + ks * 32 + fq * 8);
#pragma unroll
            for (int nt = 0; nt < 4; ++nt) { const bf16x8 bk = *(const LAS bf16x8*)(KB + (wc * 64 + nt * 16 + fr) * RS + ks * 32 + fq * 8), bs = *(const LAS bf16x8*)(ST + (wc * 64 + nt * 16 + fr) * RS + ks * 32 + fq * 8);
#pragma unroll
                for (int mt = 0; mt < 2; ++mt) { accP[mt][nt] = __builtin_amdgcn_mfma_f32_16x16x32_bf16(aq[mt], bk, accP[mt][nt], 0, 0, 0); accY[mt][nt] = __builtin_amdgcn_mfma_f32_16x16x32_bf16(aq[mt], bs, accY[mt][nt], 0, 0, 0); } }
            __builtin_amdgcn_sched_barrier(0); }
#pragma unroll
        for (int mt = 0; mt < 2; ++mt)
#pragma unroll
            for (int j = 0; j < 4; ++j) { const float qd = ri[mt][j] * gam;
#pragma unroll
                for (int nt = 0; nt < 4; ++nt) accY[mt][nt][j] *= qd; }
        __syncthreads();
#pragma unroll
        for (int mt = 0; mt < 2; ++mt)
#pragma unroll
            for (int nt = 0; nt < 4; ++nt)
#pragma unroll
                for (int j = 0; j < 4; ++j) { const int i = wr * 32 + mt * 16 + fq * 4 + j, jj = wc * 64 + nt * 16 + fr;
                    const float val = i >= jj ? accP[mt][nt][j] * ri[mt][j] * cj[nt] : 0.f; QP[i * RS + jj] = f2bf(val); }
#pragma unroll
        for (int it = 0; it < 4; ++it) { const int idx = it * 512 + tidv, j = idx >> 4, f = (idx & 15) * 4; LAS bf16_t* d = KB + f * RS + j;
            d[0] = (bf16_t)(kth[it][0] & 0xffffu); d[RS] = (bf16_t)(kth[it][0] >> 16); d[2 * RS] = (bf16_t)(kth[it][1] & 0xffffu); d[3 * RS] = (bf16_t)(kth[it][1] >> 16);
            LAS bf16_t* d2 = d + 64 * RS;
            d2[0] = (bf16_t)(kth[it][2] & 0xffffu); d2[RS] = (bf16_t)(kth[it][2] >> 16); d2[2 * RS] = (bf16_t)(kth[it][3] & 0xffffu); d2[3 * RS] = (bf16_t)(kth[it][3] >> 16); }
        __syncthreads();
#pragma unroll
        for (int mt = 0; mt < 2; ++mt)
#pragma unroll
            for (int nt = 0; nt < 4; ++nt) accS[mt][nt] = accS[mt][nt] * c_dec;
#pragma unroll
        for (int ks = 0; ks < 4; ++ks) { bf16x8 ap[2], av[2];
#pragma unroll
            for (int mt = 0; mt < 2; ++mt) { ap[mt] = *(const LAS bf16x8*)(QP + (wr * 32 + mt * 16 + fr) * RS + ks * 32 + fq * 8); av[mt] = *(const LAS bf16x8*)(VT + (wr * 32 + mt * 16 + fr) * RS + ks * 32 + fq * 8); }
#pragma unroll
            for (int nt = 0; nt < 4; ++nt) { const bf16x8 bv = *(const LAS bf16x8*)(VT + (wc * 64 + nt * 16 + fr) * RS + ks * 32 + fq * 8), bkt = *(const LAS bf16x8*)(KB + (wc * 64 + nt * 16 + fr) * RS + ks * 32 + fq * 8);
#pragma unroll
                for (int mt = 0; mt < 2; ++mt) { accY[mt][nt] = __builtin_amdgcn_mfma_f32_16x16x32_bf16(ap[mt], bv, accY[mt][nt], 0, 0, 0); accS[mt][nt] = __builtin_amdgcn_mfma_f32_16x16x32_bf16(av[mt], bkt, accS[mt][nt], 0, 0, 0); } }
            __builtin_amdgcn_sched_barrier(0); }
        __syncthreads();
#pragma unroll
        for (int mt = 0; mt < 2; ++mt)
#pragma unroll
            for (int nt = 0; nt < 4; ++nt)
#pragma unroll
                for (int j = 0; j < 4; ++j) { const int r = wr * 32 + mt * 16 + fq * 4 + j, c = wc * 64 + nt * 16 + fr;
                    ST[r * RS + c] = f2bf(accS[mt][nt][j]); YST[r * 132 + c] = accY[mt][nt][j]; }
        __syncthreads();
        { const int i = tidv >> 2, part = tidv & 3; float yv[32]; float s = 0.f;
#pragma unroll
          for (int x = 0; x < 8; ++x) { const f32x4 t4 = *(const LAS f32x4*)(YST + i * 132 + part * 32 + x * 4); yv[x * 4] = t4[0]; yv[x * 4 + 1] = t4[1]; yv[x * 4 + 2] = t4[2]; yv[x * 4 + 3] = t4[3]; s += t4[0] + t4[1] + t4[2] + t4[3]; }
          s = quad_sum(s); const float mean = s * (1.0f / 128.0f); float s2 = 0.f;
#pragma unroll
          for (int x = 0; x < 32; ++x) { yv[x] -= mean; s2 += yv[x] * yv[x]; }
          s2 = quad_sum(s2); const float rstd = rsqrtf(s2 * (1.0f / 128.0f) + 1e-5f);
          const bf16_t* gp = PS + (size_t)(row0 + i) * NCOLS + 1792 + 1536 + h * 128 + part * 32; const float* gw = P.gn_w + h * 128 + part * 32;
          bf16_t* yo = Y + (size_t)(row0 + i) * 1024 + 512 + h * 128 + part * 32;
#pragma unroll
          for (int x = 0; x < 4; ++x) { const u32x4 g4 = *(const u32x4*)(gp + x * 8); const float4 w0 = *(const float4*)(gw + x * 8), w1 = *(const float4*)(gw + x * 8 + 4);
              const float gg[8] = {lo_bf(g4.x), hi_bf(g4.x), lo_bf(g4.y), hi_bf(g4.y), lo_bf(g4.z), hi_bf(g4.z), lo_bf(g4.w), hi_bf(g4.w)}; const float ww[8] = {w0.x, w0.y, w0.z, w0.w, w1.x, w1.y, w1.z, w1.w};
              float o[8];
#pragma unroll
              for (int z = 0; z < 8; ++z) o[z] = yv[x * 8 + z] * rstd * ww[z] * (gg[z] / (1.0f + __expf(-gg[z])));
              u32x4 w; w.x = pg8::cvt_pk_bf16(o[0], o[1]); w.y = pg8::cvt_pk_bf16(o[2], o[3]); w.z = pg8::cvt_pk_bf16(o[4], o[5]); w.w = pg8::cvt_pk_bf16(o[6], o[7]);
              *(u32x4*)(yo + x * 8) = w; } }
        __syncthreads();
    }
#pragma unroll
    for (int mt = 0; mt < 2; ++mt)
#pragma unroll
        for (int nt = 0; nt < 4; ++nt)
#pragma unroll
            for (int j = 0; j < 4; ++j) { const int e = wr * 32 + mt * 16 + fq * 4 + j, d = wc * 64 + nt * 16 + fr;
                P.out[O_RTP + ((size_t)(b * 4 + h) * 128 + d) * 128 + e] = accS[mt][nt][j]; }
}

__device__ __forceinline__ void rwkv_post(PR P) {
    const int tid = fresh_tid(); const int lane = tid & 63; const int gw = blockIdx.x * 8 + (tid >> 6), nw = gridDim.x * 8;
    const bf16_t* PS = (const bf16_t*)(P.ws + WS_BIG); const bf16_t* ASIG = (const bf16_t*)(P.ws + WS_ASIG); const bf16_t* YS = (const bf16_t*)(P.ws + WS_YS);
    const bf16_t* G = (const bf16_t*)(P.ws + WS_WIN); bf16_t* Y = (bf16_t*)(P.ws + WS_XN);
    for (int task = gw; task < MT * 8; task += nw) { const int row = task >> 3, h = task & 7, ch = h * 64 + lane;
        const float ys = bf2f(YS[(size_t)row * 512 + ch]);
        const float mean = wave_sum(ys) * (1.0f / 64.0f); const float dl = ys - mean; const float var = wave_sum(dl * dl) * (1.0f / 64.0f);
        const float yn = dl * rsqrtf(var + 64e-5f) * P.lnx_w[ch] + P.lnx_b[ch];
        const bf16_t* cp = PS + (size_t)row * NCOLS + ch; const int pr = prev_row(row);
        float r = bf2f(cp[0]), k = bf2f(cp[512]), v = bf2f(cp[1024]); float pr_r = 0.f, pr_k = 0.f, pr_v = 0.f;
        if (pr >= 0) { const bf16_t* pp = PS + (size_t)pr * NCOLS + ch; pr_r = bf2f(pp[0]); pr_k = bf2f(pp[512]); pr_v = bf2f(pp[1024]); }
        r += (pr_r - r) * P.mu[ch]; k += (pr_k - k) * P.mu[512 + ch]; v += (pr_v - v) * P.mu[1024 + ch];
        const float a = bf2f(ASIG[(size_t)row * 512 + ch]); const float kn = k * (1.0f + (a - 1.0f) * P.k_a[ch]);
        const float bonus = wave_sum(r * kn * P.r_k[ch]) * v;
        const float g = bf2f(G[(size_t)row * 512 + ch]);
        Y[(size_t)row * 1024 + ch] = f2bf((yn + bonus) * g);
    }
}

__global__ void __launch_bounds__(512, 2) hymba_mega(Params P_unused) {
    extern __shared__ __attribute__((aligned(16))) unsigned char shm[];
    cg::grid_group grid = cg::this_grid();
    LAS unsigned char* lds = (LAS unsigned char*)shm; LAS float* ldsf = (LAS float*)shm;
    const int G = gridDim.x, bx = blockIdx.x;
    const CAS Params* kp = (const CAS Params*)__builtin_amdgcn_kernarg_segment_ptr();
#define P (*kp)
#define FRESH() asm volatile("" : "+s"(kp))
    unsigned char* ws = P.ws;
    bf16_t* XN = (bf16_t*)(ws + WS_XN); bf16_t* ACT = (bf16_t*)(ws + WS_BIG); float* FO = (float*)(ws + WS_FO); bf16_t* PS = (bf16_t*)(ws + WS_BIG);
    pg8::StaticOrder S;
#ifndef PHM
#define PHM 0xFFFF
#endif
#define PH(k) if ((PHM >> (k)) & 1)
    PH(0) p0_prologue(P, ldsf);
    grid.sync(); FRESH();
    PH(1) { pg8::Gemm g{XN, (const bf16_t*)(ws + WS_WGU), MT, NGU, 1024}; S.init(MT, NGU, G, bx); pg8::EpiSwiGLU E{ACT, DFF}; pg8::gemm_phase(lds, g, S, E); }
    grid.sync(); FRESH();
    PH(2) { pg8::Gemm g{ACT, (const bf16_t*)(ws + WS_WD), MT, 1024, DFF}; S.init(MT, 1024, G, bx); pg8::EpiF32 E{FO, 1024}; pg8::gemm_phase(lds, g, S, E); }
    grid.sync(); FRESH();
    PH(3) rows_phase(P, 1);
    grid.sync(); FRESH();
    PH(4) { pg8::Gemm g{XN, (const bf16_t*)(ws + WS_WIN), MIN_, NCOLS, 1024}; S.init(MIN_, NCOLS, G, bx); pg8::EpiBf16 E{PS, NCOLS}; pg8::gemm_phase(lds, g, S, E); }
    grid.sync(); FRESH();
    PH(5) lora_prep(P);
    grid.sync(); FRESH();
    PH(6) { pg8::Gemm g{(const bf16_t*)(ws + WS_LA), (const bf16_t*)(ws + WS_WL), MT, 1536, 256}; S.init(MT, 1536, G, bx);
      pg8::EpiLora E{(bf16_t*)(ws + WS_OMD), (bf16_t*)(ws + WS_ASIG), (bf16_t*)(ws + WS_WIN), P.w0, P.a0}; pg8::gemm_phase(lds, g, S, E); }
    grid.sync(); FRESH();
    PH(7) for (int u = bx; u < 160; u += G) {
#ifndef NO_RWKVP
        if (u < 128) rwkv_unit<false>(P, ldsf, u >> 4, (u >> 1) & 7, u & 1);
#endif
#ifndef NO_RETP
        if (u >= 128) ret_prompt_unit(P, lds, (u - 128) >> 2, (u - 128) & 3);
#endif
    }
    PH(14) { const int sb0 = G > 192 ? 160 : 0;
      for (int u = bx - sb0; u >= 0 && u < 2560; u += G - sb0) { if (u < 2048) rwkv_unit<true>(P, ldsf, u >> 4, (u >> 1) & 7, u & 1); else ret_sample_unit(P, ldsf, (u - 2048) >> 2, (u - 2048) & 3); } }
    grid.sync(); FRESH();
    PH(8) rwkv_post(P);
    grid.sync(); FRESH();
    PH(9) { pg8::Gemm g{XN, (const bf16_t*)(ws + WS_WOUT), MT, 1024, 1024}; S.init(MT, 1024, G, bx); pg8::EpiF32 E{FO, 1024}; pg8::gemm_phase(lds, g, S, E); }
    grid.sync(); FRESH();
    PH(10) { ffn_weights(P.f2g, P.f2u, P.f2d, ws, ldsf);
    rows_phase(P, 2); }
    grid.sync(); FRESH();
    PH(11) { pg8::Gemm g{XN, (const bf16_t*)(ws + WS_WGU), MT, NGU, 1024}; S.init(MT, NGU, G, bx); pg8::EpiSwiGLU E{ACT, DFF}; pg8::gemm_phase(lds, g, S, E); }
    grid.sync(); FRESH();
    PH(12) { pg8::Gemm g{ACT, (const bf16_t*)(ws + WS_WD), MT, 1024, DFF}; S.init(MT, 1024, G, bx); pg8::EpiF32 E{FO, 1024}; pg8::gemm_phase(lds, g, S, E); }
    grid.sync(); FRESH();
    PH(13) rows_phase(P, 3);
}

extern "C" void kernel_launch(void* const* d_in, const int* in_sizes, int n_in, void* d_out, int out_size, void* d_ws, size_t ws_size, hipStream_t stream) {
    static int grid = 0;
    if (grid == 0) {
        if (n_in != 26 || ws_size < WS_END) { fprintf(stderr, "kernel_launch: unexpected n_in %d or ws_size %zu (< %zu)\n", n_in, ws_size, (size_t)WS_END); grid = -1; return; }
        int dev = 0, cus = 0, per_cu = 0;
        hipGetDevice(&dev); hipDeviceGetAttribute(&cus, hipDeviceAttributeMultiprocessorCount, dev);
        hipFuncSetAttribute((const void*)hymba_mega, hipFuncAttributeMaxDynamicSharedMemorySize, LDS_BYTES);
        hipOccupancyMaxActiveBlocksPerMultiprocessor(&per_cu, (const void*)hymba_mega, 512, LDS_BYTES);
        if (per_cu < 1) { fprintf(stderr, "kernel_launch: occupancy query says %d blocks/CU\n", per_cu); per_cu = 1; }
        grid = cus * per_cu; if (grid > 256) grid = 256;
        fprintf(stderr, "kernel_launch: cus %d per_cu %d grid %d ws %zu\n", cus, per_cu, grid, ws_size);
    }
    if (grid < 0) return;
    Params p{};
    const float** pp = (const float**)&p;
    for (int i = 0; i < 26; ++i) pp[i] = (const float*)d_in[i];
    p.out = (float*)d_out; p.ws = (unsigned char*)d_ws;
    void* args[] = {&p};
    hipError_t e = hipLaunchCooperativeKernel((const void*)hymba_mega, dim3(grid), dim3(512), args, LDS_BYTES, stream);
    if (e != hipSuccess) fprintf(stderr, "cooperative launch failed: %s (grid %d)\n", hipGetErrorString(e), grid);
}
```

```cpp
#include <hip/hip_runtime.h>
#include <hip/hip_cooperative_groups.h>
#include <cstdio>
#include <cstdint>
namespace cg = cooperative_groups;

__device__ __forceinline__ int fresh_tid(int wv) { int l; asm volatile("v_mbcnt_lo_u32_b32 %0, -1, 0\n\tv_mbcnt_hi_u32_b32 %0, -1, %0" : "=v"(l)); return wv * 64 + l; }
namespace pg8 {
#define PG8_LAS __attribute__((address_space(3)))
typedef unsigned short bf16_t;
typedef short bf16x8 __attribute__((ext_vector_type(8)));
typedef float f32x4 __attribute__((ext_vector_type(4)));
typedef unsigned u32x4 __attribute__((ext_vector_type(4)));
typedef unsigned u32x2 __attribute__((ext_vector_type(2)));
constexpr int BM = 256, BK = 64, HALF = 128, HTB = HALF * BK * 2, STAGE_BYTES = 8 * HTB, NXCD = 8, WGM = 8;

__host__ __device__ __forceinline__ int lds_byte(int r, int c) { const int st = (r >> 4) * 2 + (c >> 5), rr = r & 15, cc = c & 31, ob = rr * 64 + cc * 2; return st * 1024 + (ob ^ (((ob >> 9) & 1) << 5)); }
__host__ __device__ __forceinline__ void stage_rc(int b, int& R, int& C) { const int st = b / 1024, sb = b % 1024, swz = sb ^ (((sb >> 9) & 1) << 5); R = (st >> 1) * 16 + swz / 64; C = (st & 1) * 32 + (swz % 64) / 2; }
__host__ __device__ __forceinline__ int perm32(int rho) { const int n = rho >> 4, i = rho & 15; return 8 * (i >> 2) + 4 * n + (i & 3); }

struct Unit { int pm, pn; };
struct Gemm { const bf16_t* A; const bf16_t* Bt; int M, N, K; };

struct StaticOrder {
    int nM, nN, nwg, G, c;
    __host__ __device__ void init(int M, int N, int G_, int c_) { nM = M / BM; nN = N / BM; nwg = nM * nN; G = G_; c = c_; }
    __host__ __device__ bool next(int i, Unit& u) const {
        const long L = (long)i * G + c; if (L >= nwg) return false;
        int wgid = (int)L; { const int q = nwg / NXCD, r = nwg % NXCD, xcd = wgid % NXCD, off = wgid / NXCD; wgid = (xcd < r ? xcd * (q + 1) : r * (q + 1) + (xcd - r) * q) + off; }
        const int nig = WGM * nN, gid = wgid / nig, fm = gid * WGM, gsz = (nM - fm) < WGM ? (nM - fm) : WGM;
        u.pm = fm + ((wgid % nig) % gsz); u.pn = (wgid % nig) / gsz; return true;
    }
    __device__ __forceinline__ void a_ready(const Unit&) const {}
    __device__ __forceinline__ void done(const Unit&) const {}
};

__device__ __forceinline__ unsigned cvt_pk_bf16(float lo, float hi) { unsigned r; asm volatile("v_cvt_pk_bf16_f32 %0, %1, %2" : "=v"(r) : "v"(lo), "v"(hi)); return r; }

struct EpiF32 {
    static constexpr bool PERM = false;
    float* C; int ldc;
    __device__ __forceinline__ void operator()(const f32x4 (&acc)[2][2][4][2], const Unit& u, int wr, int wc, int fr, int fq) const {
        const int row0 = u.pm * BM + wr * 64 + fr, col0 = u.pn * BM + wc * 32 + 4 * fq;
#pragma unroll
        for (int ai = 0; ai < 2; ++ai)
#pragma unroll
            for (int m = 0; m < 4; ++m) { float* rowp = C + (size_t)(row0 + ai * HALF + m * 16) * ldc + col0;
#pragma unroll
                for (int bj = 0; bj < 2; ++bj)
#pragma unroll
                    for (int n = 0; n < 2; ++n) *(f32x4*)(rowp + bj * HALF + n * 16) = acc[ai][bj][m][n]; }
    }
};
struct EpiBf16 {
    static constexpr bool PERM = true;
    bf16_t* O; int ldc;
    __device__ __forceinline__ void operator()(const f32x4 (&acc)[2][2][4][2], const Unit& u, int wr, int wc, int fr, int fq) const {
        const int row0 = u.pm * BM + wr * 64 + fr; const int col0 = u.pn * BM + wc * 32 + 8 * fq;
#pragma unroll
        for (int ai = 0; ai < 2; ++ai)
#pragma unroll
            for (int m = 0; m < 4; ++m) { bf16_t* rowp = O + (size_t)(row0 + ai * HALF + m * 16) * ldc + col0;
#pragma unroll
                for (int bj = 0; bj < 2; ++bj) { const f32x4 v0 = acc[ai][bj][m][0], v1 = acc[ai][bj][m][1];
                    u32x4 w; w.x = cvt_pk_bf16(v0[0], v0[1]); w.y = cvt_pk_bf16(v0[2], v0[3]); w.z = cvt_pk_bf16(v1[0], v1[1]); w.w = cvt_pk_bf16(v1[2], v1[3]);
                    *(u32x4*)(rowp + bj * HALF) = w; } }
    }
};
__device__ __forceinline__ float silu_f(float x) { return x / (1.0f + __expf(-x)); }
struct EpiSwiGLU {
    static constexpr bool PERM = true;
    bf16_t* O; int ldc;
    __device__ __forceinline__ void operator()(const f32x4 (&acc)[2][2][4][2], const Unit& u, int wr, int wc, int fr, int fq) const {
        const int row0 = u.pm * BM + wr * 64 + fr; const int col0 = u.pn * HALF + wc * 32 + 8 * fq;
#pragma unroll
        for (int ai = 0; ai < 2; ++ai)
#pragma unroll
            for (int m = 0; m < 4; ++m) { bf16_t* rowp = O + (size_t)(row0 + ai * HALF + m * 16) * ldc + col0;
                float o[8];
#pragma unroll
                for (int n = 0; n < 2; ++n)
#pragma unroll
                    for (int j = 0; j < 4; ++j) o[n * 4 + j] = silu_f(acc[ai][0][m][n][j]) * acc[ai][1][m][n][j];
                u32x4 w; w.x = cvt_pk_bf16(o[0], o[1]); w.y = cvt_pk_bf16(o[2], o[3]); w.z = cvt_pk_bf16(o[4], o[5]); w.w = cvt_pk_bf16(o[6], o[7]);
                *(u32x4*)rowp = w; }
    }
};
struct EpiLora {
    static constexpr bool PERM = true;
    bf16_t* OMD; bf16_t* ASIG; bf16_t* G; const float* w0; const float* a0;
    template <int KIND> __device__ __forceinline__ void body(const f32x4 (&acc)[2][2][4][2], bf16_t* O, const float* bias, int row0, int ch0) const {
#pragma unroll
        for (int bj = 0; bj < 2; ++bj)
#pragma unroll
            for (int ai = 0; ai < 2; ++ai)
#pragma unroll
                for (int m = 0; m < 4; ++m) { bf16_t* rowp = O + (size_t)(row0 + ai * HALF + m * 16) * 512 + ch0 + bj * HALF;
                    float o[8];
#pragma unroll
                    for (int n = 0; n < 2; ++n)
#pragma unroll
                        for (int j = 0; j < 4; ++j) { float v = acc[ai][bj][m][n][j];
                            if (KIND == 0) { v += bias[ch0 + bj * HALF + n * 4 + j]; const float nv = -v; const float sp = fmaxf(nv, 0.f) + __logf(1.0f + __expf(-fabsf(nv)));
                                const float e = __expf(-sp - 0.5f);
                                float p = 1.0f / 40320.0f; p = -1.0f / 5040.0f + e * p; p = 1.0f / 720.0f + e * p; p = -1.0f / 120.0f + e * p; p = 1.0f / 24.0f + e * p; p = -1.0f / 6.0f + e * p; p = 0.5f + e * p; p = 1.0f - e * p;
                                v = e * p; }
                            else if (KIND == 1) { v += bias[ch0 + bj * HALF + n * 4 + j]; v = 1.0f / (1.0f + __expf(-v)); }
                            o[n * 4 + j] = v; }
                    u32x4 w; w.x = cvt_pk_bf16(o[0], o[1]); w.y = cvt_pk_bf16(o[2], o[3]); w.z = cvt_pk_bf16(o[4], o[5]); w.w = cvt_pk_bf16(o[6], o[7]);
                    *(u32x4*)rowp = w; __builtin_amdgcn_sched_barrier(0); }
    }
    __device__ __forceinline__ void operator()(const f32x4 (&acc)[2][2][4][2], const Unit& u, int wr, int wc, int fr, int fq) const {
        const int kind = u.pn >> 1;
        const int row0 = u.pm * BM + wr * 64 + fr; const int ch0 = (u.pn & 1) * BM + wc * 32 + 8 * fq;
        if (kind == 0) body<0>(acc, OMD, w0, row0, ch0); else if (kind == 1) body<1>(acc, ASIG, a0, row0, ch0); else body<2>(acc, G, a0, row0, ch0);
    }
};

template <class Epi, class Sched>
__device__ __forceinline__ void gemm_phase(PG8_LAS unsigned char* lds, const Gemm g, const Sched& S, const Epi& E, const int wv) {
    const int tid = fresh_tid(wv), wid = __builtin_amdgcn_readfirstlane(tid >> 6), lane = tid & 63, wr = wid >> 2, wc = wid & 3, fr = lane & 15, fq = lane >> 4;
    const int K = g.K, nt = K / BK;
    unsigned voffA[2], voffB[2];
#pragma unroll
    for (int i = 0; i < 2; ++i) { int R, C; stage_rc(tid * 16 + i * 8192, R, C); const int Rb = Epi::PERM ? ((R & ~31) + perm32(R & 31)) : R;
        voffA[i] = (unsigned)(R * K + C) * 2u; voffB[i] = (unsigned)(Rb * K + C) * 2u; }
    const size_t kstep = (size_t)(BK * 2);
    const size_t hstep = (size_t)HALF * K * 2;
    const size_t tstep = 2 * hstep;
    const unsigned ldsw = (unsigned)wid * 1024u;
    const int aoff = lds_byte(wr * 64 + fr, fq * 8), boff = lds_byte(wc * 32 + fr, fq * 8);
#define PG8_SA(b, h) (((b) * 2 + (h)) * HTB)
#define PG8_SB(b, h) ((4 + (b) * 2 + (h)) * HTB)
#define PG8_STAGE(bufoff, gbase, voff) do { _Pragma("unroll") for (int _i = 0; _i < 2; ++_i) \
        __builtin_amdgcn_global_load_lds((const unsigned*)((const char*)(gbase) + (voff)[_i]), (PG8_LAS unsigned*)(lds + (bufoff) + ldsw + _i * 8192), 16, 0, 0); } while (0)
#define PG8_LDA(dst, b, h) do { _Pragma("unroll") for (int m = 0; m < 4; ++m) _Pragma("unroll") for (int k = 0; k < 2; ++k) dst[m][k] = *(const PG8_LAS bf16x8*)(lds + PG8_SA(b, h) + aoff + m * 2048 + k * 1024); } while (0)
#define PG8_LDB(dst, b, h) do { _Pragma("unroll") for (int n = 0; n < 2; ++n) _Pragma("unroll") for (int k = 0; k < 2; ++k) dst[n][k] = *(const PG8_LAS bf16x8*)(lds + PG8_SB(b, h) + boff + n * 2048 + k * 1024); } while (0)
#define PG8_MMA(ai, bj, At, Bt) do { __builtin_amdgcn_s_setprio(1); _Pragma("unroll") for (int m = 0; m < 4; ++m) _Pragma("unroll") for (int n = 0; n < 2; ++n) _Pragma("unroll") for (int k = 0; k < 2; ++k) \
        acc[ai][bj][m][n] = __builtin_amdgcn_mfma_f32_16x16x32_bf16(Bt[n][k], At[m][k], acc[ai][bj][m][n], 0, 0, 0); __builtin_amdgcn_s_setprio(0); } while (0)
#define PG8_WAIT_V(n) asm volatile("s_waitcnt vmcnt(" #n ")" ::: "memory")
#define PG8_WAIT_L(n) asm volatile("s_waitcnt lgkmcnt(" #n ")" ::: "memory")
#define PG8_BAR __builtin_amdgcn_s_barrier()
#define PG8_SCHED __builtin_amdgcn_sched_barrier(0)
    Unit cur, nxt; int ui = 0;
    if (!S.next(0, cur)) return;
    f32x4 acc[2][2][4][2];
#pragma unroll
    for (int a = 0; a < 2; ++a)
#pragma unroll
        for (int b = 0; b < 2; ++b)
#pragma unroll
            for (int m = 0; m < 4; ++m)
#pragma unroll
                for (int n = 0; n < 2; ++n) acc[a][b][m][n] = (f32x4){0.f, 0.f, 0.f, 0.f};
    bf16x8 At[4][2], B0[2][2], B1[2][2];
    const char* cA = (const char*)g.A + (size_t)cur.pm * tstep; const char* cB = (const char*)g.Bt + (size_t)cur.pn * tstep;
    S.a_ready(cur);
    PG8_STAGE(PG8_SB(0, 0), cB, voffB); PG8_STAGE(PG8_SA(0, 0), cA, voffA); PG8_STAGE(PG8_SB(0, 1), cB + hstep, voffB); PG8_STAGE(PG8_SA(0, 1), cA + hstep, voffA);
    if (wr == 1) PG8_BAR;
    PG8_WAIT_V(4); PG8_BAR;
    PG8_STAGE(PG8_SB(1, 0), cB + kstep, voffB); PG8_STAGE(PG8_SA(1, 0), cA + kstep, voffA); PG8_STAGE(PG8_SB(1, 1), cB + hstep + kstep, voffB);
    PG8_WAIT_V(6); PG8_BAR;
    for (;;) {
        const bool has_next = S.next(ui + 1, nxt);
        const char* nA = has_next ? (const char*)g.A + (size_t)nxt.pm * tstep : cA; const char* nB = has_next ? (const char*)g.Bt + (size_t)nxt.pn * tstep : cB;
        for (int t = 0; t < nt; t += 2) {
            const bool last = (t == nt - 2);
            const char* a1 = cA + (size_t)(t + 1) * kstep;
            const char* a2 = last ? nA : cA + (size_t)(t + 2) * kstep; const char* b2 = last ? nB : cB + (size_t)(t + 2) * kstep;
            const char* a3 = a2 + kstep; const char* b3 = b2 + kstep;
            if (last && has_next) S.a_ready(nxt);
            PG8_LDB(B0, 0, 0); PG8_SCHED; PG8_LDA(At, 0, 0); PG8_STAGE(PG8_SA(1, 1), a1 + hstep, voffA);
            PG8_WAIT_L(8); PG8_BAR; PG8_WAIT_L(0); PG8_MMA(0, 0, At, B0); PG8_BAR; PG8_SCHED;
            PG8_LDB(B1, 0, 1); PG8_STAGE(PG8_SB(0, 0), b2, voffB);
            PG8_BAR; PG8_WAIT_L(0); PG8_MMA(0, 1, At, B1); PG8_BAR;
            PG8_LDA(At, 0, 1); PG8_STAGE(PG8_SA(0, 0), a2, voffA);
            PG8_BAR; PG8_WAIT_L(0); PG8_MMA(1, 0, At, B0); PG8_BAR; PG8_SCHED;
            PG8_STAGE(PG8_SB(0, 1), b2 + hstep, voffB);
            PG8_WAIT_V(6); PG8_BAR; PG8_MMA(1, 1, At, B1); PG8_BAR;
            PG8_LDB(B0, 1, 0); PG8_SCHED; PG8_LDA(At, 1, 0); PG8_STAGE(PG8_SA(0, 1), a2 + hstep, voffA);
            PG8_WAIT_L(8); PG8_BAR; PG8_WAIT_L(0); PG8_MMA(0, 0, At, B0); PG8_BAR; PG8_SCHED;
            PG8_LDB(B1, 1, 1); PG8_STAGE(PG8_SB(1, 0), b3, voffB);
            PG8_BAR; PG8_WAIT_L(0); PG8_MMA(0, 1, At, B1); PG8_BAR;
            PG8_LDA(At, 1, 1); PG8_STAGE(PG8_SA(1, 0), a3, voffA);
            PG8_BAR; PG8_WAIT_L(0); PG8_MMA(1, 0, At, B0); PG8_BAR; PG8_SCHED;
            PG8_STAGE(PG8_SB(1, 1), b3 + hstep, voffB);
            PG8_WAIT_V(6); PG8_BAR; PG8_MMA(1, 1, At, B1); PG8_BAR;
        }
        E(acc, cur, wr, wc, fr, fq); S.done(cur);
        if (!has_next) break;
#pragma unroll
        for (int a = 0; a < 2; ++a)
#pragma unroll
            for (int b = 0; b < 2; ++b)
#pragma unroll
                for (int m = 0; m < 4; ++m)
#pragma unroll
                    for (int n = 0; n < 2; ++n) acc[a][b][m][n] = (f32x4){0.f, 0.f, 0.f, 0.f};
        cur = nxt; cA = nA; cB = nB; ++ui;
    }
    PG8_WAIT_V(0);
    if (wr == 0) PG8_BAR;
    PG8_BAR;
#undef PG8_SA
#undef PG8_SB
#undef PG8_STAGE
#undef PG8_LDA
#undef PG8_LDB
#undef PG8_MMA
#undef PG8_WAIT_V
#undef PG8_WAIT_L
#undef PG8_BAR
#undef PG8_SCHED
}
}

using pg8::bf16_t; using pg8::f32x4; using pg8::bf16x8; using pg8::u32x4; using pg8::u32x2;
#define LAS __attribute__((address_space(3)))

constexpr int D = 1024, DFF = 2816, NGU = 5632, NCOLS = 3840;
constexpr int MP = 16384, MS = 512, MT = 16896, MIN_ = 17152;
constexpr int LDS_BYTES = 147456;
constexpr size_t O_SHP = 17301504, O_WKP = O_SHP + 8192, O_RTP = O_WKP + 262144, O_SHS = O_RTP + 524288, O_WKS = O_SHS + 131072, O_RTS = O_WKS + 4194304;
constexpr size_t WS_ROPE = 16384;
constexpr size_t WS_WL   = WS_ROPE + 1050624;
constexpr size_t WS_WOUT = WS_WL + 786432;
constexpr size_t WS_WIN  = WS_WOUT + 2097152;
constexpr size_t WS_WGU  = WS_WIN + 7864320;
constexpr size_t WS_WD   = WS_WGU + 11534336;
constexpr size_t WS_XN   = WS_WD + 5767168;
constexpr size_t WS_BIG  = WS_XN + 35127296;
constexpr size_t WS_FO   = WS_BIG + 95158272;
constexpr size_t WS_YS   = WS_BIG + 131727360;
constexpr size_t WS_LA   = WS_YS + 17301504;
constexpr size_t WS_OMD  = WS_BIG + 164364288;
constexpr size_t WS_ASIG = WS_OMD + 17301504;
constexpr size_t WS_END  = WS_ASIG + 17301504;
static_assert(WS_LA + 8650752 <= WS_OMD, "mixer overlays");
static_assert(WS_END <= 268435456, "workspace");

struct Params {
    const float *x_prompt, *x_sample, *state_shift, *state_wkv, *state_ret, *norm_g, *f1g, *f1u, *f1d, *w_in, *mu, *w0, *w2, *a0, *a2, *g2, *k_k, *k_a, *r_k, *lnx_w, *lnx_b, *gn_w, *w_out, *f2g, *f2u, *f2d;
    float* out; unsigned char* ws;
};
#define CAS __attribute__((address_space(4)))
typedef const CAS Params& PR;

__device__ __forceinline__ float bf2f(unsigned b) { return __uint_as_float(b << 16); }
__device__ __forceinline__ bf16_t f2bf(float f) { unsigned u = __float_as_uint(f); u += 0x7FFFu + ((u >> 16) & 1u); return (bf16_t)(u >> 16); }
__device__ __forceinline__ float lo_bf(unsigned x) { return __uint_as_float(x << 16); }
__device__ __forceinline__ float hi_bf(unsigned x) { return __uint_as_float(x & 0xffff0000u); }
template <int CTRL> __device__ __forceinline__ float dppf(float v) { return __int_as_float(__builtin_amdgcn_update_dpp(0, __float_as_int(v), CTRL, 0xF, 0xF, false)); }
__device__ __forceinline__ float row16_sum(float v) { v += dppf<0xB1>(v); v += dppf<0x4E>(v); v += dppf<0x141>(v); v += dppf<0x140>(v); return v; }
__device__ __forceinline__ float wave_sum(float v) { v = row16_sum(v); const int i = __float_as_int(v);
    return __int_as_float(__builtin_amdgcn_readlane(i, 0)) + __int_as_float(__builtin_amdgcn_readlane(i, 16)) + __int_as_float(__builtin_amdgcn_readlane(i, 32)) + __int_as_float(__builtin_amdgcn_readlane(i, 48)); }
__device__ __forceinline__ float quad_sum(float v) { v += dppf<0xB1>(v); v += dppf<0x4E>(v); return v; }
__device__ __forceinline__ float sigmoid_f(float x) { return 1.0f / (1.0f + __expf(-x)); }


#define XB_TMO      128
#define XB_XCNT(j)  (256  + 64 * (j))
#define XB_XSUB(j)  (1280 + 64 * (j))
#define XB_XGEN(j)  (2304 + 64 * (j))
#define XB_TOP      3328
#define XB_TOPGEN   3392
#define XCD_BAR_WORDS 3456
#define XB_SPIN_CAP (1u << 18)
__device__ __forceinline__ unsigned xb_ld(unsigned* p)              { return __hip_atomic_load(p, __ATOMIC_RELAXED, __HIP_MEMORY_SCOPE_AGENT); }
__device__ __forceinline__ unsigned xb_add(unsigned* p, unsigned v) { return __hip_atomic_fetch_add(p, v, __ATOMIC_RELAXED, __HIP_MEMORY_SCOPE_AGENT); }
__device__ __forceinline__ unsigned xb_xcc_id() { return (unsigned)__builtin_amdgcn_s_getreg((3 << 11) | 20) & 0xFu; }
#define XB_SPIN(cond, bar) do { unsigned _sp = 0; while (cond) { __builtin_amdgcn_s_sleep(1); \
    if ((++_sp & 255u) == 0u) { if (xb_ld(&(bar)[XB_TMO])) break; if (_sp > XB_SPIN_CAP) { atomicAdd(&(bar)[XB_TMO], 1u); break; } } } } while (0)
struct XcdBarrier { unsigned* bar; unsigned x; volatile LAS unsigned* st; };
__device__ __forceinline__ XcdBarrier xcd_barrier_post(unsigned* bar, volatile LAS unsigned* st) {
    XcdBarrier b; b.bar = bar; b.x = xb_xcc_id(); b.st = st;
    return b;
}
__device__ __forceinline__ void xcd_barrier_complete(unsigned* bar, unsigned x, unsigned& nloc, unsigned& nx) {
    const unsigned G = gridDim.x * gridDim.y * gridDim.z;
    unsigned sum, cnt, mine, sp = 0u;
    for (;;) {
        sum = 0u; cnt = 0u; mine = 0u;
#pragma unroll
        for (unsigned j = 0; j < 16; ++j) { const unsigned c = xb_ld(&bar[XB_XCNT(j)]); sum += c; cnt += (c > 0u) ? 1u : 0u; mine = (j == x) ? c : mine; }
        if (sum == G) break;
        __builtin_amdgcn_s_sleep(1);
        if ((++sp & 255u) == 0u) { if (xb_ld(&bar[XB_TMO])) break; if (sp > XB_SPIN_CAP) { atomicAdd(&bar[XB_TMO], 1u); break; } }
    }
    nloc = mine > 0u ? mine : 1u; nx = cnt > 0u ? cnt : 1u;
}
__device__ __forceinline__ void xcd_barrier(unsigned* barw, volatile LAS unsigned* stw, const int wv) {
    XcdBarrier b; b.bar = barw; b.x = xb_xcc_id(); b.st = stw;
    asm volatile("s_waitcnt vmcnt(0)" ::: "memory");
    __syncthreads();
    if (fresh_tid(wv) == 0) {
        unsigned* bar = b.bar;
        __builtin_amdgcn_s_waitcnt(0);
        unsigned nloc = b.st[0], nx = b.st[1];
        if (nloc == 0u) { xcd_barrier_complete(bar, b.x, nloc, nx); b.st[0] = nloc; b.st[1] = nx; }
        const unsigned old = xb_add(&bar[XB_XSUB(b.x)], 1u);
        const unsigned gen = old / nloc;
        if (old + 1u == (gen + 1u) * nloc) {
            __builtin_amdgcn_fence(__ATOMIC_RELEASE, "agent");
            asm volatile("s_waitcnt vmcnt(0)" ::: "memory");
            const unsigned og = xb_add(&bar[XB_TOP], 1u);
            const unsigned tg = og / nx;
            if (og + 1u == (tg + 1u) * nx) xb_add(&bar[XB_TOPGEN], 1u);
            else XB_SPIN(xb_ld(&bar[XB_TOPGEN]) == tg, bar);
            __builtin_amdgcn_fence(__ATOMIC_ACQUIRE, "agent");
            xb_add(&bar[XB_XGEN(b.x)], 1u);
            asm volatile("s_waitcnt vmcnt(0)" ::: "memory");
        } else {
            XB_SPIN(xb_ld(&bar[XB_XGEN(b.x)]) == gen, bar);
            __builtin_amdgcn_fence(__ATOMIC_ACQUIRE, "agent");
            asm volatile("s_waitcnt vmcnt(0)" ::: "memory");
        }
    }
    __syncthreads();
}

__device__ __forceinline__ int prev_row(int r) {
    if (r < MP) return (r & 2047) == 0 ? -1 : r - 1;
    const int s = r - MP; return (s & 3) == 0 ? MT + (s >> 2) : r - 1;
}

__device__ __forceinline__ void tconv_tile(const float* __restrict__ W, int K, int N, bf16_t* __restrict__ Bt, int mode, int tile, LAS float* t, const int wv) {
    const int nkt = K / 64; const int kt = tile % nkt, nt = tile / nkt; const int k0 = kt * 64, n0 = nt * 64;
    const int brow0 = mode == 0 ? n0 : ((n0 >> 7) * 256 + (n0 & 127) + (mode == 2 ? 128 : 0));
    const int tid = fresh_tid(wv);
#pragma unroll
    for (int e = 0; e < 8; ++e) { const int idx = e * 512 + tid, r = idx >> 6, c = idx & 63; t[r * 65 + c] = W[(size_t)(k0 + r) * N + n0 + c]; }
    __syncthreads();
#pragma unroll
    for (int e = 0; e < 4; ++e) { const int idx = e * 512 + tid, n = idx >> 5, kp = idx & 31;
        const unsigned w = pg8::cvt_pk_bf16(t[(2 * kp) * 65 + n], t[(2 * kp + 1) * 65 + n]);
        *(unsigned*)(Bt + (size_t)(brow0 + n) * K + k0 + 2 * kp) = w; }
    __syncthreads();
}
__device__ __forceinline__ void ffn_weights(const float* wg, const float* wu, const float* wd, unsigned char* ws, LAS float* t, const int wv) {
    for (int i = blockIdx.x; i < 2112; i += gridDim.x) {
        if (i < 704) tconv_tile(wg, 1024, DFF, (bf16_t*)(ws + WS_WGU), 1, i, t, wv);
        else if (i < 1408) tconv_tile(wu, 1024, DFF, (bf16_t*)(ws + WS_WGU), 2, i - 704, t, wv);
        else tconv_tile(wd, DFF, 1024, (bf16_t*)(ws + WS_WD), 0, i - 1408, t, wv);
    }
}

__device__ __forceinline__ void rows_phase(PR P, const int mode, const int wv) {
    const int tid = fresh_tid(wv); const int lane = tid & 63; const int gw = blockIdx.x * 8 + (tid >> 6), nw = gridDim.x * 8;
    const float* FO = (const float*)(P.ws + WS_FO); bf16_t* XN = (bf16_t*)(P.ws + WS_XN);
    const float* gpost = P.norm_g + (mode == 1 ? 1 : (mode == 2 ? 3 : 5)) * 1024;
    const float* gnext = P.norm_g + (mode == 0 ? 0 : (mode == 1 ? 2 : 4)) * 1024;
    const float scale = mode == 2 ? 1.0f : 0.5f;
    for (int row = gw; row < MT; row += nw) {
        const float* xin = mode <= 1 ? (row < MP ? P.x_prompt + (size_t)row * 1024 : P.x_sample + (size_t)(row - MP) * 1024) : P.out + (size_t)row * 1024;
        float4 xv[4];
#pragma unroll
        for (int q = 0; q < 4; ++q) xv[q] = *(const float4*)(xin + (q * 64 + lane) * 4);
        if (mode != 0) {
            float4 fo[4]; float ss = 0.f;
#pragma unroll
            for (int q = 0; q < 4; ++q) { fo[q] = *(const float4*)(FO + (size_t)row * 1024 + (q * 64 + lane) * 4); ss += fo[q].x * fo[q].x + fo[q].y * fo[q].y + fo[q].z * fo[q].z + fo[q].w * fo[q].w; }
            ss = wave_sum(ss); const float r = rsqrtf(ss * (1.0f / 1024.0f) + 1e-6f) * scale;
#pragma unroll
            for (int q = 0; q < 4; ++q) { const float4 g = *(const float4*)(gpost + (q * 64 + lane) * 4);
                xv[q].x += fo[q].x * r * g.x; xv[q].y += fo[q].y * r * g.y; xv[q].z += fo[q].z * r * g.z; xv[q].w += fo[q].w * r * g.w;
                *(float4*)(P.out + (size_t)row * 1024 + (q * 64 + lane) * 4) = xv[q]; }
            if (mode == 3) continue;
        }
        float ss2 = 0.f;
#pragma unroll
        for (int q = 0; q < 4; ++q) ss2 += xv[q].x * xv[q].x + xv[q].y * xv[q].y + xv[q].z * xv[q].z + xv[q].w * xv[q].w;
        ss2 = wave_sum(ss2); const float r2 = rsqrtf(ss2 * (1.0f / 1024.0f) + 1e-6f);
        float* sh = nullptr;
        if (mode == 1) { if (row < MP) { if ((row & 2047) == 2047) sh = P.out + O_SHP + (size_t)(row >> 11) * 1024; } else { const int s = row - MP; if ((s & 3) == 3) sh = P.out + O_SHS + (size_t)(s >> 2) * 1024; } }
#pragma unroll
        for (int q = 0; q < 4; ++q) { const float4 g = *(const float4*)(gnext + (q * 64 + lane) * 4);
            float4 hv; hv.x = xv[q].x * r2 * g.x; hv.y = xv[q].y * r2 * g.y; hv.z = xv[q].z * r2 * g.z; hv.w = xv[q].w * r2 * g.w;
            u32x2 w; w.x = pg8::cvt_pk_bf16(hv.x, hv.y); w.y = pg8::cvt_pk_bf16(hv.z, hv.w);
            *(u32x2*)(XN + (size_t)row * 1024 + (q * 64 + lane) * 4) = w;
            if (sh) *(float4*)(sh + (q * 64 + lane) * 4) = hv; }
    }
}

__device__ __forceinline__ void p0_prologue(PR P, LAS float* ldsf, const int wv) {
    const int tid = fresh_tid(wv); const size_t gt = (size_t)blockIdx.x * 512 + tid, nth = (size_t)gridDim.x * 512;
    { float* rc = (float*)(P.ws + WS_ROPE); float* rs = rc + 2052 * 64;
      for (size_t i = gt; i < 2052 * 64; i += nth) { const int p = (int)(i >> 6), f = (int)(i & 63); const int pos = p < 2048 ? p : 16384 + (p - 2048);
          double inv = 1.0; for (int q = 0; q < f; ++q) inv *= 0.8659643233600653;
          const double ang = (double)pos * inv; const double n = rint(ang * 0.15915494309189535); const double r = ang - n * 6.283185307179586;
          const double r2 = r * r; double s = 0.0, c = 0.0;
          for (int k = 14; k >= 0; --k) { s = s * (-r2 / (double)((2 * k + 2) * (2 * k + 3))) + 1.0; c = c * (-r2 / (double)((2 * k + 1) * (2 * k + 2))) + 1.0; }
          rc[i] = (float)c; rs[i] = (float)(s * r); } }
    { bf16_t* Wl = (bf16_t*)(P.ws + WS_WL);
      for (size_t i = gt; i < 1536 * 256; i += nth) { const int n = (int)(i >> 8), k = (int)(i & 255); float v = 0.f;
          if (n < 512) { if (k < 64) v = P.w2[k * 512 + n]; } else if (n < 1024) { if (k >= 64 && k < 128) v = P.a2[(k - 64) * 512 + (n - 512)]; } else { if (k >= 128) v = P.g2[(k - 128) * 512 + (n - 1024)]; }
          Wl[i] = f2bf(v); } }
    { bf16_t* XN = (bf16_t*)(P.ws + WS_XN);
      for (size_t i = gt; i < 256 * 1024; i += nth) { const int r = (int)(i >> 10); XN[(size_t)MT * 1024 + i] = r < 128 ? f2bf(P.state_shift[i]) : (bf16_t)0; } }
    ffn_weights(P.f1g, P.f1u, P.f1d, P.ws, ldsf, wv);
    for (int i = blockIdx.x; i < 1216; i += gridDim.x) {
        if (i < 960) tconv_tile(P.w_in, 1024, NCOLS, (bf16_t*)(P.ws + WS_WIN), 0, i, ldsf, wv);
        else tconv_tile(P.w_out, 1024, 1024, (bf16_t*)(P.ws + WS_WOUT), 0, i - 960, ldsf, wv);
    }
    rows_phase(P, 0, wv);
}

__device__ __forceinline__ void lora_prep(PR P, const int wv) {
    const int tid = fresh_tid(wv); const int lane = tid & 63; const int gw = blockIdx.x * 8 + (tid >> 6), nw = gridDim.x * 8;
    const bf16_t* PS = (const bf16_t*)(P.ws + WS_BIG); bf16_t* LA = (bf16_t*)(P.ws + WS_LA);
    const float4 mu = *(const float4*)(P.mu + 1536 + lane * 4); const int kind = lane >> 4;
    for (int row = gw; row < MT; row += nw) {
        const u32x2 c = *(const u32x2*)(PS + (size_t)row * NCOLS + 1536 + lane * 4); const int pr = prev_row(row);
        u32x2 p = (u32x2){0u, 0u}; if (pr >= 0) p = *(const u32x2*)(PS + (size_t)pr * NCOLS + 1536 + lane * 4);
        float v[4]; const float cu[4] = {lo_bf(c.x), hi_bf(c.x), lo_bf(c.y), hi_bf(c.y)}, pv[4] = {lo_bf(p.x), hi_bf(p.x), lo_bf(p.y), hi_bf(p.y)}, m4[4] = {mu.x, mu.y, mu.z, mu.w};
#pragma unroll
        for (int j = 0; j < 4; ++j) { float x = cu[j] + (pv[j] - cu[j]) * m4[j];
            if (kind == 0) x = 1.0f - 2.0f / (__expf(2.0f * x) + 1.0f); else if (kind >= 2) x = sigmoid_f(x);
            v[j] = x; }
        u32x2 w; w.x = pg8::cvt_pk_bf16(v[0], v[1]); w.y = pg8::cvt_pk_bf16(v[2], v[3]);
        *(u32x2*)(LA + (size_t)row * 256 + lane * 4) = w;
    }
}

template <bool SAMPLE>
__device__ __forceinline__ void rwkv_unit(PR P, LAS float* lds, const int b, const int h, const int half, const int wv) {
    constexpr int T = SAMPLE ? 4 : 2048, TC = SAMPLE ? 4 : 32, NCH = T / TC;
    const int tid = fresh_tid(wv), lane = tid & 63, wid = tid >> 6;
    const bf16_t* PS = (const bf16_t*)(P.ws + WS_BIG); const bf16_t* OMD = (const bf16_t*)(P.ws + WS_OMD); const bf16_t* ASIG = (const bf16_t*)(P.ws + WS_ASIG);
    bf16_t* YS = (bf16_t*)(P.ws + WS_YS);
    const int row_base = SAMPLE ? MP + b * 4 : b * 2048;
    const int ltok = tid >> 4, lcg = tid & 15; const bool lact = ltok < TC; const int hch = h * 64 + lcg * 4;
    const float4 mur = *(const float4*)(P.mu + hch), muk = *(const float4*)(P.mu + 512 + hch), muv = *(const float4*)(P.mu + 1024 + hch);
    const float4 kk4 = *(const float4*)(P.k_k + hch), ka4 = *(const float4*)(P.k_a + hch);
    const int irow = half * 32 + wid * 4 + (lane >> 4), j0 = (lane & 15) * 4;
    float S0 = 0.f, S1 = 0.f, S2 = 0.f, S3 = 0.f;
    float* sout = P.out + (SAMPLE ? O_WKS : O_WKP) + ((size_t)(b * 8 + h) * 64 + irow) * 64 + j0;
    if (SAMPLE) { const float4 s = *(const float4*)(P.state_wkv + ((size_t)(b * 8 + h) * 64 + irow) * 64 + j0); S0 = s.x; S1 = s.y; S2 = s.z; S3 = s.w; }
    LAS float* buf0 = lds; LAS float* buf1 = lds + TC * 384;
    u32x2 cr, ck, cv, pr, pk, pv, co, ca;
#define RW_LOAD(c) do { if (lact) { const int t_ = (c) * TC + ltok; const int row_ = row_base + t_; const int prow_ = SAMPLE ? (t_ == 0 ? MT + b : row_ - 1) : row_ - 1; \
        const bf16_t* cp_ = PS + (size_t)row_ * NCOLS + hch; cr = *(const u32x2*)cp_; ck = *(const u32x2*)(cp_ + 512); cv = *(const u32x2*)(cp_ + 1024); \
        if (SAMPLE || t_ > 0) { const bf16_t* pp_ = PS + (size_t)prow_ * NCOLS + hch; pr = *(const u32x2*)pp_; pk = *(const u32x2*)(pp_ + 512); pv = *(const u32x2*)(pp_ + 1024); } \
        else { pr = (u32x2){0u, 0u}; pk = pr; pv = pr; } \
        co = *(const u32x2*)(OMD + (size_t)row_ * 512 + hch); ca = *(const u32x2*)(ASIG + (size_t)row_ * 512 + hch); } } while (0)
#define RW_MIX(cu, pv_, m) ((cu) + ((pv_) - (cu)) * (m))
#define RW_PROC(dst) do { if (lact) { LAS float* d_ = (dst) + ltok * 384 + lcg * 4; \
        f32x4 r_, k_, v_, o_, a_; \
        r_[0] = RW_MIX(lo_bf(cr.x), lo_bf(pr.x), mur.x); r_[1] = RW_MIX(hi_bf(cr.x), hi_bf(pr.x), mur.y); r_[2] = RW_MIX(lo_bf(cr.y), lo_bf(pr.y), mur.z); r_[3] = RW_MIX(hi_bf(cr.y), hi_bf(pr.y), mur.w); \
        k_[0] = RW_MIX(lo_bf(ck.x), lo_bf(pk.x), muk.x); k_[1] = RW_MIX(hi_bf(ck.x), hi_bf(pk.x), muk.y); k_[2] = RW_MIX(lo_bf(ck.y), lo_bf(pk.y), muk.z); k_[3] = RW_MIX(hi_bf(ck.y), hi_bf(pk.y), muk.w); \
        v_[0] = RW_MIX(lo_bf(cv.x), lo_bf(pv.x), muv.x); v_[1] = RW_MIX(hi_bf(cv.x), hi_bf(pv.x), muv.y); v_[2] = RW_MIX(lo_bf(cv.y), lo_bf(pv.y), muv.z); v_[3] = RW_MIX(hi_bf(cv.y), hi_bf(pv.y), muv.w); \
        o_[0] = lo_bf(co.x); o_[1] = hi_bf(co.x); o_[2] = lo_bf(co.y); o_[3] = hi_bf(co.y); a_[0] = lo_bf(ca.x); a_[1] = hi_bf(ca.x); a_[2] = lo_bf(ca.y); a_[3] = hi_bf(ca.y); \
        f32x4 kk_; kk_[0] = k_[0] * kk4.x; kk_[1] = k_[1] * kk4.y; kk_[2] = k_[2] * kk4.z; kk_[3] = k_[3] * kk4.w; \
        float ss_ = kk_[0] * kk_[0] + kk_[1] * kk_[1] + kk_[2] * kk_[2] + kk_[3] * kk_[3]; ss_ = row16_sum(ss_); \
        const float inv_ = 1.0f / fmaxf(sqrtf(ss_), 1e-12f); kk_ = kk_ * inv_; \
        f32x4 kn_; kn_[0] = k_[0] * (1.0f + (a_[0] - 1.0f) * ka4.x); kn_[1] = k_[1] * (1.0f + (a_[1] - 1.0f) * ka4.y); kn_[2] = k_[2] * (1.0f + (a_[2] - 1.0f) * ka4.z); kn_[3] = k_[3] * (1.0f + (a_[3] - 1.0f) * ka4.w); \
        *(LAS f32x4*)(d_) = r_; *(LAS f32x4*)(d_ + 64) = o_; *(LAS f32x4*)(d_ + 128) = kn_; *(LAS f32x4*)(d_ + 192) = -kk_; *(LAS f32x4*)(d_ + 256) = kk_ * a_; *(LAS f32x4*)(d_ + 320) = v_; } } while (0)
    RW_LOAD(0); RW_PROC(buf0); __syncthreads();
    for (int c = 0; c < NCH; ++c) {
        LAS float* cur = (c & 1) ? buf1 : buf0; LAS float* nxt = (c & 1) ? buf0 : buf1;
        if (c + 1 < NCH) RW_LOAD(c + 1);
#pragma unroll 4
        for (int t = 0; t < TC; ++t) {
            const LAS float* q = cur + t * 384;
            const f32x4 r4 = *(const LAS f32x4*)(q + j0), o4 = *(const LAS f32x4*)(q + 64 + j0), k4 = *(const LAS f32x4*)(q + 128 + j0), a4 = *(const LAS f32x4*)(q + 192 + j0), b4 = *(const LAS f32x4*)(q + 256 + j0);
            const float vi = q[320 + irow];
            float sa = S0 * a4[0] + S1 * a4[1] + S2 * a4[2] + S3 * a4[3]; sa = row16_sum(sa);
            S0 = fmaf(vi, k4[0], fmaf(sa, b4[0], fmaf(-o4[0], S0, S0)));
            S1 = fmaf(vi, k4[1], fmaf(sa, b4[1], fmaf(-o4[1], S1, S1)));
            S2 = fmaf(vi, k4[2], fmaf(sa, b4[2], fmaf(-o4[2], S2, S2)));
            S3 = fmaf(vi, k4[3], fmaf(sa, b4[3], fmaf(-o4[3], S3, S3)));
            float y = S0 * r4[0] + S1 * r4[1] + S2 * r4[2] + S3 * r4[3]; y = row16_sum(y);
            if ((lane & 15) == 0) YS[(size_t)(row_base + c * TC + t) * 512 + h * 64 + irow] = f2bf(y);
        }
        if (c + 1 < NCH) RW_PROC(nxt);
        __syncthreads();
    }
    *(float4*)sout = make_float4(S0, S1, S2, S3);
#undef RW_LOAD
#undef RW_PROC
#undef RW_MIX
}

__device__ __forceinline__ void ret_sample_unit(PR P, LAS float* lds, const int b, const int h, const int wv) {
    const int tid = fresh_tid(wv), lane = tid & 63, wid = tid >> 6;
    const bf16_t* PS = (const bf16_t*)(P.ws + WS_BIG); bf16_t* Y = (bf16_t*)(P.ws + WS_XN);
    const float* rc = (const float*)(P.ws + WS_ROPE); const float* rs = rc + 2052 * 64;
    LAS float* q = lds; LAS float* k = lds + 512; LAS float* v = lds + 1024; LAS float* Pm = lds + 1536; LAS float* y2p = lds + 1600; LAS float* red = lds + 1600 + 2048;
    const float lg2 = log2f(1.0f - exp2f(-5.0f - (float)h));
    const int row0 = MP + b * 4;
    { const int t = (tid & 255) >> 6, f = tid & 63; const bf16_t* src = PS + (size_t)(row0 + t) * NCOLS + 1792 + h * 128;
      if (tid < 256) { const float cs = rc[(2048 + t) * 64 + f], sn = rs[(2048 + t) * 64 + f];
          const float q1 = bf2f(src[f]), q2 = bf2f(src[f + 64]); q[t * 128 + f] = q1 * cs - q2 * sn; q[t * 128 + f + 64] = q1 * sn + q2 * cs;
          const float k1 = bf2f(src[512 + f]), k2 = bf2f(src[512 + f + 64]); k[t * 128 + f] = (k1 * cs - k2 * sn) * 0.08838834764831845f; k[t * 128 + f + 64] = (k1 * sn + k2 * cs) * 0.08838834764831845f; }
      else { v[t * 128 + f] = bf2f(src[1024 + f]); v[t * 128 + f + 64] = bf2f(src[1024 + f + 64]); } }
    __syncthreads();
    if (wid == 0) { const int pi = lane >> 4, pj = (lane >> 2) & 3, part = lane & 3; float s = 0.f;
        for (int d = part * 32; d < part * 32 + 32; ++d) s += q[pi * 128 + d] * k[pj * 128 + d];
        s = quad_sum(s); if (part == 0) Pm[pi * 4 + pj] = pi >= pj ? s * exp2f(lg2 * (float)(pi - pj)) : 0.f; }
    { const int e = tid & 127, dg = tid >> 7; const float c4 = exp2f(lg2 * 4.0f), g3 = exp2f(lg2 * 3.0f), g2_ = exp2f(lg2 * 2.0f), g1 = exp2f(lg2);
      const float v0 = v[e] * g3, v1 = v[128 + e] * g2_, v2 = v[256 + e] * g1, v3 = v[384 + e];
      const float* S0 = P.state_ret + ((size_t)(b * 4 + h) * 128) * 128 + e; float* So = P.out + O_RTS + ((size_t)(b * 4 + h) * 128) * 128 + e;
      float a0 = 0.f, a1 = 0.f, a2 = 0.f, a3 = 0.f;
#pragma unroll 4
      for (int d = dg * 32; d < dg * 32 + 32; ++d) { const float s = S0[(size_t)d * 128];
          a0 = fmaf(q[d], s, a0); a1 = fmaf(q[128 + d], s, a1); a2 = fmaf(q[256 + d], s, a2); a3 = fmaf(q[384 + d], s, a3);
          So[(size_t)d * 128] = s * c4 + k[d] * v0 + k[128 + d] * v1 + k[256 + d] * v2 + k[384 + d] * v3; }
      y2p[(dg * 4 + 0) * 128 + e] = a0; y2p[(dg * 4 + 1) * 128 + e] = a1; y2p[(dg * 4 + 2) * 128 + e] = a2; y2p[(dg * 4 + 3) * 128 + e] = a3; }
    __syncthreads();
    { const int i = tid >> 7, e = tid & 127;
      float y = (y2p[(0 + i) * 128 + e] + y2p[(4 + i) * 128 + e] + y2p[(8 + i) * 128 + e] + y2p[(12 + i) * 128 + e]) * exp2f(lg2 * (float)(i + 1));
#pragma unroll
      for (int j = 0; j < 4; ++j) y = fmaf(Pm[i * 4 + j], v[j * 128 + e], y);
      float s = wave_sum(y); if (lane == 0) red[wid] = s; __syncthreads();
      const float mean = (red[i * 2] + red[i * 2 + 1]) * (1.0f / 128.0f); const float dlt = y - mean;
      float s2 = wave_sum(dlt * dlt); if (lane == 0) red[8 + wid] = s2; __syncthreads();
      const float var = (red[8 + i * 2] + red[8 + i * 2 + 1]) * (1.0f / 128.0f);
      const float g = bf2f(PS[(size_t)(row0 + i) * NCOLS + 1792 + 1536 + h * 128 + e]);
      const float o = dlt * rsqrtf(var + 1e-5f) * P.gn_w[h * 128 + e] * (g / (1.0f + __expf(-g)));
      Y[(size_t)(row0 + i) * 1024 + 512 + h * 128 + e] = f2bf(o); }
    __syncthreads();
}

__device__ __forceinline__ void ret_prompt_unit(PR P, LAS unsigned char* lds, const int b, const int h, const int wv) {
    constexpr int RS = 136, BUFE = 128 * RS;
    LAS bf16_t* QP = (LAS bf16_t*)lds; LAS bf16_t* KB = QP + BUFE; LAS bf16_t* VT = KB + BUFE; LAS bf16_t* ST = VT + BUFE;
    LAS float* YST = (LAS float*)lds;
    const int tid = fresh_tid(wv), lane = tid & 63, wid = tid >> 6, wr = wid >> 1, wc = wid & 1, fr = lane & 15, fq = lane >> 4;
    const bf16_t* PS = (const bf16_t*)(P.ws + WS_BIG); bf16_t* Y = (bf16_t*)(P.ws + WS_XN);
    const float* rc = (const float*)(P.ws + WS_ROPE); const float* rs = rc + 2052 * 64;
    const float lg2 = log2f(1.0f - exp2f(-5.0f - (float)h)); const float c_dec = exp2f(lg2 * 128.0f);
    f32x4 accS[2][4];
#pragma unroll
    for (int mt = 0; mt < 2; ++mt)
#pragma unroll
        for (int nt = 0; nt < 4; ++nt) accS[mt][nt] = (f32x4){0.f, 0.f, 0.f, 0.f};
    for (int i = tid; i < BUFE / 2; i += 512) ((LAS unsigned*)ST)[i] = 0u;
    float ri[2][4], cj[4];
#pragma unroll
    for (int mt = 0; mt < 2; ++mt)
#pragma unroll
        for (int j = 0; j < 4; ++j) ri[mt][j] = exp2f(lg2 * (float)(wr * 32 + mt * 16 + fq * 4 + j));
#pragma unroll
    for (int nt = 0; nt < 4; ++nt) cj[nt] = exp2f(-lg2 * (float)(wc * 64 + nt * 16 + fr));
    const float gam = exp2f(lg2), kd0 = exp2f(lg2 * (float)(127 - (tid >> 4))), g32 = exp2f(-32.0f * lg2);
    for (int n = 0; n < 16; ++n) {
        const int row0 = b * 2048 + n * 128;
        int tidv = tid; asm volatile("" : "+v"(tidv));
        unsigned kth[4][4]; float kd = kd0;
#pragma unroll
        for (int it = 0; it < 4; ++it) { const int idx = it * 512 + tidv, i = idx >> 4, f = (idx & 15) * 4;
            const bf16_t* src = PS + (size_t)(row0 + i) * NCOLS + 1792 + h * 128;
            const u32x2 q1 = *(const u32x2*)(src + f), q2 = *(const u32x2*)(src + 64 + f), k1 = *(const u32x2*)(src + 512 + f), k2 = *(const u32x2*)(src + 576 + f);
            const float4 cs = *(const float4*)(rc + (size_t)(n * 128 + i) * 64 + f), sn = *(const float4*)(rs + (size_t)(n * 128 + i) * 64 + f);
            const float c4[4] = {cs.x, cs.y, cs.z, cs.w}, s4[4] = {sn.x, sn.y, sn.z, sn.w};
            const float qa[4] = {lo_bf(q1.x), hi_bf(q1.x), lo_bf(q1.y), hi_bf(q1.y)}, qb[4] = {lo_bf(q2.x), hi_bf(q2.x), lo_bf(q2.y), hi_bf(q2.y)};
            const float ka[4] = {lo_bf(k1.x), hi_bf(k1.x), lo_bf(k1.y), hi_bf(k1.y)}, kb[4] = {lo_bf(k2.x), hi_bf(k2.x), lo_bf(k2.y), hi_bf(k2.y)};
            float qo1[4], qo2[4], ko1[4], ko2[4];
#pragma unroll
            for (int x = 0; x < 4; ++x) { qo1[x] = qa[x] * c4[x] - qb[x] * s4[x]; qo2[x] = qa[x] * s4[x] + qb[x] * c4[x];
                ko1[x] = (ka[x] * c4[x] - kb[x] * s4[x]) * 0.08838834764831845f; ko2[x] = (ka[x] * s4[x] + kb[x] * c4[x]) * 0.08838834764831845f; }
            u32x2 w; w.x = pg8::cvt_pk_bf16(qo1[0], qo1[1]); w.y = pg8::cvt_pk_bf16(qo1[2], qo1[3]); *(LAS u32x2*)(QP + i * RS + f) = w;
            w.x = pg8::cvt_pk_bf16(qo2[0], qo2[1]); w.y = pg8::cvt_pk_bf16(qo2[2], qo2[3]); *(LAS u32x2*)(QP + i * RS + 64 + f) = w;
            w.x = pg8::cvt_pk_bf16(ko1[0], ko1[1]); w.y = pg8::cvt_pk_bf16(ko1[2], ko1[3]); *(LAS u32x2*)(KB + i * RS + f) = w;
            w.x = pg8::cvt_pk_bf16(ko2[0], ko2[1]); w.y = pg8::cvt_pk_bf16(ko2[2], ko2[3]); *(LAS u32x2*)(KB + i * RS + 64 + f) = w;
            kth[it][0] = pg8::cvt_pk_bf16(ko1[0] * kd, ko1[1] * kd); kth[it][1] = pg8::cvt_pk_bf16(ko1[2] * kd, ko1[3] * kd);
            kth[it][2] = pg8::cvt_pk_bf16(ko2[0] * kd, ko2[1] * kd); kth[it][3] = pg8::cvt_pk_bf16(ko2[2] * kd, ko2[3] * kd); kd *= g32; if (it & 1) __builtin_amdgcn_sched_barrier(0); }
#pragma unroll
        for (int it = 0; it < 4; ++it) { const int idx = it * 512 + tidv, j = idx >> 4, e = (idx & 15) * 8;
            const u32x4 vv = *(const u32x4*)(PS + (size_t)(row0 + j) * NCOLS + 1792 + 1024 + h * 128 + e);
            LAS bf16_t* d = VT + e * RS + j;
            d[0] = (bf16_t)(vv.x & 0xffffu); d[RS] = (bf16_t)(vv.x >> 16); d[2 * RS] = (bf16_t)(vv.y & 0xffffu); d[3 * RS] = (bf16_t)(vv.y >> 16);
            d[4 * RS] = (bf16_t)(vv.z & 0xffffu); d[5 * RS] = (bf16_t)(vv.z >> 16); d[6 * RS] = (bf16_t)(vv.w & 0xffffu); d[7 * RS] = (bf16_t)(vv.w >> 16); }
        __syncthreads();
        f32x4 accP[2][4], accY[2][4];
#pragma unroll
        for (int mt = 0; mt < 2; ++mt)
#pragma unroll
            for (int nt = 0; nt < 4; ++nt) { accP[mt][nt] = (f32x4){0.f, 0.f, 0.f, 0.f}; accY[mt][nt] = (f32x4){0.f, 0.f, 0.f, 0.f}; }
#pragma unroll
        for (int ks = 0; ks < 4; ++ks) { bf16x8 aq[2];
#pragma unroll
            for (int mt = 0; mt < 2; ++mt) aq[mt] = *(const LAS bf16x8*)(QP + (wr * 32 + mt * 16 + fr) * RS + ks * 32 + fq * 8);
#pragma unroll
            for (int nt = 0; nt < 4; ++nt) { const bf16x8 bk = *(const LAS bf16x8*)(KB + (wc * 64 + nt * 16 + fr) * RS + ks * 32 + fq * 8), bs = *(const LAS bf16x8*)(ST + (wc * 64 + nt * 16 + fr) * RS + ks * 32 + fq * 8);
#pragma unroll
                for (int mt = 0; mt < 2; ++mt) { accP[mt][nt] = __builtin_amdgcn_mfma_f32_16x16x32_bf16(aq[mt], bk, accP[mt][nt], 0, 0, 0); accY[mt][nt] = __builtin_amdgcn_mfma_f32_16x16x32_bf16(aq[mt], bs, accY[mt][nt], 0, 0, 0); } }
            __builtin_amdgcn_sched_barrier(0); }
#pragma unroll
        for (int mt = 0; mt < 2; ++mt)
#pragma unroll
            for (int j = 0; j < 4; ++j) { const float qd = ri[mt][j] * gam;
#pragma unroll
                for (int nt = 0; nt < 4; ++nt) accY[mt][nt][j] *= qd; }
        __syncthreads();
#pragma unroll
        for (int mt = 0; mt < 2; ++mt)
#pragma unroll
            for (int nt = 0; nt < 4; ++nt)
#pragma unroll
                for (int j = 0; j < 4; ++j) { const int i = wr * 32 + mt * 16 + fq * 4 + j, jj = wc * 64 + nt * 16 + fr;
                    const float val = i >= jj ? accP[mt][nt][j] * ri[mt][j] * cj[nt] : 0.f; QP[i * RS + jj] = f2bf(val); }
#pragma unroll
        for (int it = 0; it < 4; ++it) { const int idx = it * 512 + tidv, j = idx >> 4, f = (idx & 15) * 4; LAS bf16_t* d = KB + f * RS + j;
            d[0] = (bf16_t)(kth[it][0] & 0xffffu); d[RS] = (bf16_t)(kth[it][0] >> 16); d[2 * RS] = (bf16_t)(kth[it][1] & 0xffffu); d[3 * RS] = (bf16_t)(kth[it][1] >> 16);
            LAS bf16_t* d2 = d + 64 * RS;
            d2[0] = (bf16_t)(kth[it][2] & 0xffffu); d2[RS] = (bf16_t)(kth[it][2] >> 16); d2[2 * RS] = (bf16_t)(kth[it][3] & 0xffffu); d2[3 * RS] = (bf16_t)(kth[it][3] >> 16); }
        __syncthreads();
#pragma unroll
        for (int mt = 0; mt < 2; ++mt)
#pragma unroll
            for (int nt = 0; nt < 4; ++nt) accS[mt][nt] = accS[mt][nt] * c_dec;
#pragma unroll
        for (int ks = 0; ks < 4; ++ks) { bf16x8 ap[2], av[2];
#pragma unroll
            for (int mt = 0; mt < 2; ++mt) { ap[mt] = *(const LAS bf16x8*)(QP + (wr * 32 + mt * 16 + fr) * RS + ks * 32 + fq * 8); av[mt] = *(const LAS bf16x8*)(VT + (wr * 32 + mt * 16 + fr) * RS + ks * 32 + fq * 8); }
#pragma unroll
            for (int nt = 0; nt < 4; ++nt) { const bf16x8 bv = *(const LAS bf16x8*)(VT + (wc * 64 + nt * 16 + fr) * RS + ks * 32 + fq * 8), bkt = *(const LAS bf16x8*)(KB + (wc * 64 + nt * 16 + fr) * RS + ks * 32 + fq * 8);
#pragma unroll
                for (int mt = 0; mt < 2; ++mt) { accY[mt][nt] = __builtin_amdgcn_mfma_f32_16x16x32_bf16(ap[mt], bv, accY[mt][nt], 0, 0, 0); accS[mt][nt] = __builtin_amdgcn_mfma_f32_16x16x32_bf16(av[mt], bkt, accS[mt][nt], 0, 0, 0); } }
            __builtin_amdgcn_sched_barrier(0); }
        __syncthreads();
#pragma unroll
        for (int mt = 0; mt < 2; ++mt)
#pragma unroll
            for (int nt = 0; nt < 4; ++nt)
#pragma unroll
                for (int j = 0; j < 4; ++j) { const int r = wr * 32 + mt * 16 + fq * 4 + j, c = wc * 64 + nt * 16 + fr;
                    ST[r * RS + c] = f2bf(accS[mt][nt][j]); YST[r * 132 + c] = accY[mt][nt][j]; }
        __syncthreads();
        { const int i = tidv >> 2, part = tidv & 3; float yv[32]; float s = 0.f;
#pragma unroll
          for (int x = 0; x < 8; ++x) { const f32x4 t4 = *(const LAS f32x4*)(YST + i * 132 + part * 32 + x * 4); yv[x * 4] = t4[0]; yv[x * 4 + 1] = t4[1]; yv[x * 4 + 2] = t4[2]; yv[x * 4 + 3] = t4[3]; s += t4[0] + t4[1] + t4[2] + t4[3]; }
          s = quad_sum(s); const float mean = s * (1.0f / 128.0f); float s2 = 0.f;
#pragma unroll
          for (int x = 0; x < 32; ++x) { yv[x] -= mean; s2 += yv[x] * yv[x]; }
          s2 = quad_sum(s2); const float rstd = rsqrtf(s2 * (1.0f / 128.0f) + 1e-5f);
          const bf16_t* gp = PS + (size_t)(row0 + i) * NCOLS + 1792 + 1536 + h * 128 + part * 32; const float* gw = P.gn_w + h * 128 + part * 32;
          bf16_t* yo = Y + (size_t)(row0 + i) * 1024 + 512 + h * 128 + part * 32;
#pragma unroll
          for (int x = 0; x < 4; ++x) { const u32x4 g4 = *(const u32x4*)(gp + x * 8); const float4 w0 = *(const float4*)(gw + x * 8), w1 = *(const float4*)(gw + x * 8 + 4);
              const float gg[8] = {lo_bf(g4.x), hi_bf(g4.x), lo_bf(g4.y), hi_bf(g4.y), lo_bf(g4.z), hi_bf(g4.z), lo_bf(g4.w), hi_bf(g4.w)}; const float ww[8] = {w0.x, w0.y, w0.z, w0.w, w1.x, w1.y, w1.z, w1.w};
              float o[8];
#pragma unroll
              for (int z = 0; z < 8; ++z) o[z] = yv[x * 8 + z] * rstd * ww[z] * (gg[z] / (1.0f + __expf(-gg[z])));
              u32x4 w; w.x = pg8::cvt_pk_bf16(o[0], o[1]); w.y = pg8::cvt_pk_bf16(o[2], o[3]); w.z = pg8::cvt_pk_bf16(o[4], o[5]); w.w = pg8::cvt_pk_bf16(o[6], o[7]);
              *(u32x4*)(yo + x * 8) = w; } }
        __syncthreads();
    }
#pragma unroll
    for (int mt = 0; mt < 2; ++mt)
#pragma unroll
        for (int nt = 0; nt < 4; ++nt)
#pragma unroll
            for (int j = 0; j < 4; ++j) { const int e = wr * 32 + mt * 16 + fq * 4 + j, d = wc * 64 + nt * 16 + fr;
                P.out[O_RTP + ((size_t)(b * 4 + h) * 128 + d) * 128 + e] = accS[mt][nt][j]; }
}

__device__ __forceinline__ void rwkv_post(PR P, const int wv) {
    const int tid = fresh_tid(wv); const int lane = tid & 63; const int gw = blockIdx.x * 8 + (tid >> 6), nw = gridDim.x * 8;
    const int sub = lane >> 4, cg4 = (lane & 15) * 4;
    const bf16_t* PS = (const bf16_t*)(P.ws + WS_BIG); const bf16_t* ASIG = (const bf16_t*)(P.ws + WS_ASIG); const bf16_t* YS = (const bf16_t*)(P.ws + WS_YS);
    const bf16_t* G = (const bf16_t*)(P.ws + WS_WIN); bf16_t* Y = (bf16_t*)(P.ws + WS_XN);
    for (int task = gw; task < MT * 2; task += nw) {
        const int item = task * 4 + sub, row = item >> 3, h = item & 7, ch = h * 64 + cg4;
        const u32x2 yr = *(const u32x2*)(YS + (size_t)row * 512 + ch);
        const bf16_t* cp = PS + (size_t)row * NCOLS + ch; const int pr = prev_row(row);
        const u32x2 c_r = *(const u32x2*)cp, c_k = *(const u32x2*)(cp + 512), c_v = *(const u32x2*)(cp + 1024);
        u32x2 p_r = (u32x2){0u, 0u}, p_k = p_r, p_v = p_r;
        if (pr >= 0) { const bf16_t* pp = PS + (size_t)pr * NCOLS + ch; p_r = *(const u32x2*)pp; p_k = *(const u32x2*)(pp + 512); p_v = *(const u32x2*)(pp + 1024); }
        const u32x2 ar = *(const u32x2*)(ASIG + (size_t)row * 512 + ch), gr = *(const u32x2*)(G + (size_t)row * 512 + ch);
        const float4 mr = *(const float4*)(P.mu + ch), mk = *(const float4*)(P.mu + 512 + ch), mv = *(const float4*)(P.mu + 1024 + ch);
        const float4 ka = *(const float4*)(P.k_a + ch), rk = *(const float4*)(P.r_k + ch), lw = *(const float4*)(P.lnx_w + ch), lb = *(const float4*)(P.lnx_b + ch);
        const float ys[4] = {lo_bf(yr.x), hi_bf(yr.x), lo_bf(yr.y), hi_bf(yr.y)};
        const float mean = row16_sum(ys[0] + ys[1] + ys[2] + ys[3]) * (1.0f / 64.0f);
        float dl[4], s2 = 0.f;
#pragma unroll
        for (int j = 0; j < 4; ++j) { dl[j] = ys[j] - mean; s2 += dl[j] * dl[j]; }
        const float rstd = rsqrtf(row16_sum(s2) * (1.0f / 64.0f) + 64e-5f);
        const float cr[4] = {lo_bf(c_r.x), hi_bf(c_r.x), lo_bf(c_r.y), hi_bf(c_r.y)}, ck[4] = {lo_bf(c_k.x), hi_bf(c_k.x), lo_bf(c_k.y), hi_bf(c_k.y)}, cv[4] = {lo_bf(c_v.x), hi_bf(c_v.x), lo_bf(c_v.y), hi_bf(c_v.y)};
        const float qr[4] = {lo_bf(p_r.x), hi_bf(p_r.x), lo_bf(p_r.y), hi_bf(p_r.y)}, qk[4] = {lo_bf(p_k.x), hi_bf(p_k.x), lo_bf(p_k.y), hi_bf(p_k.y)}, qv[4] = {lo_bf(p_v.x), hi_bf(p_v.x), lo_bf(p_v.y), hi_bf(p_v.y)};
        const float aa[4] = {lo_bf(ar.x), hi_bf(ar.x), lo_bf(ar.y), hi_bf(ar.y)}, gg[4] = {lo_bf(gr.x), hi_bf(gr.x), lo_bf(gr.y), hi_bf(gr.y)};
        const float m_r[4] = {mr.x, mr.y, mr.z, mr.w}, m_k[4] = {mk.x, mk.y, mk.z, mk.w}, m_v[4] = {mv.x, mv.y, mv.z, mv.w};
        const float kaa[4] = {ka.x, ka.y, ka.z, ka.w}, rkk[4] = {rk.x, rk.y, rk.z, rk.w}, lww[4] = {lw.x, lw.y, lw.z, lw.w}, lbb[4] = {lb.x, lb.y, lb.z, lb.w};
        float v[4], bp = 0.f;
#pragma unroll
        for (int j = 0; j < 4; ++j) { const float r = cr[j] + (qr[j] - cr[j]) * m_r[j], k = ck[j] + (qk[j] - ck[j]) * m_k[j]; v[j] = cv[j] + (qv[j] - cv[j]) * m_v[j];
            const float kn = k * (1.0f + (aa[j] - 1.0f) * kaa[j]); bp += r * kn * rkk[j]; }
        const float bonus = row16_sum(bp);
        float o[4];
#pragma unroll
        for (int j = 0; j < 4; ++j) o[j] = (dl[j] * rstd * lww[j] + lbb[j] + bonus * v[j]) * gg[j];
        u32x2 w; w.x = pg8::cvt_pk_bf16(o[0], o[1]); w.y = pg8::cvt_pk_bf16(o[2], o[3]);
        *(u32x2*)(Y + (size_t)row * 1024 + ch) = w;
    }
}

__global__ void __launch_bounds__(512, 2) hymba_mega(Params P_unused) {
    extern __shared__ __attribute__((aligned(16))) unsigned char shm[];
    cg::grid_group grid = cg::this_grid();
    LAS unsigned char* lds = (LAS unsigned char*)shm; LAS float* ldsf = (LAS float*)shm;
    const int G = gridDim.x, bx = blockIdx.x;
    const int wv = __builtin_amdgcn_readfirstlane(threadIdx.x >> 6);
    const CAS Params* kp = (const CAS Params*)__builtin_amdgcn_kernarg_segment_ptr();
#define P (*kp)
#define FRESH() asm volatile("" : "+s"(kp))
#ifndef REP_SYNC
#define REP_SYNC 1
#endif
#ifndef REP_P7
#define REP_P7 1
#endif
#ifndef REP_FFN1
#define REP_FFN1 1
#endif
#ifndef REP_P8
#define REP_P8 1
#endif
#define GSYNC() do { for (int r_ = 0; r_ < REP_SYNC; ++r_) xcd_barrier((unsigned*)ws, (volatile LAS unsigned*)(lds + LDS_BYTES - 16), wv); FRESH(); } while (0)
#define ws (kp->ws)
#define XN ((bf16_t*)(ws + WS_XN))
#define ACT ((bf16_t*)(ws + WS_BIG))
#define FO ((float*)(ws + WS_FO))
#define PS ((bf16_t*)(ws + WS_BIG))
    pg8::StaticOrder S;
    { unsigned* barw = (unsigned*)ws; const int t0 = fresh_tid(wv); if (bx == 0) for (int i = t0; i < XCD_BAR_WORDS; i += 512) barw[i] = 0u;
      if (t0 < 4) ((LAS unsigned*)(lds + LDS_BYTES - 16))[t0] = 0u; }
#ifndef PHM
#define PHM 0xFFFF
#endif
#define PH(k) if ((PHM >> (k)) & 1)
    PH(0) p0_prologue(P, ldsf, wv);
    grid.sync(); FRESH();
    if (fresh_tid(wv) == 0) (void)xb_add(&((unsigned*)ws)[XB_XCNT(xb_xcc_id())], 1u);
    for (int rep1 = 0; rep1 < REP_FFN1; ++rep1) {
    PH(1) { pg8::Gemm g{XN, (const bf16_t*)(ws + WS_WGU), MT, NGU, 1024}; S.init(MT, NGU, G, bx); pg8::EpiSwiGLU E{ACT, DFF}; pg8::gemm_phase(lds, g, S, E, wv); }
    GSYNC();
    PH(2) { pg8::Gemm g{ACT, (const bf16_t*)(ws + WS_WD), MT, 1024, DFF}; S.init(MT, 1024, G, bx); pg8::EpiF32 E{FO, 1024}; pg8::gemm_phase(lds, g, S, E, wv); }
    GSYNC();
    }
    PH(3) rows_phase(P, 1, wv);
    GSYNC();
    PH(4) { pg8::Gemm g{XN, (const bf16_t*)(ws + WS_WIN), MIN_, NCOLS, 1024}; S.init(MIN_, NCOLS, G, bx); pg8::EpiBf16 E{PS, NCOLS}; pg8::gemm_phase(lds, g, S, E, wv); }
    GSYNC();
    PH(5) lora_prep(P, wv);
    GSYNC();
    PH(6) { pg8::Gemm g{(const bf16_t*)(ws + WS_LA), (const bf16_t*)(ws + WS_WL), MT, 1536, 256}; S.init(MT, 1536, G, bx);
      pg8::EpiLora E{(bf16_t*)(ws + WS_OMD), (bf16_t*)(ws + WS_ASIG), (bf16_t*)(ws + WS_WIN), P.w0, P.a0}; pg8::gemm_phase(lds, g, S, E, wv); }
    GSYNC();
    for (int rep7 = 0; rep7 < REP_P7; ++rep7) {
    PH(7) for (int u = bx; u < 160; u += G) {
#ifndef NO_RWKVP
        if (u < 128) rwkv_unit<false>(P, ldsf, u >> 4, (u >> 1) & 7, u & 1, wv);
#endif
#ifndef NO_RETP
        if (u >= 128) ret_prompt_unit(P, lds, (u - 128) >> 2, (u - 128) & 3, wv);
#endif
    }
    PH(14) { const int sb0 = G > 192 ? 160 : 0;
      for (int u = bx - sb0; u >= 0 && u < 2560; u += G - sb0) { if (u < 2048) rwkv_unit<true>(P, ldsf, u >> 4, (u >> 1) & 7, u & 1, wv); else ret_sample_unit(P, ldsf, (u - 2048) >> 2, (u - 2048) & 3, wv); } }
    }
    GSYNC();
    for (int rep8 = 0; rep8 < REP_P8; ++rep8) PH(8) rwkv_post(P, wv);
    GSYNC();
    PH(9) { pg8::Gemm g{XN, (const bf16_t*)(ws + WS_WOUT), MT, 1024, 1024}; S.init(MT, 1024, G, bx); pg8::EpiF32 E{FO, 1024}; pg8::gemm_phase(lds, g, S, E, wv); }
    GSYNC();
    PH(10) { ffn_weights(P.f2g, P.f2u, P.f2d, ws, ldsf, wv);
    rows_phase(P, 2, wv); }
    GSYNC();
    PH(11) { pg8::Gemm g{XN, (const bf16_t*)(ws + WS_WGU), MT, NGU, 1024}; S.init(MT, NGU, G, bx); pg8::EpiSwiGLU E{ACT, DFF}; pg8::gemm_phase(lds, g, S, E, wv); }
    GSYNC();
    PH(12) { pg8::Gemm g{ACT, (const bf16_t*)(ws + WS_WD), MT, 1024, DFF}; S.init(MT, 1024, G, bx); pg8::EpiF32 E{FO, 1024}; pg8::gemm_phase(lds, g, S, E, wv); }
    GSYNC();
    PH(13) rows_phase(P, 3, wv);
}

#undef ws
#undef XN
#undef ACT
#undef FO
#undef PS
#undef P
extern "C" void kernel_launch(void* const* d_in, const int* in_sizes, int n_in, void* d_out, int out_size, void* d_ws, size_t ws_size, hipStream_t stream) {
    static int grid = 0;
    if (grid == 0) {
        if (n_in != 26 || ws_size < WS_END) { fprintf(stderr, "kernel_launch: unexpected n_in %d or ws_size %zu (< %zu)\n", n_in, ws_size, (size_t)WS_END); grid = -1; return; }
        int dev = 0, cus = 0, per_cu = 0;
        hipGetDevice(&dev); hipDeviceGetAttribute(&cus, hipDeviceAttributeMultiprocessorCount, dev);
        hipFuncSetAttribute((const void*)hymba_mega, hipFuncAttributeMaxDynamicSharedMemorySize, LDS_BYTES);
        hipOccupancyMaxActiveBlocksPerMultiprocessor(&per_cu, (const void*)hymba_mega, 512, LDS_BYTES);
        if (per_cu < 1) { fprintf(stderr, "kernel_launch: occupancy query says %d blocks/CU\n", per_cu); per_cu = 1; }
        grid = cus * per_cu; if (grid > 256) grid = 256;
        fprintf(stderr, "kernel_launch: cus %d per_cu %d grid %d ws %zu\n", cus, per_cu, grid, ws_size);
    }
    if (grid < 0) return;
    Params p{};
    const float** pp = (const float**)&p;
    for (int i = 0; i < 26; ++i) pp[i] = (const float*)d_in[i];
    p.out = (float*)d_out; p.ws = (unsigned char*)d_ws;
    void* args[] = {&p};
    hipError_t e = hipLaunchCooperativeKernel((const void*)hymba_mega, dim3(grid), dim3(512), args, LDS_BYTES, stream);
    if (e != hipSuccess) fprintf(stderr, "cooperative launch failed: %s (grid %d)\n", hipGetErrorString(e), grid);
}
```

```cpp
#include <hip/hip_runtime.h>
#include <hip/hip_cooperative_groups.h>
#include <cstdio>
#include <cstdint>
namespace cg = cooperative_groups;

__device__ __forceinline__ int fresh_tid(int wv) { int l; asm volatile("v_mbcnt_lo_u32_b32 %0, -1, 0\n\tv_mbcnt_hi_u32_b32 %0, -1, %0" : "=v"(l)); return wv * 64 + l; }
namespace pg8 {
#define PG8_LAS __attribute__((address_space(3)))
typedef unsigned short bf16_t;
typedef short bf16x8 __attribute__((ext_vector_type(8)));
typedef float f32x4 __attribute__((ext_vector_type(4)));
typedef unsigned u32x4 __attribute__((ext_vector_type(4)));
typedef unsigned u32x2 __attribute__((ext_vector_type(2)));
constexpr int BM = 256, BK = 64, HALF = 128, HTB = HALF * BK * 2, STAGE_BYTES = 8 * HTB, NXCD = 8, WGM = 8;

__host__ __device__ __forceinline__ int lds_byte(int r, int c) { const int st = (r >> 4) * 2 + (c >> 5), rr = r & 15, cc = c & 31, ob = rr * 64 + cc * 2; return st * 1024 + (ob ^ (((ob >> 9) & 1) << 5)); }
__host__ __device__ __forceinline__ void stage_rc(int b, int& R, int& C) { const int st = b / 1024, sb = b % 1024, swz = sb ^ (((sb >> 9) & 1) << 5); R = (st >> 1) * 16 + swz / 64; C = (st & 1) * 32 + (swz % 64) / 2; }
__host__ __device__ __forceinline__ int perm32(int rho) { const int n = rho >> 4, i = rho & 15; return 8 * (i >> 2) + 4 * n + (i & 3); }

struct Unit { int pm, pn; };
struct Gemm { const bf16_t* A; const bf16_t* Bt; int M, N, K; };

struct StaticOrder {
    int nM, nN, nwg, G, c;
    __host__ __device__ void init(int M, int N, int G_, int c_) { nM = M / BM; nN = N / BM; nwg = nM * nN; G = G_; c = c_; }
    __host__ __device__ bool next(int i, Unit& u) const {
        const long L = (long)i * G + c; if (L >= nwg) return false;
        int wgid = (int)L; { const int q = nwg / NXCD, r = nwg % NXCD, xcd = wgid % NXCD, off = wgid / NXCD; wgid = (xcd < r ? xcd * (q + 1) : r * (q + 1) + (xcd - r) * q) + off; }
        const int nig = WGM * nN, gid = wgid / nig, fm = gid * WGM, gsz = (nM - fm) < WGM ? (nM - fm) : WGM;
        u.pm = fm + ((wgid % nig) % gsz); u.pn = (wgid % nig) / gsz; return true;
    }
    __device__ __forceinline__ void a_ready(const Unit&) const {}
    __device__ __forceinline__ void done(const Unit&) const {}
};

__device__ __forceinline__ unsigned cvt_pk_bf16(float lo, float hi) { unsigned r; asm volatile("v_cvt_pk_bf16_f32 %0, %1, %2" : "=v"(r) : "v"(lo), "v"(hi)); return r; }

struct EpiF32 {
    static constexpr bool PERM = false;
    float* C; int ldc;
    __device__ __forceinline__ void operator()(const f32x4 (&acc)[2][2][4][2], const Unit& u, int wr, int wc, int fr, int fq) const {
        const int row0 = u.pm * BM + wr * 64 + fr, col0 = u.pn * BM + wc * 32 + 4 * fq;
#pragma unroll
        for (int ai = 0; ai < 2; ++ai)
#pragma unroll
            for (int m = 0; m < 4; ++m) { float* rowp = C + (size_t)(row0 + ai * HALF + m * 16) * ldc + col0;
#pragma unroll
                for (int bj = 0; bj < 2; ++bj)
#pragma unroll
                    for (int n = 0; n < 2; ++n) *(f32x4*)(rowp + bj * HALF + n * 16) = acc[ai][bj][m][n]; }
    }
};
struct EpiBf16 {
    static constexpr bool PERM = true;
    bf16_t* O; int ldc;
    __device__ __forceinline__ void operator()(const f32x4 (&acc)[2][2][4][2], const Unit& u, int wr, int wc, int fr, int fq) const {
        const int row0 = u.pm * BM + wr * 64 + fr; const int col0 = u.pn * BM + wc * 32 + 8 * fq;
#pragma unroll
        for (int ai = 0; ai < 2; ++ai)
#pragma unroll
            for (int m = 0; m < 4; ++m) { bf16_t* rowp = O + (size_t)(row0 + ai * HALF + m * 16) * ldc + col0;
#pragma unroll
                for (int bj = 0; bj < 2; ++bj) { const f32x4 v0 = acc[ai][bj][m][0], v1 = acc[ai][bj][m][1];
                    u32x4 w; w.x = cvt_pk_bf16(v0[0], v0[1]); w.y = cvt_pk_bf16(v0[2], v0[3]); w.z = cvt_pk_bf16(v1[0], v1[1]); w.w = cvt_pk_bf16(v1[2], v1[3]);
                    *(u32x4*)(rowp + bj * HALF) = w; } }
    }
};
__device__ __forceinline__ float silu_f(float x) { return x / (1.0f + __expf(-x)); }
struct EpiSwiGLU {
    static constexpr bool PERM = true;
    bf16_t* O; int ldc;
    __device__ __forceinline__ void operator()(const f32x4 (&acc)[2][2][4][2], const Unit& u, int wr, int wc, int fr, int fq) const {
        const int row0 = u.pm * BM + wr * 64 + fr; const int col0 = u.pn * HALF + wc * 32 + 8 * fq;
#pragma unroll
        for (int ai = 0; ai < 2; ++ai)
#pragma unroll
            for (int m = 0; m < 4; ++m) { bf16_t* rowp = O + (size_t)(row0 + ai * HALF + m * 16) * ldc + col0;
                float o[8];
#pragma unroll
                for (int n = 0; n < 2; ++n)
#pragma unroll
                    for (int j = 0; j < 4; ++j) o[n * 4 + j] = silu_f(acc[ai][0][m][n][j]) * acc[ai][1][m][n][j];
                u32x4 w; w.x = cvt_pk_bf16(o[0], o[1]); w.y = cvt_pk_bf16(o[2], o[3]); w.z = cvt_pk_bf16(o[4], o[5]); w.w = cvt_pk_bf16(o[6], o[7]);
                *(u32x4*)rowp = w; }
    }
};
struct EpiLora {
    static constexpr bool PERM = true;
    bf16_t* OMD; bf16_t* ASIG; bf16_t* G; const float* w0; const float* a0;
    template <int KIND> __device__ __forceinline__ void body(const f32x4 (&acc)[2][2][4][2], bf16_t* O, const float* bias, int row0, int ch0) const {
#pragma unroll
        for (int bj = 0; bj < 2; ++bj)
#pragma unroll
            for (int ai = 0; ai < 2; ++ai)
#pragma unroll
                for (int m = 0; m < 4; ++m) { bf16_t* rowp = O + (size_t)(row0 + ai * HALF + m * 16) * 512 + ch0 + bj * HALF;
                    float o[8];
#pragma unroll
                    for (int n = 0; n < 2; ++n)
#pragma unroll
                        for (int j = 0; j < 4; ++j) { float v = acc[ai][bj][m][n][j];
                            if (KIND == 0) { v += bias[ch0 + bj * HALF + n * 4 + j]; const float nv = -v; const float sp = fmaxf(nv, 0.f) + __logf(1.0f + __expf(-fabsf(nv)));
                                const float e = __expf(-sp - 0.5f);
                                float p = 1.0f / 40320.0f; p = -1.0f / 5040.0f + e * p; p = 1.0f / 720.0f + e * p; p = -1.0f / 120.0f + e * p; p = 1.0f / 24.0f + e * p; p = -1.0f / 6.0f + e * p; p = 0.5f + e * p; p = 1.0f - e * p;
                                v = e * p; }
                            else if (KIND == 1) { v += bias[ch0 + bj * HALF + n * 4 + j]; v = 1.0f / (1.0f + __expf(-v)); }
                            o[n * 4 + j] = v; }
                    u32x4 w; w.x = cvt_pk_bf16(o[0], o[1]); w.y = cvt_pk_bf16(o[2], o[3]); w.z = cvt_pk_bf16(o[4], o[5]); w.w = cvt_pk_bf16(o[6], o[7]);
                    *(u32x4*)rowp = w; __builtin_amdgcn_sched_barrier(0); }
    }
    __device__ __forceinline__ void operator()(const f32x4 (&acc)[2][2][4][2], const Unit& u, int wr, int wc, int fr, int fq) const {
        const int kind = u.pn >> 1;
        const int row0 = u.pm * BM + wr * 64 + fr; const int ch0 = (u.pn & 1) * BM + wc * 32 + 8 * fq;
        if (kind == 0) body<0>(acc, OMD, w0, row0, ch0); else if (kind == 1) body<1>(acc, ASIG, a0, row0, ch0); else body<2>(acc, G, a0, row0, ch0);
    }
};

template <class Epi, class Sched>
__device__ __forceinline__ void gemm_phase(PG8_LAS unsigned char* lds, const Gemm g, const Sched& S, const Epi& E, const int wv) {
    const int tid = fresh_tid(wv), wid = __builtin_amdgcn_readfirstlane(tid >> 6), lane = tid & 63, wr = wid >> 2, wc = wid & 3, fr = lane & 15, fq = lane >> 4;
    const int K = g.K, nt = K / BK;
    unsigned voffA[2], voffB[2];
#pragma unroll
    for (int i = 0; i < 2; ++i) { int R, C; stage_rc(tid * 16 + i * 8192, R, C); const int Rb = Epi::PERM ? ((R & ~31) + perm32(R & 31)) : R;
        voffA[i] = (unsigned)(R * K + C) * 2u; voffB[i] = (unsigned)(Rb * K + C) * 2u; }
    const size_t kstep = (size_t)(BK * 2);
    const size_t hstep = (size_t)HALF * K * 2;
    const size_t tstep = 2 * hstep;
    const unsigned ldsw = (unsigned)wid * 1024u;
    const int aoff = lds_byte(wr * 64 + fr, fq * 8), boff = lds_byte(wc * 32 + fr, fq * 8);
#define PG8_SA(b, h) (((b) * 2 + (h)) * HTB)
#define PG8_SB(b, h) ((4 + (b) * 2 + (h)) * HTB)
#define PG8_STAGE(bufoff, gbase, voff) do { _Pragma("unroll") for (int _i = 0; _i < 2; ++_i) \
        __builtin_amdgcn_global_load_lds((const unsigned*)((const char*)(gbase) + (voff)[_i]), (PG8_LAS unsigned*)(lds + (bufoff) + ldsw + _i * 8192), 16, 0, 0); } while (0)
#define PG8_LDA(dst, b, h) do { _Pragma("unroll") for (int m = 0; m < 4; ++m) _Pragma("unroll") for (int k = 0; k < 2; ++k) dst[m][k] = *(const PG8_LAS bf16x8*)(lds + PG8_SA(b, h) + aoff + m * 2048 + k * 1024); } while (0)
#define PG8_LDB(dst, b, h) do { _Pragma("unroll") for (int n = 0; n < 2; ++n) _Pragma("unroll") for (int k = 0; k < 2; ++k) dst[n][k] = *(const PG8_LAS bf16x8*)(lds + PG8_SB(b, h) + boff + n * 2048 + k * 1024); } while (0)
#define PG8_MMA(ai, bj, At, Bt) do { __builtin_amdgcn_s_setprio(1); _Pragma("unroll") for (int m = 0; m < 4; ++m) _Pragma("unroll") for (int n = 0; n < 2; ++n) _Pragma("unroll") for (int k = 0; k < 2; ++k) \
        acc[ai][bj][m][n] = __builtin_amdgcn_mfma_f32_16x16x32_bf16(Bt[n][k], At[m][k], acc[ai][bj][m][n], 0, 0, 0); __builtin_amdgcn_s_setprio(0); } while (0)
#define PG8_WAIT_V(n) asm volatile("s_waitcnt vmcnt(" #n ")" ::: "memory")
#define PG8_WAIT_L(n) asm volatile("s_waitcnt lgkmcnt(" #n ")" ::: "memory")
#define PG8_BAR __builtin_amdgcn_s_barrier()
#define PG8_SCHED __builtin_amdgcn_sched_barrier(0)
    Unit cur, nxt; int ui = 0;
    if (!S.next(0, cur)) return;
    f32x4 acc[2][2][4][2];
#pragma unroll
    for (int a = 0; a < 2; ++a)
#pragma unroll
        for (int b = 0; b < 2; ++b)
#pragma unroll
            for (int m = 0; m < 4; ++m)
#pragma unroll
                for (int n = 0; n < 2; ++n) acc[a][b][m][n] = (f32x4){0.f, 0.f, 0.f, 0.f};
    bf16x8 At[4][2], B0[2][2], B1[2][2];
    const char* cA = (const char*)g.A + (size_t)cur.pm * tstep; const char* cB = (const char*)g.Bt + (size_t)cur.pn * tstep;
    S.a_ready(cur);
    PG8_STAGE(PG8_SB(0, 0), cB, voffB); PG8_STAGE(PG8_SA(0, 0), cA, voffA); PG8_STAGE(PG8_SB(0, 1), cB + hstep, voffB); PG8_STAGE(PG8_SA(0, 1), cA + hstep, voffA);
    if (wr == 1) PG8_BAR;
    PG8_WAIT_V(4); PG8_BAR;
    PG8_STAGE(PG8_SB(1, 0), cB + kstep, voffB); PG8_STAGE(PG8_SA(1, 0), cA + kstep, voffA); PG8_STAGE(PG8_SB(1, 1), cB + hstep + kstep, voffB);
    PG8_WAIT_V(6); PG8_BAR;
    for (;;) {
        const bool has_next = S.next(ui + 1, nxt);
        const char* nA = has_next ? (const char*)g.A + (size_t)nxt.pm * tstep : cA; const char* nB = has_next ? (const char*)g.Bt + (size_t)nxt.pn * tstep : cB;
        for (int t = 0; t < nt; t += 2) {
            const bool last = (t == nt - 2);
            const char* a1 = cA + (size_t)(t + 1) * kstep;
            const char* a2 = last ? nA : cA + (size_t)(t + 2) * kstep; const char* b2 = last ? nB : cB + (size_t)(t + 2) * kstep;
            const char* a3 = a2 + kstep; const char* b3 = b2 + kstep;
            if (last && has_next) S.a_ready(nxt);
            PG8_LDB(B0, 0, 0); PG8_SCHED; PG8_LDA(At, 0, 0); PG8_STAGE(PG8_SA(1, 1), a1 + hstep, voffA);
            PG8_WAIT_L(8); PG8_BAR; PG8_WAIT_L(0); PG8_MMA(0, 0, At, B0); PG8_BAR; PG8_SCHED;
            PG8_LDB(B1, 0, 1); PG8_STAGE(PG8_SB(0, 0), b2, voffB);
            PG8_BAR; PG8_WAIT_L(0); PG8_MMA(0, 1, At, B1); PG8_BAR;
            PG8_LDA(At, 0, 1); PG8_STAGE(PG8_SA(0, 0), a2, voffA);
            PG8_BAR; PG8_WAIT_L(0); PG8_MMA(1, 0, At, B0); PG8_BAR; PG8_SCHED;
            PG8_STAGE(PG8_SB(0, 1), b2 + hstep, voffB);
            PG8_WAIT_V(6); PG8_BAR; PG8_MMA(1, 1, At, B1); PG8_BAR;
            PG8_LDB(B0, 1, 0); PG8_SCHED; PG8_LDA(At, 1, 0); PG8_STAGE(PG8_SA(0, 1), a2 + hstep, voffA);
            PG8_WAIT_L(8); PG8_BAR; PG8_WAIT_L(0); PG8_MMA(0, 0, At, B0); PG8_BAR; PG8_SCHED;
            PG8_LDB(B1, 1, 1); PG8_STAGE(PG8_SB(1, 0), b3, voffB);
            PG8_BAR; PG8_WAIT_L(0); PG8_MMA(0, 1, At, B1); PG8_BAR;
            PG8_LDA(At, 1, 1); PG8_STAGE(PG8_SA(1, 0), a3, voffA);
            PG8_BAR; PG8_WAIT_L(0); PG8_MMA(1, 0, At, B0); PG8_BAR; PG8_SCHED;
            PG8_STAGE(PG8_SB(1, 1), b3 + hstep, voffB);
            PG8_WAIT_V(6); PG8_BAR; PG8_MMA(1, 1, At, B1); PG8_BAR;
        }
        E(acc, cur, wr, wc, fr, fq); S.done(cur);
        if (!has_next) break;
#pragma unroll
        for (int a = 0; a < 2; ++a)
#pragma unroll
            for (int b = 0; b < 2; ++b)
#pragma unroll
                for (int m = 0; m < 4; ++m)
#pragma unroll
                    for (int n = 0; n < 2; ++n) acc[a][b][m][n] = (f32x4){0.f, 0.f, 0.f, 0.f};
        cur = nxt; cA = nA; cB = nB; ++ui;
    }
    PG8_WAIT_V(0);
    if (wr == 0) PG8_BAR;
    PG8_BAR;
#undef PG8_SA
#undef PG8_SB
#undef PG8_STAGE
#undef PG8_LDA
#undef PG8_LDB
#undef PG8_MMA
#undef PG8_WAIT_V
#undef PG8_WAIT_L
#undef PG8_BAR
#undef PG8_SCHED
}
}

using pg8::bf16_t; using pg8::f32x4; using pg8::bf16x8; using pg8::u32x4; using pg8::u32x2;
#define LAS __attribute__((address_space(3)))

constexpr int D = 1024, DFF = 2816, NGU = 5632, NCOLS = 3840;
constexpr int MP = 16384, MS = 512, MT = 16896, MIN_ = 17152;
constexpr int LDS_BYTES = 147456;
constexpr size_t O_SHP = 17301504, O_WKP = O_SHP + 8192, O_RTP = O_WKP + 262144, O_SHS = O_RTP + 524288, O_WKS = O_SHS + 131072, O_RTS = O_WKS + 4194304;
constexpr size_t WS_ROPE = 16384;
constexpr size_t WS_WL   = WS_ROPE + 1050624;
constexpr size_t WS_WOUT = WS_WL + 786432;
constexpr size_t WS_WIN  = WS_WOUT + 2097152;
constexpr size_t WS_WGU  = WS_WIN + 7864320;
constexpr size_t WS_WD   = WS_WGU + 11534336;
constexpr size_t WS_XN   = WS_WD + 5767168;
constexpr size_t WS_BIG  = WS_XN + 35127296;
constexpr size_t WS_FO   = WS_BIG + 95158272;
constexpr size_t WS_YS   = WS_BIG + 131727360;
constexpr size_t WS_LA   = WS_YS + 17301504;
constexpr size_t WS_OMD  = WS_BIG + 164364288;
constexpr size_t WS_ASIG = WS_OMD + 17301504;
constexpr size_t WS_END  = WS_ASIG + 17301504;
static_assert(WS_LA + 8650752 <= WS_OMD, "mixer overlays");
static_assert(WS_END <= 268435456, "workspace");

struct Params {
    const float *x_prompt, *x_sample, *state_shift, *state_wkv, *state_ret, *norm_g, *f1g, *f1u, *f1d, *w_in, *mu, *w0, *w2, *a0, *a2, *g2, *k_k, *k_a, *r_k, *lnx_w, *lnx_b, *gn_w, *w_out, *f2g, *f2u, *f2d;
    float* out; unsigned char* ws;
};
#define CAS __attribute__((address_space(4)))
typedef const CAS Params& PR;

__device__ __forceinline__ float bf2f(unsigned b) { return __uint_as_float(b << 16); }
__device__ __forceinline__ bf16_t f2bf(float f) { unsigned u = __float_as_uint(f); u += 0x7FFFu + ((u >> 16) & 1u); return (bf16_t)(u >> 16); }
__device__ __forceinline__ float lo_bf(unsigned x) { return __uint_as_float(x << 16); }
__device__ __forceinline__ float hi_bf(unsigned x) { return __uint_as_float(x & 0xffff0000u); }
template <int CTRL> __device__ __forceinline__ float dppf(float v) { return __int_as_float(__builtin_amdgcn_update_dpp(0, __float_as_int(v), CTRL, 0xF, 0xF, false)); }
__device__ __forceinline__ float row16_sum(float v) { v += dppf<0xB1>(v); v += dppf<0x4E>(v); v += dppf<0x141>(v); v += dppf<0x140>(v); return v; }
__device__ __forceinline__ float wave_sum(float v) { v = row16_sum(v); const int i = __float_as_int(v);
    return __int_as_float(__builtin_amdgcn_readlane(i, 0)) + __int_as_float(__builtin_amdgcn_readlane(i, 16)) + __int_as_float(__builtin_amdgcn_readlane(i, 32)) + __int_as_float(__builtin_amdgcn_readlane(i, 48)); }
__device__ __forceinline__ float quad_sum(float v) { v += dppf<0xB1>(v); v += dppf<0x4E>(v); return v; }
__device__ __forceinline__ float sigmoid_f(float x) { return 1.0f / (1.0f + __expf(-x)); }


#define XB_TMO      128
#define XB_XCNT(j)  (256  + 64 * (j))
#define XB_XSUB(j)  (1280 + 64 * (j))
#define XB_XGEN(j)  (2304 + 64 * (j))
#define XB_TOP      3328
#define XB_TOPGEN   3392
#define XCD_BAR_WORDS 3456
#define XB_SPIN_CAP (1u << 18)
__device__ __forceinline__ unsigned xb_ld(unsigned* p)              { return __hip_atomic_load(p, __ATOMIC_RELAXED, __HIP_MEMORY_SCOPE_AGENT); }
__device__ __forceinline__ unsigned xb_add(unsigned* p, unsigned v) { return __hip_atomic_fetch_add(p, v, __ATOMIC_RELAXED, __HIP_MEMORY_SCOPE_AGENT); }
__device__ __forceinline__ unsigned xb_xcc_id() { return (unsigned)__builtin_amdgcn_s_getreg((3 << 11) | 20) & 0xFu; }
#define XB_SPIN(cond, bar) do { unsigned _sp = 0; while (cond) { __builtin_amdgcn_s_sleep(1); \
    if ((++_sp & 255u) == 0u) { if (xb_ld(&(bar)[XB_TMO])) break; if (_sp > XB_SPIN_CAP) { atomicAdd(&(bar)[XB_TMO], 1u); break; } } } } while (0)
struct XcdBarrier { unsigned* bar; unsigned x; volatile LAS unsigned* st; };
__device__ __forceinline__ XcdBarrier xcd_barrier_post(unsigned* bar, volatile LAS unsigned* st) {
    XcdBarrier b; b.bar = bar; b.x = xb_xcc_id(); b.st = st;
    return b;
}
__device__ __forceinline__ void xcd_barrier_complete(unsigned* bar, unsigned x, unsigned& nloc, unsigned& nx) {
    const unsigned G = gridDim.x * gridDim.y * gridDim.z;
    unsigned sum, cnt, mine, sp = 0u;
    for (;;) {
        sum = 0u; cnt = 0u; mine = 0u;
#pragma unroll
        for (unsigned j = 0; j < 16; ++j) { const unsigned c = xb_ld(&bar[XB_XCNT(j)]); sum += c; cnt += (c > 0u) ? 1u : 0u; mine = (j == x) ? c : mine; }
        if (sum == G) break;
        __builtin_amdgcn_s_sleep(1);
        if ((++sp & 255u) == 0u) { if (xb_ld(&bar[XB_TMO])) break; if (sp > XB_SPIN_CAP) { atomicAdd(&bar[XB_TMO], 1u); break; } }
    }
    nloc = mine > 0u ? mine : 1u; nx = cnt > 0u ? cnt : 1u;
}
__device__ __forceinline__ void xcd_barrier(unsigned* barw, volatile LAS unsigned* stw, const int wv) {
    XcdBarrier b; b.bar = barw; b.x = xb_xcc_id(); b.st = stw;
    asm volatile("s_waitcnt vmcnt(0)" ::: "memory");
    __syncthreads();
    if (fresh_tid(wv) == 0) {
        unsigned* bar = b.bar;
        __builtin_amdgcn_s_waitcnt(0);
        unsigned nloc = b.st[0], nx = b.st[1];
        if (nloc == 0u) { xcd_barrier_complete(bar, b.x, nloc, nx); b.st[0] = nloc; b.st[1] = nx; }
        const unsigned old = xb_add(&bar[XB_XSUB(b.x)], 1u);
        const unsigned gen = old / nloc;
        if (old + 1u == (gen + 1u) * nloc) {
            __builtin_amdgcn_fence(__ATOMIC_RELEASE, "agent");
            asm volatile("s_waitcnt vmcnt(0)" ::: "memory");
            const unsigned og = xb_add(&bar[XB_TOP], 1u);
            const unsigned tg = og / nx;
            if (og + 1u == (tg + 1u) * nx) xb_add(&bar[XB_TOPGEN], 1u);
            else XB_SPIN(xb_ld(&bar[XB_TOPGEN]) == tg, bar);
            __builtin_amdgcn_fence(__ATOMIC_ACQUIRE, "agent");
            xb_add(&bar[XB_XGEN(b.x)], 1u);
            asm volatile("s_waitcnt vmcnt(0)" ::: "memory");
        } else {
            XB_SPIN(xb_ld(&bar[XB_XGEN(b.x)]) == gen, bar);
            __builtin_amdgcn_fence(__ATOMIC_ACQUIRE, "agent");
            asm volatile("s_waitcnt vmcnt(0)" ::: "memory");
        }
    }
    __syncthreads();
}


#define DPP2(x, y, CTRL, NOP) asm volatile(NOP "\n\tv_add_f32_dpp %0, %0, %0 " CTRL " row_mask:0xf bank_mask:0xf bound_ctrl:1\n\tv_add_f32_dpp %1, %1, %1 " CTRL " row_mask:0xf bank_mask:0xf bound_ctrl:1" : "+v"(x), "+v"(y))
#define ROW16_SUM2(x, y) do { DPP2(x, y, "quad_perm:[1,0,3,2]", "s_nop 1"); DPP2(x, y, "quad_perm:[2,3,0,1]", "s_nop 0"); DPP2(x, y, "row_half_mirror", "s_nop 0"); DPP2(x, y, "row_mirror", "s_nop 0"); } while (0)
__device__ __forceinline__ int prev_row(int r) {
    if (r < MP) return (r & 2047) == 0 ? -1 : r - 1;
    const int s = r - MP; return (s & 3) == 0 ? MT + (s >> 2) : r - 1;
}

__device__ __forceinline__ void tconv_tile(const float* __restrict__ W, int K, int N, bf16_t* __restrict__ Bt, int mode, int tile, LAS float* t, const int wv) {
    const int nkt = K / 64; const int kt = tile % nkt, nt = tile / nkt; const int k0 = kt * 64, n0 = nt * 64;
    const int brow0 = mode == 0 ? n0 : ((n0 >> 7) * 256 + (n0 & 127) + (mode == 2 ? 128 : 0));
    const int tid = fresh_tid(wv);
#pragma unroll
    for (int e = 0; e < 8; ++e) { const int idx = e * 512 + tid, r = idx >> 6, c = idx & 63; t[r * 65 + c] = W[(size_t)(k0 + r) * N + n0 + c]; }
    __syncthreads();
#pragma unroll
    for (int e = 0; e < 4; ++e) { const int idx = e * 512 + tid, n = idx >> 5, kp = idx & 31;
        const unsigned w = pg8::cvt_pk_bf16(t[(2 * kp) * 65 + n], t[(2 * kp + 1) * 65 + n]);
        *(unsigned*)(Bt + (size_t)(brow0 + n) * K + k0 + 2 * kp) = w; }
    __syncthreads();
}
__device__ __forceinline__ void ffn_weights(const float* wg, const float* wu, const float* wd, unsigned char* ws, LAS float* t, const int wv) {
    for (int i = blockIdx.x; i < 2112; i += gridDim.x) {
        if (i < 704) tconv_tile(wg, 1024, DFF, (bf16_t*)(ws + WS_WGU), 1, i, t, wv);
        else if (i < 1408) tconv_tile(wu, 1024, DFF, (bf16_t*)(ws + WS_WGU), 2, i - 704, t, wv);
        else tconv_tile(wd, DFF, 1024, (bf16_t*)(ws + WS_WD), 0, i - 1408, t, wv);
    }
}

__device__ __forceinline__ void rows_phase(PR P, const int mode, const int wv) {
    const int tid = fresh_tid(wv); const int lane = tid & 63; const int gw = blockIdx.x * 8 + (tid >> 6), nw = gridDim.x * 8;
    const float* FO = (const float*)(P.ws + WS_FO); bf16_t* XN = (bf16_t*)(P.ws + WS_XN);
    const float* gpost = P.norm_g + (mode == 1 ? 1 : (mode == 2 ? 3 : 5)) * 1024;
    const float* gnext = P.norm_g + (mode == 0 ? 0 : (mode == 1 ? 2 : 4)) * 1024;
    const float scale = mode == 2 ? 1.0f : 0.5f;
    for (int row = gw; row < MT; row += nw) {
        const float* xin = mode <= 1 ? (row < MP ? P.x_prompt + (size_t)row * 1024 : P.x_sample + (size_t)(row - MP) * 1024) : P.out + (size_t)row * 1024;
        float4 xv[4];
#pragma unroll
        for (int q = 0; q < 4; ++q) xv[q] = *(const float4*)(xin + (q * 64 + lane) * 4);
        if (mode != 0) {
            float4 fo[4]; float ss = 0.f;
#pragma unroll
            for (int q = 0; q < 4; ++q) { fo[q] = *(const float4*)(FO + (size_t)row * 1024 + (q * 64 + lane) * 4); ss += fo[q].x * fo[q].x + fo[q].y * fo[q].y + fo[q].z * fo[q].z + fo[q].w * fo[q].w; }
            ss = wave_sum(ss); const float r = rsqrtf(ss * (1.0f / 1024.0f) + 1e-6f) * scale;
#pragma unroll
            for (int q = 0; q < 4; ++q) { const float4 g = *(const float4*)(gpost + (q * 64 + lane) * 4);
                xv[q].x += fo[q].x * r * g.x; xv[q].y += fo[q].y * r * g.y; xv[q].z += fo[q].z * r * g.z; xv[q].w += fo[q].w * r * g.w;
                *(float4*)(P.out + (size_t)row * 1024 + (q * 64 + lane) * 4) = xv[q]; }
            if (mode == 3) continue;
        }
        float ss2 = 0.f;
#pragma unroll
        for (int q = 0; q < 4; ++q) ss2 += xv[q].x * xv[q].x + xv[q].y * xv[q].y + xv[q].z * xv[q].z + xv[q].w * xv[q].w;
        ss2 = wave_sum(ss2); const float r2 = rsqrtf(ss2 * (1.0f / 1024.0f) + 1e-6f);
        float* sh = nullptr;
        if (mode == 1) { if (row < MP) { if ((row & 2047) == 2047) sh = P.out + O_SHP + (size_t)(row >> 11) * 1024; } else { const int s = row - MP; if ((s & 3) == 3) sh = P.out + O_SHS + (size_t)(s >> 2) * 1024; } }
#pragma unroll
        for (int q = 0; q < 4; ++q) { const float4 g = *(const float4*)(gnext + (q * 64 + lane) * 4);
            float4 hv; hv.x = xv[q].x * r2 * g.x; hv.y = xv[q].y * r2 * g.y; hv.z = xv[q].z * r2 * g.z; hv.w = xv[q].w * r2 * g.w;
            u32x2 w; w.x = pg8::cvt_pk_bf16(hv.x, hv.y); w.y = pg8::cvt_pk_bf16(hv.z, hv.w);
            *(u32x2*)(XN + (size_t)row * 1024 + (q * 64 + lane) * 4) = w;
            if (sh) *(float4*)(sh + (q * 64 + lane) * 4) = hv; }
    }
}

__device__ __forceinline__ void p0_prologue(PR P, LAS float* ldsf, const int wv) {
    const int tid = fresh_tid(wv); const size_t gt = (size_t)blockIdx.x * 512 + tid, nth = (size_t)gridDim.x * 512;
    { float* rc = (float*)(P.ws + WS_ROPE); float* rs = rc + 2052 * 64;
      for (size_t i = gt; i < 2052 * 64; i += nth) { const int p = (int)(i >> 6), f = (int)(i & 63); const int pos = p < 2048 ? p : 16384 + (p - 2048);
          double inv = 1.0; for (int q = 0; q < f; ++q) inv *= 0.8659643233600653;
          const double ang = (double)pos * inv; const double n = rint(ang * 0.15915494309189535); const double r = ang - n * 6.283185307179586;
          const double r2 = r * r; double s = 0.0, c = 0.0;
          for (int k = 14; k >= 0; --k) { s = s * (-r2 / (double)((2 * k + 2) * (2 * k + 3))) + 1.0; c = c * (-r2 / (double)((2 * k + 1) * (2 * k + 2))) + 1.0; }
          rc[i] = (float)c; rs[i] = (float)(s * r); } }
    { bf16_t* Wl = (bf16_t*)(P.ws + WS_WL);
      for (size_t i = gt; i < 1536 * 256; i += nth) { const int n = (int)(i >> 8), k = (int)(i & 255); float v = 0.f;
          if (n < 512) { if (k < 64) v = P.w2[k * 512 + n]; } else if (n < 1024) { if (k >= 64 && k < 128) v = P.a2[(k - 64) * 512 + (n - 512)]; } else { if (k >= 128) v = P.g2[(k - 128) * 512 + (n - 1024)]; }
          Wl[i] = f2bf(v); } }
    { bf16_t* XN = (bf16_t*)(P.ws + WS_XN);
      for (size_t i = gt; i < 256 * 1024; i += nth) { const int r = (int)(i >> 10); XN[(size_t)MT * 1024 + i] = r < 128 ? f2bf(P.state_shift[i]) : (bf16_t)0; } }
    ffn_weights(P.f1g, P.f1u, P.f1d, P.ws, ldsf, wv);
    for (int i = blockIdx.x; i < 1216; i += gridDim.x) {
        if (i < 960) tconv_tile(P.w_in, 1024, NCOLS, (bf16_t*)(P.ws + WS_WIN), 0, i, ldsf, wv);
        else tconv_tile(P.w_out, 1024, 1024, (bf16_t*)(P.ws + WS_WOUT), 0, i - 960, ldsf, wv);
    }
    rows_phase(P, 0, wv);
}

__device__ __forceinline__ void lora_prep(PR P, const int wv) {
    const int tid = fresh_tid(wv); const int lane = tid & 63; const int gw = blockIdx.x * 8 + (tid >> 6), nw = gridDim.x * 8;
    const bf16_t* PS = (const bf16_t*)(P.ws + WS_BIG); bf16_t* LA = (bf16_t*)(P.ws + WS_LA);
    const float4 mu = *(const float4*)(P.mu + 1536 + lane * 4); const int kind = lane >> 4;
    for (int row = gw; row < MT; row += nw) {
        const u32x2 c = *(const u32x2*)(PS + (size_t)row * NCOLS + 1536 + lane * 4); const int pr = prev_row(row);
        u32x2 p = (u32x2){0u, 0u}; if (pr >= 0) p = *(const u32x2*)(PS + (size_t)pr * NCOLS + 1536 + lane * 4);
        float v[4]; const float cu[4] = {lo_bf(c.x), hi_bf(c.x), lo_bf(c.y), hi_bf(c.y)}, pv[4] = {lo_bf(p.x), hi_bf(p.x), lo_bf(p.y), hi_bf(p.y)}, m4[4] = {mu.x, mu.y, mu.z, mu.w};
#pragma unroll
        for (int j = 0; j < 4; ++j) { float x = cu[j] + (pv[j] - cu[j]) * m4[j];
            if (kind == 0) x = 1.0f - 2.0f / (__expf(2.0f * x) + 1.0f); else if (kind >= 2) x = sigmoid_f(x);
            v[j] = x; }
        u32x2 w; w.x = pg8::cvt_pk_bf16(v[0], v[1]); w.y = pg8::cvt_pk_bf16(v[2], v[3]);
        *(u32x2*)(LA + (size_t)row * 256 + lane * 4) = w;
    }
}

template <bool SAMPLE>
__device__ __forceinline__ void rwkv_unit(PR P, LAS float* lds, const int b, const int h, const int half, const int wv) {
    constexpr int T = SAMPLE ? 4 : 2048, TC = SAMPLE ? 4 : 32, NCH = T / TC;
    const int tid = fresh_tid(wv), lane = tid & 63, wid = tid >> 6;
    const bf16_t* PS = (const bf16_t*)(P.ws + WS_BIG); const bf16_t* OMD = (const bf16_t*)(P.ws + WS_OMD); const bf16_t* ASIG = (const bf16_t*)(P.ws + WS_ASIG);
    bf16_t* YS = (bf16_t*)(P.ws + WS_YS);
    const int row_base = SAMPLE ? MP + b * 4 : b * 2048;
    const int ltok = tid >> 4, lcg = tid & 15; const bool lact = ltok < TC; const int hch = h * 64 + lcg * 4;
    const float4 mur = *(const float4*)(P.mu + hch), muk = *(const float4*)(P.mu + 512 + hch), muv = *(const float4*)(P.mu + 1024 + hch);
    const float4 kk4 = *(const float4*)(P.k_k + hch), ka4 = *(const float4*)(P.k_a + hch);
    typedef float f32x2 __attribute__((ext_vector_type(2)));
    const int row0 = half * 32 + (wid & 3) * 8 + (lane >> 4) * 2, cgl = lane & 15, j0 = cgl * 4;
    f32x2 S[4];
#pragma unroll
    for (int c = 0; c < 4; ++c) S[c] = (f32x2){0.f, 0.f};
    float* sout = P.out + (SAMPLE ? O_WKS : O_WKP) + ((size_t)(b * 8 + h) * 64 + row0) * 64 + j0;
    if (SAMPLE && wid < 4) { const float* sp = P.state_wkv + ((size_t)(b * 8 + h) * 64 + row0) * 64 + j0; const float4 s0 = *(const float4*)sp, s1 = *(const float4*)(sp + 64);
        S[0] = (f32x2){s0.x, s1.x}; S[1] = (f32x2){s0.y, s1.y}; S[2] = (f32x2){s0.z, s1.z}; S[3] = (f32x2){s0.w, s1.w}; }
    LAS float* buf0 = lds; LAS float* buf1 = lds + TC * 384;
    u32x2 cr, ck, cv, pr, pk, pv, co, ca;
#define RW_LOAD(c) do { if (lact) { const int t_ = (c) * TC + ltok; const int row_ = row_base + t_; const int prow_ = SAMPLE ? (t_ == 0 ? MT + b : row_ - 1) : row_ - 1; \
        const bf16_t* cp_ = PS + (size_t)row_ * NCOLS + hch; cr = *(const u32x2*)cp_; ck = *(const u32x2*)(cp_ + 512); cv = *(const u32x2*)(cp_ + 1024); \
        if (SAMPLE || t_ > 0) { const bf16_t* pp_ = PS + (size_t)prow_ * NCOLS + hch; pr = *(const u32x2*)pp_; pk = *(const u32x2*)(pp_ + 512); pv = *(const u32x2*)(pp_ + 1024); } \
        else { pr = (u32x2){0u, 0u}; pk = pr; pv = pr; } \
        co = *(const u32x2*)(OMD + (size_t)row_ * 512 + hch); ca = *(const u32x2*)(ASIG + (size_t)row_ * 512 + hch); } } while (0)
#define RW_MIX(cu, pv_, m) ((cu) + ((pv_) - (cu)) * (m))
#define RW_PROC(dst) do { if (lact) { LAS float* d_ = (dst) + ltok * 384 + lcg * 4; \
        f32x4 r_, k_, v_, o_, a_; \
        r_[0] = RW_MIX(lo_bf(cr.x), lo_bf(pr.x), mur.x); r_[1] = RW_MIX(hi_bf(cr.x), hi_bf(pr.x), mur.y); r_[2] = RW_MIX(lo_bf(cr.y), lo_bf(pr.y), mur.z); r_[3] = RW_MIX(hi_bf(cr.y), hi_bf(pr.y), mur.w); \
        k_[0] = RW_MIX(lo_bf(ck.x), lo_bf(pk.x), muk.x); k_[1] = RW_MIX(hi_bf(ck.x), hi_bf(pk.x), muk.y); k_[2] = RW_MIX(lo_bf(ck.y), lo_bf(pk.y), muk.z); k_[3] = RW_MIX(hi_bf(ck.y), hi_bf(pk.y), muk.w); \
        v_[0] = RW_MIX(lo_bf(cv.x), lo_bf(pv.x), muv.x); v_[1] = RW_MIX(hi_bf(cv.x), hi_bf(pv.x), muv.y); v_[2] = RW_MIX(lo_bf(cv.y), lo_bf(pv.y), muv.z); v_[3] = RW_MIX(hi_bf(cv.y), hi_bf(pv.y), muv.w); \
        o_[0] = lo_bf(co.x); o_[1] = hi_bf(co.x); o_[2] = lo_bf(co.y); o_[3] = hi_bf(co.y); a_[0] = lo_bf(ca.x); a_[1] = hi_bf(ca.x); a_[2] = lo_bf(ca.y); a_[3] = hi_bf(ca.y); \
        f32x4 kk_; kk_[0] = k_[0] * kk4.x; kk_[1] = k_[1] * kk4.y; kk_[2] = k_[2] * kk4.z; kk_[3] = k_[3] * kk4.w; \
        float ss_ = kk_[0] * kk_[0] + kk_[1] * kk_[1] + kk_[2] * kk_[2] + kk_[3] * kk_[3]; ss_ = row16_sum(ss_); \
        const float inv_ = 1.0f / fmaxf(sqrtf(ss_), 1e-12f); kk_ = kk_ * inv_; \
        f32x4 kn_; kn_[0] = k_[0] * (1.0f + (a_[0] - 1.0f) * ka4.x); kn_[1] = k_[1] * (1.0f + (a_[1] - 1.0f) * ka4.y); kn_[2] = k_[2] * (1.0f + (a_[2] - 1.0f) * ka4.z); kn_[3] = k_[3] * (1.0f + (a_[3] - 1.0f) * ka4.w); \
        *(LAS f32x4*)(d_) = r_; *(LAS f32x4*)(d_ + 64) = o_; *(LAS f32x4*)(d_ + 128) = kn_; *(LAS f32x4*)(d_ + 192) = -kk_; *(LAS f32x4*)(d_ + 256) = kk_ * a_; *(LAS f32x4*)(d_ + 320) = v_; } } while (0)
    RW_LOAD(0); RW_PROC(buf0); __syncthreads();
    for (int c = 0; c < NCH; ++c) {
        LAS float* cur = (c & 1) ? buf1 : buf0; LAS float* nxt = (c & 1) ? buf0 : buf1;
        if (c + 1 < NCH) RW_LOAD(c + 1);
        if (wid < 4) {
            constexpr int GS = SAMPLE ? 4 : 16;
            for (int g = 0; g < TC / GS; ++g) {
                float yk0 = 0.f, yk1 = 0.f;
                const LAS float* q0 = cur + (g * GS) * 384;
                f32x4 r4 = *(const LAS f32x4*)(q0 + j0), o4 = *(const LAS f32x4*)(q0 + 64 + j0), k4 = *(const LAS f32x4*)(q0 + 128 + j0), a4 = *(const LAS f32x4*)(q0 + 192 + j0), b4 = *(const LAS f32x4*)(q0 + 256 + j0);
                f32x2 v2 = *(const LAS f32x2*)(q0 + 320 + row0);
#pragma unroll
                for (int tt = 0; tt < GS; ++tt) {
                    const LAS float* qn = q0 + (tt + 1 < GS ? tt + 1 : tt) * 384;
                    const f32x4 nr4 = *(const LAS f32x4*)(qn + j0), no4 = *(const LAS f32x4*)(qn + 64 + j0), nk4 = *(const LAS f32x4*)(qn + 128 + j0), na4 = *(const LAS f32x4*)(qn + 192 + j0), nb4 = *(const LAS f32x4*)(qn + 256 + j0);
                    const f32x2 nv2 = *(const LAS f32x2*)(qn + 320 + row0);
                    f32x2 sa = (S[0] * a4[0] + S[1] * a4[1]) + (S[2] * a4[2] + S[3] * a4[3]);
                    float sx = sa.x, sy = sa.y; ROW16_SUM2(sx, sy); sa = (f32x2){sx, sy};
#pragma unroll
                    for (int c = 0; c < 4; ++c) { f32x2 t = S[c] - S[c] * o4[c]; t = t + sa * b4[c]; S[c] = t + v2 * k4[c]; }
                    f32x2 y = (S[0] * r4[0] + S[1] * r4[1]) + (S[2] * r4[2] + S[3] * r4[3]);
                    float yx = y.x, yy = y.y; ROW16_SUM2(yx, yy);
                    yk0 = cgl == tt ? yx : yk0; yk1 = cgl == tt ? yy : yk1;
                    r4 = nr4; o4 = no4; k4 = nk4; a4 = na4; b4 = nb4; v2 = nv2;
                }
                if (cgl < GS) *(unsigned*)(YS + (size_t)(row_base + c * TC + g * GS + cgl) * 512 + h * 64 + row0) = pg8::cvt_pk_bf16(yk0, yk1);
            }
        }
        if (c + 1 < NCH) RW_PROC(nxt);
        __syncthreads();
    }
    if (wid < 4) { *(float4*)sout = make_float4(S[0].x, S[1].x, S[2].x, S[3].x); *(float4*)(sout + 64) = make_float4(S[0].y, S[1].y, S[2].y, S[3].y); }
#undef RW_LOAD
#undef RW_PROC
#undef RW_MIX
}

__device__ __forceinline__ void ret_sample_unit(PR P, LAS float* lds, const int b, const int h, const int wv) {
    const int tid = fresh_tid(wv), lane = tid & 63, wid = tid >> 6;
    const bf16_t* PS = (const bf16_t*)(P.ws + WS_BIG); bf16_t* Y = (bf16_t*)(P.ws + WS_XN);
    const float* rc = (const float*)(P.ws + WS_ROPE); const float* rs = rc + 2052 * 64;
    LAS float* q = lds; LAS float* k = lds + 512; LAS float* v = lds + 1024; LAS float* Pm = lds + 1536; LAS float* y2p = lds + 1600; LAS float* red = lds + 1600 + 2048;
    const float lg2 = log2f(1.0f - exp2f(-5.0f - (float)h));
    const int row0 = MP + b * 4;
    { const int t = (tid & 255) >> 6, f = tid & 63; const bf16_t* src = PS + (size_t)(row0 + t) * NCOLS + 1792 + h * 128;
      if (tid < 256) { const float cs = rc[(2048 + t) * 64 + f], sn = rs[(2048 + t) * 64 + f];
          const float q1 = bf2f(src[f]), q2 = bf2f(src[f + 64]); q[t * 128 + f] = q1 * cs - q2 * sn; q[t * 128 + f + 64] = q1 * sn + q2 * cs;
          const float k1 = bf2f(src[512 + f]), k2 = bf2f(src[512 + f + 64]); k[t * 128 + f] = (k1 * cs - k2 * sn) * 0.08838834764831845f; k[t * 128 + f + 64] = (k1 * sn + k2 * cs) * 0.08838834764831845f; }
      else { v[t * 128 + f] = bf2f(src[1024 + f]); v[t * 128 + f + 64] = bf2f(src[1024 + f + 64]); } }
    __syncthreads();
    if (wid == 0) { const int pi = lane >> 4, pj = (lane >> 2) & 3, part = lane & 3; float s = 0.f;
        for (int d = part * 32; d < part * 32 + 32; ++d) s += q[pi * 128 + d] * k[pj * 128 + d];
        s = quad_sum(s); if (part == 0) Pm[pi * 4 + pj] = pi >= pj ? s * exp2f(lg2 * (float)(pi - pj)) : 0.f; }
    { const int e = tid & 127, dg = tid >> 7; const float c4 = exp2f(lg2 * 4.0f), g3 = exp2f(lg2 * 3.0f), g2_ = exp2f(lg2 * 2.0f), g1 = exp2f(lg2);
      const float v0 = v[e] * g3, v1 = v[128 + e] * g2_, v2 = v[256 + e] * g1, v3 = v[384 + e];
      const float* S0 = P.state_ret + ((size_t)(b * 4 + h) * 128) * 128 + e; float* So = P.out + O_RTS + ((size_t)(b * 4 + h) * 128) * 128 + e;
      float a0 = 0.f, a1 = 0.f, a2 = 0.f, a3 = 0.f;
      float sv[32];
#pragma unroll
      for (int x = 0; x < 32; ++x) sv[x] = S0[(size_t)(dg * 32 + x) * 128];
#pragma unroll
      for (int x = 0; x < 32; ++x) { const int d = dg * 32 + x; const float s = sv[x];
          a0 = fmaf(q[d], s, a0); a1 = fmaf(q[128 + d], s, a1); a2 = fmaf(q[256 + d], s, a2); a3 = fmaf(q[384 + d], s, a3);
          So[(size_t)d * 128] = s * c4 + k[d] * v0 + k[128 + d] * v1 + k[256 + d] * v2 + k[384 + d] * v3; }
      y2p[(dg * 4 + 0) * 128 + e] = a0; y2p[(dg * 4 + 1) * 128 + e] = a1; y2p[(dg * 4 + 2) * 128 + e] = a2; y2p[(dg * 4 + 3) * 128 + e] = a3; }
    __syncthreads();
    { const int i = tid >> 7, e = tid & 127;
      float y = (y2p[(0 + i) * 128 + e] + y2p[(4 + i) * 128 + e] + y2p[(8 + i) * 128 + e] + y2p[(12 + i) * 128 + e]) * exp2f(lg2 * (float)(i + 1));
#pragma unroll
      for (int j = 0; j < 4; ++j) y = fmaf(Pm[i * 4 + j], v[j * 128 + e], y);
      float s = wave_sum(y); if (lane == 0) red[wid] = s; __syncthreads();
      const float mean = (red[i * 2] + red[i * 2 + 1]) * (1.0f / 128.0f); const float dlt = y - mean;
      float s2 = wave_sum(dlt * dlt); if (lane == 0) red[8 + wid] = s2; __syncthreads();
      const float var = (red[8 + i * 2] + red[8 + i * 2 + 1]) * (1.0f / 128.0f);
      const float g = bf2f(PS[(size_t)(row0 + i) * NCOLS + 1792 + 1536 + h * 128 + e]);
      const float o = dlt * rsqrtf(var + 1e-5f) * P.gn_w[h * 128 + e] * (g / (1.0f + __expf(-g)));
      Y[(size_t)(row0 + i) * 1024 + 512 + h * 128 + e] = f2bf(o); }
    __syncthreads();
}

__device__ __forceinline__ bf16_t* kvb_ptr(unsigned char* ws, int bh) { return (bf16_t*)(bh < 29 ? ws + WS_LA + (size_t)bh * 524288 : ws + WS_WIN + 17301504 + (size_t)(bh - 29) * 524288); }
constexpr int RS = 136, BUFE = 128 * RS;

template <bool WITH_K>
__device__ __forceinline__ void ret_load_qk(PR P, LAS bf16_t* QP, LAS bf16_t* KB, unsigned (&kth)[4][4], const int tidv, const int row0, const int n, const int h, const float kd0, const float g32) {
    const bf16_t* PS = (const bf16_t*)(P.ws + WS_BIG); const float* rc = (const float*)(P.ws + WS_ROPE); const float* rs = rc + 2052 * 64;
    float kd = kd0;
#pragma unroll
    for (int it = 0; it < 4; ++it) { const int idx = it * 512 + tidv, i = idx >> 4, f = (idx & 15) * 4;
        const bf16_t* src = PS + (size_t)(row0 + i) * NCOLS + 1792 + h * 128;
        const u32x2 q1 = *(const u32x2*)(src + f), q2 = *(const u32x2*)(src + 64 + f);
        u32x2 k1 = (u32x2){0u, 0u}, k2 = k1; if (WITH_K) { k1 = *(const u32x2*)(src + 512 + f); k2 = *(const u32x2*)(src + 576 + f); }
        const float4 cs = *(const float4*)(rc + (size_t)(n * 128 + i) * 64 + f), sn = *(const float4*)(rs + (size_t)(n * 128 + i) * 64 + f);
        const float c4[4] = {cs.x, cs.y, cs.z, cs.w}, s4[4] = {sn.x, sn.y, sn.z, sn.w};
        const float qa[4] = {lo_bf(q1.x), hi_bf(q1.x), lo_bf(q1.y), hi_bf(q1.y)}, qb[4] = {lo_bf(q2.x), hi_bf(q2.x), lo_bf(q2.y), hi_bf(q2.y)};
        float qo1[4], qo2[4];
#pragma unroll
        for (int x = 0; x < 4; ++x) { qo1[x] = qa[x] * c4[x] - qb[x] * s4[x]; qo2[x] = qa[x] * s4[x] + qb[x] * c4[x]; }
        u32x2 w; w.x = pg8::cvt_pk_bf16(qo1[0], qo1[1]); w.y = pg8::cvt_pk_bf16(qo1[2], qo1[3]); *(LAS u32x2*)(QP + i * RS + f) = w;
        w.x = pg8::cvt_pk_bf16(qo2[0], qo2[1]); w.y = pg8::cvt_pk_bf16(qo2[2], qo2[3]); *(LAS u32x2*)(QP + i * RS + 64 + f) = w;
        if (WITH_K) {
            const float ka[4] = {lo_bf(k1.x), hi_bf(k1.x), lo_bf(k1.y), hi_bf(k1.y)}, kb[4] = {lo_bf(k2.x), hi_bf(k2.x), lo_bf(k2.y), hi_bf(k2.y)};
            float ko1[4], ko2[4];
#pragma unroll
            for (int x = 0; x < 4; ++x) { ko1[x] = (ka[x] * c4[x] - kb[x] * s4[x]) * 0.08838834764831845f; ko2[x] = (ka[x] * s4[x] + kb[x] * c4[x]) * 0.08838834764831845f; }
            w.x = pg8::cvt_pk_bf16(ko1[0], ko1[1]); w.y = pg8::cvt_pk_bf16(ko1[2], ko1[3]); *(LAS u32x2*)(KB + i * RS + f) = w;
            w.x = pg8::cvt_pk_bf16(ko2[0], ko2[1]); w.y = pg8::cvt_pk_bf16(ko2[2], ko2[3]); *(LAS u32x2*)(KB + i * RS + 64 + f) = w;
            kth[it][0] = pg8::cvt_pk_bf16(ko1[0] * kd, ko1[1] * kd); kth[it][1] = pg8::cvt_pk_bf16(ko1[2] * kd, ko1[3] * kd);
            kth[it][2] = pg8::cvt_pk_bf16(ko2[0] * kd, ko2[1] * kd); kth[it][3] = pg8::cvt_pk_bf16(ko2[2] * kd, ko2[3] * kd); kd *= g32; }
        if (it & 1) __builtin_amdgcn_sched_barrier(0); }
}

__device__ __forceinline__ void ret_unit_a(PR P, LAS unsigned char* lds, const int bh, const int n, const int wv) {
    LAS bf16_t* QP = (LAS bf16_t*)lds; LAS bf16_t* KB = QP + BUFE; LAS bf16_t* VT = KB + BUFE;
    const int tid = fresh_tid(wv), lane = tid & 63, wid = tid >> 6, wr = wid >> 1, wc = wid & 1, fr = lane & 15, fq = lane >> 4;
    const int b = bh >> 2, h = bh & 3;
    const bf16_t* PS = (const bf16_t*)(P.ws + WS_BIG); bf16_t* Y = (bf16_t*)(P.ws + WS_XN); bf16_t* KVB = kvb_ptr(P.ws, bh) + (size_t)n * 16384;
    const float lg2 = log2f(1.0f - exp2f(-5.0f - (float)h));
    const float kd0 = exp2f(lg2 * (float)(127 - (tid >> 4))), g32 = exp2f(-32.0f * lg2);
    const int row0 = b * 2048 + n * 128;
    unsigned kth[4][4];
    ret_load_qk<true>(P, QP, KB, kth, tid, row0, n, h, kd0, g32);
#pragma unroll
    for (int it = 0; it < 4; ++it) { const int idx = it * 512 + tid, j = idx >> 4, e = (idx & 15) * 8;
        const u32x4 vv = *(const u32x4*)(PS + (size_t)(row0 + j) * NCOLS + 1792 + 1024 + h * 128 + e);
        LAS bf16_t* d = VT + e * RS + j;
        d[0] = (bf16_t)(vv.x & 0xffffu); d[RS] = (bf16_t)(vv.x >> 16); d[2 * RS] = (bf16_t)(vv.y & 0xffffu); d[3 * RS] = (bf16_t)(vv.y >> 16);
        d[4 * RS] = (bf16_t)(vv.z & 0xffffu); d[5 * RS] = (bf16_t)(vv.z >> 16); d[6 * RS] = (bf16_t)(vv.w & 0xffffu); d[7 * RS] = (bf16_t)(vv.w >> 16); }
    __syncthreads();
    f32x4 accP[2][4];
#pragma unroll
    for (int mt = 0; mt < 2; ++mt)
#pragma unroll
        for (int nt = 0; nt < 4; ++nt) accP[mt][nt] = (f32x4){0.f, 0.f, 0.f, 0.f};
#pragma unroll
    for (int ks = 0; ks < 4; ++ks) { bf16x8 aq[2];
#pragma unroll
        for (int mt = 0; mt < 2; ++mt) aq[mt] = *(const LAS bf16x8*)(QP + (wr * 32 + mt * 16 + fr) * RS + ks * 32 + fq * 8);
#pragma unroll
        for (int nt = 0; nt < 4; ++nt) { const bf16x8 bk = *(const LAS bf16x8*)(KB + (wc * 64 + nt * 16 + fr) * RS + ks * 32 + fq * 8);
#pragma unroll
            for (int mt = 0; mt < 2; ++mt) accP[mt][nt] = __builtin_amdgcn_mfma_f32_16x16x32_bf16(aq[mt], bk, accP[mt][nt], 0, 0, 0); }
        __builtin_amdgcn_sched_barrier(0); }
    __syncthreads();
    { float ri[2][4], cj[4];
#pragma unroll
      for (int mt = 0; mt < 2; ++mt)
#pragma unroll
          for (int j = 0; j < 4; ++j) ri[mt][j] = exp2f(lg2 * (float)(wr * 32 + mt * 16 + fq * 4 + j));
#pragma unroll
      for (int nt = 0; nt < 4; ++nt) cj[nt] = exp2f(-lg2 * (float)(wc * 64 + nt * 16 + fr));
#pragma unroll
      for (int mt = 0; mt < 2; ++mt)
#pragma unroll
          for (int nt = 0; nt < 4; ++nt)
#pragma unroll
              for (int j = 0; j < 4; ++j) { const int i = wr * 32 + mt * 16 + fq * 4 + j, jj = wc * 64 + nt * 16 + fr;
                  const float val = i >= jj ? accP[mt][nt][j] * ri[mt][j] * cj[nt] : 0.f; QP[i * RS + jj] = f2bf(val); } }
#pragma unroll
    for (int it = 0; it < 4; ++it) { const int idx = it * 512 + tid, j = idx >> 4, f = (idx & 15) * 4; LAS bf16_t* d = KB + f * RS + j;
        d[0] = (bf16_t)(kth[it][0] & 0xffffu); d[RS] = (bf16_t)(kth[it][0] >> 16); d[2 * RS] = (bf16_t)(kth[it][1] & 0xffffu); d[3 * RS] = (bf16_t)(kth[it][1] >> 16);
        LAS bf16_t* d2 = d + 64 * RS;
        d2[0] = (bf16_t)(kth[it][2] & 0xffffu); d2[RS] = (bf16_t)(kth[it][2] >> 16); d2[2 * RS] = (bf16_t)(kth[it][3] & 0xffffu); d2[3 * RS] = (bf16_t)(kth[it][3] >> 16); }
    __syncthreads();
    f32x4 accY[2][4], accS[2][4];
#pragma unroll
    for (int mt = 0; mt < 2; ++mt)
#pragma unroll
        for (int nt = 0; nt < 4; ++nt) { accY[mt][nt] = (f32x4){0.f, 0.f, 0.f, 0.f}; accS[mt][nt] = (f32x4){0.f, 0.f, 0.f, 0.f}; }
#pragma unroll
    for (int ks = 0; ks < 4; ++ks) { bf16x8 ap[2], av[2];
#pragma unroll
        for (int mt = 0; mt < 2; ++mt) { ap[mt] = *(const LAS bf16x8*)(QP + (wr * 32 + mt * 16 + fr) * RS + ks * 32 + fq * 8); av[mt] = *(const LAS bf16x8*)(VT + (wr * 32 + mt * 16 + fr) * RS + ks * 32 + fq * 8); }
#pragma unroll
        for (int nt = 0; nt < 4; ++nt) { const bf16x8 bv = *(const LAS bf16x8*)(VT + (wc * 64 + nt * 16 + fr) * RS + ks * 32 + fq * 8), bkt = *(const LAS bf16x8*)(KB + (wc * 64 + nt * 16 + fr) * RS + ks * 32 + fq * 8);
#pragma unroll
            for (int mt = 0; mt < 2; ++mt) { accY[mt][nt] = __builtin_amdgcn_mfma_f32_16x16x32_bf16(ap[mt], bv, accY[mt][nt], 0, 0, 0); accS[mt][nt] = __builtin_amdgcn_mfma_f32_16x16x32_bf16(av[mt], bkt, accS[mt][nt], 0, 0, 0); } }
        __builtin_amdgcn_sched_barrier(0); }
#pragma unroll
    for (int mt = 0; mt < 2; ++mt)
#pragma unroll
        for (int nt = 0; nt < 4; ++nt)
#pragma unroll
            for (int j = 0; j < 4; ++j) { const int r = wr * 32 + mt * 16 + fq * 4 + j, c = wc * 64 + nt * 16 + fr;
                Y[(size_t)(row0 + r) * 1024 + 512 + h * 128 + c] = f2bf(accY[mt][nt][j]); KVB[r * 128 + c] = f2bf(accS[mt][nt][j]); }
    __syncthreads();
}

__device__ __forceinline__ void ret_prefix(PR P, const int item) {
    const int bh = item >> 11, i8 = (item & 2047) * 8; const int h = bh & 3;
    bf16_t* KVB = kvb_ptr(P.ws, bh) + i8;
    const float lg2 = log2f(1.0f - exp2f(-5.0f - (float)h)); const float c_dec = exp2f(lg2 * 128.0f);
    u32x4 kv[16];
#pragma unroll
    for (int n = 0; n < 16; ++n) kv[n] = *(const u32x4*)(KVB + (size_t)n * 16384);
    float S[8];
#pragma unroll
    for (int x = 0; x < 8; ++x) S[x] = 0.f;
#pragma unroll
    for (int n = 0; n < 16; ++n) { u32x4 w; w.x = pg8::cvt_pk_bf16(S[0], S[1]); w.y = pg8::cvt_pk_bf16(S[2], S[3]); w.z = pg8::cvt_pk_bf16(S[4], S[5]); w.w = pg8::cvt_pk_bf16(S[6], S[7]);
        *(u32x4*)(KVB + (size_t)n * 16384) = w;
        const float k8[8] = {lo_bf(kv[n].x), hi_bf(kv[n].x), lo_bf(kv[n].y), hi_bf(kv[n].y), lo_bf(kv[n].z), hi_bf(kv[n].z), lo_bf(kv[n].w), hi_bf(kv[n].w)};
#pragma unroll
        for (int x = 0; x < 8; ++x) S[x] = S[x] * c_dec + k8[x]; }
    const int e = i8 >> 7, d0 = i8 & 127;
#pragma unroll
    for (int x = 0; x < 8; ++x) P.out[O_RTP + ((size_t)bh * 128 + d0 + x) * 128 + e] = S[x];
}

__device__ __forceinline__ void ret_unit_c(PR P, LAS unsigned char* lds, const int bh, const int n, const int wv) {
    LAS bf16_t* QP = (LAS bf16_t*)lds; LAS bf16_t* ST = QP + 3 * BUFE; LAS float* YST = (LAS float*)(QP + BUFE);
    const int tid = fresh_tid(wv), lane = tid & 63, wid = tid >> 6, wr = wid >> 1, wc = wid & 1, fr = lane & 15, fq = lane >> 4;
    const int b = bh >> 2, h = bh & 3;
    const bf16_t* PS = (const bf16_t*)(P.ws + WS_BIG); bf16_t* Y = (bf16_t*)(P.ws + WS_XN); const bf16_t* KVB = kvb_ptr(P.ws, bh) + (size_t)n * 16384;
    const float lg2 = log2f(1.0f - exp2f(-5.0f - (float)h));
    const int row0 = b * 2048 + n * 128;
    unsigned kth[4][4];
    ret_load_qk<false>(P, QP, QP, kth, tid, row0, n, h, 0.f, 0.f);
#pragma unroll
    for (int it = 0; it < 4; ++it) { const int idx = it * 512 + tid, e = idx >> 4, d8 = (idx & 15) * 8;
        *(LAS u32x4*)(ST + e * RS + d8) = *(const u32x4*)(KVB + e * 128 + d8); }
    __syncthreads();
    f32x4 accY[2][4];
#pragma unroll
    for (int mt = 0; mt < 2; ++mt)
#pragma unroll
        for (int nt = 0; nt < 4; ++nt) accY[mt][nt] = (f32x4){0.f, 0.f, 0.f, 0.f};
#pragma unroll
    for (int ks = 0; ks < 4; ++ks) { bf16x8 aq[2];
#pragma unroll
        for (int mt = 0; mt < 2; ++mt) aq[mt] = *(const LAS bf16x8*)(QP + (wr * 32 + mt * 16 + fr) * RS + ks * 32 + fq * 8);
#pragma unroll
        for (int nt = 0; nt < 4; ++nt) { const bf16x8 bs = *(const LAS bf16x8*)(ST + (wc * 64 + nt * 16 + fr) * RS + ks * 32 + fq * 8);
#pragma unroll
            for (int mt = 0; mt < 2; ++mt) accY[mt][nt] = __builtin_amdgcn_mfma_f32_16x16x32_bf16(aq[mt], bs, accY[mt][nt], 0, 0, 0); }
        __builtin_amdgcn_sched_barrier(0); }
#pragma unroll
    for (int mt = 0; mt < 2; ++mt)
#pragma unroll
        for (int j = 0; j < 4; ++j) { const int r = wr * 32 + mt * 16 + fq * 4 + j; const float qd = exp2f(lg2 * (float)(r + 1));
#pragma unroll
            for (int nt = 0; nt < 4; ++nt) YST[r * 132 + wc * 64 + nt * 16 + fr] = accY[mt][nt][j] * qd; }
    __syncthreads();
    { const int i = tid >> 2, part = tid & 3; float yv[32]; float s = 0.f;
      bf16_t* yo = Y + (size_t)(row0 + i) * 1024 + 512 + h * 128 + part * 32;
#pragma unroll
      for (int x = 0; x < 4; ++x) { const u32x4 y1 = *(const u32x4*)(yo + x * 8); const f32x4 ta = *(const LAS f32x4*)(YST + i * 132 + part * 32 + x * 8), tb = *(const LAS f32x4*)(YST + i * 132 + part * 32 + x * 8 + 4);
          yv[x * 8 + 0] = ta[0] + lo_bf(y1.x); yv[x * 8 + 1] = ta[1] + hi_bf(y1.x); yv[x * 8 + 2] = ta[2] + lo_bf(y1.y); yv[x * 8 + 3] = ta[3] + hi_bf(y1.y);
          yv[x * 8 + 4] = tb[0] + lo_bf(y1.z); yv[x * 8 + 5] = tb[1] + hi_bf(y1.z); yv[x * 8 + 6] = tb[2] + lo_bf(y1.w); yv[x * 8 + 7] = tb[3] + hi_bf(y1.w); }
#pragma unroll
      for (int x = 0; x < 32; ++x) s += yv[x];
      s = quad_sum(s); const float mean = s * (1.0f / 128.0f); float s2 = 0.f;
#pragma unroll
      for (int x = 0; x < 32; ++x) { yv[x] -= mean; s2 += yv[x] * yv[x]; }
      s2 = quad_sum(s2); const float rstd = rsqrtf(s2 * (1.0f / 128.0f) + 1e-5f);
      const bf16_t* gp = PS + (size_t)(row0 + i) * NCOLS + 1792 + 1536 + h * 128 + part * 32; const float* gw = P.gn_w + h * 128 + part * 32;
#pragma unroll
      for (int x = 0; x < 4; ++x) { const u32x4 g4 = *(const u32x4*)(gp + x * 8); const float4 w0 = *(const float4*)(gw + x * 8), w1 = *(const float4*)(gw + x * 8 + 4);
          const float gg[8] = {lo_bf(g4.x), hi_bf(g4.x), lo_bf(g4.y), hi_bf(g4.y), lo_bf(g4.z), hi_bf(g4.z), lo_bf(g4.w), hi_bf(g4.w)}; const float ww[8] = {w0.x, w0.y, w0.z, w0.w, w1.x, w1.y, w1.z, w1.w};
          float o[8];
#pragma unroll
          for (int z = 0; z < 8; ++z) o[z] = yv[x * 8 + z] * rstd * ww[z] * (gg[z] / (1.0f + __expf(-gg[z])));
          u32x4 w; w.x = pg8::cvt_pk_bf16(o[0], o[1]); w.y = pg8::cvt_pk_bf16(o[2], o[3]); w.z = pg8::cvt_pk_bf16(o[4], o[5]); w.w = pg8::cvt_pk_bf16(o[6], o[7]);
          *(u32x4*)(yo + x * 8) = w; } }
    __syncthreads();
}

__device__ __forceinline__ void sub_barrier(unsigned* cnt, const unsigned target, const int wv) {
    asm volatile("s_waitcnt vmcnt(0)" ::: "memory");
    __syncthreads();
    if (fresh_tid(wv) == 0) {
        __builtin_amdgcn_fence(__ATOMIC_RELEASE, "agent");
        asm volatile("s_waitcnt vmcnt(0)" ::: "memory");
        (void)xb_add(cnt, 1u);
        unsigned sp = 0u;
        while (xb_ld(cnt) < target) { __builtin_amdgcn_s_sleep(2); if (++sp > (1u << 20)) break; }
        __builtin_amdgcn_fence(__ATOMIC_ACQUIRE, "agent");
        asm volatile("s_waitcnt vmcnt(0)" ::: "memory");
    }
    __syncthreads();
}

__device__ __forceinline__ void rwkv_post(PR P, const int wv) {
    const int tid = fresh_tid(wv); const int lane = tid & 63; const int gw = blockIdx.x * 8 + (tid >> 6), nw = gridDim.x * 8;
    const int sub = lane >> 4, cg4 = (lane & 15) * 4;
    const bf16_t* PS = (const bf16_t*)(P.ws + WS_BIG); const bf16_t* ASIG = (const bf16_t*)(P.ws + WS_ASIG); const bf16_t* YS = (const bf16_t*)(P.ws + WS_YS);
    const bf16_t* G = (const bf16_t*)(P.ws + WS_WIN); bf16_t* Y = (bf16_t*)(P.ws + WS_XN);
    for (int task = gw; task < MT * 2; task += nw) {
        const int item = task * 4 + sub, row = item >> 3, h = item & 7, ch = h * 64 + cg4;
        const u32x2 yr = *(const u32x2*)(YS + (size_t)row * 512 + ch);
        const bf16_t* cp = PS + (size_t)row * NCOLS + ch; const int pr = prev_row(row);
        const u32x2 c_r = *(const u32x2*)cp, c_k = *(const u32x2*)(cp + 512), c_v = *(const u32x2*)(cp + 1024);
        u32x2 p_r = (u32x2){0u, 0u}, p_k = p_r, p_v = p_r;
        if (pr >= 0) { const bf16_t* pp = PS + (size_t)pr * NCOLS + ch; p_r = *(const u32x2*)pp; p_k = *(const u32x2*)(pp + 512); p_v = *(const u32x2*)(pp + 1024); }
        const u32x2 ar = *(const u32x2*)(ASIG + (size_t)row * 512 + ch), gr = *(const u32x2*)(G + (size_t)row * 512 + ch);
        const float4 mr = *(const float4*)(P.mu + ch), mk = *(const float4*)(P.mu + 512 + ch), mv = *(const float4*)(P.mu + 1024 + ch);
        const float4 ka = *(const float4*)(P.k_a + ch), rk = *(const float4*)(P.r_k + ch), lw = *(const float4*)(P.lnx_w + ch), lb = *(const float4*)(P.lnx_b + ch);
        const float ys[4] = {lo_bf(yr.x), hi_bf(yr.x), lo_bf(yr.y), hi_bf(yr.y)};
        const float mean = row16_sum(ys[0] + ys[1] + ys[2] + ys[3]) * (1.0f / 64.0f);
        float dl[4], s2 = 0.f;
#pragma unroll
        for (int j = 0; j < 4; ++j) { dl[j] = ys[j] - mean; s2 += dl[j] * dl[j]; }
        const float rstd = rsqrtf(row16_sum(s2) * (1.0f / 64.0f) + 64e-5f);
        const float cr[4] = {lo_bf(c_r.x), hi_bf(c_r.x), lo_bf(c_r.y), hi_bf(c_r.y)}, ck[4] = {lo_bf(c_k.x), hi_bf(c_k.x), lo_bf(c_k.y), hi_bf(c_k.y)}, cv[4] = {lo_bf(c_v.x), hi_bf(c_v.x), lo_bf(c_v.y), hi_bf(c_v.y)};
        const float qr[4] = {lo_bf(p_r.x), hi_bf(p_r.x), lo_bf(p_r.y), hi_bf(p_r.y)}, qk[4] = {lo_bf(p_k.x), hi_bf(p_k.x), lo_bf(p_k.y), hi_bf(p_k.y)}, qv[4] = {lo_bf(p_v.x), hi_bf(p_v.x), lo_bf(p_v.y), hi_bf(p_v.y)};
        const float aa[4] = {lo_bf(ar.x), hi_bf(ar.x), lo_bf(ar.y), hi_bf(ar.y)}, gg[4] = {lo_bf(gr.x), hi_bf(gr.x), lo_bf(gr.y), hi_bf(gr.y)};
        const float m_r[4] = {mr.x, mr.y, mr.z, mr.w}, m_k[4] = {mk.x, mk.y, mk.z, mk.w}, m_v[4] = {mv.x, mv.y, mv.z, mv.w};
        const float kaa[4] = {ka.x, ka.y, ka.z, ka.w}, rkk[4] = {rk.x, rk.y, rk.z, rk.w}, lww[4] = {lw.x, lw.y, lw.z, lw.w}, lbb[4] = {lb.x, lb.y, lb.z, lb.w};
        float v[4], bp = 0.f;
#pragma unroll
        for (int j = 0; j < 4; ++j) { const float r = cr[j] + (qr[j] - cr[j]) * m_r[j], k = ck[j] + (qk[j] - ck[j]) * m_k[j]; v[j] = cv[j] + (qv[j] - cv[j]) * m_v[j];
            const float kn = k * (1.0f + (aa[j] - 1.0f) * kaa[j]); bp += r * kn * rkk[j]; }
        const float bonus = row16_sum(bp);
        float o[4];
#pragma unroll
        for (int j = 0; j < 4; ++j) o[j] = (dl[j] * rstd * lww[j] + lbb[j] + bonus * v[j]) * gg[j];
        u32x2 w; w.x = pg8::cvt_pk_bf16(o[0], o[1]); w.y = pg8::cvt_pk_bf16(o[2], o[3]);
        *(u32x2*)(Y + (size_t)row * 1024 + ch) = w;
    }
}

__global__ void __launch_bounds__(512, 2) hymba_mega(Params P_unused) {
    extern __shared__ __attribute__((aligned(16))) unsigned char shm[];
    cg::grid_group grid = cg::this_grid();
    LAS unsigned char* lds = (LAS unsigned char*)shm; LAS float* ldsf = (LAS float*)shm;
    const int G = gridDim.x, bx = blockIdx.x;
    const int wv = __builtin_amdgcn_readfirstlane(threadIdx.x >> 6);
    const CAS Params* kp = (const CAS Params*)__builtin_amdgcn_kernarg_segment_ptr();
#define P (*kp)
#define FRESH() asm volatile("" : "+s"(kp))
#ifndef REP_SYNC
#define REP_SYNC 1
#endif
#ifndef REP_P7
#define REP_P7 1
#endif
#ifndef REP_FFN1
#define REP_FFN1 1
#endif
#ifndef REP_RW
#define REP_RW 1
#endif
#ifndef REP_OTH
#define REP_OTH 1
#endif
#ifndef REP_RETP
#define REP_RETP 1
#endif
#ifndef REP_SAMP
#define REP_SAMP 1
#endif
#ifndef REP_P8
#define REP_P8 1
#endif
#define GSYNC() do { for (int r_ = 0; r_ < REP_SYNC; ++r_) xcd_barrier((unsigned*)ws, (volatile LAS unsigned*)(lds + LDS_BYTES - 16), wv); FRESH(); } while (0)
#define ws (kp->ws)
#define XN ((bf16_t*)(ws + WS_XN))
#define ACT ((bf16_t*)(ws + WS_BIG))
#define FO ((float*)(ws + WS_FO))
#define PS ((bf16_t*)(ws + WS_BIG))
    pg8::StaticOrder S;
    { unsigned* barw = (unsigned*)ws; const int t0 = fresh_tid(wv); if (bx == 0) for (int i = t0; i < XCD_BAR_WORDS + 128; i += 512) barw[i] = 0u;
      if (t0 < 4) ((LAS unsigned*)(lds + LDS_BYTES - 16))[t0] = 0u; }
#ifndef PHM
#define PHM 0xFFFF
#endif
#define PH(k) if ((PHM >> (k)) & 1)
    PH(0) p0_prologue(P, ldsf, wv);
    grid.sync(); FRESH();
    if (fresh_tid(wv) == 0) (void)xb_add(&((unsigned*)ws)[XB_XCNT(xb_xcc_id())], 1u);
    for (int rep1 = 0; rep1 < REP_FFN1; ++rep1) {
    PH(1) { pg8::Gemm g{XN, (const bf16_t*)(ws + WS_WGU), MT, NGU, 1024}; S.init(MT, NGU, G, bx); pg8::EpiSwiGLU E{ACT, DFF}; pg8::gemm_phase(lds, g, S, E, wv); }
    GSYNC();
    PH(2) { pg8::Gemm g{ACT, (const bf16_t*)(ws + WS_WD), MT, 1024, DFF}; S.init(MT, 1024, G, bx); pg8::EpiF32 E{FO, 1024}; pg8::gemm_phase(lds, g, S, E, wv); }
    GSYNC();
    }
    PH(3) rows_phase(P, 1, wv);
    GSYNC();
    PH(4) { pg8::Gemm g{XN, (const bf16_t*)(ws + WS_WIN), MIN_, NCOLS, 1024}; S.init(MIN_, NCOLS, G, bx); pg8::EpiBf16 E{PS, NCOLS}; pg8::gemm_phase(lds, g, S, E, wv); }
    GSYNC();
    PH(5) lora_prep(P, wv);
    GSYNC();
    PH(6) { pg8::Gemm g{(const bf16_t*)(ws + WS_LA), (const bf16_t*)(ws + WS_WL), MT, 1536, 256}; S.init(MT, 1536, G, bx);
      pg8::EpiLora E{(bf16_t*)(ws + WS_OMD), (bf16_t*)(ws + WS_ASIG), (bf16_t*)(ws + WS_WIN), P.w0, P.a0}; pg8::gemm_phase(lds, g, S, E, wv); }
    GSYNC();
    {
    if (bx < 128) { for (int rw = 0; rw < REP_RW; ++rw) rwkv_unit<false>(P, ldsf, bx >> 4, (bx >> 1) & 7, bx & 1, wv); }
    else for (int rep7 = 0; rep7 < REP_OTH; ++rep7) { const int ob = bx - 128; unsigned* sbc = (unsigned*)ws + XCD_BAR_WORDS + 64;
        for (int k = 0; k < 4; ++k) { const int u = ob + k * 128; ret_unit_a(P, lds, u >> 4, u & 15, wv); }
        sub_barrier(sbc, 128u * (2u * rep7 + 1u), wv);
        ret_prefix(P, ob * 512 + fresh_tid(wv));
        sub_barrier(sbc, 128u * (2u * rep7 + 2u), wv);
        for (int k = 0; k < 4; ++k) { const int u = ob + k * 128; ret_unit_c(P, lds, u >> 4, u & 15, wv); }
        for (int u = ob; u < 2560; u += 128) { if (u < 2048) rwkv_unit<true>(P, ldsf, u >> 4, (u >> 1) & 7, u & 1, wv); else ret_sample_unit(P, ldsf, (u - 2048) >> 2, (u - 2048) & 3, wv); }
    }
    }
    GSYNC();
    for (int rep8 = 0; rep8 < REP_P8; ++rep8) PH(8) rwkv_post(P, wv);
    GSYNC();
    PH(9) { pg8::Gemm g{XN, (const bf16_t*)(ws + WS_WOUT), MT, 1024, 1024}; S.init(MT, 1024, G, bx); pg8::EpiF32 E{FO, 1024}; pg8::gemm_phase(lds, g, S, E, wv); }
    GSYNC();
    PH(10) { ffn_weights(P.f2g, P.f2u, P.f2d, ws, ldsf, wv);
    rows_phase(P, 2, wv); }
    GSYNC();
    PH(11) { pg8::Gemm g{XN, (const bf16_t*)(ws + WS_WGU), MT, NGU, 1024}; S.init(MT, NGU, G, bx); pg8::EpiSwiGLU E{ACT, DFF}; pg8::gemm_phase(lds, g, S, E, wv); }
    GSYNC();
    PH(12) { pg8::Gemm g{ACT, (const bf16_t*)(ws + WS_WD), MT, 1024, DFF}; S.init(MT, 1024, G, bx); pg8::EpiF32 E{FO, 1024}; pg8::gemm_phase(lds, g, S, E, wv); }
    GSYNC();
    PH(13) rows_phase(P, 3, wv);
}

#undef ws
#undef XN
#undef ACT
#undef FO
#undef PS
#undef P
extern "C" void kernel_launch(void* const* d_in, const int* in_sizes, int n_in, void* d_out, int out_size, void* d_ws, size_t ws_size, hipStream_t stream) {
    static int grid = 0;
    if (grid == 0) {
        if (n_in != 26 || ws_size < WS_END) { fprintf(stderr, "kernel_launch: unexpected n_in %d or ws_size %zu (< %zu)\n", n_in, ws_size, (size_t)WS_END); grid = -1; return; }
        int dev = 0, cus = 0, per_cu = 0;
        hipGetDevice(&dev); hipDeviceGetAttribute(&cus, hipDeviceAttributeMultiprocessorCount, dev);
        hipFuncSetAttribute((const void*)hymba_mega, hipFuncAttributeMaxDynamicSharedMemorySize, LDS_BYTES);
        hipOccupancyMaxActiveBlocksPerMultiprocessor(&per_cu, (const void*)hymba_mega, 512, LDS_BYTES);
        if (per_cu < 1) { fprintf(stderr, "kernel_launch: occupancy query says %d blocks/CU\n", per_cu); per_cu = 1; }
        grid = cus * per_cu; if (grid > 256) grid = 256;
        if (grid != 256) { fprintf(stderr, "kernel_launch: this kernel needs 256 co-resident workgroups, got %d\n", grid); grid = -1; return; }
        fprintf(stderr, "kernel_launch: cus %d per_cu %d grid %d ws %zu\n", cus, per_cu, grid, ws_size);
    }
    if (grid < 0) return;
    Params p{};
    const float** pp = (const float**)&p;
    for (int i = 0; i < 26; ++i) pp[i] = (const float*)d_in[i];
    p.out = (float*)d_out; p.ws = (unsigned char*)d_ws;
    void* args[] = {&p};
    hipError_t e = hipLaunchCooperativeKernel((const void*)hymba_mega, dim3(grid), dim3(512), args, LDS_BYTES, stream);
    if (e != hipSuccess) fprintf(stderr, "cooperative launch failed: %s (grid %d)\n", hipGetErrorString(e), grid);
}
```

```cpp
#include <hip/hip_runtime.h>
#include <hip/hip_cooperative_groups.h>
#include <cstdio>
#include <cstdint>
namespace cg = cooperative_groups;

__device__ __forceinline__ int fresh_tid(int wv) { int l; asm volatile("v_mbcnt_lo_u32_b32 %0, -1, 0\n\tv_mbcnt_hi_u32_b32 %0, -1, %0" : "=v"(l)); return wv * 64 + l; }
namespace pg8 {
#define PG8_LAS __attribute__((address_space(3)))
typedef unsigned short bf16_t;
typedef short bf16x8 __attribute__((ext_vector_type(8)));
typedef float f32x4 __attribute__((ext_vector_type(4)));
typedef unsigned u32x4 __attribute__((ext_vector_type(4)));
typedef unsigned u32x2 __attribute__((ext_vector_type(2)));
constexpr int BM = 256, BK = 64, HALF = 128, HTB = HALF * BK * 2, STAGE_BYTES = 8 * HTB, NXCD = 8, WGM = 8;

__host__ __device__ __forceinline__ int lds_byte(int r, int c) { const int st = (r >> 4) * 2 + (c >> 5), rr = r & 15, cc = c & 31, ob = rr * 64 + cc * 2; return st * 1024 + (ob ^ (((ob >> 9) & 1) << 5)); }
__host__ __device__ __forceinline__ void stage_rc(int b, int& R, int& C) { const int st = b / 1024, sb = b % 1024, swz = sb ^ (((sb >> 9) & 1) << 5); R = (st >> 1) * 16 + swz / 64; C = (st & 1) * 32 + (swz % 64) / 2; }
__host__ __device__ __forceinline__ int perm32(int rho) { const int n = rho >> 4, i = rho & 15; return 8 * (i >> 2) + 4 * n + (i & 3); }

struct Unit { int pm, pn, k0, nkt, atomic; };
struct Gemm { const bf16_t* A; const bf16_t* Bt; int M, N, K; };

struct StaticOrder {
    int nM, nN, nwg, G, c, nt;
    __host__ __device__ void init(int M, int N, int G_, int c_, int K) { nM = M / BM; nN = N / BM; nwg = nM * nN; G = G_; c = c_; nt = K / BK; }
    __host__ __device__ bool next(int i, Unit& u) const {
        const long L = (long)i * G + c; if (L >= nwg) return false;
        int wgid = (int)L; { const int q = nwg / NXCD, r = nwg % NXCD, xcd = wgid % NXCD, off = wgid / NXCD; wgid = (xcd < r ? xcd * (q + 1) : r * (q + 1) + (xcd - r) * q) + off; }
        const int nig = WGM * nN, gid = wgid / nig, fm = gid * WGM, gsz = (nM - fm) < WGM ? (nM - fm) : WGM;
        u.pm = fm + ((wgid % nig) % gsz); u.pn = (wgid % nig) / gsz; u.k0 = 0; u.nkt = nt; u.atomic = 0; return true;
    }
    __device__ __forceinline__ void a_ready(const Unit&) const {}
    __device__ __forceinline__ void done(const Unit&) const {}
};
struct SplitOrder : StaticOrder {
    int KS;
    __host__ __device__ void init2(int G_, int c_, int K, int KS_) { init(16384, 1024, G_, c_, K); KS = KS_; }
    __host__ __device__ bool next(int i, Unit& u) const {
        if (i == 0) return StaticOrder::next(0, u);
        if (i > 1 || c >= 8 * KS) return false;
        const int tile = c / KS, part = c % KS, pairs = nt / 2, q = pairs / KS, r = pairs % KS;
        u.pm = 64 + (tile >> 2); u.pn = tile & 3; u.k0 = 2 * (part * q + (part < r ? part : r)); u.nkt = 2 * (q + (part < r ? 1 : 0)); u.atomic = 1 + c; return true;
    }
};

__device__ __forceinline__ unsigned cvt_pk_bf16(float lo, float hi) { unsigned r; asm volatile("v_cvt_pk_bf16_f32 %0, %1, %2" : "=v"(r) : "v"(lo), "v"(hi)); return r; }

struct EpiF32 {
    static constexpr bool PERM = false;
    float* C; int ldc; float* slab;
    __device__ __forceinline__ void operator()(const f32x4 (&acc)[2][2][4][2], const Unit& u, int wr, int wc, int fr, int fq) const {
        const bool sp = u.atomic != 0;
        const int row0 = (sp ? 0 : u.pm * BM) + wr * 64 + fr, col0 = (sp ? 0 : u.pn * BM) + wc * 32 + 4 * fq; const int ld = sp ? BM : ldc;
        float* base = sp ? slab + (size_t)(u.atomic - 1) * (BM * BM) : C;
#pragma unroll
        for (int ai = 0; ai < 2; ++ai)
#pragma unroll
            for (int m = 0; m < 4; ++m) { float* rowp = base + (size_t)(row0 + ai * HALF + m * 16) * ld + col0;
#pragma unroll
                for (int bj = 0; bj < 2; ++bj)
#pragma unroll
                    for (int n = 0; n < 2; ++n) *(f32x4*)(rowp + bj * HALF + n * 16) = acc[ai][bj][m][n]; }
    }
};
struct EpiBf16 {
    static constexpr bool PERM = true;
    bf16_t* O; int ldc;
    __device__ __forceinline__ void operator()(const f32x4 (&acc)[2][2][4][2], const Unit& u, int wr, int wc, int fr, int fq) const {
        const int row0 = u.pm * BM + wr * 64 + fr; const int col0 = u.pn * BM + wc * 32 + 8 * fq;
#pragma unroll
        for (int ai = 0; ai < 2; ++ai)
#pragma unroll
            for (int m = 0; m < 4; ++m) { bf16_t* rowp = O + (size_t)(row0 + ai * HALF + m * 16) * ldc + col0;
#pragma unroll
                for (int bj = 0; bj < 2; ++bj) { const f32x4 v0 = acc[ai][bj][m][0], v1 = acc[ai][bj][m][1];
                    u32x4 w; w.x = cvt_pk_bf16(v0[0], v0[1]); w.y = cvt_pk_bf16(v0[2], v0[3]); w.z = cvt_pk_bf16(v1[0], v1[1]); w.w = cvt_pk_bf16(v1[2], v1[3]);
                    *(u32x4*)(rowp + bj * HALF) = w; } }
    }
};
__device__ __forceinline__ float silu_f(float x) { return x / (1.0f + __expf(-x)); }
struct EpiSwiGLU {
    static constexpr bool PERM = true;
    bf16_t* O; int ldc;
    __device__ __forceinline__ void operator()(const f32x4 (&acc)[2][2][4][2], const Unit& u, int wr, int wc, int fr, int fq) const {
        const int row0 = u.pm * BM + wr * 64 + fr; const int col0 = u.pn * HALF + wc * 32 + 8 * fq;
#pragma unroll
        for (int ai = 0; ai < 2; ++ai)
#pragma unroll
            for (int m = 0; m < 4; ++m) { bf16_t* rowp = O + (size_t)(row0 + ai * HALF + m * 16) * ldc + col0;
                float o[8];
#pragma unroll
                for (int n = 0; n < 2; ++n)
#pragma unroll
                    for (int j = 0; j < 4; ++j) o[n * 4 + j] = silu_f(acc[ai][0][m][n][j]) * acc[ai][1][m][n][j];
                u32x4 w; w.x = cvt_pk_bf16(o[0], o[1]); w.y = cvt_pk_bf16(o[2], o[3]); w.z = cvt_pk_bf16(o[4], o[5]); w.w = cvt_pk_bf16(o[6], o[7]);
                *(u32x4*)rowp = w; }
    }
};
struct EpiLora {
    static constexpr bool PERM = true;
    bf16_t* OMD; bf16_t* ASIG; bf16_t* G; const float* w0; const float* a0;
    template <int KIND> __device__ __forceinline__ void body(const f32x4 (&acc)[2][2][4][2], bf16_t* O, const float* bias, int row0, int ch0) const {
#pragma unroll
        for (int bj = 0; bj < 2; ++bj)
#pragma unroll
            for (int ai = 0; ai < 2; ++ai)
#pragma unroll
                for (int m = 0; m < 4; ++m) { bf16_t* rowp = O + (size_t)(row0 + ai * HALF + m * 16) * 512 + ch0 + bj * HALF;
                    float o[8];
#pragma unroll
                    for (int n = 0; n < 2; ++n)
#pragma unroll
                        for (int j = 0; j < 4; ++j) { float v = acc[ai][bj][m][n][j];
                            if (KIND == 0) { v += bias[ch0 + bj * HALF + n * 4 + j]; const float nv = -v; const float sp = fmaxf(nv, 0.f) + __logf(1.0f + __expf(-fabsf(nv)));
                                const float e = __expf(-sp - 0.5f);
                                float p = 1.0f / 40320.0f; p = -1.0f / 5040.0f + e * p; p = 1.0f / 720.0f + e * p; p = -1.0f / 120.0f + e * p; p = 1.0f / 24.0f + e * p; p = -1.0f / 6.0f + e * p; p = 0.5f + e * p; p = 1.0f - e * p;
                                v = e * p; }
                            else if (KIND == 1) { v += bias[ch0 + bj * HALF + n * 4 + j]; v = 1.0f / (1.0f + __expf(-v)); }
                            o[n * 4 + j] = v; }
                    u32x4 w; w.x = cvt_pk_bf16(o[0], o[1]); w.y = cvt_pk_bf16(o[2], o[3]); w.z = cvt_pk_bf16(o[4], o[5]); w.w = cvt_pk_bf16(o[6], o[7]);
                    *(u32x4*)rowp = w; __builtin_amdgcn_sched_barrier(0); }
    }
    __device__ __forceinline__ void operator()(const f32x4 (&acc)[2][2][4][2], const Unit& u, int wr, int wc, int fr, int fq) const {
        const int kind = u.pn >> 1;
        const int row0 = u.pm * BM + wr * 64 + fr; const int ch0 = (u.pn & 1) * BM + wc * 32 + 8 * fq;
        if (kind == 0) body<0>(acc, OMD, w0, row0, ch0); else if (kind == 1) body<1>(acc, ASIG, a0, row0, ch0); else body<2>(acc, G, a0, row0, ch0);
    }
};

template <class Epi, class Sched>
__device__ __forceinline__ void gemm_phase(PG8_LAS unsigned char* lds, const Gemm g, const Sched& S, const Epi& E, const int wv) {
    const int tid = fresh_tid(wv), wid = __builtin_amdgcn_readfirstlane(tid >> 6), lane = tid & 63, wr = wid >> 2, wc = wid & 3, fr = lane & 15, fq = lane >> 4;
    const int K = g.K;
    unsigned voffA[2], voffB[2];
#pragma unroll
    for (int i = 0; i < 2; ++i) { int R, C; stage_rc(tid * 16 + i * 8192, R, C); const int Rb = Epi::PERM ? ((R & ~31) + perm32(R & 31)) : R;
        voffA[i] = (unsigned)(R * K + C) * 2u; voffB[i] = (unsigned)(Rb * K + C) * 2u; }
    const size_t kstep = (size_t)(BK * 2);
    const size_t hstep = (size_t)HALF * K * 2;
    const size_t tstep = 2 * hstep;
    const unsigned ldsw = (unsigned)wid * 1024u;
    const int aoff = lds_byte(wr * 64 + fr, fq * 8), boff = lds_byte(wc * 32 + fr, fq * 8);
#define PG8_SA(b, h) (((b) * 2 + (h)) * HTB)
#define PG8_SB(b, h) ((4 + (b) * 2 + (h)) * HTB)
#define PG8_STAGE(bufoff, gbase, voff) do { _Pragma("unroll") for (int _i = 0; _i < 2; ++_i) \
        __builtin_amdgcn_global_load_lds((const unsigned*)((const char*)(gbase) + (voff)[_i]), (PG8_LAS unsigned*)(lds + (bufoff) + ldsw + _i * 8192), 16, 0, 0); } while (0)
#define PG8_LDA(dst, b, h) do { _Pragma("unroll") for (int m = 0; m < 4; ++m) _Pragma("unroll") for (int k = 0; k < 2; ++k) dst[m][k] = *(const PG8_LAS bf16x8*)(lds + PG8_SA(b, h) + aoff + m * 2048 + k * 1024); } while (0)
#define PG8_LDB(dst, b, h) do { _Pragma("unroll") for (int n = 0; n < 2; ++n) _Pragma("unroll") for (int k = 0; k < 2; ++k) dst[n][k] = *(const PG8_LAS bf16x8*)(lds + PG8_SB(b, h) + boff + n * 2048 + k * 1024); } while (0)
#define PG8_MMA(ai, bj, At, Bt) do { __builtin_amdgcn_s_setprio(1); _Pragma("unroll") for (int m = 0; m < 4; ++m) _Pragma("unroll") for (int n = 0; n < 2; ++n) _Pragma("unroll") for (int k = 0; k < 2; ++k) \
        acc[ai][bj][m][n] = __builtin_amdgcn_mfma_f32_16x16x32_bf16(Bt[n][k], At[m][k], acc[ai][bj][m][n], 0, 0, 0); __builtin_amdgcn_s_setprio(0); } while (0)
#define PG8_WAIT_V(n) asm volatile("s_waitcnt vmcnt(" #n ")" ::: "memory")
#define PG8_WAIT_L(n) asm volatile("s_waitcnt lgkmcnt(" #n ")" ::: "memory")
#define PG8_BAR __builtin_amdgcn_s_barrier()
#define PG8_SCHED __builtin_amdgcn_sched_barrier(0)
    Unit cur, nxt; int ui = 0;
    if (!S.next(0, cur)) return;
    f32x4 acc[2][2][4][2];
#pragma unroll
    for (int a = 0; a < 2; ++a)
#pragma unroll
        for (int b = 0; b < 2; ++b)
#pragma unroll
            for (int m = 0; m < 4; ++m)
#pragma unroll
                for (int n = 0; n < 2; ++n) acc[a][b][m][n] = (f32x4){0.f, 0.f, 0.f, 0.f};
    bf16x8 At[4][2], B0[2][2], B1[2][2];
    const char* cA = (const char*)g.A + (size_t)cur.pm * tstep + (size_t)cur.k0 * kstep; const char* cB = (const char*)g.Bt + (size_t)cur.pn * tstep + (size_t)cur.k0 * kstep;
    S.a_ready(cur);
    PG8_STAGE(PG8_SB(0, 0), cB, voffB); PG8_STAGE(PG8_SA(0, 0), cA, voffA); PG8_STAGE(PG8_SB(0, 1), cB + hstep, voffB); PG8_STAGE(PG8_SA(0, 1), cA + hstep, voffA);
    if (wr == 1) PG8_BAR;
    PG8_WAIT_V(4); PG8_BAR;
    PG8_STAGE(PG8_SB(1, 0), cB + kstep, voffB); PG8_STAGE(PG8_SA(1, 0), cA + kstep, voffA); PG8_STAGE(PG8_SB(1, 1), cB + hstep + kstep, voffB);
    PG8_WAIT_V(6); PG8_BAR;
    for (;;) {
        const bool has_next = S.next(ui + 1, nxt);
        const char* nA = has_next ? (const char*)g.A + (size_t)nxt.pm * tstep + (size_t)nxt.k0 * kstep : cA; const char* nB = has_next ? (const char*)g.Bt + (size_t)nxt.pn * tstep + (size_t)nxt.k0 * kstep : cB;
        const int nt = cur.nkt;
        for (int t = 0; t < nt; t += 2) {
            const bool last = (t == nt - 2);
            const char* a1 = cA + (size_t)(t + 1) * kstep;
            const char* a2 = last ? nA : cA + (size_t)(t + 2) * kstep; const char* b2 = last ? nB : cB + (size_t)(t + 2) * kstep;
            const char* a3 = a2 + kstep; const char* b3 = b2 + kstep;
            if (last && has_next) S.a_ready(nxt);
            PG8_LDB(B0, 0, 0); PG8_SCHED; PG8_LDA(At, 0, 0); PG8_STAGE(PG8_SA(1, 1), a1 + hstep, voffA);
            PG8_WAIT_L(8); PG8_BAR; PG8_WAIT_L(0); PG8_MMA(0, 0, At, B0); PG8_BAR; PG8_SCHED;
            PG8_LDB(B1, 0, 1); PG8_STAGE(PG8_SB(0, 0), b2, voffB);
            PG8_BAR; PG8_WAIT_L(0); PG8_MMA(0, 1, At, B1); PG8_BAR;
            PG8_LDA(At, 0, 1); PG8_STAGE(PG8_SA(0, 0), a2, voffA);
            PG8_BAR; PG8_WAIT_L(0); PG8_MMA(1, 0, At, B0); PG8_BAR; PG8_SCHED;
            PG8_STAGE(PG8_SB(0, 1), b2 + hstep, voffB);
            PG8_WAIT_V(6); PG8_BAR; PG8_MMA(1, 1, At, B1); PG8_BAR;
            PG8_LDB(B0, 1, 0); PG8_SCHED; PG8_LDA(At, 1, 0); PG8_STAGE(PG8_SA(0, 1), a2 + hstep, voffA);
            PG8_WAIT_L(8); PG8_BAR; PG8_WAIT_L(0); PG8_MMA(0, 0, At, B0); PG8_BAR; PG8_SCHED;
            PG8_LDB(B1, 1, 1); PG8_STAGE(PG8_SB(1, 0), b3, voffB);
            PG8_BAR; PG8_WAIT_L(0); PG8_MMA(0, 1, At, B1); PG8_BAR;
            PG8_LDA(At, 1, 1); PG8_STAGE(PG8_SA(1, 0), a3, voffA);
            PG8_BAR; PG8_WAIT_L(0); PG8_MMA(1, 0, At, B0); PG8_BAR; PG8_SCHED;
            PG8_STAGE(PG8_SB(1, 1), b3 + hstep, voffB);
            PG8_WAIT_V(6); PG8_BAR; PG8_MMA(1, 1, At, B1); PG8_BAR;
        }
        E(acc, cur, wr, wc, fr, fq); S.done(cur);
        if (!has_next) break;
#pragma unroll
        for (int a = 0; a < 2; ++a)
#pragma unroll
            for (int b = 0; b < 2; ++b)
#pragma unroll
                for (int m = 0; m < 4; ++m)
#pragma unroll
                    for (int n = 0; n < 2; ++n) acc[a][b][m][n] = (f32x4){0.f, 0.f, 0.f, 0.f};
        cur = nxt; cA = nA; cB = nB; ++ui;
    }
    PG8_WAIT_V(0);
    if (wr == 0) PG8_BAR;
    PG8_BAR;
#undef PG8_SA
#undef PG8_SB
#undef PG8_STAGE
#undef PG8_LDA
#undef PG8_LDB
#undef PG8_MMA
#undef PG8_WAIT_V
#undef PG8_WAIT_L
#undef PG8_BAR
#undef PG8_SCHED
}
}

using pg8::bf16_t; using pg8::f32x4; using pg8::bf16x8; using pg8::u32x4; using pg8::u32x2;
#define LAS __attribute__((address_space(3)))

constexpr int D = 1024, DFF = 2816, NGU = 5632, NCOLS = 3840;
constexpr int MP = 16384, MS = 512, MT = 16896, MIN_ = 17152;
constexpr int LDS_BYTES = 147456;
constexpr size_t O_SHP = 17301504, O_WKP = O_SHP + 8192, O_RTP = O_WKP + 262144, O_SHS = O_RTP + 524288, O_WKS = O_SHS + 131072, O_RTS = O_WKS + 4194304;
constexpr size_t WS_ROPE = 16384;
constexpr size_t WS_WL   = WS_ROPE + 1050624;
constexpr size_t WS_WOUT = WS_WL + 786432;
constexpr size_t WS_WIN  = WS_WOUT + 2097152;
constexpr size_t WS_WGU  = WS_WIN + 7864320;
constexpr size_t WS_WD   = WS_WGU + 11534336;
constexpr size_t WS_XN   = WS_WD + 5767168;
constexpr size_t WS_BIG  = WS_XN + 35127296;
constexpr size_t WS_FO   = WS_BIG + 95158272;
constexpr size_t WS_YS   = WS_BIG + 131727360;
constexpr size_t WS_LA   = WS_YS + 17301504;
constexpr size_t WS_OMD  = WS_BIG + 164364288;
constexpr size_t WS_ASIG = WS_OMD + 17301504;
constexpr size_t WS_END  = WS_ASIG + 17301504;
static_assert(WS_LA + 8650752 <= WS_OMD, "mixer overlays");
static_assert(WS_END <= 268435456, "workspace");

struct Params {
    const float *x_prompt, *x_sample, *state_shift, *state_wkv, *state_ret, *norm_g, *f1g, *f1u, *f1d, *w_in, *mu, *w0, *w2, *a0, *a2, *g2, *k_k, *k_a, *r_k, *lnx_w, *lnx_b, *gn_w, *w_out, *f2g, *f2u, *f2d;
    float* out; unsigned char* ws;
};
#define CAS __attribute__((address_space(4)))
typedef const CAS Params& PR;

__device__ __forceinline__ float bf2f(unsigned b) { return __uint_as_float(b << 16); }
__device__ __forceinline__ bf16_t f2bf(float f) { unsigned u = __float_as_uint(f); u += 0x7FFFu + ((u >> 16) & 1u); return (bf16_t)(u >> 16); }
__device__ __forceinline__ float lo_bf(unsigned x) { return __uint_as_float(x << 16); }
__device__ __forceinline__ float hi_bf(unsigned x) { return __uint_as_float(x & 0xffff0000u); }
template <int CTRL> __device__ __forceinline__ float dppf(float v) { return __int_as_float(__builtin_amdgcn_update_dpp(0, __float_as_int(v), CTRL, 0xF, 0xF, false)); }
__device__ __forceinline__ float row16_sum(float v) { v += dppf<0xB1>(v); v += dppf<0x4E>(v); v += dppf<0x141>(v); v += dppf<0x140>(v); return v; }
__device__ __forceinline__ float wave_sum(float v) { v = row16_sum(v); const int i = __float_as_int(v);
    return __int_as_float(__builtin_amdgcn_readlane(i, 0)) + __int_as_float(__builtin_amdgcn_readlane(i, 16)) + __int_as_float(__builtin_amdgcn_readlane(i, 32)) + __int_as_float(__builtin_amdgcn_readlane(i, 48)); }
__device__ __forceinline__ float quad_sum(float v) { v += dppf<0xB1>(v); v += dppf<0x4E>(v); return v; }
__device__ __forceinline__ float sigmoid_f(float x) { return 1.0f / (1.0f + __expf(-x)); }


#define XB_TMO      128
#define XB_XCNT(j)  (256  + 64 * (j))
#define XB_XSUB(j)  (1280 + 64 * (j))
#define XB_XGEN(j)  (2304 + 64 * (j))
#define XB_TOP      3328
#define XB_TOPGEN   3392
#define XCD_BAR_WORDS 3456
#define XB_SPIN_CAP (1u << 18)
__device__ __forceinline__ unsigned xb_ld(unsigned* p)              { return __hip_atomic_load(p, __ATOMIC_RELAXED, __HIP_MEMORY_SCOPE_AGENT); }
__device__ __forceinline__ unsigned xb_add(unsigned* p, unsigned v) { return __hip_atomic_fetch_add(p, v, __ATOMIC_RELAXED, __HIP_MEMORY_SCOPE_AGENT); }
__device__ __forceinline__ unsigned xb_xcc_id() { return (unsigned)__builtin_amdgcn_s_getreg((3 << 11) | 20) & 0xFu; }
#define XB_SPIN(cond, bar) do { unsigned _sp = 0; while (cond) { __builtin_amdgcn_s_sleep(1); \
    if ((++_sp & 255u) == 0u) { if (xb_ld(&(bar)[XB_TMO])) break; if (_sp > XB_SPIN_CAP) { atomicAdd(&(bar)[XB_TMO], 1u); break; } } } } while (0)
struct XcdBarrier { unsigned* bar; unsigned x; volatile LAS unsigned* st; };
__device__ __forceinline__ XcdBarrier xcd_barrier_post(unsigned* bar, volatile LAS unsigned* st) {
    XcdBarrier b; b.bar = bar; b.x = xb_xcc_id(); b.st = st;
    return b;
}
__device__ __forceinline__ void xcd_barrier_complete(unsigned* bar, unsigned x, unsigned& nloc, unsigned& nx) {
    const unsigned G = gridDim.x * gridDim.y * gridDim.z;
    unsigned sum, cnt, mine, sp = 0u;
    for (;;) {
        sum = 0u; cnt = 0u; mine = 0u;
#pragma unroll
        for (unsigned j = 0; j < 16; ++j) { const unsigned c = xb_ld(&bar[XB_XCNT(j)]); sum += c; cnt += (c > 0u) ? 1u : 0u; mine = (j == x) ? c : mine; }
        if (sum == G) break;
        __builtin_amdgcn_s_sleep(1);
        if ((++sp & 255u) == 0u) { if (xb_ld(&bar[XB_TMO])) break; if (sp > XB_SPIN_CAP) { atomicAdd(&bar[XB_TMO], 1u); break; } }
    }
    nloc = mine > 0u ? mine : 1u; nx = cnt > 0u ? cnt : 1u;
}
__device__ __forceinline__ void xcd_barrier(unsigned* barw, volatile LAS unsigned* stw, const int wv) {
    XcdBarrier b; b.bar = barw; b.x = xb_xcc_id(); b.st = stw;
    asm volatile("s_waitcnt vmcnt(0)" ::: "memory");
    __syncthreads();
    if (fresh_tid(wv) == 0) {
        unsigned* bar = b.bar;
        __builtin_amdgcn_s_waitcnt(0);
        unsigned nloc = b.st[0], nx = b.st[1];
        if (nloc == 0u) { xcd_barrier_complete(bar, b.x, nloc, nx); b.st[0] = nloc; b.st[1] = nx; }
        const unsigned old = xb_add(&bar[XB_XSUB(b.x)], 1u);
        const unsigned gen = old / nloc;
        if (old + 1u == (gen + 1u) * nloc) {
            __builtin_amdgcn_fence(__ATOMIC_RELEASE, "agent");
            asm volatile("s_waitcnt vmcnt(0)" ::: "memory");
            const unsigned og = xb_add(&bar[XB_TOP], 1u);
            const unsigned tg = og / nx;
            if (og + 1u == (tg + 1u) * nx) xb_add(&bar[XB_TOPGEN], 1u);
            else XB_SPIN(xb_ld(&bar[XB_TOPGEN]) == tg, bar);
            __builtin_amdgcn_fence(__ATOMIC_ACQUIRE, "agent");
            xb_add(&bar[XB_XGEN(b.x)], 1u);
            asm volatile("s_waitcnt vmcnt(0)" ::: "memory");
        } else {
            XB_SPIN(xb_ld(&bar[XB_XGEN(b.x)]) == gen, bar);
            __builtin_amdgcn_fence(__ATOMIC_ACQUIRE, "agent");
            asm volatile("s_waitcnt vmcnt(0)" ::: "memory");
        }
    }
    __syncthreads();
}


#define DPP2(x, y, CTRL, NOP) asm volatile(NOP "\n\tv_add_f32_dpp %0, %0, %0 " CTRL " row_mask:0xf bank_mask:0xf bound_ctrl:1\n\tv_add_f32_dpp %1, %1, %1 " CTRL " row_mask:0xf bank_mask:0xf bound_ctrl:1" : "+v"(x), "+v"(y))
#define ROW16_SUM2(x, y) do { DPP2(x, y, "quad_perm:[1,0,3,2]", "s_nop 1"); DPP2(x, y, "quad_perm:[2,3,0,1]", "s_nop 0"); DPP2(x, y, "row_half_mirror", "s_nop 0"); DPP2(x, y, "row_mirror", "s_nop 0"); } while (0)
__device__ __forceinline__ int prev_row(int r) {
    if (r < MP) return (r & 2047) == 0 ? -1 : r - 1;
    const int s = r - MP; return (s & 3) == 0 ? MT + (s >> 2) : r - 1;
}

__device__ __forceinline__ void tconv_tile(const float* __restrict__ W, int K, int N, bf16_t* __restrict__ Bt, int mode, int tile, LAS float* t, const int wv) {
    const int nkt = K / 64; const int kt = tile % nkt, nt = tile / nkt; const int k0 = kt * 64, n0 = nt * 64;
    const int brow0 = mode == 0 ? n0 : ((n0 >> 7) * 256 + (n0 & 127) + (mode == 2 ? 128 : 0));
    const int tid = fresh_tid(wv);
#pragma unroll
    for (int e = 0; e < 8; ++e) { const int idx = e * 512 + tid, r = idx >> 6, c = idx & 63; t[r * 65 + c] = W[(size_t)(k0 + r) * N + n0 + c]; }
    __syncthreads();
#pragma unroll
    for (int e = 0; e < 4; ++e) { const int idx = e * 512 + tid, n = idx >> 5, kp = idx & 31;
        const unsigned w = pg8::cvt_pk_bf16(t[(2 * kp) * 65 + n], t[(2 * kp + 1) * 65 + n]);
        *(unsigned*)(Bt + (size_t)(brow0 + n) * K + k0 + 2 * kp) = w; }
    __syncthreads();
}
__device__ __forceinline__ void ffn_weights(const float* wg, const float* wu, const float* wd, unsigned char* ws, LAS float* t, const int wv) {
    for (int i = blockIdx.x; i < 2112; i += gridDim.x) {
        if (i < 704) tconv_tile(wg, 1024, DFF, (bf16_t*)(ws + WS_WGU), 1, i, t, wv);
        else if (i < 1408) tconv_tile(wu, 1024, DFF, (bf16_t*)(ws + WS_WGU), 2, i - 704, t, wv);
        else tconv_tile(wd, DFF, 1024, (bf16_t*)(ws + WS_WD), 0, i - 1408, t, wv);
    }
}

__device__ __forceinline__ void rows_phase(PR P, const int mode, const int wv) {
    const int tid = fresh_tid(wv); const int lane = tid & 63; const int gw = blockIdx.x * 8 + (tid >> 6), nw = gridDim.x * 8;
    const float* FO = (const float*)(P.ws + WS_FO); bf16_t* XN = (bf16_t*)(P.ws + WS_XN);
    const float* gpost = P.norm_g + (mode == 1 ? 1 : (mode == 2 ? 3 : 5)) * 1024;
    const float* gnext = P.norm_g + (mode == 0 ? 0 : (mode == 1 ? 2 : 4)) * 1024;
    const float scale = mode == 2 ? 1.0f : 0.5f;
    for (int row = gw; row < MT; row += nw) {
        const float* xin = mode <= 1 ? (row < MP ? P.x_prompt + (size_t)row * 1024 : P.x_sample + (size_t)(row - MP) * 1024) : P.out + (size_t)row * 1024;
        float4 xv[4];
#pragma unroll
        for (int q = 0; q < 4; ++q) xv[q] = *(const float4*)(xin + (q * 64 + lane) * 4);
        if (mode != 0) {
            float4 fo[4]; float ss = 0.f;
#pragma unroll
            for (int q = 0; q < 4; ++q) {
                if (row < MP) fo[q] = *(const float4*)(FO + (size_t)row * 1024 + (q * 64 + lane) * 4);
                else {
                    const int KS = mode == 2 ? 4 : 8; const float* sl = (const float*)(P.ws + WS_OMD) + (size_t)((((row - MP) >> 8) * 4 + q) * KS) * 65536 + (size_t)(row & 255) * 256 + lane * 4;
                    float4 a = *(const float4*)sl;
                    for (int p = 1; p < KS; ++p) { const float4 b = *(const float4*)(sl + (size_t)p * 65536); a.x += b.x; a.y += b.y; a.z += b.z; a.w += b.w; }
                    fo[q] = a; }
                ss += fo[q].x * fo[q].x + fo[q].y * fo[q].y + fo[q].z * fo[q].z + fo[q].w * fo[q].w; }
            ss = wave_sum(ss); const float r = rsqrtf(ss * (1.0f / 1024.0f) + 1e-6f) * scale;
#pragma unroll
            for (int q = 0; q < 4; ++q) { const float4 g = *(const float4*)(gpost + (q * 64 + lane) * 4);
                xv[q].x += fo[q].x * r * g.x; xv[q].y += fo[q].y * r * g.y; xv[q].z += fo[q].z * r * g.z; xv[q].w += fo[q].w * r * g.w;
                *(float4*)(P.out + (size_t)row * 1024 + (q * 64 + lane) * 4) = xv[q]; }
            if (mode == 3) continue;
        }
        float ss2 = 0.f;
#pragma unroll
        for (int q = 0; q < 4; ++q) ss2 += xv[q].x * xv[q].x + xv[q].y * xv[q].y + xv[q].z * xv[q].z + xv[q].w * xv[q].w;
        ss2 = wave_sum(ss2); const float r2 = rsqrtf(ss2 * (1.0f / 1024.0f) + 1e-6f);
        float* sh = nullptr;
        if (mode == 1) { if (row < MP) { if ((row & 2047) == 2047) sh = P.out + O_SHP + (size_t)(row >> 11) * 1024; } else { const int s = row - MP; if ((s & 3) == 3) sh = P.out + O_SHS + (size_t)(s >> 2) * 1024; } }
#pragma unroll
        for (int q = 0; q < 4; ++q) { const float4 g = *(const float4*)(gnext + (q * 64 + lane) * 4);
            float4 hv; hv.x = xv[q].x * r2 * g.x; hv.y = xv[q].y * r2 * g.y; hv.z = xv[q].z * r2 * g.z; hv.w = xv[q].w * r2 * g.w;
            u32x2 w; w.x = pg8::cvt_pk_bf16(hv.x, hv.y); w.y = pg8::cvt_pk_bf16(hv.z, hv.w);
            *(u32x2*)(XN + (size_t)row * 1024 + (q * 64 + lane) * 4) = w;
            if (sh) *(float4*)(sh + (q * 64 + lane) * 4) = hv; }
    }
}

__device__ __forceinline__ void p0_prologue(PR P, LAS float* ldsf, const int wv) {
    const int tid = fresh_tid(wv); const size_t gt = (size_t)blockIdx.x * 512 + tid, nth = (size_t)gridDim.x * 512;
    { float* rc = (float*)(P.ws + WS_ROPE); float* rs = rc + 2052 * 64;
      for (size_t i = gt; i < 2052 * 64; i += nth) { const int p = (int)(i >> 6), f = (int)(i & 63); const int pos = p < 2048 ? p : 16384 + (p - 2048);
          double inv = 1.0; for (int q = 0; q < f; ++q) inv *= 0.8659643233600653;
          const double ang = (double)pos * inv; const double n = rint(ang * 0.15915494309189535); const double r = ang - n * 6.283185307179586;
          const double r2 = r * r; double s = 0.0, c = 0.0;
          for (int k = 14; k >= 0; --k) { s = s * (-r2 / (double)((2 * k + 2) * (2 * k + 3))) + 1.0; c = c * (-r2 / (double)((2 * k + 1) * (2 * k + 2))) + 1.0; }
          rc[i] = (float)c; rs[i] = (float)(s * r); } }
    { bf16_t* Wl = (bf16_t*)(P.ws + WS_WL);
      for (size_t i = gt; i < 1536 * 256; i += nth) { const int n = (int)(i >> 8), k = (int)(i & 255); float v = 0.f;
          if (n < 512) { if (k < 64) v = P.w2[k * 512 + n]; } else if (n < 1024) { if (k >= 64 && k < 128) v = P.a2[(k - 64) * 512 + (n - 512)]; } else { if (k >= 128) v = P.g2[(k - 128) * 512 + (n - 1024)]; }
          Wl[i] = f2bf(v); } }
    { bf16_t* XN = (bf16_t*)(P.ws + WS_XN);
      for (size_t i = gt; i < 256 * 1024; i += nth) { const int r = (int)(i >> 10); XN[(size_t)MT * 1024 + i] = r < 128 ? f2bf(P.state_shift[i]) : (bf16_t)0; } }
    ffn_weights(P.f1g, P.f1u, P.f1d, P.ws, ldsf, wv);
    for (int i = blockIdx.x; i < 1216; i += gridDim.x) {
        if (i < 960) tconv_tile(P.w_in, 1024, NCOLS, (bf16_t*)(P.ws + WS_WIN), 0, i, ldsf, wv);
        else tconv_tile(P.w_out, 1024, 1024, (bf16_t*)(P.ws + WS_WOUT), 0, i - 960, ldsf, wv);
    }
    rows_phase(P, 0, wv);
}

__device__ __forceinline__ void lora_prep(PR P, const int wv) {
    const int tid = fresh_tid(wv); const int lane = tid & 63; const int gw = blockIdx.x * 8 + (tid >> 6), nw = gridDim.x * 8;
    const bf16_t* PS = (const bf16_t*)(P.ws + WS_BIG); bf16_t* LA = (bf16_t*)(P.ws + WS_LA);
    const float4 mu = *(const float4*)(P.mu + 1536 + lane * 4); const int kind = lane >> 4;
    for (int row = gw; row < MT; row += nw) {
        const u32x2 c = *(const u32x2*)(PS + (size_t)row * NCOLS + 1536 + lane * 4); const int pr = prev_row(row);
        u32x2 p = (u32x2){0u, 0u}; if (pr >= 0) p = *(const u32x2*)(PS + (size_t)pr * NCOLS + 1536 + lane * 4);
        float v[4]; const float cu[4] = {lo_bf(c.x), hi_bf(c.x), lo_bf(c.y), hi_bf(c.y)}, pv[4] = {lo_bf(p.x), hi_bf(p.x), lo_bf(p.y), hi_bf(p.y)}, m4[4] = {mu.x, mu.y, mu.z, mu.w};
#pragma unroll
        for (int j = 0; j < 4; ++j) { float x = cu[j] + (pv[j] - cu[j]) * m4[j];
            if (kind == 0) x = 1.0f - 2.0f / (__expf(2.0f * x) + 1.0f); else if (kind >= 2) x = sigmoid_f(x);
            v[j] = x; }
        u32x2 w; w.x = pg8::cvt_pk_bf16(v[0], v[1]); w.y = pg8::cvt_pk_bf16(v[2], v[3]);
        *(u32x2*)(LA + (size_t)row * 256 + lane * 4) = w;
    }
}

template <bool SAMPLE>
__device__ __forceinline__ void rwkv_unit(PR P, LAS float* lds, const int b, const int h, const int half, const int wv) {
    constexpr int T = SAMPLE ? 4 : 2048, TC = SAMPLE ? 4 : 32, NCH = T / TC;
    const int tid = fresh_tid(wv), lane = tid & 63, wid = tid >> 6;
    const bf16_t* PS = (const bf16_t*)(P.ws + WS_BIG); const bf16_t* OMD = (const bf16_t*)(P.ws + WS_OMD); const bf16_t* ASIG = (const bf16_t*)(P.ws + WS_ASIG);
    bf16_t* YS = (bf16_t*)(P.ws + WS_YS);
    const int row_base = SAMPLE ? MP + b * 4 : b * 2048;
    const int ltok = tid >> 4, lcg = tid & 15; const bool lact = ltok < TC; const int hch = h * 64 + lcg * 4;
    const float4 mur = *(const float4*)(P.mu + hch), muk = *(const float4*)(P.mu + 512 + hch), muv = *(const float4*)(P.mu + 1024 + hch);
    const float4 kk4 = *(const float4*)(P.k_k + hch), ka4 = *(const float4*)(P.k_a + hch);
    typedef float f32x2 __attribute__((ext_vector_type(2)));
    const int row0 = half * 32 + (wid & 3) * 8 + (lane >> 4) * 2, cgl = lane & 15, j0 = cgl * 4;
    f32x2 S[4];
#pragma unroll
    for (int c = 0; c < 4; ++c) S[c] = (f32x2){0.f, 0.f};
    float* sout = P.out + (SAMPLE ? O_WKS : O_WKP) + ((size_t)(b * 8 + h) * 64 + row0) * 64 + j0;
    if (SAMPLE && wid < 4) { const float* sp = P.state_wkv + ((size_t)(b * 8 + h) * 64 + row0) * 64 + j0; const float4 s0 = *(const float4*)sp, s1 = *(const float4*)(sp + 64);
        S[0] = (f32x2){s0.x, s1.x}; S[1] = (f32x2){s0.y, s1.y}; S[2] = (f32x2){s0.z, s1.z}; S[3] = (f32x2){s0.w, s1.w}; }
    LAS float* buf0 = lds; LAS float* buf1 = lds + TC * 384;
    u32x2 cr, ck, cv, pr, pk, pv, co, ca;
#define RW_LOAD(c) do { if (lact) { const int t_ = (c) * TC + ltok; const int row_ = row_base + t_; const int prow_ = SAMPLE ? (t_ == 0 ? MT + b : row_ - 1) : row_ - 1; \
        const bf16_t* cp_ = PS + (size_t)row_ * NCOLS + hch; cr = *(const u32x2*)cp_; ck = *(const u32x2*)(cp_ + 512); cv = *(const u32x2*)(cp_ + 1024); \
        if (SAMPLE || t_ > 0) { const bf16_t* pp_ = PS + (size_t)prow_ * NCOLS + hch; pr = *(const u32x2*)pp_; pk = *(const u32x2*)(pp_ + 512); pv = *(const u32x2*)(pp_ + 1024); } \
        else { pr = (u32x2){0u, 0u}; pk = pr; pv = pr; } \
        co = *(const u32x2*)(OMD + (size_t)row_ * 512 + hch); ca = *(const u32x2*)(ASIG + (size_t)row_ * 512 + hch); } } while (0)
#define RW_MIX(cu, pv_, m) ((cu) + ((pv_) - (cu)) * (m))
#define RW_PROC(dst) do { if (lact) { LAS float* d_ = (dst) + ltok * 384 + lcg * 4; \
        f32x4 r_, k_, v_, o_, a_; \
        r_[0] = RW_MIX(lo_bf(cr.x), lo_bf(pr.x), mur.x); r_[1] = RW_MIX(hi_bf(cr.x), hi_bf(pr.x), mur.y); r_[2] = RW_MIX(lo_bf(cr.y), lo_bf(pr.y), mur.z); r_[3] = RW_MIX(hi_bf(cr.y), hi_bf(pr.y), mur.w); \
        k_[0] = RW_MIX(lo_bf(ck.x), lo_bf(pk.x), muk.x); k_[1] = RW_MIX(hi_bf(ck.x), hi_bf(pk.x), muk.y); k_[2] = RW_MIX(lo_bf(ck.y), lo_bf(pk.y), muk.z); k_[3] = RW_MIX(hi_bf(ck.y), hi_bf(pk.y), muk.w); \
        v_[0] = RW_MIX(lo_bf(cv.x), lo_bf(pv.x), muv.x); v_[1] = RW_MIX(hi_bf(cv.x), hi_bf(pv.x), muv.y); v_[2] = RW_MIX(lo_bf(cv.y), lo_bf(pv.y), muv.z); v_[3] = RW_MIX(hi_bf(cv.y), hi_bf(pv.y), muv.w); \
        o_[0] = lo_bf(co.x); o_[1] = hi_bf(co.x); o_[2] = lo_bf(co.y); o_[3] = hi_bf(co.y); a_[0] = lo_bf(ca.x); a_[1] = hi_bf(ca.x); a_[2] = lo_bf(ca.y); a_[3] = hi_bf(ca.y); \
        f32x4 kk_; kk_[0] = k_[0] * kk4.x; kk_[1] = k_[1] * kk4.y; kk_[2] = k_[2] * kk4.z; kk_[3] = k_[3] * kk4.w; \
        float ss_ = kk_[0] * kk_[0] + kk_[1] * kk_[1] + kk_[2] * kk_[2] + kk_[3] * kk_[3]; ss_ = row16_sum(ss_); \
        const float inv_ = 1.0f / fmaxf(sqrtf(ss_), 1e-12f); kk_ = kk_ * inv_; \
        f32x4 kn_; kn_[0] = k_[0] * (1.0f + (a_[0] - 1.0f) * ka4.x); kn_[1] = k_[1] * (1.0f + (a_[1] - 1.0f) * ka4.y); kn_[2] = k_[2] * (1.0f + (a_[2] - 1.0f) * ka4.z); kn_[3] = k_[3] * (1.0f + (a_[3] - 1.0f) * ka4.w); \
        *(LAS f32x4*)(d_) = r_; *(LAS f32x4*)(d_ + 64) = o_; *(LAS f32x4*)(d_ + 128) = kn_; *(LAS f32x4*)(d_ + 192) = -kk_; *(LAS f32x4*)(d_ + 256) = kk_ * a_; *(LAS f32x4*)(d_ + 320) = v_; } } while (0)
    RW_LOAD(0); RW_PROC(buf0); __syncthreads();
    for (int c = 0; c < NCH; ++c) {
        LAS float* cur = (c & 1) ? buf1 : buf0; LAS float* nxt = (c & 1) ? buf0 : buf1;
        if (c + 1 < NCH) RW_LOAD(c + 1);
        if (wid < 4) {
            constexpr int GS = SAMPLE ? 4 : 16;
            for (int g = 0; g < TC / GS; ++g) {
                float yk0 = 0.f, yk1 = 0.f;
                const LAS float* q0 = cur + (g * GS) * 384;
                f32x4 r4 = *(const LAS f32x4*)(q0 + j0), o4 = *(const LAS f32x4*)(q0 + 64 + j0), k4 = *(const LAS f32x4*)(q0 + 128 + j0), a4 = *(const LAS f32x4*)(q0 + 192 + j0), b4 = *(const LAS f32x4*)(q0 + 256 + j0);
                f32x2 v2 = *(const LAS f32x2*)(q0 + 320 + row0);
#pragma unroll
                for (int tt = 0; tt < GS; ++tt) {
                    const LAS float* qn = q0 + (tt + 1 < GS ? tt + 1 : tt) * 384;
                    const f32x4 nr4 = *(const LAS f32x4*)(qn + j0), no4 = *(const LAS f32x4*)(qn + 64 + j0), nk4 = *(const LAS f32x4*)(qn + 128 + j0), na4 = *(const LAS f32x4*)(qn + 192 + j0), nb4 = *(const LAS f32x4*)(qn + 256 + j0);
                    const f32x2 nv2 = *(const LAS f32x2*)(qn + 320 + row0);
                    f32x2 sa = (S[0] * a4[0] + S[1] * a4[1]) + (S[2] * a4[2] + S[3] * a4[3]);
                    float sx = sa.x, sy = sa.y; ROW16_SUM2(sx, sy); sa = (f32x2){sx, sy};
#pragma unroll
                    for (int c = 0; c < 4; ++c) { f32x2 t = S[c] - S[c] * o4[c]; t = t + sa * b4[c]; S[c] = t + v2 * k4[c]; }
                    f32x2 y = (S[0] * r4[0] + S[1] * r4[1]) + (S[2] * r4[2] + S[3] * r4[3]);
                    float yx = y.x, yy = y.y; ROW16_SUM2(yx, yy);
                    yk0 = cgl == tt ? yx : yk0; yk1 = cgl == tt ? yy : yk1;
                    r4 = nr4; o4 = no4; k4 = nk4; a4 = na4; b4 = nb4; v2 = nv2;
                }
                if (cgl < GS) *(unsigned*)(YS + (size_t)(row_base + c * TC + g * GS + cgl) * 512 + h * 64 + row0) = pg8::cvt_pk_bf16(yk0, yk1);
            }
        }
        if (c + 1 < NCH) RW_PROC(nxt);
        __syncthreads();
    }
    if (wid < 4) { *(float4*)sout = make_float4(S[0].x, S[1].x, S[2].x, S[3].x); *(float4*)(sout + 64) = make_float4(S[0].y, S[1].y, S[2].y, S[3].y); }
#undef RW_LOAD
#undef RW_PROC
#undef RW_MIX
}

__device__ __forceinline__ void ret_sample_unit(PR P, LAS float* lds, const int b, const int h, const int wv) {
    const int tid = fresh_tid(wv), lane = tid & 63, wid = tid >> 6;
    const bf16_t* PS = (const bf16_t*)(P.ws + WS_BIG); bf16_t* Y = (bf16_t*)(P.ws + WS_XN);
    const float* rc = (const float*)(P.ws + WS_ROPE); const float* rs = rc + 2052 * 64;
    LAS float* q = lds; LAS float* k = lds + 512; LAS float* v = lds + 1024; LAS float* Pm = lds + 1536; LAS float* y2p = lds + 1600; LAS float* red = lds + 1600 + 2048;
    const float lg2 = log2f(1.0f - exp2f(-5.0f - (float)h));
    const int row0 = MP + b * 4;
    { const int t = (tid & 255) >> 6, f = tid & 63; const bf16_t* src = PS + (size_t)(row0 + t) * NCOLS + 1792 + h * 128;
      if (tid < 256) { const float cs = rc[(2048 + t) * 64 + f], sn = rs[(2048 + t) * 64 + f];
          const float q1 = bf2f(src[f]), q2 = bf2f(src[f + 64]); q[t * 128 + f] = q1 * cs - q2 * sn; q[t * 128 + f + 64] = q1 * sn + q2 * cs;
          const float k1 = bf2f(src[512 + f]), k2 = bf2f(src[512 + f + 64]); k[t * 128 + f] = (k1 * cs - k2 * sn) * 0.08838834764831845f; k[t * 128 + f + 64] = (k1 * sn + k2 * cs) * 0.08838834764831845f; }
      else { v[t * 128 + f] = bf2f(src[1024 + f]); v[t * 128 + f + 64] = bf2f(src[1024 + f + 64]); } }
    __syncthreads();
    if (wid == 0) { const int pi = lane >> 4, pj = (lane >> 2) & 3, part = lane & 3; float s = 0.f;
        for (int d = part * 32; d < part * 32 + 32; ++d) s += q[pi * 128 + d] * k[pj * 128 + d];
        s = quad_sum(s); if (part == 0) Pm[pi * 4 + pj] = pi >= pj ? s * exp2f(lg2 * (float)(pi - pj)) : 0.f; }
    { const int e = tid & 127, dg = tid >> 7; const float c4 = exp2f(lg2 * 4.0f), g3 = exp2f(lg2 * 3.0f), g2_ = exp2f(lg2 * 2.0f), g1 = exp2f(lg2);
      const float v0 = v[e] * g3, v1 = v[128 + e] * g2_, v2 = v[256 + e] * g1, v3 = v[384 + e];
      const float* S0 = P.state_ret + ((size_t)(b * 4 + h) * 128) * 128 + e; float* So = P.out + O_RTS + ((size_t)(b * 4 + h) * 128) * 128 + e;
      float a0 = 0.f, a1 = 0.f, a2 = 0.f, a3 = 0.f;
      float sv[32];
#pragma unroll
      for (int x = 0; x < 32; ++x) sv[x] = S0[(size_t)(dg * 32 + x) * 128];
#pragma unroll
      for (int x = 0; x < 32; ++x) { const int d = dg * 32 + x; const float s = sv[x];
          a0 = fmaf(q[d], s, a0); a1 = fmaf(q[128 + d], s, a1); a2 = fmaf(q[256 + d], s, a2); a3 = fmaf(q[384 + d], s, a3);
          So[(size_t)d * 128] = s * c4 + k[d] * v0 + k[128 + d] * v1 + k[256 + d] * v2 + k[384 + d] * v3; }
      y2p[(dg * 4 + 0) * 128 + e] = a0; y2p[(dg * 4 + 1) * 128 + e] = a1; y2p[(dg * 4 + 2) * 128 + e] = a2; y2p[(dg * 4 + 3) * 128 + e] = a3; }
    __syncthreads();
    { const int i = tid >> 7, e = tid & 127;
      float y = (y2p[(0 + i) * 128 + e] + y2p[(4 + i) * 128 + e] + y2p[(8 + i) * 128 + e] + y2p[(12 + i) * 128 + e]) * exp2f(lg2 * (float)(i + 1));
#pragma unroll
      for (int j = 0; j < 4; ++j) y = fmaf(Pm[i * 4 + j], v[j * 128 + e], y);
      float s = wave_sum(y); if (lane == 0) red[wid] = s; __syncthreads();
      const float mean = (red[i * 2] + red[i * 2 + 1]) * (1.0f / 128.0f); const float dlt = y - mean;
      float s2 = wave_sum(dlt * dlt); if (lane == 0) red[8 + wid] = s2; __syncthreads();
      const float var = (red[8 + i * 2] + red[8 + i * 2 + 1]) * (1.0f / 128.0f);
      const float g = bf2f(PS[(size_t)(row0 + i) * NCOLS + 1792 + 1536 + h * 128 + e]);
      const float o = dlt * rsqrtf(var + 1e-5f) * P.gn_w[h * 128 + e] * (g / (1.0f + __expf(-g)));
      Y[(size_t)(row0 + i) * 1024 + 512 + h * 128 + e] = f2bf(o); }
    __syncthreads();
}

__device__ __forceinline__ bf16_t* kvb_ptr(unsigned char* ws, int bh) { return (bf16_t*)(bh < 29 ? ws + WS_LA + (size_t)bh * 524288 : ws + WS_WIN + 17301504 + (size_t)(bh - 29) * 524288); }
constexpr int RS = 136, BUFE = 128 * RS;

template <bool WITH_K>
__device__ __forceinline__ void ret_load_qk(PR P, LAS bf16_t* QP, LAS bf16_t* KB, unsigned (&kth)[4][4], const int tidv, const int row0, const int n, const int h, const float kd0, const float g32) {
    const bf16_t* PS = (const bf16_t*)(P.ws + WS_BIG); const float* rc = (const float*)(P.ws + WS_ROPE); const float* rs = rc + 2052 * 64;
    float kd = kd0;
#pragma unroll
    for (int it = 0; it < 4; ++it) { const int idx = it * 512 + tidv, i = idx >> 4, f = (idx & 15) * 4;
        const bf16_t* src = PS + (size_t)(row0 + i) * NCOLS + 1792 + h * 128;
        const u32x2 q1 = *(const u32x2*)(src + f), q2 = *(const u32x2*)(src + 64 + f);
        u32x2 k1 = (u32x2){0u, 0u}, k2 = k1; if (WITH_K) { k1 = *(const u32x2*)(src + 512 + f); k2 = *(const u32x2*)(src + 576 + f); }
        const float4 cs = *(const float4*)(rc + (size_t)(n * 128 + i) * 64 + f), sn = *(const float4*)(rs + (size_t)(n * 128 + i) * 64 + f);
        const float c4[4] = {cs.x, cs.y, cs.z, cs.w}, s4[4] = {sn.x, sn.y, sn.z, sn.w};
        const float qa[4] = {lo_bf(q1.x), hi_bf(q1.x), lo_bf(q1.y), hi_bf(q1.y)}, qb[4] = {lo_bf(q2.x), hi_bf(q2.x), lo_bf(q2.y), hi_bf(q2.y)};
        float qo1[4], qo2[4];
#pragma unroll
        for (int x = 0; x < 4; ++x) { qo1[x] = qa[x] * c4[x] - qb[x] * s4[x]; qo2[x] = qa[x] * s4[x] + qb[x] * c4[x]; }
        u32x2 w; w.x = pg8::cvt_pk_bf16(qo1[0], qo1[1]); w.y = pg8::cvt_pk_bf16(qo1[2], qo1[3]); *(LAS u32x2*)(QP + i * RS + f) = w;
        w.x = pg8::cvt_pk_bf16(qo2[0], qo2[1]); w.y = pg8::cvt_pk_bf16(qo2[2], qo2[3]); *(LAS u32x2*)(QP + i * RS + 64 + f) = w;
        if (WITH_K) {
            const float ka[4] = {lo_bf(k1.x), hi_bf(k1.x), lo_bf(k1.y), hi_bf(k1.y)}, kb[4] = {lo_bf(k2.x), hi_bf(k2.x), lo_bf(k2.y), hi_bf(k2.y)};
            float ko1[4], ko2[4];
#pragma unroll
            for (int x = 0; x < 4; ++x) { ko1[x] = (ka[x] * c4[x] - kb[x] * s4[x]) * 0.08838834764831845f; ko2[x] = (ka[x] * s4[x] + kb[x] * c4[x]) * 0.08838834764831845f; }
            w.x = pg8::cvt_pk_bf16(ko1[0], ko1[1]); w.y = pg8::cvt_pk_bf16(ko1[2], ko1[3]); *(LAS u32x2*)(KB + i * RS + f) = w;
            w.x = pg8::cvt_pk_bf16(ko2[0], ko2[1]); w.y = pg8::cvt_pk_bf16(ko2[2], ko2[3]); *(LAS u32x2*)(KB + i * RS + 64 + f) = w;
            kth[it][0] = pg8::cvt_pk_bf16(ko1[0] * kd, ko1[1] * kd); kth[it][1] = pg8::cvt_pk_bf16(ko1[2] * kd, ko1[3] * kd);
            kth[it][2] = pg8::cvt_pk_bf16(ko2[0] * kd, ko2[1] * kd); kth[it][3] = pg8::cvt_pk_bf16(ko2[2] * kd, ko2[3] * kd); kd *= g32; }
        if (it & 1) __builtin_amdgcn_sched_barrier(0); }
}

__device__ __forceinline__ void ret_unit_a(PR P, LAS unsigned char* lds, const int bh, const int n, const int wv) {
    LAS bf16_t* QP = (LAS bf16_t*)lds; LAS bf16_t* KB = QP + BUFE; LAS bf16_t* VT = KB + BUFE;
    const int tid = fresh_tid(wv), lane = tid & 63, wid = tid >> 6, wr = wid >> 1, wc = wid & 1, fr = lane & 15, fq = lane >> 4;
    const int b = bh >> 2, h = bh & 3;
    const bf16_t* PS = (const bf16_t*)(P.ws + WS_BIG); bf16_t* Y = (bf16_t*)(P.ws + WS_XN); bf16_t* KVB = kvb_ptr(P.ws, bh) + (size_t)n * 16384;
    const float lg2 = log2f(1.0f - exp2f(-5.0f - (float)h));
    const float kd0 = exp2f(lg2 * (float)(127 - (tid >> 4))), g32 = exp2f(-32.0f * lg2);
    const int row0 = b * 2048 + n * 128;
    unsigned kth[4][4];
    ret_load_qk<true>(P, QP, KB, kth, tid, row0, n, h, kd0, g32);
#pragma unroll
    for (int it = 0; it < 4; ++it) { const int idx = it * 512 + tid, j = idx >> 4, e = (idx & 15) * 8;
        const u32x4 vv = *(const u32x4*)(PS + (size_t)(row0 + j) * NCOLS + 1792 + 1024 + h * 128 + e);
        LAS bf16_t* d = VT + e * RS + j;
        d[0] = (bf16_t)(vv.x & 0xffffu); d[RS] = (bf16_t)(vv.x >> 16); d[2 * RS] = (bf16_t)(vv.y & 0xffffu); d[3 * RS] = (bf16_t)(vv.y >> 16);
        d[4 * RS] = (bf16_t)(vv.z & 0xffffu); d[5 * RS] = (bf16_t)(vv.z >> 16); d[6 * RS] = (bf16_t)(vv.w & 0xffffu); d[7 * RS] = (bf16_t)(vv.w >> 16); }
    __syncthreads();
    f32x4 accP[2][4];
#pragma unroll
    for (int mt = 0; mt < 2; ++mt)
#pragma unroll
        for (int nt = 0; nt < 4; ++nt) accP[mt][nt] = (f32x4){0.f, 0.f, 0.f, 0.f};
#pragma unroll
    for (int ks = 0; ks < 4; ++ks) { bf16x8 aq[2];
#pragma unroll
        for (int mt = 0; mt < 2; ++mt) aq[mt] = *(const LAS bf16x8*)(QP + (wr * 32 + mt * 16 + fr) * RS + ks * 32 + fq * 8);
#pragma unroll
        for (int nt = 0; nt < 4; ++nt) { const bf16x8 bk = *(const LAS bf16x8*)(KB + (wc * 64 + nt * 16 + fr) * RS + ks * 32 + fq * 8);
#pragma unroll
            for (int mt = 0; mt < 2; ++mt) accP[mt][nt] = __builtin_amdgcn_mfma_f32_16x16x32_bf16(aq[mt], bk, accP[mt][nt], 0, 0, 0); }
        __builtin_amdgcn_sched_barrier(0); }
    __syncthreads();
    { float ri[2][4], cj[4];
#pragma unroll
      for (int mt = 0; mt < 2; ++mt)
#pragma unroll
          for (int j = 0; j < 4; ++j) ri[mt][j] = exp2f(lg2 * (float)(wr * 32 + mt * 16 + fq * 4 + j));
#pragma unroll
      for (int nt = 0; nt < 4; ++nt) cj[nt] = exp2f(-lg2 * (float)(wc * 64 + nt * 16 + fr));
#pragma unroll
      for (int mt = 0; mt < 2; ++mt)
#pragma unroll
          for (int nt = 0; nt < 4; ++nt)
#pragma unroll
              for (int j = 0; j < 4; ++j) { const int i = wr * 32 + mt * 16 + fq * 4 + j, jj = wc * 64 + nt * 16 + fr;
                  const float val = i >= jj ? accP[mt][nt][j] * ri[mt][j] * cj[nt] : 0.f; QP[i * RS + jj] = f2bf(val); } }
#pragma unroll
    for (int it = 0; it < 4; ++it) { const int idx = it * 512 + tid, j = idx >> 4, f = (idx & 15) * 4; LAS bf16_t* d = KB + f * RS + j;
        d[0] = (bf16_t)(kth[it][0] & 0xffffu); d[RS] = (bf16_t)(kth[it][0] >> 16); d[2 * RS] = (bf16_t)(kth[it][1] & 0xffffu); d[3 * RS] = (bf16_t)(kth[it][1] >> 16);
        LAS bf16_t* d2 = d + 64 * RS;
        d2[0] = (bf16_t)(kth[it][2] & 0xffffu); d2[RS] = (bf16_t)(kth[it][2] >> 16); d2[2 * RS] = (bf16_t)(kth[it][3] & 0xffffu); d2[3 * RS] = (bf16_t)(kth[it][3] >> 16); }
    __syncthreads();
    f32x4 accY[2][4], accS[2][4];
#pragma unroll
    for (int mt = 0; mt < 2; ++mt)
#pragma unroll
        for (int nt = 0; nt < 4; ++nt) { accY[mt][nt] = (f32x4){0.f, 0.f, 0.f, 0.f}; accS[mt][nt] = (f32x4){0.f, 0.f, 0.f, 0.f}; }
#pragma unroll
    for (int ks = 0; ks < 4; ++ks) { bf16x8 ap[2], av[2];
#pragma unroll
        for (int mt = 0; mt < 2; ++mt) { ap[mt] = *(const LAS bf16x8*)(QP + (wr * 32 + mt * 16 + fr) * RS + ks * 32 + fq * 8); av[mt] = *(const LAS bf16x8*)(VT + (wr * 32 + mt * 16 + fr) * RS + ks * 32 + fq * 8); }
#pragma unroll
        for (int nt = 0; nt < 4; ++nt) { const bf16x8 bv = *(const LAS bf16x8*)(VT + (wc * 64 + nt * 16 + fr) * RS + ks * 32 + fq * 8), bkt = *(const LAS bf16x8*)(KB + (wc * 64 + nt * 16 + fr) * RS + ks * 32 + fq * 8);
#pragma unroll
            for (int mt = 0; mt < 2; ++mt) { accY[mt][nt] = __builtin_amdgcn_mfma_f32_16x16x32_bf16(ap[mt], bv, accY[mt][nt], 0, 0, 0); accS[mt][nt] = __builtin_amdgcn_mfma_f32_16x16x32_bf16(av[mt], bkt, accS[mt][nt], 0, 0, 0); } }
        __builtin_amdgcn_sched_barrier(0); }
#pragma unroll
    for (int mt = 0; mt < 2; ++mt)
#pragma unroll
        for (int nt = 0; nt < 4; ++nt)
#pragma unroll
            for (int j = 0; j < 4; ++j) { const int r = wr * 32 + mt * 16 + fq * 4 + j, c = wc * 64 + nt * 16 + fr;
                Y[(size_t)(row0 + r) * 1024 + 512 + h * 128 + c] = f2bf(accY[mt][nt][j]); KVB[r * 128 + c] = f2bf(accS[mt][nt][j]); }
    __syncthreads();
}

__device__ __forceinline__ void ret_prefix(PR P, const int item) {
    const int bh = item >> 11, i8 = (item & 2047) * 8; const int h = bh & 3;
    bf16_t* KVB = kvb_ptr(P.ws, bh) + i8;
    const float lg2 = log2f(1.0f - exp2f(-5.0f - (float)h)); const float c_dec = exp2f(lg2 * 128.0f);
    u32x4 kv[16];
#pragma unroll
    for (int n = 0; n < 16; ++n) kv[n] = *(const u32x4*)(KVB + (size_t)n * 16384);
    float S[8];
#pragma unroll
    for (int x = 0; x < 8; ++x) S[x] = 0.f;
#pragma unroll
    for (int n = 0; n < 16; ++n) { u32x4 w; w.x = pg8::cvt_pk_bf16(S[0], S[1]); w.y = pg8::cvt_pk_bf16(S[2], S[3]); w.z = pg8::cvt_pk_bf16(S[4], S[5]); w.w = pg8::cvt_pk_bf16(S[6], S[7]);
        *(u32x4*)(KVB + (size_t)n * 16384) = w;
        const float k8[8] = {lo_bf(kv[n].x), hi_bf(kv[n].x), lo_bf(kv[n].y), hi_bf(kv[n].y), lo_bf(kv[n].z), hi_bf(kv[n].z), lo_bf(kv[n].w), hi_bf(kv[n].w)};
#pragma unroll
        for (int x = 0; x < 8; ++x) S[x] = S[x] * c_dec + k8[x]; }
    const int e = i8 >> 7, d0 = i8 & 127;
#pragma unroll
    for (int x = 0; x < 8; ++x) P.out[O_RTP + ((size_t)bh * 128 + d0 + x) * 128 + e] = S[x];
}

__device__ __forceinline__ void ret_unit_c(PR P, LAS unsigned char* lds, const int bh, const int n, const int wv) {
    LAS bf16_t* QP = (LAS bf16_t*)lds; LAS bf16_t* ST = QP + 3 * BUFE; LAS float* YST = (LAS float*)(QP + BUFE);
    const int tid = fresh_tid(wv), lane = tid & 63, wid = tid >> 6, wr = wid >> 1, wc = wid & 1, fr = lane & 15, fq = lane >> 4;
    const int b = bh >> 2, h = bh & 3;
    const bf16_t* PS = (const bf16_t*)(P.ws + WS_BIG); bf16_t* Y = (bf16_t*)(P.ws + WS_XN); const bf16_t* KVB = kvb_ptr(P.ws, bh) + (size_t)n * 16384;
    const float lg2 = log2f(1.0f - exp2f(-5.0f - (float)h));
    const int row0 = b * 2048 + n * 128;
    unsigned kth[4][4];
    ret_load_qk<false>(P, QP, QP, kth, tid, row0, n, h, 0.f, 0.f);
#pragma unroll
    for (int it = 0; it < 4; ++it) { const int idx = it * 512 + tid, e = idx >> 4, d8 = (idx & 15) * 8;
        *(LAS u32x4*)(ST + e * RS + d8) = *(const u32x4*)(KVB + e * 128 + d8); }
    __syncthreads();
    f32x4 accY[2][4];
#pragma unroll
    for (int mt = 0; mt < 2; ++mt)
#pragma unroll
        for (int nt = 0; nt < 4; ++nt) accY[mt][nt] = (f32x4){0.f, 0.f, 0.f, 0.f};
#pragma unroll
    for (int ks = 0; ks < 4; ++ks) { bf16x8 aq[2];
#pragma unroll
        for (int mt = 0; mt < 2; ++mt) aq[mt] = *(const LAS bf16x8*)(QP + (wr * 32 + mt * 16 + fr) * RS + ks * 32 + fq * 8);
#pragma unroll
        for (int nt = 0; nt < 4; ++nt) { const bf16x8 bs = *(const LAS bf16x8*)(ST + (wc * 64 + nt * 16 + fr) * RS + ks * 32 + fq * 8);
#pragma unroll
            for (int mt = 0; mt < 2; ++mt) accY[mt][nt] = __builtin_amdgcn_mfma_f32_16x16x32_bf16(aq[mt], bs, accY[mt][nt], 0, 0, 0); }
        __builtin_amdgcn_sched_barrier(0); }
#pragma unroll
    for (int mt = 0; mt < 2; ++mt)
#pragma unroll
        for (int j = 0; j < 4; ++j) { const int r = wr * 32 + mt * 16 + fq * 4 + j; const float qd = exp2f(lg2 * (float)(r + 1));
#pragma unroll
            for (int nt = 0; nt < 4; ++nt) YST[r * 132 + wc * 64 + nt * 16 + fr] = accY[mt][nt][j] * qd; }
    __syncthreads();
    { const int i = tid >> 2, part = tid & 3; float yv[32]; float s = 0.f;
      bf16_t* yo = Y + (size_t)(row0 + i) * 1024 + 512 + h * 128 + part * 32;
#pragma unroll
      for (int x = 0; x < 4; ++x) { const u32x4 y1 = *(const u32x4*)(yo + x * 8); const f32x4 ta = *(const LAS f32x4*)(YST + i * 132 + part * 32 + x * 8), tb = *(const LAS f32x4*)(YST + i * 132 + part * 32 + x * 8 + 4);
          yv[x * 8 + 0] = ta[0] + lo_bf(y1.x); yv[x * 8 + 1] = ta[1] + hi_bf(y1.x); yv[x * 8 + 2] = ta[2] + lo_bf(y1.y); yv[x * 8 + 3] = ta[3] + hi_bf(y1.y);
          yv[x * 8 + 4] = tb[0] + lo_bf(y1.z); yv[x * 8 + 5] = tb[1] + hi_bf(y1.z); yv[x * 8 + 6] = tb[2] + lo_bf(y1.w); yv[x * 8 + 7] = tb[3] + hi_bf(y1.w); }
#pragma unroll
      for (int x = 0; x < 32; ++x) s += yv[x];
      s = quad_sum(s); const float mean = s * (1.0f / 128.0f); float s2 = 0.f;
#pragma unroll
      for (int x = 0; x < 32; ++x) { yv[x] -= mean; s2 += yv[x] * yv[x]; }
      s2 = quad_sum(s2); const float rstd = rsqrtf(s2 * (1.0f / 128.0f) + 1e-5f);
      const bf16_t* gp = PS + (size_t)(row0 + i) * NCOLS + 1792 + 1536 + h * 128 + part * 32; const float* gw = P.gn_w + h * 128 + part * 32;
#pragma unroll
      for (int x = 0; x < 4; ++x) { const u32x4 g4 = *(const u32x4*)(gp + x * 8); const float4 w0 = *(const float4*)(gw + x * 8), w1 = *(const float4*)(gw + x * 8 + 4);
          const float gg[8] = {lo_bf(g4.x), hi_bf(g4.x), lo_bf(g4.y), hi_bf(g4.y), lo_bf(g4.z), hi_bf(g4.z), lo_bf(g4.w), hi_bf(g4.w)}; const float ww[8] = {w0.x, w0.y, w0.z, w0.w, w1.x, w1.y, w1.z, w1.w};
          float o[8];
#pragma unroll
          for (int z = 0; z < 8; ++z) o[z] = yv[x * 8 + z] * rstd * ww[z] * (gg[z] / (1.0f + __expf(-gg[z])));
          u32x4 w; w.x = pg8::cvt_pk_bf16(o[0], o[1]); w.y = pg8::cvt_pk_bf16(o[2], o[3]); w.z = pg8::cvt_pk_bf16(o[4], o[5]); w.w = pg8::cvt_pk_bf16(o[6], o[7]);
          *(u32x4*)(yo + x * 8) = w; } }
    __syncthreads();
}

__device__ __forceinline__ void sub_barrier(unsigned* cnt, const unsigned target, const int wv) {
    asm volatile("s_waitcnt vmcnt(0)" ::: "memory");
    __syncthreads();
    if (fresh_tid(wv) == 0) {
        __builtin_amdgcn_fence(__ATOMIC_RELEASE, "agent");
        asm volatile("s_waitcnt vmcnt(0)" ::: "memory");
        (void)xb_add(cnt, 1u);
        unsigned sp = 0u;
        while (xb_ld(cnt) < target) { __builtin_amdgcn_s_sleep(2); if (++sp > (1u << 20)) break; }
        __builtin_amdgcn_fence(__ATOMIC_ACQUIRE, "agent");
        asm volatile("s_waitcnt vmcnt(0)" ::: "memory");
    }
    __syncthreads();
}

__device__ __forceinline__ void rwkv_post(PR P, const int wv) {
    const int tid = fresh_tid(wv); const int lane = tid & 63; const int gw = blockIdx.x * 8 + (tid >> 6), nw = gridDim.x * 8;
    const int sub = lane >> 4, cg4 = (lane & 15) * 4;
    const bf16_t* PS = (const bf16_t*)(P.ws + WS_BIG); const bf16_t* ASIG = (const bf16_t*)(P.ws + WS_ASIG); const bf16_t* YS = (const bf16_t*)(P.ws + WS_YS);
    const bf16_t* G = (const bf16_t*)(P.ws + WS_WIN); bf16_t* Y = (bf16_t*)(P.ws + WS_XN);
    for (int task = gw; task < MT * 2; task += nw) {
        const int item = task * 4 + sub, row = item >> 3, h = item & 7, ch = h * 64 + cg4;
        const u32x2 yr = *(const u32x2*)(YS + (size_t)row * 512 + ch);
        const bf16_t* cp = PS + (size_t)row * NCOLS + ch; const int pr = prev_row(row);
        const u32x2 c_r = *(const u32x2*)cp, c_k = *(const u32x2*)(cp + 512), c_v = *(const u32x2*)(cp + 1024);
        u32x2 p_r = (u32x2){0u, 0u}, p_k = p_r, p_v = p_r;
        if (pr >= 0) { const bf16_t* pp = PS + (size_t)pr * NCOLS + ch; p_r = *(const u32x2*)pp; p_k = *(const u32x2*)(pp + 512); p_v = *(const u32x2*)(pp + 1024); }
        const u32x2 ar = *(const u32x2*)(ASIG + (size_t)row * 512 + ch), gr = *(const u32x2*)(G + (size_t)row * 512 + ch);
        const float4 mr = *(const float4*)(P.mu + ch), mk = *(const float4*)(P.mu + 512 + ch), mv = *(const float4*)(P.mu + 1024 + ch);
        const float4 ka = *(const float4*)(P.k_a + ch), rk = *(const float4*)(P.r_k + ch), lw = *(const float4*)(P.lnx_w + ch), lb = *(const float4*)(P.lnx_b + ch);
        const float ys[4] = {lo_bf(yr.x), hi_bf(yr.x), lo_bf(yr.y), hi_bf(yr.y)};
        const float mean = row16_sum(ys[0] + ys[1] + ys[2] + ys[3]) * (1.0f / 64.0f);
        float dl[4], s2 = 0.f;
#pragma unroll
        for (int j = 0; j < 4; ++j) { dl[j] = ys[j] - mean; s2 += dl[j] * dl[j]; }
        const float rstd = rsqrtf(row16_sum(s2) * (1.0f / 64.0f) + 64e-5f);
        const float cr[4] = {lo_bf(c_r.x), hi_bf(c_r.x), lo_bf(c_r.y), hi_bf(c_r.y)}, ck[4] = {lo_bf(c_k.x), hi_bf(c_k.x), lo_bf(c_k.y), hi_bf(c_k.y)}, cv[4] = {lo_bf(c_v.x), hi_bf(c_v.x), lo_bf(c_v.y), hi_bf(c_v.y)};
        const float qr[4] = {lo_bf(p_r.x), hi_bf(p_r.x), lo_bf(p_r.y), hi_bf(p_r.y)}, qk[4] = {lo_bf(p_k.x), hi_bf(p_k.x), lo_bf(p_k.y), hi_bf(p_k.y)}, qv[4] = {lo_bf(p_v.x), hi_bf(p_v.x), lo_bf(p_v.y), hi_bf(p_v.y)};
        const float aa[4] = {lo_bf(ar.x), hi_bf(ar.x), lo_bf(ar.y), hi_bf(ar.y)}, gg[4] = {lo_bf(gr.x), hi_bf(gr.x), lo_bf(gr.y), hi_bf(gr.y)};
        const float m_r[4] = {mr.x, mr.y, mr.z, mr.w}, m_k[4] = {mk.x, mk.y, mk.z, mk.w}, m_v[4] = {mv.x, mv.y, mv.z, mv.w};
        const float kaa[4] = {ka.x, ka.y, ka.z, ka.w}, rkk[4] = {rk.x, rk.y, rk.z, rk.w}, lww[4] = {lw.x, lw.y, lw.z, lw.w}, lbb[4] = {lb.x, lb.y, lb.z, lb.w};
        float v[4], bp = 0.f;
#pragma unroll
        for (int j = 0; j < 4; ++j) { const float r = cr[j] + (qr[j] - cr[j]) * m_r[j], k = ck[j] + (qk[j] - ck[j]) * m_k[j]; v[j] = cv[j] + (qv[j] - cv[j]) * m_v[j];
            const float kn = k * (1.0f + (aa[j] - 1.0f) * kaa[j]); bp += r * kn * rkk[j]; }
        const float bonus = row16_sum(bp);
        float o[4];
#pragma unroll
        for (int j = 0; j < 4; ++j) o[j] = (dl[j] * rstd * lww[j] + lbb[j] + bonus * v[j]) * gg[j];
        u32x2 w; w.x = pg8::cvt_pk_bf16(o[0], o[1]); w.y = pg8::cvt_pk_bf16(o[2], o[3]);
        *(u32x2*)(Y + (size_t)row * 1024 + ch) = w;
    }
}

__global__ void __launch_bounds__(512, 2) hymba_mega(Params P_unused) {
    extern __shared__ __attribute__((aligned(16))) unsigned char shm[];
    cg::grid_group grid = cg::this_grid();
    LAS unsigned char* lds = (LAS unsigned char*)shm; LAS float* ldsf = (LAS float*)shm;
    const int G = gridDim.x, bx = blockIdx.x;
    const int wv = __builtin_amdgcn_readfirstlane(threadIdx.x >> 6);
    const CAS Params* kp = (const CAS Params*)__builtin_amdgcn_kernarg_segment_ptr();
#define P (*kp)
#define FRESH() asm volatile("" : "+s"(kp))
#ifndef REP_SYNC
#define REP_SYNC 1
#endif
#ifndef REP_P7
#define REP_P7 1
#endif
#ifndef REP_FFN1
#define REP_FFN1 1
#endif
#ifndef REP_RW
#define REP_RW 1
#endif
#ifndef REP_OTH
#define REP_OTH 1
#endif
#ifndef REP_RETP
#define REP_RETP 1
#endif
#ifndef REP_SAMP
#define REP_SAMP 1
#endif
#ifndef REP_P8
#define REP_P8 1
#endif
#define GSYNC() do { for (int r_ = 0; r_ < REP_SYNC; ++r_) xcd_barrier((unsigned*)ws, (volatile LAS unsigned*)(lds + LDS_BYTES - 16), wv); FRESH(); } while (0)
#define ws (kp->ws)
#define XN ((bf16_t*)(ws + WS_XN))
#define ACT ((bf16_t*)(ws + WS_BIG))
#define FO ((float*)(ws + WS_FO))
#define PS ((bf16_t*)(ws + WS_BIG))
    pg8::StaticOrder S;
    { unsigned* barw = (unsigned*)ws; const int t0 = fresh_tid(wv); if (bx == 0) for (int i = t0; i < XCD_BAR_WORDS + 128; i += 512) barw[i] = 0u;
      if (t0 < 4) ((LAS unsigned*)(lds + LDS_BYTES - 16))[t0] = 0u; }
#ifndef PHM
#define PHM 0xFFFF
#endif
#define PH(k) if ((PHM >> (k)) & 1)
    PH(0) p0_prologue(P, ldsf, wv);
    grid.sync(); FRESH();
    if (fresh_tid(wv) == 0) (void)xb_add(&((unsigned*)ws)[XB_XCNT(xb_xcc_id())], 1u);
    for (int rep1 = 0; rep1 < REP_FFN1; ++rep1) {
    PH(1) { pg8::Gemm g{XN, (const bf16_t*)(ws + WS_WGU), MT, NGU, 1024}; S.init(MT, NGU, G, bx, 1024); pg8::EpiSwiGLU E{ACT, DFF}; pg8::gemm_phase(lds, g, S, E, wv); }
    GSYNC();
    PH(2) { pg8::Gemm g{ACT, (const bf16_t*)(ws + WS_WD), MT, 1024, DFF}; pg8::SplitOrder S2; S2.init2(G, bx, DFF, 8); pg8::EpiF32 E{FO, 1024, (float*)(ws + WS_OMD)}; pg8::gemm_phase(lds, g, S2, E, wv); }
    GSYNC();
    }
    PH(3) rows_phase(P, 1, wv);
    GSYNC();
    PH(4) { pg8::Gemm g{XN, (const bf16_t*)(ws + WS_WIN), MIN_, NCOLS, 1024}; S.init(MIN_, NCOLS, G, bx, 1024); pg8::EpiBf16 E{PS, NCOLS}; pg8::gemm_phase(lds, g, S, E, wv); }
    GSYNC();
    PH(5) lora_prep(P, wv);
    GSYNC();
    PH(6) { pg8::Gemm g{(const bf16_t*)(ws + WS_LA), (const bf16_t*)(ws + WS_WL), MT, 1536, 256}; S.init(MT, 1536, G, bx, 256);
      pg8::EpiLora E{(bf16_t*)(ws + WS_OMD), (bf16_t*)(ws + WS_ASIG), (bf16_t*)(ws + WS_WIN), P.w0, P.a0}; pg8::gemm_phase(lds, g, S, E, wv); }
    GSYNC();
    {
    if (bx < 128) { for (int rw = 0; rw < REP_RW; ++rw) rwkv_unit<false>(P, ldsf, bx >> 4, (bx >> 1) & 7, bx & 1, wv); }
    else for (int rep7 = 0; rep7 < REP_OTH; ++rep7) { const int ob = bx - 128; unsigned* sbc = (unsigned*)ws + XCD_BAR_WORDS + 64;
        for (int k = 0; k < 4; ++k) { const int u = ob + k * 128; ret_unit_a(P, lds, u >> 4, u & 15, wv); }
        sub_barrier(sbc, 128u * (2u * rep7 + 1u), wv);
        ret_prefix(P, ob * 512 + fresh_tid(wv));
        sub_barrier(sbc, 128u * (2u * rep7 + 2u), wv);
        for (int k = 0; k < 4; ++k) { const int u = ob + k * 128; ret_unit_c(P, lds, u >> 4, u & 15, wv); }
        for (int u = ob; u < 2560; u += 128) { if (u < 2048) rwkv_unit<true>(P, ldsf, u >> 4, (u >> 1) & 7, u & 1, wv); else ret_sample_unit(P, ldsf, (u - 2048) >> 2, (u - 2048) & 3, wv); }
    }
    }
    GSYNC();
    for (int rep8 = 0; rep8 < REP_P8; ++rep8) PH(8) rwkv_post(P, wv);
    GSYNC();
    PH(9) { pg8::Gemm g{XN, (const bf16_t*)(ws + WS_WOUT), MT, 1024, 1024}; pg8::SplitOrder S2; S2.init2(G, bx, 1024, 4); pg8::EpiF32 E{FO, 1024, (float*)(ws + WS_OMD)}; pg8::gemm_phase(lds, g, S2, E, wv); }
    GSYNC();
    PH(10) { ffn_weights(P.f2g, P.f2u, P.f2d, ws, ldsf, wv);
    rows_phase(P, 2, wv); }
    GSYNC();
    PH(11) { pg8::Gemm g{XN, (const bf16_t*)(ws + WS_WGU), MT, NGU, 1024}; S.init(MT, NGU, G, bx, 1024); pg8::EpiSwiGLU E{ACT, DFF}; pg8::gemm_phase(lds, g, S, E, wv); }
    GSYNC();
    PH(12) { pg8::Gemm g{ACT, (const bf16_t*)(ws + WS_WD), MT, 1024, DFF}; pg8::SplitOrder S2; S2.init2(G, bx, DFF, 8); pg8::EpiF32 E{FO, 1024, (float*)(ws + WS_OMD)}; pg8::gemm_phase(lds, g, S2, E, wv); }
    GSYNC();
    PH(13) rows_phase(P, 3, wv);
}

#undef ws
#undef XN
#undef ACT
#undef FO
#undef PS
#undef P
extern "C" void kernel_launch(void* const* d_in, const int* in_sizes, int n_in, void* d_out, int out_size, void* d_ws, size_t ws_size, hipStream_t stream) {
    static int grid = 0;
    if (grid == 0) {
        if (n_in != 26 || ws_size < WS_END) { fprintf(stderr, "kernel_launch: unexpected n_in %d or ws_size %zu (< %zu)\n", n_in, ws_size, (size_t)WS_END); grid = -1; return; }
        int dev = 0, cus = 0, per_cu = 0;
        hipGetDevice(&dev); hipDeviceGetAttribute(&cus, hipDeviceAttributeMultiprocessorCount, dev);
        hipFuncSetAttribute((const void*)hymba_mega, hipFuncAttributeMaxDynamicSharedMemorySize, LDS_BYTES);
        hipOccupancyMaxActiveBlocksPerMultiprocessor(&per_cu, (const void*)hymba_mega, 512, LDS_BYTES);
        if (per_cu < 1) { fprintf(stderr, "kernel_launch: occupancy query says %d blocks/CU\n", per_cu); per_cu = 1; }
        grid = cus * per_cu; if (grid > 256) grid = 256;
        if (grid != 256) { fprintf(stderr, "kernel_launch: this kernel needs 256 co-resident workgroups, got %d\n", grid); grid = -1; return; }
        fprintf(stderr, "kernel_launch: cus %d per_cu %d grid %d ws %zu\n", cus, per_cu, grid, ws_size);
    }
    if (grid < 0) return;
    Params p{};
    const float** pp = (const float**)&p;
    for (int i = 0; i < 26; ++i) pp[i] = (const float*)d_in[i];
    p.out = (float*)d_out; p.ws = (unsigned char*)d_ws;
    void* args[] = {&p};
    hipError_t e = hipLaunchCooperativeKernel((const void*)hymba_mega, dim3(grid), dim3(512), args, LDS_BYTES, stream);
    if (e != hipSuccess) fprintf(stderr, "cooperative launch failed: %s (grid %d)\n", hipGetErrorString(e), grid);
}
```

```cpp
#include <hip/hip_runtime.h>
#include <hip/hip_cooperative_groups.h>
#include <cstdio>
#include <cstdint>
namespace cg = cooperative_groups;

__device__ __forceinline__ int fresh_tid(int wv) { int l; asm volatile("v_mbcnt_lo_u32_b32 %0, -1, 0\n\tv_mbcnt_hi_u32_b32 %0, -1, %0" : "=v"(l)); return wv * 64 + l; }
namespace pg8 {
#define PG8_LAS __attribute__((address_space(3)))
typedef unsigned short bf16_t;
typedef short bf16x8 __attribute__((ext_vector_type(8)));
typedef float f32x4 __attribute__((ext_vector_type(4)));
typedef unsigned u32x4 __attribute__((ext_vector_type(4)));
typedef unsigned u32x2 __attribute__((ext_vector_type(2)));
constexpr int BM = 256, BK = 64, HALF = 128, HTB = HALF * BK * 2, STAGE_BYTES = 8 * HTB, NXCD = 8, WGM = 8;

__host__ __device__ __forceinline__ int lds_byte(int r, int c) { const int st = (r >> 4) * 2 + (c >> 5), rr = r & 15, cc = c & 31, ob = rr * 64 + cc * 2; return st * 1024 + (ob ^ (((ob >> 9) & 1) << 5)); }
__host__ __device__ __forceinline__ void stage_rc(int b, int& R, int& C) { const int st = b / 1024, sb = b % 1024, swz = sb ^ (((sb >> 9) & 1) << 5); R = (st >> 1) * 16 + swz / 64; C = (st & 1) * 32 + (swz % 64) / 2; }
__host__ __device__ __forceinline__ int perm32(int rho) { const int n = rho >> 4, i = rho & 15; return 8 * (i >> 2) + 4 * n + (i & 3); }

struct Unit { int pm, pn, k0, nkt, atomic; };
struct Gemm { const bf16_t* A; const bf16_t* Bt; int M, N, K; };

struct StaticOrder {
    int nM, nN, nwg, G, c, nt;
    __host__ __device__ void init(int M, int N, int G_, int c_, int K) { nM = M / BM; nN = N / BM; nwg = nM * nN; G = G_; c = c_; nt = K / BK; }
    __host__ __device__ bool next(int i, Unit& u) const {
        const long L = (long)i * G + c; if (L >= nwg) return false;
        int wgid = (int)L; { const int q = nwg / NXCD, r = nwg % NXCD, xcd = wgid % NXCD, off = wgid / NXCD; wgid = (xcd < r ? xcd * (q + 1) : r * (q + 1) + (xcd - r) * q) + off; }
        const int nig = WGM * nN, gid = wgid / nig, fm = gid * WGM, gsz = (nM - fm) < WGM ? (nM - fm) : WGM;
        u.pm = fm + ((wgid % nig) % gsz); u.pn = (wgid % nig) / gsz; u.k0 = 0; u.nkt = nt; u.atomic = 0; return true;
    }
    __device__ __forceinline__ void a_ready(const Unit&) const {}
    __device__ __forceinline__ void done(const Unit&) const {}
};
struct SplitOrder : StaticOrder {
    int KS;
    __host__ __device__ void init2(int G_, int c_, int K, int KS_) { init(16384, 1024, G_, c_, K); KS = KS_; }
    __host__ __device__ bool next(int i, Unit& u) const {
        if (i == 0) return StaticOrder::next(0, u);
        if (i > 1 || c >= 8 * KS) return false;
        const int tile = c / KS, part = c % KS, pairs = nt / 2, q = pairs / KS, r = pairs % KS;
        u.pm = 64 + (tile >> 2); u.pn = tile & 3; u.k0 = 2 * (part * q + (part < r ? part : r)); u.nkt = 2 * (q + (part < r ? 1 : 0)); u.atomic = 1 + c; return true;
    }
};

__device__ __forceinline__ unsigned cvt_pk_bf16(float lo, float hi) { unsigned r; asm volatile("v_cvt_pk_bf16_f32 %0, %1, %2" : "=v"(r) : "v"(lo), "v"(hi)); return r; }

struct EpiF32 {
    static constexpr bool PERM = false;
    float* C; int ldc; float* slab;
    __device__ __forceinline__ void operator()(const f32x4 (&acc)[2][2][4][2], const Unit& u, int wr, int wc, int fr, int fq) const {
        const bool sp = u.atomic != 0;
        const int row0 = (sp ? 0 : u.pm * BM) + wr * 64 + fr, col0 = (sp ? 0 : u.pn * BM) + wc * 32 + 4 * fq; const int ld = sp ? BM : ldc;
        float* base = sp ? slab + (size_t)(u.atomic - 1) * (BM * BM) : C;
#pragma unroll
        for (int ai = 0; ai < 2; ++ai)
#pragma unroll
            for (int m = 0; m < 4; ++m) { float* rowp = base + (size_t)(row0 + ai * HALF + m * 16) * ld + col0;
#pragma unroll
                for (int bj = 0; bj < 2; ++bj)
#pragma unroll
                    for (int n = 0; n < 2; ++n) *(f32x4*)(rowp + bj * HALF + n * 16) = acc[ai][bj][m][n]; }
    }
};
struct EpiBf16 {
    static constexpr bool PERM = true;
    bf16_t* O; int ldc;
    __device__ __forceinline__ void operator()(const f32x4 (&acc)[2][2][4][2], const Unit& u, int wr, int wc, int fr, int fq) const {
        const int row0 = u.pm * BM + wr * 64 + fr; const int col0 = u.pn * BM + wc * 32 + 8 * fq;
#pragma unroll
        for (int ai = 0; ai < 2; ++ai)
#pragma unroll
            for (int m = 0; m < 4; ++m) { bf16_t* rowp = O + (size_t)(row0 + ai * HALF + m * 16) * ldc + col0;
#pragma unroll
                for (int bj = 0; bj < 2; ++bj) { const f32x4 v0 = acc[ai][bj][m][0], v1 = acc[ai][bj][m][1];
                    u32x4 w; w.x = cvt_pk_bf16(v0[0], v0[1]); w.y = cvt_pk_bf16(v0[2], v0[3]); w.z = cvt_pk_bf16(v1[0], v1[1]); w.w = cvt_pk_bf16(v1[2], v1[3]);
                    *(u32x4*)(rowp + bj * HALF) = w; } }
    }
};
__device__ __forceinline__ float silu_f(float x) { return x / (1.0f + __expf(-x)); }
struct EpiSwiGLU {
    static constexpr bool PERM = true;
    bf16_t* O; int ldc;
    __device__ __forceinline__ void operator()(const f32x4 (&acc)[2][2][4][2], const Unit& u, int wr, int wc, int fr, int fq) const {
        const int row0 = u.pm * BM + wr * 64 + fr; const int col0 = u.pn * HALF + wc * 32 + 8 * fq;
#pragma unroll
        for (int ai = 0; ai < 2; ++ai)
#pragma unroll
            for (int m = 0; m < 4; ++m) { bf16_t* rowp = O + (size_t)(row0 + ai * HALF + m * 16) * ldc + col0;
                float o[8];
#pragma unroll
                for (int n = 0; n < 2; ++n)
#pragma unroll
                    for (int j = 0; j < 4; ++j) o[n * 4 + j] = silu_f(acc[ai][0][m][n][j]) * acc[ai][1][m][n][j];
                u32x4 w; w.x = cvt_pk_bf16(o[0], o[1]); w.y = cvt_pk_bf16(o[2], o[3]); w.z = cvt_pk_bf16(o[4], o[5]); w.w = cvt_pk_bf16(o[6], o[7]);
                *(u32x4*)rowp = w; }
    }
};
struct EpiLora {
    static constexpr bool PERM = true;
    bf16_t* OMD; bf16_t* ASIG; bf16_t* G; const float* w0; const float* a0;
    template <int KIND> __device__ __forceinline__ void body(const f32x4 (&acc)[2][2][4][2], bf16_t* O, const float* bias, int row0, int ch0) const {
#pragma unroll
        for (int bj = 0; bj < 2; ++bj)
#pragma unroll
            for (int ai = 0; ai < 2; ++ai)
#pragma unroll
                for (int m = 0; m < 4; ++m) { bf16_t* rowp = O + (size_t)(row0 + ai * HALF + m * 16) * 512 + ch0 + bj * HALF;
                    float o[8];
#pragma unroll
                    for (int n = 0; n < 2; ++n)
#pragma unroll
                        for (int j = 0; j < 4; ++j) { float v = acc[ai][bj][m][n][j];
                            if (KIND == 0) { v += bias[ch0 + bj * HALF + n * 4 + j]; const float nv = -v; const float sp = fmaxf(nv, 0.f) + __logf(1.0f + __expf(-fabsf(nv)));
                                const float e = __expf(-sp - 0.5f);
                                float p = 1.0f / 40320.0f; p = -1.0f / 5040.0f + e * p; p = 1.0f / 720.0f + e * p; p = -1.0f / 120.0f + e * p; p = 1.0f / 24.0f + e * p; p = -1.0f / 6.0f + e * p; p = 0.5f + e * p; p = 1.0f - e * p;
                                v = e * p; }
                            else if (KIND == 1) { v += bias[ch0 + bj * HALF + n * 4 + j]; v = 1.0f / (1.0f + __expf(-v)); }
                            o[n * 4 + j] = v; }
                    u32x4 w; w.x = cvt_pk_bf16(o[0], o[1]); w.y = cvt_pk_bf16(o[2], o[3]); w.z = cvt_pk_bf16(o[4], o[5]); w.w = cvt_pk_bf16(o[6], o[7]);
                    *(u32x4*)rowp = w; __builtin_amdgcn_sched_barrier(0); }
    }
    __device__ __forceinline__ void operator()(const f32x4 (&acc)[2][2][4][2], const Unit& u, int wr, int wc, int fr, int fq) const {
        const int kind = u.pn >> 1;
        const int row0 = u.pm * BM + wr * 64 + fr; const int ch0 = (u.pn & 1) * BM + wc * 32 + 8 * fq;
        if (kind == 0) body<0>(acc, OMD, w0, row0, ch0); else if (kind == 1) body<1>(acc, ASIG, a0, row0, ch0); else body<2>(acc, G, a0, row0, ch0);
    }
};

template <class Epi, class Sched>
__device__ __forceinline__ void gemm_phase(PG8_LAS unsigned char* lds, const Gemm g, const Sched& S, const Epi& E, const int wv) {
    const int tid = fresh_tid(wv), wid = __builtin_amdgcn_readfirstlane(tid >> 6), lane = tid & 63, wr = wid >> 2, wc = wid & 3, fr = lane & 15, fq = lane >> 4;
    const int K = g.K;
    unsigned voffA[2], voffB[2];
#pragma unroll
    for (int i = 0; i < 2; ++i) { int R, C; stage_rc(tid * 16 + i * 8192, R, C); const int Rb = Epi::PERM ? ((R & ~31) + perm32(R & 31)) : R;
        voffA[i] = (unsigned)(R * K + C) * 2u; voffB[i] = (unsigned)(Rb * K + C) * 2u; }
    const size_t kstep = (size_t)(BK * 2);
    const size_t hstep = (size_t)HALF * K * 2;
    const size_t tstep = 2 * hstep;
    const unsigned ldsw = (unsigned)wid * 1024u;
    const int aoff = lds_byte(wr * 64 + fr, fq * 8), boff = lds_byte(wc * 32 + fr, fq * 8);
#define PG8_SA(b, h) (((b) * 2 + (h)) * HTB)
#define PG8_SB(b, h) ((4 + (b) * 2 + (h)) * HTB)
#define PG8_STAGE(bufoff, gbase, voff) do { _Pragma("unroll") for (int _i = 0; _i < 2; ++_i) \
        __builtin_amdgcn_global_load_lds((const unsigned*)((const char*)(gbase) + (voff)[_i]), (PG8_LAS unsigned*)(lds + (bufoff) + ldsw + _i * 8192), 16, 0, 0); } while (0)
#define PG8_LDA(dst, b, h) do { _Pragma("unroll") for (int m = 0; m < 4; ++m) _Pragma("unroll") for (int k = 0; k < 2; ++k) dst[m][k] = *(const PG8_LAS bf16x8*)(lds + PG8_SA(b, h) + aoff + m * 2048 + k * 1024); } while (0)
#define PG8_LDB(dst, b, h) do { _Pragma("unroll") for (int n = 0; n < 2; ++n) _Pragma("unroll") for (int k = 0; k < 2; ++k) dst[n][k] = *(const PG8_LAS bf16x8*)(lds + PG8_SB(b, h) + boff + n * 2048 + k * 1024); } while (0)
#define PG8_MMA(ai, bj, At, Bt) do { __builtin_amdgcn_s_setprio(1); _Pragma("unroll") for (int m = 0; m < 4; ++m) _Pragma("unroll") for (int n = 0; n < 2; ++n) _Pragma("unroll") for (int k = 0; k < 2; ++k) \
        acc[ai][bj][m][n] = __builtin_amdgcn_mfma_f32_16x16x32_bf16(Bt[n][k], At[m][k], acc[ai][bj][m][n], 0, 0, 0); __builtin_amdgcn_s_setprio(0); } while (0)
#define PG8_WAIT_V(n) asm volatile("s_waitcnt vmcnt(" #n ")" ::: "memory")
#define PG8_WAIT_L(n) asm volatile("s_waitcnt lgkmcnt(" #n ")" ::: "memory")
#define PG8_BAR __builtin_amdgcn_s_barrier()
#define PG8_SCHED __builtin_amdgcn_sched_barrier(0)
    Unit cur, nxt; int ui = 0;
    if (!S.next(0, cur)) return;
    f32x4 acc[2][2][4][2];
#pragma unroll
    for (int a = 0; a < 2; ++a)
#pragma unroll
        for (int b = 0; b < 2; ++b)
#pragma unroll
            for (int m = 0; m < 4; ++m)
#pragma unroll
                for (int n = 0; n < 2; ++n) acc[a][b][m][n] = (f32x4){0.f, 0.f, 0.f, 0.f};
    bf16x8 At[4][2], B0[2][2], B1[2][2];
    const char* cA = (const char*)g.A + (size_t)cur.pm * tstep + (size_t)cur.k0 * kstep; const char* cB = (const char*)g.Bt + (size_t)cur.pn * tstep + (size_t)cur.k0 * kstep;
    S.a_ready(cur);
    PG8_STAGE(PG8_SB(0, 0), cB, voffB); PG8_STAGE(PG8_SA(0, 0), cA, voffA); PG8_STAGE(PG8_SB(0, 1), cB + hstep, voffB); PG8_STAGE(PG8_SA(0, 1), cA + hstep, voffA);
    if (wr == 1) PG8_BAR;
    PG8_WAIT_V(4); PG8_BAR;
    PG8_STAGE(PG8_SB(1, 0), cB + kstep, voffB); PG8_STAGE(PG8_SA(1, 0), cA + kstep, voffA); PG8_STAGE(PG8_SB(1, 1), cB + hstep + kstep, voffB);
    PG8_WAIT_V(6); PG8_BAR;
    for (;;) {
        const bool has_next = S.next(ui + 1, nxt);
        const char* nA = has_next ? (const char*)g.A + (size_t)nxt.pm * tstep + (size_t)nxt.k0 * kstep : cA; const char* nB = has_next ? (const char*)g.Bt + (size_t)nxt.pn * tstep + (size_t)nxt.k0 * kstep : cB;
        const int nt = cur.nkt;
        for (int t = 0; t < nt; t += 2) {
            const bool last = (t == nt - 2);
            const char* a1 = cA + (size_t)(t + 1) * kstep;
            const char* a2 = last ? nA : cA + (size_t)(t + 2) * kstep; const char* b2 = last ? nB : cB + (size_t)(t + 2) * kstep;
            const char* a3 = a2 + kstep; const char* b3 = b2 + kstep;
            if (last && has_next) S.a_ready(nxt);
            PG8_LDB(B0, 0, 0); PG8_SCHED; PG8_LDA(At, 0, 0); PG8_STAGE(PG8_SA(1, 1), a1 + hstep, voffA);
            PG8_WAIT_L(8); PG8_BAR; PG8_WAIT_L(0); PG8_MMA(0, 0, At, B0); PG8_BAR; PG8_SCHED;
            PG8_LDB(B1, 0, 1); PG8_STAGE(PG8_SB(0, 0), b2, voffB);
            PG8_BAR; PG8_WAIT_L(0); PG8_MMA(0, 1, At, B1); PG8_BAR;
            PG8_LDA(At, 0, 1); PG8_STAGE(PG8_SA(0, 0), a2, voffA);
            PG8_BAR; PG8_WAIT_L(0); PG8_MMA(1, 0, At, B0); PG8_BAR; PG8_SCHED;
            PG8_STAGE(PG8_SB(0, 1), b2 + hstep, voffB);
            PG8_WAIT_V(6); PG8_BAR; PG8_MMA(1, 1, At, B1); PG8_BAR;
            PG8_LDB(B0, 1, 0); PG8_SCHED; PG8_LDA(At, 1, 0); PG8_STAGE(PG8_SA(0, 1), a2 + hstep, voffA);
            PG8_WAIT_L(8); PG8_BAR; PG8_WAIT_L(0); PG8_MMA(0, 0, At, B0); PG8_BAR; PG8_SCHED;
            PG8_LDB(B1, 1, 1); PG8_STAGE(PG8_SB(1, 0), b3, voffB);
            PG8_BAR; PG8_WAIT_L(0); PG8_MMA(0, 1, At, B1); PG8_BAR;
            PG8_LDA(At, 1, 1); PG8_STAGE(PG8_SA(1, 0), a3, voffA);
            PG8_BAR; PG8_WAIT_L(0); PG8_MMA(1, 0, At, B0); PG8_BAR; PG8_SCHED;
            PG8_STAGE(PG8_SB(1, 1), b3 + hstep, voffB);
            PG8_WAIT_V(6); PG8_BAR; PG8_MMA(1, 1, At, B1); PG8_BAR;
        }
        E(acc, cur, wr, wc, fr, fq); S.done(cur);
        if (!has_next) break;
#pragma unroll
        for (int a = 0; a < 2; ++a)
#pragma unroll
            for (int b = 0; b < 2; ++b)
#pragma unroll
                for (int m = 0; m < 4; ++m)
#pragma unroll
                    for (int n = 0; n < 2; ++n) acc[a][b][m][n] = (f32x4){0.f, 0.f, 0.f, 0.f};
        cur = nxt; cA = nA; cB = nB; ++ui;
    }
    PG8_WAIT_V(0);
    if (wr == 0) PG8_BAR;
    PG8_BAR;
#undef PG8_SA
#undef PG8_SB
#undef PG8_STAGE
#undef PG8_LDA
#undef PG8_LDB
#undef PG8_MMA
#undef PG8_WAIT_V
#undef PG8_WAIT_L
#undef PG8_BAR
#undef PG8_SCHED
}
}

using pg8::bf16_t; using pg8::f32x4; using pg8::bf16x8; using pg8::u32x4; using pg8::u32x2;
#define LAS __attribute__((address_space(3)))

constexpr int D = 1024, DFF = 2816, NGU = 5632, NCOLS = 3840;
constexpr int MP = 16384, MS = 512, MT = 16896, MIN_ = 17152;
constexpr int LDS_BYTES = 147456;
constexpr size_t O_SHP = 17301504, O_WKP = O_SHP + 8192, O_RTP = O_WKP + 262144, O_SHS = O_RTP + 524288, O_WKS = O_SHS + 131072, O_RTS = O_WKS + 4194304;
constexpr size_t WS_ROPE = 16384;
constexpr size_t WS_WL   = WS_ROPE + 1050624;
constexpr size_t WS_WOUT = WS_WL + 786432;
constexpr size_t WS_WIN  = WS_WOUT + 2097152;
constexpr size_t WS_WGU  = WS_WIN + 7864320;
constexpr size_t WS_WD   = WS_WGU + 11534336;
constexpr size_t WS_XN   = WS_WD + 5767168;
constexpr size_t WS_BIG  = WS_XN + 35127296;
constexpr size_t WS_FO   = WS_BIG + 95158272;
constexpr size_t WS_YS   = WS_BIG + 131727360;
constexpr size_t WS_LA   = WS_YS + 17301504;
constexpr size_t WS_OMD  = WS_BIG + 164364288;
constexpr size_t WS_ASIG = WS_OMD + 17301504;
constexpr size_t WS_END  = WS_ASIG + 17301504;
static_assert(WS_LA + 8650752 <= WS_OMD, "mixer overlays");
static_assert(WS_END <= 268435456, "workspace");

struct Params {
    const float *x_prompt, *x_sample, *state_shift, *state_wkv, *state_ret, *norm_g, *f1g, *f1u, *f1d, *w_in, *mu, *w0, *w2, *a0, *a2, *g2, *k_k, *k_a, *r_k, *lnx_w, *lnx_b, *gn_w, *w_out, *f2g, *f2u, *f2d;
    float* out; unsigned char* ws;
};
#define CAS __attribute__((address_space(4)))
typedef const CAS Params& PR;

__device__ __forceinline__ float bf2f(unsigned b) { return __uint_as_float(b << 16); }
__device__ __forceinline__ bf16_t f2bf(float f) { unsigned u = __float_as_uint(f); u += 0x7FFFu + ((u >> 16) & 1u); return (bf16_t)(u >> 16); }
__device__ __forceinline__ float lo_bf(unsigned x) { return __uint_as_float(x << 16); }
__device__ __forceinline__ float hi_bf(unsigned x) { return __uint_as_float(x & 0xffff0000u); }
template <int CTRL> __device__ __forceinline__ float dppf(float v) { return __int_as_float(__builtin_amdgcn_update_dpp(0, __float_as_int(v), CTRL, 0xF, 0xF, false)); }
__device__ __forceinline__ float row16_sum(float v) { v += dppf<0xB1>(v); v += dppf<0x4E>(v); v += dppf<0x141>(v); v += dppf<0x140>(v); return v; }
__device__ __forceinline__ float wave_sum(float v) { v = row16_sum(v); const int i = __float_as_int(v);
    return __int_as_float(__builtin_amdgcn_readlane(i, 0)) + __int_as_float(__builtin_amdgcn_readlane(i, 16)) + __int_as_float(__builtin_amdgcn_readlane(i, 32)) + __int_as_float(__builtin_amdgcn_readlane(i, 48)); }
__device__ __forceinline__ float quad_sum(float v) { v += dppf<0xB1>(v); v += dppf<0x4E>(v); return v; }
__device__ __forceinline__ float sigmoid_f(float x) { return 1.0f / (1.0f + __expf(-x)); }


#define XB_TMO      128
#define XB_XCNT(j)  (256  + 64 * (j))
#define XB_XSUB(j)  (1280 + 64 * (j))
#define XB_XGEN(j)  (2304 + 64 * (j))
#define XB_TOP      3328
#define XB_TOPGEN   3392
#define XCD_BAR_WORDS 3456
#define XB_SPIN_CAP (1u << 18)
__device__ __forceinline__ unsigned xb_ld(unsigned* p)              { return __hip_atomic_load(p, __ATOMIC_RELAXED, __HIP_MEMORY_SCOPE_AGENT); }
__device__ __forceinline__ unsigned xb_add(unsigned* p, unsigned v) { return __hip_atomic_fetch_add(p, v, __ATOMIC_RELAXED, __HIP_MEMORY_SCOPE_AGENT); }
__device__ __forceinline__ unsigned xb_xcc_id() { return (unsigned)__builtin_amdgcn_s_getreg((3 << 11) | 20) & 0xFu; }
#define XB_SPIN(cond, bar) do { unsigned _sp = 0; while (cond) { __builtin_amdgcn_s_sleep(1); \
    if ((++_sp & 255u) == 0u) { if (xb_ld(&(bar)[XB_TMO])) break; if (_sp > XB_SPIN_CAP) { atomicAdd(&(bar)[XB_TMO], 1u); break; } } } } while (0)
struct XcdBarrier { unsigned* bar; unsigned x; volatile LAS unsigned* st; };
__device__ __forceinline__ XcdBarrier xcd_barrier_post(unsigned* bar, volatile LAS unsigned* st) {
    XcdBarrier b; b.bar = bar; b.x = xb_xcc_id(); b.st = st;
    return b;
}
__device__ __forceinline__ void xcd_barrier_complete(unsigned* bar, unsigned x, unsigned& nloc, unsigned& nx) {
    const unsigned G = gridDim.x * gridDim.y * gridDim.z;
    unsigned sum, cnt, mine, sp = 0u;
    for (;;) {
        sum = 0u; cnt = 0u; mine = 0u;
#pragma unroll
        for (unsigned j = 0; j < 16; ++j) { const unsigned c = xb_ld(&bar[XB_XCNT(j)]); sum += c; cnt += (c > 0u) ? 1u : 0u; mine = (j == x) ? c : mine; }
        if (sum == G) break;
        __builtin_amdgcn_s_sleep(1);
        if ((++sp & 255u) == 0u) { if (xb_ld(&bar[XB_TMO])) break; if (sp > XB_SPIN_CAP) { atomicAdd(&bar[XB_TMO], 1u); break; } }
    }
    nloc = mine > 0u ? mine : 1u; nx = cnt > 0u ? cnt : 1u;
}
__device__ __forceinline__ void xcd_barrier(unsigned* barw, volatile LAS unsigned* stw, const int wv) {
    XcdBarrier b; b.bar = barw; b.x = xb_xcc_id(); b.st = stw;
    asm volatile("s_waitcnt vmcnt(0)" ::: "memory");
    __syncthreads();
    if (fresh_tid(wv) == 0) {
        unsigned* bar = b.bar;
        __builtin_amdgcn_s_waitcnt(0);
        unsigned nloc = b.st[0], nx = b.st[1];
        if (nloc == 0u) { xcd_barrier_complete(bar, b.x, nloc, nx); b.st[0] = nloc; b.st[1] = nx; }
        const unsigned old = xb_add(&bar[XB_XSUB(b.x)], 1u);
        const unsigned gen = old / nloc;
        if (old + 1u == (gen + 1u) * nloc) {
            __builtin_amdgcn_fence(__ATOMIC_RELEASE, "agent");
            asm volatile("s_waitcnt vmcnt(0)" ::: "memory");
            const unsigned og = xb_add(&bar[XB_TOP], 1u);
            const unsigned tg = og / nx;
            if (og + 1u == (tg + 1u) * nx) xb_add(&bar[XB_TOPGEN], 1u);
            else XB_SPIN(xb_ld(&bar[XB_TOPGEN]) == tg, bar);
            __builtin_amdgcn_fence(__ATOMIC_ACQUIRE, "agent");
            xb_add(&bar[XB_XGEN(b.x)], 1u);
            asm volatile("s_waitcnt vmcnt(0)" ::: "memory");
        } else {
            XB_SPIN(xb_ld(&bar[XB_XGEN(b.x)]) == gen, bar);
            __builtin_amdgcn_fence(__ATOMIC_ACQUIRE, "agent");
            asm volatile("s_waitcnt vmcnt(0)" ::: "memory");
        }
    }
    __syncthreads();
}


#define DPP2(x, y, CTRL, NOP) asm volatile(NOP "\n\tv_add_f32_dpp %0, %0, %0 " CTRL " row_mask:0xf bank_mask:0xf bound_ctrl:1\n\tv_add_f32_dpp %1, %1, %1 " CTRL " row_mask:0xf bank_mask:0xf bound_ctrl:1" : "+v"(x), "+v"(y))
#define DPP4(x, y, z, w, CTRL, NOP) asm volatile(NOP "\n\tv_add_f32_dpp %0, %0, %0 " CTRL " row_mask:0xf bank_mask:0xf bound_ctrl:1\n\tv_add_f32_dpp %1, %1, %1 " CTRL " row_mask:0xf bank_mask:0xf bound_ctrl:1\n\tv_add_f32_dpp %2, %2, %2 " CTRL " row_mask:0xf bank_mask:0xf bound_ctrl:1\n\tv_add_f32_dpp %3, %3, %3 " CTRL " row_mask:0xf bank_mask:0xf bound_ctrl:1" : "+v"(x), "+v"(y), "+v"(z), "+v"(w))
#define ROW16_SUM4(x, y, z, w) do { DPP4(x, y, z, w, "quad_perm:[1,0,3,2]", "s_nop 1"); DPP4(x, y, z, w, "quad_perm:[2,3,0,1]", ""); DPP4(x, y, z, w, "row_half_mirror", ""); DPP4(x, y, z, w, "row_mirror", ""); } while (0)
#define ROW16_SUM2(x, y) do { DPP2(x, y, "quad_perm:[1,0,3,2]", "s_nop 1"); DPP2(x, y, "quad_perm:[2,3,0,1]", "s_nop 0"); DPP2(x, y, "row_half_mirror", "s_nop 0"); DPP2(x, y, "row_mirror", "s_nop 0"); } while (0)
__device__ __forceinline__ int prev_row(int r) {
    if (r < MP) return (r & 2047) == 0 ? -1 : r - 1;
    const int s = r - MP; return (s & 3) == 0 ? MT + (s >> 2) : r - 1;
}

__device__ __forceinline__ void tconv_tile(const float* __restrict__ W, int K, int N, bf16_t* __restrict__ Bt, int mode, int tile, LAS float* t, const int wv) {
    const int nkt = K / 64; const int kt = tile % nkt, nt = tile / nkt; const int k0 = kt * 64, n0 = nt * 64;
    const int brow0 = mode == 0 ? n0 : ((n0 >> 7) * 256 + (n0 & 127) + (mode == 2 ? 128 : 0));
    const int tid = fresh_tid(wv);
#pragma unroll
    for (int e = 0; e < 8; ++e) { const int idx = e * 512 + tid, r = idx >> 6, c = idx & 63; t[r * 65 + c] = W[(size_t)(k0 + r) * N + n0 + c]; }
    __syncthreads();
#pragma unroll
    for (int e = 0; e < 4; ++e) { const int idx = e * 512 + tid, n = idx >> 5, kp = idx & 31;
        const unsigned w = pg8::cvt_pk_bf16(t[(2 * kp) * 65 + n], t[(2 * kp + 1) * 65 + n]);
        *(unsigned*)(Bt + (size_t)(brow0 + n) * K + k0 + 2 * kp) = w; }
    __syncthreads();
}
__device__ __forceinline__ void ffn_weights(const float* wg, const float* wu, const float* wd, unsigned char* ws, LAS float* t, const int wv) {
    for (int i = blockIdx.x; i < 2112; i += gridDim.x) {
        if (i < 704) tconv_tile(wg, 1024, DFF, (bf16_t*)(ws + WS_WGU), 1, i, t, wv);
        else if (i < 1408) tconv_tile(wu, 1024, DFF, (bf16_t*)(ws + WS_WGU), 2, i - 704, t, wv);
        else tconv_tile(wd, DFF, 1024, (bf16_t*)(ws + WS_WD), 0, i - 1408, t, wv);
    }
}

__device__ __forceinline__ void rows_phase(PR P, const int mode, const int wv) {
    const int tid = fresh_tid(wv); const int lane = tid & 63; const int gw = blockIdx.x * 8 + (tid >> 6), nw = gridDim.x * 8;
    const float* FO = (const float*)(P.ws + WS_FO); bf16_t* XN = (bf16_t*)(P.ws + WS_XN);
    const float* gpost = P.norm_g + (mode == 1 ? 1 : (mode == 2 ? 3 : 5)) * 1024;
    const float* gnext = P.norm_g + (mode == 0 ? 0 : (mode == 1 ? 2 : 4)) * 1024;
    const float scale = mode == 2 ? 1.0f : 0.5f;
    for (int row = gw; row < MT; row += nw) {
        const float* xin = mode <= 1 ? (row < MP ? P.x_prompt + (size_t)row * 1024 : P.x_sample + (size_t)(row - MP) * 1024) : P.out + (size_t)row * 1024;
        float4 xv[4];
#pragma unroll
        for (int q = 0; q < 4; ++q) xv[q] = *(const float4*)(xin + (q * 64 + lane) * 4);
        if (mode != 0) {
            float4 fo[4]; float ss = 0.f;
#pragma unroll
            for (int q = 0; q < 4; ++q) {
                if (row < MP) fo[q] = *(const float4*)(FO + (size_t)row * 1024 + (q * 64 + lane) * 4);
                else {
                    const int KS = mode == 2 ? 4 : 8; const float* sl = (const float*)(P.ws + WS_OMD) + (size_t)((((row - MP) >> 8) * 4 + q) * KS) * 65536 + (size_t)(row & 255) * 256 + lane * 4;
                    float4 a = *(const float4*)sl;
                    for (int p = 1; p < KS; ++p) { const float4 b = *(const float4*)(sl + (size_t)p * 65536); a.x += b.x; a.y += b.y; a.z += b.z; a.w += b.w; }
                    fo[q] = a; }
                ss += fo[q].x * fo[q].x + fo[q].y * fo[q].y + fo[q].z * fo[q].z + fo[q].w * fo[q].w; }
            ss = wave_sum(ss); const float r = rsqrtf(ss * (1.0f / 1024.0f) + 1e-6f) * scale;
#pragma unroll
            for (int q = 0; q < 4; ++q) { const float4 g = *(const float4*)(gpost + (q * 64 + lane) * 4);
                xv[q].x += fo[q].x * r * g.x; xv[q].y += fo[q].y * r * g.y; xv[q].z += fo[q].z * r * g.z; xv[q].w += fo[q].w * r * g.w;
                *(float4*)(P.out + (size_t)row * 1024 + (q * 64 + lane) * 4) = xv[q]; }
            if (mode == 3) continue;
        }
        float ss2 = 0.f;
#pragma unroll
        for (int q = 0; q < 4; ++q) ss2 += xv[q].x * xv[q].x + xv[q].y * xv[q].y + xv[q].z * xv[q].z + xv[q].w * xv[q].w;
        ss2 = wave_sum(ss2); const float r2 = rsqrtf(ss2 * (1.0f / 1024.0f) + 1e-6f);
        float* sh = nullptr;
        if (mode == 1) { if (row < MP) { if ((row & 2047) == 2047) sh = P.out + O_SHP + (size_t)(row >> 11) * 1024; } else { const int s = row - MP; if ((s & 3) == 3) sh = P.out + O_SHS + (size_t)(s >> 2) * 1024; } }
#pragma unroll
        for (int q = 0; q < 4; ++q) { const float4 g = *(const float4*)(gnext + (q * 64 + lane) * 4);
            float4 hv; hv.x = xv[q].x * r2 * g.x; hv.y = xv[q].y * r2 * g.y; hv.z = xv[q].z * r2 * g.z; hv.w = xv[q].w * r2 * g.w;
            u32x2 w; w.x = pg8::cvt_pk_bf16(hv.x, hv.y); w.y = pg8::cvt_pk_bf16(hv.z, hv.w);
            *(u32x2*)(XN + (size_t)row * 1024 + (q * 64 + lane) * 4) = w;
            if (sh) *(float4*)(sh + (q * 64 + lane) * 4) = hv; }
    }
}

__device__ __forceinline__ void p0_prologue(PR P, LAS float* ldsf, const int wv) {
    const int tid = fresh_tid(wv); const size_t gt = (size_t)blockIdx.x * 512 + tid, nth = (size_t)gridDim.x * 512;
    { float* rc = (float*)(P.ws + WS_ROPE); float* rs = rc + 2052 * 64;
      for (size_t i = gt; i < 2052 * 64; i += nth) { const int p = (int)(i >> 6), f = (int)(i & 63); const int pos = p < 2048 ? p : 16384 + (p - 2048);
          double inv = 1.0; for (int q = 0; q < f; ++q) inv *= 0.8659643233600653;
          const double ang = (double)pos * inv; const double n = rint(ang * 0.15915494309189535); const double r = ang - n * 6.283185307179586;
          const double r2 = r * r; double s = 0.0, c = 0.0;
          for (int k = 14; k >= 0; --k) { s = s * (-r2 / (double)((2 * k + 2) * (2 * k + 3))) + 1.0; c = c * (-r2 / (double)((2 * k + 1) * (2 * k + 2))) + 1.0; }
          rc[i] = (float)c; rs[i] = (float)(s * r); } }
    { bf16_t* Wl = (bf16_t*)(P.ws + WS_WL);
      for (size_t i = gt; i < 1536 * 256; i += nth) { const int n = (int)(i >> 8), k = (int)(i & 255); float v = 0.f;
          if (n < 512) { if (k < 64) v = P.w2[k * 512 + n]; } else if (n < 1024) { if (k >= 64 && k < 128) v = P.a2[(k - 64) * 512 + (n - 512)]; } else { if (k >= 128) v = P.g2[(k - 128) * 512 + (n - 1024)]; }
          Wl[i] = f2bf(v); } }
    { bf16_t* XN = (bf16_t*)(P.ws + WS_XN);
      for (size_t i = gt; i < 256 * 1024; i += nth) { const int r = (int)(i >> 10); XN[(size_t)MT * 1024 + i] = r < 128 ? f2bf(P.state_shift[i]) : (bf16_t)0; } }
    ffn_weights(P.f1g, P.f1u, P.f1d, P.ws, ldsf, wv);
    for (int i = blockIdx.x; i < 1216; i += gridDim.x) {
        if (i < 960) tconv_tile(P.w_in, 1024, NCOLS, (bf16_t*)(P.ws + WS_WIN), 0, i, ldsf, wv);
        else tconv_tile(P.w_out, 1024, 1024, (bf16_t*)(P.ws + WS_WOUT), 0, i - 960, ldsf, wv);
    }
    rows_phase(P, 0, wv);
}

__device__ __forceinline__ void lora_prep(PR P, const int wv) {
    const int tid = fresh_tid(wv); const int lane = tid & 63; const int gw = blockIdx.x * 8 + (tid >> 6), nw = gridDim.x * 8;
    const bf16_t* PS = (const bf16_t*)(P.ws + WS_BIG); bf16_t* LA = (bf16_t*)(P.ws + WS_LA);
    const float4 mu = *(const float4*)(P.mu + 1536 + lane * 4); const int kind = lane >> 4;
    for (int row = gw; row < MT; row += nw) {
        const u32x2 c = *(const u32x2*)(PS + (size_t)row * NCOLS + 1536 + lane * 4); const int pr = prev_row(row);
        u32x2 p = (u32x2){0u, 0u}; if (pr >= 0) p = *(const u32x2*)(PS + (size_t)pr * NCOLS + 1536 + lane * 4);
        float v[4]; const float cu[4] = {lo_bf(c.x), hi_bf(c.x), lo_bf(c.y), hi_bf(c.y)}, pv[4] = {lo_bf(p.x), hi_bf(p.x), lo_bf(p.y), hi_bf(p.y)}, m4[4] = {mu.x, mu.y, mu.z, mu.w};
#pragma unroll
        for (int j = 0; j < 4; ++j) { float x = cu[j] + (pv[j] - cu[j]) * m4[j];
            if (kind == 0) x = 1.0f - 2.0f / (__expf(2.0f * x) + 1.0f); else if (kind >= 2) x = sigmoid_f(x);
            v[j] = x; }
        u32x2 w; w.x = pg8::cvt_pk_bf16(v[0], v[1]); w.y = pg8::cvt_pk_bf16(v[2], v[3]);
        *(u32x2*)(LA + (size_t)row * 256 + lane * 4) = w;
    }
}

template <bool SAMPLE>
__device__ __forceinline__ void rwkv_unit(PR P, LAS float* lds, const int b, const int h, const int half, const int wv) {
    constexpr int T = SAMPLE ? 4 : 2048, TC = SAMPLE ? 4 : 32, NCH = T / TC;
    const int tid = fresh_tid(wv), lane = tid & 63, wid = tid >> 6;
    const bf16_t* PS = (const bf16_t*)(P.ws + WS_BIG); const bf16_t* OMD = (const bf16_t*)(P.ws + WS_OMD); const bf16_t* ASIG = (const bf16_t*)(P.ws + WS_ASIG);
    bf16_t* YS = (bf16_t*)(P.ws + WS_YS);
    const int row_base = SAMPLE ? MP + b * 4 : b * 2048;
    const int ltok = tid >> 4, lcg = tid & 15; const bool lact = ltok < TC; const int hch = h * 64 + lcg * 4;
    const float4 mur = *(const float4*)(P.mu + hch), muk = *(const float4*)(P.mu + 512 + hch), muv = *(const float4*)(P.mu + 1024 + hch);
    const float4 kk4 = *(const float4*)(P.k_k + hch), ka4 = *(const float4*)(P.k_a + hch);
    typedef float f32x2 __attribute__((ext_vector_type(2)));
    const int row0 = half * 32 + (wid & 3) * 8 + (lane >> 4) * 2, cgl = lane & 15, j0 = cgl * 4;
    f32x2 S[4];
#pragma unroll
    for (int c = 0; c < 4; ++c) S[c] = (f32x2){0.f, 0.f};
    float* sout = P.out + (SAMPLE ? O_WKS : O_WKP) + ((size_t)(b * 8 + h) * 64 + row0) * 64 + j0;
    if (SAMPLE && wid < 4) { const float* sp = P.state_wkv + ((size_t)(b * 8 + h) * 64 + row0) * 64 + j0; const float4 s0 = *(const float4*)sp, s1 = *(const float4*)(sp + 64);
        S[0] = (f32x2){s0.x, s1.x}; S[1] = (f32x2){s0.y, s1.y}; S[2] = (f32x2){s0.z, s1.z}; S[3] = (f32x2){s0.w, s1.w}; }
    LAS float* buf0 = lds; LAS float* buf1 = lds + TC * 384;
    u32x2 cr, ck, cv, pr, pk, pv, co, ca;
#define RW_LOAD(c) do { if (lact) { const int t_ = (c) * TC + ltok; const int row_ = row_base + t_; const int prow_ = SAMPLE ? (t_ == 0 ? MT + b : row_ - 1) : row_ - 1; \
        const bf16_t* cp_ = PS + (size_t)row_ * NCOLS + hch; cr = *(const u32x2*)cp_; ck = *(const u32x2*)(cp_ + 512); cv = *(const u32x2*)(cp_ + 1024); \
        if (SAMPLE || t_ > 0) { const bf16_t* pp_ = PS + (size_t)prow_ * NCOLS + hch; pr = *(const u32x2*)pp_; pk = *(const u32x2*)(pp_ + 512); pv = *(const u32x2*)(pp_ + 1024); } \
        else { pr = (u32x2){0u, 0u}; pk = pr; pv = pr; } \
        co = *(const u32x2*)(OMD + (size_t)row_ * 512 + hch); ca = *(const u32x2*)(ASIG + (size_t)row_ * 512 + hch); } } while (0)
#define RW_MIX(cu, pv_, m) ((cu) + ((pv_) - (cu)) * (m))
#define RW_PROC(dst) do { if (lact) { LAS float* d_ = (dst) + ltok * 384 + lcg * 4; \
        f32x4 r_, k_, v_, o_, a_; \
        r_[0] = RW_MIX(lo_bf(cr.x), lo_bf(pr.x), mur.x); r_[1] = RW_MIX(hi_bf(cr.x), hi_bf(pr.x), mur.y); r_[2] = RW_MIX(lo_bf(cr.y), lo_bf(pr.y), mur.z); r_[3] = RW_MIX(hi_bf(cr.y), hi_bf(pr.y), mur.w); \
        k_[0] = RW_MIX(lo_bf(ck.x), lo_bf(pk.x), muk.x); k_[1] = RW_MIX(hi_bf(ck.x), hi_bf(pk.x), muk.y); k_[2] = RW_MIX(lo_bf(ck.y), lo_bf(pk.y), muk.z); k_[3] = RW_MIX(hi_bf(ck.y), hi_bf(pk.y), muk.w); \
        v_[0] = RW_MIX(lo_bf(cv.x), lo_bf(pv.x), muv.x); v_[1] = RW_MIX(hi_bf(cv.x), hi_bf(pv.x), muv.y); v_[2] = RW_MIX(lo_bf(cv.y), lo_bf(pv.y), muv.z); v_[3] = RW_MIX(hi_bf(cv.y), hi_bf(pv.y), muv.w); \
        o_[0] = lo_bf(co.x); o_[1] = hi_bf(co.x); o_[2] = lo_bf(co.y); o_[3] = hi_bf(co.y); a_[0] = lo_bf(ca.x); a_[1] = hi_bf(ca.x); a_[2] = lo_bf(ca.y); a_[3] = hi_bf(ca.y); \
        f32x4 kk_; kk_[0] = k_[0] * kk4.x; kk_[1] = k_[1] * kk4.y; kk_[2] = k_[2] * kk4.z; kk_[3] = k_[3] * kk4.w; \
        float ss_ = kk_[0] * kk_[0] + kk_[1] * kk_[1] + kk_[2] * kk_[2] + kk_[3] * kk_[3]; ss_ = row16_sum(ss_); \
        const float inv_ = 1.0f / fmaxf(sqrtf(ss_), 1e-12f); kk_ = kk_ * inv_; \
        f32x4 kn_; kn_[0] = k_[0] * (1.0f + (a_[0] - 1.0f) * ka4.x); kn_[1] = k_[1] * (1.0f + (a_[1] - 1.0f) * ka4.y); kn_[2] = k_[2] * (1.0f + (a_[2] - 1.0f) * ka4.z); kn_[3] = k_[3] * (1.0f + (a_[3] - 1.0f) * ka4.w); \
        *(LAS f32x4*)(d_) = r_; *(LAS f32x4*)(d_ + 64) = o_; *(LAS f32x4*)(d_ + 128) = kn_; *(LAS f32x4*)(d_ + 192) = -kk_; *(LAS f32x4*)(d_ + 256) = kk_ * a_; *(LAS f32x4*)(d_ + 320) = v_; } } while (0)
    RW_LOAD(0); RW_PROC(buf0); __syncthreads();
    for (int c = 0; c < NCH; ++c) {
        LAS float* cur = (c & 1) ? buf1 : buf0; LAS float* nxt = (c & 1) ? buf0 : buf1;
        if (c + 1 < NCH) RW_LOAD(c + 1);
        if (wid < 4) {
            constexpr int GS = SAMPLE ? 4 : 16;
            for (int g = 0; g < TC / GS; ++g) {
                float yk0 = 0.f, yk1 = 0.f;
                const LAS float* q0 = cur + (g * GS) * 384;
                f32x4 r4 = *(const LAS f32x4*)(q0 + j0), o4 = *(const LAS f32x4*)(q0 + 64 + j0), k4 = *(const LAS f32x4*)(q0 + 128 + j0), a4 = *(const LAS f32x4*)(q0 + 192 + j0), b4 = *(const LAS f32x4*)(q0 + 256 + j0);
                f32x2 v2 = *(const LAS f32x2*)(q0 + 320 + row0);
                float py0 = 0.f, py1 = 0.f;
#pragma unroll
                for (int tt = 0; tt < GS; ++tt) {
                    const LAS float* qn = q0 + (tt + 1 < GS ? tt + 1 : tt) * 384;
                    const f32x4 nr4 = *(const LAS f32x4*)(qn + j0), no4 = *(const LAS f32x4*)(qn + 64 + j0), nk4 = *(const LAS f32x4*)(qn + 128 + j0), na4 = *(const LAS f32x4*)(qn + 192 + j0), nb4 = *(const LAS f32x4*)(qn + 256 + j0);
                    const f32x2 nv2 = *(const LAS f32x2*)(qn + 320 + row0);
                    f32x2 sa = (S[0] * a4[0] + S[1] * a4[1]) + (S[2] * a4[2] + S[3] * a4[3]);
                    float sx = sa.x, sy = sa.y; ROW16_SUM4(sx, sy, py0, py1); sa = (f32x2){sx, sy};
                    if (tt > 0) { yk0 = cgl == tt - 1 ? py0 : yk0; yk1 = cgl == tt - 1 ? py1 : yk1; }
#pragma unroll
                    for (int c = 0; c < 4; ++c) { f32x2 t = S[c] - S[c] * o4[c]; t = t + sa * b4[c]; S[c] = t + v2 * k4[c]; }
                    const f32x2 y = (S[0] * r4[0] + S[1] * r4[1]) + (S[2] * r4[2] + S[3] * r4[3]);
                    py0 = y.x; py1 = y.y;
                    r4 = nr4; o4 = no4; k4 = nk4; a4 = na4; b4 = nb4; v2 = nv2;
                }
                ROW16_SUM2(py0, py1); yk0 = cgl == GS - 1 ? py0 : yk0; yk1 = cgl == GS - 1 ? py1 : yk1;
                if (cgl < GS) *(unsigned*)(YS + (size_t)(row_base + c * TC + g * GS + cgl) * 512 + h * 64 + row0) = pg8::cvt_pk_bf16(yk0, yk1);
            }
        }
        if (c + 1 < NCH) RW_PROC(nxt);
        __syncthreads();
    }
    if (wid < 4) { *(float4*)sout = make_float4(S[0].x, S[1].x, S[2].x, S[3].x); *(float4*)(sout + 64) = make_float4(S[0].y, S[1].y, S[2].y, S[3].y); }
#undef RW_LOAD
#undef RW_PROC
#undef RW_MIX
}

__device__ __forceinline__ void ret_sample_unit(PR P, LAS float* lds, const int b, const int h, const int wv) {
    const int tid = fresh_tid(wv), lane = tid & 63, wid = tid >> 6;
    const bf16_t* PS = (const bf16_t*)(P.ws + WS_BIG); bf16_t* Y = (bf16_t*)(P.ws + WS_XN);
    const float* rc = (const float*)(P.ws + WS_ROPE); const float* rs = rc + 2052 * 64;
    LAS float* q = lds; LAS float* k = lds + 512; LAS float* v = lds + 1024; LAS float* Pm = lds + 1536; LAS float* y2p = lds + 1600; LAS float* red = lds + 1600 + 2048;
    const float lg2 = log2f(1.0f - exp2f(-5.0f - (float)h));
    const int row0 = MP + b * 4;
    { const int t = (tid & 255) >> 6, f = tid & 63; const bf16_t* src = PS + (size_t)(row0 + t) * NCOLS + 1792 + h * 128;
      if (tid < 256) { const float cs = rc[(2048 + t) * 64 + f], sn = rs[(2048 + t) * 64 + f];
          const float q1 = bf2f(src[f]), q2 = bf2f(src[f + 64]); q[t * 128 + f] = q1 * cs - q2 * sn; q[t * 128 + f + 64] = q1 * sn + q2 * cs;
          const float k1 = bf2f(src[512 + f]), k2 = bf2f(src[512 + f + 64]); k[t * 128 + f] = (k1 * cs - k2 * sn) * 0.08838834764831845f; k[t * 128 + f + 64] = (k1 * sn + k2 * cs) * 0.08838834764831845f; }
      else { v[t * 128 + f] = bf2f(src[1024 + f]); v[t * 128 + f + 64] = bf2f(src[1024 + f + 64]); } }
    __syncthreads();
    if (wid == 0) { const int pi = lane >> 4, pj = (lane >> 2) & 3, part = lane & 3; float s = 0.f;
        for (int d = part * 32; d < part * 32 + 32; ++d) s += q[pi * 128 + d] * k[pj * 128 + d];
        s = quad_sum(s); if (part == 0) Pm[pi * 4 + pj] = pi >= pj ? s * exp2f(lg2 * (float)(pi - pj)) : 0.f; }
    { const int e = tid & 127, dg = tid >> 7; const float c4 = exp2f(lg2 * 4.0f), g3 = exp2f(lg2 * 3.0f), g2_ = exp2f(lg2 * 2.0f), g1 = exp2f(lg2);
      const float v0 = v[e] * g3, v1 = v[128 + e] * g2_, v2 = v[256 + e] * g1, v3 = v[384 + e];
      const float* S0 = P.state_ret + ((size_t)(b * 4 + h) * 128) * 128 + e; float* So = P.out + O_RTS + ((size_t)(b * 4 + h) * 128) * 128 + e;
      float a0 = 0.f, a1 = 0.f, a2 = 0.f, a3 = 0.f;
      float sv[32];
#pragma unroll
      for (int x = 0; x < 32; ++x) sv[x] = S0[(size_t)(dg * 32 + x) * 128];
#pragma unroll
      for (int x = 0; x < 32; ++x) { const int d = dg * 32 + x; const float s = sv[x];
          a0 = fmaf(q[d], s, a0); a1 = fmaf(q[128 + d], s, a1); a2 = fmaf(q[256 + d], s, a2); a3 = fmaf(q[384 + d], s, a3);
          So[(size_t)d * 128] = s * c4 + k[d] * v0 + k[128 + d] * v1 + k[256 + d] * v2 + k[384 + d] * v3; }
      y2p[(dg * 4 + 0) * 128 + e] = a0; y2p[(dg * 4 + 1) * 128 + e] = a1; y2p[(dg * 4 + 2) * 128 + e] = a2; y2p[(dg * 4 + 3) * 128 + e] = a3; }
    __syncthreads();
    { const int i = tid >> 7, e = tid & 127;
      float y = (y2p[(0 + i) * 128 + e] + y2p[(4 + i) * 128 + e] + y2p[(8 + i) * 128 + e] + y2p[(12 + i) * 128 + e]) * exp2f(lg2 * (float)(i + 1));
#pragma unroll
      for (int j = 0; j < 4; ++j) y = fmaf(Pm[i * 4 + j], v[j * 128 + e], y);
      float s = wave_sum(y); if (lane == 0) red[wid] = s; __syncthreads();
      const float mean = (red[i * 2] + red[i * 2 + 1]) * (1.0f / 128.0f); const float dlt = y - mean;
      float s2 = wave_sum(dlt * dlt); if (lane == 0) red[8 + wid] = s2; __syncthreads();
      const float var = (red[8 + i * 2] + red[8 + i * 2 + 1]) * (1.0f / 128.0f);
      const float g = bf2f(PS[(size_t)(row0 + i) * NCOLS + 1792 + 1536 + h * 128 + e]);
      const float o = dlt * rsqrtf(var + 1e-5f) * P.gn_w[h * 128 + e] * (g / (1.0f + __expf(-g)));
      Y[(size_t)(row0 + i) * 1024 + 512 + h * 128 + e] = f2bf(o); }
    __syncthreads();
}

__device__ __forceinline__ bf16_t* kvb_ptr(unsigned char* ws, int bh) { return (bf16_t*)(bh < 29 ? ws + WS_LA + (size_t)bh * 524288 : ws + WS_WIN + 17301504 + (size_t)(bh - 29) * 524288); }
constexpr int RS = 136, BUFE = 128 * RS;

template <bool WITH_K>
__device__ __forceinline__ void ret_load_qk(PR P, LAS bf16_t* QP, LAS bf16_t* KB, unsigned (&kth)[4][4], const int tidv, const int row0, const int n, const int h, const float kd0, const float g32) {
    const bf16_t* PS = (const bf16_t*)(P.ws + WS_BIG); const float* rc = (const float*)(P.ws + WS_ROPE); const float* rs = rc + 2052 * 64;
    float kd = kd0;
#pragma unroll
    for (int it = 0; it < 4; ++it) { const int idx = it * 512 + tidv, i = idx >> 4, f = (idx & 15) * 4;
        const bf16_t* src = PS + (size_t)(row0 + i) * NCOLS + 1792 + h * 128;
        const u32x2 q1 = *(const u32x2*)(src + f), q2 = *(const u32x2*)(src + 64 + f);
        u32x2 k1 = (u32x2){0u, 0u}, k2 = k1; if (WITH_K) { k1 = *(const u32x2*)(src + 512 + f); k2 = *(const u32x2*)(src + 576 + f); }
        const float4 cs = *(const float4*)(rc + (size_t)(n * 128 + i) * 64 + f), sn = *(const float4*)(rs + (size_t)(n * 128 + i) * 64 + f);
        const float c4[4] = {cs.x, cs.y, cs.z, cs.w}, s4[4] = {sn.x, sn.y, sn.z, sn.w};
        const float qa[4] = {lo_bf(q1.x), hi_bf(q1.x), lo_bf(q1.y), hi_bf(q1.y)}, qb[4] = {lo_bf(q2.x), hi_bf(q2.x), lo_bf(q2.y), hi_bf(q2.y)};
        float qo1[4], qo2[4];
#pragma unroll
        for (int x = 0; x < 4; ++x) { qo1[x] = qa[x] * c4[x] - qb[x] * s4[x]; qo2[x] = qa[x] * s4[x] + qb[x] * c4[x]; }
        u32x2 w; w.x = pg8::cvt_pk_bf16(qo1[0], qo1[1]); w.y = pg8::cvt_pk_bf16(qo1[2], qo1[3]); *(LAS u32x2*)(QP + i * RS + f) = w;
        w.x = pg8::cvt_pk_bf16(qo2[0], qo2[1]); w.y = pg8::cvt_pk_bf16(qo2[2], qo2[3]); *(LAS u32x2*)(QP + i * RS + 64 + f) = w;
        if (WITH_K) {
            const float ka[4] = {lo_bf(k1.x), hi_bf(k1.x), lo_bf(k1.y), hi_bf(k1.y)}, kb[4] = {lo_bf(k2.x), hi_bf(k2.x), lo_bf(k2.y), hi_bf(k2.y)};
            float ko1[4], ko2[4];
#pragma unroll
            for (int x = 0; x < 4; ++x) { ko1[x] = (ka[x] * c4[x] - kb[x] * s4[x]) * 0.08838834764831845f; ko2[x] = (ka[x] * s4[x] + kb[x] * c4[x]) * 0.08838834764831845f; }
            w.x = pg8::cvt_pk_bf16(ko1[0], ko1[1]); w.y = pg8::cvt_pk_bf16(ko1[2], ko1[3]); *(LAS u32x2*)(KB + i * RS + f) = w;
            w.x = pg8::cvt_pk_bf16(ko2[0], ko2[1]); w.y = pg8::cvt_pk_bf16(ko2[2], ko2[3]); *(LAS u32x2*)(KB + i * RS + 64 + f) = w;
            kth[it][0] = pg8::cvt_pk_bf16(ko1[0] * kd, ko1[1] * kd); kth[it][1] = pg8::cvt_pk_bf16(ko1[2] * kd, ko1[3] * kd);
            kth[it][2] = pg8::cvt_pk_bf16(ko2[0] * kd, ko2[1] * kd); kth[it][3] = pg8::cvt_pk_bf16(ko2[2] * kd, ko2[3] * kd); kd *= g32; }
        if (it & 1) __builtin_amdgcn_sched_barrier(0); }
}

__device__ __forceinline__ void ret_unit_a(PR P, LAS unsigned char* lds, const int bh, const int n, const int wv) {
    LAS bf16_t* QP = (LAS bf16_t*)lds; LAS bf16_t* KB = QP + BUFE; LAS bf16_t* VT = KB + BUFE;
    const int tid = fresh_tid(wv), lane = tid & 63, wid = tid >> 6, wr = wid >> 1, wc = wid & 1, fr = lane & 15, fq = lane >> 4;
    const int b = bh >> 2, h = bh & 3;
    const bf16_t* PS = (const bf16_t*)(P.ws + WS_BIG); bf16_t* Y = (bf16_t*)(P.ws + WS_XN); bf16_t* KVB = kvb_ptr(P.ws, bh) + (size_t)n * 16384;
    const float lg2 = log2f(1.0f - exp2f(-5.0f - (float)h));
    const float kd0 = exp2f(lg2 * (float)(127 - (tid >> 4))), g32 = exp2f(-32.0f * lg2);
    const int row0 = b * 2048 + n * 128;
    unsigned kth[4][4];
    ret_load_qk<true>(P, QP, KB, kth, tid, row0, n, h, kd0, g32);
#pragma unroll
    for (int it = 0; it < 4; ++it) { const int idx = it * 512 + tid, j = idx >> 4, e = (idx & 15) * 8;
        const u32x4 vv = *(const u32x4*)(PS + (size_t)(row0 + j) * NCOLS + 1792 + 1024 + h * 128 + e);
        LAS bf16_t* d = VT + e * RS + j;
        d[0] = (bf16_t)(vv.x & 0xffffu); d[RS] = (bf16_t)(vv.x >> 16); d[2 * RS] = (bf16_t)(vv.y & 0xffffu); d[3 * RS] = (bf16_t)(vv.y >> 16);
        d[4 * RS] = (bf16_t)(vv.z & 0xffffu); d[5 * RS] = (bf16_t)(vv.z >> 16); d[6 * RS] = (bf16_t)(vv.w & 0xffffu); d[7 * RS] = (bf16_t)(vv.w >> 16); }
    __syncthreads();
    f32x4 accP[2][4];
#pragma unroll
    for (int mt = 0; mt < 2; ++mt)
#pragma unroll
        for (int nt = 0; nt < 4; ++nt) accP[mt][nt] = (f32x4){0.f, 0.f, 0.f, 0.f};
#pragma unroll
    for (int ks = 0; ks < 4; ++ks) { bf16x8 aq[2];
#pragma unroll
        for (int mt = 0; mt < 2; ++mt) aq[mt] = *(const LAS bf16x8*)(QP + (wr * 32 + mt * 16 + fr) * RS + ks * 32 + fq * 8);
#pragma unroll
        for (int nt = 0; nt < 4; ++nt) { const bf16x8 bk = *(const LAS bf16x8*)(KB + (wc * 64 + nt * 16 + fr) * RS + ks * 32 + fq * 8);
#pragma unroll
            for (int mt = 0; mt < 2; ++mt) accP[mt][nt] = __builtin_amdgcn_mfma_f32_16x16x32_bf16(aq[mt], bk, accP[mt][nt], 0, 0, 0); }
        __builtin_amdgcn_sched_barrier(0); }
    __syncthreads();
    { float ri[2][4], cj[4];
#pragma unroll
      for (int mt = 0; mt < 2; ++mt)
#pragma unroll
          for (int j = 0; j < 4; ++j) ri[mt][j] = exp2f(lg2 * (float)(wr * 32 + mt * 16 + fq * 4 + j));
#pragma unroll
      for (int nt = 0; nt < 4; ++nt) cj[nt] = exp2f(-lg2 * (float)(wc * 64 + nt * 16 + fr));
#pragma unroll
      for (int mt = 0; mt < 2; ++mt)
#pragma unroll
          for (int nt = 0; nt < 4; ++nt)
#pragma unroll
              for (int j = 0; j < 4; ++j) { const int i = wr * 32 + mt * 16 + fq * 4 + j, jj = wc * 64 + nt * 16 + fr;
                  const float val = i >= jj ? accP[mt][nt][j] * ri[mt][j] * cj[nt] : 0.f; QP[i * RS + jj] = f2bf(val); } }
#pragma unroll
    for (int it = 0; it < 4; ++it) { const int idx = it * 512 + tid, j = idx >> 4, f = (idx & 15) * 4; LAS bf16_t* d = KB + f * RS + j;
        d[0] = (bf16_t)(kth[it][0] & 0xffffu); d[RS] = (bf16_t)(kth[it][0] >> 16); d[2 * RS] = (bf16_t)(kth[it][1] & 0xffffu); d[3 * RS] = (bf16_t)(kth[it][1] >> 16);
        LAS bf16_t* d2 = d + 64 * RS;
        d2[0] = (bf16_t)(kth[it][2] & 0xffffu); d2[RS] = (bf16_t)(kth[it][2] >> 16); d2[2 * RS] = (bf16_t)(kth[it][3] & 0xffffu); d2[3 * RS] = (bf16_t)(kth[it][3] >> 16); }
    __syncthreads();
    f32x4 accY[2][4], accS[2][4];
#pragma unroll
    for (int mt = 0; mt < 2; ++mt)
#pragma unroll
        for (int nt = 0; nt < 4; ++nt) { accY[mt][nt] = (f32x4){0.f, 0.f, 0.f, 0.f}; accS[mt][nt] = (f32x4){0.f, 0.f, 0.f, 0.f}; }
#pragma unroll
    for (int ks = 0; ks < 4; ++ks) { bf16x8 ap[2], av[2];
#pragma unroll
        for (int mt = 0; mt < 2; ++mt) { ap[mt] = *(const LAS bf16x8*)(QP + (wr * 32 + mt * 16 + fr) * RS + ks * 32 + fq * 8); av[mt] = *(const LAS bf16x8*)(VT + (wr * 32 + mt * 16 + fr) * RS + ks * 32 + fq * 8); }
#pragma unroll
        for (int nt = 0; nt < 4; ++nt) { const bf16x8 bv = *(const LAS bf16x8*)(VT + (wc * 64 + nt * 16 + fr) * RS + ks * 32 + fq * 8), bkt = *(const LAS bf16x8*)(KB + (wc * 64 + nt * 16 + fr) * RS + ks * 32 + fq * 8);
#pragma unroll
            for (int mt = 0; mt < 2; ++mt) { accY[mt][nt] = __builtin_amdgcn_mfma_f32_16x16x32_bf16(ap[mt], bv, accY[mt][nt], 0, 0, 0); accS[mt][nt] = __builtin_amdgcn_mfma_f32_16x16x32_bf16(av[mt], bkt, accS[mt][nt], 0, 0, 0); } }
        __builtin_amdgcn_sched_barrier(0); }
#pragma unroll
    for (int mt = 0; mt < 2; ++mt)
#pragma unroll
        for (int nt = 0; nt < 4; ++nt)
#pragma unroll
            for (int j = 0; j < 4; ++j) { const int r = wr * 32 + mt * 16 + fq * 4 + j, c = wc * 64 + nt * 16 + fr;
                Y[(size_t)(row0 + r) * 1024 + 512 + h * 128 + c] = f2bf(accY[mt][nt][j]); KVB[r * 128 + c] = f2bf(accS[mt][nt][j]); }
    __syncthreads();
}

__device__ __forceinline__ void ret_prefix(PR P, const int item) {
    const int bh = item >> 11, i8 = (item & 2047) * 8; const int h = bh & 3;
    bf16_t* KVB = kvb_ptr(P.ws, bh) + i8;
    const float lg2 = log2f(1.0f - exp2f(-5.0f - (float)h)); const float c_dec = exp2f(lg2 * 128.0f);
    u32x4 kv[16];
#pragma unroll
    for (int n = 0; n < 16; ++n) kv[n] = *(const u32x4*)(KVB + (size_t)n * 16384);
    float S[8];
#pragma unroll
    for (int x = 0; x < 8; ++x) S[x] = 0.f;
#pragma unroll
    for (int n = 0; n < 16; ++n) { u32x4 w; w.x = pg8::cvt_pk_bf16(S[0], S[1]); w.y = pg8::cvt_pk_bf16(S[2], S[3]); w.z = pg8::cvt_pk_bf16(S[4], S[5]); w.w = pg8::cvt_pk_bf16(S[6], S[7]);
        *(u32x4*)(KVB + (size_t)n * 16384) = w;
        const float k8[8] = {lo_bf(kv[n].x), hi_bf(kv[n].x), lo_bf(kv[n].y), hi_bf(kv[n].y), lo_bf(kv[n].z), hi_bf(kv[n].z), lo_bf(kv[n].w), hi_bf(kv[n].w)};
#pragma unroll
        for (int x = 0; x < 8; ++x) S[x] = S[x] * c_dec + k8[x]; }
    const int e = i8 >> 7, d0 = i8 & 127;
#pragma unroll
    for (int x = 0; x < 8; ++x) P.out[O_RTP + ((size_t)bh * 128 + d0 + x) * 128 + e] = S[x];
}

__device__ __forceinline__ void ret_unit_c(PR P, LAS unsigned char* lds, const int bh, const int n, const int wv) {
    LAS bf16_t* QP = (LAS bf16_t*)lds; LAS bf16_t* ST = QP + 3 * BUFE; LAS float* YST = (LAS float*)(QP + BUFE);
    const int tid = fresh_tid(wv), lane = tid & 63, wid = tid >> 6, wr = wid >> 1, wc = wid & 1, fr = lane & 15, fq = lane >> 4;
    const int b = bh >> 2, h = bh & 3;
    const bf16_t* PS = (const bf16_t*)(P.ws + WS_BIG); bf16_t* Y = (bf16_t*)(P.ws + WS_XN); const bf16_t* KVB = kvb_ptr(P.ws, bh) + (size_t)n * 16384;
    const float lg2 = log2f(1.0f - exp2f(-5.0f - (float)h));
    const int row0 = b * 2048 + n * 128;
    unsigned kth[4][4];
    ret_load_qk<false>(P, QP, QP, kth, tid, row0, n, h, 0.f, 0.f);
#pragma unroll
    for (int it = 0; it < 4; ++it) { const int idx = it * 512 + tid, e = idx >> 4, d8 = (idx & 15) * 8;
        *(LAS u32x4*)(ST + e * RS + d8) = *(const u32x4*)(KVB + e * 128 + d8); }
    __syncthreads();
    f32x4 accY[2][4];
#pragma unroll
    for (int mt = 0; mt < 2; ++mt)
#pragma unroll
        for (int nt = 0; nt < 4; ++nt) accY[mt][nt] = (f32x4){0.f, 0.f, 0.f, 0.f};
#pragma unroll
    for (int ks = 0; ks < 4; ++ks) { bf16x8 aq[2];
#pragma unroll
        for (int mt = 0; mt < 2; ++mt) aq[mt] = *(const LAS bf16x8*)(QP + (wr * 32 + mt * 16 + fr) * RS + ks * 32 + fq * 8);
#pragma unroll
        for (int nt = 0; nt < 4; ++nt) { const bf16x8 bs = *(const LAS bf16x8*)(ST + (wc * 64 + nt * 16 + fr) * RS + ks * 32 + fq * 8);
#pragma unroll
            for (int mt = 0; mt < 2; ++mt) accY[mt][nt] = __builtin_amdgcn_mfma_f32_16x16x32_bf16(aq[mt], bs, accY[mt][nt], 0, 0, 0); }
        __builtin_amdgcn_sched_barrier(0); }
#pragma unroll
    for (int mt = 0; mt < 2; ++mt)
#pragma unroll
        for (int j = 0; j < 4; ++j) { const int r = wr * 32 + mt * 16 + fq * 4 + j; const float qd = exp2f(lg2 * (float)(r + 1));
#pragma unroll
            for (int nt = 0; nt < 4; ++nt) YST[r * 132 + wc * 64 + nt * 16 + fr] = accY[mt][nt][j] * qd; }
    __syncthreads();
    { const int i = tid >> 2, part = tid & 3; float yv[32]; float s = 0.f;
      bf16_t* yo = Y + (size_t)(row0 + i) * 1024 + 512 + h * 128 + part * 32;
#pragma unroll
      for (int x = 0; x < 4; ++x) { const u32x4 y1 = *(const u32x4*)(yo + x * 8); const f32x4 ta = *(const LAS f32x4*)(YST + i * 132 + part * 32 + x * 8), tb = *(const LAS f32x4*)(YST + i * 132 + part * 32 + x * 8 + 4);
          yv[x * 8 + 0] = ta[0] + lo_bf(y1.x); yv[x * 8 + 1] = ta[1] + hi_bf(y1.x); yv[x * 8 + 2] = ta[2] + lo_bf(y1.y); yv[x * 8 + 3] = ta[3] + hi_bf(y1.y);
          yv[x * 8 + 4] = tb[0] + lo_bf(y1.z); yv[x * 8 + 5] = tb[1] + hi_bf(y1.z); yv[x * 8 + 6] = tb[2] + lo_bf(y1.w); yv[x * 8 + 7] = tb[3] + hi_bf(y1.w); }
#pragma unroll
      for (int x = 0; x < 32; ++x) s += yv[x];
      s = quad_sum(s); const float mean = s * (1.0f / 128.0f); float s2 = 0.f;
#pragma unroll
      for (int x = 0; x < 32; ++x) { yv[x] -= mean; s2 += yv[x] * yv[x]; }
      s2 = quad_sum(s2); const float rstd = rsqrtf(s2 * (1.0f / 128.0f) + 1e-5f);
      const bf16_t* gp = PS + (size_t)(row0 + i) * NCOLS + 1792 + 1536 + h * 128 + part * 32; const float* gw = P.gn_w + h * 128 + part * 32;
#pragma unroll
      for (int x = 0; x < 4; ++x) { const u32x4 g4 = *(const u32x4*)(gp + x * 8); const float4 w0 = *(const float4*)(gw + x * 8), w1 = *(const float4*)(gw + x * 8 + 4);
          const float gg[8] = {lo_bf(g4.x), hi_bf(g4.x), lo_bf(g4.y), hi_bf(g4.y), lo_bf(g4.z), hi_bf(g4.z), lo_bf(g4.w), hi_bf(g4.w)}; const float ww[8] = {w0.x, w0.y, w0.z, w0.w, w1.x, w1.y, w1.z, w1.w};
          float o[8];
#pragma unroll
          for (int z = 0; z < 8; ++z) o[z] = yv[x * 8 + z] * rstd * ww[z] * (gg[z] / (1.0f + __expf(-gg[z])));
          u32x4 w; w.x = pg8::cvt_pk_bf16(o[0], o[1]); w.y = pg8::cvt_pk_bf16(o[2], o[3]); w.z = pg8::cvt_pk_bf16(o[4], o[5]); w.w = pg8::cvt_pk_bf16(o[6], o[7]);
          *(u32x4*)(yo + x * 8) = w; } }
    __syncthreads();
}

__device__ __forceinline__ void sub_barrier(unsigned* cnt, const unsigned target, const int wv) {
    asm volatile("s_waitcnt vmcnt(0)" ::: "memory");
    __syncthreads();
    if (fresh_tid(wv) == 0) {
        __builtin_amdgcn_fence(__ATOMIC_RELEASE, "agent");
        asm volatile("s_waitcnt vmcnt(0)" ::: "memory");
        (void)xb_add(cnt, 1u);
        unsigned sp = 0u;
        while (xb_ld(cnt) < target) { __builtin_amdgcn_s_sleep(2); if (++sp > (1u << 20)) break; }
        __builtin_amdgcn_fence(__ATOMIC_ACQUIRE, "agent");
        asm volatile("s_waitcnt vmcnt(0)" ::: "memory");
    }
    __syncthreads();
}

__device__ __forceinline__ void rwkv_post(PR P, const int wv) {
    const int tid = fresh_tid(wv); const int lane = tid & 63; const int gw = blockIdx.x * 8 + (tid >> 6), nw = gridDim.x * 8;
    const int sub = lane >> 4, cg4 = (lane & 15) * 4;
    const bf16_t* PS = (const bf16_t*)(P.ws + WS_BIG); const bf16_t* ASIG = (const bf16_t*)(P.ws + WS_ASIG); const bf16_t* YS = (const bf16_t*)(P.ws + WS_YS);
    const bf16_t* G = (const bf16_t*)(P.ws + WS_WIN); bf16_t* Y = (bf16_t*)(P.ws + WS_XN);
    for (int task = gw; task < MT * 2; task += nw) {
        const int item = task * 4 + sub, row = item >> 3, h = item & 7, ch = h * 64 + cg4;
        const u32x2 yr = *(const u32x2*)(YS + (size_t)row * 512 + ch);
        const bf16_t* cp = PS + (size_t)row * NCOLS + ch; const int pr = prev_row(row);
        const u32x2 c_r = *(const u32x2*)cp, c_k = *(const u32x2*)(cp + 512), c_v = *(const u32x2*)(cp + 1024);
        u32x2 p_r = (u32x2){0u, 0u}, p_k = p_r, p_v = p_r;
        if (pr >= 0) { const bf16_t* pp = PS + (size_t)pr * NCOLS + ch; p_r = *(const u32x2*)pp; p_k = *(const u32x2*)(pp + 512); p_v = *(const u32x2*)(pp + 1024); }
        const u32x2 ar = *(const u32x2*)(ASIG + (size_t)row * 512 + ch), gr = *(const u32x2*)(G + (size_t)row * 512 + ch);
        const float4 mr = *(const float4*)(P.mu + ch), mk = *(const float4*)(P.mu + 512 + ch), mv = *(const float4*)(P.mu + 1024 + ch);
        const float4 ka = *(const float4*)(P.k_a + ch), rk = *(const float4*)(P.r_k + ch), lw = *(const float4*)(P.lnx_w + ch), lb = *(const float4*)(P.lnx_b + ch);
        const float ys[4] = {lo_bf(yr.x), hi_bf(yr.x), lo_bf(yr.y), hi_bf(yr.y)};
        const float mean = row16_sum(ys[0] + ys[1] + ys[2] + ys[3]) * (1.0f / 64.0f);
        float dl[4], s2 = 0.f;
#pragma unroll
        for (int j = 0; j < 4; ++j) { dl[j] = ys[j] - mean; s2 += dl[j] * dl[j]; }
        const float rstd = rsqrtf(row16_sum(s2) * (1.0f / 64.0f) + 64e-5f);
        const float cr[4] = {lo_bf(c_r.x), hi_bf(c_r.x), lo_bf(c_r.y), hi_bf(c_r.y)}, ck[4] = {lo_bf(c_k.x), hi_bf(c_k.x), lo_bf(c_k.y), hi_bf(c_k.y)}, cv[4] = {lo_bf(c_v.x), hi_bf(c_v.x), lo_bf(c_v.y), hi_bf(c_v.y)};
        const float qr[4] = {lo_bf(p_r.x), hi_bf(p_r.x), lo_bf(p_r.y), hi_bf(p_r.y)}, qk[4] = {lo_bf(p_k.x), hi_bf(p_k.x), lo_bf(p_k.y), hi_bf(p_k.y)}, qv[4] = {lo_bf(p_v.x), hi_bf(p_v.x), lo_bf(p_v.y), hi_bf(p_v.y)};
        const float aa[4] = {lo_bf(ar.x), hi_bf(ar.x), lo_bf(ar.y), hi_bf(ar.y)}, gg[4] = {lo_bf(gr.x), hi_bf(gr.x), lo_bf(gr.y), hi_bf(gr.y)};
        const float m_r[4] = {mr.x, mr.y, mr.z, mr.w}, m_k[4] = {mk.x, mk.y, mk.z, mk.w}, m_v[4] = {mv.x, mv.y, mv.z, mv.w};
        const float kaa[4] = {ka.x, ka.y, ka.z, ka.w}, rkk[4] = {rk.x, rk.y, rk.z, rk.w}, lww[4] = {lw.x, lw.y, lw.z, lw.w}, lbb[4] = {lb.x, lb.y, lb.z, lb.w};
        float v[4], bp = 0.f;
#pragma unroll
        for (int j = 0; j < 4; ++j) { const float r = cr[j] + (qr[j] - cr[j]) * m_r[j], k = ck[j] + (qk[j] - ck[j]) * m_k[j]; v[j] = cv[j] + (qv[j] - cv[j]) * m_v[j];
            const float kn = k * (1.0f + (aa[j] - 1.0f) * kaa[j]); bp += r * kn * rkk[j]; }
        const float bonus = row16_sum(bp);
        float o[4];
#pragma unroll
        for (int j = 0; j < 4; ++j) o[j] = (dl[j] * rstd * lww[j] + lbb[j] + bonus * v[j]) * gg[j];
        u32x2 w; w.x = pg8::cvt_pk_bf16(o[0], o[1]); w.y = pg8::cvt_pk_bf16(o[2], o[3]);
        *(u32x2*)(Y + (size_t)row * 1024 + ch) = w;
    }
}

__global__ void __launch_bounds__(512, 2) hymba_mega(Params P_unused) {
    extern __shared__ __attribute__((aligned(16))) unsigned char shm[];
    cg::grid_group grid = cg::this_grid();
    LAS unsigned char* lds = (LAS unsigned char*)shm; LAS float* ldsf = (LAS float*)shm;
    const int G = gridDim.x, bx = blockIdx.x;
    const int wv = __builtin_amdgcn_readfirstlane(threadIdx.x >> 6);
    const CAS Params* kp = (const CAS Params*)__builtin_amdgcn_kernarg_segment_ptr();
#define P (*kp)
#define FRESH() asm volatile("" : "+s"(kp))
#ifndef REP_SYNC
#define REP_SYNC 1
#endif
#ifndef REP_P7
#define REP_P7 1
#endif
#ifndef REP_FFN1
#define REP_FFN1 1
#endif
#ifndef REP_RW
#define REP_RW 1
#endif
#ifndef REP_OTH
#define REP_OTH 1
#endif
#ifndef REP_RETP
#define REP_RETP 1
#endif
#ifndef REP_SAMP
#define REP_SAMP 1
#endif
#ifndef REP_P8
#define REP_P8 1
#endif
#define GSYNC() do { for (int r_ = 0; r_ < REP_SYNC; ++r_) xcd_barrier((unsigned*)ws, (volatile LAS unsigned*)(lds + LDS_BYTES - 16), wv); FRESH(); } while (0)
#define ws (kp->ws)
#define XN ((bf16_t*)(ws + WS_XN))
#define ACT ((bf16_t*)(ws + WS_BIG))
#define FO ((float*)(ws + WS_FO))
#define PS ((bf16_t*)(ws + WS_BIG))
    pg8::StaticOrder S;
    { unsigned* barw = (unsigned*)ws; const int t0 = fresh_tid(wv); if (bx == 0) for (int i = t0; i < XCD_BAR_WORDS + 128; i += 512) barw[i] = 0u;
      if (t0 < 4) ((LAS unsigned*)(lds + LDS_BYTES - 16))[t0] = 0u; }
#ifndef PHM
#define PHM 0xFFFF
#endif
#define PH(k) if ((PHM >> (k)) & 1)
    PH(0) p0_prologue(P, ldsf, wv);
    grid.sync(); FRESH();
    if (fresh_tid(wv) == 0) (void)xb_add(&((unsigned*)ws)[XB_XCNT(xb_xcc_id())], 1u);
    for (int rep1 = 0; rep1 < REP_FFN1; ++rep1) {
    PH(1) { pg8::Gemm g{XN, (const bf16_t*)(ws + WS_WGU), MT, NGU, 1024}; S.init(MT, NGU, G, bx, 1024); pg8::EpiSwiGLU E{ACT, DFF}; pg8::gemm_phase(lds, g, S, E, wv); }
    GSYNC();
    PH(2) { pg8::Gemm g{ACT, (const bf16_t*)(ws + WS_WD), MT, 1024, DFF}; pg8::SplitOrder S2; S2.init2(G, bx, DFF, 8); pg8::EpiF32 E{FO, 1024, (float*)(ws + WS_OMD)}; pg8::gemm_phase(lds, g, S2, E, wv); }
    GSYNC();
    }
    PH(3) rows_phase(P, 1, wv);
    GSYNC();
    PH(4) { pg8::Gemm g{XN, (const bf16_t*)(ws + WS_WIN), MIN_, NCOLS, 1024}; S.init(MIN_, NCOLS, G, bx, 1024); pg8::EpiBf16 E{PS, NCOLS}; pg8::gemm_phase(lds, g, S, E, wv); }
    GSYNC();
    PH(5) lora_prep(P, wv);
    GSYNC();
    PH(6) { pg8::Gemm g{(const bf16_t*)(ws + WS_LA), (const bf16_t*)(ws + WS_WL), MT, 1536, 256}; S.init(MT, 1536, G, bx, 256);
      pg8::EpiLora E{(bf16_t*)(ws + WS_OMD), (bf16_t*)(ws + WS_ASIG), (bf16_t*)(ws + WS_WIN), P.w0, P.a0}; pg8::gemm_phase(lds, g, S, E, wv); }
    GSYNC();
    {
    if (bx < 128) { for (int rw = 0; rw < REP_RW; ++rw) rwkv_unit<false>(P, ldsf, bx >> 4, (bx >> 1) & 7, bx & 1, wv); }
    else for (int rep7 = 0; rep7 < REP_OTH; ++rep7) { const int ob = bx - 128; unsigned* sbc = (unsigned*)ws + XCD_BAR_WORDS + 64;
        for (int k = 0; k < 4; ++k) { const int u = ob + k * 128; ret_unit_a(P, lds, u >> 4, u & 15, wv); }
        sub_barrier(sbc, 128u * (2u * rep7 + 1u), wv);
        ret_prefix(P, ob * 512 + fresh_tid(wv));
        sub_barrier(sbc, 128u * (2u * rep7 + 2u), wv);
        for (int k = 0; k < 4; ++k) { const int u = ob + k * 128; ret_unit_c(P, lds, u >> 4, u & 15, wv); }
        for (int u = ob; u < 2560; u += 128) { if (u < 2048) rwkv_unit<true>(P, ldsf, u >> 4, (u >> 1) & 7, u & 1, wv); else ret_sample_unit(P, ldsf, (u - 2048) >> 2, (u - 2048) & 3, wv); }
    }
    }
    GSYNC();
    for (int rep8 = 0; rep8 < REP_P8; ++rep8) PH(8) rwkv_post(P, wv);
    GSYNC();
    PH(9) { pg8::Gemm g{XN, (const bf16_t*)(ws + WS_WOUT), MT, 1024, 1024}; pg8::SplitOrder S2; S2.init2(G, bx, 1024, 4); pg8::EpiF32 E{FO, 1024, (float*)(ws + WS_OMD)}; pg8::gemm_phase(lds, g, S2, E, wv); }
    GSYNC();
    PH(10) { ffn_weights(P.f2g, P.f2u, P.f2d, ws, ldsf, wv);
    rows_phase(P, 2, wv); }
    GSYNC();
    PH(11) { pg8::Gemm g{XN, (const bf16_t*)(ws + WS_WGU), MT, NGU, 1024}; S.init(MT, NGU, G, bx, 1024); pg8::EpiSwiGLU E{ACT, DFF}; pg8::gemm_phase(lds, g, S, E, wv); }
    GSYNC();
    PH(12) { pg8::Gemm g{ACT, (const bf16_t*)(ws + WS_WD), MT, 1024, DFF}; pg8::SplitOrder S2; S2.init2(G, bx, DFF, 8); pg8::EpiF32 E{FO, 1024, (float*)(ws + WS_OMD)}; pg8::gemm_phase(lds, g, S2, E, wv); }
    GSYNC();
    PH(13) rows_phase(P, 3, wv);
}

#undef ws
#undef XN
#undef ACT
#undef FO
#undef PS
#undef P
extern "C" void kernel_launch(void* const* d_in, const int* in_sizes, int n_in, void* d_out, int out_size, void* d_ws, size_t ws_size, hipStream_t stream) {
    static int grid = 0;
    if (grid == 0) {
        if (n_in != 26 || ws_size < WS_END) { fprintf(stderr, "kernel_launch: unexpected n_in %d or ws_size %zu (< %zu)\n", n_in, ws_size, (size_t)WS_END); grid = -1; return; }
        int dev = 0, cus = 0, per_cu = 0;
        hipGetDevice(&dev); hipDeviceGetAttribute(&cus, hipDeviceAttributeMultiprocessorCount, dev);
        hipFuncSetAttribute((const void*)hymba_mega, hipFuncAttributeMaxDynamicSharedMemorySize, LDS_BYTES);
        hipOccupancyMaxActiveBlocksPerMultiprocessor(&per_cu, (const void*)hymba_mega, 512, LDS_BYTES);
        if (per_cu < 1) { fprintf(stderr, "kernel_launch: occupancy query says %d blocks/CU\n", per_cu); per_cu = 1; }
        grid = cus * per_cu; if (grid > 256) grid = 256;
        if (grid != 256) { fprintf(stderr, "kernel_launch: this kernel needs 256 co-resident workgroups, got %d\n", grid); grid = -1; return; }
        fprintf(stderr, "kernel_launch: cus %d per_cu %d grid %d ws %zu\n", cus, per_cu, grid, ws_size);
    }
    if (grid < 0) return;
    Params p{};
    const float** pp = (const float**)&p;
    for (int i = 0; i < 26; ++i) pp[i] = (const float*)d_in[i];
    p.out = (float*)d_out; p.ws = (unsigned char*)d_ws;
    void* args[] = {&p};
    hipError_t e = hipLaunchCooperativeKernel((const void*)hymba_mega, dim3(grid), dim3(512), args, LDS_BYTES, stream);
    if (e != hipSuccess) fprintf(stderr, "cooperative launch failed: %s (grid %d)\n", hipGetErrorString(e), grid);
}
```

```cpp
#include <hip/hip_runtime.h>
#include <hip/hip_cooperative_groups.h>
#include <cstdio>
#include <cstdint>
namespace cg = cooperative_groups;

__device__ __forceinline__ int fresh_tid(int wv) { int l; asm volatile("v_mbcnt_lo_u32_b32 %0, -1, 0\n\tv_mbcnt_hi_u32_b32 %0, -1, %0" : "=v"(l)); return wv * 64 + l; }
namespace pg8 {
#define PG8_LAS __attribute__((address_space(3)))
typedef unsigned short bf16_t;
typedef short bf16x8 __attribute__((ext_vector_type(8)));
typedef float f32x4 __attribute__((ext_vector_type(4)));
typedef unsigned u32x4 __attribute__((ext_vector_type(4)));
typedef unsigned u32x2 __attribute__((ext_vector_type(2)));
constexpr int BM = 256, BK = 64, HALF = 128, HTB = HALF * BK * 2, STAGE_BYTES = 8 * HTB, NXCD = 8, WGM = 8;

__host__ __device__ __forceinline__ int lds_byte(int r, int c) { const int st = (r >> 4) * 2 + (c >> 5), rr = r & 15, cc = c & 31, ob = rr * 64 + cc * 2; return st * 1024 + (ob ^ (((ob >> 9) & 1) << 5)); }
__host__ __device__ __forceinline__ void stage_rc(int b, int& R, int& C) { const int st = b / 1024, sb = b % 1024, swz = sb ^ (((sb >> 9) & 1) << 5); R = (st >> 1) * 16 + swz / 64; C = (st & 1) * 32 + (swz % 64) / 2; }
__host__ __device__ __forceinline__ int perm32(int rho) { const int n = rho >> 4, i = rho & 15; return 8 * (i >> 2) + 4 * n + (i & 3); }

struct Unit { int pm, pn, k0, nkt, atomic; };
struct Gemm { const bf16_t* A; const bf16_t* Bt; int M, N, K; };

struct StaticOrder {
    int nM, nN, nwg, G, c, nt;
    __host__ __device__ void init(int M, int N, int G_, int c_, int K) { nM = M / BM; nN = N / BM; nwg = nM * nN; G = G_; c = c_; nt = K / BK; }
    __host__ __device__ bool next(int i, Unit& u) const {
        const long L = (long)i * G + c; if (L >= nwg) return false;
        int wgid = (int)L; { const int q = nwg / NXCD, r = nwg % NXCD, xcd = wgid % NXCD, off = wgid / NXCD; wgid = (xcd < r ? xcd * (q + 1) : r * (q + 1) + (xcd - r) * q) + off; }
        const int nig = WGM * nN, gid = wgid / nig, fm = gid * WGM, gsz = (nM - fm) < WGM ? (nM - fm) : WGM;
        u.pm = fm + ((wgid % nig) % gsz); u.pn = (wgid % nig) / gsz; u.k0 = 0; u.nkt = nt; u.atomic = 0; return true;
    }
    __device__ __forceinline__ void a_ready(const Unit&) const {}
    __device__ __forceinline__ void done(const Unit&) const {}
};
struct SplitOrder : StaticOrder {
    int KS;
    __host__ __device__ void init2(int G_, int c_, int K, int KS_) { init(16384, 1024, G_, c_, K); KS = KS_; }
    __host__ __device__ bool next(int i, Unit& u) const {
        if (i == 0) return StaticOrder::next(0, u);
        if (i > 1 || c >= 8 * KS) return false;
        const int tile = c / KS, part = c % KS, pairs = nt / 2, q = pairs / KS, r = pairs % KS;
        u.pm = 64 + (tile >> 2); u.pn = tile & 3; u.k0 = 2 * (part * q + (part < r ? part : r)); u.nkt = 2 * (q + (part < r ? 1 : 0)); u.atomic = 1 + c; return true;
    }
};

__device__ __forceinline__ unsigned cvt_pk_bf16(float lo, float hi) { unsigned r; asm volatile("v_cvt_pk_bf16_f32 %0, %1, %2" : "=v"(r) : "v"(lo), "v"(hi)); return r; }

struct EpiFO {
    static constexpr bool PERM = true;
    bf16_t* C; int ldc; float* slab;
    __device__ __forceinline__ void operator()(const f32x4 (&acc)[2][2][4][2], const Unit& u, int wr, int wc, int fr, int fq) const {
        if (u.atomic == 0) {
            const int row0 = u.pm * BM + wr * 64 + fr; const int col0 = u.pn * BM + wc * 32 + 8 * fq;
#pragma unroll
            for (int ai = 0; ai < 2; ++ai)
#pragma unroll
                for (int m = 0; m < 4; ++m) { bf16_t* rowp = C + (size_t)(row0 + ai * HALF + m * 16) * ldc + col0;
#pragma unroll
                    for (int bj = 0; bj < 2; ++bj) { const f32x4 v0 = acc[ai][bj][m][0], v1 = acc[ai][bj][m][1];
                        u32x4 w; w.x = cvt_pk_bf16(v0[0], v0[1]); w.y = cvt_pk_bf16(v0[2], v0[3]); w.z = cvt_pk_bf16(v1[0], v1[1]); w.w = cvt_pk_bf16(v1[2], v1[3]);
                        *(u32x4*)(rowp + bj * HALF) = w; } }
        } else {
            float* base = slab + (size_t)(u.atomic - 1) * (BM * BM) + (size_t)(wr * 64 + fr) * BM + wc * 32 + 8 * fq;
#pragma unroll
            for (int ai = 0; ai < 2; ++ai)
#pragma unroll
                for (int m = 0; m < 4; ++m) { float* rowp = base + (size_t)(ai * HALF + m * 16) * BM;
#pragma unroll
                    for (int bj = 0; bj < 2; ++bj) { *(f32x4*)(rowp + bj * HALF) = acc[ai][bj][m][0]; *(f32x4*)(rowp + bj * HALF + 4) = acc[ai][bj][m][1]; } }
        }
    }
};
struct EpiBf16 {
    static constexpr bool PERM = true;
    bf16_t* O; int ldc;
    __device__ __forceinline__ void operator()(const f32x4 (&acc)[2][2][4][2], const Unit& u, int wr, int wc, int fr, int fq) const {
        const int row0 = u.pm * BM + wr * 64 + fr; const int col0 = u.pn * BM + wc * 32 + 8 * fq;
#pragma unroll
        for (int ai = 0; ai < 2; ++ai)
#pragma unroll
            for (int m = 0; m < 4; ++m) { bf16_t* rowp = O + (size_t)(row0 + ai * HALF + m * 16) * ldc + col0;
#pragma unroll
                for (int bj = 0; bj < 2; ++bj) { const f32x4 v0 = acc[ai][bj][m][0], v1 = acc[ai][bj][m][1];
                    u32x4 w; w.x = cvt_pk_bf16(v0[0], v0[1]); w.y = cvt_pk_bf16(v0[2], v0[3]); w.z = cvt_pk_bf16(v1[0], v1[1]); w.w = cvt_pk_bf16(v1[2], v1[3]);
                    *(u32x4*)(rowp + bj * HALF) = w; } }
    }
};
__device__ __forceinline__ float silu_f(float x) { return x / (1.0f + __expf(-x)); }
struct EpiSwiGLU {
    static constexpr bool PERM = true;
    bf16_t* O; int ldc;
    __device__ __forceinline__ void operator()(const f32x4 (&acc)[2][2][4][2], const Unit& u, int wr, int wc, int fr, int fq) const {
        const int row0 = u.pm * BM + wr * 64 + fr; const int col0 = u.pn * HALF + wc * 32 + 8 * fq;
#pragma unroll
        for (int ai = 0; ai < 2; ++ai)
#pragma unroll
            for (int m = 0; m < 4; ++m) { bf16_t* rowp = O + (size_t)(row0 + ai * HALF + m * 16) * ldc + col0;
                float o[8];
#pragma unroll
                for (int n = 0; n < 2; ++n)
#pragma unroll
                    for (int j = 0; j < 4; ++j) o[n * 4 + j] = silu_f(acc[ai][0][m][n][j]) * acc[ai][1][m][n][j];
                u32x4 w; w.x = cvt_pk_bf16(o[0], o[1]); w.y = cvt_pk_bf16(o[2], o[3]); w.z = cvt_pk_bf16(o[4], o[5]); w.w = cvt_pk_bf16(o[6], o[7]);
                *(u32x4*)rowp = w; }
    }
};
struct EpiLora {
    static constexpr bool PERM = true;
    bf16_t* OMD; bf16_t* ASIG; bf16_t* G; const float* w0; const float* a0;
    template <int KIND> __device__ __forceinline__ void body(const f32x4 (&acc)[2][2][4][2], bf16_t* O, const float* bias, int row0, int ch0) const {
#pragma unroll
        for (int bj = 0; bj < 2; ++bj)
#pragma unroll
            for (int ai = 0; ai < 2; ++ai)
#pragma unroll
                for (int m = 0; m < 4; ++m) { bf16_t* rowp = O + (size_t)(row0 + ai * HALF + m * 16) * 512 + ch0 + bj * HALF;
                    float o[8];
#pragma unroll
                    for (int n = 0; n < 2; ++n)
#pragma unroll
                        for (int j = 0; j < 4; ++j) { float v = acc[ai][bj][m][n][j];
                            if (KIND == 0) { v += bias[ch0 + bj * HALF + n * 4 + j]; const float nv = -v; const float sp = fmaxf(nv, 0.f) + __logf(1.0f + __expf(-fabsf(nv)));
                                const float e = __expf(-sp - 0.5f);
                                float p = 1.0f / 40320.0f; p = -1.0f / 5040.0f + e * p; p = 1.0f / 720.0f + e * p; p = -1.0f / 120.0f + e * p; p = 1.0f / 24.0f + e * p; p = -1.0f / 6.0f + e * p; p = 0.5f + e * p; p = 1.0f - e * p;
                                v = e * p; }
                            else if (KIND == 1) { v += bias[ch0 + bj * HALF + n * 4 + j]; v = 1.0f / (1.0f + __expf(-v)); }
                            o[n * 4 + j] = v; }
                    u32x4 w; w.x = cvt_pk_bf16(o[0], o[1]); w.y = cvt_pk_bf16(o[2], o[3]); w.z = cvt_pk_bf16(o[4], o[5]); w.w = cvt_pk_bf16(o[6], o[7]);
                    *(u32x4*)rowp = w; __builtin_amdgcn_sched_barrier(0); }
    }
    __device__ __forceinline__ void operator()(const f32x4 (&acc)[2][2][4][2], const Unit& u, int wr, int wc, int fr, int fq) const {
        const int kind = u.pn >> 1;
        const int row0 = u.pm * BM + wr * 64 + fr; const int ch0 = (u.pn & 1) * BM + wc * 32 + 8 * fq;
        if (kind == 0) body<0>(acc, OMD, w0, row0, ch0); else if (kind == 1) body<1>(acc, ASIG, a0, row0, ch0); else body<2>(acc, G, a0, row0, ch0);
    }
};

template <class Epi, class Sched>
__device__ __forceinline__ void gemm_phase(PG8_LAS unsigned char* lds, const Gemm g, const Sched& S, const Epi& E, const int wv) {
    const int tid = fresh_tid(wv), wid = __builtin_amdgcn_readfirstlane(tid >> 6), lane = tid & 63, wr = wid >> 2, wc = wid & 3, fr = lane & 15, fq = lane >> 4;
    const int K = g.K;
    unsigned voffA[2], voffB[2];
#pragma unroll
    for (int i = 0; i < 2; ++i) { int R, C; stage_rc(tid * 16 + i * 8192, R, C); const int Rb = Epi::PERM ? ((R & ~31) + perm32(R & 31)) : R;
        voffA[i] = (unsigned)(R * K + C) * 2u; voffB[i] = (unsigned)(Rb * K + C) * 2u; }
    const size_t kstep = (size_t)(BK * 2);
    const size_t hstep = (size_t)HALF * K * 2;
    const size_t tstep = 2 * hstep;
    const unsigned ldsw = (unsigned)wid * 1024u;
    const int aoff = lds_byte(wr * 64 + fr, fq * 8), boff = lds_byte(wc * 32 + fr, fq * 8);
#define PG8_SA(b, h) (((b) * 2 + (h)) * HTB)
#define PG8_SB(b, h) ((4 + (b) * 2 + (h)) * HTB)
#define PG8_STAGE(bufoff, gbase, voff) do { _Pragma("unroll") for (int _i = 0; _i < 2; ++_i) \
        __builtin_amdgcn_global_load_lds((const unsigned*)((const char*)(gbase) + (voff)[_i]), (PG8_LAS unsigned*)(lds + (bufoff) + ldsw + _i * 8192), 16, 0, 0); } while (0)
#define PG8_LDA(dst, b, h) do { _Pragma("unroll") for (int m = 0; m < 4; ++m) _Pragma("unroll") for (int k = 0; k < 2; ++k) dst[m][k] = *(const PG8_LAS bf16x8*)(lds + PG8_SA(b, h) + aoff + m * 2048 + k * 1024); } while (0)
#define PG8_LDB(dst, b, h) do { _Pragma("unroll") for (int n = 0; n < 2; ++n) _Pragma("unroll") for (int k = 0; k < 2; ++k) dst[n][k] = *(const PG8_LAS bf16x8*)(lds + PG8_SB(b, h) + boff + n * 2048 + k * 1024); } while (0)
#define PG8_MMA(ai, bj, At, Bt) do { __builtin_amdgcn_s_setprio(1); _Pragma("unroll") for (int m = 0; m < 4; ++m) _Pragma("unroll") for (int n = 0; n < 2; ++n) _Pragma("unroll") for (int k = 0; k < 2; ++k) \
        acc[ai][bj][m][n] = __builtin_amdgcn_mfma_f32_16x16x32_bf16(Bt[n][k], At[m][k], acc[ai][bj][m][n], 0, 0, 0); __builtin_amdgcn_s_setprio(0); } while (0)
#define PG8_WAIT_V(n) asm volatile("s_waitcnt vmcnt(" #n ")" ::: "memory")
#define PG8_WAIT_L(n) asm volatile("s_waitcnt lgkmcnt(" #n ")" ::: "memory")
#define PG8_BAR __builtin_amdgcn_s_barrier()
#define PG8_SCHED __builtin_amdgcn_sched_barrier(0)
    Unit cur, nxt; int ui = 0;
    if (!S.next(0, cur)) return;
    f32x4 acc[2][2][4][2];
#pragma unroll
    for (int a = 0; a < 2; ++a)
#pragma unroll
        for (int b = 0; b < 2; ++b)
#pragma unroll
            for (int m = 0; m < 4; ++m)
#pragma unroll
                for (int n = 0; n < 2; ++n) acc[a][b][m][n] = (f32x4){0.f, 0.f, 0.f, 0.f};
    bf16x8 At[4][2], B0[2][2], B1[2][2];
    const char* cA = (const char*)g.A + (size_t)cur.pm * tstep + (size_t)cur.k0 * kstep; const char* cB = (const char*)g.Bt + (size_t)cur.pn * tstep + (size_t)cur.k0 * kstep;
    S.a_ready(cur);
    PG8_STAGE(PG8_SB(0, 0), cB, voffB); PG8_STAGE(PG8_SA(0, 0), cA, voffA); PG8_STAGE(PG8_SB(0, 1), cB + hstep, voffB); PG8_STAGE(PG8_SA(0, 1), cA + hstep, voffA);
    if (wr == 1) PG8_BAR;
    PG8_WAIT_V(4); PG8_BAR;
    PG8_STAGE(PG8_SB(1, 0), cB + kstep, voffB); PG8_STAGE(PG8_SA(1, 0), cA + kstep, voffA); PG8_STAGE(PG8_SB(1, 1), cB + hstep + kstep, voffB);
    PG8_WAIT_V(6); PG8_BAR;
    for (;;) {
        const bool has_next = S.next(ui + 1, nxt);
        const char* nA = has_next ? (const char*)g.A + (size_t)nxt.pm * tstep + (size_t)nxt.k0 * kstep : cA; const char* nB = has_next ? (const char*)g.Bt + (size_t)nxt.pn * tstep + (size_t)nxt.k0 * kstep : cB;
        const int nt = cur.nkt;
        for (int t = 0; t < nt; t += 2) {
            const bool last = (t == nt - 2);
            const char* a1 = cA + (size_t)(t + 1) * kstep;
            const char* a2 = last ? nA : cA + (size_t)(t + 2) * kstep; const char* b2 = last ? nB : cB + (size_t)(t + 2) * kstep;
            const char* a3 = a2 + kstep; const char* b3 = b2 + kstep;
            if (last && has_next) S.a_ready(nxt);
            PG8_LDB(B0, 0, 0); PG8_SCHED; PG8_LDA(At, 0, 0); PG8_STAGE(PG8_SA(1, 1), a1 + hstep, voffA);
            PG8_WAIT_L(8); PG8_BAR; PG8_WAIT_L(0); PG8_MMA(0, 0, At, B0); PG8_BAR; PG8_SCHED;
            PG8_LDB(B1, 0, 1); PG8_STAGE(PG8_SB(0, 0), b2, voffB);
            PG8_BAR; PG8_WAIT_L(0); PG8_MMA(0, 1, At, B1); PG8_BAR;
            PG8_LDA(At, 0, 1); PG8_STAGE(PG8_SA(0, 0), a2, voffA);
            PG8_BAR; PG8_WAIT_L(0); PG8_MMA(1, 0, At, B0); PG8_BAR; PG8_SCHED;
            PG8_STAGE(PG8_SB(0, 1), b2 + hstep, voffB);
            PG8_WAIT_V(6); PG8_BAR; PG8_MMA(1, 1, At, B1); PG8_BAR;
            PG8_LDB(B0, 1, 0); PG8_SCHED; PG8_LDA(At, 1, 0); PG8_STAGE(PG8_SA(0, 1), a2 + hstep, voffA);
            PG8_WAIT_L(8); PG8_BAR; PG8_WAIT_L(0); PG8_MMA(0, 0, At, B0); PG8_BAR; PG8_SCHED;
            PG8_LDB(B1, 1, 1); PG8_STAGE(PG8_SB(1, 0), b3, voffB);
            PG8_BAR; PG8_WAIT_L(0); PG8_MMA(0, 1, At, B1); PG8_BAR;
            PG8_LDA(At, 1, 1); PG8_STAGE(PG8_SA(1, 0), a3, voffA);
            PG8_BAR; PG8_WAIT_L(0); PG8_MMA(1, 0, At, B0); PG8_BAR; PG8_SCHED;
            PG8_STAGE(PG8_SB(1, 1), b3 + hstep, voffB);
            PG8_WAIT_V(6); PG8_BAR; PG8_MMA(1, 1, At, B1); PG8_BAR;
        }
        E(acc, cur, wr, wc, fr, fq); S.done(cur);
        if (!has_next) break;
#pragma unroll
        for (int a = 0; a < 2; ++a)
#pragma unroll
            for (int b = 0; b < 2; ++b)
#pragma unroll
                for (int m = 0; m < 4; ++m)
#pragma unroll
                    for (int n = 0; n < 2; ++n) acc[a][b][m][n] = (f32x4){0.f, 0.f, 0.f, 0.f};
        cur = nxt; cA = nA; cB = nB; ++ui;
    }
    PG8_WAIT_V(0);
    if (wr == 0) PG8_BAR;
    PG8_BAR;
#undef PG8_SA
#undef PG8_SB
#undef PG8_STAGE
#undef PG8_LDA
#undef PG8_LDB
#undef PG8_MMA
#undef PG8_WAIT_V
#undef PG8_WAIT_L
#undef PG8_BAR
#undef PG8_SCHED
}
}

using pg8::bf16_t; using pg8::f32x4; using pg8::bf16x8; using pg8::u32x4; using pg8::u32x2;
#define LAS __attribute__((address_space(3)))

constexpr int D = 1024, DFF = 2816, NGU = 5632, NCOLS = 3840;
constexpr int MP = 16384, MS = 512, MT = 16896, MIN_ = 17152;
constexpr int LDS_BYTES = 147456;
constexpr size_t O_SHP = 17301504, O_WKP = O_SHP + 8192, O_RTP = O_WKP + 262144, O_SHS = O_RTP + 524288, O_WKS = O_SHS + 131072, O_RTS = O_WKS + 4194304;
constexpr size_t WS_ROPE = 16384;
constexpr size_t WS_WL   = WS_ROPE + 1050624;
constexpr size_t WS_WOUT = WS_WL + 786432;
constexpr size_t WS_WIN  = WS_WOUT + 2097152;
constexpr size_t WS_WGU  = WS_WIN + 7864320;
constexpr size_t WS_WD   = WS_WGU + 11534336;
constexpr size_t WS_XN   = WS_WD + 5767168;
constexpr size_t WS_BIG  = WS_XN + 35127296;
constexpr size_t WS_FO   = WS_BIG + 95158272;
constexpr size_t WS_YS   = WS_BIG + 131727360;
constexpr size_t WS_LA   = WS_YS + 17301504;
constexpr size_t WS_OMD  = WS_BIG + 164364288;
constexpr size_t WS_ASIG = WS_OMD + 17301504;
constexpr size_t WS_END  = WS_ASIG + 17301504;
static_assert(WS_LA + 8650752 <= WS_OMD, "mixer overlays");
static_assert(WS_END <= 268435456, "workspace");

struct Params {
    const float *x_prompt, *x_sample, *state_shift, *state_wkv, *state_ret, *norm_g, *f1g, *f1u, *f1d, *w_in, *mu, *w0, *w2, *a0, *a2, *g2, *k_k, *k_a, *r_k, *lnx_w, *lnx_b, *gn_w, *w_out, *f2g, *f2u, *f2d;
    float* out; unsigned char* ws;
};
#define CAS __attribute__((address_space(4)))
typedef const CAS Params& PR;

__device__ __forceinline__ float bf2f(unsigned b) { return __uint_as_float(b << 16); }
__device__ __forceinline__ bf16_t f2bf(float f) { unsigned u = __float_as_uint(f); u += 0x7FFFu + ((u >> 16) & 1u); return (bf16_t)(u >> 16); }
__device__ __forceinline__ float lo_bf(unsigned x) { return __uint_as_float(x << 16); }
__device__ __forceinline__ float hi_bf(unsigned x) { return __uint_as_float(x & 0xffff0000u); }
template <int CTRL> __device__ __forceinline__ float dppf(float v) { return __int_as_float(__builtin_amdgcn_update_dpp(0, __float_as_int(v), CTRL, 0xF, 0xF, false)); }
__device__ __forceinline__ float row16_sum(float v) { v += dppf<0xB1>(v); v += dppf<0x4E>(v); v += dppf<0x141>(v); v += dppf<0x140>(v); return v; }
__device__ __forceinline__ float wave_sum(float v) { v = row16_sum(v); const int i = __float_as_int(v);
    return __int_as_float(__builtin_amdgcn_readlane(i, 0)) + __int_as_float(__builtin_amdgcn_readlane(i, 16)) + __int_as_float(__builtin_amdgcn_readlane(i, 32)) + __int_as_float(__builtin_amdgcn_readlane(i, 48)); }
__device__ __forceinline__ float quad_sum(float v) { v += dppf<0xB1>(v); v += dppf<0x4E>(v); return v; }
__device__ __forceinline__ float sigmoid_f(float x) { return 1.0f / (1.0f + __expf(-x)); }


#define XB_TMO      128
#define XB_XCNT(j)  (256  + 64 * (j))
#define XB_XSUB(j)  (1280 + 64 * (j))
#define XB_XGEN(j)  (2304 + 64 * (j))
#define XB_TOP      3328
#define XB_TOPGEN   3392
#define XCD_BAR_WORDS 3456
#define XB_SPIN_CAP (1u << 18)
__device__ __forceinline__ unsigned xb_ld(unsigned* p)              { return __hip_atomic_load(p, __ATOMIC_RELAXED, __HIP_MEMORY_SCOPE_AGENT); }
__device__ __forceinline__ unsigned xb_add(unsigned* p, unsigned v) { return __hip_atomic_fetch_add(p, v, __ATOMIC_RELAXED, __HIP_MEMORY_SCOPE_AGENT); }
__device__ __forceinline__ unsigned xb_xcc_id() { return (unsigned)__builtin_amdgcn_s_getreg((3 << 11) | 20) & 0xFu; }
#define XB_SPIN(cond, bar) do { unsigned _sp = 0; while (cond) { __builtin_amdgcn_s_sleep(1); \
    if ((++_sp & 255u) == 0u) { if (xb_ld(&(bar)[XB_TMO])) break; if (_sp > XB_SPIN_CAP) { atomicAdd(&(bar)[XB_TMO], 1u); break; } } } } while (0)
struct XcdBarrier { unsigned* bar; unsigned x; volatile LAS unsigned* st; };
__device__ __forceinline__ XcdBarrier xcd_barrier_post(unsigned* bar, volatile LAS unsigned* st) {
    XcdBarrier b; b.bar = bar; b.x = xb_xcc_id(); b.st = st;
    return b;
}
__device__ __forceinline__ void xcd_barrier_complete(unsigned* bar, unsigned x, unsigned& nloc, unsigned& nx) {
    const unsigned G = gridDim.x * gridDim.y * gridDim.z;
    unsigned sum, cnt, mine, sp = 0u;
    for (;;) {
        sum = 0u; cnt = 0u; mine = 0u;
#pragma unroll
        for (unsigned j = 0; j < 16; ++j) { const unsigned c = xb_ld(&bar[XB_XCNT(j)]); sum += c; cnt += (c > 0u) ? 1u : 0u; mine = (j == x) ? c : mine; }
        if (sum == G) break;
        __builtin_amdgcn_s_sleep(1);
        if ((++sp & 255u) == 0u) { if (xb_ld(&bar[XB_TMO])) break; if (sp > XB_SPIN_CAP) { atomicAdd(&bar[XB_TMO], 1u); break; } }
    }
    nloc = mine > 0u ? mine : 1u; nx = cnt > 0u ? cnt : 1u;
}
__device__ __forceinline__ void xcd_barrier(unsigned* barw, volatile LAS unsigned* stw, const int wv) {
    XcdBarrier b; b.bar = barw; b.x = xb_xcc_id(); b.st = stw;
    asm volatile("s_waitcnt vmcnt(0)" ::: "memory");
    __syncthreads();
    if (fresh_tid(wv) == 0) {
        unsigned* bar = b.bar;
        __builtin_amdgcn_s_waitcnt(0);
        unsigned nloc = b.st[0], nx = b.st[1];
        if (nloc == 0u) { xcd_barrier_complete(bar, b.x, nloc, nx); b.st[0] = nloc; b.st[1] = nx; }
        const unsigned old = xb_add(&bar[XB_XSUB(b.x)], 1u);
        const unsigned gen = old / nloc;
        if (old + 1u == (gen + 1u) * nloc) {
            __builtin_amdgcn_fence(__ATOMIC_RELEASE, "agent");
            asm volatile("s_waitcnt vmcnt(0)" ::: "memory");
            const unsigned og = xb_add(&bar[XB_TOP], 1u);
            const unsigned tg = og / nx;
            if (og + 1u == (tg + 1u) * nx) xb_add(&bar[XB_TOPGEN], 1u);
            else XB_SPIN(xb_ld(&bar[XB_TOPGEN]) == tg, bar);
            __builtin_amdgcn_fence(__ATOMIC_ACQUIRE, "agent");
            xb_add(&bar[XB_XGEN(b.x)], 1u);
            asm volatile("s_waitcnt vmcnt(0)" ::: "memory");
        } else {
            XB_SPIN(xb_ld(&bar[XB_XGEN(b.x)]) == gen, bar);
            __builtin_amdgcn_fence(__ATOMIC_ACQUIRE, "agent");
            asm volatile("s_waitcnt vmcnt(0)" ::: "memory");
        }
    }
    __syncthreads();
}


#define DPP2(x, y, CTRL, NOP) asm volatile(NOP "\n\tv_add_f32_dpp %0, %0, %0 " CTRL " row_mask:0xf bank_mask:0xf bound_ctrl:1\n\tv_add_f32_dpp %1, %1, %1 " CTRL " row_mask:0xf bank_mask:0xf bound_ctrl:1" : "+v"(x), "+v"(y))
#define DPP4(x, y, z, w, CTRL, NOP) asm volatile(NOP "\n\tv_add_f32_dpp %0, %0, %0 " CTRL " row_mask:0xf bank_mask:0xf bound_ctrl:1\n\tv_add_f32_dpp %1, %1, %1 " CTRL " row_mask:0xf bank_mask:0xf bound_ctrl:1\n\tv_add_f32_dpp %2, %2, %2 " CTRL " row_mask:0xf bank_mask:0xf bound_ctrl:1\n\tv_add_f32_dpp %3, %3, %3 " CTRL " row_mask:0xf bank_mask:0xf bound_ctrl:1" : "+v"(x), "+v"(y), "+v"(z), "+v"(w))
#define ROW16_SUM4(x, y, z, w) do { DPP4(x, y, z, w, "quad_perm:[1,0,3,2]", "s_nop 1"); DPP4(x, y, z, w, "quad_perm:[2,3,0,1]", ""); DPP4(x, y, z, w, "row_half_mirror", ""); DPP4(x, y, z, w, "row_mirror", ""); } while (0)
#define ROW16_SUM2(x, y) do { DPP2(x, y, "quad_perm:[1,0,3,2]", "s_nop 1"); DPP2(x, y, "quad_perm:[2,3,0,1]", "s_nop 0"); DPP2(x, y, "row_half_mirror", "s_nop 0"); DPP2(x, y, "row_mirror", "s_nop 0"); } while (0)
__device__ __forceinline__ int prev_row(int r) {
    if (r < MP) return (r & 2047) == 0 ? -1 : r - 1;
    const int s = r - MP; return (s & 3) == 0 ? MT + (s >> 2) : r - 1;
}

__device__ __forceinline__ void tconv_tile(const float* __restrict__ W, int K, int N, bf16_t* __restrict__ Bt, int mode, int tile, LAS float* t, const int wv) {
    const int nkt = K / 64; const int kt = tile % nkt, nt = tile / nkt; const int k0 = kt * 64, n0 = nt * 64;
    const int brow0 = mode == 0 ? n0 : ((n0 >> 7) * 256 + (n0 & 127) + (mode == 2 ? 128 : 0));
    const int tid = fresh_tid(wv);
#pragma unroll
    for (int e = 0; e < 8; ++e) { const int idx = e * 512 + tid, r = idx >> 6, c = idx & 63; t[r * 65 + c] = W[(size_t)(k0 + r) * N + n0 + c]; }
    __syncthreads();
#pragma unroll
    for (int e = 0; e < 4; ++e) { const int idx = e * 512 + tid, n = idx >> 5, kp = idx & 31;
        const unsigned w = pg8::cvt_pk_bf16(t[(2 * kp) * 65 + n], t[(2 * kp + 1) * 65 + n]);
        *(unsigned*)(Bt + (size_t)(brow0 + n) * K + k0 + 2 * kp) = w; }
    __syncthreads();
}
__device__ __forceinline__ void ffn_weights(const float* wg, const float* wu, const float* wd, unsigned char* ws, LAS float* t, const int wv) {
    for (int i = blockIdx.x; i < 2112; i += gridDim.x) {
        if (i < 704) tconv_tile(wg, 1024, DFF, (bf16_t*)(ws + WS_WGU), 1, i, t, wv);
        else if (i < 1408) tconv_tile(wu, 1024, DFF, (bf16_t*)(ws + WS_WGU), 2, i - 704, t, wv);
        else tconv_tile(wd, DFF, 1024, (bf16_t*)(ws + WS_WD), 0, i - 1408, t, wv);
    }
}

__device__ __forceinline__ void rows_phase(PR P, const int mode, const int wv) {
    const int tid = fresh_tid(wv); const int lane = tid & 63; const int gw = blockIdx.x * 8 + (tid >> 6), nw = gridDim.x * 8;
    const bf16_t* FO = (const bf16_t*)(P.ws + WS_FO); bf16_t* XN = (bf16_t*)(P.ws + WS_XN);
    const float* gpost = P.norm_g + (mode == 1 ? 1 : (mode == 2 ? 3 : 5)) * 1024;
    const float* gnext = P.norm_g + (mode == 0 ? 0 : (mode == 1 ? 2 : 4)) * 1024;
    const float scale = mode == 2 ? 1.0f : 0.5f;
    for (int row = gw; row < MT; row += nw) {
        const float* xin = mode <= 1 ? (row < MP ? P.x_prompt + (size_t)row * 1024 : P.x_sample + (size_t)(row - MP) * 1024) : P.out + (size_t)row * 1024;
        float4 xv[4];
#pragma unroll
        for (int q = 0; q < 4; ++q) xv[q] = *(const float4*)(xin + (q * 64 + lane) * 4);
        if (mode != 0) {
            float4 fo[4]; float ss = 0.f;
#pragma unroll
            for (int q = 0; q < 4; ++q) {
                if (row < MP) { const u32x2 fb = *(const u32x2*)(FO + (size_t)row * 1024 + (q * 64 + lane) * 4); fo[q] = make_float4(lo_bf(fb.x), hi_bf(fb.x), lo_bf(fb.y), hi_bf(fb.y)); }
                else {
                    const int KS = mode == 2 ? 4 : 8; const float* sl = (const float*)(P.ws + WS_OMD) + (size_t)((((row - MP) >> 8) * 4 + q) * KS) * 65536 + (size_t)(row & 255) * 256 + lane * 4;
                    float4 a = *(const float4*)sl;
                    for (int p = 1; p < KS; ++p) { const float4 b = *(const float4*)(sl + (size_t)p * 65536); a.x += b.x; a.y += b.y; a.z += b.z; a.w += b.w; }
                    fo[q] = a; }
                ss += fo[q].x * fo[q].x + fo[q].y * fo[q].y + fo[q].z * fo[q].z + fo[q].w * fo[q].w; }
            ss = wave_sum(ss); const float r = rsqrtf(ss * (1.0f / 1024.0f) + 1e-6f) * scale;
#pragma unroll
            for (int q = 0; q < 4; ++q) { const float4 g = *(const float4*)(gpost + (q * 64 + lane) * 4);
                xv[q].x += fo[q].x * r * g.x; xv[q].y += fo[q].y * r * g.y; xv[q].z += fo[q].z * r * g.z; xv[q].w += fo[q].w * r * g.w;
                *(float4*)(P.out + (size_t)row * 1024 + (q * 64 + lane) * 4) = xv[q]; }
            if (mode == 3) continue;
        }
        float ss2 = 0.f;
#pragma unroll
        for (int q = 0; q < 4; ++q) ss2 += xv[q].x * xv[q].x + xv[q].y * xv[q].y + xv[q].z * xv[q].z + xv[q].w * xv[q].w;
        ss2 = wave_sum(ss2); const float r2 = rsqrtf(ss2 * (1.0f / 1024.0f) + 1e-6f);
        float* sh = nullptr;
        if (mode == 1) { if (row < MP) { if ((row & 2047) == 2047) sh = P.out + O_SHP + (size_t)(row >> 11) * 1024; } else { const int s = row - MP; if ((s & 3) == 3) sh = P.out + O_SHS + (size_t)(s >> 2) * 1024; } }
#pragma unroll
        for (int q = 0; q < 4; ++q) { const float4 g = *(const float4*)(gnext + (q * 64 + lane) * 4);
            float4 hv; hv.x = xv[q].x * r2 * g.x; hv.y = xv[q].y * r2 * g.y; hv.z = xv[q].z * r2 * g.z; hv.w = xv[q].w * r2 * g.w;
            u32x2 w; w.x = pg8::cvt_pk_bf16(hv.x, hv.y); w.y = pg8::cvt_pk_bf16(hv.z, hv.w);
            *(u32x2*)(XN + (size_t)row * 1024 + (q * 64 + lane) * 4) = w;
            if (sh) *(float4*)(sh + (q * 64 + lane) * 4) = hv; }
    }
}

__device__ __forceinline__ void p0_prologue(PR P, LAS float* ldsf, const int wv) {
    const int tid = fresh_tid(wv); const size_t gt = (size_t)blockIdx.x * 512 + tid, nth = (size_t)gridDim.x * 512;
    { float* rc = (float*)(P.ws + WS_ROPE); float* rs = rc + 2052 * 64;
      for (size_t i = gt; i < 2052 * 64; i += nth) { const int p = (int)(i >> 6), f = (int)(i & 63); const int pos = p < 2048 ? p : 16384 + (p - 2048);
          double inv = 1.0; for (int q = 0; q < f; ++q) inv *= 0.8659643233600653;
          const double ang = (double)pos * inv; const double n = rint(ang * 0.15915494309189535); const double r = ang - n * 6.283185307179586;
          const double r2 = r * r; double s = 0.0, c = 0.0;
          for (int k = 14; k >= 0; --k) { s = s * (-r2 / (double)((2 * k + 2) * (2 * k + 3))) + 1.0; c = c * (-r2 / (double)((2 * k + 1) * (2 * k + 2))) + 1.0; }
          rc[i] = (float)c; rs[i] = (float)(s * r); } }
    { bf16_t* Wl = (bf16_t*)(P.ws + WS_WL);
      for (size_t i = gt; i < 1536 * 256; i += nth) { const int n = (int)(i >> 8), k = (int)(i & 255); float v = 0.f;
          if (n < 512) { if (k < 64) v = P.w2[k * 512 + n]; } else if (n < 1024) { if (k >= 64 && k < 128) v = P.a2[(k - 64) * 512 + (n - 512)]; } else { if (k >= 128) v = P.g2[(k - 128) * 512 + (n - 1024)]; }
          Wl[i] = f2bf(v); } }
    { bf16_t* XN = (bf16_t*)(P.ws + WS_XN);
      for (size_t i = gt; i < 256 * 1024; i += nth) { const int r = (int)(i >> 10); XN[(size_t)MT * 1024 + i] = r < 128 ? f2bf(P.state_shift[i]) : (bf16_t)0; } }
    ffn_weights(P.f1g, P.f1u, P.f1d, P.ws, ldsf, wv);
    for (int i = blockIdx.x; i < 1216; i += gridDim.x) {
        if (i < 960) tconv_tile(P.w_in, 1024, NCOLS, (bf16_t*)(P.ws + WS_WIN), 0, i, ldsf, wv);
        else tconv_tile(P.w_out, 1024, 1024, (bf16_t*)(P.ws + WS_WOUT), 0, i - 960, ldsf, wv);
    }
    rows_phase(P, 0, wv);
}

__device__ __forceinline__ void lora_prep(PR P, const int wv) {
    const int tid = fresh_tid(wv); const int lane = tid & 63; const int gw = blockIdx.x * 8 + (tid >> 6), nw = gridDim.x * 8;
    const bf16_t* PS = (const bf16_t*)(P.ws + WS_BIG); bf16_t* LA = (bf16_t*)(P.ws + WS_LA);
    const float4 mu = *(const float4*)(P.mu + 1536 + lane * 4); const int kind = lane >> 4;
    for (int row = gw; row < MT; row += nw) {
        const u32x2 c = *(const u32x2*)(PS + (size_t)row * NCOLS + 1536 + lane * 4); const int pr = prev_row(row);
        u32x2 p = (u32x2){0u, 0u}; if (pr >= 0) p = *(const u32x2*)(PS + (size_t)pr * NCOLS + 1536 + lane * 4);
        float v[4]; const float cu[4] = {lo_bf(c.x), hi_bf(c.x), lo_bf(c.y), hi_bf(c.y)}, pv[4] = {lo_bf(p.x), hi_bf(p.x), lo_bf(p.y), hi_bf(p.y)}, m4[4] = {mu.x, mu.y, mu.z, mu.w};
#pragma unroll
        for (int j = 0; j < 4; ++j) { float x = cu[j] + (pv[j] - cu[j]) * m4[j];
            if (kind == 0) x = 1.0f - 2.0f / (__expf(2.0f * x) + 1.0f); else if (kind >= 2) x = sigmoid_f(x);
            v[j] = x; }
        u32x2 w; w.x = pg8::cvt_pk_bf16(v[0], v[1]); w.y = pg8::cvt_pk_bf16(v[2], v[3]);
        *(u32x2*)(LA + (size_t)row * 256 + lane * 4) = w;
    }
}

template <bool SAMPLE>
__device__ __forceinline__ void rwkv_unit(PR P, LAS float* lds, const int b, const int h, const int half, const int wv) {
    constexpr int T = SAMPLE ? 4 : 2048, TC = SAMPLE ? 4 : 32, NCH = T / TC;
    const int tid = fresh_tid(wv), lane = tid & 63, wid = tid >> 6;
    const bf16_t* PS = (const bf16_t*)(P.ws + WS_BIG); const bf16_t* OMD = (const bf16_t*)(P.ws + WS_OMD); const bf16_t* ASIG = (const bf16_t*)(P.ws + WS_ASIG);
    bf16_t* YS = (bf16_t*)(P.ws + WS_YS);
    const int row_base = SAMPLE ? MP + b * 4 : b * 2048;
    const int ltok = tid >> 4, lcg = tid & 15; const bool lact = ltok < TC; const int hch = h * 64 + lcg * 4;
    const float4 mur = *(const float4*)(P.mu + hch), muk = *(const float4*)(P.mu + 512 + hch), muv = *(const float4*)(P.mu + 1024 + hch);
    const float4 kk4 = *(const float4*)(P.k_k + hch), ka4 = *(const float4*)(P.k_a + hch);
    typedef float f32x2 __attribute__((ext_vector_type(2)));
    const int row0 = half * 32 + (wid & 3) * 8 + (lane >> 4) * 2, cgl = lane & 15, j0 = cgl * 4;
    f32x2 S[4];
#pragma unroll
    for (int c = 0; c < 4; ++c) S[c] = (f32x2){0.f, 0.f};
    float* sout = P.out + (SAMPLE ? O_WKS : O_WKP) + ((size_t)(b * 8 + h) * 64 + row0) * 64 + j0;
    if (SAMPLE && wid < 4) { const float* sp = P.state_wkv + ((size_t)(b * 8 + h) * 64 + row0) * 64 + j0; const float4 s0 = *(const float4*)sp, s1 = *(const float4*)(sp + 64);
        S[0] = (f32x2){s0.x, s1.x}; S[1] = (f32x2){s0.y, s1.y}; S[2] = (f32x2){s0.z, s1.z}; S[3] = (f32x2){s0.w, s1.w}; }
    LAS float* buf0 = lds; LAS float* buf1 = lds + TC * 384;
    u32x2 cr, ck, cv, pr, pk, pv, co, ca;
#define RW_LOAD(c) do { if (lact) { const int t_ = (c) * TC + ltok; const int row_ = row_base + t_; const int prow_ = SAMPLE ? (t_ == 0 ? MT + b : row_ - 1) : row_ - 1; \
        const bf16_t* cp_ = PS + (size_t)row_ * NCOLS + hch; cr = *(const u32x2*)cp_; ck = *(const u32x2*)(cp_ + 512); cv = *(const u32x2*)(cp_ + 1024); \
        if (SAMPLE || t_ > 0) { const bf16_t* pp_ = PS + (size_t)prow_ * NCOLS + hch; pr = *(const u32x2*)pp_; pk = *(const u32x2*)(pp_ + 512); pv = *(const u32x2*)(pp_ + 1024); } \
        else { pr = (u32x2){0u, 0u}; pk = pr; pv = pr; } \
        co = *(const u32x2*)(OMD + (size_t)row_ * 512 + hch); ca = *(const u32x2*)(ASIG + (size_t)row_ * 512 + hch); } } while (0)
#define RW_MIX(cu, pv_, m) ((cu) + ((pv_) - (cu)) * (m))
#define RW_PROC(dst) do { if (lact) { LAS float* d_ = (dst) + ltok * 384 + lcg * 4; \
        f32x4 r_, k_, v_, o_, a_; \
        r_[0] = RW_MIX(lo_bf(cr.x), lo_bf(pr.x), mur.x); r_[1] = RW_MIX(hi_bf(cr.x), hi_bf(pr.x), mur.y); r_[2] = RW_MIX(lo_bf(cr.y), lo_bf(pr.y), mur.z); r_[3] = RW_MIX(hi_bf(cr.y), hi_bf(pr.y), mur.w); \
        k_[0] = RW_MIX(lo_bf(ck.x), lo_bf(pk.x), muk.x); k_[1] = RW_MIX(hi_bf(ck.x), hi_bf(pk.x), muk.y); k_[2] = RW_MIX(lo_bf(ck.y), lo_bf(pk.y), muk.z); k_[3] = RW_MIX(hi_bf(ck.y), hi_bf(pk.y), muk.w); \
        v_[0] = RW_MIX(lo_bf(cv.x), lo_bf(pv.x), muv.x); v_[1] = RW_MIX(hi_bf(cv.x), hi_bf(pv.x), muv.y); v_[2] = RW_MIX(lo_bf(cv.y), lo_bf(pv.y), muv.z); v_[3] = RW_MIX(hi_bf(cv.y), hi_bf(pv.y), muv.w); \
        o_[0] = lo_bf(co.x); o_[1] = hi_bf(co.x); o_[2] = lo_bf(co.y); o_[3] = hi_bf(co.y); a_[0] = lo_bf(ca.x); a_[1] = hi_bf(ca.x); a_[2] = lo_bf(ca.y); a_[3] = hi_bf(ca.y); \
        f32x4 kk_; kk_[0] = k_[0] * kk4.x; kk_[1] = k_[1] * kk4.y; kk_[2] = k_[2] * kk4.z; kk_[3] = k_[3] * kk4.w; \
        float ss_ = kk_[0] * kk_[0] + kk_[1] * kk_[1] + kk_[2] * kk_[2] + kk_[3] * kk_[3]; ss_ = row16_sum(ss_); \
        const float inv_ = 1.0f / fmaxf(sqrtf(ss_), 1e-12f); kk_ = kk_ * inv_; \
        f32x4 kn_; kn_[0] = k_[0] * (1.0f + (a_[0] - 1.0f) * ka4.x); kn_[1] = k_[1] * (1.0f + (a_[1] - 1.0f) * ka4.y); kn_[2] = k_[2] * (1.0f + (a_[2] - 1.0f) * ka4.z); kn_[3] = k_[3] * (1.0f + (a_[3] - 1.0f) * ka4.w); \
        *(LAS f32x4*)(d_) = r_; *(LAS f32x4*)(d_ + 64) = o_; *(LAS f32x4*)(d_ + 128) = kn_; *(LAS f32x4*)(d_ + 192) = -kk_; *(LAS f32x4*)(d_ + 256) = kk_ * a_; *(LAS f32x4*)(d_ + 320) = v_; } } while (0)
    RW_LOAD(0); RW_PROC(buf0); __syncthreads();
    for (int c = 0; c < NCH; ++c) {
        LAS float* cur = (c & 1) ? buf1 : buf0; LAS float* nxt = (c & 1) ? buf0 : buf1;
        if (c + 1 < NCH) RW_LOAD(c + 1);
        if (wid < 4) {
            constexpr int GS = SAMPLE ? 4 : 16;
            for (int g = 0; g < TC / GS; ++g) {
                float yk0 = 0.f, yk1 = 0.f;
                const LAS float* q0 = cur + (g * GS) * 384;
                f32x4 r4 = *(const LAS f32x4*)(q0 + j0), o4 = *(const LAS f32x4*)(q0 + 64 + j0), k4 = *(const LAS f32x4*)(q0 + 128 + j0), a4 = *(const LAS f32x4*)(q0 + 192 + j0), b4 = *(const LAS f32x4*)(q0 + 256 + j0);
                f32x2 v2 = *(const LAS f32x2*)(q0 + 320 + row0);
                float py0 = 0.f, py1 = 0.f;
#pragma unroll
                for (int tt = 0; tt < GS; ++tt) {
                    const LAS float* qn = q0 + (tt + 1 < GS ? tt + 1 : tt) * 384;
                    const f32x4 nr4 = *(const LAS f32x4*)(qn + j0), no4 = *(const LAS f32x4*)(qn + 64 + j0), nk4 = *(const LAS f32x4*)(qn + 128 + j0), na4 = *(const LAS f32x4*)(qn + 192 + j0), nb4 = *(const LAS f32x4*)(qn + 256 + j0);
                    const f32x2 nv2 = *(const LAS f32x2*)(qn + 320 + row0);
                    f32x2 sa = (S[0] * a4[0] + S[1] * a4[1]) + (S[2] * a4[2] + S[3] * a4[3]);
                    float sx = sa.x, sy = sa.y; ROW16_SUM4(sx, sy, py0, py1); sa = (f32x2){sx, sy};
                    if (tt > 0) { yk0 = cgl == tt - 1 ? py0 : yk0; yk1 = cgl == tt - 1 ? py1 : yk1; }
#pragma unroll
                    for (int c = 0; c < 4; ++c) { f32x2 t = S[c] - S[c] * o4[c]; t = t + sa * b4[c]; S[c] = t + v2 * k4[c]; }
                    const f32x2 y = (S[0] * r4[0] + S[1] * r4[1]) + (S[2] * r4[2] + S[3] * r4[3]);
                    py0 = y.x; py1 = y.y;
                    r4 = nr4; o4 = no4; k4 = nk4; a4 = na4; b4 = nb4; v2 = nv2;
                }
                ROW16_SUM2(py0, py1); yk0 = cgl == GS - 1 ? py0 : yk0; yk1 = cgl == GS - 1 ? py1 : yk1;
                if (cgl < GS) *(unsigned*)(YS + (size_t)(row_base + c * TC + g * GS + cgl) * 512 + h * 64 + row0) = pg8::cvt_pk_bf16(yk0, yk1);
            }
        }
        if (c + 1 < NCH) RW_PROC(nxt);
        __syncthreads();
    }
    if (wid < 4) { *(float4*)sout = make_float4(S[0].x, S[1].x, S[2].x, S[3].x); *(float4*)(sout + 64) = make_float4(S[0].y, S[1].y, S[2].y, S[3].y); }
#undef RW_LOAD
#undef RW_PROC
#undef RW_MIX
}

__device__ __forceinline__ void ret_sample_unit(PR P, LAS float* lds, const int b, const int h, const int wv) {
    const int tid = fresh_tid(wv), lane = tid & 63, wid = tid >> 6;
    const bf16_t* PS = (const bf16_t*)(P.ws + WS_BIG); bf16_t* Y = (bf16_t*)(P.ws + WS_XN);
    const float* rc = (const float*)(P.ws + WS_ROPE); const float* rs = rc + 2052 * 64;
    LAS float* q = lds; LAS float* k = lds + 512; LAS float* v = lds + 1024; LAS float* Pm = lds + 1536; LAS float* y2p = lds + 1600; LAS float* red = lds + 1600 + 2048;
    const float lg2 = log2f(1.0f - exp2f(-5.0f - (float)h));
    const int row0 = MP + b * 4;
    { const int t = (tid & 255) >> 6, f = tid & 63; const bf16_t* src = PS + (size_t)(row0 + t) * NCOLS + 1792 + h * 128;
      if (tid < 256) { const float cs = rc[(2048 + t) * 64 + f], sn = rs[(2048 + t) * 64 + f];
          const float q1 = bf2f(src[f]), q2 = bf2f(src[f + 64]); q[t * 128 + f] = q1 * cs - q2 * sn; q[t * 128 + f + 64] = q1 * sn + q2 * cs;
          const float k1 = bf2f(src[512 + f]), k2 = bf2f(src[512 + f + 64]); k[t * 128 + f] = (k1 * cs - k2 * sn) * 0.08838834764831845f; k[t * 128 + f + 64] = (k1 * sn + k2 * cs) * 0.08838834764831845f; }
      else { v[t * 128 + f] = bf2f(src[1024 + f]); v[t * 128 + f + 64] = bf2f(src[1024 + f + 64]); } }
    __syncthreads();
    if (wid == 0) { const int pi = lane >> 4, pj = (lane >> 2) & 3, part = lane & 3; float s = 0.f;
        for (int d = part * 32; d < part * 32 + 32; ++d) s += q[pi * 128 + d] * k[pj * 128 + d];
        s = quad_sum(s); if (part == 0) Pm[pi * 4 + pj] = pi >= pj ? s * exp2f(lg2 * (float)(pi - pj)) : 0.f; }
    { const int e = tid & 127, dg = tid >> 7; const float c4 = exp2f(lg2 * 4.0f), g3 = exp2f(lg2 * 3.0f), g2_ = exp2f(lg2 * 2.0f), g1 = exp2f(lg2);
      const float v0 = v[e] * g3, v1 = v[128 + e] * g2_, v2 = v[256 + e] * g1, v3 = v[384 + e];
      const float* S0 = P.state_ret + ((size_t)(b * 4 + h) * 128) * 128 + e; float* So = P.out + O_RTS + ((size_t)(b * 4 + h) * 128) * 128 + e;
      float a0 = 0.f, a1 = 0.f, a2 = 0.f, a3 = 0.f;
      float sv[32];
#pragma unroll
      for (int x = 0; x < 32; ++x) sv[x] = S0[(size_t)(dg * 32 + x) * 128];
#pragma unroll
      for (int x = 0; x < 32; ++x) { const int d = dg * 32 + x; const float s = sv[x];
          a0 = fmaf(q[d], s, a0); a1 = fmaf(q[128 + d], s, a1); a2 = fmaf(q[256 + d], s, a2); a3 = fmaf(q[384 + d], s, a3);
          So[(size_t)d * 128] = s * c4 + k[d] * v0 + k[128 + d] * v1 + k[256 + d] * v2 + k[384 + d] * v3; }
      y2p[(dg * 4 + 0) * 128 + e] = a0; y2p[(dg * 4 + 1) * 128 + e] = a1; y2p[(dg * 4 + 2) * 128 + e] = a2; y2p[(dg * 4 + 3) * 128 + e] = a3; }
    __syncthreads();
    { const int i = tid >> 7, e = tid & 127;
      float y = (y2p[(0 + i) * 128 + e] + y2p[(4 + i) * 128 + e] + y2p[(8 + i) * 128 + e] + y2p[(12 + i) * 128 + e]) * exp2f(lg2 * (float)(i + 1));
#pragma unroll
      for (int j = 0; j < 4; ++j) y = fmaf(Pm[i * 4 + j], v[j * 128 + e], y);
      float s = wave_sum(y); if (lane == 0) red[wid] = s; __syncthreads();
      const float mean = (red[i * 2] + red[i * 2 + 1]) * (1.0f / 128.0f); const float dlt = y - mean;
      float s2 = wave_sum(dlt * dlt); if (lane == 0) red[8 + wid] = s2; __syncthreads();
      const float var = (red[8 + i * 2] + red[8 + i * 2 + 1]) * (1.0f / 128.0f);
      const float g = bf2f(PS[(size_t)(row0 + i) * NCOLS + 1792 + 1536 + h * 128 + e]);
      const float o = dlt * rsqrtf(var + 1e-5f) * P.gn_w[h * 128 + e] * (g / (1.0f + __expf(-g)));
      Y[(size_t)(row0 + i) * 1024 + 512 + h * 128 + e] = f2bf(o); }
    __syncthreads();
}

__device__ __forceinline__ bf16_t* kvb_ptr(unsigned char* ws, int bh) { return (bf16_t*)(bh < 29 ? ws + WS_LA + (size_t)bh * 524288 : ws + WS_WIN + 17301504 + (size_t)(bh - 29) * 524288); }
constexpr int RS = 136, BUFE = 128 * RS;

template <bool WITH_K>
__device__ __forceinline__ void ret_load_qk(PR P, LAS bf16_t* QP, LAS bf16_t* KB, unsigned (&kth)[4][4], const int tidv, const int row0, const int n, const int h, const float kd0, const float g32) {
    const bf16_t* PS = (const bf16_t*)(P.ws + WS_BIG); const float* rc = (const float*)(P.ws + WS_ROPE); const float* rs = rc + 2052 * 64;
    float kd = kd0;
#pragma unroll
    for (int it = 0; it < 4; ++it) { const int idx = it * 512 + tidv, i = idx >> 4, f = (idx & 15) * 4;
        const bf16_t* src = PS + (size_t)(row0 + i) * NCOLS + 1792 + h * 128;
        const u32x2 q1 = *(const u32x2*)(src + f), q2 = *(const u32x2*)(src + 64 + f);
        u32x2 k1 = (u32x2){0u, 0u}, k2 = k1; if (WITH_K) { k1 = *(const u32x2*)(src + 512 + f); k2 = *(const u32x2*)(src + 576 + f); }
        const float4 cs = *(const float4*)(rc + (size_t)(n * 128 + i) * 64 + f), sn = *(const float4*)(rs + (size_t)(n * 128 + i) * 64 + f);
        const float c4[4] = {cs.x, cs.y, cs.z, cs.w}, s4[4] = {sn.x, sn.y, sn.z, sn.w};
        const float qa[4] = {lo_bf(q1.x), hi_bf(q1.x), lo_bf(q1.y), hi_bf(q1.y)}, qb[4] = {lo_bf(q2.x), hi_bf(q2.x), lo_bf(q2.y), hi_bf(q2.y)};
        float qo1[4], qo2[4];
#pragma unroll
        for (int x = 0; x < 4; ++x) { qo1[x] = qa[x] * c4[x] - qb[x] * s4[x]; qo2[x] = qa[x] * s4[x] + qb[x] * c4[x]; }
        u32x2 w; w.x = pg8::cvt_pk_bf16(qo1[0], qo1[1]); w.y = pg8::cvt_pk_bf16(qo1[2], qo1[3]); *(LAS u32x2*)(QP + i * RS + f) = w;
        w.x = pg8::cvt_pk_bf16(qo2[0], qo2[1]); w.y = pg8::cvt_pk_bf16(qo2[2], qo2[3]); *(LAS u32x2*)(QP + i * RS + 64 + f) = w;
        if (WITH_K) {
            const float ka[4] = {lo_bf(k1.x), hi_bf(k1.x), lo_bf(k1.y), hi_bf(k1.y)}, kb[4] = {lo_bf(k2.x), hi_bf(k2.x), lo_bf(k2.y), hi_bf(k2.y)};
            float ko1[4], ko2[4];
#pragma unroll
            for (int x = 0; x < 4; ++x) { ko1[x] = (ka[x] * c4[x] - kb[x] * s4[x]) * 0.08838834764831845f; ko2[x] = (ka[x] * s4[x] + kb[x] * c4[x]) * 0.08838834764831845f; }
            w.x = pg8::cvt_pk_bf16(ko1[0], ko1[1]); w.y = pg8::cvt_pk_bf16(ko1[2], ko1[3]); *(LAS u32x2*)(KB + i * RS + f) = w;
            w.x = pg8::cvt_pk_bf16(ko2[0], ko2[1]); w.y = pg8::cvt_pk_bf16(ko2[2], ko2[3]); *(LAS u32x2*)(KB + i * RS + 64 + f) = w;
            kth[it][0] = pg8::cvt_pk_bf16(ko1[0] * kd, ko1[1] * kd); kth[it][1] = pg8::cvt_pk_bf16(ko1[2] * kd, ko1[3] * kd);
            kth[it][2] = pg8::cvt_pk_bf16(ko2[0] * kd, ko2[1] * kd); kth[it][3] = pg8::cvt_pk_bf16(ko2[2] * kd, ko2[3] * kd); kd *= g32; }
        if (it & 1) __builtin_amdgcn_sched_barrier(0); }
}

__device__ __forceinline__ void ret_unit_a(PR P, LAS unsigned char* lds, const int bh, const int n, const int wv) {
    LAS bf16_t* QP = (LAS bf16_t*)lds; LAS bf16_t* KB = QP + BUFE; LAS bf16_t* VT = KB + BUFE;
    const int tid = fresh_tid(wv), lane = tid & 63, wid = tid >> 6, wr = wid >> 1, wc = wid & 1, fr = lane & 15, fq = lane >> 4;
    const int b = bh >> 2, h = bh & 3;
    const bf16_t* PS = (const bf16_t*)(P.ws + WS_BIG); bf16_t* Y = (bf16_t*)(P.ws + WS_XN); bf16_t* KVB = kvb_ptr(P.ws, bh) + (size_t)n * 16384;
    const float lg2 = log2f(1.0f - exp2f(-5.0f - (float)h));
    const float kd0 = exp2f(lg2 * (float)(127 - (tid >> 4))), g32 = exp2f(-32.0f * lg2);
    const int row0 = b * 2048 + n * 128;
    unsigned kth[4][4];
    ret_load_qk<true>(P, QP, KB, kth, tid, row0, n, h, kd0, g32);
#pragma unroll
    for (int it = 0; it < 4; ++it) { const int idx = it * 512 + tid, j = idx >> 4, e = (idx & 15) * 8;
        const u32x4 vv = *(const u32x4*)(PS + (size_t)(row0 + j) * NCOLS + 1792 + 1024 + h * 128 + e);
        LAS bf16_t* d = VT + e * RS + j;
        d[0] = (bf16_t)(vv.x & 0xffffu); d[RS] = (bf16_t)(vv.x >> 16); d[2 * RS] = (bf16_t)(vv.y & 0xffffu); d[3 * RS] = (bf16_t)(vv.y >> 16);
        d[4 * RS] = (bf16_t)(vv.z & 0xffffu); d[5 * RS] = (bf16_t)(vv.z >> 16); d[6 * RS] = (bf16_t)(vv.w & 0xffffu); d[7 * RS] = (bf16_t)(vv.w >> 16); }
    __syncthreads();
    f32x4 accP[2][4];
#pragma unroll
    for (int mt = 0; mt < 2; ++mt)
#pragma unroll
        for (int nt = 0; nt < 4; ++nt) accP[mt][nt] = (f32x4){0.f, 0.f, 0.f, 0.f};
#pragma unroll
    for (int ks = 0; ks < 4; ++ks) { bf16x8 aq[2];
#pragma unroll
        for (int mt = 0; mt < 2; ++mt) aq[mt] = *(const LAS bf16x8*)(QP + (wr * 32 + mt * 16 + fr) * RS + ks * 32 + fq * 8);
#pragma unroll
        for (int nt = 0; nt < 4; ++nt) { const bf16x8 bk = *(const LAS bf16x8*)(KB + (wc * 64 + nt * 16 + fr) * RS + ks * 32 + fq * 8);
#pragma unroll
            for (int mt = 0; mt < 2; ++mt) accP[mt][nt] = __builtin_amdgcn_mfma_f32_16x16x32_bf16(aq[mt], bk, accP[mt][nt], 0, 0, 0); }
        __builtin_amdgcn_sched_barrier(0); }
    __syncthreads();
    { float ri[2][4], cj[4];
#pragma unroll
      for (int mt = 0; mt < 2; ++mt)
#pragma unroll
          for (int j = 0; j < 4; ++j) ri[mt][j] = exp2f(lg2 * (float)(wr * 32 + mt * 16 + fq * 4 + j));
#pragma unroll
      for (int nt = 0; nt < 4; ++nt) cj[nt] = exp2f(-lg2 * (float)(wc * 64 + nt * 16 + fr));
#pragma unroll
      for (int mt = 0; mt < 2; ++mt)
#pragma unroll
          for (int nt = 0; nt < 4; ++nt)
#pragma unroll
              for (int j = 0; j < 4; ++j) { const int i = wr * 32 + mt * 16 + fq * 4 + j, jj = wc * 64 + nt * 16 + fr;
                  const float val = i >= jj ? accP[mt][nt][j] * ri[mt][j] * cj[nt] : 0.f; QP[i * RS + jj] = f2bf(val); } }
#pragma unroll
    for (int it = 0; it < 4; ++it) { const int idx = it * 512 + tid, j = idx >> 4, f = (idx & 15) * 4; LAS bf16_t* d = KB + f * RS + j;
        d[0] = (bf16_t)(kth[it][0] & 0xffffu); d[RS] = (bf16_t)(kth[it][0] >> 16); d[2 * RS] = (bf16_t)(kth[it][1] & 0xffffu); d[3 * RS] = (bf16_t)(kth[it][1] >> 16);
        LAS bf16_t* d2 = d + 64 * RS;
        d2[0] = (bf16_t)(kth[it][2] & 0xffffu); d2[RS] = (bf16_t)(kth[it][2] >> 16); d2[2 * RS] = (bf16_t)(kth[it][3] & 0xffffu); d2[3 * RS] = (bf16_t)(kth[it][3] >> 16); }
    __syncthreads();
    f32x4 accY[2][4], accS[2][4];
#pragma unroll
    for (int mt = 0; mt < 2; ++mt)
#pragma unroll
        for (int nt = 0; nt < 4; ++nt) { accY[mt][nt] = (f32x4){0.f, 0.f, 0.f, 0.f}; accS[mt][nt] = (f32x4){0.f, 0.f, 0.f, 0.f}; }
#pragma unroll
    for (int ks = 0; ks < 4; ++ks) { bf16x8 ap[2], av[2];
#pragma unroll
        for (int mt = 0; mt < 2; ++mt) { ap[mt] = *(const LAS bf16x8*)(QP + (wr * 32 + mt * 16 + fr) * RS + ks * 32 + fq * 8); av[mt] = *(const LAS bf16x8*)(VT + (wr * 32 + mt * 16 + fr) * RS + ks * 32 + fq * 8); }
#pragma unroll
        for (int nt = 0; nt < 4; ++nt) { const bf16x8 bv = *(const LAS bf16x8*)(VT + (wc * 64 + nt * 16 + fr) * RS + ks * 32 + fq * 8), bkt = *(const LAS bf16x8*)(KB + (wc * 64 + nt * 16 + fr) * RS + ks * 32 + fq * 8);
#pragma unroll
            for (int mt = 0; mt < 2; ++mt) { accY[mt][nt] = __builtin_amdgcn_mfma_f32_16x16x32_bf16(ap[mt], bv, accY[mt][nt], 0, 0, 0); accS[mt][nt] = __builtin_amdgcn_mfma_f32_16x16x32_bf16(av[mt], bkt, accS[mt][nt], 0, 0, 0); } }
        __builtin_amdgcn_sched_barrier(0); }
#pragma unroll
    for (int mt = 0; mt < 2; ++mt)
#pragma unroll
        for (int nt = 0; nt < 4; ++nt)
#pragma unroll
            for (int j = 0; j < 4; ++j) { const int r = wr * 32 + mt * 16 + fq * 4 + j, c = wc * 64 + nt * 16 + fr;
                Y[(size_t)(row0 + r) * 1024 + 512 + h * 128 + c] = f2bf(accY[mt][nt][j]); KVB[r * 128 + c] = f2bf(accS[mt][nt][j]); }
    __syncthreads();
}

__device__ __forceinline__ void ret_prefix(PR P, const int item) {
    const int bh = item >> 11, i8 = (item & 2047) * 8; const int h = bh & 3;
    bf16_t* KVB = kvb_ptr(P.ws, bh) + i8;
    const float lg2 = log2f(1.0f - exp2f(-5.0f - (float)h)); const float c_dec = exp2f(lg2 * 128.0f);
    u32x4 kv[16];
#pragma unroll
    for (int n = 0; n < 16; ++n) kv[n] = *(const u32x4*)(KVB + (size_t)n * 16384);
    float S[8];
#pragma unroll
    for (int x = 0; x < 8; ++x) S[x] = 0.f;
#pragma unroll
    for (int n = 0; n < 16; ++n) { u32x4 w; w.x = pg8::cvt_pk_bf16(S[0], S[1]); w.y = pg8::cvt_pk_bf16(S[2], S[3]); w.z = pg8::cvt_pk_bf16(S[4], S[5]); w.w = pg8::cvt_pk_bf16(S[6], S[7]);
        *(u32x4*)(KVB + (size_t)n * 16384) = w;
        const float k8[8] = {lo_bf(kv[n].x), hi_bf(kv[n].x), lo_bf(kv[n].y), hi_bf(kv[n].y), lo_bf(kv[n].z), hi_bf(kv[n].z), lo_bf(kv[n].w), hi_bf(kv[n].w)};
#pragma unroll
        for (int x = 0; x < 8; ++x) S[x] = S[x] * c_dec + k8[x]; }
    const int e = i8 >> 7, d0 = i8 & 127;
#pragma unroll
    for (int x = 0; x < 8; ++x) P.out[O_RTP + ((size_t)bh * 128 + d0 + x) * 128 + e] = S[x];
}

__device__ __forceinline__ void ret_unit_c(PR P, LAS unsigned char* lds, const int bh, const int n, const int wv) {
    LAS bf16_t* QP = (LAS bf16_t*)lds; LAS bf16_t* ST = QP + 3 * BUFE; LAS float* YST = (LAS float*)(QP + BUFE);
    const int tid = fresh_tid(wv), lane = tid & 63, wid = tid >> 6, wr = wid >> 1, wc = wid & 1, fr = lane & 15, fq = lane >> 4;
    const int b = bh >> 2, h = bh & 3;
    const bf16_t* PS = (const bf16_t*)(P.ws + WS_BIG); bf16_t* Y = (bf16_t*)(P.ws + WS_XN); const bf16_t* KVB = kvb_ptr(P.ws, bh) + (size_t)n * 16384;
    const float lg2 = log2f(1.0f - exp2f(-5.0f - (float)h));
    const int row0 = b * 2048 + n * 128;
    unsigned kth[4][4];
    ret_load_qk<false>(P, QP, QP, kth, tid, row0, n, h, 0.f, 0.f);
#pragma unroll
    for (int it = 0; it < 4; ++it) { const int idx = it * 512 + tid, e = idx >> 4, d8 = (idx & 15) * 8;
        *(LAS u32x4*)(ST + e * RS + d8) = *(const u32x4*)(KVB + e * 128 + d8); }
    __syncthreads();
    f32x4 accY[2][4];
#pragma unroll
    for (int mt = 0; mt < 2; ++mt)
#pragma unroll
        for (int nt = 0; nt < 4; ++nt) accY[mt][nt] = (f32x4){0.f, 0.f, 0.f, 0.f};
#pragma unroll
    for (int ks = 0; ks < 4; ++ks) { bf16x8 aq[2];
#pragma unroll
        for (int mt = 0; mt < 2; ++mt) aq[mt] = *(const LAS bf16x8*)(QP + (wr * 32 + mt * 16 + fr) * RS + ks * 32 + fq * 8);
#pragma unroll
        for (int nt = 0; nt < 4; ++nt) { const bf16x8 bs = *(const LAS bf16x8*)(ST + (wc * 64 + nt * 16 + fr) * RS + ks * 32 + fq * 8);
#pragma unroll
            for (int mt = 0; mt < 2; ++mt) accY[mt][nt] = __builtin_amdgcn_mfma_f32_16x16x32_bf16(aq[mt], bs, accY[mt][nt], 0, 0, 0); }
        __builtin_amdgcn_sched_barrier(0); }
#pragma unroll
    for (int mt = 0; mt < 2; ++mt)
#pragma unroll
        for (int j = 0; j < 4; ++j) { const int r = wr * 32 + mt * 16 + fq * 4 + j; const float qd = exp2f(lg2 * (float)(r + 1));
#pragma unroll
            for (int nt = 0; nt < 4; ++nt) YST[r * 132 + wc * 64 + nt * 16 + fr] = accY[mt][nt][j] * qd; }
    __syncthreads();
    { const int i = tid >> 2, part = tid & 3; float yv[32]; float s = 0.f;
      bf16_t* yo = Y + (size_t)(row0 + i) * 1024 + 512 + h * 128 + part * 32;
#pragma unroll
      for (int x = 0; x < 4; ++x) { const u32x4 y1 = *(const u32x4*)(yo + x * 8); const f32x4 ta = *(const LAS f32x4*)(YST + i * 132 + part * 32 + x * 8), tb = *(const LAS f32x4*)(YST + i * 132 + part * 32 + x * 8 + 4);
          yv[x * 8 + 0] = ta[0] + lo_bf(y1.x); yv[x * 8 + 1] = ta[1] + hi_bf(y1.x); yv[x * 8 + 2] = ta[2] + lo_bf(y1.y); yv[x * 8 + 3] = ta[3] + hi_bf(y1.y);
          yv[x * 8 + 4] = tb[0] + lo_bf(y1.z); yv[x * 8 + 5] = tb[1] + hi_bf(y1.z); yv[x * 8 + 6] = tb[2] + lo_bf(y1.w); yv[x * 8 + 7] = tb[3] + hi_bf(y1.w); }
#pragma unroll
      for (int x = 0; x < 32; ++x) s += yv[x];
      s = quad_sum(s); const float mean = s * (1.0f / 128.0f); float s2 = 0.f;
#pragma unroll
      for (int x = 0; x < 32; ++x) { yv[x] -= mean; s2 += yv[x] * yv[x]; }
      s2 = quad_sum(s2); const float rstd = rsqrtf(s2 * (1.0f / 128.0f) + 1e-5f);
      const bf16_t* gp = PS + (size_t)(row0 + i) * NCOLS + 1792 + 1536 + h * 128 + part * 32; const float* gw = P.gn_w + h * 128 + part * 32;
#pragma unroll
      for (int x = 0; x < 4; ++x) { const u32x4 g4 = *(const u32x4*)(gp + x * 8); const float4 w0 = *(const float4*)(gw + x * 8), w1 = *(const float4*)(gw + x * 8 + 4);
          const float gg[8] = {lo_bf(g4.x), hi_bf(g4.x), lo_bf(g4.y), hi_bf(g4.y), lo_bf(g4.z), hi_bf(g4.z), lo_bf(g4.w), hi_bf(g4.w)}; const float ww[8] = {w0.x, w0.y, w0.z, w0.w, w1.x, w1.y, w1.z, w1.w};
          float o[8];
#pragma unroll
          for (int z = 0; z < 8; ++z) o[z] = yv[x * 8 + z] * rstd * ww[z] * (gg[z] / (1.0f + __expf(-gg[z])));
          u32x4 w; w.x = pg8::cvt_pk_bf16(o[0], o[1]); w.y = pg8::cvt_pk_bf16(o[2], o[3]); w.z = pg8::cvt_pk_bf16(o[4], o[5]); w.w = pg8::cvt_pk_bf16(o[6], o[7]);
          *(u32x4*)(yo + x * 8) = w; } }
    __syncthreads();
}

__device__ __forceinline__ void sub_barrier(unsigned* cnt, const unsigned target, const int wv) {
    asm volatile("s_waitcnt vmcnt(0)" ::: "memory");
    __syncthreads();
    if (fresh_tid(wv) == 0) {
        __builtin_amdgcn_fence(__ATOMIC_RELEASE, "agent");
        asm volatile("s_waitcnt vmcnt(0)" ::: "memory");
        (void)xb_add(cnt, 1u);
        unsigned sp = 0u;
        while (xb_ld(cnt) < target) { __builtin_amdgcn_s_sleep(2); if (++sp > (1u << 20)) break; }
        __builtin_amdgcn_fence(__ATOMIC_ACQUIRE, "agent");
        asm volatile("s_waitcnt vmcnt(0)" ::: "memory");
    }
    __syncthreads();
}

__device__ __forceinline__ void rwkv_post(PR P, const int wv) {
    const int tid = fresh_tid(wv); const int lane = tid & 63; const int gw = blockIdx.x * 8 + (tid >> 6), nw = gridDim.x * 8;
    const int sub = lane >> 4, cg4 = (lane & 15) * 4;
    const bf16_t* PS = (const bf16_t*)(P.ws + WS_BIG); const bf16_t* ASIG = (const bf16_t*)(P.ws + WS_ASIG); const bf16_t* YS = (const bf16_t*)(P.ws + WS_YS);
    const bf16_t* G = (const bf16_t*)(P.ws + WS_WIN); bf16_t* Y = (bf16_t*)(P.ws + WS_XN);
    for (int task = gw; task < MT * 2; task += nw) {
        const int item = task * 4 + sub, row = item >> 3, h = item & 7, ch = h * 64 + cg4;
        const u32x2 yr = *(const u32x2*)(YS + (size_t)row * 512 + ch);
        const bf16_t* cp = PS + (size_t)row * NCOLS + ch; const int pr = prev_row(row);
        const u32x2 c_r = *(const u32x2*)cp, c_k = *(const u32x2*)(cp + 512), c_v = *(const u32x2*)(cp + 1024);
        u32x2 p_r = (u32x2){0u, 0u}, p_k = p_r, p_v = p_r;
        if (pr >= 0) { const bf16_t* pp = PS + (size_t)pr * NCOLS + ch; p_r = *(const u32x2*)pp; p_k = *(const u32x2*)(pp + 512); p_v = *(const u32x2*)(pp + 1024); }
        const u32x2 ar = *(const u32x2*)(ASIG + (size_t)row * 512 + ch), gr = *(const u32x2*)(G + (size_t)row * 512 + ch);
        const float4 mr = *(const float4*)(P.mu + ch), mk = *(const float4*)(P.mu + 512 + ch), mv = *(const float4*)(P.mu + 1024 + ch);
        const float4 ka = *(const float4*)(P.k_a + ch), rk = *(const float4*)(P.r_k + ch), lw = *(const float4*)(P.lnx_w + ch), lb = *(const float4*)(P.lnx_b + ch);
        const float ys[4] = {lo_bf(yr.x), hi_bf(yr.x), lo_bf(yr.y), hi_bf(yr.y)};
        const float mean = row16_sum(ys[0] + ys[1] + ys[2] + ys[3]) * (1.0f / 64.0f);
        float dl[4], s2 = 0.f;
#pragma unroll
        for (int j = 0; j < 4; ++j) { dl[j] = ys[j] - mean; s2 += dl[j] * dl[j]; }
        const float rstd = rsqrtf(row16_sum(s2) * (1.0f / 64.0f) + 64e-5f);
        const float cr[4] = {lo_bf(c_r.x), hi_bf(c_r.x), lo_bf(c_r.y), hi_bf(c_r.y)}, ck[4] = {lo_bf(c_k.x), hi_bf(c_k.x), lo_bf(c_k.y), hi_bf(c_k.y)}, cv[4] = {lo_bf(c_v.x), hi_bf(c_v.x), lo_bf(c_v.y), hi_bf(c_v.y)};
        const float qr[4] = {lo_bf(p_r.x), hi_bf(p_r.x), lo_bf(p_r.y), hi_bf(p_r.y)}, qk[4] = {lo_bf(p_k.x), hi_bf(p_k.x), lo_bf(p_k.y), hi_bf(p_k.y)}, qv[4] = {lo_bf(p_v.x), hi_bf(p_v.x), lo_bf(p_v.y), hi_bf(p_v.y)};
        const float aa[4] = {lo_bf(ar.x), hi_bf(ar.x), lo_bf(ar.y), hi_bf(ar.y)}, gg[4] = {lo_bf(gr.x), hi_bf(gr.x), lo_bf(gr.y), hi_bf(gr.y)};
        const float m_r[4] = {mr.x, mr.y, mr.z, mr.w}, m_k[4] = {mk.x, mk.y, mk.z, mk.w}, m_v[4] = {mv.x, mv.y, mv.z, mv.w};
        const float kaa[4] = {ka.x, ka.y, ka.z, ka.w}, rkk[4] = {rk.x, rk.y, rk.z, rk.w}, lww[4] = {lw.x, lw.y, lw.z, lw.w}, lbb[4] = {lb.x, lb.y, lb.z, lb.w};
        float v[4], bp = 0.f;
#pragma unroll
        for (int j = 0; j < 4; ++j) { const float r = cr[j] + (qr[j] - cr[j]) * m_r[j], k = ck[j] + (qk[j] - ck[j]) * m_k[j]; v[j] = cv[j] + (qv[j] - cv[j]) * m_v[j];
            const float kn = k * (1.0f + (aa[j] - 1.0f) * kaa[j]); bp += r * kn * rkk[j]; }
        const float bonus = row16_sum(bp);
        float o[4];
#pragma unroll
        for (int j = 0; j < 4; ++j) o[j] = (dl[j] * rstd * lww[j] + lbb[j] + bonus * v[j]) * gg[j];
        u32x2 w; w.x = pg8::cvt_pk_bf16(o[0], o[1]); w.y = pg8::cvt_pk_bf16(o[2], o[3]);
        *(u32x2*)(Y + (size_t)row * 1024 + ch) = w;
    }
}

__global__ void __launch_bounds__(512, 2) hymba_mega(Params P_unused) {
    extern __shared__ __attribute__((aligned(16))) unsigned char shm[];
    cg::grid_group grid = cg::this_grid();
    LAS unsigned char* lds = (LAS unsigned char*)shm; LAS float* ldsf = (LAS float*)shm;
    const int G = gridDim.x, bx = blockIdx.x;
    const int wv = __builtin_amdgcn_readfirstlane(threadIdx.x >> 6);
    const CAS Params* kp = (const CAS Params*)__builtin_amdgcn_kernarg_segment_ptr();
#define P (*kp)
#define FRESH() asm volatile("" : "+s"(kp))
#ifndef REP_SYNC
#define REP_SYNC 1
#endif
#ifndef REP_P7
#define REP_P7 1
#endif
#ifndef REP_FFN1
#define REP_FFN1 1
#endif
#ifndef REP_P0
#define REP_P0 1
#endif
#ifndef REP_P3
#define REP_P3 1
#endif
#ifndef REP_RW
#define REP_RW 1
#endif
#ifndef REP_OTH
#define REP_OTH 1
#endif
#ifndef REP_RETP
#define REP_RETP 1
#endif
#ifndef REP_SAMP
#define REP_SAMP 1
#endif
#ifndef REP_P8
#define REP_P8 1
#endif
#define GSYNC() do { for (int r_ = 0; r_ < REP_SYNC; ++r_) xcd_barrier((unsigned*)ws, (volatile LAS unsigned*)(lds + LDS_BYTES - 16), wv); FRESH(); } while (0)
#define ws (kp->ws)
#define XN ((bf16_t*)(ws + WS_XN))
#define ACT ((bf16_t*)(ws + WS_BIG))
#define FO ((float*)(ws + WS_FO))
#define PS ((bf16_t*)(ws + WS_BIG))
    pg8::StaticOrder S;
    { unsigned* barw = (unsigned*)ws; const int t0 = fresh_tid(wv); if (bx == 0) for (int i = t0; i < XCD_BAR_WORDS + 128; i += 512) barw[i] = 0u;
      if (t0 < 4) ((LAS unsigned*)(lds + LDS_BYTES - 16))[t0] = 0u; }
#ifndef PHM
#define PHM 0xFFFF
#endif
#define PH(k) if ((PHM >> (k)) & 1)
    for (int r0 = 0; r0 < REP_P0; ++r0) PH(0) p0_prologue(P, ldsf, wv);
    grid.sync(); FRESH();
    if (fresh_tid(wv) == 0) (void)xb_add(&((unsigned*)ws)[XB_XCNT(xb_xcc_id())], 1u);
    for (int rep1 = 0; rep1 < REP_FFN1; ++rep1) {
    PH(1) { pg8::Gemm g{XN, (const bf16_t*)(ws + WS_WGU), MT, NGU, 1024}; S.init(MT, NGU, G, bx, 1024); pg8::EpiSwiGLU E{ACT, DFF}; pg8::gemm_phase(lds, g, S, E, wv); }
    GSYNC();
    PH(2) { pg8::Gemm g{ACT, (const bf16_t*)(ws + WS_WD), MT, 1024, DFF}; pg8::SplitOrder S2; S2.init2(G, bx, DFF, 8); pg8::EpiFO E{(bf16_t*)FO, 1024, (float*)(ws + WS_OMD)}; pg8::gemm_phase(lds, g, S2, E, wv); }
    GSYNC();
    }
    for (int r3 = 0; r3 < REP_P3; ++r3) PH(3) rows_phase(P, 1, wv);
    GSYNC();
    PH(4) { pg8::Gemm g{XN, (const bf16_t*)(ws + WS_WIN), MIN_, NCOLS, 1024}; S.init(MIN_, NCOLS, G, bx, 1024); pg8::EpiBf16 E{PS, NCOLS}; pg8::gemm_phase(lds, g, S, E, wv); }
    GSYNC();
    PH(5) lora_prep(P, wv);
    GSYNC();
    PH(6) { pg8::Gemm g{(const bf16_t*)(ws + WS_LA), (const bf16_t*)(ws + WS_WL), MT, 1536, 256}; S.init(MT, 1536, G, bx, 256);
      pg8::EpiLora E{(bf16_t*)(ws + WS_OMD), (bf16_t*)(ws + WS_ASIG), (bf16_t*)(ws + WS_WIN), P.w0, P.a0}; pg8::gemm_phase(lds, g, S, E, wv); }
    GSYNC();
    {
    if (bx < 128) { for (int rw = 0; rw < REP_RW; ++rw) rwkv_unit<false>(P, ldsf, bx >> 4, (bx >> 1) & 7, bx & 1, wv); }
    else for (int rep7 = 0; rep7 < REP_OTH; ++rep7) { const int ob = bx - 128; unsigned* sbc = (unsigned*)ws + XCD_BAR_WORDS + 64;
        for (int k = 0; k < 4; ++k) { const int u = ob + k * 128; ret_unit_a(P, lds, u >> 4, u & 15, wv); }
        sub_barrier(sbc, 128u * (2u * rep7 + 1u), wv);
        ret_prefix(P, ob * 512 + fresh_tid(wv));
        sub_barrier(sbc, 128u * (2u * rep7 + 2u), wv);
        for (int k = 0; k < 4; ++k) { const int u = ob + k * 128; ret_unit_c(P, lds, u >> 4, u & 15, wv); }
        for (int u = ob; u < 2560; u += 128) { if (u < 2048) rwkv_unit<true>(P, ldsf, u >> 4, (u >> 1) & 7, u & 1, wv); else ret_sample_unit(P, ldsf, (u - 2048) >> 2, (u - 2048) & 3, wv); }
    }
    }
    GSYNC();
    for (int rep8 = 0; rep8 < REP_P8; ++rep8) PH(8) rwkv_post(P, wv);
    GSYNC();
    PH(9) { pg8::Gemm g{XN, (const bf16_t*)(ws + WS_WOUT), MT, 1024, 1024}; pg8::SplitOrder S2; S2.init2(G, bx, 1024, 4); pg8::EpiFO E{(bf16_t*)FO, 1024, (float*)(ws + WS_OMD)}; pg8::gemm_phase(lds, g, S2, E, wv); }
    GSYNC();
    PH(10) { ffn_weights(P.f2g, P.f2u, P.f2d, ws, ldsf, wv);
    rows_phase(P, 2, wv); }
    GSYNC();
    PH(11) { pg8::Gemm g{XN, (const bf16_t*)(ws + WS_WGU), MT, NGU, 1024}; S.init(MT, NGU, G, bx, 1024); pg8::EpiSwiGLU E{ACT, DFF}; pg8::gemm_phase(lds, g, S, E, wv); }
    GSYNC();
    PH(12) { pg8::Gemm g{ACT, (const bf16_t*)(ws + WS_WD), MT, 1024, DFF}; pg8::SplitOrder S2; S2.init2(G, bx, DFF, 8); pg8::EpiFO E{(bf16_t*)FO, 1024, (float*)(ws + WS_OMD)}; pg8::gemm_phase(lds, g, S2, E, wv); }
    GSYNC();
    PH(13) rows_phase(P, 3, wv);
}

#undef ws
#undef XN
#undef ACT
#undef FO
#undef PS
#undef P
extern "C" void kernel_launch(void* const* d_in, const int* in_sizes, int n_in, void* d_out, int out_size, void* d_ws, size_t ws_size, hipStream_t stream) {
    static int grid = 0;
    if (grid == 0) {
        if (n_in != 26 || ws_size < WS_END) { fprintf(stderr, "kernel_launch: unexpected n_in %d or ws_size %zu (< %zu)\n", n_in, ws_size, (size_t)WS_END); grid = -1; return; }
        int dev = 0, cus = 0, per_cu = 0;
        hipGetDevice(&dev); hipDeviceGetAttribute(&cus, hipDeviceAttributeMultiprocessorCount, dev);
        hipFuncSetAttribute((const void*)hymba_mega, hipFuncAttributeMaxDynamicSharedMemorySize, LDS_BYTES);
        hipOccupancyMaxActiveBlocksPerMultiprocessor(&per_cu, (const void*)hymba_mega, 512, LDS_BYTES);
        if (per_cu < 1) { fprintf(stderr, "kernel_launch: occupancy query says %d blocks/CU\n", per_cu); per_cu = 1; }
        grid = cus * per_cu; if (grid > 256) grid = 256;
        if (grid != 256) { fprintf(stderr, "kernel_launch: this kernel needs 256 co-resident workgroups, got %d\n", grid); grid = -1; return; }
        fprintf(stderr, "kernel_launch: cus %d per_cu %d grid %d ws %zu\n", cus, per_cu, grid, ws_size);
    }
    if (grid < 0) return;
    Params p{};
    const float** pp = (const float**)&p;
    for (int i = 0; i < 26; ++i) pp[i] = (const float*)d_in[i];
    p.out = (float*)d_out; p.ws = (unsigned char*)d_ws;
    void* args[] = {&p};
    hipError_t e = hipLaunchCooperativeKernel((const void*)hymba_mega, dim3(grid), dim3(512), args, LDS_BYTES, stream);
    if (e != hipSuccess) fprintf(stderr, "cooperative launch failed: %s (grid %d)\n", hipGetErrorString(e), grid);
}
```

```cpp
#include <hip/hip_runtime.h>
#include <hip/hip_cooperative_groups.h>
#include <cstdio>
#include <cstdint>
namespace cg = cooperative_groups;

__device__ __forceinline__ int fresh_tid(int wv) { int l; asm volatile("v_mbcnt_lo_u32_b32 %0, -1, 0\n\tv_mbcnt_hi_u32_b32 %0, -1, %0" : "=v"(l)); return wv * 64 + l; }
namespace pg8 {
#define PG8_LAS __attribute__((address_space(3)))
typedef unsigned short bf16_t;
typedef short bf16x8 __attribute__((ext_vector_type(8)));
typedef float f32x4 __attribute__((ext_vector_type(4)));
typedef unsigned u32x4 __attribute__((ext_vector_type(4)));
typedef unsigned u32x2 __attribute__((ext_vector_type(2)));
constexpr int BM = 256, BK = 64, HALF = 128, HTB = HALF * BK * 2, STAGE_BYTES = 8 * HTB, NXCD = 8, WGM = 8;

__host__ __device__ __forceinline__ int lds_byte(int r, int c) { const int st = (r >> 4) * 2 + (c >> 5), rr = r & 15, cc = c & 31, ob = rr * 64 + cc * 2; return st * 1024 + (ob ^ (((ob >> 9) & 1) << 5)); }
__host__ __device__ __forceinline__ void stage_rc(int b, int& R, int& C) { const int st = b / 1024, sb = b % 1024, swz = sb ^ (((sb >> 9) & 1) << 5); R = (st >> 1) * 16 + swz / 64; C = (st & 1) * 32 + (swz % 64) / 2; }
__host__ __device__ __forceinline__ int perm32(int rho) { const int n = rho >> 4, i = rho & 15; return 8 * (i >> 2) + 4 * n + (i & 3); }

struct Unit { int pm, pn, k0, nkt, atomic; };
struct Gemm { const bf16_t* A; const bf16_t* Bt; int M, N, K; };

struct StaticOrder {
    int nM, nN, nwg, G, c, nt;
    __host__ __device__ void init(int M, int N, int G_, int c_, int K) { nM = M / BM; nN = N / BM; nwg = nM * nN; G = G_; c = c_; nt = K / BK; }
    __host__ __device__ bool next(int i, Unit& u) const {
        const long L = (long)i * G + c; if (L >= nwg) return false;
        int wgid = (int)L; { const int q = nwg / NXCD, r = nwg % NXCD, xcd = wgid % NXCD, off = wgid / NXCD; wgid = (xcd < r ? xcd * (q + 1) : r * (q + 1) + (xcd - r) * q) + off; }
        const int nig = WGM * nN, gid = wgid / nig, fm = gid * WGM, gsz = (nM - fm) < WGM ? (nM - fm) : WGM;
        u.pm = fm + ((wgid % nig) % gsz); u.pn = (wgid % nig) / gsz; u.k0 = 0; u.nkt = nt; u.atomic = 0; return true;
    }
    __device__ __forceinline__ void a_ready(const Unit&) const {}
    __device__ __forceinline__ void done(const Unit&) const {}
};
struct SplitOrder : StaticOrder {
    int KS;
    __host__ __device__ void init2(int G_, int c_, int K, int KS_) { init(16384, 1024, G_, c_, K); KS = KS_; }
    __host__ __device__ bool next(int i, Unit& u) const {
        if (i == 0) return StaticOrder::next(0, u);
        if (i > 1 || c >= 8 * KS) return false;
        const int tile = c / KS, part = c % KS, pairs = nt / 2, q = pairs / KS, r = pairs % KS;
        u.pm = 64 + (tile >> 2); u.pn = tile & 3; u.k0 = 2 * (part * q + (part < r ? part : r)); u.nkt = 2 * (q + (part < r ? 1 : 0)); u.atomic = 1 + c; return true;
    }
};

__device__ __forceinline__ unsigned cvt_pk_bf16(float lo, float hi) { unsigned r; asm volatile("v_cvt_pk_bf16_f32 %0, %1, %2" : "=v"(r) : "v"(lo), "v"(hi)); return r; }

struct EpiFO {
    static constexpr bool PERM = true;
    bf16_t* C; int ldc; float* slab;
    __device__ __forceinline__ void operator()(const f32x4 (&acc)[2][2][4][2], const Unit& u, int wr, int wc, int fr, int fq) const {
        if (u.atomic == 0) {
            const int row0 = u.pm * BM + wr * 64 + fr; const int col0 = u.pn * BM + wc * 32 + 8 * fq;
#pragma unroll
            for (int ai = 0; ai < 2; ++ai)
#pragma unroll
                for (int m = 0; m < 4; ++m) { bf16_t* rowp = C + (size_t)(row0 + ai * HALF + m * 16) * ldc + col0;
#pragma unroll
                    for (int bj = 0; bj < 2; ++bj) { const f32x4 v0 = acc[ai][bj][m][0], v1 = acc[ai][bj][m][1];
                        u32x4 w; w.x = cvt_pk_bf16(v0[0], v0[1]); w.y = cvt_pk_bf16(v0[2], v0[3]); w.z = cvt_pk_bf16(v1[0], v1[1]); w.w = cvt_pk_bf16(v1[2], v1[3]);
                        *(u32x4*)(rowp + bj * HALF) = w; } }
        } else {
            float* base = slab + (size_t)(u.atomic - 1) * (BM * BM) + (size_t)(wr * 64 + fr) * BM + wc * 32 + 8 * fq;
#pragma unroll
            for (int ai = 0; ai < 2; ++ai)
#pragma unroll
                for (int m = 0; m < 4; ++m) { float* rowp = base + (size_t)(ai * HALF + m * 16) * BM;
#pragma unroll
                    for (int bj = 0; bj < 2; ++bj) { *(f32x4*)(rowp + bj * HALF) = acc[ai][bj][m][0]; *(f32x4*)(rowp + bj * HALF + 4) = acc[ai][bj][m][1]; } }
        }
    }
};
struct EpiBf16 {
    static constexpr bool PERM = true;
    bf16_t* O; int ldc;
    __device__ __forceinline__ void operator()(const f32x4 (&acc)[2][2][4][2], const Unit& u, int wr, int wc, int fr, int fq) const {
        const int row0 = u.pm * BM + wr * 64 + fr; const int col0 = u.pn * BM + wc * 32 + 8 * fq;
#pragma unroll
        for (int ai = 0; ai < 2; ++ai)
#pragma unroll
            for (int m = 0; m < 4; ++m) { bf16_t* rowp = O + (size_t)(row0 + ai * HALF + m * 16) * ldc + col0;
#pragma unroll
                for (int bj = 0; bj < 2; ++bj) { const f32x4 v0 = acc[ai][bj][m][0], v1 = acc[ai][bj][m][1];
                    u32x4 w; w.x = cvt_pk_bf16(v0[0], v0[1]); w.y = cvt_pk_bf16(v0[2], v0[3]); w.z = cvt_pk_bf16(v1[0], v1[1]); w.w = cvt_pk_bf16(v1[2], v1[3]);
                    *(u32x4*)(rowp + bj * HALF) = w; } }
    }
};
__device__ __forceinline__ float silu_f(float x) { return x / (1.0f + __expf(-x)); }
struct EpiSwiGLU {
    static constexpr bool PERM = true;
    bf16_t* O; int ldc;
    __device__ __forceinline__ void operator()(const f32x4 (&acc)[2][2][4][2], const Unit& u, int wr, int wc, int fr, int fq) const {
        const int row0 = u.pm * BM + wr * 64 + fr; const int col0 = u.pn * HALF + wc * 32 + 8 * fq;
#pragma unroll
        for (int ai = 0; ai < 2; ++ai)
#pragma unroll
            for (int m = 0; m < 4; ++m) { bf16_t* rowp = O + (size_t)(row0 + ai * HALF + m * 16) * ldc + col0;
                float o[8];
#pragma unroll
                for (int n = 0; n < 2; ++n)
#pragma unroll
                    for (int j = 0; j < 4; ++j) o[n * 4 + j] = silu_f(acc[ai][0][m][n][j]) * acc[ai][1][m][n][j];
                u32x4 w; w.x = cvt_pk_bf16(o[0], o[1]); w.y = cvt_pk_bf16(o[2], o[3]); w.z = cvt_pk_bf16(o[4], o[5]); w.w = cvt_pk_bf16(o[6], o[7]);
                *(u32x4*)rowp = w; }
    }
};
struct EpiLora {
    static constexpr bool PERM = true;
    bf16_t* OMD; bf16_t* ASIG; bf16_t* G; const float* w0; const float* a0;
    template <int KIND> __device__ __forceinline__ void body(const f32x4 (&acc)[2][2][4][2], bf16_t* O, const float* bias, int row0, int ch0) const {
#pragma unroll
        for (int bj = 0; bj < 2; ++bj)
#pragma unroll
            for (int ai = 0; ai < 2; ++ai)
#pragma unroll
                for (int m = 0; m < 4; ++m) { bf16_t* rowp = O + (size_t)(row0 + ai * HALF + m * 16) * 512 + ch0 + bj * HALF;
                    float o[8];
#pragma unroll
                    for (int n = 0; n < 2; ++n)
#pragma unroll
                        for (int j = 0; j < 4; ++j) { float v = acc[ai][bj][m][n][j];
                            if (KIND == 0) { v += bias[ch0 + bj * HALF + n * 4 + j]; const float nv = -v; const float sp = fmaxf(nv, 0.f) + __logf(1.0f + __expf(-fabsf(nv)));
                                const float e = __expf(-sp - 0.5f);
                                float p = 1.0f / 40320.0f; p = -1.0f / 5040.0f + e * p; p = 1.0f / 720.0f + e * p; p = -1.0f / 120.0f + e * p; p = 1.0f / 24.0f + e * p; p = -1.0f / 6.0f + e * p; p = 0.5f + e * p; p = 1.0f - e * p;
                                v = e * p; }
                            else if (KIND == 1) { v += bias[ch0 + bj * HALF + n * 4 + j]; v = 1.0f / (1.0f + __expf(-v)); }
                            o[n * 4 + j] = v; }
                    u32x4 w; w.x = cvt_pk_bf16(o[0], o[1]); w.y = cvt_pk_bf16(o[2], o[3]); w.z = cvt_pk_bf16(o[4], o[5]); w.w = cvt_pk_bf16(o[6], o[7]);
                    *(u32x4*)rowp = w; __builtin_amdgcn_sched_barrier(0); }
    }
    __device__ __forceinline__ void operator()(const f32x4 (&acc)[2][2][4][2], const Unit& u, int wr, int wc, int fr, int fq) const {
        const int kind = u.pn >> 1;
        const int row0 = u.pm * BM + wr * 64 + fr; const int ch0 = (u.pn & 1) * BM + wc * 32 + 8 * fq;
        if (kind == 0) body<0>(acc, OMD, w0, row0, ch0); else if (kind == 1) body<1>(acc, ASIG, a0, row0, ch0); else body<2>(acc, G, a0, row0, ch0);
    }
};

template <class Epi, class Sched>
__device__ __forceinline__ void gemm_phase(PG8_LAS unsigned char* lds, const Gemm g, const Sched& S, const Epi& E, const int wv) {
    const int tid = fresh_tid(wv), wid = __builtin_amdgcn_readfirstlane(tid >> 6), lane = tid & 63, wr = wid >> 2, wc = wid & 3, fr = lane & 15, fq = lane >> 4;
    const int K = g.K;
    unsigned voffA[2], voffB[2];
#pragma unroll
    for (int i = 0; i < 2; ++i) { int R, C; stage_rc(tid * 16 + i * 8192, R, C); const int Rb = Epi::PERM ? ((R & ~31) + perm32(R & 31)) : R;
        voffA[i] = (unsigned)(R * K + C) * 2u; voffB[i] = (unsigned)(Rb * K + C) * 2u; }
    const size_t kstep = (size_t)(BK * 2);
    const size_t hstep = (size_t)HALF * K * 2;
    const size_t tstep = 2 * hstep;
    const unsigned ldsw = (unsigned)wid * 1024u;
    const int aoff = lds_byte(wr * 64 + fr, fq * 8), boff = lds_byte(wc * 32 + fr, fq * 8);
#define PG8_SA(b, h) (((b) * 2 + (h)) * HTB)
#define PG8_SB(b, h) ((4 + (b) * 2 + (h)) * HTB)
#define PG8_STAGE(bufoff, gbase, voff) do { _Pragma("unroll") for (int _i = 0; _i < 2; ++_i) \
        __builtin_amdgcn_global_load_lds((const unsigned*)((const char*)(gbase) + (voff)[_i]), (PG8_LAS unsigned*)(lds + (bufoff) + ldsw + _i * 8192), 16, 0, 0); } while (0)
#define PG8_LDA(dst, b, h) do { _Pragma("unroll") for (int m = 0; m < 4; ++m) _Pragma("unroll") for (int k = 0; k < 2; ++k) dst[m][k] = *(const PG8_LAS bf16x8*)(lds + PG8_SA(b, h) + aoff + m * 2048 + k * 1024); } while (0)
#define PG8_LDB(dst, b, h) do { _Pragma("unroll") for (int n = 0; n < 2; ++n) _Pragma("unroll") for (int k = 0; k < 2; ++k) dst[n][k] = *(const PG8_LAS bf16x8*)(lds + PG8_SB(b, h) + boff + n * 2048 + k * 1024); } while (0)
#define PG8_MMA(ai, bj, At, Bt) do { __builtin_amdgcn_s_setprio(1); _Pragma("unroll") for (int m = 0; m < 4; ++m) _Pragma("unroll") for (int n = 0; n < 2; ++n) _Pragma("unroll") for (int k = 0; k < 2; ++k) \
        acc[ai][bj][m][n] = __builtin_amdgcn_mfma_f32_16x16x32_bf16(Bt[n][k], At[m][k], acc[ai][bj][m][n], 0, 0, 0); __builtin_amdgcn_s_setprio(0); } while (0)
#define PG8_WAIT_V(n) asm volatile("s_waitcnt vmcnt(" #n ")" ::: "memory")
#define PG8_WAIT_L(n) asm volatile("s_waitcnt lgkmcnt(" #n ")" ::: "memory")
#define PG8_BAR __builtin_amdgcn_s_barrier()
#define PG8_SCHED __builtin_amdgcn_sched_barrier(0)
    Unit cur, nxt; int ui = 0;
    if (!S.next(0, cur)) return;
    f32x4 acc[2][2][4][2];
#pragma unroll
    for (int a = 0; a < 2; ++a)
#pragma unroll
        for (int b = 0; b < 2; ++b)
#pragma unroll
            for (int m = 0; m < 4; ++m)
#pragma unroll
                for (int n = 0; n < 2; ++n) acc[a][b][m][n] = (f32x4){0.f, 0.f, 0.f, 0.f};
    bf16x8 At[4][2], B0[2][2], B1[2][2];
    const char* cA = (const char*)g.A + (size_t)cur.pm * tstep + (size_t)cur.k0 * kstep; const char* cB = (const char*)g.Bt + (size_t)cur.pn * tstep + (size_t)cur.k0 * kstep;
    S.a_ready(cur);
    PG8_STAGE(PG8_SB(0, 0), cB, voffB); PG8_STAGE(PG8_SA(0, 0), cA, voffA); PG8_STAGE(PG8_SB(0, 1), cB + hstep, voffB); PG8_STAGE(PG8_SA(0, 1), cA + hstep, voffA);
    if (wr == 1) PG8_BAR;
    PG8_WAIT_V(4); PG8_BAR;
    PG8_STAGE(PG8_SB(1, 0), cB + kstep, voffB); PG8_STAGE(PG8_SA(1, 0), cA + kstep, voffA); PG8_STAGE(PG8_SB(1, 1), cB + hstep + kstep, voffB);
    PG8_WAIT_V(6); PG8_BAR;
    for (;;) {
        const bool has_next = S.next(ui + 1, nxt);
        const char* nA = has_next ? (const char*)g.A + (size_t)nxt.pm * tstep + (size_t)nxt.k0 * kstep : cA; const char* nB = has_next ? (const char*)g.Bt + (size_t)nxt.pn * tstep + (size_t)nxt.k0 * kstep : cB;
        const int nt = cur.nkt;
        for (int t = 0; t < nt; t += 2) {
            const bool last = (t == nt - 2);
            const char* a1 = cA + (size_t)(t + 1) * kstep;
            const char* a2 = last ? nA : cA + (size_t)(t + 2) * kstep; const char* b2 = last ? nB : cB + (size_t)(t + 2) * kstep;
            const char* a3 = a2 + kstep; const char* b3 = b2 + kstep;
            if (last && has_next) S.a_ready(nxt);
            PG8_LDB(B0, 0, 0); PG8_SCHED; PG8_LDA(At, 0, 0); PG8_STAGE(PG8_SA(1, 1), a1 + hstep, voffA);
            PG8_WAIT_L(8); PG8_BAR; PG8_WAIT_L(0); PG8_MMA(0, 0, At, B0); PG8_BAR; PG8_SCHED;
            PG8_LDB(B1, 0, 1); PG8_STAGE(PG8_SB(0, 0), b2, voffB);
            PG8_BAR; PG8_WAIT_L(0); PG8_MMA(0, 1, At, B1); PG8_BAR;
            PG8_LDA(At, 0, 1); PG8_STAGE(PG8_SA(0, 0), a2, voffA);
            PG8_BAR; PG8_WAIT_L(0); PG8_MMA(1, 0, At, B0); PG8_BAR; PG8_SCHED;
            PG8_STAGE(PG8_SB(0, 1), b2 + hstep, voffB);
            PG8_WAIT_V(6); PG8_BAR; PG8_MMA(1, 1, At, B1); PG8_BAR;
            PG8_LDB(B0, 1, 0); PG8_SCHED; PG8_LDA(At, 1, 0); PG8_STAGE(PG8_SA(0, 1), a2 + hstep, voffA);
            PG8_WAIT_L(8); PG8_BAR; PG8_WAIT_L(0); PG8_MMA(0, 0, At, B0); PG8_BAR; PG8_SCHED;
            PG8_LDB(B1, 1, 1); PG8_STAGE(PG8_SB(1, 0), b3, voffB);
            PG8_BAR; PG8_WAIT_L(0); PG8_MMA(0, 1, At, B1); PG8_BAR;
            PG8_LDA(At, 1, 1); PG8_STAGE(PG8_SA(1, 0), a3, voffA);
            PG8_BAR; PG8_WAIT_L(0); PG8_MMA(1, 0, At, B0); PG8_BAR; PG8_SCHED;
            PG8_STAGE(PG8_SB(1, 1), b3 + hstep, voffB);
            PG8_WAIT_V(6); PG8_BAR; PG8_MMA(1, 1, At, B1); PG8_BAR;
        }
        E(acc, cur, wr, wc, fr, fq); S.done(cur);
        if (!has_next) break;
#pragma unroll
        for (int a = 0; a < 2; ++a)
#pragma unroll
            for (int b = 0; b < 2; ++b)
#pragma unroll
                for (int m = 0; m < 4; ++m)
#pragma unroll
                    for (int n = 0; n < 2; ++n) acc[a][b][m][n] = (f32x4){0.f, 0.f, 0.f, 0.f};
        cur = nxt; cA = nA; cB = nB; ++ui;
    }
    PG8_WAIT_V(0);
    if (wr == 0) PG8_BAR;
    PG8_BAR;
#undef PG8_SA
#undef PG8_SB
#undef PG8_STAGE
#undef PG8_LDA
#undef PG8_LDB
#undef PG8_MMA
#undef PG8_WAIT_V
#undef PG8_WAIT_L
#undef PG8_BAR
#undef PG8_SCHED
}
}

using pg8::bf16_t; using pg8::f32x4; using pg8::bf16x8; using pg8::u32x4; using pg8::u32x2;
#define LAS __attribute__((address_space(3)))

constexpr int D = 1024, DFF = 2816, NGU = 5632, NCOLS = 3840;
constexpr int MP = 16384, MS = 512, MT = 16896, MIN_ = 17152;
constexpr int LDS_BYTES = 147456;
constexpr size_t O_SHP = 17301504, O_WKP = O_SHP + 8192, O_RTP = O_WKP + 262144, O_SHS = O_RTP + 524288, O_WKS = O_SHS + 131072, O_RTS = O_WKS + 4194304;
constexpr size_t WS_ROPE = 16384;
constexpr size_t WS_WL   = WS_ROPE + 1050624;
constexpr size_t WS_WOUT = WS_WL + 786432;
constexpr size_t WS_WIN  = WS_WOUT + 2097152;
constexpr size_t WS_WGU  = WS_WIN + 7864320;
constexpr size_t WS_WD   = WS_WGU + 11534336;
constexpr size_t WS_XN   = WS_WD + 5767168;
constexpr size_t WS_BIG  = WS_XN + 35127296;
constexpr size_t WS_FO   = WS_BIG + 95158272;
constexpr size_t WS_YS   = WS_BIG + 131727360;
constexpr size_t WS_LA   = WS_YS + 17301504;
constexpr size_t WS_OMD  = WS_BIG + 164364288;
constexpr size_t WS_ASIG = WS_OMD + 17301504;
constexpr size_t WS_END  = WS_ASIG + 17301504;
static_assert(WS_LA + 8650752 <= WS_OMD, "mixer overlays");
static_assert(WS_END <= 268435456, "workspace");

struct Params {
    const float *x_prompt, *x_sample, *state_shift, *state_wkv, *state_ret, *norm_g, *f1g, *f1u, *f1d, *w_in, *mu, *w0, *w2, *a0, *a2, *g2, *k_k, *k_a, *r_k, *lnx_w, *lnx_b, *gn_w, *w_out, *f2g, *f2u, *f2d;
    float* out; unsigned char* ws;
};
#define CAS __attribute__((address_space(4)))
typedef const CAS Params& PR;

__device__ __forceinline__ float bf2f(unsigned b) { return __uint_as_float(b << 16); }
__device__ __forceinline__ bf16_t f2bf(float f) { unsigned u = __float_as_uint(f); u += 0x7FFFu + ((u >> 16) & 1u); return (bf16_t)(u >> 16); }
__device__ __forceinline__ float lo_bf(unsigned x) { return __uint_as_float(x << 16); }
__device__ __forceinline__ float hi_bf(unsigned x) { return __uint_as_float(x & 0xffff0000u); }
template <int CTRL> __device__ __forceinline__ float dppf(float v) { return __int_as_float(__builtin_amdgcn_update_dpp(0, __float_as_int(v), CTRL, 0xF, 0xF, false)); }
__device__ __forceinline__ float row16_sum(float v) { v += dppf<0xB1>(v); v += dppf<0x4E>(v); v += dppf<0x141>(v); v += dppf<0x140>(v); return v; }
__device__ __forceinline__ float wave_sum(float v) { v = row16_sum(v); const int i = __float_as_int(v);
    return __int_as_float(__builtin_amdgcn_readlane(i, 0)) + __int_as_float(__builtin_amdgcn_readlane(i, 16)) + __int_as_float(__builtin_amdgcn_readlane(i, 32)) + __int_as_float(__builtin_amdgcn_readlane(i, 48)); }
__device__ __forceinline__ float quad_sum(float v) { v += dppf<0xB1>(v); v += dppf<0x4E>(v); return v; }
__device__ __forceinline__ float sigmoid_f(float x) { return 1.0f / (1.0f + __expf(-x)); }


#define XB_TMO      128
#define XB_XCNT(j)  (256  + 64 * (j))
#define XB_XSUB(j)  (1280 + 64 * (j))
#define XB_XGEN(j)  (2304 + 64 * (j))
#define XB_TOP      3328
#define XB_TOPGEN   3392
#define XCD_BAR_WORDS 3456
#define XB_SPIN_CAP (1u << 18)
__device__ __forceinline__ unsigned xb_ld(unsigned* p)              { return __hip_atomic_load(p, __ATOMIC_RELAXED, __HIP_MEMORY_SCOPE_AGENT); }
__device__ __forceinline__ unsigned xb_add(unsigned* p, unsigned v) { return __hip_atomic_fetch_add(p, v, __ATOMIC_RELAXED, __HIP_MEMORY_SCOPE_AGENT); }
__device__ __forceinline__ unsigned xb_xcc_id() { return (unsigned)__builtin_amdgcn_s_getreg((3 << 11) | 20) & 0xFu; }
#define XB_SPIN(cond, bar) do { unsigned _sp = 0; while (cond) { __builtin_amdgcn_s_sleep(1); \
    if ((++_sp & 255u) == 0u) { if (xb_ld(&(bar)[XB_TMO])) break; if (_sp > XB_SPIN_CAP) { atomicAdd(&(bar)[XB_TMO], 1u); break; } } } } while (0)
struct XcdBarrier { unsigned* bar; unsigned x; volatile LAS unsigned* st; };
__device__ __forceinline__ XcdBarrier xcd_barrier_post(unsigned* bar, volatile LAS unsigned* st) {
    XcdBarrier b; b.bar = bar; b.x = xb_xcc_id(); b.st = st;
    return b;
}
__device__ __forceinline__ void xcd_barrier_complete(unsigned* bar, unsigned x, unsigned& nloc, unsigned& nx) {
    const unsigned G = gridDim.x * gridDim.y * gridDim.z;
    unsigned sum, cnt, mine, sp = 0u;
    for (;;) {
        sum = 0u; cnt = 0u; mine = 0u;
#pragma unroll
        for (unsigned j = 0; j < 16; ++j) { const unsigned c = xb_ld(&bar[XB_XCNT(j)]); sum += c; cnt += (c > 0u) ? 1u : 0u; mine = (j == x) ? c : mine; }
        if (sum == G) break;
        __builtin_amdgcn_s_sleep(1);
        if ((++sp & 255u) == 0u) { if (xb_ld(&bar[XB_TMO])) break; if (sp > XB_SPIN_CAP) { atomicAdd(&bar[XB_TMO], 1u); break; } }
    }
    nloc = mine > 0u ? mine : 1u; nx = cnt > 0u ? cnt : 1u;
}
__device__ __forceinline__ void xcd_barrier(unsigned* barw, volatile LAS unsigned* stw, const int wv) {
    XcdBarrier b; b.bar = barw; b.x = xb_xcc_id(); b.st = stw;
    asm volatile("s_waitcnt vmcnt(0)" ::: "memory");
    __syncthreads();
    if (fresh_tid(wv) == 0) {
        unsigned* bar = b.bar;
        __builtin_amdgcn_s_waitcnt(0);
        unsigned nloc = b.st[0], nx = b.st[1];
        if (nloc == 0u) { xcd_barrier_complete(bar, b.x, nloc, nx); b.st[0] = nloc; b.st[1] = nx; }
        const unsigned old = xb_add(&bar[XB_XSUB(b.x)], 1u);
        const unsigned gen = old / nloc;
        if (old + 1u == (gen + 1u) * nloc) {
            __builtin_amdgcn_fence(__ATOMIC_RELEASE, "agent");
            asm volatile("s_waitcnt vmcnt(0)" ::: "memory");
            const unsigned og = xb_add(&bar[XB_TOP], 1u);
            const unsigned tg = og / nx;
            if (og + 1u == (tg + 1u) * nx) xb_add(&bar[XB_TOPGEN], 1u);
            else XB_SPIN(xb_ld(&bar[XB_TOPGEN]) == tg, bar);
            __builtin_amdgcn_fence(__ATOMIC_ACQUIRE, "agent");
            xb_add(&bar[XB_XGEN(b.x)], 1u);
            asm volatile("s_waitcnt vmcnt(0)" ::: "memory");
        } else {
            XB_SPIN(xb_ld(&bar[XB_XGEN(b.x)]) == gen, bar);
            __builtin_amdgcn_fence(__ATOMIC_ACQUIRE, "agent");
            asm volatile("s_waitcnt vmcnt(0)" ::: "memory");
        }
    }
    __syncthreads();
}


#define DPP2(x, y, CTRL, NOP) asm volatile(NOP "\n\tv_add_f32_dpp %0, %0, %0 " CTRL " row_mask:0xf bank_mask:0xf bound_ctrl:1\n\tv_add_f32_dpp %1, %1, %1 " CTRL " row_mask:0xf bank_mask:0xf bound_ctrl:1" : "+v"(x), "+v"(y))
#define DPP4(x, y, z, w, CTRL, NOP) asm volatile(NOP "\n\tv_add_f32_dpp %0, %0, %0 " CTRL " row_mask:0xf bank_mask:0xf bound_ctrl:1\n\tv_add_f32_dpp %1, %1, %1 " CTRL " row_mask:0xf bank_mask:0xf bound_ctrl:1\n\tv_add_f32_dpp %2, %2, %2 " CTRL " row_mask:0xf bank_mask:0xf bound_ctrl:1\n\tv_add_f32_dpp %3, %3, %3 " CTRL " row_mask:0xf bank_mask:0xf bound_ctrl:1" : "+v"(x), "+v"(y), "+v"(z), "+v"(w))
#define ROW16_SUM4(x, y, z, w) do { DPP4(x, y, z, w, "quad_perm:[1,0,3,2]", "s_nop 1"); DPP4(x, y, z, w, "quad_perm:[2,3,0,1]", ""); DPP4(x, y, z, w, "row_half_mirror", ""); DPP4(x, y, z, w, "row_mirror", ""); } while (0)
#define ROW16_SUM2(x, y) do { DPP2(x, y, "quad_perm:[1,0,3,2]", "s_nop 1"); DPP2(x, y, "quad_perm:[2,3,0,1]", "s_nop 0"); DPP2(x, y, "row_half_mirror", "s_nop 0"); DPP2(x, y, "row_mirror", "s_nop 0"); } while (0)
__device__ __forceinline__ int prev_row(int r) {
    if (r < MP) return (r & 2047) == 0 ? -1 : r - 1;
    const int s = r - MP; return (s & 3) == 0 ? MT + (s >> 2) : r - 1;
}

__device__ __forceinline__ void tconv_tile(const float* __restrict__ W, int K, int N, bf16_t* __restrict__ Bt, int mode, int tile, LAS float* t, const int wv) {
    const int nkt = K / 64; const int kt = tile % nkt, nt = tile / nkt; const int k0 = kt * 64, n0 = nt * 64;
    const int brow0 = mode == 0 ? n0 : ((n0 >> 7) * 256 + (n0 & 127) + (mode == 2 ? 128 : 0));
    const int tid = fresh_tid(wv);
#pragma unroll
    for (int e = 0; e < 8; ++e) { const int idx = e * 512 + tid, r = idx >> 6, c = idx & 63; t[r * 65 + c] = W[(size_t)(k0 + r) * N + n0 + c]; }
    __syncthreads();
#pragma unroll
    for (int e = 0; e < 4; ++e) { const int idx = e * 512 + tid, n = idx >> 5, kp = idx & 31;
        const unsigned w = pg8::cvt_pk_bf16(t[(2 * kp) * 65 + n], t[(2 * kp + 1) * 65 + n]);
        *(unsigned*)(Bt + (size_t)(brow0 + n) * K + k0 + 2 * kp) = w; }
    __syncthreads();
}
__device__ __forceinline__ void ffn_weights(const float* wg, const float* wu, const float* wd, unsigned char* ws, LAS float* t, const int wv) {
    for (int i = blockIdx.x; i < 2112; i += gridDim.x) {
        if (i < 704) tconv_tile(wg, 1024, DFF, (bf16_t*)(ws + WS_WGU), 1, i, t, wv);
        else if (i < 1408) tconv_tile(wu, 1024, DFF, (bf16_t*)(ws + WS_WGU), 2, i - 704, t, wv);
        else tconv_tile(wd, DFF, 1024, (bf16_t*)(ws + WS_WD), 0, i - 1408, t, wv);
    }
}

__device__ __forceinline__ void rows_phase(PR P, const int mode, const int wv) {
    const int tid = fresh_tid(wv); const int lane = tid & 63; const int gw = blockIdx.x * 8 + (tid >> 6), nw = gridDim.x * 8;
    const bf16_t* FO = (const bf16_t*)(P.ws + WS_FO); bf16_t* XN = (bf16_t*)(P.ws + WS_XN);
    const float* gpost = P.norm_g + (mode == 1 ? 1 : (mode == 2 ? 3 : 5)) * 1024;
    const float* gnext = P.norm_g + (mode == 0 ? 0 : (mode == 1 ? 2 : 4)) * 1024;
    const float scale = mode == 2 ? 1.0f : 0.5f;
    for (int row = gw; row < MT; row += nw) {
        const float* xin = mode <= 1 ? (row < MP ? P.x_prompt + (size_t)row * 1024 : P.x_sample + (size_t)(row - MP) * 1024) : P.out + (size_t)row * 1024;
        float4 xv[4];
#pragma unroll
        for (int q = 0; q < 4; ++q) xv[q] = *(const float4*)(xin + (q * 64 + lane) * 4);
        if (mode != 0) {
            float4 fo[4]; float ss = 0.f;
#pragma unroll
            for (int q = 0; q < 4; ++q) {
                if (row < MP) { const u32x2 fb = *(const u32x2*)(FO + (size_t)row * 1024 + (q * 64 + lane) * 4); fo[q] = make_float4(lo_bf(fb.x), hi_bf(fb.x), lo_bf(fb.y), hi_bf(fb.y)); }
                else {
                    const int KS = mode == 2 ? 4 : 8; const float* sl = (const float*)(P.ws + WS_OMD) + (size_t)((((row - MP) >> 8) * 4 + q) * KS) * 65536 + (size_t)(row & 255) * 256 + lane * 4;
                    float4 a = *(const float4*)sl;
                    for (int p = 1; p < KS; ++p) { const float4 b = *(const float4*)(sl + (size_t)p * 65536); a.x += b.x; a.y += b.y; a.z += b.z; a.w += b.w; }
                    fo[q] = a; }
                ss += fo[q].x * fo[q].x + fo[q].y * fo[q].y + fo[q].z * fo[q].z + fo[q].w * fo[q].w; }
            ss = wave_sum(ss); const float r = rsqrtf(ss * (1.0f / 1024.0f) + 1e-6f) * scale;
#pragma unroll
            for (int q = 0; q < 4; ++q) { const float4 g = *(const float4*)(gpost + (q * 64 + lane) * 4);
                xv[q].x += fo[q].x * r * g.x; xv[q].y += fo[q].y * r * g.y; xv[q].z += fo[q].z * r * g.z; xv[q].w += fo[q].w * r * g.w;
                *(float4*)(P.out + (size_t)row * 1024 + (q * 64 + lane) * 4) = xv[q]; }
            if (mode == 3) continue;
        }
        float ss2 = 0.f;
#pragma unroll
        for (int q = 0; q < 4; ++q) ss2 += xv[q].x * xv[q].x + xv[q].y * xv[q].y + xv[q].z * xv[q].z + xv[q].w * xv[q].w;
        ss2 = wave_sum(ss2); const float r2 = rsqrtf(ss2 * (1.0f / 1024.0f) + 1e-6f);
        float* sh = nullptr;
        if (mode == 1) { if (row < MP) { if ((row & 2047) == 2047) sh = P.out + O_SHP + (size_t)(row >> 11) * 1024; } else { const int s = row - MP; if ((s & 3) == 3) sh = P.out + O_SHS + (size_t)(s >> 2) * 1024; } }
#pragma unroll
        for (int q = 0; q < 4; ++q) { const float4 g = *(const float4*)(gnext + (q * 64 + lane) * 4);
            float4 hv; hv.x = xv[q].x * r2 * g.x; hv.y = xv[q].y * r2 * g.y; hv.z = xv[q].z * r2 * g.z; hv.w = xv[q].w * r2 * g.w;
            u32x2 w; w.x = pg8::cvt_pk_bf16(hv.x, hv.y); w.y = pg8::cvt_pk_bf16(hv.z, hv.w);
            *(u32x2*)(XN + (size_t)row * 1024 + (q * 64 + lane) * 4) = w;
            if (sh) *(float4*)(sh + (q * 64 + lane) * 4) = hv; }
    }
}

__device__ __forceinline__ void p0_prologue(PR P, LAS float* ldsf, const int wv) {
    const int tid = fresh_tid(wv); const size_t gt = (size_t)blockIdx.x * 512 + tid, nth = (size_t)gridDim.x * 512;
    { float* rc = (float*)(P.ws + WS_ROPE); float* rs = rc + 2052 * 64;
      for (size_t i = gt; i < 2052 * 64; i += nth) { const int p = (int)(i >> 6), f = (int)(i & 63); const int pos = p < 2048 ? p : 16384 + (p - 2048);
          double inv = 1.0; for (int q = 0; q < f; ++q) inv *= 0.8659643233600653;
          const double ang = (double)pos * inv; const double n = rint(ang * 0.15915494309189535); const double r = ang - n * 6.283185307179586;
          const double r2 = r * r; double s = 0.0, c = 0.0;
          for (int k = 14; k >= 0; --k) { s = s * (-r2 / (double)((2 * k + 2) * (2 * k + 3))) + 1.0; c = c * (-r2 / (double)((2 * k + 1) * (2 * k + 2))) + 1.0; }
          rc[i] = (float)c; rs[i] = (float)(s * r); } }
    { bf16_t* Wl = (bf16_t*)(P.ws + WS_WL);
      for (size_t i = gt; i < 1536 * 256; i += nth) { const int n = (int)(i >> 8), k = (int)(i & 255); float v = 0.f;
          if (n < 512) { if (k < 64) v = P.w2[k * 512 + n]; } else if (n < 1024) { if (k >= 64 && k < 128) v = P.a2[(k - 64) * 512 + (n - 512)]; } else { if (k >= 128) v = P.g2[(k - 128) * 512 + (n - 1024)]; }
          Wl[i] = f2bf(v); } }
    { bf16_t* XN = (bf16_t*)(P.ws + WS_XN);
      for (size_t i = gt; i < 256 * 1024; i += nth) { const int r = (int)(i >> 10); XN[(size_t)MT * 1024 + i] = r < 128 ? f2bf(P.state_shift[i]) : (bf16_t)0; } }
    ffn_weights(P.f1g, P.f1u, P.f1d, P.ws, ldsf, wv);
    for (int i = blockIdx.x; i < 1216; i += gridDim.x) {
        if (i < 960) tconv_tile(P.w_in, 1024, NCOLS, (bf16_t*)(P.ws + WS_WIN), 0, i, ldsf, wv);
        else tconv_tile(P.w_out, 1024, 1024, (bf16_t*)(P.ws + WS_WOUT), 0, i - 960, ldsf, wv);
    }
    rows_phase(P, 0, wv);
}

__device__ __forceinline__ void lora_prep(PR P, const int wv) {
    const int tid = fresh_tid(wv); const int lane = tid & 63; const int gw = blockIdx.x * 8 + (tid >> 6), nw = gridDim.x * 8;
    const bf16_t* PS = (const bf16_t*)(P.ws + WS_BIG); bf16_t* LA = (bf16_t*)(P.ws + WS_LA);
    const float4 mu = *(const float4*)(P.mu + 1536 + lane * 4); const int kind = lane >> 4;
    for (int row = gw; row < MT; row += nw) {
        const u32x2 c = *(const u32x2*)(PS + (size_t)row * NCOLS + 1536 + lane * 4); const int pr = prev_row(row);
        u32x2 p = (u32x2){0u, 0u}; if (pr >= 0) p = *(const u32x2*)(PS + (size_t)pr * NCOLS + 1536 + lane * 4);
        float v[4]; const float cu[4] = {lo_bf(c.x), hi_bf(c.x), lo_bf(c.y), hi_bf(c.y)}, pv[4] = {lo_bf(p.x), hi_bf(p.x), lo_bf(p.y), hi_bf(p.y)}, m4[4] = {mu.x, mu.y, mu.z, mu.w};
#pragma unroll
        for (int j = 0; j < 4; ++j) { float x = cu[j] + (pv[j] - cu[j]) * m4[j];
            if (kind == 0) x = 1.0f - 2.0f / (__expf(2.0f * x) + 1.0f); else if (kind >= 2) x = sigmoid_f(x);
            v[j] = x; }
        u32x2 w; w.x = pg8::cvt_pk_bf16(v[0], v[1]); w.y = pg8::cvt_pk_bf16(v[2], v[3]);
        *(u32x2*)(LA + (size_t)row * 256 + lane * 4) = w;
    }
}

template <bool SAMPLE>
__device__ __forceinline__ void rwkv_unit(PR P, LAS float* lds, const int b, const int h, const int half, const int wv) {
    constexpr int T = SAMPLE ? 4 : 2048, TC = SAMPLE ? 4 : 32, NCH = T / TC;
    const int tid = fresh_tid(wv), lane = tid & 63, wid = tid >> 6;
    const bf16_t* PS = (const bf16_t*)(P.ws + WS_BIG); const bf16_t* OMD = (const bf16_t*)(P.ws + WS_OMD); const bf16_t* ASIG = (const bf16_t*)(P.ws + WS_ASIG);
    bf16_t* YS = (bf16_t*)(P.ws + WS_YS);
    const int row_base = SAMPLE ? MP + b * 4 : b * 2048;
    const int ltok = (tid - 256) >> 4, lcg = tid & 15; const bool lwave = tid >= 256; const int hch = h * 64 + lcg * 4;
    const float4 mur = *(const float4*)(P.mu + hch), muk = *(const float4*)(P.mu + 512 + hch), muv = *(const float4*)(P.mu + 1024 + hch);
    const float4 kk4 = *(const float4*)(P.k_k + hch), ka4 = *(const float4*)(P.k_a + hch);
    typedef float f32x2 __attribute__((ext_vector_type(2)));
    const int row0 = half * 32 + (wid & 3) * 8 + (lane >> 4) * 2, cgl = lane & 15, j0 = cgl * 4;
    f32x2 S[4];
#pragma unroll
    for (int c = 0; c < 4; ++c) S[c] = (f32x2){0.f, 0.f};
    float* sout = P.out + (SAMPLE ? O_WKS : O_WKP) + ((size_t)(b * 8 + h) * 64 + row0) * 64 + j0;
    if (SAMPLE && wid < 4) { const float* sp = P.state_wkv + ((size_t)(b * 8 + h) * 64 + row0) * 64 + j0; const float4 s0 = *(const float4*)sp, s1 = *(const float4*)(sp + 64);
        S[0] = (f32x2){s0.x, s1.x}; S[1] = (f32x2){s0.y, s1.y}; S[2] = (f32x2){s0.z, s1.z}; S[3] = (f32x2){s0.w, s1.w}; }
    LAS float* buf0 = lds; LAS float* buf1 = lds + TC * 384;
    u32x2 cr[2], ck[2], cv[2], pr[2], pk[2], pv[2], co[2], ca[2];
#define RW_LOAD1(c, U) do { if (lwave && ltok + 16 * (U) < TC) { const int t_ = (c) * TC + ltok + 16 * (U); const int row_ = row_base + t_; const int prow_ = SAMPLE ? (t_ == 0 ? MT + b : row_ - 1) : row_ - 1; \
        const bf16_t* cp_ = PS + (size_t)row_ * NCOLS + hch; cr[U] = *(const u32x2*)cp_; ck[U] = *(const u32x2*)(cp_ + 512); cv[U] = *(const u32x2*)(cp_ + 1024); \
        if (SAMPLE || t_ > 0) { const bf16_t* pp_ = PS + (size_t)prow_ * NCOLS + hch; pr[U] = *(const u32x2*)pp_; pk[U] = *(const u32x2*)(pp_ + 512); pv[U] = *(const u32x2*)(pp_ + 1024); } \
        else { pr[U] = (u32x2){0u, 0u}; pk[U] = pr[U]; pv[U] = pr[U]; } \
        co[U] = *(const u32x2*)(OMD + (size_t)row_ * 512 + hch); ca[U] = *(const u32x2*)(ASIG + (size_t)row_ * 512 + hch); } } while (0)
#define RW_LOAD(c) do { RW_LOAD1(c, 0); RW_LOAD1(c, 1); } while (0)
#define RW_MIX(cu, pv_, m) ((cu) + ((pv_) - (cu)) * (m))
#define RW_PROC1(dst, U) do { if (lwave && ltok + 16 * (U) < TC) { LAS float* d_ = (dst) + (ltok + 16 * (U)) * 384 + lcg * 4; \
        f32x4 r_, k_, v_, o_, a_; \
        r_[0] = RW_MIX(lo_bf(cr[U].x), lo_bf(pr[U].x), mur.x); r_[1] = RW_MIX(hi_bf(cr[U].x), hi_bf(pr[U].x), mur.y); r_[2] = RW_MIX(lo_bf(cr[U].y), lo_bf(pr[U].y), mur.z); r_[3] = RW_MIX(hi_bf(cr[U].y), hi_bf(pr[U].y), mur.w); \
        k_[0] = RW_MIX(lo_bf(ck[U].x), lo_bf(pk[U].x), muk.x); k_[1] = RW_MIX(hi_bf(ck[U].x), hi_bf(pk[U].x), muk.y); k_[2] = RW_MIX(lo_bf(ck[U].y), lo_bf(pk[U].y), muk.z); k_[3] = RW_MIX(hi_bf(ck[U].y), hi_bf(pk[U].y), muk.w); \
        v_[0] = RW_MIX(lo_bf(cv[U].x), lo_bf(pv[U].x), muv.x); v_[1] = RW_MIX(hi_bf(cv[U].x), hi_bf(pv[U].x), muv.y); v_[2] = RW_MIX(lo_bf(cv[U].y), lo_bf(pv[U].y), muv.z); v_[3] = RW_MIX(hi_bf(cv[U].y), hi_bf(pv[U].y), muv.w); \
        o_[0] = lo_bf(co[U].x); o_[1] = hi_bf(co[U].x); o_[2] = lo_bf(co[U].y); o_[3] = hi_bf(co[U].y); a_[0] = lo_bf(ca[U].x); a_[1] = hi_bf(ca[U].x); a_[2] = lo_bf(ca[U].y); a_[3] = hi_bf(ca[U].y); \
        f32x4 kk_; kk_[0] = k_[0] * kk4.x; kk_[1] = k_[1] * kk4.y; kk_[2] = k_[2] * kk4.z; kk_[3] = k_[3] * kk4.w; \
        float ss_ = kk_[0] * kk_[0] + kk_[1] * kk_[1] + kk_[2] * kk_[2] + kk_[3] * kk_[3]; ss_ = row16_sum(ss_); \
        const float inv_ = 1.0f / fmaxf(sqrtf(ss_), 1e-12f); kk_ = kk_ * inv_; \
        f32x4 kn_; kn_[0] = k_[0] * (1.0f + (a_[0] - 1.0f) * ka4.x); kn_[1] = k_[1] * (1.0f + (a_[1] - 1.0f) * ka4.y); kn_[2] = k_[2] * (1.0f + (a_[2] - 1.0f) * ka4.z); kn_[3] = k_[3] * (1.0f + (a_[3] - 1.0f) * ka4.w); \
        *(LAS f32x4*)(d_) = r_; *(LAS f32x4*)(d_ + 64) = o_; *(LAS f32x4*)(d_ + 128) = kn_; *(LAS f32x4*)(d_ + 192) = -kk_; *(LAS f32x4*)(d_ + 256) = kk_ * a_; *(LAS f32x4*)(d_ + 320) = v_; } } while (0)
#define RW_PROC(dst) do { RW_PROC1(dst, 0); RW_PROC1(dst, 1); } while (0)
    RW_LOAD(0); RW_PROC(buf0); __syncthreads();
    for (int c = 0; c < NCH; ++c) {
        LAS float* cur = (c & 1) ? buf1 : buf0; LAS float* nxt = (c & 1) ? buf0 : buf1;
        if (c + 1 < NCH) RW_LOAD(c + 1);
        if (wid < 4) {
            constexpr int GS = SAMPLE ? 4 : 16;
            for (int g = 0; g < TC / GS; ++g) {
                float yk0 = 0.f, yk1 = 0.f;
                const LAS float* q0 = cur + (g * GS) * 384;
                f32x4 r4 = *(const LAS f32x4*)(q0 + j0), o4 = *(const LAS f32x4*)(q0 + 64 + j0), k4 = *(const LAS f32x4*)(q0 + 128 + j0), a4 = *(const LAS f32x4*)(q0 + 192 + j0), b4 = *(const LAS f32x4*)(q0 + 256 + j0);
                f32x2 v2 = *(const LAS f32x2*)(q0 + 320 + row0);
                float py0 = 0.f, py1 = 0.f;
#pragma unroll
                for (int tt = 0; tt < GS; ++tt) {
                    const LAS float* qn = q0 + (tt + 1 < GS ? tt + 1 : tt) * 384;
                    const f32x4 nr4 = *(const LAS f32x4*)(qn + j0), no4 = *(const LAS f32x4*)(qn + 64 + j0), nk4 = *(const LAS f32x4*)(qn + 128 + j0), na4 = *(const LAS f32x4*)(qn + 192 + j0), nb4 = *(const LAS f32x4*)(qn + 256 + j0);
                    const f32x2 nv2 = *(const LAS f32x2*)(qn + 320 + row0);
                    f32x2 sa = (S[0] * a4[0] + S[1] * a4[1]) + (S[2] * a4[2] + S[3] * a4[3]);
                    float sx = sa.x, sy = sa.y; ROW16_SUM4(sx, sy, py0, py1); sa = (f32x2){sx, sy};
                    if (tt > 0) { yk0 = cgl == tt - 1 ? py0 : yk0; yk1 = cgl == tt - 1 ? py1 : yk1; }
#pragma unroll
                    for (int c = 0; c < 4; ++c) { f32x2 t = S[c] - S[c] * o4[c]; t = t + sa * b4[c]; S[c] = t + v2 * k4[c]; }
                    const f32x2 y = (S[0] * r4[0] + S[1] * r4[1]) + (S[2] * r4[2] + S[3] * r4[3]);
                    py0 = y.x; py1 = y.y;
                    r4 = nr4; o4 = no4; k4 = nk4; a4 = na4; b4 = nb4; v2 = nv2;
                }
                ROW16_SUM2(py0, py1); yk0 = cgl == GS - 1 ? py0 : yk0; yk1 = cgl == GS - 1 ? py1 : yk1;
                if (cgl < GS) *(unsigned*)(YS + (size_t)(row_base + c * TC + g * GS + cgl) * 512 + h * 64 + row0) = pg8::cvt_pk_bf16(yk0, yk1);
            }
        }
        if (c + 1 < NCH) RW_PROC(nxt);
        __syncthreads();
    }
    if (wid < 4) { *(float4*)sout = make_float4(S[0].x, S[1].x, S[2].x, S[3].x); *(float4*)(sout + 64) = make_float4(S[0].y, S[1].y, S[2].y, S[3].y); }
#undef RW_LOAD
#undef RW_PROC
#undef RW_LOAD1
#undef RW_PROC1
#undef RW_MIX
}

__device__ __forceinline__ void ret_sample_unit(PR P, LAS float* lds, const int b, const int h, const int wv) {
    const int tid = fresh_tid(wv), lane = tid & 63, wid = tid >> 6;
    const bf16_t* PS = (const bf16_t*)(P.ws + WS_BIG); bf16_t* Y = (bf16_t*)(P.ws + WS_XN);
    const float* rc = (const float*)(P.ws + WS_ROPE); const float* rs = rc + 2052 * 64;
    LAS float* q = lds; LAS float* k = lds + 512; LAS float* v = lds + 1024; LAS float* Pm = lds + 1536; LAS float* y2p = lds + 1600; LAS float* red = lds + 1600 + 2048;
    const float lg2 = log2f(1.0f - exp2f(-5.0f - (float)h));
    const int row0 = MP + b * 4;
    { const int t = (tid & 255) >> 6, f = tid & 63; const bf16_t* src = PS + (size_t)(row0 + t) * NCOLS + 1792 + h * 128;
      if (tid < 256) { const float cs = rc[(2048 + t) * 64 + f], sn = rs[(2048 + t) * 64 + f];
          const float q1 = bf2f(src[f]), q2 = bf2f(src[f + 64]); q[t * 128 + f] = q1 * cs - q2 * sn; q[t * 128 + f + 64] = q1 * sn + q2 * cs;
          const float k1 = bf2f(src[512 + f]), k2 = bf2f(src[512 + f + 64]); k[t * 128 + f] = (k1 * cs - k2 * sn) * 0.08838834764831845f; k[t * 128 + f + 64] = (k1 * sn + k2 * cs) * 0.08838834764831845f; }
      else { v[t * 128 + f] = bf2f(src[1024 + f]); v[t * 128 + f + 64] = bf2f(src[1024 + f + 64]); } }
    __syncthreads();
    if (wid == 0) { const int pi = lane >> 4, pj = (lane >> 2) & 3, part = lane & 3; float s = 0.f;
        for (int d = part * 32; d < part * 32 + 32; ++d) s += q[pi * 128 + d] * k[pj * 128 + d];
        s = quad_sum(s); if (part == 0) Pm[pi * 4 + pj] = pi >= pj ? s * exp2f(lg2 * (float)(pi - pj)) : 0.f; }
    { const int e = tid & 127, dg = tid >> 7; const float c4 = exp2f(lg2 * 4.0f), g3 = exp2f(lg2 * 3.0f), g2_ = exp2f(lg2 * 2.0f), g1 = exp2f(lg2);
      const float v0 = v[e] * g3, v1 = v[128 + e] * g2_, v2 = v[256 + e] * g1, v3 = v[384 + e];
      const float* S0 = P.state_ret + ((size_t)(b * 4 + h) * 128) * 128 + e; float* So = P.out + O_RTS + ((size_t)(b * 4 + h) * 128) * 128 + e;
      float a0 = 0.f, a1 = 0.f, a2 = 0.f, a3 = 0.f;
      float sv[32];
#pragma unroll
      for (int x = 0; x < 32; ++x) sv[x] = S0[(size_t)(dg * 32 + x) * 128];
#pragma unroll
      for (int x = 0; x < 32; ++x) { const int d = dg * 32 + x; const float s = sv[x];
          a0 = fmaf(q[d], s, a0); a1 = fmaf(q[128 + d], s, a1); a2 = fmaf(q[256 + d], s, a2); a3 = fmaf(q[384 + d], s, a3);
          So[(size_t)d * 128] = s * c4 + k[d] * v0 + k[128 + d] * v1 + k[256 + d] * v2 + k[384 + d] * v3; }
      y2p[(dg * 4 + 0) * 128 + e] = a0; y2p[(dg * 4 + 1) * 128 + e] = a1; y2p[(dg * 4 + 2) * 128 + e] = a2; y2p[(dg * 4 + 3) * 128 + e] = a3; }
    __syncthreads();
    { const int i = tid >> 7, e = tid & 127;
      float y = (y2p[(0 + i) * 128 + e] + y2p[(4 + i) * 128 + e] + y2p[(8 + i) * 128 + e] + y2p[(12 + i) * 128 + e]) * exp2f(lg2 * (float)(i + 1));
#pragma unroll
      for (int j = 0; j < 4; ++j) y = fmaf(Pm[i * 4 + j], v[j * 128 + e], y);
      float s = wave_sum(y); if (lane == 0) red[wid] = s; __syncthreads();
      const float mean = (red[i * 2] + red[i * 2 + 1]) * (1.0f / 128.0f); const float dlt = y - mean;
      float s2 = wave_sum(dlt * dlt); if (lane == 0) red[8 + wid] = s2; __syncthreads();
      const float var = (red[8 + i * 2] + red[8 + i * 2 + 1]) * (1.0f / 128.0f);
      const float g = bf2f(PS[(size_t)(row0 + i) * NCOLS + 1792 + 1536 + h * 128 + e]);
      const float o = dlt * rsqrtf(var + 1e-5f) * P.gn_w[h * 128 + e] * (g / (1.0f + __expf(-g)));
      Y[(size_t)(row0 + i) * 1024 + 512 + h * 128 + e] = f2bf(o); }
    __syncthreads();
}

__device__ __forceinline__ bf16_t* kvb_ptr(unsigned char* ws, int bh) { return (bf16_t*)(bh < 29 ? ws + WS_LA + (size_t)bh * 524288 : ws + WS_WIN + 17301504 + (size_t)(bh - 29) * 524288); }
constexpr int RS = 136, BUFE = 128 * RS;

template <bool WITH_K>
__device__ __forceinline__ void ret_load_qk(PR P, LAS bf16_t* QP, LAS bf16_t* KB, unsigned (&kth)[4][4], const int tidv, const int row0, const int n, const int h, const float kd0, const float g32) {
    const bf16_t* PS = (const bf16_t*)(P.ws + WS_BIG); const float* rc = (const float*)(P.ws + WS_ROPE); const float* rs = rc + 2052 * 64;
    float kd = kd0;
#pragma unroll
    for (int it = 0; it < 4; ++it) { const int idx = it * 512 + tidv, i = idx >> 4, f = (idx & 15) * 4;
        const bf16_t* src = PS + (size_t)(row0 + i) * NCOLS + 1792 + h * 128;
        const u32x2 q1 = *(const u32x2*)(src + f), q2 = *(const u32x2*)(src + 64 + f);
        u32x2 k1 = (u32x2){0u, 0u}, k2 = k1; if (WITH_K) { k1 = *(const u32x2*)(src + 512 + f); k2 = *(const u32x2*)(src + 576 + f); }
        const float4 cs = *(const float4*)(rc + (size_t)(n * 128 + i) * 64 + f), sn = *(const float4*)(rs + (size_t)(n * 128 + i) * 64 + f);
        const float c4[4] = {cs.x, cs.y, cs.z, cs.w}, s4[4] = {sn.x, sn.y, sn.z, sn.w};
        const float qa[4] = {lo_bf(q1.x), hi_bf(q1.x), lo_bf(q1.y), hi_bf(q1.y)}, qb[4] = {lo_bf(q2.x), hi_bf(q2.x), lo_bf(q2.y), hi_bf(q2.y)};
        float qo1[4], qo2[4];
#pragma unroll
        for (int x = 0; x < 4; ++x) { qo1[x] = qa[x] * c4[x] - qb[x] * s4[x]; qo2[x] = qa[x] * s4[x] + qb[x] * c4[x]; }
        u32x2 w; w.x = pg8::cvt_pk_bf16(qo1[0], qo1[1]); w.y = pg8::cvt_pk_bf16(qo1[2], qo1[3]); *(LAS u32x2*)(QP + i * RS + f) = w;
        w.x = pg8::cvt_pk_bf16(qo2[0], qo2[1]); w.y = pg8::cvt_pk_bf16(qo2[2], qo2[3]); *(LAS u32x2*)(QP + i * RS + 64 + f) = w;
        if (WITH_K) {
            const float ka[4] = {lo_bf(k1.x), hi_bf(k1.x), lo_bf(k1.y), hi_bf(k1.y)}, kb[4] = {lo_bf(k2.x), hi_bf(k2.x), lo_bf(k2.y), hi_bf(k2.y)};
            float ko1[4], ko2[4];
#pragma unroll
            for (int x = 0; x < 4; ++x) { ko1[x] = (ka[x] * c4[x] - kb[x] * s4[x]) * 0.08838834764831845f; ko2[x] = (ka[x] * s4[x] + kb[x] * c4[x]) * 0.08838834764831845f; }
            w.x = pg8::cvt_pk_bf16(ko1[0], ko1[1]); w.y = pg8::cvt_pk_bf16(ko1[2], ko1[3]); *(LAS u32x2*)(KB + i * RS + f) = w;
            w.x = pg8::cvt_pk_bf16(ko2[0], ko2[1]); w.y = pg8::cvt_pk_bf16(ko2[2], ko2[3]); *(LAS u32x2*)(KB + i * RS + 64 + f) = w;
            kth[it][0] = pg8::cvt_pk_bf16(ko1[0] * kd, ko1[1] * kd); kth[it][1] = pg8::cvt_pk_bf16(ko1[2] * kd, ko1[3] * kd);
            kth[it][2] = pg8::cvt_pk_bf16(ko2[0] * kd, ko2[1] * kd); kth[it][3] = pg8::cvt_pk_bf16(ko2[2] * kd, ko2[3] * kd); kd *= g32; }
        if (it & 1) __builtin_amdgcn_sched_barrier(0); }
}

__device__ __forceinline__ void ret_unit_a(PR P, LAS unsigned char* lds, const int bh, const int n, const int wv) {
    LAS bf16_t* QP = (LAS bf16_t*)lds; LAS bf16_t* KB = QP + BUFE; LAS bf16_t* VT = KB + BUFE;
    const int tid = fresh_tid(wv), lane = tid & 63, wid = tid >> 6, wr = wid >> 1, wc = wid & 1, fr = lane & 15, fq = lane >> 4;
    const int b = bh >> 2, h = bh & 3;
    const bf16_t* PS = (const bf16_t*)(P.ws + WS_BIG); bf16_t* Y = (bf16_t*)(P.ws + WS_XN); bf16_t* KVB = kvb_ptr(P.ws, bh) + (size_t)n * 16384;
    const float lg2 = log2f(1.0f - exp2f(-5.0f - (float)h));
    const float kd0 = exp2f(lg2 * (float)(127 - (tid >> 4))), g32 = exp2f(-32.0f * lg2);
    const int row0 = b * 2048 + n * 128;
    unsigned kth[4][4];
    ret_load_qk<true>(P, QP, KB, kth, tid, row0, n, h, kd0, g32);
#pragma unroll
    for (int it = 0; it < 4; ++it) { const int idx = it * 512 + tid, j = idx >> 4, e = (idx & 15) * 8;
        const u32x4 vv = *(const u32x4*)(PS + (size_t)(row0 + j) * NCOLS + 1792 + 1024 + h * 128 + e);
        LAS bf16_t* d = VT + e * RS + j;
        d[0] = (bf16_t)(vv.x & 0xffffu); d[RS] = (bf16_t)(vv.x >> 16); d[2 * RS] = (bf16_t)(vv.y & 0xffffu); d[3 * RS] = (bf16_t)(vv.y >> 16);
        d[4 * RS] = (bf16_t)(vv.z & 0xffffu); d[5 * RS] = (bf16_t)(vv.z >> 16); d[6 * RS] = (bf16_t)(vv.w & 0xffffu); d[7 * RS] = (bf16_t)(vv.w >> 16); }
    __syncthreads();
    f32x4 accP[2][4];
#pragma unroll
    for (int mt = 0; mt < 2; ++mt)
#pragma unroll
        for (int nt = 0; nt < 4; ++nt) accP[mt][nt] = (f32x4){0.f, 0.f, 0.f, 0.f};
#pragma unroll
    for (int ks = 0; ks < 4; ++ks) { bf16x8 aq[2];
#pragma unroll
        for (int mt = 0; mt < 2; ++mt) aq[mt] = *(const LAS bf16x8*)(QP + (wr * 32 + mt * 16 + fr) * RS + ks * 32 + fq * 8);
#pragma unroll
        for (int nt = 0; nt < 4; ++nt) { const bf16x8 bk = *(const LAS bf16x8*)(KB + (wc * 64 + nt * 16 + fr) * RS + ks * 32 + fq * 8);
#pragma unroll
            for (int mt = 0; mt < 2; ++mt) accP[mt][nt] = __builtin_amdgcn_mfma_f32_16x16x32_bf16(aq[mt], bk, accP[mt][nt], 0, 0, 0); }
        __builtin_amdgcn_sched_barrier(0); }
    __syncthreads();
    { float ri[2][4], cj[4];
#pragma unroll
      for (int mt = 0; mt < 2; ++mt)
#pragma unroll
          for (int j = 0; j < 4; ++j) ri[mt][j] = exp2f(lg2 * (float)(wr * 32 + mt * 16 + fq * 4 + j));
#pragma unroll
      for (int nt = 0; nt < 4; ++nt) cj[nt] = exp2f(-lg2 * (float)(wc * 64 + nt * 16 + fr));
#pragma unroll
      for (int mt = 0; mt < 2; ++mt)
#pragma unroll
          for (int nt = 0; nt < 4; ++nt)
#pragma unroll
              for (int j = 0; j < 4; ++j) { const int i = wr * 32 + mt * 16 + fq * 4 + j, jj = wc * 64 + nt * 16 + fr;
                  const float val = i >= jj ? accP[mt][nt][j] * ri[mt][j] * cj[nt] : 0.f; QP[i * RS + jj] = f2bf(val); } }
#pragma unroll
    for (int it = 0; it < 4; ++it) { const int idx = it * 512 + tid, j = idx >> 4, f = (idx & 15) * 4; LAS bf16_t* d = KB + f * RS + j;
        d[0] = (bf16_t)(kth[it][0] & 0xffffu); d[RS] = (bf16_t)(kth[it][0] >> 16); d[2 * RS] = (bf16_t)(kth[it][1] & 0xffffu); d[3 * RS] = (bf16_t)(kth[it][1] >> 16);
        LAS bf16_t* d2 = d + 64 * RS;
        d2[0] = (bf16_t)(kth[it][2] & 0xffffu); d2[RS] = (bf16_t)(kth[it][2] >> 16); d2[2 * RS] = (bf16_t)(kth[it][3] & 0xffffu); d2[3 * RS] = (bf16_t)(kth[it][3] >> 16); }
    __syncthreads();
    f32x4 accY[2][4], accS[2][4];
#pragma unroll
    for (int mt = 0; mt < 2; ++mt)
#pragma unroll
        for (int nt = 0; nt < 4; ++nt) { accY[mt][nt] = (f32x4){0.f, 0.f, 0.f, 0.f}; accS[mt][nt] = (f32x4){0.f, 0.f, 0.f, 0.f}; }
#pragma unroll
    for (int ks = 0; ks < 4; ++ks) { bf16x8 ap[2], av[2];
#pragma unroll
        for (int mt = 0; mt < 2; ++mt) { ap[mt] = *(const LAS bf16x8*)(QP + (wr * 32 + mt * 16 + fr) * RS + ks * 32 + fq * 8); av[mt] = *(const LAS bf16x8*)(VT + (wr * 32 + mt * 16 + fr) * RS + ks * 32 + fq * 8); }
#pragma unroll
        for (int nt = 0; nt < 4; ++nt) { const bf16x8 bv = *(const LAS bf16x8*)(VT + (wc * 64 + nt * 16 + fr) * RS + ks * 32 + fq * 8), bkt = *(const LAS bf16x8*)(KB + (wc * 64 + nt * 16 + fr) * RS + ks * 32 + fq * 8);
#pragma unroll
            for (int mt = 0; mt < 2; ++mt) { accY[mt][nt] = __builtin_amdgcn_mfma_f32_16x16x32_bf16(ap[mt], bv, accY[mt][nt], 0, 0, 0); accS[mt][nt] = __builtin_amdgcn_mfma_f32_16x16x32_bf16(av[mt], bkt, accS[mt][nt], 0, 0, 0); } }
        __builtin_amdgcn_sched_barrier(0); }
#pragma unroll
    for (int mt = 0; mt < 2; ++mt)
#pragma unroll
        for (int nt = 0; nt < 4; ++nt)
#pragma unroll
            for (int j = 0; j < 4; ++j) { const int r = wr * 32 + mt * 16 + fq * 4 + j, c = wc * 64 + nt * 16 + fr;
                Y[(size_t)(row0 + r) * 1024 + 512 + h * 128 + c] = f2bf(accY[mt][nt][j]); KVB[r * 128 + c] = f2bf(accS[mt][nt][j]); }
    __syncthreads();
}

__device__ __forceinline__ void ret_prefix(PR P, const int item) {
    const int bh = item >> 11, i8 = (item & 2047) * 8; const int h = bh & 3;
    bf16_t* KVB = kvb_ptr(P.ws, bh) + i8;
    const float lg2 = log2f(1.0f - exp2f(-5.0f - (float)h)); const float c_dec = exp2f(lg2 * 128.0f);
    u32x4 kv[16];
#pragma unroll
    for (int n = 0; n < 16; ++n) kv[n] = *(const u32x4*)(KVB + (size_t)n * 16384);
    float S[8];
#pragma unroll
    for (int x = 0; x < 8; ++x) S[x] = 0.f;
#pragma unroll
    for (int n = 0; n < 16; ++n) { u32x4 w; w.x = pg8::cvt_pk_bf16(S[0], S[1]); w.y = pg8::cvt_pk_bf16(S[2], S[3]); w.z = pg8::cvt_pk_bf16(S[4], S[5]); w.w = pg8::cvt_pk_bf16(S[6], S[7]);
        *(u32x4*)(KVB + (size_t)n * 16384) = w;
        const float k8[8] = {lo_bf(kv[n].x), hi_bf(kv[n].x), lo_bf(kv[n].y), hi_bf(kv[n].y), lo_bf(kv[n].z), hi_bf(kv[n].z), lo_bf(kv[n].w), hi_bf(kv[n].w)};
#pragma unroll
        for (int x = 0; x < 8; ++x) S[x] = S[x] * c_dec + k8[x]; }
    const int e = i8 >> 7, d0 = i8 & 127;
#pragma unroll
    for (int x = 0; x < 8; ++x) P.out[O_RTP + ((size_t)bh * 128 + d0 + x) * 128 + e] = S[x];
}

__device__ __forceinline__ void ret_unit_c(PR P, LAS unsigned char* lds, const int bh, const int n, const int wv) {
    LAS bf16_t* QP = (LAS bf16_t*)lds; LAS bf16_t* ST = QP + 3 * BUFE; LAS float* YST = (LAS float*)(QP + BUFE);
    const int tid = fresh_tid(wv), lane = tid & 63, wid = tid >> 6, wr = wid >> 1, wc = wid & 1, fr = lane & 15, fq = lane >> 4;
    const int b = bh >> 2, h = bh & 3;
    const bf16_t* PS = (const bf16_t*)(P.ws + WS_BIG); bf16_t* Y = (bf16_t*)(P.ws + WS_XN); const bf16_t* KVB = kvb_ptr(P.ws, bh) + (size_t)n * 16384;
    const float lg2 = log2f(1.0f - exp2f(-5.0f - (float)h));
    const int row0 = b * 2048 + n * 128;
    unsigned kth[4][4];
    ret_load_qk<false>(P, QP, QP, kth, tid, row0, n, h, 0.f, 0.f);
#pragma unroll
    for (int it = 0; it < 4; ++it) { const int idx = it * 512 + tid, e = idx >> 4, d8 = (idx & 15) * 8;
        *(LAS u32x4*)(ST + e * RS + d8) = *(const u32x4*)(KVB + e * 128 + d8); }
    __syncthreads();
    f32x4 accY[2][4];
#pragma unroll
    for (int mt = 0; mt < 2; ++mt)
#pragma unroll
        for (int nt = 0; nt < 4; ++nt) accY[mt][nt] = (f32x4){0.f, 0.f, 0.f, 0.f};
#pragma unroll
    for (int ks = 0; ks < 4; ++ks) { bf16x8 aq[2];
#pragma unroll
        for (int mt = 0; mt < 2; ++mt) aq[mt] = *(const LAS bf16x8*)(QP + (wr * 32 + mt * 16 + fr) * RS + ks * 32 + fq * 8);
#pragma unroll
        for (int nt = 0; nt < 4; ++nt) { const bf16x8 bs = *(const LAS bf16x8*)(ST + (wc * 64 + nt * 16 + fr) * RS + ks * 32 + fq * 8);
#pragma unroll
            for (int mt = 0; mt < 2; ++mt) accY[mt][nt] = __builtin_amdgcn_mfma_f32_16x16x32_bf16(aq[mt], bs, accY[mt][nt], 0, 0, 0); }
        __builtin_amdgcn_sched_barrier(0); }
#pragma unroll
    for (int mt = 0; mt < 2; ++mt)
#pragma unroll
        for (int j = 0; j < 4; ++j) { const int r = wr * 32 + mt * 16 + fq * 4 + j; const float qd = exp2f(lg2 * (float)(r + 1));
#pragma unroll
            for (int nt = 0; nt < 4; ++nt) YST[r * 132 + wc * 64 + nt * 16 + fr] = accY[mt][nt][j] * qd; }
    __syncthreads();
    { const int i = tid >> 2, part = tid & 3; float yv[32]; float s = 0.f;
      bf16_t* yo = Y + (size_t)(row0 + i) * 1024 + 512 + h * 128 + part * 32;
#pragma unroll
      for (int x = 0; x < 4; ++x) { const u32x4 y1 = *(const u32x4*)(yo + x * 8); const f32x4 ta = *(const LAS f32x4*)(YST + i * 132 + part * 32 + x * 8), tb = *(const LAS f32x4*)(YST + i * 132 + part * 32 + x * 8 + 4);
          yv[x * 8 + 0] = ta[0] + lo_bf(y1.x); yv[x * 8 + 1] = ta[1] + hi_bf(y1.x); yv[x * 8 + 2] = ta[2] + lo_bf(y1.y); yv[x * 8 + 3] = ta[3] + hi_bf(y1.y);
          yv[x * 8 + 4] = tb[0] + lo_bf(y1.z); yv[x * 8 + 5] = tb[1] + hi_bf(y1.z); yv[x * 8 + 6] = tb[2] + lo_bf(y1.w); yv[x * 8 + 7] = tb[3] + hi_bf(y1.w); }
#pragma unroll
      for (int x = 0; x < 32; ++x) s += yv[x];
      s = quad_sum(s); const float mean = s * (1.0f / 128.0f); float s2 = 0.f;
#pragma unroll
      for (int x = 0; x < 32; ++x) { yv[x] -= mean; s2 += yv[x] * yv[x]; }
      s2 = quad_sum(s2); const float rstd = rsqrtf(s2 * (1.0f / 128.0f) + 1e-5f);
      const bf16_t* gp = PS + (size_t)(row0 + i) * NCOLS + 1792 + 1536 + h * 128 + part * 32; const float* gw = P.gn_w + h * 128 + part * 32;
#pragma unroll
      for (int x = 0; x < 4; ++x) { const u32x4 g4 = *(const u32x4*)(gp + x * 8); const float4 w0 = *(const float4*)(gw + x * 8), w1 = *(const float4*)(gw + x * 8 + 4);
          const float gg[8] = {lo_bf(g4.x), hi_bf(g4.x), lo_bf(g4.y), hi_bf(g4.y), lo_bf(g4.z), hi_bf(g4.z), lo_bf(g4.w), hi_bf(g4.w)}; const float ww[8] = {w0.x, w0.y, w0.z, w0.w, w1.x, w1.y, w1.z, w1.w};
          float o[8];
#pragma unroll
          for (int z = 0; z < 8; ++z) o[z] = yv[x * 8 + z] * rstd * ww[z] * (gg[z] / (1.0f + __expf(-gg[z])));
          u32x4 w; w.x = pg8::cvt_pk_bf16(o[0], o[1]); w.y = pg8::cvt_pk_bf16(o[2], o[3]); w.z = pg8::cvt_pk_bf16(o[4], o[5]); w.w = pg8::cvt_pk_bf16(o[6], o[7]);
          *(u32x4*)(yo + x * 8) = w; } }
    __syncthreads();
}

__device__ __forceinline__ void sub_barrier(unsigned* cnt, const unsigned target, const int wv) {
    asm volatile("s_waitcnt vmcnt(0)" ::: "memory");
    __syncthreads();
    if (fresh_tid(wv) == 0) {
        __builtin_amdgcn_fence(__ATOMIC_RELEASE, "agent");
        asm volatile("s_waitcnt vmcnt(0)" ::: "memory");
        (void)xb_add(cnt, 1u);
        unsigned sp = 0u;
        while (xb_ld(cnt) < target) { __builtin_amdgcn_s_sleep(2); if (++sp > (1u << 20)) break; }
        __builtin_amdgcn_fence(__ATOMIC_ACQUIRE, "agent");
        asm volatile("s_waitcnt vmcnt(0)" ::: "memory");
    }
    __syncthreads();
}

__device__ __forceinline__ void rwkv_post(PR P, const int wv) {
    const int tid = fresh_tid(wv); const int lane = tid & 63; const int gw = blockIdx.x * 8 + (tid >> 6), nw = gridDim.x * 8;
    const int sub = lane >> 4, cg4 = (lane & 15) * 4;
    const bf16_t* PS = (const bf16_t*)(P.ws + WS_BIG); const bf16_t* ASIG = (const bf16_t*)(P.ws + WS_ASIG); const bf16_t* YS = (const bf16_t*)(P.ws + WS_YS);
    const bf16_t* G = (const bf16_t*)(P.ws + WS_WIN); bf16_t* Y = (bf16_t*)(P.ws + WS_XN);
    for (int task = gw; task < MT * 2; task += nw) {
        const int item = task * 4 + sub, row = item >> 3, h = item & 7, ch = h * 64 + cg4;
        const u32x2 yr = *(const u32x2*)(YS + (size_t)row * 512 + ch);
        const bf16_t* cp = PS + (size_t)row * NCOLS + ch; const int pr = prev_row(row);
        const u32x2 c_r = *(const u32x2*)cp, c_k = *(const u32x2*)(cp + 512), c_v = *(const u32x2*)(cp + 1024);
        u32x2 p_r = (u32x2){0u, 0u}, p_k = p_r, p_v = p_r;
        if (pr >= 0) { const bf16_t* pp = PS + (size_t)pr * NCOLS + ch; p_r = *(const u32x2*)pp; p_k = *(const u32x2*)(pp + 512); p_v = *(const u32x2*)(pp + 1024); }
        const u32x2 ar = *(const u32x2*)(ASIG + (size_t)row * 512 + ch), gr = *(const u32x2*)(G + (size_t)row * 512 + ch);
        const float4 mr = *(const float4*)(P.mu + ch), mk = *(const float4*)(P.mu + 512 + ch), mv = *(const float4*)(P.mu + 1024 + ch);
        const float4 ka = *(const float4*)(P.k_a + ch), rk = *(const float4*)(P.r_k + ch), lw = *(const float4*)(P.lnx_w + ch), lb = *(const float4*)(P.lnx_b + ch);
        const float ys[4] = {lo_bf(yr.x), hi_bf(yr.x), lo_bf(yr.y), hi_bf(yr.y)};
        const float mean = row16_sum(ys[0] + ys[1] + ys[2] + ys[3]) * (1.0f / 64.0f);
        float dl[4], s2 = 0.f;
#pragma unroll
        for (int j = 0; j < 4; ++j) { dl[j] = ys[j] - mean; s2 += dl[j] * dl[j]; }
        const float rstd = rsqrtf(row16_sum(s2) * (1.0f / 64.0f) + 64e-5f);
        const float cr[4] = {lo_bf(c_r.x), hi_bf(c_r.x), lo_bf(c_r.y), hi_bf(c_r.y)}, ck[4] = {lo_bf(c_k.x), hi_bf(c_k.x), lo_bf(c_k.y), hi_bf(c_k.y)}, cv[4] = {lo_bf(c_v.x), hi_bf(c_v.x), lo_bf(c_v.y), hi_bf(c_v.y)};
        const float qr[4] = {lo_bf(p_r.x), hi_bf(p_r.x), lo_bf(p_r.y), hi_bf(p_r.y)}, qk[4] = {lo_bf(p_k.x), hi_bf(p_k.x), lo_bf(p_k.y), hi_bf(p_k.y)}, qv[4] = {lo_bf(p_v.x), hi_bf(p_v.x), lo_bf(p_v.y), hi_bf(p_v.y)};
        const float aa[4] = {lo_bf(ar.x), hi_bf(ar.x), lo_bf(ar.y), hi_bf(ar.y)}, gg[4] = {lo_bf(gr.x), hi_bf(gr.x), lo_bf(gr.y), hi_bf(gr.y)};
        const float m_r[4] = {mr.x, mr.y, mr.z, mr.w}, m_k[4] = {mk.x, mk.y, mk.z, mk.w}, m_v[4] = {mv.x, mv.y, mv.z, mv.w};
        const float kaa[4] = {ka.x, ka.y, ka.z, ka.w}, rkk[4] = {rk.x, rk.y, rk.z, rk.w}, lww[4] = {lw.x, lw.y, lw.z, lw.w}, lbb[4] = {lb.x, lb.y, lb.z, lb.w};
        float v[4], bp = 0.f;
#pragma unroll
        for (int j = 0; j < 4; ++j) { const float r = cr[j] + (qr[j] - cr[j]) * m_r[j], k = ck[j] + (qk[j] - ck[j]) * m_k[j]; v[j] = cv[j] + (qv[j] - cv[j]) * m_v[j];
            const float kn = k * (1.0f + (aa[j] - 1.0f) * kaa[j]); bp += r * kn * rkk[j]; }
        const float bonus = row16_sum(bp);
        float o[4];
#pragma unroll
        for (int j = 0; j < 4; ++j) o[j] = (dl[j] * rstd * lww[j] + lbb[j] + bonus * v[j]) * gg[j];
        u32x2 w; w.x = pg8::cvt_pk_bf16(o[0], o[1]); w.y = pg8::cvt_pk_bf16(o[2], o[3]);
        *(u32x2*)(Y + (size_t)row * 1024 + ch) = w;
    }
}

__global__ void __launch_bounds__(512, 2) hymba_mega(Params P_unused) {
    extern __shared__ __attribute__((aligned(16))) unsigned char shm[];
    cg::grid_group grid = cg::this_grid();
    LAS unsigned char* lds = (LAS unsigned char*)shm; LAS float* ldsf = (LAS float*)shm;
    const int G = gridDim.x, bx = blockIdx.x;
    const int wv = __builtin_amdgcn_readfirstlane(threadIdx.x >> 6);
    const CAS Params* kp = (const CAS Params*)__builtin_amdgcn_kernarg_segment_ptr();
#define P (*kp)
#define FRESH() asm volatile("" : "+s"(kp))
#ifndef REP_SYNC
#define REP_SYNC 1
#endif
#ifndef REP_P7
#define REP_P7 1
#endif
#ifndef REP_FFN1
#define REP_FFN1 1
#endif
#ifndef REP_P0
#define REP_P0 1
#endif
#ifndef REP_P3
#define REP_P3 1
#endif
#ifndef REP_RW
#define REP_RW 1
#endif
#ifndef REP_OTH
#define REP_OTH 1
#endif
#ifndef REP_RETP
#define REP_RETP 1
#endif
#ifndef REP_SAMP
#define REP_SAMP 1
#endif
#ifndef REP_P8
#define REP_P8 1
#endif
#define GSYNC() do { for (int r_ = 0; r_ < REP_SYNC; ++r_) xcd_barrier((unsigned*)ws, (volatile LAS unsigned*)(lds + LDS_BYTES - 16), wv); FRESH(); } while (0)
#define ws (kp->ws)
#define XN ((bf16_t*)(ws + WS_XN))
#define ACT ((bf16_t*)(ws + WS_BIG))
#define FO ((float*)(ws + WS_FO))
#define PS ((bf16_t*)(ws + WS_BIG))
    pg8::StaticOrder S;
    { unsigned* barw = (unsigned*)ws; const int t0 = fresh_tid(wv); if (bx == 0) for (int i = t0; i < XCD_BAR_WORDS + 128; i += 512) barw[i] = 0u;
      if (t0 < 4) ((LAS unsigned*)(lds + LDS_BYTES - 16))[t0] = 0u; }
#ifndef PHM
#define PHM 0xFFFF
#endif
#define PH(k) if ((PHM >> (k)) & 1)
    for (int r0 = 0; r0 < REP_P0; ++r0) PH(0) p0_prologue(P, ldsf, wv);
    grid.sync(); FRESH();
    if (fresh_tid(wv) == 0) (void)xb_add(&((unsigned*)ws)[XB_XCNT(xb_xcc_id())], 1u);
    for (int rep1 = 0; rep1 < REP_FFN1; ++rep1) {
    PH(1) { pg8::Gemm g{XN, (const bf16_t*)(ws + WS_WGU), MT, NGU, 1024}; S.init(MT, NGU, G, bx, 1024); pg8::EpiSwiGLU E{ACT, DFF}; pg8::gemm_phase(lds, g, S, E, wv); }
    GSYNC();
    PH(2) { pg8::Gemm g{ACT, (const bf16_t*)(ws + WS_WD), MT, 1024, DFF}; pg8::SplitOrder S2; S2.init2(G, bx, DFF, 8); pg8::EpiFO E{(bf16_t*)FO, 1024, (float*)(ws + WS_OMD)}; pg8::gemm_phase(lds, g, S2, E, wv); }
    GSYNC();
    }
    for (int r3 = 0; r3 < REP_P3; ++r3) PH(3) rows_phase(P, 1, wv);
    GSYNC();
    PH(4) { pg8::Gemm g{XN, (const bf16_t*)(ws + WS_WIN), MIN_, NCOLS, 1024}; S.init(MIN_, NCOLS, G, bx, 1024); pg8::EpiBf16 E{PS, NCOLS}; pg8::gemm_phase(lds, g, S, E, wv); }
    GSYNC();
    PH(5) lora_prep(P, wv);
    GSYNC();
    PH(6) { pg8::Gemm g{(const bf16_t*)(ws + WS_LA), (const bf16_t*)(ws + WS_WL), MT, 1536, 256}; S.init(MT, 1536, G, bx, 256);
      pg8::EpiLora E{(bf16_t*)(ws + WS_OMD), (bf16_t*)(ws + WS_ASIG), (bf16_t*)(ws + WS_WIN), P.w0, P.a0}; pg8::gemm_phase(lds, g, S, E, wv); }
    GSYNC();
    {
    if (bx < 128) { for (int rw = 0; rw < REP_RW; ++rw) rwkv_unit<false>(P, ldsf, bx >> 4, (bx >> 1) & 7, bx & 1, wv); }
    else for (int rep7 = 0; rep7 < REP_OTH; ++rep7) { const int ob = bx - 128; unsigned* sbc = (unsigned*)ws + XCD_BAR_WORDS + 64;
        for (int k = 0; k < 4; ++k) { const int u = ob + k * 128; ret_unit_a(P, lds, u >> 4, u & 15, wv); }
        sub_barrier(sbc, 128u * (2u * rep7 + 1u), wv);
        ret_prefix(P, ob * 512 + fresh_tid(wv));
        sub_barrier(sbc, 128u * (2u * rep7 + 2u), wv);
        for (int k = 0; k < 4; ++k) { const int u = ob + k * 128; ret_unit_c(P, lds, u >> 4, u & 15, wv); }
        for (int u = ob; u < 2560; u += 128) { if (u < 2048) rwkv_unit<true>(P, ldsf, u >> 4, (u >> 1) & 7, u & 1, wv); else ret_sample_unit(P, ldsf, (u - 2048) >> 2, (u - 2048) & 3, wv); }
    }
    }
    GSYNC();
    for (int rep8 = 0; rep8 < REP_P8; ++rep8) PH(8) rwkv_post(P, wv);
    GSYNC();
    PH(9) { pg8::Gemm g{XN, (const bf16_t*)(ws + WS_WOUT), MT, 1024, 1024}; pg8::SplitOrder S2; S2.init2(G, bx, 1024, 4); pg8::EpiFO E{(bf16_t*)FO, 1024, (float*)(ws + WS_OMD)}; pg8::gemm_phase(lds, g, S2, E, wv); }
    GSYNC();
    PH(10) { ffn_weights(P.f2g, P.f2u, P.f2d, ws, ldsf, wv);
    rows_phase(P, 2, wv); }
    GSYNC();
    PH(11) { pg8::Gemm g{XN, (const bf16_t*)(ws + WS_WGU), MT, NGU, 1024}; S.init(MT, NGU, G, bx, 1024); pg8::EpiSwiGLU E{ACT, DFF}; pg8::gemm_phase(lds, g, S, E, wv); }
    GSYNC();
    PH(12) { pg8::Gemm g{ACT, (const bf16_t*)(ws + WS_WD), MT, 1024, DFF}; pg8::SplitOrder S2; S2.init2(G, bx, DFF, 8); pg8::EpiFO E{(bf16_t*)FO, 1024, (float*)(ws + WS_OMD)}; pg8::gemm_phase(lds, g, S2, E, wv); }
    GSYNC();
    PH(13) rows_phase(P, 3, wv);
}

#undef ws
#undef XN
#undef ACT
#undef FO
#undef PS
#undef P
extern "C" void kernel_launch(void* const* d_in, const int* in_sizes, int n_in, void* d_out, int out_size, void* d_ws, size_t ws_size, hipStream_t stream) {
    static int grid = 0;
    if (grid == 0) {
        if (n_in != 26 || ws_size < WS_END) { fprintf(stderr, "kernel_launch: unexpected n_in %d or ws_size %zu (< %zu)\n", n_in, ws_size, (size_t)WS_END); grid = -1; return; }
        int dev = 0, cus = 0, per_cu = 0;
        hipGetDevice(&dev); hipDeviceGetAttribute(&cus, hipDeviceAttributeMultiprocessorCount, dev);
        hipFuncSetAttribute((const void*)hymba_mega, hipFuncAttributeMaxDynamicSharedMemorySize, LDS_BYTES);
        hipOccupancyMaxActiveBlocksPerMultiprocessor(&per_cu, (const void*)hymba_mega, 512, LDS_BYTES);
        if (per_cu < 1) { fprintf(stderr, "kernel_launch: occupancy query says %d blocks/CU\n", per_cu); per_cu = 1; }
        grid = cus * per_cu; if (grid > 256) grid = 256;
        if (grid != 256) { fprintf(stderr, "kernel_launch: this kernel needs 256 co-resident workgroups, got %d\n", grid); grid = -1; return; }
        fprintf(stderr, "kernel_launch: cus %d per_cu %d grid %d ws %zu\n", cus, per_cu, grid, ws_size);
    }
    if (grid < 0) return;
    Params p{};
    const float** pp = (const float**)&p;
    for (int i = 0; i < 26; ++i) pp[i] = (const float*)d_in[i];
    p.out = (float*)d_out; p.ws = (unsigned char*)d_ws;
    void* args[] = {&p};
    hipError_t e = hipLaunchCooperativeKernel((const void*)hymba_mega, dim3(grid), dim3(512), args, LDS_BYTES, stream);
    if (e != hipSuccess) fprintf(stderr, "cooperative launch failed: %s (grid %d)\n", hipGetErrorString(e), grid);
}
```

```cpp
#include <hip/hip_runtime.h>
#include <hip/hip_cooperative_groups.h>
#include <cstdio>
#include <cstdint>
namespace cg = cooperative_groups;

__device__ __forceinline__ int fresh_tid(int wv) { int l; asm volatile("v_mbcnt_lo_u32_b32 %0, -1, 0\n\tv_mbcnt_hi_u32_b32 %0, -1, %0" : "=v"(l)); return wv * 64 + l; }
namespace pg8 {
#define PG8_LAS __attribute__((address_space(3)))
typedef unsigned short bf16_t;
typedef short bf16x8 __attribute__((ext_vector_type(8)));
typedef float f32x4 __attribute__((ext_vector_type(4)));
typedef unsigned u32x4 __attribute__((ext_vector_type(4)));
typedef unsigned u32x2 __attribute__((ext_vector_type(2)));
constexpr int BM = 256, BK = 64, HALF = 128, HTB = HALF * BK * 2, STAGE_BYTES = 8 * HTB, NXCD = 8, WGM = 8;

__host__ __device__ __forceinline__ int lds_byte(int r, int c) { const int st = (r >> 4) * 2 + (c >> 5), rr = r & 15, cc = c & 31, ob = rr * 64 + cc * 2; return st * 1024 + (ob ^ (((ob >> 9) & 1) << 5)); }
__host__ __device__ __forceinline__ void stage_rc(int b, int& R, int& C) { const int st = b / 1024, sb = b % 1024, swz = sb ^ (((sb >> 9) & 1) << 5); R = (st >> 1) * 16 + swz / 64; C = (st & 1) * 32 + (swz % 64) / 2; }
__host__ __device__ __forceinline__ int perm32(int rho) { const int n = rho >> 4, i = rho & 15; return 8 * (i >> 2) + 4 * n + (i & 3); }

struct Unit { int pm, pn, k0, nkt, atomic; };
struct Gemm { const bf16_t* A; const bf16_t* Bt; int M, N, K; };

struct StaticOrder {
    int nM, nN, nwg, G, c, nt;
    __host__ __device__ void init(int M, int N, int G_, int c_, int K) { nM = M / BM; nN = N / BM; nwg = nM * nN; G = G_; c = c_; nt = K / BK; }
    __host__ __device__ bool next(int i, Unit& u) const {
        const long L = (long)i * G + c; if (L >= nwg) return false;
        int wgid = (int)L; { const int q = nwg / NXCD, r = nwg % NXCD, xcd = wgid % NXCD, off = wgid / NXCD; wgid = (xcd < r ? xcd * (q + 1) : r * (q + 1) + (xcd - r) * q) + off; }
        const int nig = WGM * nN, gid = wgid / nig, fm = gid * WGM, gsz = (nM - fm) < WGM ? (nM - fm) : WGM;
        u.pm = fm + ((wgid % nig) % gsz); u.pn = (wgid % nig) / gsz; u.k0 = 0; u.nkt = nt; u.atomic = 0; return true;
    }
    __device__ __forceinline__ void a_ready(const Unit&) const {}
    __device__ __forceinline__ void done(const Unit&) const {}
};
struct SplitOrder : StaticOrder {
    int KS;
    __host__ __device__ void init2(int G_, int c_, int K, int KS_) { init(16384, 1024, G_, c_, K); KS = KS_; }
    __host__ __device__ bool next(int i, Unit& u) const {
        if (i == 0) return StaticOrder::next(0, u);
        if (i > 1 || c >= 8 * KS) return false;
        const int tile = c / KS, part = c % KS, pairs = nt / 2, q = pairs / KS, r = pairs % KS;
        u.pm = 64 + (tile >> 2); u.pn = tile & 3; u.k0 = 2 * (part * q + (part < r ? part : r)); u.nkt = 2 * (q + (part < r ? 1 : 0)); u.atomic = 1 + c; return true;
    }
};

__device__ __forceinline__ unsigned cvt_pk_bf16(float lo, float hi) { unsigned r; asm volatile("v_cvt_pk_bf16_f32 %0, %1, %2" : "=v"(r) : "v"(lo), "v"(hi)); return r; }

struct EpiFO {
    static constexpr bool PERM = true;
    bf16_t* C; int ldc; float* slab;
    __device__ __forceinline__ void operator()(const f32x4 (&acc)[2][2][4][2], const Unit& u, int wr, int wc, int fr, int fq) const {
        if (u.atomic == 0) {
            const int row0 = u.pm * BM + wr * 64 + fr; const int col0 = u.pn * BM + wc * 32 + 8 * fq;
#pragma unroll
            for (int ai = 0; ai < 2; ++ai)
#pragma unroll
                for (int m = 0; m < 4; ++m) { bf16_t* rowp = C + (size_t)(row0 + ai * HALF + m * 16) * ldc + col0;
#pragma unroll
                    for (int bj = 0; bj < 2; ++bj) { const f32x4 v0 = acc[ai][bj][m][0], v1 = acc[ai][bj][m][1];
                        u32x4 w; w.x = cvt_pk_bf16(v0[0], v0[1]); w.y = cvt_pk_bf16(v0[2], v0[3]); w.z = cvt_pk_bf16(v1[0], v1[1]); w.w = cvt_pk_bf16(v1[2], v1[3]);
                        *(u32x4*)(rowp + bj * HALF) = w; } }
        } else {
            float* base = slab + (size_t)(u.atomic - 1) * (BM * BM) + (size_t)(wr * 64 + fr) * BM + wc * 32 + 8 * fq;
#pragma unroll
            for (int ai = 0; ai < 2; ++ai)
#pragma unroll
                for (int m = 0; m < 4; ++m) { float* rowp = base + (size_t)(ai * HALF + m * 16) * BM;
#pragma unroll
                    for (int bj = 0; bj < 2; ++bj) { *(f32x4*)(rowp + bj * HALF) = acc[ai][bj][m][0]; *(f32x4*)(rowp + bj * HALF + 4) = acc[ai][bj][m][1]; } }
        }
    }
};
struct EpiBf16 {
    static constexpr bool PERM = true;
    bf16_t* O; int ldc;
    __device__ __forceinline__ void operator()(const f32x4 (&acc)[2][2][4][2], const Unit& u, int wr, int wc, int fr, int fq) const {
        const int row0 = u.pm * BM + wr * 64 + fr; const int col0 = u.pn * BM + wc * 32 + 8 * fq;
#pragma unroll
        for (int ai = 0; ai < 2; ++ai)
#pragma unroll
            for (int m = 0; m < 4; ++m) { bf16_t* rowp = O + (size_t)(row0 + ai * HALF + m * 16) * ldc + col0;
#pragma unroll
                for (int bj = 0; bj < 2; ++bj) { const f32x4 v0 = acc[ai][bj][m][0], v1 = acc[ai][bj][m][1];
                    u32x4 w; w.x = cvt_pk_bf16(v0[0], v0[1]); w.y = cvt_pk_bf16(v0[2], v0[3]); w.z = cvt_pk_bf16(v1[0], v1[1]); w.w = cvt_pk_bf16(v1[2], v1[3]);
                    *(u32x4*)(rowp + bj * HALF) = w; } }
    }
};
__device__ __forceinline__ float silu_f(float x) { return x / (1.0f + __expf(-x)); }
struct EpiSwiGLU {
    static constexpr bool PERM = true;
    bf16_t* O; int ldc;
    __device__ __forceinline__ void operator()(const f32x4 (&acc)[2][2][4][2], const Unit& u, int wr, int wc, int fr, int fq) const {
        const int row0 = u.pm * BM + wr * 64 + fr; const int col0 = u.pn * HALF + wc * 32 + 8 * fq;
#pragma unroll
        for (int ai = 0; ai < 2; ++ai)
#pragma unroll
            for (int m = 0; m < 4; ++m) { bf16_t* rowp = O + (size_t)(row0 + ai * HALF + m * 16) * ldc + col0;
                float o[8];
#pragma unroll
                for (int n = 0; n < 2; ++n)
#pragma unroll
                    for (int j = 0; j < 4; ++j) o[n * 4 + j] = silu_f(acc[ai][0][m][n][j]) * acc[ai][1][m][n][j];
                u32x4 w; w.x = cvt_pk_bf16(o[0], o[1]); w.y = cvt_pk_bf16(o[2], o[3]); w.z = cvt_pk_bf16(o[4], o[5]); w.w = cvt_pk_bf16(o[6], o[7]);
                *(u32x4*)rowp = w; }
    }
};
struct EpiLora {
    static constexpr bool PERM = true;
    bf16_t* OMD; bf16_t* ASIG; bf16_t* G; const float* w0; const float* a0;
    template <int KIND> __device__ __forceinline__ void body(const f32x4 (&acc)[2][2][4][2], bf16_t* O, const float* bias, int row0, int ch0) const {
#pragma unroll
        for (int bj = 0; bj < 2; ++bj)
#pragma unroll
            for (int ai = 0; ai < 2; ++ai)
#pragma unroll
                for (int m = 0; m < 4; ++m) { bf16_t* rowp = O + (size_t)(row0 + ai * HALF + m * 16) * 512 + ch0 + bj * HALF;
                    float o[8];
#pragma unroll
                    for (int n = 0; n < 2; ++n)
#pragma unroll
                        for (int j = 0; j < 4; ++j) { float v = acc[ai][bj][m][n][j];
                            if (KIND == 0) { v += bias[ch0 + bj * HALF + n * 4 + j]; const float nv = -v; const float sp = fmaxf(nv, 0.f) + __logf(1.0f + __expf(-fabsf(nv)));
                                const float e = __expf(-sp - 0.5f);
                                float p = 1.0f / 40320.0f; p = -1.0f / 5040.0f + e * p; p = 1.0f / 720.0f + e * p; p = -1.0f / 120.0f + e * p; p = 1.0f / 24.0f + e * p; p = -1.0f / 6.0f + e * p; p = 0.5f + e * p; p = 1.0f - e * p;
                                v = e * p; }
                            else if (KIND == 1) { v += bias[ch0 + bj * HALF + n * 4 + j]; v = 1.0f / (1.0f + __expf(-v)); }
                            o[n * 4 + j] = v; }
                    u32x4 w; w.x = cvt_pk_bf16(o[0], o[1]); w.y = cvt_pk_bf16(o[2], o[3]); w.z = cvt_pk_bf16(o[4], o[5]); w.w = cvt_pk_bf16(o[6], o[7]);
                    *(u32x4*)rowp = w; __builtin_amdgcn_sched_barrier(0); }
    }
    __device__ __forceinline__ void operator()(const f32x4 (&acc)[2][2][4][2], const Unit& u, int wr, int wc, int fr, int fq) const {
        const int kind = u.pn >> 1;
        const int row0 = u.pm * BM + wr * 64 + fr; const int ch0 = (u.pn & 1) * BM + wc * 32 + 8 * fq;
        if (kind == 0) body<0>(acc, OMD, w0, row0, ch0); else if (kind == 1) body<1>(acc, ASIG, a0, row0, ch0); else body<2>(acc, G, a0, row0, ch0);
    }
};

template <class Epi, class Sched>
__device__ __forceinline__ void gemm_phase(PG8_LAS unsigned char* lds, const Gemm g, const Sched& S, const Epi& E, const int wv) {
    const int tid = fresh_tid(wv), wid = __builtin_amdgcn_readfirstlane(tid >> 6), lane = tid & 63, wr = wid >> 2, wc = wid & 3, fr = lane & 15, fq = lane >> 4;
    const int K = g.K;
    unsigned voffA[2], voffB[2];
#pragma unroll
    for (int i = 0; i < 2; ++i) { int R, C; stage_rc(tid * 16 + i * 8192, R, C); const int Rb = Epi::PERM ? ((R & ~31) + perm32(R & 31)) : R;
        voffA[i] = (unsigned)(R * K + C) * 2u; voffB[i] = (unsigned)(Rb * K + C) * 2u; }
    const size_t kstep = (size_t)(BK * 2);
    const size_t hstep = (size_t)HALF * K * 2;
    const size_t tstep = 2 * hstep;
    const unsigned ldsw = (unsigned)wid * 1024u;
    const int aoff = lds_byte(wr * 64 + fr, fq * 8), boff = lds_byte(wc * 32 + fr, fq * 8);
#define PG8_SA(b, h) (((b) * 2 + (h)) * HTB)
#define PG8_SB(b, h) ((4 + (b) * 2 + (h)) * HTB)
#define PG8_STAGE(bufoff, gbase, voff) do { _Pragma("unroll") for (int _i = 0; _i < 2; ++_i) \
        __builtin_amdgcn_global_load_lds((const unsigned*)((const char*)(gbase) + (voff)[_i]), (PG8_LAS unsigned*)(lds + (bufoff) + ldsw + _i * 8192), 16, 0, 0); } while (0)
#define PG8_LDA(dst, b, h) do { _Pragma("unroll") for (int m = 0; m < 4; ++m) _Pragma("unroll") for (int k = 0; k < 2; ++k) dst[m][k] = *(const PG8_LAS bf16x8*)(lds + PG8_SA(b, h) + aoff + m * 2048 + k * 1024); } while (0)
#define PG8_LDB(dst, b, h) do { _Pragma("unroll") for (int n = 0; n < 2; ++n) _Pragma("unroll") for (int k = 0; k < 2; ++k) dst[n][k] = *(const PG8_LAS bf16x8*)(lds + PG8_SB(b, h) + boff + n * 2048 + k * 1024); } while (0)
#define PG8_MMA(ai, bj, At, Bt) do { __builtin_amdgcn_s_setprio(1); _Pragma("unroll") for (int m = 0; m < 4; ++m) _Pragma("unroll") for (int n = 0; n < 2; ++n) _Pragma("unroll") for (int k = 0; k < 2; ++k) \
        acc[ai][bj][m][n] = __builtin_amdgcn_mfma_f32_16x16x32_bf16(Bt[n][k], At[m][k], acc[ai][bj][m][n], 0, 0, 0); __builtin_amdgcn_s_setprio(0); } while (0)
#define PG8_WAIT_V(n) asm volatile("s_waitcnt vmcnt(" #n ")" ::: "memory")
#define PG8_WAIT_L(n) asm volatile("s_waitcnt lgkmcnt(" #n ")" ::: "memory")
#define PG8_BAR __builtin_amdgcn_s_barrier()
#define PG8_SCHED __builtin_amdgcn_sched_barrier(0)
    Unit cur, nxt; int ui = 0;
    if (!S.next(0, cur)) return;
    f32x4 acc[2][2][4][2];
#pragma unroll
    for (int a = 0; a < 2; ++a)
#pragma unroll
        for (int b = 0; b < 2; ++b)
#pragma unroll
            for (int m = 0; m < 4; ++m)
#pragma unroll
                for (int n = 0; n < 2; ++n) acc[a][b][m][n] = (f32x4){0.f, 0.f, 0.f, 0.f};
    bf16x8 At[4][2], B0[2][2], B1[2][2];
    const char* cA = (const char*)g.A + (size_t)cur.pm * tstep + (size_t)cur.k0 * kstep; const char* cB = (const char*)g.Bt + (size_t)cur.pn * tstep + (size_t)cur.k0 * kstep;
    S.a_ready(cur);
    PG8_STAGE(PG8_SB(0, 0), cB, voffB); PG8_STAGE(PG8_SA(0, 0), cA, voffA); PG8_STAGE(PG8_SB(0, 1), cB + hstep, voffB); PG8_STAGE(PG8_SA(0, 1), cA + hstep, voffA);
    if (wr == 1) PG8_BAR;
    PG8_WAIT_V(4); PG8_BAR;
    PG8_STAGE(PG8_SB(1, 0), cB + kstep, voffB); PG8_STAGE(PG8_SA(1, 0), cA + kstep, voffA); PG8_STAGE(PG8_SB(1, 1), cB + hstep + kstep, voffB);
    PG8_WAIT_V(6); PG8_BAR;
    for (;;) {
        const bool has_next = S.next(ui + 1, nxt);
        const char* nA = has_next ? (const char*)g.A + (size_t)nxt.pm * tstep + (size_t)nxt.k0 * kstep : cA; const char* nB = has_next ? (const char*)g.Bt + (size_t)nxt.pn * tstep + (size_t)nxt.k0 * kstep : cB;
        const int nt = cur.nkt;
        for (int t = 0; t < nt; t += 2) {
            const bool last = (t == nt - 2);
            const char* a1 = cA + (size_t)(t + 1) * kstep;
            const char* a2 = last ? nA : cA + (size_t)(t + 2) * kstep; const char* b2 = last ? nB : cB + (size_t)(t + 2) * kstep;
            const char* a3 = a2 + kstep; const char* b3 = b2 + kstep;
            if (last && has_next) S.a_ready(nxt);
            PG8_LDB(B0, 0, 0); PG8_SCHED; PG8_LDA(At, 0, 0); PG8_STAGE(PG8_SA(1, 1), a1 + hstep, voffA);
            PG8_WAIT_L(8); PG8_BAR; PG8_WAIT_L(0); PG8_MMA(0, 0, At, B0); PG8_BAR; PG8_SCHED;
            PG8_LDB(B1, 0, 1); PG8_STAGE(PG8_SB(0, 0), b2, voffB);
            PG8_BAR; PG8_WAIT_L(0); PG8_MMA(0, 1, At, B1); PG8_BAR;
            PG8_LDA(At, 0, 1); PG8_STAGE(PG8_SA(0, 0), a2, voffA);
            PG8_BAR; PG8_WAIT_L(0); PG8_MMA(1, 0, At, B0); PG8_BAR; PG8_SCHED;
            PG8_STAGE(PG8_SB(0, 1), b2 + hstep, voffB);
            PG8_WAIT_V(6); PG8_BAR; PG8_MMA(1, 1, At, B1); PG8_BAR;
            PG8_LDB(B0, 1, 0); PG8_SCHED; PG8_LDA(At, 1, 0); PG8_STAGE(PG8_SA(0, 1), a2 + hstep, voffA);
            PG8_WAIT_L(8); PG8_BAR; PG8_WAIT_L(0); PG8_MMA(0, 0, At, B0); PG8_BAR; PG8_SCHED;
            PG8_LDB(B1, 1, 1); PG8_STAGE(PG8_SB(1, 0), b3, voffB);
            PG8_BAR; PG8_WAIT_L(0); PG8_MMA(0, 1, At, B1); PG8_BAR;
            PG8_LDA(At, 1, 1); PG8_STAGE(PG8_SA(1, 0), a3, voffA);
            PG8_BAR; PG8_WAIT_L(0); PG8_MMA(1, 0, At, B0); PG8_BAR; PG8_SCHED;
            PG8_STAGE(PG8_SB(1, 1), b3 + hstep, voffB);
            PG8_WAIT_V(6); PG8_BAR; PG8_MMA(1, 1, At, B1); PG8_BAR;
        }
        E(acc, cur, wr, wc, fr, fq); S.done(cur);
        if (!has_next) break;
#pragma unroll
        for (int a = 0; a < 2; ++a)
#pragma unroll
            for (int b = 0; b < 2; ++b)
#pragma unroll
                for (int m = 0; m < 4; ++m)
#pragma unroll
                    for (int n = 0; n < 2; ++n) acc[a][b][m][n] = (f32x4){0.f, 0.f, 0.f, 0.f};
        cur = nxt; cA = nA; cB = nB; ++ui;
    }
    PG8_WAIT_V(0);
    if (wr == 0) PG8_BAR;
    PG8_BAR;
#undef PG8_SA
#undef PG8_SB
#undef PG8_STAGE
#undef PG8_LDA
#undef PG8_LDB
#undef PG8_MMA
#undef PG8_WAIT_V
#undef PG8_WAIT_L
#undef PG8_BAR
#undef PG8_SCHED
}
}

using pg8::bf16_t; using pg8::f32x4; using pg8::bf16x8; using pg8::u32x4; using pg8::u32x2;
#define LAS __attribute__((address_space(3)))

constexpr int D = 1024, DFF = 2816, NGU = 5632, NCOLS = 3840;
constexpr int MP = 16384, MS = 512, MT = 16896, MIN_ = 17152;
constexpr int LDS_BYTES = 147456;
constexpr size_t O_SHP = 17301504, O_WKP = O_SHP + 8192, O_RTP = O_WKP + 262144, O_SHS = O_RTP + 524288, O_WKS = O_SHS + 131072, O_RTS = O_WKS + 4194304;
constexpr size_t WS_ROPE = 16384;
constexpr size_t WS_WL   = WS_ROPE + 1050624;
constexpr size_t WS_WOUT = WS_WL + 786432;
constexpr size_t WS_WIN  = WS_WOUT + 2097152;
constexpr size_t WS_WGU  = WS_WIN + 7864320;
constexpr size_t WS_WD   = WS_WGU + 11534336;
constexpr size_t WS_XN   = WS_WD + 5767168;
constexpr size_t WS_BIG  = WS_XN + 35127296;
constexpr size_t WS_FO   = WS_BIG + 95158272;
constexpr size_t WS_YS   = WS_BIG + 131727360;
constexpr size_t WS_LA   = WS_YS + 17301504;
constexpr size_t WS_OMD  = WS_BIG + 164364288;
constexpr size_t WS_ASIG = WS_OMD + 17301504;
constexpr size_t WS_END  = WS_ASIG + 17301504;
static_assert(WS_LA + 8650752 <= WS_OMD, "mixer overlays");
static_assert(WS_END <= 268435456, "workspace");

struct Params {
    const float *x_prompt, *x_sample, *state_shift, *state_wkv, *state_ret, *norm_g, *f1g, *f1u, *f1d, *w_in, *mu, *w0, *w2, *a0, *a2, *g2, *k_k, *k_a, *r_k, *lnx_w, *lnx_b, *gn_w, *w_out, *f2g, *f2u, *f2d;
    float* out; unsigned char* ws;
};
#define CAS __attribute__((address_space(4)))
typedef const CAS Params& PR;

__device__ __forceinline__ float bf2f(unsigned b) { return __uint_as_float(b << 16); }
__device__ __forceinline__ bf16_t f2bf(float f) { unsigned u = __float_as_uint(f); u += 0x7FFFu + ((u >> 16) & 1u); return (bf16_t)(u >> 16); }
__device__ __forceinline__ float lo_bf(unsigned x) { return __uint_as_float(x << 16); }
__device__ __forceinline__ float hi_bf(unsigned x) { return __uint_as_float(x & 0xffff0000u); }
template <int CTRL> __device__ __forceinline__ float dppf(float v) { return __int_as_float(__builtin_amdgcn_update_dpp(0, __float_as_int(v), CTRL, 0xF, 0xF, false)); }
__device__ __forceinline__ float row16_sum(float v) { v += dppf<0xB1>(v); v += dppf<0x4E>(v); v += dppf<0x141>(v); v += dppf<0x140>(v); return v; }
__device__ __forceinline__ float wave_sum(float v) { v = row16_sum(v); const int i = __float_as_int(v);
    return __int_as_float(__builtin_amdgcn_readlane(i, 0)) + __int_as_float(__builtin_amdgcn_readlane(i, 16)) + __int_as_float(__builtin_amdgcn_readlane(i, 32)) + __int_as_float(__builtin_amdgcn_readlane(i, 48)); }
__device__ __forceinline__ float quad_sum(float v) { v += dppf<0xB1>(v); v += dppf<0x4E>(v); return v; }
__device__ __forceinline__ float sigmoid_f(float x) { return 1.0f / (1.0f + __expf(-x)); }


#define XB_TMO      128
#define XB_XCNT(j)  (256  + 64 * (j))
#define XB_XSUB(j)  (1280 + 64 * (j))
#define XB_XGEN(j)  (2304 + 64 * (j))
#define XB_TOP      3328
#define XB_TOPGEN   3392
#define XCD_BAR_WORDS 3456
#define XB_SPIN_CAP (1u << 18)
__device__ __forceinline__ unsigned xb_ld(unsigned* p)              { return __hip_atomic_load(p, __ATOMIC_RELAXED, __HIP_MEMORY_SCOPE_AGENT); }
__device__ __forceinline__ unsigned xb_add(unsigned* p, unsigned v) { return __hip_atomic_fetch_add(p, v, __ATOMIC_RELAXED, __HIP_MEMORY_SCOPE_AGENT); }
__device__ __forceinline__ unsigned xb_xcc_id() { return (unsigned)__builtin_amdgcn_s_getreg((3 << 11) | 20) & 0xFu; }
#define XB_SPIN(cond, bar) do { unsigned _sp = 0; while (cond) { __builtin_amdgcn_s_sleep(1); \
    if ((++_sp & 255u) == 0u) { if (xb_ld(&(bar)[XB_TMO])) break; if (_sp > XB_SPIN_CAP) { atomicAdd(&(bar)[XB_TMO], 1u); break; } } } } while (0)
struct XcdBarrier { unsigned* bar; unsigned x; volatile LAS unsigned* st; };
__device__ __forceinline__ XcdBarrier xcd_barrier_post(unsigned* bar, volatile LAS unsigned* st) {
    XcdBarrier b; b.bar = bar; b.x = xb_xcc_id(); b.st = st;
    return b;
}
__device__ __forceinline__ void xcd_barrier_complete(unsigned* bar, unsigned x, unsigned& nloc, unsigned& nx) {
    const unsigned G = gridDim.x * gridDim.y * gridDim.z;
    unsigned sum, cnt, mine, sp = 0u;
    for (;;) {
        sum = 0u; cnt = 0u; mine = 0u;
#pragma unroll
        for (unsigned j = 0; j < 16; ++j) { const unsigned c = xb_ld(&bar[XB_XCNT(j)]); sum += c; cnt += (c > 0u) ? 1u : 0u; mine = (j == x) ? c : mine; }
        if (sum == G) break;
        __builtin_amdgcn_s_sleep(1);
        if ((++sp & 255u) == 0u) { if (xb_ld(&bar[XB_TMO])) break; if (sp > XB_SPIN_CAP) { atomicAdd(&bar[XB_TMO], 1u); break; } }
    }
    nloc = mine > 0u ? mine : 1u; nx = cnt > 0u ? cnt : 1u;
}
__device__ __forceinline__ void xcd_barrier(unsigned* barw, volatile LAS unsigned* stw, const int wv) {
    XcdBarrier b; b.bar = barw; b.x = xb_xcc_id(); b.st = stw;
    asm volatile("s_waitcnt vmcnt(0)" ::: "memory");
    __syncthreads();
    if (fresh_tid(wv) == 0) {
        unsigned* bar = b.bar;
        __builtin_amdgcn_s_waitcnt(0);
        unsigned nloc = b.st[0], nx = b.st[1];
        if (nloc == 0u) { xcd_barrier_complete(bar, b.x, nloc, nx); b.st[0] = nloc; b.st[1] = nx; }
        const unsigned old = xb_add(&bar[XB_XSUB(b.x)], 1u);
        const unsigned gen = old / nloc;
        if (old + 1u == (gen + 1u) * nloc) {
            __builtin_amdgcn_fence(__ATOMIC_RELEASE, "agent");
            asm volatile("s_waitcnt vmcnt(0)" ::: "memory");
            const unsigned og = xb_add(&bar[XB_TOP], 1u);
            const unsigned tg = og / nx;
            if (og + 1u == (tg + 1u) * nx) xb_add(&bar[XB_TOPGEN], 1u);
            else XB_SPIN(xb_ld(&bar[XB_TOPGEN]) == tg, bar);
            __builtin_amdgcn_fence(__ATOMIC_ACQUIRE, "agent");
            xb_add(&bar[XB_XGEN(b.x)], 1u);
            asm volatile("s_waitcnt vmcnt(0)" ::: "memory");
        } else {
            XB_SPIN(xb_ld(&bar[XB_XGEN(b.x)]) == gen, bar);
            __builtin_amdgcn_fence(__ATOMIC_ACQUIRE, "agent");
            asm volatile("s_waitcnt vmcnt(0)" ::: "memory");
        }
    }
    __syncthreads();
}


#define DPP2(x, y, CTRL, NOP) asm volatile(NOP "\n\tv_add_f32_dpp %0, %0, %0 " CTRL " row_mask:0xf bank_mask:0xf bound_ctrl:1\n\tv_add_f32_dpp %1, %1, %1 " CTRL " row_mask:0xf bank_mask:0xf bound_ctrl:1" : "+v"(x), "+v"(y))
#define DPP4(x, y, z, w, CTRL, NOP) asm volatile(NOP "\n\tv_add_f32_dpp %0, %0, %0 " CTRL " row_mask:0xf bank_mask:0xf bound_ctrl:1\n\tv_add_f32_dpp %1, %1, %1 " CTRL " row_mask:0xf bank_mask:0xf bound_ctrl:1\n\tv_add_f32_dpp %2, %2, %2 " CTRL " row_mask:0xf bank_mask:0xf bound_ctrl:1\n\tv_add_f32_dpp %3, %3, %3 " CTRL " row_mask:0xf bank_mask:0xf bound_ctrl:1" : "+v"(x), "+v"(y), "+v"(z), "+v"(w))
#define ROW16_SUM4(x, y, z, w) do { DPP4(x, y, z, w, "quad_perm:[1,0,3,2]", "s_nop 1"); DPP4(x, y, z, w, "quad_perm:[2,3,0,1]", ""); DPP4(x, y, z, w, "row_half_mirror", ""); DPP4(x, y, z, w, "row_mirror", ""); } while (0)
#define ROW16_SUM2(x, y) do { DPP2(x, y, "quad_perm:[1,0,3,2]", "s_nop 1"); DPP2(x, y, "quad_perm:[2,3,0,1]", "s_nop 0"); DPP2(x, y, "row_half_mirror", "s_nop 0"); DPP2(x, y, "row_mirror", "s_nop 0"); } while (0)
__device__ __forceinline__ int prev_row(int r) {
    if (r < MP) return (r & 2047) == 0 ? -1 : r - 1;
    const int s = r - MP; return (s & 3) == 0 ? MT + (s >> 2) : r - 1;
}

struct TDesc { const float* W; bf16_t* Bt; int K, N, k0, n0, brow0; };
__device__ __forceinline__ TDesc tconv_desc(const float* wg, const float* wu, const float* wd, const float* win, const float* wout, unsigned char* ws, int i) {
    TDesc d; int mode = 0, tile = i;
    if (i < 704) { d.W = wg; d.Bt = (bf16_t*)(ws + WS_WGU); d.K = 1024; d.N = DFF; mode = 1; }
    else if (i < 1408) { d.W = wu; d.Bt = (bf16_t*)(ws + WS_WGU); d.K = 1024; d.N = DFF; mode = 2; tile = i - 704; }
    else if (i < 2112) { d.W = wd; d.Bt = (bf16_t*)(ws + WS_WD); d.K = DFF; d.N = 1024; tile = i - 1408; }
    else if (i < 3072) { d.W = win; d.Bt = (bf16_t*)(ws + WS_WIN); d.K = 1024; d.N = NCOLS; tile = i - 2112; }
    else { d.W = wout; d.Bt = (bf16_t*)(ws + WS_WOUT); d.K = 1024; d.N = 1024; tile = i - 3072; }
    const int nkt = d.K / 64; const int kt = tile % nkt, nt = tile / nkt; d.k0 = kt * 64; d.n0 = nt * 64;
    d.brow0 = mode == 0 ? d.n0 : ((d.n0 >> 7) * 256 + (d.n0 & 127) + (mode == 2 ? 128 : 0));
    return d;
}
__device__ __forceinline__ void tconv_list(const float* wg, const float* wu, const float* wd, const float* win, const float* wout, unsigned char* ws, const int ntiles, LAS float* t, const int wv) {
    const int tid = fresh_tid(wv); const int G = gridDim.x;
    float cur[8], nxt[8];
    int i = blockIdx.x;
    if (i < ntiles) { const TDesc d = tconv_desc(wg, wu, wd, win, wout, ws, i);
#pragma unroll
        for (int e = 0; e < 8; ++e) { const int idx = e * 512 + tid, r = idx >> 6, c = idx & 63; cur[e] = d.W[(size_t)(d.k0 + r) * d.N + d.n0 + c]; } }
    for (; i < ntiles; i += G) {
        const TDesc d = tconv_desc(wg, wu, wd, win, wout, ws, i);
        if (i + G < ntiles) { const TDesc dn = tconv_desc(wg, wu, wd, win, wout, ws, i + G);
#pragma unroll
            for (int e = 0; e < 8; ++e) { const int idx = e * 512 + tid, r = idx >> 6, c = idx & 63; nxt[e] = dn.W[(size_t)(dn.k0 + r) * dn.N + dn.n0 + c]; } }
#pragma unroll
        for (int e = 0; e < 8; ++e) { const int idx = e * 512 + tid, r = idx >> 6, c = idx & 63; t[r * 65 + c] = cur[e]; }
        __syncthreads();
#pragma unroll
        for (int e = 0; e < 4; ++e) { const int idx = e * 512 + tid, n = idx >> 5, kp = idx & 31;
            const unsigned w = pg8::cvt_pk_bf16(t[(2 * kp) * 65 + n], t[(2 * kp + 1) * 65 + n]);
            *(unsigned*)(d.Bt + (size_t)(d.brow0 + n) * d.K + d.k0 + 2 * kp) = w; }
        __syncthreads();
#pragma unroll
        for (int e = 0; e < 8; ++e) cur[e] = nxt[e];
    }
}

__device__ __forceinline__ void rows_phase(PR P, const int mode, const int wv) {
    const int tid = fresh_tid(wv); const int lane = tid & 63; const int gw = blockIdx.x * 8 + (tid >> 6), nw = gridDim.x * 8;
    const bf16_t* FO = (const bf16_t*)(P.ws + WS_FO); bf16_t* XN = (bf16_t*)(P.ws + WS_XN);
    const float* gpost = P.norm_g + (mode == 1 ? 1 : (mode == 2 ? 3 : 5)) * 1024;
    const float* gnext = P.norm_g + (mode == 0 ? 0 : (mode == 1 ? 2 : 4)) * 1024;
    const float scale = mode == 2 ? 1.0f : 0.5f;
    for (int row = gw; row < MT; row += nw) {
        float4 xv[4];
        if (mode <= 1) { const float* xin = row < MP ? P.x_prompt + (size_t)row * 1024 : P.x_sample + (size_t)(row - MP) * 1024;
#pragma unroll
            for (int q = 0; q < 4; ++q) xv[q] = *(const float4*)(xin + (q * 64 + lane) * 4); }
        else { const bf16_t* xb = (mode == 2 ? (const bf16_t*)P.out : (const bf16_t*)(P.ws + WS_FO + 34603008)) + (size_t)row * 1024;
#pragma unroll
            for (int q = 0; q < 4; ++q) { const u32x2 t = *(const u32x2*)(xb + (q * 64 + lane) * 4); xv[q] = make_float4(lo_bf(t.x), hi_bf(t.x), lo_bf(t.y), hi_bf(t.y)); } }
        if (mode != 0) {
            float4 fo[4]; float ss = 0.f;
#pragma unroll
            for (int q = 0; q < 4; ++q) {
                if (row < MP) { const u32x2 fb = *(const u32x2*)(FO + (size_t)row * 1024 + (q * 64 + lane) * 4); fo[q] = make_float4(lo_bf(fb.x), hi_bf(fb.x), lo_bf(fb.y), hi_bf(fb.y)); }
                else {
                    const int KS = mode == 2 ? 4 : 8; const float* sl = (const float*)(P.ws + WS_OMD) + (size_t)((((row - MP) >> 8) * 4 + q) * KS) * 65536 + (size_t)(row & 255) * 256 + lane * 4;
                    float4 a = *(const float4*)sl;
                    for (int p = 1; p < KS; ++p) { const float4 b = *(const float4*)(sl + (size_t)p * 65536); a.x += b.x; a.y += b.y; a.z += b.z; a.w += b.w; }
                    fo[q] = a; }
                ss += fo[q].x * fo[q].x + fo[q].y * fo[q].y + fo[q].z * fo[q].z + fo[q].w * fo[q].w; }
            ss = wave_sum(ss); const float r = rsqrtf(ss * (1.0f / 1024.0f) + 1e-6f) * scale;
#pragma unroll
            for (int q = 0; q < 4; ++q) { const float4 g = *(const float4*)(gpost + (q * 64 + lane) * 4);
                xv[q].x += fo[q].x * r * g.x; xv[q].y += fo[q].y * r * g.y; xv[q].z += fo[q].z * r * g.z; xv[q].w += fo[q].w * r * g.w;
                if (mode == 3) *(float4*)(P.out + (size_t)row * 1024 + (q * 64 + lane) * 4) = xv[q];
                else { bf16_t* xo = (mode == 1 ? (bf16_t*)P.out : (bf16_t*)(P.ws + WS_FO + 34603008)) + (size_t)row * 1024; u32x2 t; t.x = pg8::cvt_pk_bf16(xv[q].x, xv[q].y); t.y = pg8::cvt_pk_bf16(xv[q].z, xv[q].w);
                    *(u32x2*)(xo + (q * 64 + lane) * 4) = t; } }
            if (mode == 3) continue;
        }
        float ss2 = 0.f;
#pragma unroll
        for (int q = 0; q < 4; ++q) ss2 += xv[q].x * xv[q].x + xv[q].y * xv[q].y + xv[q].z * xv[q].z + xv[q].w * xv[q].w;
        ss2 = wave_sum(ss2); const float r2 = rsqrtf(ss2 * (1.0f / 1024.0f) + 1e-6f);
        float* sh = nullptr;
        if (mode == 1) { if (row < MP) { if ((row & 2047) == 2047) sh = P.out + O_SHP + (size_t)(row >> 11) * 1024; } else { const int s = row - MP; if ((s & 3) == 3) sh = P.out + O_SHS + (size_t)(s >> 2) * 1024; } }
#pragma unroll
        for (int q = 0; q < 4; ++q) { const float4 g = *(const float4*)(gnext + (q * 64 + lane) * 4);
            float4 hv; hv.x = xv[q].x * r2 * g.x; hv.y = xv[q].y * r2 * g.y; hv.z = xv[q].z * r2 * g.z; hv.w = xv[q].w * r2 * g.w;
            u32x2 w; w.x = pg8::cvt_pk_bf16(hv.x, hv.y); w.y = pg8::cvt_pk_bf16(hv.z, hv.w);
            *(u32x2*)(XN + (size_t)row * 1024 + (q * 64 + lane) * 4) = w;
            if (sh) *(float4*)(sh + (q * 64 + lane) * 4) = hv; }
    }
}

__device__ __forceinline__ void p0_prologue(PR P, LAS float* ldsf, const int wv) {
    const int tid = fresh_tid(wv); const size_t gt = (size_t)blockIdx.x * 512 + tid, nth = (size_t)gridDim.x * 512;
    { float* rc = (float*)(P.ws + WS_ROPE); float* rs = rc + 2052 * 64;
      for (size_t i = gt; i < 2052 * 64; i += nth) { const int p = (int)(i >> 6), f = (int)(i & 63); const int pos = p < 2048 ? p : 16384 + (p - 2048);
          double inv = 1.0; for (int q = 0; q < f; ++q) inv *= 0.8659643233600653;
          const double ang = (double)pos * inv; const double n = rint(ang * 0.15915494309189535); const double r = ang - n * 6.283185307179586;
          const double r2 = r * r; double s = 0.0, c = 0.0;
          for (int k = 14; k >= 0; --k) { s = s * (-r2 / (double)((2 * k + 2) * (2 * k + 3))) + 1.0; c = c * (-r2 / (double)((2 * k + 1) * (2 * k + 2))) + 1.0; }
          rc[i] = (float)c; rs[i] = (float)(s * r); } }
    { bf16_t* Wl = (bf16_t*)(P.ws + WS_WL);
      for (size_t i = gt; i < 1536 * 256; i += nth) { const int n = (int)(i >> 8), k = (int)(i & 255); float v = 0.f;
          if (n < 512) { if (k < 64) v = P.w2[k * 512 + n]; } else if (n < 1024) { if (k >= 64 && k < 128) v = P.a2[(k - 64) * 512 + (n - 512)]; } else { if (k >= 128) v = P.g2[(k - 128) * 512 + (n - 1024)]; }
          Wl[i] = f2bf(v); } }
    { bf16_t* XN = (bf16_t*)(P.ws + WS_XN);
      for (size_t i = gt; i < 256 * 1024; i += nth) { const int r = (int)(i >> 10); XN[(size_t)MT * 1024 + i] = r < 128 ? f2bf(P.state_shift[i]) : (bf16_t)0; } }
    tconv_list(P.f1g, P.f1u, P.f1d, P.w_in, P.w_out, P.ws, 3328, ldsf, wv);
    rows_phase(P, 0, wv);
}

__device__ __forceinline__ void lora_prep(PR P, const int wv) {
    const int tid = fresh_tid(wv); const int lane = tid & 63; const int gw = blockIdx.x * 8 + (tid >> 6), nw = gridDim.x * 8;
    const bf16_t* PS = (const bf16_t*)(P.ws + WS_BIG); bf16_t* LA = (bf16_t*)(P.ws + WS_LA);
    const float4 mu = *(const float4*)(P.mu + 1536 + lane * 4); const int kind = lane >> 4;
    u32x2 c = (u32x2){0u, 0u}, p = c, nc = c, np = c;
    if (gw < MT) { c = *(const u32x2*)(PS + (size_t)gw * NCOLS + 1536 + lane * 4); const int pr = prev_row(gw); if (pr >= 0) p = *(const u32x2*)(PS + (size_t)pr * NCOLS + 1536 + lane * 4); }
    for (int row = gw; row < MT; row += nw) {
        const int nrow = row + nw;
        if (nrow < MT) { nc = *(const u32x2*)(PS + (size_t)nrow * NCOLS + 1536 + lane * 4); const int pr = prev_row(nrow); np = (u32x2){0u, 0u}; if (pr >= 0) np = *(const u32x2*)(PS + (size_t)pr * NCOLS + 1536 + lane * 4); }
        float v[4]; const float cu[4] = {lo_bf(c.x), hi_bf(c.x), lo_bf(c.y), hi_bf(c.y)}, pv[4] = {lo_bf(p.x), hi_bf(p.x), lo_bf(p.y), hi_bf(p.y)}, m4[4] = {mu.x, mu.y, mu.z, mu.w};
#pragma unroll
        for (int j = 0; j < 4; ++j) { float x = cu[j] + (pv[j] - cu[j]) * m4[j];
            if (kind == 0) x = 1.0f - 2.0f / (__expf(2.0f * x) + 1.0f); else if (kind >= 2) x = sigmoid_f(x);
            v[j] = x; }
        u32x2 w; w.x = pg8::cvt_pk_bf16(v[0], v[1]); w.y = pg8::cvt_pk_bf16(v[2], v[3]);
        *(u32x2*)(LA + (size_t)row * 256 + lane * 4) = w;
        c = nc; p = np;
    }
}

template <bool SAMPLE>
__device__ __forceinline__ void rwkv_unit(PR P, LAS float* lds, const int b, const int h, const int half, const int wv) {
    constexpr int T = SAMPLE ? 4 : 2048, TC = SAMPLE ? 4 : 32, NCH = T / TC;
    const int tid = fresh_tid(wv), lane = tid & 63, wid = tid >> 6;
    const bf16_t* PS = (const bf16_t*)(P.ws + WS_BIG); const bf16_t* OMD = (const bf16_t*)(P.ws + WS_OMD); const bf16_t* ASIG = (const bf16_t*)(P.ws + WS_ASIG);
    bf16_t* YS = (bf16_t*)(P.ws + WS_YS);
    const int row_base = SAMPLE ? MP + b * 4 : b * 2048;
    const int ltok = (tid - 256) >> 4, lcg = tid & 15; const bool lwave = tid >= 256; const int hch = h * 64 + lcg * 4;
    const float4 mur = *(const float4*)(P.mu + hch), muk = *(const float4*)(P.mu + 512 + hch), muv = *(const float4*)(P.mu + 1024 + hch);
    const float4 kk4 = *(const float4*)(P.k_k + hch), ka4 = *(const float4*)(P.k_a + hch);
    typedef float f32x2 __attribute__((ext_vector_type(2)));
    const int row0 = half * 32 + (wid & 3) * 8 + (lane >> 4) * 2, cgl = lane & 15, j0 = cgl * 4;
    f32x2 S[4];
#pragma unroll
    for (int c = 0; c < 4; ++c) S[c] = (f32x2){0.f, 0.f};
    float* sout = P.out + (SAMPLE ? O_WKS : O_WKP) + ((size_t)(b * 8 + h) * 64 + row0) * 64 + j0;
    if (SAMPLE && wid < 4) { const float* sp = P.state_wkv + ((size_t)(b * 8 + h) * 64 + row0) * 64 + j0; const float4 s0 = *(const float4*)sp, s1 = *(const float4*)(sp + 64);
        S[0] = (f32x2){s0.x, s1.x}; S[1] = (f32x2){s0.y, s1.y}; S[2] = (f32x2){s0.z, s1.z}; S[3] = (f32x2){s0.w, s1.w}; }
    LAS float* buf0 = lds; LAS float* buf1 = lds + TC * 384;
    u32x2 cr[2], ck[2], cv[2], pr[2], pk[2], pv[2], co[2], ca[2];
#define RW_LOAD1(c, U) do { if (lwave && ltok + 16 * (U) < TC) { const int t_ = (c) * TC + ltok + 16 * (U); const int row_ = row_base + t_; const int prow_ = SAMPLE ? (t_ == 0 ? MT + b : row_ - 1) : row_ - 1; \
        const bf16_t* cp_ = PS + (size_t)row_ * NCOLS + hch; cr[U] = *(const u32x2*)cp_; ck[U] = *(const u32x2*)(cp_ + 512); cv[U] = *(const u32x2*)(cp_ + 1024); \
        if (SAMPLE || t_ > 0) { const bf16_t* pp_ = PS + (size_t)prow_ * NCOLS + hch; pr[U] = *(const u32x2*)pp_; pk[U] = *(const u32x2*)(pp_ + 512); pv[U] = *(const u32x2*)(pp_ + 1024); } \
        else { pr[U] = (u32x2){0u, 0u}; pk[U] = pr[U]; pv[U] = pr[U]; } \
        co[U] = *(const u32x2*)(OMD + (size_t)row_ * 512 + hch); ca[U] = *(const u32x2*)(ASIG + (size_t)row_ * 512 + hch); } } while (0)
#define RW_LOAD(c) do { RW_LOAD1(c, 0); RW_LOAD1(c, 1); } while (0)
#define RW_MIX(cu, pv_, m) ((cu) + ((pv_) - (cu)) * (m))
#define RW_PROC1(dst, U) do { if (lwave && ltok + 16 * (U) < TC) { LAS float* d_ = (dst) + (ltok + 16 * (U)) * 384 + lcg * 4; \
        f32x4 r_, k_, v_, o_, a_; \
        r_[0] = RW_MIX(lo_bf(cr[U].x), lo_bf(pr[U].x), mur.x); r_[1] = RW_MIX(hi_bf(cr[U].x), hi_bf(pr[U].x), mur.y); r_[2] = RW_MIX(lo_bf(cr[U].y), lo_bf(pr[U].y), mur.z); r_[3] = RW_MIX(hi_bf(cr[U].y), hi_bf(pr[U].y), mur.w); \
        k_[0] = RW_MIX(lo_bf(ck[U].x), lo_bf(pk[U].x), muk.x); k_[1] = RW_MIX(hi_bf(ck[U].x), hi_bf(pk[U].x), muk.y); k_[2] = RW_MIX(lo_bf(ck[U].y), lo_bf(pk[U].y), muk.z); k_[3] = RW_MIX(hi_bf(ck[U].y), hi_bf(pk[U].y), muk.w); \
        v_[0] = RW_MIX(lo_bf(cv[U].x), lo_bf(pv[U].x), muv.x); v_[1] = RW_MIX(hi_bf(cv[U].x), hi_bf(pv[U].x), muv.y); v_[2] = RW_MIX(lo_bf(cv[U].y), lo_bf(pv[U].y), muv.z); v_[3] = RW_MIX(hi_bf(cv[U].y), hi_bf(pv[U].y), muv.w); \
        o_[0] = lo_bf(co[U].x); o_[1] = hi_bf(co[U].x); o_[2] = lo_bf(co[U].y); o_[3] = hi_bf(co[U].y); a_[0] = lo_bf(ca[U].x); a_[1] = hi_bf(ca[U].x); a_[2] = lo_bf(ca[U].y); a_[3] = hi_bf(ca[U].y); \
        f32x4 kk_; kk_[0] = k_[0] * kk4.x; kk_[1] = k_[1] * kk4.y; kk_[2] = k_[2] * kk4.z; kk_[3] = k_[3] * kk4.w; \
        float ss_ = kk_[0] * kk_[0] + kk_[1] * kk_[1] + kk_[2] * kk_[2] + kk_[3] * kk_[3]; ss_ = row16_sum(ss_); \
        const float inv_ = 1.0f / fmaxf(sqrtf(ss_), 1e-12f); kk_ = kk_ * inv_; \
        f32x4 kn_; kn_[0] = k_[0] * (1.0f + (a_[0] - 1.0f) * ka4.x); kn_[1] = k_[1] * (1.0f + (a_[1] - 1.0f) * ka4.y); kn_[2] = k_[2] * (1.0f + (a_[2] - 1.0f) * ka4.z); kn_[3] = k_[3] * (1.0f + (a_[3] - 1.0f) * ka4.w); \
        *(LAS f32x4*)(d_) = r_; *(LAS f32x4*)(d_ + 64) = o_; *(LAS f32x4*)(d_ + 128) = kn_; *(LAS f32x4*)(d_ + 192) = -kk_; *(LAS f32x4*)(d_ + 256) = kk_ * a_; *(LAS f32x4*)(d_ + 320) = v_; } } while (0)
#define RW_PROC(dst) do { RW_PROC1(dst, 0); RW_PROC1(dst, 1); } while (0)
    RW_LOAD(0); RW_PROC(buf0); __syncthreads();
    for (int c = 0; c < NCH; ++c) {
        LAS float* cur = (c & 1) ? buf1 : buf0; LAS float* nxt = (c & 1) ? buf0 : buf1;
        if (c + 1 < NCH) RW_LOAD(c + 1);
        if (wid < 4) {
            constexpr int GS = SAMPLE ? 4 : 16;
            for (int g = 0; g < TC / GS; ++g) {
                float yk0 = 0.f, yk1 = 0.f;
                const LAS float* q0 = cur + (g * GS) * 384;
                f32x4 r4 = *(const LAS f32x4*)(q0 + j0), o4 = *(const LAS f32x4*)(q0 + 64 + j0), k4 = *(const LAS f32x4*)(q0 + 128 + j0), a4 = *(const LAS f32x4*)(q0 + 192 + j0), b4 = *(const LAS f32x4*)(q0 + 256 + j0);
                f32x2 v2 = *(const LAS f32x2*)(q0 + 320 + row0);
                float py0 = 0.f, py1 = 0.f;
#pragma unroll
                for (int tt = 0; tt < GS; ++tt) {
                    const LAS float* qn = q0 + (tt + 1 < GS ? tt + 1 : tt) * 384;
                    const f32x4 nr4 = *(const LAS f32x4*)(qn + j0), no4 = *(const LAS f32x4*)(qn + 64 + j0), nk4 = *(const LAS f32x4*)(qn + 128 + j0), na4 = *(const LAS f32x4*)(qn + 192 + j0), nb4 = *(const LAS f32x4*)(qn + 256 + j0);
                    const f32x2 nv2 = *(const LAS f32x2*)(qn + 320 + row0);
                    f32x2 sa = (S[0] * a4[0] + S[1] * a4[1]) + (S[2] * a4[2] + S[3] * a4[3]);
                    float sx = sa.x, sy = sa.y; ROW16_SUM4(sx, sy, py0, py1); sa = (f32x2){sx, sy};
                    if (tt > 0) { yk0 = cgl == tt - 1 ? py0 : yk0; yk1 = cgl == tt - 1 ? py1 : yk1; }
#pragma unroll
                    for (int c = 0; c < 4; ++c) { f32x2 t = S[c] - S[c] * o4[c]; t = t + sa * b4[c]; S[c] = t + v2 * k4[c]; }
                    const f32x2 y = (S[0] * r4[0] + S[1] * r4[1]) + (S[2] * r4[2] + S[3] * r4[3]);
                    py0 = y.x; py1 = y.y;
                    r4 = nr4; o4 = no4; k4 = nk4; a4 = na4; b4 = nb4; v2 = nv2;
                }
                ROW16_SUM2(py0, py1); yk0 = cgl == GS - 1 ? py0 : yk0; yk1 = cgl == GS - 1 ? py1 : yk1;
                if (cgl < GS) *(unsigned*)(YS + (size_t)(row_base + c * TC + g * GS + cgl) * 512 + h * 64 + row0) = pg8::cvt_pk_bf16(yk0, yk1);
            }
        }
        if (c + 1 < NCH) RW_PROC(nxt);
        __syncthreads();
    }
    if (wid < 4) { *(float4*)sout = make_float4(S[0].x, S[1].x, S[2].x, S[3].x); *(float4*)(sout + 64) = make_float4(S[0].y, S[1].y, S[2].y, S[3].y); }
#undef RW_LOAD
#undef RW_PROC
#undef RW_LOAD1
#undef RW_PROC1
#undef RW_MIX
}

__device__ __forceinline__ void ret_sample_unit(PR P, LAS float* lds, const int b, const int h, const int wv) {
    const int tid = fresh_tid(wv), lane = tid & 63, wid = tid >> 6;
    const bf16_t* PS = (const bf16_t*)(P.ws + WS_BIG); bf16_t* Y = (bf16_t*)(P.ws + WS_XN);
    const float* rc = (const float*)(P.ws + WS_ROPE); const float* rs = rc + 2052 * 64;
    LAS float* q = lds; LAS float* k = lds + 512; LAS float* v = lds + 1024; LAS float* Pm = lds + 1536; LAS float* y2p = lds + 1600; LAS float* red = lds + 1600 + 2048;
    const float lg2 = log2f(1.0f - exp2f(-5.0f - (float)h));
    const int row0 = MP + b * 4;
    { const int t = (tid & 255) >> 6, f = tid & 63; const bf16_t* src = PS + (size_t)(row0 + t) * NCOLS + 1792 + h * 128;
      if (tid < 256) { const float cs = rc[(2048 + t) * 64 + f], sn = rs[(2048 + t) * 64 + f];
          const float q1 = bf2f(src[f]), q2 = bf2f(src[f + 64]); q[t * 128 + f] = q1 * cs - q2 * sn; q[t * 128 + f + 64] = q1 * sn + q2 * cs;
          const float k1 = bf2f(src[512 + f]), k2 = bf2f(src[512 + f + 64]); k[t * 128 + f] = (k1 * cs - k2 * sn) * 0.08838834764831845f; k[t * 128 + f + 64] = (k1 * sn + k2 * cs) * 0.08838834764831845f; }
      else { v[t * 128 + f] = bf2f(src[1024 + f]); v[t * 128 + f + 64] = bf2f(src[1024 + f + 64]); } }
    __syncthreads();
    if (wid == 0) { const int pi = lane >> 4, pj = (lane >> 2) & 3, part = lane & 3; float s = 0.f;
        for (int d = part * 32; d < part * 32 + 32; ++d) s += q[pi * 128 + d] * k[pj * 128 + d];
        s = quad_sum(s); if (part == 0) Pm[pi * 4 + pj] = pi >= pj ? s * exp2f(lg2 * (float)(pi - pj)) : 0.f; }
    { const int e = tid & 127, dg = tid >> 7; const float c4 = exp2f(lg2 * 4.0f), g3 = exp2f(lg2 * 3.0f), g2_ = exp2f(lg2 * 2.0f), g1 = exp2f(lg2);
      const float v0 = v[e] * g3, v1 = v[128 + e] * g2_, v2 = v[256 + e] * g1, v3 = v[384 + e];
      const float* S0 = P.state_ret + ((size_t)(b * 4 + h) * 128) * 128 + e; float* So = P.out + O_RTS + ((size_t)(b * 4 + h) * 128) * 128 + e;
      float a0 = 0.f, a1 = 0.f, a2 = 0.f, a3 = 0.f;
      float sv[32];
#pragma unroll
      for (int x = 0; x < 32; ++x) sv[x] = S0[(size_t)(dg * 32 + x) * 128];
#pragma unroll
      for (int x = 0; x < 32; ++x) { const int d = dg * 32 + x; const float s = sv[x];
          a0 = fmaf(q[d], s, a0); a1 = fmaf(q[128 + d], s, a1); a2 = fmaf(q[256 + d], s, a2); a3 = fmaf(q[384 + d], s, a3);
          So[(size_t)d * 128] = s * c4 + k[d] * v0 + k[128 + d] * v1 + k[256 + d] * v2 + k[384 + d] * v3; }
      y2p[(dg * 4 + 0) * 128 + e] = a0; y2p[(dg * 4 + 1) * 128 + e] = a1; y2p[(dg * 4 + 2) * 128 + e] = a2; y2p[(dg * 4 + 3) * 128 + e] = a3; }
    __syncthreads();
    { const int i = tid >> 7, e = tid & 127;
      float y = (y2p[(0 + i) * 128 + e] + y2p[(4 + i) * 128 + e] + y2p[(8 + i) * 128 + e] + y2p[(12 + i) * 128 + e]) * exp2f(lg2 * (float)(i + 1));
#pragma unroll
      for (int j = 0; j < 4; ++j) y = fmaf(Pm[i * 4 + j], v[j * 128 + e], y);
      float s = wave_sum(y); if (lane == 0) red[wid] = s; __syncthreads();
      const float mean = (red[i * 2] + red[i * 2 + 1]) * (1.0f / 128.0f); const float dlt = y - mean;
      float s2 = wave_sum(dlt * dlt); if (lane == 0) red[8 + wid] = s2; __syncthreads();
      const float var = (red[8 + i * 2] + red[8 + i * 2 + 1]) * (1.0f / 128.0f);
      const float g = bf2f(PS[(size_t)(row0 + i) * NCOLS + 1792 + 1536 + h * 128 + e]);
      const float o = dlt * rsqrtf(var + 1e-5f) * P.gn_w[h * 128 + e] * (g / (1.0f + __expf(-g)));
      Y[(size_t)(row0 + i) * 1024 + 512 + h * 128 + e] = f2bf(o); }
    __syncthreads();
}

__device__ __forceinline__ bf16_t* kvb_ptr(unsigned char* ws, int bh) { return (bf16_t*)(bh < 29 ? ws + WS_LA + (size_t)bh * 524288 : ws + WS_WIN + 17301504 + (size_t)(bh - 29) * 524288); }
constexpr int RS = 136, BUFE = 128 * RS;

template <bool WITH_K>
__device__ __forceinline__ void ret_load_qk(PR P, LAS bf16_t* QP, LAS bf16_t* KB, unsigned (&kth)[4][4], const int tidv, const int row0, const int n, const int h, const float kd0, const float g32) {
    const bf16_t* PS = (const bf16_t*)(P.ws + WS_BIG); const float* rc = (const float*)(P.ws + WS_ROPE); const float* rs = rc + 2052 * 64;
    float kd = kd0;
#pragma unroll
    for (int it = 0; it < 4; ++it) { const int idx = it * 512 + tidv, i = idx >> 4, f = (idx & 15) * 4;
        const bf16_t* src = PS + (size_t)(row0 + i) * NCOLS + 1792 + h * 128;
        const u32x2 q1 = *(const u32x2*)(src + f), q2 = *(const u32x2*)(src + 64 + f);
        u32x2 k1 = (u32x2){0u, 0u}, k2 = k1; if (WITH_K) { k1 = *(const u32x2*)(src + 512 + f); k2 = *(const u32x2*)(src + 576 + f); }
        const float4 cs = *(const float4*)(rc + (size_t)(n * 128 + i) * 64 + f), sn = *(const float4*)(rs + (size_t)(n * 128 + i) * 64 + f);
        const float c4[4] = {cs.x, cs.y, cs.z, cs.w}, s4[4] = {sn.x, sn.y, sn.z, sn.w};
        const float qa[4] = {lo_bf(q1.x), hi_bf(q1.x), lo_bf(q1.y), hi_bf(q1.y)}, qb[4] = {lo_bf(q2.x), hi_bf(q2.x), lo_bf(q2.y), hi_bf(q2.y)};
        float qo1[4], qo2[4];
#pragma unroll
        for (int x = 0; x < 4; ++x) { qo1[x] = qa[x] * c4[x] - qb[x] * s4[x]; qo2[x] = qa[x] * s4[x] + qb[x] * c4[x]; }
        u32x2 w; w.x = pg8::cvt_pk_bf16(qo1[0], qo1[1]); w.y = pg8::cvt_pk_bf16(qo1[2], qo1[3]); *(LAS u32x2*)(QP + i * RS + f) = w;
        w.x = pg8::cvt_pk_bf16(qo2[0], qo2[1]); w.y = pg8::cvt_pk_bf16(qo2[2], qo2[3]); *(LAS u32x2*)(QP + i * RS + 64 + f) = w;
        if (WITH_K) {
            const float ka[4] = {lo_bf(k1.x), hi_bf(k1.x), lo_bf(k1.y), hi_bf(k1.y)}, kb[4] = {lo_bf(k2.x), hi_bf(k2.x), lo_bf(k2.y), hi_bf(k2.y)};
            float ko1[4], ko2[4];
#pragma unroll
            for (int x = 0; x < 4; ++x) { ko1[x] = (ka[x] * c4[x] - kb[x] * s4[x]) * 0.08838834764831845f; ko2[x] = (ka[x] * s4[x] + kb[x] * c4[x]) * 0.08838834764831845f; }
            w.x = pg8::cvt_pk_bf16(ko1[0], ko1[1]); w.y = pg8::cvt_pk_bf16(ko1[2], ko1[3]); *(LAS u32x2*)(KB + i * RS + f) = w;
            w.x = pg8::cvt_pk_bf16(ko2[0], ko2[1]); w.y = pg8::cvt_pk_bf16(ko2[2], ko2[3]); *(LAS u32x2*)(KB + i * RS + 64 + f) = w;
            kth[it][0] = pg8::cvt_pk_bf16(ko1[0] * kd, ko1[1] * kd); kth[it][1] = pg8::cvt_pk_bf16(ko1[2] * kd, ko1[3] * kd);
            kth[it][2] = pg8::cvt_pk_bf16(ko2[0] * kd, ko2[1] * kd); kth[it][3] = pg8::cvt_pk_bf16(ko2[2] * kd, ko2[3] * kd); kd *= g32; }
        if (it & 1) __builtin_amdgcn_sched_barrier(0); }
}

__device__ __forceinline__ void ret_unit_a(PR P, LAS unsigned char* lds, const int bh, const int n, const int wv) {
    LAS bf16_t* QP = (LAS bf16_t*)lds; LAS bf16_t* KB = QP + BUFE; LAS bf16_t* VT = KB + BUFE;
    const int tid = fresh_tid(wv), lane = tid & 63, wid = tid >> 6, wr = wid >> 1, wc = wid & 1, fr = lane & 15, fq = lane >> 4;
    const int b = bh >> 2, h = bh & 3;
    const bf16_t* PS = (const bf16_t*)(P.ws + WS_BIG); bf16_t* Y = (bf16_t*)(P.ws + WS_XN); bf16_t* KVB = kvb_ptr(P.ws, bh) + (size_t)n * 16384;
    const float lg2 = log2f(1.0f - exp2f(-5.0f - (float)h));
    const float kd0 = exp2f(lg2 * (float)(127 - (tid >> 4))), g32 = exp2f(-32.0f * lg2);
    const int row0 = b * 2048 + n * 128;
    unsigned kth[4][4];
    ret_load_qk<true>(P, QP, KB, kth, tid, row0, n, h, kd0, g32);
#pragma unroll
    for (int it = 0; it < 4; ++it) { const int idx = it * 512 + tid, j = idx >> 4, e = (idx & 15) * 8;
        const u32x4 vv = *(const u32x4*)(PS + (size_t)(row0 + j) * NCOLS + 1792 + 1024 + h * 128 + e);
        LAS bf16_t* d = VT + e * RS + j;
        d[0] = (bf16_t)(vv.x & 0xffffu); d[RS] = (bf16_t)(vv.x >> 16); d[2 * RS] = (bf16_t)(vv.y & 0xffffu); d[3 * RS] = (bf16_t)(vv.y >> 16);
        d[4 * RS] = (bf16_t)(vv.z & 0xffffu); d[5 * RS] = (bf16_t)(vv.z >> 16); d[6 * RS] = (bf16_t)(vv.w & 0xffffu); d[7 * RS] = (bf16_t)(vv.w >> 16); }
    __syncthreads();
    f32x4 accP[2][4];
#pragma unroll
    for (int mt = 0; mt < 2; ++mt)
#pragma unroll
        for (int nt = 0; nt < 4; ++nt) accP[mt][nt] = (f32x4){0.f, 0.f, 0.f, 0.f};
#pragma unroll
    for (int ks = 0; ks < 4; ++ks) { bf16x8 aq[2];
#pragma unroll
        for (int mt = 0; mt < 2; ++mt) aq[mt] = *(const LAS bf16x8*)(QP + (wr * 32 + mt * 16 + fr) * RS + ks * 32 + fq * 8);
#pragma unroll
        for (int nt = 0; nt < 4; ++nt) { const bf16x8 bk = *(const LAS bf16x8*)(KB + (wc * 64 + nt * 16 + fr) * RS + ks * 32 + fq * 8);
#pragma unroll
            for (int mt = 0; mt < 2; ++mt) accP[mt][nt] = __builtin_amdgcn_mfma_f32_16x16x32_bf16(aq[mt], bk, accP[mt][nt], 0, 0, 0); }
        __builtin_amdgcn_sched_barrier(0); }
    __syncthreads();
    { float ri[2][4], cj[4];
#pragma unroll
      for (int mt = 0; mt < 2; ++mt)
#pragma unroll
          for (int j = 0; j < 4; ++j) ri[mt][j] = exp2f(lg2 * (float)(wr * 32 + mt * 16 + fq * 4 + j));
#pragma unroll
      for (int nt = 0; nt < 4; ++nt) cj[nt] = exp2f(-lg2 * (float)(wc * 64 + nt * 16 + fr));
#pragma unroll
      for (int mt = 0; mt < 2; ++mt)
#pragma unroll
          for (int nt = 0; nt < 4; ++nt)
#pragma unroll
              for (int j = 0; j < 4; ++j) { const int i = wr * 32 + mt * 16 + fq * 4 + j, jj = wc * 64 + nt * 16 + fr;
                  const float val = i >= jj ? accP[mt][nt][j] * ri[mt][j] * cj[nt] : 0.f; QP[i * RS + jj] = f2bf(val); } }
#pragma unroll
    for (int it = 0; it < 4; ++it) { const int idx = it * 512 + tid, j = idx >> 4, f = (idx & 15) * 4; LAS bf16_t* d = KB + f * RS + j;
        d[0] = (bf16_t)(kth[it][0] & 0xffffu); d[RS] = (bf16_t)(kth[it][0] >> 16); d[2 * RS] = (bf16_t)(kth[it][1] & 0xffffu); d[3 * RS] = (bf16_t)(kth[it][1] >> 16);
        LAS bf16_t* d2 = d + 64 * RS;
        d2[0] = (bf16_t)(kth[it][2] & 0xffffu); d2[RS] = (bf16_t)(kth[it][2] >> 16); d2[2 * RS] = (bf16_t)(kth[it][3] & 0xffffu); d2[3 * RS] = (bf16_t)(kth[it][3] >> 16); }
    __syncthreads();
    f32x4 accY[2][4], accS[2][4];
#pragma unroll
    for (int mt = 0; mt < 2; ++mt)
#pragma unroll
        for (int nt = 0; nt < 4; ++nt) { accY[mt][nt] = (f32x4){0.f, 0.f, 0.f, 0.f}; accS[mt][nt] = (f32x4){0.f, 0.f, 0.f, 0.f}; }
#pragma unroll
    for (int ks = 0; ks < 4; ++ks) { bf16x8 ap[2], av[2];
#pragma unroll
        for (int mt = 0; mt < 2; ++mt) { ap[mt] = *(const LAS bf16x8*)(QP + (wr * 32 + mt * 16 + fr) * RS + ks * 32 + fq * 8); av[mt] = *(const LAS bf16x8*)(VT + (wr * 32 + mt * 16 + fr) * RS + ks * 32 + fq * 8); }
#pragma unroll
        for (int nt = 0; nt < 4; ++nt) { const bf16x8 bv = *(const LAS bf16x8*)(VT + (wc * 64 + nt * 16 + fr) * RS + ks * 32 + fq * 8), bkt = *(const LAS bf16x8*)(KB + (wc * 64 + nt * 16 + fr) * RS + ks * 32 + fq * 8);
#pragma unroll
            for (int mt = 0; mt < 2; ++mt) { accY[mt][nt] = __builtin_amdgcn_mfma_f32_16x16x32_bf16(ap[mt], bv, accY[mt][nt], 0, 0, 0); accS[mt][nt] = __builtin_amdgcn_mfma_f32_16x16x32_bf16(av[mt], bkt, accS[mt][nt], 0, 0, 0); } }
        __builtin_amdgcn_sched_barrier(0); }
#pragma unroll
    for (int mt = 0; mt < 2; ++mt)
#pragma unroll
        for (int nt = 0; nt < 4; ++nt)
#pragma unroll
            for (int j = 0; j < 4; ++j) { const int r = wr * 32 + mt * 16 + fq * 4 + j, c = wc * 64 + nt * 16 + fr;
                Y[(size_t)(row0 + r) * 1024 + 512 + h * 128 + c] = f2bf(accY[mt][nt][j]); KVB[r * 128 + c] = f2bf(accS[mt][nt][j]); }
    __syncthreads();
}

__device__ __forceinline__ void ret_prefix(PR P, const int item) {
    const int bh = item >> 11, i8 = (item & 2047) * 8; const int h = bh & 3;
    bf16_t* KVB = kvb_ptr(P.ws, bh) + i8;
    const float lg2 = log2f(1.0f - exp2f(-5.0f - (float)h)); const float c_dec = exp2f(lg2 * 128.0f);
    u32x4 kv[16];
#pragma unroll
    for (int n = 0; n < 16; ++n) kv[n] = *(const u32x4*)(KVB + (size_t)n * 16384);
    float S[8];
#pragma unroll
    for (int x = 0; x < 8; ++x) S[x] = 0.f;
#pragma unroll
    for (int n = 0; n < 16; ++n) { u32x4 w; w.x = pg8::cvt_pk_bf16(S[0], S[1]); w.y = pg8::cvt_pk_bf16(S[2], S[3]); w.z = pg8::cvt_pk_bf16(S[4], S[5]); w.w = pg8::cvt_pk_bf16(S[6], S[7]);
        *(u32x4*)(KVB + (size_t)n * 16384) = w;
        const float k8[8] = {lo_bf(kv[n].x), hi_bf(kv[n].x), lo_bf(kv[n].y), hi_bf(kv[n].y), lo_bf(kv[n].z), hi_bf(kv[n].z), lo_bf(kv[n].w), hi_bf(kv[n].w)};
#pragma unroll
        for (int x = 0; x < 8; ++x) S[x] = S[x] * c_dec + k8[x]; }
    const int e = i8 >> 7, d0 = i8 & 127;
#pragma unroll
    for (int x = 0; x < 8; ++x) P.out[O_RTP + ((size_t)bh * 128 + d0 + x) * 128 + e] = S[x];
}

__device__ __forceinline__ void ret_unit_c(PR P, LAS unsigned char* lds, const int bh, const int n, const int wv) {
    LAS bf16_t* QP = (LAS bf16_t*)lds; LAS bf16_t* ST = QP + 3 * BUFE; LAS float* YST = (LAS float*)(QP + BUFE);
    const int tid = fresh_tid(wv), lane = tid & 63, wid = tid >> 6, wr = wid >> 1, wc = wid & 1, fr = lane & 15, fq = lane >> 4;
    const int b = bh >> 2, h = bh & 3;
    const bf16_t* PS = (const bf16_t*)(P.ws + WS_BIG); bf16_t* Y = (bf16_t*)(P.ws + WS_XN); const bf16_t* KVB = kvb_ptr(P.ws, bh) + (size_t)n * 16384;
    const float lg2 = log2f(1.0f - exp2f(-5.0f - (float)h));
    const int row0 = b * 2048 + n * 128;
    unsigned kth[4][4];
    ret_load_qk<false>(P, QP, QP, kth, tid, row0, n, h, 0.f, 0.f);
#pragma unroll
    for (int it = 0; it < 4; ++it) { const int idx = it * 512 + tid, e = idx >> 4, d8 = (idx & 15) * 8;
        *(LAS u32x4*)(ST + e * RS + d8) = *(const u32x4*)(KVB + e * 128 + d8); }
    __syncthreads();
    f32x4 accY[2][4];
#pragma unroll
    for (int mt = 0; mt < 2; ++mt)
#pragma unroll
        for (int nt = 0; nt < 4; ++nt) accY[mt][nt] = (f32x4){0.f, 0.f, 0.f, 0.f};
#pragma unroll
    for (int ks = 0; ks < 4; ++ks) { bf16x8 aq[2];
#pragma unroll
        for (int mt = 0; mt < 2; ++mt) aq[mt] = *(const LAS bf16x8*)(QP + (wr * 32 + mt * 16 + fr) * RS + ks * 32 + fq * 8);
#pragma unroll
        for (int nt = 0; nt < 4; ++nt) { const bf16x8 bs = *(const LAS bf16x8*)(ST + (wc * 64 + nt * 16 + fr) * RS + ks * 32 + fq * 8);
#pragma unroll
            for (int mt = 0; mt < 2; ++mt) accY[mt][nt] = __builtin_amdgcn_mfma_f32_16x16x32_bf16(aq[mt], bs, accY[mt][nt], 0, 0, 0); }
        __builtin_amdgcn_sched_barrier(0); }
#pragma unroll
    for (int mt = 0; mt < 2; ++mt)
#pragma unroll
        for (int j = 0; j < 4; ++j) { const int r = wr * 32 + mt * 16 + fq * 4 + j; const float qd = exp2f(lg2 * (float)(r + 1));
#pragma unroll
            for (int nt = 0; nt < 4; ++nt) YST[r * 132 + wc * 64 + nt * 16 + fr] = accY[mt][nt][j] * qd; }
    __syncthreads();
    { const int i = tid >> 2, part = tid & 3; float yv[32]; float s = 0.f;
      bf16_t* yo = Y + (size_t)(row0 + i) * 1024 + 512 + h * 128 + part * 32;
#pragma unroll
      for (int x = 0; x < 4; ++x) { const u32x4 y1 = *(const u32x4*)(yo + x * 8); const f32x4 ta = *(const LAS f32x4*)(YST + i * 132 + part * 32 + x * 8), tb = *(const LAS f32x4*)(YST + i * 132 + part * 32 + x * 8 + 4);
          yv[x * 8 + 0] = ta[0] + lo_bf(y1.x); yv[x * 8 + 1] = ta[1] + hi_bf(y1.x); yv[x * 8 + 2] = ta[2] + lo_bf(y1.y); yv[x * 8 + 3] = ta[3] + hi_bf(y1.y);
          yv[x * 8 + 4] = tb[0] + lo_bf(y1.z); yv[x * 8 + 5] = tb[1] + hi_bf(y1.z); yv[x * 8 + 6] = tb[2] + lo_bf(y1.w); yv[x * 8 + 7] = tb[3] + hi_bf(y1.w); }
#pragma unroll
      for (int x = 0; x < 32; ++x) s += yv[x];
      s = quad_sum(s); const float mean = s * (1.0f / 128.0f); float s2 = 0.f;
#pragma unroll
      for (int x = 0; x < 32; ++x) { yv[x] -= mean; s2 += yv[x] * yv[x]; }
      s2 = quad_sum(s2); const float rstd = rsqrtf(s2 * (1.0f / 128.0f) + 1e-5f);
      const bf16_t* gp = PS + (size_t)(row0 + i) * NCOLS + 1792 + 1536 + h * 128 + part * 32; const float* gw = P.gn_w + h * 128 + part * 32;
#pragma unroll
      for (int x = 0; x < 4; ++x) { const u32x4 g4 = *(const u32x4*)(gp + x * 8); const float4 w0 = *(const float4*)(gw + x * 8), w1 = *(const float4*)(gw + x * 8 + 4);
          const float gg[8] = {lo_bf(g4.x), hi_bf(g4.x), lo_bf(g4.y), hi_bf(g4.y), lo_bf(g4.z), hi_bf(g4.z), lo_bf(g4.w), hi_bf(g4.w)}; const float ww[8] = {w0.x, w0.y, w0.z, w0.w, w1.x, w1.y, w1.z, w1.w};
          float o[8];
#pragma unroll
          for (int z = 0; z < 8; ++z) o[z] = yv[x * 8 + z] * rstd * ww[z] * (gg[z] / (1.0f + __expf(-gg[z])));
          u32x4 w; w.x = pg8::cvt_pk_bf16(o[0], o[1]); w.y = pg8::cvt_pk_bf16(o[2], o[3]); w.z = pg8::cvt_pk_bf16(o[4], o[5]); w.w = pg8::cvt_pk_bf16(o[6], o[7]);
          *(u32x4*)(yo + x * 8) = w; } }
    __syncthreads();
}

__device__ __forceinline__ void sub_barrier(unsigned* cnt, const unsigned target, const int wv) {
    asm volatile("s_waitcnt vmcnt(0)" ::: "memory");
    __syncthreads();
    if (fresh_tid(wv) == 0) {
        __builtin_amdgcn_fence(__ATOMIC_RELEASE, "agent");
        asm volatile("s_waitcnt vmcnt(0)" ::: "memory");
        (void)xb_add(cnt, 1u);
        unsigned sp = 0u;
        while (xb_ld(cnt) < target) { __builtin_amdgcn_s_sleep(2); if (++sp > (1u << 20)) break; }
        __builtin_amdgcn_fence(__ATOMIC_ACQUIRE, "agent");
        asm volatile("s_waitcnt vmcnt(0)" ::: "memory");
    }
    __syncthreads();
}

struct PostRegs { u32x2 yr, c_r, c_k, c_v, p_r, p_k, p_v, ar, gr; };
__device__ __forceinline__ void post_load(PR P, PostRegs& R, const int row, const int ch) {
    const bf16_t* PS = (const bf16_t*)(P.ws + WS_BIG); const bf16_t* ASIG = (const bf16_t*)(P.ws + WS_ASIG); const bf16_t* YS = (const bf16_t*)(P.ws + WS_YS); const bf16_t* G = (const bf16_t*)(P.ws + WS_WIN);
    R.yr = *(const u32x2*)(YS + (size_t)row * 512 + ch);
    const bf16_t* cp = PS + (size_t)row * NCOLS + ch; const int pr = prev_row(row);
    R.c_r = *(const u32x2*)cp; R.c_k = *(const u32x2*)(cp + 512); R.c_v = *(const u32x2*)(cp + 1024);
    R.p_r = (u32x2){0u, 0u}; R.p_k = R.p_r; R.p_v = R.p_r;
    if (pr >= 0) { const bf16_t* pp = PS + (size_t)pr * NCOLS + ch; R.p_r = *(const u32x2*)pp; R.p_k = *(const u32x2*)(pp + 512); R.p_v = *(const u32x2*)(pp + 1024); }
    R.ar = *(const u32x2*)(ASIG + (size_t)row * 512 + ch); R.gr = *(const u32x2*)(G + (size_t)row * 512 + ch);
}
__device__ __forceinline__ void rwkv_post(PR P, const int wv) {
    const int tid = fresh_tid(wv); const int lane = tid & 63; const int gw = blockIdx.x * 8 + (tid >> 6), nw = gridDim.x * 8;
    const int sub = lane >> 4, cg4 = (lane & 15) * 4;
    bf16_t* Y = (bf16_t*)(P.ws + WS_XN);
    const int h = (gw * 4 + sub) & 7, ch = h * 64 + cg4;
    const float4 mr = *(const float4*)(P.mu + ch), mk = *(const float4*)(P.mu + 512 + ch), mv = *(const float4*)(P.mu + 1024 + ch);
    const float4 ka = *(const float4*)(P.k_a + ch), rk = *(const float4*)(P.r_k + ch), lw = *(const float4*)(P.lnx_w + ch), lb = *(const float4*)(P.lnx_b + ch);
    const float m_r[4] = {mr.x, mr.y, mr.z, mr.w}, m_k[4] = {mk.x, mk.y, mk.z, mk.w}, m_v[4] = {mv.x, mv.y, mv.z, mv.w};
    const float kaa[4] = {ka.x, ka.y, ka.z, ka.w}, rkk[4] = {rk.x, rk.y, rk.z, rk.w}, lww[4] = {lw.x, lw.y, lw.z, lw.w}, lbb[4] = {lb.x, lb.y, lb.z, lb.w};
    PostRegs R, N;
    if (gw < MT * 2) post_load(P, R, (gw * 4 + sub) >> 3, ch);
    for (int task = gw; task < MT * 2; task += nw) {
        const int row = (task * 4 + sub) >> 3;
        if (task + nw < MT * 2) post_load(P, N, ((task + nw) * 4 + sub) >> 3, ch);
        const float ys[4] = {lo_bf(R.yr.x), hi_bf(R.yr.x), lo_bf(R.yr.y), hi_bf(R.yr.y)};
        const float mean = row16_sum(ys[0] + ys[1] + ys[2] + ys[3]) * (1.0f / 64.0f);
        float dl[4], s2 = 0.f;
#pragma unroll
        for (int j = 0; j < 4; ++j) { dl[j] = ys[j] - mean; s2 += dl[j] * dl[j]; }
        const float rstd = rsqrtf(row16_sum(s2) * (1.0f / 64.0f) + 64e-5f);
        const float cr[4] = {lo_bf(R.c_r.x), hi_bf(R.c_r.x), lo_bf(R.c_r.y), hi_bf(R.c_r.y)}, ck[4] = {lo_bf(R.c_k.x), hi_bf(R.c_k.x), lo_bf(R.c_k.y), hi_bf(R.c_k.y)}, cv[4] = {lo_bf(R.c_v.x), hi_bf(R.c_v.x), lo_bf(R.c_v.y), hi_bf(R.c_v.y)};
        const float qr[4] = {lo_bf(R.p_r.x), hi_bf(R.p_r.x), lo_bf(R.p_r.y), hi_bf(R.p_r.y)}, qk[4] = {lo_bf(R.p_k.x), hi_bf(R.p_k.x), lo_bf(R.p_k.y), hi_bf(R.p_k.y)}, qv[4] = {lo_bf(R.p_v.x), hi_bf(R.p_v.x), lo_bf(R.p_v.y), hi_bf(R.p_v.y)};
        const float aa[4] = {lo_bf(R.ar.x), hi_bf(R.ar.x), lo_bf(R.ar.y), hi_bf(R.ar.y)}, gg[4] = {lo_bf(R.gr.x), hi_bf(R.gr.x), lo_bf(R.gr.y), hi_bf(R.gr.y)};
        float v[4], bp = 0.f;
#pragma unroll
        for (int j = 0; j < 4; ++j) { const float r = cr[j] + (qr[j] - cr[j]) * m_r[j], k = ck[j] + (qk[j] - ck[j]) * m_k[j]; v[j] = cv[j] + (qv[j] - cv[j]) * m_v[j];
            const float kn = k * (1.0f + (aa[j] - 1.0f) * kaa[j]); bp += r * kn * rkk[j]; }
        const float bonus = row16_sum(bp);
        float o[4];
#pragma unroll
        for (int j = 0; j < 4; ++j) o[j] = (dl[j] * rstd * lww[j] + lbb[j] + bonus * v[j]) * gg[j];
        u32x2 w; w.x = pg8::cvt_pk_bf16(o[0], o[1]); w.y = pg8::cvt_pk_bf16(o[2], o[3]);
        *(u32x2*)(Y + (size_t)row * 1024 + ch) = w;
        R = N;
    }
}

__global__ void __launch_bounds__(512, 2) hymba_mega(Params P_unused) {
    extern __shared__ __attribute__((aligned(16))) unsigned char shm[];
    cg::grid_group grid = cg::this_grid();
    LAS unsigned char* lds = (LAS unsigned char*)shm; LAS float* ldsf = (LAS float*)shm;
    const int G = gridDim.x, bx = blockIdx.x;
    const int wv = __builtin_amdgcn_readfirstlane(threadIdx.x >> 6);
    const CAS Params* kp = (const CAS Params*)__builtin_amdgcn_kernarg_segment_ptr();
#define P (*kp)
#define FRESH() asm volatile("" : "+s"(kp))
#ifndef REP_SYNC
#define REP_SYNC 1
#endif
#ifndef REP_P7
#define REP_P7 1
#endif
#ifndef REP_FFN1
#define REP_FFN1 1
#endif
#ifndef REP_P0
#define REP_P0 1
#endif
#ifndef REP_P3
#define REP_P3 1
#endif
#ifndef REP_RW
#define REP_RW 1
#endif
#ifndef REP_OTH
#define REP_OTH 1
#endif
#ifndef REP_RETP
#define REP_RETP 1
#endif
#ifndef REP_SAMP
#define REP_SAMP 1
#endif
#ifndef REP_P8
#define REP_P8 1
#endif
#define GSYNC() do { for (int r_ = 0; r_ < REP_SYNC; ++r_) xcd_barrier((unsigned*)ws, (volatile LAS unsigned*)(lds + LDS_BYTES - 16), wv); FRESH(); } while (0)
#define ws (kp->ws)
#define XN ((bf16_t*)(ws + WS_XN))
#define ACT ((bf16_t*)(ws + WS_BIG))
#define FO ((float*)(ws + WS_FO))
#define PS ((bf16_t*)(ws + WS_BIG))
    pg8::StaticOrder S;
    { unsigned* barw = (unsigned*)ws; const int t0 = fresh_tid(wv); if (bx == 0) for (int i = t0; i < XCD_BAR_WORDS + 128; i += 512) barw[i] = 0u;
      if (t0 < 4) ((LAS unsigned*)(lds + LDS_BYTES - 16))[t0] = 0u; }
#ifndef PHM
#define PHM 0xFFFF
#endif
#define PH(k) if ((PHM >> (k)) & 1)
    for (int r0 = 0; r0 < REP_P0; ++r0) PH(0) p0_prologue(P, ldsf, wv);
    grid.sync(); FRESH();
    if (fresh_tid(wv) == 0) (void)xb_add(&((unsigned*)ws)[XB_XCNT(xb_xcc_id())], 1u);
    for (int rep1 = 0; rep1 < REP_FFN1; ++rep1) {
    PH(1) { pg8::Gemm g{XN, (const bf16_t*)(ws + WS_WGU), MT, NGU, 1024}; S.init(MT, NGU, G, bx, 1024); pg8::EpiSwiGLU E{ACT, DFF}; pg8::gemm_phase(lds, g, S, E, wv); }
    GSYNC();
    PH(2) { pg8::Gemm g{ACT, (const bf16_t*)(ws + WS_WD), MT, 1024, DFF}; pg8::SplitOrder S2; S2.init2(G, bx, DFF, 8); pg8::EpiFO E{(bf16_t*)FO, 1024, (float*)(ws + WS_OMD)}; pg8::gemm_phase(lds, g, S2, E, wv); }
    GSYNC();
    }
    for (int r3 = 0; r3 < REP_P3; ++r3) PH(3) rows_phase(P, 1, wv);
    GSYNC();
    PH(4) { pg8::Gemm g{XN, (const bf16_t*)(ws + WS_WIN), MIN_, NCOLS, 1024}; S.init(MIN_, NCOLS, G, bx, 1024); pg8::EpiBf16 E{PS, NCOLS}; pg8::gemm_phase(lds, g, S, E, wv); }
    GSYNC();
    PH(5) lora_prep(P, wv);
    GSYNC();
    PH(6) { pg8::Gemm g{(const bf16_t*)(ws + WS_LA), (const bf16_t*)(ws + WS_WL), MT, 1536, 256}; S.init(MT, 1536, G, bx, 256);
      pg8::EpiLora E{(bf16_t*)(ws + WS_OMD), (bf16_t*)(ws + WS_ASIG), (bf16_t*)(ws + WS_WIN), P.w0, P.a0}; pg8::gemm_phase(lds, g, S, E, wv); }
    GSYNC();
    {
    if (bx < 128) { for (int rw = 0; rw < REP_RW; ++rw) rwkv_unit<false>(P, ldsf, bx >> 4, (bx >> 1) & 7, bx & 1, wv); }
    else for (int rep7 = 0; rep7 < REP_OTH; ++rep7) { const int ob = bx - 128; unsigned* sbc = (unsigned*)ws + XCD_BAR_WORDS + 64;
        for (int k = 0; k < 4; ++k) { const int u = ob + k * 128; ret_unit_a(P, lds, u >> 4, u & 15, wv); }
        sub_barrier(sbc, 128u * (2u * rep7 + 1u), wv);
        ret_prefix(P, ob * 512 + fresh_tid(wv));
        sub_barrier(sbc, 128u * (2u * rep7 + 2u), wv);
        for (int k = 0; k < 4; ++k) { const int u = ob + k * 128; ret_unit_c(P, lds, u >> 4, u & 15, wv); }
        for (int u = ob; u < 2560; u += 128) { if (u < 2048) rwkv_unit<true>(P, ldsf, u >> 4, (u >> 1) & 7, u & 1, wv); else ret_sample_unit(P, ldsf, (u - 2048) >> 2, (u - 2048) & 3, wv); }
    }
    }
    GSYNC();
    for (int rep8 = 0; rep8 < REP_P8; ++rep8) PH(8) rwkv_post(P, wv);
    GSYNC();
    PH(9) { pg8::Gemm g{XN, (const bf16_t*)(ws + WS_WOUT), MT, 1024, 1024}; pg8::SplitOrder S2; S2.init2(G, bx, 1024, 4); pg8::EpiFO E{(bf16_t*)FO, 1024, (float*)(ws + WS_OMD)}; pg8::gemm_phase(lds, g, S2, E, wv); }
    GSYNC();
    PH(10) { tconv_list(P.f2g, P.f2u, P.f2d, nullptr, nullptr, ws, 2112, ldsf, wv);
    rows_phase(P, 2, wv); }
    GSYNC();
    PH(11) { pg8::Gemm g{XN, (const bf16_t*)(ws + WS_WGU), MT, NGU, 1024}; S.init(MT, NGU, G, bx, 1024); pg8::EpiSwiGLU E{ACT, DFF}; pg8::gemm_phase(lds, g, S, E, wv); }
    GSYNC();
    PH(12) { pg8::Gemm g{ACT, (const bf16_t*)(ws + WS_WD), MT, 1024, DFF}; pg8::SplitOrder S2; S2.init2(G, bx, DFF, 8); pg8::EpiFO E{(bf16_t*)FO, 1024, (float*)(ws + WS_OMD)}; pg8::gemm_phase(lds, g, S2, E, wv); }
    GSYNC();
    PH(13) rows_phase(P, 3, wv);
}

#undef ws
#undef XN
#undef ACT
#undef FO
#undef PS
#undef P
extern "C" void kernel_launch(void* const* d_in, const int* in_sizes, int n_in, void* d_out, int out_size, void* d_ws, size_t ws_size, hipStream_t stream) {
    static int grid = 0;
    if (grid == 0) {
        if (n_in != 26 || ws_size < WS_END) { fprintf(stderr, "kernel_launch: unexpected n_in %d or ws_size %zu (< %zu)\n", n_in, ws_size, (size_t)WS_END); grid = -1; return; }
        int dev = 0, cus = 0, per_cu = 0;
        hipGetDevice(&dev); hipDeviceGetAttribute(&cus, hipDeviceAttributeMultiprocessorCount, dev);
        hipFuncSetAttribute((const void*)hymba_mega, hipFuncAttributeMaxDynamicSharedMemorySize, LDS_BYTES);
        hipOccupancyMaxActiveBlocksPerMultiprocessor(&per_cu, (const void*)hymba_mega, 512, LDS_BYTES);
        if (per_cu < 1) { fprintf(stderr, "kernel_launch: occupancy query says %d blocks/CU\n", per_cu); per_cu = 1; }
        grid = cus * per_cu; if (grid > 256) grid = 256;
        if (grid != 256) { fprintf(stderr, "kernel_launch: this kernel needs 256 co-resident workgroups, got %d\n", grid); grid = -1; return; }
        fprintf(stderr, "kernel_launch: cus %d per_cu %d grid %d ws %zu\n", cus, per_cu, grid, ws_size);
    }
    if (grid < 0) return;
    Params p{};
    const float** pp = (const float**)&p;
    for (int i = 0; i < 26; ++i) pp[i] = (const float*)d_in[i];
    p.out = (float*)d_out; p.ws = (unsigned char*)d_ws;
    void* args[] = {&p};
    hipError_t e = hipLaunchCooperativeKernel((const void*)hymba_mega, dim3(grid), dim3(512), args, LDS_BYTES, stream);
    if (e != hipSuccess) fprintf(stderr, "cooperative launch failed: %s (grid %d)\n", hipGetErrorString(e), grid);
}
```

```cpp
#include <hip/hip_runtime.h>
#include <hip/hip_cooperative_groups.h>
#include <cstdio>
#include <cstdint>
namespace cg = cooperative_groups;

__device__ __forceinline__ int fresh_tid(int wv) { int l; asm volatile("v_mbcnt_lo_u32_b32 %0, -1, 0\n\tv_mbcnt_hi_u32_b32 %0, -1, %0" : "=v"(l)); return wv * 64 + l; }
namespace pg8 {
#define PG8_LAS __attribute__((address_space(3)))
typedef unsigned short bf16_t;
typedef short bf16x8 __attribute__((ext_vector_type(8)));
typedef float f32x4 __attribute__((ext_vector_type(4)));
typedef unsigned u32x4 __attribute__((ext_vector_type(4)));
typedef unsigned u32x2 __attribute__((ext_vector_type(2)));
constexpr int BM = 256, BK = 64, HALF = 128, HTB = HALF * BK * 2, STAGE_BYTES = 8 * HTB, NXCD = 8, WGM = 8;

__host__ __device__ __forceinline__ int lds_byte(int r, int c) { const int st = (r >> 4) * 2 + (c >> 5), rr = r & 15, cc = c & 31, ob = rr * 64 + cc * 2; return st * 1024 + (ob ^ (((ob >> 9) & 1) << 5)); }
__host__ __device__ __forceinline__ void stage_rc(int b, int& R, int& C) { const int st = b / 1024, sb = b % 1024, swz = sb ^ (((sb >> 9) & 1) << 5); R = (st >> 1) * 16 + swz / 64; C = (st & 1) * 32 + (swz % 64) / 2; }
__host__ __device__ __forceinline__ int perm32(int rho) { const int n = rho >> 4, i = rho & 15; return 8 * (i >> 2) + 4 * n + (i & 3); }

struct Unit { int pm, pn, k0, nkt, atomic; };
struct Gemm { const bf16_t* A; const bf16_t* Bt; int M, N, K; };

struct StaticOrder {
    int nM, nN, nwg, G, c, nt;
    __host__ __device__ void init(int M, int N, int G_, int c_, int K) { nM = M / BM; nN = N / BM; nwg = nM * nN; G = G_; c = c_; nt = K / BK; }
    __host__ __device__ bool next(int i, Unit& u) const {
        const long L = (long)i * G + c; if (L >= nwg) return false;
        int wgid = (int)L; { const int q = nwg / NXCD, r = nwg % NXCD, xcd = wgid % NXCD, off = wgid / NXCD; wgid = (xcd < r ? xcd * (q + 1) : r * (q + 1) + (xcd - r) * q) + off; }
        const int nig = WGM * nN, gid = wgid / nig, fm = gid * WGM, gsz = (nM - fm) < WGM ? (nM - fm) : WGM;
        u.pm = fm + ((wgid % nig) % gsz); u.pn = (wgid % nig) / gsz; u.k0 = 0; u.nkt = nt; u.atomic = 0; return true;
    }
    __device__ __forceinline__ void a_ready(const Unit&) const {}
    __device__ __forceinline__ void done(const Unit&) const {}
};
struct SplitOrder : StaticOrder {
    int KS;
    __host__ __device__ void init2(int G_, int c_, int K, int KS_) { init(16384, 1024, G_, c_, K); KS = KS_; }
    __host__ __device__ bool next(int i, Unit& u) const {
        if (i == 0) return StaticOrder::next(0, u);
        if (i > 1 || c >= 8 * KS) return false;
        const int tile = c / KS, part = c % KS, pairs = nt / 2, q = pairs / KS, r = pairs % KS;
        u.pm = 64 + (tile >> 2); u.pn = tile & 3; u.k0 = 2 * (part * q + (part < r ? part : r)); u.nkt = 2 * (q + (part < r ? 1 : 0)); u.atomic = 1 + c; return true;
    }
};

__device__ __forceinline__ unsigned cvt_pk_bf16(float lo, float hi) { unsigned r; asm volatile("v_cvt_pk_bf16_f32 %0, %1, %2" : "=v"(r) : "v"(lo), "v"(hi)); return r; }

struct EpiFO {
    static constexpr bool PERM = true;
    bf16_t* C; int ldc; float* slab;
    __device__ __forceinline__ void operator()(const f32x4 (&acc)[2][2][4][2], const Unit& u, int wr, int wc, int fr, int fq) const {
        if (u.atomic == 0) {
            const int row0 = u.pm * BM + wr * 64 + fr; const int col0 = u.pn * BM + wc * 32 + 8 * fq;
#pragma unroll
            for (int ai = 0; ai < 2; ++ai)
#pragma unroll
                for (int m = 0; m < 4; ++m) { bf16_t* rowp = C + (size_t)(row0 + ai * HALF + m * 16) * ldc + col0;
#pragma unroll
                    for (int bj = 0; bj < 2; ++bj) { const f32x4 v0 = acc[ai][bj][m][0], v1 = acc[ai][bj][m][1];
                        u32x4 w; w.x = cvt_pk_bf16(v0[0], v0[1]); w.y = cvt_pk_bf16(v0[2], v0[3]); w.z = cvt_pk_bf16(v1[0], v1[1]); w.w = cvt_pk_bf16(v1[2], v1[3]);
                        *(u32x4*)(rowp + bj * HALF) = w; } }
        } else {
            float* base = slab + (size_t)(u.atomic - 1) * (BM * BM) + (size_t)(wr * 64 + fr) * BM + wc * 32 + 8 * fq;
#pragma unroll
            for (int ai = 0; ai < 2; ++ai)
#pragma unroll
                for (int m = 0; m < 4; ++m) { float* rowp = base + (size_t)(ai * HALF + m * 16) * BM;
#pragma unroll
                    for (int bj = 0; bj < 2; ++bj) { *(f32x4*)(rowp + bj * HALF) = acc[ai][bj][m][0]; *(f32x4*)(rowp + bj * HALF + 4) = acc[ai][bj][m][1]; } }
        }
    }
};
struct EpiBf16 {
    static constexpr bool PERM = true;
    bf16_t* O; int ldc;
    __device__ __forceinline__ void operator()(const f32x4 (&acc)[2][2][4][2], const Unit& u, int wr, int wc, int fr, int fq) const {
        const int row0 = u.pm * BM + wr * 64 + fr; const int col0 = u.pn * BM + wc * 32 + 8 * fq;
#pragma unroll
        for (int ai = 0; ai < 2; ++ai)
#pragma unroll
            for (int m = 0; m < 4; ++m) { bf16_t* rowp = O + (size_t)(row0 + ai * HALF + m * 16) * ldc + col0;
#pragma unroll
                for (int bj = 0; bj < 2; ++bj) { const f32x4 v0 = acc[ai][bj][m][0], v1 = acc[ai][bj][m][1];
                    u32x4 w; w.x = cvt_pk_bf16(v0[0], v0[1]); w.y = cvt_pk_bf16(v0[2], v0[3]); w.z = cvt_pk_bf16(v1[0], v1[1]); w.w = cvt_pk_bf16(v1[2], v1[3]);
                    *(u32x4*)(rowp + bj * HALF) = w; } }
    }
};
__device__ __forceinline__ float silu_f(float x) { return x * __builtin_amdgcn_rcpf(1.0f + __expf(-x)); }
struct EpiSwiGLU {
    static constexpr bool PERM = true;
    bf16_t* O; int ldc;
    __device__ __forceinline__ void operator()(const f32x4 (&acc)[2][2][4][2], const Unit& u, int wr, int wc, int fr, int fq) const {
        const int row0 = u.pm * BM + wr * 64 + fr; const int col0 = u.pn * HALF + wc * 32 + 8 * fq;
#pragma unroll
        for (int ai = 0; ai < 2; ++ai)
#pragma unroll
            for (int m = 0; m < 4; ++m) { bf16_t* rowp = O + (size_t)(row0 + ai * HALF + m * 16) * ldc + col0;
                float o[8];
#pragma unroll
                for (int n = 0; n < 2; ++n)
#pragma unroll
                    for (int j = 0; j < 4; ++j) o[n * 4 + j] = silu_f(acc[ai][0][m][n][j]) * acc[ai][1][m][n][j];
                u32x4 w; w.x = cvt_pk_bf16(o[0], o[1]); w.y = cvt_pk_bf16(o[2], o[3]); w.z = cvt_pk_bf16(o[4], o[5]); w.w = cvt_pk_bf16(o[6], o[7]);
                *(u32x4*)rowp = w; }
    }
};
struct EpiLora {
    static constexpr bool PERM = true;
    bf16_t* OMD; bf16_t* ASIG; bf16_t* G; const float* w0; const float* a0;
    template <int KIND> __device__ __forceinline__ void body(const f32x4 (&acc)[2][2][4][2], bf16_t* O, const float* bias, int row0, int ch0) const {
#pragma unroll
        for (int bj = 0; bj < 2; ++bj)
#pragma unroll
            for (int ai = 0; ai < 2; ++ai)
#pragma unroll
                for (int m = 0; m < 4; ++m) { bf16_t* rowp = O + (size_t)(row0 + ai * HALF + m * 16) * 512 + ch0 + bj * HALF;
                    float o[8];
#pragma unroll
                    for (int n = 0; n < 2; ++n)
#pragma unroll
                        for (int j = 0; j < 4; ++j) { float v = acc[ai][bj][m][n][j];
                            if (KIND == 0) { v += bias[ch0 + bj * HALF + n * 4 + j]; const float nv = -v; const float sp = fmaxf(nv, 0.f) + __logf(1.0f + __expf(-fabsf(nv)));
                                const float e = __expf(-sp - 0.5f);
                                float p = 1.0f / 40320.0f; p = -1.0f / 5040.0f + e * p; p = 1.0f / 720.0f + e * p; p = -1.0f / 120.0f + e * p; p = 1.0f / 24.0f + e * p; p = -1.0f / 6.0f + e * p; p = 0.5f + e * p; p = 1.0f - e * p;
                                v = e * p; }
                            else if (KIND == 1) { v += bias[ch0 + bj * HALF + n * 4 + j]; v = 1.0f / (1.0f + __expf(-v)); }
                            o[n * 4 + j] = v; }
                    u32x4 w; w.x = cvt_pk_bf16(o[0], o[1]); w.y = cvt_pk_bf16(o[2], o[3]); w.z = cvt_pk_bf16(o[4], o[5]); w.w = cvt_pk_bf16(o[6], o[7]);
                    *(u32x4*)rowp = w; __builtin_amdgcn_sched_barrier(0); }
    }
    __device__ __forceinline__ void operator()(const f32x4 (&acc)[2][2][4][2], const Unit& u, int wr, int wc, int fr, int fq) const {
        const int kind = u.pn >> 1;
        const int row0 = u.pm * BM + wr * 64 + fr; const int ch0 = (u.pn & 1) * BM + wc * 32 + 8 * fq;
        if (kind == 0) body<0>(acc, OMD, w0, row0, ch0); else if (kind == 1) body<1>(acc, ASIG, a0, row0, ch0); else body<2>(acc, G, a0, row0, ch0);
    }
};

template <class Epi, class Sched>
__device__ __forceinline__ void gemm_phase(PG8_LAS unsigned char* lds, const Gemm g, const Sched& S, const Epi& E, const int wv) {
    const int tid = fresh_tid(wv), wid = __builtin_amdgcn_readfirstlane(tid >> 6), lane = tid & 63, wr = wid >> 2, wc = wid & 3, fr = lane & 15, fq = lane >> 4;
    const int K = g.K;
    unsigned voffA[2], voffB[2];
#pragma unroll
    for (int i = 0; i < 2; ++i) { int R, C; stage_rc(tid * 16 + i * 8192, R, C); const int Rb = Epi::PERM ? ((R & ~31) + perm32(R & 31)) : R;
        voffA[i] = (unsigned)(R * K + C) * 2u; voffB[i] = (unsigned)(Rb * K + C) * 2u; }
    const size_t kstep = (size_t)(BK * 2);
    const size_t hstep = (size_t)HALF * K * 2;
    const size_t tstep = 2 * hstep;
    const unsigned ldsw = (unsigned)wid * 1024u;
    const int aoff = lds_byte(wr * 64 + fr, fq * 8), boff = lds_byte(wc * 32 + fr, fq * 8);
#define PG8_SA(b, h) (((b) * 2 + (h)) * HTB)
#define PG8_SB(b, h) ((4 + (b) * 2 + (h)) * HTB)
#define PG8_STAGE(bufoff, gbase, voff) do { _Pragma("unroll") for (int _i = 0; _i < 2; ++_i) \
        __builtin_amdgcn_global_load_lds((const unsigned*)((const char*)(gbase) + (voff)[_i]), (PG8_LAS unsigned*)(lds + (bufoff) + ldsw + _i * 8192), 16, 0, 0); } while (0)
#define PG8_LDA(dst, b, h) do { _Pragma("unroll") for (int m = 0; m < 4; ++m) _Pragma("unroll") for (int k = 0; k < 2; ++k) dst[m][k] = *(const PG8_LAS bf16x8*)(lds + PG8_SA(b, h) + aoff + m * 2048 + k * 1024); } while (0)
#define PG8_LDB(dst, b, h) do { _Pragma("unroll") for (int n = 0; n < 2; ++n) _Pragma("unroll") for (int k = 0; k < 2; ++k) dst[n][k] = *(const PG8_LAS bf16x8*)(lds + PG8_SB(b, h) + boff + n * 2048 + k * 1024); } while (0)
#define PG8_MMA(ai, bj, At, Bt) do { __builtin_amdgcn_s_setprio(1); _Pragma("unroll") for (int m = 0; m < 4; ++m) _Pragma("unroll") for (int n = 0; n < 2; ++n) _Pragma("unroll") for (int k = 0; k < 2; ++k) \
        acc[ai][bj][m][n] = __builtin_amdgcn_mfma_f32_16x16x32_bf16(Bt[n][k], At[m][k], acc[ai][bj][m][n], 0, 0, 0); __builtin_amdgcn_s_setprio(0); } while (0)
#define PG8_WAIT_V(n) asm volatile("s_waitcnt vmcnt(" #n ")" ::: "memory")
#define PG8_WAIT_L(n) asm volatile("s_waitcnt lgkmcnt(" #n ")" ::: "memory")
#define PG8_BAR __builtin_amdgcn_s_barrier()
#define PG8_SCHED __builtin_amdgcn_sched_barrier(0)
    Unit cur, nxt; int ui = 0;
    if (!S.next(0, cur)) return;
    f32x4 acc[2][2][4][2];
#pragma unroll
    for (int a = 0; a < 2; ++a)
#pragma unroll
        for (int b = 0; b < 2; ++b)
#pragma unroll
            for (int m = 0; m < 4; ++m)
#pragma unroll
                for (int n = 0; n < 2; ++n) acc[a][b][m][n] = (f32x4){0.f, 0.f, 0.f, 0.f};
    bf16x8 At[4][2], B0[2][2], B1[2][2];
    const char* cA = (const char*)g.A + (size_t)cur.pm * tstep + (size_t)cur.k0 * kstep; const char* cB = (const char*)g.Bt + (size_t)cur.pn * tstep + (size_t)cur.k0 * kstep;
    S.a_ready(cur);
    PG8_STAGE(PG8_SB(0, 0), cB, voffB); PG8_STAGE(PG8_SA(0, 0), cA, voffA); PG8_STAGE(PG8_SB(0, 1), cB + hstep, voffB); PG8_STAGE(PG8_SA(0, 1), cA + hstep, voffA);
    if (wr == 1) PG8_BAR;
    PG8_WAIT_V(4); PG8_BAR;
    PG8_STAGE(PG8_SB(1, 0), cB + kstep, voffB); PG8_STAGE(PG8_SA(1, 0), cA + kstep, voffA); PG8_STAGE(PG8_SB(1, 1), cB + hstep + kstep, voffB);
    PG8_WAIT_V(6); PG8_BAR;
    for (;;) {
        const bool has_next = S.next(ui + 1, nxt);
        const char* nA = has_next ? (const char*)g.A + (size_t)nxt.pm * tstep + (size_t)nxt.k0 * kstep : cA; const char* nB = has_next ? (const char*)g.Bt + (size_t)nxt.pn * tstep + (size_t)nxt.k0 * kstep : cB;
        const int nt = cur.nkt;
        for (int t = 0; t < nt; t += 2) {
            const bool last = (t == nt - 2);
            const char* a1 = cA + (size_t)(t + 1) * kstep;
            const char* a2 = last ? nA : cA + (size_t)(t + 2) * kstep; const char* b2 = last ? nB : cB + (size_t)(t + 2) * kstep;
            const char* a3 = a2 + kstep; const char* b3 = b2 + kstep;
            if (last && has_next) S.a_ready(nxt);
            PG8_LDB(B0, 0, 0); PG8_SCHED; PG8_LDA(At, 0, 0); PG8_STAGE(PG8_SA(1, 1), a1 + hstep, voffA);
            PG8_WAIT_L(8); PG8_BAR; PG8_WAIT_L(0); PG8_MMA(0, 0, At, B0); PG8_BAR; PG8_SCHED;
            PG8_LDB(B1, 0, 1); PG8_STAGE(PG8_SB(0, 0), b2, voffB);
            PG8_BAR; PG8_WAIT_L(0); PG8_MMA(0, 1, At, B1); PG8_BAR;
            PG8_LDA(At, 0, 1); PG8_STAGE(PG8_SA(0, 0), a2, voffA);
            PG8_BAR; PG8_WAIT_L(0); PG8_MMA(1, 0, At, B0); PG8_BAR; PG8_SCHED;
            PG8_STAGE(PG8_SB(0, 1), b2 + hstep, voffB);
            PG8_WAIT_V(6); PG8_BAR; PG8_MMA(1, 1, At, B1); PG8_BAR;
            PG8_LDB(B0, 1, 0); PG8_SCHED; PG8_LDA(At, 1, 0); PG8_STAGE(PG8_SA(0, 1), a2 + hstep, voffA);
            PG8_WAIT_L(8); PG8_BAR; PG8_WAIT_L(0); PG8_MMA(0, 0, At, B0); PG8_BAR; PG8_SCHED;
            PG8_LDB(B1, 1, 1); PG8_STAGE(PG8_SB(1, 0), b3, voffB);
            PG8_BAR; PG8_WAIT_L(0); PG8_MMA(0, 1, At, B1); PG8_BAR;
            PG8_LDA(At, 1, 1); PG8_STAGE(PG8_SA(1, 0), a3, voffA);
            PG8_BAR; PG8_WAIT_L(0); PG8_MMA(1, 0, At, B0); PG8_BAR; PG8_SCHED;
            PG8_STAGE(PG8_SB(1, 1), b3 + hstep, voffB);
            PG8_WAIT_V(6); PG8_BAR; PG8_MMA(1, 1, At, B1); PG8_BAR;
        }
        E(acc, cur, wr, wc, fr, fq); S.done(cur);
        if (!has_next) break;
#pragma unroll
        for (int a = 0; a < 2; ++a)
#pragma unroll
            for (int b = 0; b < 2; ++b)
#pragma unroll
                for (int m = 0; m < 4; ++m)
#pragma unroll
                    for (int n = 0; n < 2; ++n) acc[a][b][m][n] = (f32x4){0.f, 0.f, 0.f, 0.f};
        cur = nxt; cA = nA; cB = nB; ++ui;
    }
    PG8_WAIT_V(0);
    if (wr == 0) PG8_BAR;
    PG8_BAR;
#undef PG8_SA
#undef PG8_SB
#undef PG8_STAGE
#undef PG8_LDA
#undef PG8_LDB
#undef PG8_MMA
#undef PG8_WAIT_V
#undef PG8_WAIT_L
#undef PG8_BAR
#undef PG8_SCHED
}
}

using pg8::bf16_t; using pg8::f32x4; using pg8::bf16x8; using pg8::u32x4; using pg8::u32x2;
#define LAS __attribute__((address_space(3)))

constexpr int D = 1024, DFF = 2816, NGU = 5632, NCOLS = 3840;
constexpr int MP = 16384, MS = 512, MT = 16896, MIN_ = 17152;
constexpr int LDS_BYTES = 147456;
constexpr size_t O_SHP = 17301504, O_WKP = O_SHP + 8192, O_RTP = O_WKP + 262144, O_SHS = O_RTP + 524288, O_WKS = O_SHS + 131072, O_RTS = O_WKS + 4194304;
constexpr size_t WS_ROPE = 16384;
constexpr size_t WS_WL   = WS_ROPE + 1050624;
constexpr size_t WS_WOUT = WS_WL + 786432;
constexpr size_t WS_WIN  = WS_WOUT + 2097152;
constexpr size_t WS_WGU  = WS_WIN + 7864320;
constexpr size_t WS_WD   = WS_WGU + 11534336;
constexpr size_t WS_XN   = WS_WD + 5767168;
constexpr size_t WS_BIG  = WS_XN + 35127296;
constexpr size_t WS_FO   = WS_BIG + 95158272;
constexpr size_t WS_YS   = WS_BIG + 131727360;
constexpr size_t WS_LA   = WS_YS + 17301504;
constexpr size_t WS_OMD  = WS_BIG + 164364288;
constexpr size_t WS_ASIG = WS_OMD + 17301504;
constexpr size_t WS_END  = WS_ASIG + 17301504;
static_assert(WS_LA + 8650752 <= WS_OMD, "mixer overlays");
static_assert(WS_END <= 268435456, "workspace");

struct Params {
    const float *x_prompt, *x_sample, *state_shift, *state_wkv, *state_ret, *norm_g, *f1g, *f1u, *f1d, *w_in, *mu, *w0, *w2, *a0, *a2, *g2, *k_k, *k_a, *r_k, *lnx_w, *lnx_b, *gn_w, *w_out, *f2g, *f2u, *f2d;
    float* out; unsigned char* ws;
};
#define CAS __attribute__((address_space(4)))
typedef const CAS Params& PR;

__device__ __forceinline__ float bf2f(unsigned b) { return __uint_as_float(b << 16); }
__device__ __forceinline__ bf16_t f2bf(float f) { unsigned u = __float_as_uint(f); u += 0x7FFFu + ((u >> 16) & 1u); return (bf16_t)(u >> 16); }
__device__ __forceinline__ float lo_bf(unsigned x) { return __uint_as_float(x << 16); }
__device__ __forceinline__ float hi_bf(unsigned x) { return __uint_as_float(x & 0xffff0000u); }
template <int CTRL> __device__ __forceinline__ float dppf(float v) { return __int_as_float(__builtin_amdgcn_update_dpp(0, __float_as_int(v), CTRL, 0xF, 0xF, false)); }
__device__ __forceinline__ float row16_sum(float v) { v += dppf<0xB1>(v); v += dppf<0x4E>(v); v += dppf<0x141>(v); v += dppf<0x140>(v); return v; }
__device__ __forceinline__ float wave_sum(float v) { v = row16_sum(v); const int i = __float_as_int(v);
    return __int_as_float(__builtin_amdgcn_readlane(i, 0)) + __int_as_float(__builtin_amdgcn_readlane(i, 16)) + __int_as_float(__builtin_amdgcn_readlane(i, 32)) + __int_as_float(__builtin_amdgcn_readlane(i, 48)); }
__device__ __forceinline__ float quad_sum(float v) { v += dppf<0xB1>(v); v += dppf<0x4E>(v); return v; }
__device__ __forceinline__ float sigmoid_f(float x) { return 1.0f / (1.0f + __expf(-x)); }


#define XB_TMO      128
#define XB_XCNT(j)  (256  + 64 * (j))
#define XB_XSUB(j)  (1280 + 64 * (j))
#define XB_XGEN(j)  (2304 + 64 * (j))
#define XB_TOP      3328
#define XB_TOPGEN   3392
#define XCD_BAR_WORDS 3456
#define XB_SPIN_CAP (1u << 18)
__device__ __forceinline__ unsigned xb_ld(unsigned* p)              { return __hip_atomic_load(p, __ATOMIC_RELAXED, __HIP_MEMORY_SCOPE_AGENT); }
__device__ __forceinline__ unsigned xb_add(unsigned* p, unsigned v) { return __hip_atomic_fetch_add(p, v, __ATOMIC_RELAXED, __HIP_MEMORY_SCOPE_AGENT); }
__device__ __forceinline__ unsigned xb_xcc_id() { return (unsigned)__builtin_amdgcn_s_getreg((3 << 11) | 20) & 0xFu; }
#define XB_SPIN(cond, bar) do { unsigned _sp = 0; while (cond) { __builtin_amdgcn_s_sleep(1); \
    if ((++_sp & 255u) == 0u) { if (xb_ld(&(bar)[XB_TMO])) break; if (_sp > XB_SPIN_CAP) { atomicAdd(&(bar)[XB_TMO], 1u); break; } } } } while (0)
struct XcdBarrier { unsigned* bar; unsigned x; volatile LAS unsigned* st; };
__device__ __forceinline__ XcdBarrier xcd_barrier_post(unsigned* bar, volatile LAS unsigned* st) {
    XcdBarrier b; b.bar = bar; b.x = xb_xcc_id(); b.st = st;
    return b;
}
__device__ __forceinline__ void xcd_barrier_complete(unsigned* bar, unsigned x, unsigned& nloc, unsigned& nx) {
    const unsigned G = gridDim.x * gridDim.y * gridDim.z;
    unsigned sum, cnt, mine, sp = 0u;
    for (;;) {
        sum = 0u; cnt = 0u; mine = 0u;
#pragma unroll
        for (unsigned j = 0; j < 16; ++j) { const unsigned c = xb_ld(&bar[XB_XCNT(j)]); sum += c; cnt += (c > 0u) ? 1u : 0u; mine = (j == x) ? c : mine; }
        if (sum == G) break;
        __builtin_amdgcn_s_sleep(1);
        if ((++sp & 255u) == 0u) { if (xb_ld(&bar[XB_TMO])) break; if (sp > XB_SPIN_CAP) { atomicAdd(&bar[XB_TMO], 1u); break; } }
    }
    nloc = mine > 0u ? mine : 1u; nx = cnt > 0u ? cnt : 1u;
}
__device__ __forceinline__ void xcd_barrier(unsigned* barw, volatile LAS unsigned* stw, const int wv) {
    XcdBarrier b; b.bar = barw; b.x = xb_xcc_id(); b.st = stw;
    asm volatile("s_waitcnt vmcnt(0)" ::: "memory");
    __syncthreads();
    if (fresh_tid(wv) == 0) {
        unsigned* bar = b.bar;
        __builtin_amdgcn_s_waitcnt(0);
        unsigned nloc = b.st[0], nx = b.st[1];
        if (nloc == 0u) { xcd_barrier_complete(bar, b.x, nloc, nx); b.st[0] = nloc; b.st[1] = nx; }
        const unsigned old = xb_add(&bar[XB_XSUB(b.x)], 1u);
        const unsigned gen = old / nloc;
        if (old + 1u == (gen + 1u) * nloc) {
            __builtin_amdgcn_fence(__ATOMIC_RELEASE, "agent");
            asm volatile("s_waitcnt vmcnt(0)" ::: "memory");
            const unsigned og = xb_add(&bar[XB_TOP], 1u);
            const unsigned tg = og / nx;
            if (og + 1u == (tg + 1u) * nx) xb_add(&bar[XB_TOPGEN], 1u);
            else XB_SPIN(xb_ld(&bar[XB_TOPGEN]) == tg, bar);
            __builtin_amdgcn_fence(__ATOMIC_ACQUIRE, "agent");
            xb_add(&bar[XB_XGEN(b.x)], 1u);
            asm volatile("s_waitcnt vmcnt(0)" ::: "memory");
        } else {
            XB_SPIN(xb_ld(&bar[XB_XGEN(b.x)]) == gen, bar);
            __builtin_amdgcn_fence(__ATOMIC_ACQUIRE, "agent");
            asm volatile("s_waitcnt vmcnt(0)" ::: "memory");
        }
    }
    __syncthreads();
}


#define DPP2(x, y, CTRL, NOP) asm volatile(NOP "\n\tv_add_f32_dpp %0, %0, %0 " CTRL " row_mask:0xf bank_mask:0xf bound_ctrl:1\n\tv_add_f32_dpp %1, %1, %1 " CTRL " row_mask:0xf bank_mask:0xf bound_ctrl:1" : "+v"(x), "+v"(y))
#define DPP4(x, y, z, w, CTRL, NOP) asm volatile(NOP "\n\tv_add_f32_dpp %0, %0, %0 " CTRL " row_mask:0xf bank_mask:0xf bound_ctrl:1\n\tv_add_f32_dpp %1, %1, %1 " CTRL " row_mask:0xf bank_mask:0xf bound_ctrl:1\n\tv_add_f32_dpp %2, %2, %2 " CTRL " row_mask:0xf bank_mask:0xf bound_ctrl:1\n\tv_add_f32_dpp %3, %3, %3 " CTRL " row_mask:0xf bank_mask:0xf bound_ctrl:1" : "+v"(x), "+v"(y), "+v"(z), "+v"(w))
#define ROW16_SUM4(x, y, z, w) do { DPP4(x, y, z, w, "quad_perm:[1,0,3,2]", "s_nop 1"); DPP4(x, y, z, w, "quad_perm:[2,3,0,1]", ""); DPP4(x, y, z, w, "row_half_mirror", ""); DPP4(x, y, z, w, "row_mirror", ""); } while (0)
#define ROW16_SUM2(x, y) do { DPP2(x, y, "quad_perm:[1,0,3,2]", "s_nop 1"); DPP2(x, y, "quad_perm:[2,3,0,1]", "s_nop 0"); DPP2(x, y, "row_half_mirror", "s_nop 0"); DPP2(x, y, "row_mirror", "s_nop 0"); } while (0)
__device__ __forceinline__ int prev_row(int r) {
    if (r < MP) return (r & 2047) == 0 ? -1 : r - 1;
    const int s = r - MP; return (s & 3) == 0 ? MT + (s >> 2) : r - 1;
}

struct TDesc { const float* W; bf16_t* Bt; int K, N, k0, n0, brow0; };
__device__ __forceinline__ TDesc tconv_desc(const float* wg, const float* wu, const float* wd, const float* win, const float* wout, unsigned char* ws, int i) {
    TDesc d; int mode = 0, tile = i;
    if (i < 704) { d.W = wg; d.Bt = (bf16_t*)(ws + WS_WGU); d.K = 1024; d.N = DFF; mode = 1; }
    else if (i < 1408) { d.W = wu; d.Bt = (bf16_t*)(ws + WS_WGU); d.K = 1024; d.N = DFF; mode = 2; tile = i - 704; }
    else if (i < 2112) { d.W = wd; d.Bt = (bf16_t*)(ws + WS_WD); d.K = DFF; d.N = 1024; tile = i - 1408; }
    else if (i < 3072) { d.W = win; d.Bt = (bf16_t*)(ws + WS_WIN); d.K = 1024; d.N = NCOLS; tile = i - 2112; }
    else { d.W = wout; d.Bt = (bf16_t*)(ws + WS_WOUT); d.K = 1024; d.N = 1024; tile = i - 3072; }
    const int nkt = d.K / 64; const int kt = tile % nkt, nt = tile / nkt; d.k0 = kt * 64; d.n0 = nt * 64;
    d.brow0 = mode == 0 ? d.n0 : ((d.n0 >> 7) * 256 + (d.n0 & 127) + (mode == 2 ? 128 : 0));
    return d;
}
__device__ __forceinline__ void tconv_list(const float* wg, const float* wu, const float* wd, const float* win, const float* wout, unsigned char* ws, const int ntiles, LAS float* t, const int wv) {
    const int tid = fresh_tid(wv); const int G = gridDim.x;
    float cur[8], nxt[8];
    int i = blockIdx.x;
    if (i < ntiles) { const TDesc d = tconv_desc(wg, wu, wd, win, wout, ws, i);
#pragma unroll
        for (int e = 0; e < 8; ++e) { const int idx = e * 512 + tid, r = idx >> 6, c = idx & 63; cur[e] = d.W[(size_t)(d.k0 + r) * d.N + d.n0 + c]; } }
    for (; i < ntiles; i += G) {
        const TDesc d = tconv_desc(wg, wu, wd, win, wout, ws, i);
        if (i + G < ntiles) { const TDesc dn = tconv_desc(wg, wu, wd, win, wout, ws, i + G);
#pragma unroll
            for (int e = 0; e < 8; ++e) { const int idx = e * 512 + tid, r = idx >> 6, c = idx & 63; nxt[e] = dn.W[(size_t)(dn.k0 + r) * dn.N + dn.n0 + c]; } }
#pragma unroll
        for (int e = 0; e < 8; ++e) { const int idx = e * 512 + tid, r = idx >> 6, c = idx & 63; t[r * 65 + c] = cur[e]; }
        __syncthreads();
#pragma unroll
        for (int e = 0; e < 4; ++e) { const int idx = e * 512 + tid, n = idx >> 5, kp = idx & 31;
            const unsigned w = pg8::cvt_pk_bf16(t[(2 * kp) * 65 + n], t[(2 * kp + 1) * 65 + n]);
            *(unsigned*)(d.Bt + (size_t)(d.brow0 + n) * d.K + d.k0 + 2 * kp) = w; }
        __syncthreads();
#pragma unroll
        for (int e = 0; e < 8; ++e) cur[e] = nxt[e];
    }
}

__device__ __forceinline__ void rows_phase(PR P, const int mode, const int wv) {
    const int tid = fresh_tid(wv); const int lane = tid & 63; const int gw = blockIdx.x * 8 + (tid >> 6), nw = gridDim.x * 8;
    const bf16_t* FO = (const bf16_t*)(P.ws + WS_FO); bf16_t* XN = (bf16_t*)(P.ws + WS_XN);
    const float* gpost = P.norm_g + (mode == 1 ? 1 : (mode == 2 ? 3 : 5)) * 1024;
    const float* gnext = P.norm_g + (mode == 0 ? 0 : (mode == 1 ? 2 : 4)) * 1024;
    const float scale = mode == 2 ? 1.0f : 0.5f;
    for (int row = gw; row < MT; row += nw) {
        float4 xv[4];
        if (mode <= 1) { const float* xin = row < MP ? P.x_prompt + (size_t)row * 1024 : P.x_sample + (size_t)(row - MP) * 1024;
#pragma unroll
            for (int q = 0; q < 4; ++q) xv[q] = *(const float4*)(xin + (q * 64 + lane) * 4); }
        else { const bf16_t* xb = (mode == 2 ? (const bf16_t*)P.out : (const bf16_t*)(P.ws + WS_FO + 34603008)) + (size_t)row * 1024;
#pragma unroll
            for (int q = 0; q < 4; ++q) { const u32x2 t = *(const u32x2*)(xb + (q * 64 + lane) * 4); xv[q] = make_float4(lo_bf(t.x), hi_bf(t.x), lo_bf(t.y), hi_bf(t.y)); } }
        if (mode != 0) {
            float4 fo[4]; float ss = 0.f;
#pragma unroll
            for (int q = 0; q < 4; ++q) {
                if (row < MP) { const u32x2 fb = *(const u32x2*)(FO + (size_t)row * 1024 + (q * 64 + lane) * 4); fo[q] = make_float4(lo_bf(fb.x), hi_bf(fb.x), lo_bf(fb.y), hi_bf(fb.y)); }
                else {
                    const int KS = mode == 2 ? 4 : 8; const float* sl = (const float*)(P.ws + WS_OMD) + (size_t)((((row - MP) >> 8) * 4 + q) * KS) * 65536 + (size_t)(row & 255) * 256 + lane * 4;
                    float4 a = *(const float4*)sl;
                    for (int p = 1; p < KS; ++p) { const float4 b = *(const float4*)(sl + (size_t)p * 65536); a.x += b.x; a.y += b.y; a.z += b.z; a.w += b.w; }
                    fo[q] = a; }
                ss += fo[q].x * fo[q].x + fo[q].y * fo[q].y + fo[q].z * fo[q].z + fo[q].w * fo[q].w; }
            ss = wave_sum(ss); const float r = rsqrtf(ss * (1.0f / 1024.0f) + 1e-6f) * scale;
#pragma unroll
            for (int q = 0; q < 4; ++q) { const float4 g = *(const float4*)(gpost + (q * 64 + lane) * 4);
                xv[q].x += fo[q].x * r * g.x; xv[q].y += fo[q].y * r * g.y; xv[q].z += fo[q].z * r * g.z; xv[q].w += fo[q].w * r * g.w;
                if (mode == 3) *(float4*)(P.out + (size_t)row * 1024 + (q * 64 + lane) * 4) = xv[q];
                else { bf16_t* xo = (mode == 1 ? (bf16_t*)P.out : (bf16_t*)(P.ws + WS_FO + 34603008)) + (size_t)row * 1024; u32x2 t; t.x = pg8::cvt_pk_bf16(xv[q].x, xv[q].y); t.y = pg8::cvt_pk_bf16(xv[q].z, xv[q].w);
                    *(u32x2*)(xo + (q * 64 + lane) * 4) = t; } }
            if (mode == 3) continue;
        }
        float ss2 = 0.f;
#pragma unroll
        for (int q = 0; q < 4; ++q) ss2 += xv[q].x * xv[q].x + xv[q].y * xv[q].y + xv[q].z * xv[q].z + xv[q].w * xv[q].w;
        ss2 = wave_sum(ss2); const float r2 = rsqrtf(ss2 * (1.0f / 1024.0f) + 1e-6f);
        float* sh = nullptr;
        if (mode == 1) { if (row < MP) { if ((row & 2047) == 2047) sh = P.out + O_SHP + (size_t)(row >> 11) * 1024; } else { const int s = row - MP; if ((s & 3) == 3) sh = P.out + O_SHS + (size_t)(s >> 2) * 1024; } }
#pragma unroll
        for (int q = 0; q < 4; ++q) { const float4 g = *(const float4*)(gnext + (q * 64 + lane) * 4);
            float4 hv; hv.x = xv[q].x * r2 * g.x; hv.y = xv[q].y * r2 * g.y; hv.z = xv[q].z * r2 * g.z; hv.w = xv[q].w * r2 * g.w;
            u32x2 w; w.x = pg8::cvt_pk_bf16(hv.x, hv.y); w.y = pg8::cvt_pk_bf16(hv.z, hv.w);
            *(u32x2*)(XN + (size_t)row * 1024 + (q * 64 + lane) * 4) = w;
            if (sh) *(float4*)(sh + (q * 64 + lane) * 4) = hv; }
    }
}

__device__ __forceinline__ void p0_prologue(PR P, LAS float* ldsf, const int wv) {
    const int tid = fresh_tid(wv); const size_t gt = (size_t)blockIdx.x * 512 + tid, nth = (size_t)gridDim.x * 512;
    { float* rc = (float*)(P.ws + WS_ROPE); float* rs = rc + 2052 * 64;
      for (size_t i = gt; i < 2052 * 64; i += nth) { const int p = (int)(i >> 6), f = (int)(i & 63); const int pos = p < 2048 ? p : 16384 + (p - 2048);
          double inv = 1.0; for (int q = 0; q < f; ++q) inv *= 0.8659643233600653;
          const double ang = (double)pos * inv; const double n = rint(ang * 0.15915494309189535); const double r = ang - n * 6.283185307179586;
          const double r2 = r * r; double s = 0.0, c = 0.0;
          for (int k = 14; k >= 0; --k) { s = s * (-r2 / (double)((2 * k + 2) * (2 * k + 3))) + 1.0; c = c * (-r2 / (double)((2 * k + 1) * (2 * k + 2))) + 1.0; }
          rc[i] = (float)c; rs[i] = (float)(s * r); } }
    { bf16_t* Wl = (bf16_t*)(P.ws + WS_WL);
      for (size_t i = gt; i < 1536 * 256; i += nth) { const int n = (int)(i >> 8), k = (int)(i & 255); float v = 0.f;
          if (n < 512) { if (k < 64) v = P.w2[k * 512 + n]; } else if (n < 1024) { if (k >= 64 && k < 128) v = P.a2[(k - 64) * 512 + (n - 512)]; } else { if (k >= 128) v = P.g2[(k - 128) * 512 + (n - 1024)]; }
          Wl[i] = f2bf(v); } }
    { bf16_t* XN = (bf16_t*)(P.ws + WS_XN);
      for (size_t i = gt; i < 256 * 1024; i += nth) { const int r = (int)(i >> 10); XN[(size_t)MT * 1024 + i] = r < 128 ? f2bf(P.state_shift[i]) : (bf16_t)0; } }
    tconv_list(P.f1g, P.f1u, P.f1d, P.w_in, P.w_out, P.ws, 3328, ldsf, wv);
    rows_phase(P, 0, wv);
}

__device__ __forceinline__ void lora_prep(PR P, const int wv) {
    const int tid = fresh_tid(wv); const int lane = tid & 63; const int gw = blockIdx.x * 8 + (tid >> 6), nw = gridDim.x * 8;
    const bf16_t* PS = (const bf16_t*)(P.ws + WS_BIG); bf16_t* LA = (bf16_t*)(P.ws + WS_LA);
    const float4 mu = *(const float4*)(P.mu + 1536 + lane * 4); const int kind = lane >> 4;
    u32x2 c = (u32x2){0u, 0u}, p = c, nc = c, np = c;
    if (gw < MT) { c = *(const u32x2*)(PS + (size_t)gw * NCOLS + 1536 + lane * 4); const int pr = prev_row(gw); if (pr >= 0) p = *(const u32x2*)(PS + (size_t)pr * NCOLS + 1536 + lane * 4); }
    for (int row = gw; row < MT; row += nw) {
        const int nrow = row + nw;
        if (nrow < MT) { nc = *(const u32x2*)(PS + (size_t)nrow * NCOLS + 1536 + lane * 4); const int pr = prev_row(nrow); np = (u32x2){0u, 0u}; if (pr >= 0) np = *(const u32x2*)(PS + (size_t)pr * NCOLS + 1536 + lane * 4); }
        float v[4]; const float cu[4] = {lo_bf(c.x), hi_bf(c.x), lo_bf(c.y), hi_bf(c.y)}, pv[4] = {lo_bf(p.x), hi_bf(p.x), lo_bf(p.y), hi_bf(p.y)}, m4[4] = {mu.x, mu.y, mu.z, mu.w};
#pragma unroll
        for (int j = 0; j < 4; ++j) { float x = cu[j] + (pv[j] - cu[j]) * m4[j];
            if (kind == 0) x = 1.0f - 2.0f / (__expf(2.0f * x) + 1.0f); else if (kind >= 2) x = sigmoid_f(x);
            v[j] = x; }
        u32x2 w; w.x = pg8::cvt_pk_bf16(v[0], v[1]); w.y = pg8::cvt_pk_bf16(v[2], v[3]);
        *(u32x2*)(LA + (size_t)row * 256 + lane * 4) = w;
        c = nc; p = np;
    }
}

template <bool SAMPLE>
__device__ __forceinline__ void rwkv_unit(PR P, LAS float* lds, const int b, const int h, const int half, const int wv) {
    constexpr int T = SAMPLE ? 4 : 2048, TC = SAMPLE ? 4 : 32, NCH = T / TC;
    const int tid = fresh_tid(wv), lane = tid & 63, wid = tid >> 6;
    const bf16_t* PS = (const bf16_t*)(P.ws + WS_BIG); const bf16_t* OMD = (const bf16_t*)(P.ws + WS_OMD); const bf16_t* ASIG = (const bf16_t*)(P.ws + WS_ASIG);
    bf16_t* YS = (bf16_t*)(P.ws + WS_YS);
    const int row_base = SAMPLE ? MP + b * 4 : b * 2048;
    const int ltok = (tid - 256) >> 4, lcg = tid & 15; const bool lwave = tid >= 256; const int hch = h * 64 + lcg * 4;
    const float4 mur = *(const float4*)(P.mu + hch), muk = *(const float4*)(P.mu + 512 + hch), muv = *(const float4*)(P.mu + 1024 + hch);
    const float4 kk4 = *(const float4*)(P.k_k + hch), ka4 = *(const float4*)(P.k_a + hch);
    typedef float f32x2 __attribute__((ext_vector_type(2)));
    const int row0 = half * 32 + (wid & 3) * 8 + (lane >> 4) * 2, cgl = lane & 15, j0 = cgl * 4;
    f32x2 S[4];
#pragma unroll
    for (int c = 0; c < 4; ++c) S[c] = (f32x2){0.f, 0.f};
    float* sout = P.out + (SAMPLE ? O_WKS : O_WKP) + ((size_t)(b * 8 + h) * 64 + row0) * 64 + j0;
    if (SAMPLE && wid < 4) { const float* sp = P.state_wkv + ((size_t)(b * 8 + h) * 64 + row0) * 64 + j0; const float4 s0 = *(const float4*)sp, s1 = *(const float4*)(sp + 64);
        S[0] = (f32x2){s0.x, s1.x}; S[1] = (f32x2){s0.y, s1.y}; S[2] = (f32x2){s0.z, s1.z}; S[3] = (f32x2){s0.w, s1.w}; }
    LAS float* buf0 = lds; LAS float* buf1 = lds + TC * 384;
    u32x2 cr[2], ck[2], cv[2], pr[2], pk[2], pv[2], co[2], ca[2];
#define RW_LOAD1(c, U) do { if (lwave && ltok + 16 * (U) < TC) { const int t_ = (c) * TC + ltok + 16 * (U); const int row_ = row_base + t_; const int prow_ = SAMPLE ? (t_ == 0 ? MT + b : row_ - 1) : row_ - 1; \
        const bf16_t* cp_ = PS + (size_t)row_ * NCOLS + hch; cr[U] = *(const u32x2*)cp_; ck[U] = *(const u32x2*)(cp_ + 512); cv[U] = *(const u32x2*)(cp_ + 1024); \
        if (SAMPLE || t_ > 0) { const bf16_t* pp_ = PS + (size_t)prow_ * NCOLS + hch; pr[U] = *(const u32x2*)pp_; pk[U] = *(const u32x2*)(pp_ + 512); pv[U] = *(const u32x2*)(pp_ + 1024); } \
        else { pr[U] = (u32x2){0u, 0u}; pk[U] = pr[U]; pv[U] = pr[U]; } \
        co[U] = *(const u32x2*)(OMD + (size_t)row_ * 512 + hch); ca[U] = *(const u32x2*)(ASIG + (size_t)row_ * 512 + hch); } } while (0)
#define RW_LOAD(c) do { RW_LOAD1(c, 0); RW_LOAD1(c, 1); } while (0)
#define RW_MIX(cu, pv_, m) ((cu) + ((pv_) - (cu)) * (m))
#define RW_PROC1(dst, U) do { if (lwave && ltok + 16 * (U) < TC) { LAS float* d_ = (dst) + (ltok + 16 * (U)) * 384 + lcg * 4; \
        f32x4 r_, k_, v_, o_, a_; \
        r_[0] = RW_MIX(lo_bf(cr[U].x), lo_bf(pr[U].x), mur.x); r_[1] = RW_MIX(hi_bf(cr[U].x), hi_bf(pr[U].x), mur.y); r_[2] = RW_MIX(lo_bf(cr[U].y), lo_bf(pr[U].y), mur.z); r_[3] = RW_MIX(hi_bf(cr[U].y), hi_bf(pr[U].y), mur.w); \
        k_[0] = RW_MIX(lo_bf(ck[U].x), lo_bf(pk[U].x), muk.x); k_[1] = RW_MIX(hi_bf(ck[U].x), hi_bf(pk[U].x), muk.y); k_[2] = RW_MIX(lo_bf(ck[U].y), lo_bf(pk[U].y), muk.z); k_[3] = RW_MIX(hi_bf(ck[U].y), hi_bf(pk[U].y), muk.w); \
        v_[0] = RW_MIX(lo_bf(cv[U].x), lo_bf(pv[U].x), muv.x); v_[1] = RW_MIX(hi_bf(cv[U].x), hi_bf(pv[U].x), muv.y); v_[2] = RW_MIX(lo_bf(cv[U].y), lo_bf(pv[U].y), muv.z); v_[3] = RW_MIX(hi_bf(cv[U].y), hi_bf(pv[U].y), muv.w); \
        o_[0] = lo_bf(co[U].x); o_[1] = hi_bf(co[U].x); o_[2] = lo_bf(co[U].y); o_[3] = hi_bf(co[U].y); a_[0] = lo_bf(ca[U].x); a_[1] = hi_bf(ca[U].x); a_[2] = lo_bf(ca[U].y); a_[3] = hi_bf(ca[U].y); \
        f32x4 kk_; kk_[0] = k_[0] * kk4.x; kk_[1] = k_[1] * kk4.y; kk_[2] = k_[2] * kk4.z; kk_[3] = k_[3] * kk4.w; \
        float ss_ = kk_[0] * kk_[0] + kk_[1] * kk_[1] + kk_[2] * kk_[2] + kk_[3] * kk_[3]; ss_ = row16_sum(ss_); \
        const float inv_ = 1.0f / fmaxf(sqrtf(ss_), 1e-12f); kk_ = kk_ * inv_; \
        f32x4 kn_; kn_[0] = k_[0] * (1.0f + (a_[0] - 1.0f) * ka4.x); kn_[1] = k_[1] * (1.0f + (a_[1] - 1.0f) * ka4.y); kn_[2] = k_[2] * (1.0f + (a_[2] - 1.0f) * ka4.z); kn_[3] = k_[3] * (1.0f + (a_[3] - 1.0f) * ka4.w); \
        *(LAS f32x4*)(d_) = r_; *(LAS f32x4*)(d_ + 64) = o_; *(LAS f32x4*)(d_ + 128) = kn_; *(LAS f32x4*)(d_ + 192) = -kk_; *(LAS f32x4*)(d_ + 256) = kk_ * a_; *(LAS f32x4*)(d_ + 320) = v_; } } while (0)
#define RW_PROC(dst) do { RW_PROC1(dst, 0); RW_PROC1(dst, 1); } while (0)
    RW_LOAD(0); RW_PROC(buf0); __syncthreads();
    for (int c = 0; c < NCH; ++c) {
        LAS float* cur = (c & 1) ? buf1 : buf0; LAS float* nxt = (c & 1) ? buf0 : buf1;
        if (c + 1 < NCH) RW_LOAD(c + 1);
        if (wid < 4) {
            constexpr int GS = SAMPLE ? 4 : 16;
            for (int g = 0; g < TC / GS; ++g) {
                float yk0 = 0.f, yk1 = 0.f;
                const LAS float* q0 = cur + (g * GS) * 384;
                f32x4 r4 = *(const LAS f32x4*)(q0 + j0), o4 = *(const LAS f32x4*)(q0 + 64 + j0), k4 = *(const LAS f32x4*)(q0 + 128 + j0), a4 = *(const LAS f32x4*)(q0 + 192 + j0), b4 = *(const LAS f32x4*)(q0 + 256 + j0);
                f32x2 v2 = *(const LAS f32x2*)(q0 + 320 + row0);
                float py0 = 0.f, py1 = 0.f;
#pragma unroll
                for (int tt = 0; tt < GS; ++tt) {
                    const LAS float* qn = q0 + (tt + 1 < GS ? tt + 1 : tt) * 384;
                    const f32x4 nr4 = *(const LAS f32x4*)(qn + j0), no4 = *(const LAS f32x4*)(qn + 64 + j0), nk4 = *(const LAS f32x4*)(qn + 128 + j0), na4 = *(const LAS f32x4*)(qn + 192 + j0), nb4 = *(const LAS f32x4*)(qn + 256 + j0);
                    const f32x2 nv2 = *(const LAS f32x2*)(qn + 320 + row0);
                    f32x2 sa = (S[0] * a4[0] + S[1] * a4[1]) + (S[2] * a4[2] + S[3] * a4[3]);
                    float sx = sa.x, sy = sa.y; ROW16_SUM4(sx, sy, py0, py1); sa = (f32x2){sx, sy};
                    if (tt > 0) { yk0 = cgl == tt - 1 ? py0 : yk0; yk1 = cgl == tt - 1 ? py1 : yk1; }
#pragma unroll
                    for (int c = 0; c < 4; ++c) { f32x2 t = S[c] - S[c] * o4[c]; t = t + sa * b4[c]; S[c] = t + v2 * k4[c]; }
                    const f32x2 y = (S[0] * r4[0] + S[1] * r4[1]) + (S[2] * r4[2] + S[3] * r4[3]);
                    py0 = y.x; py1 = y.y;
                    r4 = nr4; o4 = no4; k4 = nk4; a4 = na4; b4 = nb4; v2 = nv2;
                }
                ROW16_SUM2(py0, py1); yk0 = cgl == GS - 1 ? py0 : yk0; yk1 = cgl == GS - 1 ? py1 : yk1;
                if (cgl < GS) *(unsigned*)(YS + (size_t)(row_base + c * TC + g * GS + cgl) * 512 + h * 64 + row0) = pg8::cvt_pk_bf16(yk0, yk1);
            }
        }
        if (c + 1 < NCH) RW_PROC(nxt);
        __syncthreads();
    }
    if (wid < 4) { *(float4*)sout = make_float4(S[0].x, S[1].x, S[2].x, S[3].x); *(float4*)(sout + 64) = make_float4(S[0].y, S[1].y, S[2].y, S[3].y); }
#undef RW_LOAD
#undef RW_PROC
#undef RW_LOAD1
#undef RW_PROC1
#undef RW_MIX
}

__device__ __forceinline__ void ret_sample_unit(PR P, LAS float* lds, const int b, const int h, const int wv) {
    const int tid = fresh_tid(wv), lane = tid & 63, wid = tid >> 6;
    const bf16_t* PS = (const bf16_t*)(P.ws + WS_BIG); bf16_t* Y = (bf16_t*)(P.ws + WS_XN);
    const float* rc = (const float*)(P.ws + WS_ROPE); const float* rs = rc + 2052 * 64;
    LAS float* q = lds; LAS float* k = lds + 512; LAS float* v = lds + 1024; LAS float* Pm = lds + 1536; LAS float* y2p = lds + 1600; LAS float* red = lds + 1600 + 2048;
    const float lg2 = log2f(1.0f - exp2f(-5.0f - (float)h));
    const int row0 = MP + b * 4;
    { const int t = (tid & 255) >> 6, f = tid & 63; const bf16_t* src = PS + (size_t)(row0 + t) * NCOLS + 1792 + h * 128;
      if (tid < 256) { const float cs = rc[(2048 + t) * 64 + f], sn = rs[(2048 + t) * 64 + f];
          const float q1 = bf2f(src[f]), q2 = bf2f(src[f + 64]); q[t * 128 + f] = q1 * cs - q2 * sn; q[t * 128 + f + 64] = q1 * sn + q2 * cs;
          const float k1 = bf2f(src[512 + f]), k2 = bf2f(src[512 + f + 64]); k[t * 128 + f] = (k1 * cs - k2 * sn) * 0.08838834764831845f; k[t * 128 + f + 64] = (k1 * sn + k2 * cs) * 0.08838834764831845f; }
      else { v[t * 128 + f] = bf2f(src[1024 + f]); v[t * 128 + f + 64] = bf2f(src[1024 + f + 64]); } }
    __syncthreads();
    if (wid == 0) { const int pi = lane >> 4, pj = (lane >> 2) & 3, part = lane & 3; float s = 0.f;
        for (int d = part * 32; d < part * 32 + 32; ++d) s += q[pi * 128 + d] * k[pj * 128 + d];
        s = quad_sum(s); if (part == 0) Pm[pi * 4 + pj] = pi >= pj ? s * exp2f(lg2 * (float)(pi - pj)) : 0.f; }
    { const int e = tid & 127, dg = tid >> 7; const float c4 = exp2f(lg2 * 4.0f), g3 = exp2f(lg2 * 3.0f), g2_ = exp2f(lg2 * 2.0f), g1 = exp2f(lg2);
      const float v0 = v[e] * g3, v1 = v[128 + e] * g2_, v2 = v[256 + e] * g1, v3 = v[384 + e];
      const float* S0 = P.state_ret + ((size_t)(b * 4 + h) * 128) * 128 + e; float* So = P.out + O_RTS + ((size_t)(b * 4 + h) * 128) * 128 + e;
      float a0 = 0.f, a1 = 0.f, a2 = 0.f, a3 = 0.f;
      float sv[32];
#pragma unroll
      for (int x = 0; x < 32; ++x) sv[x] = S0[(size_t)(dg * 32 + x) * 128];
#pragma unroll
      for (int x = 0; x < 32; ++x) { const int d = dg * 32 + x; const float s = sv[x];
          a0 = fmaf(q[d], s, a0); a1 = fmaf(q[128 + d], s, a1); a2 = fmaf(q[256 + d], s, a2); a3 = fmaf(q[384 + d], s, a3);
          So[(size_t)d * 128] = s * c4 + k[d] * v0 + k[128 + d] * v1 + k[256 + d] * v2 + k[384 + d] * v3; }
      y2p[(dg * 4 + 0) * 128 + e] = a0; y2p[(dg * 4 + 1) * 128 + e] = a1; y2p[(dg * 4 + 2) * 128 + e] = a2; y2p[(dg * 4 + 3) * 128 + e] = a3; }
    __syncthreads();
    { const int i = tid >> 7, e = tid & 127;
      float y = (y2p[(0 + i) * 128 + e] + y2p[(4 + i) * 128 + e] + y2p[(8 + i) * 128 + e] + y2p[(12 + i) * 128 + e]) * exp2f(lg2 * (float)(i + 1));
#pragma unroll
      for (int j = 0; j < 4; ++j) y = fmaf(Pm[i * 4 + j], v[j * 128 + e], y);
      float s = wave_sum(y); if (lane == 0) red[wid] = s; __syncthreads();
      const float mean = (red[i * 2] + red[i * 2 + 1]) * (1.0f / 128.0f); const float dlt = y - mean;
      float s2 = wave_sum(dlt * dlt); if (lane == 0) red[8 + wid] = s2; __syncthreads();
      const float var = (red[8 + i * 2] + red[8 + i * 2 + 1]) * (1.0f / 128.0f);
      const float g = bf2f(PS[(size_t)(row0 + i) * NCOLS + 1792 + 1536 + h * 128 + e]);
      const float o = dlt * rsqrtf(var + 1e-5f) * P.gn_w[h * 128 + e] * (g / (1.0f + __expf(-g)));
      Y[(size_t)(row0 + i) * 1024 + 512 + h * 128 + e] = f2bf(o); }
    __syncthreads();
}

__device__ __forceinline__ bf16_t* kvb_ptr(unsigned char* ws, int bh) { return (bf16_t*)(bh < 29 ? ws + WS_LA + (size_t)bh * 524288 : ws + WS_WIN + 17301504 + (size_t)(bh - 29) * 524288); }
constexpr int RS = 136, BUFE = 128 * RS;

template <bool WITH_K>
__device__ __forceinline__ void ret_load_qk(PR P, LAS bf16_t* QP, LAS bf16_t* KB, unsigned (&kth)[4][4], const int tidv, const int row0, const int n, const int h, const float kd0, const float g32) {
    const bf16_t* PS = (const bf16_t*)(P.ws + WS_BIG); const float* rc = (const float*)(P.ws + WS_ROPE); const float* rs = rc + 2052 * 64;
    float kd = kd0;
#pragma unroll
    for (int it = 0; it < 4; ++it) { const int idx = it * 512 + tidv, i = idx >> 4, f = (idx & 15) * 4;
        const bf16_t* src = PS + (size_t)(row0 + i) * NCOLS + 1792 + h * 128;
        const u32x2 q1 = *(const u32x2*)(src + f), q2 = *(const u32x2*)(src + 64 + f);
        u32x2 k1 = (u32x2){0u, 0u}, k2 = k1; if (WITH_K) { k1 = *(const u32x2*)(src + 512 + f); k2 = *(const u32x2*)(src + 576 + f); }
        const float4 cs = *(const float4*)(rc + (size_t)(n * 128 + i) * 64 + f), sn = *(const float4*)(rs + (size_t)(n * 128 + i) * 64 + f);
        const float c4[4] = {cs.x, cs.y, cs.z, cs.w}, s4[4] = {sn.x, sn.y, sn.z, sn.w};
        const float qa[4] = {lo_bf(q1.x), hi_bf(q1.x), lo_bf(q1.y), hi_bf(q1.y)}, qb[4] = {lo_bf(q2.x), hi_bf(q2.x), lo_bf(q2.y), hi_bf(q2.y)};
        float qo1[4], qo2[4];
#pragma unroll
        for (int x = 0; x < 4; ++x) { qo1[x] = qa[x] * c4[x] - qb[x] * s4[x]; qo2[x] = qa[x] * s4[x] + qb[x] * c4[x]; }
        u32x2 w; w.x = pg8::cvt_pk_bf16(qo1[0], qo1[1]); w.y = pg8::cvt_pk_bf16(qo1[2], qo1[3]); *(LAS u32x2*)(QP + i * RS + f) = w;
        w.x = pg8::cvt_pk_bf16(qo2[0], qo2[1]); w.y = pg8::cvt_pk_bf16(qo2[2], qo2[3]); *(LAS u32x2*)(QP + i * RS + 64 + f) = w;
        if (WITH_K) {
            const float ka[4] = {lo_bf(k1.x), hi_bf(k1.x), lo_bf(k1.y), hi_bf(k1.y)}, kb[4] = {lo_bf(k2.x), hi_bf(k2.x), lo_bf(k2.y), hi_bf(k2.y)};
            float ko1[4], ko2[4];
#pragma unroll
            for (int x = 0; x < 4; ++x) { ko1[x] = (ka[x] * c4[x] - kb[x] * s4[x]) * 0.08838834764831845f; ko2[x] = (ka[x] * s4[x] + kb[x] * c4[x]) * 0.08838834764831845f; }
            w.x = pg8::cvt_pk_bf16(ko1[0], ko1[1]); w.y = pg8::cvt_pk_bf16(ko1[2], ko1[3]); *(LAS u32x2*)(KB + i * RS + f) = w;
            w.x = pg8::cvt_pk_bf16(ko2[0], ko2[1]); w.y = pg8::cvt_pk_bf16(ko2[2], ko2[3]); *(LAS u32x2*)(KB + i * RS + 64 + f) = w;
            kth[it][0] = pg8::cvt_pk_bf16(ko1[0] * kd, ko1[1] * kd); kth[it][1] = pg8::cvt_pk_bf16(ko1[2] * kd, ko1[3] * kd);
            kth[it][2] = pg8::cvt_pk_bf16(ko2[0] * kd, ko2[1] * kd); kth[it][3] = pg8::cvt_pk_bf16(ko2[2] * kd, ko2[3] * kd); kd *= g32; }
        if (it & 1) __builtin_amdgcn_sched_barrier(0); }
}

__device__ __forceinline__ void ret_unit_a(PR P, LAS unsigned char* lds, const int bh, const int n, const int wv) {
    LAS bf16_t* QP = (LAS bf16_t*)lds; LAS bf16_t* KB = QP + BUFE; LAS bf16_t* VT = KB + BUFE;
    const int tid = fresh_tid(wv), lane = tid & 63, wid = tid >> 6, wr = wid >> 1, wc = wid & 1, fr = lane & 15, fq = lane >> 4;
    const int b = bh >> 2, h = bh & 3;
    const bf16_t* PS = (const bf16_t*)(P.ws + WS_BIG); bf16_t* Y = (bf16_t*)(P.ws + WS_XN); bf16_t* KVB = kvb_ptr(P.ws, bh) + (size_t)n * 16384;
    const float lg2 = log2f(1.0f - exp2f(-5.0f - (float)h));
    const float kd0 = exp2f(lg2 * (float)(127 - (tid >> 4))), g32 = exp2f(-32.0f * lg2);
    const int row0 = b * 2048 + n * 128;
    unsigned kth[4][4];
    ret_load_qk<true>(P, QP, KB, kth, tid, row0, n, h, kd0, g32);
#pragma unroll
    for (int it = 0; it < 4; ++it) { const int idx = it * 512 + tid, j = idx >> 4, e = (idx & 15) * 8;
        const u32x4 vv = *(const u32x4*)(PS + (size_t)(row0 + j) * NCOLS + 1792 + 1024 + h * 128 + e);
        LAS bf16_t* d = VT + e * RS + j;
        d[0] = (bf16_t)(vv.x & 0xffffu); d[RS] = (bf16_t)(vv.x >> 16); d[2 * RS] = (bf16_t)(vv.y & 0xffffu); d[3 * RS] = (bf16_t)(vv.y >> 16);
        d[4 * RS] = (bf16_t)(vv.z & 0xffffu); d[5 * RS] = (bf16_t)(vv.z >> 16); d[6 * RS] = (bf16_t)(vv.w & 0xffffu); d[7 * RS] = (bf16_t)(vv.w >> 16); }
    __syncthreads();
    f32x4 accP[2][4];
#pragma unroll
    for (int mt = 0; mt < 2; ++mt)
#pragma unroll
        for (int nt = 0; nt < 4; ++nt) accP[mt][nt] = (f32x4){0.f, 0.f, 0.f, 0.f};
#pragma unroll
    for (int ks = 0; ks < 4; ++ks) { bf16x8 aq[2];
#pragma unroll
        for (int mt = 0; mt < 2; ++mt) aq[mt] = *(const LAS bf16x8*)(QP + (wr * 32 + mt * 16 + fr) * RS + ks * 32 + fq * 8);
#pragma unroll
        for (int nt = 0; nt < 4; ++nt) { const bf16x8 bk = *(const LAS bf16x8*)(KB + (wc * 64 + nt * 16 + fr) * RS + ks * 32 + fq * 8);
#pragma unroll
            for (int mt = 0; mt < 2; ++mt) accP[mt][nt] = __builtin_amdgcn_mfma_f32_16x16x32_bf16(aq[mt], bk, accP[mt][nt], 0, 0, 0); }
        __builtin_amdgcn_sched_barrier(0); }
    __syncthreads();
    { float ri[2][4], cj[4];
#pragma unroll
      for (int mt = 0; mt < 2; ++mt)
#pragma unroll
          for (int j = 0; j < 4; ++j) ri[mt][j] = exp2f(lg2 * (float)(wr * 32 + mt * 16 + fq * 4 + j));
#pragma unroll
      for (int nt = 0; nt < 4; ++nt) cj[nt] = exp2f(-lg2 * (float)(wc * 64 + nt * 16 + fr));
#pragma unroll
      for (int mt = 0; mt < 2; ++mt)
#pragma unroll
          for (int nt = 0; nt < 4; ++nt)
#pragma unroll
              for (int j = 0; j < 4; ++j) { const int i = wr * 32 + mt * 16 + fq * 4 + j, jj = wc * 64 + nt * 16 + fr;
                  const float val = i >= jj ? accP[mt][nt][j] * ri[mt][j] * cj[nt] : 0.f; QP[i * RS + jj] = f2bf(val); } }
#pragma unroll
    for (int it = 0; it < 4; ++it) { const int idx = it * 512 + tid, j = idx >> 4, f = (idx & 15) * 4; LAS bf16_t* d = KB + f * RS + j;
        d[0] = (bf16_t)(kth[it][0] & 0xffffu); d[RS] = (bf16_t)(kth[it][0] >> 16); d[2 * RS] = (bf16_t)(kth[it][1] & 0xffffu); d[3 * RS] = (bf16_t)(kth[it][1] >> 16);
        LAS bf16_t* d2 = d + 64 * RS;
        d2[0] = (bf16_t)(kth[it][2] & 0xffffu); d2[RS] = (bf16_t)(kth[it][2] >> 16); d2[2 * RS] = (bf16_t)(kth[it][3] & 0xffffu); d2[3 * RS] = (bf16_t)(kth[it][3] >> 16); }
    __syncthreads();
    f32x4 accY[2][4], accS[2][4];
#pragma unroll
    for (int mt = 0; mt < 2; ++mt)
#pragma unroll
        for (int nt = 0; nt < 4; ++nt) { accY[mt][nt] = (f32x4){0.f, 0.f, 0.f, 0.f}; accS[mt][nt] = (f32x4){0.f, 0.f, 0.f, 0.f}; }
#pragma unroll
    for (int ks = 0; ks < 4; ++ks) { bf16x8 ap[2], av[2];
#pragma unroll
        for (int mt = 0; mt < 2; ++mt) { ap[mt] = *(const LAS bf16x8*)(QP + (wr * 32 + mt * 16 + fr) * RS + ks * 32 + fq * 8); av[mt] = *(const LAS bf16x8*)(VT + (wr * 32 + mt * 16 + fr) * RS + ks * 32 + fq * 8); }
#pragma unroll
        for (int nt = 0; nt < 4; ++nt) { const bf16x8 bv = *(const LAS bf16x8*)(VT + (wc * 64 + nt * 16 + fr) * RS + ks * 32 + fq * 8), bkt = *(const LAS bf16x8*)(KB + (wc * 64 + nt * 16 + fr) * RS + ks * 32 + fq * 8);
#pragma unroll
            for (int mt = 0; mt < 2; ++mt) { accY[mt][nt] = __builtin_amdgcn_mfma_f32_16x16x32_bf16(ap[mt], bv, accY[mt][nt], 0, 0, 0); accS[mt][nt] = __builtin_amdgcn_mfma_f32_16x16x32_bf16(av[mt], bkt, accS[mt][nt], 0, 0, 0); } }
        __builtin_amdgcn_sched_barrier(0); }
#pragma unroll
    for (int mt = 0; mt < 2; ++mt)
#pragma unroll
        for (int nt = 0; nt < 4; ++nt)
#pragma unroll
            for (int j = 0; j < 4; ++j) { const int r = wr * 32 + mt * 16 + fq * 4 + j, c = wc * 64 + nt * 16 + fr;
                Y[(size_t)(row0 + r) * 1024 + 512 + h * 128 + c] = f2bf(accY[mt][nt][j]); KVB[r * 128 + c] = f2bf(accS[mt][nt][j]); }
    __syncthreads();
}

__device__ __forceinline__ void ret_prefix(PR P, const int item) {
    const int bh = item >> 11, i8 = (item & 2047) * 8; const int h = bh & 3;
    bf16_t* KVB = kvb_ptr(P.ws, bh) + i8;
    const float lg2 = log2f(1.0f - exp2f(-5.0f - (float)h)); const float c_dec = exp2f(lg2 * 128.0f);
    u32x4 kv[16];
#pragma unroll
    for (int n = 0; n < 16; ++n) kv[n] = *(const u32x4*)(KVB + (size_t)n * 16384);
    float S[8];
#pragma unroll
    for (int x = 0; x < 8; ++x) S[x] = 0.f;
#pragma unroll
    for (int n = 0; n < 16; ++n) { u32x4 w; w.x = pg8::cvt_pk_bf16(S[0], S[1]); w.y = pg8::cvt_pk_bf16(S[2], S[3]); w.z = pg8::cvt_pk_bf16(S[4], S[5]); w.w = pg8::cvt_pk_bf16(S[6], S[7]);
        *(u32x4*)(KVB + (size_t)n * 16384) = w;
        const float k8[8] = {lo_bf(kv[n].x), hi_bf(kv[n].x), lo_bf(kv[n].y), hi_bf(kv[n].y), lo_bf(kv[n].z), hi_bf(kv[n].z), lo_bf(kv[n].w), hi_bf(kv[n].w)};
#pragma unroll
        for (int x = 0; x < 8; ++x) S[x] = S[x] * c_dec + k8[x]; }
    const int e = i8 >> 7, d0 = i8 & 127;
#pragma unroll
    for (int x = 0; x < 8; ++x) P.out[O_RTP + ((size_t)bh * 128 + d0 + x) * 128 + e] = S[x];
}

__device__ __forceinline__ void ret_unit_c(PR P, LAS unsigned char* lds, const int bh, const int n, const int wv) {
    LAS bf16_t* QP = (LAS bf16_t*)lds; LAS bf16_t* ST = QP + 3 * BUFE; LAS float* YST = (LAS float*)(QP + BUFE);
    const int tid = fresh_tid(wv), lane = tid & 63, wid = tid >> 6, wr = wid >> 1, wc = wid & 1, fr = lane & 15, fq = lane >> 4;
    const int b = bh >> 2, h = bh & 3;
    const bf16_t* PS = (const bf16_t*)(P.ws + WS_BIG); bf16_t* Y = (bf16_t*)(P.ws + WS_XN); const bf16_t* KVB = kvb_ptr(P.ws, bh) + (size_t)n * 16384;
    const float lg2 = log2f(1.0f - exp2f(-5.0f - (float)h));
    const int row0 = b * 2048 + n * 128;
    unsigned kth[4][4];
    ret_load_qk<false>(P, QP, QP, kth, tid, row0, n, h, 0.f, 0.f);
#pragma unroll
    for (int it = 0; it < 4; ++it) { const int idx = it * 512 + tid, e = idx >> 4, d8 = (idx & 15) * 8;
        *(LAS u32x4*)(ST + e * RS + d8) = *(const u32x4*)(KVB + e * 128 + d8); }
    __syncthreads();
    f32x4 accY[2][4];
#pragma unroll
    for (int mt = 0; mt < 2; ++mt)
#pragma unroll
        for (int nt = 0; nt < 4; ++nt) accY[mt][nt] = (f32x4){0.f, 0.f, 0.f, 0.f};
#pragma unroll
    for (int ks = 0; ks < 4; ++ks) { bf16x8 aq[2];
#pragma unroll
        for (int mt = 0; mt < 2; ++mt) aq[mt] = *(const LAS bf16x8*)(QP + (wr * 32 + mt * 16 + fr) * RS + ks * 32 + fq * 8);
#pragma unroll
        for (int nt = 0; nt < 4; ++nt) { const bf16x8 bs = *(const LAS bf16x8*)(ST + (wc * 64 + nt * 16 + fr) * RS + ks * 32 + fq * 8);
#pragma unroll
            for (int mt = 0; mt < 2; ++mt) accY[mt][nt] = __builtin_amdgcn_mfma_f32_16x16x32_bf16(aq[mt], bs, accY[mt][nt], 0, 0, 0); }
        __builtin_amdgcn_sched_barrier(0); }
#pragma unroll
    for (int mt = 0; mt < 2; ++mt)
#pragma unroll
        for (int j = 0; j < 4; ++j) { const int r = wr * 32 + mt * 16 + fq * 4 + j; const float qd = exp2f(lg2 * (float)(r + 1));
#pragma unroll
            for (int nt = 0; nt < 4; ++nt) YST[r * 132 + wc * 64 + nt * 16 + fr] = accY[mt][nt][j] * qd; }
    __syncthreads();
    { const int i = tid >> 2, part = tid & 3; float yv[32]; float s = 0.f;
      bf16_t* yo = Y + (size_t)(row0 + i) * 1024 + 512 + h * 128 + part * 32;
#pragma unroll
      for (int x = 0; x < 4; ++x) { const u32x4 y1 = *(const u32x4*)(yo + x * 8); const f32x4 ta = *(const LAS f32x4*)(YST + i * 132 + part * 32 + x * 8), tb = *(const LAS f32x4*)(YST + i * 132 + part * 32 + x * 8 + 4);
          yv[x * 8 + 0] = ta[0] + lo_bf(y1.x); yv[x * 8 + 1] = ta[1] + hi_bf(y1.x); yv[x * 8 + 2] = ta[2] + lo_bf(y1.y); yv[x * 8 + 3] = ta[3] + hi_bf(y1.y);
          yv[x * 8 + 4] = tb[0] + lo_bf(y1.z); yv[x * 8 + 5] = tb[1] + hi_bf(y1.z); yv[x * 8 + 6] = tb[2] + lo_bf(y1.w); yv[x * 8 + 7] = tb[3] + hi_bf(y1.w); }
#pragma unroll
      for (int x = 0; x < 32; ++x) s += yv[x];
      s = quad_sum(s); const float mean = s * (1.0f / 128.0f); float s2 = 0.f;
#pragma unroll
      for (int x = 0; x < 32; ++x) { yv[x] -= mean; s2 += yv[x] * yv[x]; }
      s2 = quad_sum(s2); const float rstd = rsqrtf(s2 * (1.0f / 128.0f) + 1e-5f);
      const bf16_t* gp = PS + (size_t)(row0 + i) * NCOLS + 1792 + 1536 + h * 128 + part * 32; const float* gw = P.gn_w + h * 128 + part * 32;
#pragma unroll
      for (int x = 0; x < 4; ++x) { const u32x4 g4 = *(const u32x4*)(gp + x * 8); const float4 w0 = *(const float4*)(gw + x * 8), w1 = *(const float4*)(gw + x * 8 + 4);
          const float gg[8] = {lo_bf(g4.x), hi_bf(g4.x), lo_bf(g4.y), hi_bf(g4.y), lo_bf(g4.z), hi_bf(g4.z), lo_bf(g4.w), hi_bf(g4.w)}; const float ww[8] = {w0.x, w0.y, w0.z, w0.w, w1.x, w1.y, w1.z, w1.w};
          float o[8];
#pragma unroll
          for (int z = 0; z < 8; ++z) o[z] = yv[x * 8 + z] * rstd * ww[z] * (gg[z] / (1.0f + __expf(-gg[z])));
          u32x4 w; w.x = pg8::cvt_pk_bf16(o[0], o[1]); w.y = pg8::cvt_pk_bf16(o[2], o[3]); w.z = pg8::cvt_pk_bf16(o[4], o[5]); w.w = pg8::cvt_pk_bf16(o[6], o[7]);
          *(u32x4*)(yo + x * 8) = w; } }
    __syncthreads();
}

__device__ __forceinline__ void sub_barrier(unsigned* cnt, const unsigned target, const int wv) {
    asm volatile("s_waitcnt vmcnt(0)" ::: "memory");
    __syncthreads();
    if (fresh_tid(wv) == 0) {
        __builtin_amdgcn_fence(__ATOMIC_RELEASE, "agent");
        asm volatile("s_waitcnt vmcnt(0)" ::: "memory");
        (void)xb_add(cnt, 1u);
        unsigned sp = 0u;
        while (xb_ld(cnt) < target) { __builtin_amdgcn_s_sleep(2); if (++sp > (1u << 20)) break; }
        __builtin_amdgcn_fence(__ATOMIC_ACQUIRE, "agent");
        asm volatile("s_waitcnt vmcnt(0)" ::: "memory");
    }
    __syncthreads();
}

struct PostRegs { u32x2 yr, c_r, c_k, c_v, p_r, p_k, p_v, ar, gr; };
__device__ __forceinline__ void post_load(PR P, PostRegs& R, const int row, const int ch) {
    const bf16_t* PS = (const bf16_t*)(P.ws + WS_BIG); const bf16_t* ASIG = (const bf16_t*)(P.ws + WS_ASIG); const bf16_t* YS = (const bf16_t*)(P.ws + WS_YS); const bf16_t* G = (const bf16_t*)(P.ws + WS_WIN);
    R.yr = *(const u32x2*)(YS + (size_t)row * 512 + ch);
    const bf16_t* cp = PS + (size_t)row * NCOLS + ch; const int pr = prev_row(row);
    R.c_r = *(const u32x2*)cp; R.c_k = *(const u32x2*)(cp + 512); R.c_v = *(const u32x2*)(cp + 1024);
    R.p_r = (u32x2){0u, 0u}; R.p_k = R.p_r; R.p_v = R.p_r;
    if (pr >= 0) { const bf16_t* pp = PS + (size_t)pr * NCOLS + ch; R.p_r = *(const u32x2*)pp; R.p_k = *(const u32x2*)(pp + 512); R.p_v = *(const u32x2*)(pp + 1024); }
    R.ar = *(const u32x2*)(ASIG + (size_t)row * 512 + ch); R.gr = *(const u32x2*)(G + (size_t)row * 512 + ch);
}
__device__ __forceinline__ void rwkv_post(PR P, const int wv) {
    const int tid = fresh_tid(wv); const int lane = tid & 63; const int gw = blockIdx.x * 8 + (tid >> 6), nw = gridDim.x * 8;
    const int sub = lane >> 4, cg4 = (lane & 15) * 4;
    bf16_t* Y = (bf16_t*)(P.ws + WS_XN);
    const int h = (gw * 4 + sub) & 7, ch = h * 64 + cg4;
    const float4 mr = *(const float4*)(P.mu + ch), mk = *(const float4*)(P.mu + 512 + ch), mv = *(const float4*)(P.mu + 1024 + ch);
    const float4 ka = *(const float4*)(P.k_a + ch), rk = *(const float4*)(P.r_k + ch), lw = *(const float4*)(P.lnx_w + ch), lb = *(const float4*)(P.lnx_b + ch);
    const float m_r[4] = {mr.x, mr.y, mr.z, mr.w}, m_k[4] = {mk.x, mk.y, mk.z, mk.w}, m_v[4] = {mv.x, mv.y, mv.z, mv.w};
    const float kaa[4] = {ka.x, ka.y, ka.z, ka.w}, rkk[4] = {rk.x, rk.y, rk.z, rk.w}, lww[4] = {lw.x, lw.y, lw.z, lw.w}, lbb[4] = {lb.x, lb.y, lb.z, lb.w};
    PostRegs R, N;
    if (gw < MT * 2) post_load(P, R, (gw * 4 + sub) >> 3, ch);
    for (int task = gw; task < MT * 2; task += nw) {
        const int row = (task * 4 + sub) >> 3;
        if (task + nw < MT * 2) post_load(P, N, ((task + nw) * 4 + sub) >> 3, ch);
        const float ys[4] = {lo_bf(R.yr.x), hi_bf(R.yr.x), lo_bf(R.yr.y), hi_bf(R.yr.y)};
        const float mean = row16_sum(ys[0] + ys[1] + ys[2] + ys[3]) * (1.0f / 64.0f);
        float dl[4], s2 = 0.f;
#pragma unroll
        for (int j = 0; j < 4; ++j) { dl[j] = ys[j] - mean; s2 += dl[j] * dl[j]; }
        const float rstd = rsqrtf(row16_sum(s2) * (1.0f / 64.0f) + 64e-5f);
        const float cr[4] = {lo_bf(R.c_r.x), hi_bf(R.c_r.x), lo_bf(R.c_r.y), hi_bf(R.c_r.y)}, ck[4] = {lo_bf(R.c_k.x), hi_bf(R.c_k.x), lo_bf(R.c_k.y), hi_bf(R.c_k.y)}, cv[4] = {lo_bf(R.c_v.x), hi_bf(R.c_v.x), lo_bf(R.c_v.y), hi_bf(R.c_v.y)};
        const float qr[4] = {lo_bf(R.p_r.x), hi_bf(R.p_r.x), lo_bf(R.p_r.y), hi_bf(R.p_r.y)}, qk[4] = {lo_bf(R.p_k.x), hi_bf(R.p_k.x), lo_bf(R.p_k.y), hi_bf(R.p_k.y)}, qv[4] = {lo_bf(R.p_v.x), hi_bf(R.p_v.x), lo_bf(R.p_v.y), hi_bf(R.p_v.y)};
        const float aa[4] = {lo_bf(R.ar.x), hi_bf(R.ar.x), lo_bf(R.ar.y), hi_bf(R.ar.y)}, gg[4] = {lo_bf(R.gr.x), hi_bf(R.gr.x), lo_bf(R.gr.y), hi_bf(R.gr.y)};
        float v[4], bp = 0.f;
#pragma unroll
        for (int j = 0; j < 4; ++j) { const float r = cr[j] + (qr[j] - cr[j]) * m_r[j], k = ck[j] + (qk[j] - ck[j]) * m_k[j]; v[j] = cv[j] + (qv[j] - cv[j]) * m_v[j];
            const float kn = k * (1.0f + (aa[j] - 1.0f) * kaa[j]); bp += r * kn * rkk[j]; }
        const float bonus = row16_sum(bp);
        float o[4];
#pragma unroll
        for (int j = 0; j < 4; ++j) o[j] = (dl[j] * rstd * lww[j] + lbb[j] + bonus * v[j]) * gg[j];
        u32x2 w; w.x = pg8::cvt_pk_bf16(o[0], o[1]); w.y = pg8::cvt_pk_bf16(o[2], o[3]);
        *(u32x2*)(Y + (size_t)row * 1024 + ch) = w;
        R = N;
    }
}

__global__ void __launch_bounds__(512, 2) hymba_mega(Params P_unused) {
    extern __shared__ __attribute__((aligned(16))) unsigned char shm[];
    cg::grid_group grid = cg::this_grid();
    LAS unsigned char* lds = (LAS unsigned char*)shm; LAS float* ldsf = (LAS float*)shm;
    const int G = gridDim.x, bx = blockIdx.x;
    const int wv = __builtin_amdgcn_readfirstlane(threadIdx.x >> 6);
    const CAS Params* kp = (const CAS Params*)__builtin_amdgcn_kernarg_segment_ptr();
#define P (*kp)
#define FRESH() asm volatile("" : "+s"(kp))
#ifndef REP_SYNC
#define REP_SYNC 1
#endif
#ifndef REP_P7
#define REP_P7 1
#endif
#ifndef REP_FFN1
#define REP_FFN1 1
#endif
#ifndef REP_P0
#define REP_P0 1
#endif
#ifndef REP_P3
#define REP_P3 1
#endif
#ifndef REP_RW
#define REP_RW 1
#endif
#ifndef REP_OTH
#define REP_OTH 1
#endif
#ifndef REP_RETP
#define REP_RETP 1
#endif
#ifndef REP_SAMP
#define REP_SAMP 1
#endif
#ifndef REP_P8
#define REP_P8 1
#endif
#define GSYNC() do { for (int r_ = 0; r_ < REP_SYNC; ++r_) xcd_barrier((unsigned*)ws, (volatile LAS unsigned*)(lds + LDS_BYTES - 16), wv); FRESH(); } while (0)
#define ws (kp->ws)
#define XN ((bf16_t*)(ws + WS_XN))
#define ACT ((bf16_t*)(ws + WS_BIG))
#define FO ((float*)(ws + WS_FO))
#define PS ((bf16_t*)(ws + WS_BIG))
    pg8::StaticOrder S;
    { unsigned* barw = (unsigned*)ws; const int t0 = fresh_tid(wv); if (bx == 0) for (int i = t0; i < XCD_BAR_WORDS + 128; i += 512) barw[i] = 0u;
      if (t0 < 4) ((LAS unsigned*)(lds + LDS_BYTES - 16))[t0] = 0u; }
#ifndef PHM
#define PHM 0xFFFF
#endif
#define PH(k) if ((PHM >> (k)) & 1)
    for (int r0 = 0; r0 < REP_P0; ++r0) PH(0) p0_prologue(P, ldsf, wv);
    grid.sync(); FRESH();
    if (fresh_tid(wv) == 0) (void)xb_add(&((unsigned*)ws)[XB_XCNT(xb_xcc_id())], 1u);
    for (int rep1 = 0; rep1 < REP_FFN1; ++rep1) {
    PH(1) { pg8::Gemm g{XN, (const bf16_t*)(ws + WS_WGU), MT, NGU, 1024}; S.init(MT, NGU, G, bx, 1024); pg8::EpiSwiGLU E{ACT, DFF}; pg8::gemm_phase(lds, g, S, E, wv); }
    GSYNC();
    PH(2) { pg8::Gemm g{ACT, (const bf16_t*)(ws + WS_WD), MT, 1024, DFF}; pg8::SplitOrder S2; S2.init2(G, bx, DFF, 8); pg8::EpiFO E{(bf16_t*)FO, 1024, (float*)(ws + WS_OMD)}; pg8::gemm_phase(lds, g, S2, E, wv); }
    GSYNC();
    }
    for (int r3 = 0; r3 < REP_P3; ++r3) PH(3) rows_phase(P, 1, wv);
    GSYNC();
    PH(4) { pg8::Gemm g{XN, (const bf16_t*)(ws + WS_WIN), MIN_, NCOLS, 1024}; S.init(MIN_, NCOLS, G, bx, 1024); pg8::EpiBf16 E{PS, NCOLS}; pg8::gemm_phase(lds, g, S, E, wv); }
    GSYNC();
    PH(5) lora_prep(P, wv);
    GSYNC();
    PH(6) { pg8::Gemm g{(const bf16_t*)(ws + WS_LA), (const bf16_t*)(ws + WS_WL), MT, 1536, 256}; S.init(MT, 1536, G, bx, 256);
      pg8::EpiLora E{(bf16_t*)(ws + WS_OMD), (bf16_t*)(ws + WS_ASIG), (bf16_t*)(ws + WS_WIN), P.w0, P.a0}; pg8::gemm_phase(lds, g, S, E, wv); }
    GSYNC();
    {
    if (bx < 128) { for (int rw = 0; rw < REP_RW; ++rw) rwkv_unit<false>(P, ldsf, bx >> 4, (bx >> 1) & 7, bx & 1, wv); }
    else for (int rep7 = 0; rep7 < REP_OTH; ++rep7) { const int ob = bx - 128; unsigned* sbc = (unsigned*)ws + XCD_BAR_WORDS + 64;
        for (int k = 0; k < 4; ++k) { const int u = ob + k * 128; ret_unit_a(P, lds, u >> 4, u & 15, wv); }
        sub_barrier(sbc, 128u * (2u * rep7 + 1u), wv);
        ret_prefix(P, ob * 512 + fresh_tid(wv));
        sub_barrier(sbc, 128u * (2u * rep7 + 2u), wv);
        for (int k = 0; k < 4; ++k) { const int u = ob + k * 128; ret_unit_c(P, lds, u >> 4, u & 15, wv); }
        for (int u = ob; u < 2560; u += 128) { if (u < 2048) rwkv_unit<true>(P, ldsf, u >> 4, (u >> 1) & 7, u & 1, wv); else ret_sample_unit(P, ldsf, (u - 2048) >> 2, (u - 2048) & 3, wv); }
    }
    }
    GSYNC();
    for (int rep8 = 0; rep8 < REP_P8; ++rep8) PH(8) rwkv_post(P, wv);
    GSYNC();
    PH(9) { pg8::Gemm g{XN, (const bf16_t*)(ws + WS_WOUT), MT, 1024, 1024}; pg8::SplitOrder S2; S2.init2(G, bx, 1024, 4); pg8::EpiFO E{(bf16_t*)FO, 1024, (float*)(ws + WS_OMD)}; pg8::gemm_phase(lds, g, S2, E, wv); }
    GSYNC();
    PH(10) { tconv_list(P.f2g, P.f2u, P.f2d, nullptr, nullptr, ws, 2112, ldsf, wv);
    rows_phase(P, 2, wv); }
    GSYNC();
    PH(11) { pg8::Gemm g{XN, (const bf16_t*)(ws + WS_WGU), MT, NGU, 1024}; S.init(MT, NGU, G, bx, 1024); pg8::EpiSwiGLU E{ACT, DFF}; pg8::gemm_phase(lds, g, S, E, wv); }
    GSYNC();
    PH(12) { pg8::Gemm g{ACT, (const bf16_t*)(ws + WS_WD), MT, 1024, DFF}; pg8::SplitOrder S2; S2.init2(G, bx, DFF, 8); pg8::EpiFO E{(bf16_t*)FO, 1024, (float*)(ws + WS_OMD)}; pg8::gemm_phase(lds, g, S2, E, wv); }
    GSYNC();
    PH(13) rows_phase(P, 3, wv);
}

#undef ws
#undef XN
#undef ACT
#undef FO
#undef PS
#undef P
extern "C" void kernel_launch(void* const* d_in, const int* in_sizes, int n_in, void* d_out, int out_size, void* d_ws, size_t ws_size, hipStream_t stream) {
    static int grid = 0;
    if (grid == 0) {
        if (n_in != 26 || ws_size < WS_END) { fprintf(stderr, "kernel_launch: unexpected n_in %d or ws_size %zu (< %zu)\n", n_in, ws_size, (size_t)WS_END); grid = -1; return; }
        int dev = 0, cus = 0, per_cu = 0;
        hipGetDevice(&dev); hipDeviceGetAttribute(&cus, hipDeviceAttributeMultiprocessorCount, dev);
        hipFuncSetAttribute((const void*)hymba_mega, hipFuncAttributeMaxDynamicSharedMemorySize, LDS_BYTES);
        hipOccupancyMaxActiveBlocksPerMultiprocessor(&per_cu, (const void*)hymba_mega, 512, LDS_BYTES);
        if (per_cu < 1) { fprintf(stderr, "kernel_launch: occupancy query says %d blocks/CU\n", per_cu); per_cu = 1; }
        grid = cus * per_cu; if (grid > 256) grid = 256;
        if (grid != 256) { fprintf(stderr, "kernel_launch: this kernel needs 256 co-resident workgroups, got %d\n", grid); grid = -1; return; }
        fprintf(stderr, "kernel_launch: cus %d per_cu %d grid %d ws %zu\n", cus, per_cu, grid, ws_size);
    }
    if (grid < 0) return;
    Params p{};
    const float** pp = (const float**)&p;
    for (int i = 0; i < 26; ++i) pp[i] = (const float*)d_in[i];
    p.out = (float*)d_out; p.ws = (unsigned char*)d_ws;
    void* args[] = {&p};
    hipError_t e = hipLaunchCooperativeKernel((const void*)hymba_mega, dim3(grid), dim3(512), args, LDS_BYTES, stream);
    if (e != hipSuccess) fprintf(stderr, "cooperative launch failed: %s (grid %d)\n", hipGetErrorString(e), grid);
}
```

```cpp
#include <hip/hip_runtime.h>
#include <hip/hip_cooperative_groups.h>
#include <cstdio>
#include <cstdint>
namespace cg = cooperative_groups;

__device__ __forceinline__ int fresh_tid(int wv) { int l; asm volatile("v_mbcnt_lo_u32_b32 %0, -1, 0\n\tv_mbcnt_hi_u32_b32 %0, -1, %0" : "=v"(l)); return wv * 64 + l; }
namespace pg8 {
#define PG8_LAS __attribute__((address_space(3)))
typedef unsigned short bf16_t;
typedef short bf16x8 __attribute__((ext_vector_type(8)));
typedef float f32x4 __attribute__((ext_vector_type(4)));
typedef unsigned u32x4 __attribute__((ext_vector_type(4)));
typedef unsigned u32x2 __attribute__((ext_vector_type(2)));
constexpr int BM = 256, BK = 64, HALF = 128, HTB = HALF * BK * 2, STAGE_BYTES = 8 * HTB, NXCD = 8, WGM = 8;

__host__ __device__ __forceinline__ int lds_byte(int r, int c) { const int st = (r >> 4) * 2 + (c >> 5), rr = r & 15, cc = c & 31, ob = rr * 64 + cc * 2; return st * 1024 + (ob ^ (((ob >> 9) & 1) << 5)); }
__host__ __device__ __forceinline__ void stage_rc(int b, int& R, int& C) { const int st = b / 1024, sb = b % 1024, swz = sb ^ (((sb >> 9) & 1) << 5); R = (st >> 1) * 16 + swz / 64; C = (st & 1) * 32 + (swz % 64) / 2; }
__host__ __device__ __forceinline__ int perm32(int rho) { const int n = rho >> 4, i = rho & 15; return 8 * (i >> 2) + 4 * n + (i & 3); }

struct Unit { int pm, pn, k0, nkt, atomic; };
struct Gemm { const bf16_t* A; const bf16_t* Bt; int M, N, K; };

struct StaticOrder {
    int nM, nN, nwg, G, c, nt;
    __host__ __device__ void init(int M, int N, int G_, int c_, int K) { nM = M / BM; nN = N / BM; nwg = nM * nN; G = G_; c = c_; nt = K / BK; }
    __host__ __device__ bool next(int i, Unit& u) const {
        const long L = (long)i * G + c; if (L >= nwg) return false;
        int wgid = (int)L; { const int q = nwg / NXCD, r = nwg % NXCD, xcd = wgid % NXCD, off = wgid / NXCD; wgid = (xcd < r ? xcd * (q + 1) : r * (q + 1) + (xcd - r) * q) + off; }
        const int nig = WGM * nN, gid = wgid / nig, fm = gid * WGM, gsz = (nM - fm) < WGM ? (nM - fm) : WGM;
        u.pm = fm + ((wgid % nig) % gsz); u.pn = (wgid % nig) / gsz; u.k0 = 0; u.nkt = nt; u.atomic = 0; return true;
    }
    __device__ __forceinline__ void a_ready(const Unit&) const {}
    __device__ __forceinline__ void done(const Unit&) const {}
};
struct SplitOrder : StaticOrder {
    int KS;
    __host__ __device__ void init2(int G_, int c_, int K, int KS_) { init(16384, 1024, G_, c_, K); KS = KS_; }
    __host__ __device__ bool next(int i, Unit& u) const {
        if (i == 0) return StaticOrder::next(0, u);
        if (i > 1 || c >= 8 * KS) return false;
        const int tile = c / KS, part = c % KS, pairs = nt / 2, q = pairs / KS, r = pairs % KS;
        u.pm = 64 + (tile >> 2); u.pn = tile & 3; u.k0 = 2 * (part * q + (part < r ? part : r)); u.nkt = 2 * (q + (part < r ? 1 : 0)); u.atomic = 1 + c; return true;
    }
};

typedef __bf16 bf16x2_t __attribute__((ext_vector_type(2)));
typedef float f32x2_t __attribute__((ext_vector_type(2)));
__device__ __forceinline__ unsigned cvt_pk_bf16(float lo, float hi) { const f32x2_t v = {lo, hi}; const bf16x2_t b = __builtin_convertvector(v, bf16x2_t); return __builtin_bit_cast(unsigned, b); }

struct EpiFO {
    static constexpr bool PERM = true;
    bf16_t* C; int ldc; float* slab;
    __device__ __forceinline__ void operator()(const f32x4 (&acc)[2][2][4][2], const Unit& u, int wr, int wc, int fr, int fq) const {
        if (u.atomic == 0) {
            const int row0 = u.pm * BM + wr * 64 + fr; const int col0 = u.pn * BM + wc * 32 + 8 * fq;
#pragma unroll
            for (int ai = 0; ai < 2; ++ai)
#pragma unroll
                for (int m = 0; m < 4; ++m) { bf16_t* rowp = C + (size_t)(row0 + ai * HALF + m * 16) * ldc + col0;
#pragma unroll
                    for (int bj = 0; bj < 2; ++bj) { const f32x4 v0 = acc[ai][bj][m][0], v1 = acc[ai][bj][m][1];
                        u32x4 w; w.x = cvt_pk_bf16(v0[0], v0[1]); w.y = cvt_pk_bf16(v0[2], v0[3]); w.z = cvt_pk_bf16(v1[0], v1[1]); w.w = cvt_pk_bf16(v1[2], v1[3]);
                        *(u32x4*)(rowp + bj * HALF) = w; } }
        } else {
            float* base = slab + (size_t)(u.atomic - 1) * (BM * BM) + (size_t)(wr * 64 + fr) * BM + wc * 32 + 8 * fq;
#pragma unroll
            for (int ai = 0; ai < 2; ++ai)
#pragma unroll
                for (int m = 0; m < 4; ++m) { float* rowp = base + (size_t)(ai * HALF + m * 16) * BM;
#pragma unroll
                    for (int bj = 0; bj < 2; ++bj) { *(f32x4*)(rowp + bj * HALF) = acc[ai][bj][m][0]; *(f32x4*)(rowp + bj * HALF + 4) = acc[ai][bj][m][1]; } }
        }
    }
};
struct EpiBf16 {
    static constexpr bool PERM = true;
    bf16_t* O; int ldc;
    __device__ __forceinline__ void operator()(const f32x4 (&acc)[2][2][4][2], const Unit& u, int wr, int wc, int fr, int fq) const {
        const int row0 = u.pm * BM + wr * 64 + fr; const int col0 = u.pn * BM + wc * 32 + 8 * fq;
#pragma unroll
        for (int ai = 0; ai < 2; ++ai)
#pragma unroll
            for (int m = 0; m < 4; ++m) { bf16_t* rowp = O + (size_t)(row0 + ai * HALF + m * 16) * ldc + col0;
#pragma unroll
                for (int bj = 0; bj < 2; ++bj) { const f32x4 v0 = acc[ai][bj][m][0], v1 = acc[ai][bj][m][1];
                    u32x4 w; w.x = cvt_pk_bf16(v0[0], v0[1]); w.y = cvt_pk_bf16(v0[2], v0[3]); w.z = cvt_pk_bf16(v1[0], v1[1]); w.w = cvt_pk_bf16(v1[2], v1[3]);
                    *(u32x4*)(rowp + bj * HALF) = w; } }
    }
};
__device__ __forceinline__ float silu_f(float x) { return x * __builtin_amdgcn_rcpf(1.0f + __expf(-x)); }
struct EpiSwiGLU {
    static constexpr bool PERM = true;
    bf16_t* O; int ldc;
    __device__ __forceinline__ void operator()(const f32x4 (&acc)[2][2][4][2], const Unit& u, int wr, int wc, int fr, int fq) const {
        const int row0 = u.pm * BM + wr * 64 + fr; const int col0 = u.pn * HALF + wc * 32 + 8 * fq;
#pragma unroll
        for (int ai = 0; ai < 2; ++ai)
#pragma unroll
            for (int m = 0; m < 4; ++m) { bf16_t* rowp = O + (size_t)(row0 + ai * HALF + m * 16) * ldc + col0;
                float o[8];
#pragma unroll
                for (int n = 0; n < 2; ++n)
#pragma unroll
                    for (int j = 0; j < 4; ++j) o[n * 4 + j] = silu_f(acc[ai][0][m][n][j]) * acc[ai][1][m][n][j];
                u32x4 w; w.x = cvt_pk_bf16(o[0], o[1]); w.y = cvt_pk_bf16(o[2], o[3]); w.z = cvt_pk_bf16(o[4], o[5]); w.w = cvt_pk_bf16(o[6], o[7]);
                *(u32x4*)rowp = w; }
    }
};
struct EpiLora {
    static constexpr bool PERM = true;
    bf16_t* OMD; bf16_t* ASIG; bf16_t* G; const float* w0; const float* a0;
    template <int KIND> __device__ __forceinline__ void body(const f32x4 (&acc)[2][2][4][2], bf16_t* O, const float* bias, int row0, int ch0) const {
#pragma unroll
        for (int bj = 0; bj < 2; ++bj)
#pragma unroll
            for (int ai = 0; ai < 2; ++ai)
#pragma unroll
                for (int m = 0; m < 4; ++m) { bf16_t* rowp = O + (size_t)(row0 + ai * HALF + m * 16) * 512 + ch0 + bj * HALF;
                    float o[8];
#pragma unroll
                    for (int n = 0; n < 2; ++n)
#pragma unroll
                        for (int j = 0; j < 4; ++j) { float v = acc[ai][bj][m][n][j];
                            if (KIND == 0) { v += bias[ch0 + bj * HALF + n * 4 + j]; const float e = 0.6065306597126334f * __builtin_amdgcn_rcpf(1.0f + __expf(-v));
                                float p = 1.0f / 40320.0f; p = -1.0f / 5040.0f + e * p; p = 1.0f / 720.0f + e * p; p = -1.0f / 120.0f + e * p; p = 1.0f / 24.0f + e * p; p = -1.0f / 6.0f + e * p; p = 0.5f + e * p; p = 1.0f - e * p;
                                v = e * p; }
                            else if (KIND == 1) { v += bias[ch0 + bj * HALF + n * 4 + j]; v = __builtin_amdgcn_rcpf(1.0f + __expf(-v)); }
                            o[n * 4 + j] = v; }
                    u32x4 w; w.x = cvt_pk_bf16(o[0], o[1]); w.y = cvt_pk_bf16(o[2], o[3]); w.z = cvt_pk_bf16(o[4], o[5]); w.w = cvt_pk_bf16(o[6], o[7]);
                    *(u32x4*)rowp = w; __builtin_amdgcn_sched_barrier(0); }
    }
    __device__ __forceinline__ void operator()(const f32x4 (&acc)[2][2][4][2], const Unit& u, int wr, int wc, int fr, int fq) const {
        const int kind = u.pn >> 1;
        const int row0 = u.pm * BM + wr * 64 + fr; const int ch0 = (u.pn & 1) * BM + wc * 32 + 8 * fq;
        if (kind == 0) body<0>(acc, OMD, w0, row0, ch0); else if (kind == 1) body<1>(acc, ASIG, a0, row0, ch0); else body<2>(acc, G, a0, row0, ch0);
    }
};

template <class Epi, class Sched>
__device__ __forceinline__ void gemm_phase(PG8_LAS unsigned char* lds, const Gemm g, const Sched& S, const Epi& E, const int wv) {
    const int tid = fresh_tid(wv), wid = __builtin_amdgcn_readfirstlane(tid >> 6), lane = tid & 63, wr = wid >> 2, wc = wid & 3, fr = lane & 15, fq = lane >> 4;
    const int K = g.K;
    unsigned voffA[2], voffB[2];
#pragma unroll
    for (int i = 0; i < 2; ++i) { int R, C; stage_rc(tid * 16 + i * 8192, R, C); const int Rb = Epi::PERM ? ((R & ~31) + perm32(R & 31)) : R;
        voffA[i] = (unsigned)(R * K + C) * 2u; voffB[i] = (unsigned)(Rb * K + C) * 2u; }
    const size_t kstep = (size_t)(BK * 2);
    const size_t hstep = (size_t)HALF * K * 2;
    const size_t tstep = 2 * hstep;
    const unsigned ldsw = (unsigned)wid * 1024u;
    const int aoff = lds_byte(wr * 64 + fr, fq * 8), boff = lds_byte(wc * 32 + fr, fq * 8);
#define PG8_SA(b, h) (((b) * 2 + (h)) * HTB)
#define PG8_SB(b, h) ((4 + (b) * 2 + (h)) * HTB)
#define PG8_STAGE(bufoff, gbase, voff) do { _Pragma("unroll") for (int _i = 0; _i < 2; ++_i) \
        __builtin_amdgcn_global_load_lds((const unsigned*)((const char*)(gbase) + (voff)[_i]), (PG8_LAS unsigned*)(lds + (bufoff) + ldsw + _i * 8192), 16, 0, 0); } while (0)
#define PG8_LDA(dst, b, h) do { _Pragma("unroll") for (int m = 0; m < 4; ++m) _Pragma("unroll") for (int k = 0; k < 2; ++k) dst[m][k] = *(const PG8_LAS bf16x8*)(lds + PG8_SA(b, h) + aoff + m * 2048 + k * 1024); } while (0)
#define PG8_LDB(dst, b, h) do { _Pragma("unroll") for (int n = 0; n < 2; ++n) _Pragma("unroll") for (int k = 0; k < 2; ++k) dst[n][k] = *(const PG8_LAS bf16x8*)(lds + PG8_SB(b, h) + boff + n * 2048 + k * 1024); } while (0)
#define PG8_MMA(ai, bj, At, Bt) do { __builtin_amdgcn_s_setprio(1); _Pragma("unroll") for (int m = 0; m < 4; ++m) _Pragma("unroll") for (int n = 0; n < 2; ++n) _Pragma("unroll") for (int k = 0; k < 2; ++k) \
        acc[ai][bj][m][n] = __builtin_amdgcn_mfma_f32_16x16x32_bf16(Bt[n][k], At[m][k], acc[ai][bj][m][n], 0, 0, 0); __builtin_amdgcn_s_setprio(0); } while (0)
#define PG8_WAIT_V(n) asm volatile("s_waitcnt vmcnt(" #n ")" ::: "memory")
#define PG8_WAIT_L(n) asm volatile("s_waitcnt lgkmcnt(" #n ")" ::: "memory")
#define PG8_BAR __builtin_amdgcn_s_barrier()
#define PG8_SCHED __builtin_amdgcn_sched_barrier(0)
    Unit cur, nxt; int ui = 0;
    if (!S.next(0, cur)) return;
    f32x4 acc[2][2][4][2];
#pragma unroll
    for (int a = 0; a < 2; ++a)
#pragma unroll
        for (int b = 0; b < 2; ++b)
#pragma unroll
            for (int m = 0; m < 4; ++m)
#pragma unroll
                for (int n = 0; n < 2; ++n) acc[a][b][m][n] = (f32x4){0.f, 0.f, 0.f, 0.f};
    bf16x8 At[4][2], B0[2][2], B1[2][2];
    const char* cA = (const char*)g.A + (size_t)cur.pm * tstep + (size_t)cur.k0 * kstep; const char* cB = (const char*)g.Bt + (size_t)cur.pn * tstep + (size_t)cur.k0 * kstep;
    S.a_ready(cur);
    PG8_STAGE(PG8_SB(0, 0), cB, voffB); PG8_STAGE(PG8_SA(0, 0), cA, voffA); PG8_STAGE(PG8_SB(0, 1), cB + hstep, voffB); PG8_STAGE(PG8_SA(0, 1), cA + hstep, voffA);
    if (wr == 1) PG8_BAR;
    PG8_WAIT_V(4); PG8_BAR;
    PG8_STAGE(PG8_SB(1, 0), cB + kstep, voffB); PG8_STAGE(PG8_SA(1, 0), cA + kstep, voffA); PG8_STAGE(PG8_SB(1, 1), cB + hstep + kstep, voffB);
    PG8_WAIT_V(6); PG8_BAR;
    for (;;) {
        const bool has_next = S.next(ui + 1, nxt);
        const char* nA = has_next ? (const char*)g.A + (size_t)nxt.pm * tstep + (size_t)nxt.k0 * kstep : cA; const char* nB = has_next ? (const char*)g.Bt + (size_t)nxt.pn * tstep + (size_t)nxt.k0 * kstep : cB;
        const int nt = cur.nkt;
        for (int t = 0; t < nt; t += 2) {
            const bool last = (t == nt - 2);
            const char* a1 = cA + (size_t)(t + 1) * kstep;
            const char* a2 = last ? nA : cA + (size_t)(t + 2) * kstep; const char* b2 = last ? nB : cB + (size_t)(t + 2) * kstep;
            const char* a3 = a2 + kstep; const char* b3 = b2 + kstep;
            if (last && has_next) S.a_ready(nxt);
            PG8_LDB(B0, 0, 0); PG8_SCHED; PG8_LDA(At, 0, 0); PG8_STAGE(PG8_SA(1, 1), a1 + hstep, voffA);
            PG8_WAIT_L(8); PG8_BAR; PG8_WAIT_L(0); PG8_MMA(0, 0, At, B0); PG8_BAR; PG8_SCHED;
            PG8_LDB(B1, 0, 1); PG8_STAGE(PG8_SB(0, 0), b2, voffB);
            PG8_BAR; PG8_WAIT_L(0); PG8_MMA(0, 1, At, B1); PG8_BAR;
            PG8_LDA(At, 0, 1); PG8_STAGE(PG8_SA(0, 0), a2, voffA);
            PG8_BAR; PG8_WAIT_L(0); PG8_MMA(1, 0, At, B0); PG8_BAR; PG8_SCHED;
            PG8_STAGE(PG8_SB(0, 1), b2 + hstep, voffB);
            PG8_WAIT_V(6); PG8_BAR; PG8_MMA(1, 1, At, B1); PG8_BAR;
            PG8_LDB(B0, 1, 0); PG8_SCHED; PG8_LDA(At, 1, 0); PG8_STAGE(PG8_SA(0, 1), a2 + hstep, voffA);
            PG8_WAIT_L(8); PG8_BAR; PG8_WAIT_L(0); PG8_MMA(0, 0, At, B0); PG8_BAR; PG8_SCHED;
            PG8_LDB(B1, 1, 1); PG8_STAGE(PG8_SB(1, 0), b3, voffB);
            PG8_BAR; PG8_WAIT_L(0); PG8_MMA(0, 1, At, B1); PG8_BAR;
            PG8_LDA(At, 1, 1); PG8_STAGE(PG8_SA(1, 0), a3, voffA);
            PG8_BAR; PG8_WAIT_L(0); PG8_MMA(1, 0, At, B0); PG8_BAR; PG8_SCHED;
            PG8_STAGE(PG8_SB(1, 1), b3 + hstep, voffB);
            PG8_WAIT_V(6); PG8_BAR; PG8_MMA(1, 1, At, B1); PG8_BAR;
        }
        E(acc, cur, wr, wc, fr, fq); S.done(cur);
        if (!has_next) break;
#pragma unroll
        for (int a = 0; a < 2; ++a)
#pragma unroll
            for (int b = 0; b < 2; ++b)
#pragma unroll
                for (int m = 0; m < 4; ++m)
#pragma unroll
                    for (int n = 0; n < 2; ++n) acc[a][b][m][n] = (f32x4){0.f, 0.f, 0.f, 0.f};
        cur = nxt; cA = nA; cB = nB; ++ui;
    }
    PG8_WAIT_V(0);
    if (wr == 0) PG8_BAR;
    PG8_BAR;
#undef PG8_SA
#undef PG8_SB
#undef PG8_STAGE
#undef PG8_LDA
#undef PG8_LDB
#undef PG8_MMA
#undef PG8_WAIT_V
#undef PG8_WAIT_L
#undef PG8_BAR
#undef PG8_SCHED
}
}

using pg8::bf16_t; using pg8::f32x4; using pg8::bf16x8; using pg8::u32x4; using pg8::u32x2;
#define LAS __attribute__((address_space(3)))

constexpr int D = 1024, DFF = 2816, NGU = 5632, NCOLS = 3840;
constexpr int MP = 16384, MS = 512, MT = 16896, MIN_ = 17152;
constexpr int LDS_BYTES = 147456;
constexpr size_t O_SHP = 17301504, O_WKP = O_SHP + 8192, O_RTP = O_WKP + 262144, O_SHS = O_RTP + 524288, O_WKS = O_SHS + 131072, O_RTS = O_WKS + 4194304;
constexpr size_t WS_ROPE = 16384;
constexpr size_t WS_WL   = WS_ROPE + 1050624;
constexpr size_t WS_WOUT = WS_WL + 786432;
constexpr size_t WS_WIN  = WS_WOUT + 2097152;
constexpr size_t WS_WGU  = WS_WIN + 7864320;
constexpr size_t WS_WD   = WS_WGU + 11534336;
constexpr size_t WS_XN   = WS_WD + 5767168;
constexpr size_t WS_BIG  = WS_XN + 35127296;
constexpr size_t WS_FO   = WS_BIG + 95158272;
constexpr size_t WS_YS   = WS_BIG + 131727360;
constexpr size_t WS_LA   = WS_YS + 17301504;
constexpr size_t WS_OMD  = WS_BIG + 164364288;
constexpr size_t WS_ASIG = WS_OMD + 17301504;
constexpr size_t WS_END  = WS_ASIG + 17301504;
static_assert(WS_LA + 8650752 <= WS_OMD, "mixer overlays");
static_assert(WS_END <= 268435456, "workspace");

struct Params {
    const float *x_prompt, *x_sample, *state_shift, *state_wkv, *state_ret, *norm_g, *f1g, *f1u, *f1d, *w_in, *mu, *w0, *w2, *a0, *a2, *g2, *k_k, *k_a, *r_k, *lnx_w, *lnx_b, *gn_w, *w_out, *f2g, *f2u, *f2d;
    float* out; unsigned char* ws;
};
#define CAS __attribute__((address_space(4)))
typedef const CAS Params& PR;

__device__ __forceinline__ float bf2f(unsigned b) { return __uint_as_float(b << 16); }
__device__ __forceinline__ bf16_t f2bf(float f) { unsigned u = __float_as_uint(f); u += 0x7FFFu + ((u >> 16) & 1u); return (bf16_t)(u >> 16); }
__device__ __forceinline__ float lo_bf(unsigned x) { return __uint_as_float(x << 16); }
__device__ __forceinline__ float hi_bf(unsigned x) { return __uint_as_float(x & 0xffff0000u); }
template <int CTRL> __device__ __forceinline__ float dppf(float v) { return __int_as_float(__builtin_amdgcn_update_dpp(0, __float_as_int(v), CTRL, 0xF, 0xF, false)); }
__device__ __forceinline__ float row16_sum(float v) { v += dppf<0xB1>(v); v += dppf<0x4E>(v); v += dppf<0x141>(v); v += dppf<0x140>(v); return v; }
__device__ __forceinline__ float wave_sum(float v) { v = row16_sum(v); const int i = __float_as_int(v);
    return __int_as_float(__builtin_amdgcn_readlane(i, 0)) + __int_as_float(__builtin_amdgcn_readlane(i, 16)) + __int_as_float(__builtin_amdgcn_readlane(i, 32)) + __int_as_float(__builtin_amdgcn_readlane(i, 48)); }
__device__ __forceinline__ float quad_sum(float v) { v += dppf<0xB1>(v); v += dppf<0x4E>(v); return v; }
__device__ __forceinline__ float sigmoid_f(float x) { return __builtin_amdgcn_rcpf(1.0f + __expf(-x)); }


#define XB_TMO      128
#define XB_XCNT(j)  (256  + 64 * (j))
#define XB_XSUB(j)  (1280 + 64 * (j))
#define XB_XGEN(j)  (2304 + 64 * (j))
#define XB_TOP      3328
#define XB_TOPGEN   3392
#define XCD_BAR_WORDS 3456
#define XB_SPIN_CAP (1u << 18)
__device__ __forceinline__ unsigned xb_ld(unsigned* p)              { return __hip_atomic_load(p, __ATOMIC_RELAXED, __HIP_MEMORY_SCOPE_AGENT); }
__device__ __forceinline__ unsigned xb_add(unsigned* p, unsigned v) { return __hip_atomic_fetch_add(p, v, __ATOMIC_RELAXED, __HIP_MEMORY_SCOPE_AGENT); }
__device__ __forceinline__ unsigned xb_xcc_id() { return (unsigned)__builtin_amdgcn_s_getreg((3 << 11) | 20) & 0xFu; }
#define XB_SPIN(cond, bar) do { unsigned _sp = 0; while (cond) { __builtin_amdgcn_s_sleep(1); \
    if ((++_sp & 255u) == 0u) { if (xb_ld(&(bar)[XB_TMO])) break; if (_sp > XB_SPIN_CAP) { atomicAdd(&(bar)[XB_TMO], 1u); break; } } } } while (0)
struct XcdBarrier { unsigned* bar; unsigned x; volatile LAS unsigned* st; };
__device__ __forceinline__ XcdBarrier xcd_barrier_post(unsigned* bar, volatile LAS unsigned* st) {
    XcdBarrier b; b.bar = bar; b.x = xb_xcc_id(); b.st = st;
    return b;
}
__device__ __forceinline__ void xcd_barrier_complete(unsigned* bar, unsigned x, unsigned& nloc, unsigned& nx) {
    const unsigned G = gridDim.x * gridDim.y * gridDim.z;
    unsigned sum, cnt, mine, sp = 0u;
    for (;;) {
        sum = 0u; cnt = 0u; mine = 0u;
#pragma unroll
        for (unsigned j = 0; j < 16; ++j) { const unsigned c = xb_ld(&bar[XB_XCNT(j)]); sum += c; cnt += (c > 0u) ? 1u : 0u; mine = (j == x) ? c : mine; }
        if (sum == G) break;
        __builtin_amdgcn_s_sleep(1);
        if ((++sp & 255u) == 0u) { if (xb_ld(&bar[XB_TMO])) break; if (sp > XB_SPIN_CAP) { atomicAdd(&bar[XB_TMO], 1u); break; } }
    }
    nloc = mine > 0u ? mine : 1u; nx = cnt > 0u ? cnt : 1u;
}
__device__ __forceinline__ void xcd_barrier(unsigned* barw, volatile LAS unsigned* stw, const int wv) {
    XcdBarrier b; b.bar = barw; b.x = xb_xcc_id(); b.st = stw;
    asm volatile("s_waitcnt vmcnt(0)" ::: "memory");
    __syncthreads();
    if (fresh_tid(wv) == 0) {
        unsigned* bar = b.bar;
        __builtin_amdgcn_s_waitcnt(0);
        unsigned nloc = b.st[0], nx = b.st[1];
        if (nloc == 0u) { xcd_barrier_complete(bar, b.x, nloc, nx); b.st[0] = nloc; b.st[1] = nx; }
        const unsigned old = xb_add(&bar[XB_XSUB(b.x)], 1u);
        const unsigned gen = old / nloc;
        if (old + 1u == (gen + 1u) * nloc) {
            __builtin_amdgcn_fence(__ATOMIC_RELEASE, "agent");
            asm volatile("s_waitcnt vmcnt(0)" ::: "memory");
            const unsigned og = xb_add(&bar[XB_TOP], 1u);
            const unsigned tg = og / nx;
            if (og + 1u == (tg + 1u) * nx) xb_add(&bar[XB_TOPGEN], 1u);
            else XB_SPIN(xb_ld(&bar[XB_TOPGEN]) == tg, bar);
            __builtin_amdgcn_fence(__ATOMIC_ACQUIRE, "agent");
            xb_add(&bar[XB_XGEN(b.x)], 1u);
            asm volatile("s_waitcnt vmcnt(0)" ::: "memory");
        } else {
            XB_SPIN(xb_ld(&bar[XB_XGEN(b.x)]) == gen, bar);
            __builtin_amdgcn_fence(__ATOMIC_ACQUIRE, "agent");
            asm volatile("s_waitcnt vmcnt(0)" ::: "memory");
        }
    }
    __syncthreads();
}


#define DPP2(x, y, CTRL, NOP) asm volatile(NOP "\n\tv_add_f32_dpp %0, %0, %0 " CTRL " row_mask:0xf bank_mask:0xf bound_ctrl:1\n\tv_add_f32_dpp %1, %1, %1 " CTRL " row_mask:0xf bank_mask:0xf bound_ctrl:1" : "+v"(x), "+v"(y))
#define DPP4(x, y, z, w, CTRL, NOP) asm volatile(NOP "\n\tv_add_f32_dpp %0, %0, %0 " CTRL " row_mask:0xf bank_mask:0xf bound_ctrl:1\n\tv_add_f32_dpp %1, %1, %1 " CTRL " row_mask:0xf bank_mask:0xf bound_ctrl:1\n\tv_add_f32_dpp %2, %2, %2 " CTRL " row_mask:0xf bank_mask:0xf bound_ctrl:1\n\tv_add_f32_dpp %3, %3, %3 " CTRL " row_mask:0xf bank_mask:0xf bound_ctrl:1" : "+v"(x), "+v"(y), "+v"(z), "+v"(w))
#define ROW16_SUM4(x, y, z, w) do { DPP4(x, y, z, w, "quad_perm:[1,0,3,2]", "s_nop 1"); DPP4(x, y, z, w, "quad_perm:[2,3,0,1]", ""); DPP4(x, y, z, w, "row_half_mirror", ""); DPP4(x, y, z, w, "row_mirror", ""); } while (0)
#define ROW16_SUM2(x, y) do { DPP2(x, y, "quad_perm:[1,0,3,2]", "s_nop 1"); DPP2(x, y, "quad_perm:[2,3,0,1]", "s_nop 0"); DPP2(x, y, "row_half_mirror", "s_nop 0"); DPP2(x, y, "row_mirror", "s_nop 0"); } while (0)
__device__ __forceinline__ int prev_row(int r) {
    if (r < MP) return (r & 2047) == 0 ? -1 : r - 1;
    const int s = r - MP; return (s & 3) == 0 ? MT + (s >> 2) : r - 1;
}

struct TDesc { const float* W; bf16_t* Bt; int K, N, k0, n0, brow0; };
__device__ __forceinline__ TDesc tconv_desc(const float* wg, const float* wu, const float* wd, const float* win, const float* wout, unsigned char* ws, int i) {
    TDesc d; int mode = 0, tile = i;
    if (i < 704) { d.W = wg; d.Bt = (bf16_t*)(ws + WS_WGU); d.K = 1024; d.N = DFF; mode = 1; }
    else if (i < 1408) { d.W = wu; d.Bt = (bf16_t*)(ws + WS_WGU); d.K = 1024; d.N = DFF; mode = 2; tile = i - 704; }
    else if (i < 2112) { d.W = wd; d.Bt = (bf16_t*)(ws + WS_WD); d.K = DFF; d.N = 1024; tile = i - 1408; }
    else if (i < 3072) { d.W = win; d.Bt = (bf16_t*)(ws + WS_WIN); d.K = 1024; d.N = NCOLS; tile = i - 2112; }
    else { d.W = wout; d.Bt = (bf16_t*)(ws + WS_WOUT); d.K = 1024; d.N = 1024; tile = i - 3072; }
    const int nkt = d.K / 64; const int kt = tile % nkt, nt = tile / nkt; d.k0 = kt * 64; d.n0 = nt * 64;
    d.brow0 = mode == 0 ? d.n0 : ((d.n0 >> 7) * 256 + (d.n0 & 127) + (mode == 2 ? 128 : 0));
    return d;
}
__device__ __forceinline__ void tconv_list(const float* wg, const float* wu, const float* wd, const float* win, const float* wout, unsigned char* ws, const int ntiles, LAS float* t, const int wv) {
    const int tid = fresh_tid(wv); const int G = gridDim.x;
    float cur[8], nxt[8];
    int i = blockIdx.x;
    if (i < ntiles) { const TDesc d = tconv_desc(wg, wu, wd, win, wout, ws, i);
#pragma unroll
        for (int e = 0; e < 8; ++e) { const int idx = e * 512 + tid, r = idx >> 6, c = idx & 63; cur[e] = d.W[(size_t)(d.k0 + r) * d.N + d.n0 + c]; } }
    for (; i < ntiles; i += G) {
        const TDesc d = tconv_desc(wg, wu, wd, win, wout, ws, i);
        if (i + G < ntiles) { const TDesc dn = tconv_desc(wg, wu, wd, win, wout, ws, i + G);
#pragma unroll
            for (int e = 0; e < 8; ++e) { const int idx = e * 512 + tid, r = idx >> 6, c = idx & 63; nxt[e] = dn.W[(size_t)(dn.k0 + r) * dn.N + dn.n0 + c]; } }
#pragma unroll
        for (int e = 0; e < 8; ++e) { const int idx = e * 512 + tid, r = idx >> 6, c = idx & 63; t[r * 65 + c] = cur[e]; }
        __syncthreads();
#pragma unroll
        for (int e = 0; e < 4; ++e) { const int idx = e * 512 + tid, n = idx >> 5, kp = idx & 31;
            const unsigned w = pg8::cvt_pk_bf16(t[(2 * kp) * 65 + n], t[(2 * kp + 1) * 65 + n]);
            *(unsigned*)(d.Bt + (size_t)(d.brow0 + n) * d.K + d.k0 + 2 * kp) = w; }
        __syncthreads();
#pragma unroll
        for (int e = 0; e < 8; ++e) cur[e] = nxt[e];
    }
}

__device__ __forceinline__ void rows_phase(PR P, const int mode, const int wv) {
    const int tid = fresh_tid(wv); const int lane = tid & 63; const int gw = blockIdx.x * 8 + (tid >> 6), nw = gridDim.x * 8;
    const bf16_t* FO = (const bf16_t*)(P.ws + WS_FO); bf16_t* XN = (bf16_t*)(P.ws + WS_XN);
    const float* gpost = P.norm_g + (mode == 1 ? 1 : (mode == 2 ? 3 : 5)) * 1024;
    const float* gnext = P.norm_g + (mode == 0 ? 0 : (mode == 1 ? 2 : 4)) * 1024;
    const float scale = mode == 2 ? 1.0f : 0.5f;
    for (int row = gw; row < MT; row += nw) {
        float4 xv[4];
        if (mode <= 1) { const float* xin = row < MP ? P.x_prompt + (size_t)row * 1024 : P.x_sample + (size_t)(row - MP) * 1024;
#pragma unroll
            for (int q = 0; q < 4; ++q) xv[q] = *(const float4*)(xin + (q * 64 + lane) * 4); }
        else { const bf16_t* xb = (mode == 2 ? (const bf16_t*)P.out : (const bf16_t*)(P.ws + WS_FO + 34603008)) + (size_t)row * 1024;
#pragma unroll
            for (int q = 0; q < 4; ++q) { const u32x2 t = *(const u32x2*)(xb + (q * 64 + lane) * 4); xv[q] = make_float4(lo_bf(t.x), hi_bf(t.x), lo_bf(t.y), hi_bf(t.y)); } }
        if (mode != 0) {
            float4 fo[4]; float ss = 0.f;
#pragma unroll
            for (int q = 0; q < 4; ++q) {
                if (row < MP) { const u32x2 fb = *(const u32x2*)(FO + (size_t)row * 1024 + (q * 64 + lane) * 4); fo[q] = make_float4(lo_bf(fb.x), hi_bf(fb.x), lo_bf(fb.y), hi_bf(fb.y)); }
                else {
                    const int KS = mode == 2 ? 4 : 8; const float* sl = (const float*)(P.ws + WS_OMD) + (size_t)((((row - MP) >> 8) * 4 + q) * KS) * 65536 + (size_t)(row & 255) * 256 + lane * 4;
                    float4 a = *(const float4*)sl;
                    for (int p = 1; p < KS; ++p) { const float4 b = *(const float4*)(sl + (size_t)p * 65536); a.x += b.x; a.y += b.y; a.z += b.z; a.w += b.w; }
                    fo[q] = a; }
                ss += fo[q].x * fo[q].x + fo[q].y * fo[q].y + fo[q].z * fo[q].z + fo[q].w * fo[q].w; }
            ss = wave_sum(ss); const float r = rsqrtf(ss * (1.0f / 1024.0f) + 1e-6f) * scale;
#pragma unroll
            for (int q = 0; q < 4; ++q) { const float4 g = *(const float4*)(gpost + (q * 64 + lane) * 4);
                xv[q].x += fo[q].x * r * g.x; xv[q].y += fo[q].y * r * g.y; xv[q].z += fo[q].z * r * g.z; xv[q].w += fo[q].w * r * g.w;
                if (mode == 3) *(float4*)(P.out + (size_t)row * 1024 + (q * 64 + lane) * 4) = xv[q];
                else { bf16_t* xo = (mode == 1 ? (bf16_t*)P.out : (bf16_t*)(P.ws + WS_FO + 34603008)) + (size_t)row * 1024; u32x2 t; t.x = pg8::cvt_pk_bf16(xv[q].x, xv[q].y); t.y = pg8::cvt_pk_bf16(xv[q].z, xv[q].w);
                    *(u32x2*)(xo + (q * 64 + lane) * 4) = t; } }
            if (mode == 3) continue;
        }
        float ss2 = 0.f;
#pragma unroll
        for (int q = 0; q < 4; ++q) ss2 += xv[q].x * xv[q].x + xv[q].y * xv[q].y + xv[q].z * xv[q].z + xv[q].w * xv[q].w;
        ss2 = wave_sum(ss2); const float r2 = rsqrtf(ss2 * (1.0f / 1024.0f) + 1e-6f);
        float* sh = nullptr;
        if (mode == 1) { if (row < MP) { if ((row & 2047) == 2047) sh = P.out + O_SHP + (size_t)(row >> 11) * 1024; } else { const int s = row - MP; if ((s & 3) == 3) sh = P.out + O_SHS + (size_t)(s >> 2) * 1024; } }
#pragma unroll
        for (int q = 0; q < 4; ++q) { const float4 g = *(const float4*)(gnext + (q * 64 + lane) * 4);
            float4 hv; hv.x = xv[q].x * r2 * g.x; hv.y = xv[q].y * r2 * g.y; hv.z = xv[q].z * r2 * g.z; hv.w = xv[q].w * r2 * g.w;
            u32x2 w; w.x = pg8::cvt_pk_bf16(hv.x, hv.y); w.y = pg8::cvt_pk_bf16(hv.z, hv.w);
            *(u32x2*)(XN + (size_t)row * 1024 + (q * 64 + lane) * 4) = w;
            if (sh) *(float4*)(sh + (q * 64 + lane) * 4) = hv; }
    }
}

__device__ __forceinline__ void p0_prologue(PR P, LAS float* ldsf, const int wv) {
    const int tid = fresh_tid(wv); const size_t gt = (size_t)blockIdx.x * 512 + tid, nth = (size_t)gridDim.x * 512;
    { float* rc = (float*)(P.ws + WS_ROPE); float* rs = rc + 2052 * 64;
      for (size_t i = gt; i < 2052 * 64; i += nth) { const int p = (int)(i >> 6), f = (int)(i & 63); const int pos = p < 2048 ? p : 16384 + (p - 2048);
          double inv = 1.0; for (int q = 0; q < f; ++q) inv *= 0.8659643233600653;
          const double ang = (double)pos * inv; const double n = rint(ang * 0.15915494309189535); const double r = ang - n * 6.283185307179586;
          const double r2 = r * r; double s = 0.0, c = 0.0;
          for (int k = 14; k >= 0; --k) { s = s * (-r2 / (double)((2 * k + 2) * (2 * k + 3))) + 1.0; c = c * (-r2 / (double)((2 * k + 1) * (2 * k + 2))) + 1.0; }
          rc[i] = (float)c; rs[i] = (float)(s * r); } }
    { bf16_t* Wl = (bf16_t*)(P.ws + WS_WL);
      for (size_t i = gt; i < 1536 * 256; i += nth) { const int n = (int)(i >> 8), k = (int)(i & 255); float v = 0.f;
          if (n < 512) { if (k < 64) v = P.w2[k * 512 + n]; } else if (n < 1024) { if (k >= 64 && k < 128) v = P.a2[(k - 64) * 512 + (n - 512)]; } else { if (k >= 128) v = P.g2[(k - 128) * 512 + (n - 1024)]; }
          Wl[i] = f2bf(v); } }
    { bf16_t* XN = (bf16_t*)(P.ws + WS_XN);
      for (size_t i = gt; i < 256 * 1024; i += nth) { const int r = (int)(i >> 10); XN[(size_t)MT * 1024 + i] = r < 128 ? f2bf(P.state_shift[i]) : (bf16_t)0; } }
    tconv_list(P.f1g, P.f1u, P.f1d, P.w_in, P.w_out, P.ws, 3328, ldsf, wv);
    rows_phase(P, 0, wv);
}

__device__ __forceinline__ void lora_prep(PR P, const int wv) {
    const int tid = fresh_tid(wv); const int lane = tid & 63; const int gw = blockIdx.x * 8 + (tid >> 6), nw = gridDim.x * 8;
    const bf16_t* PS = (const bf16_t*)(P.ws + WS_BIG); bf16_t* LA = (bf16_t*)(P.ws + WS_LA);
    const float4 mu = *(const float4*)(P.mu + 1536 + lane * 4); const int kind = lane >> 4;
    u32x2 c = (u32x2){0u, 0u}, p = c, nc = c, np = c;
    if (gw < MT) { c = *(const u32x2*)(PS + (size_t)gw * NCOLS + 1536 + lane * 4); const int pr = prev_row(gw); if (pr >= 0) p = *(const u32x2*)(PS + (size_t)pr * NCOLS + 1536 + lane * 4); }
    for (int row = gw; row < MT; row += nw) {
        const int nrow = row + nw;
        if (nrow < MT) { nc = *(const u32x2*)(PS + (size_t)nrow * NCOLS + 1536 + lane * 4); const int pr = prev_row(nrow); np = (u32x2){0u, 0u}; if (pr >= 0) np = *(const u32x2*)(PS + (size_t)pr * NCOLS + 1536 + lane * 4); }
        float v[4]; const float cu[4] = {lo_bf(c.x), hi_bf(c.x), lo_bf(c.y), hi_bf(c.y)}, pv[4] = {lo_bf(p.x), hi_bf(p.x), lo_bf(p.y), hi_bf(p.y)}, m4[4] = {mu.x, mu.y, mu.z, mu.w};
#pragma unroll
        for (int j = 0; j < 4; ++j) { float x = cu[j] + (pv[j] - cu[j]) * m4[j];
            if (kind == 0) x = 1.0f - 2.0f * __builtin_amdgcn_rcpf(__expf(2.0f * x) + 1.0f); else if (kind >= 2) x = sigmoid_f(x);
            v[j] = x; }
        u32x2 w; w.x = pg8::cvt_pk_bf16(v[0], v[1]); w.y = pg8::cvt_pk_bf16(v[2], v[3]);
        *(u32x2*)(LA + (size_t)row * 256 + lane * 4) = w;
        c = nc; p = np;
    }
}

template <bool SAMPLE>
__device__ __forceinline__ void rwkv_unit(PR P, LAS float* lds, const int b, const int h, const int half, const int wv) {
    constexpr int T = SAMPLE ? 4 : 2048, TC = SAMPLE ? 4 : 32, NCH = T / TC;
    const int tid = fresh_tid(wv), lane = tid & 63, wid = tid >> 6;
    const bf16_t* PS = (const bf16_t*)(P.ws + WS_BIG); const bf16_t* OMD = (const bf16_t*)(P.ws + WS_OMD); const bf16_t* ASIG = (const bf16_t*)(P.ws + WS_ASIG);
    bf16_t* YS = (bf16_t*)(P.ws + WS_YS);
    const int row_base = SAMPLE ? MP + b * 4 : b * 2048;
    const int ltok = (tid - 256) >> 4, lcg = tid & 15; const bool lwave = tid >= 256; const int hch = h * 64 + lcg * 4;
    const float4 mur = *(const float4*)(P.mu + hch), muk = *(const float4*)(P.mu + 512 + hch), muv = *(const float4*)(P.mu + 1024 + hch);
    const float4 kk4 = *(const float4*)(P.k_k + hch), ka4 = *(const float4*)(P.k_a + hch);
    typedef float f32x2 __attribute__((ext_vector_type(2)));
    const int row0 = half * 32 + (wid & 3) * 8 + (lane >> 4) * 2, cgl = lane & 15, j0 = cgl * 4;
    f32x2 S[4];
#pragma unroll
    for (int c = 0; c < 4; ++c) S[c] = (f32x2){0.f, 0.f};
    float* sout = P.out + (SAMPLE ? O_WKS : O_WKP) + ((size_t)(b * 8 + h) * 64 + row0) * 64 + j0;
    if (SAMPLE && wid < 4) { const float* sp = P.state_wkv + ((size_t)(b * 8 + h) * 64 + row0) * 64 + j0; const float4 s0 = *(const float4*)sp, s1 = *(const float4*)(sp + 64);
        S[0] = (f32x2){s0.x, s1.x}; S[1] = (f32x2){s0.y, s1.y}; S[2] = (f32x2){s0.z, s1.z}; S[3] = (f32x2){s0.w, s1.w}; }
    LAS float* buf0 = lds; LAS float* buf1 = lds + TC * 384;
    u32x2 cr[2], ck[2], cv[2], pr[2], pk[2], pv[2], co[2], ca[2];
#define RW_LOAD1(c, U) do { if (lwave && ltok + 16 * (U) < TC) { const int t_ = (c) * TC + ltok + 16 * (U); const int row_ = row_base + t_; const int prow_ = SAMPLE ? (t_ == 0 ? MT + b : row_ - 1) : row_ - 1; \
        const bf16_t* cp_ = PS + (size_t)row_ * NCOLS + hch; cr[U] = *(const u32x2*)cp_; ck[U] = *(const u32x2*)(cp_ + 512); cv[U] = *(const u32x2*)(cp_ + 1024); \
        if (SAMPLE || t_ > 0) { const bf16_t* pp_ = PS + (size_t)prow_ * NCOLS + hch; pr[U] = *(const u32x2*)pp_; pk[U] = *(const u32x2*)(pp_ + 512); pv[U] = *(const u32x2*)(pp_ + 1024); } \
        else { pr[U] = (u32x2){0u, 0u}; pk[U] = pr[U]; pv[U] = pr[U]; } \
        co[U] = *(const u32x2*)(OMD + (size_t)row_ * 512 + hch); ca[U] = *(const u32x2*)(ASIG + (size_t)row_ * 512 + hch); } } while (0)
#define RW_LOAD(c) do { RW_LOAD1(c, 0); RW_LOAD1(c, 1); } while (0)
#define RW_MIX(cu, pv_, m) ((cu) + ((pv_) - (cu)) * (m))
#define RW_PROC1(dst, U) do { if (lwave && ltok + 16 * (U) < TC) { LAS float* d_ = (dst) + (ltok + 16 * (U)) * 384 + lcg * 4; \
        f32x4 r_, k_, v_, o_, a_; \
        r_[0] = RW_MIX(lo_bf(cr[U].x), lo_bf(pr[U].x), mur.x); r_[1] = RW_MIX(hi_bf(cr[U].x), hi_bf(pr[U].x), mur.y); r_[2] = RW_MIX(lo_bf(cr[U].y), lo_bf(pr[U].y), mur.z); r_[3] = RW_MIX(hi_bf(cr[U].y), hi_bf(pr[U].y), mur.w); \
        k_[0] = RW_MIX(lo_bf(ck[U].x), lo_bf(pk[U].x), muk.x); k_[1] = RW_MIX(hi_bf(ck[U].x), hi_bf(pk[U].x), muk.y); k_[2] = RW_MIX(lo_bf(ck[U].y), lo_bf(pk[U].y), muk.z); k_[3] = RW_MIX(hi_bf(ck[U].y), hi_bf(pk[U].y), muk.w); \
        v_[0] = RW_MIX(lo_bf(cv[U].x), lo_bf(pv[U].x), muv.x); v_[1] = RW_MIX(hi_bf(cv[U].x), hi_bf(pv[U].x), muv.y); v_[2] = RW_MIX(lo_bf(cv[U].y), lo_bf(pv[U].y), muv.z); v_[3] = RW_MIX(hi_bf(cv[U].y), hi_bf(pv[U].y), muv.w); \
        o_[0] = lo_bf(co[U].x); o_[1] = hi_bf(co[U].x); o_[2] = lo_bf(co[U].y); o_[3] = hi_bf(co[U].y); a_[0] = lo_bf(ca[U].x); a_[1] = hi_bf(ca[U].x); a_[2] = lo_bf(ca[U].y); a_[3] = hi_bf(ca[U].y); \
        f32x4 kk_; kk_[0] = k_[0] * kk4.x; kk_[1] = k_[1] * kk4.y; kk_[2] = k_[2] * kk4.z; kk_[3] = k_[3] * kk4.w; \
        float ss_ = kk_[0] * kk_[0] + kk_[1] * kk_[1] + kk_[2] * kk_[2] + kk_[3] * kk_[3]; ss_ = row16_sum(ss_); \
        const float inv_ = __builtin_amdgcn_rcpf(fmaxf(__builtin_amdgcn_sqrtf(ss_), 1e-12f)); kk_ = kk_ * inv_; \
        f32x4 kn_; kn_[0] = k_[0] * (1.0f + (a_[0] - 1.0f) * ka4.x); kn_[1] = k_[1] * (1.0f + (a_[1] - 1.0f) * ka4.y); kn_[2] = k_[2] * (1.0f + (a_[2] - 1.0f) * ka4.z); kn_[3] = k_[3] * (1.0f + (a_[3] - 1.0f) * ka4.w); \
        *(LAS f32x4*)(d_) = r_; *(LAS f32x4*)(d_ + 64) = o_; *(LAS f32x4*)(d_ + 128) = kn_; *(LAS f32x4*)(d_ + 192) = -kk_; *(LAS f32x4*)(d_ + 256) = kk_ * a_; *(LAS f32x4*)(d_ + 320) = v_; } } while (0)
#define RW_PROC(dst) do { RW_PROC1(dst, 0); RW_PROC1(dst, 1); } while (0)
    RW_LOAD(0); RW_PROC(buf0); __syncthreads();
    for (int c = 0; c < NCH; ++c) {
        LAS float* cur = (c & 1) ? buf1 : buf0; LAS float* nxt = (c & 1) ? buf0 : buf1;
        if (c + 1 < NCH) RW_LOAD(c + 1);
        if (wid < 4) {
            constexpr int GS = SAMPLE ? 4 : 16;
            for (int g = 0; g < TC / GS; ++g) {
                float yk0 = 0.f, yk1 = 0.f;
                const LAS float* q0 = cur + (g * GS) * 384;
                f32x4 r4 = *(const LAS f32x4*)(q0 + j0), o4 = *(const LAS f32x4*)(q0 + 64 + j0), k4 = *(const LAS f32x4*)(q0 + 128 + j0), a4 = *(const LAS f32x4*)(q0 + 192 + j0), b4 = *(const LAS f32x4*)(q0 + 256 + j0);
                f32x2 v2 = *(const LAS f32x2*)(q0 + 320 + row0);
                float py0 = 0.f, py1 = 0.f;
#pragma unroll
                for (int tt = 0; tt < GS; ++tt) {
                    const LAS float* qn = q0 + (tt + 1 < GS ? tt + 1 : tt) * 384;
                    const f32x4 nr4 = *(const LAS f32x4*)(qn + j0), no4 = *(const LAS f32x4*)(qn + 64 + j0), nk4 = *(const LAS f32x4*)(qn + 128 + j0), na4 = *(const LAS f32x4*)(qn + 192 + j0), nb4 = *(const LAS f32x4*)(qn + 256 + j0);
                    const f32x2 nv2 = *(const LAS f32x2*)(qn + 320 + row0);
                    f32x2 sa = (S[0] * a4[0] + S[1] * a4[1]) + (S[2] * a4[2] + S[3] * a4[3]);
                    float sx = sa.x, sy = sa.y; ROW16_SUM4(sx, sy, py0, py1); sa = (f32x2){sx, sy};
                    if (tt > 0) { yk0 = cgl == tt - 1 ? py0 : yk0; yk1 = cgl == tt - 1 ? py1 : yk1; }
#pragma unroll
                    for (int c = 0; c < 4; ++c) { f32x2 t = S[c] - S[c] * o4[c]; t = t + sa * b4[c]; S[c] = t + v2 * k4[c]; }
                    const f32x2 y = (S[0] * r4[0] + S[1] * r4[1]) + (S[2] * r4[2] + S[3] * r4[3]);
                    py0 = y.x; py1 = y.y;
                    r4 = nr4; o4 = no4; k4 = nk4; a4 = na4; b4 = nb4; v2 = nv2;
                }
                ROW16_SUM2(py0, py1); yk0 = cgl == GS - 1 ? py0 : yk0; yk1 = cgl == GS - 1 ? py1 : yk1;
                if (cgl < GS) *(unsigned*)(YS + (size_t)(row_base + c * TC + g * GS + cgl) * 512 + h * 64 + row0) = pg8::cvt_pk_bf16(yk0, yk1);
            }
        }
        if (c + 1 < NCH) RW_PROC(nxt);
        __syncthreads();
    }
    if (wid < 4) { *(float4*)sout = make_float4(S[0].x, S[1].x, S[2].x, S[3].x); *(float4*)(sout + 64) = make_float4(S[0].y, S[1].y, S[2].y, S[3].y); }
#undef RW_LOAD
#undef RW_PROC
#undef RW_LOAD1
#undef RW_PROC1
#undef RW_MIX
}

__device__ __forceinline__ void ret_sample_unit(PR P, LAS float* lds, const int b, const int h, const int wv) {
    const int tid = fresh_tid(wv), lane = tid & 63, wid = tid >> 6;
    const bf16_t* PS = (const bf16_t*)(P.ws + WS_BIG); bf16_t* Y = (bf16_t*)(P.ws + WS_XN);
    const float* rc = (const float*)(P.ws + WS_ROPE); const float* rs = rc + 2052 * 64;
    LAS float* q = lds; LAS float* k = lds + 512; LAS float* v = lds + 1024; LAS float* Pm = lds + 1536; LAS float* y2p = lds + 1600; LAS float* red = lds + 1600 + 2048;
    const float lg2 = log2f(1.0f - exp2f(-5.0f - (float)h));
    const int row0 = MP + b * 4;
    { const int t = (tid & 255) >> 6, f = tid & 63; const bf16_t* src = PS + (size_t)(row0 + t) * NCOLS + 1792 + h * 128;
      if (tid < 256) { const float cs = rc[(2048 + t) * 64 + f], sn = rs[(2048 + t) * 64 + f];
          const float q1 = bf2f(src[f]), q2 = bf2f(src[f + 64]); q[t * 128 + f] = q1 * cs - q2 * sn; q[t * 128 + f + 64] = q1 * sn + q2 * cs;
          const float k1 = bf2f(src[512 + f]), k2 = bf2f(src[512 + f + 64]); k[t * 128 + f] = (k1 * cs - k2 * sn) * 0.08838834764831845f; k[t * 128 + f + 64] = (k1 * sn + k2 * cs) * 0.08838834764831845f; }
      else { v[t * 128 + f] = bf2f(src[1024 + f]); v[t * 128 + f + 64] = bf2f(src[1024 + f + 64]); } }
    __syncthreads();
    if (wid == 0) { const int pi = lane >> 4, pj = (lane >> 2) & 3, part = lane & 3; float s = 0.f;
        for (int d = part * 32; d < part * 32 + 32; ++d) s += q[pi * 128 + d] * k[pj * 128 + d];
        s = quad_sum(s); if (part == 0) Pm[pi * 4 + pj] = pi >= pj ? s * exp2f(lg2 * (float)(pi - pj)) : 0.f; }
    { const int e = tid & 127, dg = tid >> 7; const float c4 = exp2f(lg2 * 4.0f), g3 = exp2f(lg2 * 3.0f), g2_ = exp2f(lg2 * 2.0f), g1 = exp2f(lg2);
      const float v0 = v[e] * g3, v1 = v[128 + e] * g2_, v2 = v[256 + e] * g1, v3 = v[384 + e];
      const float* S0 = P.state_ret + ((size_t)(b * 4 + h) * 128) * 128 + e; float* So = P.out + O_RTS + ((size_t)(b * 4 + h) * 128) * 128 + e;
      float a0 = 0.f, a1 = 0.f, a2 = 0.f, a3 = 0.f;
      float sv[32];
#pragma unroll
      for (int x = 0; x < 32; ++x) sv[x] = S0[(size_t)(dg * 32 + x) * 128];
#pragma unroll
      for (int x = 0; x < 32; ++x) { const int d = dg * 32 + x; const float s = sv[x];
          a0 = fmaf(q[d], s, a0); a1 = fmaf(q[128 + d], s, a1); a2 = fmaf(q[256 + d], s, a2); a3 = fmaf(q[384 + d], s, a3);
          So[(size_t)d * 128] = s * c4 + k[d] * v0 + k[128 + d] * v1 + k[256 + d] * v2 + k[384 + d] * v3; }
      y2p[(dg * 4 + 0) * 128 + e] = a0; y2p[(dg * 4 + 1) * 128 + e] = a1; y2p[(dg * 4 + 2) * 128 + e] = a2; y2p[(dg * 4 + 3) * 128 + e] = a3; }
    __syncthreads();
    { const int i = tid >> 7, e = tid & 127;
      float y = (y2p[(0 + i) * 128 + e] + y2p[(4 + i) * 128 + e] + y2p[(8 + i) * 128 + e] + y2p[(12 + i) * 128 + e]) * exp2f(lg2 * (float)(i + 1));
#pragma unroll
      for (int j = 0; j < 4; ++j) y = fmaf(Pm[i * 4 + j], v[j * 128 + e], y);
      float s = wave_sum(y); if (lane == 0) red[wid] = s; __syncthreads();
      const float mean = (red[i * 2] + red[i * 2 + 1]) * (1.0f / 128.0f); const float dlt = y - mean;
      float s2 = wave_sum(dlt * dlt); if (lane == 0) red[8 + wid] = s2; __syncthreads();
      const float var = (red[8 + i * 2] + red[8 + i * 2 + 1]) * (1.0f / 128.0f);
      const float g = bf2f(PS[(size_t)(row0 + i) * NCOLS + 1792 + 1536 + h * 128 + e]);
      const float o = dlt * rsqrtf(var + 1e-5f) * P.gn_w[h * 128 + e] * (g * __builtin_amdgcn_rcpf(1.0f + __expf(-g)));
      Y[(size_t)(row0 + i) * 1024 + 512 + h * 128 + e] = f2bf(o); }
    __syncthreads();
}

__device__ __forceinline__ bf16_t* kvb_ptr(unsigned char* ws, int bh) { return (bf16_t*)(bh < 29 ? ws + WS_LA + (size_t)bh * 524288 : ws + WS_WIN + 17301504 + (size_t)(bh - 29) * 524288); }
constexpr int RS = 136, BUFE = 128 * RS;

template <bool WITH_K>
__device__ __forceinline__ void ret_load_qk(PR P, LAS bf16_t* QP, LAS bf16_t* KB, unsigned (&kth)[4][4], const int tidv, const int row0, const int n, const int h, const float kd0, const float g32) {
    const bf16_t* PS = (const bf16_t*)(P.ws + WS_BIG); const float* rc = (const float*)(P.ws + WS_ROPE); const float* rs = rc + 2052 * 64;
    float kd = kd0;
#pragma unroll
    for (int it = 0; it < 4; ++it) { const int idx = it * 512 + tidv, i = idx >> 4, f = (idx & 15) * 4;
        const bf16_t* src = PS + (size_t)(row0 + i) * NCOLS + 1792 + h * 128;
        const u32x2 q1 = *(const u32x2*)(src + f), q2 = *(const u32x2*)(src + 64 + f);
        u32x2 k1 = (u32x2){0u, 0u}, k2 = k1; if (WITH_K) { k1 = *(const u32x2*)(src + 512 + f); k2 = *(const u32x2*)(src + 576 + f); }
        const float4 cs = *(const float4*)(rc + (size_t)(n * 128 + i) * 64 + f), sn = *(const float4*)(rs + (size_t)(n * 128 + i) * 64 + f);
        const float c4[4] = {cs.x, cs.y, cs.z, cs.w}, s4[4] = {sn.x, sn.y, sn.z, sn.w};
        const float qa[4] = {lo_bf(q1.x), hi_bf(q1.x), lo_bf(q1.y), hi_bf(q1.y)}, qb[4] = {lo_bf(q2.x), hi_bf(q2.x), lo_bf(q2.y), hi_bf(q2.y)};
        float qo1[4], qo2[4];
#pragma unroll
        for (int x = 0; x < 4; ++x) { qo1[x] = qa[x] * c4[x] - qb[x] * s4[x]; qo2[x] = qa[x] * s4[x] + qb[x] * c4[x]; }
        u32x2 w; w.x = pg8::cvt_pk_bf16(qo1[0], qo1[1]); w.y = pg8::cvt_pk_bf16(qo1[2], qo1[3]); *(LAS u32x2*)(QP + i * RS + f) = w;
        w.x = pg8::cvt_pk_bf16(qo2[0], qo2[1]); w.y = pg8::cvt_pk_bf16(qo2[2], qo2[3]); *(LAS u32x2*)(QP + i * RS + 64 + f) = w;
        if (WITH_K) {
            const float ka[4] = {lo_bf(k1.x), hi_bf(k1.x), lo_bf(k1.y), hi_bf(k1.y)}, kb[4] = {lo_bf(k2.x), hi_bf(k2.x), lo_bf(k2.y), hi_bf(k2.y)};
            float ko1[4], ko2[4];
#pragma unroll
            for (int x = 0; x < 4; ++x) { ko1[x] = (ka[x] * c4[x] - kb[x] * s4[x]) * 0.08838834764831845f; ko2[x] = (ka[x] * s4[x] + kb[x] * c4[x]) * 0.08838834764831845f; }
            w.x = pg8::cvt_pk_bf16(ko1[0], ko1[1]); w.y = pg8::cvt_pk_bf16(ko1[2], ko1[3]); *(LAS u32x2*)(KB + i * RS + f) = w;
            w.x = pg8::cvt_pk_bf16(ko2[0], ko2[1]); w.y = pg8::cvt_pk_bf16(ko2[2], ko2[3]); *(LAS u32x2*)(KB + i * RS + 64 + f) = w;
            kth[it][0] = pg8::cvt_pk_bf16(ko1[0] * kd, ko1[1] * kd); kth[it][1] = pg8::cvt_pk_bf16(ko1[2] * kd, ko1[3] * kd);
            kth[it][2] = pg8::cvt_pk_bf16(ko2[0] * kd, ko2[1] * kd); kth[it][3] = pg8::cvt_pk_bf16(ko2[2] * kd, ko2[3] * kd); kd *= g32; }
        if (it & 1) __builtin_amdgcn_sched_barrier(0); }
}

__device__ __forceinline__ void ret_unit_a(PR P, LAS unsigned char* lds, const int bh, const int n, const int wv) {
    LAS bf16_t* QP = (LAS bf16_t*)lds; LAS bf16_t* KB = QP + BUFE; LAS bf16_t* VT = KB + BUFE;
    const int tid = fresh_tid(wv), lane = tid & 63, wid = tid >> 6, wr = wid >> 1, wc = wid & 1, fr = lane & 15, fq = lane >> 4;
    const int b = bh >> 2, h = bh & 3;
    const bf16_t* PS = (const bf16_t*)(P.ws + WS_BIG); bf16_t* Y = (bf16_t*)(P.ws + WS_XN); bf16_t* KVB = kvb_ptr(P.ws, bh) + (size_t)n * 16384;
    const float lg2 = log2f(1.0f - exp2f(-5.0f - (float)h));
    const float kd0 = exp2f(lg2 * (float)(127 - (tid >> 4))), g32 = exp2f(-32.0f * lg2);
    const int row0 = b * 2048 + n * 128;
    unsigned kth[4][4];
    ret_load_qk<true>(P, QP, KB, kth, tid, row0, n, h, kd0, g32);
#pragma unroll
    for (int it = 0; it < 4; ++it) { const int idx = it * 512 + tid, j = idx >> 4, e = (idx & 15) * 8;
        const u32x4 vv = *(const u32x4*)(PS + (size_t)(row0 + j) * NCOLS + 1792 + 1024 + h * 128 + e);
        LAS bf16_t* d = VT + e * RS + j;
        d[0] = (bf16_t)(vv.x & 0xffffu); d[RS] = (bf16_t)(vv.x >> 16); d[2 * RS] = (bf16_t)(vv.y & 0xffffu); d[3 * RS] = (bf16_t)(vv.y >> 16);
        d[4 * RS] = (bf16_t)(vv.z & 0xffffu); d[5 * RS] = (bf16_t)(vv.z >> 16); d[6 * RS] = (bf16_t)(vv.w & 0xffffu); d[7 * RS] = (bf16_t)(vv.w >> 16); }
    __syncthreads();
    f32x4 accP[2][4];
#pragma unroll
    for (int mt = 0; mt < 2; ++mt)
#pragma unroll
        for (int nt = 0; nt < 4; ++nt) accP[mt][nt] = (f32x4){0.f, 0.f, 0.f, 0.f};
#pragma unroll
    for (int ks = 0; ks < 4; ++ks) { bf16x8 aq[2];
#pragma unroll
        for (int mt = 0; mt < 2; ++mt) aq[mt] = *(const LAS bf16x8*)(QP + (wr * 32 + mt * 16 + fr) * RS + ks * 32 + fq * 8);
#pragma unroll
        for (int nt = 0; nt < 4; ++nt) { const bf16x8 bk = *(const LAS bf16x8*)(KB + (wc * 64 + nt * 16 + fr) * RS + ks * 32 + fq * 8);
#pragma unroll
            for (int mt = 0; mt < 2; ++mt) accP[mt][nt] = __builtin_amdgcn_mfma_f32_16x16x32_bf16(aq[mt], bk, accP[mt][nt], 0, 0, 0); }
        __builtin_amdgcn_sched_barrier(0); }
    __syncthreads();
    { float ri[2][4], cj[4];
#pragma unroll
      for (int mt = 0; mt < 2; ++mt)
#pragma unroll
          for (int j = 0; j < 4; ++j) ri[mt][j] = exp2f(lg2 * (float)(wr * 32 + mt * 16 + fq * 4 + j));
#pragma unroll
      for (int nt = 0; nt < 4; ++nt) cj[nt] = exp2f(-lg2 * (float)(wc * 64 + nt * 16 + fr));
#pragma unroll
      for (int mt = 0; mt < 2; ++mt)
#pragma unroll
          for (int nt = 0; nt < 4; ++nt)
#pragma unroll
              for (int j = 0; j < 4; ++j) { const int i = wr * 32 + mt * 16 + fq * 4 + j, jj = wc * 64 + nt * 16 + fr;
                  const float val = i >= jj ? accP[mt][nt][j] * ri[mt][j] * cj[nt] : 0.f; QP[i * RS + jj] = f2bf(val); } }
#pragma unroll
    for (int it = 0; it < 4; ++it) { const int idx = it * 512 + tid, j = idx >> 4, f = (idx & 15) * 4; LAS bf16_t* d = KB + f * RS + j;
        d[0] = (bf16_t)(kth[it][0] & 0xffffu); d[RS] = (bf16_t)(kth[it][0] >> 16); d[2 * RS] = (bf16_t)(kth[it][1] & 0xffffu); d[3 * RS] = (bf16_t)(kth[it][1] >> 16);
        LAS bf16_t* d2 = d + 64 * RS;
        d2[0] = (bf16_t)(kth[it][2] & 0xffffu); d2[RS] = (bf16_t)(kth[it][2] >> 16); d2[2 * RS] = (bf16_t)(kth[it][3] & 0xffffu); d2[3 * RS] = (bf16_t)(kth[it][3] >> 16); }
    __syncthreads();
    f32x4 accY[2][4], accS[2][4];
#pragma unroll
    for (int mt = 0; mt < 2; ++mt)
#pragma unroll
        for (int nt = 0; nt < 4; ++nt) { accY[mt][nt] = (f32x4){0.f, 0.f, 0.f, 0.f}; accS[mt][nt] = (f32x4){0.f, 0.f, 0.f, 0.f}; }
#pragma unroll
    for (int ks = 0; ks < 4; ++ks) { bf16x8 ap[2], av[2];
#pragma unroll
        for (int mt = 0; mt < 2; ++mt) { ap[mt] = *(const LAS bf16x8*)(QP + (wr * 32 + mt * 16 + fr) * RS + ks * 32 + fq * 8); av[mt] = *(const LAS bf16x8*)(VT + (wr * 32 + mt * 16 + fr) * RS + ks * 32 + fq * 8); }
#pragma unroll
        for (int nt = 0; nt < 4; ++nt) { const bf16x8 bv = *(const LAS bf16x8*)(VT + (wc * 64 + nt * 16 + fr) * RS + ks * 32 + fq * 8), bkt = *(const LAS bf16x8*)(KB + (wc * 64 + nt * 16 + fr) * RS + ks * 32 + fq * 8);
#pragma unroll
            for (int mt = 0; mt < 2; ++mt) { accY[mt][nt] = __builtin_amdgcn_mfma_f32_16x16x32_bf16(ap[mt], bv, accY[mt][nt], 0, 0, 0); accS[mt][nt] = __builtin_amdgcn_mfma_f32_16x16x32_bf16(av[mt], bkt, accS[mt][nt], 0, 0, 0); } }
        __builtin_amdgcn_sched_barrier(0); }
#pragma unroll
    for (int mt = 0; mt < 2; ++mt)
#pragma unroll
        for (int nt = 0; nt < 4; ++nt)
#pragma unroll
            for (int j = 0; j < 4; ++j) { const int r = wr * 32 + mt * 16 + fq * 4 + j, c = wc * 64 + nt * 16 + fr;
                Y[(size_t)(row0 + r) * 1024 + 512 + h * 128 + c] = f2bf(accY[mt][nt][j]); KVB[r * 128 + c] = f2bf(accS[mt][nt][j]); }
    __syncthreads();
}

__device__ __forceinline__ void ret_prefix(PR P, const int item) {
    const int bh = item >> 11, i8 = (item & 2047) * 8; const int h = bh & 3;
    bf16_t* KVB = kvb_ptr(P.ws, bh) + i8;
    const float lg2 = log2f(1.0f - exp2f(-5.0f - (float)h)); const float c_dec = exp2f(lg2 * 128.0f);
    u32x4 kv[16];
#pragma unroll
    for (int n = 0; n < 16; ++n) kv[n] = *(const u32x4*)(KVB + (size_t)n * 16384);
    float S[8];
#pragma unroll
    for (int x = 0; x < 8; ++x) S[x] = 0.f;
#pragma unroll
    for (int n = 0; n < 16; ++n) { u32x4 w; w.x = pg8::cvt_pk_bf16(S[0], S[1]); w.y = pg8::cvt_pk_bf16(S[2], S[3]); w.z = pg8::cvt_pk_bf16(S[4], S[5]); w.w = pg8::cvt_pk_bf16(S[6], S[7]);
        *(u32x4*)(KVB + (size_t)n * 16384) = w;
        const float k8[8] = {lo_bf(kv[n].x), hi_bf(kv[n].x), lo_bf(kv[n].y), hi_bf(kv[n].y), lo_bf(kv[n].z), hi_bf(kv[n].z), lo_bf(kv[n].w), hi_bf(kv[n].w)};
#pragma unroll
        for (int x = 0; x < 8; ++x) S[x] = S[x] * c_dec + k8[x]; }
    const int e = i8 >> 7, d0 = i8 & 127;
#pragma unroll
    for (int x = 0; x < 8; ++x) P.out[O_RTP + ((size_t)bh * 128 + d0 + x) * 128 + e] = S[x];
}

__device__ __forceinline__ void ret_unit_c(PR P, LAS unsigned char* lds, const int bh, const int n, const int wv) {
    LAS bf16_t* QP = (LAS bf16_t*)lds; LAS bf16_t* ST = QP + 3 * BUFE; LAS float* YST = (LAS float*)(QP + BUFE);
    const int tid = fresh_tid(wv), lane = tid & 63, wid = tid >> 6, wr = wid >> 1, wc = wid & 1, fr = lane & 15, fq = lane >> 4;
    const int b = bh >> 2, h = bh & 3;
    const bf16_t* PS = (const bf16_t*)(P.ws + WS_BIG); bf16_t* Y = (bf16_t*)(P.ws + WS_XN); const bf16_t* KVB = kvb_ptr(P.ws, bh) + (size_t)n * 16384;
    const float lg2 = log2f(1.0f - exp2f(-5.0f - (float)h));
    const int row0 = b * 2048 + n * 128;
    unsigned kth[4][4];
    ret_load_qk<false>(P, QP, QP, kth, tid, row0, n, h, 0.f, 0.f);
#pragma unroll
    for (int it = 0; it < 4; ++it) { const int idx = it * 512 + tid, e = idx >> 4, d8 = (idx & 15) * 8;
        *(LAS u32x4*)(ST + e * RS + d8) = *(const u32x4*)(KVB + e * 128 + d8); }
    __syncthreads();
    f32x4 accY[2][4];
#pragma unroll
    for (int mt = 0; mt < 2; ++mt)
#pragma unroll
        for (int nt = 0; nt < 4; ++nt) accY[mt][nt] = (f32x4){0.f, 0.f, 0.f, 0.f};
#pragma unroll
    for (int ks = 0; ks < 4; ++ks) { bf16x8 aq[2];
#pragma unroll
        for (int mt = 0; mt < 2; ++mt) aq[mt] = *(const LAS bf16x8*)(QP + (wr * 32 + mt * 16 + fr) * RS + ks * 32 + fq * 8);
#pragma unroll
        for (int nt = 0; nt < 4; ++nt) { const bf16x8 bs = *(const LAS bf16x8*)(ST + (wc * 64 + nt * 16 + fr) * RS + ks * 32 + fq * 8);
#pragma unroll
            for (int mt = 0; mt < 2; ++mt) accY[mt][nt] = __builtin_amdgcn_mfma_f32_16x16x32_bf16(aq[mt], bs, accY[mt][nt], 0, 0, 0); }
        __builtin_amdgcn_sched_barrier(0); }
#pragma unroll
    for (int mt = 0; mt < 2; ++mt)
#pragma unroll
        for (int j = 0; j < 4; ++j) { const int r = wr * 32 + mt * 16 + fq * 4 + j; const float qd = exp2f(lg2 * (float)(r + 1));
#pragma unroll
            for (int nt = 0; nt < 4; ++nt) YST[r * 132 + wc * 64 + nt * 16 + fr] = accY[mt][nt][j] * qd; }
    __syncthreads();
    { const int i = tid >> 2, part = tid & 3; float yv[32]; float s = 0.f;
      bf16_t* yo = Y + (size_t)(row0 + i) * 1024 + 512 + h * 128 + part * 32;
#pragma unroll
      for (int x = 0; x < 4; ++x) { const u32x4 y1 = *(const u32x4*)(yo + x * 8); const f32x4 ta = *(const LAS f32x4*)(YST + i * 132 + part * 32 + x * 8), tb = *(const LAS f32x4*)(YST + i * 132 + part * 32 + x * 8 + 4);
          yv[x * 8 + 0] = ta[0] + lo_bf(y1.x); yv[x * 8 + 1] = ta[1] + hi_bf(y1.x); yv[x * 8 + 2] = ta[2] + lo_bf(y1.y); yv[x * 8 + 3] = ta[3] + hi_bf(y1.y);
          yv[x * 8 + 4] = tb[0] + lo_bf(y1.z); yv[x * 8 + 5] = tb[1] + hi_bf(y1.z); yv[x * 8 + 6] = tb[2] + lo_bf(y1.w); yv[x * 8 + 7] = tb[3] + hi_bf(y1.w); }
#pragma unroll
      for (int x = 0; x < 32; ++x) s += yv[x];
      s = quad_sum(s); const float mean = s * (1.0f / 128.0f); float s2 = 0.f;
#pragma unroll
      for (int x = 0; x < 32; ++x) { yv[x] -= mean; s2 += yv[x] * yv[x]; }
      s2 = quad_sum(s2); const float rstd = rsqrtf(s2 * (1.0f / 128.0f) + 1e-5f);
      const bf16_t* gp = PS + (size_t)(row0 + i) * NCOLS + 1792 + 1536 + h * 128 + part * 32; const float* gw = P.gn_w + h * 128 + part * 32;
#pragma unroll
      for (int x = 0; x < 4; ++x) { const u32x4 g4 = *(const u32x4*)(gp + x * 8); const float4 w0 = *(const float4*)(gw + x * 8), w1 = *(const float4*)(gw + x * 8 + 4);
          const float gg[8] = {lo_bf(g4.x), hi_bf(g4.x), lo_bf(g4.y), hi_bf(g4.y), lo_bf(g4.z), hi_bf(g4.z), lo_bf(g4.w), hi_bf(g4.w)}; const float ww[8] = {w0.x, w0.y, w0.z, w0.w, w1.x, w1.y, w1.z, w1.w};
          float o[8];
#pragma unroll
          for (int z = 0; z < 8; ++z) o[z] = yv[x * 8 + z] * rstd * ww[z] * (gg[z] * __builtin_amdgcn_rcpf(1.0f + __expf(-gg[z])));
          u32x4 w; w.x = pg8::cvt_pk_bf16(o[0], o[1]); w.y = pg8::cvt_pk_bf16(o[2], o[3]); w.z = pg8::cvt_pk_bf16(o[4], o[5]); w.w = pg8::cvt_pk_bf16(o[6], o[7]);
          *(u32x4*)(yo + x * 8) = w; } }
    __syncthreads();
}

__device__ __forceinline__ void sub_barrier(unsigned* cnt, const unsigned target, const int wv) {
    asm volatile("s_waitcnt vmcnt(0)" ::: "memory");
    __syncthreads();
    if (fresh_tid(wv) == 0) {
        __builtin_amdgcn_fence(__ATOMIC_RELEASE, "agent");
        asm volatile("s_waitcnt vmcnt(0)" ::: "memory");
        (void)xb_add(cnt, 1u);
        unsigned sp = 0u;
        while (xb_ld(cnt) < target) { __builtin_amdgcn_s_sleep(2); if (++sp > (1u << 20)) break; }
        __builtin_amdgcn_fence(__ATOMIC_ACQUIRE, "agent");
        asm volatile("s_waitcnt vmcnt(0)" ::: "memory");
    }
    __syncthreads();
}

struct PostRegs { u32x2 yr, c_r, c_k, c_v, p_r, p_k, p_v, ar, gr; };
__device__ __forceinline__ void post_load(PR P, PostRegs& R, const int row, const int ch) {
    const bf16_t* PS = (const bf16_t*)(P.ws + WS_BIG); const bf16_t* ASIG = (const bf16_t*)(P.ws + WS_ASIG); const bf16_t* YS = (const bf16_t*)(P.ws + WS_YS); const bf16_t* G = (const bf16_t*)(P.ws + WS_WIN);
    R.yr = *(const u32x2*)(YS + (size_t)row * 512 + ch);
    const bf16_t* cp = PS + (size_t)row * NCOLS + ch; const int pr = prev_row(row);
    R.c_r = *(const u32x2*)cp; R.c_k = *(const u32x2*)(cp + 512); R.c_v = *(const u32x2*)(cp + 1024);
    R.p_r = (u32x2){0u, 0u}; R.p_k = R.p_r; R.p_v = R.p_r;
    if (pr >= 0) { const bf16_t* pp = PS + (size_t)pr * NCOLS + ch; R.p_r = *(const u32x2*)pp; R.p_k = *(const u32x2*)(pp + 512); R.p_v = *(const u32x2*)(pp + 1024); }
    R.ar = *(const u32x2*)(ASIG + (size_t)row * 512 + ch); R.gr = *(const u32x2*)(G + (size_t)row * 512 + ch);
}
__device__ __forceinline__ void rwkv_post(PR P, const int wv) {
    const int tid = fresh_tid(wv); const int lane = tid & 63; const int gw = blockIdx.x * 8 + (tid >> 6), nw = gridDim.x * 8;
    const int sub = lane >> 4, cg4 = (lane & 15) * 4;
    bf16_t* Y = (bf16_t*)(P.ws + WS_XN);
    const int h = (gw * 4 + sub) & 7, ch = h * 64 + cg4;
    const float4 mr = *(const float4*)(P.mu + ch), mk = *(const float4*)(P.mu + 512 + ch), mv = *(const float4*)(P.mu + 1024 + ch);
    const float4 ka = *(const float4*)(P.k_a + ch), rk = *(const float4*)(P.r_k + ch), lw = *(const float4*)(P.lnx_w + ch), lb = *(const float4*)(P.lnx_b + ch);
    const float m_r[4] = {mr.x, mr.y, mr.z, mr.w}, m_k[4] = {mk.x, mk.y, mk.z, mk.w}, m_v[4] = {mv.x, mv.y, mv.z, mv.w};
    const float kaa[4] = {ka.x, ka.y, ka.z, ka.w}, rkk[4] = {rk.x, rk.y, rk.z, rk.w}, lww[4] = {lw.x, lw.y, lw.z, lw.w}, lbb[4] = {lb.x, lb.y, lb.z, lb.w};
    PostRegs R, N;
    if (gw < MT * 2) post_load(P, R, (gw * 4 + sub) >> 3, ch);
    for (int task = gw; task < MT * 2; task += nw) {
        const int row = (task * 4 + sub) >> 3;
        if (task + nw < MT * 2) post_load(P, N, ((task + nw) * 4 + sub) >> 3, ch);
        const float ys[4] = {lo_bf(R.yr.x), hi_bf(R.yr.x), lo_bf(R.yr.y), hi_bf(R.yr.y)};
        const float mean = row16_sum(ys[0] + ys[1] + ys[2] + ys[3]) * (1.0f / 64.0f);
        float dl[4], s2 = 0.f;
#pragma unroll
        for (int j = 0; j < 4; ++j) { dl[j] = ys[j] - mean; s2 += dl[j] * dl[j]; }
        const float rstd = rsqrtf(row16_sum(s2) * (1.0f / 64.0f) + 64e-5f);
        const float cr[4] = {lo_bf(R.c_r.x), hi_bf(R.c_r.x), lo_bf(R.c_r.y), hi_bf(R.c_r.y)}, ck[4] = {lo_bf(R.c_k.x), hi_bf(R.c_k.x), lo_bf(R.c_k.y), hi_bf(R.c_k.y)}, cv[4] = {lo_bf(R.c_v.x), hi_bf(R.c_v.x), lo_bf(R.c_v.y), hi_bf(R.c_v.y)};
        const float qr[4] = {lo_bf(R.p_r.x), hi_bf(R.p_r.x), lo_bf(R.p_r.y), hi_bf(R.p_r.y)}, qk[4] = {lo_bf(R.p_k.x), hi_bf(R.p_k.x), lo_bf(R.p_k.y), hi_bf(R.p_k.y)}, qv[4] = {lo_bf(R.p_v.x), hi_bf(R.p_v.x), lo_bf(R.p_v.y), hi_bf(R.p_v.y)};
        const float aa[4] = {lo_bf(R.ar.x), hi_bf(R.ar.x), lo_bf(R.ar.y), hi_bf(R.ar.y)}, gg[4] = {lo_bf(R.gr.x), hi_bf(R.gr.x), lo_bf(R.gr.y), hi_bf(R.gr.y)};
        float v[4], bp = 0.f;
#pragma unroll
        for (int j = 0; j < 4; ++j) { const float r = cr[j] + (qr[j] - cr[j]) * m_r[j], k = ck[j] + (qk[j] - ck[j]) * m_k[j]; v[j] = cv[j] + (qv[j] - cv[j]) * m_v[j];
            const float kn = k * (1.0f + (aa[j] - 1.0f) * kaa[j]); bp += r * kn * rkk[j]; }
        const float bonus = row16_sum(bp);
        float o[4];
#pragma unroll
        for (int j = 0; j < 4; ++j) o[j] = (dl[j] * rstd * lww[j] + lbb[j] + bonus * v[j]) * gg[j];
        u32x2 w; w.x = pg8::cvt_pk_bf16(o[0], o[1]); w.y = pg8::cvt_pk_bf16(o[2], o[3]);
        *(u32x2*)(Y + (size_t)row * 1024 + ch) = w;
        R = N;
    }
}

__global__ void __launch_bounds__(512, 2) hymba_mega(Params P_unused) {
    extern __shared__ __attribute__((aligned(16))) unsigned char shm[];
    cg::grid_group grid = cg::this_grid();
    LAS unsigned char* lds = (LAS unsigned char*)shm; LAS float* ldsf = (LAS float*)shm;
    const int G = gridDim.x, bx = blockIdx.x;
    const int wv = __builtin_amdgcn_readfirstlane(threadIdx.x >> 6);
    const CAS Params* kp = (const CAS Params*)__builtin_amdgcn_kernarg_segment_ptr();
#define P (*kp)
#define FRESH() asm volatile("" : "+s"(kp))
#ifndef REP_SYNC
#define REP_SYNC 1
#endif
#ifndef REP_P7
#define REP_P7 1
#endif
#ifndef REP_FFN1
#define REP_FFN1 1
#endif
#ifndef REP_P0
#define REP_P0 1
#endif
#ifndef REP_P3
#define REP_P3 1
#endif
#ifndef REP_RW
#define REP_RW 1
#endif
#ifndef REP_OTH
#define REP_OTH 1
#endif
#ifndef REP_RETP
#define REP_RETP 1
#endif
#ifndef REP_SAMP
#define REP_SAMP 1
#endif
#ifndef REP_P8
#define REP_P8 1
#endif
#define GSYNC() do { for (int r_ = 0; r_ < REP_SYNC; ++r_) xcd_barrier((unsigned*)ws, (volatile LAS unsigned*)(lds + LDS_BYTES - 16), wv); FRESH(); } while (0)
#define ws (kp->ws)
#define XN ((bf16_t*)(ws + WS_XN))
#define ACT ((bf16_t*)(ws + WS_BIG))
#define FO ((float*)(ws + WS_FO))
#define PS ((bf16_t*)(ws + WS_BIG))
    pg8::StaticOrder S;
    { unsigned* barw = (unsigned*)ws; const int t0 = fresh_tid(wv); if (bx == 0) for (int i = t0; i < XCD_BAR_WORDS + 128; i += 512) barw[i] = 0u;
      if (t0 < 4) ((LAS unsigned*)(lds + LDS_BYTES - 16))[t0] = 0u; }
#ifndef PHM
#define PHM 0xFFFF
#endif
#define PH(k) if ((PHM >> (k)) & 1)
    for (int r0 = 0; r0 < REP_P0; ++r0) PH(0) p0_prologue(P, ldsf, wv);
    grid.sync(); FRESH();
    if (fresh_tid(wv) == 0) (void)xb_add(&((unsigned*)ws)[XB_XCNT(xb_xcc_id())], 1u);
    for (int rep1 = 0; rep1 < REP_FFN1; ++rep1) {
    PH(1) { pg8::Gemm g{XN, (const bf16_t*)(ws + WS_WGU), MT, NGU, 1024}; S.init(MT, NGU, G, bx, 1024); pg8::EpiSwiGLU E{ACT, DFF}; pg8::gemm_phase(lds, g, S, E, wv); }
    GSYNC();
    PH(2) { pg8::Gemm g{ACT, (const bf16_t*)(ws + WS_WD), MT, 1024, DFF}; pg8::SplitOrder S2; S2.init2(G, bx, DFF, 8); pg8::EpiFO E{(bf16_t*)FO, 1024, (float*)(ws + WS_OMD)}; pg8::gemm_phase(lds, g, S2, E, wv); }
    GSYNC();
    }
    for (int r3 = 0; r3 < REP_P3; ++r3) PH(3) rows_phase(P, 1, wv);
    GSYNC();
    PH(4) { pg8::Gemm g{XN, (const bf16_t*)(ws + WS_WIN), MIN_, NCOLS, 1024}; S.init(MIN_, NCOLS, G, bx, 1024); pg8::EpiBf16 E{PS, NCOLS}; pg8::gemm_phase(lds, g, S, E, wv); }
    GSYNC();
    PH(5) lora_prep(P, wv);
    GSYNC();
    PH(6) { pg8::Gemm g{(const bf16_t*)(ws + WS_LA), (const bf16_t*)(ws + WS_WL), MT, 1536, 256}; S.init(MT, 1536, G, bx, 256);
      pg8::EpiLora E{(bf16_t*)(ws + WS_OMD), (bf16_t*)(ws + WS_ASIG), (bf16_t*)(ws + WS_WIN), P.w0, P.a0}; pg8::gemm_phase(lds, g, S, E, wv); }
    GSYNC();
    {
    if (bx < 128) { for (int rw = 0; rw < REP_RW; ++rw) rwkv_unit<false>(P, ldsf, bx >> 4, (bx >> 1) & 7, bx & 1, wv); }
    else for (int rep7 = 0; rep7 < REP_OTH; ++rep7) { const int ob = bx - 128; unsigned* sbc = (unsigned*)ws + XCD_BAR_WORDS + 64;
        for (int k = 0; k < 4; ++k) { const int u = ob + k * 128; ret_unit_a(P, lds, u >> 4, u & 15, wv); }
        sub_barrier(sbc, 128u * (2u * rep7 + 1u), wv);
        ret_prefix(P, ob * 512 + fresh_tid(wv));
        sub_barrier(sbc, 128u * (2u * rep7 + 2u), wv);
        for (int k = 0; k < 4; ++k) { const int u = ob + k * 128; ret_unit_c(P, lds, u >> 4, u & 15, wv); }
        for (int u = ob; u < 2560; u += 128) { if (u < 2048) rwkv_unit<true>(P, ldsf, u >> 4, (u >> 1) & 7, u & 1, wv); else ret_sample_unit(P, ldsf, (u - 2048) >> 2, (u - 2048) & 3, wv); }
    }
    }
    GSYNC();
    for (int rep8 = 0; rep8 < REP_P8; ++rep8) PH(8) rwkv_post(P, wv);
    GSYNC();
    PH(9) { pg8::Gemm g{XN, (const bf16_t*)(ws + WS_WOUT), MT, 1024, 1024}; pg8::SplitOrder S2; S2.init2(G, bx, 1024, 4); pg8::EpiFO E{(bf16_t*)FO, 1024, (float*)(ws + WS_OMD)}; pg8::gemm_phase(lds, g, S2, E, wv); }
    GSYNC();
    PH(10) { tconv_list(P.f2g, P.f2u, P.f2d, nullptr, nullptr, ws, 2112, ldsf, wv);
    rows_phase(P, 2, wv); }
    GSYNC();
    PH(11) { pg8::Gemm g{XN, (const bf16_t*)(ws + WS_WGU), MT, NGU, 1024}; S.init(MT, NGU, G, bx, 1024); pg8::EpiSwiGLU E{ACT, DFF}; pg8::gemm_phase(lds, g, S, E, wv); }
    GSYNC();
    PH(12) { pg8::Gemm g{ACT, (const bf16_t*)(ws + WS_WD), MT, 1024, DFF}; pg8::SplitOrder S2; S2.init2(G, bx, DFF, 8); pg8::EpiFO E{(bf16_t*)FO, 1024, (float*)(ws + WS_OMD)}; pg8::gemm_phase(lds, g, S2, E, wv); }
    GSYNC();
    PH(13) rows_phase(P, 3, wv);
}

#undef ws
#undef XN
#undef ACT
#undef FO
#undef PS
#undef P
extern "C" void kernel_launch(void* const* d_in, const int* in_sizes, int n_in, void* d_out, int out_size, void* d_ws, size_t ws_size, hipStream_t stream) {
    static int grid = 0;
    if (grid == 0) {
        if (n_in != 26 || ws_size < WS_END) { fprintf(stderr, "kernel_launch: unexpected n_in %d or ws_size %zu (< %zu)\n", n_in, ws_size, (size_t)WS_END); grid = -1; return; }
        int dev = 0, cus = 0, per_cu = 0;
        hipGetDevice(&dev); hipDeviceGetAttribute(&cus, hipDeviceAttributeMultiprocessorCount, dev);
        hipFuncSetAttribute((const void*)hymba_mega, hipFuncAttributeMaxDynamicSharedMemorySize, LDS_BYTES);
        hipOccupancyMaxActiveBlocksPerMultiprocessor(&per_cu, (const void*)hymba_mega, 512, LDS_BYTES);
        if (per_cu < 1) { fprintf(stderr, "kernel_launch: occupancy query says %d blocks/CU\n", per_cu); per_cu = 1; }
        grid = cus * per_cu; if (grid > 256) grid = 256;
        if (grid != 256) { fprintf(stderr, "kernel_launch: this kernel needs 256 co-resident workgroups, got %d\n", grid); grid = -1; return; }
        fprintf(stderr, "kernel_launch: cus %d per_cu %d grid %d ws %zu\n", cus, per_cu, grid, ws_size);
    }
    if (grid < 0) return;
    Params p{};
    const float** pp = (const float**)&p;
    for (int i = 0; i < 26; ++i) pp[i] = (const float*)d_in[i];
    p.out = (float*)d_out; p.ws = (unsigned char*)d_ws;
    void* args[] = {&p};
    hipError_t e = hipLaunchCooperativeKernel((const void*)hymba_mega, dim3(grid), dim3(512), args, LDS_BYTES, stream);
    if (e != hipSuccess) fprintf(stderr, "cooperative launch failed: %s (grid %d)\n", hipGetErrorString(e), grid);
}
```

```cpp
#include <hip/hip_runtime.h>
#include <hip/hip_cooperative_groups.h>
#include <cstdio>
#include <cstdint>
namespace cg = cooperative_groups;

__device__ __forceinline__ int fresh_tid(int wv) { int l; asm volatile("v_mbcnt_lo_u32_b32 %0, -1, 0\n\tv_mbcnt_hi_u32_b32 %0, -1, %0" : "=v"(l)); return wv * 64 + l; }
namespace pg8 {
#define PG8_LAS __attribute__((address_space(3)))
typedef unsigned short bf16_t;
typedef short bf16x8 __attribute__((ext_vector_type(8)));
typedef float f32x4 __attribute__((ext_vector_type(4)));
typedef unsigned u32x4 __attribute__((ext_vector_type(4)));
typedef unsigned u32x2 __attribute__((ext_vector_type(2)));
constexpr int BM = 256, BK = 64, HALF = 128, HTB = HALF * BK * 2, STAGE_BYTES = 8 * HTB, NXCD = 8, WGM = 8;

__host__ __device__ __forceinline__ int lds_byte(int r, int c) { const int st = (r >> 4) * 2 + (c >> 5), rr = r & 15, cc = c & 31, ob = rr * 64 + cc * 2; return st * 1024 + (ob ^ (((ob >> 9) & 1) << 5)); }
__host__ __device__ __forceinline__ void stage_rc(int b, int& R, int& C) { const int st = b / 1024, sb = b % 1024, swz = sb ^ (((sb >> 9) & 1) << 5); R = (st >> 1) * 16 + swz / 64; C = (st & 1) * 32 + (swz % 64) / 2; }
__host__ __device__ __forceinline__ int perm32(int rho) { const int n = rho >> 4, i = rho & 15; return 8 * (i >> 2) + 4 * n + (i & 3); }

struct Unit { int pm, pn, k0, nkt, atomic; };
struct Gemm { const bf16_t* A; const bf16_t* Bt; int M, N, K; };

struct StaticOrder {
    int nM, nN, nwg, G, c, nt;
    __host__ __device__ void init(int M, int N, int G_, int c_, int K) { nM = M / BM; nN = N / BM; nwg = nM * nN; G = G_; c = c_; nt = K / BK; }
    __host__ __device__ bool next(int i, Unit& u) const {
        const long L = (long)i * G + c; if (L >= nwg) return false;
        int wgid = (int)L; { const int q = nwg / NXCD, r = nwg % NXCD, xcd = wgid % NXCD, off = wgid / NXCD; wgid = (xcd < r ? xcd * (q + 1) : r * (q + 1) + (xcd - r) * q) + off; }
        const int nig = WGM * nN, gid = wgid / nig, fm = gid * WGM, gsz = (nM - fm) < WGM ? (nM - fm) : WGM;
        u.pm = fm + ((wgid % nig) % gsz); u.pn = (wgid % nig) / gsz; u.k0 = 0; u.nkt = nt; u.atomic = 0; return true;
    }
    __device__ __forceinline__ void a_ready(const Unit&) const {}
    __device__ __forceinline__ void done(const Unit&) const {}
};
struct LoraRestOrder {
    int ob;
    __host__ __device__ bool next(int i, Unit& u) const {
        const int L = i * 128 + ob; if (L >= 140) return false;
        if (L < 132) { u.pm = L >> 1; u.pn = 4 + (L & 1); } else { const int x = L - 132; u.pm = 64 + (x >> 2); u.pn = x & 3; }
        u.k0 = 0; u.nkt = 4; u.atomic = 0; return true;
    }
    __device__ __forceinline__ void a_ready(const Unit&) const {}
    __device__ __forceinline__ void done(const Unit&) const {}
};
struct SplitOrder : StaticOrder {
    int KS;
    __host__ __device__ void init2(int G_, int c_, int K, int KS_) { init(16384, 1024, G_, c_, K); KS = KS_; }
    __host__ __device__ bool next(int i, Unit& u) const {
        if (i == 0) return StaticOrder::next(0, u);
        if (i > 1 || c >= 8 * KS) return false;
        const int tile = c / KS, part = c % KS, pairs = nt / 2, q = pairs / KS, r = pairs % KS;
        u.pm = 64 + (tile >> 2); u.pn = tile & 3; u.k0 = 2 * (part * q + (part < r ? part : r)); u.nkt = 2 * (q + (part < r ? 1 : 0)); u.atomic = 1 + c; return true;
    }
};

typedef __bf16 bf16x2_t __attribute__((ext_vector_type(2)));
typedef float f32x2_t __attribute__((ext_vector_type(2)));
__device__ __forceinline__ unsigned cvt_pk_bf16(float lo, float hi) { const f32x2_t v = {lo, hi}; const bf16x2_t b = __builtin_convertvector(v, bf16x2_t); return __builtin_bit_cast(unsigned, b); }

struct EpiFO {
    static constexpr bool PERM = true;
    bf16_t* C; int ldc; float* slab;
    __device__ __forceinline__ void operator()(const f32x4 (&acc)[2][2][4][2], const Unit& u, int wr, int wc, int fr, int fq) const {
        if (u.atomic == 0) {
            const int row0 = u.pm * BM + wr * 64 + fr; const int col0 = u.pn * BM + wc * 32 + 8 * fq;
#pragma unroll
            for (int ai = 0; ai < 2; ++ai)
#pragma unroll
                for (int m = 0; m < 4; ++m) { bf16_t* rowp = C + (size_t)(row0 + ai * HALF + m * 16) * ldc + col0;
#pragma unroll
                    for (int bj = 0; bj < 2; ++bj) { const f32x4 v0 = acc[ai][bj][m][0], v1 = acc[ai][bj][m][1];
                        u32x4 w; w.x = cvt_pk_bf16(v0[0], v0[1]); w.y = cvt_pk_bf16(v0[2], v0[3]); w.z = cvt_pk_bf16(v1[0], v1[1]); w.w = cvt_pk_bf16(v1[2], v1[3]);
                        *(u32x4*)(rowp + bj * HALF) = w; } }
        } else {
            float* base = slab + (size_t)(u.atomic - 1) * (BM * BM) + (size_t)(wr * 64 + fr) * BM + wc * 32 + 8 * fq;
#pragma unroll
            for (int ai = 0; ai < 2; ++ai)
#pragma unroll
                for (int m = 0; m < 4; ++m) { float* rowp = base + (size_t)(ai * HALF + m * 16) * BM;
#pragma unroll
                    for (int bj = 0; bj < 2; ++bj) { *(f32x4*)(rowp + bj * HALF) = acc[ai][bj][m][0]; *(f32x4*)(rowp + bj * HALF + 4) = acc[ai][bj][m][1]; } }
        }
    }
};
struct EpiBf16 {
    static constexpr bool PERM = true;
    bf16_t* O; int ldc;
    __device__ __forceinline__ void operator()(const f32x4 (&acc)[2][2][4][2], const Unit& u, int wr, int wc, int fr, int fq) const {
        const int row0 = u.pm * BM + wr * 64 + fr; const int col0 = u.pn * BM + wc * 32 + 8 * fq;
#pragma unroll
        for (int ai = 0; ai < 2; ++ai)
#pragma unroll
            for (int m = 0; m < 4; ++m) { bf16_t* rowp = O + (size_t)(row0 + ai * HALF + m * 16) * ldc + col0;
#pragma unroll
                for (int bj = 0; bj < 2; ++bj) { const f32x4 v0 = acc[ai][bj][m][0], v1 = acc[ai][bj][m][1];
                    u32x4 w; w.x = cvt_pk_bf16(v0[0], v0[1]); w.y = cvt_pk_bf16(v0[2], v0[3]); w.z = cvt_pk_bf16(v1[0], v1[1]); w.w = cvt_pk_bf16(v1[2], v1[3]);
                    *(u32x4*)(rowp + bj * HALF) = w; } }
    }
};
__device__ __forceinline__ float silu_f(float x) { return x * __builtin_amdgcn_rcpf(1.0f + __expf(-x)); }
struct EpiSwiGLU {
    static constexpr bool PERM = true;
    bf16_t* O; int ldc;
    __device__ __forceinline__ void operator()(const f32x4 (&acc)[2][2][4][2], const Unit& u, int wr, int wc, int fr, int fq) const {
        const int row0 = u.pm * BM + wr * 64 + fr; const int col0 = u.pn * HALF + wc * 32 + 8 * fq;
#pragma unroll
        for (int ai = 0; ai < 2; ++ai)
#pragma unroll
            for (int m = 0; m < 4; ++m) { bf16_t* rowp = O + (size_t)(row0 + ai * HALF + m * 16) * ldc + col0;
                float o[8];
#pragma unroll
                for (int n = 0; n < 2; ++n)
#pragma unroll
                    for (int j = 0; j < 4; ++j) o[n * 4 + j] = silu_f(acc[ai][0][m][n][j]) * acc[ai][1][m][n][j];
                u32x4 w; w.x = cvt_pk_bf16(o[0], o[1]); w.y = cvt_pk_bf16(o[2], o[3]); w.z = cvt_pk_bf16(o[4], o[5]); w.w = cvt_pk_bf16(o[6], o[7]);
                *(u32x4*)rowp = w; }
    }
};
struct EpiLora {
    static constexpr bool PERM = true;
    bf16_t* OMD; bf16_t* ASIG; bf16_t* G; const float* w0; const float* a0;
    template <int KIND> __device__ __forceinline__ void body(const f32x4 (&acc)[2][2][4][2], bf16_t* O, const float* bias, int row0, int ch0) const {
#pragma unroll
        for (int bj = 0; bj < 2; ++bj)
#pragma unroll
            for (int ai = 0; ai < 2; ++ai)
#pragma unroll
                for (int m = 0; m < 4; ++m) { bf16_t* rowp = O + (size_t)(row0 + ai * HALF + m * 16) * 512 + ch0 + bj * HALF;
                    float o[8];
#pragma unroll
                    for (int n = 0; n < 2; ++n)
#pragma unroll
                        for (int j = 0; j < 4; ++j) { float v = acc[ai][bj][m][n][j];
                            if (KIND == 0) { v += bias[ch0 + bj * HALF + n * 4 + j]; const float e = 0.6065306597126334f * __builtin_amdgcn_rcpf(1.0f + __expf(-v));
                                float p = 1.0f / 40320.0f; p = -1.0f / 5040.0f + e * p; p = 1.0f / 720.0f + e * p; p = -1.0f / 120.0f + e * p; p = 1.0f / 24.0f + e * p; p = -1.0f / 6.0f + e * p; p = 0.5f + e * p; p = 1.0f - e * p;
                                v = e * p; }
                            else if (KIND == 1) { v += bias[ch0 + bj * HALF + n * 4 + j]; v = __builtin_amdgcn_rcpf(1.0f + __expf(-v)); }
                            o[n * 4 + j] = v; }
                    u32x4 w; w.x = cvt_pk_bf16(o[0], o[1]); w.y = cvt_pk_bf16(o[2], o[3]); w.z = cvt_pk_bf16(o[4], o[5]); w.w = cvt_pk_bf16(o[6], o[7]);
                    *(u32x4*)rowp = w; __builtin_amdgcn_sched_barrier(0); }
    }
    __device__ __forceinline__ void operator()(const f32x4 (&acc)[2][2][4][2], const Unit& u, int wr, int wc, int fr, int fq) const {
        const int kind = u.pn >> 1;
        const int row0 = u.pm * BM + wr * 64 + fr; const int ch0 = (u.pn & 1) * BM + wc * 32 + 8 * fq;
        if (kind == 0) body<0>(acc, OMD, w0, row0, ch0); else if (kind == 1) body<1>(acc, ASIG, a0, row0, ch0); else body<2>(acc, G, a0, row0, ch0);
    }
};

template <class Epi, class Sched>
__device__ __forceinline__ void gemm_phase(PG8_LAS unsigned char* lds, const Gemm g, const Sched& S, const Epi& E, const int wv) {
    const int tid = fresh_tid(wv), wid = __builtin_amdgcn_readfirstlane(tid >> 6), lane = tid & 63, wr = wid >> 2, wc = wid & 3, fr = lane & 15, fq = lane >> 4;
    const int K = g.K;
    unsigned voffA[2], voffB[2];
#pragma unroll
    for (int i = 0; i < 2; ++i) { int R, C; stage_rc(tid * 16 + i * 8192, R, C); const int Rb = Epi::PERM ? ((R & ~31) + perm32(R & 31)) : R;
        voffA[i] = (unsigned)(R * K + C) * 2u; voffB[i] = (unsigned)(Rb * K + C) * 2u; }
    const size_t kstep = (size_t)(BK * 2);
    const size_t hstep = (size_t)HALF * K * 2;
    const size_t tstep = 2 * hstep;
    const unsigned ldsw = (unsigned)wid * 1024u;
    const int aoff = lds_byte(wr * 64 + fr, fq * 8), boff = lds_byte(wc * 32 + fr, fq * 8);
#define PG8_SA(b, h) (((b) * 2 + (h)) * HTB)
#define PG8_SB(b, h) ((4 + (b) * 2 + (h)) * HTB)
#define PG8_STAGE(bufoff, gbase, voff) do { _Pragma("unroll") for (int _i = 0; _i < 2; ++_i) \
        __builtin_amdgcn_global_load_lds((const unsigned*)((const char*)(gbase) + (voff)[_i]), (PG8_LAS unsigned*)(lds + (bufoff) + ldsw + _i * 8192), 16, 0, 0); } while (0)
#define PG8_LDA(dst, b, h) do { _Pragma("unroll") for (int m = 0; m < 4; ++m) _Pragma("unroll") for (int k = 0; k < 2; ++k) dst[m][k] = *(const PG8_LAS bf16x8*)(lds + PG8_SA(b, h) + aoff + m * 2048 + k * 1024); } while (0)
#define PG8_LDB(dst, b, h) do { _Pragma("unroll") for (int n = 0; n < 2; ++n) _Pragma("unroll") for (int k = 0; k < 2; ++k) dst[n][k] = *(const PG8_LAS bf16x8*)(lds + PG8_SB(b, h) + boff + n * 2048 + k * 1024); } while (0)
#define PG8_MMA(ai, bj, At, Bt) do { __builtin_amdgcn_s_setprio(1); _Pragma("unroll") for (int m = 0; m < 4; ++m) _Pragma("unroll") for (int n = 0; n < 2; ++n) _Pragma("unroll") for (int k = 0; k < 2; ++k) \
        acc[ai][bj][m][n] = __builtin_amdgcn_mfma_f32_16x16x32_bf16(Bt[n][k], At[m][k], acc[ai][bj][m][n], 0, 0, 0); __builtin_amdgcn_s_setprio(0); } while (0)
#define PG8_WAIT_V(n) asm volatile("s_waitcnt vmcnt(" #n ")" ::: "memory")
#define PG8_WAIT_L(n) asm volatile("s_waitcnt lgkmcnt(" #n ")" ::: "memory")
#define PG8_BAR __builtin_amdgcn_s_barrier()
#define PG8_SCHED __builtin_amdgcn_sched_barrier(0)
    Unit cur, nxt; int ui = 0;
    if (!S.next(0, cur)) return;
    f32x4 acc[2][2][4][2];
#pragma unroll
    for (int a = 0; a < 2; ++a)
#pragma unroll
        for (int b = 0; b < 2; ++b)
#pragma unroll
            for (int m = 0; m < 4; ++m)
#pragma unroll
                for (int n = 0; n < 2; ++n) acc[a][b][m][n] = (f32x4){0.f, 0.f, 0.f, 0.f};
    bf16x8 At[4][2], B0[2][2], B1[2][2];
    const char* cA = (const char*)g.A + (size_t)cur.pm * tstep + (size_t)cur.k0 * kstep; const char* cB = (const char*)g.Bt + (size_t)cur.pn * tstep + (size_t)cur.k0 * kstep;
    S.a_ready(cur);
    PG8_STAGE(PG8_SB(0, 0), cB, voffB); PG8_STAGE(PG8_SA(0, 0), cA, voffA); PG8_STAGE(PG8_SB(0, 1), cB + hstep, voffB); PG8_STAGE(PG8_SA(0, 1), cA + hstep, voffA);
    if (wr == 1) PG8_BAR;
    PG8_WAIT_V(4); PG8_BAR;
    PG8_STAGE(PG8_SB(1, 0), cB + kstep, voffB); PG8_STAGE(PG8_SA(1, 0), cA + kstep, voffA); PG8_STAGE(PG8_SB(1, 1), cB + hstep + kstep, voffB);
    PG8_WAIT_V(6); PG8_BAR;
    for (;;) {
        const bool has_next = S.next(ui + 1, nxt);
        const char* nA = has_next ? (const char*)g.A + (size_t)nxt.pm * tstep + (size_t)nxt.k0 * kstep : cA; const char* nB = has_next ? (const char*)g.Bt + (size_t)nxt.pn * tstep + (size_t)nxt.k0 * kstep : cB;
        const int nt = cur.nkt;
        for (int t = 0; t < nt; t += 2) {
            const bool last = (t == nt - 2);
            const char* a1 = cA + (size_t)(t + 1) * kstep;
            const char* a2 = last ? nA : cA + (size_t)(t + 2) * kstep; const char* b2 = last ? nB : cB + (size_t)(t + 2) * kstep;
            const char* a3 = a2 + kstep; const char* b3 = b2 + kstep;
            if (last && has_next) S.a_ready(nxt);
            PG8_LDB(B0, 0, 0); PG8_SCHED; PG8_LDA(At, 0, 0); PG8_STAGE(PG8_SA(1, 1), a1 + hstep, voffA);
            PG8_WAIT_L(8); PG8_BAR; PG8_WAIT_L(0); PG8_MMA(0, 0, At, B0); PG8_BAR; PG8_SCHED;
            PG8_LDB(B1, 0, 1); PG8_STAGE(PG8_SB(0, 0), b2, voffB);
            PG8_BAR; PG8_WAIT_L(0); PG8_MMA(0, 1, At, B1); PG8_BAR;
            PG8_LDA(At, 0, 1); PG8_STAGE(PG8_SA(0, 0), a2, voffA);
            PG8_BAR; PG8_WAIT_L(0); PG8_MMA(1, 0, At, B0); PG8_BAR; PG8_SCHED;
            PG8_STAGE(PG8_SB(0, 1), b2 + hstep, voffB);
            PG8_WAIT_V(6); PG8_BAR; PG8_MMA(1, 1, At, B1); PG8_BAR;
            PG8_LDB(B0, 1, 0); PG8_SCHED; PG8_LDA(At, 1, 0); PG8_STAGE(PG8_SA(0, 1), a2 + hstep, voffA);
            PG8_WAIT_L(8); PG8_BAR; PG8_WAIT_L(0); PG8_MMA(0, 0, At, B0); PG8_BAR; PG8_SCHED;
            PG8_LDB(B1, 1, 1); PG8_STAGE(PG8_SB(1, 0), b3, voffB);
            PG8_BAR; PG8_WAIT_L(0); PG8_MMA(0, 1, At, B1); PG8_BAR;
            PG8_LDA(At, 1, 1); PG8_STAGE(PG8_SA(1, 0), a3, voffA);
            PG8_BAR; PG8_WAIT_L(0); PG8_MMA(1, 0, At, B0); PG8_BAR; PG8_SCHED;
            PG8_STAGE(PG8_SB(1, 1), b3 + hstep, voffB);
            PG8_WAIT_V(6); PG8_BAR; PG8_MMA(1, 1, At, B1); PG8_BAR;
        }
        { const int l2 = fresh_tid(wv) & 63; E(acc, cur, wr, wc, l2 & 15, l2 >> 4); } S.done(cur);
        if (!has_next) break;
#pragma unroll
        for (int a = 0; a < 2; ++a)
#pragma unroll
            for (int b = 0; b < 2; ++b)
#pragma unroll
                for (int m = 0; m < 4; ++m)
#pragma unroll
                    for (int n = 0; n < 2; ++n) acc[a][b][m][n] = (f32x4){0.f, 0.f, 0.f, 0.f};
        cur = nxt; cA = nA; cB = nB; ++ui;
    }
    PG8_WAIT_V(0);
    if (wr == 0) PG8_BAR;
    PG8_BAR;
#undef PG8_SA
#undef PG8_SB
#undef PG8_STAGE
#undef PG8_LDA
#undef PG8_LDB
#undef PG8_MMA
#undef PG8_WAIT_V
#undef PG8_WAIT_L
#undef PG8_BAR
#undef PG8_SCHED
}
}

using pg8::bf16_t; using pg8::f32x4; using pg8::bf16x8; using pg8::u32x4; using pg8::u32x2;
#define LAS __attribute__((address_space(3)))

constexpr int D = 1024, DFF = 2816, NGU = 5632, NCOLS = 3840;
constexpr int MP = 16384, MS = 512, MT = 16896, MIN_ = 17152;
constexpr int LDS_BYTES = 147456;
constexpr size_t O_SHP = 17301504, O_WKP = O_SHP + 8192, O_RTP = O_WKP + 262144, O_SHS = O_RTP + 524288, O_WKS = O_SHS + 131072, O_RTS = O_WKS + 4194304;
constexpr size_t WS_ROPE = 16384;
constexpr size_t WS_WL   = WS_ROPE + 1050624;
constexpr size_t WS_WOUT = WS_WL + 786432;
constexpr size_t WS_WIN  = WS_WOUT + 2097152;
constexpr size_t WS_WGU  = WS_WIN + 7864320;
constexpr size_t WS_WD   = WS_WGU + 11534336;
constexpr size_t WS_XN   = WS_WD + 5767168;
constexpr size_t WS_BIG  = WS_XN + 35127296;
constexpr size_t WS_FO   = WS_BIG + 95158272;
constexpr size_t WS_YS   = WS_BIG + 131727360;
constexpr size_t WS_LA   = WS_YS + 17301504;
constexpr size_t WS_OMD  = WS_BIG + 164364288;
constexpr size_t WS_ASIG = WS_OMD + 17301504;
constexpr size_t WS_END  = WS_ASIG + 17301504;
static_assert(WS_LA + 8650752 <= WS_OMD, "mixer overlays");
static_assert(WS_END <= 268435456, "workspace");

struct Params {
    const float *x_prompt, *x_sample, *state_shift, *state_wkv, *state_ret, *norm_g, *f1g, *f1u, *f1d, *w_in, *mu, *w0, *w2, *a0, *a2, *g2, *k_k, *k_a, *r_k, *lnx_w, *lnx_b, *gn_w, *w_out, *f2g, *f2u, *f2d;
    float* out; unsigned char* ws;
};
#define CAS __attribute__((address_space(4)))
typedef const CAS Params& PR;

__device__ __forceinline__ float bf2f(unsigned b) { return __uint_as_float(b << 16); }
__device__ __forceinline__ bf16_t f2bf(float f) { unsigned u = __float_as_uint(f); u += 0x7FFFu + ((u >> 16) & 1u); return (bf16_t)(u >> 16); }
__device__ __forceinline__ float lo_bf(unsigned x) { return __uint_as_float(x << 16); }
__device__ __forceinline__ float hi_bf(unsigned x) { return __uint_as_float(x & 0xffff0000u); }
template <int CTRL> __device__ __forceinline__ float dppf(float v) { return __int_as_float(__builtin_amdgcn_update_dpp(0, __float_as_int(v), CTRL, 0xF, 0xF, false)); }
__device__ __forceinline__ float row16_sum(float v) { v += dppf<0xB1>(v); v += dppf<0x4E>(v); v += dppf<0x141>(v); v += dppf<0x140>(v); return v; }
__device__ __forceinline__ float wave_sum(float v) { v = row16_sum(v); const int i = __float_as_int(v);
    return __int_as_float(__builtin_amdgcn_readlane(i, 0)) + __int_as_float(__builtin_amdgcn_readlane(i, 16)) + __int_as_float(__builtin_amdgcn_readlane(i, 32)) + __int_as_float(__builtin_amdgcn_readlane(i, 48)); }
__device__ __forceinline__ float quad_sum(float v) { v += dppf<0xB1>(v); v += dppf<0x4E>(v); return v; }
__device__ __forceinline__ float sigmoid_f(float x) { return __builtin_amdgcn_rcpf(1.0f + __expf(-x)); }


#define XB_TMO      128
#define XB_XCNT(j)  (256  + 64 * (j))
#define XB_XSUB(j)  (1280 + 64 * (j))
#define XB_XGEN(j)  (2304 + 64 * (j))
#define XB_TOP      3328
#define XB_TOPGEN   3392
#define XCD_BAR_WORDS 3456
#define XB_SPIN_CAP (1u << 18)
__device__ __forceinline__ unsigned xb_ld(unsigned* p)              { return __hip_atomic_load(p, __ATOMIC_RELAXED, __HIP_MEMORY_SCOPE_AGENT); }
__device__ __forceinline__ unsigned xb_add(unsigned* p, unsigned v) { return __hip_atomic_fetch_add(p, v, __ATOMIC_RELAXED, __HIP_MEMORY_SCOPE_AGENT); }
__device__ __forceinline__ unsigned xb_xcc_id() { return (unsigned)__builtin_amdgcn_s_getreg((3 << 11) | 20) & 0xFu; }
#define XB_SPIN(cond, bar) do { unsigned _sp = 0; while (cond) { __builtin_amdgcn_s_sleep(1); \
    if ((++_sp & 255u) == 0u) { if (xb_ld(&(bar)[XB_TMO])) break; if (_sp > XB_SPIN_CAP) { atomicAdd(&(bar)[XB_TMO], 1u); break; } } } } while (0)
struct XcdBarrier { unsigned* bar; unsigned x; volatile LAS unsigned* st; };
__device__ __forceinline__ XcdBarrier xcd_barrier_post(unsigned* bar, volatile LAS unsigned* st) {
    XcdBarrier b; b.bar = bar; b.x = xb_xcc_id(); b.st = st;
    return b;
}
__device__ __forceinline__ void xcd_barrier_complete(unsigned* bar, unsigned x, unsigned& nloc, unsigned& nx) {
    const unsigned G = gridDim.x * gridDim.y * gridDim.z;
    unsigned sum, cnt, mine, sp = 0u;
    for (;;) {
        sum = 0u; cnt = 0u; mine = 0u;
#pragma unroll
        for (unsigned j = 0; j < 16; ++j) { const unsigned c = xb_ld(&bar[XB_XCNT(j)]); sum += c; cnt += (c > 0u) ? 1u : 0u; mine = (j == x) ? c : mine; }
        if (sum == G) break;
        __builtin_amdgcn_s_sleep(1);
        if ((++sp & 255u) == 0u) { if (xb_ld(&bar[XB_TMO])) break; if (sp > XB_SPIN_CAP) { atomicAdd(&bar[XB_TMO], 1u); break; } }
    }
    nloc = mine > 0u ? mine : 1u; nx = cnt > 0u ? cnt : 1u;
}
__device__ __forceinline__ void xcd_barrier(unsigned* barw, volatile LAS unsigned* stw, const int wv) {
    XcdBarrier b; b.bar = barw; b.x = xb_xcc_id(); b.st = stw;
    asm volatile("s_waitcnt vmcnt(0)" ::: "memory");
    __syncthreads();
    if (fresh_tid(wv) == 0) {
        unsigned* bar = b.bar;
        __builtin_amdgcn_s_waitcnt(0);
        unsigned nloc = b.st[0], nx = b.st[1];
        if (nloc == 0u) { xcd_barrier_complete(bar, b.x, nloc, nx); b.st[0] = nloc; b.st[1] = nx; }
        const unsigned old = xb_add(&bar[XB_XSUB(b.x)], 1u);
        const unsigned gen = old / nloc;
        if (old + 1u == (gen + 1u) * nloc) {
            __builtin_amdgcn_fence(__ATOMIC_RELEASE, "agent");
            asm volatile("s_waitcnt vmcnt(0)" ::: "memory");
            const unsigned og = xb_add(&bar[XB_TOP], 1u);
            const unsigned tg = og / nx;
            if (og + 1u == (tg + 1u) * nx) xb_add(&bar[XB_TOPGEN], 1u);
            else XB_SPIN(xb_ld(&bar[XB_TOPGEN]) == tg, bar);
            __builtin_amdgcn_fence(__ATOMIC_ACQUIRE, "agent");
            xb_add(&bar[XB_XGEN(b.x)], 1u);
            asm volatile("s_waitcnt vmcnt(0)" ::: "memory");
        } else {
            XB_SPIN(xb_ld(&bar[XB_XGEN(b.x)]) == gen, bar);
            __builtin_amdgcn_fence(__ATOMIC_ACQUIRE, "agent");
            asm volatile("s_waitcnt vmcnt(0)" ::: "memory");
        }
    }
    __syncthreads();
}


#define DPP2(x, y, CTRL, NOP) asm volatile(NOP "\n\tv_add_f32_dpp %0, %0, %0 " CTRL " row_mask:0xf bank_mask:0xf bound_ctrl:1\n\tv_add_f32_dpp %1, %1, %1 " CTRL " row_mask:0xf bank_mask:0xf bound_ctrl:1" : "+v"(x), "+v"(y))
#define DPP4(x, y, z, w, CTRL, NOP) asm volatile(NOP "\n\tv_add_f32_dpp %0, %0, %0 " CTRL " row_mask:0xf bank_mask:0xf bound_ctrl:1\n\tv_add_f32_dpp %1, %1, %1 " CTRL " row_mask:0xf bank_mask:0xf bound_ctrl:1\n\tv_add_f32_dpp %2, %2, %2 " CTRL " row_mask:0xf bank_mask:0xf bound_ctrl:1\n\tv_add_f32_dpp %3, %3, %3 " CTRL " row_mask:0xf bank_mask:0xf bound_ctrl:1" : "+v"(x), "+v"(y), "+v"(z), "+v"(w))
#define ROW16_SUM4(x, y, z, w) do { DPP4(x, y, z, w, "quad_perm:[1,0,3,2]", "s_nop 1"); DPP4(x, y, z, w, "quad_perm:[2,3,0,1]", ""); DPP4(x, y, z, w, "row_half_mirror", ""); DPP4(x, y, z, w, "row_mirror", ""); } while (0)
#define ROW16_SUM2(x, y) do { DPP2(x, y, "quad_perm:[1,0,3,2]", "s_nop 1"); DPP2(x, y, "quad_perm:[2,3,0,1]", "s_nop 0"); DPP2(x, y, "row_half_mirror", "s_nop 0"); DPP2(x, y, "row_mirror", "s_nop 0"); } while (0)
__device__ __forceinline__ int prev_row(int r) {
    if (r < MP) return (r & 2047) == 0 ? -1 : r - 1;
    const int s = r - MP; return (s & 3) == 0 ? MT + (s >> 2) : r - 1;
}

struct TDesc { const float* W; bf16_t* Bt; int K, N, k0, n0, brow0; };
__device__ __forceinline__ TDesc tconv_desc(const float* wg, const float* wu, const float* wd, const float* win, const float* wout, unsigned char* ws, int i) {
    TDesc d; int mode = 0, tile = i;
    if (i < 704) { d.W = wg; d.Bt = (bf16_t*)(ws + WS_WGU); d.K = 1024; d.N = DFF; mode = 1; }
    else if (i < 1408) { d.W = wu; d.Bt = (bf16_t*)(ws + WS_WGU); d.K = 1024; d.N = DFF; mode = 2; tile = i - 704; }
    else if (i < 2112) { d.W = wd; d.Bt = (bf16_t*)(ws + WS_WD); d.K = DFF; d.N = 1024; tile = i - 1408; }
    else if (i < 3072) { d.W = win; d.Bt = (bf16_t*)(ws + WS_WIN); d.K = 1024; d.N = NCOLS; tile = i - 2112; }
    else { d.W = wout; d.Bt = (bf16_t*)(ws + WS_WOUT); d.K = 1024; d.N = 1024; tile = i - 3072; }
    const int nkt = d.K / 64; const int kt = tile % nkt, nt = tile / nkt; d.k0 = kt * 64; d.n0 = nt * 64;
    d.brow0 = mode == 0 ? d.n0 : ((d.n0 >> 7) * 256 + (d.n0 & 127) + (mode == 2 ? 128 : 0));
    return d;
}
__device__ __forceinline__ void tconv_list(const float* wg, const float* wu, const float* wd, const float* win, const float* wout, unsigned char* ws, const int ntiles, LAS float* t, const int wv) {
    const int tid = fresh_tid(wv); const int G = gridDim.x;
    float cur[8], nxt[8];
    int i = blockIdx.x;
    if (i < ntiles) { const TDesc d = tconv_desc(wg, wu, wd, win, wout, ws, i);
#pragma unroll
        for (int e = 0; e < 8; ++e) { const int idx = e * 512 + tid, r = idx >> 6, c = idx & 63; cur[e] = d.W[(size_t)(d.k0 + r) * d.N + d.n0 + c]; } }
    for (; i < ntiles; i += G) {
        const TDesc d = tconv_desc(wg, wu, wd, win, wout, ws, i);
        if (i + G < ntiles) { const TDesc dn = tconv_desc(wg, wu, wd, win, wout, ws, i + G);
#pragma unroll
            for (int e = 0; e < 8; ++e) { const int idx = e * 512 + tid, r = idx >> 6, c = idx & 63; nxt[e] = dn.W[(size_t)(dn.k0 + r) * dn.N + dn.n0 + c]; } }
#pragma unroll
        for (int e = 0; e < 8; ++e) { const int idx = e * 512 + tid, r = idx >> 6, c = idx & 63; t[r * 65 + c] = cur[e]; }
        __syncthreads();
#pragma unroll
        for (int e = 0; e < 4; ++e) { const int idx = e * 512 + tid, n = idx >> 5, kp = idx & 31;
            const unsigned w = pg8::cvt_pk_bf16(t[(2 * kp) * 65 + n], t[(2 * kp + 1) * 65 + n]);
            *(unsigned*)(d.Bt + (size_t)(d.brow0 + n) * d.K + d.k0 + 2 * kp) = w; }
        __syncthreads();
#pragma unroll
        for (int e = 0; e < 8; ++e) cur[e] = nxt[e];
    }
}

__device__ __forceinline__ void rows_phase(PR P, const int mode, const int wv) {
    const int tid = fresh_tid(wv); const int lane = tid & 63; const int gw = blockIdx.x * 8 + (tid >> 6), nw = gridDim.x * 8;
    const bf16_t* FO = (const bf16_t*)(P.ws + WS_FO); bf16_t* XN = (bf16_t*)(P.ws + WS_XN);
    const float* gpost = P.norm_g + (mode == 1 ? 1 : (mode == 2 ? 3 : 5)) * 1024;
    const float* gnext = P.norm_g + (mode == 0 ? 0 : (mode == 1 ? 2 : 4)) * 1024;
    const float scale = mode == 2 ? 1.0f : 0.5f;
    for (int row = gw; row < MT; row += nw) {
        float4 xv[4];
        if (mode <= 1) { const float* xin = row < MP ? P.x_prompt + (size_t)row * 1024 : P.x_sample + (size_t)(row - MP) * 1024;
#pragma unroll
            for (int q = 0; q < 4; ++q) xv[q] = *(const float4*)(xin + (q * 64 + lane) * 4); }
        else { const bf16_t* xb = (mode == 2 ? (const bf16_t*)P.out : (const bf16_t*)(P.ws + WS_FO + 34603008)) + (size_t)row * 1024;
#pragma unroll
            for (int q = 0; q < 4; ++q) { const u32x2 t = *(const u32x2*)(xb + (q * 64 + lane) * 4); xv[q] = make_float4(lo_bf(t.x), hi_bf(t.x), lo_bf(t.y), hi_bf(t.y)); } }
        if (mode != 0) {
            float4 fo[4]; float ss = 0.f;
#pragma unroll
            for (int q = 0; q < 4; ++q) {
                if (row < MP) { const u32x2 fb = *(const u32x2*)(FO + (size_t)row * 1024 + (q * 64 + lane) * 4); fo[q] = make_float4(lo_bf(fb.x), hi_bf(fb.x), lo_bf(fb.y), hi_bf(fb.y)); }
                else {
                    const int KS = mode == 2 ? 4 : 8; const float* sl = (const float*)(P.ws + WS_OMD) + (size_t)((((row - MP) >> 8) * 4 + q) * KS) * 65536 + (size_t)(row & 255) * 256 + lane * 4;
                    float4 a = *(const float4*)sl;
                    for (int p = 1; p < KS; ++p) { const float4 b = *(const float4*)(sl + (size_t)p * 65536); a.x += b.x; a.y += b.y; a.z += b.z; a.w += b.w; }
                    fo[q] = a; }
                ss += fo[q].x * fo[q].x + fo[q].y * fo[q].y + fo[q].z * fo[q].z + fo[q].w * fo[q].w; }
            ss = wave_sum(ss); const float r = rsqrtf(ss * (1.0f / 1024.0f) + 1e-6f) * scale;
#pragma unroll
            for (int q = 0; q < 4; ++q) { const float4 g = *(const float4*)(gpost + (q * 64 + lane) * 4);
                xv[q].x += fo[q].x * r * g.x; xv[q].y += fo[q].y * r * g.y; xv[q].z += fo[q].z * r * g.z; xv[q].w += fo[q].w * r * g.w;
                if (mode == 3) *(float4*)(P.out + (size_t)row * 1024 + (q * 64 + lane) * 4) = xv[q];
                else { bf16_t* xo = (mode == 1 ? (bf16_t*)P.out : (bf16_t*)(P.ws + WS_FO + 34603008)) + (size_t)row * 1024; u32x2 t; t.x = pg8::cvt_pk_bf16(xv[q].x, xv[q].y); t.y = pg8::cvt_pk_bf16(xv[q].z, xv[q].w);
                    *(u32x2*)(xo + (q * 64 + lane) * 4) = t; } }
            if (mode == 3) continue;
        }
        float ss2 = 0.f;
#pragma unroll
        for (int q = 0; q < 4; ++q) ss2 += xv[q].x * xv[q].x + xv[q].y * xv[q].y + xv[q].z * xv[q].z + xv[q].w * xv[q].w;
        ss2 = wave_sum(ss2); const float r2 = rsqrtf(ss2 * (1.0f / 1024.0f) + 1e-6f);
        float* sh = nullptr;
        if (mode == 1) { if (row < MP) { if ((row & 2047) == 2047) sh = P.out + O_SHP + (size_t)(row >> 11) * 1024; } else { const int s = row - MP; if ((s & 3) == 3) sh = P.out + O_SHS + (size_t)(s >> 2) * 1024; } }
#pragma unroll
        for (int q = 0; q < 4; ++q) { const float4 g = *(const float4*)(gnext + (q * 64 + lane) * 4);
            float4 hv; hv.x = xv[q].x * r2 * g.x; hv.y = xv[q].y * r2 * g.y; hv.z = xv[q].z * r2 * g.z; hv.w = xv[q].w * r2 * g.w;
            u32x2 w; w.x = pg8::cvt_pk_bf16(hv.x, hv.y); w.y = pg8::cvt_pk_bf16(hv.z, hv.w);
            *(u32x2*)(XN + (size_t)row * 1024 + (q * 64 + lane) * 4) = w;
            if (sh) *(float4*)(sh + (q * 64 + lane) * 4) = hv; }
    }
}

__device__ __forceinline__ void p0_prologue(PR P, LAS float* ldsf, const int wv) {
    const int tid = fresh_tid(wv); const size_t gt = (size_t)blockIdx.x * 512 + tid, nth = (size_t)gridDim.x * 512;
    { float* rc = (float*)(P.ws + WS_ROPE); float* rs = rc + 2052 * 64;
      for (size_t i = gt; i < 2052 * 64; i += nth) { const int p = (int)(i >> 6), f = (int)(i & 63); const int pos = p < 2048 ? p : 16384 + (p - 2048);
          double inv = 1.0; for (int q = 0; q < f; ++q) inv *= 0.8659643233600653;
          const double ang = (double)pos * inv; const double n = rint(ang * 0.15915494309189535); const double r = ang - n * 6.283185307179586;
          const double r2 = r * r; double s = 0.0, c = 0.0;
          for (int k = 14; k >= 0; --k) { s = s * (-r2 / (double)((2 * k + 2) * (2 * k + 3))) + 1.0; c = c * (-r2 / (double)((2 * k + 1) * (2 * k + 2))) + 1.0; }
          rc[i] = (float)c; rs[i] = (float)(s * r); } }
    { bf16_t* Wl = (bf16_t*)(P.ws + WS_WL);
      for (size_t i = gt; i < 1536 * 256; i += nth) { const int n = (int)(i >> 8), k = (int)(i & 255); float v = 0.f;
          if (n < 512) { if (k < 64) v = P.w2[k * 512 + n]; } else if (n < 1024) { if (k >= 64 && k < 128) v = P.a2[(k - 64) * 512 + (n - 512)]; } else { if (k >= 128) v = P.g2[(k - 128) * 512 + (n - 1024)]; }
          Wl[i] = f2bf(v); } }
    { bf16_t* XN = (bf16_t*)(P.ws + WS_XN);
      for (size_t i = gt; i < 256 * 1024; i += nth) { const int r = (int)(i >> 10); XN[(size_t)MT * 1024 + i] = r < 128 ? f2bf(P.state_shift[i]) : (bf16_t)0; } }
    tconv_list(P.f1g, P.f1u, P.f1d, P.w_in, P.w_out, P.ws, 3328, ldsf, wv);
    rows_phase(P, 0, wv);
}

__device__ __forceinline__ void lora_prep(PR P, const int wv) {
    const int tid = fresh_tid(wv); const int lane = tid & 63; const int gw = blockIdx.x * 8 + (tid >> 6), nw = gridDim.x * 8;
    const bf16_t* PS = (const bf16_t*)(P.ws + WS_BIG); bf16_t* LA = (bf16_t*)(P.ws + WS_LA);
    const float4 mu = *(const float4*)(P.mu + 1536 + lane * 4); const int kind = lane >> 4;
    u32x2 c = (u32x2){0u, 0u}, p = c, nc = c, np = c;
    if (gw < MT) { c = *(const u32x2*)(PS + (size_t)gw * NCOLS + 1536 + lane * 4); const int pr = prev_row(gw); if (pr >= 0) p = *(const u32x2*)(PS + (size_t)pr * NCOLS + 1536 + lane * 4); }
    for (int row = gw; row < MT; row += nw) {
        const int nrow = row + nw;
        if (nrow < MT) { nc = *(const u32x2*)(PS + (size_t)nrow * NCOLS + 1536 + lane * 4); const int pr = prev_row(nrow); np = (u32x2){0u, 0u}; if (pr >= 0) np = *(const u32x2*)(PS + (size_t)pr * NCOLS + 1536 + lane * 4); }
        float v[4]; const float cu[4] = {lo_bf(c.x), hi_bf(c.x), lo_bf(c.y), hi_bf(c.y)}, pv[4] = {lo_bf(p.x), hi_bf(p.x), lo_bf(p.y), hi_bf(p.y)}, m4[4] = {mu.x, mu.y, mu.z, mu.w};
#pragma unroll
        for (int j = 0; j < 4; ++j) { float x = cu[j] + (pv[j] - cu[j]) * m4[j];
            if (kind == 0) x = 1.0f - 2.0f * __builtin_amdgcn_rcpf(__expf(2.0f * x) + 1.0f); else if (kind >= 2) x = sigmoid_f(x);
            v[j] = x; }
        u32x2 w; w.x = pg8::cvt_pk_bf16(v[0], v[1]); w.y = pg8::cvt_pk_bf16(v[2], v[3]);
        *(u32x2*)(LA + (size_t)row * 256 + lane * 4) = w;
        c = nc; p = np;
    }
}

template <bool SAMPLE>
__device__ __forceinline__ void rwkv_unit(PR P, LAS float* lds, const int b, const int h, const int half, const int wv) {
    constexpr int T = SAMPLE ? 4 : 2048, TC = SAMPLE ? 4 : 32, NCH = T / TC;
    const int tid = fresh_tid(wv), lane = tid & 63, wid = tid >> 6;
    const bf16_t* PS = (const bf16_t*)(P.ws + WS_BIG); const bf16_t* OMD = (const bf16_t*)(P.ws + WS_OMD); const bf16_t* ASIG = (const bf16_t*)(P.ws + WS_ASIG);
    bf16_t* YS = (bf16_t*)(P.ws + WS_YS);
    const int row_base = SAMPLE ? MP + b * 4 : b * 2048;
    const int ltok = (tid - 256) >> 4, lcg = tid & 15; const bool lwave = tid >= 256; const int hch = h * 64 + lcg * 4;
    const float4 mur = *(const float4*)(P.mu + hch), muk = *(const float4*)(P.mu + 512 + hch), muv = *(const float4*)(P.mu + 1024 + hch);
    const float4 kk4 = *(const float4*)(P.k_k + hch), ka4 = *(const float4*)(P.k_a + hch);
    typedef float f32x2 __attribute__((ext_vector_type(2)));
    const int row0 = half * 32 + (wid & 3) * 8 + (lane >> 4) * 2, cgl = lane & 15, j0 = cgl * 4;
    f32x2 S[4];
#pragma unroll
    for (int c = 0; c < 4; ++c) S[c] = (f32x2){0.f, 0.f};
    float* sout = P.out + (SAMPLE ? O_WKS : O_WKP) + ((size_t)(b * 8 + h) * 64 + row0) * 64 + j0;
    if (SAMPLE && wid < 4) { const float* sp = P.state_wkv + ((size_t)(b * 8 + h) * 64 + row0) * 64 + j0; const float4 s0 = *(const float4*)sp, s1 = *(const float4*)(sp + 64);
        S[0] = (f32x2){s0.x, s1.x}; S[1] = (f32x2){s0.y, s1.y}; S[2] = (f32x2){s0.z, s1.z}; S[3] = (f32x2){s0.w, s1.w}; }
    LAS float* buf0 = lds; LAS float* buf1 = lds + TC * 384;
    u32x2 cr[2], ck[2], cv[2], pr[2], pk[2], pv[2], co[2], ca[2];
#define RW_LOAD1(c, U) do { if (lwave && ltok + 16 * (U) < TC) { const int t_ = (c) * TC + ltok + 16 * (U); const int row_ = row_base + t_; const int prow_ = SAMPLE ? (t_ == 0 ? MT + b : row_ - 1) : row_ - 1; \
        const bf16_t* cp_ = PS + (size_t)row_ * NCOLS + hch; cr[U] = *(const u32x2*)cp_; ck[U] = *(const u32x2*)(cp_ + 512); cv[U] = *(const u32x2*)(cp_ + 1024); \
        if (SAMPLE || t_ > 0) { const bf16_t* pp_ = PS + (size_t)prow_ * NCOLS + hch; pr[U] = *(const u32x2*)pp_; pk[U] = *(const u32x2*)(pp_ + 512); pv[U] = *(const u32x2*)(pp_ + 1024); } \
        else { pr[U] = (u32x2){0u, 0u}; pk[U] = pr[U]; pv[U] = pr[U]; } \
        co[U] = *(const u32x2*)(OMD + (size_t)row_ * 512 + hch); ca[U] = *(const u32x2*)(ASIG + (size_t)row_ * 512 + hch); } } while (0)
#define RW_LOAD(c) do { RW_LOAD1(c, 0); RW_LOAD1(c, 1); } while (0)
#define RW_MIX(cu, pv_, m) ((cu) + ((pv_) - (cu)) * (m))
#define RW_PROC1(dst, U) do { if (lwave && ltok + 16 * (U) < TC) { LAS float* d_ = (dst) + (ltok + 16 * (U)) * 384 + lcg * 4; \
        f32x4 r_, k_, v_, o_, a_; \
        r_[0] = RW_MIX(lo_bf(cr[U].x), lo_bf(pr[U].x), mur.x); r_[1] = RW_MIX(hi_bf(cr[U].x), hi_bf(pr[U].x), mur.y); r_[2] = RW_MIX(lo_bf(cr[U].y), lo_bf(pr[U].y), mur.z); r_[3] = RW_MIX(hi_bf(cr[U].y), hi_bf(pr[U].y), mur.w); \
        k_[0] = RW_MIX(lo_bf(ck[U].x), lo_bf(pk[U].x), muk.x); k_[1] = RW_MIX(hi_bf(ck[U].x), hi_bf(pk[U].x), muk.y); k_[2] = RW_MIX(lo_bf(ck[U].y), lo_bf(pk[U].y), muk.z); k_[3] = RW_MIX(hi_bf(ck[U].y), hi_bf(pk[U].y), muk.w); \
        v_[0] = RW_MIX(lo_bf(cv[U].x), lo_bf(pv[U].x), muv.x); v_[1] = RW_MIX(hi_bf(cv[U].x), hi_bf(pv[U].x), muv.y); v_[2] = RW_MIX(lo_bf(cv[U].y), lo_bf(pv[U].y), muv.z); v_[3] = RW_MIX(hi_bf(cv[U].y), hi_bf(pv[U].y), muv.w); \
        o_[0] = lo_bf(co[U].x); o_[1] = hi_bf(co[U].x); o_[2] = lo_bf(co[U].y); o_[3] = hi_bf(co[U].y); a_[0] = lo_bf(ca[U].x); a_[1] = hi_bf(ca[U].x); a_[2] = lo_bf(ca[U].y); a_[3] = hi_bf(ca[U].y); \
        f32x4 kk_; kk_[0] = k_[0] * kk4.x; kk_[1] = k_[1] * kk4.y; kk_[2] = k_[2] * kk4.z; kk_[3] = k_[3] * kk4.w; \
        float ss_ = kk_[0] * kk_[0] + kk_[1] * kk_[1] + kk_[2] * kk_[2] + kk_[3] * kk_[3]; ss_ = row16_sum(ss_); \
        const float inv_ = __builtin_amdgcn_rcpf(fmaxf(__builtin_amdgcn_sqrtf(ss_), 1e-12f)); kk_ = kk_ * inv_; \
        f32x4 kn_; kn_[0] = k_[0] * (1.0f + (a_[0] - 1.0f) * ka4.x); kn_[1] = k_[1] * (1.0f + (a_[1] - 1.0f) * ka4.y); kn_[2] = k_[2] * (1.0f + (a_[2] - 1.0f) * ka4.z); kn_[3] = k_[3] * (1.0f + (a_[3] - 1.0f) * ka4.w); \
        *(LAS f32x4*)(d_) = r_; *(LAS f32x4*)(d_ + 64) = o_; *(LAS f32x4*)(d_ + 128) = kn_; *(LAS f32x4*)(d_ + 192) = -kk_; *(LAS f32x4*)(d_ + 256) = kk_ * a_; *(LAS f32x4*)(d_ + 320) = v_; } } while (0)
#define RW_PROC(dst) do { RW_PROC1(dst, 0); RW_PROC1(dst, 1); } while (0)
    RW_LOAD(0); RW_PROC(buf0); __syncthreads();
    for (int c = 0; c < NCH; ++c) {
        LAS float* cur = (c & 1) ? buf1 : buf0; LAS float* nxt = (c & 1) ? buf0 : buf1;
        if (c + 1 < NCH) RW_LOAD(c + 1);
        if (wid < 4) {
            constexpr int GS = SAMPLE ? 4 : 16;
            for (int g = 0; g < TC / GS; ++g) {
                float yk0 = 0.f, yk1 = 0.f;
                const LAS float* q0 = cur + (g * GS) * 384;
                f32x4 r4 = *(const LAS f32x4*)(q0 + j0), o4 = *(const LAS f32x4*)(q0 + 64 + j0), k4 = *(const LAS f32x4*)(q0 + 128 + j0), a4 = *(const LAS f32x4*)(q0 + 192 + j0), b4 = *(const LAS f32x4*)(q0 + 256 + j0);
                f32x2 v2 = *(const LAS f32x2*)(q0 + 320 + row0);
                float py0 = 0.f, py1 = 0.f;
#pragma unroll
                for (int tt = 0; tt < GS; ++tt) {
                    const LAS float* qn = q0 + (tt + 1 < GS ? tt + 1 : tt) * 384;
                    const f32x4 nr4 = *(const LAS f32x4*)(qn + j0), no4 = *(const LAS f32x4*)(qn + 64 + j0), nk4 = *(const LAS f32x4*)(qn + 128 + j0), na4 = *(const LAS f32x4*)(qn + 192 + j0), nb4 = *(const LAS f32x4*)(qn + 256 + j0);
                    const f32x2 nv2 = *(const LAS f32x2*)(qn + 320 + row0);
                    f32x2 sa = (S[0] * a4[0] + S[1] * a4[1]) + (S[2] * a4[2] + S[3] * a4[3]);
                    float sx = sa.x, sy = sa.y; ROW16_SUM4(sx, sy, py0, py1); sa = (f32x2){sx, sy};
                    if (tt > 0) { yk0 = cgl == tt - 1 ? py0 : yk0; yk1 = cgl == tt - 1 ? py1 : yk1; }
#pragma unroll
                    for (int c = 0; c < 4; ++c) { f32x2 t = S[c] - S[c] * o4[c]; t = t + sa * b4[c]; S[c] = t + v2 * k4[c]; }
                    const f32x2 y = (S[0] * r4[0] + S[1] * r4[1]) + (S[2] * r4[2] + S[3] * r4[3]);
                    py0 = y.x; py1 = y.y;
                    r4 = nr4; o4 = no4; k4 = nk4; a4 = na4; b4 = nb4; v2 = nv2;
                }
                ROW16_SUM2(py0, py1); yk0 = cgl == GS - 1 ? py0 : yk0; yk1 = cgl == GS - 1 ? py1 : yk1;
                if (cgl < GS) *(unsigned*)(YS + (size_t)(row_base + c * TC + g * GS + cgl) * 512 + h * 64 + row0) = pg8::cvt_pk_bf16(yk0, yk1);
            }
        }
        if (c + 1 < NCH) RW_PROC(nxt);
        __syncthreads();
    }
    if (wid < 4) { *(float4*)sout = make_float4(S[0].x, S[1].x, S[2].x, S[3].x); *(float4*)(sout + 64) = make_float4(S[0].y, S[1].y, S[2].y, S[3].y); }
#undef RW_LOAD
#undef RW_PROC
#undef RW_LOAD1
#undef RW_PROC1
#undef RW_MIX
}

__device__ __forceinline__ void ret_sample_unit(PR P, LAS float* lds, const int b, const int h, const int wv) {
    const int tid = fresh_tid(wv), lane = tid & 63, wid = tid >> 6;
    const bf16_t* PS = (const bf16_t*)(P.ws + WS_BIG); bf16_t* Y = (bf16_t*)(P.ws + WS_XN);
    const float* rc = (const float*)(P.ws + WS_ROPE); const float* rs = rc + 2052 * 64;
    LAS float* q = lds; LAS float* k = lds + 512; LAS float* v = lds + 1024; LAS float* Pm = lds + 1536; LAS float* y2p = lds + 1600; LAS float* red = lds + 1600 + 2048;
    const float lg2 = log2f(1.0f - exp2f(-5.0f - (float)h));
    const int row0 = MP + b * 4;
    { const int t = (tid & 255) >> 6, f = tid & 63; const bf16_t* src = PS + (size_t)(row0 + t) * NCOLS + 1792 + h * 128;
      if (tid < 256) { const float cs = rc[(2048 + t) * 64 + f], sn = rs[(2048 + t) * 64 + f];
          const float q1 = bf2f(src[f]), q2 = bf2f(src[f + 64]); q[t * 128 + f] = q1 * cs - q2 * sn; q[t * 128 + f + 64] = q1 * sn + q2 * cs;
          const float k1 = bf2f(src[512 + f]), k2 = bf2f(src[512 + f + 64]); k[t * 128 + f] = (k1 * cs - k2 * sn) * 0.08838834764831845f; k[t * 128 + f + 64] = (k1 * sn + k2 * cs) * 0.08838834764831845f; }
      else { v[t * 128 + f] = bf2f(src[1024 + f]); v[t * 128 + f + 64] = bf2f(src[1024 + f + 64]); } }
    __syncthreads();
    if (wid == 0) { const int pi = lane >> 4, pj = (lane >> 2) & 3, part = lane & 3; float s = 0.f;
        for (int d = part * 32; d < part * 32 + 32; ++d) s += q[pi * 128 + d] * k[pj * 128 + d];
        s = quad_sum(s); if (part == 0) Pm[pi * 4 + pj] = pi >= pj ? s * exp2f(lg2 * (float)(pi - pj)) : 0.f; }
    { const int e = tid & 127, dg = tid >> 7; const float c4 = exp2f(lg2 * 4.0f), g3 = exp2f(lg2 * 3.0f), g2_ = exp2f(lg2 * 2.0f), g1 = exp2f(lg2);
      const float v0 = v[e] * g3, v1 = v[128 + e] * g2_, v2 = v[256 + e] * g1, v3 = v[384 + e];
      const float* S0 = P.state_ret + ((size_t)(b * 4 + h) * 128) * 128 + e; float* So = P.out + O_RTS + ((size_t)(b * 4 + h) * 128) * 128 + e;
      float a0 = 0.f, a1 = 0.f, a2 = 0.f, a3 = 0.f;
      float sv[32];
#pragma unroll
      for (int x = 0; x < 32; ++x) sv[x] = S0[(size_t)(dg * 32 + x) * 128];
#pragma unroll
      for (int x = 0; x < 32; ++x) { const int d = dg * 32 + x; const float s = sv[x];
          a0 = fmaf(q[d], s, a0); a1 = fmaf(q[128 + d], s, a1); a2 = fmaf(q[256 + d], s, a2); a3 = fmaf(q[384 + d], s, a3);
          So[(size_t)d * 128] = s * c4 + k[d] * v0 + k[128 + d] * v1 + k[256 + d] * v2 + k[384 + d] * v3; }
      y2p[(dg * 4 + 0) * 128 + e] = a0; y2p[(dg * 4 + 1) * 128 + e] = a1; y2p[(dg * 4 + 2) * 128 + e] = a2; y2p[(dg * 4 + 3) * 128 + e] = a3; }
    __syncthreads();
    { const int i = tid >> 7, e = tid & 127;
      float y = (y2p[(0 + i) * 128 + e] + y2p[(4 + i) * 128 + e] + y2p[(8 + i) * 128 + e] + y2p[(12 + i) * 128 + e]) * exp2f(lg2 * (float)(i + 1));
#pragma unroll
      for (int j = 0; j < 4; ++j) y = fmaf(Pm[i * 4 + j], v[j * 128 + e], y);
      float s = wave_sum(y); if (lane == 0) red[wid] = s; __syncthreads();
      const float mean = (red[i * 2] + red[i * 2 + 1]) * (1.0f / 128.0f); const float dlt = y - mean;
      float s2 = wave_sum(dlt * dlt); if (lane == 0) red[8 + wid] = s2; __syncthreads();
      const float var = (red[8 + i * 2] + red[8 + i * 2 + 1]) * (1.0f / 128.0f);
      const float g = bf2f(PS[(size_t)(row0 + i) * NCOLS + 1792 + 1536 + h * 128 + e]);
      const float o = dlt * rsqrtf(var + 1e-5f) * P.gn_w[h * 128 + e] * (g * __builtin_amdgcn_rcpf(1.0f + __expf(-g)));
      Y[(size_t)(row0 + i) * 1024 + 512 + h * 128 + e] = f2bf(o); }
    __syncthreads();
}

__device__ __forceinline__ bf16_t* kvb_ptr(unsigned char* ws, int bh) { return (bf16_t*)(bh < 29 ? ws + WS_LA + (size_t)bh * 524288 : ws + WS_WIN + 17301504 + (size_t)(bh - 29) * 524288); }
constexpr int RS = 136, BUFE = 128 * RS;

template <bool WITH_K>
__device__ __forceinline__ void ret_load_qk(PR P, LAS bf16_t* QP, LAS bf16_t* KB, unsigned (&kth)[4][4], const int tidv, const int row0, const int n, const int h, const float kd0, const float g32) {
    const bf16_t* PS = (const bf16_t*)(P.ws + WS_BIG); const float* rc = (const float*)(P.ws + WS_ROPE); const float* rs = rc + 2052 * 64;
    float kd = kd0;
#pragma unroll
    for (int it = 0; it < 4; ++it) { const int idx = it * 512 + tidv, i = idx >> 4, f = (idx & 15) * 4;
        const bf16_t* src = PS + (size_t)(row0 + i) * NCOLS + 1792 + h * 128;
        const u32x2 q1 = *(const u32x2*)(src + f), q2 = *(const u32x2*)(src + 64 + f);
        u32x2 k1 = (u32x2){0u, 0u}, k2 = k1; if (WITH_K) { k1 = *(const u32x2*)(src + 512 + f); k2 = *(const u32x2*)(src + 576 + f); }
        const float4 cs = *(const float4*)(rc + (size_t)(n * 128 + i) * 64 + f), sn = *(const float4*)(rs + (size_t)(n * 128 + i) * 64 + f);
        const float c4[4] = {cs.x, cs.y, cs.z, cs.w}, s4[4] = {sn.x, sn.y, sn.z, sn.w};
        const float qa[4] = {lo_bf(q1.x), hi_bf(q1.x), lo_bf(q1.y), hi_bf(q1.y)}, qb[4] = {lo_bf(q2.x), hi_bf(q2.x), lo_bf(q2.y), hi_bf(q2.y)};
        float qo1[4], qo2[4];
#pragma unroll
        for (int x = 0; x < 4; ++x) { qo1[x] = qa[x] * c4[x] - qb[x] * s4[x]; qo2[x] = qa[x] * s4[x] + qb[x] * c4[x]; }
        u32x2 w; w.x = pg8::cvt_pk_bf16(qo1[0], qo1[1]); w.y = pg8::cvt_pk_bf16(qo1[2], qo1[3]); *(LAS u32x2*)(QP + i * RS + f) = w;
        w.x = pg8::cvt_pk_bf16(qo2[0], qo2[1]); w.y = pg8::cvt_pk_bf16(qo2[2], qo2[3]); *(LAS u32x2*)(QP + i * RS + 64 + f) = w;
        if (WITH_K) {
            const float ka[4] = {lo_bf(k1.x), hi_bf(k1.x), lo_bf(k1.y), hi_bf(k1.y)}, kb[4] = {lo_bf(k2.x), hi_bf(k2.x), lo_bf(k2.y), hi_bf(k2.y)};
            float ko1[4], ko2[4];
#pragma unroll
            for (int x = 0; x < 4; ++x) { ko1[x] = (ka[x] * c4[x] - kb[x] * s4[x]) * 0.08838834764831845f; ko2[x] = (ka[x] * s4[x] + kb[x] * c4[x]) * 0.08838834764831845f; }
            w.x = pg8::cvt_pk_bf16(ko1[0], ko1[1]); w.y = pg8::cvt_pk_bf16(ko1[2], ko1[3]); *(LAS u32x2*)(KB + i * RS + f) = w;
            w.x = pg8::cvt_pk_bf16(ko2[0], ko2[1]); w.y = pg8::cvt_pk_bf16(ko2[2], ko2[3]); *(LAS u32x2*)(KB + i * RS + 64 + f) = w;
            kth[it][0] = pg8::cvt_pk_bf16(ko1[0] * kd, ko1[1] * kd); kth[it][1] = pg8::cvt_pk_bf16(ko1[2] * kd, ko1[3] * kd);
            kth[it][2] = pg8::cvt_pk_bf16(ko2[0] * kd, ko2[1] * kd); kth[it][3] = pg8::cvt_pk_bf16(ko2[2] * kd, ko2[3] * kd); kd *= g32; }
        if (it & 1) __builtin_amdgcn_sched_barrier(0); }
}

__device__ __forceinline__ void ret_unit_a(PR P, LAS unsigned char* lds, const int bh, const int n, const int wv) {
    LAS bf16_t* QP = (LAS bf16_t*)lds; LAS bf16_t* KB = QP + BUFE; LAS bf16_t* VT = KB + BUFE;
    const int tid = fresh_tid(wv), lane = tid & 63, wid = tid >> 6, wr = wid >> 1, wc = wid & 1, fr = lane & 15, fq = lane >> 4;
    const int b = bh >> 2, h = bh & 3;
    const bf16_t* PS = (const bf16_t*)(P.ws + WS_BIG); bf16_t* Y = (bf16_t*)(P.ws + WS_XN); bf16_t* KVB = kvb_ptr(P.ws, bh) + (size_t)n * 16384;
    const float lg2 = log2f(1.0f - exp2f(-5.0f - (float)h));
    const float kd0 = exp2f(lg2 * (float)(127 - (tid >> 4))), g32 = exp2f(-32.0f * lg2);
    const int row0 = b * 2048 + n * 128;
    unsigned kth[4][4];
    ret_load_qk<true>(P, QP, KB, kth, tid, row0, n, h, kd0, g32);
#pragma unroll
    for (int it = 0; it < 4; ++it) { const int idx = it * 512 + tid, j = idx >> 4, e = (idx & 15) * 8;
        const u32x4 vv = *(const u32x4*)(PS + (size_t)(row0 + j) * NCOLS + 1792 + 1024 + h * 128 + e);
        LAS bf16_t* d = VT + e * RS + j;
        d[0] = (bf16_t)(vv.x & 0xffffu); d[RS] = (bf16_t)(vv.x >> 16); d[2 * RS] = (bf16_t)(vv.y & 0xffffu); d[3 * RS] = (bf16_t)(vv.y >> 16);
        d[4 * RS] = (bf16_t)(vv.z & 0xffffu); d[5 * RS] = (bf16_t)(vv.z >> 16); d[6 * RS] = (bf16_t)(vv.w & 0xffffu); d[7 * RS] = (bf16_t)(vv.w >> 16); }
    __syncthreads();
    f32x4 accP[2][4];
#pragma unroll
    for (int mt = 0; mt < 2; ++mt)
#pragma unroll
        for (int nt = 0; nt < 4; ++nt) accP[mt][nt] = (f32x4){0.f, 0.f, 0.f, 0.f};
#pragma unroll
    for (int ks = 0; ks < 4; ++ks) { bf16x8 aq[2];
#pragma unroll
        for (int mt = 0; mt < 2; ++mt) aq[mt] = *(const LAS bf16x8*)(QP + (wr * 32 + mt * 16 + fr) * RS + ks * 32 + fq * 8);
#pragma unroll
        for (int nt = 0; nt < 4; ++nt) { const bf16x8 bk = *(const LAS bf16x8*)(KB + (wc * 64 + nt * 16 + fr) * RS + ks * 32 + fq * 8);
#pragma unroll
            for (int mt = 0; mt < 2; ++mt) accP[mt][nt] = __builtin_amdgcn_mfma_f32_16x16x32_bf16(aq[mt], bk, accP[mt][nt], 0, 0, 0); }
        __builtin_amdgcn_sched_barrier(0); }
    __syncthreads();
    { float ri[2][4], cj[4];
#pragma unroll
      for (int mt = 0; mt < 2; ++mt)
#pragma unroll
          for (int j = 0; j < 4; ++j) ri[mt][j] = exp2f(lg2 * (float)(wr * 32 + mt * 16 + fq * 4 + j));
#pragma unroll
      for (int nt = 0; nt < 4; ++nt) cj[nt] = exp2f(-lg2 * (float)(wc * 64 + nt * 16 + fr));
#pragma unroll
      for (int mt = 0; mt < 2; ++mt)
#pragma unroll
          for (int nt = 0; nt < 4; ++nt)
#pragma unroll
              for (int j = 0; j < 4; ++j) { const int i = wr * 32 + mt * 16 + fq * 4 + j, jj = wc * 64 + nt * 16 + fr;
                  const float val = i >= jj ? accP[mt][nt][j] * ri[mt][j] * cj[nt] : 0.f; QP[i * RS + jj] = f2bf(val); } }
#pragma unroll
    for (int it = 0; it < 4; ++it) { const int idx = it * 512 + tid, j = idx >> 4, f = (idx & 15) * 4; LAS bf16_t* d = KB + f * RS + j;
        d[0] = (bf16_t)(kth[it][0] & 0xffffu); d[RS] = (bf16_t)(kth[it][0] >> 16); d[2 * RS] = (bf16_t)(kth[it][1] & 0xffffu); d[3 * RS] = (bf16_t)(kth[it][1] >> 16);
        LAS bf16_t* d2 = d + 64 * RS;
        d2[0] = (bf16_t)(kth[it][2] & 0xffffu); d2[RS] = (bf16_t)(kth[it][2] >> 16); d2[2 * RS] = (bf16_t)(kth[it][3] & 0xffffu); d2[3 * RS] = (bf16_t)(kth[it][3] >> 16); }
    __syncthreads();
    f32x4 accY[2][4], accS[2][4];
#pragma unroll
    for (int mt = 0; mt < 2; ++mt)
#pragma unroll
        for (int nt = 0; nt < 4; ++nt) { accY[mt][nt] = (f32x4){0.f, 0.f, 0.f, 0.f}; accS[mt][nt] = (f32x4){0.f, 0.f, 0.f, 0.f}; }
#pragma unroll
    for (int ks = 0; ks < 4; ++ks) { bf16x8 ap[2], av[2];
#pragma unroll
        for (int mt = 0; mt < 2; ++mt) { ap[mt] = *(const LAS bf16x8*)(QP + (wr * 32 + mt * 16 + fr) * RS + ks * 32 + fq * 8); av[mt] = *(const LAS bf16x8*)(VT + (wr * 32 + mt * 16 + fr) * RS + ks * 32 + fq * 8); }
#pragma unroll
        for (int nt = 0; nt < 4; ++nt) { const bf16x8 bv = *(const LAS bf16x8*)(VT + (wc * 64 + nt * 16 + fr) * RS + ks * 32 + fq * 8), bkt = *(const LAS bf16x8*)(KB + (wc * 64 + nt * 16 + fr) * RS + ks * 32 + fq * 8);
#pragma unroll
            for (int mt = 0; mt < 2; ++mt) { accY[mt][nt] = __builtin_amdgcn_mfma_f32_16x16x32_bf16(ap[mt], bv, accY[mt][nt], 0, 0, 0); accS[mt][nt] = __builtin_amdgcn_mfma_f32_16x16x32_bf16(av[mt], bkt, accS[mt][nt], 0, 0, 0); } }
        __builtin_amdgcn_sched_barrier(0); }
#pragma unroll
    for (int mt = 0; mt < 2; ++mt)
#pragma unroll
        for (int nt = 0; nt < 4; ++nt)
#pragma unroll
            for (int j = 0; j < 4; ++j) { const int r = wr * 32 + mt * 16 + fq * 4 + j, c = wc * 64 + nt * 16 + fr;
                Y[(size_t)(row0 + r) * 1024 + 512 + h * 128 + c] = f2bf(accY[mt][nt][j]); KVB[r * 128 + c] = f2bf(accS[mt][nt][j]); }
    __syncthreads();
}

__device__ __forceinline__ void ret_prefix(PR P, const int item) {
    const int bh = item >> 11, i8 = (item & 2047) * 8; const int h = bh & 3;
    bf16_t* KVB = kvb_ptr(P.ws, bh) + i8;
    const float lg2 = log2f(1.0f - exp2f(-5.0f - (float)h)); const float c_dec = exp2f(lg2 * 128.0f);
    u32x4 kv[16];
#pragma unroll
    for (int n = 0; n < 16; ++n) kv[n] = *(const u32x4*)(KVB + (size_t)n * 16384);
    float S[8];
#pragma unroll
    for (int x = 0; x < 8; ++x) S[x] = 0.f;
#pragma unroll
    for (int n = 0; n < 16; ++n) { u32x4 w; w.x = pg8::cvt_pk_bf16(S[0], S[1]); w.y = pg8::cvt_pk_bf16(S[2], S[3]); w.z = pg8::cvt_pk_bf16(S[4], S[5]); w.w = pg8::cvt_pk_bf16(S[6], S[7]);
        *(u32x4*)(KVB + (size_t)n * 16384) = w;
        const float k8[8] = {lo_bf(kv[n].x), hi_bf(kv[n].x), lo_bf(kv[n].y), hi_bf(kv[n].y), lo_bf(kv[n].z), hi_bf(kv[n].z), lo_bf(kv[n].w), hi_bf(kv[n].w)};
#pragma unroll
        for (int x = 0; x < 8; ++x) S[x] = S[x] * c_dec + k8[x]; }
    const int e = i8 >> 7, d0 = i8 & 127;
#pragma unroll
    for (int x = 0; x < 8; ++x) P.out[O_RTP + ((size_t)bh * 128 + d0 + x) * 128 + e] = S[x];
}

__device__ __forceinline__ void ret_unit_c(PR P, LAS unsigned char* lds, const int bh, const int n, const int wv) {
    LAS bf16_t* QP = (LAS bf16_t*)lds; LAS bf16_t* ST = QP + 3 * BUFE; LAS float* YST = (LAS float*)(QP + BUFE);
    const int tid = fresh_tid(wv), lane = tid & 63, wid = tid >> 6, wr = wid >> 1, wc = wid & 1, fr = lane & 15, fq = lane >> 4;
    const int b = bh >> 2, h = bh & 3;
    const bf16_t* PS = (const bf16_t*)(P.ws + WS_BIG); bf16_t* Y = (bf16_t*)(P.ws + WS_XN); const bf16_t* KVB = kvb_ptr(P.ws, bh) + (size_t)n * 16384;
    const float lg2 = log2f(1.0f - exp2f(-5.0f - (float)h));
    const int row0 = b * 2048 + n * 128;
    unsigned kth[4][4];
    ret_load_qk<false>(P, QP, QP, kth, tid, row0, n, h, 0.f, 0.f);
#pragma unroll
    for (int it = 0; it < 4; ++it) { const int idx = it * 512 + tid, e = idx >> 4, d8 = (idx & 15) * 8;
        *(LAS u32x4*)(ST + e * RS + d8) = *(const u32x4*)(KVB + e * 128 + d8); }
    __syncthreads();
    f32x4 accY[2][4];
#pragma unroll
    for (int mt = 0; mt < 2; ++mt)
#pragma unroll
        for (int nt = 0; nt < 4; ++nt) accY[mt][nt] = (f32x4){0.f, 0.f, 0.f, 0.f};
#pragma unroll
    for (int ks = 0; ks < 4; ++ks) { bf16x8 aq[2];
#pragma unroll
        for (int mt = 0; mt < 2; ++mt) aq[mt] = *(const LAS bf16x8*)(QP + (wr * 32 + mt * 16 + fr) * RS + ks * 32 + fq * 8);
#pragma unroll
        for (int nt = 0; nt < 4; ++nt) { const bf16x8 bs = *(const LAS bf16x8*)(ST + (wc * 64 + nt * 16 + fr) * RS + ks * 32 + fq * 8);
#pragma unroll
            for (int mt = 0; mt < 2; ++mt) accY[mt][nt] = __builtin_amdgcn_mfma_f32_16x16x32_bf16(aq[mt], bs, accY[mt][nt], 0, 0, 0); }
        __builtin_amdgcn_sched_barrier(0); }
#pragma unroll
    for (int mt = 0; mt < 2; ++mt)
#pragma unroll
        for (int j = 0; j < 4; ++j) { const int r = wr * 32 + mt * 16 + fq * 4 + j; const float qd = exp2f(lg2 * (float)(r + 1));
#pragma unroll
            for (int nt = 0; nt < 4; ++nt) YST[r * 132 + wc * 64 + nt * 16 + fr] = accY[mt][nt][j] * qd; }
    __syncthreads();
    { const int i = tid >> 2, part = tid & 3; float yv[32]; float s = 0.f;
      bf16_t* yo = Y + (size_t)(row0 + i) * 1024 + 512 + h * 128 + part * 32;
#pragma unroll
      for (int x = 0; x < 4; ++x) { const u32x4 y1 = *(const u32x4*)(yo + x * 8); const f32x4 ta = *(const LAS f32x4*)(YST + i * 132 + part * 32 + x * 8), tb = *(const LAS f32x4*)(YST + i * 132 + part * 32 + x * 8 + 4);
          yv[x * 8 + 0] = ta[0] + lo_bf(y1.x); yv[x * 8 + 1] = ta[1] + hi_bf(y1.x); yv[x * 8 + 2] = ta[2] + lo_bf(y1.y); yv[x * 8 + 3] = ta[3] + hi_bf(y1.y);
          yv[x * 8 + 4] = tb[0] + lo_bf(y1.z); yv[x * 8 + 5] = tb[1] + hi_bf(y1.z); yv[x * 8 + 6] = tb[2] + lo_bf(y1.w); yv[x * 8 + 7] = tb[3] + hi_bf(y1.w); }
#pragma unroll
      for (int x = 0; x < 32; ++x) s += yv[x];
      s = quad_sum(s); const float mean = s * (1.0f / 128.0f); float s2 = 0.f;
#pragma unroll
      for (int x = 0; x < 32; ++x) { yv[x] -= mean; s2 += yv[x] * yv[x]; }
      s2 = quad_sum(s2); const float rstd = rsqrtf(s2 * (1.0f / 128.0f) + 1e-5f);
      const bf16_t* gp = PS + (size_t)(row0 + i) * NCOLS + 1792 + 1536 + h * 128 + part * 32; const float* gw = P.gn_w + h * 128 + part * 32;
#pragma unroll
      for (int x = 0; x < 4; ++x) { const u32x4 g4 = *(const u32x4*)(gp + x * 8); const float4 w0 = *(const float4*)(gw + x * 8), w1 = *(const float4*)(gw + x * 8 + 4);
          const float gg[8] = {lo_bf(g4.x), hi_bf(g4.x), lo_bf(g4.y), hi_bf(g4.y), lo_bf(g4.z), hi_bf(g4.z), lo_bf(g4.w), hi_bf(g4.w)}; const float ww[8] = {w0.x, w0.y, w0.z, w0.w, w1.x, w1.y, w1.z, w1.w};
          float o[8];
#pragma unroll
          for (int z = 0; z < 8; ++z) o[z] = yv[x * 8 + z] * rstd * ww[z] * (gg[z] * __builtin_amdgcn_rcpf(1.0f + __expf(-gg[z])));
          u32x4 w; w.x = pg8::cvt_pk_bf16(o[0], o[1]); w.y = pg8::cvt_pk_bf16(o[2], o[3]); w.z = pg8::cvt_pk_bf16(o[4], o[5]); w.w = pg8::cvt_pk_bf16(o[6], o[7]);
          *(u32x4*)(yo + x * 8) = w; } }
    __syncthreads();
}

__device__ __forceinline__ void sub_barrier(unsigned* cnt, const unsigned target, const int wv) {
    asm volatile("s_waitcnt vmcnt(0)" ::: "memory");
    __syncthreads();
    if (fresh_tid(wv) == 0) {
        __builtin_amdgcn_fence(__ATOMIC_RELEASE, "agent");
        asm volatile("s_waitcnt vmcnt(0)" ::: "memory");
        (void)xb_add(cnt, 1u);
        unsigned sp = 0u;
        while (xb_ld(cnt) < target) { __builtin_amdgcn_s_sleep(2); if (++sp > (1u << 20)) break; }
        __builtin_amdgcn_fence(__ATOMIC_ACQUIRE, "agent");
        asm volatile("s_waitcnt vmcnt(0)" ::: "memory");
    }
    __syncthreads();
}

struct PostRegs { u32x2 yr, c_r, c_k, c_v, p_r, p_k, p_v, ar, gr; };
__device__ __forceinline__ void post_load(PR P, PostRegs& R, const int row, const int ch) {
    const bf16_t* PS = (const bf16_t*)(P.ws + WS_BIG); const bf16_t* ASIG = (const bf16_t*)(P.ws + WS_ASIG); const bf16_t* YS = (const bf16_t*)(P.ws + WS_YS); const bf16_t* G = (const bf16_t*)(P.ws + WS_WIN);
    R.yr = *(const u32x2*)(YS + (size_t)row * 512 + ch);
    const bf16_t* cp = PS + (size_t)row * NCOLS + ch; const int pr = prev_row(row);
    R.c_r = *(const u32x2*)cp; R.c_k = *(const u32x2*)(cp + 512); R.c_v = *(const u32x2*)(cp + 1024);
    R.p_r = (u32x2){0u, 0u}; R.p_k = R.p_r; R.p_v = R.p_r;
    if (pr >= 0) { const bf16_t* pp = PS + (size_t)pr * NCOLS + ch; R.p_r = *(const u32x2*)pp; R.p_k = *(const u32x2*)(pp + 512); R.p_v = *(const u32x2*)(pp + 1024); }
    R.ar = *(const u32x2*)(ASIG + (size_t)row * 512 + ch); R.gr = *(const u32x2*)(G + (size_t)row * 512 + ch);
}
__device__ __forceinline__ void rwkv_post(PR P, const int wv) {
    const int tid = fresh_tid(wv); const int lane = tid & 63; const int gw = blockIdx.x * 8 + (tid >> 6), nw = gridDim.x * 8;
    const int sub = lane >> 4, cg4 = (lane & 15) * 4;
    bf16_t* Y = (bf16_t*)(P.ws + WS_XN);
    const int h = (gw * 4 + sub) & 7, ch = h * 64 + cg4;
    const float4 mr = *(const float4*)(P.mu + ch), mk = *(const float4*)(P.mu + 512 + ch), mv = *(const float4*)(P.mu + 1024 + ch);
    const float4 ka = *(const float4*)(P.k_a + ch), rk = *(const float4*)(P.r_k + ch), lw = *(const float4*)(P.lnx_w + ch), lb = *(const float4*)(P.lnx_b + ch);
    const float m_r[4] = {mr.x, mr.y, mr.z, mr.w}, m_k[4] = {mk.x, mk.y, mk.z, mk.w}, m_v[4] = {mv.x, mv.y, mv.z, mv.w};
    const float kaa[4] = {ka.x, ka.y, ka.z, ka.w}, rkk[4] = {rk.x, rk.y, rk.z, rk.w}, lww[4] = {lw.x, lw.y, lw.z, lw.w}, lbb[4] = {lb.x, lb.y, lb.z, lb.w};
    PostRegs R, N;
    if (gw < MT * 2) post_load(P, R, (gw * 4 + sub) >> 3, ch);
    for (int task = gw; task < MT * 2; task += nw) {
        const int row = (task * 4 + sub) >> 3;
        if (task + nw < MT * 2) post_load(P, N, ((task + nw) * 4 + sub) >> 3, ch);
        const float ys[4] = {lo_bf(R.yr.x), hi_bf(R.yr.x), lo_bf(R.yr.y), hi_bf(R.yr.y)};
        const float mean = row16_sum(ys[0] + ys[1] + ys[2] + ys[3]) * (1.0f / 64.0f);
        float dl[4], s2 = 0.f;
#pragma unroll
        for (int j = 0; j < 4; ++j) { dl[j] = ys[j] - mean; s2 += dl[j] * dl[j]; }
        const float rstd = rsqrtf(row16_sum(s2) * (1.0f / 64.0f) + 64e-5f);
        const float cr[4] = {lo_bf(R.c_r.x), hi_bf(R.c_r.x), lo_bf(R.c_r.y), hi_bf(R.c_r.y)}, ck[4] = {lo_bf(R.c_k.x), hi_bf(R.c_k.x), lo_bf(R.c_k.y), hi_bf(R.c_k.y)}, cv[4] = {lo_bf(R.c_v.x), hi_bf(R.c_v.x), lo_bf(R.c_v.y), hi_bf(R.c_v.y)};
        const float qr[4] = {lo_bf(R.p_r.x), hi_bf(R.p_r.x), lo_bf(R.p_r.y), hi_bf(R.p_r.y)}, qk[4] = {lo_bf(R.p_k.x), hi_bf(R.p_k.x), lo_bf(R.p_k.y), hi_bf(R.p_k.y)}, qv[4] = {lo_bf(R.p_v.x), hi_bf(R.p_v.x), lo_bf(R.p_v.y), hi_bf(R.p_v.y)};
        const float aa[4] = {lo_bf(R.ar.x), hi_bf(R.ar.x), lo_bf(R.ar.y), hi_bf(R.ar.y)}, gg[4] = {lo_bf(R.gr.x), hi_bf(R.gr.x), lo_bf(R.gr.y), hi_bf(R.gr.y)};
        float v[4], bp = 0.f;
#pragma unroll
        for (int j = 0; j < 4; ++j) { const float r = cr[j] + (qr[j] - cr[j]) * m_r[j], k = ck[j] + (qk[j] - ck[j]) * m_k[j]; v[j] = cv[j] + (qv[j] - cv[j]) * m_v[j];
            const float kn = k * (1.0f + (aa[j] - 1.0f) * kaa[j]); bp += r * kn * rkk[j]; }
        const float bonus = row16_sum(bp);
        float o[4];
#pragma unroll
        for (int j = 0; j < 4; ++j) o[j] = (dl[j] * rstd * lww[j] + lbb[j] + bonus * v[j]) * gg[j];
        u32x2 w; w.x = pg8::cvt_pk_bf16(o[0], o[1]); w.y = pg8::cvt_pk_bf16(o[2], o[3]);
        *(u32x2*)(Y + (size_t)row * 1024 + ch) = w;
        R = N;
    }
}

__global__ void __launch_bounds__(512, 2) hymba_mega(Params P_unused) {
    extern __shared__ __attribute__((aligned(16))) unsigned char shm[];
    cg::grid_group grid = cg::this_grid();
    LAS unsigned char* lds = (LAS unsigned char*)shm; LAS float* ldsf = (LAS float*)shm;
    const int G = gridDim.x, bx = blockIdx.x;
    const int wv = __builtin_amdgcn_readfirstlane(threadIdx.x >> 6);
    const CAS Params* kp = (const CAS Params*)__builtin_amdgcn_kernarg_segment_ptr();
#define P (*kp)
#define FRESH() asm volatile("" : "+s"(kp))
#ifndef REP_SYNC
#define REP_SYNC 1
#endif
#ifndef REP_P7
#define REP_P7 1
#endif
#ifndef REP_FFN1
#define REP_FFN1 1
#endif
#ifndef REP_P0
#define REP_P0 1
#endif
#ifndef REP_P3
#define REP_P3 1
#endif
#ifndef REP_RW
#define REP_RW 1
#endif
#ifndef REP_OTH
#define REP_OTH 1
#endif
#ifndef REP_RETP
#define REP_RETP 1
#endif
#ifndef REP_SAMP
#define REP_SAMP 1
#endif
#ifndef REP_P8
#define REP_P8 1
#endif
#define GSYNC() do { for (int r_ = 0; r_ < REP_SYNC; ++r_) xcd_barrier((unsigned*)ws, (volatile LAS unsigned*)(lds + LDS_BYTES - 16), wv); FRESH(); } while (0)
#define ws (kp->ws)
#define XN ((bf16_t*)(ws + WS_XN))
#define ACT ((bf16_t*)(ws + WS_BIG))
#define FO ((float*)(ws + WS_FO))
#define PS ((bf16_t*)(ws + WS_BIG))
    pg8::StaticOrder S;
    { unsigned* barw = (unsigned*)ws; const int t0 = fresh_tid(wv); if (bx == 0) for (int i = t0; i < XCD_BAR_WORDS + 128; i += 512) barw[i] = 0u;
      if (t0 < 4) ((LAS unsigned*)(lds + LDS_BYTES - 16))[t0] = 0u; }
#ifndef PHM
#define PHM 0xFFFF
#endif
#define PH(k) if ((PHM >> (k)) & 1)
    for (int r0 = 0; r0 < REP_P0; ++r0) PH(0) p0_prologue(P, ldsf, wv);
    grid.sync(); FRESH();
    if (fresh_tid(wv) == 0) (void)xb_add(&((unsigned*)ws)[XB_XCNT(xb_xcc_id())], 1u);
    for (int rep1 = 0; rep1 < REP_FFN1; ++rep1) {
    PH(1) { pg8::Gemm g{XN, (const bf16_t*)(ws + WS_WGU), MT, NGU, 1024}; S.init(MT, NGU, G, bx, 1024); pg8::EpiSwiGLU E{ACT, DFF}; pg8::gemm_phase(lds, g, S, E, wv); }
    GSYNC();
    PH(2) { pg8::Gemm g{ACT, (const bf16_t*)(ws + WS_WD), MT, 1024, DFF}; pg8::SplitOrder S2; S2.init2(G, bx, DFF, 8); pg8::EpiFO E{(bf16_t*)FO, 1024, (float*)(ws + WS_OMD)}; pg8::gemm_phase(lds, g, S2, E, wv); }
    GSYNC();
    }
    for (int r3 = 0; r3 < REP_P3; ++r3) PH(3) rows_phase(P, 1, wv);
    GSYNC();
    PH(4) { pg8::Gemm g{XN, (const bf16_t*)(ws + WS_WIN), MIN_, NCOLS, 1024}; S.init(MIN_, NCOLS, G, bx, 1024); pg8::EpiBf16 E{PS, NCOLS}; pg8::gemm_phase(lds, g, S, E, wv); }
    GSYNC();
    PH(5) lora_prep(P, wv);
    GSYNC();
    PH(6) { pg8::Gemm g{(const bf16_t*)(ws + WS_LA), (const bf16_t*)(ws + WS_WL), MT, 1536, 256}; S.init(MP, 1024, G, bx, 256);
      pg8::EpiLora E{(bf16_t*)(ws + WS_OMD), (bf16_t*)(ws + WS_ASIG), (bf16_t*)(ws + WS_WIN), P.w0, P.a0}; pg8::gemm_phase(lds, g, S, E, wv); }
    GSYNC();
    {
    if (bx < 128) { for (int rw = 0; rw < REP_RW; ++rw) rwkv_unit<false>(P, ldsf, bx >> 4, (bx >> 1) & 7, bx & 1, wv); }
    else {
        { pg8::Gemm g{(const bf16_t*)(ws + WS_LA), (const bf16_t*)(ws + WS_WL), MT, 1536, 256}; pg8::LoraRestOrder SL; SL.ob = bx - 128;
          pg8::EpiLora E{(bf16_t*)(ws + WS_OMD), (bf16_t*)(ws + WS_ASIG), (bf16_t*)(ws + WS_WIN), P.w0, P.a0}; pg8::gemm_phase(lds, g, SL, E, wv); }
        FRESH();
        const int rep7 = 0; const int ob = bx - 128; unsigned* sbc = (unsigned*)ws + XCD_BAR_WORDS + 64;
        for (int k = 0; k < 4; ++k) { const int u = ob + k * 128; ret_unit_a(P, lds, u >> 4, u & 15, wv); }
        sub_barrier(sbc, 128u * (2u * rep7 + 1u), wv);
        ret_prefix(P, ob * 512 + fresh_tid(wv));
        sub_barrier(sbc, 128u * (2u * rep7 + 2u), wv);
        for (int k = 0; k < 4; ++k) { const int u = ob + k * 128; ret_unit_c(P, lds, u >> 4, u & 15, wv); }
        for (int u = ob; u < 2560; u += 128) { if (u < 2048) rwkv_unit<true>(P, ldsf, u >> 4, (u >> 1) & 7, u & 1, wv); else ret_sample_unit(P, ldsf, (u - 2048) >> 2, (u - 2048) & 3, wv); }
    }
    }
    GSYNC();
    for (int rep8 = 0; rep8 < REP_P8; ++rep8) PH(8) rwkv_post(P, wv);
    GSYNC();
    PH(9) { pg8::Gemm g{XN, (const bf16_t*)(ws + WS_WOUT), MT, 1024, 1024}; pg8::SplitOrder S2; S2.init2(G, bx, 1024, 4); pg8::EpiFO E{(bf16_t*)FO, 1024, (float*)(ws + WS_OMD)}; pg8::gemm_phase(lds, g, S2, E, wv); }
    GSYNC();
    PH(10) { tconv_list(P.f2g, P.f2u, P.f2d, nullptr, nullptr, ws, 2112, ldsf, wv);
    rows_phase(P, 2, wv); }
    GSYNC();
    PH(11) { pg8::Gemm g{XN, (const bf16_t*)(ws + WS_WGU), MT, NGU, 1024}; S.init(MT, NGU, G, bx, 1024); pg8::EpiSwiGLU E{ACT, DFF}; pg8::gemm_phase(lds, g, S, E, wv); }
    GSYNC();
    PH(12) { pg8::Gemm g{ACT, (const bf16_t*)(ws + WS_WD), MT, 1024, DFF}; pg8::SplitOrder S2; S2.init2(G, bx, DFF, 8); pg8::EpiFO E{(bf16_t*)FO, 1024, (float*)(ws + WS_OMD)}; pg8::gemm_phase(lds, g, S2, E, wv); }
    GSYNC();
    PH(13) rows_phase(P, 3, wv);
}

#undef ws
#undef XN
#undef ACT
#undef FO
#undef PS
#undef P
extern "C" void kernel_launch(void* const* d_in, const int* in_sizes, int n_in, void* d_out, int out_size, void* d_ws, size_t ws_size, hipStream_t stream) {
    static int grid = 0;
    if (grid == 0) {
        if (n_in != 26 || ws_size < WS_END) { fprintf(stderr, "kernel_launch: unexpected n_in %d or ws_size %zu (< %zu)\n", n_in, ws_size, (size_t)WS_END); grid = -1; return; }
        int dev = 0, cus = 0, per_cu = 0;
        hipGetDevice(&dev); hipDeviceGetAttribute(&cus, hipDeviceAttributeMultiprocessorCount, dev);
        hipFuncSetAttribute((const void*)hymba_mega, hipFuncAttributeMaxDynamicSharedMemorySize, LDS_BYTES);
        hipOccupancyMaxActiveBlocksPerMultiprocessor(&per_cu, (const void*)hymba_mega, 512, LDS_BYTES);
        if (per_cu < 1) { fprintf(stderr, "kernel_launch: occupancy query says %d blocks/CU\n", per_cu); per_cu = 1; }
        grid = cus * per_cu; if (grid > 256) grid = 256;
        if (grid != 256) { fprintf(stderr, "kernel_launch: this kernel needs 256 co-resident workgroups, got %d\n", grid); grid = -1; return; }
        fprintf(stderr, "kernel_launch: cus %d per_cu %d grid %d ws %zu\n", cus, per_cu, grid, ws_size);
    }
    if (grid < 0) return;
    Params p{};
    const float** pp = (const float**)&p;
    for (int i = 0; i < 26; ++i) pp[i] = (const float*)d_in[i];
    p.out = (float*)d_out; p.ws = (unsigned char*)d_ws;
    void* args[] = {&p};
    hipError_t e = hipLaunchCooperativeKernel((const void*)hymba_mega, dim3(grid), dim3(512), args, LDS_BYTES, stream);
    if (e != hipSuccess) fprintf(stderr, "cooperative launch failed: %s (grid %d)\n", hipGetErrorString(e), grid);
}
```

```cpp
#include <hip/hip_runtime.h>
#include <hip/hip_cooperative_groups.h>
#include <cstdio>
#include <cstdint>
namespace cg = cooperative_groups;

__device__ __forceinline__ int fresh_tid(int wv) { int l; asm volatile("v_mbcnt_lo_u32_b32 %0, -1, 0\n\tv_mbcnt_hi_u32_b32 %0, -1, %0" : "=v"(l)); return wv * 64 + l; }
namespace pg8 {
#define PG8_LAS __attribute__((address_space(3)))
typedef unsigned short bf16_t;
typedef short bf16x8 __attribute__((ext_vector_type(8)));
typedef float f32x4 __attribute__((ext_vector_type(4)));
typedef unsigned u32x4 __attribute__((ext_vector_type(4)));
typedef unsigned u32x2 __attribute__((ext_vector_type(2)));
constexpr int BM = 256, BK = 64, HALF = 128, HTB = HALF * BK * 2, STAGE_BYTES = 8 * HTB, NXCD = 8, WGM = 8;

__host__ __device__ __forceinline__ int lds_byte(int r, int c) { const int st = (r >> 4) * 2 + (c >> 5), rr = r & 15, cc = c & 31, ob = rr * 64 + cc * 2; return st * 1024 + (ob ^ (((ob >> 9) & 1) << 5)); }
__host__ __device__ __forceinline__ void stage_rc(int b, int& R, int& C) { const int st = b / 1024, sb = b % 1024, swz = sb ^ (((sb >> 9) & 1) << 5); R = (st >> 1) * 16 + swz / 64; C = (st & 1) * 32 + (swz % 64) / 2; }
__host__ __device__ __forceinline__ int perm32(int rho) { const int n = rho >> 4, i = rho & 15; return 8 * (i >> 2) + 4 * n + (i & 3); }

struct Unit { int pm, pn, k0, nkt, atomic; };
struct Gemm { const bf16_t* A; const bf16_t* Bt; int M, N, K; };

struct StaticOrder {
    int nM, nN, nwg, G, c, nt;
    __host__ __device__ void init(int M, int N, int G_, int c_, int K) { nM = M / BM; nN = N / BM; nwg = nM * nN; G = G_; c = c_; nt = K / BK; }
    __host__ __device__ bool next(int i, Unit& u) const {
        const long L = (long)i * G + c; if (L >= nwg) return false;
        int wgid = (int)L; { const int q = nwg / NXCD, r = nwg % NXCD, xcd = wgid % NXCD, off = wgid / NXCD; wgid = (xcd < r ? xcd * (q + 1) : r * (q + 1) + (xcd - r) * q) + off; }
        const int nig = WGM * nN, gid = wgid / nig, fm = gid * WGM, gsz = (nM - fm) < WGM ? (nM - fm) : WGM;
        u.pm = fm + ((wgid % nig) % gsz); u.pn = (wgid % nig) / gsz; u.k0 = 0; u.nkt = nt; u.atomic = 0; return true;
    }
    __device__ __forceinline__ void a_ready(const Unit&) const {}
    __device__ __forceinline__ void done(const Unit&) const {}
};
struct LoraMainOrder : StaticOrder {
    __host__ __device__ bool next(int i, Unit& u) const { if (!StaticOrder::next(i, u)) return false; u.k0 = 0; u.nkt = 2; return true; }
};
struct LoraRestOrder {
    int ob;
    __host__ __device__ bool next(int i, Unit& u) const {
        const int L = i * 128 + ob; if (L >= 140) return false;
        if (L < 132) { u.pm = L >> 1; u.pn = 4 + (L & 1); u.k0 = 2; } else { const int x = L - 132; u.pm = 64 + (x >> 2); u.pn = x & 3; u.k0 = 0; }
        u.nkt = 2; u.atomic = 0; return true;
    }
    __device__ __forceinline__ void a_ready(const Unit&) const {}
    __device__ __forceinline__ void done(const Unit&) const {}
};
struct SplitOrder : StaticOrder {
    int KS;
    __host__ __device__ void init2(int G_, int c_, int K, int KS_) { init(16384, 1024, G_, c_, K); KS = KS_; }
    __host__ __device__ bool next(int i, Unit& u) const {
        if (i == 0) return StaticOrder::next(0, u);
        if (i > 1 || c >= 8 * KS) return false;
        const int tile = c / KS, part = c % KS, pairs = nt / 2, q = pairs / KS, r = pairs % KS;
        u.pm = 64 + (tile >> 2); u.pn = tile & 3; u.k0 = 2 * (part * q + (part < r ? part : r)); u.nkt = 2 * (q + (part < r ? 1 : 0)); u.atomic = 1 + c; return true;
    }
};

typedef __bf16 bf16x2_t __attribute__((ext_vector_type(2)));
typedef float f32x2_t __attribute__((ext_vector_type(2)));
__device__ __forceinline__ unsigned cvt_pk_bf16(float lo, float hi) { const f32x2_t v = {lo, hi}; const bf16x2_t b = __builtin_convertvector(v, bf16x2_t); return __builtin_bit_cast(unsigned, b); }

struct EpiFO {
    static constexpr bool PERM = true;
    bf16_t* C; int ldc; float* slab;
    __device__ __forceinline__ void operator()(const f32x4 (&acc)[2][2][4][2], const Unit& u, int wr, int wc, int fr, int fq) const {
        if (u.atomic == 0) {
            const int row0 = u.pm * BM + wr * 64 + fr; const int col0 = u.pn * BM + wc * 32 + 8 * fq;
#pragma unroll
            for (int ai = 0; ai < 2; ++ai)
#pragma unroll
                for (int m = 0; m < 4; ++m) { bf16_t* rowp = C + (size_t)(row0 + ai * HALF + m * 16) * ldc + col0;
#pragma unroll
                    for (int bj = 0; bj < 2; ++bj) { const f32x4 v0 = acc[ai][bj][m][0], v1 = acc[ai][bj][m][1];
                        u32x4 w; w.x = cvt_pk_bf16(v0[0], v0[1]); w.y = cvt_pk_bf16(v0[2], v0[3]); w.z = cvt_pk_bf16(v1[0], v1[1]); w.w = cvt_pk_bf16(v1[2], v1[3]);
                        *(u32x4*)(rowp + bj * HALF) = w; } }
        } else {
            float* base = slab + (size_t)(u.atomic - 1) * (BM * BM) + (size_t)(wr * 64 + fr) * BM + wc * 32 + 8 * fq;
#pragma unroll
            for (int ai = 0; ai < 2; ++ai)
#pragma unroll
                for (int m = 0; m < 4; ++m) { float* rowp = base + (size_t)(ai * HALF + m * 16) * BM;
#pragma unroll
                    for (int bj = 0; bj < 2; ++bj) { *(f32x4*)(rowp + bj * HALF) = acc[ai][bj][m][0]; *(f32x4*)(rowp + bj * HALF + 4) = acc[ai][bj][m][1]; } }
        }
    }
};
struct EpiBf16 {
    static constexpr bool PERM = true;
    bf16_t* O; int ldc;
    __device__ __forceinline__ void operator()(const f32x4 (&acc)[2][2][4][2], const Unit& u, int wr, int wc, int fr, int fq) const {
        const int row0 = u.pm * BM + wr * 64 + fr; const int col0 = u.pn * BM + wc * 32 + 8 * fq;
#pragma unroll
        for (int ai = 0; ai < 2; ++ai)
#pragma unroll
            for (int m = 0; m < 4; ++m) { bf16_t* rowp = O + (size_t)(row0 + ai * HALF + m * 16) * ldc + col0;
#pragma unroll
                for (int bj = 0; bj < 2; ++bj) { const f32x4 v0 = acc[ai][bj][m][0], v1 = acc[ai][bj][m][1];
                    u32x4 w; w.x = cvt_pk_bf16(v0[0], v0[1]); w.y = cvt_pk_bf16(v0[2], v0[3]); w.z = cvt_pk_bf16(v1[0], v1[1]); w.w = cvt_pk_bf16(v1[2], v1[3]);
                    *(u32x4*)(rowp + bj * HALF) = w; } }
    }
};
__device__ __forceinline__ float silu_f(float x) { return x * __builtin_amdgcn_rcpf(1.0f + __expf(-x)); }
struct EpiSwiGLU {
    static constexpr bool PERM = true;
    bf16_t* O; int ldc;
    __device__ __forceinline__ void operator()(const f32x4 (&acc)[2][2][4][2], const Unit& u, int wr, int wc, int fr, int fq) const {
        const int row0 = u.pm * BM + wr * 64 + fr; const int col0 = u.pn * HALF + wc * 32 + 8 * fq;
#pragma unroll
        for (int ai = 0; ai < 2; ++ai)
#pragma unroll
            for (int m = 0; m < 4; ++m) { bf16_t* rowp = O + (size_t)(row0 + ai * HALF + m * 16) * ldc + col0;
                float o[8];
#pragma unroll
                for (int n = 0; n < 2; ++n)
#pragma unroll
                    for (int j = 0; j < 4; ++j) o[n * 4 + j] = silu_f(acc[ai][0][m][n][j]) * acc[ai][1][m][n][j];
                u32x4 w; w.x = cvt_pk_bf16(o[0], o[1]); w.y = cvt_pk_bf16(o[2], o[3]); w.z = cvt_pk_bf16(o[4], o[5]); w.w = cvt_pk_bf16(o[6], o[7]);
                *(u32x4*)rowp = w; }
    }
};
struct EpiLora {
    static constexpr bool PERM = true;
    bf16_t* OMD; bf16_t* ASIG; bf16_t* G; const float* w0; const float* a0;
    template <int KIND> __device__ __forceinline__ void body(const f32x4 (&acc)[2][2][4][2], bf16_t* O, const float* bias, int row0, int ch0) const {
#pragma unroll
        for (int bj = 0; bj < 2; ++bj)
#pragma unroll
            for (int ai = 0; ai < 2; ++ai)
#pragma unroll
                for (int m = 0; m < 4; ++m) { bf16_t* rowp = O + (size_t)(row0 + ai * HALF + m * 16) * 512 + ch0 + bj * HALF;
                    float o[8];
#pragma unroll
                    for (int n = 0; n < 2; ++n)
#pragma unroll
                        for (int j = 0; j < 4; ++j) { float v = acc[ai][bj][m][n][j];
                            if (KIND == 0) { v += bias[ch0 + bj * HALF + n * 4 + j]; const float e = 0.6065306597126334f * __builtin_amdgcn_rcpf(1.0f + __expf(-v));
                                float p = 1.0f / 40320.0f; p = -1.0f / 5040.0f + e * p; p = 1.0f / 720.0f + e * p; p = -1.0f / 120.0f + e * p; p = 1.0f / 24.0f + e * p; p = -1.0f / 6.0f + e * p; p = 0.5f + e * p; p = 1.0f - e * p;
                                v = e * p; }
                            else if (KIND == 1) { v += bias[ch0 + bj * HALF + n * 4 + j]; v = __builtin_amdgcn_rcpf(1.0f + __expf(-v)); }
                            o[n * 4 + j] = v; }
                    u32x4 w; w.x = cvt_pk_bf16(o[0], o[1]); w.y = cvt_pk_bf16(o[2], o[3]); w.z = cvt_pk_bf16(o[4], o[5]); w.w = cvt_pk_bf16(o[6], o[7]);
                    *(u32x4*)rowp = w; __builtin_amdgcn_sched_barrier(0); }
    }
    __device__ __forceinline__ void operator()(const f32x4 (&acc)[2][2][4][2], const Unit& u, int wr, int wc, int fr, int fq) const {
        const int kind = u.pn >> 1;
        const int row0 = u.pm * BM + wr * 64 + fr; const int ch0 = (u.pn & 1) * BM + wc * 32 + 8 * fq;
        if (kind == 0) body<0>(acc, OMD, w0, row0, ch0); else if (kind == 1) body<1>(acc, ASIG, a0, row0, ch0); else body<2>(acc, G, a0, row0, ch0);
    }
};

template <class Epi, class Sched>
__device__ __forceinline__ void gemm_phase(PG8_LAS unsigned char* lds, const Gemm g, const Sched& S, const Epi& E, const int wv) {
    const int tid = fresh_tid(wv), wid = __builtin_amdgcn_readfirstlane(tid >> 6), lane = tid & 63, wr = wid >> 2, wc = wid & 3, fr = lane & 15, fq = lane >> 4;
    const int K = g.K;
    unsigned voffA[2], voffB[2];
#pragma unroll
    for (int i = 0; i < 2; ++i) { int R, C; stage_rc(tid * 16 + i * 8192, R, C); const int Rb = Epi::PERM ? ((R & ~31) + perm32(R & 31)) : R;
        voffA[i] = (unsigned)(R * K + C) * 2u; voffB[i] = (unsigned)(Rb * K + C) * 2u; }
    const size_t kstep = (size_t)(BK * 2);
    const size_t hstep = (size_t)HALF * K * 2;
    const size_t tstep = 2 * hstep;
    const unsigned ldsw = (unsigned)wid * 1024u;
    const int aoff = lds_byte(wr * 64 + fr, fq * 8), boff = lds_byte(wc * 32 + fr, fq * 8);
#define PG8_SA(b, h) (((b) * 2 + (h)) * HTB)
#define PG8_SB(b, h) ((4 + (b) * 2 + (h)) * HTB)
#define PG8_STAGE(bufoff, gbase, voff) do { _Pragma("unroll") for (int _i = 0; _i < 2; ++_i) \
        __builtin_amdgcn_global_load_lds((const unsigned*)((const char*)(gbase) + (voff)[_i]), (PG8_LAS unsigned*)(lds + (bufoff) + ldsw + _i * 8192), 16, 0, 0); } while (0)
#define PG8_LDA(dst, b, h) do { _Pragma("unroll") for (int m = 0; m < 4; ++m) _Pragma("unroll") for (int k = 0; k < 2; ++k) dst[m][k] = *(const PG8_LAS bf16x8*)(lds + PG8_SA(b, h) + aoff + m * 2048 + k * 1024); } while (0)
#define PG8_LDB(dst, b, h) do { _Pragma("unroll") for (int n = 0; n < 2; ++n) _Pragma("unroll") for (int k = 0; k < 2; ++k) dst[n][k] = *(const PG8_LAS bf16x8*)(lds + PG8_SB(b, h) + boff + n * 2048 + k * 1024); } while (0)
#define PG8_MMA(ai, bj, At, Bt) do { __builtin_amdgcn_s_setprio(1); _Pragma("unroll") for (int m = 0; m < 4; ++m) _Pragma("unroll") for (int n = 0; n < 2; ++n) _Pragma("unroll") for (int k = 0; k < 2; ++k) \
        acc[ai][bj][m][n] = __builtin_amdgcn_mfma_f32_16x16x32_bf16(Bt[n][k], At[m][k], acc[ai][bj][m][n], 0, 0, 0); __builtin_amdgcn_s_setprio(0); } while (0)
#define PG8_WAIT_V(n) asm volatile("s_waitcnt vmcnt(" #n ")" ::: "memory")
#define PG8_WAIT_L(n) asm volatile("s_waitcnt lgkmcnt(" #n ")" ::: "memory")
#define PG8_BAR __builtin_amdgcn_s_barrier()
#define PG8_SCHED __builtin_amdgcn_sched_barrier(0)
    Unit cur, nxt; int ui = 0;
    if (!S.next(0, cur)) return;
    f32x4 acc[2][2][4][2];
#pragma unroll
    for (int a = 0; a < 2; ++a)
#pragma unroll
        for (int b = 0; b < 2; ++b)
#pragma unroll
            for (int m = 0; m < 4; ++m)
#pragma unroll
                for (int n = 0; n < 2; ++n) acc[a][b][m][n] = (f32x4){0.f, 0.f, 0.f, 0.f};
    bf16x8 At[4][2], B0[2][2], B1[2][2];
    const char* cA = (const char*)g.A + (size_t)cur.pm * tstep + (size_t)cur.k0 * kstep; const char* cB = (const char*)g.Bt + (size_t)cur.pn * tstep + (size_t)cur.k0 * kstep;
    S.a_ready(cur);
    PG8_STAGE(PG8_SB(0, 0), cB, voffB); PG8_STAGE(PG8_SA(0, 0), cA, voffA); PG8_STAGE(PG8_SB(0, 1), cB + hstep, voffB); PG8_STAGE(PG8_SA(0, 1), cA + hstep, voffA);
    if (wr == 1) PG8_BAR;
    PG8_WAIT_V(4); PG8_BAR;
    PG8_STAGE(PG8_SB(1, 0), cB + kstep, voffB); PG8_STAGE(PG8_SA(1, 0), cA + kstep, voffA); PG8_STAGE(PG8_SB(1, 1), cB + hstep + kstep, voffB);
    PG8_WAIT_V(6); PG8_BAR;
    for (;;) {
        const bool has_next = S.next(ui + 1, nxt);
        const char* nA = has_next ? (const char*)g.A + (size_t)nxt.pm * tstep + (size_t)nxt.k0 * kstep : cA; const char* nB = has_next ? (const char*)g.Bt + (size_t)nxt.pn * tstep + (size_t)nxt.k0 * kstep : cB;
        const int nt = cur.nkt;
        for (int t = 0; t < nt; t += 2) {
            const bool last = (t == nt - 2);
            const char* a1 = cA + (size_t)(t + 1) * kstep;
            const char* a2 = last ? nA : cA + (size_t)(t + 2) * kstep; const char* b2 = last ? nB : cB + (size_t)(t + 2) * kstep;
            const char* a3 = a2 + kstep; const char* b3 = b2 + kstep;
            if (last && has_next) S.a_ready(nxt);
            PG8_LDB(B0, 0, 0); PG8_SCHED; PG8_LDA(At, 0, 0); PG8_STAGE(PG8_SA(1, 1), a1 + hstep, voffA);
            PG8_WAIT_L(8); PG8_BAR; PG8_WAIT_L(0); PG8_MMA(0, 0, At, B0); PG8_BAR; PG8_SCHED;
            PG8_LDB(B1, 0, 1); PG8_STAGE(PG8_SB(0, 0), b2, voffB);
            PG8_BAR; PG8_WAIT_L(0); PG8_MMA(0, 1, At, B1); PG8_BAR;
            PG8_LDA(At, 0, 1); PG8_STAGE(PG8_SA(0, 0), a2, voffA);
            PG8_BAR; PG8_WAIT_L(0); PG8_MMA(1, 0, At, B0); PG8_BAR; PG8_SCHED;
            PG8_STAGE(PG8_SB(0, 1), b2 + hstep, voffB);
            PG8_WAIT_V(6); PG8_BAR; PG8_MMA(1, 1, At, B1); PG8_BAR;
            PG8_LDB(B0, 1, 0); PG8_SCHED; PG8_LDA(At, 1, 0); PG8_STAGE(PG8_SA(0, 1), a2 + hstep, voffA);
            PG8_WAIT_L(8); PG8_BAR; PG8_WAIT_L(0); PG8_MMA(0, 0, At, B0); PG8_BAR; PG8_SCHED;
            PG8_LDB(B1, 1, 1); PG8_STAGE(PG8_SB(1, 0), b3, voffB);
            PG8_BAR; PG8_WAIT_L(0); PG8_MMA(0, 1, At, B1); PG8_BAR;
            PG8_LDA(At, 1, 1); PG8_STAGE(PG8_SA(1, 0), a3, voffA);
            PG8_BAR; PG8_WAIT_L(0); PG8_MMA(1, 0, At, B0); PG8_BAR; PG8_SCHED;
            PG8_STAGE(PG8_SB(1, 1), b3 + hstep, voffB);
            PG8_WAIT_V(6); PG8_BAR; PG8_MMA(1, 1, At, B1); PG8_BAR;
        }
        { const int l2 = fresh_tid(wv) & 63; E(acc, cur, wr, wc, l2 & 15, l2 >> 4); } S.done(cur);
        if (!has_next) break;
#pragma unroll
        for (int a = 0; a < 2; ++a)
#pragma unroll
            for (int b = 0; b < 2; ++b)
#pragma unroll
                for (int m = 0; m < 4; ++m)
#pragma unroll
                    for (int n = 0; n < 2; ++n) acc[a][b][m][n] = (f32x4){0.f, 0.f, 0.f, 0.f};
        cur = nxt; cA = nA; cB = nB; ++ui;
    }
    PG8_WAIT_V(0);
    if (wr == 0) PG8_BAR;
    PG8_BAR;
#undef PG8_SA
#undef PG8_SB
#undef PG8_STAGE
#undef PG8_LDA
#undef PG8_LDB
#undef PG8_MMA
#undef PG8_WAIT_V
#undef PG8_WAIT_L
#undef PG8_BAR
#undef PG8_SCHED
}
}

using pg8::bf16_t; using pg8::f32x4; using pg8::bf16x8; using pg8::u32x4; using pg8::u32x2;
#define LAS __attribute__((address_space(3)))

constexpr int D = 1024, DFF = 2816, NGU = 5632, NCOLS = 3840;
constexpr int MP = 16384, MS = 512, MT = 16896, MIN_ = 17152;
constexpr int LDS_BYTES = 147456;
constexpr size_t O_SHP = 17301504, O_WKP = O_SHP + 8192, O_RTP = O_WKP + 262144, O_SHS = O_RTP + 524288, O_WKS = O_SHS + 131072, O_RTS = O_WKS + 4194304;
constexpr size_t WS_ROPE = 16384;
constexpr size_t WS_WL   = WS_ROPE + 1050624;
constexpr size_t WS_WOUT = WS_WL + 786432;
constexpr size_t WS_WIN  = WS_WOUT + 2097152;
constexpr size_t WS_WGU  = WS_WIN + 7864320;
constexpr size_t WS_WD   = WS_WGU + 11534336;
constexpr size_t WS_XN   = WS_WD + 5767168;
constexpr size_t WS_BIG  = WS_XN + 35127296;
constexpr size_t WS_FO   = WS_BIG + 95158272;
constexpr size_t WS_YS   = WS_BIG + 131727360;
constexpr size_t WS_LA   = WS_YS + 17301504;
constexpr size_t WS_OMD  = WS_BIG + 164364288;
constexpr size_t WS_ASIG = WS_OMD + 17301504;
constexpr size_t WS_END  = WS_ASIG + 17301504;
static_assert(WS_LA + 8650752 <= WS_OMD, "mixer overlays");
static_assert(WS_END <= 268435456, "workspace");

struct Params {
    const float *x_prompt, *x_sample, *state_shift, *state_wkv, *state_ret, *norm_g, *f1g, *f1u, *f1d, *w_in, *mu, *w0, *w2, *a0, *a2, *g2, *k_k, *k_a, *r_k, *lnx_w, *lnx_b, *gn_w, *w_out, *f2g, *f2u, *f2d;
    float* out; unsigned char* ws;
};
#define CAS __attribute__((address_space(4)))
typedef const CAS Params& PR;

__device__ __forceinline__ float bf2f(unsigned b) { return __uint_as_float(b << 16); }
__device__ __forceinline__ bf16_t f2bf(float f) { unsigned u = __float_as_uint(f); u += 0x7FFFu + ((u >> 16) & 1u); return (bf16_t)(u >> 16); }
__device__ __forceinline__ float lo_bf(unsigned x) { return __uint_as_float(x << 16); }
__device__ __forceinline__ float hi_bf(unsigned x) { return __uint_as_float(x & 0xffff0000u); }
template <int CTRL> __device__ __forceinline__ float dppf(float v) { return __int_as_float(__builtin_amdgcn_update_dpp(0, __float_as_int(v), CTRL, 0xF, 0xF, false)); }
__device__ __forceinline__ float row16_sum(float v) { v += dppf<0xB1>(v); v += dppf<0x4E>(v); v += dppf<0x141>(v); v += dppf<0x140>(v); return v; }
__device__ __forceinline__ float wave_sum(float v) { v = row16_sum(v); const int i = __float_as_int(v);
    return __int_as_float(__builtin_amdgcn_readlane(i, 0)) + __int_as_float(__builtin_amdgcn_readlane(i, 16)) + __int_as_float(__builtin_amdgcn_readlane(i, 32)) + __int_as_float(__builtin_amdgcn_readlane(i, 48)); }
__device__ __forceinline__ float quad_sum(float v) { v += dppf<0xB1>(v); v += dppf<0x4E>(v); return v; }
__device__ __forceinline__ float sigmoid_f(float x) { return __builtin_amdgcn_rcpf(1.0f + __expf(-x)); }


#define XB_TMO      128
#define XB_XCNT(j)  (256  + 64 * (j))
#define XB_XSUB(j)  (1280 + 64 * (j))
#define XB_XGEN(j)  (2304 + 64 * (j))
#define XB_TOP      3328
#define XB_TOPGEN   3392
#define XCD_BAR_WORDS 3456
#define XB_SPIN_CAP (1u << 18)
__device__ __forceinline__ unsigned xb_ld(unsigned* p)              { return __hip_atomic_load(p, __ATOMIC_RELAXED, __HIP_MEMORY_SCOPE_AGENT); }
__device__ __forceinline__ unsigned xb_add(unsigned* p, unsigned v) { return __hip_atomic_fetch_add(p, v, __ATOMIC_RELAXED, __HIP_MEMORY_SCOPE_AGENT); }
__device__ __forceinline__ unsigned xb_xcc_id() { return (unsigned)__builtin_amdgcn_s_getreg((3 << 11) | 20) & 0xFu; }
#define XB_SPIN(cond, bar) do { unsigned _sp = 0; while (cond) { __builtin_amdgcn_s_sleep(1); \
    if ((++_sp & 255u) == 0u) { if (xb_ld(&(bar)[XB_TMO])) break; if (_sp > XB_SPIN_CAP) { atomicAdd(&(bar)[XB_TMO], 1u); break; } } } } while (0)
struct XcdBarrier { unsigned* bar; unsigned x; volatile LAS unsigned* st; };
__device__ __forceinline__ XcdBarrier xcd_barrier_post(unsigned* bar, volatile LAS unsigned* st) {
    XcdBarrier b; b.bar = bar; b.x = xb_xcc_id(); b.st = st;
    return b;
}
__device__ __forceinline__ void xcd_barrier_complete(unsigned* bar, unsigned x, unsigned& nloc, unsigned& nx) {
    const unsigned G = gridDim.x * gridDim.y * gridDim.z;
    unsigned sum, cnt, mine, sp = 0u;
    for (;;) {
        sum = 0u; cnt = 0u; mine = 0u;
#pragma unroll
        for (unsigned j = 0; j < 16; ++j) { const unsigned c = xb_ld(&bar[XB_XCNT(j)]); sum += c; cnt += (c > 0u) ? 1u : 0u; mine = (j == x) ? c : mine; }
        if (sum == G) break;
        __builtin_amdgcn_s_sleep(1);
        if ((++sp & 255u) == 0u) { if (xb_ld(&bar[XB_TMO])) break; if (sp > XB_SPIN_CAP) { atomicAdd(&bar[XB_TMO], 1u); break; } }
    }
    nloc = mine > 0u ? mine : 1u; nx = cnt > 0u ? cnt : 1u;
}
__device__ __forceinline__ void xcd_barrier(unsigned* barw, volatile LAS unsigned* stw, const int wv) {
    XcdBarrier b; b.bar = barw; b.x = xb_xcc_id(); b.st = stw;
    asm volatile("s_waitcnt vmcnt(0)" ::: "memory");
    __syncthreads();
    if (fresh_tid(wv) == 0) {
        unsigned* bar = b.bar;
        __builtin_amdgcn_s_waitcnt(0);
        unsigned nloc = b.st[0], nx = b.st[1];
        if (nloc == 0u) { xcd_barrier_complete(bar, b.x, nloc, nx); b.st[0] = nloc; b.st[1] = nx; }
        const unsigned old = xb_add(&bar[XB_XSUB(b.x)], 1u);
        const unsigned gen = old / nloc;
        if (old + 1u == (gen + 1u) * nloc) {
            __builtin_amdgcn_fence(__ATOMIC_RELEASE, "agent");
            asm volatile("s_waitcnt vmcnt(0)" ::: "memory");
            const unsigned og = xb_add(&bar[XB_TOP], 1u);
            const unsigned tg = og / nx;
            if (og + 1u == (tg + 1u) * nx) xb_add(&bar[XB_TOPGEN], 1u);
            else XB_SPIN(xb_ld(&bar[XB_TOPGEN]) == tg, bar);
            __builtin_amdgcn_fence(__ATOMIC_ACQUIRE, "agent");
            xb_add(&bar[XB_XGEN(b.x)], 1u);
            asm volatile("s_waitcnt vmcnt(0)" ::: "memory");
        } else {
            XB_SPIN(xb_ld(&bar[XB_XGEN(b.x)]) == gen, bar);
            __builtin_amdgcn_fence(__ATOMIC_ACQUIRE, "agent");
            asm volatile("s_waitcnt vmcnt(0)" ::: "memory");
        }
    }
    __syncthreads();
}


#define DPP2(x, y, CTRL, NOP) asm volatile(NOP "\n\tv_add_f32_dpp %0, %0, %0 " CTRL " row_mask:0xf bank_mask:0xf bound_ctrl:1\n\tv_add_f32_dpp %1, %1, %1 " CTRL " row_mask:0xf bank_mask:0xf bound_ctrl:1" : "+v"(x), "+v"(y))
#define DPP4(x, y, z, w, CTRL, NOP) asm volatile(NOP "\n\tv_add_f32_dpp %0, %0, %0 " CTRL " row_mask:0xf bank_mask:0xf bound_ctrl:1\n\tv_add_f32_dpp %1, %1, %1 " CTRL " row_mask:0xf bank_mask:0xf bound_ctrl:1\n\tv_add_f32_dpp %2, %2, %2 " CTRL " row_mask:0xf bank_mask:0xf bound_ctrl:1\n\tv_add_f32_dpp %3, %3, %3 " CTRL " row_mask:0xf bank_mask:0xf bound_ctrl:1" : "+v"(x), "+v"(y), "+v"(z), "+v"(w))
#define ROW16_SUM4(x, y, z, w) do { DPP4(x, y, z, w, "quad_perm:[1,0,3,2]", "s_nop 1"); DPP4(x, y, z, w, "quad_perm:[2,3,0,1]", ""); DPP4(x, y, z, w, "row_half_mirror", ""); DPP4(x, y, z, w, "row_mirror", ""); } while (0)
#define ROW16_SUM2(x, y) do { DPP2(x, y, "quad_perm:[1,0,3,2]", "s_nop 1"); DPP2(x, y, "quad_perm:[2,3,0,1]", "s_nop 0"); DPP2(x, y, "row_half_mirror", "s_nop 0"); DPP2(x, y, "row_mirror", "s_nop 0"); } while (0)
__device__ __forceinline__ int prev_row(int r) {
    if (r < MP) return (r & 2047) == 0 ? -1 : r - 1;
    const int s = r - MP; return (s & 3) == 0 ? MT + (s >> 2) : r - 1;
}

struct TDesc { const float* W; bf16_t* Bt; int K, N, k0, n0, brow0; };
__device__ __forceinline__ TDesc tconv_desc(const float* wg, const float* wu, const float* wd, const float* win, const float* wout, unsigned char* ws, int i) {
    TDesc d; int mode = 0, tile = i;
    if (i < 704) { d.W = wg; d.Bt = (bf16_t*)(ws + WS_WGU); d.K = 1024; d.N = DFF; mode = 1; }
    else if (i < 1408) { d.W = wu; d.Bt = (bf16_t*)(ws + WS_WGU); d.K = 1024; d.N = DFF; mode = 2; tile = i - 704; }
    else if (i < 2112) { d.W = wd; d.Bt = (bf16_t*)(ws + WS_WD); d.K = DFF; d.N = 1024; tile = i - 1408; }
    else if (i < 3072) { d.W = win; d.Bt = (bf16_t*)(ws + WS_WIN); d.K = 1024; d.N = NCOLS; tile = i - 2112; }
    else { d.W = wout; d.Bt = (bf16_t*)(ws + WS_WOUT); d.K = 1024; d.N = 1024; tile = i - 3072; }
    const int nkt = d.K / 64; const int kt = tile % nkt, nt = tile / nkt; d.k0 = kt * 64; d.n0 = nt * 64;
    d.brow0 = mode == 0 ? d.n0 : ((d.n0 >> 7) * 256 + (d.n0 & 127) + (mode == 2 ? 128 : 0));
    return d;
}
__device__ __forceinline__ void tconv_list(const float* wg, const float* wu, const float* wd, const float* win, const float* wout, unsigned char* ws, const int ntiles, LAS float* t, const int wv) {
    const int tid = fresh_tid(wv); const int G = gridDim.x;
    float cur[8], nxt[8];
    int i = blockIdx.x;
    if (i < ntiles) { const TDesc d = tconv_desc(wg, wu, wd, win, wout, ws, i);
#pragma unroll
        for (int e = 0; e < 8; ++e) { const int idx = e * 512 + tid, r = idx >> 6, c = idx & 63; cur[e] = d.W[(size_t)(d.k0 + r) * d.N + d.n0 + c]; } }
    for (; i < ntiles; i += G) {
        const TDesc d = tconv_desc(wg, wu, wd, win, wout, ws, i);
        if (i + G < ntiles) { const TDesc dn = tconv_desc(wg, wu, wd, win, wout, ws, i + G);
#pragma unroll
            for (int e = 0; e < 8; ++e) { const int idx = e * 512 + tid, r = idx >> 6, c = idx & 63; nxt[e] = dn.W[(size_t)(dn.k0 + r) * dn.N + dn.n0 + c]; } }
#pragma unroll
        for (int e = 0; e < 8; ++e) { const int idx = e * 512 + tid, r = idx >> 6, c = idx & 63; t[r * 65 + c] = cur[e]; }
        __syncthreads();
#pragma unroll
        for (int e = 0; e < 4; ++e) { const int idx = e * 512 + tid, n = idx >> 5, kp = idx & 31;
            const unsigned w = pg8::cvt_pk_bf16(t[(2 * kp) * 65 + n], t[(2 * kp + 1) * 65 + n]);
            *(unsigned*)(d.Bt + (size_t)(d.brow0 + n) * d.K + d.k0 + 2 * kp) = w; }
        __syncthreads();
#pragma unroll
        for (int e = 0; e < 8; ++e) cur[e] = nxt[e];
    }
}

__device__ __forceinline__ void rows_phase(PR P, const int mode, const int wv) {
    const int tid = fresh_tid(wv); const int lane = tid & 63; const int gw = blockIdx.x * 8 + (tid >> 6), nw = gridDim.x * 8;
    const bf16_t* FO = (const bf16_t*)(P.ws + WS_FO); bf16_t* XN = (bf16_t*)(P.ws + WS_XN);
    const float* gpost = P.norm_g + (mode == 1 ? 1 : (mode == 2 ? 3 : 5)) * 1024;
    const float* gnext = P.norm_g + (mode == 0 ? 0 : (mode == 1 ? 2 : 4)) * 1024;
    const float scale = mode == 2 ? 1.0f : 0.5f;
    for (int row = gw; row < MT; row += nw) {
        float4 xv[4];
        if (mode <= 1) { const float* xin = row < MP ? P.x_prompt + (size_t)row * 1024 : P.x_sample + (size_t)(row - MP) * 1024;
#pragma unroll
            for (int q = 0; q < 4; ++q) xv[q] = *(const float4*)(xin + (q * 64 + lane) * 4); }
        else { const bf16_t* xb = (mode == 2 ? (const bf16_t*)P.out : (const bf16_t*)(P.ws + WS_FO + 34603008)) + (size_t)row * 1024;
#pragma unroll
            for (int q = 0; q < 4; ++q) { const u32x2 t = *(const u32x2*)(xb + (q * 64 + lane) * 4); xv[q] = make_float4(lo_bf(t.x), hi_bf(t.x), lo_bf(t.y), hi_bf(t.y)); } }
        if (mode != 0) {
            float4 fo[4]; float ss = 0.f;
#pragma unroll
            for (int q = 0; q < 4; ++q) {
                if (row < MP) { const u32x2 fb = *(const u32x2*)(FO + (size_t)row * 1024 + (q * 64 + lane) * 4); fo[q] = make_float4(lo_bf(fb.x), hi_bf(fb.x), lo_bf(fb.y), hi_bf(fb.y)); }
                else {
                    const int KS = mode == 2 ? 4 : 8; const float* sl = (const float*)(P.ws + WS_OMD) + (size_t)((((row - MP) >> 8) * 4 + q) * KS) * 65536 + (size_t)(row & 255) * 256 + lane * 4;
                    float4 a = *(const float4*)sl;
                    for (int p = 1; p < KS; ++p) { const float4 b = *(const float4*)(sl + (size_t)p * 65536); a.x += b.x; a.y += b.y; a.z += b.z; a.w += b.w; }
                    fo[q] = a; }
                ss += fo[q].x * fo[q].x + fo[q].y * fo[q].y + fo[q].z * fo[q].z + fo[q].w * fo[q].w; }
            ss = wave_sum(ss); const float r = rsqrtf(ss * (1.0f / 1024.0f) + 1e-6f) * scale;
#pragma unroll
            for (int q = 0; q < 4; ++q) { const float4 g = *(const float4*)(gpost + (q * 64 + lane) * 4);
                xv[q].x += fo[q].x * r * g.x; xv[q].y += fo[q].y * r * g.y; xv[q].z += fo[q].z * r * g.z; xv[q].w += fo[q].w * r * g.w;
                if (mode == 3) *(float4*)(P.out + (size_t)row * 1024 + (q * 64 + lane) * 4) = xv[q];
                else { bf16_t* xo = (mode == 1 ? (bf16_t*)P.out : (bf16_t*)(P.ws + WS_FO + 34603008)) + (size_t)row * 1024; u32x2 t; t.x = pg8::cvt_pk_bf16(xv[q].x, xv[q].y); t.y = pg8::cvt_pk_bf16(xv[q].z, xv[q].w);
                    *(u32x2*)(xo + (q * 64 + lane) * 4) = t; } }
            if (mode == 3) continue;
        }
        float ss2 = 0.f;
#pragma unroll
        for (int q = 0; q < 4; ++q) ss2 += xv[q].x * xv[q].x + xv[q].y * xv[q].y + xv[q].z * xv[q].z + xv[q].w * xv[q].w;
        ss2 = wave_sum(ss2); const float r2 = rsqrtf(ss2 * (1.0f / 1024.0f) + 1e-6f);
        float* sh = nullptr;
        if (mode == 1) { if (row < MP) { if ((row & 2047) == 2047) sh = P.out + O_SHP + (size_t)(row >> 11) * 1024; } else { const int s = row - MP; if ((s & 3) == 3) sh = P.out + O_SHS + (size_t)(s >> 2) * 1024; } }
#pragma unroll
        for (int q = 0; q < 4; ++q) { const float4 g = *(const float4*)(gnext + (q * 64 + lane) * 4);
            float4 hv; hv.x = xv[q].x * r2 * g.x; hv.y = xv[q].y * r2 * g.y; hv.z = xv[q].z * r2 * g.z; hv.w = xv[q].w * r2 * g.w;
            u32x2 w; w.x = pg8::cvt_pk_bf16(hv.x, hv.y); w.y = pg8::cvt_pk_bf16(hv.z, hv.w);
            *(u32x2*)(XN + (size_t)row * 1024 + (q * 64 + lane) * 4) = w;
            if (sh) *(float4*)(sh + (q * 64 + lane) * 4) = hv; }
    }
}

__device__ __forceinline__ void p0_prologue(PR P, LAS float* ldsf, const int wv) {
    const int tid = fresh_tid(wv); const size_t gt = (size_t)blockIdx.x * 512 + tid, nth = (size_t)gridDim.x * 512;
    { float* rc = (float*)(P.ws + WS_ROPE); float* rs = rc + 2052 * 64;
      for (size_t i = gt; i < 2052 * 64; i += nth) { const int p = (int)(i >> 6), f = (int)(i & 63); const int pos = p < 2048 ? p : 16384 + (p - 2048);
          double inv = 1.0; for (int q = 0; q < f; ++q) inv *= 0.8659643233600653;
          const double ang = (double)pos * inv; const double n = rint(ang * 0.15915494309189535); const double r = ang - n * 6.283185307179586;
          const double r2 = r * r; double s = 0.0, c = 0.0;
          for (int k = 14; k >= 0; --k) { s = s * (-r2 / (double)((2 * k + 2) * (2 * k + 3))) + 1.0; c = c * (-r2 / (double)((2 * k + 1) * (2 * k + 2))) + 1.0; }
          rc[i] = (float)c; rs[i] = (float)(s * r); } }
    { bf16_t* Wl = (bf16_t*)(P.ws + WS_WL);
      for (size_t i = gt; i < 1536 * 256; i += nth) { const int n = (int)(i >> 8), k = (int)(i & 255); float v = 0.f;
          if (n < 512) { if (k < 64) v = P.w2[k * 512 + n]; } else if (n < 1024) { if (k >= 64 && k < 128) v = P.a2[(k - 64) * 512 + (n - 512)]; } else { if (k >= 128) v = P.g2[(k - 128) * 512 + (n - 1024)]; }
          Wl[i] = f2bf(v); } }
    { bf16_t* XN = (bf16_t*)(P.ws + WS_XN);
      for (size_t i = gt; i < 256 * 1024; i += nth) { const int r = (int)(i >> 10); XN[(size_t)MT * 1024 + i] = r < 128 ? f2bf(P.state_shift[i]) : (bf16_t)0; } }
    tconv_list(P.f1g, P.f1u, P.f1d, P.w_in, P.w_out, P.ws, 3328, ldsf, wv);
    rows_phase(P, 0, wv);
}

__device__ __forceinline__ void lora_prep(PR P, const int wv) {
    const int tid = fresh_tid(wv); const int lane = tid & 63; const int gw = blockIdx.x * 8 + (tid >> 6), nw = gridDim.x * 8;
    const bf16_t* PS = (const bf16_t*)(P.ws + WS_BIG); bf16_t* LA = (bf16_t*)(P.ws + WS_LA);
    const float4 mu = *(const float4*)(P.mu + 1536 + lane * 4); const int kind = lane >> 4;
    u32x2 c = (u32x2){0u, 0u}, p = c, nc = c, np = c;
    if (gw < MT) { c = *(const u32x2*)(PS + (size_t)gw * NCOLS + 1536 + lane * 4); const int pr = prev_row(gw); if (pr >= 0) p = *(const u32x2*)(PS + (size_t)pr * NCOLS + 1536 + lane * 4); }
    for (int row = gw; row < MT; row += nw) {
        const int nrow = row + nw;
        if (nrow < MT) { nc = *(const u32x2*)(PS + (size_t)nrow * NCOLS + 1536 + lane * 4); const int pr = prev_row(nrow); np = (u32x2){0u, 0u}; if (pr >= 0) np = *(const u32x2*)(PS + (size_t)pr * NCOLS + 1536 + lane * 4); }
        float v[4]; const float cu[4] = {lo_bf(c.x), hi_bf(c.x), lo_bf(c.y), hi_bf(c.y)}, pv[4] = {lo_bf(p.x), hi_bf(p.x), lo_bf(p.y), hi_bf(p.y)}, m4[4] = {mu.x, mu.y, mu.z, mu.w};
#pragma unroll
        for (int j = 0; j < 4; ++j) { float x = cu[j] + (pv[j] - cu[j]) * m4[j];
            if (kind == 0) x = 1.0f - 2.0f * __builtin_amdgcn_rcpf(__expf(2.0f * x) + 1.0f); else if (kind >= 2) x = sigmoid_f(x);
            v[j] = x; }
        u32x2 w; w.x = pg8::cvt_pk_bf16(v[0], v[1]); w.y = pg8::cvt_pk_bf16(v[2], v[3]);
        *(u32x2*)(LA + (size_t)row * 256 + lane * 4) = w;
        c = nc; p = np;
    }
}

template <bool SAMPLE>
__device__ __forceinline__ void rwkv_unit(PR P, LAS float* lds, const int b, const int h, const int half, const int wv) {
    constexpr int T = SAMPLE ? 4 : 2048, TC = SAMPLE ? 4 : 32, NCH = T / TC;
    const int tid = fresh_tid(wv), lane = tid & 63, wid = tid >> 6;
    const bf16_t* PS = (const bf16_t*)(P.ws + WS_BIG); const bf16_t* OMD = (const bf16_t*)(P.ws + WS_OMD); const bf16_t* ASIG = (const bf16_t*)(P.ws + WS_ASIG);
    bf16_t* YS = (bf16_t*)(P.ws + WS_YS);
    const int row_base = SAMPLE ? MP + b * 4 : b * 2048;
    const int ltok = (tid - 256) >> 4, lcg = tid & 15; const bool lwave = tid >= 256; const int hch = h * 64 + lcg * 4;
    const float4 mur = *(const float4*)(P.mu + hch), muk = *(const float4*)(P.mu + 512 + hch), muv = *(const float4*)(P.mu + 1024 + hch);
    const float4 kk4 = *(const float4*)(P.k_k + hch), ka4 = *(const float4*)(P.k_a + hch);
    typedef float f32x2 __attribute__((ext_vector_type(2)));
    const int row0 = half * 32 + (wid & 3) * 8 + (lane >> 4) * 2, cgl = lane & 15, j0 = cgl * 4;
    f32x2 S[4];
#pragma unroll
    for (int c = 0; c < 4; ++c) S[c] = (f32x2){0.f, 0.f};
    float* sout = P.out + (SAMPLE ? O_WKS : O_WKP) + ((size_t)(b * 8 + h) * 64 + row0) * 64 + j0;
    if (SAMPLE && wid < 4) { const float* sp = P.state_wkv + ((size_t)(b * 8 + h) * 64 + row0) * 64 + j0; const float4 s0 = *(const float4*)sp, s1 = *(const float4*)(sp + 64);
        S[0] = (f32x2){s0.x, s1.x}; S[1] = (f32x2){s0.y, s1.y}; S[2] = (f32x2){s0.z, s1.z}; S[3] = (f32x2){s0.w, s1.w}; }
    LAS float* buf0 = lds; LAS float* buf1 = lds + TC * 384;
    u32x2 cr[2], ck[2], cv[2], pr[2], pk[2], pv[2], co[2], ca[2];
#define RW_LOAD1(c, U) do { if (lwave && ltok + 16 * (U) < TC) { const int t_ = (c) * TC + ltok + 16 * (U); const int row_ = row_base + t_; const int prow_ = SAMPLE ? (t_ == 0 ? MT + b : row_ - 1) : row_ - 1; \
        const bf16_t* cp_ = PS + (size_t)row_ * NCOLS + hch; cr[U] = *(const u32x2*)cp_; ck[U] = *(const u32x2*)(cp_ + 512); cv[U] = *(const u32x2*)(cp_ + 1024); \
        if (SAMPLE || t_ > 0) { const bf16_t* pp_ = PS + (size_t)prow_ * NCOLS + hch; pr[U] = *(const u32x2*)pp_; pk[U] = *(const u32x2*)(pp_ + 512); pv[U] = *(const u32x2*)(pp_ + 1024); } \
        else { pr[U] = (u32x2){0u, 0u}; pk[U] = pr[U]; pv[U] = pr[U]; } \
        co[U] = *(const u32x2*)(OMD + (size_t)row_ * 512 + hch); ca[U] = *(const u32x2*)(ASIG + (size_t)row_ * 512 + hch); } } while (0)
#define RW_LOAD(c) do { RW_LOAD1(c, 0); RW_LOAD1(c, 1); } while (0)
#define RW_MIX(cu, pv_, m) ((cu) + ((pv_) - (cu)) * (m))
#define RW_PROC1(dst, U) do { if (lwave && ltok + 16 * (U) < TC) { LAS float* d_ = (dst) + (ltok + 16 * (U)) * 384 + lcg * 4; \
        f32x4 r_, k_, v_, o_, a_; \
        r_[0] = RW_MIX(lo_bf(cr[U].x), lo_bf(pr[U].x), mur.x); r_[1] = RW_MIX(hi_bf(cr[U].x), hi_bf(pr[U].x), mur.y); r_[2] = RW_MIX(lo_bf(cr[U].y), lo_bf(pr[U].y), mur.z); r_[3] = RW_MIX(hi_bf(cr[U].y), hi_bf(pr[U].y), mur.w); \
        k_[0] = RW_MIX(lo_bf(ck[U].x), lo_bf(pk[U].x), muk.x); k_[1] = RW_MIX(hi_bf(ck[U].x), hi_bf(pk[U].x), muk.y); k_[2] = RW_MIX(lo_bf(ck[U].y), lo_bf(pk[U].y), muk.z); k_[3] = RW_MIX(hi_bf(ck[U].y), hi_bf(pk[U].y), muk.w); \
        v_[0] = RW_MIX(lo_bf(cv[U].x), lo_bf(pv[U].x), muv.x); v_[1] = RW_MIX(hi_bf(cv[U].x), hi_bf(pv[U].x), muv.y); v_[2] = RW_MIX(lo_bf(cv[U].y), lo_bf(pv[U].y), muv.z); v_[3] = RW_MIX(hi_bf(cv[U].y), hi_bf(pv[U].y), muv.w); \
        o_[0] = lo_bf(co[U].x); o_[1] = hi_bf(co[U].x); o_[2] = lo_bf(co[U].y); o_[3] = hi_bf(co[U].y); a_[0] = lo_bf(ca[U].x); a_[1] = hi_bf(ca[U].x); a_[2] = lo_bf(ca[U].y); a_[3] = hi_bf(ca[U].y); \
        f32x4 kk_; kk_[0] = k_[0] * kk4.x; kk_[1] = k_[1] * kk4.y; kk_[2] = k_[2] * kk4.z; kk_[3] = k_[3] * kk4.w; \
        float ss_ = kk_[0] * kk_[0] + kk_[1] * kk_[1] + kk_[2] * kk_[2] + kk_[3] * kk_[3]; ss_ = row16_sum(ss_); \
        const float inv_ = __builtin_amdgcn_rcpf(fmaxf(__builtin_amdgcn_sqrtf(ss_), 1e-12f)); kk_ = kk_ * inv_; \
        f32x4 kn_; kn_[0] = k_[0] * (1.0f + (a_[0] - 1.0f) * ka4.x); kn_[1] = k_[1] * (1.0f + (a_[1] - 1.0f) * ka4.y); kn_[2] = k_[2] * (1.0f + (a_[2] - 1.0f) * ka4.z); kn_[3] = k_[3] * (1.0f + (a_[3] - 1.0f) * ka4.w); \
        *(LAS f32x4*)(d_) = r_; *(LAS f32x4*)(d_ + 64) = o_; *(LAS f32x4*)(d_ + 128) = kn_; *(LAS f32x4*)(d_ + 192) = -kk_; *(LAS f32x4*)(d_ + 256) = kk_ * a_; *(LAS f32x4*)(d_ + 320) = v_; } } while (0)
#define RW_PROC(dst) do { RW_PROC1(dst, 0); RW_PROC1(dst, 1); } while (0)
    RW_LOAD(0); RW_PROC(buf0); __syncthreads();
    for (int c = 0; c < NCH; ++c) {
        LAS float* cur = (c & 1) ? buf1 : buf0; LAS float* nxt = (c & 1) ? buf0 : buf1;
        if (c + 1 < NCH) RW_LOAD(c + 1);
        if (wid < 4) {
            constexpr int GS = SAMPLE ? 4 : 16;
            for (int g = 0; g < TC / GS; ++g) {
                float yk0 = 0.f, yk1 = 0.f;
                const LAS float* q0 = cur + (g * GS) * 384;
                f32x4 r4 = *(const LAS f32x4*)(q0 + j0), o4 = *(const LAS f32x4*)(q0 + 64 + j0), k4 = *(const LAS f32x4*)(q0 + 128 + j0), a4 = *(const LAS f32x4*)(q0 + 192 + j0), b4 = *(const LAS f32x4*)(q0 + 256 + j0);
                f32x2 v2 = *(const LAS f32x2*)(q0 + 320 + row0);
                float py0 = 0.f, py1 = 0.f;
#pragma unroll
                for (int tt = 0; tt < GS; ++tt) {
                    const LAS float* qn = q0 + (tt + 1 < GS ? tt + 1 : tt) * 384;
                    const f32x4 nr4 = *(const LAS f32x4*)(qn + j0), no4 = *(const LAS f32x4*)(qn + 64 + j0), nk4 = *(const LAS f32x4*)(qn + 128 + j0), na4 = *(const LAS f32x4*)(qn + 192 + j0), nb4 = *(const LAS f32x4*)(qn + 256 + j0);
                    const f32x2 nv2 = *(const LAS f32x2*)(qn + 320 + row0);
                    f32x2 sa = (S[0] * a4[0] + S[1] * a4[1]) + (S[2] * a4[2] + S[3] * a4[3]);
                    float sx = sa.x, sy = sa.y; ROW16_SUM4(sx, sy, py0, py1); sa = (f32x2){sx, sy};
                    if (tt > 0) { yk0 = cgl == tt - 1 ? py0 : yk0; yk1 = cgl == tt - 1 ? py1 : yk1; }
#pragma unroll
                    for (int c = 0; c < 4; ++c) { f32x2 t = S[c] - S[c] * o4[c]; t = t + sa * b4[c]; S[c] = t + v2 * k4[c]; }
                    const f32x2 y = (S[0] * r4[0] + S[1] * r4[1]) + (S[2] * r4[2] + S[3] * r4[3]);
                    py0 = y.x; py1 = y.y;
                    r4 = nr4; o4 = no4; k4 = nk4; a4 = na4; b4 = nb4; v2 = nv2;
                }
                ROW16_SUM2(py0, py1); yk0 = cgl == GS - 1 ? py0 : yk0; yk1 = cgl == GS - 1 ? py1 : yk1;
                if (cgl < GS) *(unsigned*)(YS + (size_t)(row_base + c * TC + g * GS + cgl) * 512 + h * 64 + row0) = pg8::cvt_pk_bf16(yk0, yk1);
            }
        }
        if (c + 1 < NCH) RW_PROC(nxt);
        __syncthreads();
    }
    if (wid < 4) { *(float4*)sout = make_float4(S[0].x, S[1].x, S[2].x, S[3].x); *(float4*)(sout + 64) = make_float4(S[0].y, S[1].y, S[2].y, S[3].y); }
#undef RW_LOAD
#undef RW_PROC
#undef RW_LOAD1
#undef RW_PROC1
#undef RW_MIX
}

__device__ __forceinline__ void ret_sample_unit(PR P, LAS float* lds, const int b, const int h, const int wv) {
    const int tid = fresh_tid(wv), lane = tid & 63, wid = tid >> 6;
    const bf16_t* PS = (const bf16_t*)(P.ws + WS_BIG); bf16_t* Y = (bf16_t*)(P.ws + WS_XN);
    const float* rc = (const float*)(P.ws + WS_ROPE); const float* rs = rc + 2052 * 64;
    LAS float* q = lds; LAS float* k = lds + 512; LAS float* v = lds + 1024; LAS float* Pm = lds + 1536; LAS float* y2p = lds + 1600; LAS float* red = lds + 1600 + 2048;
    const float lg2 = log2f(1.0f - exp2f(-5.0f - (float)h));
    const int row0 = MP + b * 4;
    { const int t = (tid & 255) >> 6, f = tid & 63; const bf16_t* src = PS + (size_t)(row0 + t) * NCOLS + 1792 + h * 128;
      if (tid < 256) { const float cs = rc[(2048 + t) * 64 + f], sn = rs[(2048 + t) * 64 + f];
          const float q1 = bf2f(src[f]), q2 = bf2f(src[f + 64]); q[t * 128 + f] = q1 * cs - q2 * sn; q[t * 128 + f + 64] = q1 * sn + q2 * cs;
          const float k1 = bf2f(src[512 + f]), k2 = bf2f(src[512 + f + 64]); k[t * 128 + f] = (k1 * cs - k2 * sn) * 0.08838834764831845f; k[t * 128 + f + 64] = (k1 * sn + k2 * cs) * 0.08838834764831845f; }
      else { v[t * 128 + f] = bf2f(src[1024 + f]); v[t * 128 + f + 64] = bf2f(src[1024 + f + 64]); } }
    __syncthreads();
    if (wid == 0) { const int pi = lane >> 4, pj = (lane >> 2) & 3, part = lane & 3; float s = 0.f;
        for (int d = part * 32; d < part * 32 + 32; ++d) s += q[pi * 128 + d] * k[pj * 128 + d];
        s = quad_sum(s); if (part == 0) Pm[pi * 4 + pj] = pi >= pj ? s * exp2f(lg2 * (float)(pi - pj)) : 0.f; }
    { const int e = tid & 127, dg = tid >> 7; const float c4 = exp2f(lg2 * 4.0f), g3 = exp2f(lg2 * 3.0f), g2_ = exp2f(lg2 * 2.0f), g1 = exp2f(lg2);
      const float v0 = v[e] * g3, v1 = v[128 + e] * g2_, v2 = v[256 + e] * g1, v3 = v[384 + e];
      const float* S0 = P.state_ret + ((size_t)(b * 4 + h) * 128) * 128 + e; float* So = P.out + O_RTS + ((size_t)(b * 4 + h) * 128) * 128 + e;
      float a0 = 0.f, a1 = 0.f, a2 = 0.f, a3 = 0.f;
      float sv[32];
#pragma unroll
      for (int x = 0; x < 32; ++x) sv[x] = S0[(size_t)(dg * 32 + x) * 128];
#pragma unroll
      for (int x = 0; x < 32; ++x) { const int d = dg * 32 + x; const float s = sv[x];
          a0 = fmaf(q[d], s, a0); a1 = fmaf(q[128 + d], s, a1); a2 = fmaf(q[256 + d], s, a2); a3 = fmaf(q[384 + d], s, a3);
          So[(size_t)d * 128] = s * c4 + k[d] * v0 + k[128 + d] * v1 + k[256 + d] * v2 + k[384 + d] * v3; }
      y2p[(dg * 4 + 0) * 128 + e] = a0; y2p[(dg * 4 + 1) * 128 + e] = a1; y2p[(dg * 4 + 2) * 128 + e] = a2; y2p[(dg * 4 + 3) * 128 + e] = a3; }
    __syncthreads();
    { const int i = tid >> 7, e = tid & 127;
      float y = (y2p[(0 + i) * 128 + e] + y2p[(4 + i) * 128 + e] + y2p[(8 + i) * 128 + e] + y2p[(12 + i) * 128 + e]) * exp2f(lg2 * (float)(i + 1));
#pragma unroll
      for (int j = 0; j < 4; ++j) y = fmaf(Pm[i * 4 + j], v[j * 128 + e], y);
      float s = wave_sum(y); if (lane == 0) red[wid] = s; __syncthreads();
      const float mean = (red[i * 2] + red[i * 2 + 1]) * (1.0f / 128.0f); const float dlt = y - mean;
      float s2 = wave_sum(dlt * dlt); if (lane == 0) red[8 + wid] = s2; __syncthreads();
      const float var = (red[8 + i * 2] + red[8 + i * 2 + 1]) * (1.0f / 128.0f);
      const float g = bf2f(PS[(size_t)(row0 + i) * NCOLS + 1792 + 1536 + h * 128 + e]);
      const float o = dlt * rsqrtf(var + 1e-5f) * P.gn_w[h * 128 + e] * (g * __builtin_amdgcn_rcpf(1.0f + __expf(-g)));
      Y[(size_t)(row0 + i) * 1024 + 512 + h * 128 + e] = f2bf(o); }
    __syncthreads();
}

__device__ __forceinline__ bf16_t* kvb_ptr(unsigned char* ws, int bh) { return (bf16_t*)(bh < 29 ? ws + WS_LA + (size_t)bh * 524288 : ws + WS_WIN + 17301504 + (size_t)(bh - 29) * 524288); }
constexpr int RS = 136, BUFE = 128 * RS;

template <bool WITH_K>
__device__ __forceinline__ void ret_load_qk(PR P, LAS bf16_t* QP, LAS bf16_t* KB, unsigned (&kth)[4][4], const int tidv, const int row0, const int n, const int h, const float kd0, const float g32) {
    const bf16_t* PS = (const bf16_t*)(P.ws + WS_BIG); const float* rc = (const float*)(P.ws + WS_ROPE); const float* rs = rc + 2052 * 64;
    float kd = kd0;
#pragma unroll
    for (int it = 0; it < 4; ++it) { const int idx = it * 512 + tidv, i = idx >> 4, f = (idx & 15) * 4;
        const bf16_t* src = PS + (size_t)(row0 + i) * NCOLS + 1792 + h * 128;
        const u32x2 q1 = *(const u32x2*)(src + f), q2 = *(const u32x2*)(src + 64 + f);
        u32x2 k1 = (u32x2){0u, 0u}, k2 = k1; if (WITH_K) { k1 = *(const u32x2*)(src + 512 + f); k2 = *(const u32x2*)(src + 576 + f); }
        const float4 cs = *(const float4*)(rc + (size_t)(n * 128 + i) * 64 + f), sn = *(const float4*)(rs + (size_t)(n * 128 + i) * 64 + f);
        const float c4[4] = {cs.x, cs.y, cs.z, cs.w}, s4[4] = {sn.x, sn.y, sn.z, sn.w};
        const float qa[4] = {lo_bf(q1.x), hi_bf(q1.x), lo_bf(q1.y), hi_bf(q1.y)}, qb[4] = {lo_bf(q2.x), hi_bf(q2.x), lo_bf(q2.y), hi_bf(q2.y)};
        float qo1[4], qo2[4];
#pragma unroll
        for (int x = 0; x < 4; ++x) { qo1[x] = qa[x] * c4[x] - qb[x] * s4[x]; qo2[x] = qa[x] * s4[x] + qb[x] * c4[x]; }
        u32x2 w; w.x = pg8::cvt_pk_bf16(qo1[0], qo1[1]); w.y = pg8::cvt_pk_bf16(qo1[2], qo1[3]); *(LAS u32x2*)(QP + i * RS + f) = w;
        w.x = pg8::cvt_pk_bf16(qo2[0], qo2[1]); w.y = pg8::cvt_pk_bf16(qo2[2], qo2[3]); *(LAS u32x2*)(QP + i * RS + 64 + f) = w;
        if (WITH_K) {
            const float ka[4] = {lo_bf(k1.x), hi_bf(k1.x), lo_bf(k1.y), hi_bf(k1.y)}, kb[4] = {lo_bf(k2.x), hi_bf(k2.x), lo_bf(k2.y), hi_bf(k2.y)};
            float ko1[4], ko2[4];
#pragma unroll
            for (int x = 0; x < 4; ++x) { ko1[x] = (ka[x] * c4[x] - kb[x] * s4[x]) * 0.08838834764831845f; ko2[x] = (ka[x] * s4[x] + kb[x] * c4[x]) * 0.08838834764831845f; }
            w.x = pg8::cvt_pk_bf16(ko1[0], ko1[1]); w.y = pg8::cvt_pk_bf16(ko1[2], ko1[3]); *(LAS u32x2*)(KB + i * RS + f) = w;
            w.x = pg8::cvt_pk_bf16(ko2[0], ko2[1]); w.y = pg8::cvt_pk_bf16(ko2[2], ko2[3]); *(LAS u32x2*)(KB + i * RS + 64 + f) = w;
            kth[it][0] = pg8::cvt_pk_bf16(ko1[0] * kd, ko1[1] * kd); kth[it][1] = pg8::cvt_pk_bf16(ko1[2] * kd, ko1[3] * kd);
            kth[it][2] = pg8::cvt_pk_bf16(ko2[0] * kd, ko2[1] * kd); kth[it][3] = pg8::cvt_pk_bf16(ko2[2] * kd, ko2[3] * kd); kd *= g32; }
        if (it & 1) __builtin_amdgcn_sched_barrier(0); }
}

__device__ __forceinline__ void ret_unit_a(PR P, LAS unsigned char* lds, const int bh, const int n, const int wv) {
    LAS bf16_t* QP = (LAS bf16_t*)lds; LAS bf16_t* KB = QP + BUFE; LAS bf16_t* VT = KB + BUFE;
    const int tid = fresh_tid(wv), lane = tid & 63, wid = tid >> 6, wr = wid >> 1, wc = wid & 1, fr = lane & 15, fq = lane >> 4;
    const int b = bh >> 2, h = bh & 3;
    const bf16_t* PS = (const bf16_t*)(P.ws + WS_BIG); bf16_t* Y = (bf16_t*)(P.ws + WS_XN); bf16_t* KVB = kvb_ptr(P.ws, bh) + (size_t)n * 16384;
    const float lg2 = log2f(1.0f - exp2f(-5.0f - (float)h));
    const float kd0 = exp2f(lg2 * (float)(127 - (tid >> 4))), g32 = exp2f(-32.0f * lg2);
    const int row0 = b * 2048 + n * 128;
    unsigned kth[4][4];
    ret_load_qk<true>(P, QP, KB, kth, tid, row0, n, h, kd0, g32);
#pragma unroll
    for (int it = 0; it < 4; ++it) { const int idx = it * 512 + tid, j = idx >> 4, e = (idx & 15) * 8;
        const u32x4 vv = *(const u32x4*)(PS + (size_t)(row0 + j) * NCOLS + 1792 + 1024 + h * 128 + e);
        LAS bf16_t* d = VT + e * RS + j;
        d[0] = (bf16_t)(vv.x & 0xffffu); d[RS] = (bf16_t)(vv.x >> 16); d[2 * RS] = (bf16_t)(vv.y & 0xffffu); d[3 * RS] = (bf16_t)(vv.y >> 16);
        d[4 * RS] = (bf16_t)(vv.z & 0xffffu); d[5 * RS] = (bf16_t)(vv.z >> 16); d[6 * RS] = (bf16_t)(vv.w & 0xffffu); d[7 * RS] = (bf16_t)(vv.w >> 16); }
    __syncthreads();
    f32x4 accP[2][4];
#pragma unroll
    for (int mt = 0; mt < 2; ++mt)
#pragma unroll
        for (int nt = 0; nt < 4; ++nt) accP[mt][nt] = (f32x4){0.f, 0.f, 0.f, 0.f};
#pragma unroll
    for (int ks = 0; ks < 4; ++ks) { bf16x8 aq[2];
#pragma unroll
        for (int mt = 0; mt < 2; ++mt) aq[mt] = *(const LAS bf16x8*)(QP + (wr * 32 + mt * 16 + fr) * RS + ks * 32 + fq * 8);
#pragma unroll
        for (int nt = 0; nt < 4; ++nt) { const bf16x8 bk = *(const LAS bf16x8*)(KB + (wc * 64 + nt * 16 + fr) * RS + ks * 32 + fq * 8);
#pragma unroll
            for (int mt = 0; mt < 2; ++mt) accP[mt][nt] = __builtin_amdgcn_mfma_f32_16x16x32_bf16(aq[mt], bk, accP[mt][nt], 0, 0, 0); }
        __builtin_amdgcn_sched_barrier(0); }
    __syncthreads();
    { float ri[2][4], cj[4];
#pragma unroll
      for (int mt = 0; mt < 2; ++mt)
#pragma unroll
          for (int j = 0; j < 4; ++j) ri[mt][j] = exp2f(lg2 * (float)(wr * 32 + mt * 16 + fq * 4 + j));
#pragma unroll
      for (int nt = 0; nt < 4; ++nt) cj[nt] = exp2f(-lg2 * (float)(wc * 64 + nt * 16 + fr));
#pragma unroll
      for (int mt = 0; mt < 2; ++mt)
#pragma unroll
          for (int nt = 0; nt < 4; ++nt)
#pragma unroll
              for (int j = 0; j < 4; ++j) { const int i = wr * 32 + mt * 16 + fq * 4 + j, jj = wc * 64 + nt * 16 + fr;
                  const float val = i >= jj ? accP[mt][nt][j] * ri[mt][j] * cj[nt] : 0.f; QP[i * RS + jj] = f2bf(val); } }
#pragma unroll
    for (int it = 0; it < 4; ++it) { const int idx = it * 512 + tid, j = idx >> 4, f = (idx & 15) * 4; LAS bf16_t* d = KB + f * RS + j;
        d[0] = (bf16_t)(kth[it][0] & 0xffffu); d[RS] = (bf16_t)(kth[it][0] >> 16); d[2 * RS] = (bf16_t)(kth[it][1] & 0xffffu); d[3 * RS] = (bf16_t)(kth[it][1] >> 16);
        LAS bf16_t* d2 = d + 64 * RS;
        d2[0] = (bf16_t)(kth[it][2] & 0xffffu); d2[RS] = (bf16_t)(kth[it][2] >> 16); d2[2 * RS] = (bf16_t)(kth[it][3] & 0xffffu); d2[3 * RS] = (bf16_t)(kth[it][3] >> 16); }
    __syncthreads();
    f32x4 accY[2][4], accS[2][4];
#pragma unroll
    for (int mt = 0; mt < 2; ++mt)
#pragma unroll
        for (int nt = 0; nt < 4; ++nt) { accY[mt][nt] = (f32x4){0.f, 0.f, 0.f, 0.f}; accS[mt][nt] = (f32x4){0.f, 0.f, 0.f, 0.f}; }
#pragma unroll
    for (int ks = 0; ks < 4; ++ks) { bf16x8 ap[2], av[2];
#pragma unroll
        for (int mt = 0; mt < 2; ++mt) { ap[mt] = *(const LAS bf16x8*)(QP + (wr * 32 + mt * 16 + fr) * RS + ks * 32 + fq * 8); av[mt] = *(const LAS bf16x8*)(VT + (wr * 32 + mt * 16 + fr) * RS + ks * 32 + fq * 8); }
#pragma unroll
        for (int nt = 0; nt < 4; ++nt) { const bf16x8 bv = *(const LAS bf16x8*)(VT + (wc * 64 + nt * 16 + fr) * RS + ks * 32 + fq * 8), bkt = *(const LAS bf16x8*)(KB + (wc * 64 + nt * 16 + fr) * RS + ks * 32 + fq * 8);
#pragma unroll
            for (int mt = 0; mt < 2; ++mt) { accY[mt][nt] = __builtin_amdgcn_mfma_f32_16x16x32_bf16(ap[mt], bv, accY[mt][nt], 0, 0, 0); accS[mt][nt] = __builtin_amdgcn_mfma_f32_16x16x32_bf16(av[mt], bkt, accS[mt][nt], 0, 0, 0); } }
        __builtin_amdgcn_sched_barrier(0); }
#pragma unroll
    for (int mt = 0; mt < 2; ++mt)
#pragma unroll
        for (int nt = 0; nt < 4; ++nt)
#pragma unroll
            for (int j = 0; j < 4; ++j) { const int r = wr * 32 + mt * 16 + fq * 4 + j, c = wc * 64 + nt * 16 + fr;
                Y[(size_t)(row0 + r) * 1024 + 512 + h * 128 + c] = f2bf(accY[mt][nt][j]); KVB[r * 128 + c] = f2bf(accS[mt][nt][j]); }
    __syncthreads();
}

__device__ __forceinline__ void ret_prefix(PR P, const int item) {
    const int bh = item >> 11, i8 = (item & 2047) * 8; const int h = bh & 3;
    bf16_t* KVB = kvb_ptr(P.ws, bh) + i8;
    const float lg2 = log2f(1.0f - exp2f(-5.0f - (float)h)); const float c_dec = exp2f(lg2 * 128.0f);
    u32x4 kv[16];
#pragma unroll
    for (int n = 0; n < 16; ++n) kv[n] = *(const u32x4*)(KVB + (size_t)n * 16384);
    float S[8];
#pragma unroll
    for (int x = 0; x < 8; ++x) S[x] = 0.f;
#pragma unroll
    for (int n = 0; n < 16; ++n) { u32x4 w; w.x = pg8::cvt_pk_bf16(S[0], S[1]); w.y = pg8::cvt_pk_bf16(S[2], S[3]); w.z = pg8::cvt_pk_bf16(S[4], S[5]); w.w = pg8::cvt_pk_bf16(S[6], S[7]);
        *(u32x4*)(KVB + (size_t)n * 16384) = w;
        const float k8[8] = {lo_bf(kv[n].x), hi_bf(kv[n].x), lo_bf(kv[n].y), hi_bf(kv[n].y), lo_bf(kv[n].z), hi_bf(kv[n].z), lo_bf(kv[n].w), hi_bf(kv[n].w)};
#pragma unroll
        for (int x = 0; x < 8; ++x) S[x] = S[x] * c_dec + k8[x]; }
    const int e = i8 >> 7, d0 = i8 & 127;
#pragma unroll
    for (int x = 0; x < 8; ++x) P.out[O_RTP + ((size_t)bh * 128 + d0 + x) * 128 + e] = S[x];
}

__device__ __forceinline__ void ret_unit_c(PR P, LAS unsigned char* lds, const int bh, const int n, const int wv) {
    LAS bf16_t* QP = (LAS bf16_t*)lds; LAS bf16_t* ST = QP + 3 * BUFE; LAS float* YST = (LAS float*)(QP + BUFE);
    const int tid = fresh_tid(wv), lane = tid & 63, wid = tid >> 6, wr = wid >> 1, wc = wid & 1, fr = lane & 15, fq = lane >> 4;
    const int b = bh >> 2, h = bh & 3;
    const bf16_t* PS = (const bf16_t*)(P.ws + WS_BIG); bf16_t* Y = (bf16_t*)(P.ws + WS_XN); const bf16_t* KVB = kvb_ptr(P.ws, bh) + (size_t)n * 16384;
    const float lg2 = log2f(1.0f - exp2f(-5.0f - (float)h));
    const int row0 = b * 2048 + n * 128;
    unsigned kth[4][4];
    ret_load_qk<false>(P, QP, QP, kth, tid, row0, n, h, 0.f, 0.f);
#pragma unroll
    for (int it = 0; it < 4; ++it) { const int idx = it * 512 + tid, e = idx >> 4, d8 = (idx & 15) * 8;
        *(LAS u32x4*)(ST + e * RS + d8) = *(const u32x4*)(KVB + e * 128 + d8); }
    __syncthreads();
    f32x4 accY[2][4];
#pragma unroll
    for (int mt = 0; mt < 2; ++mt)
#pragma unroll
        for (int nt = 0; nt < 4; ++nt) accY[mt][nt] = (f32x4){0.f, 0.f, 0.f, 0.f};
#pragma unroll
    for (int ks = 0; ks < 4; ++ks) { bf16x8 aq[2];
#pragma unroll
        for (int mt = 0; mt < 2; ++mt) aq[mt] = *(const LAS bf16x8*)(QP + (wr * 32 + mt * 16 + fr) * RS + ks * 32 + fq * 8);
#pragma unroll
        for (int nt = 0; nt < 4; ++nt) { const bf16x8 bs = *(const LAS bf16x8*)(ST + (wc * 64 + nt * 16 + fr) * RS + ks * 32 + fq * 8);
#pragma unroll
            for (int mt = 0; mt < 2; ++mt) accY[mt][nt] = __builtin_amdgcn_mfma_f32_16x16x32_bf16(aq[mt], bs, accY[mt][nt], 0, 0, 0); }
        __builtin_amdgcn_sched_barrier(0); }
#pragma unroll
    for (int mt = 0; mt < 2; ++mt)
#pragma unroll
        for (int j = 0; j < 4; ++j) { const int r = wr * 32 + mt * 16 + fq * 4 + j; const float qd = exp2f(lg2 * (float)(r + 1));
#pragma unroll
            for (int nt = 0; nt < 4; ++nt) YST[r * 132 + wc * 64 + nt * 16 + fr] = accY[mt][nt][j] * qd; }
    __syncthreads();
    { const int i = tid >> 2, part = tid & 3; float yv[32]; float s = 0.f;
      bf16_t* yo = Y + (size_t)(row0 + i) * 1024 + 512 + h * 128 + part * 32;
#pragma unroll
      for (int x = 0; x < 4; ++x) { const u32x4 y1 = *(const u32x4*)(yo + x * 8); const f32x4 ta = *(const LAS f32x4*)(YST + i * 132 + part * 32 + x * 8), tb = *(const LAS f32x4*)(YST + i * 132 + part * 32 + x * 8 + 4);
          yv[x * 8 + 0] = ta[0] + lo_bf(y1.x); yv[x * 8 + 1] = ta[1] + hi_bf(y1.x); yv[x * 8 + 2] = ta[2] + lo_bf(y1.y); yv[x * 8 + 3] = ta[3] + hi_bf(y1.y);
          yv[x * 8 + 4] = tb[0] + lo_bf(y1.z); yv[x * 8 + 5] = tb[1] + hi_bf(y1.z); yv[x * 8 + 6] = tb[2] + lo_bf(y1.w); yv[x * 8 + 7] = tb[3] + hi_bf(y1.w); }
#pragma unroll
      for (int x = 0; x < 32; ++x) s += yv[x];
      s = quad_sum(s); const float mean = s * (1.0f / 128.0f); float s2 = 0.f;
#pragma unroll
      for (int x = 0; x < 32; ++x) { yv[x] -= mean; s2 += yv[x] * yv[x]; }
      s2 = quad_sum(s2); const float rstd = rsqrtf(s2 * (1.0f / 128.0f) + 1e-5f);
      const bf16_t* gp = PS + (size_t)(row0 + i) * NCOLS + 1792 + 1536 + h * 128 + part * 32; const float* gw = P.gn_w + h * 128 + part * 32;
#pragma unroll
      for (int x = 0; x < 4; ++x) { const u32x4 g4 = *(const u32x4*)(gp + x * 8); const float4 w0 = *(const float4*)(gw + x * 8), w1 = *(const float4*)(gw + x * 8 + 4);
          const float gg[8] = {lo_bf(g4.x), hi_bf(g4.x), lo_bf(g4.y), hi_bf(g4.y), lo_bf(g4.z), hi_bf(g4.z), lo_bf(g4.w), hi_bf(g4.w)}; const float ww[8] = {w0.x, w0.y, w0.z, w0.w, w1.x, w1.y, w1.z, w1.w};
          float o[8];
#pragma unroll
          for (int z = 0; z < 8; ++z) o[z] = yv[x * 8 + z] * rstd * ww[z] * (gg[z] * __builtin_amdgcn_rcpf(1.0f + __expf(-gg[z])));
          u32x4 w; w.x = pg8::cvt_pk_bf16(o[0], o[1]); w.y = pg8::cvt_pk_bf16(o[2], o[3]); w.z = pg8::cvt_pk_bf16(o[4], o[5]); w.w = pg8::cvt_pk_bf16(o[6], o[7]);
          *(u32x4*)(yo + x * 8) = w; } }
    __syncthreads();
}

__device__ __forceinline__ void sub_barrier(unsigned* cnt, const unsigned target, const int wv) {
    asm volatile("s_waitcnt vmcnt(0)" ::: "memory");
    __syncthreads();
    if (fresh_tid(wv) == 0) {
        __builtin_amdgcn_fence(__ATOMIC_RELEASE, "agent");
        asm volatile("s_waitcnt vmcnt(0)" ::: "memory");
        (void)xb_add(cnt, 1u);
        unsigned sp = 0u;
        while (xb_ld(cnt) < target) { __builtin_amdgcn_s_sleep(2); if (++sp > (1u << 20)) break; }
        __builtin_amdgcn_fence(__ATOMIC_ACQUIRE, "agent");
        asm volatile("s_waitcnt vmcnt(0)" ::: "memory");
    }
    __syncthreads();
}

struct PostRegs { u32x2 yr, c_r, c_k, c_v, p_r, p_k, p_v, ar, gr; };
__device__ __forceinline__ void post_load(PR P, PostRegs& R, const int row, const int ch) {
    const bf16_t* PS = (const bf16_t*)(P.ws + WS_BIG); const bf16_t* ASIG = (const bf16_t*)(P.ws + WS_ASIG); const bf16_t* YS = (const bf16_t*)(P.ws + WS_YS); const bf16_t* G = (const bf16_t*)(P.ws + WS_WIN);
    R.yr = *(const u32x2*)(YS + (size_t)row * 512 + ch);
    const bf16_t* cp = PS + (size_t)row * NCOLS + ch; const int pr = prev_row(row);
    R.c_r = *(const u32x2*)cp; R.c_k = *(const u32x2*)(cp + 512); R.c_v = *(const u32x2*)(cp + 1024);
    R.p_r = (u32x2){0u, 0u}; R.p_k = R.p_r; R.p_v = R.p_r;
    if (pr >= 0) { const bf16_t* pp = PS + (size_t)pr * NCOLS + ch; R.p_r = *(const u32x2*)pp; R.p_k = *(const u32x2*)(pp + 512); R.p_v = *(const u32x2*)(pp + 1024); }
    R.ar = *(const u32x2*)(ASIG + (size_t)row * 512 + ch); R.gr = *(const u32x2*)(G + (size_t)row * 512 + ch);
}
__device__ __forceinline__ void rwkv_post(PR P, const int wv) {
    const int tid = fresh_tid(wv); const int lane = tid & 63; const int gw = blockIdx.x * 8 + (tid >> 6), nw = gridDim.x * 8;
    const int sub = lane >> 4, cg4 = (lane & 15) * 4;
    bf16_t* Y = (bf16_t*)(P.ws + WS_XN);
    const int h = (gw * 4 + sub) & 7, ch = h * 64 + cg4;
    const float4 mr = *(const float4*)(P.mu + ch), mk = *(const float4*)(P.mu + 512 + ch), mv = *(const float4*)(P.mu + 1024 + ch);
    const float4 ka = *(const float4*)(P.k_a + ch), rk = *(const float4*)(P.r_k + ch), lw = *(const float4*)(P.lnx_w + ch), lb = *(const float4*)(P.lnx_b + ch);
    const float m_r[4] = {mr.x, mr.y, mr.z, mr.w}, m_k[4] = {mk.x, mk.y, mk.z, mk.w}, m_v[4] = {mv.x, mv.y, mv.z, mv.w};
    const float kaa[4] = {ka.x, ka.y, ka.z, ka.w}, rkk[4] = {rk.x, rk.y, rk.z, rk.w}, lww[4] = {lw.x, lw.y, lw.z, lw.w}, lbb[4] = {lb.x, lb.y, lb.z, lb.w};
    PostRegs R, N;
    if (gw < MT * 2) post_load(P, R, (gw * 4 + sub) >> 3, ch);
    for (int task = gw; task < MT * 2; task += nw) {
        const int row = (task * 4 + sub) >> 3;
        if (task + nw < MT * 2) post_load(P, N, ((task + nw) * 4 + sub) >> 3, ch);
        const float ys[4] = {lo_bf(R.yr.x), hi_bf(R.yr.x), lo_bf(R.yr.y), hi_bf(R.yr.y)};
        const float mean = row16_sum(ys[0] + ys[1] + ys[2] + ys[3]) * (1.0f / 64.0f);
        float dl[4], s2 = 0.f;
#pragma unroll
        for (int j = 0; j < 4; ++j) { dl[j] = ys[j] - mean; s2 += dl[j] * dl[j]; }
        const float rstd = rsqrtf(row16_sum(s2) * (1.0f / 64.0f) + 64e-5f);
        const float cr[4] = {lo_bf(R.c_r.x), hi_bf(R.c_r.x), lo_bf(R.c_r.y), hi_bf(R.c_r.y)}, ck[4] = {lo_bf(R.c_k.x), hi_bf(R.c_k.x), lo_bf(R.c_k.y), hi_bf(R.c_k.y)}, cv[4] = {lo_bf(R.c_v.x), hi_bf(R.c_v.x), lo_bf(R.c_v.y), hi_bf(R.c_v.y)};
        const float qr[4] = {lo_bf(R.p_r.x), hi_bf(R.p_r.x), lo_bf(R.p_r.y), hi_bf(R.p_r.y)}, qk[4] = {lo_bf(R.p_k.x), hi_bf(R.p_k.x), lo_bf(R.p_k.y), hi_bf(R.p_k.y)}, qv[4] = {lo_bf(R.p_v.x), hi_bf(R.p_v.x), lo_bf(R.p_v.y), hi_bf(R.p_v.y)};
        const float aa[4] = {lo_bf(R.ar.x), hi_bf(R.ar.x), lo_bf(R.ar.y), hi_bf(R.ar.y)}, gg[4] = {lo_bf(R.gr.x), hi_bf(R.gr.x), lo_bf(R.gr.y), hi_bf(R.gr.y)};
        float v[4], bp = 0.f;
#pragma unroll
        for (int j = 0; j < 4; ++j) { const float r = cr[j] + (qr[j] - cr[j]) * m_r[j], k = ck[j] + (qk[j] - ck[j]) * m_k[j]; v[j] = cv[j] + (qv[j] - cv[j]) * m_v[j];
            const float kn = k * (1.0f + (aa[j] - 1.0f) * kaa[j]); bp += r * kn * rkk[j]; }
        const float bonus = row16_sum(bp);
        float o[4];
#pragma unroll
        for (int j = 0; j < 4; ++j) o[j] = (dl[j] * rstd * lww[j] + lbb[j] + bonus * v[j]) * gg[j];
        u32x2 w; w.x = pg8::cvt_pk_bf16(o[0], o[1]); w.y = pg8::cvt_pk_bf16(o[2], o[3]);
        *(u32x2*)(Y + (size_t)row * 1024 + ch) = w;
        R = N;
    }
}

__global__ void __launch_bounds__(512, 2) hymba_mega(Params P_unused) {
    extern __shared__ __attribute__((aligned(16))) unsigned char shm[];
    cg::grid_group grid = cg::this_grid();
    LAS unsigned char* lds = (LAS unsigned char*)shm; LAS float* ldsf = (LAS float*)shm;
    const int G = gridDim.x, bx = blockIdx.x;
    const int wv = __builtin_amdgcn_readfirstlane(threadIdx.x >> 6);
    const CAS Params* kp = (const CAS Params*)__builtin_amdgcn_kernarg_segment_ptr();
#define P (*kp)
#define FRESH() asm volatile("" : "+s"(kp))
#ifndef REP_SYNC
#define REP_SYNC 1
#endif
#ifndef REP_P7
#define REP_P7 1
#endif
#ifndef REP_FFN1
#define REP_FFN1 1
#endif
#ifndef REP_P0
#define REP_P0 1
#endif
#ifndef REP_P3
#define REP_P3 1
#endif
#ifndef REP_RW
#define REP_RW 1
#endif
#ifndef REP_OTH
#define REP_OTH 1
#endif
#ifndef REP_RETP
#define REP_RETP 1
#endif
#ifndef REP_SAMP
#define REP_SAMP 1
#endif
#ifndef REP_P8
#define REP_P8 1
#endif
#define GSYNC() do { for (int r_ = 0; r_ < REP_SYNC; ++r_) xcd_barrier((unsigned*)ws, (volatile LAS unsigned*)(lds + LDS_BYTES - 16), wv); FRESH(); } while (0)
#define ws (kp->ws)
#define XN ((bf16_t*)(ws + WS_XN))
#define ACT ((bf16_t*)(ws + WS_BIG))
#define FO ((float*)(ws + WS_FO))
#define PS ((bf16_t*)(ws + WS_BIG))
    pg8::StaticOrder S;
    { unsigned* barw = (unsigned*)ws; const int t0 = fresh_tid(wv); if (bx == 0) for (int i = t0; i < XCD_BAR_WORDS + 128; i += 512) barw[i] = 0u;
      if (t0 < 4) ((LAS unsigned*)(lds + LDS_BYTES - 16))[t0] = 0u; }
#ifndef PHM
#define PHM 0xFFFF
#endif
#define PH(k) if ((PHM >> (k)) & 1)
    for (int r0 = 0; r0 < REP_P0; ++r0) PH(0) p0_prologue(P, ldsf, wv);
    grid.sync(); FRESH();
    if (fresh_tid(wv) == 0) (void)xb_add(&((unsigned*)ws)[XB_XCNT(xb_xcc_id())], 1u);
    for (int rep1 = 0; rep1 < REP_FFN1; ++rep1) {
    PH(1) { pg8::Gemm g{XN, (const bf16_t*)(ws + WS_WGU), MT, NGU, 1024}; S.init(MT, NGU, G, bx, 1024); pg8::EpiSwiGLU E{ACT, DFF}; pg8::gemm_phase(lds, g, S, E, wv); }
    GSYNC();
    PH(2) { pg8::Gemm g{ACT, (const bf16_t*)(ws + WS_WD), MT, 1024, DFF}; pg8::SplitOrder S2; S2.init2(G, bx, DFF, 8); pg8::EpiFO E{(bf16_t*)FO, 1024, (float*)(ws + WS_OMD)}; pg8::gemm_phase(lds, g, S2, E, wv); }
    GSYNC();
    }
    for (int r3 = 0; r3 < REP_P3; ++r3) PH(3) rows_phase(P, 1, wv);
    GSYNC();
    PH(4) { pg8::Gemm g{XN, (const bf16_t*)(ws + WS_WIN), MIN_, NCOLS, 1024}; S.init(MIN_, NCOLS, G, bx, 1024); pg8::EpiBf16 E{PS, NCOLS}; pg8::gemm_phase(lds, g, S, E, wv); }
    GSYNC();
    PH(5) lora_prep(P, wv);
    GSYNC();
    PH(6) { pg8::Gemm g{(const bf16_t*)(ws + WS_LA), (const bf16_t*)(ws + WS_WL), MT, 1536, 256}; pg8::LoraMainOrder SM; SM.init(MP, 1024, G, bx, 256);
      pg8::EpiLora E{(bf16_t*)(ws + WS_OMD), (bf16_t*)(ws + WS_ASIG), (bf16_t*)(ws + WS_WIN), P.w0, P.a0}; pg8::gemm_phase(lds, g, SM, E, wv); }
    GSYNC();
    {
    if (bx < 128) { for (int rw = 0; rw < REP_RW; ++rw) rwkv_unit<false>(P, ldsf, bx >> 4, (bx >> 1) & 7, bx & 1, wv); }
    else {
        { pg8::Gemm g{(const bf16_t*)(ws + WS_LA), (const bf16_t*)(ws + WS_WL), MT, 1536, 256}; pg8::LoraRestOrder SL; SL.ob = bx - 128;
          pg8::EpiLora E{(bf16_t*)(ws + WS_OMD), (bf16_t*)(ws + WS_ASIG), (bf16_t*)(ws + WS_WIN), P.w0, P.a0}; pg8::gemm_phase(lds, g, SL, E, wv); }
        FRESH();
        const int rep7 = 0; const int ob = bx - 128; unsigned* sbc = (unsigned*)ws + XCD_BAR_WORDS + 64;
        for (int k = 0; k < 4; ++k) { const int u = ob + k * 128; ret_unit_a(P, lds, u >> 4, u & 15, wv); }
        sub_barrier(sbc, 128u * (2u * rep7 + 1u), wv);
        ret_prefix(P, ob * 512 + fresh_tid(wv));
        sub_barrier(sbc, 128u * (2u * rep7 + 2u), wv);
        for (int k = 0; k < 4; ++k) { const int u = ob + k * 128; ret_unit_c(P, lds, u >> 4, u & 15, wv); }
        for (int u = ob; u < 2560; u += 128) { if (u < 2048) rwkv_unit<true>(P, ldsf, u >> 4, (u >> 1) & 7, u & 1, wv); else ret_sample_unit(P, ldsf, (u - 2048) >> 2, (u - 2048) & 3, wv); }
    }
    }
    GSYNC();
    for (int rep8 = 0; rep8 < REP_P8; ++rep8) PH(8) rwkv_post(P, wv);
    GSYNC();
    PH(9) { pg8::Gemm g{XN, (const bf16_t*)(ws + WS_WOUT), MT, 1024, 1024}; pg8::SplitOrder S2; S2.init2(G, bx, 1024, 4); pg8::EpiFO E{(bf16_t*)FO, 1024, (float*)(ws + WS_OMD)}; pg8::gemm_phase(lds, g, S2, E, wv); }
    GSYNC();
    PH(10) { tconv_list(P.f2g, P.f2u, P.f2d, nullptr, nullptr, ws, 2112, ldsf, wv);
    rows_phase(P, 2, wv); }
    GSYNC();
    PH(11) { pg8::Gemm g{XN, (const bf16_t*)(ws + WS_WGU), MT, NGU, 1024}; S.init(MT, NGU, G, bx, 1024); pg8::EpiSwiGLU E{ACT, DFF}; pg8::gemm_phase(lds, g, S, E, wv); }
    GSYNC();
    PH(12) { pg8::Gemm g{ACT, (const bf16_t*)(ws + WS_WD), MT, 1024, DFF}; pg8::SplitOrder S2; S2.init2(G, bx, DFF, 8); pg8::EpiFO E{(bf16_t*)FO, 1024, (float*)(ws + WS_OMD)}; pg8::gemm_phase(lds, g, S2, E, wv); }
    GSYNC();
    PH(13) rows_phase(P, 3, wv);
}

#undef ws
#undef XN
#undef ACT
#undef FO
#undef PS
#undef P
extern "C" void kernel_launch(void* const* d_in, const int* in_sizes, int n_in, void* d_out, int out_size, void* d_ws, size_t ws_size, hipStream_t stream) {
    static int grid = 0;
    if (grid == 0) {
        if (n_in != 26 || ws_size < WS_END) { fprintf(stderr, "kernel_launch: unexpected n_in %d or ws_size %zu (< %zu)\n", n_in, ws_size, (size_t)WS_END); grid = -1; return; }
        int dev = 0, cus = 0, per_cu = 0;
        hipGetDevice(&dev); hipDeviceGetAttribute(&cus, hipDeviceAttributeMultiprocessorCount, dev);
        hipFuncSetAttribute((const void*)hymba_mega, hipFuncAttributeMaxDynamicSharedMemorySize, LDS_BYTES);
        hipOccupancyMaxActiveBlocksPerMultiprocessor(&per_cu, (const void*)hymba_mega, 512, LDS_BYTES);
        if (per_cu < 1) { fprintf(stderr, "kernel_launch: occupancy query says %d blocks/CU\n", per_cu); per_cu = 1; }
        grid = cus * per_cu; if (grid > 256) grid = 256;
        if (grid != 256) { fprintf(stderr, "kernel_launch: this kernel needs 256 co-resident workgroups, got %d\n", grid); grid = -1; return; }
        fprintf(stderr, "kernel_launch: cus %d per_cu %d grid %d ws %zu\n", cus, per_cu, grid, ws_size);
    }
    if (grid < 0) return;
    Params p{};
    const float** pp = (const float**)&p;
    for (int i = 0; i < 26; ++i) pp[i] = (const float*)d_in[i];
    p.out = (float*)d_out; p.ws = (unsigned char*)d_ws;
    void* args[] = {&p};
    hipError_t e = hipLaunchCooperativeKernel((const void*)hymba_mega, dim3(grid), dim3(512), args, LDS_BYTES, stream);
    if (e != hipSuccess) fprintf(stderr, "cooperative launch failed: %s (grid %d)\n", hipGetErrorString(e), grid);
}
```

```cpp
#include <hip/hip_runtime.h>
#include <hip/hip_cooperative_groups.h>
#include <cstdio>
#include <cstdint>
namespace cg = cooperative_groups;

__device__ __forceinline__ int fresh_tid(int wv) { int l; asm volatile("v_mbcnt_lo_u32_b32 %0, -1, 0\n\tv_mbcnt_hi_u32_b32 %0, -1, %0" : "=v"(l)); return wv * 64 + l; }
namespace pg8 {
#define PG8_LAS __attribute__((address_space(3)))
typedef unsigned short bf16_t;
typedef short bf16x8 __attribute__((ext_vector_type(8)));
typedef float f32x4 __attribute__((ext_vector_type(4)));
typedef unsigned u32x4 __attribute__((ext_vector_type(4)));
typedef unsigned u32x2 __attribute__((ext_vector_type(2)));
constexpr int BM = 256, BK = 64, HALF = 128, HTB = HALF * BK * 2, STAGE_BYTES = 8 * HTB, NXCD = 8, WGM = 8;

__host__ __device__ __forceinline__ int lds_byte(int r, int c) { const int st = (r >> 4) * 2 + (c >> 5), rr = r & 15, cc = c & 31, ob = rr * 64 + cc * 2; return st * 1024 + (ob ^ (((ob >> 9) & 1) << 5)); }
__host__ __device__ __forceinline__ void stage_rc(int b, int& R, int& C) { const int st = b / 1024, sb = b % 1024, swz = sb ^ (((sb >> 9) & 1) << 5); R = (st >> 1) * 16 + swz / 64; C = (st & 1) * 32 + (swz % 64) / 2; }
__host__ __device__ __forceinline__ int perm32(int rho) { const int n = rho >> 4, i = rho & 15; return 8 * (i >> 2) + 4 * n + (i & 3); }

struct Unit { int pm, pn, k0, nkt, atomic; };
struct Gemm { const bf16_t* A; const bf16_t* Bt; int M, N, K; };

struct StaticOrder {
    int nM, nN, nwg, G, c, nt;
    __host__ __device__ void init(int M, int N, int G_, int c_, int K) { nM = M / BM; nN = N / BM; nwg = nM * nN; G = G_; c = c_; nt = K / BK; }
    __host__ __device__ bool next(int i, Unit& u) const {
        const long L = (long)i * G + c; if (L >= nwg) return false;
        int wgid = (int)L; { const int q = nwg / NXCD, r = nwg % NXCD, xcd = wgid % NXCD, off = wgid / NXCD; wgid = (xcd < r ? xcd * (q + 1) : r * (q + 1) + (xcd - r) * q) + off; }
        const int nig = WGM * nN, gid = wgid / nig, fm = gid * WGM, gsz = (nM - fm) < WGM ? (nM - fm) : WGM;
        u.pm = fm + ((wgid % nig) % gsz); u.pn = (wgid % nig) / gsz; u.k0 = 0; u.nkt = nt; u.atomic = 0; return true;
    }
    __device__ __forceinline__ void a_ready(const Unit&) const {}
    __device__ __forceinline__ void done(const Unit&) const {}
};
struct LoraMainOrder : StaticOrder {
    __host__ __device__ bool next(int i, Unit& u) const { if (!StaticOrder::next(i, u)) return false; u.k0 = 0; u.nkt = 2; return true; }
};
struct LoraRestOrder {
    int ob;
    __host__ __device__ bool next(int i, Unit& u) const {
        const int L = i * 128 + ob; if (L >= 140) return false;
        if (L < 132) { u.pm = L >> 1; u.pn = 4 + (L & 1); u.k0 = 2; } else { const int x = L - 132; u.pm = 64 + (x >> 2); u.pn = x & 3; u.k0 = 0; }
        u.nkt = 2; u.atomic = 0; return true;
    }
    __device__ __forceinline__ void a_ready(const Unit&) const {}
    __device__ __forceinline__ void done(const Unit&) const {}
};
struct SplitOrder : StaticOrder {
    int KS;
    __host__ __device__ void init2(int G_, int c_, int K, int KS_) { init(16384, 1024, G_, c_, K); KS = KS_; }
    __host__ __device__ bool next(int i, Unit& u) const {
        if (i == 0) return StaticOrder::next(0, u);
        if (i > 1 || c >= 8 * KS) return false;
        const int tile = c / KS, part = c % KS, pairs = nt / 2, q = pairs / KS, r = pairs % KS;
        u.pm = 64 + (tile >> 2); u.pn = tile & 3; u.k0 = 2 * (part * q + (part < r ? part : r)); u.nkt = 2 * (q + (part < r ? 1 : 0)); u.atomic = 1 + c; return true;
    }
};

typedef __bf16 bf16x2_t __attribute__((ext_vector_type(2)));
typedef float f32x2_t __attribute__((ext_vector_type(2)));
__device__ __forceinline__ unsigned cvt_pk_bf16(float lo, float hi) { const f32x2_t v = {lo, hi}; const bf16x2_t b = __builtin_convertvector(v, bf16x2_t); return __builtin_bit_cast(unsigned, b); }

struct EpiFO {
    static constexpr bool PERM = true;
    bf16_t* C; int ldc; float* slab;
    __device__ __forceinline__ void operator()(const f32x4 (&acc)[2][2][4][2], const Unit& u, int wr, int wc, int fr, int fq) const {
        if (u.atomic == 0) {
            const int row0 = u.pm * BM + wr * 64 + fr; const int col0 = u.pn * BM + wc * 32 + 8 * fq;
#pragma unroll
            for (int ai = 0; ai < 2; ++ai)
#pragma unroll
                for (int m = 0; m < 4; ++m) { bf16_t* rowp = C + (size_t)(row0 + ai * HALF + m * 16) * ldc + col0;
#pragma unroll
                    for (int bj = 0; bj < 2; ++bj) { const f32x4 v0 = acc[ai][bj][m][0], v1 = acc[ai][bj][m][1];
                        u32x4 w; w.x = cvt_pk_bf16(v0[0], v0[1]); w.y = cvt_pk_bf16(v0[2], v0[3]); w.z = cvt_pk_bf16(v1[0], v1[1]); w.w = cvt_pk_bf16(v1[2], v1[3]);
                        *(u32x4*)(rowp + bj * HALF) = w; } }
        } else {
            float* base = slab + (size_t)(u.atomic - 1) * (BM * BM) + (size_t)(wr * 64 + fr) * BM + wc * 32 + 8 * fq;
#pragma unroll
            for (int ai = 0; ai < 2; ++ai)
#pragma unroll
                for (int m = 0; m < 4; ++m) { float* rowp = base + (size_t)(ai * HALF + m * 16) * BM;
#pragma unroll
                    for (int bj = 0; bj < 2; ++bj) { *(f32x4*)(rowp + bj * HALF) = acc[ai][bj][m][0]; *(f32x4*)(rowp + bj * HALF + 4) = acc[ai][bj][m][1]; } }
        }
    }
};
struct EpiBf16 {
    static constexpr bool PERM = true;
    bf16_t* O; int ldc;
    __device__ __forceinline__ void operator()(const f32x4 (&acc)[2][2][4][2], const Unit& u, int wr, int wc, int fr, int fq) const {
        const int row0 = u.pm * BM + wr * 64 + fr; const int col0 = u.pn * BM + wc * 32 + 8 * fq;
#pragma unroll
        for (int ai = 0; ai < 2; ++ai)
#pragma unroll
            for (int m = 0; m < 4; ++m) { bf16_t* rowp = O + (size_t)(row0 + ai * HALF + m * 16) * ldc + col0;
#pragma unroll
                for (int bj = 0; bj < 2; ++bj) { const f32x4 v0 = acc[ai][bj][m][0], v1 = acc[ai][bj][m][1];
                    u32x4 w; w.x = cvt_pk_bf16(v0[0], v0[1]); w.y = cvt_pk_bf16(v0[2], v0[3]); w.z = cvt_pk_bf16(v1[0], v1[1]); w.w = cvt_pk_bf16(v1[2], v1[3]);
                    *(u32x4*)(rowp + bj * HALF) = w; } }
    }
};
__device__ __forceinline__ float silu_f(float x) { return x * __builtin_amdgcn_rcpf(1.0f + __expf(-x)); }
struct EpiSwiGLU {
    static constexpr bool PERM = true;
    bf16_t* O; int ldc;
    __device__ __forceinline__ void operator()(const f32x4 (&acc)[2][2][4][2], const Unit& u, int wr, int wc, int fr, int fq) const {
        const int row0 = u.pm * BM + wr * 64 + fr; const int col0 = u.pn * HALF + wc * 32 + 8 * fq;
#pragma unroll
        for (int ai = 0; ai < 2; ++ai)
#pragma unroll
            for (int m = 0; m < 4; ++m) { bf16_t* rowp = O + (size_t)(row0 + ai * HALF + m * 16) * ldc + col0;
                float o[8];
#pragma unroll
                for (int n = 0; n < 2; ++n)
#pragma unroll
                    for (int j = 0; j < 4; ++j) o[n * 4 + j] = silu_f(acc[ai][0][m][n][j]) * acc[ai][1][m][n][j];
                u32x4 w; w.x = cvt_pk_bf16(o[0], o[1]); w.y = cvt_pk_bf16(o[2], o[3]); w.z = cvt_pk_bf16(o[4], o[5]); w.w = cvt_pk_bf16(o[6], o[7]);
                *(u32x4*)rowp = w; }
    }
};
struct EpiLora {
    static constexpr bool PERM = true;
    bf16_t* OMD; bf16_t* ASIG; bf16_t* G; const float* w0; const float* a0;
    template <int KIND> __device__ __forceinline__ void body(const f32x4 (&acc)[2][2][4][2], bf16_t* O, const float* bias, int row0, int ch0) const {
#pragma unroll
        for (int bj = 0; bj < 2; ++bj)
#pragma unroll
            for (int ai = 0; ai < 2; ++ai)
#pragma unroll
                for (int m = 0; m < 4; ++m) { bf16_t* rowp = O + (size_t)(row0 + ai * HALF + m * 16) * 512 + ch0 + bj * HALF;
                    float o[8];
#pragma unroll
                    for (int n = 0; n < 2; ++n)
#pragma unroll
                        for (int j = 0; j < 4; ++j) { float v = acc[ai][bj][m][n][j];
                            if (KIND == 0) { v += bias[ch0 + bj * HALF + n * 4 + j]; const float e = 0.6065306597126334f * __builtin_amdgcn_rcpf(1.0f + __expf(-v));
                                float p = 1.0f / 40320.0f; p = -1.0f / 5040.0f + e * p; p = 1.0f / 720.0f + e * p; p = -1.0f / 120.0f + e * p; p = 1.0f / 24.0f + e * p; p = -1.0f / 6.0f + e * p; p = 0.5f + e * p; p = 1.0f - e * p;
                                v = e * p; }
                            else if (KIND == 1) { v += bias[ch0 + bj * HALF + n * 4 + j]; v = __builtin_amdgcn_rcpf(1.0f + __expf(-v)); }
                            o[n * 4 + j] = v; }
                    u32x4 w; w.x = cvt_pk_bf16(o[0], o[1]); w.y = cvt_pk_bf16(o[2], o[3]); w.z = cvt_pk_bf16(o[4], o[5]); w.w = cvt_pk_bf16(o[6], o[7]);
                    *(u32x4*)rowp = w; __builtin_amdgcn_sched_barrier(0); }
    }
    __device__ __forceinline__ void operator()(const f32x4 (&acc)[2][2][4][2], const Unit& u, int wr, int wc, int fr, int fq) const {
        const int kind = u.pn >> 1;
        const int row0 = u.pm * BM + wr * 64 + fr; const int ch0 = (u.pn & 1) * BM + wc * 32 + 8 * fq;
        if (kind == 0) body<0>(acc, OMD, w0, row0, ch0); else if (kind == 1) body<1>(acc, ASIG, a0, row0, ch0); else body<2>(acc, G, a0, row0, ch0);
    }
};

template <class Epi, class Sched>
__device__ __forceinline__ void gemm_phase(PG8_LAS unsigned char* lds, const Gemm g, const Sched& S, const Epi& E, const int wv) {
    const int tid = fresh_tid(wv), wid = __builtin_amdgcn_readfirstlane(tid >> 6), lane = tid & 63, wr = wid >> 2, wc = wid & 3, fr = lane & 15, fq = lane >> 4;
    const int K = g.K;
    unsigned voffA[2], voffB[2];
#pragma unroll
    for (int i = 0; i < 2; ++i) { int R, C; stage_rc(tid * 16 + i * 8192, R, C); const int Rb = Epi::PERM ? ((R & ~31) + perm32(R & 31)) : R;
        voffA[i] = (unsigned)(R * K + C) * 2u; voffB[i] = (unsigned)(Rb * K + C) * 2u; }
    const size_t kstep = (size_t)(BK * 2);
    const size_t hstep = (size_t)HALF * K * 2;
    const size_t tstep = 2 * hstep;
    const unsigned ldsw = (unsigned)wid * 1024u;
    const int aoff = lds_byte(wr * 64 + fr, fq * 8), boff = lds_byte(wc * 32 + fr, fq * 8);
#define PG8_SA(b, h) (((b) * 2 + (h)) * HTB)
#define PG8_SB(b, h) ((4 + (b) * 2 + (h)) * HTB)
#define PG8_STAGE(bufoff, gbase, voff) do { _Pragma("unroll") for (int _i = 0; _i < 2; ++_i) \
        __builtin_amdgcn_global_load_lds((const unsigned*)((const char*)(gbase) + (voff)[_i]), (PG8_LAS unsigned*)(lds + (bufoff) + ldsw + _i * 8192), 16, 0, 0); } while (0)
#define PG8_LDA(dst, b, h) do { _Pragma("unroll") for (int m = 0; m < 4; ++m) _Pragma("unroll") for (int k = 0; k < 2; ++k) dst[m][k] = *(const PG8_LAS bf16x8*)(lds + PG8_SA(b, h) + aoff + m * 2048 + k * 1024); } while (0)
#define PG8_LDB(dst, b, h) do { _Pragma("unroll") for (int n = 0; n < 2; ++n) _Pragma("unroll") for (int k = 0; k < 2; ++k) dst[n][k] = *(const PG8_LAS bf16x8*)(lds + PG8_SB(b, h) + boff + n * 2048 + k * 1024); } while (0)
#define PG8_MMA(ai, bj, At, Bt) do { __builtin_amdgcn_s_setprio(1); _Pragma("unroll") for (int m = 0; m < 4; ++m) _Pragma("unroll") for (int n = 0; n < 2; ++n) _Pragma("unroll") for (int k = 0; k < 2; ++k) \
        acc[ai][bj][m][n] = __builtin_amdgcn_mfma_f32_16x16x32_bf16(Bt[n][k], At[m][k], acc[ai][bj][m][n], 0, 0, 0); __builtin_amdgcn_s_setprio(0); } while (0)
#define PG8_WAIT_V(n) asm volatile("s_waitcnt vmcnt(" #n ")" ::: "memory")
#define PG8_WAIT_L(n) asm volatile("s_waitcnt lgkmcnt(" #n ")" ::: "memory")
#define PG8_BAR __builtin_amdgcn_s_barrier()
#define PG8_SCHED __builtin_amdgcn_sched_barrier(0)
    Unit cur, nxt; int ui = 0;
    if (!S.next(0, cur)) return;
    f32x4 acc[2][2][4][2];
#pragma unroll
    for (int a = 0; a < 2; ++a)
#pragma unroll
        for (int b = 0; b < 2; ++b)
#pragma unroll
            for (int m = 0; m < 4; ++m)
#pragma unroll
                for (int n = 0; n < 2; ++n) acc[a][b][m][n] = (f32x4){0.f, 0.f, 0.f, 0.f};
    bf16x8 At[4][2], B0[2][2], B1[2][2];
    const char* cA = (const char*)g.A + (size_t)cur.pm * tstep + (size_t)cur.k0 * kstep; const char* cB = (const char*)g.Bt + (size_t)cur.pn * tstep + (size_t)cur.k0 * kstep;
    S.a_ready(cur);
    PG8_STAGE(PG8_SB(0, 0), cB, voffB); PG8_STAGE(PG8_SA(0, 0), cA, voffA); PG8_STAGE(PG8_SB(0, 1), cB + hstep, voffB); PG8_STAGE(PG8_SA(0, 1), cA + hstep, voffA);
    if (wr == 1) PG8_BAR;
    PG8_WAIT_V(4); PG8_BAR;
    PG8_STAGE(PG8_SB(1, 0), cB + kstep, voffB); PG8_STAGE(PG8_SA(1, 0), cA + kstep, voffA); PG8_STAGE(PG8_SB(1, 1), cB + hstep + kstep, voffB);
    PG8_WAIT_V(6); PG8_BAR;
    for (;;) {
        const bool has_next = S.next(ui + 1, nxt);
        const char* nA = has_next ? (const char*)g.A + (size_t)nxt.pm * tstep + (size_t)nxt.k0 * kstep : cA; const char* nB = has_next ? (const char*)g.Bt + (size_t)nxt.pn * tstep + (size_t)nxt.k0 * kstep : cB;
        const int nt = cur.nkt;
        for (int t = 0; t < nt; t += 2) {
            const bool last = (t == nt - 2);
            const char* a1 = cA + (size_t)(t + 1) * kstep;
            const char* a2 = last ? nA : cA + (size_t)(t + 2) * kstep; const char* b2 = last ? nB : cB + (size_t)(t + 2) * kstep;
            const char* a3 = a2 + kstep; const char* b3 = b2 + kstep;
            if (last && has_next) S.a_ready(nxt);
            PG8_LDB(B0, 0, 0); PG8_SCHED; PG8_LDA(At, 0, 0); PG8_STAGE(PG8_SA(1, 1), a1 + hstep, voffA);
            PG8_WAIT_L(8); PG8_BAR; PG8_WAIT_L(0); PG8_MMA(0, 0, At, B0); PG8_BAR; PG8_SCHED;
            PG8_LDB(B1, 0, 1); PG8_STAGE(PG8_SB(0, 0), b2, voffB);
            PG8_BAR; PG8_WAIT_L(0); PG8_MMA(0, 1, At, B1); PG8_BAR;
            PG8_LDA(At, 0, 1); PG8_STAGE(PG8_SA(0, 0), a2, voffA);
            PG8_BAR; PG8_WAIT_L(0); PG8_MMA(1, 0, At, B0); PG8_BAR; PG8_SCHED;
            PG8_STAGE(PG8_SB(0, 1), b2 + hstep, voffB);
            PG8_WAIT_V(6); PG8_BAR; PG8_MMA(1, 1, At, B1); PG8_BAR;
            PG8_LDB(B0, 1, 0); PG8_SCHED; PG8_LDA(At, 1, 0); PG8_STAGE(PG8_SA(0, 1), a2 + hstep, voffA);
            PG8_WAIT_L(8); PG8_BAR; PG8_WAIT_L(0); PG8_MMA(0, 0, At, B0); PG8_BAR; PG8_SCHED;
            PG8_LDB(B1, 1, 1); PG8_STAGE(PG8_SB(1, 0), b3, voffB);
            PG8_BAR; PG8_WAIT_L(0); PG8_MMA(0, 1, At, B1); PG8_BAR;
            PG8_LDA(At, 1, 1); PG8_STAGE(PG8_SA(1, 0), a3, voffA);
            PG8_BAR; PG8_WAIT_L(0); PG8_MMA(1, 0, At, B0); PG8_BAR; PG8_SCHED;
            PG8_STAGE(PG8_SB(1, 1), b3 + hstep, voffB);
            PG8_WAIT_V(6); PG8_BAR; PG8_MMA(1, 1, At, B1); PG8_BAR;
        }
        { const int l2 = fresh_tid(wv) & 63; E(acc, cur, wr, wc, l2 & 15, l2 >> 4); } S.done(cur);
        if (!has_next) break;
#pragma unroll
        for (int a = 0; a < 2; ++a)
#pragma unroll
            for (int b = 0; b < 2; ++b)
#pragma unroll
                for (int m = 0; m < 4; ++m)
#pragma unroll
                    for (int n = 0; n < 2; ++n) acc[a][b][m][n] = (f32x4){0.f, 0.f, 0.f, 0.f};
        cur = nxt; cA = nA; cB = nB; ++ui;
    }
    PG8_WAIT_V(0);
    if (wr == 0) PG8_BAR;
    PG8_BAR;
#undef PG8_SA
#undef PG8_SB
#undef PG8_STAGE
#undef PG8_LDA
#undef PG8_LDB
#undef PG8_MMA
#undef PG8_WAIT_V
#undef PG8_WAIT_L
#undef PG8_BAR
#undef PG8_SCHED
}
}

using pg8::bf16_t; using pg8::f32x4; using pg8::bf16x8; using pg8::u32x4; using pg8::u32x2;
#define LAS __attribute__((address_space(3)))

constexpr int D = 1024, DFF = 2816, NGU = 5632, NCOLS = 3840;
constexpr int MP = 16384, MS = 512, MT = 16896, MIN_ = 17152;
constexpr int LDS_BYTES = 147456;
constexpr size_t O_SHP = 17301504, O_WKP = O_SHP + 8192, O_RTP = O_WKP + 262144, O_SHS = O_RTP + 524288, O_WKS = O_SHS + 131072, O_RTS = O_WKS + 4194304;
constexpr size_t WS_ROPE = 16384;
constexpr size_t WS_WL   = WS_ROPE + 1050624;
constexpr size_t WS_WOUT = WS_WL + 786432;
constexpr size_t WS_WIN  = WS_WOUT + 2097152;
constexpr size_t WS_WGU  = WS_WIN + 7864320;
constexpr size_t WS_WD   = WS_WGU + 11534336;
constexpr size_t WS_XN   = WS_WD + 5767168;
constexpr size_t WS_BIG  = WS_XN + 35127296;
constexpr size_t WS_FO   = WS_BIG + 95158272;
constexpr size_t WS_YS   = WS_BIG + 131727360;
constexpr size_t WS_LA   = WS_YS + 17301504;
constexpr size_t WS_OMD  = WS_BIG + 164364288;
constexpr size_t WS_ASIG = WS_OMD + 17301504;
constexpr size_t WS_END  = WS_ASIG + 17301504;
static_assert(WS_LA + 8650752 <= WS_OMD, "mixer overlays");
static_assert(WS_END <= 268435456, "workspace");

struct Params {
    const float *x_prompt, *x_sample, *state_shift, *state_wkv, *state_ret, *norm_g, *f1g, *f1u, *f1d, *w_in, *mu, *w0, *w2, *a0, *a2, *g2, *k_k, *k_a, *r_k, *lnx_w, *lnx_b, *gn_w, *w_out, *f2g, *f2u, *f2d;
    float* out; unsigned char* ws;
};
#define CAS __attribute__((address_space(4)))
typedef const CAS Params& PR;

__device__ __forceinline__ float bf2f(unsigned b) { return __uint_as_float(b << 16); }
__device__ __forceinline__ bf16_t f2bf(float f) { unsigned u = __float_as_uint(f); u += 0x7FFFu + ((u >> 16) & 1u); return (bf16_t)(u >> 16); }
__device__ __forceinline__ float lo_bf(unsigned x) { return __uint_as_float(x << 16); }
__device__ __forceinline__ float hi_bf(unsigned x) { return __uint_as_float(x & 0xffff0000u); }
template <int CTRL> __device__ __forceinline__ float dppf(float v) { return __int_as_float(__builtin_amdgcn_update_dpp(0, __float_as_int(v), CTRL, 0xF, 0xF, false)); }
__device__ __forceinline__ float row16_sum(float v) { v += dppf<0xB1>(v); v += dppf<0x4E>(v); v += dppf<0x141>(v); v += dppf<0x140>(v); return v; }
__device__ __forceinline__ float wave_sum(float v) { v = row16_sum(v); const int i = __float_as_int(v);
    return __int_as_float(__builtin_amdgcn_readlane(i, 0)) + __int_as_float(__builtin_amdgcn_readlane(i, 16)) + __int_as_float(__builtin_amdgcn_readlane(i, 32)) + __int_as_float(__builtin_amdgcn_readlane(i, 48)); }
__device__ __forceinline__ float quad_sum(float v) { v += dppf<0xB1>(v); v += dppf<0x4E>(v); return v; }
__device__ __forceinline__ float sigmoid_f(float x) { return __builtin_amdgcn_rcpf(1.0f + __expf(-x)); }


#define XB_TMO      128
#define XB_XCNT(j)  (256  + 64 * (j))
#define XB_XSUB(j)  (1280 + 64 * (j))
#define XB_XGEN(j)  (2304 + 64 * (j))
#define XB_TOP      3328
#define XB_TOPGEN   3392
#define XCD_BAR_WORDS 3456
#define XB_SPIN_CAP (1u << 18)
__device__ __forceinline__ unsigned xb_ld(unsigned* p)              { return __hip_atomic_load(p, __ATOMIC_RELAXED, __HIP_MEMORY_SCOPE_AGENT); }
__device__ __forceinline__ unsigned xb_add(unsigned* p, unsigned v) { return __hip_atomic_fetch_add(p, v, __ATOMIC_RELAXED, __HIP_MEMORY_SCOPE_AGENT); }
__device__ __forceinline__ unsigned xb_xcc_id() { return (unsigned)__builtin_amdgcn_s_getreg((3 << 11) | 20) & 0xFu; }
#define XB_SPIN(cond, bar) do { unsigned _sp = 0; while (cond) { __builtin_amdgcn_s_sleep(1); \
    if ((++_sp & 255u) == 0u) { if (xb_ld(&(bar)[XB_TMO])) break; if (_sp > XB_SPIN_CAP) { atomicAdd(&(bar)[XB_TMO], 1u); break; } } } } while (0)
struct XcdBarrier { unsigned* bar; unsigned x; volatile LAS unsigned* st; };
__device__ __forceinline__ XcdBarrier xcd_barrier_post(unsigned* bar, volatile LAS unsigned* st) {
    XcdBarrier b; b.bar = bar; b.x = xb_xcc_id(); b.st = st;
    return b;
}
__device__ __forceinline__ void xcd_barrier_complete(unsigned* bar, unsigned x, unsigned& nloc, unsigned& nx) {
    const unsigned G = gridDim.x * gridDim.y * gridDim.z;
    unsigned sum, cnt, mine, sp = 0u;
    for (;;) {
        sum = 0u; cnt = 0u; mine = 0u;
#pragma unroll
        for (unsigned j = 0; j < 16; ++j) { const unsigned c = xb_ld(&bar[XB_XCNT(j)]); sum += c; cnt += (c > 0u) ? 1u : 0u; mine = (j == x) ? c : mine; }
        if (sum == G) break;
        __builtin_amdgcn_s_sleep(1);
        if ((++sp & 255u) == 0u) { if (xb_ld(&bar[XB_TMO])) break; if (sp > XB_SPIN_CAP) { atomicAdd(&bar[XB_TMO], 1u); break; } }
    }
    nloc = mine > 0u ? mine : 1u; nx = cnt > 0u ? cnt : 1u;
}
__device__ __forceinline__ void xcd_barrier(unsigned* barw, volatile LAS unsigned* stw, const int wv) {
    XcdBarrier b; b.bar = barw; b.x = xb_xcc_id(); b.st = stw;
    asm volatile("s_waitcnt vmcnt(0)" ::: "memory");
    __syncthreads();
    if (fresh_tid(wv) == 0) {
        unsigned* bar = b.bar;
        __builtin_amdgcn_s_waitcnt(0);
        unsigned nloc = b.st[0], nx = b.st[1];
        if (nloc == 0u) { xcd_barrier_complete(bar, b.x, nloc, nx); b.st[0] = nloc; b.st[1] = nx; }
        const unsigned old = xb_add(&bar[XB_XSUB(b.x)], 1u);
        const unsigned gen = old / nloc;
        if (old + 1u == (gen + 1u) * nloc) {
            __builtin_amdgcn_fence(__ATOMIC_RELEASE, "agent");
            asm volatile("s_waitcnt vmcnt(0)" ::: "memory");
            const unsigned og = xb_add(&bar[XB_TOP], 1u);
            const unsigned tg = og / nx;
            if (og + 1u == (tg + 1u) * nx) xb_add(&bar[XB_TOPGEN], 1u);
            else XB_SPIN(xb_ld(&bar[XB_TOPGEN]) == tg, bar);
            __builtin_amdgcn_fence(__ATOMIC_ACQUIRE, "agent");
            xb_add(&bar[XB_XGEN(b.x)], 1u);
            asm volatile("s_waitcnt vmcnt(0)" ::: "memory");
        } else {
            XB_SPIN(xb_ld(&bar[XB_XGEN(b.x)]) == gen, bar);
            __builtin_amdgcn_fence(__ATOMIC_ACQUIRE, "agent");
            asm volatile("s_waitcnt vmcnt(0)" ::: "memory");
        }
    }
    __syncthreads();
}


#define DPP2(x, y, CTRL, NOP) asm volatile(NOP "\n\tv_add_f32_dpp %0, %0, %0 " CTRL " row_mask:0xf bank_mask:0xf bound_ctrl:1\n\tv_add_f32_dpp %1, %1, %1 " CTRL " row_mask:0xf bank_mask:0xf bound_ctrl:1" : "+v"(x), "+v"(y))
#define DPP4(x, y, z, w, CTRL, NOP) asm volatile(NOP "\n\tv_add_f32_dpp %0, %0, %0 " CTRL " row_mask:0xf bank_mask:0xf bound_ctrl:1\n\tv_add_f32_dpp %1, %1, %1 " CTRL " row_mask:0xf bank_mask:0xf bound_ctrl:1\n\tv_add_f32_dpp %2, %2, %2 " CTRL " row_mask:0xf bank_mask:0xf bound_ctrl:1\n\tv_add_f32_dpp %3, %3, %3 " CTRL " row_mask:0xf bank_mask:0xf bound_ctrl:1" : "+v"(x), "+v"(y), "+v"(z), "+v"(w))
#define ROW16_SUM4(x, y, z, w) do { DPP4(x, y, z, w, "quad_perm:[1,0,3,2]", "s_nop 1"); DPP4(x, y, z, w, "quad_perm:[2,3,0,1]", ""); DPP4(x, y, z, w, "row_half_mirror", ""); DPP4(x, y, z, w, "row_mirror", ""); } while (0)
#define ROW16_SUM2(x, y) do { DPP2(x, y, "quad_perm:[1,0,3,2]", "s_nop 1"); DPP2(x, y, "quad_perm:[2,3,0,1]", "s_nop 0"); DPP2(x, y, "row_half_mirror", "s_nop 0"); DPP2(x, y, "row_mirror", "s_nop 0"); } while (0)
__device__ __forceinline__ int prev_row(int r) {
    if (r < MP) return (r & 2047) == 0 ? -1 : r - 1;
    const int s = r - MP; return (s & 3) == 0 ? MT + (s >> 2) : r - 1;
}

struct TDesc { const float* W; bf16_t* Bt; int K, N, k0, n0, brow0; };
__device__ __forceinline__ TDesc tconv_desc(const float* wg, const float* wu, const float* wd, const float* win, const float* wout, unsigned char* ws, int i) {
    TDesc d; int mode = 0, tile = i;
    if (i < 704) { d.W = wg; d.Bt = (bf16_t*)(ws + WS_WGU); d.K = 1024; d.N = DFF; mode = 1; }
    else if (i < 1408) { d.W = wu; d.Bt = (bf16_t*)(ws + WS_WGU); d.K = 1024; d.N = DFF; mode = 2; tile = i - 704; }
    else if (i < 2112) { d.W = wd; d.Bt = (bf16_t*)(ws + WS_WD); d.K = DFF; d.N = 1024; tile = i - 1408; }
    else if (i < 3072) { d.W = win; d.Bt = (bf16_t*)(ws + WS_WIN); d.K = 1024; d.N = NCOLS; tile = i - 2112; }
    else { d.W = wout; d.Bt = (bf16_t*)(ws + WS_WOUT); d.K = 1024; d.N = 1024; tile = i - 3072; }
    const int nkt = d.K / 64; const int kt = tile % nkt, nt = tile / nkt; d.k0 = kt * 64; d.n0 = nt * 64;
    d.brow0 = mode == 0 ? d.n0 : ((d.n0 >> 7) * 256 + (d.n0 & 127) + (mode == 2 ? 128 : 0));
    return d;
}
__device__ __forceinline__ void tconv_list(const float* wg, const float* wu, const float* wd, const float* win, const float* wout, unsigned char* ws, const int ntiles, LAS float* t, const int wv) {
    const int tid = fresh_tid(wv); const int G = gridDim.x;
    float cur[8], nxt[8];
    int i = blockIdx.x;
    if (i < ntiles) { const TDesc d = tconv_desc(wg, wu, wd, win, wout, ws, i);
#pragma unroll
        for (int e = 0; e < 8; ++e) { const int idx = e * 512 + tid, r = idx >> 6, c = idx & 63; cur[e] = d.W[(size_t)(d.k0 + r) * d.N + d.n0 + c]; } }
    for (; i < ntiles; i += G) {
        const TDesc d = tconv_desc(wg, wu, wd, win, wout, ws, i);
        if (i + G < ntiles) { const TDesc dn = tconv_desc(wg, wu, wd, win, wout, ws, i + G);
#pragma unroll
            for (int e = 0; e < 8; ++e) { const int idx = e * 512 + tid, r = idx >> 6, c = idx & 63; nxt[e] = dn.W[(size_t)(dn.k0 + r) * dn.N + dn.n0 + c]; } }
#pragma unroll
        for (int e = 0; e < 8; ++e) { const int idx = e * 512 + tid, r = idx >> 6, c = idx & 63; t[r * 65 + c] = cur[e]; }
        __syncthreads();
#pragma unroll
        for (int e = 0; e < 4; ++e) { const int idx = e * 512 + tid, n = idx >> 5, kp = idx & 31;
            const unsigned w = pg8::cvt_pk_bf16(t[(2 * kp) * 65 + n], t[(2 * kp + 1) * 65 + n]);
            *(unsigned*)(d.Bt + (size_t)(d.brow0 + n) * d.K + d.k0 + 2 * kp) = w; }
        __syncthreads();
#pragma unroll
        for (int e = 0; e < 8; ++e) cur[e] = nxt[e];
    }
}

__device__ __forceinline__ void rows_phase(PR P, const int mode, const int wv) {
    const int tid = fresh_tid(wv); const int lane = tid & 63; const int gw = blockIdx.x * 8 + (tid >> 6), nw = gridDim.x * 8;
    const bf16_t* FO = (const bf16_t*)(P.ws + WS_FO); bf16_t* XN = (bf16_t*)(P.ws + WS_XN);
    const float* gpost = P.norm_g + (mode == 1 ? 1 : (mode == 2 ? 3 : 5)) * 1024;
    const float* gnext = P.norm_g + (mode == 0 ? 0 : (mode == 1 ? 2 : 4)) * 1024;
    const float scale = mode == 2 ? 1.0f : 0.5f;
    for (int row = gw; row < MT; row += nw) {
        float4 xv[4];
        if (mode <= 1) { const float* xin = row < MP ? P.x_prompt + (size_t)row * 1024 : P.x_sample + (size_t)(row - MP) * 1024;
#pragma unroll
            for (int q = 0; q < 4; ++q) xv[q] = *(const float4*)(xin + (q * 64 + lane) * 4); }
        else { const bf16_t* xb = (mode == 2 ? (const bf16_t*)P.out : (const bf16_t*)(P.ws + WS_FO + 34603008)) + (size_t)row * 1024;
#pragma unroll
            for (int q = 0; q < 4; ++q) { const u32x2 t = *(const u32x2*)(xb + (q * 64 + lane) * 4); xv[q] = make_float4(lo_bf(t.x), hi_bf(t.x), lo_bf(t.y), hi_bf(t.y)); } }
        if (mode != 0) {
            float4 fo[4]; float ss = 0.f;
#pragma unroll
            for (int q = 0; q < 4; ++q) {
                if (row < MP) { const u32x2 fb = *(const u32x2*)(FO + (size_t)row * 1024 + (q * 64 + lane) * 4); fo[q] = make_float4(lo_bf(fb.x), hi_bf(fb.x), lo_bf(fb.y), hi_bf(fb.y)); }
                else {
                    const int KS = mode == 2 ? 4 : 8; const float* sl = (const float*)(P.ws + WS_OMD) + (size_t)((((row - MP) >> 8) * 4 + q) * KS) * 65536 + (size_t)(row & 255) * 256 + lane * 4;
                    float4 a = *(const float4*)sl;
                    for (int p = 1; p < KS; ++p) { const float4 b = *(const float4*)(sl + (size_t)p * 65536); a.x += b.x; a.y += b.y; a.z += b.z; a.w += b.w; }
                    fo[q] = a; }
                ss += fo[q].x * fo[q].x + fo[q].y * fo[q].y + fo[q].z * fo[q].z + fo[q].w * fo[q].w; }
            ss = wave_sum(ss); const float r = rsqrtf(ss * (1.0f / 1024.0f) + 1e-6f) * scale;
#pragma unroll
            for (int q = 0; q < 4; ++q) { const float4 g = *(const float4*)(gpost + (q * 64 + lane) * 4);
                xv[q].x += fo[q].x * r * g.x; xv[q].y += fo[q].y * r * g.y; xv[q].z += fo[q].z * r * g.z; xv[q].w += fo[q].w * r * g.w;
                if (mode == 3) *(float4*)(P.out + (size_t)row * 1024 + (q * 64 + lane) * 4) = xv[q];
                else { bf16_t* xo = (mode == 1 ? (bf16_t*)P.out : (bf16_t*)(P.ws + WS_FO + 34603008)) + (size_t)row * 1024; u32x2 t; t.x = pg8::cvt_pk_bf16(xv[q].x, xv[q].y); t.y = pg8::cvt_pk_bf16(xv[q].z, xv[q].w);
                    *(u32x2*)(xo + (q * 64 + lane) * 4) = t; } }
            if (mode == 3) continue;
        }
        float ss2 = 0.f;
#pragma unroll
        for (int q = 0; q < 4; ++q) ss2 += xv[q].x * xv[q].x + xv[q].y * xv[q].y + xv[q].z * xv[q].z + xv[q].w * xv[q].w;
        ss2 = wave_sum(ss2); const float r2 = rsqrtf(ss2 * (1.0f / 1024.0f) + 1e-6f);
        float* sh = nullptr;
        if (mode == 1) { if (row < MP) { if ((row & 2047) == 2047) sh = P.out + O_SHP + (size_t)(row >> 11) * 1024; } else { const int s = row - MP; if ((s & 3) == 3) sh = P.out + O_SHS + (size_t)(s >> 2) * 1024; } }
#pragma unroll
        for (int q = 0; q < 4; ++q) { const float4 g = *(const float4*)(gnext + (q * 64 + lane) * 4);
            float4 hv; hv.x = xv[q].x * r2 * g.x; hv.y = xv[q].y * r2 * g.y; hv.z = xv[q].z * r2 * g.z; hv.w = xv[q].w * r2 * g.w;
            u32x2 w; w.x = pg8::cvt_pk_bf16(hv.x, hv.y); w.y = pg8::cvt_pk_bf16(hv.z, hv.w);
            *(u32x2*)(XN + (size_t)row * 1024 + (q * 64 + lane) * 4) = w;
            if (sh) *(float4*)(sh + (q * 64 + lane) * 4) = hv; }
    }
}

__device__ __forceinline__ void p0_prologue(PR P, LAS float* ldsf, const int wv) {
    const int tid = fresh_tid(wv); const size_t gt = (size_t)blockIdx.x * 512 + tid, nth = (size_t)gridDim.x * 512;
    { float* rc = (float*)(P.ws + WS_ROPE); float* rs = rc + 2052 * 64;
      for (size_t i = gt; i < 2052 * 64; i += nth) { const int p = (int)(i >> 6), f = (int)(i & 63); const int pos = p < 2048 ? p : 16384 + (p - 2048);
          double inv = 1.0; for (int q = 0; q < f; ++q) inv *= 0.8659643233600653;
          const double ang = (double)pos * inv; const double n = rint(ang * 0.15915494309189535); const double r = ang - n * 6.283185307179586;
          const double r2 = r * r; double s = 0.0, c = 0.0;
          for (int k = 14; k >= 0; --k) { s = s * (-r2 / (double)((2 * k + 2) * (2 * k + 3))) + 1.0; c = c * (-r2 / (double)((2 * k + 1) * (2 * k + 2))) + 1.0; }
          rc[i] = (float)c; rs[i] = (float)(s * r); } }
    { bf16_t* Wl = (bf16_t*)(P.ws + WS_WL);
      for (size_t i = gt; i < 1536 * 256; i += nth) { const int n = (int)(i >> 8), k = (int)(i & 255); float v = 0.f;
          if (n < 512) { if (k < 64) v = P.w2[k * 512 + n]; } else if (n < 1024) { if (k >= 64 && k < 128) v = P.a2[(k - 64) * 512 + (n - 512)]; } else { if (k >= 128) v = P.g2[(k - 128) * 512 + (n - 1024)]; }
          Wl[i] = f2bf(v); } }
    { bf16_t* XN = (bf16_t*)(P.ws + WS_XN);
      for (size_t i = gt; i < 256 * 1024; i += nth) { const int r = (int)(i >> 10); XN[(size_t)MT * 1024 + i] = r < 128 ? f2bf(P.state_shift[i]) : (bf16_t)0; } }
    tconv_list(P.f1g, P.f1u, P.f1d, P.w_in, P.w_out, P.ws, 3328, ldsf, wv);
    rows_phase(P, 0, wv);
}

__device__ __forceinline__ void lora_prep(PR P, const int wv) {
    const int tid = fresh_tid(wv); const int lane = tid & 63; const int gw = blockIdx.x * 8 + (tid >> 6), nw = gridDim.x * 8;
    const bf16_t* PS = (const bf16_t*)(P.ws + WS_BIG); bf16_t* LA = (bf16_t*)(P.ws + WS_LA);
    const float4 mu = *(const float4*)(P.mu + 1536 + lane * 4); const int kind = lane >> 4;
    u32x2 c = (u32x2){0u, 0u}, p = c, nc = c, np = c;
    if (gw < MT) { c = *(const u32x2*)(PS + (size_t)gw * NCOLS + 1536 + lane * 4); const int pr = prev_row(gw); if (pr >= 0) p = *(const u32x2*)(PS + (size_t)pr * NCOLS + 1536 + lane * 4); }
    for (int row = gw; row < MT; row += nw) {
        const int nrow = row + nw;
        if (nrow < MT) { nc = *(const u32x2*)(PS + (size_t)nrow * NCOLS + 1536 + lane * 4); const int pr = prev_row(nrow); np = (u32x2){0u, 0u}; if (pr >= 0) np = *(const u32x2*)(PS + (size_t)pr * NCOLS + 1536 + lane * 4); }
        float v[4]; const float cu[4] = {lo_bf(c.x), hi_bf(c.x), lo_bf(c.y), hi_bf(c.y)}, pv[4] = {lo_bf(p.x), hi_bf(p.x), lo_bf(p.y), hi_bf(p.y)}, m4[4] = {mu.x, mu.y, mu.z, mu.w};
#pragma unroll
        for (int j = 0; j < 4; ++j) { float x = cu[j] + (pv[j] - cu[j]) * m4[j];
            if (kind == 0) x = 1.0f - 2.0f * __builtin_amdgcn_rcpf(__expf(2.0f * x) + 1.0f); else if (kind >= 2) x = sigmoid_f(x);
            v[j] = x; }
        u32x2 w; w.x = pg8::cvt_pk_bf16(v[0], v[1]); w.y = pg8::cvt_pk_bf16(v[2], v[3]);
        *(u32x2*)(LA + (size_t)row * 256 + lane * 4) = w;
        c = nc; p = np;
    }
}

template <bool SAMPLE>
__device__ __forceinline__ void rwkv_unit(PR P, LAS float* lds, const int b, const int h, const int half, const int wv) {
    constexpr int T = SAMPLE ? 4 : 2048, TC = SAMPLE ? 4 : 32, NCH = T / TC;
    const int tid = fresh_tid(wv), lane = tid & 63, wid = tid >> 6;
    const bf16_t* PS = (const bf16_t*)(P.ws + WS_BIG); const bf16_t* OMD = (const bf16_t*)(P.ws + WS_OMD); const bf16_t* ASIG = (const bf16_t*)(P.ws + WS_ASIG);
    bf16_t* YS = (bf16_t*)(P.ws + WS_YS);
    const int row_base = SAMPLE ? MP + b * 4 : b * 2048;
    const int ltok = (tid - 256) >> 4, lcg = tid & 15; const bool lwave = tid >= 256; const int hch = h * 64 + lcg * 4;
    const float4 mur = *(const float4*)(P.mu + hch), muk = *(const float4*)(P.mu + 512 + hch), muv = *(const float4*)(P.mu + 1024 + hch);
    const float4 kk4 = *(const float4*)(P.k_k + hch), ka4 = *(const float4*)(P.k_a + hch);
    typedef float f32x2 __attribute__((ext_vector_type(2)));
    const int row0 = half * 32 + (wid & 3) * 8 + (lane >> 4) * 2, cgl = lane & 15, j0 = cgl * 4;
    f32x2 S[4];
#pragma unroll
    for (int c = 0; c < 4; ++c) S[c] = (f32x2){0.f, 0.f};
    float* sout = P.out + (SAMPLE ? O_WKS : O_WKP) + ((size_t)(b * 8 + h) * 64 + row0) * 64 + j0;
    if (SAMPLE && wid < 4) { const float* sp = P.state_wkv + ((size_t)(b * 8 + h) * 64 + row0) * 64 + j0; const float4 s0 = *(const float4*)sp, s1 = *(const float4*)(sp + 64);
        S[0] = (f32x2){s0.x, s1.x}; S[1] = (f32x2){s0.y, s1.y}; S[2] = (f32x2){s0.z, s1.z}; S[3] = (f32x2){s0.w, s1.w}; }
    LAS float* buf0 = lds; LAS float* buf1 = lds + TC * 384;
    u32x2 cr[2], ck[2], cv[2], pr[2], pk[2], pv[2], co[2], ca[2];
#define RW_LOAD1(c, U) do { if (lwave && ltok + 16 * (U) < TC) { const int t_ = (c) * TC + ltok + 16 * (U); const int row_ = row_base + t_; const int prow_ = SAMPLE ? (t_ == 0 ? MT + b : row_ - 1) : row_ - 1; \
        const bf16_t* cp_ = PS + (size_t)row_ * NCOLS + hch; cr[U] = *(const u32x2*)cp_; ck[U] = *(const u32x2*)(cp_ + 512); cv[U] = *(const u32x2*)(cp_ + 1024); \
        if (SAMPLE || t_ > 0) { const bf16_t* pp_ = PS + (size_t)prow_ * NCOLS + hch; pr[U] = *(const u32x2*)pp_; pk[U] = *(const u32x2*)(pp_ + 512); pv[U] = *(const u32x2*)(pp_ + 1024); } \
        else { pr[U] = (u32x2){0u, 0u}; pk[U] = pr[U]; pv[U] = pr[U]; } \
        co[U] = *(const u32x2*)(OMD + (size_t)row_ * 512 + hch); ca[U] = *(const u32x2*)(ASIG + (size_t)row_ * 512 + hch); } } while (0)
#define RW_LOAD(c) do { RW_LOAD1(c, 0); RW_LOAD1(c, 1); } while (0)
#define RW_MIX(cu, pv_, m) ((cu) + ((pv_) - (cu)) * (m))
#define RW_PROC1(dst, U) do { if (lwave && ltok + 16 * (U) < TC) { LAS float* d_ = (dst) + (ltok + 16 * (U)) * 384 + lcg * 4; \
        f32x4 r_, k_, v_, o_, a_; \
        r_[0] = RW_MIX(lo_bf(cr[U].x), lo_bf(pr[U].x), mur.x); r_[1] = RW_MIX(hi_bf(cr[U].x), hi_bf(pr[U].x), mur.y); r_[2] = RW_MIX(lo_bf(cr[U].y), lo_bf(pr[U].y), mur.z); r_[3] = RW_MIX(hi_bf(cr[U].y), hi_bf(pr[U].y), mur.w); \
        k_[0] = RW_MIX(lo_bf(ck[U].x), lo_bf(pk[U].x), muk.x); k_[1] = RW_MIX(hi_bf(ck[U].x), hi_bf(pk[U].x), muk.y); k_[2] = RW_MIX(lo_bf(ck[U].y), lo_bf(pk[U].y), muk.z); k_[3] = RW_MIX(hi_bf(ck[U].y), hi_bf(pk[U].y), muk.w); \
        v_[0] = RW_MIX(lo_bf(cv[U].x), lo_bf(pv[U].x), muv.x); v_[1] = RW_MIX(hi_bf(cv[U].x), hi_bf(pv[U].x), muv.y); v_[2] = RW_MIX(lo_bf(cv[U].y), lo_bf(pv[U].y), muv.z); v_[3] = RW_MIX(hi_bf(cv[U].y), hi_bf(pv[U].y), muv.w); \
        o_[0] = lo_bf(co[U].x); o_[1] = hi_bf(co[U].x); o_[2] = lo_bf(co[U].y); o_[3] = hi_bf(co[U].y); a_[0] = lo_bf(ca[U].x); a_[1] = hi_bf(ca[U].x); a_[2] = lo_bf(ca[U].y); a_[3] = hi_bf(ca[U].y); \
        f32x4 kk_; kk_[0] = k_[0] * kk4.x; kk_[1] = k_[1] * kk4.y; kk_[2] = k_[2] * kk4.z; kk_[3] = k_[3] * kk4.w; \
        float ss_ = kk_[0] * kk_[0] + kk_[1] * kk_[1] + kk_[2] * kk_[2] + kk_[3] * kk_[3]; ss_ = row16_sum(ss_); \
        const float inv_ = __builtin_amdgcn_rcpf(fmaxf(__builtin_amdgcn_sqrtf(ss_), 1e-12f)); kk_ = kk_ * inv_; \
        f32x4 kn_; kn_[0] = k_[0] * (1.0f + (a_[0] - 1.0f) * ka4.x); kn_[1] = k_[1] * (1.0f + (a_[1] - 1.0f) * ka4.y); kn_[2] = k_[2] * (1.0f + (a_[2] - 1.0f) * ka4.z); kn_[3] = k_[3] * (1.0f + (a_[3] - 1.0f) * ka4.w); \
        *(LAS f32x4*)(d_) = r_; *(LAS f32x4*)(d_ + 64) = o_; *(LAS f32x4*)(d_ + 128) = kn_; *(LAS f32x4*)(d_ + 192) = -kk_; *(LAS f32x4*)(d_ + 256) = kk_ * a_; *(LAS f32x4*)(d_ + 320) = v_; } } while (0)
#define RW_PROC(dst) do { RW_PROC1(dst, 0); RW_PROC1(dst, 1); } while (0)
    RW_LOAD(0); RW_PROC(buf0); __syncthreads();
    for (int c = 0; c < NCH; ++c) {
        LAS float* cur = (c & 1) ? buf1 : buf0; LAS float* nxt = (c & 1) ? buf0 : buf1;
        if (c + 1 < NCH) RW_LOAD(c + 1);
        if (wid < 4) {
            constexpr int GS = SAMPLE ? 4 : 16;
            for (int g = 0; g < TC / GS; ++g) {
                float yk0 = 0.f, yk1 = 0.f;
                const LAS float* q0 = cur + (g * GS) * 384;
                f32x4 r4 = *(const LAS f32x4*)(q0 + j0), o4 = *(const LAS f32x4*)(q0 + 64 + j0), k4 = *(const LAS f32x4*)(q0 + 128 + j0), a4 = *(const LAS f32x4*)(q0 + 192 + j0), b4 = *(const LAS f32x4*)(q0 + 256 + j0);
                f32x2 v2 = *(const LAS f32x2*)(q0 + 320 + row0);
                float py0 = 0.f, py1 = 0.f;
#pragma unroll
                for (int tt = 0; tt < GS; ++tt) {
                    const LAS float* qn = q0 + (tt + 1 < GS ? tt + 1 : tt) * 384;
                    const f32x4 nr4 = *(const LAS f32x4*)(qn + j0), no4 = *(const LAS f32x4*)(qn + 64 + j0), nk4 = *(const LAS f32x4*)(qn + 128 + j0), na4 = *(const LAS f32x4*)(qn + 192 + j0), nb4 = *(const LAS f32x4*)(qn + 256 + j0);
                    const f32x2 nv2 = *(const LAS f32x2*)(qn + 320 + row0);
                    f32x2 sa = (S[0] * a4[0] + S[1] * a4[1]) + (S[2] * a4[2] + S[3] * a4[3]);
                    float sx = sa.x, sy = sa.y; ROW16_SUM4(sx, sy, py0, py1); sa = (f32x2){sx, sy};
                    if (tt > 0) { yk0 = cgl == tt - 1 ? py0 : yk0; yk1 = cgl == tt - 1 ? py1 : yk1; }
#pragma unroll
                    for (int c = 0; c < 4; ++c) { f32x2 t = S[c] - S[c] * o4[c]; t = t + sa * b4[c]; S[c] = t + v2 * k4[c]; }
                    const f32x2 y = (S[0] * r4[0] + S[1] * r4[1]) + (S[2] * r4[2] + S[3] * r4[3]);
                    py0 = y.x; py1 = y.y;
                    r4 = nr4; o4 = no4; k4 = nk4; a4 = na4; b4 = nb4; v2 = nv2;
                }
                ROW16_SUM2(py0, py1); yk0 = cgl == GS - 1 ? py0 : yk0; yk1 = cgl == GS - 1 ? py1 : yk1;
                if (cgl < GS) *(unsigned*)(YS + (size_t)(row_base + c * TC + g * GS + cgl) * 512 + h * 64 + row0) = pg8::cvt_pk_bf16(yk0, yk1);
            }
        }
        if (c + 1 < NCH) RW_PROC(nxt);
        __syncthreads();
    }
    if (wid < 4) { *(float4*)sout = make_float4(S[0].x, S[1].x, S[2].x, S[3].x); *(float4*)(sout + 64) = make_float4(S[0].y, S[1].y, S[2].y, S[3].y); }
#undef RW_LOAD
#undef RW_PROC
#undef RW_LOAD1
#undef RW_PROC1
#undef RW_MIX
}

__device__ __forceinline__ void ret_sample_unit(PR P, LAS float* lds, const int b, const int h, const int wv) {
    const int tid = fresh_tid(wv), lane = tid & 63, wid = tid >> 6;
    const bf16_t* PS = (const bf16_t*)(P.ws + WS_BIG); bf16_t* Y = (bf16_t*)(P.ws + WS_XN);
    const float* rc = (const float*)(P.ws + WS_ROPE); const float* rs = rc + 2052 * 64;
    LAS float* q = lds; LAS float* k = lds + 512; LAS float* v = lds + 1024; LAS float* Pm = lds + 1536; LAS float* y2p = lds + 1600; LAS float* red = lds + 1600 + 2048;
    const float lg2 = log2f(1.0f - exp2f(-5.0f - (float)h));
    const int row0 = MP + b * 4;
    { const int t = (tid & 255) >> 6, f = tid & 63; const bf16_t* src = PS + (size_t)(row0 + t) * NCOLS + 1792 + h * 128;
      if (tid < 256) { const float cs = rc[(2048 + t) * 64 + f], sn = rs[(2048 + t) * 64 + f];
          const float q1 = bf2f(src[f]), q2 = bf2f(src[f + 64]); q[t * 128 + f] = q1 * cs - q2 * sn; q[t * 128 + f + 64] = q1 * sn + q2 * cs;
          const float k1 = bf2f(src[512 + f]), k2 = bf2f(src[512 + f + 64]); k[t * 128 + f] = (k1 * cs - k2 * sn) * 0.08838834764831845f; k[t * 128 + f + 64] = (k1 * sn + k2 * cs) * 0.08838834764831845f; }
      else { v[t * 128 + f] = bf2f(src[1024 + f]); v[t * 128 + f + 64] = bf2f(src[1024 + f + 64]); } }
    __syncthreads();
    if (wid == 0) { const int pi = lane >> 4, pj = (lane >> 2) & 3, part = lane & 3; float s = 0.f;
        for (int d = part * 32; d < part * 32 + 32; ++d) s += q[pi * 128 + d] * k[pj * 128 + d];
        s = quad_sum(s); if (part == 0) Pm[pi * 4 + pj] = pi >= pj ? s * exp2f(lg2 * (float)(pi - pj)) : 0.f; }
    { const int e = tid & 127, dg = tid >> 7; const float c4 = exp2f(lg2 * 4.0f), g3 = exp2f(lg2 * 3.0f), g2_ = exp2f(lg2 * 2.0f), g1 = exp2f(lg2);
      const float v0 = v[e] * g3, v1 = v[128 + e] * g2_, v2 = v[256 + e] * g1, v3 = v[384 + e];
      const float* S0 = P.state_ret + ((size_t)(b * 4 + h) * 128) * 128 + e; float* So = P.out + O_RTS + ((size_t)(b * 4 + h) * 128) * 128 + e;
      float a0 = 0.f, a1 = 0.f, a2 = 0.f, a3 = 0.f;
      float sv[32];
#pragma unroll
      for (int x = 0; x < 32; ++x) sv[x] = S0[(size_t)(dg * 32 + x) * 128];
#pragma unroll
      for (int x = 0; x < 32; ++x) { const int d = dg * 32 + x; const float s = sv[x];
          a0 = fmaf(q[d], s, a0); a1 = fmaf(q[128 + d], s, a1); a2 = fmaf(q[256 + d], s, a2); a3 = fmaf(q[384 + d], s, a3);
          So[(size_t)d * 128] = s * c4 + k[d] * v0 + k[128 + d] * v1 + k[256 + d] * v2 + k[384 + d] * v3; }
      y2p[(dg * 4 + 0) * 128 + e] = a0; y2p[(dg * 4 + 1) * 128 + e] = a1; y2p[(dg * 4 + 2) * 128 + e] = a2; y2p[(dg * 4 + 3) * 128 + e] = a3; }
    __syncthreads();
    { const int i = tid >> 7, e = tid & 127;
      float y = (y2p[(0 + i) * 128 + e] + y2p[(4 + i) * 128 + e] + y2p[(8 + i) * 128 + e] + y2p[(12 + i) * 128 + e]) * exp2f(lg2 * (float)(i + 1));
#pragma unroll
      for (int j = 0; j < 4; ++j) y = fmaf(Pm[i * 4 + j], v[j * 128 + e], y);
      float s = wave_sum(y); if (lane == 0) red[wid] = s; __syncthreads();
      const float mean = (red[i * 2] + red[i * 2 + 1]) * (1.0f / 128.0f); const float dlt = y - mean;
      float s2 = wave_sum(dlt * dlt); if (lane == 0) red[8 + wid] = s2; __syncthreads();
      const float var = (red[8 + i * 2] + red[8 + i * 2 + 1]) * (1.0f / 128.0f);
      const float g = bf2f(PS[(size_t)(row0 + i) * NCOLS + 1792 + 1536 + h * 128 + e]);
      const float o = dlt * rsqrtf(var + 1e-5f) * P.gn_w[h * 128 + e] * (g * __builtin_amdgcn_rcpf(1.0f + __expf(-g)));
      Y[(size_t)(row0 + i) * 1024 + 512 + h * 128 + e] = f2bf(o); }
    __syncthreads();
}

__device__ __forceinline__ bf16_t* kvb_ptr(unsigned char* ws, int bh) { return (bf16_t*)(bh < 29 ? ws + WS_LA + (size_t)bh * 524288 : ws + WS_WIN + 17301504 + (size_t)(bh - 29) * 524288); }
constexpr int RS = 136, BUFE = 128 * RS;

template <bool WITH_K>
__device__ __forceinline__ void ret_load_qk(PR P, LAS bf16_t* QP, LAS bf16_t* KB, unsigned (&kth)[4][4], const int tidv, const int row0, const int n, const int h, const float kd0, const float g32) {
    const bf16_t* PS = (const bf16_t*)(P.ws + WS_BIG); const float* rc = (const float*)(P.ws + WS_ROPE); const float* rs = rc + 2052 * 64;
    float kd = kd0;
#pragma unroll
    for (int it = 0; it < 4; ++it) { const int idx = it * 512 + tidv, i = idx >> 4, f = (idx & 15) * 4;
        const bf16_t* src = PS + (size_t)(row0 + i) * NCOLS + 1792 + h * 128;
        const u32x2 q1 = *(const u32x2*)(src + f), q2 = *(const u32x2*)(src + 64 + f);
        u32x2 k1 = (u32x2){0u, 0u}, k2 = k1; if (WITH_K) { k1 = *(const u32x2*)(src + 512 + f); k2 = *(const u32x2*)(src + 576 + f); }
        const float4 cs = *(const float4*)(rc + (size_t)(n * 128 + i) * 64 + f), sn = *(const float4*)(rs + (size_t)(n * 128 + i) * 64 + f);
        const float c4[4] = {cs.x, cs.y, cs.z, cs.w}, s4[4] = {sn.x, sn.y, sn.z, sn.w};
        const float qa[4] = {lo_bf(q1.x), hi_bf(q1.x), lo_bf(q1.y), hi_bf(q1.y)}, qb[4] = {lo_bf(q2.x), hi_bf(q2.x), lo_bf(q2.y), hi_bf(q2.y)};
        float qo1[4], qo2[4];
#pragma unroll
        for (int x = 0; x < 4; ++x) { qo1[x] = qa[x] * c4[x] - qb[x] * s4[x]; qo2[x] = qa[x] * s4[x] + qb[x] * c4[x]; }
        u32x2 w; w.x = pg8::cvt_pk_bf16(qo1[0], qo1[1]); w.y = pg8::cvt_pk_bf16(qo1[2], qo1[3]); *(LAS u32x2*)(QP + i * RS + f) = w;
        w.x = pg8::cvt_pk_bf16(qo2[0], qo2[1]); w.y = pg8::cvt_pk_bf16(qo2[2], qo2[3]); *(LAS u32x2*)(QP + i * RS + 64 + f) = w;
        if (WITH_K) {
            const float ka[4] = {lo_bf(k1.x), hi_bf(k1.x), lo_bf(k1.y), hi_bf(k1.y)}, kb[4] = {lo_bf(k2.x), hi_bf(k2.x), lo_bf(k2.y), hi_bf(k2.y)};
            float ko1[4], ko2[4];
#pragma unroll
            for (int x = 0; x < 4; ++x) { ko1[x] = (ka[x] * c4[x] - kb[x] * s4[x]) * 0.08838834764831845f; ko2[x] = (ka[x] * s4[x] + kb[x] * c4[x]) * 0.08838834764831845f; }
            w.x = pg8::cvt_pk_bf16(ko1[0], ko1[1]); w.y = pg8::cvt_pk_bf16(ko1[2], ko1[3]); *(LAS u32x2*)(KB + i * RS + f) = w;
            w.x = pg8::cvt_pk_bf16(ko2[0], ko2[1]); w.y = pg8::cvt_pk_bf16(ko2[2], ko2[3]); *(LAS u32x2*)(KB + i * RS + 64 + f) = w;
            kth[it][0] = pg8::cvt_pk_bf16(ko1[0] * kd, ko1[1] * kd); kth[it][1] = pg8::cvt_pk_bf16(ko1[2] * kd, ko1[3] * kd);
            kth[it][2] = pg8::cvt_pk_bf16(ko2[0] * kd, ko2[1] * kd); kth[it][3] = pg8::cvt_pk_bf16(ko2[2] * kd, ko2[3] * kd); kd *= g32; }
        if (it & 1) __builtin_amdgcn_sched_barrier(0); }
}

__device__ __forceinline__ void ret_unit_a(PR P, LAS unsigned char* lds, const int bh, const int n, const int wv) {
    LAS bf16_t* QP = (LAS bf16_t*)lds; LAS bf16_t* KB = QP + BUFE; LAS bf16_t* VT = KB + BUFE;
    const int tid = fresh_tid(wv), lane = tid & 63, wid = tid >> 6, wr = wid >> 1, wc = wid & 1, fr = lane & 15, fq = lane >> 4;
    const int b = bh >> 2, h = bh & 3;
    const bf16_t* PS = (const bf16_t*)(P.ws + WS_BIG); bf16_t* Y = (bf16_t*)(P.ws + WS_XN); bf16_t* KVB = kvb_ptr(P.ws, bh) + (size_t)n * 16384;
    const float lg2 = log2f(1.0f - exp2f(-5.0f - (float)h));
    const float kd0 = exp2f(lg2 * (float)(127 - (tid >> 4))), g32 = exp2f(-32.0f * lg2);
    const int row0 = b * 2048 + n * 128;
    unsigned kth[4][4];
    ret_load_qk<true>(P, QP, KB, kth, tid, row0, n, h, kd0, g32);
#pragma unroll
    for (int it = 0; it < 4; ++it) { const int idx = it * 512 + tid, j = idx >> 4, e = (idx & 15) * 8;
        const u32x4 vv = *(const u32x4*)(PS + (size_t)(row0 + j) * NCOLS + 1792 + 1024 + h * 128 + e);
        LAS bf16_t* d = VT + e * RS + j;
        d[0] = (bf16_t)(vv.x & 0xffffu); d[RS] = (bf16_t)(vv.x >> 16); d[2 * RS] = (bf16_t)(vv.y & 0xffffu); d[3 * RS] = (bf16_t)(vv.y >> 16);
        d[4 * RS] = (bf16_t)(vv.z & 0xffffu); d[5 * RS] = (bf16_t)(vv.z >> 16); d[6 * RS] = (bf16_t)(vv.w & 0xffffu); d[7 * RS] = (bf16_t)(vv.w >> 16); }
    __syncthreads();
    f32x4 accP[2][4];
#pragma unroll
    for (int mt = 0; mt < 2; ++mt)
#pragma unroll
        for (int nt = 0; nt < 4; ++nt) accP[mt][nt] = (f32x4){0.f, 0.f, 0.f, 0.f};
#pragma unroll
    for (int ks = 0; ks < 4; ++ks) { bf16x8 aq[2];
#pragma unroll
        for (int mt = 0; mt < 2; ++mt) aq[mt] = *(const LAS bf16x8*)(QP + (wr * 32 + mt * 16 + fr) * RS + ks * 32 + fq * 8);
#pragma unroll
        for (int nt = 0; nt < 4; ++nt) { const bf16x8 bk = *(const LAS bf16x8*)(KB + (wc * 64 + nt * 16 + fr) * RS + ks * 32 + fq * 8);
#pragma unroll
            for (int mt = 0; mt < 2; ++mt) accP[mt][nt] = __builtin_amdgcn_mfma_f32_16x16x32_bf16(aq[mt], bk, accP[mt][nt], 0, 0, 0); }
        __builtin_amdgcn_sched_barrier(0); }
    __syncthreads();
    { float ri[2][4], cj[4];
#pragma unroll
      for (int mt = 0; mt < 2; ++mt)
#pragma unroll
          for (int j = 0; j < 4; ++j) ri[mt][j] = exp2f(lg2 * (float)(wr * 32 + mt * 16 + fq * 4 + j));
#pragma unroll
      for (int nt = 0; nt < 4; ++nt) cj[nt] = exp2f(-lg2 * (float)(wc * 64 + nt * 16 + fr));
#pragma unroll
      for (int mt = 0; mt < 2; ++mt)
#pragma unroll
          for (int nt = 0; nt < 4; ++nt)
#pragma unroll
              for (int j = 0; j < 4; ++j) { const int i = wr * 32 + mt * 16 + fq * 4 + j, jj = wc * 64 + nt * 16 + fr;
                  const float val = i >= jj ? accP[mt][nt][j] * ri[mt][j] * cj[nt] : 0.f; QP[i * RS + jj] = f2bf(val); } }
#pragma unroll
    for (int it = 0; it < 4; ++it) { const int idx = it * 512 + tid, j = idx >> 4, f = (idx & 15) * 4; LAS bf16_t* d = KB + f * RS + j;
        d[0] = (bf16_t)(kth[it][0] & 0xffffu); d[RS] = (bf16_t)(kth[it][0] >> 16); d[2 * RS] = (bf16_t)(kth[it][1] & 0xffffu); d[3 * RS] = (bf16_t)(kth[it][1] >> 16);
        LAS bf16_t* d2 = d + 64 * RS;
        d2[0] = (bf16_t)(kth[it][2] & 0xffffu); d2[RS] = (bf16_t)(kth[it][2] >> 16); d2[2 * RS] = (bf16_t)(kth[it][3] & 0xffffu); d2[3 * RS] = (bf16_t)(kth[it][3] >> 16); }
    __syncthreads();
    f32x4 accY[2][4], accS[2][4];
#pragma unroll
    for (int mt = 0; mt < 2; ++mt)
#pragma unroll
        for (int nt = 0; nt < 4; ++nt) { accY[mt][nt] = (f32x4){0.f, 0.f, 0.f, 0.f}; accS[mt][nt] = (f32x4){0.f, 0.f, 0.f, 0.f}; }
#pragma unroll
    for (int ks = 0; ks < 4; ++ks) { bf16x8 ap[2], av[2];
#pragma unroll
        for (int mt = 0; mt < 2; ++mt) { ap[mt] = *(const LAS bf16x8*)(QP + (wr * 32 + mt * 16 + fr) * RS + ks * 32 + fq * 8); av[mt] = *(const LAS bf16x8*)(VT + (wr * 32 + mt * 16 + fr) * RS + ks * 32 + fq * 8); }
#pragma unroll
        for (int nt = 0; nt < 4; ++nt) { const bf16x8 bv = *(const LAS bf16x8*)(VT + (wc * 64 + nt * 16 + fr) * RS + ks * 32 + fq * 8), bkt = *(const LAS bf16x8*)(KB + (wc * 64 + nt * 16 + fr) * RS + ks * 32 + fq * 8);
#pragma unroll
            for (int mt = 0; mt < 2; ++mt) { accY[mt][nt] = __builtin_amdgcn_mfma_f32_16x16x32_bf16(ap[mt], bv, accY[mt][nt], 0, 0, 0); accS[mt][nt] = __builtin_amdgcn_mfma_f32_16x16x32_bf16(av[mt], bkt, accS[mt][nt], 0, 0, 0); } }
        __builtin_amdgcn_sched_barrier(0); }
#pragma unroll
    for (int mt = 0; mt < 2; ++mt)
#pragma unroll
        for (int nt = 0; nt < 4; ++nt)
#pragma unroll
            for (int j = 0; j < 4; ++j) { const int r = wr * 32 + mt * 16 + fq * 4 + j, c = wc * 64 + nt * 16 + fr;
                Y[(size_t)(row0 + r) * 1024 + 512 + h * 128 + c] = f2bf(accY[mt][nt][j]); KVB[r * 128 + c] = f2bf(accS[mt][nt][j]); }
    __syncthreads();
}

__device__ __forceinline__ void ret_prefix(PR P, const int item) {
    const int bh = item >> 11, i8 = (item & 2047) * 8; const int h = bh & 3;
    bf16_t* KVB = kvb_ptr(P.ws, bh) + i8;
    const float lg2 = log2f(1.0f - exp2f(-5.0f - (float)h)); const float c_dec = exp2f(lg2 * 128.0f);
    u32x4 kv[16];
#pragma unroll
    for (int n = 0; n < 16; ++n) kv[n] = *(const u32x4*)(KVB + (size_t)n * 16384);
    float S[8];
#pragma unroll
    for (int x = 0; x < 8; ++x) S[x] = 0.f;
#pragma unroll
    for (int n = 0; n < 16; ++n) { u32x4 w; w.x = pg8::cvt_pk_bf16(S[0], S[1]); w.y = pg8::cvt_pk_bf16(S[2], S[3]); w.z = pg8::cvt_pk_bf16(S[4], S[5]); w.w = pg8::cvt_pk_bf16(S[6], S[7]);
        *(u32x4*)(KVB + (size_t)n * 16384) = w;
        const float k8[8] = {lo_bf(kv[n].x), hi_bf(kv[n].x), lo_bf(kv[n].y), hi_bf(kv[n].y), lo_bf(kv[n].z), hi_bf(kv[n].z), lo_bf(kv[n].w), hi_bf(kv[n].w)};
#pragma unroll
        for (int x = 0; x < 8; ++x) S[x] = S[x] * c_dec + k8[x]; }
    const int e = i8 >> 7, d0 = i8 & 127;
#pragma unroll
    for (int x = 0; x < 8; ++x) P.out[O_RTP + ((size_t)bh * 128 + d0 + x) * 128 + e] = S[x];
}

__device__ __forceinline__ void ret_unit_c(PR P, LAS unsigned char* lds, const int bh, const int n, const int wv) {
    LAS bf16_t* QP = (LAS bf16_t*)lds; LAS bf16_t* ST = QP + 3 * BUFE; LAS float* YST = (LAS float*)(QP + BUFE);
    const int tid = fresh_tid(wv), lane = tid & 63, wid = tid >> 6, wr = wid >> 1, wc = wid & 1, fr = lane & 15, fq = lane >> 4;
    const int b = bh >> 2, h = bh & 3;
    const bf16_t* PS = (const bf16_t*)(P.ws + WS_BIG); bf16_t* Y = (bf16_t*)(P.ws + WS_XN); const bf16_t* KVB = kvb_ptr(P.ws, bh) + (size_t)n * 16384;
    const float lg2 = log2f(1.0f - exp2f(-5.0f - (float)h));
    const int row0 = b * 2048 + n * 128;
    unsigned kth[4][4];
    ret_load_qk<false>(P, QP, QP, kth, tid, row0, n, h, 0.f, 0.f);
#pragma unroll
    for (int it = 0; it < 4; ++it) { const int idx = it * 512 + tid, e = idx >> 4, d8 = (idx & 15) * 8;
        *(LAS u32x4*)(ST + e * RS + d8) = *(const u32x4*)(KVB + e * 128 + d8); }
    __syncthreads();
    f32x4 accY[2][4];
#pragma unroll
    for (int mt = 0; mt < 2; ++mt)
#pragma unroll
        for (int nt = 0; nt < 4; ++nt) accY[mt][nt] = (f32x4){0.f, 0.f, 0.f, 0.f};
#pragma unroll
    for (int ks = 0; ks < 4; ++ks) { bf16x8 aq[2];
#pragma unroll
        for (int mt = 0; mt < 2; ++mt) aq[mt] = *(const LAS bf16x8*)(QP + (wr * 32 + mt * 16 + fr) * RS + ks * 32 + fq * 8);
#pragma unroll
        for (int nt = 0; nt < 4; ++nt) { const bf16x8 bs = *(const LAS bf16x8*)(ST + (wc * 64 + nt * 16 + fr) * RS + ks * 32 + fq * 8);
#pragma unroll
            for (int mt = 0; mt < 2; ++mt) accY[mt][nt] = __builtin_amdgcn_mfma_f32_16x16x32_bf16(aq[mt], bs, accY[mt][nt], 0, 0, 0); }
        __builtin_amdgcn_sched_barrier(0); }
#pragma unroll
    for (int mt = 0; mt < 2; ++mt)
#pragma unroll
        for (int j = 0; j < 4; ++j) { const int r = wr * 32 + mt * 16 + fq * 4 + j; const float qd = exp2f(lg2 * (float)(r + 1));
#pragma unroll
            for (int nt = 0; nt < 4; ++nt) YST[r * 132 + wc * 64 + nt * 16 + fr] = accY[mt][nt][j] * qd; }
    __syncthreads();
    { const int i = tid >> 2, part = tid & 3; float yv[32]; float s = 0.f;
      bf16_t* yo = Y + (size_t)(row0 + i) * 1024 + 512 + h * 128 + part * 32;
#pragma unroll
      for (int x = 0; x < 4; ++x) { const u32x4 y1 = *(const u32x4*)(yo + x * 8); const f32x4 ta = *(const LAS f32x4*)(YST + i * 132 + part * 32 + x * 8), tb = *(const LAS f32x4*)(YST + i * 132 + part * 32 + x * 8 + 4);
          yv[x * 8 + 0] = ta[0] + lo_bf(y1.x); yv[x * 8 + 1] = ta[1] + hi_bf(y1.x); yv[x * 8 + 2] = ta[2] + lo_bf(y1.y); yv[x * 8 + 3] = ta[3] + hi_bf(y1.y);
          yv[x * 8 + 4] = tb[0] + lo_bf(y1.z); yv[x * 8 + 5] = tb[1] + hi_bf(y1.z); yv[x * 8 + 6] = tb[2] + lo_bf(y1.w); yv[x * 8 + 7] = tb[3] + hi_bf(y1.w); }
#pragma unroll
      for (int x = 0; x < 32; ++x) s += yv[x];
      s = quad_sum(s); const float mean = s * (1.0f / 128.0f); float s2 = 0.f;
#pragma unroll
      for (int x = 0; x < 32; ++x) { yv[x] -= mean; s2 += yv[x] * yv[x]; }
      s2 = quad_sum(s2); const float rstd = rsqrtf(s2 * (1.0f / 128.0f) + 1e-5f);
      const bf16_t* gp = PS + (size_t)(row0 + i) * NCOLS + 1792 + 1536 + h * 128 + part * 32; const float* gw = P.gn_w + h * 128 + part * 32;
#pragma unroll
      for (int x = 0; x < 4; ++x) { const u32x4 g4 = *(const u32x4*)(gp + x * 8); const float4 w0 = *(const float4*)(gw + x * 8), w1 = *(const float4*)(gw + x * 8 + 4);
          const float gg[8] = {lo_bf(g4.x), hi_bf(g4.x), lo_bf(g4.y), hi_bf(g4.y), lo_bf(g4.z), hi_bf(g4.z), lo_bf(g4.w), hi_bf(g4.w)}; const float ww[8] = {w0.x, w0.y, w0.z, w0.w, w1.x, w1.y, w1.z, w1.w};
          float o[8];
#pragma unroll
          for (int z = 0; z < 8; ++z) o[z] = yv[x * 8 + z] * rstd * ww[z] * (gg[z] * __builtin_amdgcn_rcpf(1.0f + __expf(-gg[z])));
          u32x4 w; w.x = pg8::cvt_pk_bf16(o[0], o[1]); w.y = pg8::cvt_pk_bf16(o[2], o[3]); w.z = pg8::cvt_pk_bf16(o[4], o[5]); w.w = pg8::cvt_pk_bf16(o[6], o[7]);
          *(u32x4*)(yo + x * 8) = w; } }
    __syncthreads();
}

__device__ __forceinline__ void sub_barrier(unsigned* cnt, const unsigned target, const int wv) {
    asm volatile("s_waitcnt vmcnt(0)" ::: "memory");
    __syncthreads();
    if (fresh_tid(wv) == 0) {
        __builtin_amdgcn_fence(__ATOMIC_RELEASE, "agent");
        asm volatile("s_waitcnt vmcnt(0)" ::: "memory");
        (void)xb_add(cnt, 1u);
        unsigned sp = 0u;
        while (xb_ld(cnt) < target) { __builtin_amdgcn_s_sleep(2); if (++sp > (1u << 20)) break; }
        __builtin_amdgcn_fence(__ATOMIC_ACQUIRE, "agent");
        asm volatile("s_waitcnt vmcnt(0)" ::: "memory");
    }
    __syncthreads();
}

struct PostRegs { u32x2 yr, c_r, c_k, c_v, p_r, p_k, p_v, ar, gr; };
__device__ __forceinline__ void post_load(PR P, PostRegs& R, const int row, const int ch) {
    const bf16_t* PS = (const bf16_t*)(P.ws + WS_BIG); const bf16_t* ASIG = (const bf16_t*)(P.ws + WS_ASIG); const bf16_t* YS = (const bf16_t*)(P.ws + WS_YS); const bf16_t* G = (const bf16_t*)(P.ws + WS_WIN);
    R.yr = *(const u32x2*)(YS + (size_t)row * 512 + ch);
    const bf16_t* cp = PS + (size_t)row * NCOLS + ch; const int pr = prev_row(row);
    R.c_r = *(const u32x2*)cp; R.c_k = *(const u32x2*)(cp + 512); R.c_v = *(const u32x2*)(cp + 1024);
    R.p_r = (u32x2){0u, 0u}; R.p_k = R.p_r; R.p_v = R.p_r;
    if (pr >= 0) { const bf16_t* pp = PS + (size_t)pr * NCOLS + ch; R.p_r = *(const u32x2*)pp; R.p_k = *(const u32x2*)(pp + 512); R.p_v = *(const u32x2*)(pp + 1024); }
    R.ar = *(const u32x2*)(ASIG + (size_t)row * 512 + ch); R.gr = *(const u32x2*)(G + (size_t)row * 512 + ch);
}
__device__ __forceinline__ void rwkv_post(PR P, const int wv) {
    const int tid = fresh_tid(wv); const int lane = tid & 63; const int gw = blockIdx.x * 8 + (tid >> 6), nw = gridDim.x * 8;
    const int sub = lane >> 4, cg4 = (lane & 15) * 4;
    bf16_t* Y = (bf16_t*)(P.ws + WS_XN);
    const int h = (gw * 4 + sub) & 7, ch = h * 64 + cg4;
    const float4 mr = *(const float4*)(P.mu + ch), mk = *(const float4*)(P.mu + 512 + ch), mv = *(const float4*)(P.mu + 1024 + ch);
    const float4 ka = *(const float4*)(P.k_a + ch), rk = *(const float4*)(P.r_k + ch), lw = *(const float4*)(P.lnx_w + ch), lb = *(const float4*)(P.lnx_b + ch);
    const float m_r[4] = {mr.x, mr.y, mr.z, mr.w}, m_k[4] = {mk.x, mk.y, mk.z, mk.w}, m_v[4] = {mv.x, mv.y, mv.z, mv.w};
    const float kaa[4] = {ka.x, ka.y, ka.z, ka.w}, rkk[4] = {rk.x, rk.y, rk.z, rk.w}, lww[4] = {lw.x, lw.y, lw.z, lw.w}, lbb[4] = {lb.x, lb.y, lb.z, lb.w};
    PostRegs R, N;
    if (gw < MT * 2) post_load(P, R, (gw * 4 + sub) >> 3, ch);
    for (int task = gw; task < MT * 2; task += nw) {
        const int row = (task * 4 + sub) >> 3;
        if (task + nw < MT * 2) post_load(P, N, ((task + nw) * 4 + sub) >> 3, ch);
        const float ys[4] = {lo_bf(R.yr.x), hi_bf(R.yr.x), lo_bf(R.yr.y), hi_bf(R.yr.y)};
        const float mean = row16_sum(ys[0] + ys[1] + ys[2] + ys[3]) * (1.0f / 64.0f);
        float dl[4], s2 = 0.f;
#pragma unroll
        for (int j = 0; j < 4; ++j) { dl[j] = ys[j] - mean; s2 += dl[j] * dl[j]; }
        const float rstd = rsqrtf(row16_sum(s2) * (1.0f / 64.0f) + 64e-5f);
        const float cr[4] = {lo_bf(R.c_r.x), hi_bf(R.c_r.x), lo_bf(R.c_r.y), hi_bf(R.c_r.y)}, ck[4] = {lo_bf(R.c_k.x), hi_bf(R.c_k.x), lo_bf(R.c_k.y), hi_bf(R.c_k.y)}, cv[4] = {lo_bf(R.c_v.x), hi_bf(R.c_v.x), lo_bf(R.c_v.y), hi_bf(R.c_v.y)};
        const float qr[4] = {lo_bf(R.p_r.x), hi_bf(R.p_r.x), lo_bf(R.p_r.y), hi_bf(R.p_r.y)}, qk[4] = {lo_bf(R.p_k.x), hi_bf(R.p_k.x), lo_bf(R.p_k.y), hi_bf(R.p_k.y)}, qv[4] = {lo_bf(R.p_v.x), hi_bf(R.p_v.x), lo_bf(R.p_v.y), hi_bf(R.p_v.y)};
        const float aa[4] = {lo_bf(R.ar.x), hi_bf(R.ar.x), lo_bf(R.ar.y), hi_bf(R.ar.y)}, gg[4] = {lo_bf(R.gr.x), hi_bf(R.gr.x), lo_bf(R.gr.y), hi_bf(R.gr.y)};
        float v[4], bp = 0.f;
#pragma unroll
        for (int j = 0; j < 4; ++j) { const float r = cr[j] + (qr[j] - cr[j]) * m_r[j], k = ck[j] + (qk[j] - ck[j]) * m_k[j]; v[j] = cv[j] + (qv[j] - cv[j]) * m_v[j];
            const float kn = k * (1.0f + (aa[j] - 1.0f) * kaa[j]); bp += r * kn * rkk[j]; }
        const float bonus = row16_sum(bp);
        float o[4];
#pragma unroll
        for (int j = 0; j < 4; ++j) o[j] = (dl[j] * rstd * lww[j] + lbb[j] + bonus * v[j]) * gg[j];
        u32x2 w; w.x = pg8::cvt_pk_bf16(o[0], o[1]); w.y = pg8::cvt_pk_bf16(o[2], o[3]);
        *(u32x2*)(Y + (size_t)row * 1024 + ch) = w;
        R = N;
    }
}

__global__ void __launch_bounds__(512, 2) hymba_mega(Params P_unused) {
    extern __shared__ __attribute__((aligned(16))) unsigned char shm[];
    cg::grid_group grid = cg::this_grid();
    LAS unsigned char* lds = (LAS unsigned char*)shm; LAS float* ldsf = (LAS float*)shm;
    const int G = gridDim.x, bx = blockIdx.x;
    const int wv = __builtin_amdgcn_readfirstlane(threadIdx.x >> 6);
    const CAS Params* kp = (const CAS Params*)__builtin_amdgcn_kernarg_segment_ptr();
#define P (*kp)
#define FRESH() asm volatile("" : "+s"(kp))
#ifndef REP_SYNC
#define REP_SYNC 1
#endif
#ifndef REP_P7
#define REP_P7 1
#endif
#ifndef REP_FFN1
#define REP_FFN1 1
#endif
#ifndef REP_P0
#define REP_P0 1
#endif
#ifndef REP_P3
#define REP_P3 1
#endif
#ifndef REP_RW
#define REP_RW 1
#endif
#ifndef REP_OTH
#define REP_OTH 1
#endif
#ifndef REP_RETP
#define REP_RETP 1
#endif
#ifndef REP_SAMP
#define REP_SAMP 1
#endif
#ifndef REP_P8
#define REP_P8 1
#endif
#define GSYNC() do { for (int r_ = 0; r_ < REP_SYNC; ++r_) xcd_barrier((unsigned*)ws, (volatile LAS unsigned*)(lds + LDS_BYTES - 16), wv); FRESH(); } while (0)
#define ws (kp->ws)
#define XN ((bf16_t*)(ws + WS_XN))
#define ACT ((bf16_t*)(ws + WS_BIG))
#define FO ((float*)(ws + WS_FO))
#define PS ((bf16_t*)(ws + WS_BIG))
    pg8::StaticOrder S;
    { const int t0 = fresh_tid(wv); if (t0 < 4) ((LAS unsigned*)(lds + LDS_BYTES - 16))[t0] = 0u;
      if (t0 == 0) (void)xb_add(&((unsigned*)ws)[XB_XCNT(xb_xcc_id())], 1u); }
    if (G == 0x7fffffff) grid.sync();
#ifndef PHM
#define PHM 0xFFFF
#endif
#define PH(k) if ((PHM >> (k)) & 1)
    for (int r0 = 0; r0 < REP_P0; ++r0) PH(0) p0_prologue(P, ldsf, wv);
    GSYNC();
    for (int rep1 = 0; rep1 < REP_FFN1; ++rep1) {
    PH(1) { pg8::Gemm g{XN, (const bf16_t*)(ws + WS_WGU), MT, NGU, 1024}; S.init(MT, NGU, G, bx, 1024); pg8::EpiSwiGLU E{ACT, DFF}; pg8::gemm_phase(lds, g, S, E, wv); }
    GSYNC();
    PH(2) { pg8::Gemm g{ACT, (const bf16_t*)(ws + WS_WD), MT, 1024, DFF}; pg8::SplitOrder S2; S2.init2(G, bx, DFF, 8); pg8::EpiFO E{(bf16_t*)FO, 1024, (float*)(ws + WS_OMD)}; pg8::gemm_phase(lds, g, S2, E, wv); }
    GSYNC();
    }
    for (int r3 = 0; r3 < REP_P3; ++r3) PH(3) rows_phase(P, 1, wv);
    GSYNC();
    PH(4) { pg8::Gemm g{XN, (const bf16_t*)(ws + WS_WIN), MIN_, NCOLS, 1024}; S.init(MIN_, NCOLS, G, bx, 1024); pg8::EpiBf16 E{PS, NCOLS}; pg8::gemm_phase(lds, g, S, E, wv); }
    GSYNC();
    PH(5) lora_prep(P, wv);
    GSYNC();
    PH(6) { pg8::Gemm g{(const bf16_t*)(ws + WS_LA), (const bf16_t*)(ws + WS_WL), MT, 1536, 256}; pg8::LoraMainOrder SM; SM.init(MP, 1024, G, bx, 256);
      pg8::EpiLora E{(bf16_t*)(ws + WS_OMD), (bf16_t*)(ws + WS_ASIG), (bf16_t*)(ws + WS_WIN), P.w0, P.a0}; pg8::gemm_phase(lds, g, SM, E, wv); }
    GSYNC();
    {
    if (bx < 128) { for (int rw = 0; rw < REP_RW; ++rw) rwkv_unit<false>(P, ldsf, bx >> 4, (bx >> 1) & 7, bx & 1, wv); }
    else {
        { pg8::Gemm g{(const bf16_t*)(ws + WS_LA), (const bf16_t*)(ws + WS_WL), MT, 1536, 256}; pg8::LoraRestOrder SL; SL.ob = bx - 128;
          pg8::EpiLora E{(bf16_t*)(ws + WS_OMD), (bf16_t*)(ws + WS_ASIG), (bf16_t*)(ws + WS_WIN), P.w0, P.a0}; pg8::gemm_phase(lds, g, SL, E, wv); }
        FRESH();
        const int rep7 = 0; const int ob = bx - 128; unsigned* sbc = (unsigned*)ws + XCD_BAR_WORDS + 64;
        for (int k = 0; k < 4; ++k) { const int u = ob + k * 128; ret_unit_a(P, lds, u >> 4, u & 15, wv); }
        sub_barrier(sbc, 128u * (2u * rep7 + 1u), wv);
        ret_prefix(P, ob * 512 + fresh_tid(wv));
        sub_barrier(sbc, 128u * (2u * rep7 + 2u), wv);
        for (int k = 0; k < 4; ++k) { const int u = ob + k * 128; ret_unit_c(P, lds, u >> 4, u & 15, wv); }
        for (int u = ob; u < 2560; u += 128) { if (u < 2048) rwkv_unit<true>(P, ldsf, u >> 4, (u >> 1) & 7, u & 1, wv); else ret_sample_unit(P, ldsf, (u - 2048) >> 2, (u - 2048) & 3, wv); }
    }
    }
    GSYNC();
    for (int rep8 = 0; rep8 < REP_P8; ++rep8) PH(8) rwkv_post(P, wv);
    GSYNC();
    PH(9) { pg8::Gemm g{XN, (const bf16_t*)(ws + WS_WOUT), MT, 1024, 1024}; pg8::SplitOrder S2; S2.init2(G, bx, 1024, 4); pg8::EpiFO E{(bf16_t*)FO, 1024, (float*)(ws + WS_OMD)}; pg8::gemm_phase(lds, g, S2, E, wv); }
    GSYNC();
    PH(10) { tconv_list(P.f2g, P.f2u, P.f2d, nullptr, nullptr, ws, 2112, ldsf, wv);
    rows_phase(P, 2, wv); }
    GSYNC();
    PH(11) { pg8::Gemm g{XN, (const bf16_t*)(ws + WS_WGU), MT, NGU, 1024}; S.init(MT, NGU, G, bx, 1024); pg8::EpiSwiGLU E{ACT, DFF}; pg8::gemm_phase(lds, g, S, E, wv); }
    GSYNC();
    PH(12) { pg8::Gemm g{ACT, (const bf16_t*)(ws + WS_WD), MT, 1024, DFF}; pg8::SplitOrder S2; S2.init2(G, bx, DFF, 8); pg8::EpiFO E{(bf16_t*)FO, 1024, (float*)(ws + WS_OMD)}; pg8::gemm_phase(lds, g, S2, E, wv); }
    GSYNC();
    PH(13) rows_phase(P, 3, wv);
}

#undef ws
#undef XN
#undef ACT
#undef FO
#undef PS
#undef P
extern "C" void kernel_launch(void* const* d_in, const int* in_sizes, int n_in, void* d_out, int out_size, void* d_ws, size_t ws_size, hipStream_t stream) {
    static int grid = 0;
    if (grid == 0) {
        if (n_in != 26 || ws_size < WS_END) { fprintf(stderr, "kernel_launch: unexpected n_in %d or ws_size %zu (< %zu)\n", n_in, ws_size, (size_t)WS_END); grid = -1; return; }
        int dev = 0, cus = 0, per_cu = 0;
        hipGetDevice(&dev); hipDeviceGetAttribute(&cus, hipDeviceAttributeMultiprocessorCount, dev);
        hipFuncSetAttribute((const void*)hymba_mega, hipFuncAttributeMaxDynamicSharedMemorySize, LDS_BYTES);
        hipOccupancyMaxActiveBlocksPerMultiprocessor(&per_cu, (const void*)hymba_mega, 512, LDS_BYTES);
        if (per_cu < 1) { fprintf(stderr, "kernel_launch: occupancy query says %d blocks/CU\n", per_cu); per_cu = 1; }
        grid = cus * per_cu; if (grid > 256) grid = 256;
        if (grid != 256) { fprintf(stderr, "kernel_launch: this kernel needs 256 co-resident workgroups, got %d\n", grid); grid = -1; return; }
        fprintf(stderr, "kernel_launch: cus %d per_cu %d grid %d ws %zu\n", cus, per_cu, grid, ws_size);
    }
    if (grid < 0) return;
    if (hipMemsetAsync(d_ws, 0, 16384, stream) != hipSuccess) { fprintf(stderr, "kernel_launch: hipMemsetAsync failed\n"); return; }
    Params p{};
    const float** pp = (const float**)&p;
    for (int i = 0; i < 26; ++i) pp[i] = (const float*)d_in[i];
    p.out = (float*)d_out; p.ws = (unsigned char*)d_ws;
    void* args[] = {&p};
    hipError_t e = hipLaunchCooperativeKernel((const void*)hymba_mega, dim3(grid), dim3(512), args, LDS_BYTES, stream);
    if (e != hipSuccess) fprintf(stderr, "cooperative launch failed: %s (grid %d)\n", hipGetErrorString(e), grid);
}
```

```cpp
#include <hip/hip_runtime.h>
#include <hip/hip_cooperative_groups.h>
#include <cstdio>
#include <cstdint>
namespace cg = cooperative_groups;

__device__ __forceinline__ int fresh_tid(int wv) { int l; asm volatile("v_mbcnt_lo_u32_b32 %0, -1, 0\n\tv_mbcnt_hi_u32_b32 %0, -1, %0" : "=v"(l)); return wv * 64 + l; }
namespace pg8 {
#define PG8_LAS __attribute__((address_space(3)))
typedef unsigned short bf16_t;
typedef short bf16x8 __attribute__((ext_vector_type(8)));
typedef float f32x4 __attribute__((ext_vector_type(4)));
typedef unsigned u32x4 __attribute__((ext_vector_type(4)));
typedef unsigned u32x2 __attribute__((ext_vector_type(2)));
constexpr int BM = 256, BK = 64, HALF = 128, HTB = HALF * BK * 2, STAGE_BYTES = 8 * HTB, NXCD = 8, WGM = 8;

__host__ __device__ __forceinline__ int lds_byte(int r, int c) { const int st = (r >> 4) * 2 + (c >> 5), rr = r & 15, cc = c & 31, ob = rr * 64 + cc * 2; return st * 1024 + (ob ^ (((ob >> 9) & 1) << 5)); }
__host__ __device__ __forceinline__ void stage_rc(int b, int& R, int& C) { const int st = b / 1024, sb = b % 1024, swz = sb ^ (((sb >> 9) & 1) << 5); R = (st >> 1) * 16 + swz / 64; C = (st & 1) * 32 + (swz % 64) / 2; }
__host__ __device__ __forceinline__ int perm32(int rho) { const int n = rho >> 4, i = rho & 15; return 8 * (i >> 2) + 4 * n + (i & 3); }

struct Unit { int pm, pn, k0, nkt, atomic; };
struct Gemm { const bf16_t* A; const bf16_t* Bt; int M, N, K; };

struct StaticOrder {
    int nM, nN, nwg, G, c, nt;
    __host__ __device__ void init(int M, int N, int G_, int c_, int K) { nM = M / BM; nN = N / BM; nwg = nM * nN; G = G_; c = c_; nt = K / BK; }
    __host__ __device__ bool next(int i, Unit& u) const {
        const long L = (long)i * G + c; if (L >= nwg) return false;
        int wgid = (int)L; { const int q = nwg / NXCD, r = nwg % NXCD, xcd = wgid % NXCD, off = wgid / NXCD; wgid = (xcd < r ? xcd * (q + 1) : r * (q + 1) + (xcd - r) * q) + off; }
        const int nig = WGM * nN, gid = wgid / nig, fm = gid * WGM, gsz = (nM - fm) < WGM ? (nM - fm) : WGM;
        u.pm = fm + ((wgid % nig) % gsz); u.pn = (wgid % nig) / gsz; u.k0 = 0; u.nkt = nt; u.atomic = 0; return true;
    }
    __device__ __forceinline__ void a_ready(const Unit&) const {}
    __device__ __forceinline__ void done(const Unit&) const {}
};
struct LoraMainOrder : StaticOrder {
    __host__ __device__ bool next(int i, Unit& u) const { if (!StaticOrder::next(i, u)) return false; u.k0 = 0; u.nkt = 2; return true; }
};
struct LoraRestOrder {
    int ob;
    __host__ __device__ bool next(int i, Unit& u) const {
        const int L = i * 128 + ob; if (L >= 140) return false;
        if (L < 132) { u.pm = L >> 1; u.pn = 4 + (L & 1); u.k0 = 2; } else { const int x = L - 132; u.pm = 64 + (x >> 2); u.pn = x & 3; u.k0 = 0; }
        u.nkt = 2; u.atomic = 0; return true;
    }
    __device__ __forceinline__ void a_ready(const Unit&) const {}
    __device__ __forceinline__ void done(const Unit&) const {}
};
struct SplitOrder : StaticOrder {
    int KS;
    __host__ __device__ void init2(int G_, int c_, int K, int KS_) { init(16384, 1024, G_, c_, K); KS = KS_; }
    __host__ __device__ bool next(int i, Unit& u) const {
        if (i == 0) return StaticOrder::next(0, u);
        if (i > 1 || c >= 8 * KS) return false;
        const int tile = c / KS, part = c % KS, pairs = nt / 2, q = pairs / KS, r = pairs % KS;
        u.pm = 64 + (tile >> 2); u.pn = tile & 3; u.k0 = 2 * (part * q + (part < r ? part : r)); u.nkt = 2 * (q + (part < r ? 1 : 0)); u.atomic = 1 + c; return true;
    }
};

typedef __bf16 bf16x2_t __attribute__((ext_vector_type(2)));
typedef float f32x2_t __attribute__((ext_vector_type(2)));
__device__ __forceinline__ unsigned cvt_pk_bf16(float lo, float hi) { const f32x2_t v = {lo, hi}; const bf16x2_t b = __builtin_convertvector(v, bf16x2_t); return __builtin_bit_cast(unsigned, b); }

struct EpiFO {
    static constexpr bool PERM = true;
    bf16_t* C; int ldc; float* slab;
    __device__ __forceinline__ void operator()(const f32x4 (&acc)[2][2][4][2], const Unit& u, int wr, int wc, int fr, int fq) const {
        if (u.atomic == 0) {
            const int row0 = u.pm * BM + wr * 64 + fr; const int col0 = u.pn * BM + wc * 32 + 8 * fq;
#pragma unroll
            for (int ai = 0; ai < 2; ++ai)
#pragma unroll
                for (int m = 0; m < 4; ++m) { bf16_t* rowp = C + (size_t)(row0 + ai * HALF + m * 16) * ldc + col0;
#pragma unroll
                    for (int bj = 0; bj < 2; ++bj) { const f32x4 v0 = acc[ai][bj][m][0], v1 = acc[ai][bj][m][1];
                        u32x4 w; w.x = cvt_pk_bf16(v0[0], v0[1]); w.y = cvt_pk_bf16(v0[2], v0[3]); w.z = cvt_pk_bf16(v1[0], v1[1]); w.w = cvt_pk_bf16(v1[2], v1[3]);
                        *(u32x4*)(rowp + bj * HALF) = w; } }
        } else {
            float* base = slab + (size_t)(u.atomic - 1) * (BM * BM) + (size_t)(wr * 64 + fr) * BM + wc * 32 + 8 * fq;
#pragma unroll
            for (int ai = 0; ai < 2; ++ai)
#pragma unroll
                for (int m = 0; m < 4; ++m) { float* rowp = base + (size_t)(ai * HALF + m * 16) * BM;
#pragma unroll
                    for (int bj = 0; bj < 2; ++bj) { *(f32x4*)(rowp + bj * HALF) = acc[ai][bj][m][0]; *(f32x4*)(rowp + bj * HALF + 4) = acc[ai][bj][m][1]; } }
        }
    }
};
struct EpiBf16 {
    static constexpr bool PERM = true;
    bf16_t* O; int ldc;
    __device__ __forceinline__ void operator()(const f32x4 (&acc)[2][2][4][2], const Unit& u, int wr, int wc, int fr, int fq) const {
        const int row0 = u.pm * BM + wr * 64 + fr; const int col0 = u.pn * BM + wc * 32 + 8 * fq;
#pragma unroll
        for (int ai = 0; ai < 2; ++ai)
#pragma unroll
            for (int m = 0; m < 4; ++m) { bf16_t* rowp = O + (size_t)(row0 + ai * HALF + m * 16) * ldc + col0;
#pragma unroll
                for (int bj = 0; bj < 2; ++bj) { const f32x4 v0 = acc[ai][bj][m][0], v1 = acc[ai][bj][m][1];
                    u32x4 w; w.x = cvt_pk_bf16(v0[0], v0[1]); w.y = cvt_pk_bf16(v0[2], v0[3]); w.z = cvt_pk_bf16(v1[0], v1[1]); w.w = cvt_pk_bf16(v1[2], v1[3]);
                    *(u32x4*)(rowp + bj * HALF) = w; } }
    }
};
__device__ __forceinline__ float silu_f(float x) { return x * __builtin_amdgcn_rcpf(1.0f + __expf(-x)); }
struct EpiSwiGLU {
    static constexpr bool PERM = true;
    bf16_t* O; int ldc;
    __device__ __forceinline__ void operator()(const f32x4 (&acc)[2][2][4][2], const Unit& u, int wr, int wc, int fr, int fq) const {
        const int row0 = u.pm * BM + wr * 64 + fr; const int col0 = u.pn * HALF + wc * 32 + 8 * fq;
#pragma unroll
        for (int ai = 0; ai < 2; ++ai)
#pragma unroll
            for (int m = 0; m < 4; ++m) { bf16_t* rowp = O + (size_t)(row0 + ai * HALF + m * 16) * ldc + col0;
                float o[8];
#pragma unroll
                for (int n = 0; n < 2; ++n)
#pragma unroll
                    for (int j = 0; j < 4; ++j) o[n * 4 + j] = silu_f(acc[ai][0][m][n][j]) * acc[ai][1][m][n][j];
                u32x4 w; w.x = cvt_pk_bf16(o[0], o[1]); w.y = cvt_pk_bf16(o[2], o[3]); w.z = cvt_pk_bf16(o[4], o[5]); w.w = cvt_pk_bf16(o[6], o[7]);
                *(u32x4*)rowp = w; }
    }
};
struct EpiLora {
    static constexpr bool PERM = true;
    bf16_t* OMD; bf16_t* ASIG; bf16_t* G; const float* w0; const float* a0;
    template <int KIND> __device__ __forceinline__ void body(const f32x4 (&acc)[2][2][4][2], bf16_t* O, const float* bias, int row0, int ch0) const {
#pragma unroll
        for (int bj = 0; bj < 2; ++bj)
#pragma unroll
            for (int ai = 0; ai < 2; ++ai)
#pragma unroll
                for (int m = 0; m < 4; ++m) { bf16_t* rowp = O + (size_t)(row0 + ai * HALF + m * 16) * 512 + ch0 + bj * HALF;
                    float o[8];
#pragma unroll
                    for (int n = 0; n < 2; ++n)
#pragma unroll
                        for (int j = 0; j < 4; ++j) { float v = acc[ai][bj][m][n][j];
                            if (KIND == 0) { v += bias[ch0 + bj * HALF + n * 4 + j]; const float e = 0.6065306597126334f * __builtin_amdgcn_rcpf(1.0f + __expf(-v));
                                float p = 1.0f / 40320.0f; p = -1.0f / 5040.0f + e * p; p = 1.0f / 720.0f + e * p; p = -1.0f / 120.0f + e * p; p = 1.0f / 24.0f + e * p; p = -1.0f / 6.0f + e * p; p = 0.5f + e * p; p = 1.0f - e * p;
                                v = e * p; }
                            else if (KIND == 1) { v += bias[ch0 + bj * HALF + n * 4 + j]; v = __builtin_amdgcn_rcpf(1.0f + __expf(-v)); }
                            o[n * 4 + j] = v; }
                    u32x4 w; w.x = cvt_pk_bf16(o[0], o[1]); w.y = cvt_pk_bf16(o[2], o[3]); w.z = cvt_pk_bf16(o[4], o[5]); w.w = cvt_pk_bf16(o[6], o[7]);
                    *(u32x4*)rowp = w; __builtin_amdgcn_sched_barrier(0); }
    }
    __device__ __forceinline__ void operator()(const f32x4 (&acc)[2][2][4][2], const Unit& u, int wr, int wc, int fr, int fq) const {
        const int kind = u.pn >> 1;
        const int row0 = u.pm * BM + wr * 64 + fr; const int ch0 = (u.pn & 1) * BM + wc * 32 + 8 * fq;
        if (kind == 0) body<0>(acc, OMD, w0, row0, ch0); else if (kind == 1) body<1>(acc, ASIG, a0, row0, ch0); else body<2>(acc, G, a0, row0, ch0);
    }
};

template <class Epi, class Sched>
__device__ __forceinline__ void gemm_phase(PG8_LAS unsigned char* lds, const Gemm g, const Sched& S, const Epi& E, const int wv) {
    const int tid = fresh_tid(wv), wid = __builtin_amdgcn_readfirstlane(tid >> 6), lane = tid & 63, wr = wid >> 2, wc = wid & 3, fr = lane & 15, fq = lane >> 4;
    const int K = g.K;
    unsigned voffA[2], voffB[2];
#pragma unroll
    for (int i = 0; i < 2; ++i) { int R, C; stage_rc(tid * 16 + i * 8192, R, C); const int Rb = Epi::PERM ? ((R & ~31) + perm32(R & 31)) : R;
        voffA[i] = (unsigned)(R * K + C) * 2u; voffB[i] = (unsigned)(Rb * K + C) * 2u; }
    const size_t kstep = (size_t)(BK * 2);
    const size_t hstep = (size_t)HALF * K * 2;
    const size_t tstep = 2 * hstep;
    const unsigned ldsw = (unsigned)wid * 1024u;
    const int aoff = lds_byte(wr * 64 + fr, fq * 8), boff = lds_byte(wc * 32 + fr, fq * 8);
#define PG8_SA(b, h) (((b) * 2 + (h)) * HTB)
#define PG8_SB(b, h) ((4 + (b) * 2 + (h)) * HTB)
#define PG8_STAGE(bufoff, gbase, voff) do { _Pragma("unroll") for (int _i = 0; _i < 2; ++_i) \
        __builtin_amdgcn_global_load_lds((const unsigned*)((const char*)(gbase) + (voff)[_i]), (PG8_LAS unsigned*)(lds + (bufoff) + ldsw + _i * 8192), 16, 0, 0); } while (0)
#define PG8_LDA(dst, b, h) do { _Pragma("unroll") for (int m = 0; m < 4; ++m) _Pragma("unroll") for (int k = 0; k < 2; ++k) dst[m][k] = *(const PG8_LAS bf16x8*)(lds + PG8_SA(b, h) + aoff + m * 2048 + k * 1024); } while (0)
#define PG8_LDB(dst, b, h) do { _Pragma("unroll") for (int n = 0; n < 2; ++n) _Pragma("unroll") for (int k = 0; k < 2; ++k) dst[n][k] = *(const PG8_LAS bf16x8*)(lds + PG8_SB(b, h) + boff + n * 2048 + k * 1024); } while (0)
#define PG8_MMA(ai, bj, At, Bt) do { __builtin_amdgcn_s_setprio(1); _Pragma("unroll") for (int m = 0; m < 4; ++m) _Pragma("unroll") for (int n = 0; n < 2; ++n) _Pragma("unroll") for (int k = 0; k < 2; ++k) \
        acc[ai][bj][m][n] = __builtin_amdgcn_mfma_f32_16x16x32_bf16(Bt[n][k], At[m][k], acc[ai][bj][m][n], 0, 0, 0); __builtin_amdgcn_s_setprio(0); } while (0)
#define PG8_WAIT_V(n) asm volatile("s_waitcnt vmcnt(" #n ")" ::: "memory")
#define PG8_WAIT_L(n) asm volatile("s_waitcnt lgkmcnt(" #n ")" ::: "memory")
#define PG8_BAR __builtin_amdgcn_s_barrier()
#define PG8_SCHED __builtin_amdgcn_sched_barrier(0)
    Unit cur, nxt; int ui = 0;
    if (!S.next(0, cur)) return;
    f32x4 acc[2][2][4][2];
#pragma unroll
    for (int a = 0; a < 2; ++a)
#pragma unroll
        for (int b = 0; b < 2; ++b)
#pragma unroll
            for (int m = 0; m < 4; ++m)
#pragma unroll
                for (int n = 0; n < 2; ++n) acc[a][b][m][n] = (f32x4){0.f, 0.f, 0.f, 0.f};
    bf16x8 At[4][2], B0[2][2], B1[2][2];
    const char* cA = (const char*)g.A + (size_t)cur.pm * tstep + (size_t)cur.k0 * kstep; const char* cB = (const char*)g.Bt + (size_t)cur.pn * tstep + (size_t)cur.k0 * kstep;
    S.a_ready(cur);
    PG8_STAGE(PG8_SB(0, 0), cB, voffB); PG8_STAGE(PG8_SA(0, 0), cA, voffA); PG8_STAGE(PG8_SB(0, 1), cB + hstep, voffB); PG8_STAGE(PG8_SA(0, 1), cA + hstep, voffA);
    if (wr == 1) PG8_BAR;
    PG8_WAIT_V(4); PG8_BAR;
    PG8_STAGE(PG8_SB(1, 0), cB + kstep, voffB); PG8_STAGE(PG8_SA(1, 0), cA + kstep, voffA); PG8_STAGE(PG8_SB(1, 1), cB + hstep + kstep, voffB);
    PG8_WAIT_V(6); PG8_BAR;
    for (;;) {
        const bool has_next = S.next(ui + 1, nxt);
        const char* nA = has_next ? (const char*)g.A + (size_t)nxt.pm * tstep + (size_t)nxt.k0 * kstep : cA; const char* nB = has_next ? (const char*)g.Bt + (size_t)nxt.pn * tstep + (size_t)nxt.k0 * kstep : cB;
        const int nt = cur.nkt;
        for (int t = 0; t < nt; t += 2) {
            const bool last = (t == nt - 2);
            const char* a1 = cA + (size_t)(t + 1) * kstep;
            const char* a2 = last ? nA : cA + (size_t)(t + 2) * kstep; const char* b2 = last ? nB : cB + (size_t)(t + 2) * kstep;
            const char* a3 = a2 + kstep; const char* b3 = b2 + kstep;
            if (last && has_next) S.a_ready(nxt);
            PG8_LDB(B0, 0, 0); PG8_SCHED; PG8_LDA(At, 0, 0); PG8_STAGE(PG8_SA(1, 1), a1 + hstep, voffA);
            PG8_WAIT_L(8); PG8_BAR; PG8_WAIT_L(0); PG8_MMA(0, 0, At, B0); PG8_BAR; PG8_SCHED;
            PG8_LDB(B1, 0, 1); PG8_STAGE(PG8_SB(0, 0), b2, voffB);
            PG8_BAR; PG8_WAIT_L(0); PG8_MMA(0, 1, At, B1); PG8_BAR;
            PG8_LDA(At, 0, 1); PG8_STAGE(PG8_SA(0, 0), a2, voffA);
            PG8_BAR; PG8_WAIT_L(0); PG8_MMA(1, 0, At, B0); PG8_BAR; PG8_SCHED;
            PG8_STAGE(PG8_SB(0, 1), b2 + hstep, voffB);
            PG8_WAIT_V(6); PG8_BAR; PG8_MMA(1, 1, At, B1); PG8_BAR;
            PG8_LDB(B0, 1, 0); PG8_SCHED; PG8_LDA(At, 1, 0); PG8_STAGE(PG8_SA(0, 1), a2 + hstep, voffA);
            PG8_WAIT_L(8); PG8_BAR; PG8_WAIT_L(0); PG8_MMA(0, 0, At, B0); PG8_BAR; PG8_SCHED;
            PG8_LDB(B1, 1, 1); PG8_STAGE(PG8_SB(1, 0), b3, voffB);
            PG8_BAR; PG8_WAIT_L(0); PG8_MMA(0, 1, At, B1); PG8_BAR;
            PG8_LDA(At, 1, 1); PG8_STAGE(PG8_SA(1, 0), a3, voffA);
            PG8_BAR; PG8_WAIT_L(0); PG8_MMA(1, 0, At, B0); PG8_BAR; PG8_SCHED;
            PG8_STAGE(PG8_SB(1, 1), b3 + hstep, voffB);
            PG8_WAIT_V(6); PG8_BAR; PG8_MMA(1, 1, At, B1); PG8_BAR;
        }
        { const int l2 = fresh_tid(wv) & 63; E(acc, cur, wr, wc, l2 & 15, l2 >> 4); } S.done(cur);
        if (!has_next) break;
#pragma unroll
        for (int a = 0; a < 2; ++a)
#pragma unroll
            for (int b = 0; b < 2; ++b)
#pragma unroll
                for (int m = 0; m < 4; ++m)
#pragma unroll
                    for (int n = 0; n < 2; ++n) acc[a][b][m][n] = (f32x4){0.f, 0.f, 0.f, 0.f};
        cur = nxt; cA = nA; cB = nB; ++ui;
    }
    PG8_WAIT_V(0);
    if (wr == 0) PG8_BAR;
    PG8_BAR;
#undef PG8_SA
#undef PG8_SB
#undef PG8_STAGE
#undef PG8_LDA
#undef PG8_LDB
#undef PG8_MMA
#undef PG8_WAIT_V
#undef PG8_WAIT_L
#undef PG8_BAR
#undef PG8_SCHED
}
}

using pg8::bf16_t; using pg8::f32x4; using pg8::bf16x8; using pg8::u32x4; using pg8::u32x2;
#define LAS __attribute__((address_space(3)))

constexpr int D = 1024, DFF = 2816, NGU = 5632, NCOLS = 3840;
constexpr int MP = 16384, MS = 512, MT = 16896, MIN_ = 17152;
constexpr int LDS_BYTES = 147456;
constexpr size_t O_SHP = 17301504, O_WKP = O_SHP + 8192, O_RTP = O_WKP + 262144, O_SHS = O_RTP + 524288, O_WKS = O_SHS + 131072, O_RTS = O_WKS + 4194304;
constexpr size_t WS_ROPE = 16384;
constexpr size_t WS_WL   = WS_ROPE + 1050624;
constexpr size_t WS_WOUT = WS_WL + 786432;
constexpr size_t WS_WIN  = WS_WOUT + 2097152;
constexpr size_t WS_WGU  = WS_WIN + 7864320;
constexpr size_t WS_WD   = WS_WGU + 11534336;
constexpr size_t WS_XN   = WS_WD + 5767168;
constexpr size_t WS_BIG  = WS_XN + 35127296;
constexpr size_t WS_FO   = WS_BIG + 95158272;
constexpr size_t WS_YS   = WS_BIG + 131727360;
constexpr size_t WS_LA   = WS_YS + 17301504;
constexpr size_t WS_OMD  = WS_BIG + 164364288;
constexpr size_t WS_ASIG = WS_OMD + 17301504;
constexpr size_t WS_END  = WS_ASIG + 17301504;
static_assert(WS_LA + 8650752 <= WS_OMD, "mixer overlays");
static_assert(WS_END <= 268435456, "workspace");

struct Params {
    const float *x_prompt, *x_sample, *state_shift, *state_wkv, *state_ret, *norm_g, *f1g, *f1u, *f1d, *w_in, *mu, *w0, *w2, *a0, *a2, *g2, *k_k, *k_a, *r_k, *lnx_w, *lnx_b, *gn_w, *w_out, *f2g, *f2u, *f2d;
    float* out; unsigned char* ws;
};
#define CAS __attribute__((address_space(4)))
typedef const CAS Params& PR;

__device__ __forceinline__ float bf2f(unsigned b) { return __uint_as_float(b << 16); }
__device__ __forceinline__ bf16_t f2bf(float f) { unsigned u = __float_as_uint(f); u += 0x7FFFu + ((u >> 16) & 1u); return (bf16_t)(u >> 16); }
__device__ __forceinline__ float lo_bf(unsigned x) { return __uint_as_float(x << 16); }
__device__ __forceinline__ float hi_bf(unsigned x) { return __uint_as_float(x & 0xffff0000u); }
template <int CTRL> __device__ __forceinline__ float dppf(float v) { return __int_as_float(__builtin_amdgcn_update_dpp(0, __float_as_int(v), CTRL, 0xF, 0xF, false)); }
__device__ __forceinline__ float row16_sum(float v) { v += dppf<0xB1>(v); v += dppf<0x4E>(v); v += dppf<0x141>(v); v += dppf<0x140>(v); return v; }
__device__ __forceinline__ float wave_sum(float v) { v = row16_sum(v); const int i = __float_as_int(v);
    return __int_as_float(__builtin_amdgcn_readlane(i, 0)) + __int_as_float(__builtin_amdgcn_readlane(i, 16)) + __int_as_float(__builtin_amdgcn_readlane(i, 32)) + __int_as_float(__builtin_amdgcn_readlane(i, 48)); }
__device__ __forceinline__ float quad_sum(float v) { v += dppf<0xB1>(v); v += dppf<0x4E>(v); return v; }
__device__ __forceinline__ float sigmoid_f(float x) { return __builtin_amdgcn_rcpf(1.0f + __expf(-x)); }


#define XB_TMO      128
#define XB_XCNT(j)  (256  + 64 * (j))
#define XB_XSUB(j)  (1280 + 64 * (j))
#define XB_XGEN(j)  (2304 + 64 * (j))
#define XB_TOP      3328
#define XB_TOPGEN   3392
#define XCD_BAR_WORDS 3456
#define XB_SPIN_CAP (1u << 18)
__device__ __forceinline__ unsigned xb_ld(unsigned* p)              { return __hip_atomic_load(p, __ATOMIC_RELAXED, __HIP_MEMORY_SCOPE_AGENT); }
__device__ __forceinline__ unsigned xb_add(unsigned* p, unsigned v) { return __hip_atomic_fetch_add(p, v, __ATOMIC_RELAXED, __HIP_MEMORY_SCOPE_AGENT); }
__device__ __forceinline__ unsigned xb_xcc_id() { return (unsigned)__builtin_amdgcn_s_getreg((3 << 11) | 20) & 0xFu; }
#define XB_SPIN(cond, bar) do { unsigned _sp = 0; while (cond) { __builtin_amdgcn_s_sleep(1); \
    if ((++_sp & 255u) == 0u) { if (xb_ld(&(bar)[XB_TMO])) break; if (_sp > XB_SPIN_CAP) { atomicAdd(&(bar)[XB_TMO], 1u); break; } } } } while (0)
struct XcdBarrier { unsigned* bar; unsigned x; volatile LAS unsigned* st; };
__device__ __forceinline__ XcdBarrier xcd_barrier_post(unsigned* bar, volatile LAS unsigned* st) {
    XcdBarrier b; b.bar = bar; b.x = xb_xcc_id(); b.st = st;
    return b;
}
__device__ __forceinline__ void xcd_barrier_complete(unsigned* bar, unsigned x, unsigned& nloc, unsigned& nx) {
    const unsigned G = gridDim.x * gridDim.y * gridDim.z;
    unsigned sum, cnt, mine, sp = 0u;
    for (;;) {
        sum = 0u; cnt = 0u; mine = 0u;
#pragma unroll
        for (unsigned j = 0; j < 16; ++j) { const unsigned c = xb_ld(&bar[XB_XCNT(j)]); sum += c; cnt += (c > 0u) ? 1u : 0u; mine = (j == x) ? c : mine; }
        if (sum == G) break;
        __builtin_amdgcn_s_sleep(1);
        if ((++sp & 255u) == 0u) { if (xb_ld(&bar[XB_TMO])) break; if (sp > XB_SPIN_CAP) { atomicAdd(&bar[XB_TMO], 1u); break; } }
    }
    nloc = mine > 0u ? mine : 1u; nx = cnt > 0u ? cnt : 1u;
}
__device__ __forceinline__ void xcd_barrier(unsigned* barw, volatile LAS unsigned* stw, const int wv) {
    XcdBarrier b; b.bar = barw; b.x = xb_xcc_id(); b.st = stw;
    asm volatile("s_waitcnt vmcnt(0)" ::: "memory");
    __syncthreads();
    if (fresh_tid(wv) == 0) {
        unsigned* bar = b.bar;
        __builtin_amdgcn_s_waitcnt(0);
        unsigned nloc = b.st[0], nx = b.st[1];
        if (nloc == 0u) { xcd_barrier_complete(bar, b.x, nloc, nx); b.st[0] = nloc; b.st[1] = nx; }
        const unsigned old = xb_add(&bar[XB_XSUB(b.x)], 1u);
        const unsigned gen = old / nloc;
        if (old + 1u == (gen + 1u) * nloc) {
            __builtin_amdgcn_fence(__ATOMIC_RELEASE, "agent");
            asm volatile("s_waitcnt vmcnt(0)" ::: "memory");
            const unsigned og = xb_add(&bar[XB_TOP], 1u);
            const unsigned tg = og / nx;
            if (og + 1u == (tg + 1u) * nx) xb_add(&bar[XB_TOPGEN], 1u);
            else XB_SPIN(xb_ld(&bar[XB_TOPGEN]) == tg, bar);
            __builtin_amdgcn_fence(__ATOMIC_ACQUIRE, "agent");
            xb_add(&bar[XB_XGEN(b.x)], 1u);
            asm volatile("s_waitcnt vmcnt(0)" ::: "memory");
        } else {
            XB_SPIN(xb_ld(&bar[XB_XGEN(b.x)]) == gen, bar);
            __builtin_amdgcn_fence(__ATOMIC_ACQUIRE, "agent");
            asm volatile("s_waitcnt vmcnt(0)" ::: "memory");
        }
    }
    __syncthreads();
}


#define DPP2(x, y, CTRL, NOP) asm volatile(NOP "\n\tv_add_f32_dpp %0, %0, %0 " CTRL " row_mask:0xf bank_mask:0xf bound_ctrl:1\n\tv_add_f32_dpp %1, %1, %1 " CTRL " row_mask:0xf bank_mask:0xf bound_ctrl:1" : "+v"(x), "+v"(y))
#define DPP4(x, y, z, w, CTRL, NOP) asm volatile(NOP "\n\tv_add_f32_dpp %0, %0, %0 " CTRL " row_mask:0xf bank_mask:0xf bound_ctrl:1\n\tv_add_f32_dpp %1, %1, %1 " CTRL " row_mask:0xf bank_mask:0xf bound_ctrl:1\n\tv_add_f32_dpp %2, %2, %2 " CTRL " row_mask:0xf bank_mask:0xf bound_ctrl:1\n\tv_add_f32_dpp %3, %3, %3 " CTRL " row_mask:0xf bank_mask:0xf bound_ctrl:1" : "+v"(x), "+v"(y), "+v"(z), "+v"(w))
#define ROW16_SUM4(x, y, z, w) do { DPP4(x, y, z, w, "quad_perm:[1,0,3,2]", "s_nop 1"); DPP4(x, y, z, w, "quad_perm:[2,3,0,1]", ""); DPP4(x, y, z, w, "row_half_mirror", ""); DPP4(x, y, z, w, "row_mirror", ""); } while (0)
#define ROW16_SUM2(x, y) do { DPP2(x, y, "quad_perm:[1,0,3,2]", "s_nop 1"); DPP2(x, y, "quad_perm:[2,3,0,1]", "s_nop 0"); DPP2(x, y, "row_half_mirror", "s_nop 0"); DPP2(x, y, "row_mirror", "s_nop 0"); } while (0)
__device__ __forceinline__ int prev_row(int r) {
    if (r < MP) return (r & 2047) == 0 ? -1 : r - 1;
    const int s = r - MP; return (s & 3) == 0 ? MT + (s >> 2) : r - 1;
}

struct TDesc { const float* W; bf16_t* Bt; int K, N, k0, n0, brow0; };
__device__ __forceinline__ TDesc tconv_desc(const float* wg, const float* wu, const float* wd, const float* win, const float* wout, unsigned char* ws, int i) {
    TDesc d; int mode = 0, tile = i;
    if (i < 704) { d.W = wg; d.Bt = (bf16_t*)(ws + WS_WGU); d.K = 1024; d.N = DFF; mode = 1; }
    else if (i < 1408) { d.W = wu; d.Bt = (bf16_t*)(ws + WS_WGU); d.K = 1024; d.N = DFF; mode = 2; tile = i - 704; }
    else if (i < 2112) { d.W = wd; d.Bt = (bf16_t*)(ws + WS_WD); d.K = DFF; d.N = 1024; tile = i - 1408; }
    else if (i < 3072) { d.W = win; d.Bt = (bf16_t*)(ws + WS_WIN); d.K = 1024; d.N = NCOLS; tile = i - 2112; }
    else { d.W = wout; d.Bt = (bf16_t*)(ws + WS_WOUT); d.K = 1024; d.N = 1024; tile = i - 3072; }
    const int nkt = d.K / 64; const int kt = tile % nkt, nt = tile / nkt; d.k0 = kt * 64; d.n0 = nt * 64;
    d.brow0 = mode == 0 ? d.n0 : ((d.n0 >> 7) * 256 + (d.n0 & 127) + (mode == 2 ? 128 : 0));
    return d;
}
__device__ __forceinline__ void tconv_list(const float* wg, const float* wu, const float* wd, const float* win, const float* wout, unsigned char* ws, const int ntiles, LAS float* t, const int wv) {
    const int tid = fresh_tid(wv); const int G = gridDim.x;
    float cur[8], nxt[8];
    int i = blockIdx.x;
    if (i < ntiles) { const TDesc d = tconv_desc(wg, wu, wd, win, wout, ws, i);
#pragma unroll
        for (int e = 0; e < 8; ++e) { const int idx = e * 512 + tid, r = idx >> 6, c = idx & 63; cur[e] = d.W[(size_t)(d.k0 + r) * d.N + d.n0 + c]; } }
    for (; i < ntiles; i += G) {
        const TDesc d = tconv_desc(wg, wu, wd, win, wout, ws, i);
        if (i + G < ntiles) { const TDesc dn = tconv_desc(wg, wu, wd, win, wout, ws, i + G);
#pragma unroll
            for (int e = 0; e < 8; ++e) { const int idx = e * 512 + tid, r = idx >> 6, c = idx & 63; nxt[e] = dn.W[(size_t)(dn.k0 + r) * dn.N + dn.n0 + c]; } }
#pragma unroll
        for (int e = 0; e < 8; ++e) { const int idx = e * 512 + tid, r = idx >> 6, c = idx & 63; t[r * 65 + c] = cur[e]; }
        __syncthreads();
#pragma unroll
        for (int e = 0; e < 4; ++e) { const int idx = e * 512 + tid, n = idx >> 5, kp = idx & 31;
            const unsigned w = pg8::cvt_pk_bf16(t[(2 * kp) * 65 + n], t[(2 * kp + 1) * 65 + n]);
            *(unsigned*)(d.Bt + (size_t)(d.brow0 + n) * d.K + d.k0 + 2 * kp) = w; }
        __syncthreads();
#pragma unroll
        for (int e = 0; e < 8; ++e) cur[e] = nxt[e];
    }
}

struct RowRaw { float4 xf[4]; u32x2 xb[4]; u32x2 fb[4]; };
__device__ __forceinline__ void rows_load(PR P, const int mode, const int row, const int lane, RowRaw& R) {
    if (mode <= 1) { const float* xin = P.x_prompt + (size_t)row * 1024;
#pragma unroll
        for (int q = 0; q < 4; ++q) R.xf[q] = *(const float4*)(xin + (q * 64 + lane) * 4); }
    else { const bf16_t* xb = (mode == 2 ? (const bf16_t*)P.out : (const bf16_t*)(P.ws + WS_FO + 34603008)) + (size_t)row * 1024;
#pragma unroll
        for (int q = 0; q < 4; ++q) R.xb[q] = *(const u32x2*)(xb + (q * 64 + lane) * 4); }
    if (mode != 0) { const bf16_t* FO = (const bf16_t*)(P.ws + WS_FO) + (size_t)row * 1024;
#pragma unroll
        for (int q = 0; q < 4; ++q) R.fb[q] = *(const u32x2*)(FO + (q * 64 + lane) * 4); }
}
__device__ __forceinline__ void rows_proc(PR P, const int mode, const int row, const int lane, float4 (&xv)[4], const float4 (&fo)[4], const float4 (&gp)[4], const float4 (&gn)[4]) {
    bf16_t* XN = (bf16_t*)(P.ws + WS_XN);
    if (mode != 0) {
        float ss = 0.f;
#pragma unroll
        for (int q = 0; q < 4; ++q) ss += fo[q].x * fo[q].x + fo[q].y * fo[q].y + fo[q].z * fo[q].z + fo[q].w * fo[q].w;
        ss = wave_sum(ss); const float r = rsqrtf(ss * (1.0f / 1024.0f) + 1e-6f) * (mode == 2 ? 1.0f : 0.5f);
#pragma unroll
        for (int q = 0; q < 4; ++q) {
            xv[q].x += fo[q].x * r * gp[q].x; xv[q].y += fo[q].y * r * gp[q].y; xv[q].z += fo[q].z * r * gp[q].z; xv[q].w += fo[q].w * r * gp[q].w;
            if (mode == 3) *(float4*)(P.out + (size_t)row * 1024 + (q * 64 + lane) * 4) = xv[q];
            else { bf16_t* xo = (mode == 1 ? (bf16_t*)P.out : (bf16_t*)(P.ws + WS_FO + 34603008)) + (size_t)row * 1024; u32x2 t; t.x = pg8::cvt_pk_bf16(xv[q].x, xv[q].y); t.y = pg8::cvt_pk_bf16(xv[q].z, xv[q].w);
                *(u32x2*)(xo + (q * 64 + lane) * 4) = t; } }
        if (mode == 3) return;
    }
    float ss2 = 0.f;
#pragma unroll
    for (int q = 0; q < 4; ++q) ss2 += xv[q].x * xv[q].x + xv[q].y * xv[q].y + xv[q].z * xv[q].z + xv[q].w * xv[q].w;
    ss2 = wave_sum(ss2); const float r2 = rsqrtf(ss2 * (1.0f / 1024.0f) + 1e-6f);
    float* sh = nullptr;
    if (mode == 1) { if (row < MP) { if ((row & 2047) == 2047) sh = P.out + O_SHP + (size_t)(row >> 11) * 1024; } else { const int s = row - MP; if ((s & 3) == 3) sh = P.out + O_SHS + (size_t)(s >> 2) * 1024; } }
#pragma unroll
    for (int q = 0; q < 4; ++q) {
        float4 hv; hv.x = xv[q].x * r2 * gn[q].x; hv.y = xv[q].y * r2 * gn[q].y; hv.z = xv[q].z * r2 * gn[q].z; hv.w = xv[q].w * r2 * gn[q].w;
        u32x2 w; w.x = pg8::cvt_pk_bf16(hv.x, hv.y); w.y = pg8::cvt_pk_bf16(hv.z, hv.w);
        *(u32x2*)(XN + (size_t)row * 1024 + (q * 64 + lane) * 4) = w;
        if (sh) *(float4*)(sh + (q * 64 + lane) * 4) = hv; }
}
__device__ __forceinline__ void rows_phase(PR P, const int mode, const int wv) {
    const int tid = fresh_tid(wv); const int lane = tid & 63; const int gw = blockIdx.x * 8 + (tid >> 6), nw = gridDim.x * 8;
    const float* gpost = P.norm_g + (mode == 1 ? 1 : (mode == 2 ? 3 : 5)) * 1024;
    const float* gnext = P.norm_g + (mode == 0 ? 0 : (mode == 1 ? 2 : 4)) * 1024;
    float4 gp[4], gn[4];
#pragma unroll
    for (int q = 0; q < 4; ++q) { gp[q] = *(const float4*)(gpost + (q * 64 + lane) * 4); gn[q] = *(const float4*)(gnext + (q * 64 + lane) * 4); }
    if (gw < MP) {
        const int last = gw + ((MP - 1 - gw) / nw) * nw;
        RowRaw R, N;
        rows_load(P, mode, gw, lane, R);
        for (int row = gw; row < MP; row += nw) {
            const int nrow = row + nw < MP ? row + nw : last;
            rows_load(P, mode, nrow, lane, N);
            float4 xv[4], fo[4];
#pragma unroll
            for (int q = 0; q < 4; ++q) {
                xv[q] = mode <= 1 ? R.xf[q] : make_float4(lo_bf(R.xb[q].x), hi_bf(R.xb[q].x), lo_bf(R.xb[q].y), hi_bf(R.xb[q].y));
                fo[q] = make_float4(lo_bf(R.fb[q].x), hi_bf(R.fb[q].x), lo_bf(R.fb[q].y), hi_bf(R.fb[q].y)); }
            rows_proc(P, mode, row, lane, xv, fo, gp, gn);
            R = N;
        }
    }
    for (int row = MP + gw; row < MT; row += nw) {
        float4 xv[4], fo[4];
        if (mode <= 1) { const float* xin = P.x_sample + (size_t)(row - MP) * 1024;
#pragma unroll
            for (int q = 0; q < 4; ++q) xv[q] = *(const float4*)(xin + (q * 64 + lane) * 4); }
        else { const bf16_t* xb = (mode == 2 ? (const bf16_t*)P.out : (const bf16_t*)(P.ws + WS_FO + 34603008)) + (size_t)row * 1024;
#pragma unroll
            for (int q = 0; q < 4; ++q) { const u32x2 t = *(const u32x2*)(xb + (q * 64 + lane) * 4); xv[q] = make_float4(lo_bf(t.x), hi_bf(t.x), lo_bf(t.y), hi_bf(t.y)); } }
        if (mode != 0) {
#pragma unroll
            for (int q = 0; q < 4; ++q) { const int KS = mode == 2 ? 4 : 8; const float* sl = (const float*)(P.ws + WS_OMD) + (size_t)((((row - MP) >> 8) * 4 + q) * KS) * 65536 + (size_t)(row & 255) * 256 + lane * 4;
                float4 a = *(const float4*)sl;
                for (int p = 1; p < KS; ++p) { const float4 b = *(const float4*)(sl + (size_t)p * 65536); a.x += b.x; a.y += b.y; a.z += b.z; a.w += b.w; }
                fo[q] = a; } }
        else {
#pragma unroll
            for (int q = 0; q < 4; ++q) fo[q] = make_float4(0.f, 0.f, 0.f, 0.f); }
        rows_proc(P, mode, row, lane, xv, fo, gp, gn);
    }
}

__device__ __forceinline__ void p0_prologue(PR P, LAS float* ldsf, const int wv) {
    const int tid = fresh_tid(wv); const size_t gt = (size_t)blockIdx.x * 512 + tid, nth = (size_t)gridDim.x * 512;
    { float* rc = (float*)(P.ws + WS_ROPE); float* rs = rc + 2052 * 64;
      for (size_t i = gt; i < 2052 * 64; i += nth) { const int p = (int)(i >> 6), f = (int)(i & 63); const int pos = p < 2048 ? p : 16384 + (p - 2048);
          double inv = 1.0; for (int q = 0; q < f; ++q) inv *= 0.8659643233600653;
          const double ang = (double)pos * inv; const double n = rint(ang * 0.15915494309189535); const double r = ang - n * 6.283185307179586;
          const double r2 = r * r; double s = 0.0, c = 0.0;
          for (int k = 14; k >= 0; --k) { s = s * (-r2 / (double)((2 * k + 2) * (2 * k + 3))) + 1.0; c = c * (-r2 / (double)((2 * k + 1) * (2 * k + 2))) + 1.0; }
          rc[i] = (float)c; rs[i] = (float)(s * r); } }
    { bf16_t* Wl = (bf16_t*)(P.ws + WS_WL);
      for (size_t i = gt; i < 1536 * 256; i += nth) { const int n = (int)(i >> 8), k = (int)(i & 255); float v = 0.f;
          if (n < 512) { if (k < 64) v = P.w2[k * 512 + n]; } else if (n < 1024) { if (k >= 64 && k < 128) v = P.a2[(k - 64) * 512 + (n - 512)]; } else { if (k >= 128) v = P.g2[(k - 128) * 512 + (n - 1024)]; }
          Wl[i] = f2bf(v); } }
    { bf16_t* XN = (bf16_t*)(P.ws + WS_XN);
      for (size_t i = gt; i < 256 * 1024; i += nth) { const int r = (int)(i >> 10); XN[(size_t)MT * 1024 + i] = r < 128 ? f2bf(P.state_shift[i]) : (bf16_t)0; } }
    tconv_list(P.f1g, P.f1u, P.f1d, P.w_in, P.w_out, P.ws, 3328, ldsf, wv);
    rows_phase(P, 0, wv);
}

__device__ __forceinline__ void lora_prep(PR P, const int wv) {
    const int tid = fresh_tid(wv); const int lane = tid & 63; const int gw = blockIdx.x * 8 + (tid >> 6), nw = gridDim.x * 8;
    const bf16_t* PS = (const bf16_t*)(P.ws + WS_BIG); bf16_t* LA = (bf16_t*)(P.ws + WS_LA);
    const float4 mu = *(const float4*)(P.mu + 1536 + lane * 4); const int kind = lane >> 4;
    u32x2 c = (u32x2){0u, 0u}, p = c, nc = c, np = c;
    if (gw < MT) { c = *(const u32x2*)(PS + (size_t)gw * NCOLS + 1536 + lane * 4); const int pr = prev_row(gw); if (pr >= 0) p = *(const u32x2*)(PS + (size_t)pr * NCOLS + 1536 + lane * 4); }
    for (int row = gw; row < MT; row += nw) {
        const int nrow = row + nw;
        if (nrow < MT) { nc = *(const u32x2*)(PS + (size_t)nrow * NCOLS + 1536 + lane * 4); const int pr = prev_row(nrow); np = (u32x2){0u, 0u}; if (pr >= 0) np = *(const u32x2*)(PS + (size_t)pr * NCOLS + 1536 + lane * 4); }
        float v[4]; const float cu[4] = {lo_bf(c.x), hi_bf(c.x), lo_bf(c.y), hi_bf(c.y)}, pv[4] = {lo_bf(p.x), hi_bf(p.x), lo_bf(p.y), hi_bf(p.y)}, m4[4] = {mu.x, mu.y, mu.z, mu.w};
#pragma unroll
        for (int j = 0; j < 4; ++j) { float x = cu[j] + (pv[j] - cu[j]) * m4[j];
            if (kind == 0) x = 1.0f - 2.0f * __builtin_amdgcn_rcpf(__expf(2.0f * x) + 1.0f); else if (kind >= 2) x = sigmoid_f(x);
            v[j] = x; }
        u32x2 w; w.x = pg8::cvt_pk_bf16(v[0], v[1]); w.y = pg8::cvt_pk_bf16(v[2], v[3]);
        *(u32x2*)(LA + (size_t)row * 256 + lane * 4) = w;
        c = nc; p = np;
    }
}

template <bool SAMPLE>
__device__ __forceinline__ void rwkv_unit(PR P, LAS float* lds, const int b, const int h, const int half, const int wv) {
    constexpr int T = SAMPLE ? 4 : 2048, TC = SAMPLE ? 4 : 32, NCH = T / TC;
    const int tid = fresh_tid(wv), lane = tid & 63, wid = tid >> 6;
    const bf16_t* PS = (const bf16_t*)(P.ws + WS_BIG); const bf16_t* OMD = (const bf16_t*)(P.ws + WS_OMD); const bf16_t* ASIG = (const bf16_t*)(P.ws + WS_ASIG);
    bf16_t* YS = (bf16_t*)(P.ws + WS_YS);
    const int row_base = SAMPLE ? MP + b * 4 : b * 2048;
    const int ltok = (tid - 256) >> 4, lcg = tid & 15; const bool lwave = tid >= 256; const int hch = h * 64 + lcg * 4;
    const float4 mur = *(const float4*)(P.mu + hch), muk = *(const float4*)(P.mu + 512 + hch), muv = *(const float4*)(P.mu + 1024 + hch);
    const float4 kk4 = *(const float4*)(P.k_k + hch), ka4 = *(const float4*)(P.k_a + hch);
    typedef float f32x2 __attribute__((ext_vector_type(2)));
    const int row0 = half * 32 + (wid & 3) * 8 + (lane >> 4) * 2, cgl = lane & 15, j0 = cgl * 4;
    f32x2 S[4];
#pragma unroll
    for (int c = 0; c < 4; ++c) S[c] = (f32x2){0.f, 0.f};
    float* sout = P.out + (SAMPLE ? O_WKS : O_WKP) + ((size_t)(b * 8 + h) * 64 + row0) * 64 + j0;
    if (SAMPLE && wid < 4) { const float* sp = P.state_wkv + ((size_t)(b * 8 + h) * 64 + row0) * 64 + j0; const float4 s0 = *(const float4*)sp, s1 = *(const float4*)(sp + 64);
        S[0] = (f32x2){s0.x, s1.x}; S[1] = (f32x2){s0.y, s1.y}; S[2] = (f32x2){s0.z, s1.z}; S[3] = (f32x2){s0.w, s1.w}; }
    LAS float* buf0 = lds; LAS float* buf1 = lds + TC * 384;
    u32x2 cr[2], ck[2], cv[2], pr[2], pk[2], pv[2], co[2], ca[2];
#define RW_LOAD1(c, U) do { if (lwave && ltok + 16 * (U) < TC) { const int t_ = (c) * TC + ltok + 16 * (U); const int row_ = row_base + t_; const int prow_ = SAMPLE ? (t_ == 0 ? MT + b : row_ - 1) : row_ - 1; \
        const bf16_t* cp_ = PS + (size_t)row_ * NCOLS + hch; cr[U] = *(const u32x2*)cp_; ck[U] = *(const u32x2*)(cp_ + 512); cv[U] = *(const u32x2*)(cp_ + 1024); \
        if (SAMPLE || t_ > 0) { const bf16_t* pp_ = PS + (size_t)prow_ * NCOLS + hch; pr[U] = *(const u32x2*)pp_; pk[U] = *(const u32x2*)(pp_ + 512); pv[U] = *(const u32x2*)(pp_ + 1024); } \
        else { pr[U] = (u32x2){0u, 0u}; pk[U] = pr[U]; pv[U] = pr[U]; } \
        co[U] = *(const u32x2*)(OMD + (size_t)row_ * 512 + hch); ca[U] = *(const u32x2*)(ASIG + (size_t)row_ * 512 + hch); } } while (0)
#define RW_LOAD(c) do { RW_LOAD1(c, 0); RW_LOAD1(c, 1); } while (0)
#define RW_MIX(cu, pv_, m) ((cu) + ((pv_) - (cu)) * (m))
#define RW_PROC1(dst, U) do { if (lwave && ltok + 16 * (U) < TC) { LAS float* d_ = (dst) + (ltok + 16 * (U)) * 384 + lcg * 4; \
        f32x4 r_, k_, v_, o_, a_; \
        r_[0] = RW_MIX(lo_bf(cr[U].x), lo_bf(pr[U].x), mur.x); r_[1] = RW_MIX(hi_bf(cr[U].x), hi_bf(pr[U].x), mur.y); r_[2] = RW_MIX(lo_bf(cr[U].y), lo_bf(pr[U].y), mur.z); r_[3] = RW_MIX(hi_bf(cr[U].y), hi_bf(pr[U].y), mur.w); \
        k_[0] = RW_MIX(lo_bf(ck[U].x), lo_bf(pk[U].x), muk.x); k_[1] = RW_MIX(hi_bf(ck[U].x), hi_bf(pk[U].x), muk.y); k_[2] = RW_MIX(lo_bf(ck[U].y), lo_bf(pk[U].y), muk.z); k_[3] = RW_MIX(hi_bf(ck[U].y), hi_bf(pk[U].y), muk.w); \
        v_[0] = RW_MIX(lo_bf(cv[U].x), lo_bf(pv[U].x), muv.x); v_[1] = RW_MIX(hi_bf(cv[U].x), hi_bf(pv[U].x), muv.y); v_[2] = RW_MIX(lo_bf(cv[U].y), lo_bf(pv[U].y), muv.z); v_[3] = RW_MIX(hi_bf(cv[U].y), hi_bf(pv[U].y), muv.w); \
        o_[0] = lo_bf(co[U].x); o_[1] = hi_bf(co[U].x); o_[2] = lo_bf(co[U].y); o_[3] = hi_bf(co[U].y); a_[0] = lo_bf(ca[U].x); a_[1] = hi_bf(ca[U].x); a_[2] = lo_bf(ca[U].y); a_[3] = hi_bf(ca[U].y); \
        f32x4 kk_; kk_[0] = k_[0] * kk4.x; kk_[1] = k_[1] * kk4.y; kk_[2] = k_[2] * kk4.z; kk_[3] = k_[3] * kk4.w; \
        float ss_ = kk_[0] * kk_[0] + kk_[1] * kk_[1] + kk_[2] * kk_[2] + kk_[3] * kk_[3]; ss_ = row16_sum(ss_); \
        const float inv_ = __builtin_amdgcn_rcpf(fmaxf(__builtin_amdgcn_sqrtf(ss_), 1e-12f)); kk_ = kk_ * inv_; \
        f32x4 kn_; kn_[0] = k_[0] * (1.0f + (a_[0] - 1.0f) * ka4.x); kn_[1] = k_[1] * (1.0f + (a_[1] - 1.0f) * ka4.y); kn_[2] = k_[2] * (1.0f + (a_[2] - 1.0f) * ka4.z); kn_[3] = k_[3] * (1.0f + (a_[3] - 1.0f) * ka4.w); \
        *(LAS f32x4*)(d_) = r_; *(LAS f32x4*)(d_ + 64) = o_; *(LAS f32x4*)(d_ + 128) = kn_; *(LAS f32x4*)(d_ + 192) = -kk_; *(LAS f32x4*)(d_ + 256) = kk_ * a_; *(LAS f32x4*)(d_ + 320) = v_; } } while (0)
#define RW_PROC(dst) do { RW_PROC1(dst, 0); RW_PROC1(dst, 1); } while (0)
    RW_LOAD(0); RW_PROC(buf0); __syncthreads();
    for (int c = 0; c < NCH; ++c) {
        LAS float* cur = (c & 1) ? buf1 : buf0; LAS float* nxt = (c & 1) ? buf0 : buf1;
        if (c + 1 < NCH) RW_LOAD(c + 1);
        if (wid < 4) {
            constexpr int GS = SAMPLE ? 4 : 16;
            for (int g = 0; g < TC / GS; ++g) {
                float yk0 = 0.f, yk1 = 0.f;
                const LAS float* q0 = cur + (g * GS) * 384;
                f32x4 r4 = *(const LAS f32x4*)(q0 + j0), o4 = *(const LAS f32x4*)(q0 + 64 + j0), k4 = *(const LAS f32x4*)(q0 + 128 + j0), a4 = *(const LAS f32x4*)(q0 + 192 + j0), b4 = *(const LAS f32x4*)(q0 + 256 + j0);
                f32x2 v2 = *(const LAS f32x2*)(q0 + 320 + row0);
                float py0 = 0.f, py1 = 0.f;
#pragma unroll
                for (int tt = 0; tt < GS; ++tt) {
                    const LAS float* qn = q0 + (tt + 1 < GS ? tt + 1 : tt) * 384;
                    const f32x4 nr4 = *(const LAS f32x4*)(qn + j0), no4 = *(const LAS f32x4*)(qn + 64 + j0), nk4 = *(const LAS f32x4*)(qn + 128 + j0), na4 = *(const LAS f32x4*)(qn + 192 + j0), nb4 = *(const LAS f32x4*)(qn + 256 + j0);
                    const f32x2 nv2 = *(const LAS f32x2*)(qn + 320 + row0);
                    f32x2 sa = (S[0] * a4[0] + S[1] * a4[1]) + (S[2] * a4[2] + S[3] * a4[3]);
                    float sx = sa.x, sy = sa.y; ROW16_SUM4(sx, sy, py0, py1); sa = (f32x2){sx, sy};
                    if (tt > 0) { yk0 = cgl == tt - 1 ? py0 : yk0; yk1 = cgl == tt - 1 ? py1 : yk1; }
#pragma unroll
                    for (int c = 0; c < 4; ++c) { f32x2 t = S[c] - S[c] * o4[c]; t = t + sa * b4[c]; S[c] = t + v2 * k4[c]; }
                    const f32x2 y = (S[0] * r4[0] + S[1] * r4[1]) + (S[2] * r4[2] + S[3] * r4[3]);
                    py0 = y.x; py1 = y.y;
                    r4 = nr4; o4 = no4; k4 = nk4; a4 = na4; b4 = nb4; v2 = nv2;
                }
                ROW16_SUM2(py0, py1); yk0 = cgl == GS - 1 ? py0 : yk0; yk1 = cgl == GS - 1 ? py1 : yk1;
                if (cgl < GS) *(unsigned*)(YS + (size_t)(row_base + c * TC + g * GS + cgl) * 512 + h * 64 + row0) = pg8::cvt_pk_bf16(yk0, yk1);
            }
        }
        if (c + 1 < NCH) RW_PROC(nxt);
        __syncthreads();
    }
    if (wid < 4) { *(float4*)sout = make_float4(S[0].x, S[1].x, S[2].x, S[3].x); *(float4*)(sout + 64) = make_float4(S[0].y, S[1].y, S[2].y, S[3].y); }
#undef RW_LOAD
#undef RW_PROC
#undef RW_LOAD1
#undef RW_PROC1
#undef RW_MIX
}

__device__ __forceinline__ void ret_sample_unit(PR P, LAS float* lds, const int b, const int h, const int wv) {
    const int tid = fresh_tid(wv), lane = tid & 63, wid = tid >> 6;
    const bf16_t* PS = (const bf16_t*)(P.ws + WS_BIG); bf16_t* Y = (bf16_t*)(P.ws + WS_XN);
    const float* rc = (const float*)(P.ws + WS_ROPE); const float* rs = rc + 2052 * 64;
    LAS float* q = lds; LAS float* k = lds + 512; LAS float* v = lds + 1024; LAS float* Pm = lds + 1536; LAS float* y2p = lds + 1600; LAS float* red = lds + 1600 + 2048;
    const float lg2 = log2f(1.0f - exp2f(-5.0f - (float)h));
    const int row0 = MP + b * 4;
    { const int t = (tid & 255) >> 6, f = tid & 63; const bf16_t* src = PS + (size_t)(row0 + t) * NCOLS + 1792 + h * 128;
      if (tid < 256) { const float cs = rc[(2048 + t) * 64 + f], sn = rs[(2048 + t) * 64 + f];
          const float q1 = bf2f(src[f]), q2 = bf2f(src[f + 64]); q[t * 128 + f] = q1 * cs - q2 * sn; q[t * 128 + f + 64] = q1 * sn + q2 * cs;
          const float k1 = bf2f(src[512 + f]), k2 = bf2f(src[512 + f + 64]); k[t * 128 + f] = (k1 * cs - k2 * sn) * 0.08838834764831845f; k[t * 128 + f + 64] = (k1 * sn + k2 * cs) * 0.08838834764831845f; }
      else { v[t * 128 + f] = bf2f(src[1024 + f]); v[t * 128 + f + 64] = bf2f(src[1024 + f + 64]); } }
    __syncthreads();
    if (wid == 0) { const int pi = lane >> 4, pj = (lane >> 2) & 3, part = lane & 3; float s = 0.f;
        for (int d = part * 32; d < part * 32 + 32; ++d) s += q[pi * 128 + d] * k[pj * 128 + d];
        s = quad_sum(s); if (part == 0) Pm[pi * 4 + pj] = pi >= pj ? s * exp2f(lg2 * (float)(pi - pj)) : 0.f; }
    { const int e = tid & 127, dg = tid >> 7; const float c4 = exp2f(lg2 * 4.0f), g3 = exp2f(lg2 * 3.0f), g2_ = exp2f(lg2 * 2.0f), g1 = exp2f(lg2);
      const float v0 = v[e] * g3, v1 = v[128 + e] * g2_, v2 = v[256 + e] * g1, v3 = v[384 + e];
      const float* S0 = P.state_ret + ((size_t)(b * 4 + h) * 128) * 128 + e; float* So = P.out + O_RTS + ((size_t)(b * 4 + h) * 128) * 128 + e;
      float a0 = 0.f, a1 = 0.f, a2 = 0.f, a3 = 0.f;
      float sv[32];
#pragma unroll
      for (int x = 0; x < 32; ++x) sv[x] = S0[(size_t)(dg * 32 + x) * 128];
#pragma unroll
      for (int x = 0; x < 32; ++x) { const int d = dg * 32 + x; const float s = sv[x];
          a0 = fmaf(q[d], s, a0); a1 = fmaf(q[128 + d], s, a1); a2 = fmaf(q[256 + d], s, a2); a3 = fmaf(q[384 + d], s, a3);
          So[(size_t)d * 128] = s * c4 + k[d] * v0 + k[128 + d] * v1 + k[256 + d] * v2 + k[384 + d] * v3; }
      y2p[(dg * 4 + 0) * 128 + e] = a0; y2p[(dg * 4 + 1) * 128 + e] = a1; y2p[(dg * 4 + 2) * 128 + e] = a2; y2p[(dg * 4 + 3) * 128 + e] = a3; }
    __syncthreads();
    { const int i = tid >> 7, e = tid & 127;
      float y = (y2p[(0 + i) * 128 + e] + y2p[(4 + i) * 128 + e] + y2p[(8 + i) * 128 + e] + y2p[(12 + i) * 128 + e]) * exp2f(lg2 * (float)(i + 1));
#pragma unroll
      for (int j = 0; j < 4; ++j) y = fmaf(Pm[i * 4 + j], v[j * 128 + e], y);
      float s = wave_sum(y); if (lane == 0) red[wid] = s; __syncthreads();
      const float mean = (red[i * 2] + red[i * 2 + 1]) * (1.0f / 128.0f); const float dlt = y - mean;
      float s2 = wave_sum(dlt * dlt); if (lane == 0) red[8 + wid] = s2; __syncthreads();
      const float var = (red[8 + i * 2] + red[8 + i * 2 + 1]) * (1.0f / 128.0f);
      const float g = bf2f(PS[(size_t)(row0 + i) * NCOLS + 1792 + 1536 + h * 128 + e]);
      const float o = dlt * rsqrtf(var + 1e-5f) * P.gn_w[h * 128 + e] * (g * __builtin_amdgcn_rcpf(1.0f + __expf(-g)));
      Y[(size_t)(row0 + i) * 1024 + 512 + h * 128 + e] = f2bf(o); }
    __syncthreads();
}

__device__ __forceinline__ bf16_t* kvb_ptr(unsigned char* ws, int bh) { return (bf16_t*)(bh < 29 ? ws + WS_LA + (size_t)bh * 524288 : ws + WS_WIN + 17301504 + (size_t)(bh - 29) * 524288); }
constexpr int RS = 136, BUFE = 128 * RS;

template <bool WITH_K>
__device__ __forceinline__ void ret_load_qk(PR P, LAS bf16_t* QP, LAS bf16_t* KB, unsigned (&kth)[4][4], const int tidv, const int row0, const int n, const int h, const float kd0, const float g32) {
    const bf16_t* PS = (const bf16_t*)(P.ws + WS_BIG); const float* rc = (const float*)(P.ws + WS_ROPE); const float* rs = rc + 2052 * 64;
    float kd = kd0;
#pragma unroll
    for (int it = 0; it < 4; ++it) { const int idx = it * 512 + tidv, i = idx >> 4, f = (idx & 15) * 4;
        const bf16_t* src = PS + (size_t)(row0 + i) * NCOLS + 1792 + h * 128;
        const u32x2 q1 = *(const u32x2*)(src + f), q2 = *(const u32x2*)(src + 64 + f);
        u32x2 k1 = (u32x2){0u, 0u}, k2 = k1; if (WITH_K) { k1 = *(const u32x2*)(src + 512 + f); k2 = *(const u32x2*)(src + 576 + f); }
        const float4 cs = *(const float4*)(rc + (size_t)(n * 128 + i) * 64 + f), sn = *(const float4*)(rs + (size_t)(n * 128 + i) * 64 + f);
        const float c4[4] = {cs.x, cs.y, cs.z, cs.w}, s4[4] = {sn.x, sn.y, sn.z, sn.w};
        const float qa[4] = {lo_bf(q1.x), hi_bf(q1.x), lo_bf(q1.y), hi_bf(q1.y)}, qb[4] = {lo_bf(q2.x), hi_bf(q2.x), lo_bf(q2.y), hi_bf(q2.y)};
        float qo1[4], qo2[4];
#pragma unroll
        for (int x = 0; x < 4; ++x) { qo1[x] = qa[x] * c4[x] - qb[x] * s4[x]; qo2[x] = qa[x] * s4[x] + qb[x] * c4[x]; }
        u32x2 w; w.x = pg8::cvt_pk_bf16(qo1[0], qo1[1]); w.y = pg8::cvt_pk_bf16(qo1[2], qo1[3]); *(LAS u32x2*)(QP + i * RS + f) = w;
        w.x = pg8::cvt_pk_bf16(qo2[0], qo2[1]); w.y = pg8::cvt_pk_bf16(qo2[2], qo2[3]); *(LAS u32x2*)(QP + i * RS + 64 + f) = w;
        if (WITH_K) {
            const float ka[4] = {lo_bf(k1.x), hi_bf(k1.x), lo_bf(k1.y), hi_bf(k1.y)}, kb[4] = {lo_bf(k2.x), hi_bf(k2.x), lo_bf(k2.y), hi_bf(k2.y)};
            float ko1[4], ko2[4];
#pragma unroll
            for (int x = 0; x < 4; ++x) { ko1[x] = (ka[x] * c4[x] - kb[x] * s4[x]) * 0.08838834764831845f; ko2[x] = (ka[x] * s4[x] + kb[x] * c4[x]) * 0.08838834764831845f; }
            w.x = pg8::cvt_pk_bf16(ko1[0], ko1[1]); w.y = pg8::cvt_pk_bf16(ko1[2], ko1[3]); *(LAS u32x2*)(KB + i * RS + f) = w;
            w.x = pg8::cvt_pk_bf16(ko2[0], ko2[1]); w.y = pg8::cvt_pk_bf16(ko2[2], ko2[3]); *(LAS u32x2*)(KB + i * RS + 64 + f) = w;
            kth[it][0] = pg8::cvt_pk_bf16(ko1[0] * kd, ko1[1] * kd); kth[it][1] = pg8::cvt_pk_bf16(ko1[2] * kd, ko1[3] * kd);
            kth[it][2] = pg8::cvt_pk_bf16(ko2[0] * kd, ko2[1] * kd); kth[it][3] = pg8::cvt_pk_bf16(ko2[2] * kd, ko2[3] * kd); kd *= g32; }
        if (it & 1) __builtin_amdgcn_sched_barrier(0); }
}

__device__ __forceinline__ void ret_unit_a(PR P, LAS unsigned char* lds, const int bh, const int n, const int wv) {
    LAS bf16_t* QP = (LAS bf16_t*)lds; LAS bf16_t* KB = QP + BUFE; LAS bf16_t* VT = KB + BUFE;
    const int tid = fresh_tid(wv), lane = tid & 63, wid = tid >> 6, wr = wid >> 1, wc = wid & 1, fr = lane & 15, fq = lane >> 4;
    const int b = bh >> 2, h = bh & 3;
    const bf16_t* PS = (const bf16_t*)(P.ws + WS_BIG); bf16_t* Y = (bf16_t*)(P.ws + WS_XN); bf16_t* KVB = kvb_ptr(P.ws, bh) + (size_t)n * 16384;
    const float lg2 = log2f(1.0f - exp2f(-5.0f - (float)h));
    const float kd0 = exp2f(lg2 * (float)(127 - (tid >> 4))), g32 = exp2f(-32.0f * lg2);
    const int row0 = b * 2048 + n * 128;
    unsigned kth[4][4];
    ret_load_qk<true>(P, QP, KB, kth, tid, row0, n, h, kd0, g32);
#pragma unroll
    for (int it = 0; it < 4; ++it) { const int idx = it * 512 + tid, j = idx >> 4, e = (idx & 15) * 8;
        const u32x4 vv = *(const u32x4*)(PS + (size_t)(row0 + j) * NCOLS + 1792 + 1024 + h * 128 + e);
        LAS bf16_t* d = VT + e * RS + j;
        d[0] = (bf16_t)(vv.x & 0xffffu); d[RS] = (bf16_t)(vv.x >> 16); d[2 * RS] = (bf16_t)(vv.y & 0xffffu); d[3 * RS] = (bf16_t)(vv.y >> 16);
        d[4 * RS] = (bf16_t)(vv.z & 0xffffu); d[5 * RS] = (bf16_t)(vv.z >> 16); d[6 * RS] = (bf16_t)(vv.w & 0xffffu); d[7 * RS] = (bf16_t)(vv.w >> 16); }
    __syncthreads();
    f32x4 accP[2][4];
#pragma unroll
    for (int mt = 0; mt < 2; ++mt)
#pragma unroll
        for (int nt = 0; nt < 4; ++nt) accP[mt][nt] = (f32x4){0.f, 0.f, 0.f, 0.f};
#pragma unroll
    for (int ks = 0; ks < 4; ++ks) { bf16x8 aq[2];
#pragma unroll
        for (int mt = 0; mt < 2; ++mt) aq[mt] = *(const LAS bf16x8*)(QP + (wr * 32 + mt * 16 + fr) * RS + ks * 32 + fq * 8);
#pragma unroll
        for (int nt = 0; nt < 4; ++nt) { const bf16x8 bk = *(const LAS bf16x8*)(KB + (wc * 64 + nt * 16 + fr) * RS + ks * 32 + fq * 8);
#pragma unroll
            for (int mt = 0; mt < 2; ++mt) accP[mt][nt] = __builtin_amdgcn_mfma_f32_16x16x32_bf16(aq[mt], bk, accP[mt][nt], 0, 0, 0); }
        __builtin_amdgcn_sched_barrier(0); }
    __syncthreads();
    { float ri[2][4], cj[4];
#pragma unroll
      for (int mt = 0; mt < 2; ++mt)
#pragma unroll
          for (int j = 0; j < 4; ++j) ri[mt][j] = exp2f(lg2 * (float)(wr * 32 + mt * 16 + fq * 4 + j));
#pragma unroll
      for (int nt = 0; nt < 4; ++nt) cj[nt] = exp2f(-lg2 * (float)(wc * 64 + nt * 16 + fr));
#pragma unroll
      for (int mt = 0; mt < 2; ++mt)
#pragma unroll
          for (int nt = 0; nt < 4; ++nt)
#pragma unroll
              for (int j = 0; j < 4; ++j) { const int i = wr * 32 + mt * 16 + fq * 4 + j, jj = wc * 64 + nt * 16 + fr;
                  const float val = i >= jj ? accP[mt][nt][j] * ri[mt][j] * cj[nt] : 0.f; QP[i * RS + jj] = f2bf(val); } }
#pragma unroll
    for (int it = 0; it < 4; ++it) { const int idx = it * 512 + tid, j = idx >> 4, f = (idx & 15) * 4; LAS bf16_t* d = KB + f * RS + j;
        d[0] = (bf16_t)(kth[it][0] & 0xffffu); d[RS] = (bf16_t)(kth[it][0] >> 16); d[2 * RS] = (bf16_t)(kth[it][1] & 0xffffu); d[3 * RS] = (bf16_t)(kth[it][1] >> 16);
        LAS bf16_t* d2 = d + 64 * RS;
        d2[0] = (bf16_t)(kth[it][2] & 0xffffu); d2[RS] = (bf16_t)(kth[it][2] >> 16); d2[2 * RS] = (bf16_t)(kth[it][3] & 0xffffu); d2[3 * RS] = (bf16_t)(kth[it][3] >> 16); }
    __syncthreads();
    f32x4 accY[2][4], accS[2][4];
#pragma unroll
    for (int mt = 0; mt < 2; ++mt)
#pragma unroll
        for (int nt = 0; nt < 4; ++nt) { accY[mt][nt] = (f32x4){0.f, 0.f, 0.f, 0.f}; accS[mt][nt] = (f32x4){0.f, 0.f, 0.f, 0.f}; }
#pragma unroll
    for (int ks = 0; ks < 4; ++ks) { bf16x8 ap[2], av[2];
#pragma unroll
        for (int mt = 0; mt < 2; ++mt) { ap[mt] = *(const LAS bf16x8*)(QP + (wr * 32 + mt * 16 + fr) * RS + ks * 32 + fq * 8); av[mt] = *(const LAS bf16x8*)(VT + (wr * 32 + mt * 16 + fr) * RS + ks * 32 + fq * 8); }
#pragma unroll
        for (int nt = 0; nt < 4; ++nt) { const bf16x8 bv = *(const LAS bf16x8*)(VT + (wc * 64 + nt * 16 + fr) * RS + ks * 32 + fq * 8), bkt = *(const LAS bf16x8*)(KB + (wc * 64 + nt * 16 + fr) * RS + ks * 32 + fq * 8);
#pragma unroll
            for (int mt = 0; mt < 2; ++mt) { accY[mt][nt] = __builtin_amdgcn_mfma_f32_16x16x32_bf16(ap[mt], bv, accY[mt][nt], 0, 0, 0); accS[mt][nt] = __builtin_amdgcn_mfma_f32_16x16x32_bf16(av[mt], bkt, accS[mt][nt], 0, 0, 0); } }
        __builtin_amdgcn_sched_barrier(0); }
#pragma unroll
    for (int mt = 0; mt < 2; ++mt)
#pragma unroll
        for (int nt = 0; nt < 4; ++nt)
#pragma unroll
            for (int j = 0; j < 4; ++j) { const int r = wr * 32 + mt * 16 + fq * 4 + j, c = wc * 64 + nt * 16 + fr;
                Y[(size_t)(row0 + r) * 1024 + 512 + h * 128 + c] = f2bf(accY[mt][nt][j]); KVB[r * 128 + c] = f2bf(accS[mt][nt][j]); }
    __syncthreads();
}

__device__ __forceinline__ void ret_prefix(PR P, const int item) {
    const int bh = item >> 11, i8 = (item & 2047) * 8; const int h = bh & 3;
    bf16_t* KVB = kvb_ptr(P.ws, bh) + i8;
    const float lg2 = log2f(1.0f - exp2f(-5.0f - (float)h)); const float c_dec = exp2f(lg2 * 128.0f);
    u32x4 kv[16];
#pragma unroll
    for (int n = 0; n < 16; ++n) kv[n] = *(const u32x4*)(KVB + (size_t)n * 16384);
    float S[8];
#pragma unroll
    for (int x = 0; x < 8; ++x) S[x] = 0.f;
#pragma unroll
    for (int n = 0; n < 16; ++n) { u32x4 w; w.x = pg8::cvt_pk_bf16(S[0], S[1]); w.y = pg8::cvt_pk_bf16(S[2], S[3]); w.z = pg8::cvt_pk_bf16(S[4], S[5]); w.w = pg8::cvt_pk_bf16(S[6], S[7]);
        *(u32x4*)(KVB + (size_t)n * 16384) = w;
        const float k8[8] = {lo_bf(kv[n].x), hi_bf(kv[n].x), lo_bf(kv[n].y), hi_bf(kv[n].y), lo_bf(kv[n].z), hi_bf(kv[n].z), lo_bf(kv[n].w), hi_bf(kv[n].w)};
#pragma unroll
        for (int x = 0; x < 8; ++x) S[x] = S[x] * c_dec + k8[x]; }
    const int e = i8 >> 7, d0 = i8 & 127;
#pragma unroll
    for (int x = 0; x < 8; ++x) P.out[O_RTP + ((size_t)bh * 128 + d0 + x) * 128 + e] = S[x];
}

__device__ __forceinline__ void ret_unit_c(PR P, LAS unsigned char* lds, const int bh, const int n, const int wv) {
    LAS bf16_t* QP = (LAS bf16_t*)lds; LAS bf16_t* ST = QP + 3 * BUFE; LAS float* YST = (LAS float*)(QP + BUFE);
    const int tid = fresh_tid(wv), lane = tid & 63, wid = tid >> 6, wr = wid >> 1, wc = wid & 1, fr = lane & 15, fq = lane >> 4;
    const int b = bh >> 2, h = bh & 3;
    const bf16_t* PS = (const bf16_t*)(P.ws + WS_BIG); bf16_t* Y = (bf16_t*)(P.ws + WS_XN); const bf16_t* KVB = kvb_ptr(P.ws, bh) + (size_t)n * 16384;
    const float lg2 = log2f(1.0f - exp2f(-5.0f - (float)h));
    const int row0 = b * 2048 + n * 128;
    unsigned kth[4][4];
    ret_load_qk<false>(P, QP, QP, kth, tid, row0, n, h, 0.f, 0.f);
#pragma unroll
    for (int it = 0; it < 4; ++it) { const int idx = it * 512 + tid, e = idx >> 4, d8 = (idx & 15) * 8;
        *(LAS u32x4*)(ST + e * RS + d8) = *(const u32x4*)(KVB + e * 128 + d8); }
    __syncthreads();
    f32x4 accY[2][4];
#pragma unroll
    for (int mt = 0; mt < 2; ++mt)
#pragma unroll
        for (int nt = 0; nt < 4; ++nt) accY[mt][nt] = (f32x4){0.f, 0.f, 0.f, 0.f};
#pragma unroll
    for (int ks = 0; ks < 4; ++ks) { bf16x8 aq[2];
#pragma unroll
        for (int mt = 0; mt < 2; ++mt) aq[mt] = *(const LAS bf16x8*)(QP + (wr * 32 + mt * 16 + fr) * RS + ks * 32 + fq * 8);
#pragma unroll
        for (int nt = 0; nt < 4; ++nt) { const bf16x8 bs = *(const LAS bf16x8*)(ST + (wc * 64 + nt * 16 + fr) * RS + ks * 32 + fq * 8);
#pragma unroll
            for (int mt = 0; mt < 2; ++mt) accY[mt][nt] = __builtin_amdgcn_mfma_f32_16x16x32_bf16(aq[mt], bs, accY[mt][nt], 0, 0, 0); }
        __builtin_amdgcn_sched_barrier(0); }
#pragma unroll
    for (int mt = 0; mt < 2; ++mt)
#pragma unroll
        for (int j = 0; j < 4; ++j) { const int r = wr * 32 + mt * 16 + fq * 4 + j; const float qd = exp2f(lg2 * (float)(r + 1));
#pragma unroll
            for (int nt = 0; nt < 4; ++nt) YST[r * 132 + wc * 64 + nt * 16 + fr] = accY[mt][nt][j] * qd; }
    __syncthreads();
    { const int i = tid >> 2, part = tid & 3; float yv[32]; float s = 0.f;
      bf16_t* yo = Y + (size_t)(row0 + i) * 1024 + 512 + h * 128 + part * 32;
#pragma unroll
      for (int x = 0; x < 4; ++x) { const u32x4 y1 = *(const u32x4*)(yo + x * 8); const f32x4 ta = *(const LAS f32x4*)(YST + i * 132 + part * 32 + x * 8), tb = *(const LAS f32x4*)(YST + i * 132 + part * 32 + x * 8 + 4);
          yv[x * 8 + 0] = ta[0] + lo_bf(y1.x); yv[x * 8 + 1] = ta[1] + hi_bf(y1.x); yv[x * 8 + 2] = ta[2] + lo_bf(y1.y); yv[x * 8 + 3] = ta[3] + hi_bf(y1.y);
          yv[x * 8 + 4] = tb[0] + lo_bf(y1.z); yv[x * 8 + 5] = tb[1] + hi_bf(y1.z); yv[x * 8 + 6] = tb[2] + lo_bf(y1.w); yv[x * 8 + 7] = tb[3] + hi_bf(y1.w); }
#pragma unroll
      for (int x = 0; x < 32; ++x) s += yv[x];
      s = quad_sum(s); const float mean = s * (1.0f / 128.0f); float s2 = 0.f;
#pragma unroll
      for (int x = 0; x < 32; ++x) { yv[x] -= mean; s2 += yv[x] * yv[x]; }
      s2 = quad_sum(s2); const float rstd = rsqrtf(s2 * (1.0f / 128.0f) + 1e-5f);
      const bf16_t* gp = PS + (size_t)(row0 + i) * NCOLS + 1792 + 1536 + h * 128 + part * 32; const float* gw = P.gn_w + h * 128 + part * 32;
#pragma unroll
      for (int x = 0; x < 4; ++x) { const u32x4 g4 = *(const u32x4*)(gp + x * 8); const float4 w0 = *(const float4*)(gw + x * 8), w1 = *(const float4*)(gw + x * 8 + 4);
          const float gg[8] = {lo_bf(g4.x), hi_bf(g4.x), lo_bf(g4.y), hi_bf(g4.y), lo_bf(g4.z), hi_bf(g4.z), lo_bf(g4.w), hi_bf(g4.w)}; const float ww[8] = {w0.x, w0.y, w0.z, w0.w, w1.x, w1.y, w1.z, w1.w};
          float o[8];
#pragma unroll
          for (int z = 0; z < 8; ++z) o[z] = yv[x * 8 + z] * rstd * ww[z] * (gg[z] * __builtin_amdgcn_rcpf(1.0f + __expf(-gg[z])));
          u32x4 w; w.x = pg8::cvt_pk_bf16(o[0], o[1]); w.y = pg8::cvt_pk_bf16(o[2], o[3]); w.z = pg8::cvt_pk_bf16(o[4], o[5]); w.w = pg8::cvt_pk_bf16(o[6], o[7]);
          *(u32x4*)(yo + x * 8) = w; } }
    __syncthreads();
}

__device__ __forceinline__ void sub_barrier(unsigned* cnt, const unsigned target, const int wv) {
    asm volatile("s_waitcnt vmcnt(0)" ::: "memory");
    __syncthreads();
    if (fresh_tid(wv) == 0) {
        __builtin_amdgcn_fence(__ATOMIC_RELEASE, "agent");
        asm volatile("s_waitcnt vmcnt(0)" ::: "memory");
        (void)xb_add(cnt, 1u);
        unsigned sp = 0u;
        while (xb_ld(cnt) < target) { __builtin_amdgcn_s_sleep(2); if (++sp > (1u << 20)) break; }
        __builtin_amdgcn_fence(__ATOMIC_ACQUIRE, "agent");
        asm volatile("s_waitcnt vmcnt(0)" ::: "memory");
    }
    __syncthreads();
}

struct PostRegs { u32x2 yr, c_r, c_k, c_v, p_r, p_k, p_v, ar, gr; };
__device__ __forceinline__ void post_load(PR P, PostRegs& R, const int row, const int ch) {
    const bf16_t* PS = (const bf16_t*)(P.ws + WS_BIG); const bf16_t* ASIG = (const bf16_t*)(P.ws + WS_ASIG); const bf16_t* YS = (const bf16_t*)(P.ws + WS_YS); const bf16_t* G = (const bf16_t*)(P.ws + WS_WIN);
    R.yr = *(const u32x2*)(YS + (size_t)row * 512 + ch);
    const bf16_t* cp = PS + (size_t)row * NCOLS + ch; const int pr = prev_row(row);
    R.c_r = *(const u32x2*)cp; R.c_k = *(const u32x2*)(cp + 512); R.c_v = *(const u32x2*)(cp + 1024);
    R.p_r = (u32x2){0u, 0u}; R.p_k = R.p_r; R.p_v = R.p_r;
    if (pr >= 0) { const bf16_t* pp = PS + (size_t)pr * NCOLS + ch; R.p_r = *(const u32x2*)pp; R.p_k = *(const u32x2*)(pp + 512); R.p_v = *(const u32x2*)(pp + 1024); }
    R.ar = *(const u32x2*)(ASIG + (size_t)row * 512 + ch); R.gr = *(const u32x2*)(G + (size_t)row * 512 + ch);
}
__device__ __forceinline__ void rwkv_post(PR P, const int wv) {
    const int tid = fresh_tid(wv); const int lane = tid & 63; const int gw = blockIdx.x * 8 + (tid >> 6), nw = gridDim.x * 8;
    const int sub = lane >> 4, cg4 = (lane & 15) * 4;
    bf16_t* Y = (bf16_t*)(P.ws + WS_XN);
    const int h = (gw * 4 + sub) & 7, ch = h * 64 + cg4;
    const float4 mr = *(const float4*)(P.mu + ch), mk = *(const float4*)(P.mu + 512 + ch), mv = *(const float4*)(P.mu + 1024 + ch);
    const float4 ka = *(const float4*)(P.k_a + ch), rk = *(const float4*)(P.r_k + ch), lw = *(const float4*)(P.lnx_w + ch), lb = *(const float4*)(P.lnx_b + ch);
    const float m_r[4] = {mr.x, mr.y, mr.z, mr.w}, m_k[4] = {mk.x, mk.y, mk.z, mk.w}, m_v[4] = {mv.x, mv.y, mv.z, mv.w};
    const float kaa[4] = {ka.x, ka.y, ka.z, ka.w}, rkk[4] = {rk.x, rk.y, rk.z, rk.w}, lww[4] = {lw.x, lw.y, lw.z, lw.w}, lbb[4] = {lb.x, lb.y, lb.z, lb.w};
    PostRegs R, N;
    if (gw < MT * 2) post_load(P, R, (gw * 4 + sub) >> 3, ch);
    for (int task = gw; task < MT * 2; task += nw) {
        const int row = (task * 4 + sub) >> 3;
        if (task + nw < MT * 2) post_load(P, N, ((task + nw) * 4 + sub) >> 3, ch);
        const float ys[4] = {lo_bf(R.yr.x), hi_bf(R.yr.x), lo_bf(R.yr.y), hi_bf(R.yr.y)};
        const float mean = row16_sum(ys[0] + ys[1] + ys[2] + ys[3]) * (1.0f / 64.0f);
        float dl[4], s2 = 0.f;
#pragma unroll
        for (int j = 0; j < 4; ++j) { dl[j] = ys[j] - mean; s2 += dl[j] * dl[j]; }
        const float rstd = rsqrtf(row16_sum(s2) * (1.0f / 64.0f) + 64e-5f);
        const float cr[4] = {lo_bf(R.c_r.x), hi_bf(R.c_r.x), lo_bf(R.c_r.y), hi_bf(R.c_r.y)}, ck[4] = {lo_bf(R.c_k.x), hi_bf(R.c_k.x), lo_bf(R.c_k.y), hi_bf(R.c_k.y)}, cv[4] = {lo_bf(R.c_v.x), hi_bf(R.c_v.x), lo_bf(R.c_v.y), hi_bf(R.c_v.y)};
        const float qr[4] = {lo_bf(R.p_r.x), hi_bf(R.p_r.x), lo_bf(R.p_r.y), hi_bf(R.p_r.y)}, qk[4] = {lo_bf(R.p_k.x), hi_bf(R.p_k.x), lo_bf(R.p_k.y), hi_bf(R.p_k.y)}, qv[4] = {lo_bf(R.p_v.x), hi_bf(R.p_v.x), lo_bf(R.p_v.y), hi_bf(R.p_v.y)};
        const float aa[4] = {lo_bf(R.ar.x), hi_bf(R.ar.x), lo_bf(R.ar.y), hi_bf(R.ar.y)}, gg[4] = {lo_bf(R.gr.x), hi_bf(R.gr.x), lo_bf(R.gr.y), hi_bf(R.gr.y)};
        float v[4], bp = 0.f;
#pragma unroll
        for (int j = 0; j < 4; ++j) { const float r = cr[j] + (qr[j] - cr[j]) * m_r[j], k = ck[j] + (qk[j] - ck[j]) * m_k[j]; v[j] = cv[j] + (qv[j] - cv[j]) * m_v[j];
            const float kn = k * (1.0f + (aa[j] - 1.0f) * kaa[j]); bp += r * kn * rkk[j]; }
        const float bonus = row16_sum(bp);
        float o[4];
#pragma unroll
        for (int j = 0; j < 4; ++j) o[j] = (dl[j] * rstd * lww[j] + lbb[j] + bonus * v[j]) * gg[j];
        u32x2 w; w.x = pg8::cvt_pk_bf16(o[0], o[1]); w.y = pg8::cvt_pk_bf16(o[2], o[3]);
        *(u32x2*)(Y + (size_t)row * 1024 + ch) = w;
        R = N;
    }
}

__global__ void __launch_bounds__(512, 2) hymba_mega(Params P_unused) {
    extern __shared__ __attribute__((aligned(16))) unsigned char shm[];
    cg::grid_group grid = cg::this_grid();
    LAS unsigned char* lds = (LAS unsigned char*)shm; LAS float* ldsf = (LAS float*)shm;
    const int G = gridDim.x, bx = blockIdx.x;
    const int wv = __builtin_amdgcn_readfirstlane(threadIdx.x >> 6);
    const CAS Params* kp = (const CAS Params*)__builtin_amdgcn_kernarg_segment_ptr();
#define P (*kp)
#define FRESH() asm volatile("" : "+s"(kp))
#ifndef REP_SYNC
#define REP_SYNC 1
#endif
#ifndef REP_P7
#define REP_P7 1
#endif
#ifndef REP_FFN1
#define REP_FFN1 1
#endif
#ifndef REP_P0
#define REP_P0 1
#endif
#ifndef REP_P3
#define REP_P3 1
#endif
#ifndef REP_RW
#define REP_RW 1
#endif
#ifndef REP_OTH
#define REP_OTH 1
#endif
#ifndef REP_RETP
#define REP_RETP 1
#endif
#ifndef REP_SAMP
#define REP_SAMP 1
#endif
#ifndef REP_P8
#define REP_P8 1
#endif
#define GSYNC() do { for (int r_ = 0; r_ < REP_SYNC; ++r_) xcd_barrier((unsigned*)ws, (volatile LAS unsigned*)(lds + LDS_BYTES - 16), wv); FRESH(); } while (0)
#define ws (kp->ws)
#define XN ((bf16_t*)(ws + WS_XN))
#define ACT ((bf16_t*)(ws + WS_BIG))
#define FO ((float*)(ws + WS_FO))
#define PS ((bf16_t*)(ws + WS_BIG))
    pg8::StaticOrder S;
    { const int t0 = fresh_tid(wv); if (t0 < 4) ((LAS unsigned*)(lds + LDS_BYTES - 16))[t0] = 0u;
      if (t0 == 0) (void)xb_add(&((unsigned*)ws)[XB_XCNT(xb_xcc_id())], 1u); }
    if (G == 0x7fffffff) grid.sync();
#ifndef PHM
#define PHM 0xFFFF
#endif
#define PH(k) if ((PHM >> (k)) & 1)
    for (int r0 = 0; r0 < REP_P0; ++r0) PH(0) p0_prologue(P, ldsf, wv);
    GSYNC();
    for (int rep1 = 0; rep1 < REP_FFN1; ++rep1) {
    PH(1) { pg8::Gemm g{XN, (const bf16_t*)(ws + WS_WGU), MT, NGU, 1024}; S.init(MT, NGU, G, bx, 1024); pg8::EpiSwiGLU E{ACT, DFF}; pg8::gemm_phase(lds, g, S, E, wv); }
    GSYNC();
    PH(2) { pg8::Gemm g{ACT, (const bf16_t*)(ws + WS_WD), MT, 1024, DFF}; pg8::SplitOrder S2; S2.init2(G, bx, DFF, 8); pg8::EpiFO E{(bf16_t*)FO, 1024, (float*)(ws + WS_OMD)}; pg8::gemm_phase(lds, g, S2, E, wv); }
    GSYNC();
    }
    for (int r3 = 0; r3 < REP_P3; ++r3) PH(3) rows_phase(P, 1, wv);
    GSYNC();
    PH(4) { pg8::Gemm g{XN, (const bf16_t*)(ws + WS_WIN), MIN_, NCOLS, 1024}; S.init(MIN_, NCOLS, G, bx, 1024); pg8::EpiBf16 E{PS, NCOLS}; pg8::gemm_phase(lds, g, S, E, wv); }
    GSYNC();
    PH(5) lora_prep(P, wv);
    GSYNC();
    PH(6) { pg8::Gemm g{(const bf16_t*)(ws + WS_LA), (const bf16_t*)(ws + WS_WL), MT, 1536, 256}; pg8::LoraMainOrder SM; SM.init(MP, 1024, G, bx, 256);
      pg8::EpiLora E{(bf16_t*)(ws + WS_OMD), (bf16_t*)(ws + WS_ASIG), (bf16_t*)(ws + WS_WIN), P.w0, P.a0}; pg8::gemm_phase(lds, g, SM, E, wv); }
    GSYNC();
    {
    if (bx < 128) { for (int rw = 0; rw < REP_RW; ++rw) rwkv_unit<false>(P, ldsf, bx >> 4, (bx >> 1) & 7, bx & 1, wv); }
    else {
        { pg8::Gemm g{(const bf16_t*)(ws + WS_LA), (const bf16_t*)(ws + WS_WL), MT, 1536, 256}; pg8::LoraRestOrder SL; SL.ob = bx - 128;
          pg8::EpiLora E{(bf16_t*)(ws + WS_OMD), (bf16_t*)(ws + WS_ASIG), (bf16_t*)(ws + WS_WIN), P.w0, P.a0}; pg8::gemm_phase(lds, g, SL, E, wv); }
        FRESH();
        const int rep7 = 0; const int ob = bx - 128; unsigned* sbc = (unsigned*)ws + XCD_BAR_WORDS + 64;
        for (int k = 0; k < 4; ++k) { const int u = ob + k * 128; ret_unit_a(P, lds, u >> 4, u & 15, wv); }
        sub_barrier(sbc, 128u * (2u * rep7 + 1u), wv);
        ret_prefix(P, ob * 512 + fresh_tid(wv));
        sub_barrier(sbc, 128u * (2u * rep7 + 2u), wv);
        for (int k = 0; k < 4; ++k) { const int u = ob + k * 128; ret_unit_c(P, lds, u >> 4, u & 15, wv); }
        for (int u = ob; u < 2560; u += 128) { if (u < 2048) rwkv_unit<true>(P, ldsf, u >> 4, (u >> 1) & 7, u & 1, wv); else ret_sample_unit(P, ldsf, (u - 2048) >> 2, (u - 2048) & 3, wv); }
    }
    }
    GSYNC();
    for (int rep8 = 0; rep8 < REP_P8; ++rep8) PH(8) rwkv_post(P, wv);
    GSYNC();
    PH(9) { pg8::Gemm g{XN, (const bf16_t*)(ws + WS_WOUT), MT, 1024, 1024}; pg8::SplitOrder S2; S2.init2(G, bx, 1024, 4); pg8::EpiFO E{(bf16_t*)FO, 1024, (float*)(ws + WS_OMD)}; pg8::gemm_phase(lds, g, S2, E, wv); }
    GSYNC();
    PH(10) { tconv_list(P.f2g, P.f2u, P.f2d, nullptr, nullptr, ws, 2112, ldsf, wv);
    rows_phase(P, 2, wv); }
    GSYNC();
    PH(11) { pg8::Gemm g{XN, (const bf16_t*)(ws + WS_WGU), MT, NGU, 1024}; S.init(MT, NGU, G, bx, 1024); pg8::EpiSwiGLU E{ACT, DFF}; pg8::gemm_phase(lds, g, S, E, wv); }
    GSYNC();
    PH(12) { pg8::Gemm g{ACT, (const bf16_t*)(ws + WS_WD), MT, 1024, DFF}; pg8::SplitOrder S2; S2.init2(G, bx, DFF, 8); pg8::EpiFO E{(bf16_t*)FO, 1024, (float*)(ws + WS_OMD)}; pg8::gemm_phase(lds, g, S2, E, wv); }
    GSYNC();
    PH(13) rows_phase(P, 3, wv);
}

#undef ws
#undef XN
#undef ACT
#undef FO
#undef PS
#undef P
extern "C" void kernel_launch(void* const* d_in, const int* in_sizes, int n_in, void* d_out, int out_size, void* d_ws, size_t ws_size, hipStream_t stream) {
    static int grid = 0;
    if (grid == 0) {
        if (n_in != 26 || ws_size < WS_END) { fprintf(stderr, "kernel_launch: unexpected n_in %d or ws_size %zu (< %zu)\n", n_in, ws_size, (size_t)WS_END); grid = -1; return; }
        int dev = 0, cus = 0, per_cu = 0;
        hipGetDevice(&dev); hipDeviceGetAttribute(&cus, hipDeviceAttributeMultiprocessorCount, dev);
        hipFuncSetAttribute((const void*)hymba_mega, hipFuncAttributeMaxDynamicSharedMemorySize, LDS_BYTES);
        hipOccupancyMaxActiveBlocksPerMultiprocessor(&per_cu, (const void*)hymba_mega, 512, LDS_BYTES);
        if (per_cu < 1) { fprintf(stderr, "kernel_launch: occupancy query says %d blocks/CU\n", per_cu); per_cu = 1; }
        grid = cus * per_cu; if (grid > 256) grid = 256;
        if (grid != 256) { fprintf(stderr, "kernel_launch: this kernel needs 256 co-resident workgroups, got %d\n", grid); grid = -1; return; }
        fprintf(stderr, "kernel_launch: cus %d per_cu %d grid %d ws %zu\n", cus, per_cu, grid, ws_size);
    }
    if (grid < 0) return;
    if (hipMemsetAsync(d_ws, 0, 16384, stream) != hipSuccess) { fprintf(stderr, "kernel_launch: hipMemsetAsync failed\n"); return; }
    Params p{};
    const float** pp = (const float**)&p;
    for (int i = 0; i < 26; ++i) pp[i] = (const float*)d_in[i];
    p.out = (float*)d_out; p.ws = (unsigned char*)d_ws;
    void* args[] = {&p};
    hipError_t e = hipLaunchCooperativeKernel((const void*)hymba_mega, dim3(grid), dim3(512), args, LDS_BYTES, stream);
    if (e != hipSuccess) fprintf(stderr, "cooperative launch failed: %s (grid %d)\n", hipGetErrorString(e), grid);
}
```

```cpp
#include <hip/hip_runtime.h>
#include <hip/hip_cooperative_groups.h>
#include <cstdio>
#include <cstdint>
namespace cg = cooperative_groups;

__device__ __forceinline__ int fresh_tid(int wv) { int l; asm volatile("v_mbcnt_lo_u32_b32 %0, -1, 0\n\tv_mbcnt_hi_u32_b32 %0, -1, %0" : "=v"(l)); return wv * 64 + l; }
namespace pg8 {
#define PG8_LAS __attribute__((address_space(3)))
typedef unsigned short bf16_t;
typedef short bf16x8 __attribute__((ext_vector_type(8)));
typedef float f32x4 __attribute__((ext_vector_type(4)));
typedef unsigned u32x4 __attribute__((ext_vector_type(4)));
typedef unsigned u32x2 __attribute__((ext_vector_type(2)));
constexpr int BM = 256, BK = 64, HALF = 128, HTB = HALF * BK * 2, STAGE_BYTES = 8 * HTB, NXCD = 8, WGM = 8;

__host__ __device__ __forceinline__ int lds_byte(int r, int c) { const int st = (r >> 4) * 2 + (c >> 5), rr = r & 15, cc = c & 31, ob = rr * 64 + cc * 2; return st * 1024 + (ob ^ (((ob >> 9) & 1) << 5)); }
__host__ __device__ __forceinline__ void stage_rc(int b, int& R, int& C) { const int st = b / 1024, sb = b % 1024, swz = sb ^ (((sb >> 9) & 1) << 5); R = (st >> 1) * 16 + swz / 64; C = (st & 1) * 32 + (swz % 64) / 2; }
__host__ __device__ __forceinline__ int perm32(int rho) { const int n = rho >> 4, i = rho & 15; return 8 * (i >> 2) + 4 * n + (i & 3); }

struct Unit { int pm, pn, k0, nkt, atomic; };
struct Gemm { const bf16_t* A; const bf16_t* Bt; int M, N, K; };

struct StaticOrder {
    int nM, nN, nwg, G, c, nt;
    __host__ __device__ void init(int M, int N, int G_, int c_, int K) { nM = M / BM; nN = N / BM; nwg = nM * nN; G = G_; c = c_; nt = K / BK; }
    __host__ __device__ bool next(int i, Unit& u) const {
        const long L = (long)i * G + c; if (L >= nwg) return false;
        int wgid = (int)L; { const int q = nwg / NXCD, r = nwg % NXCD, xcd = wgid % NXCD, off = wgid / NXCD; wgid = (xcd < r ? xcd * (q + 1) : r * (q + 1) + (xcd - r) * q) + off; }
        const int nig = WGM * nN, gid = wgid / nig, fm = gid * WGM, gsz = (nM - fm) < WGM ? (nM - fm) : WGM;
        u.pm = fm + ((wgid % nig) % gsz); u.pn = (wgid % nig) / gsz; u.k0 = 0; u.nkt = nt; u.atomic = 0; return true;
    }
    __device__ __forceinline__ void a_ready(const Unit&) const {}
    __device__ __forceinline__ void done(const Unit&) const {}
};
struct LoraMainOrder : StaticOrder {
    __host__ __device__ bool next(int i, Unit& u) const { if (!StaticOrder::next(i, u)) return false; u.k0 = 0; u.nkt = 2; return true; }
};
struct LoraRestOrder {
    int ob;
    __host__ __device__ bool next(int i, Unit& u) const {
        const int L = i * 128 + ob; if (L >= 140) return false;
        if (L < 132) { u.pm = L >> 1; u.pn = 4 + (L & 1); u.k0 = 2; } else { const int x = L - 132; u.pm = 64 + (x >> 2); u.pn = x & 3; u.k0 = 0; }
        u.nkt = 2; u.atomic = 0; return true;
    }
    __device__ __forceinline__ void a_ready(const Unit&) const {}
    __device__ __forceinline__ void done(const Unit&) const {}
};
struct SplitOrder : StaticOrder {
    int KS;
    __host__ __device__ void init2(int G_, int c_, int K, int KS_) { init(16384, 1024, G_, c_, K); KS = KS_; }
    __host__ __device__ bool next(int i, Unit& u) const {
        if (i == 0) return StaticOrder::next(0, u);
        if (i > 1 || c >= 8 * KS) return false;
        const int tile = c / KS, part = c % KS, pairs = nt / 2, q = pairs / KS, r = pairs % KS;
        u.pm = 64 + (tile >> 2); u.pn = tile & 3; u.k0 = 2 * (part * q + (part < r ? part : r)); u.nkt = 2 * (q + (part < r ? 1 : 0)); u.atomic = 1 + c; return true;
    }
};

typedef __bf16 bf16x2_t __attribute__((ext_vector_type(2)));
typedef float f32x2_t __attribute__((ext_vector_type(2)));
__device__ __forceinline__ unsigned cvt_pk_bf16(float lo, float hi) { const f32x2_t v = {lo, hi}; const bf16x2_t b = __builtin_convertvector(v, bf16x2_t); return __builtin_bit_cast(unsigned, b); }

struct EpiFO {
    static constexpr bool PERM = true;
    bf16_t* C; int ldc; float* slab;
    __device__ __forceinline__ void operator()(const f32x4 (&acc)[2][2][4][2], const Unit& u, int wr, int wc, int fr, int fq) const {
        if (u.atomic == 0) {
            const int row0 = u.pm * BM + wr * 64 + fr; const int col0 = u.pn * BM + wc * 32 + 8 * fq;
#pragma unroll
            for (int ai = 0; ai < 2; ++ai)
#pragma unroll
                for (int m = 0; m < 4; ++m) { bf16_t* rowp = C + (size_t)(row0 + ai * HALF + m * 16) * ldc + col0;
#pragma unroll
                    for (int bj = 0; bj < 2; ++bj) { const f32x4 v0 = acc[ai][bj][m][0], v1 = acc[ai][bj][m][1];
                        u32x4 w; w.x = cvt_pk_bf16(v0[0], v0[1]); w.y = cvt_pk_bf16(v0[2], v0[3]); w.z = cvt_pk_bf16(v1[0], v1[1]); w.w = cvt_pk_bf16(v1[2], v1[3]);
                        *(u32x4*)(rowp + bj * HALF) = w; } }
        } else {
            float* base = slab + (size_t)(u.atomic - 1) * (BM * BM) + (size_t)(wr * 64 + fr) * BM + wc * 32 + 8 * fq;
#pragma unroll
            for (int ai = 0; ai < 2; ++ai)
#pragma unroll
                for (int m = 0; m < 4; ++m) { float* rowp = base + (size_t)(ai * HALF + m * 16) * BM;
#pragma unroll
                    for (int bj = 0; bj < 2; ++bj) { *(f32x4*)(rowp + bj * HALF) = acc[ai][bj][m][0]; *(f32x4*)(rowp + bj * HALF + 4) = acc[ai][bj][m][1]; } }
        }
    }
};
struct EpiBf16 {
    static constexpr bool PERM = true;
    bf16_t* O; int ldc;
    __device__ __forceinline__ void operator()(const f32x4 (&acc)[2][2][4][2], const Unit& u, int wr, int wc, int fr, int fq) const {
        const int row0 = u.pm * BM + wr * 64 + fr; const int col0 = u.pn * BM + wc * 32 + 8 * fq;
#pragma unroll
        for (int ai = 0; ai < 2; ++ai)
#pragma unroll
            for (int m = 0; m < 4; ++m) { bf16_t* rowp = O + (size_t)(row0 + ai * HALF + m * 16) * ldc + col0;
#pragma unroll
                for (int bj = 0; bj < 2; ++bj) { const f32x4 v0 = acc[ai][bj][m][0], v1 = acc[ai][bj][m][1];
                    u32x4 w; w.x = cvt_pk_bf16(v0[0], v0[1]); w.y = cvt_pk_bf16(v0[2], v0[3]); w.z = cvt_pk_bf16(v1[0], v1[1]); w.w = cvt_pk_bf16(v1[2], v1[3]);
                    *(u32x4*)(rowp + bj * HALF) = w; } }
    }
};
__device__ __forceinline__ float silu_f(float x) { return x * __builtin_amdgcn_rcpf(1.0f + __expf(-x)); }
struct EpiSwiGLU {
    static constexpr bool PERM = true;
    bf16_t* O; int ldc;
    __device__ __forceinline__ void operator()(const f32x4 (&acc)[2][2][4][2], const Unit& u, int wr, int wc, int fr, int fq) const {
        const int row0 = u.pm * BM + wr * 64 + fr; const int col0 = u.pn * HALF + wc * 32 + 8 * fq;
#pragma unroll
        for (int ai = 0; ai < 2; ++ai)
#pragma unroll
            for (int m = 0; m < 4; ++m) { bf16_t* rowp = O + (size_t)(row0 + ai * HALF + m * 16) * ldc + col0;
                float o[8];
#pragma unroll
                for (int n = 0; n < 2; ++n)
#pragma unroll
                    for (int j = 0; j < 4; ++j) o[n * 4 + j] = silu_f(acc[ai][0][m][n][j]) * acc[ai][1][m][n][j];
                u32x4 w; w.x = cvt_pk_bf16(o[0], o[1]); w.y = cvt_pk_bf16(o[2], o[3]); w.z = cvt_pk_bf16(o[4], o[5]); w.w = cvt_pk_bf16(o[6], o[7]);
                *(u32x4*)rowp = w; }
    }
};
struct EpiLora {
    static constexpr bool PERM = true;
    bf16_t* OMD; bf16_t* ASIG; bf16_t* G; const float* w0; const float* a0;
    template <int KIND> __device__ __forceinline__ void body(const f32x4 (&acc)[2][2][4][2], bf16_t* O, const float* bias, int row0, int ch0) const {
#pragma unroll
        for (int bj = 0; bj < 2; ++bj)
#pragma unroll
            for (int ai = 0; ai < 2; ++ai)
#pragma unroll
                for (int m = 0; m < 4; ++m) { bf16_t* rowp = O + (size_t)(row0 + ai * HALF + m * 16) * 512 + ch0 + bj * HALF;
                    float o[8];
#pragma unroll
                    for (int n = 0; n < 2; ++n)
#pragma unroll
                        for (int j = 0; j < 4; ++j) { float v = acc[ai][bj][m][n][j];
                            if (KIND == 0) { v += bias[ch0 + bj * HALF + n * 4 + j]; const float e = 0.6065306597126334f * __builtin_amdgcn_rcpf(1.0f + __expf(-v));
                                float p = 1.0f / 40320.0f; p = -1.0f / 5040.0f + e * p; p = 1.0f / 720.0f + e * p; p = -1.0f / 120.0f + e * p; p = 1.0f / 24.0f + e * p; p = -1.0f / 6.0f + e * p; p = 0.5f + e * p; p = 1.0f - e * p;
                                v = e * p; }
                            else if (KIND == 1) { v += bias[ch0 + bj * HALF + n * 4 + j]; v = __builtin_amdgcn_rcpf(1.0f + __expf(-v)); }
                            o[n * 4 + j] = v; }
                    u32x4 w; w.x = cvt_pk_bf16(o[0], o[1]); w.y = cvt_pk_bf16(o[2], o[3]); w.z = cvt_pk_bf16(o[4], o[5]); w.w = cvt_pk_bf16(o[6], o[7]);
                    *(u32x4*)rowp = w; __builtin_amdgcn_sched_barrier(0); }
    }
    __device__ __forceinline__ void operator()(const f32x4 (&acc)[2][2][4][2], const Unit& u, int wr, int wc, int fr, int fq) const {
        const int kind = u.pn >> 1;
        const int row0 = u.pm * BM + wr * 64 + fr; const int ch0 = (u.pn & 1) * BM + wc * 32 + 8 * fq;
        if (kind == 0) body<0>(acc, OMD, w0, row0, ch0); else if (kind == 1) body<1>(acc, ASIG, a0, row0, ch0); else body<2>(acc, G, a0, row0, ch0);
    }
};

template <class Epi, class Sched>
__device__ __forceinline__ void gemm_phase(PG8_LAS unsigned char* lds, const Gemm g, const Sched& S, const Epi& E, const int wv) {
    const int tid = fresh_tid(wv), wid = __builtin_amdgcn_readfirstlane(tid >> 6), lane = tid & 63, wr = wid >> 2, wc = wid & 3, fr = lane & 15, fq = lane >> 4;
    const int K = g.K;
    unsigned voffA[2], voffB[2];
#pragma unroll
    for (int i = 0; i < 2; ++i) { int R, C; stage_rc(tid * 16 + i * 8192, R, C); const int Rb = Epi::PERM ? ((R & ~31) + perm32(R & 31)) : R;
        voffA[i] = (unsigned)(R * K + C) * 2u; voffB[i] = (unsigned)(Rb * K + C) * 2u; }
    const size_t kstep = (size_t)(BK * 2);
    const size_t hstep = (size_t)HALF * K * 2;
    const size_t tstep = 2 * hstep;
    const unsigned ldsw = (unsigned)wid * 1024u;
    const int aoff = lds_byte(wr * 64 + fr, fq * 8), boff = lds_byte(wc * 32 + fr, fq * 8);
#define PG8_SA(b, h) (((b) * 2 + (h)) * HTB)
#define PG8_SB(b, h) ((4 + (b) * 2 + (h)) * HTB)
#define PG8_STAGE(bufoff, gbase, voff) do { _Pragma("unroll") for (int _i = 0; _i < 2; ++_i) \
        __builtin_amdgcn_global_load_lds((const unsigned*)((const char*)(gbase) + (voff)[_i]), (PG8_LAS unsigned*)(lds + (bufoff) + ldsw + _i * 8192), 16, 0, 0); } while (0)
#define PG8_LDA(dst, b, h) do { _Pragma("unroll") for (int m = 0; m < 4; ++m) _Pragma("unroll") for (int k = 0; k < 2; ++k) dst[m][k] = *(const PG8_LAS bf16x8*)(lds + PG8_SA(b, h) + aoff + m * 2048 + k * 1024); } while (0)
#define PG8_LDB(dst, b, h) do { _Pragma("unroll") for (int n = 0; n < 2; ++n) _Pragma("unroll") for (int k = 0; k < 2; ++k) dst[n][k] = *(const PG8_LAS bf16x8*)(lds + PG8_SB(b, h) + boff + n * 2048 + k * 1024); } while (0)
#define PG8_MMA(ai, bj, At, Bt) do { __builtin_amdgcn_s_setprio(1); _Pragma("unroll") for (int m = 0; m < 4; ++m) _Pragma("unroll") for (int n = 0; n < 2; ++n) _Pragma("unroll") for (int k = 0; k < 2; ++k) \
        acc[ai][bj][m][n] = __builtin_amdgcn_mfma_f32_16x16x32_bf16(Bt[n][k], At[m][k], acc[ai][bj][m][n], 0, 0, 0); __builtin_amdgcn_s_setprio(0); } while (0)
#define PG8_WAIT_V(n) asm volatile("s_waitcnt vmcnt(" #n ")" ::: "memory")
#define PG8_WAIT_L(n) asm volatile("s_waitcnt lgkmcnt(" #n ")" ::: "memory")
#define PG8_BAR __builtin_amdgcn_s_barrier()
#define PG8_SCHED __builtin_amdgcn_sched_barrier(0)
    Unit cur, nxt; int ui = 0;
    if (!S.next(0, cur)) return;
    f32x4 acc[2][2][4][2];
#pragma unroll
    for (int a = 0; a < 2; ++a)
#pragma unroll
        for (int b = 0; b < 2; ++b)
#pragma unroll
            for (int m = 0; m < 4; ++m)
#pragma unroll
                for (int n = 0; n < 2; ++n) acc[a][b][m][n] = (f32x4){0.f, 0.f, 0.f, 0.f};
    bf16x8 At[4][2], B0[2][2], B1[2][2];
    const char* cA = (const char*)g.A + (size_t)cur.pm * tstep + (size_t)cur.k0 * kstep; const char* cB = (const char*)g.Bt + (size_t)cur.pn * tstep + (size_t)cur.k0 * kstep;
    S.a_ready(cur);
    PG8_STAGE(PG8_SB(0, 0), cB, voffB); PG8_STAGE(PG8_SA(0, 0), cA, voffA); PG8_STAGE(PG8_SB(0, 1), cB + hstep, voffB); PG8_STAGE(PG8_SA(0, 1), cA + hstep, voffA);
    if (wr == 1) PG8_BAR;
    PG8_WAIT_V(4); PG8_BAR;
    PG8_STAGE(PG8_SB(1, 0), cB + kstep, voffB); PG8_STAGE(PG8_SA(1, 0), cA + kstep, voffA); PG8_STAGE(PG8_SB(1, 1), cB + hstep + kstep, voffB);
    PG8_WAIT_V(6); PG8_BAR;
    for (;;) {
        const bool has_next = S.next(ui + 1, nxt);
        const char* nA = has_next ? (const char*)g.A + (size_t)nxt.pm * tstep + (size_t)nxt.k0 * kstep : cA; const char* nB = has_next ? (const char*)g.Bt + (size_t)nxt.pn * tstep + (size_t)nxt.k0 * kstep : cB;
        const int nt = cur.nkt;
        for (int t = 0; t < nt; t += 2) {
            const bool last = (t == nt - 2);
            const char* a1 = cA + (size_t)(t + 1) * kstep;
            const char* a2 = last ? nA : cA + (size_t)(t + 2) * kstep; const char* b2 = last ? nB : cB + (size_t)(t + 2) * kstep;
            const char* a3 = a2 + kstep; const char* b3 = b2 + kstep;
            if (last && has_next) S.a_ready(nxt);
            PG8_LDB(B0, 0, 0); PG8_SCHED; PG8_LDA(At, 0, 0); PG8_STAGE(PG8_SA(1, 1), a1 + hstep, voffA);
            PG8_WAIT_L(8); PG8_BAR; PG8_WAIT_L(0); PG8_MMA(0, 0, At, B0); PG8_BAR; PG8_SCHED;
            PG8_LDB(B1, 0, 1); PG8_STAGE(PG8_SB(0, 0), b2, voffB);
            PG8_BAR; PG8_WAIT_L(0); PG8_MMA(0, 1, At, B1); PG8_BAR;
            PG8_LDA(At, 0, 1); PG8_STAGE(PG8_SA(0, 0), a2, voffA);
            PG8_BAR; PG8_WAIT_L(0); PG8_MMA(1, 0, At, B0); PG8_BAR; PG8_SCHED;
            PG8_STAGE(PG8_SB(0, 1), b2 + hstep, voffB);
            PG8_WAIT_V(6); PG8_BAR; PG8_MMA(1, 1, At, B1); PG8_BAR;
            PG8_LDB(B0, 1, 0); PG8_SCHED; PG8_LDA(At, 1, 0); PG8_STAGE(PG8_SA(0, 1), a2 + hstep, voffA);
            PG8_WAIT_L(8); PG8_BAR; PG8_WAIT_L(0); PG8_MMA(0, 0, At, B0); PG8_BAR; PG8_SCHED;
            PG8_LDB(B1, 1, 1); PG8_STAGE(PG8_SB(1, 0), b3, voffB);
            PG8_BAR; PG8_WAIT_L(0); PG8_MMA(0, 1, At, B1); PG8_BAR;
            PG8_LDA(At, 1, 1); PG8_STAGE(PG8_SA(1, 0), a3, voffA);
            PG8_BAR; PG8_WAIT_L(0); PG8_MMA(1, 0, At, B0); PG8_BAR; PG8_SCHED;
            PG8_STAGE(PG8_SB(1, 1), b3 + hstep, voffB);
            PG8_WAIT_V(6); PG8_BAR; PG8_MMA(1, 1, At, B1); PG8_BAR;
        }
        { const int l2 = fresh_tid(wv) & 63; E(acc, cur, wr, wc, l2 & 15, l2 >> 4); } S.done(cur);
        if (!has_next) break;
#pragma unroll
        for (int a = 0; a < 2; ++a)
#pragma unroll
            for (int b = 0; b < 2; ++b)
#pragma unroll
                for (int m = 0; m < 4; ++m)
#pragma unroll
                    for (int n = 0; n < 2; ++n) acc[a][b][m][n] = (f32x4){0.f, 0.f, 0.f, 0.f};
        cur = nxt; cA = nA; cB = nB; ++ui;
    }
    PG8_WAIT_V(0);
    if (wr == 0) PG8_BAR;
    PG8_BAR;
#undef PG8_SA
#undef PG8_SB
#undef PG8_STAGE
#undef PG8_LDA
#undef PG8_LDB
#undef PG8_MMA
#undef PG8_WAIT_V
#undef PG8_WAIT_L
#undef PG8_BAR
#undef PG8_SCHED
}
}

using pg8::bf16_t; using pg8::f32x4; using pg8::bf16x8; using pg8::u32x4; using pg8::u32x2;
#define LAS __attribute__((address_space(3)))

constexpr int D = 1024, DFF = 2816, NGU = 5632, NCOLS = 3840;
constexpr int MP = 16384, MS = 512, MT = 16896, MIN_ = 17152;
constexpr int LDS_BYTES = 147456;
constexpr size_t O_SHP = 17301504, O_WKP = O_SHP + 8192, O_RTP = O_WKP + 262144, O_SHS = O_RTP + 524288, O_WKS = O_SHS + 131072, O_RTS = O_WKS + 4194304;
constexpr size_t WS_ROPE = 16384;
constexpr size_t WS_WL   = WS_ROPE + 1050624;
constexpr size_t WS_WOUT = WS_WL + 786432;
constexpr size_t WS_WIN  = WS_WOUT + 2097152;
constexpr size_t WS_WGU  = WS_WIN + 7864320;
constexpr size_t WS_WD   = WS_WGU + 11534336;
constexpr size_t WS_XN   = WS_WD + 5767168;
constexpr size_t WS_BIG  = WS_XN + 35127296;
constexpr size_t WS_FO   = WS_BIG + 95158272;
constexpr size_t WS_YS   = WS_BIG + 131727360;
constexpr size_t WS_LA   = WS_YS + 17301504;
constexpr size_t WS_OMD  = WS_BIG + 164364288;
constexpr size_t WS_ASIG = WS_OMD + 17301504;
constexpr size_t WS_END  = WS_ASIG + 17301504;
static_assert(WS_LA + 8650752 <= WS_OMD, "mixer overlays");
static_assert(WS_END <= 268435456, "workspace");

struct Params {
    const float *x_prompt, *x_sample, *state_shift, *state_wkv, *state_ret, *norm_g, *f1g, *f1u, *f1d, *w_in, *mu, *w0, *w2, *a0, *a2, *g2, *k_k, *k_a, *r_k, *lnx_w, *lnx_b, *gn_w, *w_out, *f2g, *f2u, *f2d;
    float* out; unsigned char* ws;
};
#define CAS __attribute__((address_space(4)))
typedef const CAS Params& PR;

__device__ __forceinline__ float bf2f(unsigned b) { return __uint_as_float(b << 16); }
__device__ __forceinline__ bf16_t f2bf(float f) { unsigned u = __float_as_uint(f); u += 0x7FFFu + ((u >> 16) & 1u); return (bf16_t)(u >> 16); }
__device__ __forceinline__ float lo_bf(unsigned x) { return __uint_as_float(x << 16); }
__device__ __forceinline__ float hi_bf(unsigned x) { return __uint_as_float(x & 0xffff0000u); }
template <int CTRL> __device__ __forceinline__ float dppf(float v) { return __int_as_float(__builtin_amdgcn_update_dpp(0, __float_as_int(v), CTRL, 0xF, 0xF, false)); }
__device__ __forceinline__ float row16_sum(float v) { v += dppf<0xB1>(v); v += dppf<0x4E>(v); v += dppf<0x141>(v); v += dppf<0x140>(v); return v; }
__device__ __forceinline__ float wave_sum(float v) { v = row16_sum(v); const int i = __float_as_int(v);
    return __int_as_float(__builtin_amdgcn_readlane(i, 0)) + __int_as_float(__builtin_amdgcn_readlane(i, 16)) + __int_as_float(__builtin_amdgcn_readlane(i, 32)) + __int_as_float(__builtin_amdgcn_readlane(i, 48)); }
__device__ __forceinline__ float quad_sum(float v) { v += dppf<0xB1>(v); v += dppf<0x4E>(v); return v; }
__device__ __forceinline__ float sigmoid_f(float x) { return __builtin_amdgcn_rcpf(1.0f + __expf(-x)); }


#define XB_TMO      128
#define XB_XCNT(j)  (256  + 64 * (j))
#define XB_XSUB(j)  (1280 + 64 * (j))
#define XB_XGEN(j)  (2304 + 64 * (j))
#define XB_TOP      3328
#define XB_TOPGEN   3392
#define XCD_BAR_WORDS 3456
#define XB_SPIN_CAP (1u << 18)
__device__ __forceinline__ unsigned xb_ld(unsigned* p)              { return __hip_atomic_load(p, __ATOMIC_RELAXED, __HIP_MEMORY_SCOPE_AGENT); }
__device__ __forceinline__ unsigned xb_add(unsigned* p, unsigned v) { return __hip_atomic_fetch_add(p, v, __ATOMIC_RELAXED, __HIP_MEMORY_SCOPE_AGENT); }
__device__ __forceinline__ unsigned xb_xcc_id() { return (unsigned)__builtin_amdgcn_s_getreg((3 << 11) | 20) & 0xFu; }
#define XB_SPIN(cond, bar) do { unsigned _sp = 0; while (cond) { __builtin_amdgcn_s_sleep(1); \
    if ((++_sp & 255u) == 0u) { if (xb_ld(&(bar)[XB_TMO])) break; if (_sp > XB_SPIN_CAP) { atomicAdd(&(bar)[XB_TMO], 1u); break; } } } } while (0)
struct XcdBarrier { unsigned* bar; unsigned x; volatile LAS unsigned* st; };
__device__ __forceinline__ XcdBarrier xcd_barrier_post(unsigned* bar, volatile LAS unsigned* st) {
    XcdBarrier b; b.bar = bar; b.x = xb_xcc_id(); b.st = st;
    return b;
}
__device__ __forceinline__ void xcd_barrier_complete(unsigned* bar, unsigned x, unsigned& nloc, unsigned& nx) {
    const unsigned G = gridDim.x * gridDim.y * gridDim.z;
    unsigned sum, cnt, mine, sp = 0u;
    for (;;) {
        sum = 0u; cnt = 0u; mine = 0u;
#pragma unroll
        for (unsigned j = 0; j < 16; ++j) { const unsigned c = xb_ld(&bar[XB_XCNT(j)]); sum += c; cnt += (c > 0u) ? 1u : 0u; mine = (j == x) ? c : mine; }
        if (sum == G) break;
        __builtin_amdgcn_s_sleep(1);
        if ((++sp & 255u) == 0u) { if (xb_ld(&bar[XB_TMO])) break; if (sp > XB_SPIN_CAP) { atomicAdd(&bar[XB_TMO], 1u); break; } }
    }
    nloc = mine > 0u ? mine : 1u; nx = cnt > 0u ? cnt : 1u;
}
__device__ __forceinline__ void xcd_barrier(unsigned* barw, volatile LAS unsigned* stw, const int wv) {
    XcdBarrier b; b.bar = barw; b.x = xb_xcc_id(); b.st = stw;
    asm volatile("s_waitcnt vmcnt(0)" ::: "memory");
    __syncthreads();
    if (fresh_tid(wv) == 0) {
        unsigned* bar = b.bar;
        __builtin_amdgcn_s_waitcnt(0);
        unsigned nloc = b.st[0], nx = b.st[1];
        if (nloc == 0u) { xcd_barrier_complete(bar, b.x, nloc, nx); b.st[0] = nloc; b.st[1] = nx; }
        const unsigned old = xb_add(&bar[XB_XSUB(b.x)], 1u);
        const unsigned gen = old / nloc;
        if (old + 1u == (gen + 1u) * nloc) {
            __builtin_amdgcn_fence(__ATOMIC_RELEASE, "agent");
            asm volatile("s_waitcnt vmcnt(0)" ::: "memory");
            const unsigned og = xb_add(&bar[XB_TOP], 1u);
            const unsigned tg = og / nx;
            if (og + 1u == (tg + 1u) * nx) xb_add(&bar[XB_TOPGEN], 1u);
            else XB_SPIN(xb_ld(&bar[XB_TOPGEN]) == tg, bar);
            __builtin_amdgcn_fence(__ATOMIC_ACQUIRE, "agent");
            xb_add(&bar[XB_XGEN(b.x)], 1u);
            asm volatile("s_waitcnt vmcnt(0)" ::: "memory");
        } else {
            XB_SPIN(xb_ld(&bar[XB_XGEN(b.x)]) == gen, bar);
            __builtin_amdgcn_fence(__ATOMIC_ACQUIRE, "agent");
            asm volatile("s_waitcnt vmcnt(0)" ::: "memory");
        }
    }
    __syncthreads();
}


#define DPP2(x, y, CTRL, NOP) asm volatile(NOP "\n\tv_add_f32_dpp %0, %0, %0 " CTRL " row_mask:0xf bank_mask:0xf bound_ctrl:1\n\tv_add_f32_dpp %1, %1, %1 " CTRL " row_mask:0xf bank_mask:0xf bound_ctrl:1" : "+v"(x), "+v"(y))
#define DPP4(x, y, z, w, CTRL, NOP) asm volatile(NOP "\n\tv_add_f32_dpp %0, %0, %0 " CTRL " row_mask:0xf bank_mask:0xf bound_ctrl:1\n\tv_add_f32_dpp %1, %1, %1 " CTRL " row_mask:0xf bank_mask:0xf bound_ctrl:1\n\tv_add_f32_dpp %2, %2, %2 " CTRL " row_mask:0xf bank_mask:0xf bound_ctrl:1\n\tv_add_f32_dpp %3, %3, %3 " CTRL " row_mask:0xf bank_mask:0xf bound_ctrl:1" : "+v"(x), "+v"(y), "+v"(z), "+v"(w))
#define ROW16_SUM4(x, y, z, w) do { DPP4(x, y, z, w, "quad_perm:[1,0,3,2]", "s_nop 1"); DPP4(x, y, z, w, "quad_perm:[2,3,0,1]", ""); DPP4(x, y, z, w, "row_half_mirror", ""); DPP4(x, y, z, w, "row_mirror", ""); } while (0)
#define ROW16_SUM2(x, y) do { DPP2(x, y, "quad_perm:[1,0,3,2]", "s_nop 1"); DPP2(x, y, "quad_perm:[2,3,0,1]", "s_nop 0"); DPP2(x, y, "row_half_mirror", "s_nop 0"); DPP2(x, y, "row_mirror", "s_nop 0"); } while (0)
__device__ __forceinline__ int prev_row(int r) {
    if (r < MP) return (r & 2047) == 0 ? -1 : r - 1;
    const int s = r - MP; return (s & 3) == 0 ? MT + (s >> 2) : r - 1;
}

struct TDesc { const float* W; bf16_t* Bt; int K, N, k0, n0, brow0; };
__device__ __forceinline__ TDesc tconv_desc(const float* wg, const float* wu, const float* wd, const float* win, const float* wout, unsigned char* ws, int i) {
    TDesc d; int mode = 0, tile = i;
    if (i < 704) { d.W = wg; d.Bt = (bf16_t*)(ws + WS_WGU); d.K = 1024; d.N = DFF; mode = 1; }
    else if (i < 1408) { d.W = wu; d.Bt = (bf16_t*)(ws + WS_WGU); d.K = 1024; d.N = DFF; mode = 2; tile = i - 704; }
    else if (i < 2112) { d.W = wd; d.Bt = (bf16_t*)(ws + WS_WD); d.K = DFF; d.N = 1024; tile = i - 1408; }
    else if (i < 3072) { d.W = win; d.Bt = (bf16_t*)(ws + WS_WIN); d.K = 1024; d.N = NCOLS; tile = i - 2112; }
    else { d.W = wout; d.Bt = (bf16_t*)(ws + WS_WOUT); d.K = 1024; d.N = 1024; tile = i - 3072; }
    const int nkt = d.K / 64; const int kt = tile % nkt, nt = tile / nkt; d.k0 = kt * 64; d.n0 = nt * 64;
    d.brow0 = mode == 0 ? d.n0 : ((d.n0 >> 7) * 256 + (d.n0 & 127) + (mode == 2 ? 128 : 0));
    return d;
}
__device__ __forceinline__ void tconv_list(const float* wg, const float* wu, const float* wd, const float* win, const float* wout, unsigned char* ws, const int ntiles, LAS float* t, const int wv) {
    const int tid = fresh_tid(wv); const int G = gridDim.x;
    float cur[8], nxt[8];
    int i = blockIdx.x;
    if (i < ntiles) { const TDesc d = tconv_desc(wg, wu, wd, win, wout, ws, i);
#pragma unroll
        for (int e = 0; e < 8; ++e) { const int idx = e * 512 + tid, r = idx >> 6, c = idx & 63; cur[e] = d.W[(size_t)(d.k0 + r) * d.N + d.n0 + c]; } }
    for (; i < ntiles; i += G) {
        const TDesc d = tconv_desc(wg, wu, wd, win, wout, ws, i);
        { const TDesc dn = tconv_desc(wg, wu, wd, win, wout, ws, i + G < ntiles ? i + G : i);
#pragma unroll
            for (int e = 0; e < 8; ++e) { const int idx = e * 512 + tid, r = idx >> 6, c = idx & 63; nxt[e] = dn.W[(size_t)(dn.k0 + r) * dn.N + dn.n0 + c]; } }
#pragma unroll
        for (int e = 0; e < 8; ++e) { const int idx = e * 512 + tid, r = idx >> 6, c = idx & 63; t[r * 65 + c] = cur[e]; }
        __syncthreads();
#pragma unroll
        for (int e = 0; e < 4; ++e) { const int idx = e * 512 + tid, n = idx >> 5, kp = idx & 31;
            const unsigned w = pg8::cvt_pk_bf16(t[(2 * kp) * 65 + n], t[(2 * kp + 1) * 65 + n]);
            *(unsigned*)(d.Bt + (size_t)(d.brow0 + n) * d.K + d.k0 + 2 * kp) = w; }
        __syncthreads();
#pragma unroll
        for (int e = 0; e < 8; ++e) cur[e] = nxt[e];
    }
}

struct RowRaw { float4 xf[4]; u32x2 xb[4]; u32x2 fb[4]; };
__device__ __forceinline__ void rows_load(PR P, const int mode, const int row, const int lane, RowRaw& R) {
    if (mode <= 1) { const float* xin = P.x_prompt + (size_t)row * 1024;
#pragma unroll
        for (int q = 0; q < 4; ++q) R.xf[q] = *(const float4*)(xin + (q * 64 + lane) * 4); }
    else { const bf16_t* xb = (mode == 2 ? (const bf16_t*)P.out : (const bf16_t*)(P.ws + WS_FO + 34603008)) + (size_t)row * 1024;
#pragma unroll
        for (int q = 0; q < 4; ++q) R.xb[q] = *(const u32x2*)(xb + (q * 64 + lane) * 4); }
    if (mode != 0) { const bf16_t* FO = (const bf16_t*)(P.ws + WS_FO) + (size_t)row * 1024;
#pragma unroll
        for (int q = 0; q < 4; ++q) R.fb[q] = *(const u32x2*)(FO + (q * 64 + lane) * 4); }
}
__device__ __forceinline__ void rows_proc(PR P, const int mode, const int row, const int lane, float4 (&xv)[4], const float4 (&fo)[4], const float4 (&gp)[4], const float4 (&gn)[4]) {
    bf16_t* XN = (bf16_t*)(P.ws + WS_XN);
    if (mode != 0) {
        float ss = 0.f;
#pragma unroll
        for (int q = 0; q < 4; ++q) ss += fo[q].x * fo[q].x + fo[q].y * fo[q].y + fo[q].z * fo[q].z + fo[q].w * fo[q].w;
        ss = wave_sum(ss); const float r = rsqrtf(ss * (1.0f / 1024.0f) + 1e-6f) * (mode == 2 ? 1.0f : 0.5f);
#pragma unroll
        for (int q = 0; q < 4; ++q) {
            xv[q].x += fo[q].x * r * gp[q].x; xv[q].y += fo[q].y * r * gp[q].y; xv[q].z += fo[q].z * r * gp[q].z; xv[q].w += fo[q].w * r * gp[q].w;
            if (mode == 3) *(float4*)(P.out + (size_t)row * 1024 + (q * 64 + lane) * 4) = xv[q];
            else { bf16_t* xo = (mode == 1 ? (bf16_t*)P.out : (bf16_t*)(P.ws + WS_FO + 34603008)) + (size_t)row * 1024; u32x2 t; t.x = pg8::cvt_pk_bf16(xv[q].x, xv[q].y); t.y = pg8::cvt_pk_bf16(xv[q].z, xv[q].w);
                *(u32x2*)(xo + (q * 64 + lane) * 4) = t; } }
        if (mode == 3) return;
    }
    float ss2 = 0.f;
#pragma unroll
    for (int q = 0; q < 4; ++q) ss2 += xv[q].x * xv[q].x + xv[q].y * xv[q].y + xv[q].z * xv[q].z + xv[q].w * xv[q].w;
    ss2 = wave_sum(ss2); const float r2 = rsqrtf(ss2 * (1.0f / 1024.0f) + 1e-6f);
    float* sh = nullptr;
    if (mode == 1) { if (row < MP) { if ((row & 2047) == 2047) sh = P.out + O_SHP + (size_t)(row >> 11) * 1024; } else { const int s = row - MP; if ((s & 3) == 3) sh = P.out + O_SHS + (size_t)(s >> 2) * 1024; } }
#pragma unroll
    for (int q = 0; q < 4; ++q) {
        float4 hv; hv.x = xv[q].x * r2 * gn[q].x; hv.y = xv[q].y * r2 * gn[q].y; hv.z = xv[q].z * r2 * gn[q].z; hv.w = xv[q].w * r2 * gn[q].w;
        u32x2 w; w.x = pg8::cvt_pk_bf16(hv.x, hv.y); w.y = pg8::cvt_pk_bf16(hv.z, hv.w);
        *(u32x2*)(XN + (size_t)row * 1024 + (q * 64 + lane) * 4) = w;
        if (sh) *(float4*)(sh + (q * 64 + lane) * 4) = hv; }
}
__device__ __forceinline__ void rows_phase(PR P, const int mode, const int wv) {
    const int tid = fresh_tid(wv); const int lane = tid & 63; const int gw = blockIdx.x * 8 + (tid >> 6), nw = gridDim.x * 8;
    const float* gpost = P.norm_g + (mode == 1 ? 1 : (mode == 2 ? 3 : 5)) * 1024;
    const float* gnext = P.norm_g + (mode == 0 ? 0 : (mode == 1 ? 2 : 4)) * 1024;
    float4 gp[4], gn[4];
#pragma unroll
    for (int q = 0; q < 4; ++q) { gp[q] = *(const float4*)(gpost + (q * 64 + lane) * 4); gn[q] = *(const float4*)(gnext + (q * 64 + lane) * 4); }
    if (gw < MP) {
        const int last = gw + ((MP - 1 - gw) / nw) * nw;
        RowRaw R, N;
        rows_load(P, mode, gw, lane, R);
        for (int row = gw; row < MP; row += nw) {
            const int nrow = row + nw < MP ? row + nw : last;
            rows_load(P, mode, nrow, lane, N);
            float4 xv[4], fo[4];
#pragma unroll
            for (int q = 0; q < 4; ++q) {
                xv[q] = mode <= 1 ? R.xf[q] : make_float4(lo_bf(R.xb[q].x), hi_bf(R.xb[q].x), lo_bf(R.xb[q].y), hi_bf(R.xb[q].y));
                fo[q] = make_float4(lo_bf(R.fb[q].x), hi_bf(R.fb[q].x), lo_bf(R.fb[q].y), hi_bf(R.fb[q].y)); }
            rows_proc(P, mode, row, lane, xv, fo, gp, gn);
            R = N;
        }
    }
    for (int row = MP + gw; row < MT; row += nw) {
        float4 xv[4], fo[4];
        if (mode <= 1) { const float* xin = P.x_sample + (size_t)(row - MP) * 1024;
#pragma unroll
            for (int q = 0; q < 4; ++q) xv[q] = *(const float4*)(xin + (q * 64 + lane) * 4); }
        else { const bf16_t* xb = (mode == 2 ? (const bf16_t*)P.out : (const bf16_t*)(P.ws + WS_FO + 34603008)) + (size_t)row * 1024;
#pragma unroll
            for (int q = 0; q < 4; ++q) { const u32x2 t = *(const u32x2*)(xb + (q * 64 + lane) * 4); xv[q] = make_float4(lo_bf(t.x), hi_bf(t.x), lo_bf(t.y), hi_bf(t.y)); } }
        if (mode != 0) {
#pragma unroll
            for (int q = 0; q < 4; ++q) { const int KS = mode == 2 ? 4 : 8; const float* sl = (const float*)(P.ws + WS_OMD) + (size_t)((((row - MP) >> 8) * 4 + q) * KS) * 65536 + (size_t)(row & 255) * 256 + lane * 4;
                float4 a = *(const float4*)sl;
                for (int p = 1; p < KS; ++p) { const float4 b = *(const float4*)(sl + (size_t)p * 65536); a.x += b.x; a.y += b.y; a.z += b.z; a.w += b.w; }
                fo[q] = a; } }
        else {
#pragma unroll
            for (int q = 0; q < 4; ++q) fo[q] = make_float4(0.f, 0.f, 0.f, 0.f); }
        rows_proc(P, mode, row, lane, xv, fo, gp, gn);
    }
}

__device__ __forceinline__ void p0_prologue(PR P, LAS float* ldsf, const int wv) {
    const int tid = fresh_tid(wv); const size_t gt = (size_t)blockIdx.x * 512 + tid, nth = (size_t)gridDim.x * 512;
    { float* rc = (float*)(P.ws + WS_ROPE); float* rs = rc + 2052 * 64;
      for (size_t i = gt; i < 2052 * 64; i += nth) { const int p = (int)(i >> 6), f = (int)(i & 63); const int pos = p < 2048 ? p : 16384 + (p - 2048);
          double inv = 1.0; for (int q = 0; q < f; ++q) inv *= 0.8659643233600653;
          const double ang = (double)pos * inv; const double n = rint(ang * 0.15915494309189535); const double r = ang - n * 6.283185307179586;
          const double r2 = r * r; double s = 0.0, c = 0.0;
          for (int k = 14; k >= 0; --k) { s = s * (-r2 / (double)((2 * k + 2) * (2 * k + 3))) + 1.0; c = c * (-r2 / (double)((2 * k + 1) * (2 * k + 2))) + 1.0; }
          rc[i] = (float)c; rs[i] = (float)(s * r); } }
    { bf16_t* Wl = (bf16_t*)(P.ws + WS_WL);
      for (size_t i = gt; i < 1536 * 256; i += nth) { const int n = (int)(i >> 8), k = (int)(i & 255); float v = 0.f;
          if (n < 512) { if (k < 64) v = P.w2[k * 512 + n]; } else if (n < 1024) { if (k >= 64 && k < 128) v = P.a2[(k - 64) * 512 + (n - 512)]; } else { if (k >= 128) v = P.g2[(k - 128) * 512 + (n - 1024)]; }
          Wl[i] = f2bf(v); } }
    { bf16_t* XN = (bf16_t*)(P.ws + WS_XN);
      for (size_t i = gt; i < 256 * 1024; i += nth) { const int r = (int)(i >> 10); XN[(size_t)MT * 1024 + i] = r < 128 ? f2bf(P.state_shift[i]) : (bf16_t)0; } }
    tconv_list(P.f1g, P.f1u, P.f1d, P.w_in, P.w_out, P.ws, 3328, ldsf, wv);
    rows_phase(P, 0, wv);
}

__device__ __forceinline__ void lora_prep(PR P, const int wv) {
    const int tid = fresh_tid(wv); const int lane = tid & 63; const int gw = blockIdx.x * 8 + (tid >> 6), nw = gridDim.x * 8;
    const bf16_t* PS = (const bf16_t*)(P.ws + WS_BIG); bf16_t* LA = (bf16_t*)(P.ws + WS_LA);
    const float4 mu = *(const float4*)(P.mu + 1536 + lane * 4); const int kind = lane >> 4;
    if (gw >= MT) return;
    const int last = gw + ((MT - 1 - gw) / nw) * nw;
    u32x2 c, p, nc, np;
    { const int pr = prev_row(gw); c = *(const u32x2*)(PS + (size_t)gw * NCOLS + 1536 + lane * 4); p = *(const u32x2*)(PS + (size_t)(pr >= 0 ? pr : gw) * NCOLS + 1536 + lane * 4); }
    for (int row = gw; row < MT; row += nw) {
        const int nrow = row + nw < MT ? row + nw : last; const int npr = prev_row(nrow);
        nc = *(const u32x2*)(PS + (size_t)nrow * NCOLS + 1536 + lane * 4); np = *(const u32x2*)(PS + (size_t)(npr >= 0 ? npr : nrow) * NCOLS + 1536 + lane * 4);
        if (prev_row(row) < 0) p = (u32x2){0u, 0u};
        float v[4]; const float cu[4] = {lo_bf(c.x), hi_bf(c.x), lo_bf(c.y), hi_bf(c.y)}, pv[4] = {lo_bf(p.x), hi_bf(p.x), lo_bf(p.y), hi_bf(p.y)}, m4[4] = {mu.x, mu.y, mu.z, mu.w};
#pragma unroll
        for (int j = 0; j < 4; ++j) { float x = cu[j] + (pv[j] - cu[j]) * m4[j];
            if (kind == 0) x = 1.0f - 2.0f * __builtin_amdgcn_rcpf(__expf(2.0f * x) + 1.0f); else if (kind >= 2) x = sigmoid_f(x);
            v[j] = x; }
        u32x2 w; w.x = pg8::cvt_pk_bf16(v[0], v[1]); w.y = pg8::cvt_pk_bf16(v[2], v[3]);
        *(u32x2*)(LA + (size_t)row * 256 + lane * 4) = w;
        c = nc; p = np;
    }
}

template <bool SAMPLE>
__device__ __forceinline__ void rwkv_unit(PR P, LAS float* lds, const int b, const int h, const int half, const int wv) {
    constexpr int T = SAMPLE ? 4 : 2048, TC = SAMPLE ? 4 : 32, NCH = T / TC;
    const int tid = fresh_tid(wv), lane = tid & 63, wid = tid >> 6;
    const bf16_t* PS = (const bf16_t*)(P.ws + WS_BIG); const bf16_t* OMD = (const bf16_t*)(P.ws + WS_OMD); const bf16_t* ASIG = (const bf16_t*)(P.ws + WS_ASIG);
    bf16_t* YS = (bf16_t*)(P.ws + WS_YS);
    const int row_base = SAMPLE ? MP + b * 4 : b * 2048;
    const int ltok = (tid - 256) >> 4, lcg = tid & 15; const bool lwave = tid >= 256; const int hch = h * 64 + lcg * 4;
    const float4 mur = *(const float4*)(P.mu + hch), muk = *(const float4*)(P.mu + 512 + hch), muv = *(const float4*)(P.mu + 1024 + hch);
    const float4 kk4 = *(const float4*)(P.k_k + hch), ka4 = *(const float4*)(P.k_a + hch);
    typedef float f32x2 __attribute__((ext_vector_type(2)));
    const int row0 = half * 32 + (wid & 3) * 8 + (lane >> 4) * 2, cgl = lane & 15, j0 = cgl * 4;
    f32x2 S[4];
#pragma unroll
    for (int c = 0; c < 4; ++c) S[c] = (f32x2){0.f, 0.f};
    float* sout = P.out + (SAMPLE ? O_WKS : O_WKP) + ((size_t)(b * 8 + h) * 64 + row0) * 64 + j0;
    if (SAMPLE && wid < 4) { const float* sp = P.state_wkv + ((size_t)(b * 8 + h) * 64 + row0) * 64 + j0; const float4 s0 = *(const float4*)sp, s1 = *(const float4*)(sp + 64);
        S[0] = (f32x2){s0.x, s1.x}; S[1] = (f32x2){s0.y, s1.y}; S[2] = (f32x2){s0.z, s1.z}; S[3] = (f32x2){s0.w, s1.w}; }
    LAS float* buf0 = lds; LAS float* buf1 = lds + TC * 384;
    u32x2 cr[2], ck[2], cv[2], pr[2], pk[2], pv[2], co[2], ca[2];
#define RW_LOAD1(c, U) do { if (lwave && ltok + 16 * (U) < TC) { const int t_ = (c) * TC + ltok + 16 * (U); const int row_ = row_base + t_; const int prow_ = SAMPLE ? (t_ == 0 ? MT + b : row_ - 1) : row_ - 1; \
        const bf16_t* cp_ = PS + (size_t)row_ * NCOLS + hch; cr[U] = *(const u32x2*)cp_; ck[U] = *(const u32x2*)(cp_ + 512); cv[U] = *(const u32x2*)(cp_ + 1024); \
        if (SAMPLE || t_ > 0) { const bf16_t* pp_ = PS + (size_t)prow_ * NCOLS + hch; pr[U] = *(const u32x2*)pp_; pk[U] = *(const u32x2*)(pp_ + 512); pv[U] = *(const u32x2*)(pp_ + 1024); } \
        else { pr[U] = (u32x2){0u, 0u}; pk[U] = pr[U]; pv[U] = pr[U]; } \
        co[U] = *(const u32x2*)(OMD + (size_t)row_ * 512 + hch); ca[U] = *(const u32x2*)(ASIG + (size_t)row_ * 512 + hch); } } while (0)
#define RW_LOAD(c) do { RW_LOAD1(c, 0); RW_LOAD1(c, 1); } while (0)
#define RW_MIX(cu, pv_, m) ((cu) + ((pv_) - (cu)) * (m))
#define RW_PROC1(dst, U) do { if (lwave && ltok + 16 * (U) < TC) { LAS float* d_ = (dst) + (ltok + 16 * (U)) * 384 + lcg * 4; \
        f32x4 r_, k_, v_, o_, a_; \
        r_[0] = RW_MIX(lo_bf(cr[U].x), lo_bf(pr[U].x), mur.x); r_[1] = RW_MIX(hi_bf(cr[U].x), hi_bf(pr[U].x), mur.y); r_[2] = RW_MIX(lo_bf(cr[U].y), lo_bf(pr[U].y), mur.z); r_[3] = RW_MIX(hi_bf(cr[U].y), hi_bf(pr[U].y), mur.w); \
        k_[0] = RW_MIX(lo_bf(ck[U].x), lo_bf(pk[U].x), muk.x); k_[1] = RW_MIX(hi_bf(ck[U].x), hi_bf(pk[U].x), muk.y); k_[2] = RW_MIX(lo_bf(ck[U].y), lo_bf(pk[U].y), muk.z); k_[3] = RW_MIX(hi_bf(ck[U].y), hi_bf(pk[U].y), muk.w); \
        v_[0] = RW_MIX(lo_bf(cv[U].x), lo_bf(pv[U].x), muv.x); v_[1] = RW_MIX(hi_bf(cv[U].x), hi_bf(pv[U].x), muv.y); v_[2] = RW_MIX(lo_bf(cv[U].y), lo_bf(pv[U].y), muv.z); v_[3] = RW_MIX(hi_bf(cv[U].y), hi_bf(pv[U].y), muv.w); \
        o_[0] = lo_bf(co[U].x); o_[1] = hi_bf(co[U].x); o_[2] = lo_bf(co[U].y); o_[3] = hi_bf(co[U].y); a_[0] = lo_bf(ca[U].x); a_[1] = hi_bf(ca[U].x); a_[2] = lo_bf(ca[U].y); a_[3] = hi_bf(ca[U].y); \
        f32x4 kk_; kk_[0] = k_[0] * kk4.x; kk_[1] = k_[1] * kk4.y; kk_[2] = k_[2] * kk4.z; kk_[3] = k_[3] * kk4.w; \
        float ss_ = kk_[0] * kk_[0] + kk_[1] * kk_[1] + kk_[2] * kk_[2] + kk_[3] * kk_[3]; ss_ = row16_sum(ss_); \
        const float inv_ = __builtin_amdgcn_rcpf(fmaxf(__builtin_amdgcn_sqrtf(ss_), 1e-12f)); kk_ = kk_ * inv_; \
        f32x4 kn_; kn_[0] = k_[0] * (1.0f + (a_[0] - 1.0f) * ka4.x); kn_[1] = k_[1] * (1.0f + (a_[1] - 1.0f) * ka4.y); kn_[2] = k_[2] * (1.0f + (a_[2] - 1.0f) * ka4.z); kn_[3] = k_[3] * (1.0f + (a_[3] - 1.0f) * ka4.w); \
        *(LAS f32x4*)(d_) = r_; *(LAS f32x4*)(d_ + 64) = o_; *(LAS f32x4*)(d_ + 128) = kn_; *(LAS f32x4*)(d_ + 192) = -kk_; *(LAS f32x4*)(d_ + 256) = kk_ * a_; *(LAS f32x4*)(d_ + 320) = v_; } } while (0)
#define RW_PROC(dst) do { RW_PROC1(dst, 0); RW_PROC1(dst, 1); } while (0)
    RW_LOAD(0); RW_PROC(buf0); __syncthreads();
    for (int c = 0; c < NCH; ++c) {
        LAS float* cur = (c & 1) ? buf1 : buf0; LAS float* nxt = (c & 1) ? buf0 : buf1;
        if (c + 1 < NCH) RW_LOAD(c + 1);
        if (wid < 4) {
            constexpr int GS = SAMPLE ? 4 : 16;
            for (int g = 0; g < TC / GS; ++g) {
                float yk0 = 0.f, yk1 = 0.f;
                const LAS float* q0 = cur + (g * GS) * 384;
                f32x4 r4 = *(const LAS f32x4*)(q0 + j0), o4 = *(const LAS f32x4*)(q0 + 64 + j0), k4 = *(const LAS f32x4*)(q0 + 128 + j0), a4 = *(const LAS f32x4*)(q0 + 192 + j0), b4 = *(const LAS f32x4*)(q0 + 256 + j0);
                f32x2 v2 = *(const LAS f32x2*)(q0 + 320 + row0);
                float py0 = 0.f, py1 = 0.f;
#pragma unroll
                for (int tt = 0; tt < GS; ++tt) {
                    const LAS float* qn = q0 + (tt + 1 < GS ? tt + 1 : tt) * 384;
                    const f32x4 nr4 = *(const LAS f32x4*)(qn + j0), no4 = *(const LAS f32x4*)(qn + 64 + j0), nk4 = *(const LAS f32x4*)(qn + 128 + j0), na4 = *(const LAS f32x4*)(qn + 192 + j0), nb4 = *(const LAS f32x4*)(qn + 256 + j0);
                    const f32x2 nv2 = *(const LAS f32x2*)(qn + 320 + row0);
                    f32x2 sa = (S[0] * a4[0] + S[1] * a4[1]) + (S[2] * a4[2] + S[3] * a4[3]);
                    float sx = sa.x, sy = sa.y; ROW16_SUM4(sx, sy, py0, py1); sa = (f32x2){sx, sy};
                    if (tt > 0) { yk0 = cgl == tt - 1 ? py0 : yk0; yk1 = cgl == tt - 1 ? py1 : yk1; }
#pragma unroll
                    for (int c = 0; c < 4; ++c) { f32x2 t = S[c] - S[c] * o4[c]; t = t + sa * b4[c]; S[c] = t + v2 * k4[c]; }
                    const f32x2 y = (S[0] * r4[0] + S[1] * r4[1]) + (S[2] * r4[2] + S[3] * r4[3]);
                    py0 = y.x; py1 = y.y;
                    r4 = nr4; o4 = no4; k4 = nk4; a4 = na4; b4 = nb4; v2 = nv2;
                }
                ROW16_SUM2(py0, py1); yk0 = cgl == GS - 1 ? py0 : yk0; yk1 = cgl == GS - 1 ? py1 : yk1;
                if (cgl < GS) *(unsigned*)(YS + (size_t)(row_base + c * TC + g * GS + cgl) * 512 + h * 64 + row0) = pg8::cvt_pk_bf16(yk0, yk1);
            }
        }
        if (c + 1 < NCH) RW_PROC(nxt);
        __syncthreads();
    }
    if (wid < 4) { *(float4*)sout = make_float4(S[0].x, S[1].x, S[2].x, S[3].x); *(float4*)(sout + 64) = make_float4(S[0].y, S[1].y, S[2].y, S[3].y); }
#undef RW_LOAD
#undef RW_PROC
#undef RW_LOAD1
#undef RW_PROC1
#undef RW_MIX
}

__device__ __forceinline__ void ret_sample_unit(PR P, LAS float* lds, const int b, const int h, const int wv) {
    const int tid = fresh_tid(wv), lane = tid & 63, wid = tid >> 6;
    const bf16_t* PS = (const bf16_t*)(P.ws + WS_BIG); bf16_t* Y = (bf16_t*)(P.ws + WS_XN);
    const float* rc = (const float*)(P.ws + WS_ROPE); const float* rs = rc + 2052 * 64;
    LAS float* q = lds; LAS float* k = lds + 512; LAS float* v = lds + 1024; LAS float* Pm = lds + 1536; LAS float* y2p = lds + 1600; LAS float* red = lds + 1600 + 2048;
    const float lg2 = log2f(1.0f - exp2f(-5.0f - (float)h));
    const int row0 = MP + b * 4;
    { const int t = (tid & 255) >> 6, f = tid & 63; const bf16_t* src = PS + (size_t)(row0 + t) * NCOLS + 1792 + h * 128;
      if (tid < 256) { const float cs = rc[(2048 + t) * 64 + f], sn = rs[(2048 + t) * 64 + f];
          const float q1 = bf2f(src[f]), q2 = bf2f(src[f + 64]); q[t * 128 + f] = q1 * cs - q2 * sn; q[t * 128 + f + 64] = q1 * sn + q2 * cs;
          const float k1 = bf2f(src[512 + f]), k2 = bf2f(src[512 + f + 64]); k[t * 128 + f] = (k1 * cs - k2 * sn) * 0.08838834764831845f; k[t * 128 + f + 64] = (k1 * sn + k2 * cs) * 0.08838834764831845f; }
      else { v[t * 128 + f] = bf2f(src[1024 + f]); v[t * 128 + f + 64] = bf2f(src[1024 + f + 64]); } }
    __syncthreads();
    if (wid == 0) { const int pi = lane >> 4, pj = (lane >> 2) & 3, part = lane & 3; float s = 0.f;
        for (int d = part * 32; d < part * 32 + 32; ++d) s += q[pi * 128 + d] * k[pj * 128 + d];
        s = quad_sum(s); if (part == 0) Pm[pi * 4 + pj] = pi >= pj ? s * exp2f(lg2 * (float)(pi - pj)) : 0.f; }
    { const int e = tid & 127, dg = tid >> 7; const float c4 = exp2f(lg2 * 4.0f), g3 = exp2f(lg2 * 3.0f), g2_ = exp2f(lg2 * 2.0f), g1 = exp2f(lg2);
      const float v0 = v[e] * g3, v1 = v[128 + e] * g2_, v2 = v[256 + e] * g1, v3 = v[384 + e];
      const float* S0 = P.state_ret + ((size_t)(b * 4 + h) * 128) * 128 + e; float* So = P.out + O_RTS + ((size_t)(b * 4 + h) * 128) * 128 + e;
      float a0 = 0.f, a1 = 0.f, a2 = 0.f, a3 = 0.f;
      float sv[32];
#pragma unroll
      for (int x = 0; x < 32; ++x) sv[x] = S0[(size_t)(dg * 32 + x) * 128];
#pragma unroll
      for (int x = 0; x < 32; ++x) { const int d = dg * 32 + x; const float s = sv[x];
          a0 = fmaf(q[d], s, a0); a1 = fmaf(q[128 + d], s, a1); a2 = fmaf(q[256 + d], s, a2); a3 = fmaf(q[384 + d], s, a3);
          So[(size_t)d * 128] = s * c4 + k[d] * v0 + k[128 + d] * v1 + k[256 + d] * v2 + k[384 + d] * v3; }
      y2p[(dg * 4 + 0) * 128 + e] = a0; y2p[(dg * 4 + 1) * 128 + e] = a1; y2p[(dg * 4 + 2) * 128 + e] = a2; y2p[(dg * 4 + 3) * 128 + e] = a3; }
    __syncthreads();
    { const int i = tid >> 7, e = tid & 127;
      float y = (y2p[(0 + i) * 128 + e] + y2p[(4 + i) * 128 + e] + y2p[(8 + i) * 128 + e] + y2p[(12 + i) * 128 + e]) * exp2f(lg2 * (float)(i + 1));
#pragma unroll
      for (int j = 0; j < 4; ++j) y = fmaf(Pm[i * 4 + j], v[j * 128 + e], y);
      float s = wave_sum(y); if (lane == 0) red[wid] = s; __syncthreads();
      const float mean = (red[i * 2] + red[i * 2 + 1]) * (1.0f / 128.0f); const float dlt = y - mean;
      float s2 = wave_sum(dlt * dlt); if (lane == 0) red[8 + wid] = s2; __syncthreads();
      const float var = (red[8 + i * 2] + red[8 + i * 2 + 1]) * (1.0f / 128.0f);
      const float g = bf2f(PS[(size_t)(row0 + i) * NCOLS + 1792 + 1536 + h * 128 + e]);
      const float o = dlt * rsqrtf(var + 1e-5f) * P.gn_w[h * 128 + e] * (g * __builtin_amdgcn_rcpf(1.0f + __expf(-g)));
      Y[(size_t)(row0 + i) * 1024 + 512 + h * 128 + e] = f2bf(o); }
    __syncthreads();
}

__device__ __forceinline__ bf16_t* kvb_ptr(unsigned char* ws, int bh) { return (bf16_t*)(bh < 29 ? ws + WS_LA + (size_t)bh * 524288 : ws + WS_WIN + 17301504 + (size_t)(bh - 29) * 524288); }
constexpr int RS = 136, BUFE = 128 * RS;

template <bool WITH_K>
__device__ __forceinline__ void ret_load_qk(PR P, LAS bf16_t* QP, LAS bf16_t* KB, unsigned (&kth)[4][4], const int tidv, const int row0, const int n, const int h, const float kd0, const float g32) {
    const bf16_t* PS = (const bf16_t*)(P.ws + WS_BIG); const float* rc = (const float*)(P.ws + WS_ROPE); const float* rs = rc + 2052 * 64;
    float kd = kd0;
#pragma unroll
    for (int it = 0; it < 4; ++it) { const int idx = it * 512 + tidv, i = idx >> 4, f = (idx & 15) * 4;
        const bf16_t* src = PS + (size_t)(row0 + i) * NCOLS + 1792 + h * 128;
        const u32x2 q1 = *(const u32x2*)(src + f), q2 = *(const u32x2*)(src + 64 + f);
        u32x2 k1 = (u32x2){0u, 0u}, k2 = k1; if (WITH_K) { k1 = *(const u32x2*)(src + 512 + f); k2 = *(const u32x2*)(src + 576 + f); }
        const float4 cs = *(const float4*)(rc + (size_t)(n * 128 + i) * 64 + f), sn = *(const float4*)(rs + (size_t)(n * 128 + i) * 64 + f);
        const float c4[4] = {cs.x, cs.y, cs.z, cs.w}, s4[4] = {sn.x, sn.y, sn.z, sn.w};
        const float qa[4] = {lo_bf(q1.x), hi_bf(q1.x), lo_bf(q1.y), hi_bf(q1.y)}, qb[4] = {lo_bf(q2.x), hi_bf(q2.x), lo_bf(q2.y), hi_bf(q2.y)};
        float qo1[4], qo2[4];
#pragma unroll
        for (int x = 0; x < 4; ++x) { qo1[x] = qa[x] * c4[x] - qb[x] * s4[x]; qo2[x] = qa[x] * s4[x] + qb[x] * c4[x]; }
        u32x2 w; w.x = pg8::cvt_pk_bf16(qo1[0], qo1[1]); w.y = pg8::cvt_pk_bf16(qo1[2], qo1[3]); *(LAS u32x2*)(QP + i * RS + f) = w;
        w.x = pg8::cvt_pk_bf16(qo2[0], qo2[1]); w.y = pg8::cvt_pk_bf16(qo2[2], qo2[3]); *(LAS u32x2*)(QP + i * RS + 64 + f) = w;
        if (WITH_K) {
            const float ka[4] = {lo_bf(k1.x), hi_bf(k1.x), lo_bf(k1.y), hi_bf(k1.y)}, kb[4] = {lo_bf(k2.x), hi_bf(k2.x), lo_bf(k2.y), hi_bf(k2.y)};
            float ko1[4], ko2[4];
#pragma unroll
            for (int x = 0; x < 4; ++x) { ko1[x] = (ka[x] * c4[x] - kb[x] * s4[x]) * 0.08838834764831845f; ko2[x] = (ka[x] * s4[x] + kb[x] * c4[x]) * 0.08838834764831845f; }
            w.x = pg8::cvt_pk_bf16(ko1[0], ko1[1]); w.y = pg8::cvt_pk_bf16(ko1[2], ko1[3]); *(LAS u32x2*)(KB + i * RS + f) = w;
            w.x = pg8::cvt_pk_bf16(ko2[0], ko2[1]); w.y = pg8::cvt_pk_bf16(ko2[2], ko2[3]); *(LAS u32x2*)(KB + i * RS + 64 + f) = w;
            kth[it][0] = pg8::cvt_pk_bf16(ko1[0] * kd, ko1[1] * kd); kth[it][1] = pg8::cvt_pk_bf16(ko1[2] * kd, ko1[3] * kd);
            kth[it][2] = pg8::cvt_pk_bf16(ko2[0] * kd, ko2[1] * kd); kth[it][3] = pg8::cvt_pk_bf16(ko2[2] * kd, ko2[3] * kd); kd *= g32; }
        if (it & 1) __builtin_amdgcn_sched_barrier(0); }
}

__device__ __forceinline__ void ret_unit_a(PR P, LAS unsigned char* lds, const int bh, const int n, const int wv) {
    LAS bf16_t* QP = (LAS bf16_t*)lds; LAS bf16_t* KB = QP + BUFE; LAS bf16_t* VT = KB + BUFE;
    const int tid = fresh_tid(wv), lane = tid & 63, wid = tid >> 6, wr = wid >> 1, wc = wid & 1, fr = lane & 15, fq = lane >> 4;
    const int b = bh >> 2, h = bh & 3;
    const bf16_t* PS = (const bf16_t*)(P.ws + WS_BIG); bf16_t* Y = (bf16_t*)(P.ws + WS_XN); bf16_t* KVB = kvb_ptr(P.ws, bh) + (size_t)n * 16384;
    const float lg2 = log2f(1.0f - exp2f(-5.0f - (float)h));
    const float kd0 = exp2f(lg2 * (float)(127 - (tid >> 4))), g32 = exp2f(-32.0f * lg2);
    const int row0 = b * 2048 + n * 128;
    unsigned kth[4][4];
    ret_load_qk<true>(P, QP, KB, kth, tid, row0, n, h, kd0, g32);
#pragma unroll
    for (int it = 0; it < 4; ++it) { const int idx = it * 512 + tid, j = idx >> 4, e = (idx & 15) * 8;
        const u32x4 vv = *(const u32x4*)(PS + (size_t)(row0 + j) * NCOLS + 1792 + 1024 + h * 128 + e);
        LAS bf16_t* d = VT + e * RS + j;
        d[0] = (bf16_t)(vv.x & 0xffffu); d[RS] = (bf16_t)(vv.x >> 16); d[2 * RS] = (bf16_t)(vv.y & 0xffffu); d[3 * RS] = (bf16_t)(vv.y >> 16);
        d[4 * RS] = (bf16_t)(vv.z & 0xffffu); d[5 * RS] = (bf16_t)(vv.z >> 16); d[6 * RS] = (bf16_t)(vv.w & 0xffffu); d[7 * RS] = (bf16_t)(vv.w >> 16); }
    __syncthreads();
    f32x4 accP[2][4];
#pragma unroll
    for (int mt = 0; mt < 2; ++mt)
#pragma unroll
        for (int nt = 0; nt < 4; ++nt) accP[mt][nt] = (f32x4){0.f, 0.f, 0.f, 0.f};
#pragma unroll
    for (int ks = 0; ks < 4; ++ks) { bf16x8 aq[2];
#pragma unroll
        for (int mt = 0; mt < 2; ++mt) aq[mt] = *(const LAS bf16x8*)(QP + (wr * 32 + mt * 16 + fr) * RS + ks * 32 + fq * 8);
#pragma unroll
        for (int nt = 0; nt < 4; ++nt) { const bf16x8 bk = *(const LAS bf16x8*)(KB + (wc * 64 + nt * 16 + fr) * RS + ks * 32 + fq * 8);
#pragma unroll
            for (int mt = 0; mt < 2; ++mt) accP[mt][nt] = __builtin_amdgcn_mfma_f32_16x16x32_bf16(aq[mt], bk, accP[mt][nt], 0, 0, 0); }
        __builtin_amdgcn_sched_barrier(0); }
    __syncthreads();
    { float ri[2][4], cj[4];
#pragma unroll
      for (int mt = 0; mt < 2; ++mt)
#pragma unroll
          for (int j = 0; j < 4; ++j) ri[mt][j] = exp2f(lg2 * (float)(wr * 32 + mt * 16 + fq * 4 + j));
#pragma unroll
      for (int nt = 0; nt < 4; ++nt) cj[nt] = exp2f(-lg2 * (float)(wc * 64 + nt * 16 + fr));
#pragma unroll
      for (int mt = 0; mt < 2; ++mt)
#pragma unroll
          for (int nt = 0; nt < 4; ++nt)
#pragma unroll
              for (int j = 0; j < 4; ++j) { const int i = wr * 32 + mt * 16 + fq * 4 + j, jj = wc * 64 + nt * 16 + fr;
                  const float val = i >= jj ? accP[mt][nt][j] * ri[mt][j] * cj[nt] : 0.f; QP[i * RS + jj] = f2bf(val); } }
#pragma unroll
    for (int it = 0; it < 4; ++it) { const int idx = it * 512 + tid, j = idx >> 4, f = (idx & 15) * 4; LAS bf16_t* d = KB + f * RS + j;
        d[0] = (bf16_t)(kth[it][0] & 0xffffu); d[RS] = (bf16_t)(kth[it][0] >> 16); d[2 * RS] = (bf16_t)(kth[it][1] & 0xffffu); d[3 * RS] = (bf16_t)(kth[it][1] >> 16);
        LAS bf16_t* d2 = d + 64 * RS;
        d2[0] = (bf16_t)(kth[it][2] & 0xffffu); d2[RS] = (bf16_t)(kth[it][2] >> 16); d2[2 * RS] = (bf16_t)(kth[it][3] & 0xffffu); d2[3 * RS] = (bf16_t)(kth[it][3] >> 16); }
    __syncthreads();
    f32x4 accY[2][4], accS[2][4];
#pragma unroll
    for (int mt = 0; mt < 2; ++mt)
#pragma unroll
        for (int nt = 0; nt < 4; ++nt) { accY[mt][nt] = (f32x4){0.f, 0.f, 0.f, 0.f}; accS[mt][nt] = (f32x4){0.f, 0.f, 0.f, 0.f}; }
#pragma unroll
    for (int ks = 0; ks < 4; ++ks) { bf16x8 ap[2], av[2];
#pragma unroll
        for (int mt = 0; mt < 2; ++mt) { ap[mt] = *(const LAS bf16x8*)(QP + (wr * 32 + mt * 16 + fr) * RS + ks * 32 + fq * 8); av[mt] = *(const LAS bf16x8*)(VT + (wr * 32 + mt * 16 + fr) * RS + ks * 32 + fq * 8); }
#pragma unroll
        for (int nt = 0; nt < 4; ++nt) { const bf16x8 bv = *(const LAS bf16x8*)(VT + (wc * 64 + nt * 16 + fr) * RS + ks * 32 + fq * 8), bkt = *(const LAS bf16x8*)(KB + (wc * 64 + nt * 16 + fr) * RS + ks * 32 + fq * 8);
#pragma unroll
            for (int mt = 0; mt < 2; ++mt) { accY[mt][nt] = __builtin_amdgcn_mfma_f32_16x16x32_bf16(ap[mt], bv, accY[mt][nt], 0, 0, 0); accS[mt][nt] = __builtin_amdgcn_mfma_f32_16x16x32_bf16(av[mt], bkt, accS[mt][nt], 0, 0, 0); } }
        __builtin_amdgcn_sched_barrier(0); }
#pragma unroll
    for (int mt = 0; mt < 2; ++mt)
#pragma unroll
        for (int nt = 0; nt < 4; ++nt)
#pragma unroll
            for (int j = 0; j < 4; ++j) { const int r = wr * 32 + mt * 16 + fq * 4 + j, c = wc * 64 + nt * 16 + fr;
                Y[(size_t)(row0 + r) * 1024 + 512 + h * 128 + c] = f2bf(accY[mt][nt][j]); KVB[r * 128 + c] = f2bf(accS[mt][nt][j]); }
    __syncthreads();
}

__device__ __forceinline__ void ret_prefix(PR P, const int item) {
    const int bh = item >> 11, i8 = (item & 2047) * 8; const int h = bh & 3;
    bf16_t* KVB = kvb_ptr(P.ws, bh) + i8;
    const float lg2 = log2f(1.0f - exp2f(-5.0f - (float)h)); const float c_dec = exp2f(lg2 * 128.0f);
    u32x4 kv[16];
#pragma unroll
    for (int n = 0; n < 16; ++n) kv[n] = *(const u32x4*)(KVB + (size_t)n * 16384);
    float S[8];
#pragma unroll
    for (int x = 0; x < 8; ++x) S[x] = 0.f;
#pragma unroll
    for (int n = 0; n < 16; ++n) { u32x4 w; w.x = pg8::cvt_pk_bf16(S[0], S[1]); w.y = pg8::cvt_pk_bf16(S[2], S[3]); w.z = pg8::cvt_pk_bf16(S[4], S[5]); w.w = pg8::cvt_pk_bf16(S[6], S[7]);
        *(u32x4*)(KVB + (size_t)n * 16384) = w;
        const float k8[8] = {lo_bf(kv[n].x), hi_bf(kv[n].x), lo_bf(kv[n].y), hi_bf(kv[n].y), lo_bf(kv[n].z), hi_bf(kv[n].z), lo_bf(kv[n].w), hi_bf(kv[n].w)};
#pragma unroll
        for (int x = 0; x < 8; ++x) S[x] = S[x] * c_dec + k8[x]; }
    const int e = i8 >> 7, d0 = i8 & 127;
#pragma unroll
    for (int x = 0; x < 8; ++x) P.out[O_RTP + ((size_t)bh * 128 + d0 + x) * 128 + e] = S[x];
}

__device__ __forceinline__ void ret_unit_c(PR P, LAS unsigned char* lds, const int bh, const int n, const int wv) {
    LAS bf16_t* QP = (LAS bf16_t*)lds; LAS bf16_t* ST = QP + 3 * BUFE; LAS float* YST = (LAS float*)(QP + BUFE);
    const int tid = fresh_tid(wv), lane = tid & 63, wid = tid >> 6, wr = wid >> 1, wc = wid & 1, fr = lane & 15, fq = lane >> 4;
    const int b = bh >> 2, h = bh & 3;
    const bf16_t* PS = (const bf16_t*)(P.ws + WS_BIG); bf16_t* Y = (bf16_t*)(P.ws + WS_XN); const bf16_t* KVB = kvb_ptr(P.ws, bh) + (size_t)n * 16384;
    const float lg2 = log2f(1.0f - exp2f(-5.0f - (float)h));
    const int row0 = b * 2048 + n * 128;
    unsigned kth[4][4];
    ret_load_qk<false>(P, QP, QP, kth, tid, row0, n, h, 0.f, 0.f);
#pragma unroll
    for (int it = 0; it < 4; ++it) { const int idx = it * 512 + tid, e = idx >> 4, d8 = (idx & 15) * 8;
        *(LAS u32x4*)(ST + e * RS + d8) = *(const u32x4*)(KVB + e * 128 + d8); }
    __syncthreads();
    f32x4 accY[2][4];
#pragma unroll
    for (int mt = 0; mt < 2; ++mt)
#pragma unroll
        for (int nt = 0; nt < 4; ++nt) accY[mt][nt] = (f32x4){0.f, 0.f, 0.f, 0.f};
#pragma unroll
    for (int ks = 0; ks < 4; ++ks) { bf16x8 aq[2];
#pragma unroll
        for (int mt = 0; mt < 2; ++mt) aq[mt] = *(const LAS bf16x8*)(QP + (wr * 32 + mt * 16 + fr) * RS + ks * 32 + fq * 8);
#pragma unroll
        for (int nt = 0; nt < 4; ++nt) { const bf16x8 bs = *(const LAS bf16x8*)(ST + (wc * 64 + nt * 16 + fr) * RS + ks * 32 + fq * 8);
#pragma unroll
            for (int mt = 0; mt < 2; ++mt) accY[mt][nt] = __builtin_amdgcn_mfma_f32_16x16x32_bf16(aq[mt], bs, accY[mt][nt], 0, 0, 0); }
        __builtin_amdgcn_sched_barrier(0); }
#pragma unroll
    for (int mt = 0; mt < 2; ++mt)
#pragma unroll
        for (int j = 0; j < 4; ++j) { const int r = wr * 32 + mt * 16 + fq * 4 + j; const float qd = exp2f(lg2 * (float)(r + 1));
#pragma unroll
            for (int nt = 0; nt < 4; ++nt) YST[r * 132 + wc * 64 + nt * 16 + fr] = accY[mt][nt][j] * qd; }
    __syncthreads();
    { const int i = tid >> 2, part = tid & 3; float yv[32]; float s = 0.f;
      bf16_t* yo = Y + (size_t)(row0 + i) * 1024 + 512 + h * 128 + part * 32;
#pragma unroll
      for (int x = 0; x < 4; ++x) { const u32x4 y1 = *(const u32x4*)(yo + x * 8); const f32x4 ta = *(const LAS f32x4*)(YST + i * 132 + part * 32 + x * 8), tb = *(const LAS f32x4*)(YST + i * 132 + part * 32 + x * 8 + 4);
          yv[x * 8 + 0] = ta[0] + lo_bf(y1.x); yv[x * 8 + 1] = ta[1] + hi_bf(y1.x); yv[x * 8 + 2] = ta[2] + lo_bf(y1.y); yv[x * 8 + 3] = ta[3] + hi_bf(y1.y);
          yv[x * 8 + 4] = tb[0] + lo_bf(y1.z); yv[x * 8 + 5] = tb[1] + hi_bf(y1.z); yv[x * 8 + 6] = tb[2] + lo_bf(y1.w); yv[x * 8 + 7] = tb[3] + hi_bf(y1.w); }
#pragma unroll
      for (int x = 0; x < 32; ++x) s += yv[x];
      s = quad_sum(s); const float mean = s * (1.0f / 128.0f); float s2 = 0.f;
#pragma unroll
      for (int x = 0; x < 32; ++x) { yv[x] -= mean; s2 += yv[x] * yv[x]; }
      s2 = quad_sum(s2); const float rstd = rsqrtf(s2 * (1.0f / 128.0f) + 1e-5f);
      const bf16_t* gp = PS + (size_t)(row0 + i) * NCOLS + 1792 + 1536 + h * 128 + part * 32; const float* gw = P.gn_w + h * 128 + part * 32;
#pragma unroll
      for (int x = 0; x < 4; ++x) { const u32x4 g4 = *(const u32x4*)(gp + x * 8); const float4 w0 = *(const float4*)(gw + x * 8), w1 = *(const float4*)(gw + x * 8 + 4);
          const float gg[8] = {lo_bf(g4.x), hi_bf(g4.x), lo_bf(g4.y), hi_bf(g4.y), lo_bf(g4.z), hi_bf(g4.z), lo_bf(g4.w), hi_bf(g4.w)}; const float ww[8] = {w0.x, w0.y, w0.z, w0.w, w1.x, w1.y, w1.z, w1.w};
          float o[8];
#pragma unroll
          for (int z = 0; z < 8; ++z) o[z] = yv[x * 8 + z] * rstd * ww[z] * (gg[z] * __builtin_amdgcn_rcpf(1.0f + __expf(-gg[z])));
          u32x4 w; w.x = pg8::cvt_pk_bf16(o[0], o[1]); w.y = pg8::cvt_pk_bf16(o[2], o[3]); w.z = pg8::cvt_pk_bf16(o[4], o[5]); w.w = pg8::cvt_pk_bf16(o[6], o[7]);
          *(u32x4*)(yo + x * 8) = w; } }
    __syncthreads();
}

__device__ __forceinline__ void sub_barrier(unsigned* cnt, const unsigned target, const int wv) {
    asm volatile("s_waitcnt vmcnt(0)" ::: "memory");
    __syncthreads();
    if (fresh_tid(wv) == 0) {
        __builtin_amdgcn_fence(__ATOMIC_RELEASE, "agent");
        asm volatile("s_waitcnt vmcnt(0)" ::: "memory");
        (void)xb_add(cnt, 1u);
        unsigned sp = 0u;
        while (xb_ld(cnt) < target) { __builtin_amdgcn_s_sleep(2); if (++sp > (1u << 20)) break; }
        __builtin_amdgcn_fence(__ATOMIC_ACQUIRE, "agent");
        asm volatile("s_waitcnt vmcnt(0)" ::: "memory");
    }
    __syncthreads();
}

struct PostRegs { u32x2 yr, c_r, c_k, c_v, p_r, p_k, p_v, ar, gr; };
__device__ __forceinline__ void post_load(PR P, PostRegs& R, const int row, const int ch) {
    const bf16_t* PS = (const bf16_t*)(P.ws + WS_BIG); const bf16_t* ASIG = (const bf16_t*)(P.ws + WS_ASIG); const bf16_t* YS = (const bf16_t*)(P.ws + WS_YS); const bf16_t* G = (const bf16_t*)(P.ws + WS_WIN);
    R.yr = *(const u32x2*)(YS + (size_t)row * 512 + ch);
    const bf16_t* cp = PS + (size_t)row * NCOLS + ch; const int pr = prev_row(row);
    R.c_r = *(const u32x2*)cp; R.c_k = *(const u32x2*)(cp + 512); R.c_v = *(const u32x2*)(cp + 1024);
    { const bf16_t* pp = PS + (size_t)(pr >= 0 ? pr : row) * NCOLS + ch; R.p_r = *(const u32x2*)pp; R.p_k = *(const u32x2*)(pp + 512); R.p_v = *(const u32x2*)(pp + 1024); }
    R.ar = *(const u32x2*)(ASIG + (size_t)row * 512 + ch); R.gr = *(const u32x2*)(G + (size_t)row * 512 + ch);
}
__device__ __forceinline__ void rwkv_post(PR P, const int wv) {
    const int tid = fresh_tid(wv); const int lane = tid & 63; const int gw = blockIdx.x * 8 + (tid >> 6), nw = gridDim.x * 8;
    const int sub = lane >> 4, cg4 = (lane & 15) * 4;
    bf16_t* Y = (bf16_t*)(P.ws + WS_XN);
    const int h = (gw * 4 + sub) & 7, ch = h * 64 + cg4;
    const float4 mr = *(const float4*)(P.mu + ch), mk = *(const float4*)(P.mu + 512 + ch), mv = *(const float4*)(P.mu + 1024 + ch);
    const float4 ka = *(const float4*)(P.k_a + ch), rk = *(const float4*)(P.r_k + ch), lw = *(const float4*)(P.lnx_w + ch), lb = *(const float4*)(P.lnx_b + ch);
    const float m_r[4] = {mr.x, mr.y, mr.z, mr.w}, m_k[4] = {mk.x, mk.y, mk.z, mk.w}, m_v[4] = {mv.x, mv.y, mv.z, mv.w};
    const float kaa[4] = {ka.x, ka.y, ka.z, ka.w}, rkk[4] = {rk.x, rk.y, rk.z, rk.w}, lww[4] = {lw.x, lw.y, lw.z, lw.w}, lbb[4] = {lb.x, lb.y, lb.z, lb.w};
    PostRegs R, N;
    if (gw < MT * 2) post_load(P, R, (gw * 4 + sub) >> 3, ch);
    for (int task = gw; task < MT * 2; task += nw) {
        const int row = (task * 4 + sub) >> 3;
        { const int nt_ = task + nw < MT * 2 ? task + nw : task; post_load(P, N, (nt_ * 4 + sub) >> 3, ch); }
        if (prev_row(row) < 0) { R.p_r = (u32x2){0u, 0u}; R.p_k = R.p_r; R.p_v = R.p_r; }
        const float ys[4] = {lo_bf(R.yr.x), hi_bf(R.yr.x), lo_bf(R.yr.y), hi_bf(R.yr.y)};
        const float mean = row16_sum(ys[0] + ys[1] + ys[2] + ys[3]) * (1.0f / 64.0f);
        float dl[4], s2 = 0.f;
#pragma unroll
        for (int j = 0; j < 4; ++j) { dl[j] = ys[j] - mean; s2 += dl[j] * dl[j]; }
        const float rstd = rsqrtf(row16_sum(s2) * (1.0f / 64.0f) + 64e-5f);
        const float cr[4] = {lo_bf(R.c_r.x), hi_bf(R.c_r.x), lo_bf(R.c_r.y), hi_bf(R.c_r.y)}, ck[4] = {lo_bf(R.c_k.x), hi_bf(R.c_k.x), lo_bf(R.c_k.y), hi_bf(R.c_k.y)}, cv[4] = {lo_bf(R.c_v.x), hi_bf(R.c_v.x), lo_bf(R.c_v.y), hi_bf(R.c_v.y)};
        const float qr[4] = {lo_bf(R.p_r.x), hi_bf(R.p_r.x), lo_bf(R.p_r.y), hi_bf(R.p_r.y)}, qk[4] = {lo_bf(R.p_k.x), hi_bf(R.p_k.x), lo_bf(R.p_k.y), hi_bf(R.p_k.y)}, qv[4] = {lo_bf(R.p_v.x), hi_bf(R.p_v.x), lo_bf(R.p_v.y), hi_bf(R.p_v.y)};
        const float aa[4] = {lo_bf(R.ar.x), hi_bf(R.ar.x), lo_bf(R.ar.y), hi_bf(R.ar.y)}, gg[4] = {lo_bf(R.gr.x), hi_bf(R.gr.x), lo_bf(R.gr.y), hi_bf(R.gr.y)};
        float v[4], bp = 0.f;
#pragma unroll
        for (int j = 0; j < 4; ++j) { const float r = cr[j] + (qr[j] - cr[j]) * m_r[j], k = ck[j] + (qk[j] - ck[j]) * m_k[j]; v[j] = cv[j] + (qv[j] - cv[j]) * m_v[j];
            const float kn = k * (1.0f + (aa[j] - 1.0f) * kaa[j]); bp += r * kn * rkk[j]; }
        const float bonus = row16_sum(bp);
        float o[4];
#pragma unroll
        for (int j = 0; j < 4; ++j) o[j] = (dl[j] * rstd * lww[j] + lbb[j] + bonus * v[j]) * gg[j];
        u32x2 w; w.x = pg8::cvt_pk_bf16(o[0], o[1]); w.y = pg8::cvt_pk_bf16(o[2], o[3]);
        *(u32x2*)(Y + (size_t)row * 1024 + ch) = w;
        R = N;
    }
}

__global__ void __launch_bounds__(512, 2) hymba_mega(Params P_unused) {
    extern __shared__ __attribute__((aligned(16))) unsigned char shm[];
    cg::grid_group grid = cg::this_grid();
    LAS unsigned char* lds = (LAS unsigned char*)shm; LAS float* ldsf = (LAS float*)shm;
    const int G = gridDim.x, bx = blockIdx.x;
    const int wv = __builtin_amdgcn_readfirstlane(threadIdx.x >> 6);
    const CAS Params* kp = (const CAS Params*)__builtin_amdgcn_kernarg_segment_ptr();
#define P (*kp)
#define FRESH() asm volatile("" : "+s"(kp))
#ifndef REP_SYNC
#define REP_SYNC 1
#endif
#ifndef REP_P7
#define REP_P7 1
#endif
#ifndef REP_FFN1
#define REP_FFN1 1
#endif
#ifndef REP_P0
#define REP_P0 1
#endif
#ifndef REP_P3
#define REP_P3 1
#endif
#ifndef REP_RW
#define REP_RW 1
#endif
#ifndef REP_OTH
#define REP_OTH 1
#endif
#ifndef REP_RETP
#define REP_RETP 1
#endif
#ifndef REP_SAMP
#define REP_SAMP 1
#endif
#ifndef REP_P8
#define REP_P8 1
#endif
#define GSYNC() do { for (int r_ = 0; r_ < REP_SYNC; ++r_) xcd_barrier((unsigned*)ws, (volatile LAS unsigned*)(lds + LDS_BYTES - 16), wv); FRESH(); } while (0)
#define ws (kp->ws)
#define XN ((bf16_t*)(ws + WS_XN))
#define ACT ((bf16_t*)(ws + WS_BIG))
#define FO ((float*)(ws + WS_FO))
#define PS ((bf16_t*)(ws + WS_BIG))
    pg8::StaticOrder S;
    { const int t0 = fresh_tid(wv); if (t0 < 4) ((LAS unsigned*)(lds + LDS_BYTES - 16))[t0] = 0u;
      if (t0 == 0) (void)xb_add(&((unsigned*)ws)[XB_XCNT(xb_xcc_id())], 1u); }
    if (G == 0x7fffffff) grid.sync();
#ifndef PHM
#define PHM 0xFFFF
#endif
#define PH(k) if ((PHM >> (k)) & 1)
    for (int r0 = 0; r0 < REP_P0; ++r0) PH(0) p0_prologue(P, ldsf, wv);
    GSYNC();
    for (int rep1 = 0; rep1 < REP_FFN1; ++rep1) {
    PH(1) { pg8::Gemm g{XN, (const bf16_t*)(ws + WS_WGU), MT, NGU, 1024}; S.init(MT, NGU, G, bx, 1024); pg8::EpiSwiGLU E{ACT, DFF}; pg8::gemm_phase(lds, g, S, E, wv); }
    GSYNC();
    PH(2) { pg8::Gemm g{ACT, (const bf16_t*)(ws + WS_WD), MT, 1024, DFF}; pg8::SplitOrder S2; S2.init2(G, bx, DFF, 8); pg8::EpiFO E{(bf16_t*)FO, 1024, (float*)(ws + WS_OMD)}; pg8::gemm_phase(lds, g, S2, E, wv); }
    GSYNC();
    }
    for (int r3 = 0; r3 < REP_P3; ++r3) PH(3) rows_phase(P, 1, wv);
    GSYNC();
    PH(4) { pg8::Gemm g{XN, (const bf16_t*)(ws + WS_WIN), MIN_, NCOLS, 1024}; S.init(MIN_, NCOLS, G, bx, 1024); pg8::EpiBf16 E{PS, NCOLS}; pg8::gemm_phase(lds, g, S, E, wv); }
    GSYNC();
    PH(5) lora_prep(P, wv);
    GSYNC();
    PH(6) { pg8::Gemm g{(const bf16_t*)(ws + WS_LA), (const bf16_t*)(ws + WS_WL), MT, 1536, 256}; pg8::LoraMainOrder SM; SM.init(MP, 1024, G, bx, 256);
      pg8::EpiLora E{(bf16_t*)(ws + WS_OMD), (bf16_t*)(ws + WS_ASIG), (bf16_t*)(ws + WS_WIN), P.w0, P.a0}; pg8::gemm_phase(lds, g, SM, E, wv); }
    GSYNC();
    {
    if (bx < 128) { for (int rw = 0; rw < REP_RW; ++rw) rwkv_unit<false>(P, ldsf, bx >> 4, (bx >> 1) & 7, bx & 1, wv); }
    else {
        { pg8::Gemm g{(const bf16_t*)(ws + WS_LA), (const bf16_t*)(ws + WS_WL), MT, 1536, 256}; pg8::LoraRestOrder SL; SL.ob = bx - 128;
          pg8::EpiLora E{(bf16_t*)(ws + WS_OMD), (bf16_t*)(ws + WS_ASIG), (bf16_t*)(ws + WS_WIN), P.w0, P.a0}; pg8::gemm_phase(lds, g, SL, E, wv); }
        FRESH();
        const int rep7 = 0; const int ob = bx - 128; unsigned* sbc = (unsigned*)ws + XCD_BAR_WORDS + 64;
        for (int k = 0; k < 4; ++k) { const int u = ob + k * 128; ret_unit_a(P, lds, u >> 4, u & 15, wv); }
        sub_barrier(sbc, 128u * (2u * rep7 + 1u), wv);
        ret_prefix(P, ob * 512 + fresh_tid(wv));
        sub_barrier(sbc, 128u * (2u * rep7 + 2u), wv);
        for (int k = 0; k < 4; ++k) { const int u = ob + k * 128; ret_unit_c(P, lds, u >> 4, u & 15, wv); }
        for (int u = ob; u < 2560; u += 128) { if (u < 2048) rwkv_unit<true>(P, ldsf, u >> 4, (u >> 1) & 7, u & 1, wv); else ret_sample_unit(P, ldsf, (u - 2048) >> 2, (u - 2048) & 3, wv); }
    }
    }
    GSYNC();
    for (int rep8 = 0; rep8 < REP_P8; ++rep8) PH(8) rwkv_post(P, wv);
    GSYNC();
    PH(9) { pg8::Gemm g{XN, (const bf16_t*)(ws + WS_WOUT), MT, 1024, 1024}; pg8::SplitOrder S2; S2.init2(G, bx, 1024, 4); pg8::EpiFO E{(bf16_t*)FO, 1024, (float*)(ws + WS_OMD)}; pg8::gemm_phase(lds, g, S2, E, wv); }
    GSYNC();
    PH(10) { tconv_list(P.f2g, P.f2u, P.f2d, nullptr, nullptr, ws, 2112, ldsf, wv);
    rows_phase(P, 2, wv); }
    GSYNC();
    PH(11) { pg8::Gemm g{XN, (const bf16_t*)(ws + WS_WGU), MT, NGU, 1024}; S.init(MT, NGU, G, bx, 1024); pg8::EpiSwiGLU E{ACT, DFF}; pg8::gemm_phase(lds, g, S, E, wv); }
    GSYNC();
    PH(12) { pg8::Gemm g{ACT, (const bf16_t*)(ws + WS_WD), MT, 1024, DFF}; pg8::SplitOrder S2; S2.init2(G, bx, DFF, 8); pg8::EpiFO E{(bf16_t*)FO, 1024, (float*)(ws + WS_OMD)}; pg8::gemm_phase(lds, g, S2, E, wv); }
    GSYNC();
    PH(13) rows_phase(P, 3, wv);
}

#undef ws
#undef XN
#undef ACT
#undef FO
#undef PS
#undef P
extern "C" void kernel_launch(void* const* d_in, const int* in_sizes, int n_in, void* d_out, int out_size, void* d_ws, size_t ws_size, hipStream_t stream) {
    static int grid = 0;
    if (grid == 0) {
        if (n_in != 26 || ws_size < WS_END) { fprintf(stderr, "kernel_launch: unexpected n_in %d or ws_size %zu (< %zu)\n", n_in, ws_size, (size_t)WS_END); grid = -1; return; }
        int dev = 0, cus = 0, per_cu = 0;
        hipGetDevice(&dev); hipDeviceGetAttribute(&cus, hipDeviceAttributeMultiprocessorCount, dev);
        hipFuncSetAttribute((const void*)hymba_mega, hipFuncAttributeMaxDynamicSharedMemorySize, LDS_BYTES);
        hipOccupancyMaxActiveBlocksPerMultiprocessor(&per_cu, (const void*)hymba_mega, 512, LDS_BYTES);
        if (per_cu < 1) { fprintf(stderr, "kernel_launch: occupancy query says %d blocks/CU\n", per_cu); per_cu = 1; }
        grid = cus * per_cu; if (grid > 256) grid = 256;
        if (grid != 256) { fprintf(stderr, "kernel_launch: this kernel needs 256 co-resident workgroups, got %d\n", grid); grid = -1; return; }
        fprintf(stderr, "kernel_launch: cus %d per_cu %d grid %d ws %zu\n", cus, per_cu, grid, ws_size);
    }
    if (grid < 0) return;
    if (hipMemsetAsync(d_ws, 0, 16384, stream) != hipSuccess) { fprintf(stderr, "kernel_launch: hipMemsetAsync failed\n"); return; }
    Params p{};
    const float** pp = (const float**)&p;
    for (int i = 0; i < 26; ++i) pp[i] = (const float*)d_in[i];
    p.out = (float*)d_out; p.ws = (unsigned char*)d_ws;
    void* args[] = {&p};
    hipError_t e = hipLaunchCooperativeKernel((const void*)hymba_mega, dim3(grid), dim3(512), args, LDS_BYTES, stream);
    if (e != hipSuccess) fprintf(stderr, "cooperative launch failed: %s (grid %d)\n", hipGetErrorString(e), grid);
}
```

```cpp
#include <hip/hip_runtime.h>
#include <hip/hip_cooperative_groups.h>
#include <cstdio>
#include <cstdint>
namespace cg = cooperative_groups;

__device__ __forceinline__ int fresh_tid(int wv) { int l; asm volatile("v_mbcnt_lo_u32_b32 %0, -1, 0\n\tv_mbcnt_hi_u32_b32 %0, -1, %0" : "=v"(l)); return wv * 64 + l; }
namespace pg8 {
#define PG8_LAS __attribute__((address_space(3)))
typedef unsigned short bf16_t;
typedef short bf16x8 __attribute__((ext_vector_type(8)));
typedef float f32x4 __attribute__((ext_vector_type(4)));
typedef unsigned u32x4 __attribute__((ext_vector_type(4)));
typedef unsigned u32x2 __attribute__((ext_vector_type(2)));
constexpr int BM = 256, BK = 64, HALF = 128, HTB = HALF * BK * 2, STAGE_BYTES = 8 * HTB, NXCD = 8, WGM = 8;

__host__ __device__ __forceinline__ int lds_byte(int r, int c) { const int st = (r >> 4) * 2 + (c >> 5), rr = r & 15, cc = c & 31, ob = rr * 64 + cc * 2; return st * 1024 + (ob ^ (((ob >> 9) & 1) << 5)); }
__host__ __device__ __forceinline__ void stage_rc(int b, int& R, int& C) { const int st = b / 1024, sb = b % 1024, swz = sb ^ (((sb >> 9) & 1) << 5); R = (st >> 1) * 16 + swz / 64; C = (st & 1) * 32 + (swz % 64) / 2; }
__host__ __device__ __forceinline__ int perm32(int rho) { const int n = rho >> 4, i = rho & 15; return 8 * (i >> 2) + 4 * n + (i & 3); }

struct Unit { int pm, pn, k0, nkt, atomic; };
struct Gemm { const bf16_t* A; const bf16_t* Bt; int M, N, K; };

struct StaticOrder {
    int nM, nN, nwg, G, c, nt;
    __host__ __device__ void init(int M, int N, int G_, int c_, int K) { nM = M / BM; nN = N / BM; nwg = nM * nN; G = G_; c = c_; nt = K / BK; }
    __host__ __device__ bool next(int i, Unit& u) const {
        const long L = (long)i * G + c; if (L >= nwg) return false;
        int wgid = (int)L; { const int q = nwg / NXCD, r = nwg % NXCD, xcd = wgid % NXCD, off = wgid / NXCD; wgid = (xcd < r ? xcd * (q + 1) : r * (q + 1) + (xcd - r) * q) + off; }
        const int nig = WGM * nN, gid = wgid / nig, fm = gid * WGM, gsz = (nM - fm) < WGM ? (nM - fm) : WGM;
        u.pm = fm + ((wgid % nig) % gsz); u.pn = (wgid % nig) / gsz; u.k0 = 0; u.nkt = nt; u.atomic = 0; return true;
    }
    __device__ __forceinline__ void a_ready(const Unit&) const {}
    __device__ __forceinline__ void done(const Unit&) const {}
};
struct LoraMainOrder : StaticOrder {
    __host__ __device__ bool next(int i, Unit& u) const { if (!StaticOrder::next(i, u)) return false; u.k0 = 0; u.nkt = 2; return true; }
};
struct LoraRestOrder {
    int ob;
    __host__ __device__ bool next(int i, Unit& u) const {
        const int L = i * 128 + ob; if (L >= 140) return false;
        if (L < 132) { u.pm = L >> 1; u.pn = 4 + (L & 1); u.k0 = 2; } else { const int x = L - 132; u.pm = 64 + (x >> 2); u.pn = x & 3; u.k0 = 0; }
        u.nkt = 2; u.atomic = 0; return true;
    }
    __device__ __forceinline__ void a_ready(const Unit&) const {}
    __device__ __forceinline__ void done(const Unit&) const {}
};
struct SplitOrder : StaticOrder {
    int KS;
    __host__ __device__ void init2(int G_, int c_, int K, int KS_) { init(16384, 1024, G_, c_, K); KS = KS_; }
    __host__ __device__ bool next(int i, Unit& u) const {
        if (i == 0) return StaticOrder::next(0, u);
        if (i > 1 || c >= 8 * KS) return false;
        const int tile = c / KS, part = c % KS, pairs = nt / 2, q = pairs / KS, r = pairs % KS;
        u.pm = 64 + (tile >> 2); u.pn = tile & 3; u.k0 = 2 * (part * q + (part < r ? part : r)); u.nkt = 2 * (q + (part < r ? 1 : 0)); u.atomic = 1 + c; return true;
    }
};

typedef __bf16 bf16x2_t __attribute__((ext_vector_type(2)));
typedef float f32x2_t __attribute__((ext_vector_type(2)));
__device__ __forceinline__ unsigned cvt_pk_bf16(float lo, float hi) { const f32x2_t v = {lo, hi}; const bf16x2_t b = __builtin_convertvector(v, bf16x2_t); return __builtin_bit_cast(unsigned, b); }

struct EpiFO {
    static constexpr bool PERM = true;
    bf16_t* C; int ldc; float* slab;
    __device__ __forceinline__ void operator()(const f32x4 (&acc)[2][2][4][2], const Unit& u, int wr, int wc, int fr, int fq) const {
        if (u.atomic == 0) {
            const int row0 = u.pm * BM + wr * 64 + fr; const int col0 = u.pn * BM + wc * 32 + 8 * fq;
#pragma unroll
            for (int ai = 0; ai < 2; ++ai)
#pragma unroll
                for (int m = 0; m < 4; ++m) { bf16_t* rowp = C + (size_t)(row0 + ai * HALF + m * 16) * ldc + col0;
#pragma unroll
                    for (int bj = 0; bj < 2; ++bj) { const f32x4 v0 = acc[ai][bj][m][0], v1 = acc[ai][bj][m][1];
                        u32x4 w; w.x = cvt_pk_bf16(v0[0], v0[1]); w.y = cvt_pk_bf16(v0[2], v0[3]); w.z = cvt_pk_bf16(v1[0], v1[1]); w.w = cvt_pk_bf16(v1[2], v1[3]);
                        *(u32x4*)(rowp + bj * HALF) = w; } }
        } else {
            float* base = slab + (size_t)(u.atomic - 1) * (BM * BM) + (size_t)(wr * 64 + fr) * BM + wc * 32 + 8 * fq;
#pragma unroll
            for (int ai = 0; ai < 2; ++ai)
#pragma unroll
                for (int m = 0; m < 4; ++m) { float* rowp = base + (size_t)(ai * HALF + m * 16) * BM;
#pragma unroll
                    for (int bj = 0; bj < 2; ++bj) { *(f32x4*)(rowp + bj * HALF) = acc[ai][bj][m][0]; *(f32x4*)(rowp + bj * HALF + 4) = acc[ai][bj][m][1]; } }
        }
    }
};
struct EpiBf16 {
    static constexpr bool PERM = true;
    bf16_t* O; int ldc;
    __device__ __forceinline__ void operator()(const f32x4 (&acc)[2][2][4][2], const Unit& u, int wr, int wc, int fr, int fq) const {
        const int row0 = u.pm * BM + wr * 64 + fr; const int col0 = u.pn * BM + wc * 32 + 8 * fq;
#pragma unroll
        for (int ai = 0; ai < 2; ++ai)
#pragma unroll
            for (int m = 0; m < 4; ++m) { bf16_t* rowp = O + (size_t)(row0 + ai * HALF + m * 16) * ldc + col0;
#pragma unroll
                for (int bj = 0; bj < 2; ++bj) { const f32x4 v0 = acc[ai][bj][m][0], v1 = acc[ai][bj][m][1];
                    u32x4 w; w.x = cvt_pk_bf16(v0[0], v0[1]); w.y = cvt_pk_bf16(v0[2], v0[3]); w.z = cvt_pk_bf16(v1[0], v1[1]); w.w = cvt_pk_bf16(v1[2], v1[3]);
                    *(u32x4*)(rowp + bj * HALF) = w; } }
    }
};
__device__ __forceinline__ float silu_f(float x) { return x * __builtin_amdgcn_rcpf(1.0f + __expf(-x)); }
struct EpiSwiGLU {
    static constexpr bool PERM = true;
    bf16_t* O; int ldc;
    __device__ __forceinline__ void operator()(const f32x4 (&acc)[2][2][4][2], const Unit& u, int wr, int wc, int fr, int fq) const {
        const int row0 = u.pm * BM + wr * 64 + fr; const int col0 = u.pn * HALF + wc * 32 + 8 * fq;
#pragma unroll
        for (int ai = 0; ai < 2; ++ai)
#pragma unroll
            for (int m = 0; m < 4; ++m) { bf16_t* rowp = O + (size_t)(row0 + ai * HALF + m * 16) * ldc + col0;
                float o[8];
#pragma unroll
                for (int n = 0; n < 2; ++n)
#pragma unroll
                    for (int j = 0; j < 4; ++j) o[n * 4 + j] = silu_f(acc[ai][0][m][n][j]) * acc[ai][1][m][n][j];
                u32x4 w; w.x = cvt_pk_bf16(o[0], o[1]); w.y = cvt_pk_bf16(o[2], o[3]); w.z = cvt_pk_bf16(o[4], o[5]); w.w = cvt_pk_bf16(o[6], o[7]);
                *(u32x4*)rowp = w; }
    }
};
struct EpiLora {
    static constexpr bool PERM = true;
    bf16_t* OMD; bf16_t* ASIG; bf16_t* G; const float* w0; const float* a0;
    template <int KIND> __device__ __forceinline__ void body(const f32x4 (&acc)[2][2][4][2], bf16_t* O, const float* bias, int row0, int ch0) const {
#pragma unroll
        for (int bj = 0; bj < 2; ++bj)
#pragma unroll
            for (int ai = 0; ai < 2; ++ai)
#pragma unroll
                for (int m = 0; m < 4; ++m) { bf16_t* rowp = O + (size_t)(row0 + ai * HALF + m * 16) * 512 + ch0 + bj * HALF;
                    float o[8];
#pragma unroll
                    for (int n = 0; n < 2; ++n)
#pragma unroll
                        for (int j = 0; j < 4; ++j) { float v = acc[ai][bj][m][n][j];
                            if (KIND == 0) { v += bias[ch0 + bj * HALF + n * 4 + j]; const float e = 0.6065306597126334f * __builtin_amdgcn_rcpf(1.0f + __expf(-v));
                                float p = 1.0f / 40320.0f; p = -1.0f / 5040.0f + e * p; p = 1.0f / 720.0f + e * p; p = -1.0f / 120.0f + e * p; p = 1.0f / 24.0f + e * p; p = -1.0f / 6.0f + e * p; p = 0.5f + e * p; p = 1.0f - e * p;
                                v = e * p; }
                            else if (KIND == 1) { v += bias[ch0 + bj * HALF + n * 4 + j]; v = __builtin_amdgcn_rcpf(1.0f + __expf(-v)); }
                            o[n * 4 + j] = v; }
                    u32x4 w; w.x = cvt_pk_bf16(o[0], o[1]); w.y = cvt_pk_bf16(o[2], o[3]); w.z = cvt_pk_bf16(o[4], o[5]); w.w = cvt_pk_bf16(o[6], o[7]);
                    *(u32x4*)rowp = w; __builtin_amdgcn_sched_barrier(0); }
    }
    __device__ __forceinline__ void operator()(const f32x4 (&acc)[2][2][4][2], const Unit& u, int wr, int wc, int fr, int fq) const {
        const int kind = u.pn >> 1;
        const int row0 = u.pm * BM + wr * 64 + fr; const int ch0 = (u.pn & 1) * BM + wc * 32 + 8 * fq;
        if (kind == 0) body<0>(acc, OMD, w0, row0, ch0); else if (kind == 1) body<1>(acc, ASIG, a0, row0, ch0); else body<2>(acc, G, a0, row0, ch0);
    }
};

template <class Epi, class Sched>
__device__ __forceinline__ void gemm_phase(PG8_LAS unsigned char* lds, const Gemm g, const Sched& S, const Epi& E, const int wv) {
    const int tid = fresh_tid(wv), wid = __builtin_amdgcn_readfirstlane(tid >> 6), lane = tid & 63, wr = wid >> 2, wc = wid & 3, fr = lane & 15, fq = lane >> 4;
    const int K = g.K;
    unsigned voffA[2], voffB[2];
#pragma unroll
    for (int i = 0; i < 2; ++i) { int R, C; stage_rc(tid * 16 + i * 8192, R, C); const int Rb = Epi::PERM ? ((R & ~31) + perm32(R & 31)) : R;
        voffA[i] = (unsigned)(R * K + C) * 2u; voffB[i] = (unsigned)(Rb * K + C) * 2u; }
    const size_t kstep = (size_t)(BK * 2);
    const size_t hstep = (size_t)HALF * K * 2;
    const size_t tstep = 2 * hstep;
    const unsigned ldsw = (unsigned)wid * 1024u;
    const int aoff = lds_byte(wr * 64 + fr, fq * 8), boff = lds_byte(wc * 32 + fr, fq * 8);
#define PG8_SA(b, h) (((b) * 2 + (h)) * HTB)
#define PG8_SB(b, h) ((4 + (b) * 2 + (h)) * HTB)
#define PG8_STAGE(bufoff, gbase, voff) do { _Pragma("unroll") for (int _i = 0; _i < 2; ++_i) \
        __builtin_amdgcn_global_load_lds((const unsigned*)((const char*)(gbase) + (voff)[_i]), (PG8_LAS unsigned*)(lds + (bufoff) + ldsw + _i * 8192), 16, 0, 0); } while (0)
#define PG8_LDA(dst, b, h) do { _Pragma("unroll") for (int m = 0; m < 4; ++m) _Pragma("unroll") for (int k = 0; k < 2; ++k) dst[m][k] = *(const PG8_LAS bf16x8*)(lds + PG8_SA(b, h) + aoff + m * 2048 + k * 1024); } while (0)
#define PG8_LDB(dst, b, h) do { _Pragma("unroll") for (int n = 0; n < 2; ++n) _Pragma("unroll") for (int k = 0; k < 2; ++k) dst[n][k] = *(const PG8_LAS bf16x8*)(lds + PG8_SB(b, h) + boff + n * 2048 + k * 1024); } while (0)
#define PG8_MMA(ai, bj, At, Bt) do { __builtin_amdgcn_s_setprio(1); _Pragma("unroll") for (int m = 0; m < 4; ++m) _Pragma("unroll") for (int n = 0; n < 2; ++n) _Pragma("unroll") for (int k = 0; k < 2; ++k) \
        acc[ai][bj][m][n] = __builtin_amdgcn_mfma_f32_16x16x32_bf16(Bt[n][k], At[m][k], acc[ai][bj][m][n], 0, 0, 0); __builtin_amdgcn_s_setprio(0); } while (0)
#define PG8_WAIT_V(n) asm volatile("s_waitcnt vmcnt(" #n ")" ::: "memory")
#define PG8_WAIT_L(n) asm volatile("s_waitcnt lgkmcnt(" #n ")" ::: "memory")
#define PG8_BAR __builtin_amdgcn_s_barrier()
#define PG8_SCHED __builtin_amdgcn_sched_barrier(0)
    Unit cur, nxt; int ui = 0;
    if (!S.next(0, cur)) return;
    f32x4 acc[2][2][4][2];
#pragma unroll
    for (int a = 0; a < 2; ++a)
#pragma unroll
        for (int b = 0; b < 2; ++b)
#pragma unroll
            for (int m = 0; m < 4; ++m)
#pragma unroll
                for (int n = 0; n < 2; ++n) acc[a][b][m][n] = (f32x4){0.f, 0.f, 0.f, 0.f};
    bf16x8 At[4][2], B0[2][2], B1[2][2];
    const char* cA = (const char*)g.A + (size_t)cur.pm * tstep + (size_t)cur.k0 * kstep; const char* cB = (const char*)g.Bt + (size_t)cur.pn * tstep + (size_t)cur.k0 * kstep;
    S.a_ready(cur);
    PG8_STAGE(PG8_SB(0, 0), cB, voffB); PG8_STAGE(PG8_SA(0, 0), cA, voffA); PG8_STAGE(PG8_SB(0, 1), cB + hstep, voffB); PG8_STAGE(PG8_SA(0, 1), cA + hstep, voffA);
    if (wr == 1) PG8_BAR;
    PG8_WAIT_V(4); PG8_BAR;
    PG8_STAGE(PG8_SB(1, 0), cB + kstep, voffB); PG8_STAGE(PG8_SA(1, 0), cA + kstep, voffA); PG8_STAGE(PG8_SB(1, 1), cB + hstep + kstep, voffB);
    PG8_WAIT_V(6); PG8_BAR;
    for (;;) {
        const bool has_next = S.next(ui + 1, nxt);
        const char* nA = has_next ? (const char*)g.A + (size_t)nxt.pm * tstep + (size_t)nxt.k0 * kstep : cA; const char* nB = has_next ? (const char*)g.Bt + (size_t)nxt.pn * tstep + (size_t)nxt.k0 * kstep : cB;
        const int nt = cur.nkt;
        for (int t = 0; t < nt; t += 2) {
            const bool last = (t == nt - 2);
            const char* a1 = cA + (size_t)(t + 1) * kstep;
            const char* a2 = last ? nA : cA + (size_t)(t + 2) * kstep; const char* b2 = last ? nB : cB + (size_t)(t + 2) * kstep;
            const char* a3 = a2 + kstep; const char* b3 = b2 + kstep;
            if (last && has_next) S.a_ready(nxt);
            PG8_LDB(B0, 0, 0); PG8_SCHED; PG8_LDA(At, 0, 0); PG8_STAGE(PG8_SA(1, 1), a1 + hstep, voffA);
            PG8_WAIT_L(8); PG8_BAR; PG8_WAIT_L(0); PG8_MMA(0, 0, At, B0); PG8_BAR; PG8_SCHED;
            PG8_LDB(B1, 0, 1); PG8_STAGE(PG8_SB(0, 0), b2, voffB);
            PG8_BAR; PG8_WAIT_L(0); PG8_MMA(0, 1, At, B1); PG8_BAR;
            PG8_LDA(At, 0, 1); PG8_STAGE(PG8_SA(0, 0), a2, voffA);
            PG8_BAR; PG8_WAIT_L(0); PG8_MMA(1, 0, At, B0); PG8_BAR; PG8_SCHED;
            PG8_STAGE(PG8_SB(0, 1), b2 + hstep, voffB);
            PG8_WAIT_V(6); PG8_BAR; PG8_MMA(1, 1, At, B1); PG8_BAR;
            PG8_LDB(B0, 1, 0); PG8_SCHED; PG8_LDA(At, 1, 0); PG8_STAGE(PG8_SA(0, 1), a2 + hstep, voffA);
            PG8_WAIT_L(8); PG8_BAR; PG8_WAIT_L(0); PG8_MMA(0, 0, At, B0); PG8_BAR; PG8_SCHED;
            PG8_LDB(B1, 1, 1); PG8_STAGE(PG8_SB(1, 0), b3, voffB);
            PG8_BAR; PG8_WAIT_L(0); PG8_MMA(0, 1, At, B1); PG8_BAR;
            PG8_LDA(At, 1, 1); PG8_STAGE(PG8_SA(1, 0), a3, voffA);
            PG8_BAR; PG8_WAIT_L(0); PG8_MMA(1, 0, At, B0); PG8_BAR; PG8_SCHED;
            PG8_STAGE(PG8_SB(1, 1), b3 + hstep, voffB);
            PG8_WAIT_V(6); PG8_BAR; PG8_MMA(1, 1, At, B1); PG8_BAR;
        }
        { const int l2 = fresh_tid(wv) & 63; E(acc, cur, wr, wc, l2 & 15, l2 >> 4); } S.done(cur);
        if (!has_next) break;
#pragma unroll
        for (int a = 0; a < 2; ++a)
#pragma unroll
            for (int b = 0; b < 2; ++b)
#pragma unroll
                for (int m = 0; m < 4; ++m)
#pragma unroll
                    for (int n = 0; n < 2; ++n) acc[a][b][m][n] = (f32x4){0.f, 0.f, 0.f, 0.f};
        cur = nxt; cA = nA; cB = nB; ++ui;
    }
    PG8_WAIT_V(0);
    if (wr == 0) PG8_BAR;
    PG8_BAR;
#undef PG8_SA
#undef PG8_SB
#undef PG8_STAGE
#undef PG8_LDA
#undef PG8_LDB
#undef PG8_MMA
#undef PG8_WAIT_V
#undef PG8_WAIT_L
#undef PG8_BAR
#undef PG8_SCHED
}
}

using pg8::bf16_t; using pg8::f32x4; using pg8::bf16x8; using pg8::u32x4; using pg8::u32x2;
#define LAS __attribute__((address_space(3)))

constexpr int D = 1024, DFF = 2816, NGU = 5632, NCOLS = 3840;
constexpr int MP = 16384, MS = 512, MT = 16896, MIN_ = 17152;
constexpr int LDS_BYTES = 147456;
constexpr size_t O_SHP = 17301504, O_WKP = O_SHP + 8192, O_RTP = O_WKP + 262144, O_SHS = O_RTP + 524288, O_WKS = O_SHS + 131072, O_RTS = O_WKS + 4194304;
constexpr size_t WS_ROPE = 16384;
constexpr size_t WS_WL   = WS_ROPE + 1050624;
constexpr size_t WS_WOUT = WS_WL + 786432;
constexpr size_t WS_WIN  = WS_WOUT + 2097152;
constexpr size_t WS_WGU  = WS_WIN + 7864320;
constexpr size_t WS_WD   = WS_WGU + 11534336;
constexpr size_t WS_XN   = WS_WD + 5767168;
constexpr size_t WS_BIG  = WS_XN + 35127296;
constexpr size_t WS_FO   = WS_BIG + 95158272;
constexpr size_t WS_YS   = WS_BIG + 131727360;
constexpr size_t WS_LA   = WS_YS + 17301504;
constexpr size_t WS_OMD  = WS_BIG + 164364288;
constexpr size_t WS_ASIG = WS_OMD + 17301504;
constexpr size_t WS_END  = WS_ASIG + 17301504;
static_assert(WS_LA + 8650752 <= WS_OMD, "mixer overlays");
static_assert(WS_END <= 268435456, "workspace");

struct Params {
    const float *x_prompt, *x_sample, *state_shift, *state_wkv, *state_ret, *norm_g, *f1g, *f1u, *f1d, *w_in, *mu, *w0, *w2, *a0, *a2, *g2, *k_k, *k_a, *r_k, *lnx_w, *lnx_b, *gn_w, *w_out, *f2g, *f2u, *f2d;
    float* out; unsigned char* ws;
};
#define CAS __attribute__((address_space(4)))
typedef const CAS Params& PR;

__device__ __forceinline__ float bf2f(unsigned b) { return __uint_as_float(b << 16); }
__device__ __forceinline__ bf16_t f2bf(float f) { unsigned u = __float_as_uint(f); u += 0x7FFFu + ((u >> 16) & 1u); return (bf16_t)(u >> 16); }
__device__ __forceinline__ float lo_bf(unsigned x) { return __uint_as_float(x << 16); }
__device__ __forceinline__ float hi_bf(unsigned x) { return __uint_as_float(x & 0xffff0000u); }
template <int CTRL> __device__ __forceinline__ float dppf(float v) { return __int_as_float(__builtin_amdgcn_update_dpp(0, __float_as_int(v), CTRL, 0xF, 0xF, false)); }
__device__ __forceinline__ float row16_sum(float v) { v += dppf<0xB1>(v); v += dppf<0x4E>(v); v += dppf<0x141>(v); v += dppf<0x140>(v); return v; }
__device__ __forceinline__ float wave_sum(float v) { v = row16_sum(v); const int i = __float_as_int(v);
    return __int_as_float(__builtin_amdgcn_readlane(i, 0)) + __int_as_float(__builtin_amdgcn_readlane(i, 16)) + __int_as_float(__builtin_amdgcn_readlane(i, 32)) + __int_as_float(__builtin_amdgcn_readlane(i, 48)); }
__device__ __forceinline__ float quad_sum(float v) { v += dppf<0xB1>(v); v += dppf<0x4E>(v); return v; }
__device__ __forceinline__ float sigmoid_f(float x) { return __builtin_amdgcn_rcpf(1.0f + __expf(-x)); }


#define XB_TMO      128
#define XB_XCNT(j)  (256  + 64 * (j))
#define XB_XSUB(j)  (1280 + 64 * (j))
#define XB_XGEN(j)  (2304 + 64 * (j))
#define XB_TOP      3328
#define XB_TOPGEN   3392
#define XCD_BAR_WORDS 3456
#define XB_SPIN_CAP (1u << 18)
__device__ __forceinline__ unsigned xb_ld(unsigned* p)              { return __hip_atomic_load(p, __ATOMIC_RELAXED, __HIP_MEMORY_SCOPE_AGENT); }
__device__ __forceinline__ unsigned xb_add(unsigned* p, unsigned v) { return __hip_atomic_fetch_add(p, v, __ATOMIC_RELAXED, __HIP_MEMORY_SCOPE_AGENT); }
__device__ __forceinline__ unsigned xb_xcc_id() { return (unsigned)__builtin_amdgcn_s_getreg((3 << 11) | 20) & 0xFu; }
#define XB_SPIN(cond, bar) do { unsigned _sp = 0; while (cond) { __builtin_amdgcn_s_sleep(1); \
    if ((++_sp & 255u) == 0u) { if (xb_ld(&(bar)[XB_TMO])) break; if (_sp > XB_SPIN_CAP) { atomicAdd(&(bar)[XB_TMO], 1u); break; } } } } while (0)
struct XcdBarrier { unsigned* bar; unsigned x; volatile LAS unsigned* st; };
__device__ __forceinline__ XcdBarrier xcd_barrier_post(unsigned* bar, volatile LAS unsigned* st) {
    XcdBarrier b; b.bar = bar; b.x = xb_xcc_id(); b.st = st;
    return b;
}
__device__ __forceinline__ void xcd_barrier_complete(unsigned* bar, unsigned x, unsigned& nloc, unsigned& nx) {
    const unsigned G = gridDim.x * gridDim.y * gridDim.z;
    unsigned sum, cnt, mine, sp = 0u;
    for (;;) {
        sum = 0u; cnt = 0u; mine = 0u;
#pragma unroll
        for (unsigned j = 0; j < 16; ++j) { const unsigned c = xb_ld(&bar[XB_XCNT(j)]); sum += c; cnt += (c > 0u) ? 1u : 0u; mine = (j == x) ? c : mine; }
        if (sum == G) break;
        __builtin_amdgcn_s_sleep(1);
        if ((++sp & 255u) == 0u) { if (xb_ld(&bar[XB_TMO])) break; if (sp > XB_SPIN_CAP) { atomicAdd(&bar[XB_TMO], 1u); break; } }
    }
    nloc = mine > 0u ? mine : 1u; nx = cnt > 0u ? cnt : 1u;
}
__device__ __forceinline__ void xcd_barrier(unsigned* barw, volatile LAS unsigned* stw, const int wv) {
    XcdBarrier b; b.bar = barw; b.x = xb_xcc_id(); b.st = stw;
    asm volatile("s_waitcnt vmcnt(0)" ::: "memory");
    __syncthreads();
    if (fresh_tid(wv) == 0) {
        unsigned* bar = b.bar;
        __builtin_amdgcn_s_waitcnt(0);
        unsigned nloc = b.st[0], nx = b.st[1];
        if (nloc == 0u) { xcd_barrier_complete(bar, b.x, nloc, nx); b.st[0] = nloc; b.st[1] = nx; }
        const unsigned old = xb_add(&bar[XB_XSUB(b.x)], 1u);
        const unsigned gen = old / nloc;
        if (old + 1u == (gen + 1u) * nloc) {
            __builtin_amdgcn_fence(__ATOMIC_RELEASE, "agent");
            asm volatile("s_waitcnt vmcnt(0)" ::: "memory");
            const unsigned og = xb_add(&bar[XB_TOP], 1u);
            const unsigned tg = og / nx;
            if (og + 1u == (tg + 1u) * nx) xb_add(&bar[XB_TOPGEN], 1u);
            else XB_SPIN(xb_ld(&bar[XB_TOPGEN]) == tg, bar);
            __builtin_amdgcn_fence(__ATOMIC_ACQUIRE, "agent");
            xb_add(&bar[XB_XGEN(b.x)], 1u);
            asm volatile("s_waitcnt vmcnt(0)" ::: "memory");
        } else {
            XB_SPIN(xb_ld(&bar[XB_XGEN(b.x)]) == gen, bar);
            __builtin_amdgcn_fence(__ATOMIC_ACQUIRE, "agent");
            asm volatile("s_waitcnt vmcnt(0)" ::: "memory");
        }
    }
    __syncthreads();
}


#define DPP2(x, y, CTRL, NOP) asm volatile(NOP "\n\tv_add_f32_dpp %0, %0, %0 " CTRL " row_mask:0xf bank_mask:0xf bound_ctrl:1\n\tv_add_f32_dpp %1, %1, %1 " CTRL " row_mask:0xf bank_mask:0xf bound_ctrl:1" : "+v"(x), "+v"(y))
#define DPP4(x, y, z, w, CTRL, NOP) asm volatile(NOP "\n\tv_add_f32_dpp %0, %0, %0 " CTRL " row_mask:0xf bank_mask:0xf bound_ctrl:1\n\tv_add_f32_dpp %1, %1, %1 " CTRL " row_mask:0xf bank_mask:0xf bound_ctrl:1\n\tv_add_f32_dpp %2, %2, %2 " CTRL " row_mask:0xf bank_mask:0xf bound_ctrl:1\n\tv_add_f32_dpp %3, %3, %3 " CTRL " row_mask:0xf bank_mask:0xf bound_ctrl:1" : "+v"(x), "+v"(y), "+v"(z), "+v"(w))
#define ROW16_SUM4(x, y, z, w) do { DPP4(x, y, z, w, "quad_perm:[1,0,3,2]", "s_nop 1"); DPP4(x, y, z, w, "quad_perm:[2,3,0,1]", ""); DPP4(x, y, z, w, "row_half_mirror", ""); DPP4(x, y, z, w, "row_mirror", ""); } while (0)
#define ROW16_SUM2(x, y) do { DPP2(x, y, "quad_perm:[1,0,3,2]", "s_nop 1"); DPP2(x, y, "quad_perm:[2,3,0,1]", "s_nop 0"); DPP2(x, y, "row_half_mirror", "s_nop 0"); DPP2(x, y, "row_mirror", "s_nop 0"); } while (0)
__device__ __forceinline__ int prev_row(int r) {
    if (r < MP) return (r & 2047) == 0 ? -1 : r - 1;
    const int s = r - MP; return (s & 3) == 0 ? MT + (s >> 2) : r - 1;
}

struct TDesc { const float* W; bf16_t* Bt; int K, N, k0, n0, brow0; };
__device__ __forceinline__ TDesc tconv_desc(const float* wg, const float* wu, const float* wd, const float* win, const float* wout, unsigned char* ws, int i) {
    TDesc d; int mode = 0, tile = i;
    if (i < 704) { d.W = wg; d.Bt = (bf16_t*)(ws + WS_WGU); d.K = 1024; d.N = DFF; mode = 1; }
    else if (i < 1408) { d.W = wu; d.Bt = (bf16_t*)(ws + WS_WGU); d.K = 1024; d.N = DFF; mode = 2; tile = i - 704; }
    else if (i < 2112) { d.W = wd; d.Bt = (bf16_t*)(ws + WS_WD); d.K = DFF; d.N = 1024; tile = i - 1408; }
    else if (i < 3072) { d.W = win; d.Bt = (bf16_t*)(ws + WS_WIN); d.K = 1024; d.N = NCOLS; tile = i - 2112; }
    else { d.W = wout; d.Bt = (bf16_t*)(ws + WS_WOUT); d.K = 1024; d.N = 1024; tile = i - 3072; }
    const int nkt = d.K / 64; const int kt = tile % nkt, nt = tile / nkt; d.k0 = kt * 64; d.n0 = nt * 64;
    d.brow0 = mode == 0 ? d.n0 : ((d.n0 >> 7) * 256 + (d.n0 & 127) + (mode == 2 ? 128 : 0));
    return d;
}
__device__ __forceinline__ void tconv_list(const float* wg, const float* wu, const float* wd, const float* win, const float* wout, unsigned char* ws, const int ntiles, LAS float* t, const int wv) {
    const int tid = fresh_tid(wv); const int G = gridDim.x;
    float cur[8], nxt[8];
    int i = blockIdx.x;
    if (i < ntiles) { const TDesc d = tconv_desc(wg, wu, wd, win, wout, ws, i);
#pragma unroll
        for (int e = 0; e < 8; ++e) { const int idx = e * 512 + tid, r = idx >> 6, c = idx & 63; cur[e] = d.W[(size_t)(d.k0 + r) * d.N + d.n0 + c]; } }
    for (; i < ntiles; i += G) {
        const TDesc d = tconv_desc(wg, wu, wd, win, wout, ws, i);
        { const TDesc dn = tconv_desc(wg, wu, wd, win, wout, ws, i + G < ntiles ? i + G : i);
#pragma unroll
            for (int e = 0; e < 8; ++e) { const int idx = e * 512 + tid, r = idx >> 6, c = idx & 63; nxt[e] = dn.W[(size_t)(dn.k0 + r) * dn.N + dn.n0 + c]; } }
#pragma unroll
        for (int e = 0; e < 8; ++e) { const int idx = e * 512 + tid, r = idx >> 6, c = idx & 63; t[r * 65 + c] = cur[e]; }
        __syncthreads();
#pragma unroll
        for (int e = 0; e < 4; ++e) { const int idx = e * 512 + tid, n = idx >> 5, kp = idx & 31;
            const unsigned w = pg8::cvt_pk_bf16(t[(2 * kp) * 65 + n], t[(2 * kp + 1) * 65 + n]);
            *(unsigned*)(d.Bt + (size_t)(d.brow0 + n) * d.K + d.k0 + 2 * kp) = w; }
        __syncthreads();
#pragma unroll
        for (int e = 0; e < 8; ++e) cur[e] = nxt[e];
    }
}

struct RowRaw { float4 xf[4]; u32x2 xb[4]; u32x2 fb[4]; };
__device__ __forceinline__ void rows_load(PR P, const int mode, const int row, const int lane, RowRaw& R) {
    if (mode <= 1) { const float* xin = P.x_prompt + (size_t)row * 1024;
#pragma unroll
        for (int q = 0; q < 4; ++q) { const f32x4 t_ = __builtin_nontemporal_load((const f32x4*)(xin + (q * 64 + lane) * 4)); R.xf[q] = make_float4(t_[0], t_[1], t_[2], t_[3]); } }
    else { const bf16_t* xb = (mode == 2 ? (const bf16_t*)P.out : (const bf16_t*)(P.ws + WS_FO + 34603008)) + (size_t)row * 1024;
#pragma unroll
        for (int q = 0; q < 4; ++q) R.xb[q] = __builtin_nontemporal_load((const u32x2*)(xb + (q * 64 + lane) * 4)); }
    if (mode != 0) { const bf16_t* FO = (const bf16_t*)(P.ws + WS_FO) + (size_t)row * 1024;
#pragma unroll
        for (int q = 0; q < 4; ++q) R.fb[q] = __builtin_nontemporal_load((const u32x2*)(FO + (q * 64 + lane) * 4)); }
}
__device__ __forceinline__ void rows_proc(PR P, const int mode, const int row, const int lane, float4 (&xv)[4], const float4 (&fo)[4], const float4 (&gp)[4], const float4 (&gn)[4]) {
    bf16_t* XN = (bf16_t*)(P.ws + WS_XN);
    if (mode != 0) {
        float ss = 0.f;
#pragma unroll
        for (int q = 0; q < 4; ++q) ss += fo[q].x * fo[q].x + fo[q].y * fo[q].y + fo[q].z * fo[q].z + fo[q].w * fo[q].w;
        ss = wave_sum(ss); const float r = rsqrtf(ss * (1.0f / 1024.0f) + 1e-6f) * (mode == 2 ? 1.0f : 0.5f);
#pragma unroll
        for (int q = 0; q < 4; ++q) {
            xv[q].x += fo[q].x * r * gp[q].x; xv[q].y += fo[q].y * r * gp[q].y; xv[q].z += fo[q].z * r * gp[q].z; xv[q].w += fo[q].w * r * gp[q].w;
            if (mode == 3) { const f32x4 t_ = {xv[q].x, xv[q].y, xv[q].z, xv[q].w}; __builtin_nontemporal_store(t_, (f32x4*)(P.out + (size_t)row * 1024 + (q * 64 + lane) * 4)); }
            else { bf16_t* xo = (mode == 1 ? (bf16_t*)P.out : (bf16_t*)(P.ws + WS_FO + 34603008)) + (size_t)row * 1024; u32x2 t; t.x = pg8::cvt_pk_bf16(xv[q].x, xv[q].y); t.y = pg8::cvt_pk_bf16(xv[q].z, xv[q].w);
                __builtin_nontemporal_store(t, (u32x2*)(xo + (q * 64 + lane) * 4)); } }
        if (mode == 3) return;
    }
    float ss2 = 0.f;
#pragma unroll
    for (int q = 0; q < 4; ++q) ss2 += xv[q].x * xv[q].x + xv[q].y * xv[q].y + xv[q].z * xv[q].z + xv[q].w * xv[q].w;
    ss2 = wave_sum(ss2); const float r2 = rsqrtf(ss2 * (1.0f / 1024.0f) + 1e-6f);
    float* sh = nullptr;
    if (mode == 1) { if (row < MP) { if ((row & 2047) == 2047) sh = P.out + O_SHP + (size_t)(row >> 11) * 1024; } else { const int s = row - MP; if ((s & 3) == 3) sh = P.out + O_SHS + (size_t)(s >> 2) * 1024; } }
#pragma unroll
    for (int q = 0; q < 4; ++q) {
        float4 hv; hv.x = xv[q].x * r2 * gn[q].x; hv.y = xv[q].y * r2 * gn[q].y; hv.z = xv[q].z * r2 * gn[q].z; hv.w = xv[q].w * r2 * gn[q].w;
        u32x2 w; w.x = pg8::cvt_pk_bf16(hv.x, hv.y); w.y = pg8::cvt_pk_bf16(hv.z, hv.w);
        *(u32x2*)(XN + (size_t)row * 1024 + (q * 64 + lane) * 4) = w;
        if (sh) *(float4*)(sh + (q * 64 + lane) * 4) = hv; }
}
__device__ __forceinline__ void rows_phase(PR P, const int mode, const int wv) {
    const int tid = fresh_tid(wv); const int lane = tid & 63; const int gw = blockIdx.x * 8 + (tid >> 6), nw = gridDim.x * 8;
    const float* gpost = P.norm_g + (mode == 1 ? 1 : (mode == 2 ? 3 : 5)) * 1024;
    const float* gnext = P.norm_g + (mode == 0 ? 0 : (mode == 1 ? 2 : 4)) * 1024;
    float4 gp[4], gn[4];
#pragma unroll
    for (int q = 0; q < 4; ++q) { gp[q] = *(const float4*)(gpost + (q * 64 + lane) * 4); gn[q] = *(const float4*)(gnext + (q * 64 + lane) * 4); }
    if (gw < MP) {
        const int last = gw + ((MP - 1 - gw) / nw) * nw;
        RowRaw R, N;
        rows_load(P, mode, gw, lane, R);
        for (int row = gw; row < MP; row += nw) {
            const int nrow = row + nw < MP ? row + nw : last;
            rows_load(P, mode, nrow, lane, N);
            float4 xv[4], fo[4];
#pragma unroll
            for (int q = 0; q < 4; ++q) {
                xv[q] = mode <= 1 ? R.xf[q] : make_float4(lo_bf(R.xb[q].x), hi_bf(R.xb[q].x), lo_bf(R.xb[q].y), hi_bf(R.xb[q].y));
                fo[q] = make_float4(lo_bf(R.fb[q].x), hi_bf(R.fb[q].x), lo_bf(R.fb[q].y), hi_bf(R.fb[q].y)); }
            rows_proc(P, mode, row, lane, xv, fo, gp, gn);
            R = N;
        }
    }
    for (int row = MP + gw; row < MT; row += nw) {
        float4 xv[4], fo[4];
        if (mode <= 1) { const float* xin = P.x_sample + (size_t)(row - MP) * 1024;
#pragma unroll
            for (int q = 0; q < 4; ++q) xv[q] = *(const float4*)(xin + (q * 64 + lane) * 4); }
        else { const bf16_t* xb = (mode == 2 ? (const bf16_t*)P.out : (const bf16_t*)(P.ws + WS_FO + 34603008)) + (size_t)row * 1024;
#pragma unroll
            for (int q = 0; q < 4; ++q) { const u32x2 t = *(const u32x2*)(xb + (q * 64 + lane) * 4); xv[q] = make_float4(lo_bf(t.x), hi_bf(t.x), lo_bf(t.y), hi_bf(t.y)); } }
        if (mode != 0) {
#pragma unroll
            for (int q = 0; q < 4; ++q) { const int KS = mode == 2 ? 4 : 8; const float* sl = (const float*)(P.ws + WS_OMD) + (size_t)((((row - MP) >> 8) * 4 + q) * KS) * 65536 + (size_t)(row & 255) * 256 + lane * 4;
                float4 a = *(const float4*)sl;
                for (int p = 1; p < KS; ++p) { const float4 b = *(const float4*)(sl + (size_t)p * 65536); a.x += b.x; a.y += b.y; a.z += b.z; a.w += b.w; }
                fo[q] = a; } }
        else {
#pragma unroll
            for (int q = 0; q < 4; ++q) fo[q] = make_float4(0.f, 0.f, 0.f, 0.f); }
        rows_proc(P, mode, row, lane, xv, fo, gp, gn);
    }
}

__device__ __forceinline__ void p0_prologue(PR P, LAS float* ldsf, const int wv) {
    const int tid = fresh_tid(wv); const size_t gt = (size_t)blockIdx.x * 512 + tid, nth = (size_t)gridDim.x * 512;
    { float* rc = (float*)(P.ws + WS_ROPE); float* rs = rc + 2052 * 64;
      for (size_t i = gt; i < 2052 * 64; i += nth) { const int p = (int)(i >> 6), f = (int)(i & 63); const int pos = p < 2048 ? p : 16384 + (p - 2048);
          double inv = 1.0; for (int q = 0; q < f; ++q) inv *= 0.8659643233600653;
          const double ang = (double)pos * inv; const double n = rint(ang * 0.15915494309189535); const double r = ang - n * 6.283185307179586;
          const double r2 = r * r; double s = 0.0, c = 0.0;
          for (int k = 14; k >= 0; --k) { s = s * (-r2 / (double)((2 * k + 2) * (2 * k + 3))) + 1.0; c = c * (-r2 / (double)((2 * k + 1) * (2 * k + 2))) + 1.0; }
          rc[i] = (float)c; rs[i] = (float)(s * r); } }
    { bf16_t* Wl = (bf16_t*)(P.ws + WS_WL);
      for (size_t i = gt; i < 1536 * 256; i += nth) { const int n = (int)(i >> 8), k = (int)(i & 255); float v = 0.f;
          if (n < 512) { if (k < 64) v = P.w2[k * 512 + n]; } else if (n < 1024) { if (k >= 64 && k < 128) v = P.a2[(k - 64) * 512 + (n - 512)]; } else { if (k >= 128) v = P.g2[(k - 128) * 512 + (n - 1024)]; }
          Wl[i] = f2bf(v); } }
    { bf16_t* XN = (bf16_t*)(P.ws + WS_XN);
      for (size_t i = gt; i < 256 * 1024; i += nth) { const int r = (int)(i >> 10); XN[(size_t)MT * 1024 + i] = r < 128 ? f2bf(P.state_shift[i]) : (bf16_t)0; } }
    tconv_list(P.f1g, P.f1u, P.f1d, P.w_in, P.w_out, P.ws, 3328, ldsf, wv);
    rows_phase(P, 0, wv);
}

__device__ __forceinline__ void lora_prep(PR P, const int wv) {
    const int tid = fresh_tid(wv); const int lane = tid & 63; const int gw = blockIdx.x * 8 + (tid >> 6), nw = gridDim.x * 8;
    const bf16_t* PS = (const bf16_t*)(P.ws + WS_BIG); bf16_t* LA = (bf16_t*)(P.ws + WS_LA);
    const float4 mu = *(const float4*)(P.mu + 1536 + lane * 4); const int kind = lane >> 4;
    if (gw >= MT) return;
    const int last = gw + ((MT - 1 - gw) / nw) * nw;
    u32x2 c, p, nc, np;
    { const int pr = prev_row(gw); c = *(const u32x2*)(PS + (size_t)gw * NCOLS + 1536 + lane * 4); p = *(const u32x2*)(PS + (size_t)(pr >= 0 ? pr : gw) * NCOLS + 1536 + lane * 4); }
    for (int row = gw; row < MT; row += nw) {
        const int nrow = row + nw < MT ? row + nw : last; const int npr = prev_row(nrow);
        nc = *(const u32x2*)(PS + (size_t)nrow * NCOLS + 1536 + lane * 4); np = *(const u32x2*)(PS + (size_t)(npr >= 0 ? npr : nrow) * NCOLS + 1536 + lane * 4);
        if (prev_row(row) < 0) p = (u32x2){0u, 0u};
        float v[4]; const float cu[4] = {lo_bf(c.x), hi_bf(c.x), lo_bf(c.y), hi_bf(c.y)}, pv[4] = {lo_bf(p.x), hi_bf(p.x), lo_bf(p.y), hi_bf(p.y)}, m4[4] = {mu.x, mu.y, mu.z, mu.w};
#pragma unroll
        for (int j = 0; j < 4; ++j) { float x = cu[j] + (pv[j] - cu[j]) * m4[j];
            if (kind == 0) x = 1.0f - 2.0f * __builtin_amdgcn_rcpf(__expf(2.0f * x) + 1.0f); else if (kind >= 2) x = sigmoid_f(x);
            v[j] = x; }
        u32x2 w; w.x = pg8::cvt_pk_bf16(v[0], v[1]); w.y = pg8::cvt_pk_bf16(v[2], v[3]);
        *(u32x2*)(LA + (size_t)row * 256 + lane * 4) = w;
        c = nc; p = np;
    }
}

template <bool SAMPLE>
__device__ __forceinline__ void rwkv_unit(PR P, LAS float* lds, const int b, const int h, const int half, const int wv) {
    constexpr int T = SAMPLE ? 4 : 2048, TC = SAMPLE ? 4 : 32, NCH = T / TC;
    const int tid = fresh_tid(wv), lane = tid & 63, wid = tid >> 6;
    const bf16_t* PS = (const bf16_t*)(P.ws + WS_BIG); const bf16_t* OMD = (const bf16_t*)(P.ws + WS_OMD); const bf16_t* ASIG = (const bf16_t*)(P.ws + WS_ASIG);
    bf16_t* YS = (bf16_t*)(P.ws + WS_YS);
    const int row_base = SAMPLE ? MP + b * 4 : b * 2048;
    const int ltok = (tid - 256) >> 4, lcg = tid & 15; const bool lwave = tid >= 256; const int hch = h * 64 + lcg * 4;
    const float4 mur = *(const float4*)(P.mu + hch), muk = *(const float4*)(P.mu + 512 + hch), muv = *(const float4*)(P.mu + 1024 + hch);
    const float4 kk4 = *(const float4*)(P.k_k + hch), ka4 = *(const float4*)(P.k_a + hch);
    typedef float f32x2 __attribute__((ext_vector_type(2)));
    const int row0 = half * 32 + (wid & 3) * 8 + (lane >> 4) * 2, cgl = lane & 15, j0 = cgl * 4;
    f32x2 S[4];
#pragma unroll
    for (int c = 0; c < 4; ++c) S[c] = (f32x2){0.f, 0.f};
    float* sout = P.out + (SAMPLE ? O_WKS : O_WKP) + ((size_t)(b * 8 + h) * 64 + row0) * 64 + j0;
    if (SAMPLE && wid < 4) { const float* sp = P.state_wkv + ((size_t)(b * 8 + h) * 64 + row0) * 64 + j0; const float4 s0 = *(const float4*)sp, s1 = *(const float4*)(sp + 64);
        S[0] = (f32x2){s0.x, s1.x}; S[1] = (f32x2){s0.y, s1.y}; S[2] = (f32x2){s0.z, s1.z}; S[3] = (f32x2){s0.w, s1.w}; }
    LAS float* buf0 = lds; LAS float* buf1 = lds + TC * 384;
    u32x2 cr[2], ck[2], cv[2], pr[2], pk[2], pv[2], co[2], ca[2];
#define RW_LOAD1(c, U) do { if (lwave && ltok + 16 * (U) < TC) { const int t_ = (c) * TC + ltok + 16 * (U); const int row_ = row_base + t_; const int prow_ = SAMPLE ? (t_ == 0 ? MT + b : row_ - 1) : row_ - 1; \
        const bf16_t* cp_ = PS + (size_t)row_ * NCOLS + hch; cr[U] = *(const u32x2*)cp_; ck[U] = *(const u32x2*)(cp_ + 512); cv[U] = *(const u32x2*)(cp_ + 1024); \
        if (SAMPLE || t_ > 0) { const bf16_t* pp_ = PS + (size_t)prow_ * NCOLS + hch; pr[U] = *(const u32x2*)pp_; pk[U] = *(const u32x2*)(pp_ + 512); pv[U] = *(const u32x2*)(pp_ + 1024); } \
        else { pr[U] = (u32x2){0u, 0u}; pk[U] = pr[U]; pv[U] = pr[U]; } \
        co[U] = *(const u32x2*)(OMD + (size_t)row_ * 512 + hch); ca[U] = *(const u32x2*)(ASIG + (size_t)row_ * 512 + hch); } } while (0)
#define RW_LOAD(c) do { RW_LOAD1(c, 0); RW_LOAD1(c, 1); } while (0)
#define RW_MIX(cu, pv_, m) ((cu) + ((pv_) - (cu)) * (m))
#define RW_PROC1(dst, U) do { if (lwave && ltok + 16 * (U) < TC) { LAS float* d_ = (dst) + (ltok + 16 * (U)) * 384 + lcg * 4; \
        f32x4 r_, k_, v_, o_, a_; \
        r_[0] = RW_MIX(lo_bf(cr[U].x), lo_bf(pr[U].x), mur.x); r_[1] = RW_MIX(hi_bf(cr[U].x), hi_bf(pr[U].x), mur.y); r_[2] = RW_MIX(lo_bf(cr[U].y), lo_bf(pr[U].y), mur.z); r_[3] = RW_MIX(hi_bf(cr[U].y), hi_bf(pr[U].y), mur.w); \
        k_[0] = RW_MIX(lo_bf(ck[U].x), lo_bf(pk[U].x), muk.x); k_[1] = RW_MIX(hi_bf(ck[U].x), hi_bf(pk[U].x), muk.y); k_[2] = RW_MIX(lo_bf(ck[U].y), lo_bf(pk[U].y), muk.z); k_[3] = RW_MIX(hi_bf(ck[U].y), hi_bf(pk[U].y), muk.w); \
        v_[0] = RW_MIX(lo_bf(cv[U].x), lo_bf(pv[U].x), muv.x); v_[1] = RW_MIX(hi_bf(cv[U].x), hi_bf(pv[U].x), muv.y); v_[2] = RW_MIX(lo_bf(cv[U].y), lo_bf(pv[U].y), muv.z); v_[3] = RW_MIX(hi_bf(cv[U].y), hi_bf(pv[U].y), muv.w); \
        o_[0] = lo_bf(co[U].x); o_[1] = hi_bf(co[U].x); o_[2] = lo_bf(co[U].y); o_[3] = hi_bf(co[U].y); a_[0] = lo_bf(ca[U].x); a_[1] = hi_bf(ca[U].x); a_[2] = lo_bf(ca[U].y); a_[3] = hi_bf(ca[U].y); \
        f32x4 kk_; kk_[0] = k_[0] * kk4.x; kk_[1] = k_[1] * kk4.y; kk_[2] = k_[2] * kk4.z; kk_[3] = k_[3] * kk4.w; \
        float ss_ = kk_[0] * kk_[0] + kk_[1] * kk_[1] + kk_[2] * kk_[2] + kk_[3] * kk_[3]; ss_ = row16_sum(ss_); \
        const float inv_ = __builtin_amdgcn_rcpf(fmaxf(__builtin_amdgcn_sqrtf(ss_), 1e-12f)); kk_ = kk_ * inv_; \
        f32x4 kn_; kn_[0] = k_[0] * (1.0f + (a_[0] - 1.0f) * ka4.x); kn_[1] = k_[1] * (1.0f + (a_[1] - 1.0f) * ka4.y); kn_[2] = k_[2] * (1.0f + (a_[2] - 1.0f) * ka4.z); kn_[3] = k_[3] * (1.0f + (a_[3] - 1.0f) * ka4.w); \
        *(LAS f32x4*)(d_) = r_; *(LAS f32x4*)(d_ + 64) = o_; *(LAS f32x4*)(d_ + 128) = kn_; *(LAS f32x4*)(d_ + 192) = -kk_; *(LAS f32x4*)(d_ + 256) = kk_ * a_; *(LAS f32x4*)(d_ + 320) = v_; } } while (0)
#define RW_PROC(dst) do { RW_PROC1(dst, 0); RW_PROC1(dst, 1); } while (0)
    RW_LOAD(0); RW_PROC(buf0); __syncthreads();
    for (int c = 0; c < NCH; ++c) {
        LAS float* cur = (c & 1) ? buf1 : buf0; LAS float* nxt = (c & 1) ? buf0 : buf1;
        if (c + 1 < NCH) RW_LOAD(c + 1);
        if (wid < 4) {
            constexpr int GS = SAMPLE ? 4 : 16;
            for (int g = 0; g < TC / GS; ++g) {
                float yk0 = 0.f, yk1 = 0.f;
                const LAS float* q0 = cur + (g * GS) * 384;
                f32x4 r4 = *(const LAS f32x4*)(q0 + j0), o4 = *(const LAS f32x4*)(q0 + 64 + j0), k4 = *(const LAS f32x4*)(q0 + 128 + j0), a4 = *(const LAS f32x4*)(q0 + 192 + j0), b4 = *(const LAS f32x4*)(q0 + 256 + j0);
                f32x2 v2 = *(const LAS f32x2*)(q0 + 320 + row0);
                float py0 = 0.f, py1 = 0.f;
#pragma unroll
                for (int tt = 0; tt < GS; ++tt) {
                    const LAS float* qn = q0 + (tt + 1 < GS ? tt + 1 : tt) * 384;
                    const f32x4 nr4 = *(const LAS f32x4*)(qn + j0), no4 = *(const LAS f32x4*)(qn + 64 + j0), nk4 = *(const LAS f32x4*)(qn + 128 + j0), na4 = *(const LAS f32x4*)(qn + 192 + j0), nb4 = *(const LAS f32x4*)(qn + 256 + j0);
                    const f32x2 nv2 = *(const LAS f32x2*)(qn + 320 + row0);
                    f32x2 sa = (S[0] * a4[0] + S[1] * a4[1]) + (S[2] * a4[2] + S[3] * a4[3]);
                    float sx = sa.x, sy = sa.y; ROW16_SUM4(sx, sy, py0, py1); sa = (f32x2){sx, sy};
                    if (tt > 0) { yk0 = cgl == tt - 1 ? py0 : yk0; yk1 = cgl == tt - 1 ? py1 : yk1; }
#pragma unroll
                    for (int c = 0; c < 4; ++c) { f32x2 t = S[c] - S[c] * o4[c]; t = t + sa * b4[c]; S[c] = t + v2 * k4[c]; }
                    const f32x2 y = (S[0] * r4[0] + S[1] * r4[1]) + (S[2] * r4[2] + S[3] * r4[3]);
                    py0 = y.x; py1 = y.y;
                    r4 = nr4; o4 = no4; k4 = nk4; a4 = na4; b4 = nb4; v2 = nv2;
                }
                ROW16_SUM2(py0, py1); yk0 = cgl == GS - 1 ? py0 : yk0; yk1 = cgl == GS - 1 ? py1 : yk1;
                if (cgl < GS) *(unsigned*)(YS + (size_t)(row_base + c * TC + g * GS + cgl) * 512 + h * 64 + row0) = pg8::cvt_pk_bf16(yk0, yk1);
            }
        }
        if (c + 1 < NCH) RW_PROC(nxt);
        __syncthreads();
    }
    if (wid < 4) { *(float4*)sout = make_float4(S[0].x, S[1].x, S[2].x, S[3].x); *(float4*)(sout + 64) = make_float4(S[0].y, S[1].y, S[2].y, S[3].y); }
#undef RW_LOAD
#undef RW_PROC
#undef RW_LOAD1
#undef RW_PROC1
#undef RW_MIX
}

__device__ __forceinline__ void ret_sample_unit(PR P, LAS float* lds, const int b, const int h, const int wv) {
    const int tid = fresh_tid(wv), lane = tid & 63, wid = tid >> 6;
    const bf16_t* PS = (const bf16_t*)(P.ws + WS_BIG); bf16_t* Y = (bf16_t*)(P.ws + WS_XN);
    const float* rc = (const float*)(P.ws + WS_ROPE); const float* rs = rc + 2052 * 64;
    LAS float* q = lds; LAS float* k = lds + 512; LAS float* v = lds + 1024; LAS float* Pm = lds + 1536; LAS float* y2p = lds + 1600; LAS float* red = lds + 1600 + 2048;
    const float lg2 = log2f(1.0f - exp2f(-5.0f - (float)h));
    const int row0 = MP + b * 4;
    { const int t = (tid & 255) >> 6, f = tid & 63; const bf16_t* src = PS + (size_t)(row0 + t) * NCOLS + 1792 + h * 128;
      if (tid < 256) { const float cs = rc[(2048 + t) * 64 + f], sn = rs[(2048 + t) * 64 + f];
          const float q1 = bf2f(src[f]), q2 = bf2f(src[f + 64]); q[t * 128 + f] = q1 * cs - q2 * sn; q[t * 128 + f + 64] = q1 * sn + q2 * cs;
          const float k1 = bf2f(src[512 + f]), k2 = bf2f(src[512 + f + 64]); k[t * 128 + f] = (k1 * cs - k2 * sn) * 0.08838834764831845f; k[t * 128 + f + 64] = (k1 * sn + k2 * cs) * 0.08838834764831845f; }
      else { v[t * 128 + f] = bf2f(src[1024 + f]); v[t * 128 + f + 64] = bf2f(src[1024 + f + 64]); } }
    __syncthreads();
    if (wid == 0) { const int pi = lane >> 4, pj = (lane >> 2) & 3, part = lane & 3; float s = 0.f;
        for (int d = part * 32; d < part * 32 + 32; ++d) s += q[pi * 128 + d] * k[pj * 128 + d];
        s = quad_sum(s); if (part == 0) Pm[pi * 4 + pj] = pi >= pj ? s * exp2f(lg2 * (float)(pi - pj)) : 0.f; }
    { const int e = tid & 127, dg = tid >> 7; const float c4 = exp2f(lg2 * 4.0f), g3 = exp2f(lg2 * 3.0f), g2_ = exp2f(lg2 * 2.0f), g1 = exp2f(lg2);
      const float v0 = v[e] * g3, v1 = v[128 + e] * g2_, v2 = v[256 + e] * g1, v3 = v[384 + e];
      const float* S0 = P.state_ret + ((size_t)(b * 4 + h) * 128) * 128 + e; float* So = P.out + O_RTS + ((size_t)(b * 4 + h) * 128) * 128 + e;
      float a0 = 0.f, a1 = 0.f, a2 = 0.f, a3 = 0.f;
      float sv[32];
#pragma unroll
      for (int x = 0; x < 32; ++x) sv[x] = S0[(size_t)(dg * 32 + x) * 128];
#pragma unroll
      for (int x = 0; x < 32; ++x) { const int d = dg * 32 + x; const float s = sv[x];
          a0 = fmaf(q[d], s, a0); a1 = fmaf(q[128 + d], s, a1); a2 = fmaf(q[256 + d], s, a2); a3 = fmaf(q[384 + d], s, a3);
          So[(size_t)d * 128] = s * c4 + k[d] * v0 + k[128 + d] * v1 + k[256 + d] * v2 + k[384 + d] * v3; }
      y2p[(dg * 4 + 0) * 128 + e] = a0; y2p[(dg * 4 + 1) * 128 + e] = a1; y2p[(dg * 4 + 2) * 128 + e] = a2; y2p[(dg * 4 + 3) * 128 + e] = a3; }
    __syncthreads();
    { const int i = tid >> 7, e = tid & 127;
      float y = (y2p[(0 + i) * 128 + e] + y2p[(4 + i) * 128 + e] + y2p[(8 + i) * 128 + e] + y2p[(12 + i) * 128 + e]) * exp2f(lg2 * (float)(i + 1));
#pragma unroll
      for (int j = 0; j < 4; ++j) y = fmaf(Pm[i * 4 + j], v[j * 128 + e], y);
      float s = wave_sum(y); if (lane == 0) red[wid] = s; __syncthreads();
      const float mean = (red[i * 2] + red[i * 2 + 1]) * (1.0f / 128.0f); const float dlt = y - mean;
      float s2 = wave_sum(dlt * dlt); if (lane == 0) red[8 + wid] = s2; __syncthreads();
      const float var = (red[8 + i * 2] + red[8 + i * 2 + 1]) * (1.0f / 128.0f);
      const float g = bf2f(PS[(size_t)(row0 + i) * NCOLS + 1792 + 1536 + h * 128 + e]);
      const float o = dlt * rsqrtf(var + 1e-5f) * P.gn_w[h * 128 + e] * (g * __builtin_amdgcn_rcpf(1.0f + __expf(-g)));
      Y[(size_t)(row0 + i) * 1024 + 512 + h * 128 + e] = f2bf(o); }
    __syncthreads();
}

__device__ __forceinline__ bf16_t* kvb_ptr(unsigned char* ws, int bh) { return (bf16_t*)(bh < 29 ? ws + WS_LA + (size_t)bh * 524288 : ws + WS_WIN + 17301504 + (size_t)(bh - 29) * 524288); }
constexpr int RS = 136, BUFE = 128 * RS;

template <bool WITH_K>
__device__ __forceinline__ void ret_load_qk(PR P, LAS bf16_t* QP, LAS bf16_t* KB, unsigned (&kth)[4][4], const int tidv, const int row0, const int n, const int h, const float kd0, const float g32) {
    const bf16_t* PS = (const bf16_t*)(P.ws + WS_BIG); const float* rc = (const float*)(P.ws + WS_ROPE); const float* rs = rc + 2052 * 64;
    float kd = kd0;
#pragma unroll
    for (int it = 0; it < 4; ++it) { const int idx = it * 512 + tidv, i = idx >> 4, f = (idx & 15) * 4;
        const bf16_t* src = PS + (size_t)(row0 + i) * NCOLS + 1792 + h * 128;
        const u32x2 q1 = *(const u32x2*)(src + f), q2 = *(const u32x2*)(src + 64 + f);
        u32x2 k1 = (u32x2){0u, 0u}, k2 = k1; if (WITH_K) { k1 = *(const u32x2*)(src + 512 + f); k2 = *(const u32x2*)(src + 576 + f); }
        const float4 cs = *(const float4*)(rc + (size_t)(n * 128 + i) * 64 + f), sn = *(const float4*)(rs + (size_t)(n * 128 + i) * 64 + f);
        const float c4[4] = {cs.x, cs.y, cs.z, cs.w}, s4[4] = {sn.x, sn.y, sn.z, sn.w};
        const float qa[4] = {lo_bf(q1.x), hi_bf(q1.x), lo_bf(q1.y), hi_bf(q1.y)}, qb[4] = {lo_bf(q2.x), hi_bf(q2.x), lo_bf(q2.y), hi_bf(q2.y)};
        float qo1[4], qo2[4];
#pragma unroll
        for (int x = 0; x < 4; ++x) { qo1[x] = qa[x] * c4[x] - qb[x] * s4[x]; qo2[x] = qa[x] * s4[x] + qb[x] * c4[x]; }
        u32x2 w; w.x = pg8::cvt_pk_bf16(qo1[0], qo1[1]); w.y = pg8::cvt_pk_bf16(qo1[2], qo1[3]); *(LAS u32x2*)(QP + i * RS + f) = w;
        w.x = pg8::cvt_pk_bf16(qo2[0], qo2[1]); w.y = pg8::cvt_pk_bf16(qo2[2], qo2[3]); *(LAS u32x2*)(QP + i * RS + 64 + f) = w;
        if (WITH_K) {
            const float ka[4] = {lo_bf(k1.x), hi_bf(k1.x), lo_bf(k1.y), hi_bf(k1.y)}, kb[4] = {lo_bf(k2.x), hi_bf(k2.x), lo_bf(k2.y), hi_bf(k2.y)};
            float ko1[4], ko2[4];
#pragma unroll
            for (int x = 0; x < 4; ++x) { ko1[x] = (ka[x] * c4[x] - kb[x] * s4[x]) * 0.08838834764831845f; ko2[x] = (ka[x] * s4[x] + kb[x] * c4[x]) * 0.08838834764831845f; }
            w.x = pg8::cvt_pk_bf16(ko1[0], ko1[1]); w.y = pg8::cvt_pk_bf16(ko1[2], ko1[3]); *(LAS u32x2*)(KB + i * RS + f) = w;
            w.x = pg8::cvt_pk_bf16(ko2[0], ko2[1]); w.y = pg8::cvt_pk_bf16(ko2[2], ko2[3]); *(LAS u32x2*)(KB + i * RS + 64 + f) = w;
            kth[it][0] = pg8::cvt_pk_bf16(ko1[0] * kd, ko1[1] * kd); kth[it][1] = pg8::cvt_pk_bf16(ko1[2] * kd, ko1[3] * kd);
            kth[it][2] = pg8::cvt_pk_bf16(ko2[0] * kd, ko2[1] * kd); kth[it][3] = pg8::cvt_pk_bf16(ko2[2] * kd, ko2[3] * kd); kd *= g32; }
        if (it & 1) __builtin_amdgcn_sched_barrier(0); }
}

__device__ __forceinline__ void ret_unit_a(PR P, LAS unsigned char* lds, const int bh, const int n, const int wv) {
    LAS bf16_t* QP = (LAS bf16_t*)lds; LAS bf16_t* KB = QP + BUFE; LAS bf16_t* VT = KB + BUFE;
    const int tid = fresh_tid(wv), lane = tid & 63, wid = tid >> 6, wr = wid >> 1, wc = wid & 1, fr = lane & 15, fq = lane >> 4;
    const int b = bh >> 2, h = bh & 3;
    const bf16_t* PS = (const bf16_t*)(P.ws + WS_BIG); bf16_t* Y = (bf16_t*)(P.ws + WS_XN); bf16_t* KVB = kvb_ptr(P.ws, bh) + (size_t)n * 16384;
    const float lg2 = log2f(1.0f - exp2f(-5.0f - (float)h));
    const float kd0 = exp2f(lg2 * (float)(127 - (tid >> 4))), g32 = exp2f(-32.0f * lg2);
    const int row0 = b * 2048 + n * 128;
    unsigned kth[4][4];
    ret_load_qk<true>(P, QP, KB, kth, tid, row0, n, h, kd0, g32);
#pragma unroll
    for (int it = 0; it < 4; ++it) { const int idx = it * 512 + tid, j = idx >> 4, e = (idx & 15) * 8;
        const u32x4 vv = *(const u32x4*)(PS + (size_t)(row0 + j) * NCOLS + 1792 + 1024 + h * 128 + e);
        LAS bf16_t* d = VT + e * RS + j;
        d[0] = (bf16_t)(vv.x & 0xffffu); d[RS] = (bf16_t)(vv.x >> 16); d[2 * RS] = (bf16_t)(vv.y & 0xffffu); d[3 * RS] = (bf16_t)(vv.y >> 16);
        d[4 * RS] = (bf16_t)(vv.z & 0xffffu); d[5 * RS] = (bf16_t)(vv.z >> 16); d[6 * RS] = (bf16_t)(vv.w & 0xffffu); d[7 * RS] = (bf16_t)(vv.w >> 16); }
    __syncthreads();
    f32x4 accP[2][4];
#pragma unroll
    for (int mt = 0; mt < 2; ++mt)
#pragma unroll
        for (int nt = 0; nt < 4; ++nt) accP[mt][nt] = (f32x4){0.f, 0.f, 0.f, 0.f};
#pragma unroll
    for (int ks = 0; ks < 4; ++ks) { bf16x8 aq[2];
#pragma unroll
        for (int mt = 0; mt < 2; ++mt) aq[mt] = *(const LAS bf16x8*)(QP + (wr * 32 + mt * 16 + fr) * RS + ks * 32 + fq * 8);
#pragma unroll
        for (int nt = 0; nt < 4; ++nt) { const bf16x8 bk = *(const LAS bf16x8*)(KB + (wc * 64 + nt * 16 + fr) * RS + ks * 32 + fq * 8);
#pragma unroll
            for (int mt = 0; mt < 2; ++mt) accP[mt][nt] = __builtin_amdgcn_mfma_f32_16x16x32_bf16(aq[mt], bk, accP[mt][nt], 0, 0, 0); }
        __builtin_amdgcn_sched_barrier(0); }
    __syncthreads();
    { float ri[2][4], cj[4];
#pragma unroll
      for (int mt = 0; mt < 2; ++mt)
#pragma unroll
          for (int j = 0; j < 4; ++j) ri[mt][j] = exp2f(lg2 * (float)(wr * 32 + mt * 16 + fq * 4 + j));
#pragma unroll
      for (int nt = 0; nt < 4; ++nt) cj[nt] = exp2f(-lg2 * (float)(wc * 64 + nt * 16 + fr));
#pragma unroll
      for (int mt = 0; mt < 2; ++mt)
#pragma unroll
          for (int nt = 0; nt < 4; ++nt)
#pragma unroll
              for (int j = 0; j < 4; ++j) { const int i = wr * 32 + mt * 16 + fq * 4 + j, jj = wc * 64 + nt * 16 + fr;
                  const float val = i >= jj ? accP[mt][nt][j] * ri[mt][j] * cj[nt] : 0.f; QP[i * RS + jj] = f2bf(val); } }
#pragma unroll
    for (int it = 0; it < 4; ++it) { const int idx = it * 512 + tid, j = idx >> 4, f = (idx & 15) * 4; LAS bf16_t* d = KB + f * RS + j;
        d[0] = (bf16_t)(kth[it][0] & 0xffffu); d[RS] = (bf16_t)(kth[it][0] >> 16); d[2 * RS] = (bf16_t)(kth[it][1] & 0xffffu); d[3 * RS] = (bf16_t)(kth[it][1] >> 16);
        LAS bf16_t* d2 = d + 64 * RS;
        d2[0] = (bf16_t)(kth[it][2] & 0xffffu); d2[RS] = (bf16_t)(kth[it][2] >> 16); d2[2 * RS] = (bf16_t)(kth[it][3] & 0xffffu); d2[3 * RS] = (bf16_t)(kth[it][3] >> 16); }
    __syncthreads();
    f32x4 accY[2][4], accS[2][4];
#pragma unroll
    for (int mt = 0; mt < 2; ++mt)
#pragma unroll
        for (int nt = 0; nt < 4; ++nt) { accY[mt][nt] = (f32x4){0.f, 0.f, 0.f, 0.f}; accS[mt][nt] = (f32x4){0.f, 0.f, 0.f, 0.f}; }
#pragma unroll
    for (int ks = 0; ks < 4; ++ks) { bf16x8 ap[2], av[2];
#pragma unroll
        for (int mt = 0; mt < 2; ++mt) { ap[mt] = *(const LAS bf16x8*)(QP + (wr * 32 + mt * 16 + fr) * RS + ks * 32 + fq * 8); av[mt] = *(const LAS bf16x8*)(VT + (wr * 32 + mt * 16 + fr) * RS + ks * 32 + fq * 8); }
#pragma unroll
        for (int nt = 0; nt < 4; ++nt) { const bf16x8 bv = *(const LAS bf16x8*)(VT + (wc * 64 + nt * 16 + fr) * RS + ks * 32 + fq * 8), bkt = *(const LAS bf16x8*)(KB + (wc * 64 + nt * 16 + fr) * RS + ks * 32 + fq * 8);
#pragma unroll
            for (int mt = 0; mt < 2; ++mt) { accY[mt][nt] = __builtin_amdgcn_mfma_f32_16x16x32_bf16(ap[mt], bv, accY[mt][nt], 0, 0, 0); accS[mt][nt] = __builtin_amdgcn_mfma_f32_16x16x32_bf16(av[mt], bkt, accS[mt][nt], 0, 0, 0); } }
        __builtin_amdgcn_sched_barrier(0); }
#pragma unroll
    for (int mt = 0; mt < 2; ++mt)
#pragma unroll
        for (int nt = 0; nt < 4; ++nt)
#pragma unroll
            for (int j = 0; j < 4; ++j) { const int r = wr * 32 + mt * 16 + fq * 4 + j, c = wc * 64 + nt * 16 + fr;
                Y[(size_t)(row0 + r) * 1024 + 512 + h * 128 + c] = f2bf(accY[mt][nt][j]); KVB[r * 128 + c] = f2bf(accS[mt][nt][j]); }
    __syncthreads();
}

__device__ __forceinline__ void ret_prefix(PR P, const int item) {
    const int bh = item >> 11, i8 = (item & 2047) * 8; const int h = bh & 3;
    bf16_t* KVB = kvb_ptr(P.ws, bh) + i8;
    const float lg2 = log2f(1.0f - exp2f(-5.0f - (float)h)); const float c_dec = exp2f(lg2 * 128.0f);
    u32x4 kv[16];
#pragma unroll
    for (int n = 0; n < 16; ++n) kv[n] = *(const u32x4*)(KVB + (size_t)n * 16384);
    float S[8];
#pragma unroll
    for (int x = 0; x < 8; ++x) S[x] = 0.f;
#pragma unroll
    for (int n = 0; n < 16; ++n) { u32x4 w; w.x = pg8::cvt_pk_bf16(S[0], S[1]); w.y = pg8::cvt_pk_bf16(S[2], S[3]); w.z = pg8::cvt_pk_bf16(S[4], S[5]); w.w = pg8::cvt_pk_bf16(S[6], S[7]);
        *(u32x4*)(KVB + (size_t)n * 16384) = w;
        const float k8[8] = {lo_bf(kv[n].x), hi_bf(kv[n].x), lo_bf(kv[n].y), hi_bf(kv[n].y), lo_bf(kv[n].z), hi_bf(kv[n].z), lo_bf(kv[n].w), hi_bf(kv[n].w)};
#pragma unroll
        for (int x = 0; x < 8; ++x) S[x] = S[x] * c_dec + k8[x]; }
    const int e = i8 >> 7, d0 = i8 & 127;
#pragma unroll
    for (int x = 0; x < 8; ++x) P.out[O_RTP + ((size_t)bh * 128 + d0 + x) * 128 + e] = S[x];
}

__device__ __forceinline__ void ret_unit_c(PR P, LAS unsigned char* lds, const int bh, const int n, const int wv) {
    LAS bf16_t* QP = (LAS bf16_t*)lds; LAS bf16_t* ST = QP + 3 * BUFE; LAS float* YST = (LAS float*)(QP + BUFE);
    const int tid = fresh_tid(wv), lane = tid & 63, wid = tid >> 6, wr = wid >> 1, wc = wid & 1, fr = lane & 15, fq = lane >> 4;
    const int b = bh >> 2, h = bh & 3;
    const bf16_t* PS = (const bf16_t*)(P.ws + WS_BIG); bf16_t* Y = (bf16_t*)(P.ws + WS_XN); const bf16_t* KVB = kvb_ptr(P.ws, bh) + (size_t)n * 16384;
    const float lg2 = log2f(1.0f - exp2f(-5.0f - (float)h));
    const int row0 = b * 2048 + n * 128;
    unsigned kth[4][4];
    ret_load_qk<false>(P, QP, QP, kth, tid, row0, n, h, 0.f, 0.f);
#pragma unroll
    for (int it = 0; it < 4; ++it) { const int idx = it * 512 + tid, e = idx >> 4, d8 = (idx & 15) * 8;
        *(LAS u32x4*)(ST + e * RS + d8) = *(const u32x4*)(KVB + e * 128 + d8); }
    __syncthreads();
    f32x4 accY[2][4];
#pragma unroll
    for (int mt = 0; mt < 2; ++mt)
#pragma unroll
        for (int nt = 0; nt < 4; ++nt) accY[mt][nt] = (f32x4){0.f, 0.f, 0.f, 0.f};
#pragma unroll
    for (int ks = 0; ks < 4; ++ks) { bf16x8 aq[2];
#pragma unroll
        for (int mt = 0; mt < 2; ++mt) aq[mt] = *(const LAS bf16x8*)(QP + (wr * 32 + mt * 16 + fr) * RS + ks * 32 + fq * 8);
#pragma unroll
        for (int nt = 0; nt < 4; ++nt) { const bf16x8 bs = *(const LAS bf16x8*)(ST + (wc * 64 + nt * 16 + fr) * RS + ks * 32 + fq * 8);
#pragma unroll
            for (int mt = 0; mt < 2; ++mt) accY[mt][nt] = __builtin_amdgcn_mfma_f32_16x16x32_bf16(aq[mt], bs, accY[mt][nt], 0, 0, 0); }
        __builtin_amdgcn_sched_barrier(0); }
#pragma unroll
    for (int mt = 0; mt < 2; ++mt)
#pragma unroll
        for (int j = 0; j < 4; ++j) { const int r = wr * 32 + mt * 16 + fq * 4 + j; const float qd = exp2f(lg2 * (float)(r + 1));
#pragma unroll
            for (int nt = 0; nt < 4; ++nt) YST[r * 132 + wc * 64 + nt * 16 + fr] = accY[mt][nt][j] * qd; }
    __syncthreads();
    { const int i = tid >> 2, part = tid & 3; float yv[32]; float s = 0.f;
      bf16_t* yo = Y + (size_t)(row0 + i) * 1024 + 512 + h * 128 + part * 32;
#pragma unroll
      for (int x = 0; x < 4; ++x) { const u32x4 y1 = *(const u32x4*)(yo + x * 8); const f32x4 ta = *(const LAS f32x4*)(YST + i * 132 + part * 32 + x * 8), tb = *(const LAS f32x4*)(YST + i * 132 + part * 32 + x * 8 + 4);
          yv[x * 8 + 0] = ta[0] + lo_bf(y1.x); yv[x * 8 + 1] = ta[1] + hi_bf(y1.x); yv[x * 8 + 2] = ta[2] + lo_bf(y1.y); yv[x * 8 + 3] = ta[3] + hi_bf(y1.y);
          yv[x * 8 + 4] = tb[0] + lo_bf(y1.z); yv[x * 8 + 5] = tb[1] + hi_bf(y1.z); yv[x * 8 + 6] = tb[2] + lo_bf(y1.w); yv[x * 8 + 7] = tb[3] + hi_bf(y1.w); }
#pragma unroll
      for (int x = 0; x < 32; ++x) s += yv[x];
      s = quad_sum(s); const float mean = s * (1.0f / 128.0f); float s2 = 0.f;
#pragma unroll
      for (int x = 0; x < 32; ++x) { yv[x] -= mean; s2 += yv[x] * yv[x]; }
      s2 = quad_sum(s2); const float rstd = rsqrtf(s2 * (1.0f / 128.0f) + 1e-5f);
      const bf16_t* gp = PS + (size_t)(row0 + i) * NCOLS + 1792 + 1536 + h * 128 + part * 32; const float* gw = P.gn_w + h * 128 + part * 32;
#pragma unroll
      for (int x = 0; x < 4; ++x) { const u32x4 g4 = *(const u32x4*)(gp + x * 8); const float4 w0 = *(const float4*)(gw + x * 8), w1 = *(const float4*)(gw + x * 8 + 4);
          const float gg[8] = {lo_bf(g4.x), hi_bf(g4.x), lo_bf(g4.y), hi_bf(g4.y), lo_bf(g4.z), hi_bf(g4.z), lo_bf(g4.w), hi_bf(g4.w)}; const float ww[8] = {w0.x, w0.y, w0.z, w0.w, w1.x, w1.y, w1.z, w1.w};
          float o[8];
#pragma unroll
          for (int z = 0; z < 8; ++z) o[z] = yv[x * 8 + z] * rstd * ww[z] * (gg[z] * __builtin_amdgcn_rcpf(1.0f + __expf(-gg[z])));
          u32x4 w; w.x = pg8::cvt_pk_bf16(o[0], o[1]); w.y = pg8::cvt_pk_bf16(o[2], o[3]); w.z = pg8::cvt_pk_bf16(o[4], o[5]); w.w = pg8::cvt_pk_bf16(o[6], o[7]);
          *(u32x4*)(yo + x * 8) = w; } }
    __syncthreads();
}

__device__ __forceinline__ void sub_barrier(unsigned* cnt, const unsigned target, const int wv) {
    asm volatile("s_waitcnt vmcnt(0)" ::: "memory");
    __syncthreads();
    if (fresh_tid(wv) == 0) {
        __builtin_amdgcn_fence(__ATOMIC_RELEASE, "agent");
        asm volatile("s_waitcnt vmcnt(0)" ::: "memory");
        (void)xb_add(cnt, 1u);
        unsigned sp = 0u;
        while (xb_ld(cnt) < target) { __builtin_amdgcn_s_sleep(2); if (++sp > (1u << 20)) break; }
        __builtin_amdgcn_fence(__ATOMIC_ACQUIRE, "agent");
        asm volatile("s_waitcnt vmcnt(0)" ::: "memory");
    }
    __syncthreads();
}

struct PostRegs { u32x2 yr, c_r, c_k, c_v, p_r, p_k, p_v, ar, gr; };
__device__ __forceinline__ void post_load(PR P, PostRegs& R, const int row, const int ch) {
    const bf16_t* PS = (const bf16_t*)(P.ws + WS_BIG); const bf16_t* ASIG = (const bf16_t*)(P.ws + WS_ASIG); const bf16_t* YS = (const bf16_t*)(P.ws + WS_YS); const bf16_t* G = (const bf16_t*)(P.ws + WS_WIN);
    R.yr = *(const u32x2*)(YS + (size_t)row * 512 + ch);
    const bf16_t* cp = PS + (size_t)row * NCOLS + ch; const int pr = prev_row(row);
    R.c_r = *(const u32x2*)cp; R.c_k = *(const u32x2*)(cp + 512); R.c_v = *(const u32x2*)(cp + 1024);
    { const bf16_t* pp = PS + (size_t)(pr >= 0 ? pr : row) * NCOLS + ch; R.p_r = *(const u32x2*)pp; R.p_k = *(const u32x2*)(pp + 512); R.p_v = *(const u32x2*)(pp + 1024); }
    R.ar = *(const u32x2*)(ASIG + (size_t)row * 512 + ch); R.gr = *(const u32x2*)(G + (size_t)row * 512 + ch);
}
__device__ __forceinline__ void rwkv_post(PR P, const int wv) {
    const int tid = fresh_tid(wv); const int lane = tid & 63; const int gw = blockIdx.x * 8 + (tid >> 6), nw = gridDim.x * 8;
    const int sub = lane >> 4, cg4 = (lane & 15) * 4;
    bf16_t* Y = (bf16_t*)(P.ws + WS_XN);
    const int h = (gw * 4 + sub) & 7, ch = h * 64 + cg4;
    const float4 mr = *(const float4*)(P.mu + ch), mk = *(const float4*)(P.mu + 512 + ch), mv = *(const float4*)(P.mu + 1024 + ch);
    const float4 ka = *(const float4*)(P.k_a + ch), rk = *(const float4*)(P.r_k + ch), lw = *(const float4*)(P.lnx_w + ch), lb = *(const float4*)(P.lnx_b + ch);
    const float m_r[4] = {mr.x, mr.y, mr.z, mr.w}, m_k[4] = {mk.x, mk.y, mk.z, mk.w}, m_v[4] = {mv.x, mv.y, mv.z, mv.w};
    const float kaa[4] = {ka.x, ka.y, ka.z, ka.w}, rkk[4] = {rk.x, rk.y, rk.z, rk.w}, lww[4] = {lw.x, lw.y, lw.z, lw.w}, lbb[4] = {lb.x, lb.y, lb.z, lb.w};
    PostRegs R, N;
    if (gw < MT * 2) post_load(P, R, (gw * 4 + sub) >> 3, ch);
    for (int task = gw; task < MT * 2; task += nw) {
        const int row = (task * 4 + sub) >> 3;
        { const int nt_ = task + nw < MT * 2 ? task + nw : task; post_load(P, N, (nt_ * 4 + sub) >> 3, ch); }
        if (prev_row(row) < 0) { R.p_r = (u32x2){0u, 0u}; R.p_k = R.p_r; R.p_v = R.p_r; }
        const float ys[4] = {lo_bf(R.yr.x), hi_bf(R.yr.x), lo_bf(R.yr.y), hi_bf(R.yr.y)};
        const float mean = row16_sum(ys[0] + ys[1] + ys[2] + ys[3]) * (1.0f / 64.0f);
        float dl[4], s2 = 0.f;
#pragma unroll
        for (int j = 0; j < 4; ++j) { dl[j] = ys[j] - mean; s2 += dl[j] * dl[j]; }
        const float rstd = rsqrtf(row16_sum(s2) * (1.0f / 64.0f) + 64e-5f);
        const float cr[4] = {lo_bf(R.c_r.x), hi_bf(R.c_r.x), lo_bf(R.c_r.y), hi_bf(R.c_r.y)}, ck[4] = {lo_bf(R.c_k.x), hi_bf(R.c_k.x), lo_bf(R.c_k.y), hi_bf(R.c_k.y)}, cv[4] = {lo_bf(R.c_v.x), hi_bf(R.c_v.x), lo_bf(R.c_v.y), hi_bf(R.c_v.y)};
        const float qr[4] = {lo_bf(R.p_r.x), hi_bf(R.p_r.x), lo_bf(R.p_r.y), hi_bf(R.p_r.y)}, qk[4] = {lo_bf(R.p_k.x), hi_bf(R.p_k.x), lo_bf(R.p_k.y), hi_bf(R.p_k.y)}, qv[4] = {lo_bf(R.p_v.x), hi_bf(R.p_v.x), lo_bf(R.p_v.y), hi_bf(R.p_v.y)};
        const float aa[4] = {lo_bf(R.ar.x), hi_bf(R.ar.x), lo_bf(R.ar.y), hi_bf(R.ar.y)}, gg[4] = {lo_bf(R.gr.x), hi_bf(R.gr.x), lo_bf(R.gr.y), hi_bf(R.gr.y)};
        float v[4], bp = 0.f;
#pragma unroll
        for (int j = 0; j < 4; ++j) { const float r = cr[j] + (qr[j] - cr[j]) * m_r[j], k = ck[j] + (qk[j] - ck[j]) * m_k[j]; v[j] = cv[j] + (qv[j] - cv[j]) * m_v[j];
            const float kn = k * (1.0f + (aa[j] - 1.0f) * kaa[j]); bp += r * kn * rkk[j]; }
        const float bonus = row16_sum(bp);
        float o[4];
#pragma unroll
        for (int j = 0; j < 4; ++j) o[j] = (dl[j] * rstd * lww[j] + lbb[j] + bonus * v[j]) * gg[j];
        u32x2 w; w.x = pg8::cvt_pk_bf16(o[0], o[1]); w.y = pg8::cvt_pk_bf16(o[2], o[3]);
        *(u32x2*)(Y + (size_t)row * 1024 + ch) = w;
        R = N;
    }
}

__global__ void __launch_bounds__(512, 2) hymba_mega(Params P_unused) {
    extern __shared__ __attribute__((aligned(16))) unsigned char shm[];
    cg::grid_group grid = cg::this_grid();
    LAS unsigned char* lds = (LAS unsigned char*)shm; LAS float* ldsf = (LAS float*)shm;
    const int G = gridDim.x, bx = blockIdx.x;
    const int wv = __builtin_amdgcn_readfirstlane(threadIdx.x >> 6);
    const CAS Params* kp = (const CAS Params*)__builtin_amdgcn_kernarg_segment_ptr();
#define P (*kp)
#define FRESH() asm volatile("" : "+s"(kp))
#ifndef REP_SYNC
#define REP_SYNC 1
#endif
#ifndef REP_P7
#define REP_P7 1
#endif
#ifndef REP_FFN1
#define REP_FFN1 1
#endif
#ifndef REP_P0
#define REP_P0 1
#endif
#ifndef REP_P3
#define REP_P3 1
#endif
#ifndef REP_RW
#define REP_RW 1
#endif
#ifndef REP_OTH
#define REP_OTH 1
#endif
#ifndef REP_RETP
#define REP_RETP 1
#endif
#ifndef REP_SAMP
#define REP_SAMP 1
#endif
#ifndef REP_P8
#define REP_P8 1
#endif
#define GSYNC() do { for (int r_ = 0; r_ < REP_SYNC; ++r_) xcd_barrier((unsigned*)ws, (volatile LAS unsigned*)(lds + LDS_BYTES - 16), wv); FRESH(); } while (0)
#define ws (kp->ws)
#define XN ((bf16_t*)(ws + WS_XN))
#define ACT ((bf16_t*)(ws + WS_BIG))
#define FO ((float*)(ws + WS_FO))
#define PS ((bf16_t*)(ws + WS_BIG))
    pg8::StaticOrder S;
    { const int t0 = fresh_tid(wv); if (t0 < 4) ((LAS unsigned*)(lds + LDS_BYTES - 16))[t0] = 0u;
      if (t0 == 0) (void)xb_add(&((unsigned*)ws)[XB_XCNT(xb_xcc_id())], 1u); }
    if (G == 0x7fffffff) grid.sync();
#ifndef PHM
#define PHM 0xFFFF
#endif
#define PH(k) if ((PHM >> (k)) & 1)
    for (int r0 = 0; r0 < REP_P0; ++r0) PH(0) p0_prologue(P, ldsf, wv);
    GSYNC();
    for (int rep1 = 0; rep1 < REP_FFN1; ++rep1) {
    PH(1) { pg8::Gemm g{XN, (const bf16_t*)(ws + WS_WGU), MT, NGU, 1024}; S.init(MT, NGU, G, bx, 1024); pg8::EpiSwiGLU E{ACT, DFF}; pg8::gemm_phase(lds, g, S, E, wv); }
    GSYNC();
    PH(2) { pg8::Gemm g{ACT, (const bf16_t*)(ws + WS_WD), MT, 1024, DFF}; pg8::SplitOrder S2; S2.init2(G, bx, DFF, 8); pg8::EpiFO E{(bf16_t*)FO, 1024, (float*)(ws + WS_OMD)}; pg8::gemm_phase(lds, g, S2, E, wv); }
    GSYNC();
    }
    for (int r3 = 0; r3 < REP_P3; ++r3) PH(3) rows_phase(P, 1, wv);
    GSYNC();
    PH(4) { pg8::Gemm g{XN, (const bf16_t*)(ws + WS_WIN), MIN_, NCOLS, 1024}; S.init(MIN_, NCOLS, G, bx, 1024); pg8::EpiBf16 E{PS, NCOLS}; pg8::gemm_phase(lds, g, S, E, wv); }
    GSYNC();
    PH(5) lora_prep(P, wv);
    GSYNC();
    PH(6) { pg8::Gemm g{(const bf16_t*)(ws + WS_LA), (const bf16_t*)(ws + WS_WL), MT, 1536, 256}; pg8::LoraMainOrder SM; SM.init(MP, 1024, G, bx, 256);
      pg8::EpiLora E{(bf16_t*)(ws + WS_OMD), (bf16_t*)(ws + WS_ASIG), (bf16_t*)(ws + WS_WIN), P.w0, P.a0}; pg8::gemm_phase(lds, g, SM, E, wv); }
    GSYNC();
    {
    if (bx < 128) { for (int rw = 0; rw < REP_RW; ++rw) rwkv_unit<false>(P, ldsf, bx >> 4, (bx >> 1) & 7, bx & 1, wv); }
    else {
        { pg8::Gemm g{(const bf16_t*)(ws + WS_LA), (const bf16_t*)(ws + WS_WL), MT, 1536, 256}; pg8::LoraRestOrder SL; SL.ob = bx - 128;
          pg8::EpiLora E{(bf16_t*)(ws + WS_OMD), (bf16_t*)(ws + WS_ASIG), (bf16_t*)(ws + WS_WIN), P.w0, P.a0}; pg8::gemm_phase(lds, g, SL, E, wv); }
        FRESH();
        const int rep7 = 0; const int ob = bx - 128; unsigned* sbc = (unsigned*)ws + XCD_BAR_WORDS + 64;
        for (int k = 0; k < 4; ++k) { const int u = ob + k * 128; ret_unit_a(P, lds, u >> 4, u & 15, wv); }
        sub_barrier(sbc, 128u * (2u * rep7 + 1u), wv);
        ret_prefix(P, ob * 512 + fresh_tid(wv));
        sub_barrier(sbc, 128u * (2u * rep7 + 2u), wv);
        for (int k = 0; k < 4; ++k) { const int u = ob + k * 128; ret_unit_c(P, lds, u >> 4, u & 15, wv); }
        for (int u = ob; u < 2560; u += 128) { if (u < 2048) rwkv_unit<true>(P, ldsf, u >> 4, (u >> 1) & 7, u & 1, wv); else ret_sample_unit(P, ldsf, (u - 2048) >> 2, (u - 2048) & 3, wv); }
    }
    }
    GSYNC();
    for (int rep8 = 0; rep8 < REP_P8; ++rep8) PH(8) rwkv_post(P, wv);
    GSYNC();
    PH(9) { pg8::Gemm g{XN, (const bf16_t*)(ws + WS_WOUT), MT, 1024, 1024}; pg8::SplitOrder S2; S2.init2(G, bx, 1024, 4); pg8::EpiFO E{(bf16_t*)FO, 1024, (float*)(ws + WS_OMD)}; pg8::gemm_phase(lds, g, S2, E, wv); }
    GSYNC();
    PH(10) { tconv_list(P.f2g, P.f2u, P.f2d, nullptr, nullptr, ws, 2112, ldsf, wv);
    rows_phase(P, 2, wv); }
    GSYNC();
    PH(11) { pg8::Gemm g{XN, (const bf16_t*)(ws + WS_WGU), MT, NGU, 1024}; S.init(MT, NGU, G, bx, 1024); pg8::EpiSwiGLU E{ACT, DFF}; pg8::gemm_phase(lds, g, S, E, wv); }
    GSYNC();
    PH(12) { pg8::Gemm g{ACT, (const bf16_t*)(ws + WS_WD), MT, 1024, DFF}; pg8::SplitOrder S2; S2.init2(G, bx, DFF, 8); pg8::EpiFO E{(bf16_t*)FO, 1024, (float*)(ws + WS_OMD)}; pg8::gemm_phase(lds, g, S2, E, wv); }
    GSYNC();
    PH(13) rows_phase(P, 3, wv);
}

#undef ws
#undef XN
#undef ACT
#undef FO
#undef PS
#undef P
extern "C" void kernel_launch(void* const* d_in, const int* in_sizes, int n_in, void* d_out, int out_size, void* d_ws, size_t ws_size, hipStream_t stream) {
    static int grid = 0;
    if (grid == 0) {
        if (n_in != 26 || ws_size < WS_END) { fprintf(stderr, "kernel_launch: unexpected n_in %d or ws_size %zu (< %zu)\n", n_in, ws_size, (size_t)WS_END); grid = -1; return; }
        int dev = 0, cus = 0, per_cu = 0;
        hipGetDevice(&dev); hipDeviceGetAttribute(&cus, hipDeviceAttributeMultiprocessorCount, dev);
        hipFuncSetAttribute((const void*)hymba_mega, hipFuncAttributeMaxDynamicSharedMemorySize, LDS_BYTES);
        hipOccupancyMaxActiveBlocksPerMultiprocessor(&per_cu, (const void*)hymba_mega, 512, LDS_BYTES);
        if (per_cu < 1) { fprintf(stderr, "kernel_launch: occupancy query says %d blocks/CU\n", per_cu); per_cu = 1; }
        grid = cus * per_cu; if (grid > 256) grid = 256;
        if (grid != 256) { fprintf(stderr, "kernel_launch: this kernel needs 256 co-resident workgroups, got %d\n", grid); grid = -1; return; }
        fprintf(stderr, "kernel_launch: cus %d per_cu %d grid %d ws %zu\n", cus, per_cu, grid, ws_size);
    }
    if (grid < 0) return;
    if (hipMemsetAsync(d_ws, 0, 16384, stream) != hipSuccess) { fprintf(stderr, "kernel_launch: hipMemsetAsync failed\n"); return; }
    Params p{};
    const float** pp = (const float**)&p;
    for (int i = 0; i < 26; ++i) pp[i] = (const float*)d_in[i];
    p.out = (float*)d_out; p.ws = (unsigned char*)d_ws;
    void* args[] = {&p};
    hipError_t e = hipLaunchCooperativeKernel((const void*)hymba_mega, dim3(grid), dim3(512), args, LDS_BYTES, stream);
    if (e != hipSuccess) fprintf(stderr, "cooperative launch failed: %s (grid %d)\n", hipGetErrorString(e), grid);
}
```

```cpp
#include <hip/hip_runtime.h>
#include <hip/hip_cooperative_groups.h>
#include <cstdio>
#include <cstdint>
namespace cg = cooperative_groups;

__device__ __forceinline__ int fresh_tid(int wv) { int l; asm volatile("v_mbcnt_lo_u32_b32 %0, -1, 0\n\tv_mbcnt_hi_u32_b32 %0, -1, %0" : "=v"(l)); return wv * 64 + l; }
namespace pg8 {
#define PG8_LAS __attribute__((address_space(3)))
typedef unsigned short bf16_t;
typedef short bf16x8 __attribute__((ext_vector_type(8)));
typedef float f32x4 __attribute__((ext_vector_type(4)));
typedef unsigned u32x4 __attribute__((ext_vector_type(4)));
typedef unsigned u32x2 __attribute__((ext_vector_type(2)));
constexpr int BM = 256, BK = 64, HALF = 128, HTB = HALF * BK * 2, STAGE_BYTES = 8 * HTB, NXCD = 8, WGM = 8;

__host__ __device__ __forceinline__ int lds_byte(int r, int c) { const int st = (r >> 4) * 2 + (c >> 5), rr = r & 15, cc = c & 31, ob = rr * 64 + cc * 2; return st * 1024 + (ob ^ (((ob >> 9) & 1) << 5)); }
__host__ __device__ __forceinline__ void stage_rc(int b, int& R, int& C) { const int st = b / 1024, sb = b % 1024, swz = sb ^ (((sb >> 9) & 1) << 5); R = (st >> 1) * 16 + swz / 64; C = (st & 1) * 32 + (swz % 64) / 2; }
__host__ __device__ __forceinline__ int perm32(int rho) { const int n = rho >> 4, i = rho & 15; return 8 * (i >> 2) + 4 * n + (i & 3); }

struct Unit { int pm, pn, k0, nkt, atomic; };
struct Gemm { const bf16_t* A; const bf16_t* Bt; int M, N, K; };

struct StaticOrder {
    int nM, nN, nwg, G, c, nt;
    __host__ __device__ void init(int M, int N, int G_, int c_, int K) { nM = M / BM; nN = N / BM; nwg = nM * nN; G = G_; c = c_; nt = K / BK; }
    __host__ __device__ bool next(int i, Unit& u) const {
        const long L = (long)i * G + c; if (L >= nwg) return false;
        int wgid = (int)L; { const int q = nwg / NXCD, r = nwg % NXCD, xcd = wgid % NXCD, off = wgid / NXCD; wgid = (xcd < r ? xcd * (q + 1) : r * (q + 1) + (xcd - r) * q) + off; }
        const int nig = WGM * nN, gid = wgid / nig, fm = gid * WGM, gsz = (nM - fm) < WGM ? (nM - fm) : WGM;
        u.pm = fm + ((wgid % nig) % gsz); u.pn = (wgid % nig) / gsz; u.k0 = 0; u.nkt = nt; u.atomic = 0; return true;
    }
    __device__ __forceinline__ void a_ready(const Unit&) const {}
    __device__ __forceinline__ void done(const Unit&) const {}
};
struct LoraMainOrder : StaticOrder {
    __host__ __device__ bool next(int i, Unit& u) const { if (!StaticOrder::next(i, u)) return false; u.k0 = 0; u.nkt = 2; return true; }
};
struct LoraRestOrder {
    int ob;
    __host__ __device__ bool next(int i, Unit& u) const {
        const int L = i * 128 + ob; if (L >= 140) return false;
        if (L < 132) { u.pm = L >> 1; u.pn = 4 + (L & 1); u.k0 = 2; } else { const int x = L - 132; u.pm = 64 + (x >> 2); u.pn = x & 3; u.k0 = 0; }
        u.nkt = 2; u.atomic = 0; return true;
    }
    __device__ __forceinline__ void a_ready(const Unit&) const {}
    __device__ __forceinline__ void done(const Unit&) const {}
};
struct SplitOrder : StaticOrder {
    int KS;
    __host__ __device__ void init2(int G_, int c_, int K, int KS_) { init(16384, 1024, G_, c_, K); KS = KS_; }
    __host__ __device__ bool next(int i, Unit& u) const {
        if (i == 0) return StaticOrder::next(0, u);
        if (i > 1 || c >= 8 * KS) return false;
        const int tile = c / KS, part = c % KS, pairs = nt / 2, q = pairs / KS, r = pairs % KS;
        u.pm = 64 + (tile >> 2); u.pn = tile & 3; u.k0 = 2 * (part * q + (part < r ? part : r)); u.nkt = 2 * (q + (part < r ? 1 : 0)); u.atomic = 1 + c; return true;
    }
};

typedef __bf16 bf16x2_t __attribute__((ext_vector_type(2)));
typedef float f32x2_t __attribute__((ext_vector_type(2)));
__device__ __forceinline__ unsigned cvt_pk_bf16(float lo, float hi) { const f32x2_t v = {lo, hi}; const bf16x2_t b = __builtin_convertvector(v, bf16x2_t); return __builtin_bit_cast(unsigned, b); }

struct EpiFO {
    static constexpr bool PERM = true;
    bf16_t* C; int ldc; float* slab;
    __device__ __forceinline__ void operator()(const f32x4 (&acc)[2][2][4][2], const Unit& u, int wr, int wc, int fr, int fq) const {
        if (u.atomic == 0) {
            const int row0 = u.pm * BM + wr * 64 + fr; const int col0 = u.pn * BM + wc * 32 + 8 * fq;
#pragma unroll
            for (int ai = 0; ai < 2; ++ai)
#pragma unroll
                for (int m = 0; m < 4; ++m) { bf16_t* rowp = C + (size_t)(row0 + ai * HALF + m * 16) * ldc + col0;
#pragma unroll
                    for (int bj = 0; bj < 2; ++bj) { const f32x4 v0 = acc[ai][bj][m][0], v1 = acc[ai][bj][m][1];
                        u32x4 w; w.x = cvt_pk_bf16(v0[0], v0[1]); w.y = cvt_pk_bf16(v0[2], v0[3]); w.z = cvt_pk_bf16(v1[0], v1[1]); w.w = cvt_pk_bf16(v1[2], v1[3]);
                        *(u32x4*)(rowp + bj * HALF) = w; } }
        } else {
            float* base = slab + (size_t)(u.atomic - 1) * (BM * BM) + (size_t)(wr * 64 + fr) * BM + wc * 32 + 8 * fq;
#pragma unroll
            for (int ai = 0; ai < 2; ++ai)
#pragma unroll
                for (int m = 0; m < 4; ++m) { float* rowp = base + (size_t)(ai * HALF + m * 16) * BM;
#pragma unroll
                    for (int bj = 0; bj < 2; ++bj) { *(f32x4*)(rowp + bj * HALF) = acc[ai][bj][m][0]; *(f32x4*)(rowp + bj * HALF + 4) = acc[ai][bj][m][1]; } }
        }
    }
};
struct EpiBf16 {
    static constexpr bool PERM = true;
    bf16_t* O; int ldc;
    __device__ __forceinline__ void operator()(const f32x4 (&acc)[2][2][4][2], const Unit& u, int wr, int wc, int fr, int fq) const {
        const int row0 = u.pm * BM + wr * 64 + fr; const int col0 = u.pn * BM + wc * 32 + 8 * fq;
#pragma unroll
        for (int ai = 0; ai < 2; ++ai)
#pragma unroll
            for (int m = 0; m < 4; ++m) { bf16_t* rowp = O + (size_t)(row0 + ai * HALF + m * 16) * ldc + col0;
#pragma unroll
                for (int bj = 0; bj < 2; ++bj) { const f32x4 v0 = acc[ai][bj][m][0], v1 = acc[ai][bj][m][1];
                    u32x4 w; w.x = cvt_pk_bf16(v0[0], v0[1]); w.y = cvt_pk_bf16(v0[2], v0[3]); w.z = cvt_pk_bf16(v1[0], v1[1]); w.w = cvt_pk_bf16(v1[2], v1[3]);
                    *(u32x4*)(rowp + bj * HALF) = w; } }
    }
};
__device__ __forceinline__ float silu_f(float x) { return x * __builtin_amdgcn_rcpf(1.0f + __expf(-x)); }
struct EpiSwiGLU {
    static constexpr bool PERM = true;
    bf16_t* O; int ldc;
    __device__ __forceinline__ void operator()(const f32x4 (&acc)[2][2][4][2], const Unit& u, int wr, int wc, int fr, int fq) const {
        const int row0 = u.pm * BM + wr * 64 + fr; const int col0 = u.pn * HALF + wc * 32 + 8 * fq;
#pragma unroll
        for (int ai = 0; ai < 2; ++ai)
#pragma unroll
            for (int m = 0; m < 4; ++m) { bf16_t* rowp = O + (size_t)(row0 + ai * HALF + m * 16) * ldc + col0;
                float o[8];
#pragma unroll
                for (int n = 0; n < 2; ++n)
#pragma unroll
                    for (int j = 0; j < 4; ++j) o[n * 4 + j] = silu_f(acc[ai][0][m][n][j]) * acc[ai][1][m][n][j];
                u32x4 w; w.x = cvt_pk_bf16(o[0], o[1]); w.y = cvt_pk_bf16(o[2], o[3]); w.z = cvt_pk_bf16(o[4], o[5]); w.w = cvt_pk_bf16(o[6], o[7]);
                *(u32x4*)rowp = w; }
    }
};
struct EpiLora {
    static constexpr bool PERM = true;
    bf16_t* OMD; bf16_t* ASIG; bf16_t* G; const float* w0; const float* a0;
    template <int KIND> __device__ __forceinline__ void body(const f32x4 (&acc)[2][2][4][2], bf16_t* O, const float* bias, int row0, int ch0) const {
#pragma unroll
        for (int bj = 0; bj < 2; ++bj)
#pragma unroll
            for (int ai = 0; ai < 2; ++ai)
#pragma unroll
                for (int m = 0; m < 4; ++m) { bf16_t* rowp = O + (size_t)(row0 + ai * HALF + m * 16) * 512 + ch0 + bj * HALF;
                    float o[8];
#pragma unroll
                    for (int n = 0; n < 2; ++n)
#pragma unroll
                        for (int j = 0; j < 4; ++j) { float v = acc[ai][bj][m][n][j];
                            if (KIND == 0) { v += bias[ch0 + bj * HALF + n * 4 + j]; const float e = 0.6065306597126334f * __builtin_amdgcn_rcpf(1.0f + __expf(-v));
                                float p = 1.0f / 40320.0f; p = -1.0f / 5040.0f + e * p; p = 1.0f / 720.0f + e * p; p = -1.0f / 120.0f + e * p; p = 1.0f / 24.0f + e * p; p = -1.0f / 6.0f + e * p; p = 0.5f + e * p; p = 1.0f - e * p;
                                v = e * p; }
                            else if (KIND == 1) { v += bias[ch0 + bj * HALF + n * 4 + j]; v = __builtin_amdgcn_rcpf(1.0f + __expf(-v)); }
                            o[n * 4 + j] = v; }
                    u32x4 w; w.x = cvt_pk_bf16(o[0], o[1]); w.y = cvt_pk_bf16(o[2], o[3]); w.z = cvt_pk_bf16(o[4], o[5]); w.w = cvt_pk_bf16(o[6], o[7]);
                    *(u32x4*)rowp = w; __builtin_amdgcn_sched_barrier(0); }
    }
    __device__ __forceinline__ void operator()(const f32x4 (&acc)[2][2][4][2], const Unit& u, int wr, int wc, int fr, int fq) const {
        const int kind = u.pn >> 1;
        const int row0 = u.pm * BM + wr * 64 + fr; const int ch0 = (u.pn & 1) * BM + wc * 32 + 8 * fq;
        if (kind == 0) body<0>(acc, OMD, w0, row0, ch0); else if (kind == 1) body<1>(acc, ASIG, a0, row0, ch0); else body<2>(acc, G, a0, row0, ch0);
    }
};

template <class Epi, class Sched>
__device__ __forceinline__ void gemm_phase(PG8_LAS unsigned char* lds, const Gemm g, const Sched& S, const Epi& E, const int wv) {
    const int tid = fresh_tid(wv), wid = __builtin_amdgcn_readfirstlane(tid >> 6), lane = tid & 63, wr = wid >> 2, wc = wid & 3, fr = lane & 15, fq = lane >> 4;
    const int K = g.K;
    unsigned voffA[2], voffB[2];
#pragma unroll
    for (int i = 0; i < 2; ++i) { int R, C; stage_rc(tid * 16 + i * 8192, R, C); const int Rb = Epi::PERM ? ((R & ~31) + perm32(R & 31)) : R;
        voffA[i] = (unsigned)(R * K + C) * 2u; voffB[i] = (unsigned)(Rb * K + C) * 2u; }
    const size_t kstep = (size_t)(BK * 2);
    const size_t hstep = (size_t)HALF * K * 2;
    const size_t tstep = 2 * hstep;
    const unsigned ldsw = (unsigned)wid * 1024u;
    const int aoff = lds_byte(wr * 64 + fr, fq * 8), boff = lds_byte(wc * 32 + fr, fq * 8);
#define PG8_SA(b, h) (((b) * 2 + (h)) * HTB)
#define PG8_SB(b, h) ((4 + (b) * 2 + (h)) * HTB)
#define PG8_STAGE(bufoff, gbase, voff) do { _Pragma("unroll") for (int _i = 0; _i < 2; ++_i) \
        __builtin_amdgcn_global_load_lds((const unsigned*)((const char*)(gbase) + (voff)[_i]), (PG8_LAS unsigned*)(lds + (bufoff) + ldsw + _i * 8192), 16, 0, 0); } while (0)
#define PG8_LDA(dst, b, h) do { _Pragma("unroll") for (int m = 0; m < 4; ++m) _Pragma("unroll") for (int k = 0; k < 2; ++k) dst[m][k] = *(const PG8_LAS bf16x8*)(lds + PG8_SA(b, h) + aoff + m * 2048 + k * 1024); } while (0)
#define PG8_LDB(dst, b, h) do { _Pragma("unroll") for (int n = 0; n < 2; ++n) _Pragma("unroll") for (int k = 0; k < 2; ++k) dst[n][k] = *(const PG8_LAS bf16x8*)(lds + PG8_SB(b, h) + boff + n * 2048 + k * 1024); } while (0)
#define PG8_MMA(ai, bj, At, Bt) do { __builtin_amdgcn_s_setprio(1); _Pragma("unroll") for (int m = 0; m < 4; ++m) _Pragma("unroll") for (int n = 0; n < 2; ++n) _Pragma("unroll") for (int k = 0; k < 2; ++k) \
        acc[ai][bj][m][n] = __builtin_amdgcn_mfma_f32_16x16x32_bf16(Bt[n][k], At[m][k], acc[ai][bj][m][n], 0, 0, 0); __builtin_amdgcn_s_setprio(0); } while (0)
#define PG8_WAIT_V(n) asm volatile("s_waitcnt vmcnt(" #n ")" ::: "memory")
#define PG8_WAIT_L(n) asm volatile("s_waitcnt lgkmcnt(" #n ")" ::: "memory")
#define PG8_BAR __builtin_amdgcn_s_barrier()
#define PG8_SCHED __builtin_amdgcn_sched_barrier(0)
    Unit cur, nxt; int ui = 0;
    if (!S.next(0, cur)) return;
    f32x4 acc[2][2][4][2];
#pragma unroll
    for (int a = 0; a < 2; ++a)
#pragma unroll
        for (int b = 0; b < 2; ++b)
#pragma unroll
            for (int m = 0; m < 4; ++m)
#pragma unroll
                for (int n = 0; n < 2; ++n) acc[a][b][m][n] = (f32x4){0.f, 0.f, 0.f, 0.f};
    bf16x8 At[4][2], B0[2][2], B1[2][2];
    const char* cA = (const char*)g.A + (size_t)cur.pm * tstep + (size_t)cur.k0 * kstep; const char* cB = (const char*)g.Bt + (size_t)cur.pn * tstep + (size_t)cur.k0 * kstep;
    S.a_ready(cur);
    PG8_STAGE(PG8_SB(0, 0), cB, voffB); PG8_STAGE(PG8_SA(0, 0), cA, voffA); PG8_STAGE(PG8_SB(0, 1), cB + hstep, voffB); PG8_STAGE(PG8_SA(0, 1), cA + hstep, voffA);
    if (wr == 1) PG8_BAR;
    PG8_WAIT_V(4); PG8_BAR;
    PG8_STAGE(PG8_SB(1, 0), cB + kstep, voffB); PG8_STAGE(PG8_SA(1, 0), cA + kstep, voffA); PG8_STAGE(PG8_SB(1, 1), cB + hstep + kstep, voffB);
    PG8_WAIT_V(6); PG8_BAR;
    for (;;) {
        const bool has_next = S.next(ui + 1, nxt);
        const char* nA = has_next ? (const char*)g.A + (size_t)nxt.pm * tstep + (size_t)nxt.k0 * kstep : cA; const char* nB = has_next ? (const char*)g.Bt + (size_t)nxt.pn * tstep + (size_t)nxt.k0 * kstep : cB;
        const int nt = cur.nkt;
        for (int t = 0; t < nt; t += 2) {
            const bool last = (t == nt - 2);
            const char* a1 = cA + (size_t)(t + 1) * kstep;
            const char* a2 = last ? nA : cA + (size_t)(t + 2) * kstep; const char* b2 = last ? nB : cB + (size_t)(t + 2) * kstep;
            const char* a3 = a2 + kstep; const char* b3 = b2 + kstep;
            if (last && has_next) S.a_ready(nxt);
            PG8_LDB(B0, 0, 0); PG8_SCHED; PG8_LDA(At, 0, 0); PG8_STAGE(PG8_SA(1, 1), a1 + hstep, voffA);
            PG8_WAIT_L(8); PG8_BAR; PG8_WAIT_L(0); PG8_MMA(0, 0, At, B0); PG8_BAR; PG8_SCHED;
            PG8_LDB(B1, 0, 1); PG8_STAGE(PG8_SB(0, 0), b2, voffB);
            PG8_BAR; PG8_WAIT_L(0); PG8_MMA(0, 1, At, B1); PG8_BAR;
            PG8_LDA(At, 0, 1); PG8_STAGE(PG8_SA(0, 0), a2, voffA);
            PG8_BAR; PG8_WAIT_L(0); PG8_MMA(1, 0, At, B0); PG8_BAR; PG8_SCHED;
            PG8_STAGE(PG8_SB(0, 1), b2 + hstep, voffB);
            PG8_WAIT_V(6); PG8_BAR; PG8_MMA(1, 1, At, B1); PG8_BAR;
            PG8_LDB(B0, 1, 0); PG8_SCHED; PG8_LDA(At, 1, 0); PG8_STAGE(PG8_SA(0, 1), a2 + hstep, voffA);
            PG8_WAIT_L(8); PG8_BAR; PG8_WAIT_L(0); PG8_MMA(0, 0, At, B0); PG8_BAR; PG8_SCHED;
            PG8_LDB(B1, 1, 1); PG8_STAGE(PG8_SB(1, 0), b3, voffB);
            PG8_BAR; PG8_WAIT_L(0); PG8_MMA(0, 1, At, B1); PG8_BAR;
            PG8_LDA(At, 1, 1); PG8_STAGE(PG8_SA(1, 0), a3, voffA);
            PG8_BAR; PG8_WAIT_L(0); PG8_MMA(1, 0, At, B0); PG8_BAR; PG8_SCHED;
            PG8_STAGE(PG8_SB(1, 1), b3 + hstep, voffB);
            PG8_WAIT_V(6); PG8_BAR; PG8_MMA(1, 1, At, B1); PG8_BAR;
        }
        { const int l2 = fresh_tid(wv) & 63; E(acc, cur, wr, wc, l2 & 15, l2 >> 4); } S.done(cur);
        if (!has_next) break;
#pragma unroll
        for (int a = 0; a < 2; ++a)
#pragma unroll
            for (int b = 0; b < 2; ++b)
#pragma unroll
                for (int m = 0; m < 4; ++m)
#pragma unroll
                    for (int n = 0; n < 2; ++n) acc[a][b][m][n] = (f32x4){0.f, 0.f, 0.f, 0.f};
        cur = nxt; cA = nA; cB = nB; ++ui;
    }
    PG8_WAIT_V(0);
    if (wr == 0) PG8_BAR;
    PG8_BAR;
#undef PG8_SA
#undef PG8_SB
#undef PG8_STAGE
#undef PG8_LDA
#undef PG8_LDB
#undef PG8_MMA
#undef PG8_WAIT_V
#undef PG8_WAIT_L
#undef PG8_BAR
#undef PG8_SCHED
}
}

using pg8::bf16_t; using pg8::f32x4; using pg8::bf16x8; using pg8::u32x4; using pg8::u32x2;
#define LAS __attribute__((address_space(3)))

constexpr int D = 1024, DFF = 2816, NGU = 5632, NCOLS = 3840;
constexpr int MP = 16384, MS = 512, MT = 16896, MIN_ = 17152;
constexpr int LDS_BYTES = 147456;
constexpr size_t O_SHP = 17301504, O_WKP = O_SHP + 8192, O_RTP = O_WKP + 262144, O_SHS = O_RTP + 524288, O_WKS = O_SHS + 131072, O_RTS = O_WKS + 4194304;
constexpr size_t WS_ROPE = 16384;
constexpr size_t WS_WL   = WS_ROPE + 1050624;
constexpr size_t WS_WOUT = WS_WL + 786432;
constexpr size_t WS_WIN  = WS_WOUT + 2097152;
constexpr size_t WS_WGU  = WS_WIN + 7864320;
constexpr size_t WS_WD   = WS_WGU + 11534336;
constexpr size_t WS_XN   = WS_WD + 5767168;
constexpr size_t WS_BIG  = WS_XN + 35127296;
constexpr size_t WS_FO   = WS_BIG + 95158272;
constexpr size_t WS_YS   = WS_BIG + 131727360;
constexpr size_t WS_LA   = WS_YS + 17301504;
constexpr size_t WS_OMD  = WS_BIG + 164364288;
constexpr size_t WS_ASIG = WS_OMD + 17301504;
constexpr size_t WS_END  = WS_ASIG + 17301504;
static_assert(WS_LA + 8650752 <= WS_OMD, "mixer overlays");
static_assert(WS_END <= 268435456, "workspace");

struct Params {
    const float *x_prompt, *x_sample, *state_shift, *state_wkv, *state_ret, *norm_g, *f1g, *f1u, *f1d, *w_in, *mu, *w0, *w2, *a0, *a2, *g2, *k_k, *k_a, *r_k, *lnx_w, *lnx_b, *gn_w, *w_out, *f2g, *f2u, *f2d;
    float* out; unsigned char* ws;
};
#define CAS __attribute__((address_space(4)))
typedef const CAS Params& PR;

__device__ __forceinline__ float bf2f(unsigned b) { return __uint_as_float(b << 16); }
__device__ __forceinline__ bf16_t f2bf(float f) { unsigned u = __float_as_uint(f); u += 0x7FFFu + ((u >> 16) & 1u); return (bf16_t)(u >> 16); }
__device__ __forceinline__ float lo_bf(unsigned x) { return __uint_as_float(x << 16); }
__device__ __forceinline__ float hi_bf(unsigned x) { return __uint_as_float(x & 0xffff0000u); }
template <int CTRL> __device__ __forceinline__ float dppf(float v) { return __int_as_float(__builtin_amdgcn_update_dpp(0, __float_as_int(v), CTRL, 0xF, 0xF, false)); }
__device__ __forceinline__ float row16_sum(float v) { v += dppf<0xB1>(v); v += dppf<0x4E>(v); v += dppf<0x141>(v); v += dppf<0x140>(v); return v; }
__device__ __forceinline__ float wave_sum(float v) { v = row16_sum(v); const int i = __float_as_int(v);
    return __int_as_float(__builtin_amdgcn_readlane(i, 0)) + __int_as_float(__builtin_amdgcn_readlane(i, 16)) + __int_as_float(__builtin_amdgcn_readlane(i, 32)) + __int_as_float(__builtin_amdgcn_readlane(i, 48)); }
__device__ __forceinline__ float quad_sum(float v) { v += dppf<0xB1>(v); v += dppf<0x4E>(v); return v; }
__device__ __forceinline__ float sigmoid_f(float x) { return __builtin_amdgcn_rcpf(1.0f + __expf(-x)); }


#define XB_TMO      128
#define XB_XCNT(j)  (256  + 64 * (j))
#define XB_XSUB(j)  (1280 + 64 * (j))
#define XB_XGEN(j)  (2304 + 64 * (j))
#define XB_TOP      3328
#define XB_TOPGEN   3392
#define XCD_BAR_WORDS 3456
#define XB_SPIN_CAP (1u << 18)
__device__ __forceinline__ unsigned xb_ld(unsigned* p)              { return __hip_atomic_load(p, __ATOMIC_RELAXED, __HIP_MEMORY_SCOPE_AGENT); }
__device__ __forceinline__ unsigned xb_add(unsigned* p, unsigned v) { return __hip_atomic_fetch_add(p, v, __ATOMIC_RELAXED, __HIP_MEMORY_SCOPE_AGENT); }
__device__ __forceinline__ unsigned xb_xcc_id() { return (unsigned)__builtin_amdgcn_s_getreg((3 << 11) | 20) & 0xFu; }
#define XB_SPIN(cond, bar) do { unsigned _sp = 0; while (cond) { __builtin_amdgcn_s_sleep(1); \
    if ((++_sp & 255u) == 0u) { if (xb_ld(&(bar)[XB_TMO])) break; if (_sp > XB_SPIN_CAP) { atomicAdd(&(bar)[XB_TMO], 1u); break; } } } } while (0)
struct XcdBarrier { unsigned* bar; unsigned x; volatile LAS unsigned* st; };
__device__ __forceinline__ XcdBarrier xcd_barrier_post(unsigned* bar, volatile LAS unsigned* st) {
    XcdBarrier b; b.bar = bar; b.x = xb_xcc_id(); b.st = st;
    return b;
}
__device__ __forceinline__ void xcd_barrier_complete(unsigned* bar, unsigned x, unsigned& nloc, unsigned& nx) {
    const unsigned G = gridDim.x * gridDim.y * gridDim.z;
    unsigned sum, cnt, mine, sp = 0u;
    for (;;) {
        sum = 0u; cnt = 0u; mine = 0u;
#pragma unroll
        for (unsigned j = 0; j < 16; ++j) { const unsigned c = xb_ld(&bar[XB_XCNT(j)]); sum += c; cnt += (c > 0u) ? 1u : 0u; mine = (j == x) ? c : mine; }
        if (sum == G) break;
        __builtin_amdgcn_s_sleep(1);
        if ((++sp & 255u) == 0u) { if (xb_ld(&bar[XB_TMO])) break; if (sp > XB_SPIN_CAP) { atomicAdd(&bar[XB_TMO], 1u); break; } }
    }
    nloc = mine > 0u ? mine : 1u; nx = cnt > 0u ? cnt : 1u;
}
__device__ __forceinline__ void xcd_barrier(unsigned* barw, volatile LAS unsigned* stw, const int wv) {
    XcdBarrier b; b.bar = barw; b.x = xb_xcc_id(); b.st = stw;
    asm volatile("s_waitcnt vmcnt(0)" ::: "memory");
    __syncthreads();
    if (fresh_tid(wv) == 0) {
        unsigned* bar = b.bar;
        __builtin_amdgcn_s_waitcnt(0);
        unsigned nloc = b.st[0], nx = b.st[1];
        if (nloc == 0u) { xcd_barrier_complete(bar, b.x, nloc, nx); b.st[0] = nloc; b.st[1] = nx; }
        const unsigned old = xb_add(&bar[XB_XSUB(b.x)], 1u);
        const unsigned gen = old / nloc;
        if (old + 1u == (gen + 1u) * nloc) {
            __builtin_amdgcn_fence(__ATOMIC_RELEASE, "agent");
            asm volatile("s_waitcnt vmcnt(0)" ::: "memory");
            const unsigned og = xb_add(&bar[XB_TOP], 1u);
            const unsigned tg = og / nx;
            if (og + 1u == (tg + 1u) * nx) xb_add(&bar[XB_TOPGEN], 1u);
            else XB_SPIN(xb_ld(&bar[XB_TOPGEN]) == tg, bar);
            __builtin_amdgcn_fence(__ATOMIC_ACQUIRE, "agent");
            xb_add(&bar[XB_XGEN(b.x)], 1u);
            asm volatile("s_waitcnt vmcnt(0)" ::: "memory");
        } else {
            XB_SPIN(xb_ld(&bar[XB_XGEN(b.x)]) == gen, bar);
            __builtin_amdgcn_fence(__ATOMIC_ACQUIRE, "agent");
            asm volatile("s_waitcnt vmcnt(0)" ::: "memory");
        }
    }
    __syncthreads();
}


#define DPP2(x, y, CTRL, NOP) asm volatile(NOP "\n\tv_add_f32_dpp %0, %0, %0 " CTRL " row_mask:0xf bank_mask:0xf bound_ctrl:1\n\tv_add_f32_dpp %1, %1, %1 " CTRL " row_mask:0xf bank_mask:0xf bound_ctrl:1" : "+v"(x), "+v"(y))
#define DPP4(x, y, z, w, CTRL, NOP) asm volatile(NOP "\n\tv_add_f32_dpp %0, %0, %0 " CTRL " row_mask:0xf bank_mask:0xf bound_ctrl:1\n\tv_add_f32_dpp %1, %1, %1 " CTRL " row_mask:0xf bank_mask:0xf bound_ctrl:1\n\tv_add_f32_dpp %2, %2, %2 " CTRL " row_mask:0xf bank_mask:0xf bound_ctrl:1\n\tv_add_f32_dpp %3, %3, %3 " CTRL " row_mask:0xf bank_mask:0xf bound_ctrl:1" : "+v"(x), "+v"(y), "+v"(z), "+v"(w))
#define ROW16_SUM4(x, y, z, w) do { DPP4(x, y, z, w, "quad_perm:[1,0,3,2]", "s_nop 1"); DPP4(x, y, z, w, "quad_perm:[2,3,0,1]", ""); DPP4(x, y, z, w, "row_half_mirror", ""); DPP4(x, y, z, w, "row_mirror", ""); } while (0)
#define ROW16_SUM2(x, y) do { DPP2(x, y, "quad_perm:[1,0,3,2]", "s_nop 1"); DPP2(x, y, "quad_perm:[2,3,0,1]", "s_nop 0"); DPP2(x, y, "row_half_mirror", "s_nop 0"); DPP2(x, y, "row_mirror", "s_nop 0"); } while (0)
__device__ __forceinline__ int prev_row(int r) {
    if (r < MP) return (r & 2047) == 0 ? -1 : r - 1;
    const int s = r - MP; return (s & 3) == 0 ? MT + (s >> 2) : r - 1;
}

struct TDesc { const float* W; bf16_t* Bt; int K, N, k0, n0, brow0; };
__device__ __forceinline__ TDesc tconv_desc(const float* wg, const float* wu, const float* wd, const float* win, const float* wout, unsigned char* ws, int i) {
    TDesc d; int mode = 0, tile = i;
    if (i < 704) { d.W = wg; d.Bt = (bf16_t*)(ws + WS_WGU); d.K = 1024; d.N = DFF; mode = 1; }
    else if (i < 1408) { d.W = wu; d.Bt = (bf16_t*)(ws + WS_WGU); d.K = 1024; d.N = DFF; mode = 2; tile = i - 704; }
    else if (i < 2112) { d.W = wd; d.Bt = (bf16_t*)(ws + WS_WD); d.K = DFF; d.N = 1024; tile = i - 1408; }
    else if (i < 3072) { d.W = win; d.Bt = (bf16_t*)(ws + WS_WIN); d.K = 1024; d.N = NCOLS; tile = i - 2112; }
    else { d.W = wout; d.Bt = (bf16_t*)(ws + WS_WOUT); d.K = 1024; d.N = 1024; tile = i - 3072; }
    const int nkt = d.K / 64; const int kt = tile % nkt, nt = tile / nkt; d.k0 = kt * 64; d.n0 = nt * 64;
    d.brow0 = mode == 0 ? d.n0 : ((d.n0 >> 7) * 256 + (d.n0 & 127) + (mode == 2 ? 128 : 0));
    return d;
}
__device__ __forceinline__ void tconv_list(const float* wg, const float* wu, const float* wd, const float* win, const float* wout, unsigned char* ws, const int ntiles, LAS float* t, const int wv) {
    const int tid = fresh_tid(wv); const int G = gridDim.x;
    float cur[8], nxt[8];
    int i = blockIdx.x;
    if (i < ntiles) { const TDesc d = tconv_desc(wg, wu, wd, win, wout, ws, i);
#pragma unroll
        for (int e = 0; e < 8; ++e) { const int idx = e * 512 + tid, r = idx >> 6, c = idx & 63; cur[e] = __builtin_nontemporal_load(d.W + (size_t)(d.k0 + r) * d.N + d.n0 + c); } }
    for (; i < ntiles; i += G) {
        const TDesc d = tconv_desc(wg, wu, wd, win, wout, ws, i);
        { const TDesc dn = tconv_desc(wg, wu, wd, win, wout, ws, i + G < ntiles ? i + G : i);
#pragma unroll
            for (int e = 0; e < 8; ++e) { const int idx = e * 512 + tid, r = idx >> 6, c = idx & 63; nxt[e] = __builtin_nontemporal_load(dn.W + (size_t)(dn.k0 + r) * dn.N + dn.n0 + c); } }
#pragma unroll
        for (int e = 0; e < 8; ++e) { const int idx = e * 512 + tid, r = idx >> 6, c = idx & 63; t[r * 65 + c] = cur[e]; }
        __syncthreads();
#pragma unroll
        for (int e = 0; e < 4; ++e) { const int idx = e * 512 + tid, n = idx >> 5, kp = idx & 31;
            const unsigned w = pg8::cvt_pk_bf16(t[(2 * kp) * 65 + n], t[(2 * kp + 1) * 65 + n]);
            *(unsigned*)(d.Bt + (size_t)(d.brow0 + n) * d.K + d.k0 + 2 * kp) = w; }
        __syncthreads();
#pragma unroll
        for (int e = 0; e < 8; ++e) cur[e] = nxt[e];
    }
}

struct RowRaw { float4 xf[4]; u32x2 xb[4]; u32x2 fb[4]; };
__device__ __forceinline__ void rows_load(PR P, const int mode, const int row, const int lane, RowRaw& R) {
    if (mode <= 1) { const float* xin = P.x_prompt + (size_t)row * 1024;
#pragma unroll
        for (int q = 0; q < 4; ++q) { const f32x4 t_ = __builtin_nontemporal_load((const f32x4*)(xin + (q * 64 + lane) * 4)); R.xf[q] = make_float4(t_[0], t_[1], t_[2], t_[3]); } }
    else { const bf16_t* xb = (mode == 2 ? (const bf16_t*)P.out : (const bf16_t*)(P.ws + WS_FO + 34603008)) + (size_t)row * 1024;
#pragma unroll
        for (int q = 0; q < 4; ++q) R.xb[q] = __builtin_nontemporal_load((const u32x2*)(xb + (q * 64 + lane) * 4)); }
    if (mode != 0) { const bf16_t* FO = (const bf16_t*)(P.ws + WS_FO) + (size_t)row * 1024;
#pragma unroll
        for (int q = 0; q < 4; ++q) R.fb[q] = __builtin_nontemporal_load((const u32x2*)(FO + (q * 64 + lane) * 4)); }
}
__device__ __forceinline__ void rows_proc(PR P, const int mode, const int row, const int lane, float4 (&xv)[4], const float4 (&fo)[4], const float4 (&gp)[4], const float4 (&gn)[4]) {
    bf16_t* XN = (bf16_t*)(P.ws + WS_XN);
    if (mode != 0) {
        float ss = 0.f;
#pragma unroll
        for (int q = 0; q < 4; ++q) ss += fo[q].x * fo[q].x + fo[q].y * fo[q].y + fo[q].z * fo[q].z + fo[q].w * fo[q].w;
        ss = wave_sum(ss); const float r = rsqrtf(ss * (1.0f / 1024.0f) + 1e-6f) * (mode == 2 ? 1.0f : 0.5f);
#pragma unroll
        for (int q = 0; q < 4; ++q) {
            xv[q].x += fo[q].x * r * gp[q].x; xv[q].y += fo[q].y * r * gp[q].y; xv[q].z += fo[q].z * r * gp[q].z; xv[q].w += fo[q].w * r * gp[q].w;
            if (mode == 3) { const f32x4 t_ = {xv[q].x, xv[q].y, xv[q].z, xv[q].w}; __builtin_nontemporal_store(t_, (f32x4*)(P.out + (size_t)row * 1024 + (q * 64 + lane) * 4)); }
            else { bf16_t* xo = (mode == 1 ? (bf16_t*)P.out : (bf16_t*)(P.ws + WS_FO + 34603008)) + (size_t)row * 1024; u32x2 t; t.x = pg8::cvt_pk_bf16(xv[q].x, xv[q].y); t.y = pg8::cvt_pk_bf16(xv[q].z, xv[q].w);
                __builtin_nontemporal_store(t, (u32x2*)(xo + (q * 64 + lane) * 4)); } }
        if (mode == 3) return;
    }
    float ss2 = 0.f;
#pragma unroll
    for (int q = 0; q < 4; ++q) ss2 += xv[q].x * xv[q].x + xv[q].y * xv[q].y + xv[q].z * xv[q].z + xv[q].w * xv[q].w;
    ss2 = wave_sum(ss2); const float r2 = rsqrtf(ss2 * (1.0f / 1024.0f) + 1e-6f);
    float* sh = nullptr;
    if (mode == 1) { if (row < MP) { if ((row & 2047) == 2047) sh = P.out + O_SHP + (size_t)(row >> 11) * 1024; } else { const int s = row - MP; if ((s & 3) == 3) sh = P.out + O_SHS + (size_t)(s >> 2) * 1024; } }
#pragma unroll
    for (int q = 0; q < 4; ++q) {
        float4 hv; hv.x = xv[q].x * r2 * gn[q].x; hv.y = xv[q].y * r2 * gn[q].y; hv.z = xv[q].z * r2 * gn[q].z; hv.w = xv[q].w * r2 * gn[q].w;
        u32x2 w; w.x = pg8::cvt_pk_bf16(hv.x, hv.y); w.y = pg8::cvt_pk_bf16(hv.z, hv.w);
        *(u32x2*)(XN + (size_t)row * 1024 + (q * 64 + lane) * 4) = w;
        if (sh) *(float4*)(sh + (q * 64 + lane) * 4) = hv; }
}
__device__ __forceinline__ void rows_phase(PR P, const int mode, const int wv) {
    const int tid = fresh_tid(wv); const int lane = tid & 63; const int gw = blockIdx.x * 8 + (tid >> 6), nw = gridDim.x * 8;
    const float* gpost = P.norm_g + (mode == 1 ? 1 : (mode == 2 ? 3 : 5)) * 1024;
    const float* gnext = P.norm_g + (mode == 0 ? 0 : (mode == 1 ? 2 : 4)) * 1024;
    float4 gp[4], gn[4];
#pragma unroll
    for (int q = 0; q < 4; ++q) { gp[q] = *(const float4*)(gpost + (q * 64 + lane) * 4); gn[q] = *(const float4*)(gnext + (q * 64 + lane) * 4); }
    if (gw < MP) {
        const int last = gw + ((MP - 1 - gw) / nw) * nw;
        RowRaw R, N;
        rows_load(P, mode, gw, lane, R);
        for (int row = gw; row < MP; row += nw) {
            const int nrow = row + nw < MP ? row + nw : last;
            rows_load(P, mode, nrow, lane, N);
            float4 xv[4], fo[4];
#pragma unroll
            for (int q = 0; q < 4; ++q) {
                xv[q] = mode <= 1 ? R.xf[q] : make_float4(lo_bf(R.xb[q].x), hi_bf(R.xb[q].x), lo_bf(R.xb[q].y), hi_bf(R.xb[q].y));
                fo[q] = make_float4(lo_bf(R.fb[q].x), hi_bf(R.fb[q].x), lo_bf(R.fb[q].y), hi_bf(R.fb[q].y)); }
            rows_proc(P, mode, row, lane, xv, fo, gp, gn);
            R = N;
        }
    }
    for (int row = MP + gw; row < MT; row += nw) {
        float4 xv[4], fo[4];
        if (mode <= 1) { const float* xin = P.x_sample + (size_t)(row - MP) * 1024;
#pragma unroll
            for (int q = 0; q < 4; ++q) xv[q] = *(const float4*)(xin + (q * 64 + lane) * 4); }
        else { const bf16_t* xb = (mode == 2 ? (const bf16_t*)P.out : (const bf16_t*)(P.ws + WS_FO + 34603008)) + (size_t)row * 1024;
#pragma unroll
            for (int q = 0; q < 4; ++q) { const u32x2 t = *(const u32x2*)(xb + (q * 64 + lane) * 4); xv[q] = make_float4(lo_bf(t.x), hi_bf(t.x), lo_bf(t.y), hi_bf(t.y)); } }
        if (mode != 0) {
#pragma unroll
            for (int q = 0; q < 4; ++q) { const int KS = mode == 2 ? 4 : 8; const float* sl = (const float*)(P.ws + WS_OMD) + (size_t)((((row - MP) >> 8) * 4 + q) * KS) * 65536 + (size_t)(row & 255) * 256 + lane * 4;
                float4 a = *(const float4*)sl;
                for (int p = 1; p < KS; ++p) { const float4 b = *(const float4*)(sl + (size_t)p * 65536); a.x += b.x; a.y += b.y; a.z += b.z; a.w += b.w; }
                fo[q] = a; } }
        else {
#pragma unroll
            for (int q = 0; q < 4; ++q) fo[q] = make_float4(0.f, 0.f, 0.f, 0.f); }
        rows_proc(P, mode, row, lane, xv, fo, gp, gn);
    }
}

__device__ __forceinline__ void p0_prologue(PR P, LAS float* ldsf, const int wv) {
    const int tid = fresh_tid(wv); const size_t gt = (size_t)blockIdx.x * 512 + tid, nth = (size_t)gridDim.x * 512;
    { float* rc = (float*)(P.ws + WS_ROPE); float* rs = rc + 2052 * 64;
      for (size_t i = gt; i < 2052 * 64; i += nth) { const int p = (int)(i >> 6), f = (int)(i & 63); const int pos = p < 2048 ? p : 16384 + (p - 2048);
          double inv = 1.0; for (int q = 0; q < f; ++q) inv *= 0.8659643233600653;
          const double ang = (double)pos * inv; const double n = rint(ang * 0.15915494309189535); const double r = ang - n * 6.283185307179586;
          const double r2 = r * r; double s = 0.0, c = 0.0;
          for (int k = 14; k >= 0; --k) { s = s * (-r2 / (double)((2 * k + 2) * (2 * k + 3))) + 1.0; c = c * (-r2 / (double)((2 * k + 1) * (2 * k + 2))) + 1.0; }
          rc[i] = (float)c; rs[i] = (float)(s * r); } }
    { bf16_t* Wl = (bf16_t*)(P.ws + WS_WL);
      for (size_t i = gt; i < 1536 * 256; i += nth) { const int n = (int)(i >> 8), k = (int)(i & 255); float v = 0.f;
          if (n < 512) { if (k < 64) v = P.w2[k * 512 + n]; } else if (n < 1024) { if (k >= 64 && k < 128) v = P.a2[(k - 64) * 512 + (n - 512)]; } else { if (k >= 128) v = P.g2[(k - 128) * 512 + (n - 1024)]; }
          Wl[i] = f2bf(v); } }
    { bf16_t* XN = (bf16_t*)(P.ws + WS_XN);
      for (size_t i = gt; i < 256 * 1024; i += nth) { const int r = (int)(i >> 10); XN[(size_t)MT * 1024 + i] = r < 128 ? f2bf(P.state_shift[i]) : (bf16_t)0; } }
    tconv_list(P.f1g, P.f1u, P.f1d, P.w_in, P.w_out, P.ws, 3328, ldsf, wv);
    rows_phase(P, 0, wv);
}

__device__ __forceinline__ void lora_prep(PR P, const int wv) {
    const int tid = fresh_tid(wv); const int lane = tid & 63; const int gw = blockIdx.x * 8 + (tid >> 6), nw = gridDim.x * 8;
    const bf16_t* PS = (const bf16_t*)(P.ws + WS_BIG); bf16_t* LA = (bf16_t*)(P.ws + WS_LA);
    const float4 mu = *(const float4*)(P.mu + 1536 + lane * 4); const int kind = lane >> 4;
    if (gw >= MT) return;
    const int last = gw + ((MT - 1 - gw) / nw) * nw;
    u32x2 c, p, nc, np;
    { const int pr = prev_row(gw); c = *(const u32x2*)(PS + (size_t)gw * NCOLS + 1536 + lane * 4); p = *(const u32x2*)(PS + (size_t)(pr >= 0 ? pr : gw) * NCOLS + 1536 + lane * 4); }
    for (int row = gw; row < MT; row += nw) {
        const int nrow = row + nw < MT ? row + nw : last; const int npr = prev_row(nrow);
        nc = *(const u32x2*)(PS + (size_t)nrow * NCOLS + 1536 + lane * 4); np = *(const u32x2*)(PS + (size_t)(npr >= 0 ? npr : nrow) * NCOLS + 1536 + lane * 4);
        if (prev_row(row) < 0) p = (u32x2){0u, 0u};
        float v[4]; const float cu[4] = {lo_bf(c.x), hi_bf(c.x), lo_bf(c.y), hi_bf(c.y)}, pv[4] = {lo_bf(p.x), hi_bf(p.x), lo_bf(p.y), hi_bf(p.y)}, m4[4] = {mu.x, mu.y, mu.z, mu.w};
#pragma unroll
        for (int j = 0; j < 4; ++j) { float x = cu[j] + (pv[j] - cu[j]) * m4[j];
            if (kind == 0) x = 1.0f - 2.0f * __builtin_amdgcn_rcpf(__expf(2.0f * x) + 1.0f); else if (kind >= 2) x = sigmoid_f(x);
            v[j] = x; }
        u32x2 w; w.x = pg8::cvt_pk_bf16(v[0], v[1]); w.y = pg8::cvt_pk_bf16(v[2], v[3]);
        *(u32x2*)(LA + (size_t)row * 256 + lane * 4) = w;
        c = nc; p = np;
    }
}

template <bool SAMPLE>
__device__ __forceinline__ void rwkv_unit(PR P, LAS float* lds, const int b, const int h, const int half, const int wv) {
    constexpr int T = SAMPLE ? 4 : 2048, TC = SAMPLE ? 4 : 32, NCH = T / TC;
    const int tid = fresh_tid(wv), lane = tid & 63, wid = tid >> 6;
    const bf16_t* PS = (const bf16_t*)(P.ws + WS_BIG); const bf16_t* OMD = (const bf16_t*)(P.ws + WS_OMD); const bf16_t* ASIG = (const bf16_t*)(P.ws + WS_ASIG);
    bf16_t* YS = (bf16_t*)(P.ws + WS_YS);
    const int row_base = SAMPLE ? MP + b * 4 : b * 2048;
    const int ltok = (tid - 256) >> 4, lcg = tid & 15; const bool lwave = tid >= 256; const int hch = h * 64 + lcg * 4;
    const float4 mur = *(const float4*)(P.mu + hch), muk = *(const float4*)(P.mu + 512 + hch), muv = *(const float4*)(P.mu + 1024 + hch);
    const float4 kk4 = *(const float4*)(P.k_k + hch), ka4 = *(const float4*)(P.k_a + hch);
    typedef float f32x2 __attribute__((ext_vector_type(2)));
    const int row0 = half * 32 + (wid & 3) * 8 + (lane >> 4) * 2, cgl = lane & 15, j0 = cgl * 4;
    f32x2 S[4];
#pragma unroll
    for (int c = 0; c < 4; ++c) S[c] = (f32x2){0.f, 0.f};
    float* sout = P.out + (SAMPLE ? O_WKS : O_WKP) + ((size_t)(b * 8 + h) * 64 + row0) * 64 + j0;
    if (SAMPLE && wid < 4) { const float* sp = P.state_wkv + ((size_t)(b * 8 + h) * 64 + row0) * 64 + j0; const float4 s0 = *(const float4*)sp, s1 = *(const float4*)(sp + 64);
        S[0] = (f32x2){s0.x, s1.x}; S[1] = (f32x2){s0.y, s1.y}; S[2] = (f32x2){s0.z, s1.z}; S[3] = (f32x2){s0.w, s1.w}; }
    LAS float* buf0 = lds; LAS float* buf1 = lds + TC * 384;
    u32x2 cr[2], ck[2], cv[2], pr[2], pk[2], pv[2], co[2], ca[2];
#define RW_LOAD1(c, U) do { if (lwave && ltok + 16 * (U) < TC) { const int t_ = (c) * TC + ltok + 16 * (U); const int row_ = row_base + t_; const int prow_ = SAMPLE ? (t_ == 0 ? MT + b : row_ - 1) : row_ - 1; \
        const bf16_t* cp_ = PS + (size_t)row_ * NCOLS + hch; cr[U] = *(const u32x2*)cp_; ck[U] = *(const u32x2*)(cp_ + 512); cv[U] = *(const u32x2*)(cp_ + 1024); \
        if (SAMPLE || t_ > 0) { const bf16_t* pp_ = PS + (size_t)prow_ * NCOLS + hch; pr[U] = *(const u32x2*)pp_; pk[U] = *(const u32x2*)(pp_ + 512); pv[U] = *(const u32x2*)(pp_ + 1024); } \
        else { pr[U] = (u32x2){0u, 0u}; pk[U] = pr[U]; pv[U] = pr[U]; } \
        co[U] = *(const u32x2*)(OMD + (size_t)row_ * 512 + hch); ca[U] = *(const u32x2*)(ASIG + (size_t)row_ * 512 + hch); } } while (0)
#define RW_LOAD(c) do { RW_LOAD1(c, 0); RW_LOAD1(c, 1); } while (0)
#define RW_MIX(cu, pv_, m) ((cu) + ((pv_) - (cu)) * (m))
#define RW_PROC1(dst, U) do { if (lwave && ltok + 16 * (U) < TC) { LAS float* d_ = (dst) + (ltok + 16 * (U)) * 384 + lcg * 4; \
        f32x4 r_, k_, v_, o_, a_; \
        r_[0] = RW_MIX(lo_bf(cr[U].x), lo_bf(pr[U].x), mur.x); r_[1] = RW_MIX(hi_bf(cr[U].x), hi_bf(pr[U].x), mur.y); r_[2] = RW_MIX(lo_bf(cr[U].y), lo_bf(pr[U].y), mur.z); r_[3] = RW_MIX(hi_bf(cr[U].y), hi_bf(pr[U].y), mur.w); \
        k_[0] = RW_MIX(lo_bf(ck[U].x), lo_bf(pk[U].x), muk.x); k_[1] = RW_MIX(hi_bf(ck[U].x), hi_bf(pk[U].x), muk.y); k_[2] = RW_MIX(lo_bf(ck[U].y), lo_bf(pk[U].y), muk.z); k_[3] = RW_MIX(hi_bf(ck[U].y), hi_bf(pk[U].y), muk.w); \
        v_[0] = RW_MIX(lo_bf(cv[U].x), lo_bf(pv[U].x), muv.x); v_[1] = RW_MIX(hi_bf(cv[U].x), hi_bf(pv[U].x), muv.y); v_[2] = RW_MIX(lo_bf(cv[U].y), lo_bf(pv[U].y), muv.z); v_[3] = RW_MIX(hi_bf(cv[U].y), hi_bf(pv[U].y), muv.w); \
        o_[0] = lo_bf(co[U].x); o_[1] = hi_bf(co[U].x); o_[2] = lo_bf(co[U].y); o_[3] = hi_bf(co[U].y); a_[0] = lo_bf(ca[U].x); a_[1] = hi_bf(ca[U].x); a_[2] = lo_bf(ca[U].y); a_[3] = hi_bf(ca[U].y); \
        f32x4 kk_; kk_[0] = k_[0] * kk4.x; kk_[1] = k_[1] * kk4.y; kk_[2] = k_[2] * kk4.z; kk_[3] = k_[3] * kk4.w; \
        float ss_ = kk_[0] * kk_[0] + kk_[1] * kk_[1] + kk_[2] * kk_[2] + kk_[3] * kk_[3]; ss_ = row16_sum(ss_); \
        const float inv_ = __builtin_amdgcn_rcpf(fmaxf(__builtin_amdgcn_sqrtf(ss_), 1e-12f)); kk_ = kk_ * inv_; \
        f32x4 kn_; kn_[0] = k_[0] * (1.0f + (a_[0] - 1.0f) * ka4.x); kn_[1] = k_[1] * (1.0f + (a_[1] - 1.0f) * ka4.y); kn_[2] = k_[2] * (1.0f + (a_[2] - 1.0f) * ka4.z); kn_[3] = k_[3] * (1.0f + (a_[3] - 1.0f) * ka4.w); \
        *(LAS f32x4*)(d_) = r_; *(LAS f32x4*)(d_ + 64) = o_; *(LAS f32x4*)(d_ + 128) = kn_; *(LAS f32x4*)(d_ + 192) = -kk_; *(LAS f32x4*)(d_ + 256) = kk_ * a_; *(LAS f32x4*)(d_ + 320) = v_; } } while (0)
#define RW_PROC(dst) do { RW_PROC1(dst, 0); RW_PROC1(dst, 1); } while (0)
    RW_LOAD(0); RW_PROC(buf0); __syncthreads();
    for (int c = 0; c < NCH; ++c) {
        LAS float* cur = (c & 1) ? buf1 : buf0; LAS float* nxt = (c & 1) ? buf0 : buf1;
        if (c + 1 < NCH) RW_LOAD(c + 1);
        if (wid < 4) {
            constexpr int GS = SAMPLE ? 4 : 16;
            for (int g = 0; g < TC / GS; ++g) {
                float yk0 = 0.f, yk1 = 0.f;
                const LAS float* q0 = cur + (g * GS) * 384;
                f32x4 r4 = *(const LAS f32x4*)(q0 + j0), o4 = *(const LAS f32x4*)(q0 + 64 + j0), k4 = *(const LAS f32x4*)(q0 + 128 + j0), a4 = *(const LAS f32x4*)(q0 + 192 + j0), b4 = *(const LAS f32x4*)(q0 + 256 + j0);
                f32x2 v2 = *(const LAS f32x2*)(q0 + 320 + row0);
                float py0 = 0.f, py1 = 0.f;
#pragma unroll
                for (int tt = 0; tt < GS; ++tt) {
                    const LAS float* qn = q0 + (tt + 1 < GS ? tt + 1 : tt) * 384;
                    const f32x4 nr4 = *(const LAS f32x4*)(qn + j0), no4 = *(const LAS f32x4*)(qn + 64 + j0), nk4 = *(const LAS f32x4*)(qn + 128 + j0), na4 = *(const LAS f32x4*)(qn + 192 + j0), nb4 = *(const LAS f32x4*)(qn + 256 + j0);
                    const f32x2 nv2 = *(const LAS f32x2*)(qn + 320 + row0);
                    f32x2 sa = (S[0] * a4[0] + S[1] * a4[1]) + (S[2] * a4[2] + S[3] * a4[3]);
                    float sx = sa.x, sy = sa.y; ROW16_SUM4(sx, sy, py0, py1); sa = (f32x2){sx, sy};
                    if (tt > 0) { yk0 = cgl == tt - 1 ? py0 : yk0; yk1 = cgl == tt - 1 ? py1 : yk1; }
#pragma unroll
                    for (int c = 0; c < 4; ++c) { f32x2 t = S[c] - S[c] * o4[c]; t = t + sa * b4[c]; S[c] = t + v2 * k4[c]; }
                    const f32x2 y = (S[0] * r4[0] + S[1] * r4[1]) + (S[2] * r4[2] + S[3] * r4[3]);
                    py0 = y.x; py1 = y.y;
                    r4 = nr4; o4 = no4; k4 = nk4; a4 = na4; b4 = nb4; v2 = nv2;
                }
                ROW16_SUM2(py0, py1); yk0 = cgl == GS - 1 ? py0 : yk0; yk1 = cgl == GS - 1 ? py1 : yk1;
                if (cgl < GS) *(unsigned*)(YS + (size_t)(row_base + c * TC + g * GS + cgl) * 512 + h * 64 + row0) = pg8::cvt_pk_bf16(yk0, yk1);
            }
        }
        if (c + 1 < NCH) RW_PROC(nxt);
        __syncthreads();
    }
    if (wid < 4) { *(float4*)sout = make_float4(S[0].x, S[1].x, S[2].x, S[3].x); *(float4*)(sout + 64) = make_float4(S[0].y, S[1].y, S[2].y, S[3].y); }
#undef RW_LOAD
#undef RW_PROC
#undef RW_LOAD1
#undef RW_PROC1
#undef RW_MIX
}

__device__ __forceinline__ void ret_sample_unit(PR P, LAS float* lds, const int b, const int h, const int wv) {
    const int tid = fresh_tid(wv), lane = tid & 63, wid = tid >> 6;
    const bf16_t* PS = (const bf16_t*)(P.ws + WS_BIG); bf16_t* Y = (bf16_t*)(P.ws + WS_XN);
    const float* rc = (const float*)(P.ws + WS_ROPE); const float* rs = rc + 2052 * 64;
    LAS float* q = lds; LAS float* k = lds + 512; LAS float* v = lds + 1024; LAS float* Pm = lds + 1536; LAS float* y2p = lds + 1600; LAS float* red = lds + 1600 + 2048;
    const float lg2 = log2f(1.0f - exp2f(-5.0f - (float)h));
    const int row0 = MP + b * 4;
    { const int t = (tid & 255) >> 6, f = tid & 63; const bf16_t* src = PS + (size_t)(row0 + t) * NCOLS + 1792 + h * 128;
      if (tid < 256) { const float cs = rc[(2048 + t) * 64 + f], sn = rs[(2048 + t) * 64 + f];
          const float q1 = bf2f(src[f]), q2 = bf2f(src[f + 64]); q[t * 128 + f] = q1 * cs - q2 * sn; q[t * 128 + f + 64] = q1 * sn + q2 * cs;
          const float k1 = bf2f(src[512 + f]), k2 = bf2f(src[512 + f + 64]); k[t * 128 + f] = (k1 * cs - k2 * sn) * 0.08838834764831845f; k[t * 128 + f + 64] = (k1 * sn + k2 * cs) * 0.08838834764831845f; }
      else { v[t * 128 + f] = bf2f(src[1024 + f]); v[t * 128 + f + 64] = bf2f(src[1024 + f + 64]); } }
    __syncthreads();
    if (wid == 0) { const int pi = lane >> 4, pj = (lane >> 2) & 3, part = lane & 3; float s = 0.f;
        for (int d = part * 32; d < part * 32 + 32; ++d) s += q[pi * 128 + d] * k[pj * 128 + d];
        s = quad_sum(s); if (part == 0) Pm[pi * 4 + pj] = pi >= pj ? s * exp2f(lg2 * (float)(pi - pj)) : 0.f; }
    { const int e = tid & 127, dg = tid >> 7; const float c4 = exp2f(lg2 * 4.0f), g3 = exp2f(lg2 * 3.0f), g2_ = exp2f(lg2 * 2.0f), g1 = exp2f(lg2);
      const float v0 = v[e] * g3, v1 = v[128 + e] * g2_, v2 = v[256 + e] * g1, v3 = v[384 + e];
      const float* S0 = P.state_ret + ((size_t)(b * 4 + h) * 128) * 128 + e; float* So = P.out + O_RTS + ((size_t)(b * 4 + h) * 128) * 128 + e;
      float a0 = 0.f, a1 = 0.f, a2 = 0.f, a3 = 0.f;
      float sv[32];
#pragma unroll
      for (int x = 0; x < 32; ++x) sv[x] = S0[(size_t)(dg * 32 + x) * 128];
#pragma unroll
      for (int x = 0; x < 32; ++x) { const int d = dg * 32 + x; const float s = sv[x];
          a0 = fmaf(q[d], s, a0); a1 = fmaf(q[128 + d], s, a1); a2 = fmaf(q[256 + d], s, a2); a3 = fmaf(q[384 + d], s, a3);
          So[(size_t)d * 128] = s * c4 + k[d] * v0 + k[128 + d] * v1 + k[256 + d] * v2 + k[384 + d] * v3; }
      y2p[(dg * 4 + 0) * 128 + e] = a0; y2p[(dg * 4 + 1) * 128 + e] = a1; y2p[(dg * 4 + 2) * 128 + e] = a2; y2p[(dg * 4 + 3) * 128 + e] = a3; }
    __syncthreads();
    { const int i = tid >> 7, e = tid & 127;
      float y = (y2p[(0 + i) * 128 + e] + y2p[(4 + i) * 128 + e] + y2p[(8 + i) * 128 + e] + y2p[(12 + i) * 128 + e]) * exp2f(lg2 * (float)(i + 1));
#pragma unroll
      for (int j = 0; j < 4; ++j) y = fmaf(Pm[i * 4 + j], v[j * 128 + e], y);
      float s = wave_sum(y); if (lane == 0) red[wid] = s; __syncthreads();
      const float mean = (red[i * 2] + red[i * 2 + 1]) * (1.0f / 128.0f); const float dlt = y - mean;
      float s2 = wave_sum(dlt * dlt); if (lane == 0) red[8 + wid] = s2; __syncthreads();
      const float var = (red[8 + i * 2] + red[8 + i * 2 + 1]) * (1.0f / 128.0f);
      const float g = bf2f(PS[(size_t)(row0 + i) * NCOLS + 1792 + 1536 + h * 128 + e]);
      const float o = dlt * rsqrtf(var + 1e-5f) * P.gn_w[h * 128 + e] * (g * __builtin_amdgcn_rcpf(1.0f + __expf(-g)));
      Y[(size_t)(row0 + i) * 1024 + 512 + h * 128 + e] = f2bf(o); }
    __syncthreads();
}

__device__ __forceinline__ bf16_t* kvb_ptr(unsigned char* ws, int bh) { return (bf16_t*)(bh < 29 ? ws + WS_LA + (size_t)bh * 524288 : ws + WS_WIN + 17301504 + (size_t)(bh - 29) * 524288); }
constexpr int RS = 136, BUFE = 128 * RS;

template <bool WITH_K>
__device__ __forceinline__ void ret_load_qk(PR P, LAS bf16_t* QP, LAS bf16_t* KB, unsigned (&kth)[4][4], const int tidv, const int row0, const int n, const int h, const float kd0, const float g32) {
    const bf16_t* PS = (const bf16_t*)(P.ws + WS_BIG); const float* rc = (const float*)(P.ws + WS_ROPE); const float* rs = rc + 2052 * 64;
    float kd = kd0;
#pragma unroll
    for (int it = 0; it < 4; ++it) { const int idx = it * 512 + tidv, i = idx >> 4, f = (idx & 15) * 4;
        const bf16_t* src = PS + (size_t)(row0 + i) * NCOLS + 1792 + h * 128;
        const u32x2 q1 = *(const u32x2*)(src + f), q2 = *(const u32x2*)(src + 64 + f);
        u32x2 k1 = (u32x2){0u, 0u}, k2 = k1; if (WITH_K) { k1 = *(const u32x2*)(src + 512 + f); k2 = *(const u32x2*)(src + 576 + f); }
        const float4 cs = *(const float4*)(rc + (size_t)(n * 128 + i) * 64 + f), sn = *(const float4*)(rs + (size_t)(n * 128 + i) * 64 + f);
        const float c4[4] = {cs.x, cs.y, cs.z, cs.w}, s4[4] = {sn.x, sn.y, sn.z, sn.w};
        const float qa[4] = {lo_bf(q1.x), hi_bf(q1.x), lo_bf(q1.y), hi_bf(q1.y)}, qb[4] = {lo_bf(q2.x), hi_bf(q2.x), lo_bf(q2.y), hi_bf(q2.y)};
        float qo1[4], qo2[4];
#pragma unroll
        for (int x = 0; x < 4; ++x) { qo1[x] = qa[x] * c4[x] - qb[x] * s4[x]; qo2[x] = qa[x] * s4[x] + qb[x] * c4[x]; }
        u32x2 w; w.x = pg8::cvt_pk_bf16(qo1[0], qo1[1]); w.y = pg8::cvt_pk_bf16(qo1[2], qo1[3]); *(LAS u32x2*)(QP + i * RS + f) = w;
        w.x = pg8::cvt_pk_bf16(qo2[0], qo2[1]); w.y = pg8::cvt_pk_bf16(qo2[2], qo2[3]); *(LAS u32x2*)(QP + i * RS + 64 + f) = w;
        if (WITH_K) {
            const float ka[4] = {lo_bf(k1.x), hi_bf(k1.x), lo_bf(k1.y), hi_bf(k1.y)}, kb[4] = {lo_bf(k2.x), hi_bf(k2.x), lo_bf(k2.y), hi_bf(k2.y)};
            float ko1[4], ko2[4];
#pragma unroll
            for (int x = 0; x < 4; ++x) { ko1[x] = (ka[x] * c4[x] - kb[x] * s4[x]) * 0.08838834764831845f; ko2[x] = (ka[x] * s4[x] + kb[x] * c4[x]) * 0.08838834764831845f; }
            w.x = pg8::cvt_pk_bf16(ko1[0], ko1[1]); w.y = pg8::cvt_pk_bf16(ko1[2], ko1[3]); *(LAS u32x2*)(KB + i * RS + f) = w;
            w.x = pg8::cvt_pk_bf16(ko2[0], ko2[1]); w.y = pg8::cvt_pk_bf16(ko2[2], ko2[3]); *(LAS u32x2*)(KB + i * RS + 64 + f) = w;
            kth[it][0] = pg8::cvt_pk_bf16(ko1[0] * kd, ko1[1] * kd); kth[it][1] = pg8::cvt_pk_bf16(ko1[2] * kd, ko1[3] * kd);
            kth[it][2] = pg8::cvt_pk_bf16(ko2[0] * kd, ko2[1] * kd); kth[it][3] = pg8::cvt_pk_bf16(ko2[2] * kd, ko2[3] * kd); kd *= g32; }
        if (it & 1) __builtin_amdgcn_sched_barrier(0); }
}

__device__ __forceinline__ void ret_unit_a(PR P, LAS unsigned char* lds, const int bh, const int n, const int wv) {
    LAS bf16_t* QP = (LAS bf16_t*)lds; LAS bf16_t* KB = QP + BUFE; LAS bf16_t* VT = KB + BUFE;
    const int tid = fresh_tid(wv), lane = tid & 63, wid = tid >> 6, wr = wid >> 1, wc = wid & 1, fr = lane & 15, fq = lane >> 4;
    const int b = bh >> 2, h = bh & 3;
    const bf16_t* PS = (const bf16_t*)(P.ws + WS_BIG); bf16_t* Y = (bf16_t*)(P.ws + WS_XN); bf16_t* KVB = kvb_ptr(P.ws, bh) + (size_t)n * 16384;
    const float lg2 = log2f(1.0f - exp2f(-5.0f - (float)h));
    const float kd0 = exp2f(lg2 * (float)(127 - (tid >> 4))), g32 = exp2f(-32.0f * lg2);
    const int row0 = b * 2048 + n * 128;
    unsigned kth[4][4];
    ret_load_qk<true>(P, QP, KB, kth, tid, row0, n, h, kd0, g32);
#pragma unroll
    for (int it = 0; it < 4; ++it) { const int idx = it * 512 + tid, j = idx >> 4, e = (idx & 15) * 8;
        const u32x4 vv = *(const u32x4*)(PS + (size_t)(row0 + j) * NCOLS + 1792 + 1024 + h * 128 + e);
        LAS bf16_t* d = VT + e * RS + j;
        d[0] = (bf16_t)(vv.x & 0xffffu); d[RS] = (bf16_t)(vv.x >> 16); d[2 * RS] = (bf16_t)(vv.y & 0xffffu); d[3 * RS] = (bf16_t)(vv.y >> 16);
        d[4 * RS] = (bf16_t)(vv.z & 0xffffu); d[5 * RS] = (bf16_t)(vv.z >> 16); d[6 * RS] = (bf16_t)(vv.w & 0xffffu); d[7 * RS] = (bf16_t)(vv.w >> 16); }
    __syncthreads();
    f32x4 accP[2][4];
#pragma unroll
    for (int mt = 0; mt < 2; ++mt)
#pragma unroll
        for (int nt = 0; nt < 4; ++nt) accP[mt][nt] = (f32x4){0.f, 0.f, 0.f, 0.f};
#pragma unroll
    for (int ks = 0; ks < 4; ++ks) { bf16x8 aq[2];
#pragma unroll
        for (int mt = 0; mt < 2; ++mt) aq[mt] = *(const LAS bf16x8*)(QP + (wr * 32 + mt * 16 + fr) * RS + ks * 32 + fq * 8);
#pragma unroll
        for (int nt = 0; nt < 4; ++nt) { const bf16x8 bk = *(const LAS bf16x8*)(KB + (wc * 64 + nt * 16 + fr) * RS + ks * 32 + fq * 8);
#pragma unroll
            for (int mt = 0; mt < 2; ++mt) accP[mt][nt] = __builtin_amdgcn_mfma_f32_16x16x32_bf16(aq[mt], bk, accP[mt][nt], 0, 0, 0); }
        __builtin_amdgcn_sched_barrier(0); }
    __syncthreads();
    { float ri[2][4], cj[4];
#pragma unroll
      for (int mt = 0; mt < 2; ++mt)
#pragma unroll
          for (int j = 0; j < 4; ++j) ri[mt][j] = exp2f(lg2 * (float)(wr * 32 + mt * 16 + fq * 4 + j));
#pragma unroll
      for (int nt = 0; nt < 4; ++nt) cj[nt] = exp2f(-lg2 * (float)(wc * 64 + nt * 16 + fr));
#pragma unroll
      for (int mt = 0; mt < 2; ++mt)
#pragma unroll
          for (int nt = 0; nt < 4; ++nt)
#pragma unroll
              for (int j = 0; j < 4; ++j) { const int i = wr * 32 + mt * 16 + fq * 4 + j, jj = wc * 64 + nt * 16 + fr;
                  const float val = i >= jj ? accP[mt][nt][j] * ri[mt][j] * cj[nt] : 0.f; QP[i * RS + jj] = f2bf(val); } }
#pragma unroll
    for (int it = 0; it < 4; ++it) { const int idx = it * 512 + tid, j = idx >> 4, f = (idx & 15) * 4; LAS bf16_t* d = KB + f * RS + j;
        d[0] = (bf16_t)(kth[it][0] & 0xffffu); d[RS] = (bf16_t)(kth[it][0] >> 16); d[2 * RS] = (bf16_t)(kth[it][1] & 0xffffu); d[3 * RS] = (bf16_t)(kth[it][1] >> 16);
        LAS bf16_t* d2 = d + 64 * RS;
        d2[0] = (bf16_t)(kth[it][2] & 0xffffu); d2[RS] = (bf16_t)(kth[it][2] >> 16); d2[2 * RS] = (bf16_t)(kth[it][3] & 0xffffu); d2[3 * RS] = (bf16_t)(kth[it][3] >> 16); }
    __syncthreads();
    f32x4 accY[2][4], accS[2][4];
#pragma unroll
    for (int mt = 0; mt < 2; ++mt)
#pragma unroll
        for (int nt = 0; nt < 4; ++nt) { accY[mt][nt] = (f32x4){0.f, 0.f, 0.f, 0.f}; accS[mt][nt] = (f32x4){0.f, 0.f, 0.f, 0.f}; }
#pragma unroll
    for (int ks = 0; ks < 4; ++ks) { bf16x8 ap[2], av[2];
#pragma unroll
        for (int mt = 0; mt < 2; ++mt) { ap[mt] = *(const LAS bf16x8*)(QP + (wr * 32 + mt * 16 + fr) * RS + ks * 32 + fq * 8); av[mt] = *(const LAS bf16x8*)(VT + (wr * 32 + mt * 16 + fr) * RS + ks * 32 + fq * 8); }
#pragma unroll
        for (int nt = 0; nt < 4; ++nt) { const bf16x8 bv = *(const LAS bf16x8*)(VT + (wc * 64 + nt * 16 + fr) * RS + ks * 32 + fq * 8), bkt = *(const LAS bf16x8*)(KB + (wc * 64 + nt * 16 + fr) * RS + ks * 32 + fq * 8);
#pragma unroll
            for (int mt = 0; mt < 2; ++mt) { accY[mt][nt] = __builtin_amdgcn_mfma_f32_16x16x32_bf16(ap[mt], bv, accY[mt][nt], 0, 0, 0); accS[mt][nt] = __builtin_amdgcn_mfma_f32_16x16x32_bf16(av[mt], bkt, accS[mt][nt], 0, 0, 0); } }
        __builtin_amdgcn_sched_barrier(0); }
#pragma unroll
    for (int mt = 0; mt < 2; ++mt)
#pragma unroll
        for (int nt = 0; nt < 4; ++nt)
#pragma unroll
            for (int j = 0; j < 4; ++j) { const int r = wr * 32 + mt * 16 + fq * 4 + j, c = wc * 64 + nt * 16 + fr;
                Y[(size_t)(row0 + r) * 1024 + 512 + h * 128 + c] = f2bf(accY[mt][nt][j]); KVB[r * 128 + c] = f2bf(accS[mt][nt][j]); }
    __syncthreads();
}

__device__ __forceinline__ void ret_prefix(PR P, const int item) {
    const int bh = item >> 11, i8 = (item & 2047) * 8; const int h = bh & 3;
    bf16_t* KVB = kvb_ptr(P.ws, bh) + i8;
    const float lg2 = log2f(1.0f - exp2f(-5.0f - (float)h)); const float c_dec = exp2f(lg2 * 128.0f);
    u32x4 kv[16];
#pragma unroll
    for (int n = 0; n < 16; ++n) kv[n] = *(const u32x4*)(KVB + (size_t)n * 16384);
    float S[8];
#pragma unroll
    for (int x = 0; x < 8; ++x) S[x] = 0.f;
#pragma unroll
    for (int n = 0; n < 16; ++n) { u32x4 w; w.x = pg8::cvt_pk_bf16(S[0], S[1]); w.y = pg8::cvt_pk_bf16(S[2], S[3]); w.z = pg8::cvt_pk_bf16(S[4], S[5]); w.w = pg8::cvt_pk_bf16(S[6], S[7]);
        *(u32x4*)(KVB + (size_t)n * 16384) = w;
        const float k8[8] = {lo_bf(kv[n].x), hi_bf(kv[n].x), lo_bf(kv[n].y), hi_bf(kv[n].y), lo_bf(kv[n].z), hi_bf(kv[n].z), lo_bf(kv[n].w), hi_bf(kv[n].w)};
#pragma unroll
        for (int x = 0; x < 8; ++x) S[x] = S[x] * c_dec + k8[x]; }
    const int e = i8 >> 7, d0 = i8 & 127;
#pragma unroll
    for (int x = 0; x < 8; ++x) P.out[O_RTP + ((size_t)bh * 128 + d0 + x) * 128 + e] = S[x];
}

__device__ __forceinline__ void ret_unit_c(PR P, LAS unsigned char* lds, const int bh, const int n, const int wv) {
    LAS bf16_t* QP = (LAS bf16_t*)lds; LAS bf16_t* ST = QP + 3 * BUFE; LAS float* YST = (LAS float*)(QP + BUFE);
    const int tid = fresh_tid(wv), lane = tid & 63, wid = tid >> 6, wr = wid >> 1, wc = wid & 1, fr = lane & 15, fq = lane >> 4;
    const int b = bh >> 2, h = bh & 3;
    const bf16_t* PS = (const bf16_t*)(P.ws + WS_BIG); bf16_t* Y = (bf16_t*)(P.ws + WS_XN); const bf16_t* KVB = kvb_ptr(P.ws, bh) + (size_t)n * 16384;
    const float lg2 = log2f(1.0f - exp2f(-5.0f - (float)h));
    const int row0 = b * 2048 + n * 128;
    unsigned kth[4][4];
    ret_load_qk<false>(P, QP, QP, kth, tid, row0, n, h, 0.f, 0.f);
#pragma unroll
    for (int it = 0; it < 4; ++it) { const int idx = it * 512 + tid, e = idx >> 4, d8 = (idx & 15) * 8;
        *(LAS u32x4*)(ST + e * RS + d8) = *(const u32x4*)(KVB + e * 128 + d8); }
    __syncthreads();
    f32x4 accY[2][4];
#pragma unroll
    for (int mt = 0; mt < 2; ++mt)
#pragma unroll
        for (int nt = 0; nt < 4; ++nt) accY[mt][nt] = (f32x4){0.f, 0.f, 0.f, 0.f};
#pragma unroll
    for (int ks = 0; ks < 4; ++ks) { bf16x8 aq[2];
#pragma unroll
        for (int mt = 0; mt < 2; ++mt) aq[mt] = *(const LAS bf16x8*)(QP + (wr * 32 + mt * 16 + fr) * RS + ks * 32 + fq * 8);
#pragma unroll
        for (int nt = 0; nt < 4; ++nt) { const bf16x8 bs = *(const LAS bf16x8*)(ST + (wc * 64 + nt * 16 + fr) * RS + ks * 32 + fq * 8);
#pragma unroll
            for (int mt = 0; mt < 2; ++mt) accY[mt][nt] = __builtin_amdgcn_mfma_f32_16x16x32_bf16(aq[mt], bs, accY[mt][nt], 0, 0, 0); }
        __builtin_amdgcn_sched_barrier(0); }
#pragma unroll
    for (int mt = 0; mt < 2; ++mt)
#pragma unroll
        for (int j = 0; j < 4; ++j) { const int r = wr * 32 + mt * 16 + fq * 4 + j; const float qd = exp2f(lg2 * (float)(r + 1));
#pragma unroll
            for (int nt = 0; nt < 4; ++nt) YST[r * 132 + wc * 64 + nt * 16 + fr] = accY[mt][nt][j] * qd; }
    __syncthreads();
    { const int i = tid >> 2, part = tid & 3; float yv[32]; float s = 0.f;
      bf16_t* yo = Y + (size_t)(row0 + i) * 1024 + 512 + h * 128 + part * 32;
#pragma unroll
      for (int x = 0; x < 4; ++x) { const u32x4 y1 = *(const u32x4*)(yo + x * 8); const f32x4 ta = *(const LAS f32x4*)(YST + i * 132 + part * 32 + x * 8), tb = *(const LAS f32x4*)(YST + i * 132 + part * 32 + x * 8 + 4);
          yv[x * 8 + 0] = ta[0] + lo_bf(y1.x); yv[x * 8 + 1] = ta[1] + hi_bf(y1.x); yv[x * 8 + 2] = ta[2] + lo_bf(y1.y); yv[x * 8 + 3] = ta[3] + hi_bf(y1.y);
          yv[x * 8 + 4] = tb[0] + lo_bf(y1.z); yv[x * 8 + 5] = tb[1] + hi_bf(y1.z); yv[x * 8 + 6] = tb[2] + lo_bf(y1.w); yv[x * 8 + 7] = tb[3] + hi_bf(y1.w); }
#pragma unroll
      for (int x = 0; x < 32; ++x) s += yv[x];
      s = quad_sum(s); const float mean = s * (1.0f / 128.0f); float s2 = 0.f;
#pragma unroll
      for (int x = 0; x < 32; ++x) { yv[x] -= mean; s2 += yv[x] * yv[x]; }
      s2 = quad_sum(s2); const float rstd = rsqrtf(s2 * (1.0f / 128.0f) + 1e-5f);
      const bf16_t* gp = PS + (size_t)(row0 + i) * NCOLS + 1792 + 1536 + h * 128 + part * 32; const float* gw = P.gn_w + h * 128 + part * 32;
#pragma unroll
      for (int x = 0; x < 4; ++x) { const u32x4 g4 = *(const u32x4*)(gp + x * 8); const float4 w0 = *(const float4*)(gw + x * 8), w1 = *(const float4*)(gw + x * 8 + 4);
          const float gg[8] = {lo_bf(g4.x), hi_bf(g4.x), lo_bf(g4.y), hi_bf(g4.y), lo_bf(g4.z), hi_bf(g4.z), lo_bf(g4.w), hi_bf(g4.w)}; const float ww[8] = {w0.x, w0.y, w0.z, w0.w, w1.x, w1.y, w1.z, w1.w};
          float o[8];
#pragma unroll
          for (int z = 0; z < 8; ++z) o[z] = yv[x * 8 + z] * rstd * ww[z] * (gg[z] * __builtin_amdgcn_rcpf(1.0f + __expf(-gg[z])));
          u32x4 w; w.x = pg8::cvt_pk_bf16(o[0], o[1]); w.y = pg8::cvt_pk_bf16(o[2], o[3]); w.z = pg8::cvt_pk_bf16(o[4], o[5]); w.w = pg8::cvt_pk_bf16(o[6], o[7]);
          *(u32x4*)(yo + x * 8) = w; } }
    __syncthreads();
}

__device__ __forceinline__ void sub_barrier(unsigned* cnt, const unsigned target, const int wv) {
    asm volatile("s_waitcnt vmcnt(0)" ::: "memory");
    __syncthreads();
    if (fresh_tid(wv) == 0) {
        __builtin_amdgcn_fence(__ATOMIC_RELEASE, "agent");
        asm volatile("s_waitcnt vmcnt(0)" ::: "memory");
        (void)xb_add(cnt, 1u);
        unsigned sp = 0u;
        while (xb_ld(cnt) < target) { __builtin_amdgcn_s_sleep(2); if (++sp > (1u << 20)) break; }
        __builtin_amdgcn_fence(__ATOMIC_ACQUIRE, "agent");
        asm volatile("s_waitcnt vmcnt(0)" ::: "memory");
    }
    __syncthreads();
}

struct PostRegs { u32x2 yr, c_r, c_k, c_v, p_r, p_k, p_v, ar, gr; };
__device__ __forceinline__ void post_load(PR P, PostRegs& R, const int row, const int ch) {
    const bf16_t* PS = (const bf16_t*)(P.ws + WS_BIG); const bf16_t* ASIG = (const bf16_t*)(P.ws + WS_ASIG); const bf16_t* YS = (const bf16_t*)(P.ws + WS_YS); const bf16_t* G = (const bf16_t*)(P.ws + WS_WIN);
    R.yr = *(const u32x2*)(YS + (size_t)row * 512 + ch);
    const bf16_t* cp = PS + (size_t)row * NCOLS + ch; const int pr = prev_row(row);
    R.c_r = *(const u32x2*)cp; R.c_k = *(const u32x2*)(cp + 512); R.c_v = *(const u32x2*)(cp + 1024);
    { const bf16_t* pp = PS + (size_t)(pr >= 0 ? pr : row) * NCOLS + ch; R.p_r = *(const u32x2*)pp; R.p_k = *(const u32x2*)(pp + 512); R.p_v = *(const u32x2*)(pp + 1024); }
    R.ar = *(const u32x2*)(ASIG + (size_t)row * 512 + ch); R.gr = *(const u32x2*)(G + (size_t)row * 512 + ch);
}
__device__ __forceinline__ void rwkv_post(PR P, const int wv) {
    const int tid = fresh_tid(wv); const int lane = tid & 63; const int gw = blockIdx.x * 8 + (tid >> 6), nw = gridDim.x * 8;
    const int sub = lane >> 4, cg4 = (lane & 15) * 4;
    bf16_t* Y = (bf16_t*)(P.ws + WS_XN);
    const int h = (gw * 4 + sub) & 7, ch = h * 64 + cg4;
    const float4 mr = *(const float4*)(P.mu + ch), mk = *(const float4*)(P.mu + 512 + ch), mv = *(const float4*)(P.mu + 1024 + ch);
    const float4 ka = *(const float4*)(P.k_a + ch), rk = *(const float4*)(P.r_k + ch), lw = *(const float4*)(P.lnx_w + ch), lb = *(const float4*)(P.lnx_b + ch);
    const float m_r[4] = {mr.x, mr.y, mr.z, mr.w}, m_k[4] = {mk.x, mk.y, mk.z, mk.w}, m_v[4] = {mv.x, mv.y, mv.z, mv.w};
    const float kaa[4] = {ka.x, ka.y, ka.z, ka.w}, rkk[4] = {rk.x, rk.y, rk.z, rk.w}, lww[4] = {lw.x, lw.y, lw.z, lw.w}, lbb[4] = {lb.x, lb.y, lb.z, lb.w};
    PostRegs R, N;
    if (gw < MT * 2) post_load(P, R, (gw * 4 + sub) >> 3, ch);
    for (int task = gw; task < MT * 2; task += nw) {
        const int row = (task * 4 + sub) >> 3;
        { const int nt_ = task + nw < MT * 2 ? task + nw : task; post_load(P, N, (nt_ * 4 + sub) >> 3, ch); }
        if (prev_row(row) < 0) { R.p_r = (u32x2){0u, 0u}; R.p_k = R.p_r; R.p_v = R.p_r; }
        const float ys[4] = {lo_bf(R.yr.x), hi_bf(R.yr.x), lo_bf(R.yr.y), hi_bf(R.yr.y)};
        const float mean = row16_sum(ys[0] + ys[1] + ys[2] + ys[3]) * (1.0f / 64.0f);
        float dl[4], s2 = 0.f;
#pragma unroll
        for (int j = 0; j < 4; ++j) { dl[j] = ys[j] - mean; s2 += dl[j] * dl[j]; }
        const float rstd = rsqrtf(row16_sum(s2) * (1.0f / 64.0f) + 64e-5f);
        const float cr[4] = {lo_bf(R.c_r.x), hi_bf(R.c_r.x), lo_bf(R.c_r.y), hi_bf(R.c_r.y)}, ck[4] = {lo_bf(R.c_k.x), hi_bf(R.c_k.x), lo_bf(R.c_k.y), hi_bf(R.c_k.y)}, cv[4] = {lo_bf(R.c_v.x), hi_bf(R.c_v.x), lo_bf(R.c_v.y), hi_bf(R.c_v.y)};
        const float qr[4] = {lo_bf(R.p_r.x), hi_bf(R.p_r.x), lo_bf(R.p_r.y), hi_bf(R.p_r.y)}, qk[4] = {lo_bf(R.p_k.x), hi_bf(R.p_k.x), lo_bf(R.p_k.y), hi_bf(R.p_k.y)}, qv[4] = {lo_bf(R.p_v.x), hi_bf(R.p_v.x), lo_bf(R.p_v.y), hi_bf(R.p_v.y)};
        const float aa[4] = {lo_bf(R.ar.x), hi_bf(R.ar.x), lo_bf(R.ar.y), hi_bf(R.ar.y)}, gg[4] = {lo_bf(R.gr.x), hi_bf(R.gr.x), lo_bf(R.gr.y), hi_bf(R.gr.y)};
        float v[4], bp = 0.f;
#pragma unroll
        for (int j = 0; j < 4; ++j) { const float r = cr[j] + (qr[j] - cr[j]) * m_r[j], k = ck[j] + (qk[j] - ck[j]) * m_k[j]; v[j] = cv[j] + (qv[j] - cv[j]) * m_v[j];
            const float kn = k * (1.0f + (aa[j] - 1.0f) * kaa[j]); bp += r * kn * rkk[j]; }
        const float bonus = row16_sum(bp);
        float o[4];
#pragma unroll
        for (int j = 0; j < 4; ++j) o[j] = (dl[j] * rstd * lww[j] + lbb[j] + bonus * v[j]) * gg[j];
        u32x2 w; w.x = pg8::cvt_pk_bf16(o[0], o[1]); w.y = pg8::cvt_pk_bf16(o[2], o[3]);
        *(u32x2*)(Y + (size_t)row * 1024 + ch) = w;
        R = N;
    }
}

__global__ void __launch_bounds__(512, 2) hymba_mega(Params P_unused) {
    extern __shared__ __attribute__((aligned(16))) unsigned char shm[];
    cg::grid_group grid = cg::this_grid();
    LAS unsigned char* lds = (LAS unsigned char*)shm; LAS float* ldsf = (LAS float*)shm;
    const int G = gridDim.x, bx = blockIdx.x;
    const int wv = __builtin_amdgcn_readfirstlane(threadIdx.x >> 6);
    const CAS Params* kp = (const CAS Params*)__builtin_amdgcn_kernarg_segment_ptr();
#define P (*kp)
#define FRESH() asm volatile("" : "+s"(kp))
#ifndef REP_SYNC
#define REP_SYNC 1
#endif
#ifndef REP_P7
#define REP_P7 1
#endif
#ifndef REP_FFN1
#define REP_FFN1 1
#endif
#ifndef REP_P0
#define REP_P0 1
#endif
#ifndef REP_P3
#define REP_P3 1
#endif
#ifndef REP_RW
#define REP_RW 1
#endif
#ifndef REP_OTH
#define REP_OTH 1
#endif
#ifndef REP_RETP
#define REP_RETP 1
#endif
#ifndef REP_SAMP
#define REP_SAMP 1
#endif
#ifndef REP_P8
#define REP_P8 1
#endif
#define GSYNC() do { for (int r_ = 0; r_ < REP_SYNC; ++r_) xcd_barrier((unsigned*)ws, (volatile LAS unsigned*)(lds + LDS_BYTES - 16), wv); FRESH(); } while (0)
#define ws (kp->ws)
#define XN ((bf16_t*)(ws + WS_XN))
#define ACT ((bf16_t*)(ws + WS_BIG))
#define FO ((float*)(ws + WS_FO))
#define PS ((bf16_t*)(ws + WS_BIG))
    pg8::StaticOrder S;
    { const int t0 = fresh_tid(wv); if (t0 < 4) ((LAS unsigned*)(lds + LDS_BYTES - 16))[t0] = 0u;
      if (t0 == 0) (void)xb_add(&((unsigned*)ws)[XB_XCNT(xb_xcc_id())], 1u); }
    if (G == 0x7fffffff) grid.sync();
#ifndef PHM
#define PHM 0xFFFF
#endif
#define PH(k) if ((PHM >> (k)) & 1)
    for (int r0 = 0; r0 < REP_P0; ++r0) PH(0) p0_prologue(P, ldsf, wv);
    GSYNC();
    for (int rep1 = 0; rep1 < REP_FFN1; ++rep1) {
    PH(1) { pg8::Gemm g{XN, (const bf16_t*)(ws + WS_WGU), MT, NGU, 1024}; S.init(MT, NGU, G, bx, 1024); pg8::EpiSwiGLU E{ACT, DFF}; pg8::gemm_phase(lds, g, S, E, wv); }
    GSYNC();
    PH(2) { pg8::Gemm g{ACT, (const bf16_t*)(ws + WS_WD), MT, 1024, DFF}; pg8::SplitOrder S2; S2.init2(G, bx, DFF, 8); pg8::EpiFO E{(bf16_t*)FO, 1024, (float*)(ws + WS_OMD)}; pg8::gemm_phase(lds, g, S2, E, wv); }
    GSYNC();
    }
    for (int r3 = 0; r3 < REP_P3; ++r3) PH(3) rows_phase(P, 1, wv);
    GSYNC();
    PH(4) { pg8::Gemm g{XN, (const bf16_t*)(ws + WS_WIN), MIN_, NCOLS, 1024}; S.init(MIN_, NCOLS, G, bx, 1024); pg8::EpiBf16 E{PS, NCOLS}; pg8::gemm_phase(lds, g, S, E, wv); }
    GSYNC();
    PH(5) lora_prep(P, wv);
    GSYNC();
    PH(6) { pg8::Gemm g{(const bf16_t*)(ws + WS_LA), (const bf16_t*)(ws + WS_WL), MT, 1536, 256}; pg8::LoraMainOrder SM; SM.init(MP, 1024, G, bx, 256);
      pg8::EpiLora E{(bf16_t*)(ws + WS_OMD), (bf16_t*)(ws + WS_ASIG), (bf16_t*)(ws + WS_WIN), P.w0, P.a0}; pg8::gemm_phase(lds, g, SM, E, wv); }
    GSYNC();
    {
    if (bx < 128) { for (int rw = 0; rw < REP_RW; ++rw) rwkv_unit<false>(P, ldsf, bx >> 4, (bx >> 1) & 7, bx & 1, wv); }
    else {
        { pg8::Gemm g{(const bf16_t*)(ws + WS_LA), (const bf16_t*)(ws + WS_WL), MT, 1536, 256}; pg8::LoraRestOrder SL; SL.ob = bx - 128;
          pg8::EpiLora E{(bf16_t*)(ws + WS_OMD), (bf16_t*)(ws + WS_ASIG), (bf16_t*)(ws + WS_WIN), P.w0, P.a0}; pg8::gemm_phase(lds, g, SL, E, wv); }
        FRESH();
        const int rep7 = 0; const int ob = bx - 128; unsigned* sbc = (unsigned*)ws + XCD_BAR_WORDS + 64;
        for (int k = 0; k < 4; ++k) { const int u = ob + k * 128; ret_unit_a(P, lds, u >> 4, u & 15, wv); }
        sub_barrier(sbc, 128u * (2u * rep7 + 1u), wv);
        ret_prefix(P, ob * 512 + fresh_tid(wv));
        sub_barrier(sbc, 128u * (2u * rep7 + 2u), wv);
        for (int k = 0; k < 4; ++k) { const int u = ob + k * 128; ret_unit_c(P, lds, u >> 4, u & 15, wv); }
        for (int u = ob; u < 2560; u += 128) { if (u < 2048) rwkv_unit<true>(P, ldsf, u >> 4, (u >> 1) & 7, u & 1, wv); else ret_sample_unit(P, ldsf, (u - 2048) >> 2, (u - 2048) & 3, wv); }
    }
    }
    GSYNC();
    for (int rep8 = 0; rep8 < REP_P8; ++rep8) PH(8) rwkv_post(P, wv);
    GSYNC();
    PH(9) { pg8::Gemm g{XN, (const bf16_t*)(ws + WS_WOUT), MT, 1024, 1024}; pg8::SplitOrder S2; S2.init2(G, bx, 1024, 4); pg8::EpiFO E{(bf16_t*)FO, 1024, (float*)(ws + WS_OMD)}; pg8::gemm_phase(lds, g, S2, E, wv); }
    GSYNC();
    PH(10) { tconv_list(P.f2g, P.f2u, P.f2d, nullptr, nullptr, ws, 2112, ldsf, wv);
    rows_phase(P, 2, wv); }
    GSYNC();
    PH(11) { pg8::Gemm g{XN, (const bf16_t*)(ws + WS_WGU), MT, NGU, 1024}; S.init(MT, NGU, G, bx, 1024); pg8::EpiSwiGLU E{ACT, DFF}; pg8::gemm_phase(lds, g, S, E, wv); }
    GSYNC();
    PH(12) { pg8::Gemm g{ACT, (const bf16_t*)(ws + WS_WD), MT, 1024, DFF}; pg8::SplitOrder S2; S2.init2(G, bx, DFF, 8); pg8::EpiFO E{(bf16_t*)FO, 1024, (float*)(ws + WS_OMD)}; pg8::gemm_phase(lds, g, S2, E, wv); }
    GSYNC();
    PH(13) rows_phase(P, 3, wv);
}

#undef ws
#undef XN
#undef ACT
#undef FO
#undef PS
#undef P
extern "C" void kernel_launch(void* const* d_in, const int* in_sizes, int n_in, void* d_out, int out_size, void* d_ws, size_t ws_size, hipStream_t stream) {
    static int grid = 0;
    if (grid == 0) {
        if (n_in != 26 || ws_size < WS_END) { fprintf(stderr, "kernel_launch: unexpected n_in %d or ws_size %zu (< %zu)\n", n_in, ws_size, (size_t)WS_END); grid = -1; return; }
        int dev = 0, cus = 0, per_cu = 0;
        hipGetDevice(&dev); hipDeviceGetAttribute(&cus, hipDeviceAttributeMultiprocessorCount, dev);
        hipFuncSetAttribute((const void*)hymba_mega, hipFuncAttributeMaxDynamicSharedMemorySize, LDS_BYTES);
        hipOccupancyMaxActiveBlocksPerMultiprocessor(&per_cu, (const void*)hymba_mega, 512, LDS_BYTES);
        if (per_cu < 1) { fprintf(stderr, "kernel_launch: occupancy query says %d blocks/CU\n", per_cu); per_cu = 1; }
        grid = cus * per_cu; if (grid > 256) grid = 256;
        if (grid != 256) { fprintf(stderr, "kernel_launch: this kernel needs 256 co-resident workgroups, got %d\n", grid); grid = -1; return; }
        fprintf(stderr, "kernel_launch: cus %d per_cu %d grid %d ws %zu\n", cus, per_cu, grid, ws_size);
    }
    if (grid < 0) return;
    if (hipMemsetAsync(d_ws, 0, 16384, stream) != hipSuccess) { fprintf(stderr, "kernel_launch: hipMemsetAsync failed\n"); return; }
    Params p{};
    const float** pp = (const float**)&p;
    for (int i = 0; i < 26; ++i) pp[i] = (const float*)d_in[i];
    p.out = (float*)d_out; p.ws = (unsigned char*)d_ws;
    void* args[] = {&p};
    hipError_t e = hipLaunchCooperativeKernel((const void*)hymba_mega, dim3(grid), dim3(512), args, LDS_BYTES, stream);
    if (e != hipSuccess) fprintf(stderr, "cooperative launch failed: %s (grid %d)\n", hipGetErrorString(e), grid);
}
```

```cpp
#include <hip/hip_runtime.h>
#include <hip/hip_cooperative_groups.h>
#include <cstdio>
#include <cstdint>
namespace cg = cooperative_groups;

__device__ __forceinline__ int fresh_tid(int wv) { int l; asm volatile("v_mbcnt_lo_u32_b32 %0, -1, 0\n\tv_mbcnt_hi_u32_b32 %0, -1, %0" : "=v"(l)); return wv * 64 + l; }
namespace pg8 {
#define PG8_LAS __attribute__((address_space(3)))
typedef unsigned short bf16_t;
typedef short bf16x8 __attribute__((ext_vector_type(8)));
typedef float f32x4 __attribute__((ext_vector_type(4)));
typedef unsigned u32x4 __attribute__((ext_vector_type(4)));
typedef unsigned u32x2 __attribute__((ext_vector_type(2)));
constexpr int BM = 256, BK = 64, HALF = 128, HTB = HALF * BK * 2, STAGE_BYTES = 8 * HTB, NXCD = 8, WGM = 8;

__host__ __device__ __forceinline__ int lds_byte(int r, int c) { const int st = (r >> 4) * 2 + (c >> 5), rr = r & 15, cc = c & 31, ob = rr * 64 + cc * 2; return st * 1024 + (ob ^ (((ob >> 9) & 1) << 5)); }
__host__ __device__ __forceinline__ void stage_rc(int b, int& R, int& C) { const int st = b / 1024, sb = b % 1024, swz = sb ^ (((sb >> 9) & 1) << 5); R = (st >> 1) * 16 + swz / 64; C = (st & 1) * 32 + (swz % 64) / 2; }
__host__ __device__ __forceinline__ int perm32(int rho) { const int n = rho >> 4, i = rho & 15; return 8 * (i >> 2) + 4 * n + (i & 3); }

struct Unit { int pm, pn, k0, nkt, atomic; };
struct Gemm { const bf16_t* A; const bf16_t* Bt; int M, N, K; };

struct StaticOrder {
    int nM, nN, nwg, G, c, nt;
    __host__ __device__ void init(int M, int N, int G_, int c_, int K) { nM = M / BM; nN = N / BM; nwg = nM * nN; G = G_; c = c_; nt = K / BK; }
    __host__ __device__ bool next(int i, Unit& u) const {
        const long L = (long)i * G + c; if (L >= nwg) return false;
        int wgid = (int)L; { const int q = nwg / NXCD, r = nwg % NXCD, xcd = wgid % NXCD, off = wgid / NXCD; wgid = (xcd < r ? xcd * (q + 1) : r * (q + 1) + (xcd - r) * q) + off; }
        const int nig = WGM * nN, gid = wgid / nig, fm = gid * WGM, gsz = (nM - fm) < WGM ? (nM - fm) : WGM;
        u.pm = fm + ((wgid % nig) % gsz); u.pn = (wgid % nig) / gsz; u.k0 = 0; u.nkt = nt; u.atomic = 0; return true;
    }
    __device__ __forceinline__ void a_ready(const Unit&) const {}
    __device__ __forceinline__ void done(const Unit&) const {}
};
struct LoraMainOrder : StaticOrder {
    __host__ __device__ bool next(int i, Unit& u) const { if (!StaticOrder::next(i, u)) return false; u.k0 = 0; u.nkt = 2; return true; }
};
struct LoraRestOrder {
    int ob;
    __host__ __device__ bool next(int i, Unit& u) const {
        const int L = i * 128 + ob; if (L >= 140) return false;
        if (L < 132) { u.pm = L >> 1; u.pn = 4 + (L & 1); u.k0 = 2; } else { const int x = L - 132; u.pm = 64 + (x >> 2); u.pn = x & 3; u.k0 = 0; }
        u.nkt = 2; u.atomic = 0; return true;
    }
    __device__ __forceinline__ void a_ready(const Unit&) const {}
    __device__ __forceinline__ void done(const Unit&) const {}
};
struct SplitOrder : StaticOrder {
    int KS;
    __host__ __device__ void init2(int G_, int c_, int K, int KS_) { init(16384, 1024, G_, c_, K); KS = KS_; }
    __host__ __device__ bool next(int i, Unit& u) const {
        if (i == 0) return StaticOrder::next(0, u);
        if (i > 1 || c >= 8 * KS) return false;
        const int tile = c / KS, part = c % KS, pairs = nt / 2, q = pairs / KS, r = pairs % KS;
        u.pm = 64 + (tile >> 2); u.pn = tile & 3; u.k0 = 2 * (part * q + (part < r ? part : r)); u.nkt = 2 * (q + (part < r ? 1 : 0)); u.atomic = 1 + c; return true;
    }
};

typedef __bf16 bf16x2_t __attribute__((ext_vector_type(2)));
typedef float f32x2_t __attribute__((ext_vector_type(2)));
__device__ __forceinline__ unsigned cvt_pk_bf16(float lo, float hi) { const f32x2_t v = {lo, hi}; const bf16x2_t b = __builtin_convertvector(v, bf16x2_t); return __builtin_bit_cast(unsigned, b); }

struct EpiFO {
    static constexpr bool PERM = true;
    bf16_t* C; int ldc; float* slab;
    __device__ __forceinline__ void operator()(const f32x4 (&acc)[2][2][4][2], const Unit& u, int wr, int wc, int fr, int fq) const {
        if (u.atomic == 0) {
            const __amdgpu_buffer_rsrc_t rs = __builtin_amdgcn_make_buffer_rsrc(C, 0, 0x7ffffff0, 0x00020000);
            const int row0 = u.pm * BM + wr * 64 + fr; const int col0 = u.pn * BM + wc * 32 + 8 * fq;
#pragma unroll
            for (int ai = 0; ai < 2; ++ai)
#pragma unroll
                for (int m = 0; m < 4; ++m) { const unsigned ro = (unsigned)((row0 + ai * HALF + m * 16) * ldc + col0) * 2u;
#pragma unroll
                    for (int bj = 0; bj < 2; ++bj) { const f32x4 v0 = acc[ai][bj][m][0], v1 = acc[ai][bj][m][1];
                        u32x4 w; w.x = cvt_pk_bf16(v0[0], v0[1]); w.y = cvt_pk_bf16(v0[2], v0[3]); w.z = cvt_pk_bf16(v1[0], v1[1]); w.w = cvt_pk_bf16(v1[2], v1[3]);
                        __builtin_amdgcn_raw_buffer_store_b128(w, rs, ro + bj * HALF * 2, 0, 16); } }
        } else {
            float* base = slab + (size_t)(u.atomic - 1) * (BM * BM) + (size_t)(wr * 64 + fr) * BM + wc * 32 + 8 * fq;
#pragma unroll
            for (int ai = 0; ai < 2; ++ai)
#pragma unroll
                for (int m = 0; m < 4; ++m) { float* rowp = base + (size_t)(ai * HALF + m * 16) * BM;
#pragma unroll
                    for (int bj = 0; bj < 2; ++bj) { *(f32x4*)(rowp + bj * HALF) = acc[ai][bj][m][0]; *(f32x4*)(rowp + bj * HALF + 4) = acc[ai][bj][m][1]; } }
        }
    }
};
struct EpiBf16 {
    static constexpr bool PERM = true;
    bf16_t* O; int ldc;
    __device__ __forceinline__ void operator()(const f32x4 (&acc)[2][2][4][2], const Unit& u, int wr, int wc, int fr, int fq) const {
        const int row0 = u.pm * BM + wr * 64 + fr; const int col0 = u.pn * BM + wc * 32 + 8 * fq;
        const __amdgpu_buffer_rsrc_t rs = __builtin_amdgcn_make_buffer_rsrc(O, 0, 0x7ffffff0, 0x00020000);
#pragma unroll
        for (int ai = 0; ai < 2; ++ai)
#pragma unroll
            for (int m = 0; m < 4; ++m) { const unsigned ro = (unsigned)((row0 + ai * HALF + m * 16) * ldc + col0) * 2u;
#pragma unroll
                for (int bj = 0; bj < 2; ++bj) { const f32x4 v0 = acc[ai][bj][m][0], v1 = acc[ai][bj][m][1];
                    u32x4 w; w.x = cvt_pk_bf16(v0[0], v0[1]); w.y = cvt_pk_bf16(v0[2], v0[3]); w.z = cvt_pk_bf16(v1[0], v1[1]); w.w = cvt_pk_bf16(v1[2], v1[3]);
                    __builtin_amdgcn_raw_buffer_store_b128(w, rs, ro + bj * HALF * 2, 0, 16); } }
    }
};
__device__ __forceinline__ float silu_f(float x) { return x * __builtin_amdgcn_rcpf(1.0f + __expf(-x)); }
struct EpiSwiGLU {
    static constexpr bool PERM = true;
    bf16_t* O; int ldc;
    __device__ __forceinline__ void operator()(const f32x4 (&acc)[2][2][4][2], const Unit& u, int wr, int wc, int fr, int fq) const {
        const int row0 = u.pm * BM + wr * 64 + fr; const int col0 = u.pn * HALF + wc * 32 + 8 * fq;
        const __amdgpu_buffer_rsrc_t rs = __builtin_amdgcn_make_buffer_rsrc(O, 0, 0x7ffffff0, 0x00020000);
#pragma unroll
        for (int ai = 0; ai < 2; ++ai)
#pragma unroll
            for (int m = 0; m < 4; ++m) { const unsigned ro = (unsigned)((row0 + ai * HALF + m * 16) * ldc + col0) * 2u;
                float o[8];
#pragma unroll
                for (int n = 0; n < 2; ++n)
#pragma unroll
                    for (int j = 0; j < 4; ++j) o[n * 4 + j] = silu_f(acc[ai][0][m][n][j]) * acc[ai][1][m][n][j];
                u32x4 w; w.x = cvt_pk_bf16(o[0], o[1]); w.y = cvt_pk_bf16(o[2], o[3]); w.z = cvt_pk_bf16(o[4], o[5]); w.w = cvt_pk_bf16(o[6], o[7]);
                __builtin_amdgcn_raw_buffer_store_b128(w, rs, ro, 0, 16); }
    }
};
struct EpiLora {
    static constexpr bool PERM = true;
    bf16_t* OMD; bf16_t* ASIG; bf16_t* G; const float* w0; const float* a0;
    template <int KIND> __device__ __forceinline__ void body(const f32x4 (&acc)[2][2][4][2], bf16_t* O, const float* bias, int row0, int ch0) const {
#pragma unroll
        for (int bj = 0; bj < 2; ++bj)
#pragma unroll
            for (int ai = 0; ai < 2; ++ai)
#pragma unroll
                for (int m = 0; m < 4; ++m) { bf16_t* rowp = O + (size_t)(row0 + ai * HALF + m * 16) * 512 + ch0 + bj * HALF;
                    float o[8];
#pragma unroll
                    for (int n = 0; n < 2; ++n)
#pragma unroll
                        for (int j = 0; j < 4; ++j) { float v = acc[ai][bj][m][n][j];
                            if (KIND == 0) { v += bias[ch0 + bj * HALF + n * 4 + j]; const float e = 0.6065306597126334f * __builtin_amdgcn_rcpf(1.0f + __expf(-v));
                                float p = 1.0f / 40320.0f; p = -1.0f / 5040.0f + e * p; p = 1.0f / 720.0f + e * p; p = -1.0f / 120.0f + e * p; p = 1.0f / 24.0f + e * p; p = -1.0f / 6.0f + e * p; p = 0.5f + e * p; p = 1.0f - e * p;
                                v = e * p; }
                            else if (KIND == 1) { v += bias[ch0 + bj * HALF + n * 4 + j]; v = __builtin_amdgcn_rcpf(1.0f + __expf(-v)); }
                            o[n * 4 + j] = v; }
                    u32x4 w; w.x = cvt_pk_bf16(o[0], o[1]); w.y = cvt_pk_bf16(o[2], o[3]); w.z = cvt_pk_bf16(o[4], o[5]); w.w = cvt_pk_bf16(o[6], o[7]);
                    *(u32x4*)rowp = w; __builtin_amdgcn_sched_barrier(0); }
    }
    __device__ __forceinline__ void operator()(const f32x4 (&acc)[2][2][4][2], const Unit& u, int wr, int wc, int fr, int fq) const {
        const int kind = u.pn >> 1;
        const int row0 = u.pm * BM + wr * 64 + fr; const int ch0 = (u.pn & 1) * BM + wc * 32 + 8 * fq;
        if (kind == 0) body<0>(acc, OMD, w0, row0, ch0); else if (kind == 1) body<1>(acc, ASIG, a0, row0, ch0); else body<2>(acc, G, a0, row0, ch0);
    }
};

template <class Epi, class Sched>
__device__ __forceinline__ void gemm_phase(PG8_LAS unsigned char* lds, const Gemm g, const Sched& S, const Epi& E, const int wv) {
    const int tid = fresh_tid(wv), wid = __builtin_amdgcn_readfirstlane(tid >> 6), lane = tid & 63, wr = wid >> 2, wc = wid & 3, fr = lane & 15, fq = lane >> 4;
    const int K = g.K;
    unsigned voffA[2], voffB[2];
#pragma unroll
    for (int i = 0; i < 2; ++i) { int R, C; stage_rc(tid * 16 + i * 8192, R, C); const int Rb = Epi::PERM ? ((R & ~31) + perm32(R & 31)) : R;
        voffA[i] = (unsigned)(R * K + C) * 2u; voffB[i] = (unsigned)(Rb * K + C) * 2u; }
    const size_t kstep = (size_t)(BK * 2);
    const size_t hstep = (size_t)HALF * K * 2;
    const size_t tstep = 2 * hstep;
    const unsigned ldsw = (unsigned)wid * 1024u;
    const int aoff = lds_byte(wr * 64 + fr, fq * 8), boff = lds_byte(wc * 32 + fr, fq * 8);
#define PG8_SA(b, h) (((b) * 2 + (h)) * HTB)
#define PG8_SB(b, h) ((4 + (b) * 2 + (h)) * HTB)
#define PG8_STAGE(bufoff, gbase, voff) do { _Pragma("unroll") for (int _i = 0; _i < 2; ++_i) \
        __builtin_amdgcn_global_load_lds((const unsigned*)((const char*)(gbase) + (voff)[_i]), (PG8_LAS unsigned*)(lds + (bufoff) + ldsw + _i * 8192), 16, 0, 0); } while (0)
#define PG8_LDA(dst, b, h) do { _Pragma("unroll") for (int m = 0; m < 4; ++m) _Pragma("unroll") for (int k = 0; k < 2; ++k) dst[m][k] = *(const PG8_LAS bf16x8*)(lds + PG8_SA(b, h) + aoff + m * 2048 + k * 1024); } while (0)
#define PG8_LDB(dst, b, h) do { _Pragma("unroll") for (int n = 0; n < 2; ++n) _Pragma("unroll") for (int k = 0; k < 2; ++k) dst[n][k] = *(const PG8_LAS bf16x8*)(lds + PG8_SB(b, h) + boff + n * 2048 + k * 1024); } while (0)
#define PG8_MMA(ai, bj, At, Bt) do { __builtin_amdgcn_s_setprio(1); _Pragma("unroll") for (int m = 0; m < 4; ++m) _Pragma("unroll") for (int n = 0; n < 2; ++n) _Pragma("unroll") for (int k = 0; k < 2; ++k) \
        acc[ai][bj][m][n] = __builtin_amdgcn_mfma_f32_16x16x32_bf16(Bt[n][k], At[m][k], acc[ai][bj][m][n], 0, 0, 0); __builtin_amdgcn_s_setprio(0); } while (0)
#define PG8_WAIT_V(n) asm volatile("s_waitcnt vmcnt(" #n ")" ::: "memory")
#define PG8_WAIT_L(n) asm volatile("s_waitcnt lgkmcnt(" #n ")" ::: "memory")
#define PG8_BAR __builtin_amdgcn_s_barrier()
#define PG8_SCHED __builtin_amdgcn_sched_barrier(0)
    Unit cur, nxt; int ui = 0;
    if (!S.next(0, cur)) return;
    f32x4 acc[2][2][4][2];
#pragma unroll
    for (int a = 0; a < 2; ++a)
#pragma unroll
        for (int b = 0; b < 2; ++b)
#pragma unroll
            for (int m = 0; m < 4; ++m)
#pragma unroll
                for (int n = 0; n < 2; ++n) acc[a][b][m][n] = (f32x4){0.f, 0.f, 0.f, 0.f};
    bf16x8 At[4][2], B0[2][2], B1[2][2];
    const char* cA = (const char*)g.A + (size_t)cur.pm * tstep + (size_t)cur.k0 * kstep; const char* cB = (const char*)g.Bt + (size_t)cur.pn * tstep + (size_t)cur.k0 * kstep;
    S.a_ready(cur);
    PG8_STAGE(PG8_SB(0, 0), cB, voffB); PG8_STAGE(PG8_SA(0, 0), cA, voffA); PG8_STAGE(PG8_SB(0, 1), cB + hstep, voffB); PG8_STAGE(PG8_SA(0, 1), cA + hstep, voffA);
    if (wr == 1) PG8_BAR;
    PG8_WAIT_V(4); PG8_BAR;
    PG8_STAGE(PG8_SB(1, 0), cB + kstep, voffB); PG8_STAGE(PG8_SA(1, 0), cA + kstep, voffA); PG8_STAGE(PG8_SB(1, 1), cB + hstep + kstep, voffB);
    PG8_WAIT_V(6); PG8_BAR;
    for (;;) {
        const bool has_next = S.next(ui + 1, nxt);
        const char* nA = has_next ? (const char*)g.A + (size_t)nxt.pm * tstep + (size_t)nxt.k0 * kstep : cA; const char* nB = has_next ? (const char*)g.Bt + (size_t)nxt.pn * tstep + (size_t)nxt.k0 * kstep : cB;
        const int nt = cur.nkt;
        for (int t = 0; t < nt; t += 2) {
            const bool last = (t == nt - 2);
            const char* a1 = cA + (size_t)(t + 1) * kstep;
            const char* a2 = last ? nA : cA + (size_t)(t + 2) * kstep; const char* b2 = last ? nB : cB + (size_t)(t + 2) * kstep;
            const char* a3 = a2 + kstep; const char* b3 = b2 + kstep;
            if (last && has_next) S.a_ready(nxt);
            PG8_LDB(B0, 0, 0); PG8_SCHED; PG8_LDA(At, 0, 0); PG8_STAGE(PG8_SA(1, 1), a1 + hstep, voffA);
            PG8_WAIT_L(8); PG8_BAR; PG8_WAIT_L(0); PG8_MMA(0, 0, At, B0); PG8_BAR; PG8_SCHED;
            PG8_LDB(B1, 0, 1); PG8_STAGE(PG8_SB(0, 0), b2, voffB);
            PG8_BAR; PG8_WAIT_L(0); PG8_MMA(0, 1, At, B1); PG8_BAR;
            PG8_LDA(At, 0, 1); PG8_STAGE(PG8_SA(0, 0), a2, voffA);
            PG8_BAR; PG8_WAIT_L(0); PG8_MMA(1, 0, At, B0); PG8_BAR; PG8_SCHED;
            PG8_STAGE(PG8_SB(0, 1), b2 + hstep, voffB);
            PG8_WAIT_V(6); PG8_BAR; PG8_MMA(1, 1, At, B1); PG8_BAR;
            PG8_LDB(B0, 1, 0); PG8_SCHED; PG8_LDA(At, 1, 0); PG8_STAGE(PG8_SA(0, 1), a2 + hstep, voffA);
            PG8_WAIT_L(8); PG8_BAR; PG8_WAIT_L(0); PG8_MMA(0, 0, At, B0); PG8_BAR; PG8_SCHED;
            PG8_LDB(B1, 1, 1); PG8_STAGE(PG8_SB(1, 0), b3, voffB);
            PG8_BAR; PG8_WAIT_L(0); PG8_MMA(0, 1, At, B1); PG8_BAR;
            PG8_LDA(At, 1, 1); PG8_STAGE(PG8_SA(1, 0), a3, voffA);
            PG8_BAR; PG8_WAIT_L(0); PG8_MMA(1, 0, At, B0); PG8_BAR; PG8_SCHED;
            PG8_STAGE(PG8_SB(1, 1), b3 + hstep, voffB);
            PG8_WAIT_V(6); PG8_BAR; PG8_MMA(1, 1, At, B1); PG8_BAR;
        }
        { const int l2 = fresh_tid(wv) & 63; E(acc, cur, wr, wc, l2 & 15, l2 >> 4); } S.done(cur);
        if (!has_next) break;
#pragma unroll
        for (int a = 0; a < 2; ++a)
#pragma unroll
            for (int b = 0; b < 2; ++b)
#pragma unroll
                for (int m = 0; m < 4; ++m)
#pragma unroll
                    for (int n = 0; n < 2; ++n) acc[a][b][m][n] = (f32x4){0.f, 0.f, 0.f, 0.f};
        cur = nxt; cA = nA; cB = nB; ++ui;
    }
    PG8_WAIT_V(0);
    if (wr == 0) PG8_BAR;
    PG8_BAR;
#undef PG8_SA
#undef PG8_SB
#undef PG8_STAGE
#undef PG8_LDA
#undef PG8_LDB
#undef PG8_MMA
#undef PG8_WAIT_V
#undef PG8_WAIT_L
#undef PG8_BAR
#undef PG8_SCHED
}
}

using pg8::bf16_t; using pg8::f32x4; using pg8::bf16x8; using pg8::u32x4; using pg8::u32x2;
#define LAS __attribute__((address_space(3)))

constexpr int D = 1024, DFF = 2816, NGU = 5632, NCOLS = 3840;
constexpr int MP = 16384, MS = 512, MT = 16896, MIN_ = 17152;
constexpr int LDS_BYTES = 147456;
constexpr size_t O_SHP = 17301504, O_WKP = O_SHP + 8192, O_RTP = O_WKP + 262144, O_SHS = O_RTP + 524288, O_WKS = O_SHS + 131072, O_RTS = O_WKS + 4194304;
constexpr size_t WS_ROPE = 16384;
constexpr size_t WS_WL   = WS_ROPE + 1050624;
constexpr size_t WS_WOUT = WS_WL + 786432;
constexpr size_t WS_WIN  = WS_WOUT + 2097152;
constexpr size_t WS_WGU  = WS_WIN + 7864320;
constexpr size_t WS_WD   = WS_WGU + 11534336;
constexpr size_t WS_XN   = WS_WD + 5767168;
constexpr size_t WS_BIG  = WS_XN + 35127296;
constexpr size_t WS_FO   = WS_BIG + 95158272;
constexpr size_t WS_YS   = WS_BIG + 131727360;
constexpr size_t WS_LA   = WS_YS + 17301504;
constexpr size_t WS_OMD  = WS_BIG + 164364288;
constexpr size_t WS_ASIG = WS_OMD + 17301504;
constexpr size_t WS_END  = WS_ASIG + 17301504;
static_assert(WS_LA + 8650752 <= WS_OMD, "mixer overlays");
static_assert(WS_END <= 268435456, "workspace");

struct Params {
    const float *x_prompt, *x_sample, *state_shift, *state_wkv, *state_ret, *norm_g, *f1g, *f1u, *f1d, *w_in, *mu, *w0, *w2, *a0, *a2, *g2, *k_k, *k_a, *r_k, *lnx_w, *lnx_b, *gn_w, *w_out, *f2g, *f2u, *f2d;
    float* out; unsigned char* ws;
};
#define CAS __attribute__((address_space(4)))
typedef const CAS Params& PR;

__device__ __forceinline__ float bf2f(unsigned b) { return __uint_as_float(b << 16); }
__device__ __forceinline__ bf16_t f2bf(float f) { unsigned u = __float_as_uint(f); u += 0x7FFFu + ((u >> 16) & 1u); return (bf16_t)(u >> 16); }
__device__ __forceinline__ float lo_bf(unsigned x) { return __uint_as_float(x << 16); }
__device__ __forceinline__ float hi_bf(unsigned x) { return __uint_as_float(x & 0xffff0000u); }
template <int CTRL> __device__ __forceinline__ float dppf(float v) { return __int_as_float(__builtin_amdgcn_update_dpp(0, __float_as_int(v), CTRL, 0xF, 0xF, false)); }
__device__ __forceinline__ float row16_sum(float v) { v += dppf<0xB1>(v); v += dppf<0x4E>(v); v += dppf<0x141>(v); v += dppf<0x140>(v); return v; }
__device__ __forceinline__ float wave_sum(float v) { v = row16_sum(v); const int i = __float_as_int(v);
    return __int_as_float(__builtin_amdgcn_readlane(i, 0)) + __int_as_float(__builtin_amdgcn_readlane(i, 16)) + __int_as_float(__builtin_amdgcn_readlane(i, 32)) + __int_as_float(__builtin_amdgcn_readlane(i, 48)); }
__device__ __forceinline__ float quad_sum(float v) { v += dppf<0xB1>(v); v += dppf<0x4E>(v); return v; }
__device__ __forceinline__ float sigmoid_f(float x) { return __builtin_amdgcn_rcpf(1.0f + __expf(-x)); }


#define XB_TMO      128
#define XB_XCNT(j)  (256  + 64 * (j))
#define XB_XSUB(j)  (1280 + 64 * (j))
#define XB_XGEN(j)  (2304 + 64 * (j))
#define XB_TOP      3328
#define XB_TOPGEN   3392
#define XCD_BAR_WORDS 3456
#define XB_SPIN_CAP (1u << 18)
__device__ __forceinline__ unsigned xb_ld(unsigned* p)              { return __hip_atomic_load(p, __ATOMIC_RELAXED, __HIP_MEMORY_SCOPE_AGENT); }
__device__ __forceinline__ unsigned xb_add(unsigned* p, unsigned v) { return __hip_atomic_fetch_add(p, v, __ATOMIC_RELAXED, __HIP_MEMORY_SCOPE_AGENT); }
__device__ __forceinline__ unsigned xb_xcc_id() { return (unsigned)__builtin_amdgcn_s_getreg((3 << 11) | 20) & 0xFu; }
#define XB_SPIN(cond, bar) do { unsigned _sp = 0; while (cond) { __builtin_amdgcn_s_sleep(1); \
    if ((++_sp & 255u) == 0u) { if (xb_ld(&(bar)[XB_TMO])) break; if (_sp > XB_SPIN_CAP) { atomicAdd(&(bar)[XB_TMO], 1u); break; } } } } while (0)
struct XcdBarrier { unsigned* bar; unsigned x; volatile LAS unsigned* st; };
__device__ __forceinline__ XcdBarrier xcd_barrier_post(unsigned* bar, volatile LAS unsigned* st) {
    XcdBarrier b; b.bar = bar; b.x = xb_xcc_id(); b.st = st;
    return b;
}
__device__ __forceinline__ void xcd_barrier_complete(unsigned* bar, unsigned x, unsigned& nloc, unsigned& nx) {
    const unsigned G = gridDim.x * gridDim.y * gridDim.z;
    unsigned sum, cnt, mine, sp = 0u;
    for (;;) {
        sum = 0u; cnt = 0u; mine = 0u;
#pragma unroll
        for (unsigned j = 0; j < 16; ++j) { const unsigned c = xb_ld(&bar[XB_XCNT(j)]); sum += c; cnt += (c > 0u) ? 1u : 0u; mine = (j == x) ? c : mine; }
        if (sum == G) break;
        __builtin_amdgcn_s_sleep(1);
        if ((++sp & 255u) == 0u) { if (xb_ld(&bar[XB_TMO])) break; if (sp > XB_SPIN_CAP) { atomicAdd(&bar[XB_TMO], 1u); break; } }
    }
    nloc = mine > 0u ? mine : 1u; nx = cnt > 0u ? cnt : 1u;
}
__device__ __forceinline__ void xcd_barrier(unsigned* barw, volatile LAS unsigned* stw, const int wv) {
    XcdBarrier b; b.bar = barw; b.x = xb_xcc_id(); b.st = stw;
    asm volatile("s_waitcnt vmcnt(0)" ::: "memory");
    __syncthreads();
    if (fresh_tid(wv) == 0) {
        unsigned* bar = b.bar;
        __builtin_amdgcn_s_waitcnt(0);
        unsigned nloc = b.st[0], nx = b.st[1];
        if (nloc == 0u) { xcd_barrier_complete(bar, b.x, nloc, nx); b.st[0] = nloc; b.st[1] = nx; }
        const unsigned old = xb_add(&bar[XB_XSUB(b.x)], 1u);
        const unsigned gen = old / nloc;
        if (old + 1u == (gen + 1u) * nloc) {
            __builtin_amdgcn_fence(__ATOMIC_RELEASE, "agent");
            asm volatile("s_waitcnt vmcnt(0)" ::: "memory");
            const unsigned og = xb_add(&bar[XB_TOP], 1u);
            const unsigned tg = og / nx;
            if (og + 1u == (tg + 1u) * nx) xb_add(&bar[XB_TOPGEN], 1u);
            else XB_SPIN(xb_ld(&bar[XB_TOPGEN]) == tg, bar);
            __builtin_amdgcn_fence(__ATOMIC_ACQUIRE, "agent");
            xb_add(&bar[XB_XGEN(b.x)], 1u);
            asm volatile("s_waitcnt vmcnt(0)" ::: "memory");
        } else {
            XB_SPIN(xb_ld(&bar[XB_XGEN(b.x)]) == gen, bar);
            __builtin_amdgcn_fence(__ATOMIC_ACQUIRE, "agent");
            asm volatile("s_waitcnt vmcnt(0)" ::: "memory");
        }
    }
    __syncthreads();
}


#define DPP2(x, y, CTRL, NOP) asm volatile(NOP "\n\tv_add_f32_dpp %0, %0, %0 " CTRL " row_mask:0xf bank_mask:0xf bound_ctrl:1\n\tv_add_f32_dpp %1, %1, %1 " CTRL " row_mask:0xf bank_mask:0xf bound_ctrl:1" : "+v"(x), "+v"(y))
#define DPP4(x, y, z, w, CTRL, NOP) asm volatile(NOP "\n\tv_add_f32_dpp %0, %0, %0 " CTRL " row_mask:0xf bank_mask:0xf bound_ctrl:1\n\tv_add_f32_dpp %1, %1, %1 " CTRL " row_mask:0xf bank_mask:0xf bound_ctrl:1\n\tv_add_f32_dpp %2, %2, %2 " CTRL " row_mask:0xf bank_mask:0xf bound_ctrl:1\n\tv_add_f32_dpp %3, %3, %3 " CTRL " row_mask:0xf bank_mask:0xf bound_ctrl:1" : "+v"(x), "+v"(y), "+v"(z), "+v"(w))
#define ROW16_SUM4(x, y, z, w) do { DPP4(x, y, z, w, "quad_perm:[1,0,3,2]", "s_nop 1"); DPP4(x, y, z, w, "quad_perm:[2,3,0,1]", ""); DPP4(x, y, z, w, "row_half_mirror", ""); DPP4(x, y, z, w, "row_mirror", ""); } while (0)
#define ROW16_SUM2(x, y) do { DPP2(x, y, "quad_perm:[1,0,3,2]", "s_nop 1"); DPP2(x, y, "quad_perm:[2,3,0,1]", "s_nop 0"); DPP2(x, y, "row_half_mirror", "s_nop 0"); DPP2(x, y, "row_mirror", "s_nop 0"); } while (0)
__device__ __forceinline__ int prev_row(int r) {
    if (r < MP) return (r & 2047) == 0 ? -1 : r - 1;
    const int s = r - MP; return (s & 3) == 0 ? MT + (s >> 2) : r - 1;
}

struct TDesc { const float* W; bf16_t* Bt; int K, N, k0, n0, brow0; };
__device__ __forceinline__ TDesc tconv_desc(const float* wg, const float* wu, const float* wd, const float* win, const float* wout, unsigned char* ws, int i) {
    TDesc d; int mode = 0, tile = i;
    if (i < 704) { d.W = wg; d.Bt = (bf16_t*)(ws + WS_WGU); d.K = 1024; d.N = DFF; mode = 1; }
    else if (i < 1408) { d.W = wu; d.Bt = (bf16_t*)(ws + WS_WGU); d.K = 1024; d.N = DFF; mode = 2; tile = i - 704; }
    else if (i < 2112) { d.W = wd; d.Bt = (bf16_t*)(ws + WS_WD); d.K = DFF; d.N = 1024; tile = i - 1408; }
    else if (i < 3072) { d.W = win; d.Bt = (bf16_t*)(ws + WS_WIN); d.K = 1024; d.N = NCOLS; tile = i - 2112; }
    else { d.W = wout; d.Bt = (bf16_t*)(ws + WS_WOUT); d.K = 1024; d.N = 1024; tile = i - 3072; }
    const int nkt = d.K / 64; const int kt = tile % nkt, nt = tile / nkt; d.k0 = kt * 64; d.n0 = nt * 64;
    d.brow0 = mode == 0 ? d.n0 : ((d.n0 >> 7) * 256 + (d.n0 & 127) + (mode == 2 ? 128 : 0));
    return d;
}
__device__ __forceinline__ void tconv_list(const float* wg, const float* wu, const float* wd, const float* win, const float* wout, unsigned char* ws, const int ntiles, LAS float* t, const int wv) {
    const int tid = fresh_tid(wv); const int G = gridDim.x;
    float cur[8], nxt[8];
    int i = blockIdx.x;
    if (i < ntiles) { const TDesc d = tconv_desc(wg, wu, wd, win, wout, ws, i);
#pragma unroll
        for (int e = 0; e < 8; ++e) { const int idx = e * 512 + tid, r = idx >> 6, c = idx & 63; cur[e] = __builtin_nontemporal_load(d.W + (size_t)(d.k0 + r) * d.N + d.n0 + c); } }
    for (; i < ntiles; i += G) {
        const TDesc d = tconv_desc(wg, wu, wd, win, wout, ws, i);
        { const TDesc dn = tconv_desc(wg, wu, wd, win, wout, ws, i + G < ntiles ? i + G : i);
#pragma unroll
            for (int e = 0; e < 8; ++e) { const int idx = e * 512 + tid, r = idx >> 6, c = idx & 63; nxt[e] = __builtin_nontemporal_load(dn.W + (size_t)(dn.k0 + r) * dn.N + dn.n0 + c); } }
#pragma unroll
        for (int e = 0; e < 8; ++e) { const int idx = e * 512 + tid, r = idx >> 6, c = idx & 63; t[r * 65 + c] = cur[e]; }
        __syncthreads();
#pragma unroll
        for (int e = 0; e < 4; ++e) { const int idx = e * 512 + tid, n = idx >> 5, kp = idx & 31;
            const unsigned w = pg8::cvt_pk_bf16(t[(2 * kp) * 65 + n], t[(2 * kp + 1) * 65 + n]);
            *(unsigned*)(d.Bt + (size_t)(d.brow0 + n) * d.K + d.k0 + 2 * kp) = w; }
        __syncthreads();
#pragma unroll
        for (int e = 0; e < 8; ++e) cur[e] = nxt[e];
    }
}

struct RowRaw { float4 xf[4]; u32x2 xb[4]; u32x2 fb[4]; };
__device__ __forceinline__ void rows_load(PR P, const int mode, const int row, const int lane, RowRaw& R) {
    if (mode <= 1) { const float* xin = P.x_prompt + (size_t)row * 1024;
#pragma unroll
        for (int q = 0; q < 4; ++q) { const f32x4 t_ = __builtin_nontemporal_load((const f32x4*)(xin + (q * 64 + lane) * 4)); R.xf[q] = make_float4(t_[0], t_[1], t_[2], t_[3]); } }
    else { const bf16_t* xb = (mode == 2 ? (const bf16_t*)P.out : (const bf16_t*)(P.ws + WS_FO + 34603008)) + (size_t)row * 1024;
#pragma unroll
        for (int q = 0; q < 4; ++q) R.xb[q] = __builtin_nontemporal_load((const u32x2*)(xb + (q * 64 + lane) * 4)); }
    if (mode != 0) { const bf16_t* FO = (const bf16_t*)(P.ws + WS_FO) + (size_t)row * 1024;
#pragma unroll
        for (int q = 0; q < 4; ++q) R.fb[q] = __builtin_nontemporal_load((const u32x2*)(FO + (q * 64 + lane) * 4)); }
}
__device__ __forceinline__ void rows_proc(PR P, const int mode, const int row, const int lane, float4 (&xv)[4], const float4 (&fo)[4], const float4 (&gp)[4], const float4 (&gn)[4]) {
    bf16_t* XN = (bf16_t*)(P.ws + WS_XN);
    if (mode != 0) {
        float ss = 0.f;
#pragma unroll
        for (int q = 0; q < 4; ++q) ss += fo[q].x * fo[q].x + fo[q].y * fo[q].y + fo[q].z * fo[q].z + fo[q].w * fo[q].w;
        ss = wave_sum(ss); const float r = rsqrtf(ss * (1.0f / 1024.0f) + 1e-6f) * (mode == 2 ? 1.0f : 0.5f);
#pragma unroll
        for (int q = 0; q < 4; ++q) {
            xv[q].x += fo[q].x * r * gp[q].x; xv[q].y += fo[q].y * r * gp[q].y; xv[q].z += fo[q].z * r * gp[q].z; xv[q].w += fo[q].w * r * gp[q].w;
            if (mode == 3) { const f32x4 t_ = {xv[q].x, xv[q].y, xv[q].z, xv[q].w}; __builtin_nontemporal_store(t_, (f32x4*)(P.out + (size_t)row * 1024 + (q * 64 + lane) * 4)); }
            else { bf16_t* xo = (mode == 1 ? (bf16_t*)P.out : (bf16_t*)(P.ws + WS_FO + 34603008)) + (size_t)row * 1024; u32x2 t; t.x = pg8::cvt_pk_bf16(xv[q].x, xv[q].y); t.y = pg8::cvt_pk_bf16(xv[q].z, xv[q].w);
                __builtin_nontemporal_store(t, (u32x2*)(xo + (q * 64 + lane) * 4)); } }
        if (mode == 3) return;
    }
    float ss2 = 0.f;
#pragma unroll
    for (int q = 0; q < 4; ++q) ss2 += xv[q].x * xv[q].x + xv[q].y * xv[q].y + xv[q].z * xv[q].z + xv[q].w * xv[q].w;
    ss2 = wave_sum(ss2); const float r2 = rsqrtf(ss2 * (1.0f / 1024.0f) + 1e-6f);
    float* sh = nullptr;
    if (mode == 1) { if (row < MP) { if ((row & 2047) == 2047) sh = P.out + O_SHP + (size_t)(row >> 11) * 1024; } else { const int s = row - MP; if ((s & 3) == 3) sh = P.out + O_SHS + (size_t)(s >> 2) * 1024; } }
#pragma unroll
    for (int q = 0; q < 4; ++q) {
        float4 hv; hv.x = xv[q].x * r2 * gn[q].x; hv.y = xv[q].y * r2 * gn[q].y; hv.z = xv[q].z * r2 * gn[q].z; hv.w = xv[q].w * r2 * gn[q].w;
        u32x2 w; w.x = pg8::cvt_pk_bf16(hv.x, hv.y); w.y = pg8::cvt_pk_bf16(hv.z, hv.w);
        *(u32x2*)(XN + (size_t)row * 1024 + (q * 64 + lane) * 4) = w;
        if (sh) *(float4*)(sh + (q * 64 + lane) * 4) = hv; }
}
__device__ __forceinline__ void rows_phase(PR P, const int mode, const int wv) {
    const int tid = fresh_tid(wv); const int lane = tid & 63; const int gw = blockIdx.x * 8 + (tid >> 6), nw = gridDim.x * 8;
    const float* gpost = P.norm_g + (mode == 1 ? 1 : (mode == 2 ? 3 : 5)) * 1024;
    const float* gnext = P.norm_g + (mode == 0 ? 0 : (mode == 1 ? 2 : 4)) * 1024;
    float4 gp[4], gn[4];
#pragma unroll
    for (int q = 0; q < 4; ++q) { gp[q] = *(const float4*)(gpost + (q * 64 + lane) * 4); gn[q] = *(const float4*)(gnext + (q * 64 + lane) * 4); }
    if (gw < MP) {
        const int last = gw + ((MP - 1 - gw) / nw) * nw;
        RowRaw R, N;
        rows_load(P, mode, gw, lane, R);
        for (int row = gw; row < MP; row += nw) {
            const int nrow = row + nw < MP ? row + nw : last;
            rows_load(P, mode, nrow, lane, N);
            float4 xv[4], fo[4];
#pragma unroll
            for (int q = 0; q < 4; ++q) {
                xv[q] = mode <= 1 ? R.xf[q] : make_float4(lo_bf(R.xb[q].x), hi_bf(R.xb[q].x), lo_bf(R.xb[q].y), hi_bf(R.xb[q].y));
                fo[q] = make_float4(lo_bf(R.fb[q].x), hi_bf(R.fb[q].x), lo_bf(R.fb[q].y), hi_bf(R.fb[q].y)); }
            rows_proc(P, mode, row, lane, xv, fo, gp, gn);
            R = N;
        }
    }
    for (int row = MP + gw; row < MT; row += nw) {
        float4 xv[4], fo[4];
        if (mode <= 1) { const float* xin = P.x_sample + (size_t)(row - MP) * 1024;
#pragma unroll
            for (int q = 0; q < 4; ++q) xv[q] = *(const float4*)(xin + (q * 64 + lane) * 4); }
        else { const bf16_t* xb = (mode == 2 ? (const bf16_t*)P.out : (const bf16_t*)(P.ws + WS_FO + 34603008)) + (size_t)row * 1024;
#pragma unroll
            for (int q = 0; q < 4; ++q) { const u32x2 t = *(const u32x2*)(xb + (q * 64 + lane) * 4); xv[q] = make_float4(lo_bf(t.x), hi_bf(t.x), lo_bf(t.y), hi_bf(t.y)); } }
        if (mode != 0) {
#pragma unroll
            for (int q = 0; q < 4; ++q) { const int KS = mode == 2 ? 4 : 8; const float* sl = (const float*)(P.ws + WS_OMD) + (size_t)((((row - MP) >> 8) * 4 + q) * KS) * 65536 + (size_t)(row & 255) * 256 + lane * 4;
                float4 a = *(const float4*)sl;
                for (int p = 1; p < KS; ++p) { const float4 b = *(const float4*)(sl + (size_t)p * 65536); a.x += b.x; a.y += b.y; a.z += b.z; a.w += b.w; }
                fo[q] = a; } }
        else {
#pragma unroll
            for (int q = 0; q < 4; ++q) fo[q] = make_float4(0.f, 0.f, 0.f, 0.f); }
        rows_proc(P, mode, row, lane, xv, fo, gp, gn);
    }
}

__device__ __forceinline__ void p0_prologue(PR P, LAS float* ldsf, const int wv) {
    const int tid = fresh_tid(wv); const size_t gt = (size_t)blockIdx.x * 512 + tid, nth = (size_t)gridDim.x * 512;
    { float* rc = (float*)(P.ws + WS_ROPE); float* rs = rc + 2052 * 64;
      for (size_t i = gt; i < 2052 * 64; i += nth) { const int p = (int)(i >> 6), f = (int)(i & 63); const int pos = p < 2048 ? p : 16384 + (p - 2048);
          double inv = 1.0; for (int q = 0; q < f; ++q) inv *= 0.8659643233600653;
          const double ang = (double)pos * inv; const double n = rint(ang * 0.15915494309189535); const double r = ang - n * 6.283185307179586;
          const double r2 = r * r; double s = 0.0, c = 0.0;
          for (int k = 14; k >= 0; --k) { s = s * (-r2 / (double)((2 * k + 2) * (2 * k + 3))) + 1.0; c = c * (-r2 / (double)((2 * k + 1) * (2 * k + 2))) + 1.0; }
          rc[i] = (float)c; rs[i] = (float)(s * r); } }
    { bf16_t* Wl = (bf16_t*)(P.ws + WS_WL);
      for (size_t i = gt; i < 1536 * 256; i += nth) { const int n = (int)(i >> 8), k = (int)(i & 255); float v = 0.f;
          if (n < 512) { if (k < 64) v = P.w2[k * 512 + n]; } else if (n < 1024) { if (k >= 64 && k < 128) v = P.a2[(k - 64) * 512 + (n - 512)]; } else { if (k >= 128) v = P.g2[(k - 128) * 512 + (n - 1024)]; }
          Wl[i] = f2bf(v); } }
    { bf16_t* XN = (bf16_t*)(P.ws + WS_XN);
      for (size_t i = gt; i < 256 * 1024; i += nth) { const int r = (int)(i >> 10); XN[(size_t)MT * 1024 + i] = r < 128 ? f2bf(P.state_shift[i]) : (bf16_t)0; } }
    tconv_list(P.f1g, P.f1u, P.f1d, P.w_in, P.w_out, P.ws, 3328, ldsf, wv);
    rows_phase(P, 0, wv);
}

__device__ __forceinline__ void lora_prep(PR P, const int wv) {
    const int tid = fresh_tid(wv); const int lane = tid & 63; const int gw = blockIdx.x * 8 + (tid >> 6), nw = gridDim.x * 8;
    const bf16_t* PS = (const bf16_t*)(P.ws + WS_BIG); bf16_t* LA = (bf16_t*)(P.ws + WS_LA);
    const float4 mu = *(const float4*)(P.mu + 1536 + lane * 4); const int kind = lane >> 4;
    if (gw >= MT) return;
    const int last = gw + ((MT - 1 - gw) / nw) * nw;
    u32x2 c, p, nc, np;
    { const int pr = prev_row(gw); c = *(const u32x2*)(PS + (size_t)gw * NCOLS + 1536 + lane * 4); p = *(const u32x2*)(PS + (size_t)(pr >= 0 ? pr : gw) * NCOLS + 1536 + lane * 4); }
    for (int row = gw; row < MT; row += nw) {
        const int nrow = row + nw < MT ? row + nw : last; const int npr = prev_row(nrow);
        nc = *(const u32x2*)(PS + (size_t)nrow * NCOLS + 1536 + lane * 4); np = *(const u32x2*)(PS + (size_t)(npr >= 0 ? npr : nrow) * NCOLS + 1536 + lane * 4);
        if (prev_row(row) < 0) p = (u32x2){0u, 0u};
        float v[4]; const float cu[4] = {lo_bf(c.x), hi_bf(c.x), lo_bf(c.y), hi_bf(c.y)}, pv[4] = {lo_bf(p.x), hi_bf(p.x), lo_bf(p.y), hi_bf(p.y)}, m4[4] = {mu.x, mu.y, mu.z, mu.w};
#pragma unroll
        for (int j = 0; j < 4; ++j) { float x = cu[j] + (pv[j] - cu[j]) * m4[j];
            if (kind == 0) x = 1.0f - 2.0f * __builtin_amdgcn_rcpf(__expf(2.0f * x) + 1.0f); else if (kind >= 2) x = sigmoid_f(x);
            v[j] = x; }
        u32x2 w; w.x = pg8::cvt_pk_bf16(v[0], v[1]); w.y = pg8::cvt_pk_bf16(v[2], v[3]);
        *(u32x2*)(LA + (size_t)row * 256 + lane * 4) = w;
        c = nc; p = np;
    }
}

template <bool SAMPLE>
__device__ __forceinline__ void rwkv_unit(PR P, LAS float* lds, const int b, const int h, const int half, const int wv) {
    constexpr int T = SAMPLE ? 4 : 2048, TC = SAMPLE ? 4 : 32, NCH = T / TC;
    const int tid = fresh_tid(wv), lane = tid & 63, wid = tid >> 6;
    const bf16_t* PS = (const bf16_t*)(P.ws + WS_BIG); const bf16_t* OMD = (const bf16_t*)(P.ws + WS_OMD); const bf16_t* ASIG = (const bf16_t*)(P.ws + WS_ASIG);
    bf16_t* YS = (bf16_t*)(P.ws + WS_YS);
    const int row_base = SAMPLE ? MP + b * 4 : b * 2048;
    const int ltok = (tid - 256) >> 4, lcg = tid & 15; const bool lwave = tid >= 256; const int hch = h * 64 + lcg * 4;
    const float4 mur = *(const float4*)(P.mu + hch), muk = *(const float4*)(P.mu + 512 + hch), muv = *(const float4*)(P.mu + 1024 + hch);
    const float4 kk4 = *(const float4*)(P.k_k + hch), ka4 = *(const float4*)(P.k_a + hch);
    typedef float f32x2 __attribute__((ext_vector_type(2)));
    const int row0 = half * 32 + (wid & 3) * 8 + (lane >> 4) * 2, cgl = lane & 15, j0 = cgl * 4;
    f32x2 S[4];
#pragma unroll
    for (int c = 0; c < 4; ++c) S[c] = (f32x2){0.f, 0.f};
    float* sout = P.out + (SAMPLE ? O_WKS : O_WKP) + ((size_t)(b * 8 + h) * 64 + row0) * 64 + j0;
    if (SAMPLE && wid < 4) { const float* sp = P.state_wkv + ((size_t)(b * 8 + h) * 64 + row0) * 64 + j0; const float4 s0 = *(const float4*)sp, s1 = *(const float4*)(sp + 64);
        S[0] = (f32x2){s0.x, s1.x}; S[1] = (f32x2){s0.y, s1.y}; S[2] = (f32x2){s0.z, s1.z}; S[3] = (f32x2){s0.w, s1.w}; }
    LAS float* buf0 = lds; LAS float* buf1 = lds + TC * 384;
    u32x2 cr[2], ck[2], cv[2], pr[2], pk[2], pv[2], co[2], ca[2];
#define RW_LOAD1(c, U) do { if (lwave && ltok + 16 * (U) < TC) { const int t_ = (c) * TC + ltok + 16 * (U); const int row_ = row_base + t_; const int prow_ = SAMPLE ? (t_ == 0 ? MT + b : row_ - 1) : row_ - 1; \
        const bf16_t* cp_ = PS + (size_t)row_ * NCOLS + hch; cr[U] = *(const u32x2*)cp_; ck[U] = *(const u32x2*)(cp_ + 512); cv[U] = *(const u32x2*)(cp_ + 1024); \
        if (SAMPLE || t_ > 0) { const bf16_t* pp_ = PS + (size_t)prow_ * NCOLS + hch; pr[U] = *(const u32x2*)pp_; pk[U] = *(const u32x2*)(pp_ + 512); pv[U] = *(const u32x2*)(pp_ + 1024); } \
        else { pr[U] = (u32x2){0u, 0u}; pk[U] = pr[U]; pv[U] = pr[U]; } \
        co[U] = *(const u32x2*)(OMD + (size_t)row_ * 512 + hch); ca[U] = *(const u32x2*)(ASIG + (size_t)row_ * 512 + hch); } } while (0)
#define RW_LOAD(c) do { RW_LOAD1(c, 0); RW_LOAD1(c, 1); } while (0)
#define RW_MIX(cu, pv_, m) ((cu) + ((pv_) - (cu)) * (m))
#define RW_PROC1(dst, U) do { if (lwave && ltok + 16 * (U) < TC) { LAS float* d_ = (dst) + (ltok + 16 * (U)) * 384 + lcg * 4; \
        f32x4 r_, k_, v_, o_, a_; \
        r_[0] = RW_MIX(lo_bf(cr[U].x), lo_bf(pr[U].x), mur.x); r_[1] = RW_MIX(hi_bf(cr[U].x), hi_bf(pr[U].x), mur.y); r_[2] = RW_MIX(lo_bf(cr[U].y), lo_bf(pr[U].y), mur.z); r_[3] = RW_MIX(hi_bf(cr[U].y), hi_bf(pr[U].y), mur.w); \
        k_[0] = RW_MIX(lo_bf(ck[U].x), lo_bf(pk[U].x), muk.x); k_[1] = RW_MIX(hi_bf(ck[U].x), hi_bf(pk[U].x), muk.y); k_[2] = RW_MIX(lo_bf(ck[U].y), lo_bf(pk[U].y), muk.z); k_[3] = RW_MIX(hi_bf(ck[U].y), hi_bf(pk[U].y), muk.w); \
        v_[0] = RW_MIX(lo_bf(cv[U].x), lo_bf(pv[U].x), muv.x); v_[1] = RW_MIX(hi_bf(cv[U].x), hi_bf(pv[U].x), muv.y); v_[2] = RW_MIX(lo_bf(cv[U].y), lo_bf(pv[U].y), muv.z); v_[3] = RW_MIX(hi_bf(cv[U].y), hi_bf(pv[U].y), muv.w); \
        o_[0] = lo_bf(co[U].x); o_[1] = hi_bf(co[U].x); o_[2] = lo_bf(co[U].y); o_[3] = hi_bf(co[U].y); a_[0] = lo_bf(ca[U].x); a_[1] = hi_bf(ca[U].x); a_[2] = lo_bf(ca[U].y); a_[3] = hi_bf(ca[U].y); \
        f32x4 kk_; kk_[0] = k_[0] * kk4.x; kk_[1] = k_[1] * kk4.y; kk_[2] = k_[2] * kk4.z; kk_[3] = k_[3] * kk4.w; \
        float ss_ = kk_[0] * kk_[0] + kk_[1] * kk_[1] + kk_[2] * kk_[2] + kk_[3] * kk_[3]; ss_ = row16_sum(ss_); \
        const float inv_ = __builtin_amdgcn_rcpf(fmaxf(__builtin_amdgcn_sqrtf(ss_), 1e-12f)); kk_ = kk_ * inv_; \
        f32x4 kn_; kn_[0] = k_[0] * (1.0f + (a_[0] - 1.0f) * ka4.x); kn_[1] = k_[1] * (1.0f + (a_[1] - 1.0f) * ka4.y); kn_[2] = k_[2] * (1.0f + (a_[2] - 1.0f) * ka4.z); kn_[3] = k_[3] * (1.0f + (a_[3] - 1.0f) * ka4.w); \
        *(LAS f32x4*)(d_) = r_; *(LAS f32x4*)(d_ + 64) = o_; *(LAS f32x4*)(d_ + 128) = kn_; *(LAS f32x4*)(d_ + 192) = -kk_; *(LAS f32x4*)(d_ + 256) = kk_ * a_; *(LAS f32x4*)(d_ + 320) = v_; } } while (0)
#define RW_PROC(dst) do { RW_PROC1(dst, 0); RW_PROC1(dst, 1); } while (0)
    RW_LOAD(0); RW_PROC(buf0); __syncthreads();
    for (int c = 0; c < NCH; ++c) {
        LAS float* cur = (c & 1) ? buf1 : buf0; LAS float* nxt = (c & 1) ? buf0 : buf1;
        if (c + 1 < NCH) RW_LOAD(c + 1);
        if (wid < 4) {
            constexpr int GS = SAMPLE ? 4 : 16;
            for (int g = 0; g < TC / GS; ++g) {
                float yk0 = 0.f, yk1 = 0.f;
                const LAS float* q0 = cur + (g * GS) * 384;
                f32x4 r4 = *(const LAS f32x4*)(q0 + j0), o4 = *(const LAS f32x4*)(q0 + 64 + j0), k4 = *(const LAS f32x4*)(q0 + 128 + j0), a4 = *(const LAS f32x4*)(q0 + 192 + j0), b4 = *(const LAS f32x4*)(q0 + 256 + j0);
                f32x2 v2 = *(const LAS f32x2*)(q0 + 320 + row0);
                float py0 = 0.f, py1 = 0.f;
#pragma unroll
                for (int tt = 0; tt < GS; ++tt) {
                    const LAS float* qn = q0 + (tt + 1 < GS ? tt + 1 : tt) * 384;
                    const f32x4 nr4 = *(const LAS f32x4*)(qn + j0), no4 = *(const LAS f32x4*)(qn + 64 + j0), nk4 = *(const LAS f32x4*)(qn + 128 + j0), na4 = *(const LAS f32x4*)(qn + 192 + j0), nb4 = *(const LAS f32x4*)(qn + 256 + j0);
                    const f32x2 nv2 = *(const LAS f32x2*)(qn + 320 + row0);
                    f32x2 sa = (S[0] * a4[0] + S[1] * a4[1]) + (S[2] * a4[2] + S[3] * a4[3]);
                    float sx = sa.x, sy = sa.y; ROW16_SUM4(sx, sy, py0, py1); sa = (f32x2){sx, sy};
                    if (tt > 0) { yk0 = cgl == tt - 1 ? py0 : yk0; yk1 = cgl == tt - 1 ? py1 : yk1; }
#pragma unroll
                    for (int c = 0; c < 4; ++c) { f32x2 t = S[c] - S[c] * o4[c]; t = t + sa * b4[c]; S[c] = t + v2 * k4[c]; }
                    const f32x2 y = (S[0] * r4[0] + S[1] * r4[1]) + (S[2] * r4[2] + S[3] * r4[3]);
                    py0 = y.x; py1 = y.y;
                    r4 = nr4; o4 = no4; k4 = nk4; a4 = na4; b4 = nb4; v2 = nv2;
                }
                ROW16_SUM2(py0, py1); yk0 = cgl == GS - 1 ? py0 : yk0; yk1 = cgl == GS - 1 ? py1 : yk1;
                if (cgl < GS) *(unsigned*)(YS + (size_t)(row_base + c * TC + g * GS + cgl) * 512 + h * 64 + row0) = pg8::cvt_pk_bf16(yk0, yk1);
            }
        }
        if (c + 1 < NCH) RW_PROC(nxt);
        __syncthreads();
    }
    if (wid < 4) { *(float4*)sout = make_float4(S[0].x, S[1].x, S[2].x, S[3].x); *(float4*)(sout + 64) = make_float4(S[0].y, S[1].y, S[2].y, S[3].y); }
#undef RW_LOAD
#undef RW_PROC
#undef RW_LOAD1
#undef RW_PROC1
#undef RW_MIX
}

__device__ __forceinline__ void ret_sample_unit(PR P, LAS float* lds, const int b, const int h, const int wv) {
    const int tid = fresh_tid(wv), lane = tid & 63, wid = tid >> 6;
    const bf16_t* PS = (const bf16_t*)(P.ws + WS_BIG); bf16_t* Y = (bf16_t*)(P.ws + WS_XN);
    const float* rc = (const float*)(P.ws + WS_ROPE); const float* rs = rc + 2052 * 64;
    LAS float* q = lds; LAS float* k = lds + 512; LAS float* v = lds + 1024; LAS float* Pm = lds + 1536; LAS float* y2p = lds + 1600; LAS float* red = lds + 1600 + 2048;
    const float lg2 = log2f(1.0f - exp2f(-5.0f - (float)h));
    const int row0 = MP + b * 4;
    { const int t = (tid & 255) >> 6, f = tid & 63; const bf16_t* src = PS + (size_t)(row0 + t) * NCOLS + 1792 + h * 128;
      if (tid < 256) { const float cs = rc[(2048 + t) * 64 + f], sn = rs[(2048 + t) * 64 + f];
          const float q1 = bf2f(src[f]), q2 = bf2f(src[f + 64]); q[t * 128 + f] = q1 * cs - q2 * sn; q[t * 128 + f + 64] = q1 * sn + q2 * cs;
          const float k1 = bf2f(src[512 + f]), k2 = bf2f(src[512 + f + 64]); k[t * 128 + f] = (k1 * cs - k2 * sn) * 0.08838834764831845f; k[t * 128 + f + 64] = (k1 * sn + k2 * cs) * 0.08838834764831845f; }
      else { v[t * 128 + f] = bf2f(src[1024 + f]); v[t * 128 + f + 64] = bf2f(src[1024 + f + 64]); } }
    __syncthreads();
    if (wid == 0) { const int pi = lane >> 4, pj = (lane >> 2) & 3, part = lane & 3; float s = 0.f;
        for (int d = part * 32; d < part * 32 + 32; ++d) s += q[pi * 128 + d] * k[pj * 128 + d];
        s = quad_sum(s); if (part == 0) Pm[pi * 4 + pj] = pi >= pj ? s * exp2f(lg2 * (float)(pi - pj)) : 0.f; }
    { const int e = tid & 127, dg = tid >> 7; const float c4 = exp2f(lg2 * 4.0f), g3 = exp2f(lg2 * 3.0f), g2_ = exp2f(lg2 * 2.0f), g1 = exp2f(lg2);
      const float v0 = v[e] * g3, v1 = v[128 + e] * g2_, v2 = v[256 + e] * g1, v3 = v[384 + e];
      const float* S0 = P.state_ret + ((size_t)(b * 4 + h) * 128) * 128 + e; float* So = P.out + O_RTS + ((size_t)(b * 4 + h) * 128) * 128 + e;
      float a0 = 0.f, a1 = 0.f, a2 = 0.f, a3 = 0.f;
      float sv[32];
#pragma unroll
      for (int x = 0; x < 32; ++x) sv[x] = S0[(size_t)(dg * 32 + x) * 128];
#pragma unroll
      for (int x = 0; x < 32; ++x) { const int d = dg * 32 + x; const float s = sv[x];
          a0 = fmaf(q[d], s, a0); a1 = fmaf(q[128 + d], s, a1); a2 = fmaf(q[256 + d], s, a2); a3 = fmaf(q[384 + d], s, a3);
          So[(size_t)d * 128] = s * c4 + k[d] * v0 + k[128 + d] * v1 + k[256 + d] * v2 + k[384 + d] * v3; }
      y2p[(dg * 4 + 0) * 128 + e] = a0; y2p[(dg * 4 + 1) * 128 + e] = a1; y2p[(dg * 4 + 2) * 128 + e] = a2; y2p[(dg * 4 + 3) * 128 + e] = a3; }
    __syncthreads();
    { const int i = tid >> 7, e = tid & 127;
      float y = (y2p[(0 + i) * 128 + e] + y2p[(4 + i) * 128 + e] + y2p[(8 + i) * 128 + e] + y2p[(12 + i) * 128 + e]) * exp2f(lg2 * (float)(i + 1));
#pragma unroll
      for (int j = 0; j < 4; ++j) y = fmaf(Pm[i * 4 + j], v[j * 128 + e], y);
      float s = wave_sum(y); if (lane == 0) red[wid] = s; __syncthreads();
      const float mean = (red[i * 2] + red[i * 2 + 1]) * (1.0f / 128.0f); const float dlt = y - mean;
      float s2 = wave_sum(dlt * dlt); if (lane == 0) red[8 + wid] = s2; __syncthreads();
      const float var = (red[8 + i * 2] + red[8 + i * 2 + 1]) * (1.0f / 128.0f);
      const float g = bf2f(PS[(size_t)(row0 + i) * NCOLS + 1792 + 1536 + h * 128 + e]);
      const float o = dlt * rsqrtf(var + 1e-5f) * P.gn_w[h * 128 + e] * (g * __builtin_amdgcn_rcpf(1.0f + __expf(-g)));
      Y[(size_t)(row0 + i) * 1024 + 512 + h * 128 + e] = f2bf(o); }
    __syncthreads();
}

__device__ __forceinline__ bf16_t* kvb_ptr(unsigned char* ws, int bh) { return (bf16_t*)(bh < 29 ? ws + WS_LA + (size_t)bh * 524288 : ws + WS_WIN + 17301504 + (size_t)(bh - 29) * 524288); }
constexpr int RS = 136, BUFE = 128 * RS;

template <bool WITH_K>
__device__ __forceinline__ void ret_load_qk(PR P, LAS bf16_t* QP, LAS bf16_t* KB, unsigned (&kth)[4][4], const int tidv, const int row0, const int n, const int h, const float kd0, const float g32) {
    const bf16_t* PS = (const bf16_t*)(P.ws + WS_BIG); const float* rc = (const float*)(P.ws + WS_ROPE); const float* rs = rc + 2052 * 64;
    float kd = kd0;
#pragma unroll
    for (int it = 0; it < 4; ++it) { const int idx = it * 512 + tidv, i = idx >> 4, f = (idx & 15) * 4;
        const bf16_t* src = PS + (size_t)(row0 + i) * NCOLS + 1792 + h * 128;
        const u32x2 q1 = *(const u32x2*)(src + f), q2 = *(const u32x2*)(src + 64 + f);
        u32x2 k1 = (u32x2){0u, 0u}, k2 = k1; if (WITH_K) { k1 = *(const u32x2*)(src + 512 + f); k2 = *(const u32x2*)(src + 576 + f); }
        const float4 cs = *(const float4*)(rc + (size_t)(n * 128 + i) * 64 + f), sn = *(const float4*)(rs + (size_t)(n * 128 + i) * 64 + f);
        const float c4[4] = {cs.x, cs.y, cs.z, cs.w}, s4[4] = {sn.x, sn.y, sn.z, sn.w};
        const float qa[4] = {lo_bf(q1.x), hi_bf(q1.x), lo_bf(q1.y), hi_bf(q1.y)}, qb[4] = {lo_bf(q2.x), hi_bf(q2.x), lo_bf(q2.y), hi_bf(q2.y)};
        float qo1[4], qo2[4];
#pragma unroll
        for (int x = 0; x < 4; ++x) { qo1[x] = qa[x] * c4[x] - qb[x] * s4[x]; qo2[x] = qa[x] * s4[x] + qb[x] * c4[x]; }
        u32x2 w; w.x = pg8::cvt_pk_bf16(qo1[0], qo1[1]); w.y = pg8::cvt_pk_bf16(qo1[2], qo1[3]); *(LAS u32x2*)(QP + i * RS + f) = w;
        w.x = pg8::cvt_pk_bf16(qo2[0], qo2[1]); w.y = pg8::cvt_pk_bf16(qo2[2], qo2[3]); *(LAS u32x2*)(QP + i * RS + 64 + f) = w;
        if (WITH_K) {
            const float ka[4] = {lo_bf(k1.x), hi_bf(k1.x), lo_bf(k1.y), hi_bf(k1.y)}, kb[4] = {lo_bf(k2.x), hi_bf(k2.x), lo_bf(k2.y), hi_bf(k2.y)};
            float ko1[4], ko2[4];
#pragma unroll
            for (int x = 0; x < 4; ++x) { ko1[x] = (ka[x] * c4[x] - kb[x] * s4[x]) * 0.08838834764831845f; ko2[x] = (ka[x] * s4[x] + kb[x] * c4[x]) * 0.08838834764831845f; }
            w.x = pg8::cvt_pk_bf16(ko1[0], ko1[1]); w.y = pg8::cvt_pk_bf16(ko1[2], ko1[3]); *(LAS u32x2*)(KB + i * RS + f) = w;
            w.x = pg8::cvt_pk_bf16(ko2[0], ko2[1]); w.y = pg8::cvt_pk_bf16(ko2[2], ko2[3]); *(LAS u32x2*)(KB + i * RS + 64 + f) = w;
            kth[it][0] = pg8::cvt_pk_bf16(ko1[0] * kd, ko1[1] * kd); kth[it][1] = pg8::cvt_pk_bf16(ko1[2] * kd, ko1[3] * kd);
            kth[it][2] = pg8::cvt_pk_bf16(ko2[0] * kd, ko2[1] * kd); kth[it][3] = pg8::cvt_pk_bf16(ko2[2] * kd, ko2[3] * kd); kd *= g32; }
        if (it & 1) __builtin_amdgcn_sched_barrier(0); }
}

__device__ __forceinline__ void ret_unit_a(PR P, LAS unsigned char* lds, const int bh, const int n, const int wv) {
    LAS bf16_t* QP = (LAS bf16_t*)lds; LAS bf16_t* KB = QP + BUFE; LAS bf16_t* VT = KB + BUFE;
    const int tid = fresh_tid(wv), lane = tid & 63, wid = tid >> 6, wr = wid >> 1, wc = wid & 1, fr = lane & 15, fq = lane >> 4;
    const int b = bh >> 2, h = bh & 3;
    const bf16_t* PS = (const bf16_t*)(P.ws + WS_BIG); bf16_t* Y = (bf16_t*)(P.ws + WS_XN); bf16_t* KVB = kvb_ptr(P.ws, bh) + (size_t)n * 16384;
    const float lg2 = log2f(1.0f - exp2f(-5.0f - (float)h));
    const float kd0 = exp2f(lg2 * (float)(127 - (tid >> 4))), g32 = exp2f(-32.0f * lg2);
    const int row0 = b * 2048 + n * 128;
    unsigned kth[4][4];
    ret_load_qk<true>(P, QP, KB, kth, tid, row0, n, h, kd0, g32);
#pragma unroll
    for (int it = 0; it < 4; ++it) { const int idx = it * 512 + tid, j = idx >> 4, e = (idx & 15) * 8;
        const u32x4 vv = *(const u32x4*)(PS + (size_t)(row0 + j) * NCOLS + 1792 + 1024 + h * 128 + e);
        LAS bf16_t* d = VT + e * RS + j;
        d[0] = (bf16_t)(vv.x & 0xffffu); d[RS] = (bf16_t)(vv.x >> 16); d[2 * RS] = (bf16_t)(vv.y & 0xffffu); d[3 * RS] = (bf16_t)(vv.y >> 16);
        d[4 * RS] = (bf16_t)(vv.z & 0xffffu); d[5 * RS] = (bf16_t)(vv.z >> 16); d[6 * RS] = (bf16_t)(vv.w & 0xffffu); d[7 * RS] = (bf16_t)(vv.w >> 16); }
    __syncthreads();
    f32x4 accP[2][4];
#pragma unroll
    for (int mt = 0; mt < 2; ++mt)
#pragma unroll
        for (int nt = 0; nt < 4; ++nt) accP[mt][nt] = (f32x4){0.f, 0.f, 0.f, 0.f};
#pragma unroll
    for (int ks = 0; ks < 4; ++ks) { bf16x8 aq[2];
#pragma unroll
        for (int mt = 0; mt < 2; ++mt) aq[mt] = *(const LAS bf16x8*)(QP + (wr * 32 + mt * 16 + fr) * RS + ks * 32 + fq * 8);
#pragma unroll
        for (int nt = 0; nt < 4; ++nt) { const bf16x8 bk = *(const LAS bf16x8*)(KB + (wc * 64 + nt * 16 + fr) * RS + ks * 32 + fq * 8);
#pragma unroll
            for (int mt = 0; mt < 2; ++mt) accP[mt][nt] = __builtin_amdgcn_mfma_f32_16x16x32_bf16(aq[mt], bk, accP[mt][nt], 0, 0, 0); }
        __builtin_amdgcn_sched_barrier(0); }
    __syncthreads();
    { float ri[2][4], cj[4];
#pragma unroll
      for (int mt = 0; mt < 2; ++mt)
#pragma unroll
          for (int j = 0; j < 4; ++j) ri[mt][j] = exp2f(lg2 * (float)(wr * 32 + mt * 16 + fq * 4 + j));
#pragma unroll
      for (int nt = 0; nt < 4; ++nt) cj[nt] = exp2f(-lg2 * (float)(wc * 64 + nt * 16 + fr));
#pragma unroll
      for (int mt = 0; mt < 2; ++mt)
#pragma unroll
          for (int nt = 0; nt < 4; ++nt)
#pragma unroll
              for (int j = 0; j < 4; ++j) { const int i = wr * 32 + mt * 16 + fq * 4 + j, jj = wc * 64 + nt * 16 + fr;
                  const float val = i >= jj ? accP[mt][nt][j] * ri[mt][j] * cj[nt] : 0.f; QP[i * RS + jj] = f2bf(val); } }
#pragma unroll
    for (int it = 0; it < 4; ++it) { const int idx = it * 512 + tid, j = idx >> 4, f = (idx & 15) * 4; LAS bf16_t* d = KB + f * RS + j;
        d[0] = (bf16_t)(kth[it][0] & 0xffffu); d[RS] = (bf16_t)(kth[it][0] >> 16); d[2 * RS] = (bf16_t)(kth[it][1] & 0xffffu); d[3 * RS] = (bf16_t)(kth[it][1] >> 16);
        LAS bf16_t* d2 = d + 64 * RS;
        d2[0] = (bf16_t)(kth[it][2] & 0xffffu); d2[RS] = (bf16_t)(kth[it][2] >> 16); d2[2 * RS] = (bf16_t)(kth[it][3] & 0xffffu); d2[3 * RS] = (bf16_t)(kth[it][3] >> 16); }
    __syncthreads();
    f32x4 accY[2][4], accS[2][4];
#pragma unroll
    for (int mt = 0; mt < 2; ++mt)
#pragma unroll
        for (int nt = 0; nt < 4; ++nt) { accY[mt][nt] = (f32x4){0.f, 0.f, 0.f, 0.f}; accS[mt][nt] = (f32x4){0.f, 0.f, 0.f, 0.f}; }
#pragma unroll
    for (int ks = 0; ks < 4; ++ks) { bf16x8 ap[2], av[2];
#pragma unroll
        for (int mt = 0; mt < 2; ++mt) { ap[mt] = *(const LAS bf16x8*)(QP + (wr * 32 + mt * 16 + fr) * RS + ks * 32 + fq * 8); av[mt] = *(const LAS bf16x8*)(VT + (wr * 32 + mt * 16 + fr) * RS + ks * 32 + fq * 8); }
#pragma unroll
        for (int nt = 0; nt < 4; ++nt) { const bf16x8 bv = *(const LAS bf16x8*)(VT + (wc * 64 + nt * 16 + fr) * RS + ks * 32 + fq * 8), bkt = *(const LAS bf16x8*)(KB + (wc * 64 + nt * 16 + fr) * RS + ks * 32 + fq * 8);
#pragma unroll
            for (int mt = 0; mt < 2; ++mt) { accY[mt][nt] = __builtin_amdgcn_mfma_f32_16x16x32_bf16(ap[mt], bv, accY[mt][nt], 0, 0, 0); accS[mt][nt] = __builtin_amdgcn_mfma_f32_16x16x32_bf16(av[mt], bkt, accS[mt][nt], 0, 0, 0); } }
        __builtin_amdgcn_sched_barrier(0); }
#pragma unroll
    for (int mt = 0; mt < 2; ++mt)
#pragma unroll
        for (int nt = 0; nt < 4; ++nt)
#pragma unroll
            for (int j = 0; j < 4; ++j) { const int r = wr * 32 + mt * 16 + fq * 4 + j, c = wc * 64 + nt * 16 + fr;
                Y[(size_t)(row0 + r) * 1024 + 512 + h * 128 + c] = f2bf(accY[mt][nt][j]); KVB[r * 128 + c] = f2bf(accS[mt][nt][j]); }
    __syncthreads();
}

__device__ __forceinline__ void ret_prefix(PR P, const int item) {
    const int bh = item >> 11, i8 = (item & 2047) * 8; const int h = bh & 3;
    bf16_t* KVB = kvb_ptr(P.ws, bh) + i8;
    const float lg2 = log2f(1.0f - exp2f(-5.0f - (float)h)); const float c_dec = exp2f(lg2 * 128.0f);
    u32x4 kv[16];
#pragma unroll
    for (int n = 0; n < 16; ++n) kv[n] = *(const u32x4*)(KVB + (size_t)n * 16384);
    float S[8];
#pragma unroll
    for (int x = 0; x < 8; ++x) S[x] = 0.f;
#pragma unroll
    for (int n = 0; n < 16; ++n) { u32x4 w; w.x = pg8::cvt_pk_bf16(S[0], S[1]); w.y = pg8::cvt_pk_bf16(S[2], S[3]); w.z = pg8::cvt_pk_bf16(S[4], S[5]); w.w = pg8::cvt_pk_bf16(S[6], S[7]);
        *(u32x4*)(KVB + (size_t)n * 16384) = w;
        const float k8[8] = {lo_bf(kv[n].x), hi_bf(kv[n].x), lo_bf(kv[n].y), hi_bf(kv[n].y), lo_bf(kv[n].z), hi_bf(kv[n].z), lo_bf(kv[n].w), hi_bf(kv[n].w)};
#pragma unroll
        for (int x = 0; x < 8; ++x) S[x] = S[x] * c_dec + k8[x]; }
    const int e = i8 >> 7, d0 = i8 & 127;
#pragma unroll
    for (int x = 0; x < 8; ++x) P.out[O_RTP + ((size_t)bh * 128 + d0 + x) * 128 + e] = S[x];
}

__device__ __forceinline__ void ret_unit_c(PR P, LAS unsigned char* lds, const int bh, const int n, const int wv) {
    LAS bf16_t* QP = (LAS bf16_t*)lds; LAS bf16_t* ST = QP + 3 * BUFE; LAS float* YST = (LAS float*)(QP + BUFE);
    const int tid = fresh_tid(wv), lane = tid & 63, wid = tid >> 6, wr = wid >> 1, wc = wid & 1, fr = lane & 15, fq = lane >> 4;
    const int b = bh >> 2, h = bh & 3;
    const bf16_t* PS = (const bf16_t*)(P.ws + WS_BIG); bf16_t* Y = (bf16_t*)(P.ws + WS_XN); const bf16_t* KVB = kvb_ptr(P.ws, bh) + (size_t)n * 16384;
    const float lg2 = log2f(1.0f - exp2f(-5.0f - (float)h));
    const int row0 = b * 2048 + n * 128;
    unsigned kth[4][4];
    ret_load_qk<false>(P, QP, QP, kth, tid, row0, n, h, 0.f, 0.f);
#pragma unroll
    for (int it = 0; it < 4; ++it) { const int idx = it * 512 + tid, e = idx >> 4, d8 = (idx & 15) * 8;
        *(LAS u32x4*)(ST + e * RS + d8) = *(const u32x4*)(KVB + e * 128 + d8); }
    __syncthreads();
    f32x4 accY[2][4];
#pragma unroll
    for (int mt = 0; mt < 2; ++mt)
#pragma unroll
        for (int nt = 0; nt < 4; ++nt) accY[mt][nt] = (f32x4){0.f, 0.f, 0.f, 0.f};
#pragma unroll
    for (int ks = 0; ks < 4; ++ks) { bf16x8 aq[2];
#pragma unroll
        for (int mt = 0; mt < 2; ++mt) aq[mt] = *(const LAS bf16x8*)(QP + (wr * 32 + mt * 16 + fr) * RS + ks * 32 + fq * 8);
#pragma unroll
        for (int nt = 0; nt < 4; ++nt) { const bf16x8 bs = *(const LAS bf16x8*)(ST + (wc * 64 + nt * 16 + fr) * RS + ks * 32 + fq * 8);
#pragma unroll
            for (int mt = 0; mt < 2; ++mt) accY[mt][nt] = __builtin_amdgcn_mfma_f32_16x16x32_bf16(aq[mt], bs, accY[mt][nt], 0, 0, 0); }
        __builtin_amdgcn_sched_barrier(0); }
#pragma unroll
    for (int mt = 0; mt < 2; ++mt)
#pragma unroll
        for (int j = 0; j < 4; ++j) { const int r = wr * 32 + mt * 16 + fq * 4 + j; const float qd = exp2f(lg2 * (float)(r + 1));
#pragma unroll
            for (int nt = 0; nt < 4; ++nt) YST[r * 132 + wc * 64 + nt * 16 + fr] = accY[mt][nt][j] * qd; }
    __syncthreads();
    { const int i = tid >> 2, part = tid & 3; float yv[32]; float s = 0.f;
      bf16_t* yo = Y + (size_t)(row0 + i) * 1024 + 512 + h * 128 + part * 32;
#pragma unroll
      for (int x = 0; x < 4; ++x) { const u32x4 y1 = *(const u32x4*)(yo + x * 8); const f32x4 ta = *(const LAS f32x4*)(YST + i * 132 + part * 32 + x * 8), tb = *(const LAS f32x4*)(YST + i * 132 + part * 32 + x * 8 + 4);
          yv[x * 8 + 0] = ta[0] + lo_bf(y1.x); yv[x * 8 + 1] = ta[1] + hi_bf(y1.x); yv[x * 8 + 2] = ta[2] + lo_bf(y1.y); yv[x * 8 + 3] = ta[3] + hi_bf(y1.y);
          yv[x * 8 + 4] = tb[0] + lo_bf(y1.z); yv[x * 8 + 5] = tb[1] + hi_bf(y1.z); yv[x * 8 + 6] = tb[2] + lo_bf(y1.w); yv[x * 8 + 7] = tb[3] + hi_bf(y1.w); }
#pragma unroll
      for (int x = 0; x < 32; ++x) s += yv[x];
      s = quad_sum(s); const float mean = s * (1.0f / 128.0f); float s2 = 0.f;
#pragma unroll
      for (int x = 0; x < 32; ++x) { yv[x] -= mean; s2 += yv[x] * yv[x]; }
      s2 = quad_sum(s2); const float rstd = rsqrtf(s2 * (1.0f / 128.0f) + 1e-5f);
      const bf16_t* gp = PS + (size_t)(row0 + i) * NCOLS + 1792 + 1536 + h * 128 + part * 32; const float* gw = P.gn_w + h * 128 + part * 32;
#pragma unroll
      for (int x = 0; x < 4; ++x) { const u32x4 g4 = *(const u32x4*)(gp + x * 8); const float4 w0 = *(const float4*)(gw + x * 8), w1 = *(const float4*)(gw + x * 8 + 4);
          const float gg[8] = {lo_bf(g4.x), hi_bf(g4.x), lo_bf(g4.y), hi_bf(g4.y), lo_bf(g4.z), hi_bf(g4.z), lo_bf(g4.w), hi_bf(g4.w)}; const float ww[8] = {w0.x, w0.y, w0.z, w0.w, w1.x, w1.y, w1.z, w1.w};
          float o[8];
#pragma unroll
          for (int z = 0; z < 8; ++z) o[z] = yv[x * 8 + z] * rstd * ww[z] * (gg[z] * __builtin_amdgcn_rcpf(1.0f + __expf(-gg[z])));
          u32x4 w; w.x = pg8::cvt_pk_bf16(o[0], o[1]); w.y = pg8::cvt_pk_bf16(o[2], o[3]); w.z = pg8::cvt_pk_bf16(o[4], o[5]); w.w = pg8::cvt_pk_bf16(o[6], o[7]);
          *(u32x4*)(yo + x * 8) = w; } }
    __syncthreads();
}

__device__ __forceinline__ void sub_barrier(unsigned* cnt, const unsigned target, const int wv) {
    asm volatile("s_waitcnt vmcnt(0)" ::: "memory");
    __syncthreads();
    if (fresh_tid(wv) == 0) {
        __builtin_amdgcn_fence(__ATOMIC_RELEASE, "agent");
        asm volatile("s_waitcnt vmcnt(0)" ::: "memory");
        (void)xb_add(cnt, 1u);
        unsigned sp = 0u;
        while (xb_ld(cnt) < target) { __builtin_amdgcn_s_sleep(2); if (++sp > (1u << 20)) break; }
        __builtin_amdgcn_fence(__ATOMIC_ACQUIRE, "agent");
        asm volatile("s_waitcnt vmcnt(0)" ::: "memory");
    }
    __syncthreads();
}

struct PostRegs { u32x2 yr, c_r, c_k, c_v, p_r, p_k, p_v, ar, gr; };
__device__ __forceinline__ void post_load(PR P, PostRegs& R, const int row, const int ch) {
    const bf16_t* PS = (const bf16_t*)(P.ws + WS_BIG); const bf16_t* ASIG = (const bf16_t*)(P.ws + WS_ASIG); const bf16_t* YS = (const bf16_t*)(P.ws + WS_YS); const bf16_t* G = (const bf16_t*)(P.ws + WS_WIN);
    R.yr = *(const u32x2*)(YS + (size_t)row * 512 + ch);
    const bf16_t* cp = PS + (size_t)row * NCOLS + ch; const int pr = prev_row(row);
    R.c_r = *(const u32x2*)cp; R.c_k = *(const u32x2*)(cp + 512); R.c_v = *(const u32x2*)(cp + 1024);
    { const bf16_t* pp = PS + (size_t)(pr >= 0 ? pr : row) * NCOLS + ch; R.p_r = *(const u32x2*)pp; R.p_k = *(const u32x2*)(pp + 512); R.p_v = *(const u32x2*)(pp + 1024); }
    R.ar = *(const u32x2*)(ASIG + (size_t)row * 512 + ch); R.gr = *(const u32x2*)(G + (size_t)row * 512 + ch);
}
__device__ __forceinline__ void rwkv_post(PR P, const int wv) {
    const int tid = fresh_tid(wv); const int lane = tid & 63; const int gw = blockIdx.x * 8 + (tid >> 6), nw = gridDim.x * 8;
    const int sub = lane >> 4, cg4 = (lane & 15) * 4;
    bf16_t* Y = (bf16_t*)(P.ws + WS_XN);
    const int h = (gw * 4 + sub) & 7, ch = h * 64 + cg4;
    const float4 mr = *(const float4*)(P.mu + ch), mk = *(const float4*)(P.mu + 512 + ch), mv = *(const float4*)(P.mu + 1024 + ch);
    const float4 ka = *(const float4*)(P.k_a + ch), rk = *(const float4*)(P.r_k + ch), lw = *(const float4*)(P.lnx_w + ch), lb = *(const float4*)(P.lnx_b + ch);
    const float m_r[4] = {mr.x, mr.y, mr.z, mr.w}, m_k[4] = {mk.x, mk.y, mk.z, mk.w}, m_v[4] = {mv.x, mv.y, mv.z, mv.w};
    const float kaa[4] = {ka.x, ka.y, ka.z, ka.w}, rkk[4] = {rk.x, rk.y, rk.z, rk.w}, lww[4] = {lw.x, lw.y, lw.z, lw.w}, lbb[4] = {lb.x, lb.y, lb.z, lb.w};
    PostRegs R, N;
    if (gw < MT * 2) post_load(P, R, (gw * 4 + sub) >> 3, ch);
    for (int task = gw; task < MT * 2; task += nw) {
        const int row = (task * 4 + sub) >> 3;
        { const int nt_ = task + nw < MT * 2 ? task + nw : task; post_load(P, N, (nt_ * 4 + sub) >> 3, ch); }
        if (prev_row(row) < 0) { R.p_r = (u32x2){0u, 0u}; R.p_k = R.p_r; R.p_v = R.p_r; }
        const float ys[4] = {lo_bf(R.yr.x), hi_bf(R.yr.x), lo_bf(R.yr.y), hi_bf(R.yr.y)};
        const float mean = row16_sum(ys[0] + ys[1] + ys[2] + ys[3]) * (1.0f / 64.0f);
        float dl[4], s2 = 0.f;
#pragma unroll
        for (int j = 0; j < 4; ++j) { dl[j] = ys[j] - mean; s2 += dl[j] * dl[j]; }
        const float rstd = rsqrtf(row16_sum(s2) * (1.0f / 64.0f) + 64e-5f);
        const float cr[4] = {lo_bf(R.c_r.x), hi_bf(R.c_r.x), lo_bf(R.c_r.y), hi_bf(R.c_r.y)}, ck[4] = {lo_bf(R.c_k.x), hi_bf(R.c_k.x), lo_bf(R.c_k.y), hi_bf(R.c_k.y)}, cv[4] = {lo_bf(R.c_v.x), hi_bf(R.c_v.x), lo_bf(R.c_v.y), hi_bf(R.c_v.y)};
        const float qr[4] = {lo_bf(R.p_r.x), hi_bf(R.p_r.x), lo_bf(R.p_r.y), hi_bf(R.p_r.y)}, qk[4] = {lo_bf(R.p_k.x), hi_bf(R.p_k.x), lo_bf(R.p_k.y), hi_bf(R.p_k.y)}, qv[4] = {lo_bf(R.p_v.x), hi_bf(R.p_v.x), lo_bf(R.p_v.y), hi_bf(R.p_v.y)};
        const float aa[4] = {lo_bf(R.ar.x), hi_bf(R.ar.x), lo_bf(R.ar.y), hi_bf(R.ar.y)}, gg[4] = {lo_bf(R.gr.x), hi_bf(R.gr.x), lo_bf(R.gr.y), hi_bf(R.gr.y)};
        float v[4], bp = 0.f;
#pragma unroll
        for (int j = 0; j < 4; ++j) { const float r = cr[j] + (qr[j] - cr[j]) * m_r[j], k = ck[j] + (qk[j] - ck[j]) * m_k[j]; v[j] = cv[j] + (qv[j] - cv[j]) * m_v[j];
            const float kn = k * (1.0f + (aa[j] - 1.0f) * kaa[j]); bp += r * kn * rkk[j]; }
        const float bonus = row16_sum(bp);
        float o[4];
#pragma unroll
        for (int j = 0; j < 4; ++j) o[j] = (dl[j] * rstd * lww[j] + lbb[j] + bonus * v[j]) * gg[j];
        u32x2 w; w.x = pg8::cvt_pk_bf16(o[0], o[1]); w.y = pg8::cvt_pk_bf16(o[2], o[3]);
        *(u32x2*)(Y + (size_t)row * 1024 + ch) = w;
        R = N;
    }
}

__global__ void __launch_bounds__(512, 2) hymba_mega(Params P_unused) {
    extern __shared__ __attribute__((aligned(16))) unsigned char shm[];
    cg::grid_group grid = cg::this_grid();
    LAS unsigned char* lds = (LAS unsigned char*)shm; LAS float* ldsf = (LAS float*)shm;
    const int G = gridDim.x, bx = blockIdx.x;
    const int wv = __builtin_amdgcn_readfirstlane(threadIdx.x >> 6);
    const CAS Params* kp = (const CAS Params*)__builtin_amdgcn_kernarg_segment_ptr();
#define P (*kp)
#define FRESH() asm volatile("" : "+s"(kp))
#ifndef REP_SYNC
#define REP_SYNC 1
#endif
#ifndef REP_P7
#define REP_P7 1
#endif
#ifndef REP_FFN1
#define REP_FFN1 1
#endif
#ifndef REP_P0
#define REP_P0 1
#endif
#ifndef REP_P3
#define REP_P3 1
#endif
#ifndef REP_RW
#define REP_RW 1
#endif
#ifndef REP_OTH
#define REP_OTH 1
#endif
#ifndef REP_RETP
#define REP_RETP 1
#endif
#ifndef REP_SAMP
#define REP_SAMP 1
#endif
#ifndef REP_P8
#define REP_P8 1
#endif
#define GSYNC() do { for (int r_ = 0; r_ < REP_SYNC; ++r_) xcd_barrier((unsigned*)ws, (volatile LAS unsigned*)(lds + LDS_BYTES - 16), wv); FRESH(); } while (0)
#define ws (kp->ws)
#define XN ((bf16_t*)(ws + WS_XN))
#define ACT ((bf16_t*)(ws + WS_BIG))
#define FO ((float*)(ws + WS_FO))
#define PS ((bf16_t*)(ws + WS_BIG))
    pg8::StaticOrder S;
    { const int t0 = fresh_tid(wv); if (t0 < 4) ((LAS unsigned*)(lds + LDS_BYTES - 16))[t0] = 0u;
      if (t0 == 0) (void)xb_add(&((unsigned*)ws)[XB_XCNT(xb_xcc_id())], 1u); }
    if (G == 0x7fffffff) grid.sync();
#ifndef PHM
#define PHM 0xFFFF
#endif
#define PH(k) if ((PHM >> (k)) & 1)
    for (int r0 = 0; r0 < REP_P0; ++r0) PH(0) p0_prologue(P, ldsf, wv);
    GSYNC();
    for (int rep1 = 0; rep1 < REP_FFN1; ++rep1) {
    PH(1) { pg8::Gemm g{XN, (const bf16_t*)(ws + WS_WGU), MT, NGU, 1024}; S.init(MT, NGU, G, bx, 1024); pg8::EpiSwiGLU E{ACT, DFF}; pg8::gemm_phase(lds, g, S, E, wv); }
    GSYNC();
    PH(2) { pg8::Gemm g{ACT, (const bf16_t*)(ws + WS_WD), MT, 1024, DFF}; pg8::SplitOrder S2; S2.init2(G, bx, DFF, 8); pg8::EpiFO E{(bf16_t*)FO, 1024, (float*)(ws + WS_OMD)}; pg8::gemm_phase(lds, g, S2, E, wv); }
    GSYNC();
    }
    for (int r3 = 0; r3 < REP_P3; ++r3) PH(3) rows_phase(P, 1, wv);
    GSYNC();
    PH(4) { pg8::Gemm g{XN, (const bf16_t*)(ws + WS_WIN), MIN_, NCOLS, 1024}; S.init(MIN_, NCOLS, G, bx, 1024); pg8::EpiBf16 E{PS, NCOLS}; pg8::gemm_phase(lds, g, S, E, wv); }
    GSYNC();
    PH(5) lora_prep(P, wv);
    GSYNC();
    PH(6) { pg8::Gemm g{(const bf16_t*)(ws + WS_LA), (const bf16_t*)(ws + WS_WL), MT, 1536, 256}; pg8::LoraMainOrder SM; SM.init(MP, 1024, G, bx, 256);
      pg8::EpiLora E{(bf16_t*)(ws + WS_OMD), (bf16_t*)(ws + WS_ASIG), (bf16_t*)(ws + WS_WIN), P.w0, P.a0}; pg8::gemm_phase(lds, g, SM, E, wv); }
    GSYNC();
    {
    if (bx < 128) { for (int rw = 0; rw < REP_RW; ++rw) rwkv_unit<false>(P, ldsf, bx >> 4, (bx >> 1) & 7, bx & 1, wv); }
    else {
        { pg8::Gemm g{(const bf16_t*)(ws + WS_LA), (const bf16_t*)(ws + WS_WL), MT, 1536, 256}; pg8::LoraRestOrder SL; SL.ob = bx - 128;
          pg8::EpiLora E{(bf16_t*)(ws + WS_OMD), (bf16_t*)(ws + WS_ASIG), (bf16_t*)(ws + WS_WIN), P.w0, P.a0}; pg8::gemm_phase(lds, g, SL, E, wv); }
        FRESH();
        const int rep7 = 0; const int ob = bx - 128; unsigned* sbc = (unsigned*)ws + XCD_BAR_WORDS + 64;
        for (int k = 0; k < 4; ++k) { const int u = ob + k * 128; ret_unit_a(P, lds, u >> 4, u & 15, wv); }
        sub_barrier(sbc, 128u * (2u * rep7 + 1u), wv);
        ret_prefix(P, ob * 512 + fresh_tid(wv));
        sub_barrier(sbc, 128u * (2u * rep7 + 2u), wv);
        for (int k = 0; k < 4; ++k) { const int u = ob + k * 128; ret_unit_c(P, lds, u >> 4, u & 15, wv); }
        for (int u = ob; u < 2560; u += 128) { if (u < 2048) rwkv_unit<true>(P, ldsf, u >> 4, (u >> 1) & 7, u & 1, wv); else ret_sample_unit(P, ldsf, (u - 2048) >> 2, (u - 2048) & 3, wv); }
    }
    }
    GSYNC();
    for (int rep8 = 0; rep8 < REP_P8; ++rep8) PH(8) rwkv_post(P, wv);
    GSYNC();
    PH(9) { pg8::Gemm g{XN, (const bf16_t*)(ws + WS_WOUT), MT, 1024, 1024}; pg8::SplitOrder S2; S2.init2(G, bx, 1024, 4); pg8::EpiFO E{(bf16_t*)FO, 1024, (float*)(ws + WS_OMD)}; pg8::gemm_phase(lds, g, S2, E, wv); }
    GSYNC();
    PH(10) { tconv_list(P.f2g, P.f2u, P.f2d, nullptr, nullptr, ws, 2112, ldsf, wv);
    rows_phase(P, 2, wv); }
    GSYNC();
    PH(11) { pg8::Gemm g{XN, (const bf16_t*)(ws + WS_WGU), MT, NGU, 1024}; S.init(MT, NGU, G, bx, 1024); pg8::EpiSwiGLU E{ACT, DFF}; pg8::gemm_phase(lds, g, S, E, wv); }
    GSYNC();
    PH(12) { pg8::Gemm g{ACT, (const bf16_t*)(ws + WS_WD), MT, 1024, DFF}; pg8::SplitOrder S2; S2.init2(G, bx, DFF, 8); pg8::EpiFO E{(bf16_t*)FO, 1024, (float*)(ws + WS_OMD)}; pg8::gemm_phase(lds, g, S2, E, wv); }
    GSYNC();
    PH(13) rows_phase(P, 3, wv);
}

#undef ws
#undef XN
#undef ACT
#undef FO
#undef PS
#undef P
extern "C" void kernel_launch(void* const* d_in, const int* in_sizes, int n_in, void* d_out, int out_size, void* d_ws, size_t ws_size, hipStream_t stream) {
    static int grid = 0;
    if (grid == 0) {
        if (n_in != 26 || ws_size < WS_END) { fprintf(stderr, "kernel_launch: unexpected n_in %d or ws_size %zu (< %zu)\n", n_in, ws_size, (size_t)WS_END); grid = -1; return; }
        int dev = 0, cus = 0, per_cu = 0;
        hipGetDevice(&dev); hipDeviceGetAttribute(&cus, hipDeviceAttributeMultiprocessorCount, dev);
        hipFuncSetAttribute((const void*)hymba_mega, hipFuncAttributeMaxDynamicSharedMemorySize, LDS_BYTES);
        hipOccupancyMaxActiveBlocksPerMultiprocessor(&per_cu, (const void*)hymba_mega, 512, LDS_BYTES);
        if (per_cu < 1) { fprintf(stderr, "kernel_launch: occupancy query says %d blocks/CU\n", per_cu); per_cu = 1; }
        grid = cus * per_cu; if (grid > 256) grid = 256;
        if (grid != 256) { fprintf(stderr, "kernel_launch: this kernel needs 256 co-resident workgroups, got %d\n", grid); grid = -1; return; }
        fprintf(stderr, "kernel_launch: cus %d per_cu %d grid %d ws %zu\n", cus, per_cu, grid, ws_size);
    }
    if (grid < 0) return;
    if (hipMemsetAsync(d_ws, 0, 16384, stream) != hipSuccess) { fprintf(stderr, "kernel_launch: hipMemsetAsync failed\n"); return; }
    Params p{};
    const float** pp = (const float**)&p;
    for (int i = 0; i < 26; ++i) pp[i] = (const float*)d_in[i];
    p.out = (float*)d_out; p.ws = (unsigned char*)d_ws;
    void* args[] = {&p};
    hipError_t e = hipLaunchCooperativeKernel((const void*)hymba_mega, dim3(grid), dim3(512), args, LDS_BYTES, stream);
    if (e != hipSuccess) fprintf(stderr, "cooperative launch failed: %s (grid %d)\n", hipGetErrorString(e), grid);
}
```

```cpp
#include <hip/hip_runtime.h>
#include <hip/hip_cooperative_groups.h>
#include <cstdio>
#include <cstdint>
namespace cg = cooperative_groups;

__device__ __forceinline__ int fresh_tid(int wv) { int l; asm volatile("v_mbcnt_lo_u32_b32 %0, -1, 0\n\tv_mbcnt_hi_u32_b32 %0, -1, %0" : "=v"(l)); return wv * 64 + l; }
namespace pg8 {
#define PG8_LAS __attribute__((address_space(3)))
typedef unsigned short bf16_t;
typedef short bf16x8 __attribute__((ext_vector_type(8)));
typedef float f32x4 __attribute__((ext_vector_type(4)));
typedef unsigned u32x4 __attribute__((ext_vector_type(4)));
typedef unsigned u32x2 __attribute__((ext_vector_type(2)));
constexpr int BM = 256, BK = 64, HALF = 128, HTB = HALF * BK * 2, STAGE_BYTES = 8 * HTB, NXCD = 8, WGM = 8;

__host__ __device__ __forceinline__ int lds_byte(int r, int c) { const int st = (r >> 4) * 2 + (c >> 5), rr = r & 15, cc = c & 31, ob = rr * 64 + cc * 2; return st * 1024 + (ob ^ (((ob >> 9) & 1) << 5)); }
__host__ __device__ __forceinline__ void stage_rc(int b, int& R, int& C) { const int st = b / 1024, sb = b % 1024, swz = sb ^ (((sb >> 9) & 1) << 5); R = (st >> 1) * 16 + swz / 64; C = (st & 1) * 32 + (swz % 64) / 2; }
__host__ __device__ __forceinline__ int perm32(int rho) { const int n = rho >> 4, i = rho & 15; return 8 * (i >> 2) + 4 * n + (i & 3); }

struct Unit { int pm, pn, k0, nkt, atomic; };
struct Gemm { const bf16_t* A; const bf16_t* Bt; int M, N, K; };

struct StaticOrder {
    int nM, nN, nwg, G, c, nt;
    __host__ __device__ void init(int M, int N, int G_, int c_, int K) { nM = M / BM; nN = N / BM; nwg = nM * nN; G = G_; c = c_; nt = K / BK; }
    __host__ __device__ bool next(int i, Unit& u) const {
        const long L = (long)i * G + c; if (L >= nwg) return false;
        int wgid = (int)L; { const int q = nwg / NXCD, r = nwg % NXCD, xcd = wgid % NXCD, off = wgid / NXCD; wgid = (xcd < r ? xcd * (q + 1) : r * (q + 1) + (xcd - r) * q) + off; }
        const int nig = WGM * nN, gid = wgid / nig, fm = gid * WGM, gsz = (nM - fm) < WGM ? (nM - fm) : WGM;
        u.pm = fm + ((wgid % nig) % gsz); u.pn = (wgid % nig) / gsz; u.k0 = 0; u.nkt = nt; u.atomic = 0; return true;
    }
    __device__ __forceinline__ void a_ready(const Unit&) const {}
    __device__ __forceinline__ void done(const Unit&) const {}
};
struct LoraMainOrder : StaticOrder {
    __host__ __device__ bool next(int i, Unit& u) const { if (!StaticOrder::next(i, u)) return false; u.k0 = 0; u.nkt = 2; return true; }
};
struct LoraRestOrder {
    int ob;
    __host__ __device__ bool next(int i, Unit& u) const {
        const int L = i * 128 + ob; if (L >= 140) return false;
        if (L < 132) { u.pm = L >> 1; u.pn = 4 + (L & 1); u.k0 = 2; } else { const int x = L - 132; u.pm = 64 + (x >> 2); u.pn = x & 3; u.k0 = 0; }
        u.nkt = 2; u.atomic = 0; return true;
    }
    __device__ __forceinline__ void a_ready(const Unit&) const {}
    __device__ __forceinline__ void done(const Unit&) const {}
};
struct SplitOrder : StaticOrder {
    int KS;
    __host__ __device__ void init2(int G_, int c_, int K, int KS_) { init(16384, 1024, G_, c_, K); KS = KS_; }
    __host__ __device__ bool next(int i, Unit& u) const {
        if (i == 0) return StaticOrder::next(0, u);
        if (i > 1 || c >= 8 * KS) return false;
        const int tile = c / KS, part = c % KS, pairs = nt / 2, q = pairs / KS, r = pairs % KS;
        u.pm = 64 + (tile >> 2); u.pn = tile & 3; u.k0 = 2 * (part * q + (part < r ? part : r)); u.nkt = 2 * (q + (part < r ? 1 : 0)); u.atomic = 1 + c; return true;
    }
};

typedef __bf16 bf16x2_t __attribute__((ext_vector_type(2)));
typedef float f32x2_t __attribute__((ext_vector_type(2)));
__device__ __forceinline__ unsigned cvt_pk_bf16(float lo, float hi) { const f32x2_t v = {lo, hi}; const bf16x2_t b = __builtin_convertvector(v, bf16x2_t); return __builtin_bit_cast(unsigned, b); }

struct EpiFO {
    static constexpr bool PERM = true;
    bf16_t* C; int ldc; float* slab;
    __device__ __forceinline__ void operator()(const f32x4 (&acc)[2][2][4][2], const Unit& u, int wr, int wc, int fr, int fq) const {
        if (u.atomic == 0) {
            const __amdgpu_buffer_rsrc_t rs = __builtin_amdgcn_make_buffer_rsrc(C, 0, 0x7ffffff0, 0x00020000);
            const int row0 = u.pm * BM + wr * 64 + fr; const int col0 = u.pn * BM + wc * 32 + 8 * fq;
#pragma unroll
            for (int ai = 0; ai < 2; ++ai)
#pragma unroll
                for (int m = 0; m < 4; ++m) { const unsigned ro = (unsigned)((row0 + ai * HALF + m * 16) * ldc + col0) * 2u;
#pragma unroll
                    for (int bj = 0; bj < 2; ++bj) { const f32x4 v0 = acc[ai][bj][m][0], v1 = acc[ai][bj][m][1];
                        u32x4 w; w.x = cvt_pk_bf16(v0[0], v0[1]); w.y = cvt_pk_bf16(v0[2], v0[3]); w.z = cvt_pk_bf16(v1[0], v1[1]); w.w = cvt_pk_bf16(v1[2], v1[3]);
                        __builtin_amdgcn_raw_buffer_store_b128(w, rs, ro + bj * HALF * 2, 0, 16); } }
        } else {
            float* base = slab + (size_t)(u.atomic - 1) * (BM * BM) + (size_t)(wr * 64 + fr) * BM + wc * 32 + 8 * fq;
#pragma unroll
            for (int ai = 0; ai < 2; ++ai)
#pragma unroll
                for (int m = 0; m < 4; ++m) { float* rowp = base + (size_t)(ai * HALF + m * 16) * BM;
#pragma unroll
                    for (int bj = 0; bj < 2; ++bj) { *(f32x4*)(rowp + bj * HALF) = acc[ai][bj][m][0]; *(f32x4*)(rowp + bj * HALF + 4) = acc[ai][bj][m][1]; } }
        }
    }
};
struct EpiBf16 {
    static constexpr bool PERM = true;
    bf16_t* O; int ldc;
    __device__ __forceinline__ void operator()(const f32x4 (&acc)[2][2][4][2], const Unit& u, int wr, int wc, int fr, int fq) const {
        const int row0 = u.pm * BM + wr * 64 + fr; const int col0 = u.pn * BM + wc * 32 + 8 * fq;
        const __amdgpu_buffer_rsrc_t rs = __builtin_amdgcn_make_buffer_rsrc(O, 0, 0x7ffffff0, 0x00020000);
#pragma unroll
        for (int ai = 0; ai < 2; ++ai)
#pragma unroll
            for (int m = 0; m < 4; ++m) { const unsigned ro = (unsigned)((row0 + ai * HALF + m * 16) * ldc + col0) * 2u;
#pragma unroll
                for (int bj = 0; bj < 2; ++bj) { const f32x4 v0 = acc[ai][bj][m][0], v1 = acc[ai][bj][m][1];
                    u32x4 w; w.x = cvt_pk_bf16(v0[0], v0[1]); w.y = cvt_pk_bf16(v0[2], v0[3]); w.z = cvt_pk_bf16(v1[0], v1[1]); w.w = cvt_pk_bf16(v1[2], v1[3]);
                    __builtin_amdgcn_raw_buffer_store_b128(w, rs, ro + bj * HALF * 2, 0, 16); } }
    }
};
__device__ __forceinline__ float silu_f(float x) { return x * __builtin_amdgcn_rcpf(1.0f + __expf(-x)); }
struct EpiSwiGLU {
    static constexpr bool PERM = true;
    bf16_t* O; int ldc;
    __device__ __forceinline__ void operator()(const f32x4 (&acc)[2][2][4][2], const Unit& u, int wr, int wc, int fr, int fq) const {
        const int row0 = u.pm * BM + wr * 64 + fr; const int col0 = u.pn * HALF + wc * 32 + 8 * fq;
        const __amdgpu_buffer_rsrc_t rs = __builtin_amdgcn_make_buffer_rsrc(O, 0, 0x7ffffff0, 0x00020000);
#pragma unroll
        for (int ai = 0; ai < 2; ++ai)
#pragma unroll
            for (int m = 0; m < 4; ++m) { const unsigned ro = (unsigned)((row0 + ai * HALF + m * 16) * ldc + col0) * 2u;
                float o[8];
#pragma unroll
                for (int n = 0; n < 2; ++n)
#pragma unroll
                    for (int j = 0; j < 4; ++j) o[n * 4 + j] = silu_f(acc[ai][0][m][n][j]) * acc[ai][1][m][n][j];
                u32x4 w; w.x = cvt_pk_bf16(o[0], o[1]); w.y = cvt_pk_bf16(o[2], o[3]); w.z = cvt_pk_bf16(o[4], o[5]); w.w = cvt_pk_bf16(o[6], o[7]);
                __builtin_amdgcn_raw_buffer_store_b128(w, rs, ro, 0, 16); }
    }
};
struct EpiLora {
    static constexpr bool PERM = true;
    bf16_t* OMD; bf16_t* ASIG; bf16_t* G; const float* w0; const float* a0;
    template <int KIND> __device__ __forceinline__ void body(const f32x4 (&acc)[2][2][4][2], bf16_t* O, const float* bias, int row0, int ch0) const {
#pragma unroll
        for (int bj = 0; bj < 2; ++bj)
#pragma unroll
            for (int ai = 0; ai < 2; ++ai)
#pragma unroll
                for (int m = 0; m < 4; ++m) { bf16_t* rowp = O + (size_t)(row0 + ai * HALF + m * 16) * 512 + ch0 + bj * HALF;
                    float o[8];
#pragma unroll
                    for (int n = 0; n < 2; ++n)
#pragma unroll
                        for (int j = 0; j < 4; ++j) { float v = acc[ai][bj][m][n][j];
                            if (KIND == 0) { v += bias[ch0 + bj * HALF + n * 4 + j]; const float e = 0.6065306597126334f * __builtin_amdgcn_rcpf(1.0f + __expf(-v));
                                float p = 1.0f / 40320.0f; p = -1.0f / 5040.0f + e * p; p = 1.0f / 720.0f + e * p; p = -1.0f / 120.0f + e * p; p = 1.0f / 24.0f + e * p; p = -1.0f / 6.0f + e * p; p = 0.5f + e * p; p = 1.0f - e * p;
                                v = e * p; }
                            else if (KIND == 1) { v += bias[ch0 + bj * HALF + n * 4 + j]; v = __builtin_amdgcn_rcpf(1.0f + __expf(-v)); }
                            o[n * 4 + j] = v; }
                    u32x4 w; w.x = cvt_pk_bf16(o[0], o[1]); w.y = cvt_pk_bf16(o[2], o[3]); w.z = cvt_pk_bf16(o[4], o[5]); w.w = cvt_pk_bf16(o[6], o[7]);
                    *(u32x4*)rowp = w; __builtin_amdgcn_sched_barrier(0); }
    }
    __device__ __forceinline__ void operator()(const f32x4 (&acc)[2][2][4][2], const Unit& u, int wr, int wc, int fr, int fq) const {
        const int kind = u.pn >> 1;
        const int row0 = u.pm * BM + wr * 64 + fr; const int ch0 = (u.pn & 1) * BM + wc * 32 + 8 * fq;
        if (kind == 0) body<0>(acc, OMD, w0, row0, ch0); else if (kind == 1) body<1>(acc, ASIG, a0, row0, ch0); else body<2>(acc, G, a0, row0, ch0);
    }
};

template <class Epi, class Sched>
__device__ __forceinline__ void gemm_phase(PG8_LAS unsigned char* lds, const Gemm g, const Sched& S, const Epi& E, const int wv) {
    const int tid = fresh_tid(wv), wid = __builtin_amdgcn_readfirstlane(tid >> 6), lane = tid & 63, wr = wid >> 2, wc = wid & 3, fr = lane & 15, fq = lane >> 4;
    const int K = g.K;
    unsigned voffA[2], voffB[2];
#pragma unroll
    for (int i = 0; i < 2; ++i) { int R, C; stage_rc(tid * 16 + i * 8192, R, C); const int Rb = Epi::PERM ? ((R & ~31) + perm32(R & 31)) : R;
        voffA[i] = (unsigned)(R * K + C) * 2u; voffB[i] = (unsigned)(Rb * K + C) * 2u; }
    const size_t kstep = (size_t)(BK * 2);
    const size_t hstep = (size_t)HALF * K * 2;
    const size_t tstep = 2 * hstep;
    const unsigned ldsw = (unsigned)wid * 1024u;
    const int aoff = lds_byte(wr * 64 + fr, fq * 8), boff = lds_byte(wc * 32 + fr, fq * 8);
#define PG8_SA(b, h) (((b) * 2 + (h)) * HTB)
#define PG8_SB(b, h) ((4 + (b) * 2 + (h)) * HTB)
#define PG8_STAGE(bufoff, gbase, voff) do { _Pragma("unroll") for (int _i = 0; _i < 2; ++_i) \
        __builtin_amdgcn_global_load_lds((const unsigned*)((const char*)(gbase) + (voff)[_i]), (PG8_LAS unsigned*)(lds + (bufoff) + ldsw + _i * 8192), 16, 0, 0); } while (0)
#define PG8_LDA(dst, b, h) do { _Pragma("unroll") for (int m = 0; m < 4; ++m) _Pragma("unroll") for (int k = 0; k < 2; ++k) dst[m][k] = *(const PG8_LAS bf16x8*)(lds + PG8_SA(b, h) + aoff + m * 2048 + k * 1024); } while (0)
#define PG8_LDB(dst, b, h) do { _Pragma("unroll") for (int n = 0; n < 2; ++n) _Pragma("unroll") for (int k = 0; k < 2; ++k) dst[n][k] = *(const PG8_LAS bf16x8*)(lds + PG8_SB(b, h) + boff + n * 2048 + k * 1024); } while (0)
#define PG8_MMA(ai, bj, At, Bt) do { __builtin_amdgcn_s_setprio(1); _Pragma("unroll") for (int m = 0; m < 4; ++m) _Pragma("unroll") for (int n = 0; n < 2; ++n) _Pragma("unroll") for (int k = 0; k < 2; ++k) \
        acc[ai][bj][m][n] = __builtin_amdgcn_mfma_f32_16x16x32_bf16(Bt[n][k], At[m][k], acc[ai][bj][m][n], 0, 0, 0); __builtin_amdgcn_s_setprio(0); } while (0)
#define PG8_WAIT_V(n) asm volatile("s_waitcnt vmcnt(" #n ")" ::: "memory")
#define PG8_WAIT_L(n) asm volatile("s_waitcnt lgkmcnt(" #n ")" ::: "memory")
#define PG8_BAR __builtin_amdgcn_s_barrier()
#define PG8_SCHED __builtin_amdgcn_sched_barrier(0)
    Unit cur, nxt; int ui = 0;
    if (!S.next(0, cur)) return;
    f32x4 acc[2][2][4][2];
#pragma unroll
    for (int a = 0; a < 2; ++a)
#pragma unroll
        for (int b = 0; b < 2; ++b)
#pragma unroll
            for (int m = 0; m < 4; ++m)
#pragma unroll
                for (int n = 0; n < 2; ++n) acc[a][b][m][n] = (f32x4){0.f, 0.f, 0.f, 0.f};
    bf16x8 At[4][2], B0[2][2], B1[2][2];
    const char* cA = (const char*)g.A + (size_t)cur.pm * tstep + (size_t)cur.k0 * kstep; const char* cB = (const char*)g.Bt + (size_t)cur.pn * tstep + (size_t)cur.k0 * kstep;
    S.a_ready(cur);
    PG8_STAGE(PG8_SB(0, 0), cB, voffB); PG8_STAGE(PG8_SA(0, 0), cA, voffA); PG8_STAGE(PG8_SB(0, 1), cB + hstep, voffB); PG8_STAGE(PG8_SA(0, 1), cA + hstep, voffA);
    if (wr == 1) PG8_BAR;
    PG8_WAIT_V(4); PG8_BAR;
    PG8_STAGE(PG8_SB(1, 0), cB + kstep, voffB); PG8_STAGE(PG8_SA(1, 0), cA + kstep, voffA); PG8_STAGE(PG8_SB(1, 1), cB + hstep + kstep, voffB);
    PG8_WAIT_V(6); PG8_BAR;
    for (;;) {
        const bool has_next = S.next(ui + 1, nxt);
        const char* nA = has_next ? (const char*)g.A + (size_t)nxt.pm * tstep + (size_t)nxt.k0 * kstep : cA; const char* nB = has_next ? (const char*)g.Bt + (size_t)nxt.pn * tstep + (size_t)nxt.k0 * kstep : cB;
        const int nt = cur.nkt;
        for (int t = 0; t < nt; t += 2) {
            const bool last = (t == nt - 2);
            const char* a1 = cA + (size_t)(t + 1) * kstep;
            const char* a2 = last ? nA : cA + (size_t)(t + 2) * kstep; const char* b2 = last ? nB : cB + (size_t)(t + 2) * kstep;
            const char* a3 = a2 + kstep; const char* b3 = b2 + kstep;
            if (last && has_next) S.a_ready(nxt);
            PG8_LDB(B0, 0, 0); PG8_SCHED; PG8_LDA(At, 0, 0); PG8_STAGE(PG8_SA(1, 1), a1 + hstep, voffA);
            PG8_WAIT_L(8); PG8_BAR; PG8_WAIT_L(0); PG8_MMA(0, 0, At, B0); PG8_BAR; PG8_SCHED;
            PG8_LDB(B1, 0, 1); PG8_STAGE(PG8_SB(0, 0), b2, voffB);
            PG8_BAR; PG8_WAIT_L(0); PG8_MMA(0, 1, At, B1); PG8_BAR;
            PG8_LDA(At, 0, 1); PG8_STAGE(PG8_SA(0, 0), a2, voffA);
            PG8_BAR; PG8_WAIT_L(0); PG8_MMA(1, 0, At, B0); PG8_BAR; PG8_SCHED;
            PG8_STAGE(PG8_SB(0, 1), b2 + hstep, voffB);
            PG8_WAIT_V(6); PG8_BAR; PG8_MMA(1, 1, At, B1); PG8_BAR;
            PG8_LDB(B0, 1, 0); PG8_SCHED; PG8_LDA(At, 1, 0); PG8_STAGE(PG8_SA(0, 1), a2 + hstep, voffA);
            PG8_WAIT_L(8); PG8_BAR; PG8_WAIT_L(0); PG8_MMA(0, 0, At, B0); PG8_BAR; PG8_SCHED;
            PG8_LDB(B1, 1, 1); PG8_STAGE(PG8_SB(1, 0), b3, voffB);
            PG8_BAR; PG8_WAIT_L(0); PG8_MMA(0, 1, At, B1); PG8_BAR;
            PG8_LDA(At, 1, 1); PG8_STAGE(PG8_SA(1, 0), a3, voffA);
            PG8_BAR; PG8_WAIT_L(0); PG8_MMA(1, 0, At, B0); PG8_BAR; PG8_SCHED;
            PG8_STAGE(PG8_SB(1, 1), b3 + hstep, voffB);
            PG8_WAIT_V(6); PG8_BAR; PG8_MMA(1, 1, At, B1); PG8_BAR;
        }
        { const int l2 = fresh_tid(wv) & 63; E(acc, cur, wr, wc, l2 & 15, l2 >> 4); } S.done(cur);
        if (!has_next) break;
#pragma unroll
        for (int a = 0; a < 2; ++a)
#pragma unroll
            for (int b = 0; b < 2; ++b)
#pragma unroll
                for (int m = 0; m < 4; ++m)
#pragma unroll
                    for (int n = 0; n < 2; ++n) acc[a][b][m][n] = (f32x4){0.f, 0.f, 0.f, 0.f};
        cur = nxt; cA = nA; cB = nB; ++ui;
    }
    PG8_WAIT_V(0);
    if (wr == 0) PG8_BAR;
    PG8_BAR;
#undef PG8_SA
#undef PG8_SB
#undef PG8_STAGE
#undef PG8_LDA
#undef PG8_LDB
#undef PG8_MMA
#undef PG8_WAIT_V
#undef PG8_WAIT_L
#undef PG8_BAR
#undef PG8_SCHED
}
}

using pg8::bf16_t; using pg8::f32x4; using pg8::bf16x8; using pg8::u32x4; using pg8::u32x2;
#define LAS __attribute__((address_space(3)))

constexpr int D = 1024, DFF = 2816, NGU = 5632, NCOLS = 3840;
constexpr int MP = 16384, MS = 512, MT = 16896, MIN_ = 17152;
constexpr int LDS_BYTES = 147456;
constexpr size_t O_SHP = 17301504, O_WKP = O_SHP + 8192, O_RTP = O_WKP + 262144, O_SHS = O_RTP + 524288, O_WKS = O_SHS + 131072, O_RTS = O_WKS + 4194304;
constexpr size_t WS_ROPE = 16384;
constexpr size_t WS_WL   = WS_ROPE + 1050624;
constexpr size_t WS_WOUT = WS_WL + 786432;
constexpr size_t WS_WIN  = WS_WOUT + 2097152;
constexpr size_t WS_WGU  = WS_WIN + 7864320;
constexpr size_t WS_WD   = WS_WGU + 11534336;
constexpr size_t WS_XN   = WS_WD + 5767168;
constexpr size_t WS_BIG  = WS_XN + 35127296;
constexpr size_t WS_FO   = WS_BIG + 95158272;
constexpr size_t WS_YS   = WS_BIG + 131727360;
constexpr size_t WS_LA   = WS_YS + 17301504;
constexpr size_t WS_OMD  = WS_BIG + 164364288;
constexpr size_t WS_ASIG = WS_OMD + 17301504;
constexpr size_t WS_END  = WS_ASIG + 17301504;
static_assert(WS_LA + 8650752 <= WS_OMD, "mixer overlays");
static_assert(WS_END <= 268435456, "workspace");

struct Params {
    const float *x_prompt, *x_sample, *state_shift, *state_wkv, *state_ret, *norm_g, *f1g, *f1u, *f1d, *w_in, *mu, *w0, *w2, *a0, *a2, *g2, *k_k, *k_a, *r_k, *lnx_w, *lnx_b, *gn_w, *w_out, *f2g, *f2u, *f2d;
    float* out; unsigned char* ws;
};
#define CAS __attribute__((address_space(4)))
typedef const CAS Params& PR;

__device__ __forceinline__ float bf2f(unsigned b) { return __uint_as_float(b << 16); }
__device__ __forceinline__ bf16_t f2bf(float f) { unsigned u = __float_as_uint(f); u += 0x7FFFu + ((u >> 16) & 1u); return (bf16_t)(u >> 16); }
__device__ __forceinline__ float lo_bf(unsigned x) { return __uint_as_float(x << 16); }
__device__ __forceinline__ float hi_bf(unsigned x) { return __uint_as_float(x & 0xffff0000u); }
template <int CTRL> __device__ __forceinline__ float dppf(float v) { return __int_as_float(__builtin_amdgcn_update_dpp(0, __float_as_int(v), CTRL, 0xF, 0xF, false)); }
__device__ __forceinline__ float row16_sum(float v) { v += dppf<0xB1>(v); v += dppf<0x4E>(v); v += dppf<0x141>(v); v += dppf<0x140>(v); return v; }
__device__ __forceinline__ float wave_sum(float v) { v = row16_sum(v); const int i = __float_as_int(v);
    return __int_as_float(__builtin_amdgcn_readlane(i, 0)) + __int_as_float(__builtin_amdgcn_readlane(i, 16)) + __int_as_float(__builtin_amdgcn_readlane(i, 32)) + __int_as_float(__builtin_amdgcn_readlane(i, 48)); }
__device__ __forceinline__ float quad_sum(float v) { v += dppf<0xB1>(v); v += dppf<0x4E>(v); return v; }
__device__ __forceinline__ float sigmoid_f(float x) { return __builtin_amdgcn_rcpf(1.0f + __expf(-x)); }


#define XB_TMO      128
#define XB_XCNT(j)  (256  + 64 * (j))
#define XB_XSUB(j)  (1280 + 64 * (j))
#define XB_XGEN(j)  (2304 + 64 * (j))
#define XB_TOP      3328
#define XB_TOPGEN   3392
#define XCD_BAR_WORDS 3456
#define XB_SPIN_CAP (1u << 18)
__device__ __forceinline__ unsigned xb_ld(unsigned* p)              { return __hip_atomic_load(p, __ATOMIC_RELAXED, __HIP_MEMORY_SCOPE_AGENT); }
__device__ __forceinline__ unsigned xb_add(unsigned* p, unsigned v) { return __hip_atomic_fetch_add(p, v, __ATOMIC_RELAXED, __HIP_MEMORY_SCOPE_AGENT); }
__device__ __forceinline__ unsigned xb_xcc_id() { return (unsigned)__builtin_amdgcn_s_getreg((3 << 11) | 20) & 0xFu; }
#define XB_SPIN(cond, bar) do { unsigned _sp = 0; while (cond) { __builtin_amdgcn_s_sleep(1); \
    if ((++_sp & 255u) == 0u) { if (xb_ld(&(bar)[XB_TMO])) break; if (_sp > XB_SPIN_CAP) { atomicAdd(&(bar)[XB_TMO], 1u); break; } } } } while (0)
struct XcdBarrier { unsigned* bar; unsigned x; volatile LAS unsigned* st; };
__device__ __forceinline__ XcdBarrier xcd_barrier_post(unsigned* bar, volatile LAS unsigned* st) {
    XcdBarrier b; b.bar = bar; b.x = xb_xcc_id(); b.st = st;
    return b;
}
__device__ __forceinline__ void xcd_barrier_complete(unsigned* bar, unsigned x, unsigned& nloc, unsigned& nx) {
    const unsigned G = gridDim.x * gridDim.y * gridDim.z;
    unsigned sum, cnt, mine, sp = 0u;
    for (;;) {
        sum = 0u; cnt = 0u; mine = 0u;
#pragma unroll
        for (unsigned j = 0; j < 16; ++j) { const unsigned c = xb_ld(&bar[XB_XCNT(j)]); sum += c; cnt += (c > 0u) ? 1u : 0u; mine = (j == x) ? c : mine; }
        if (sum == G) break;
        __builtin_amdgcn_s_sleep(1);
        if ((++sp & 255u) == 0u) { if (xb_ld(&bar[XB_TMO])) break; if (sp > XB_SPIN_CAP) { atomicAdd(&bar[XB_TMO], 1u); break; } }
    }
    nloc = mine > 0u ? mine : 1u; nx = cnt > 0u ? cnt : 1u;
}
__device__ __forceinline__ void xcd_barrier(unsigned* barw, volatile LAS unsigned* stw, const int wv) {
    XcdBarrier b; b.bar = barw; b.x = xb_xcc_id(); b.st = stw;
    asm volatile("s_waitcnt vmcnt(0)" ::: "memory");
    __syncthreads();
    if (fresh_tid(wv) == 0) {
        unsigned* bar = b.bar;
        __builtin_amdgcn_s_waitcnt(0);
        unsigned nloc = b.st[0], nx = b.st[1];
        if (nloc == 0u) { xcd_barrier_complete(bar, b.x, nloc, nx); b.st[0] = nloc; b.st[1] = nx; }
        const unsigned old = xb_add(&bar[XB_XSUB(b.x)], 1u);
        const unsigned gen = old / nloc;
        if (old + 1u == (gen + 1u) * nloc) {
            __builtin_amdgcn_fence(__ATOMIC_RELEASE, "agent");
            asm volatile("s_waitcnt vmcnt(0)" ::: "memory");
            const unsigned og = xb_add(&bar[XB_TOP], 1u);
            const unsigned tg = og / nx;
            if (og + 1u == (tg + 1u) * nx) xb_add(&bar[XB_TOPGEN], 1u);
            else XB_SPIN(xb_ld(&bar[XB_TOPGEN]) == tg, bar);
            __builtin_amdgcn_fence(__ATOMIC_ACQUIRE, "agent");
            xb_add(&bar[XB_XGEN(b.x)], 1u);
            asm volatile("s_waitcnt vmcnt(0)" ::: "memory");
        } else {
            XB_SPIN(xb_ld(&bar[XB_XGEN(b.x)]) == gen, bar);
            __builtin_amdgcn_fence(__ATOMIC_ACQUIRE, "agent");
            asm volatile("s_waitcnt vmcnt(0)" ::: "memory");
        }
    }
    __syncthreads();
}


#define DPP2(x, y, CTRL, NOP) asm volatile(NOP "\n\tv_add_f32_dpp %0, %0, %0 " CTRL " row_mask:0xf bank_mask:0xf bound_ctrl:1\n\tv_add_f32_dpp %1, %1, %1 " CTRL " row_mask:0xf bank_mask:0xf bound_ctrl:1" : "+v"(x), "+v"(y))
#define DPP4(x, y, z, w, CTRL, NOP) asm volatile(NOP "\n\tv_add_f32_dpp %0, %0, %0 " CTRL " row_mask:0xf bank_mask:0xf bound_ctrl:1\n\tv_add_f32_dpp %1, %1, %1 " CTRL " row_mask:0xf bank_mask:0xf bound_ctrl:1\n\tv_add_f32_dpp %2, %2, %2 " CTRL " row_mask:0xf bank_mask:0xf bound_ctrl:1\n\tv_add_f32_dpp %3, %3, %3 " CTRL " row_mask:0xf bank_mask:0xf bound_ctrl:1" : "+v"(x), "+v"(y), "+v"(z), "+v"(w))
#define ROW16_SUM4(x, y, z, w) do { DPP4(x, y, z, w, "quad_perm:[1,0,3,2]", "s_nop 1"); DPP4(x, y, z, w, "quad_perm:[2,3,0,1]", ""); DPP4(x, y, z, w, "row_half_mirror", ""); DPP4(x, y, z, w, "row_mirror", ""); } while (0)
#define ROW16_SUM2(x, y) do { DPP2(x, y, "quad_perm:[1,0,3,2]", "s_nop 1"); DPP2(x, y, "quad_perm:[2,3,0,1]", "s_nop 0"); DPP2(x, y, "row_half_mirror", "s_nop 0"); DPP2(x, y, "row_mirror", "s_nop 0"); } while (0)
__device__ __forceinline__ int prev_row(int r) {
    if (r < MP) return (r & 2047) == 0 ? -1 : r - 1;
    const int s = r - MP; return (s & 3) == 0 ? MT + (s >> 2) : r - 1;
}

struct TDesc { const float* W; bf16_t* Bt; int K, N, k0, n0, brow0; };
__device__ __forceinline__ TDesc tconv_desc(const float* wg, const float* wu, const float* wd, const float* win, const float* wout, unsigned char* ws, int i) {
    TDesc d; int mode = 0, tile = i;
    if (i < 704) { d.W = wg; d.Bt = (bf16_t*)(ws + WS_WGU); d.K = 1024; d.N = DFF; mode = 1; }
    else if (i < 1408) { d.W = wu; d.Bt = (bf16_t*)(ws + WS_WGU); d.K = 1024; d.N = DFF; mode = 2; tile = i - 704; }
    else if (i < 2112) { d.W = wd; d.Bt = (bf16_t*)(ws + WS_WD); d.K = DFF; d.N = 1024; tile = i - 1408; }
    else if (i < 3072) { d.W = win; d.Bt = (bf16_t*)(ws + WS_WIN); d.K = 1024; d.N = NCOLS; tile = i - 2112; }
    else { d.W = wout; d.Bt = (bf16_t*)(ws + WS_WOUT); d.K = 1024; d.N = 1024; tile = i - 3072; }
    const int nkt = d.K / 64; const int kt = tile % nkt, nt = tile / nkt; d.k0 = kt * 64; d.n0 = nt * 64;
    d.brow0 = mode == 0 ? d.n0 : ((d.n0 >> 7) * 256 + (d.n0 & 127) + (mode == 2 ? 128 : 0));
    return d;
}
__device__ __forceinline__ void tconv_list(const float* wg, const float* wu, const float* wd, const float* win, const float* wout, unsigned char* ws, const int ntiles, LAS float* t, const int wv) {
    const int tid = fresh_tid(wv); const int G = gridDim.x;
    float cur[8], nxt[8];
    int i = blockIdx.x;
    if (i < ntiles) { const TDesc d = tconv_desc(wg, wu, wd, win, wout, ws, i);
#pragma unroll
        for (int e = 0; e < 8; ++e) { const int idx = e * 512 + tid, r = idx >> 6, c = idx & 63; cur[e] = __builtin_nontemporal_load(d.W + (size_t)(d.k0 + r) * d.N + d.n0 + c); } }
    for (; i < ntiles; i += G) {
        const TDesc d = tconv_desc(wg, wu, wd, win, wout, ws, i);
        { const TDesc dn = tconv_desc(wg, wu, wd, win, wout, ws, i + G < ntiles ? i + G : i);
#pragma unroll
            for (int e = 0; e < 8; ++e) { const int idx = e * 512 + tid, r = idx >> 6, c = idx & 63; nxt[e] = __builtin_nontemporal_load(dn.W + (size_t)(dn.k0 + r) * dn.N + dn.n0 + c); } }
#pragma unroll
        for (int e = 0; e < 8; ++e) { const int idx = e * 512 + tid, r = idx >> 6, c = idx & 63; t[r * 65 + c] = cur[e]; }
        __syncthreads();
#pragma unroll
        for (int e = 0; e < 4; ++e) { const int idx = e * 512 + tid, n = idx >> 5, kp = idx & 31;
            const unsigned w = pg8::cvt_pk_bf16(t[(2 * kp) * 65 + n], t[(2 * kp + 1) * 65 + n]);
            *(unsigned*)(d.Bt + (size_t)(d.brow0 + n) * d.K + d.k0 + 2 * kp) = w; }
        __syncthreads();
#pragma unroll
        for (int e = 0; e < 8; ++e) cur[e] = nxt[e];
    }
}

struct RowRaw { float4 xf[4]; u32x2 xb[4]; u32x2 fb[4]; };
__device__ __forceinline__ void rows_load(PR P, const int mode, const int row, const int lane, RowRaw& R) {
    if (mode <= 1) { const float* xin = P.x_prompt + (size_t)row * 1024;
#pragma unroll
        for (int q = 0; q < 4; ++q) { const f32x4 t_ = __builtin_nontemporal_load((const f32x4*)(xin + (q * 64 + lane) * 4)); R.xf[q] = make_float4(t_[0], t_[1], t_[2], t_[3]); } }
    else { const bf16_t* xb = (mode == 2 ? (const bf16_t*)P.out : (const bf16_t*)(P.ws + WS_FO + 34603008)) + (size_t)row * 1024;
#pragma unroll
        for (int q = 0; q < 4; ++q) R.xb[q] = __builtin_nontemporal_load((const u32x2*)(xb + (q * 64 + lane) * 4)); }
    if (mode != 0) { const bf16_t* FO = (const bf16_t*)(P.ws + WS_FO) + (size_t)row * 1024;
#pragma unroll
        for (int q = 0; q < 4; ++q) R.fb[q] = __builtin_nontemporal_load((const u32x2*)(FO + (q * 64 + lane) * 4)); }
}
__device__ __forceinline__ void rows_proc(PR P, const int mode, const int row, const int lane, float4 (&xv)[4], const float4 (&fo)[4], const float4 (&gp)[4], const float4 (&gn)[4]) {
    bf16_t* XN = (bf16_t*)(P.ws + WS_XN);
    if (mode != 0) {
        float ss = 0.f;
#pragma unroll
        for (int q = 0; q < 4; ++q) ss += fo[q].x * fo[q].x + fo[q].y * fo[q].y + fo[q].z * fo[q].z + fo[q].w * fo[q].w;
        ss = wave_sum(ss); const float r = rsqrtf(ss * (1.0f / 1024.0f) + 1e-6f) * (mode == 2 ? 1.0f : 0.5f);
#pragma unroll
        for (int q = 0; q < 4; ++q) {
            xv[q].x += fo[q].x * r * gp[q].x; xv[q].y += fo[q].y * r * gp[q].y; xv[q].z += fo[q].z * r * gp[q].z; xv[q].w += fo[q].w * r * gp[q].w;
            if (mode == 3) { const f32x4 t_ = {xv[q].x, xv[q].y, xv[q].z, xv[q].w}; __builtin_nontemporal_store(t_, (f32x4*)(P.out + (size_t)row * 1024 + (q * 64 + lane) * 4)); }
            else { bf16_t* xo = (mode == 1 ? (bf16_t*)P.out : (bf16_t*)(P.ws + WS_FO + 34603008)) + (size_t)row * 1024; u32x2 t; t.x = pg8::cvt_pk_bf16(xv[q].x, xv[q].y); t.y = pg8::cvt_pk_bf16(xv[q].z, xv[q].w);
                __builtin_nontemporal_store(t, (u32x2*)(xo + (q * 64 + lane) * 4)); } }
        if (mode == 3) return;
    }
    float ss2 = 0.f;
#pragma unroll
    for (int q = 0; q < 4; ++q) ss2 += xv[q].x * xv[q].x + xv[q].y * xv[q].y + xv[q].z * xv[q].z + xv[q].w * xv[q].w;
    ss2 = wave_sum(ss2); const float r2 = rsqrtf(ss2 * (1.0f / 1024.0f) + 1e-6f);
    float* sh = nullptr;
    if (mode == 1) { if (row < MP) { if ((row & 2047) == 2047) sh = P.out + O_SHP + (size_t)(row >> 11) * 1024; } else { const int s = row - MP; if ((s & 3) == 3) sh = P.out + O_SHS + (size_t)(s >> 2) * 1024; } }
#pragma unroll
    for (int q = 0; q < 4; ++q) {
        float4 hv; hv.x = xv[q].x * r2 * gn[q].x; hv.y = xv[q].y * r2 * gn[q].y; hv.z = xv[q].z * r2 * gn[q].z; hv.w = xv[q].w * r2 * gn[q].w;
        u32x2 w; w.x = pg8::cvt_pk_bf16(hv.x, hv.y); w.y = pg8::cvt_pk_bf16(hv.z, hv.w);
        *(u32x2*)(XN + (size_t)row * 1024 + (q * 64 + lane) * 4) = w;
        if (sh) *(float4*)(sh + (q * 64 + lane) * 4) = hv; }
}
__device__ __forceinline__ void rows_phase(PR P, const int mode, LAS float* ldsf, const int wv) {
    const int tid = fresh_tid(wv); const int lane = tid & 63; const int gw = blockIdx.x * 8 + (tid >> 6), nw = gridDim.x * 8;
    const float* gpost = P.norm_g + (mode == 1 ? 1 : (mode == 2 ? 3 : 5)) * 1024;
    const float* gnext = P.norm_g + (mode == 0 ? 0 : (mode == 1 ? 2 : 4)) * 1024;
    float4 gp[4], gn[4];
#pragma unroll
    for (int q = 0; q < 4; ++q) { gp[q] = *(const float4*)(gpost + (q * 64 + lane) * 4); gn[q] = *(const float4*)(gnext + (q * 64 + lane) * 4); }
    if (gw < MP) {
        const int last = gw + ((MP - 1 - gw) / nw) * nw;
        RowRaw R, N;
        rows_load(P, mode, gw, lane, R);
        for (int row = gw; row < MP; row += nw) {
            const int nrow = row + nw < MP ? row + nw : last;
            rows_load(P, mode, nrow, lane, N);
            float4 xv[4], fo[4];
#pragma unroll
            for (int q = 0; q < 4; ++q) {
                xv[q] = mode <= 1 ? R.xf[q] : make_float4(lo_bf(R.xb[q].x), hi_bf(R.xb[q].x), lo_bf(R.xb[q].y), hi_bf(R.xb[q].y));
                fo[q] = make_float4(lo_bf(R.fb[q].x), hi_bf(R.fb[q].x), lo_bf(R.fb[q].y), hi_bf(R.fb[q].y)); }
            rows_proc(P, mode, row, lane, xv, fo, gp, gn);
            R = N;
        }
    }
    {
        const int wid = tid >> 6, q = wid & 3, row = MP + 2 * (int)blockIdx.x + (wid >> 2), col = q * 256 + lane * 4;
        const bool act = row < MT;
        float4 xv = make_float4(0.f, 0.f, 0.f, 0.f), fo = xv;
        if (act) {
            if (mode <= 1) xv = *(const float4*)(P.x_sample + (size_t)(row - MP) * 1024 + col);
            else { const u32x2 tb = *(const u32x2*)((mode == 2 ? (const bf16_t*)P.out : (const bf16_t*)(P.ws + WS_FO + 34603008)) + (size_t)row * 1024 + col); xv = make_float4(lo_bf(tb.x), hi_bf(tb.x), lo_bf(tb.y), hi_bf(tb.y)); }
            if (mode != 0) { const int KS = mode == 2 ? 4 : 8; const float* sl = (const float*)(P.ws + WS_OMD) + (size_t)((((row - MP) >> 8) * 4 + q) * KS) * 65536 + (size_t)(row & 255) * 256 + lane * 4;
                float4 a = *(const float4*)sl;
                for (int p = 1; p < KS; ++p) { const float4 b = *(const float4*)(sl + (size_t)p * 65536); a.x += b.x; a.y += b.y; a.z += b.z; a.w += b.w; }
                fo = a; }
        }
        if (mode != 0) {
            const float ssp = wave_sum(fo.x * fo.x + fo.y * fo.y + fo.z * fo.z + fo.w * fo.w);
            __syncthreads(); if (lane == 0) ldsf[wid] = ssp; __syncthreads();
            const float ss = ldsf[wid & 4] + ldsf[(wid & 4) + 1] + ldsf[(wid & 4) + 2] + ldsf[(wid & 4) + 3];
            const float r = rsqrtf(ss * (1.0f / 1024.0f) + 1e-6f) * (mode == 2 ? 1.0f : 0.5f);
            const float4 g = *(const float4*)(gpost + col);
            xv.x += fo.x * r * g.x; xv.y += fo.y * r * g.y; xv.z += fo.z * r * g.z; xv.w += fo.w * r * g.w;
            if (act) { if (mode == 3) *(float4*)(P.out + (size_t)row * 1024 + col) = xv;
                else { u32x2 tb; tb.x = pg8::cvt_pk_bf16(xv.x, xv.y); tb.y = pg8::cvt_pk_bf16(xv.z, xv.w); *(u32x2*)((mode == 1 ? (bf16_t*)P.out : (bf16_t*)(P.ws + WS_FO + 34603008)) + (size_t)row * 1024 + col) = tb; } }
        }
        if (mode != 3) {
            const float s2p = wave_sum(xv.x * xv.x + xv.y * xv.y + xv.z * xv.z + xv.w * xv.w);
            __syncthreads(); if (lane == 0) ldsf[8 + wid] = s2p; __syncthreads();
            const float ss2 = ldsf[8 + (wid & 4)] + ldsf[8 + (wid & 4) + 1] + ldsf[8 + (wid & 4) + 2] + ldsf[8 + (wid & 4) + 3];
            const float r2 = rsqrtf(ss2 * (1.0f / 1024.0f) + 1e-6f);
            const float4 g = *(const float4*)(gnext + col);
            float4 hv; hv.x = xv.x * r2 * g.x; hv.y = xv.y * r2 * g.y; hv.z = xv.z * r2 * g.z; hv.w = xv.w * r2 * g.w;
            if (act) { u32x2 w; w.x = pg8::cvt_pk_bf16(hv.x, hv.y); w.y = pg8::cvt_pk_bf16(hv.z, hv.w);
                *(u32x2*)((bf16_t*)(P.ws + WS_XN) + (size_t)row * 1024 + col) = w;
                if (mode == 1) { const int sr = row - MP; if ((sr & 3) == 3) *(float4*)(P.out + O_SHS + (size_t)(sr >> 2) * 1024 + col) = hv; } }
        }
        __syncthreads();
    }
}

__device__ __forceinline__ void p0_prologue(PR P, LAS float* ldsf, const int wv) {
    const int tid = fresh_tid(wv); const size_t gt = (size_t)blockIdx.x * 512 + tid, nth = (size_t)gridDim.x * 512;
    { float* rc = (float*)(P.ws + WS_ROPE); float* rs = rc + 2052 * 64;
      for (size_t i = gt; i < 2052 * 64; i += nth) { const int p = (int)(i >> 6), f = (int)(i & 63); const int pos = p < 2048 ? p : 16384 + (p - 2048);
          double inv = 1.0; for (int q = 0; q < f; ++q) inv *= 0.8659643233600653;
          const double ang = (double)pos * inv; const double n = rint(ang * 0.15915494309189535); const double r = ang - n * 6.283185307179586;
          const double r2 = r * r; double s = 0.0, c = 0.0;
          for (int k = 14; k >= 0; --k) { s = s * (-r2 / (double)((2 * k + 2) * (2 * k + 3))) + 1.0; c = c * (-r2 / (double)((2 * k + 1) * (2 * k + 2))) + 1.0; }
          rc[i] = (float)c; rs[i] = (float)(s * r); } }
    { bf16_t* Wl = (bf16_t*)(P.ws + WS_WL);
      for (size_t i = gt; i < 1536 * 256; i += nth) { const int n = (int)(i >> 8), k = (int)(i & 255); float v = 0.f;
          if (n < 512) { if (k < 64) v = P.w2[k * 512 + n]; } else if (n < 1024) { if (k >= 64 && k < 128) v = P.a2[(k - 64) * 512 + (n - 512)]; } else { if (k >= 128) v = P.g2[(k - 128) * 512 + (n - 1024)]; }
          Wl[i] = f2bf(v); } }
    { bf16_t* XN = (bf16_t*)(P.ws + WS_XN);
      for (size_t i = gt; i < 256 * 1024; i += nth) { const int r = (int)(i >> 10); XN[(size_t)MT * 1024 + i] = r < 128 ? f2bf(P.state_shift[i]) : (bf16_t)0; } }
    tconv_list(P.f1g, P.f1u, P.f1d, P.w_in, P.w_out, P.ws, 3328, ldsf, wv);
    rows_phase(P, 0, ldsf, wv);
}

__device__ __forceinline__ void lora_prep(PR P, const int wv) {
    const int tid = fresh_tid(wv); const int lane = tid & 63; const int gw = blockIdx.x * 8 + (tid >> 6), nw = gridDim.x * 8;
    const bf16_t* PS = (const bf16_t*)(P.ws + WS_BIG); bf16_t* LA = (bf16_t*)(P.ws + WS_LA);
    const float4 mu = *(const float4*)(P.mu + 1536 + lane * 4); const int kind = lane >> 4;
    if (gw >= MT) return;
    const int last = gw + ((MT - 1 - gw) / nw) * nw;
    u32x2 c, p, nc, np;
    { const int pr = prev_row(gw); c = *(const u32x2*)(PS + (size_t)gw * NCOLS + 1536 + lane * 4); p = *(const u32x2*)(PS + (size_t)(pr >= 0 ? pr : gw) * NCOLS + 1536 + lane * 4); }
    for (int row = gw; row < MT; row += nw) {
        const int nrow = row + nw < MT ? row + nw : last; const int npr = prev_row(nrow);
        nc = *(const u32x2*)(PS + (size_t)nrow * NCOLS + 1536 + lane * 4); np = *(const u32x2*)(PS + (size_t)(npr >= 0 ? npr : nrow) * NCOLS + 1536 + lane * 4);
        if (prev_row(row) < 0) p = (u32x2){0u, 0u};
        float v[4]; const float cu[4] = {lo_bf(c.x), hi_bf(c.x), lo_bf(c.y), hi_bf(c.y)}, pv[4] = {lo_bf(p.x), hi_bf(p.x), lo_bf(p.y), hi_bf(p.y)}, m4[4] = {mu.x, mu.y, mu.z, mu.w};
#pragma unroll
        for (int j = 0; j < 4; ++j) { float x = cu[j] + (pv[j] - cu[j]) * m4[j];
            if (kind == 0) x = 1.0f - 2.0f * __builtin_amdgcn_rcpf(__expf(2.0f * x) + 1.0f); else if (kind >= 2) x = sigmoid_f(x);
            v[j] = x; }
        u32x2 w; w.x = pg8::cvt_pk_bf16(v[0], v[1]); w.y = pg8::cvt_pk_bf16(v[2], v[3]);
        *(u32x2*)(LA + (size_t)row * 256 + lane * 4) = w;
        c = nc; p = np;
    }
}

template <bool SAMPLE>
__device__ __forceinline__ void rwkv_unit(PR P, LAS float* lds, const int b, const int h, const int half, const int wv) {
    constexpr int T = SAMPLE ? 4 : 2048, TC = SAMPLE ? 4 : 32, NCH = T / TC;
    const int tid = fresh_tid(wv), lane = tid & 63, wid = tid >> 6;
    const bf16_t* PS = (const bf16_t*)(P.ws + WS_BIG); const bf16_t* OMD = (const bf16_t*)(P.ws + WS_OMD); const bf16_t* ASIG = (const bf16_t*)(P.ws + WS_ASIG);
    bf16_t* YS = (bf16_t*)(P.ws + WS_YS);
    const int row_base = SAMPLE ? MP + b * 4 : b * 2048;
    const int ltok = (tid - 256) >> 4, lcg = tid & 15; const bool lwave = tid >= 256; const int hch = h * 64 + lcg * 4;
    const float4 mur = *(const float4*)(P.mu + hch), muk = *(const float4*)(P.mu + 512 + hch), muv = *(const float4*)(P.mu + 1024 + hch);
    const float4 kk4 = *(const float4*)(P.k_k + hch), ka4 = *(const float4*)(P.k_a + hch);
    typedef float f32x2 __attribute__((ext_vector_type(2)));
    const int row0 = half * 32 + (wid & 3) * 8 + (lane >> 4) * 2, cgl = lane & 15, j0 = cgl * 4;
    f32x2 S[4];
#pragma unroll
    for (int c = 0; c < 4; ++c) S[c] = (f32x2){0.f, 0.f};
    float* sout = P.out + (SAMPLE ? O_WKS : O_WKP) + ((size_t)(b * 8 + h) * 64 + row0) * 64 + j0;
    if (SAMPLE && wid < 4) { const float* sp = P.state_wkv + ((size_t)(b * 8 + h) * 64 + row0) * 64 + j0; const float4 s0 = *(const float4*)sp, s1 = *(const float4*)(sp + 64);
        S[0] = (f32x2){s0.x, s1.x}; S[1] = (f32x2){s0.y, s1.y}; S[2] = (f32x2){s0.z, s1.z}; S[3] = (f32x2){s0.w, s1.w}; }
    LAS float* buf0 = lds; LAS float* buf1 = lds + TC * 384;
    u32x2 cr[2], ck[2], cv[2], pr[2], pk[2], pv[2], co[2], ca[2];
#define RW_LOAD1(c, U) do { if (lwave && ltok + 16 * (U) < TC) { const int t_ = (c) * TC + ltok + 16 * (U); const int row_ = row_base + t_; const int prow_ = SAMPLE ? (t_ == 0 ? MT + b : row_ - 1) : row_ - 1; \
        const bf16_t* cp_ = PS + (size_t)row_ * NCOLS + hch; cr[U] = *(const u32x2*)cp_; ck[U] = *(const u32x2*)(cp_ + 512); cv[U] = *(const u32x2*)(cp_ + 1024); \
        if (SAMPLE || t_ > 0) { const bf16_t* pp_ = PS + (size_t)prow_ * NCOLS + hch; pr[U] = *(const u32x2*)pp_; pk[U] = *(const u32x2*)(pp_ + 512); pv[U] = *(const u32x2*)(pp_ + 1024); } \
        else { pr[U] = (u32x2){0u, 0u}; pk[U] = pr[U]; pv[U] = pr[U]; } \
        co[U] = *(const u32x2*)(OMD + (size_t)row_ * 512 + hch); ca[U] = *(const u32x2*)(ASIG + (size_t)row_ * 512 + hch); } } while (0)
#define RW_LOAD(c) do { RW_LOAD1(c, 0); RW_LOAD1(c, 1); } while (0)
#define RW_MIX(cu, pv_, m) ((cu) + ((pv_) - (cu)) * (m))
#define RW_PROC1(dst, U) do { if (lwave && ltok + 16 * (U) < TC) { LAS float* d_ = (dst) + (ltok + 16 * (U)) * 384 + lcg * 4; \
        f32x4 r_, k_, v_, o_, a_; \
        r_[0] = RW_MIX(lo_bf(cr[U].x), lo_bf(pr[U].x), mur.x); r_[1] = RW_MIX(hi_bf(cr[U].x), hi_bf(pr[U].x), mur.y); r_[2] = RW_MIX(lo_bf(cr[U].y), lo_bf(pr[U].y), mur.z); r_[3] = RW_MIX(hi_bf(cr[U].y), hi_bf(pr[U].y), mur.w); \
        k_[0] = RW_MIX(lo_bf(ck[U].x), lo_bf(pk[U].x), muk.x); k_[1] = RW_MIX(hi_bf(ck[U].x), hi_bf(pk[U].x), muk.y); k_[2] = RW_MIX(lo_bf(ck[U].y), lo_bf(pk[U].y), muk.z); k_[3] = RW_MIX(hi_bf(ck[U].y), hi_bf(pk[U].y), muk.w); \
        v_[0] = RW_MIX(lo_bf(cv[U].x), lo_bf(pv[U].x), muv.x); v_[1] = RW_MIX(hi_bf(cv[U].x), hi_bf(pv[U].x), muv.y); v_[2] = RW_MIX(lo_bf(cv[U].y), lo_bf(pv[U].y), muv.z); v_[3] = RW_MIX(hi_bf(cv[U].y), hi_bf(pv[U].y), muv.w); \
        o_[0] = lo_bf(co[U].x); o_[1] = hi_bf(co[U].x); o_[2] = lo_bf(co[U].y); o_[3] = hi_bf(co[U].y); a_[0] = lo_bf(ca[U].x); a_[1] = hi_bf(ca[U].x); a_[2] = lo_bf(ca[U].y); a_[3] = hi_bf(ca[U].y); \
        f32x4 kk_; kk_[0] = k_[0] * kk4.x; kk_[1] = k_[1] * kk4.y; kk_[2] = k_[2] * kk4.z; kk_[3] = k_[3] * kk4.w; \
        float ss_ = kk_[0] * kk_[0] + kk_[1] * kk_[1] + kk_[2] * kk_[2] + kk_[3] * kk_[3]; ss_ = row16_sum(ss_); \
        const float inv_ = __builtin_amdgcn_rcpf(fmaxf(__builtin_amdgcn_sqrtf(ss_), 1e-12f)); kk_ = kk_ * inv_; \
        f32x4 kn_; kn_[0] = k_[0] * (1.0f + (a_[0] - 1.0f) * ka4.x); kn_[1] = k_[1] * (1.0f + (a_[1] - 1.0f) * ka4.y); kn_[2] = k_[2] * (1.0f + (a_[2] - 1.0f) * ka4.z); kn_[3] = k_[3] * (1.0f + (a_[3] - 1.0f) * ka4.w); \
        *(LAS f32x4*)(d_) = r_; *(LAS f32x4*)(d_ + 64) = o_; *(LAS f32x4*)(d_ + 128) = kn_; *(LAS f32x4*)(d_ + 192) = -kk_; *(LAS f32x4*)(d_ + 256) = kk_ * a_; *(LAS f32x4*)(d_ + 320) = v_; } } while (0)
#define RW_PROC(dst) do { RW_PROC1(dst, 0); RW_PROC1(dst, 1); } while (0)
    RW_LOAD(0); RW_PROC(buf0); __syncthreads();
    for (int c = 0; c < NCH; ++c) {
        LAS float* cur = (c & 1) ? buf1 : buf0; LAS float* nxt = (c & 1) ? buf0 : buf1;
        if (c + 1 < NCH) RW_LOAD(c + 1);
        if (wid < 4) {
            constexpr int GS = SAMPLE ? 4 : 16;
            for (int g = 0; g < TC / GS; ++g) {
                float yk0 = 0.f, yk1 = 0.f;
                const LAS float* q0 = cur + (g * GS) * 384;
                f32x4 r4 = *(const LAS f32x4*)(q0 + j0), o4 = *(const LAS f32x4*)(q0 + 64 + j0), k4 = *(const LAS f32x4*)(q0 + 128 + j0), a4 = *(const LAS f32x4*)(q0 + 192 + j0), b4 = *(const LAS f32x4*)(q0 + 256 + j0);
                f32x2 v2 = *(const LAS f32x2*)(q0 + 320 + row0);
                float py0 = 0.f, py1 = 0.f;
#pragma unroll
                for (int tt = 0; tt < GS; ++tt) {
                    const LAS float* qn = q0 + (tt + 1 < GS ? tt + 1 : tt) * 384;
                    const f32x4 nr4 = *(const LAS f32x4*)(qn + j0), no4 = *(const LAS f32x4*)(qn + 64 + j0), nk4 = *(const LAS f32x4*)(qn + 128 + j0), na4 = *(const LAS f32x4*)(qn + 192 + j0), nb4 = *(const LAS f32x4*)(qn + 256 + j0);
                    const f32x2 nv2 = *(const LAS f32x2*)(qn + 320 + row0);
                    f32x2 sa = (S[0] * a4[0] + S[1] * a4[1]) + (S[2] * a4[2] + S[3] * a4[3]);
                    float sx = sa.x, sy = sa.y; ROW16_SUM4(sx, sy, py0, py1); sa = (f32x2){sx, sy};
                    if (tt > 0) { yk0 = cgl == tt - 1 ? py0 : yk0; yk1 = cgl == tt - 1 ? py1 : yk1; }
#pragma unroll
                    for (int c = 0; c < 4; ++c) { f32x2 t = S[c] - S[c] * o4[c]; t = t + sa * b4[c]; S[c] = t + v2 * k4[c]; }
                    const f32x2 y = (S[0] * r4[0] + S[1] * r4[1]) + (S[2] * r4[2] + S[3] * r4[3]);
                    py0 = y.x; py1 = y.y;
                    r4 = nr4; o4 = no4; k4 = nk4; a4 = na4; b4 = nb4; v2 = nv2;
                }
                ROW16_SUM2(py0, py1); yk0 = cgl == GS - 1 ? py0 : yk0; yk1 = cgl == GS - 1 ? py1 : yk1;
                if (cgl < GS) *(unsigned*)(YS + (size_t)(row_base + c * TC + g * GS + cgl) * 512 + h * 64 + row0) = pg8::cvt_pk_bf16(yk0, yk1);
            }
        }
        if (c + 1 < NCH) RW_PROC(nxt);
        __syncthreads();
    }
    if (wid < 4) { *(float4*)sout = make_float4(S[0].x, S[1].x, S[2].x, S[3].x); *(float4*)(sout + 64) = make_float4(S[0].y, S[1].y, S[2].y, S[3].y); }
#undef RW_LOAD
#undef RW_PROC
#undef RW_LOAD1
#undef RW_PROC1
#undef RW_MIX
}

__device__ __forceinline__ void ret_sample_unit(PR P, LAS float* lds, const int b, const int h, const int wv) {
    const int tid = fresh_tid(wv), lane = tid & 63, wid = tid >> 6;
    const bf16_t* PS = (const bf16_t*)(P.ws + WS_BIG); bf16_t* Y = (bf16_t*)(P.ws + WS_XN);
    const float* rc = (const float*)(P.ws + WS_ROPE); const float* rs = rc + 2052 * 64;
    LAS float* q = lds; LAS float* k = lds + 512; LAS float* v = lds + 1024; LAS float* Pm = lds + 1536; LAS float* y2p = lds + 1600; LAS float* red = lds + 1600 + 2048;
    const float lg2 = log2f(1.0f - exp2f(-5.0f - (float)h));
    const int row0 = MP + b * 4;
    { const int t = (tid & 255) >> 6, f = tid & 63; const bf16_t* src = PS + (size_t)(row0 + t) * NCOLS + 1792 + h * 128;
      if (tid < 256) { const float cs = rc[(2048 + t) * 64 + f], sn = rs[(2048 + t) * 64 + f];
          const float q1 = bf2f(src[f]), q2 = bf2f(src[f + 64]); q[t * 128 + f] = q1 * cs - q2 * sn; q[t * 128 + f + 64] = q1 * sn + q2 * cs;
          const float k1 = bf2f(src[512 + f]), k2 = bf2f(src[512 + f + 64]); k[t * 128 + f] = (k1 * cs - k2 * sn) * 0.08838834764831845f; k[t * 128 + f + 64] = (k1 * sn + k2 * cs) * 0.08838834764831845f; }
      else { v[t * 128 + f] = bf2f(src[1024 + f]); v[t * 128 + f + 64] = bf2f(src[1024 + f + 64]); } }
    __syncthreads();
    if (wid == 0) { const int pi = lane >> 4, pj = (lane >> 2) & 3, part = lane & 3; float s = 0.f;
        for (int d = part * 32; d < part * 32 + 32; ++d) s += q[pi * 128 + d] * k[pj * 128 + d];
        s = quad_sum(s); if (part == 0) Pm[pi * 4 + pj] = pi >= pj ? s * exp2f(lg2 * (float)(pi - pj)) : 0.f; }
    { const int e = tid & 127, dg = tid >> 7; const float c4 = exp2f(lg2 * 4.0f), g3 = exp2f(lg2 * 3.0f), g2_ = exp2f(lg2 * 2.0f), g1 = exp2f(lg2);
      const float v0 = v[e] * g3, v1 = v[128 + e] * g2_, v2 = v[256 + e] * g1, v3 = v[384 + e];
      const float* S0 = P.state_ret + ((size_t)(b * 4 + h) * 128) * 128 + e; float* So = P.out + O_RTS + ((size_t)(b * 4 + h) * 128) * 128 + e;
      float a0 = 0.f, a1 = 0.f, a2 = 0.f, a3 = 0.f;
      float sv[32];
#pragma unroll
      for (int x = 0; x < 32; ++x) sv[x] = S0[(size_t)(dg * 32 + x) * 128];
#pragma unroll
      for (int x = 0; x < 32; ++x) { const int d = dg * 32 + x; const float s = sv[x];
          a0 = fmaf(q[d], s, a0); a1 = fmaf(q[128 + d], s, a1); a2 = fmaf(q[256 + d], s, a2); a3 = fmaf(q[384 + d], s, a3);
          So[(size_t)d * 128] = s * c4 + k[d] * v0 + k[128 + d] * v1 + k[256 + d] * v2 + k[384 + d] * v3; }
      y2p[(dg * 4 + 0) * 128 + e] = a0; y2p[(dg * 4 + 1) * 128 + e] = a1; y2p[(dg * 4 + 2) * 128 + e] = a2; y2p[(dg * 4 + 3) * 128 + e] = a3; }
    __syncthreads();
    { const int i = tid >> 7, e = tid & 127;
      float y = (y2p[(0 + i) * 128 + e] + y2p[(4 + i) * 128 + e] + y2p[(8 + i) * 128 + e] + y2p[(12 + i) * 128 + e]) * exp2f(lg2 * (float)(i + 1));
#pragma unroll
      for (int j = 0; j < 4; ++j) y = fmaf(Pm[i * 4 + j], v[j * 128 + e], y);
      float s = wave_sum(y); if (lane == 0) red[wid] = s; __syncthreads();
      const float mean = (red[i * 2] + red[i * 2 + 1]) * (1.0f / 128.0f); const float dlt = y - mean;
      float s2 = wave_sum(dlt * dlt); if (lane == 0) red[8 + wid] = s2; __syncthreads();
      const float var = (red[8 + i * 2] + red[8 + i * 2 + 1]) * (1.0f / 128.0f);
      const float g = bf2f(PS[(size_t)(row0 + i) * NCOLS + 1792 + 1536 + h * 128 + e]);
      const float o = dlt * rsqrtf(var + 1e-5f) * P.gn_w[h * 128 + e] * (g * __builtin_amdgcn_rcpf(1.0f + __expf(-g)));
      Y[(size_t)(row0 + i) * 1024 + 512 + h * 128 + e] = f2bf(o); }
    __syncthreads();
}

__device__ __forceinline__ bf16_t* kvb_ptr(unsigned char* ws, int bh) { return (bf16_t*)(bh < 29 ? ws + WS_LA + (size_t)bh * 524288 : ws + WS_WIN + 17301504 + (size_t)(bh - 29) * 524288); }
constexpr int RS = 136, BUFE = 128 * RS;

template <bool WITH_K>
__device__ __forceinline__ void ret_load_qk(PR P, LAS bf16_t* QP, LAS bf16_t* KB, unsigned (&kth)[4][4], const int tidv, const int row0, const int n, const int h, const float kd0, const float g32) {
    const bf16_t* PS = (const bf16_t*)(P.ws + WS_BIG); const float* rc = (const float*)(P.ws + WS_ROPE); const float* rs = rc + 2052 * 64;
    float kd = kd0;
#pragma unroll
    for (int it = 0; it < 4; ++it) { const int idx = it * 512 + tidv, i = idx >> 4, f = (idx & 15) * 4;
        const bf16_t* src = PS + (size_t)(row0 + i) * NCOLS + 1792 + h * 128;
        const u32x2 q1 = *(const u32x2*)(src + f), q2 = *(const u32x2*)(src + 64 + f);
        u32x2 k1 = (u32x2){0u, 0u}, k2 = k1; if (WITH_K) { k1 = *(const u32x2*)(src + 512 + f); k2 = *(const u32x2*)(src + 576 + f); }
        const float4 cs = *(const float4*)(rc + (size_t)(n * 128 + i) * 64 + f), sn = *(const float4*)(rs + (size_t)(n * 128 + i) * 64 + f);
        const float c4[4] = {cs.x, cs.y, cs.z, cs.w}, s4[4] = {sn.x, sn.y, sn.z, sn.w};
        const float qa[4] = {lo_bf(q1.x), hi_bf(q1.x), lo_bf(q1.y), hi_bf(q1.y)}, qb[4] = {lo_bf(q2.x), hi_bf(q2.x), lo_bf(q2.y), hi_bf(q2.y)};
        float qo1[4], qo2[4];
#pragma unroll
        for (int x = 0; x < 4; ++x) { qo1[x] = qa[x] * c4[x] - qb[x] * s4[x]; qo2[x] = qa[x] * s4[x] + qb[x] * c4[x]; }
        u32x2 w; w.x = pg8::cvt_pk_bf16(qo1[0], qo1[1]); w.y = pg8::cvt_pk_bf16(qo1[2], qo1[3]); *(LAS u32x2*)(QP + i * RS + f) = w;
        w.x = pg8::cvt_pk_bf16(qo2[0], qo2[1]); w.y = pg8::cvt_pk_bf16(qo2[2], qo2[3]); *(LAS u32x2*)(QP + i * RS + 64 + f) = w;
        if (WITH_K) {
            const float ka[4] = {lo_bf(k1.x), hi_bf(k1.x), lo_bf(k1.y), hi_bf(k1.y)}, kb[4] = {lo_bf(k2.x), hi_bf(k2.x), lo_bf(k2.y), hi_bf(k2.y)};
            float ko1[4], ko2[4];
#pragma unroll
            for (int x = 0; x < 4; ++x) { ko1[x] = (ka[x] * c4[x] - kb[x] * s4[x]) * 0.08838834764831845f; ko2[x] = (ka[x] * s4[x] + kb[x] * c4[x]) * 0.08838834764831845f; }
            w.x = pg8::cvt_pk_bf16(ko1[0], ko1[1]); w.y = pg8::cvt_pk_bf16(ko1[2], ko1[3]); *(LAS u32x2*)(KB + i * RS + f) = w;
            w.x = pg8::cvt_pk_bf16(ko2[0], ko2[1]); w.y = pg8::cvt_pk_bf16(ko2[2], ko2[3]); *(LAS u32x2*)(KB + i * RS + 64 + f) = w;
            kth[it][0] = pg8::cvt_pk_bf16(ko1[0] * kd, ko1[1] * kd); kth[it][1] = pg8::cvt_pk_bf16(ko1[2] * kd, ko1[3] * kd);
            kth[it][2] = pg8::cvt_pk_bf16(ko2[0] * kd, ko2[1] * kd); kth[it][3] = pg8::cvt_pk_bf16(ko2[2] * kd, ko2[3] * kd); kd *= g32; }
        if (it & 1) __builtin_amdgcn_sched_barrier(0); }
}

__device__ __forceinline__ void ret_unit_a(PR P, LAS unsigned char* lds, const int bh, const int n, const int wv) {
    LAS bf16_t* QP = (LAS bf16_t*)lds; LAS bf16_t* KB = QP + BUFE; LAS bf16_t* VT = KB + BUFE;
    const int tid = fresh_tid(wv), lane = tid & 63, wid = tid >> 6, wr = wid >> 1, wc = wid & 1, fr = lane & 15, fq = lane >> 4;
    const int b = bh >> 2, h = bh & 3;
    const bf16_t* PS = (const bf16_t*)(P.ws + WS_BIG); bf16_t* Y = (bf16_t*)(P.ws + WS_XN); bf16_t* KVB = kvb_ptr(P.ws, bh) + (size_t)n * 16384;
    const float lg2 = log2f(1.0f - exp2f(-5.0f - (float)h));
    const float kd0 = exp2f(lg2 * (float)(127 - (tid >> 4))), g32 = exp2f(-32.0f * lg2);
    const int row0 = b * 2048 + n * 128;
    unsigned kth[4][4];
    ret_load_qk<true>(P, QP, KB, kth, tid, row0, n, h, kd0, g32);
#pragma unroll
    for (int it = 0; it < 4; ++it) { const int idx = it * 512 + tid, j = idx >> 4, e = (idx & 15) * 8;
        const u32x4 vv = *(const u32x4*)(PS + (size_t)(row0 + j) * NCOLS + 1792 + 1024 + h * 128 + e);
        LAS bf16_t* d = VT + e * RS + j;
        d[0] = (bf16_t)(vv.x & 0xffffu); d[RS] = (bf16_t)(vv.x >> 16); d[2 * RS] = (bf16_t)(vv.y & 0xffffu); d[3 * RS] = (bf16_t)(vv.y >> 16);
        d[4 * RS] = (bf16_t)(vv.z & 0xffffu); d[5 * RS] = (bf16_t)(vv.z >> 16); d[6 * RS] = (bf16_t)(vv.w & 0xffffu); d[7 * RS] = (bf16_t)(vv.w >> 16); }
    __syncthreads();
    f32x4 accP[2][4];
#pragma unroll
    for (int mt = 0; mt < 2; ++mt)
#pragma unroll
        for (int nt = 0; nt < 4; ++nt) accP[mt][nt] = (f32x4){0.f, 0.f, 0.f, 0.f};
#pragma unroll
    for (int ks = 0; ks < 4; ++ks) { bf16x8 aq[2];
#pragma unroll
        for (int mt = 0; mt < 2; ++mt) aq[mt] = *(const LAS bf16x8*)(QP + (wr * 32 + mt * 16 + fr) * RS + ks * 32 + fq * 8);
#pragma unroll
        for (int nt = 0; nt < 4; ++nt) { const bf16x8 bk = *(const LAS bf16x8*)(KB + (wc * 64 + nt * 16 + fr) * RS + ks * 32 + fq * 8);
#pragma unroll
            for (int mt = 0; mt < 2; ++mt) accP[mt][nt] = __builtin_amdgcn_mfma_f32_16x16x32_bf16(aq[mt], bk, accP[mt][nt], 0, 0, 0); }
        __builtin_amdgcn_sched_barrier(0); }
    __syncthreads();
    { float ri[2][4], cj[4];
#pragma unroll
      for (int mt = 0; mt < 2; ++mt)
#pragma unroll
          for (int j = 0; j < 4; ++j) ri[mt][j] = exp2f(lg2 * (float)(wr * 32 + mt * 16 + fq * 4 + j));
#pragma unroll
      for (int nt = 0; nt < 4; ++nt) cj[nt] = exp2f(-lg2 * (float)(wc * 64 + nt * 16 + fr));
#pragma unroll
      for (int mt = 0; mt < 2; ++mt)
#pragma unroll
          for (int nt = 0; nt < 4; ++nt)
#pragma unroll
              for (int j = 0; j < 4; ++j) { const int i = wr * 32 + mt * 16 + fq * 4 + j, jj = wc * 64 + nt * 16 + fr;
                  const float val = i >= jj ? accP[mt][nt][j] * ri[mt][j] * cj[nt] : 0.f; QP[i * RS + jj] = f2bf(val); } }
#pragma unroll
    for (int it = 0; it < 4; ++it) { const int idx = it * 512 + tid, j = idx >> 4, f = (idx & 15) * 4; LAS bf16_t* d = KB + f * RS + j;
        d[0] = (bf16_t)(kth[it][0] & 0xffffu); d[RS] = (bf16_t)(kth[it][0] >> 16); d[2 * RS] = (bf16_t)(kth[it][1] & 0xffffu); d[3 * RS] = (bf16_t)(kth[it][1] >> 16);
        LAS bf16_t* d2 = d + 64 * RS;
        d2[0] = (bf16_t)(kth[it][2] & 0xffffu); d2[RS] = (bf16_t)(kth[it][2] >> 16); d2[2 * RS] = (bf16_t)(kth[it][3] & 0xffffu); d2[3 * RS] = (bf16_t)(kth[it][3] >> 16); }
    __syncthreads();
    f32x4 accY[2][4], accS[2][4];
#pragma unroll
    for (int mt = 0; mt < 2; ++mt)
#pragma unroll
        for (int nt = 0; nt < 4; ++nt) { accY[mt][nt] = (f32x4){0.f, 0.f, 0.f, 0.f}; accS[mt][nt] = (f32x4){0.f, 0.f, 0.f, 0.f}; }
#pragma unroll
    for (int ks = 0; ks < 4; ++ks) { bf16x8 ap[2], av[2];
#pragma unroll
        for (int mt = 0; mt < 2; ++mt) { ap[mt] = *(const LAS bf16x8*)(QP + (wr * 32 + mt * 16 + fr) * RS + ks * 32 + fq * 8); av[mt] = *(const LAS bf16x8*)(VT + (wr * 32 + mt * 16 + fr) * RS + ks * 32 + fq * 8); }
#pragma unroll
        for (int nt = 0; nt < 4; ++nt) { const bf16x8 bv = *(const LAS bf16x8*)(VT + (wc * 64 + nt * 16 + fr) * RS + ks * 32 + fq * 8), bkt = *(const LAS bf16x8*)(KB + (wc * 64 + nt * 16 + fr) * RS + ks * 32 + fq * 8);
#pragma unroll
            for (int mt = 0; mt < 2; ++mt) { accY[mt][nt] = __builtin_amdgcn_mfma_f32_16x16x32_bf16(ap[mt], bv, accY[mt][nt], 0, 0, 0); accS[mt][nt] = __builtin_amdgcn_mfma_f32_16x16x32_bf16(av[mt], bkt, accS[mt][nt], 0, 0, 0); } }
        __builtin_amdgcn_sched_barrier(0); }
#pragma unroll
    for (int mt = 0; mt < 2; ++mt)
#pragma unroll
        for (int nt = 0; nt < 4; ++nt)
#pragma unroll
            for (int j = 0; j < 4; ++j) { const int r = wr * 32 + mt * 16 + fq * 4 + j, c = wc * 64 + nt * 16 + fr;
                Y[(size_t)(row0 + r) * 1024 + 512 + h * 128 + c] = f2bf(accY[mt][nt][j]); KVB[r * 128 + c] = f2bf(accS[mt][nt][j]); }
    __syncthreads();
}

__device__ __forceinline__ void ret_prefix(PR P, const int item) {
    const int bh = item >> 11, i8 = (item & 2047) * 8; const int h = bh & 3;
    bf16_t* KVB = kvb_ptr(P.ws, bh) + i8;
    const float lg2 = log2f(1.0f - exp2f(-5.0f - (float)h)); const float c_dec = exp2f(lg2 * 128.0f);
    u32x4 kv[16];
#pragma unroll
    for (int n = 0; n < 16; ++n) kv[n] = *(const u32x4*)(KVB + (size_t)n * 16384);
    float S[8];
#pragma unroll
    for (int x = 0; x < 8; ++x) S[x] = 0.f;
#pragma unroll
    for (int n = 0; n < 16; ++n) { u32x4 w; w.x = pg8::cvt_pk_bf16(S[0], S[1]); w.y = pg8::cvt_pk_bf16(S[2], S[3]); w.z = pg8::cvt_pk_bf16(S[4], S[5]); w.w = pg8::cvt_pk_bf16(S[6], S[7]);
        *(u32x4*)(KVB + (size_t)n * 16384) = w;
        const float k8[8] = {lo_bf(kv[n].x), hi_bf(kv[n].x), lo_bf(kv[n].y), hi_bf(kv[n].y), lo_bf(kv[n].z), hi_bf(kv[n].z), lo_bf(kv[n].w), hi_bf(kv[n].w)};
#pragma unroll
        for (int x = 0; x < 8; ++x) S[x] = S[x] * c_dec + k8[x]; }
    const int e = i8 >> 7, d0 = i8 & 127;
#pragma unroll
    for (int x = 0; x < 8; ++x) P.out[O_RTP + ((size_t)bh * 128 + d0 + x) * 128 + e] = S[x];
}

__device__ __forceinline__ void ret_unit_c(PR P, LAS unsigned char* lds, const int bh, const int n, const int wv) {
    LAS bf16_t* QP = (LAS bf16_t*)lds; LAS bf16_t* ST = QP + 3 * BUFE; LAS float* YST = (LAS float*)(QP + BUFE);
    const int tid = fresh_tid(wv), lane = tid & 63, wid = tid >> 6, wr = wid >> 1, wc = wid & 1, fr = lane & 15, fq = lane >> 4;
    const int b = bh >> 2, h = bh & 3;
    const bf16_t* PS = (const bf16_t*)(P.ws + WS_BIG); bf16_t* Y = (bf16_t*)(P.ws + WS_XN); const bf16_t* KVB = kvb_ptr(P.ws, bh) + (size_t)n * 16384;
    const float lg2 = log2f(1.0f - exp2f(-5.0f - (float)h));
    const int row0 = b * 2048 + n * 128;
    unsigned kth[4][4];
    ret_load_qk<false>(P, QP, QP, kth, tid, row0, n, h, 0.f, 0.f);
#pragma unroll
    for (int it = 0; it < 4; ++it) { const int idx = it * 512 + tid, e = idx >> 4, d8 = (idx & 15) * 8;
        *(LAS u32x4*)(ST + e * RS + d8) = *(const u32x4*)(KVB + e * 128 + d8); }
    __syncthreads();
    f32x4 accY[2][4];
#pragma unroll
    for (int mt = 0; mt < 2; ++mt)
#pragma unroll
        for (int nt = 0; nt < 4; ++nt) accY[mt][nt] = (f32x4){0.f, 0.f, 0.f, 0.f};
#pragma unroll
    for (int ks = 0; ks < 4; ++ks) { bf16x8 aq[2];
#pragma unroll
        for (int mt = 0; mt < 2; ++mt) aq[mt] = *(const LAS bf16x8*)(QP + (wr * 32 + mt * 16 + fr) * RS + ks * 32 + fq * 8);
#pragma unroll
        for (int nt = 0; nt < 4; ++nt) { const bf16x8 bs = *(const LAS bf16x8*)(ST + (wc * 64 + nt * 16 + fr) * RS + ks * 32 + fq * 8);
#pragma unroll
            for (int mt = 0; mt < 2; ++mt) accY[mt][nt] = __builtin_amdgcn_mfma_f32_16x16x32_bf16(aq[mt], bs, accY[mt][nt], 0, 0, 0); }
        __builtin_amdgcn_sched_barrier(0); }
#pragma unroll
    for (int mt = 0; mt < 2; ++mt)
#pragma unroll
        for (int j = 0; j < 4; ++j) { const int r = wr * 32 + mt * 16 + fq * 4 + j; const float qd = exp2f(lg2 * (float)(r + 1));
#pragma unroll
            for (int nt = 0; nt < 4; ++nt) YST[r * 132 + wc * 64 + nt * 16 + fr] = accY[mt][nt][j] * qd; }
    __syncthreads();
    { const int i = tid >> 2, part = tid & 3; float yv[32]; float s = 0.f;
      bf16_t* yo = Y + (size_t)(row0 + i) * 1024 + 512 + h * 128 + part * 32;
#pragma unroll
      for (int x = 0; x < 4; ++x) { const u32x4 y1 = *(const u32x4*)(yo + x * 8); const f32x4 ta = *(const LAS f32x4*)(YST + i * 132 + part * 32 + x * 8), tb = *(const LAS f32x4*)(YST + i * 132 + part * 32 + x * 8 + 4);
          yv[x * 8 + 0] = ta[0] + lo_bf(y1.x); yv[x * 8 + 1] = ta[1] + hi_bf(y1.x); yv[x * 8 + 2] = ta[2] + lo_bf(y1.y); yv[x * 8 + 3] = ta[3] + hi_bf(y1.y);
          yv[x * 8 + 4] = tb[0] + lo_bf(y1.z); yv[x * 8 + 5] = tb[1] + hi_bf(y1.z); yv[x * 8 + 6] = tb[2] + lo_bf(y1.w); yv[x * 8 + 7] = tb[3] + hi_bf(y1.w); }
#pragma unroll
      for (int x = 0; x < 32; ++x) s += yv[x];
      s = quad_sum(s); const float mean = s * (1.0f / 128.0f); float s2 = 0.f;
#pragma unroll
      for (int x = 0; x < 32; ++x) { yv[x] -= mean; s2 += yv[x] * yv[x]; }
      s2 = quad_sum(s2); const float rstd = rsqrtf(s2 * (1.0f / 128.0f) + 1e-5f);
      const bf16_t* gp = PS + (size_t)(row0 + i) * NCOLS + 1792 + 1536 + h * 128 + part * 32; const float* gw = P.gn_w + h * 128 + part * 32;
#pragma unroll
      for (int x = 0; x < 4; ++x) { const u32x4 g4 = *(const u32x4*)(gp + x * 8); const float4 w0 = *(const float4*)(gw + x * 8), w1 = *(const float4*)(gw + x * 8 + 4);
          const float gg[8] = {lo_bf(g4.x), hi_bf(g4.x), lo_bf(g4.y), hi_bf(g4.y), lo_bf(g4.z), hi_bf(g4.z), lo_bf(g4.w), hi_bf(g4.w)}; const float ww[8] = {w0.x, w0.y, w0.z, w0.w, w1.x, w1.y, w1.z, w1.w};
          float o[8];
#pragma unroll
          for (int z = 0; z < 8; ++z) o[z] = yv[x * 8 + z] * rstd * ww[z] * (gg[z] * __builtin_amdgcn_rcpf(1.0f + __expf(-gg[z])));
          u32x4 w; w.x = pg8::cvt_pk_bf16(o[0], o[1]); w.y = pg8::cvt_pk_bf16(o[2], o[3]); w.z = pg8::cvt_pk_bf16(o[4], o[5]); w.w = pg8::cvt_pk_bf16(o[6], o[7]);
          *(u32x4*)(yo + x * 8) = w; } }
    __syncthreads();
}

__device__ __forceinline__ void sub_barrier(unsigned* cnt, const unsigned target, const int wv) {
    asm volatile("s_waitcnt vmcnt(0)" ::: "memory");
    __syncthreads();
    if (fresh_tid(wv) == 0) {
        __builtin_amdgcn_fence(__ATOMIC_RELEASE, "agent");
        asm volatile("s_waitcnt vmcnt(0)" ::: "memory");
        (void)xb_add(cnt, 1u);
        unsigned sp = 0u;
        while (xb_ld(cnt) < target) { __builtin_amdgcn_s_sleep(2); if (++sp > (1u << 20)) break; }
        __builtin_amdgcn_fence(__ATOMIC_ACQUIRE, "agent");
        asm volatile("s_waitcnt vmcnt(0)" ::: "memory");
    }
    __syncthreads();
}

struct PostRegs { u32x2 yr, c_r, c_k, c_v, p_r, p_k, p_v, ar, gr; };
__device__ __forceinline__ void post_load(PR P, PostRegs& R, const int row, const int ch) {
    const bf16_t* PS = (const bf16_t*)(P.ws + WS_BIG); const bf16_t* ASIG = (const bf16_t*)(P.ws + WS_ASIG); const bf16_t* YS = (const bf16_t*)(P.ws + WS_YS); const bf16_t* G = (const bf16_t*)(P.ws + WS_WIN);
    R.yr = *(const u32x2*)(YS + (size_t)row * 512 + ch);
    const bf16_t* cp = PS + (size_t)row * NCOLS + ch; const int pr = prev_row(row);
    R.c_r = *(const u32x2*)cp; R.c_k = *(const u32x2*)(cp + 512); R.c_v = *(const u32x2*)(cp + 1024);
    { const bf16_t* pp = PS + (size_t)(pr >= 0 ? pr : row) * NCOLS + ch; R.p_r = *(const u32x2*)pp; R.p_k = *(const u32x2*)(pp + 512); R.p_v = *(const u32x2*)(pp + 1024); }
    R.ar = *(const u32x2*)(ASIG + (size_t)row * 512 + ch); R.gr = *(const u32x2*)(G + (size_t)row * 512 + ch);
}
__device__ __forceinline__ void rwkv_post(PR P, const int wv) {
    const int tid = fresh_tid(wv); const int lane = tid & 63; const int gw = blockIdx.x * 8 + (tid >> 6), nw = gridDim.x * 8;
    const int sub = lane >> 4, cg4 = (lane & 15) * 4;
    bf16_t* Y = (bf16_t*)(P.ws + WS_XN);
    const int h = (gw * 4 + sub) & 7, ch = h * 64 + cg4;
    const float4 mr = *(const float4*)(P.mu + ch), mk = *(const float4*)(P.mu + 512 + ch), mv = *(const float4*)(P.mu + 1024 + ch);
    const float4 ka = *(const float4*)(P.k_a + ch), rk = *(const float4*)(P.r_k + ch), lw = *(const float4*)(P.lnx_w + ch), lb = *(const float4*)(P.lnx_b + ch);
    const float m_r[4] = {mr.x, mr.y, mr.z, mr.w}, m_k[4] = {mk.x, mk.y, mk.z, mk.w}, m_v[4] = {mv.x, mv.y, mv.z, mv.w};
    const float kaa[4] = {ka.x, ka.y, ka.z, ka.w}, rkk[4] = {rk.x, rk.y, rk.z, rk.w}, lww[4] = {lw.x, lw.y, lw.z, lw.w}, lbb[4] = {lb.x, lb.y, lb.z, lb.w};
    PostRegs R, N;
    if (gw < MT * 2) post_load(P, R, (gw * 4 + sub) >> 3, ch);
    for (int task = gw; task < MT * 2; task += nw) {
        const int row = (task * 4 + sub) >> 3;
        { const int nt_ = task + nw < MT * 2 ? task + nw : task; post_load(P, N, (nt_ * 4 + sub) >> 3, ch); }
        if (prev_row(row) < 0) { R.p_r = (u32x2){0u, 0u}; R.p_k = R.p_r; R.p_v = R.p_r; }
        const float ys[4] = {lo_bf(R.yr.x), hi_bf(R.yr.x), lo_bf(R.yr.y), hi_bf(R.yr.y)};
        const float mean = row16_sum(ys[0] + ys[1] + ys[2] + ys[3]) * (1.0f / 64.0f);
        float dl[4], s2 = 0.f;
#pragma unroll
        for (int j = 0; j < 4; ++j) { dl[j] = ys[j] - mean; s2 += dl[j] * dl[j]; }
        const float rstd = rsqrtf(row16_sum(s2) * (1.0f / 64.0f) + 64e-5f);
        const float cr[4] = {lo_bf(R.c_r.x), hi_bf(R.c_r.x), lo_bf(R.c_r.y), hi_bf(R.c_r.y)}, ck[4] = {lo_bf(R.c_k.x), hi_bf(R.c_k.x), lo_bf(R.c_k.y), hi_bf(R.c_k.y)}, cv[4] = {lo_bf(R.c_v.x), hi_bf(R.c_v.x), lo_bf(R.c_v.y), hi_bf(R.c_v.y)};
        const float qr[4] = {lo_bf(R.p_r.x), hi_bf(R.p_r.x), lo_bf(R.p_r.y), hi_bf(R.p_r.y)}, qk[4] = {lo_bf(R.p_k.x), hi_bf(R.p_k.x), lo_bf(R.p_k.y), hi_bf(R.p_k.y)}, qv[4] = {lo_bf(R.p_v.x), hi_bf(R.p_v.x), lo_bf(R.p_v.y), hi_bf(R.p_v.y)};
        const float aa[4] = {lo_bf(R.ar.x), hi_bf(R.ar.x), lo_bf(R.ar.y), hi_bf(R.ar.y)}, gg[4] = {lo_bf(R.gr.x), hi_bf(R.gr.x), lo_bf(R.gr.y), hi_bf(R.gr.y)};
        float v[4], bp = 0.f;
#pragma unroll
        for (int j = 0; j < 4; ++j) { const float r = cr[j] + (qr[j] - cr[j]) * m_r[j], k = ck[j] + (qk[j] - ck[j]) * m_k[j]; v[j] = cv[j] + (qv[j] - cv[j]) * m_v[j];
            const float kn = k * (1.0f + (aa[j] - 1.0f) * kaa[j]); bp += r * kn * rkk[j]; }
        const float bonus = row16_sum(bp);
        float o[4];
#pragma unroll
        for (int j = 0; j < 4; ++j) o[j] = (dl[j] * rstd * lww[j] + lbb[j] + bonus * v[j]) * gg[j];
        u32x2 w; w.x = pg8::cvt_pk_bf16(o[0], o[1]); w.y = pg8::cvt_pk_bf16(o[2], o[3]);
        *(u32x2*)(Y + (size_t)row * 1024 + ch) = w;
        R = N;
    }
}

__global__ void __launch_bounds__(512, 2) hymba_mega(Params P_unused) {
    extern __shared__ __attribute__((aligned(16))) unsigned char shm[];
    cg::grid_group grid = cg::this_grid();
    LAS unsigned char* lds = (LAS unsigned char*)shm; LAS float* ldsf = (LAS float*)shm;
    const int G = gridDim.x, bx = blockIdx.x;
    const int wv = __builtin_amdgcn_readfirstlane(threadIdx.x >> 6);
    const CAS Params* kp = (const CAS Params*)__builtin_amdgcn_kernarg_segment_ptr();
#define P (*kp)
#define FRESH() asm volatile("" : "+s"(kp))
#ifndef REP_SYNC
#define REP_SYNC 1
#endif
#ifndef REP_P7
#define REP_P7 1
#endif
#ifndef REP_FFN1
#define REP_FFN1 1
#endif
#ifndef REP_P0
#define REP_P0 1
#endif
#ifndef REP_P3
#define REP_P3 1
#endif
#ifndef REP_RW
#define REP_RW 1
#endif
#ifndef REP_OTH
#define REP_OTH 1
#endif
#ifndef REP_RETP
#define REP_RETP 1
#endif
#ifndef REP_SAMP
#define REP_SAMP 1
#endif
#ifndef REP_P8
#define REP_P8 1
#endif
#define GSYNC() do { for (int r_ = 0; r_ < REP_SYNC; ++r_) xcd_barrier((unsigned*)ws, (volatile LAS unsigned*)(lds + LDS_BYTES - 16), wv); FRESH(); } while (0)
#define ws (kp->ws)
#define XN ((bf16_t*)(ws + WS_XN))
#define ACT ((bf16_t*)(ws + WS_BIG))
#define FO ((float*)(ws + WS_FO))
#define PS ((bf16_t*)(ws + WS_BIG))
    pg8::StaticOrder S;
    { const int t0 = fresh_tid(wv); if (t0 < 4) ((LAS unsigned*)(lds + LDS_BYTES - 16))[t0] = 0u;
      if (t0 == 0) (void)xb_add(&((unsigned*)ws)[XB_XCNT(xb_xcc_id())], 1u); }
    if (G == 0x7fffffff) grid.sync();
#ifndef PHM
#define PHM 0xFFFF
#endif
#define PH(k) if ((PHM >> (k)) & 1)
    for (int r0 = 0; r0 < REP_P0; ++r0) PH(0) p0_prologue(P, ldsf, wv);
    GSYNC();
    for (int rep1 = 0; rep1 < REP_FFN1; ++rep1) {
    PH(1) { pg8::Gemm g{XN, (const bf16_t*)(ws + WS_WGU), MT, NGU, 1024}; S.init(MT, NGU, G, bx, 1024); pg8::EpiSwiGLU E{ACT, DFF}; pg8::gemm_phase(lds, g, S, E, wv); }
    GSYNC();
    PH(2) { pg8::Gemm g{ACT, (const bf16_t*)(ws + WS_WD), MT, 1024, DFF}; pg8::SplitOrder S2; S2.init2(G, bx, DFF, 8); pg8::EpiFO E{(bf16_t*)FO, 1024, (float*)(ws + WS_OMD)}; pg8::gemm_phase(lds, g, S2, E, wv); }
    GSYNC();
    }
    for (int r3 = 0; r3 < REP_P3; ++r3) PH(3) rows_phase(P, 1, ldsf, wv);
    GSYNC();
    PH(4) { pg8::Gemm g{XN, (const bf16_t*)(ws + WS_WIN), MIN_, NCOLS, 1024}; S.init(MIN_, NCOLS, G, bx, 1024); pg8::EpiBf16 E{PS, NCOLS}; pg8::gemm_phase(lds, g, S, E, wv); }
    GSYNC();
    PH(5) lora_prep(P, wv);
    GSYNC();
    PH(6) { pg8::Gemm g{(const bf16_t*)(ws + WS_LA), (const bf16_t*)(ws + WS_WL), MT, 1536, 256}; pg8::LoraMainOrder SM; SM.init(MP, 1024, G, bx, 256);
      pg8::EpiLora E{(bf16_t*)(ws + WS_OMD), (bf16_t*)(ws + WS_ASIG), (bf16_t*)(ws + WS_WIN), P.w0, P.a0}; pg8::gemm_phase(lds, g, SM, E, wv); }
    GSYNC();
    {
    if (bx < 128) { for (int rw = 0; rw < REP_RW; ++rw) rwkv_unit<false>(P, ldsf, bx >> 4, (bx >> 1) & 7, bx & 1, wv); }
    else {
        { pg8::Gemm g{(const bf16_t*)(ws + WS_LA), (const bf16_t*)(ws + WS_WL), MT, 1536, 256}; pg8::LoraRestOrder SL; SL.ob = bx - 128;
          pg8::EpiLora E{(bf16_t*)(ws + WS_OMD), (bf16_t*)(ws + WS_ASIG), (bf16_t*)(ws + WS_WIN), P.w0, P.a0}; pg8::gemm_phase(lds, g, SL, E, wv); }
        FRESH();
        const int rep7 = 0; const int ob = bx - 128; unsigned* sbc = (unsigned*)ws + XCD_BAR_WORDS + 64;
        for (int k = 0; k < 4; ++k) { const int u = ob + k * 128; ret_unit_a(P, lds, u >> 4, u & 15, wv); }
        sub_barrier(sbc, 128u * (2u * rep7 + 1u), wv);
        ret_prefix(P, ob * 512 + fresh_tid(wv));
        sub_barrier(sbc, 128u * (2u * rep7 + 2u), wv);
        for (int k = 0; k < 4; ++k) { const int u = ob + k * 128; ret_unit_c(P, lds, u >> 4, u & 15, wv); }
        for (int u = ob; u < 2560; u += 128) { if (u < 2048) rwkv_unit<true>(P, ldsf, u >> 4, (u >> 1) & 7, u & 1, wv); else ret_sample_unit(P, ldsf, (u - 2048) >> 2, (u - 2048) & 3, wv); }
    }
    }
    GSYNC();
    for (int rep8 = 0; rep8 < REP_P8; ++rep8) PH(8) rwkv_post(P, wv);
    GSYNC();
    PH(9) { pg8::Gemm g{XN, (const bf16_t*)(ws + WS_WOUT), MT, 1024, 1024}; pg8::SplitOrder S2; S2.init2(G, bx, 1024, 4); pg8::EpiFO E{(bf16_t*)FO, 1024, (float*)(ws + WS_OMD)}; pg8::gemm_phase(lds, g, S2, E, wv); }
    GSYNC();
    PH(10) { tconv_list(P.f2g, P.f2u, P.f2d, nullptr, nullptr, ws, 2112, ldsf, wv);
    rows_phase(P, 2, ldsf, wv); }
    GSYNC();
    PH(11) { pg8::Gemm g{XN, (const bf16_t*)(ws + WS_WGU), MT, NGU, 1024}; S.init(MT, NGU, G, bx, 1024); pg8::EpiSwiGLU E{ACT, DFF}; pg8::gemm_phase(lds, g, S, E, wv); }
    GSYNC();
    PH(12) { pg8::Gemm g{ACT, (const bf16_t*)(ws + WS_WD), MT, 1024, DFF}; pg8::SplitOrder S2; S2.init2(G, bx, DFF, 8); pg8::EpiFO E{(bf16_t*)FO, 1024, (float*)(ws + WS_OMD)}; pg8::gemm_phase(lds, g, S2, E, wv); }
    GSYNC();
    PH(13) rows_phase(P, 3, ldsf, wv);
}

#undef ws
#undef XN
#undef ACT
#undef FO
#undef PS
#undef P
extern "C" void kernel_launch(void* const* d_in, const int* in_sizes, int n_in, void* d_out, int out_size, void* d_ws, size_t ws_size, hipStream_t stream) {
    static int grid = 0;
    if (grid == 0) {
        if (n_in != 26 || ws_size < WS_END) { fprintf(stderr, "kernel_launch: unexpected n_in %d or ws_size %zu (< %zu)\n", n_in, ws_size, (size_t)WS_END); grid = -1; return; }
        int dev = 0, cus = 0, per_cu = 0;
        hipGetDevice(&dev); hipDeviceGetAttribute(&cus, hipDeviceAttributeMultiprocessorCount, dev);
        hipFuncSetAttribute((const void*)hymba_mega, hipFuncAttributeMaxDynamicSharedMemorySize, LDS_BYTES);
        hipOccupancyMaxActiveBlocksPerMultiprocessor(&per_cu, (const void*)hymba_mega, 512, LDS_BYTES);
        if (per_cu < 1) { fprintf(stderr, "kernel_launch: occupancy query says %d blocks/CU\n", per_cu); per_cu = 1; }
        grid = cus * per_cu; if (grid > 256) grid = 256;
        if (grid != 256) { fprintf(stderr, "kernel_launch: this kernel needs 256 co-resident workgroups, got %d\n", grid); grid = -1; return; }
        fprintf(stderr, "kernel_launch: cus %d per_cu %d grid %d ws %zu\n", cus, per_cu, grid, ws_size);
    }
    if (grid < 0) return;
    if (hipMemsetAsync(d_ws, 0, 16384, stream) != hipSuccess) { fprintf(stderr, "kernel_launch: hipMemsetAsync failed\n"); return; }
    Params p{};
    const float** pp = (const float**)&p;
    for (int i = 0; i < 26; ++i) pp[i] = (const float*)d_in[i];
    p.out = (float*)d_out; p.ws = (unsigned char*)d_ws;
    void* args[] = {&p};
    hipError_t e = hipLaunchCooperativeKernel((const void*)hymba_mega, dim3(grid), dim3(512), args, LDS_BYTES, stream);
    if (e != hipSuccess) fprintf(stderr, "cooperative launch failed: %s (grid %d)\n", hipGetErrorString(e), grid);
}
```

```cpp
#include <hip/hip_runtime.h>
#include <hip/hip_cooperative_groups.h>
#include <cstdio>
#include <cstdint>
namespace cg = cooperative_groups;

__device__ __forceinline__ int fresh_tid(int wv) { int l; asm volatile("v_mbcnt_lo_u32_b32 %0, -1, 0\n\tv_mbcnt_hi_u32_b32 %0, -1, %0" : "=v"(l)); return wv * 64 + l; }
namespace pg8 {
#define PG8_LAS __attribute__((address_space(3)))
typedef unsigned short bf16_t;
typedef short bf16x8 __attribute__((ext_vector_type(8)));
typedef float f32x4 __attribute__((ext_vector_type(4)));
typedef unsigned u32x4 __attribute__((ext_vector_type(4)));
typedef unsigned u32x2 __attribute__((ext_vector_type(2)));
constexpr int BM = 256, BK = 64, HALF = 128, HTB = HALF * BK * 2, STAGE_BYTES = 8 * HTB, NXCD = 8, WGM = 4;

__host__ __device__ __forceinline__ int lds_byte(int r, int c) { const int st = (r >> 4) * 2 + (c >> 5), rr = r & 15, cc = c & 31, ob = rr * 64 + cc * 2; return st * 1024 + (ob ^ (((ob >> 9) & 1) << 5)); }
__host__ __device__ __forceinline__ void stage_rc(int b, int& R, int& C) { const int st = b / 1024, sb = b % 1024, swz = sb ^ (((sb >> 9) & 1) << 5); R = (st >> 1) * 16 + swz / 64; C = (st & 1) * 32 + (swz % 64) / 2; }
__host__ __device__ __forceinline__ int perm32(int rho) { const int n = rho >> 4, i = rho & 15; return 8 * (i >> 2) + 4 * n + (i & 3); }

struct Unit { int pm, pn, k0, nkt, atomic; };
struct Gemm { const bf16_t* A; const bf16_t* Bt; int M, N, K; };

struct StaticOrder {
    int nM, nN, nwg, G, c, nt;
    __host__ __device__ void init(int M, int N, int G_, int c_, int K) { nM = M / BM; nN = N / BM; nwg = nM * nN; G = G_; c = c_; nt = K / BK; }
    __host__ __device__ bool next(int i, Unit& u) const {
        const long L = (long)i * G + c; if (L >= nwg) return false;
        int wgid = (int)L; { const int q = nwg / NXCD, r = nwg % NXCD, xcd = wgid % NXCD, off = wgid / NXCD; wgid = (xcd < r ? xcd * (q + 1) : r * (q + 1) + (xcd - r) * q) + off; }
        const int nig = WGM * nN, gid = wgid / nig, fm = gid * WGM, gsz = (nM - fm) < WGM ? (nM - fm) : WGM;
        u.pm = fm + ((wgid % nig) % gsz); u.pn = (wgid % nig) / gsz; u.k0 = 0; u.nkt = nt; u.atomic = 0; return true;
    }
    __device__ __forceinline__ void a_ready(const Unit&) const {}
    __device__ __forceinline__ void done(const Unit&) const {}
};
struct LoraMainOrder : StaticOrder {
    __host__ __device__ bool next(int i, Unit& u) const { if (!StaticOrder::next(i, u)) return false; u.k0 = 0; u.nkt = 2; return true; }
};
struct LoraRestOrder {
    int ob;
    __host__ __device__ bool next(int i, Unit& u) const {
        const int L = i * 128 + ob; if (L >= 140) return false;
        if (L < 132) { u.pm = L >> 1; u.pn = 4 + (L & 1); u.k0 = 2; } else { const int x = L - 132; u.pm = 64 + (x >> 2); u.pn = x & 3; u.k0 = 0; }
        u.nkt = 2; u.atomic = 0; return true;
    }
    __device__ __forceinline__ void a_ready(const Unit&) const {}
    __device__ __forceinline__ void done(const Unit&) const {}
};
struct SplitOrder : StaticOrder {
    int KS;
    __host__ __device__ void init2(int G_, int c_, int K, int KS_) { init(16384, 1024, G_, c_, K); KS = KS_; }
    __host__ __device__ bool next(int i, Unit& u) const {
        if (i == 0) return StaticOrder::next(0, u);
        if (i > 1 || c >= 8 * KS) return false;
        const int tile = c / KS, part = c % KS, pairs = nt / 2, q = pairs / KS, r = pairs % KS;
        u.pm = 64 + (tile >> 2); u.pn = tile & 3; u.k0 = 2 * (part * q + (part < r ? part : r)); u.nkt = 2 * (q + (part < r ? 1 : 0)); u.atomic = 1 + c; return true;
    }
};

typedef __bf16 bf16x2_t __attribute__((ext_vector_type(2)));
typedef float f32x2_t __attribute__((ext_vector_type(2)));
__device__ __forceinline__ unsigned cvt_pk_bf16(float lo, float hi) { const f32x2_t v = {lo, hi}; const bf16x2_t b = __builtin_convertvector(v, bf16x2_t); return __builtin_bit_cast(unsigned, b); }

struct EpiFO {
    static constexpr bool PERM = true;
    bf16_t* C; int ldc; float* slab;
    __device__ __forceinline__ void operator()(const f32x4 (&acc)[2][2][4][2], const Unit& u, int wr, int wc, int fr, int fq) const {
        if (u.atomic == 0) {
            const __amdgpu_buffer_rsrc_t rs = __builtin_amdgcn_make_buffer_rsrc(C, 0, 0x7ffffff0, 0x00020000);
            const int row0 = u.pm * BM + wr * 64 + fr; const int col0 = u.pn * BM + wc * 32 + 8 * fq;
#pragma unroll
            for (int ai = 0; ai < 2; ++ai)
#pragma unroll
                for (int m = 0; m < 4; ++m) { const unsigned ro = (unsigned)((row0 + ai * HALF + m * 16) * ldc + col0) * 2u;
#pragma unroll
                    for (int bj = 0; bj < 2; ++bj) { const f32x4 v0 = acc[ai][bj][m][0], v1 = acc[ai][bj][m][1];
                        u32x4 w; w.x = cvt_pk_bf16(v0[0], v0[1]); w.y = cvt_pk_bf16(v0[2], v0[3]); w.z = cvt_pk_bf16(v1[0], v1[1]); w.w = cvt_pk_bf16(v1[2], v1[3]);
                        __builtin_amdgcn_raw_buffer_store_b128(w, rs, ro + bj * HALF * 2, 0, 16); } }
        } else {
            float* base = slab + (size_t)(u.atomic - 1) * (BM * BM) + (size_t)(wr * 64 + fr) * BM + wc * 32 + 8 * fq;
#pragma unroll
            for (int ai = 0; ai < 2; ++ai)
#pragma unroll
                for (int m = 0; m < 4; ++m) { float* rowp = base + (size_t)(ai * HALF + m * 16) * BM;
#pragma unroll
                    for (int bj = 0; bj < 2; ++bj) { *(f32x4*)(rowp + bj * HALF) = acc[ai][bj][m][0]; *(f32x4*)(rowp + bj * HALF + 4) = acc[ai][bj][m][1]; } }
        }
    }
};
struct EpiBf16 {
    static constexpr bool PERM = true;
    bf16_t* O; int ldc;
    __device__ __forceinline__ void operator()(const f32x4 (&acc)[2][2][4][2], const Unit& u, int wr, int wc, int fr, int fq) const {
        const int row0 = u.pm * BM + wr * 64 + fr; const int col0 = u.pn * BM + wc * 32 + 8 * fq;
        const __amdgpu_buffer_rsrc_t rs = __builtin_amdgcn_make_buffer_rsrc(O, 0, 0x7ffffff0, 0x00020000);
#pragma unroll
        for (int ai = 0; ai < 2; ++ai)
#pragma unroll
            for (int m = 0; m < 4; ++m) { const unsigned ro = (unsigned)((row0 + ai * HALF + m * 16) * ldc + col0) * 2u;
#pragma unroll
                for (int bj = 0; bj < 2; ++bj) { const f32x4 v0 = acc[ai][bj][m][0], v1 = acc[ai][bj][m][1];
                    u32x4 w; w.x = cvt_pk_bf16(v0[0], v0[1]); w.y = cvt_pk_bf16(v0[2], v0[3]); w.z = cvt_pk_bf16(v1[0], v1[1]); w.w = cvt_pk_bf16(v1[2], v1[3]);
                    __builtin_amdgcn_raw_buffer_store_b128(w, rs, ro + bj * HALF * 2, 0, 16); } }
    }
};
__device__ __forceinline__ float silu_f(float x) { return x * __builtin_amdgcn_rcpf(1.0f + __expf(-x)); }
struct EpiSwiGLU {
    static constexpr bool PERM = true;
    bf16_t* O; int ldc;
    __device__ __forceinline__ void operator()(const f32x4 (&acc)[2][2][4][2], const Unit& u, int wr, int wc, int fr, int fq) const {
        const int row0 = u.pm * BM + wr * 64 + fr; const int col0 = u.pn * HALF + wc * 32 + 8 * fq;
        const __amdgpu_buffer_rsrc_t rs = __builtin_amdgcn_make_buffer_rsrc(O, 0, 0x7ffffff0, 0x00020000);
#pragma unroll
        for (int ai = 0; ai < 2; ++ai)
#pragma unroll
            for (int m = 0; m < 4; ++m) { const unsigned ro = (unsigned)((row0 + ai * HALF + m * 16) * ldc + col0) * 2u;
                float o[8];
#pragma unroll
                for (int n = 0; n < 2; ++n)
#pragma unroll
                    for (int j = 0; j < 4; ++j) o[n * 4 + j] = silu_f(acc[ai][0][m][n][j]) * acc[ai][1][m][n][j];
                u32x4 w; w.x = cvt_pk_bf16(o[0], o[1]); w.y = cvt_pk_bf16(o[2], o[3]); w.z = cvt_pk_bf16(o[4], o[5]); w.w = cvt_pk_bf16(o[6], o[7]);
                __builtin_amdgcn_raw_buffer_store_b128(w, rs, ro, 0, 16); }
    }
};
struct EpiLora {
    static constexpr bool PERM = true;
    bf16_t* OMD; bf16_t* ASIG; bf16_t* G; const float* w0; const float* a0;
    template <int KIND> __device__ __forceinline__ void body(const f32x4 (&acc)[2][2][4][2], bf16_t* O, const float* bias, int row0, int ch0) const {
#pragma unroll
        for (int bj = 0; bj < 2; ++bj)
#pragma unroll
            for (int ai = 0; ai < 2; ++ai)
#pragma unroll
                for (int m = 0; m < 4; ++m) { bf16_t* rowp = O + (size_t)(row0 + ai * HALF + m * 16) * 512 + ch0 + bj * HALF;
                    float o[8];
#pragma unroll
                    for (int n = 0; n < 2; ++n)
#pragma unroll
                        for (int j = 0; j < 4; ++j) { float v = acc[ai][bj][m][n][j];
                            if (KIND == 0) { v += bias[ch0 + bj * HALF + n * 4 + j]; const float e = 0.6065306597126334f * __builtin_amdgcn_rcpf(1.0f + __expf(-v));
                                float p = 1.0f / 40320.0f; p = -1.0f / 5040.0f + e * p; p = 1.0f / 720.0f + e * p; p = -1.0f / 120.0f + e * p; p = 1.0f / 24.0f + e * p; p = -1.0f / 6.0f + e * p; p = 0.5f + e * p; p = 1.0f - e * p;
                                v = e * p; }
                            else if (KIND == 1) { v += bias[ch0 + bj * HALF + n * 4 + j]; v = __builtin_amdgcn_rcpf(1.0f + __expf(-v)); }
                            o[n * 4 + j] = v; }
                    u32x4 w; w.x = cvt_pk_bf16(o[0], o[1]); w.y = cvt_pk_bf16(o[2], o[3]); w.z = cvt_pk_bf16(o[4], o[5]); w.w = cvt_pk_bf16(o[6], o[7]);
                    *(u32x4*)rowp = w; __builtin_amdgcn_sched_barrier(0); }
    }
    __device__ __forceinline__ void operator()(const f32x4 (&acc)[2][2][4][2], const Unit& u, int wr, int wc, int fr, int fq) const {
        const int kind = u.pn >> 1;
        const int row0 = u.pm * BM + wr * 64 + fr; const int ch0 = (u.pn & 1) * BM + wc * 32 + 8 * fq;
        if (kind == 0) body<0>(acc, OMD, w0, row0, ch0); else if (kind == 1) body<1>(acc, ASIG, a0, row0, ch0); else body<2>(acc, G, a0, row0, ch0);
    }
};

template <class Epi, class Sched>
__device__ __forceinline__ void gemm_phase(PG8_LAS unsigned char* lds, const Gemm g, const Sched& S, const Epi& E, const int wv) {
    const int tid = fresh_tid(wv), wid = __builtin_amdgcn_readfirstlane(tid >> 6), lane = tid & 63, wr = wid >> 2, wc = wid & 3, fr = lane & 15, fq = lane >> 4;
    const int K = g.K;
    unsigned voffA[2], voffB[2];
#pragma unroll
    for (int i = 0; i < 2; ++i) { int R, C; stage_rc(tid * 16 + i * 8192, R, C); const int Rb = Epi::PERM ? ((R & ~31) + perm32(R & 31)) : R;
        voffA[i] = (unsigned)(R * K + C) * 2u; voffB[i] = (unsigned)(Rb * K + C) * 2u; }
    const size_t kstep = (size_t)(BK * 2);
    const size_t hstep = (size_t)HALF * K * 2;
    const size_t tstep = 2 * hstep;
    const unsigned ldsw = (unsigned)wid * 1024u;
    const int aoff = lds_byte(wr * 64 + fr, fq * 8), boff = lds_byte(wc * 32 + fr, fq * 8);
#define PG8_SA(b, h) (((b) * 2 + (h)) * HTB)
#define PG8_SB(b, h) ((4 + (b) * 2 + (h)) * HTB)
#define PG8_STAGE(bufoff, gbase, voff) do { _Pragma("unroll") for (int _i = 0; _i < 2; ++_i) \
        __builtin_amdgcn_global_load_lds((const unsigned*)((const char*)(gbase) + (voff)[_i]), (PG8_LAS unsigned*)(lds + (bufoff) + ldsw + _i * 8192), 16, 0, 0); } while (0)
#define PG8_LDA(dst, b, h) do { _Pragma("unroll") for (int m = 0; m < 4; ++m) _Pragma("unroll") for (int k = 0; k < 2; ++k) dst[m][k] = *(const PG8_LAS bf16x8*)(lds + PG8_SA(b, h) + aoff + m * 2048 + k * 1024); } while (0)
#define PG8_LDB(dst, b, h) do { _Pragma("unroll") for (int n = 0; n < 2; ++n) _Pragma("unroll") for (int k = 0; k < 2; ++k) dst[n][k] = *(const PG8_LAS bf16x8*)(lds + PG8_SB(b, h) + boff + n * 2048 + k * 1024); } while (0)
#define PG8_MMA(ai, bj, At, Bt) do { __builtin_amdgcn_s_setprio(1); _Pragma("unroll") for (int m = 0; m < 4; ++m) _Pragma("unroll") for (int n = 0; n < 2; ++n) _Pragma("unroll") for (int k = 0; k < 2; ++k) \
        acc[ai][bj][m][n] = __builtin_amdgcn_mfma_f32_16x16x32_bf16(Bt[n][k], At[m][k], acc[ai][bj][m][n], 0, 0, 0); __builtin_amdgcn_s_setprio(0); } while (0)
#define PG8_WAIT_V(n) asm volatile("s_waitcnt vmcnt(" #n ")" ::: "memory")
#define PG8_WAIT_L(n) asm volatile("s_waitcnt lgkmcnt(" #n ")" ::: "memory")
#define PG8_BAR __builtin_amdgcn_s_barrier()
#define PG8_SCHED __builtin_amdgcn_sched_barrier(0)
    Unit cur, nxt; int ui = 0;
    if (!S.next(0, cur)) return;
    f32x4 acc[2][2][4][2];
#pragma unroll
    for (int a = 0; a < 2; ++a)
#pragma unroll
        for (int b = 0; b < 2; ++b)
#pragma unroll
            for (int m = 0; m < 4; ++m)
#pragma unroll
                for (int n = 0; n < 2; ++n) acc[a][b][m][n] = (f32x4){0.f, 0.f, 0.f, 0.f};
    bf16x8 At[4][2], B0[2][2], B1[2][2];
    const char* cA = (const char*)g.A + (size_t)cur.pm * tstep + (size_t)cur.k0 * kstep; const char* cB = (const char*)g.Bt + (size_t)cur.pn * tstep + (size_t)cur.k0 * kstep;
    S.a_ready(cur);
    PG8_STAGE(PG8_SB(0, 0), cB, voffB); PG8_STAGE(PG8_SA(0, 0), cA, voffA); PG8_STAGE(PG8_SB(0, 1), cB + hstep, voffB); PG8_STAGE(PG8_SA(0, 1), cA + hstep, voffA);
    if (wr == 1) PG8_BAR;
    PG8_WAIT_V(4); PG8_BAR;
    PG8_STAGE(PG8_SB(1, 0), cB + kstep, voffB); PG8_STAGE(PG8_SA(1, 0), cA + kstep, voffA); PG8_STAGE(PG8_SB(1, 1), cB + hstep + kstep, voffB);
    PG8_WAIT_V(6); PG8_BAR;
    for (;;) {
        const bool has_next = S.next(ui + 1, nxt);
        const char* nA = has_next ? (const char*)g.A + (size_t)nxt.pm * tstep + (size_t)nxt.k0 * kstep : cA; const char* nB = has_next ? (const char*)g.Bt + (size_t)nxt.pn * tstep + (size_t)nxt.k0 * kstep : cB;
        const int nt = cur.nkt;
        for (int t = 0; t < nt; t += 2) {
            const bool last = (t == nt - 2);
            const char* a1 = cA + (size_t)(t + 1) * kstep;
            const char* a2 = last ? nA : cA + (size_t)(t + 2) * kstep; const char* b2 = last ? nB : cB + (size_t)(t + 2) * kstep;
            const char* a3 = a2 + kstep; const char* b3 = b2 + kstep;
            if (last && has_next) S.a_ready(nxt);
            PG8_LDB(B0, 0, 0); PG8_SCHED; PG8_LDA(At, 0, 0); PG8_STAGE(PG8_SA(1, 1), a1 + hstep, voffA);
            PG8_WAIT_L(8); PG8_BAR; PG8_WAIT_L(0); PG8_MMA(0, 0, At, B0); PG8_BAR; PG8_SCHED;
            PG8_LDB(B1, 0, 1); PG8_STAGE(PG8_SB(0, 0), b2, voffB);
            PG8_BAR; PG8_WAIT_L(0); PG8_MMA(0, 1, At, B1); PG8_BAR;
            PG8_LDA(At, 0, 1); PG8_STAGE(PG8_SA(0, 0), a2, voffA);
            PG8_BAR; PG8_WAIT_L(0); PG8_MMA(1, 0, At, B0); PG8_BAR; PG8_SCHED;
            PG8_STAGE(PG8_SB(0, 1), b2 + hstep, voffB);
            PG8_WAIT_V(6); PG8_BAR; PG8_MMA(1, 1, At, B1); PG8_BAR;
            PG8_LDB(B0, 1, 0); PG8_SCHED; PG8_LDA(At, 1, 0); PG8_STAGE(PG8_SA(0, 1), a2 + hstep, voffA);
            PG8_WAIT_L(8); PG8_BAR; PG8_WAIT_L(0); PG8_MMA(0, 0, At, B0); PG8_BAR; PG8_SCHED;
            PG8_LDB(B1, 1, 1); PG8_STAGE(PG8_SB(1, 0), b3, voffB);
            PG8_BAR; PG8_WAIT_L(0); PG8_MMA(0, 1, At, B1); PG8_BAR;
            PG8_LDA(At, 1, 1); PG8_STAGE(PG8_SA(1, 0), a3, voffA);
            PG8_BAR; PG8_WAIT_L(0); PG8_MMA(1, 0, At, B0); PG8_BAR; PG8_SCHED;
            PG8_STAGE(PG8_SB(1, 1), b3 + hstep, voffB);
            PG8_WAIT_V(6); PG8_BAR; PG8_MMA(1, 1, At, B1); PG8_BAR;
        }
        { const int l2 = fresh_tid(wv) & 63; E(acc, cur, wr, wc, l2 & 15, l2 >> 4); } S.done(cur);
        if (!has_next) break;
#pragma unroll
        for (int a = 0; a < 2; ++a)
#pragma unroll
            for (int b = 0; b < 2; ++b)
#pragma unroll
                for (int m = 0; m < 4; ++m)
#pragma unroll
                    for (int n = 0; n < 2; ++n) acc[a][b][m][n] = (f32x4){0.f, 0.f, 0.f, 0.f};
        cur = nxt; cA = nA; cB = nB; ++ui;
    }
    PG8_WAIT_V(0);
    if (wr == 0) PG8_BAR;
    PG8_BAR;
#undef PG8_SA
#undef PG8_SB
#undef PG8_STAGE
#undef PG8_LDA
#undef PG8_LDB
#undef PG8_MMA
#undef PG8_WAIT_V
#undef PG8_WAIT_L
#undef PG8_BAR
#undef PG8_SCHED
}
}

using pg8::bf16_t; using pg8::f32x4; using pg8::bf16x8; using pg8::u32x4; using pg8::u32x2;
#define LAS __attribute__((address_space(3)))

constexpr int D = 1024, DFF = 2816, NGU = 5632, NCOLS = 3840;
constexpr int MP = 16384, MS = 512, MT = 16896, MIN_ = 17152;
constexpr int LDS_BYTES = 147456;
constexpr size_t O_SHP = 17301504, O_WKP = O_SHP + 8192, O_RTP = O_WKP + 262144, O_SHS = O_RTP + 524288, O_WKS = O_SHS + 131072, O_RTS = O_WKS + 4194304;
constexpr size_t WS_ROPE = 16384;
constexpr size_t WS_WL   = WS_ROPE + 1050624;
constexpr size_t WS_WOUT = WS_WL + 786432;
constexpr size_t WS_WIN  = WS_WOUT + 2097152;
constexpr size_t WS_WGU  = WS_WIN + 7864320;
constexpr size_t WS_WD   = WS_WGU + 11534336;
constexpr size_t WS_XN   = WS_WD + 5767168;
constexpr size_t WS_BIG  = WS_XN + 35127296;
constexpr size_t WS_FO   = WS_BIG + 95158272;
constexpr size_t WS_YS   = WS_BIG + 131727360;
constexpr size_t WS_LA   = WS_YS + 17301504;
constexpr size_t WS_OMD  = WS_BIG + 164364288;
constexpr size_t WS_ASIG = WS_OMD + 17301504;
constexpr size_t WS_END  = WS_ASIG + 17301504;
static_assert(WS_LA + 8650752 <= WS_OMD, "mixer overlays");
static_assert(WS_END <= 268435456, "workspace");

struct Params {
    const float *x_prompt, *x_sample, *state_shift, *state_wkv, *state_ret, *norm_g, *f1g, *f1u, *f1d, *w_in, *mu, *w0, *w2, *a0, *a2, *g2, *k_k, *k_a, *r_k, *lnx_w, *lnx_b, *gn_w, *w_out, *f2g, *f2u, *f2d;
    float* out; unsigned char* ws;
};
#define CAS __attribute__((address_space(4)))
typedef const CAS Params& PR;

__device__ __forceinline__ float bf2f(unsigned b) { return __uint_as_float(b << 16); }
__device__ __forceinline__ bf16_t f2bf(float f) { unsigned u = __float_as_uint(f); u += 0x7FFFu + ((u >> 16) & 1u); return (bf16_t)(u >> 16); }
__device__ __forceinline__ float lo_bf(unsigned x) { return __uint_as_float(x << 16); }
__device__ __forceinline__ float hi_bf(unsigned x) { return __uint_as_float(x & 0xffff0000u); }
template <int CTRL> __device__ __forceinline__ float dppf(float v) { return __int_as_float(__builtin_amdgcn_update_dpp(0, __float_as_int(v), CTRL, 0xF, 0xF, false)); }
__device__ __forceinline__ float row16_sum(float v) { v += dppf<0xB1>(v); v += dppf<0x4E>(v); v += dppf<0x141>(v); v += dppf<0x140>(v); return v; }
__device__ __forceinline__ float wave_sum(float v) { v = row16_sum(v); const int i = __float_as_int(v);
    return __int_as_float(__builtin_amdgcn_readlane(i, 0)) + __int_as_float(__builtin_amdgcn_readlane(i, 16)) + __int_as_float(__builtin_amdgcn_readlane(i, 32)) + __int_as_float(__builtin_amdgcn_readlane(i, 48)); }
__device__ __forceinline__ float quad_sum(float v) { v += dppf<0xB1>(v); v += dppf<0x4E>(v); return v; }
__device__ __forceinline__ float sigmoid_f(float x) { return __builtin_amdgcn_rcpf(1.0f + __expf(-x)); }


#define XB_TMO      128
#define XB_XCNT(j)  (256  + 64 * (j))
#define XB_XSUB(j)  (1280 + 64 * (j))
#define XB_XGEN(j)  (2304 + 64 * (j))
#define XB_TOP      3328
#define XB_TOPGEN   3392
#define XCD_BAR_WORDS 3456
#define XB_SPIN_CAP (1u << 18)
__device__ __forceinline__ unsigned xb_ld(unsigned* p)              { return __hip_atomic_load(p, __ATOMIC_RELAXED, __HIP_MEMORY_SCOPE_AGENT); }
__device__ __forceinline__ unsigned xb_add(unsigned* p, unsigned v) { return __hip_atomic_fetch_add(p, v, __ATOMIC_RELAXED, __HIP_MEMORY_SCOPE_AGENT); }
__device__ __forceinline__ unsigned xb_xcc_id() { return (unsigned)__builtin_amdgcn_s_getreg((3 << 11) | 20) & 0xFu; }
#define XB_SPIN(cond, bar) do { unsigned _sp = 0; while (cond) { __builtin_amdgcn_s_sleep(1); \
    if ((++_sp & 255u) == 0u) { if (xb_ld(&(bar)[XB_TMO])) break; if (_sp > XB_SPIN_CAP) { atomicAdd(&(bar)[XB_TMO], 1u); break; } } } } while (0)
struct XcdBarrier { unsigned* bar; unsigned x; volatile LAS unsigned* st; };
__device__ __forceinline__ XcdBarrier xcd_barrier_post(unsigned* bar, volatile LAS unsigned* st) {
    XcdBarrier b; b.bar = bar; b.x = xb_xcc_id(); b.st = st;
    return b;
}
__device__ __forceinline__ void xcd_barrier_complete(unsigned* bar, unsigned x, unsigned& nloc, unsigned& nx) {
    const unsigned G = gridDim.x * gridDim.y * gridDim.z;
    unsigned sum, cnt, mine, sp = 0u;
    for (;;) {
        sum = 0u; cnt = 0u; mine = 0u;
#pragma unroll
        for (unsigned j = 0; j < 16; ++j) { const unsigned c = xb_ld(&bar[XB_XCNT(j)]); sum += c; cnt += (c > 0u) ? 1u : 0u; mine = (j == x) ? c : mine; }
        if (sum == G) break;
        __builtin_amdgcn_s_sleep(1);
        if ((++sp & 255u) == 0u) { if (xb_ld(&bar[XB_TMO])) break; if (sp > XB_SPIN_CAP) { atomicAdd(&bar[XB_TMO], 1u); break; } }
    }
    nloc = mine > 0u ? mine : 1u; nx = cnt > 0u ? cnt : 1u;
}
__device__ __forceinline__ void xcd_barrier(unsigned* barw, volatile LAS unsigned* stw, const int wv) {
    XcdBarrier b; b.bar = barw; b.x = xb_xcc_id(); b.st = stw;
    asm volatile("s_waitcnt vmcnt(0)" ::: "memory");
    __syncthreads();
    if (fresh_tid(wv) == 0) {
        unsigned* bar = b.bar;
        __builtin_amdgcn_s_waitcnt(0);
        unsigned nloc = b.st[0], nx = b.st[1];
        if (nloc == 0u) { xcd_barrier_complete(bar, b.x, nloc, nx); b.st[0] = nloc; b.st[1] = nx; }
        const unsigned old = xb_add(&bar[XB_XSUB(b.x)], 1u);
        const unsigned gen = old / nloc;
        if (old + 1u == (gen + 1u) * nloc) {
            __builtin_amdgcn_fence(__ATOMIC_RELEASE, "agent");
            asm volatile("s_waitcnt vmcnt(0)" ::: "memory");
            const unsigned og = xb_add(&bar[XB_TOP], 1u);
            const unsigned tg = og / nx;
            if (og + 1u == (tg + 1u) * nx) xb_add(&bar[XB_TOPGEN], 1u);
            else XB_SPIN(xb_ld(&bar[XB_TOPGEN]) == tg, bar);
            __builtin_amdgcn_fence(__ATOMIC_ACQUIRE, "agent");
            xb_add(&bar[XB_XGEN(b.x)], 1u);
            asm volatile("s_waitcnt vmcnt(0)" ::: "memory");
        } else {
            XB_SPIN(xb_ld(&bar[XB_XGEN(b.x)]) == gen, bar);
            __builtin_amdgcn_fence(__ATOMIC_ACQUIRE, "agent");
            asm volatile("s_waitcnt vmcnt(0)" ::: "memory");
        }
    }
    __syncthreads();
}


#define DPP2(x, y, CTRL, NOP) asm volatile(NOP "\n\tv_add_f32_dpp %0, %0, %0 " CTRL " row_mask:0xf bank_mask:0xf bound_ctrl:1\n\tv_add_f32_dpp %1, %1, %1 " CTRL " row_mask:0xf bank_mask:0xf bound_ctrl:1" : "+v"(x), "+v"(y))
#define DPP4(x, y, z, w, CTRL, NOP) asm volatile(NOP "\n\tv_add_f32_dpp %0, %0, %0 " CTRL " row_mask:0xf bank_mask:0xf bound_ctrl:1\n\tv_add_f32_dpp %1, %1, %1 " CTRL " row_mask:0xf bank_mask:0xf bound_ctrl:1\n\tv_add_f32_dpp %2, %2, %2 " CTRL " row_mask:0xf bank_mask:0xf bound_ctrl:1\n\tv_add_f32_dpp %3, %3, %3 " CTRL " row_mask:0xf bank_mask:0xf bound_ctrl:1" : "+v"(x), "+v"(y), "+v"(z), "+v"(w))
#define ROW16_SUM4(x, y, z, w) do { DPP4(x, y, z, w, "quad_perm:[1,0,3,2]", "s_nop 1"); DPP4(x, y, z, w, "quad_perm:[2,3,0,1]", ""); DPP4(x, y, z, w, "row_half_mirror", ""); DPP4(x, y, z, w, "row_mirror", ""); } while (0)
#define ROW16_SUM2(x, y) do { DPP2(x, y, "quad_perm:[1,0,3,2]", "s_nop 1"); DPP2(x, y, "quad_perm:[2,3,0,1]", "s_nop 0"); DPP2(x, y, "row_half_mirror", "s_nop 0"); DPP2(x, y, "row_mirror", "s_nop 0"); } while (0)
__device__ __forceinline__ int prev_row(int r) {
    if (r < MP) return (r & 2047) == 0 ? -1 : r - 1;
    const int s = r - MP; return (s & 3) == 0 ? MT + (s >> 2) : r - 1;
}

struct TDesc { const float* W; bf16_t* Bt; int K, N, k0, n0, brow0; };
__device__ __forceinline__ TDesc tconv_desc(const float* wg, const float* wu, const float* wd, const float* win, const float* wout, unsigned char* ws, int i) {
    TDesc d; int mode = 0, tile = i;
    if (i < 704) { d.W = wg; d.Bt = (bf16_t*)(ws + WS_WGU); d.K = 1024; d.N = DFF; mode = 1; }
    else if (i < 1408) { d.W = wu; d.Bt = (bf16_t*)(ws + WS_WGU); d.K = 1024; d.N = DFF; mode = 2; tile = i - 704; }
    else if (i < 2112) { d.W = wd; d.Bt = (bf16_t*)(ws + WS_WD); d.K = DFF; d.N = 1024; tile = i - 1408; }
    else if (i < 3072) { d.W = win; d.Bt = (bf16_t*)(ws + WS_WIN); d.K = 1024; d.N = NCOLS; tile = i - 2112; }
    else { d.W = wout; d.Bt = (bf16_t*)(ws + WS_WOUT); d.K = 1024; d.N = 1024; tile = i - 3072; }
    const int nkt = d.K / 64; const int kt = tile % nkt, nt = tile / nkt; d.k0 = kt * 64; d.n0 = nt * 64;
    d.brow0 = mode == 0 ? d.n0 : ((d.n0 >> 7) * 256 + (d.n0 & 127) + (mode == 2 ? 128 : 0));
    return d;
}
__device__ __forceinline__ void tconv_list(const float* wg, const float* wu, const float* wd, const float* win, const float* wout, unsigned char* ws, const int ntiles, LAS float* t, const int wv) {
    const int tid = fresh_tid(wv); const int G = gridDim.x;
    float cur[8], nxt[8];
    int i = blockIdx.x;
    if (i < ntiles) { const TDesc d = tconv_desc(wg, wu, wd, win, wout, ws, i);
#pragma unroll
        for (int e = 0; e < 8; ++e) { const int idx = e * 512 + tid, r = idx >> 6, c = idx & 63; cur[e] = __builtin_nontemporal_load(d.W + (size_t)(d.k0 + r) * d.N + d.n0 + c); } }
    for (; i < ntiles; i += G) {
        const TDesc d = tconv_desc(wg, wu, wd, win, wout, ws, i);
        { const TDesc dn = tconv_desc(wg, wu, wd, win, wout, ws, i + G < ntiles ? i + G : i);
#pragma unroll
            for (int e = 0; e < 8; ++e) { const int idx = e * 512 + tid, r = idx >> 6, c = idx & 63; nxt[e] = __builtin_nontemporal_load(dn.W + (size_t)(dn.k0 + r) * dn.N + dn.n0 + c); } }
#pragma unroll
        for (int e = 0; e < 8; ++e) { const int idx = e * 512 + tid, r = idx >> 6, c = idx & 63; t[r * 65 + c] = cur[e]; }
        __syncthreads();
#pragma unroll
        for (int e = 0; e < 4; ++e) { const int idx = e * 512 + tid, n = idx >> 5, kp = idx & 31;
            const unsigned w = pg8::cvt_pk_bf16(t[(2 * kp) * 65 + n], t[(2 * kp + 1) * 65 + n]);
            *(unsigned*)(d.Bt + (size_t)(d.brow0 + n) * d.K + d.k0 + 2 * kp) = w; }
        __syncthreads();
#pragma unroll
        for (int e = 0; e < 8; ++e) cur[e] = nxt[e];
    }
}

struct RowRaw { float4 xf[4]; u32x2 xb[4]; u32x2 fb[4]; };
__device__ __forceinline__ void rows_load(PR P, const int mode, const int row, const int lane, RowRaw& R) {
    if (mode <= 1) { const float* xin = P.x_prompt + (size_t)row * 1024;
#pragma unroll
        for (int q = 0; q < 4; ++q) { const f32x4 t_ = __builtin_nontemporal_load((const f32x4*)(xin + (q * 64 + lane) * 4)); R.xf[q] = make_float4(t_[0], t_[1], t_[2], t_[3]); } }
    else { const bf16_t* xb = (mode == 2 ? (const bf16_t*)P.out : (const bf16_t*)(P.ws + WS_FO + 34603008)) + (size_t)row * 1024;
#pragma unroll
        for (int q = 0; q < 4; ++q) R.xb[q] = __builtin_nontemporal_load((const u32x2*)(xb + (q * 64 + lane) * 4)); }
    if (mode != 0) { const bf16_t* FO = (const bf16_t*)(P.ws + WS_FO) + (size_t)row * 1024;
#pragma unroll
        for (int q = 0; q < 4; ++q) R.fb[q] = __builtin_nontemporal_load((const u32x2*)(FO + (q * 64 + lane) * 4)); }
}
__device__ __forceinline__ void rows_proc(PR P, const int mode, const int row, const int lane, float4 (&xv)[4], const float4 (&fo)[4], const float4 (&gp)[4], const float4 (&gn)[4]) {
    bf16_t* XN = (bf16_t*)(P.ws + WS_XN);
    if (mode != 0) {
        float ss = 0.f;
#pragma unroll
        for (int q = 0; q < 4; ++q) ss += fo[q].x * fo[q].x + fo[q].y * fo[q].y + fo[q].z * fo[q].z + fo[q].w * fo[q].w;
        ss = wave_sum(ss); const float r = rsqrtf(ss * (1.0f / 1024.0f) + 1e-6f) * (mode == 2 ? 1.0f : 0.5f);
#pragma unroll
        for (int q = 0; q < 4; ++q) {
            xv[q].x += fo[q].x * r * gp[q].x; xv[q].y += fo[q].y * r * gp[q].y; xv[q].z += fo[q].z * r * gp[q].z; xv[q].w += fo[q].w * r * gp[q].w;
            if (mode == 3) { const f32x4 t_ = {xv[q].x, xv[q].y, xv[q].z, xv[q].w}; __builtin_nontemporal_store(t_, (f32x4*)(P.out + (size_t)row * 1024 + (q * 64 + lane) * 4)); }
            else { bf16_t* xo = (mode == 1 ? (bf16_t*)P.out : (bf16_t*)(P.ws + WS_FO + 34603008)) + (size_t)row * 1024; u32x2 t; t.x = pg8::cvt_pk_bf16(xv[q].x, xv[q].y); t.y = pg8::cvt_pk_bf16(xv[q].z, xv[q].w);
                __builtin_nontemporal_store(t, (u32x2*)(xo + (q * 64 + lane) * 4)); } }
        if (mode == 3) return;
    }
    float ss2 = 0.f;
#pragma unroll
    for (int q = 0; q < 4; ++q) ss2 += xv[q].x * xv[q].x + xv[q].y * xv[q].y + xv[q].z * xv[q].z + xv[q].w * xv[q].w;
    ss2 = wave_sum(ss2); const float r2 = rsqrtf(ss2 * (1.0f / 1024.0f) + 1e-6f);
    float* sh = nullptr;
    if (mode == 1) { if (row < MP) { if ((row & 2047) == 2047) sh = P.out + O_SHP + (size_t)(row >> 11) * 1024; } else { const int s = row - MP; if ((s & 3) == 3) sh = P.out + O_SHS + (size_t)(s >> 2) * 1024; } }
#pragma unroll
    for (int q = 0; q < 4; ++q) {
        float4 hv; hv.x = xv[q].x * r2 * gn[q].x; hv.y = xv[q].y * r2 * gn[q].y; hv.z = xv[q].z * r2 * gn[q].z; hv.w = xv[q].w * r2 * gn[q].w;
        u32x2 w; w.x = pg8::cvt_pk_bf16(hv.x, hv.y); w.y = pg8::cvt_pk_bf16(hv.z, hv.w);
        *(u32x2*)(XN + (size_t)row * 1024 + (q * 64 + lane) * 4) = w;
        if (sh) *(float4*)(sh + (q * 64 + lane) * 4) = hv; }
}
__device__ __forceinline__ void rows_phase(PR P, const int mode, LAS float* ldsf, const int wv) {
    const int tid = fresh_tid(wv); const int lane = tid & 63; const int gw = blockIdx.x * 8 + (tid >> 6), nw = gridDim.x * 8;
    const float* gpost = P.norm_g + (mode == 1 ? 1 : (mode == 2 ? 3 : 5)) * 1024;
    const float* gnext = P.norm_g + (mode == 0 ? 0 : (mode == 1 ? 2 : 4)) * 1024;
    float4 gp[4], gn[4];
#pragma unroll
    for (int q = 0; q < 4; ++q) { gp[q] = *(const float4*)(gpost + (q * 64 + lane) * 4); gn[q] = *(const float4*)(gnext + (q * 64 + lane) * 4); }
    if (gw < MP) {
        const int last = gw + ((MP - 1 - gw) / nw) * nw;
        RowRaw R, N;
        rows_load(P, mode, gw, lane, R);
        for (int row = gw; row < MP; row += nw) {
            const int nrow = row + nw < MP ? row + nw : last;
            rows_load(P, mode, nrow, lane, N);
            float4 xv[4], fo[4];
#pragma unroll
            for (int q = 0; q < 4; ++q) {
                xv[q] = mode <= 1 ? R.xf[q] : make_float4(lo_bf(R.xb[q].x), hi_bf(R.xb[q].x), lo_bf(R.xb[q].y), hi_bf(R.xb[q].y));
                fo[q] = make_float4(lo_bf(R.fb[q].x), hi_bf(R.fb[q].x), lo_bf(R.fb[q].y), hi_bf(R.fb[q].y)); }
            rows_proc(P, mode, row, lane, xv, fo, gp, gn);
            R = N;
        }
    }
    {
        const int wid = tid >> 6, q = wid & 3, row = MP + 2 * (int)blockIdx.x + (wid >> 2), col = q * 256 + lane * 4;
        const bool act = row < MT;
        float4 xv = make_float4(0.f, 0.f, 0.f, 0.f), fo = xv;
        if (act) {
            if (mode <= 1) xv = *(const float4*)(P.x_sample + (size_t)(row - MP) * 1024 + col);
            else { const u32x2 tb = *(const u32x2*)((mode == 2 ? (const bf16_t*)P.out : (const bf16_t*)(P.ws + WS_FO + 34603008)) + (size_t)row * 1024 + col); xv = make_float4(lo_bf(tb.x), hi_bf(tb.x), lo_bf(tb.y), hi_bf(tb.y)); }
            if (mode != 0) { const int KS = mode == 2 ? 4 : 8; const float* sl = (const float*)(P.ws + WS_OMD) + (size_t)((((row - MP) >> 8) * 4 + q) * KS) * 65536 + (size_t)(row & 255) * 256 + lane * 4;
                float4 a = *(const float4*)sl;
                for (int p = 1; p < KS; ++p) { const float4 b = *(const float4*)(sl + (size_t)p * 65536); a.x += b.x; a.y += b.y; a.z += b.z; a.w += b.w; }
                fo = a; }
        }
        if (mode != 0) {
            const float ssp = wave_sum(fo.x * fo.x + fo.y * fo.y + fo.z * fo.z + fo.w * fo.w);
            __syncthreads(); if (lane == 0) ldsf[wid] = ssp; __syncthreads();
            const float ss = ldsf[wid & 4] + ldsf[(wid & 4) + 1] + ldsf[(wid & 4) + 2] + ldsf[(wid & 4) + 3];
            const float r = rsqrtf(ss * (1.0f / 1024.0f) + 1e-6f) * (mode == 2 ? 1.0f : 0.5f);
            const float4 g = *(const float4*)(gpost + col);
            xv.x += fo.x * r * g.x; xv.y += fo.y * r * g.y; xv.z += fo.z * r * g.z; xv.w += fo.w * r * g.w;
            if (act) { if (mode == 3) *(float4*)(P.out + (size_t)row * 1024 + col) = xv;
                else { u32x2 tb; tb.x = pg8::cvt_pk_bf16(xv.x, xv.y); tb.y = pg8::cvt_pk_bf16(xv.z, xv.w); *(u32x2*)((mode == 1 ? (bf16_t*)P.out : (bf16_t*)(P.ws + WS_FO + 34603008)) + (size_t)row * 1024 + col) = tb; } }
        }
        if (mode != 3) {
            const float s2p = wave_sum(xv.x * xv.x + xv.y * xv.y + xv.z * xv.z + xv.w * xv.w);
            __syncthreads(); if (lane == 0) ldsf[8 + wid] = s2p; __syncthreads();
            const float ss2 = ldsf[8 + (wid & 4)] + ldsf[8 + (wid & 4) + 1] + ldsf[8 + (wid & 4) + 2] + ldsf[8 + (wid & 4) + 3];
            const float r2 = rsqrtf(ss2 * (1.0f / 1024.0f) + 1e-6f);
            const float4 g = *(const float4*)(gnext + col);
            float4 hv; hv.x = xv.x * r2 * g.x; hv.y = xv.y * r2 * g.y; hv.z = xv.z * r2 * g.z; hv.w = xv.w * r2 * g.w;
            if (act) { u32x2 w; w.x = pg8::cvt_pk_bf16(hv.x, hv.y); w.y = pg8::cvt_pk_bf16(hv.z, hv.w);
                *(u32x2*)((bf16_t*)(P.ws + WS_XN) + (size_t)row * 1024 + col) = w;
                if (mode == 1) { const int sr = row - MP; if ((sr & 3) == 3) *(float4*)(P.out + O_SHS + (size_t)(sr >> 2) * 1024 + col) = hv; } }
        }
        __syncthreads();
    }
}

__device__ __forceinline__ void p0_prologue(PR P, LAS float* ldsf, const int wv) {
    const int tid = fresh_tid(wv); const size_t gt = (size_t)blockIdx.x * 512 + tid, nth = (size_t)gridDim.x * 512;
    { float* rc = (float*)(P.ws + WS_ROPE); float* rs = rc + 2052 * 64;
      for (size_t i = gt; i < 2052 * 64; i += nth) { const int p = (int)(i >> 6), f = (int)(i & 63); const int pos = p < 2048 ? p : 16384 + (p - 2048);
          double inv = 1.0; for (int q = 0; q < f; ++q) inv *= 0.8659643233600653;
          const double ang = (double)pos * inv; const double n = rint(ang * 0.15915494309189535); const double r = ang - n * 6.283185307179586;
          const double r2 = r * r; double s = 0.0, c = 0.0;
          for (int k = 14; k >= 0; --k) { s = s * (-r2 / (double)((2 * k + 2) * (2 * k + 3))) + 1.0; c = c * (-r2 / (double)((2 * k + 1) * (2 * k + 2))) + 1.0; }
          rc[i] = (float)c; rs[i] = (float)(s * r); } }
    { bf16_t* Wl = (bf16_t*)(P.ws + WS_WL);
      for (size_t i = gt; i < 1536 * 256; i += nth) { const int n = (int)(i >> 8), k = (int)(i & 255); float v = 0.f;
          if (n < 512) { if (k < 64) v = P.w2[k * 512 + n]; } else if (n < 1024) { if (k >= 64 && k < 128) v = P.a2[(k - 64) * 512 + (n - 512)]; } else { if (k >= 128) v = P.g2[(k - 128) * 512 + (n - 1024)]; }
          Wl[i] = f2bf(v); } }
    { bf16_t* XN = (bf16_t*)(P.ws + WS_XN);
      for (size_t i = gt; i < 256 * 1024; i += nth) { const int r = (int)(i >> 10); XN[(size_t)MT * 1024 + i] = r < 128 ? f2bf(P.state_shift[i]) : (bf16_t)0; } }
    tconv_list(P.f1g, P.f1u, P.f1d, P.w_in, P.w_out, P.ws, 3328, ldsf, wv);
    rows_phase(P, 0, ldsf, wv);
}

__device__ __forceinline__ void lora_prep(PR P, const int wv) {
    const int tid = fresh_tid(wv); const int lane = tid & 63; const int gw = blockIdx.x * 8 + (tid >> 6), nw = gridDim.x * 8;
    const bf16_t* PS = (const bf16_t*)(P.ws + WS_BIG); bf16_t* LA = (bf16_t*)(P.ws + WS_LA);
    const float4 mu = *(const float4*)(P.mu + 1536 + lane * 4); const int kind = lane >> 4;
    if (gw >= MT) return;
    const int last = gw + ((MT - 1 - gw) / nw) * nw;
    u32x2 c, p, nc, np;
    { const int pr = prev_row(gw); c = *(const u32x2*)(PS + (size_t)gw * NCOLS + 1536 + lane * 4); p = *(const u32x2*)(PS + (size_t)(pr >= 0 ? pr : gw) * NCOLS + 1536 + lane * 4); }
    for (int row = gw; row < MT; row += nw) {
        const int nrow = row + nw < MT ? row + nw : last; const int npr = prev_row(nrow);
        nc = *(const u32x2*)(PS + (size_t)nrow * NCOLS + 1536 + lane * 4); np = *(const u32x2*)(PS + (size_t)(npr >= 0 ? npr : nrow) * NCOLS + 1536 + lane * 4);
        if (prev_row(row) < 0) p = (u32x2){0u, 0u};
        float v[4]; const float cu[4] = {lo_bf(c.x), hi_bf(c.x), lo_bf(c.y), hi_bf(c.y)}, pv[4] = {lo_bf(p.x), hi_bf(p.x), lo_bf(p.y), hi_bf(p.y)}, m4[4] = {mu.x, mu.y, mu.z, mu.w};
#pragma unroll
        for (int j = 0; j < 4; ++j) { float x = cu[j] + (pv[j] - cu[j]) * m4[j];
            if (kind == 0) x = 1.0f - 2.0f * __builtin_amdgcn_rcpf(__expf(2.0f * x) + 1.0f); else if (kind >= 2) x = sigmoid_f(x);
            v[j] = x; }
        u32x2 w; w.x = pg8::cvt_pk_bf16(v[0], v[1]); w.y = pg8::cvt_pk_bf16(v[2], v[3]);
        *(u32x2*)(LA + (size_t)row * 256 + lane * 4) = w;
        c = nc; p = np;
    }
}

template <bool SAMPLE>
__device__ __forceinline__ void rwkv_unit(PR P, LAS float* lds, const int b, const int h, const int half, const int wv) {
    constexpr int T = SAMPLE ? 4 : 2048, TC = SAMPLE ? 4 : 32, NCH = T / TC;
    const int tid = fresh_tid(wv), lane = tid & 63, wid = tid >> 6;
    const bf16_t* PS = (const bf16_t*)(P.ws + WS_BIG); const bf16_t* OMD = (const bf16_t*)(P.ws + WS_OMD); const bf16_t* ASIG = (const bf16_t*)(P.ws + WS_ASIG);
    bf16_t* YS = (bf16_t*)(P.ws + WS_YS);
    const int row_base = SAMPLE ? MP + b * 4 : b * 2048;
    const int ltok = (tid - 256) >> 4, lcg = tid & 15; const bool lwave = tid >= 256; const int hch = h * 64 + lcg * 4;
    const float4 mur = *(const float4*)(P.mu + hch), muk = *(const float4*)(P.mu + 512 + hch), muv = *(const float4*)(P.mu + 1024 + hch);
    const float4 kk4 = *(const float4*)(P.k_k + hch), ka4 = *(const float4*)(P.k_a + hch);
    typedef float f32x2 __attribute__((ext_vector_type(2)));
    const int row0 = half * 32 + (wid & 3) * 8 + (lane >> 4) * 2, cgl = lane & 15, j0 = cgl * 4;
    f32x2 S[4];
#pragma unroll
    for (int c = 0; c < 4; ++c) S[c] = (f32x2){0.f, 0.f};
    float* sout = P.out + (SAMPLE ? O_WKS : O_WKP) + ((size_t)(b * 8 + h) * 64 + row0) * 64 + j0;
    if (SAMPLE && wid < 4) { const float* sp = P.state_wkv + ((size_t)(b * 8 + h) * 64 + row0) * 64 + j0; const float4 s0 = *(const float4*)sp, s1 = *(const float4*)(sp + 64);
        S[0] = (f32x2){s0.x, s1.x}; S[1] = (f32x2){s0.y, s1.y}; S[2] = (f32x2){s0.z, s1.z}; S[3] = (f32x2){s0.w, s1.w}; }
    LAS float* buf0 = lds; LAS float* buf1 = lds + TC * 384;
    u32x2 cr[2], ck[2], cv[2], pr[2], pk[2], pv[2], co[2], ca[2];
#define RW_LOAD1(c, U) do { if (lwave && ltok + 16 * (U) < TC) { const int t_ = (c) * TC + ltok + 16 * (U); const int row_ = row_base + t_; const int prow_ = SAMPLE ? (t_ == 0 ? MT + b : row_ - 1) : row_ - 1; \
        const bf16_t* cp_ = PS + (size_t)row_ * NCOLS + hch; cr[U] = *(const u32x2*)cp_; ck[U] = *(const u32x2*)(cp_ + 512); cv[U] = *(const u32x2*)(cp_ + 1024); \
        if (SAMPLE || t_ > 0) { const bf16_t* pp_ = PS + (size_t)prow_ * NCOLS + hch; pr[U] = *(const u32x2*)pp_; pk[U] = *(const u32x2*)(pp_ + 512); pv[U] = *(const u32x2*)(pp_ + 1024); } \
        else { pr[U] = (u32x2){0u, 0u}; pk[U] = pr[U]; pv[U] = pr[U]; } \
        co[U] = *(const u32x2*)(OMD + (size_t)row_ * 512 + hch); ca[U] = *(const u32x2*)(ASIG + (size_t)row_ * 512 + hch); } } while (0)
#define RW_LOAD(c) do { RW_LOAD1(c, 0); RW_LOAD1(c, 1); } while (0)
#define RW_MIX(cu, pv_, m) ((cu) + ((pv_) - (cu)) * (m))
#define RW_PROC1(dst, U) do { if (lwave && ltok + 16 * (U) < TC) { LAS float* d_ = (dst) + (ltok + 16 * (U)) * 384 + lcg * 4; \
        f32x4 r_, k_, v_, o_, a_; \
        r_[0] = RW_MIX(lo_bf(cr[U].x), lo_bf(pr[U].x), mur.x); r_[1] = RW_MIX(hi_bf(cr[U].x), hi_bf(pr[U].x), mur.y); r_[2] = RW_MIX(lo_bf(cr[U].y), lo_bf(pr[U].y), mur.z); r_[3] = RW_MIX(hi_bf(cr[U].y), hi_bf(pr[U].y), mur.w); \
        k_[0] = RW_MIX(lo_bf(ck[U].x), lo_bf(pk[U].x), muk.x); k_[1] = RW_MIX(hi_bf(ck[U].x), hi_bf(pk[U].x), muk.y); k_[2] = RW_MIX(lo_bf(ck[U].y), lo_bf(pk[U].y), muk.z); k_[3] = RW_MIX(hi_bf(ck[U].y), hi_bf(pk[U].y), muk.w); \
        v_[0] = RW_MIX(lo_bf(cv[U].x), lo_bf(pv[U].x), muv.x); v_[1] = RW_MIX(hi_bf(cv[U].x), hi_bf(pv[U].x), muv.y); v_[2] = RW_MIX(lo_bf(cv[U].y), lo_bf(pv[U].y), muv.z); v_[3] = RW_MIX(hi_bf(cv[U].y), hi_bf(pv[U].y), muv.w); \
        o_[0] = lo_bf(co[U].x); o_[1] = hi_bf(co[U].x); o_[2] = lo_bf(co[U].y); o_[3] = hi_bf(co[U].y); a_[0] = lo_bf(ca[U].x); a_[1] = hi_bf(ca[U].x); a_[2] = lo_bf(ca[U].y); a_[3] = hi_bf(ca[U].y); \
        f32x4 kk_; kk_[0] = k_[0] * kk4.x; kk_[1] = k_[1] * kk4.y; kk_[2] = k_[2] * kk4.z; kk_[3] = k_[3] * kk4.w; \
        float ss_ = kk_[0] * kk_[0] + kk_[1] * kk_[1] + kk_[2] * kk_[2] + kk_[3] * kk_[3]; ss_ = row16_sum(ss_); \
        const float inv_ = __builtin_amdgcn_rcpf(fmaxf(__builtin_amdgcn_sqrtf(ss_), 1e-12f)); kk_ = kk_ * inv_; \
        f32x4 kn_; kn_[0] = k_[0] * (1.0f + (a_[0] - 1.0f) * ka4.x); kn_[1] = k_[1] * (1.0f + (a_[1] - 1.0f) * ka4.y); kn_[2] = k_[2] * (1.0f + (a_[2] - 1.0f) * ka4.z); kn_[3] = k_[3] * (1.0f + (a_[3] - 1.0f) * ka4.w); \
        *(LAS f32x4*)(d_) = r_; *(LAS f32x4*)(d_ + 64) = o_; *(LAS f32x4*)(d_ + 128) = kn_; *(LAS f32x4*)(d_ + 192) = -kk_; *(LAS f32x4*)(d_ + 256) = kk_ * a_; *(LAS f32x4*)(d_ + 320) = v_; } } while (0)
#define RW_PROC(dst) do { RW_PROC1(dst, 0); RW_PROC1(dst, 1); } while (0)
    RW_LOAD(0); RW_PROC(buf0); __syncthreads();
    for (int c = 0; c < NCH; ++c) {
        LAS float* cur = (c & 1) ? buf1 : buf0; LAS float* nxt = (c & 1) ? buf0 : buf1;
        if (c + 1 < NCH) RW_LOAD(c + 1);
        if (wid < 4) {
            constexpr int GS = SAMPLE ? 4 : 16;
            for (int g = 0; g < TC / GS; ++g) {
                float yk0 = 0.f, yk1 = 0.f;
                const LAS float* q0 = cur + (g * GS) * 384;
                f32x4 r4 = *(const LAS f32x4*)(q0 + j0), o4 = *(const LAS f32x4*)(q0 + 64 + j0), k4 = *(const LAS f32x4*)(q0 + 128 + j0), a4 = *(const LAS f32x4*)(q0 + 192 + j0), b4 = *(const LAS f32x4*)(q0 + 256 + j0);
                f32x2 v2 = *(const LAS f32x2*)(q0 + 320 + row0);
                float py0 = 0.f, py1 = 0.f;
#pragma unroll
                for (int tt = 0; tt < GS; ++tt) {
                    const LAS float* qn = q0 + (tt + 1 < GS ? tt + 1 : tt) * 384;
                    const f32x4 nr4 = *(const LAS f32x4*)(qn + j0), no4 = *(const LAS f32x4*)(qn + 64 + j0), nk4 = *(const LAS f32x4*)(qn + 128 + j0), na4 = *(const LAS f32x4*)(qn + 192 + j0), nb4 = *(const LAS f32x4*)(qn + 256 + j0);
                    const f32x2 nv2 = *(const LAS f32x2*)(qn + 320 + row0);
                    f32x2 sa = (S[0] * a4[0] + S[1] * a4[1]) + (S[2] * a4[2] + S[3] * a4[3]);
                    float sx = sa.x, sy = sa.y; ROW16_SUM4(sx, sy, py0, py1); sa = (f32x2){sx, sy};
                    if (tt > 0) { yk0 = cgl == tt - 1 ? py0 : yk0; yk1 = cgl == tt - 1 ? py1 : yk1; }
#pragma unroll
                    for (int c = 0; c < 4; ++c) { f32x2 t = S[c] - S[c] * o4[c]; t = t + sa * b4[c]; S[c] = t + v2 * k4[c]; }
                    const f32x2 y = (S[0] * r4[0] + S[1] * r4[1]) + (S[2] * r4[2] + S[3] * r4[3]);
                    py0 = y.x; py1 = y.y;
                    r4 = nr4; o4 = no4; k4 = nk4; a4 = na4; b4 = nb4; v2 = nv2;
                }
                ROW16_SUM2(py0, py1); yk0 = cgl == GS - 1 ? py0 : yk0; yk1 = cgl == GS - 1 ? py1 : yk1;
                if (cgl < GS) *(unsigned*)(YS + (size_t)(row_base + c * TC + g * GS + cgl) * 512 + h * 64 + row0) = pg8::cvt_pk_bf16(yk0, yk1);
            }
        }
        if (c + 1 < NCH) RW_PROC(nxt);
        __syncthreads();
    }
    if (wid < 4) { *(float4*)sout = make_float4(S[0].x, S[1].x, S[2].x, S[3].x); *(float4*)(sout + 64) = make_float4(S[0].y, S[1].y, S[2].y, S[3].y); }
#undef RW_LOAD
#undef RW_PROC
#undef RW_LOAD1
#undef RW_PROC1
#undef RW_MIX
}

__device__ __forceinline__ void ret_sample_unit(PR P, LAS float* lds, const int b, const int h, const int wv) {
    const int tid = fresh_tid(wv), lane = tid & 63, wid = tid >> 6;
    const bf16_t* PS = (const bf16_t*)(P.ws + WS_BIG); bf16_t* Y = (bf16_t*)(P.ws + WS_XN);
    const float* rc = (const float*)(P.ws + WS_ROPE); const float* rs = rc + 2052 * 64;
    LAS float* q = lds; LAS float* k = lds + 512; LAS float* v = lds + 1024; LAS float* Pm = lds + 1536; LAS float* y2p = lds + 1600; LAS float* red = lds + 1600 + 2048;
    const float lg2 = log2f(1.0f - exp2f(-5.0f - (float)h));
    const int row0 = MP + b * 4;
    { const int t = (tid & 255) >> 6, f = tid & 63; const bf16_t* src = PS + (size_t)(row0 + t) * NCOLS + 1792 + h * 128;
      if (tid < 256) { const float cs = rc[(2048 + t) * 64 + f], sn = rs[(2048 + t) * 64 + f];
          const float q1 = bf2f(src[f]), q2 = bf2f(src[f + 64]); q[t * 128 + f] = q1 * cs - q2 * sn; q[t * 128 + f + 64] = q1 * sn + q2 * cs;
          const float k1 = bf2f(src[512 + f]), k2 = bf2f(src[512 + f + 64]); k[t * 128 + f] = (k1 * cs - k2 * sn) * 0.08838834764831845f; k[t * 128 + f + 64] = (k1 * sn + k2 * cs) * 0.08838834764831845f; }
      else { v[t * 128 + f] = bf2f(src[1024 + f]); v[t * 128 + f + 64] = bf2f(src[1024 + f + 64]); } }
    __syncthreads();
    if (wid == 0) { const int pi = lane >> 4, pj = (lane >> 2) & 3, part = lane & 3; float s = 0.f;
        for (int d = part * 32; d < part * 32 + 32; ++d) s += q[pi * 128 + d] * k[pj * 128 + d];
        s = quad_sum(s); if (part == 0) Pm[pi * 4 + pj] = pi >= pj ? s * exp2f(lg2 * (float)(pi - pj)) : 0.f; }
    { const int e = tid & 127, dg = tid >> 7; const float c4 = exp2f(lg2 * 4.0f), g3 = exp2f(lg2 * 3.0f), g2_ = exp2f(lg2 * 2.0f), g1 = exp2f(lg2);
      const float v0 = v[e] * g3, v1 = v[128 + e] * g2_, v2 = v[256 + e] * g1, v3 = v[384 + e];
      const float* S0 = P.state_ret + ((size_t)(b * 4 + h) * 128) * 128 + e; float* So = P.out + O_RTS + ((size_t)(b * 4 + h) * 128) * 128 + e;
      float a0 = 0.f, a1 = 0.f, a2 = 0.f, a3 = 0.f;
      float sv[32];
#pragma unroll
      for (int x = 0; x < 32; ++x) sv[x] = S0[(size_t)(dg * 32 + x) * 128];
#pragma unroll
      for (int x = 0; x < 32; ++x) { const int d = dg * 32 + x; const float s = sv[x];
          a0 = fmaf(q[d], s, a0); a1 = fmaf(q[128 + d], s, a1); a2 = fmaf(q[256 + d], s, a2); a3 = fmaf(q[384 + d], s, a3);
          So[(size_t)d * 128] = s * c4 + k[d] * v0 + k[128 + d] * v1 + k[256 + d] * v2 + k[384 + d] * v3; }
      y2p[(dg * 4 + 0) * 128 + e] = a0; y2p[(dg * 4 + 1) * 128 + e] = a1; y2p[(dg * 4 + 2) * 128 + e] = a2; y2p[(dg * 4 + 3) * 128 + e] = a3; }
    __syncthreads();
    { const int i = tid >> 7, e = tid & 127;
      float y = (y2p[(0 + i) * 128 + e] + y2p[(4 + i) * 128 + e] + y2p[(8 + i) * 128 + e] + y2p[(12 + i) * 128 + e]) * exp2f(lg2 * (float)(i + 1));
#pragma unroll
      for (int j = 0; j < 4; ++j) y = fmaf(Pm[i * 4 + j], v[j * 128 + e], y);
      float s = wave_sum(y); if (lane == 0) red[wid] = s; __syncthreads();
      const float mean = (red[i * 2] + red[i * 2 + 1]) * (1.0f / 128.0f); const float dlt = y - mean;
      float s2 = wave_sum(dlt * dlt); if (lane == 0) red[8 + wid] = s2; __syncthreads();
      const float var = (red[8 + i * 2] + red[8 + i * 2 + 1]) * (1.0f / 128.0f);
      const float g = bf2f(PS[(size_t)(row0 + i) * NCOLS + 1792 + 1536 + h * 128 + e]);
      const float o = dlt * rsqrtf(var + 1e-5f) * P.gn_w[h * 128 + e] * (g * __builtin_amdgcn_rcpf(1.0f + __expf(-g)));
      Y[(size_t)(row0 + i) * 1024 + 512 + h * 128 + e] = f2bf(o); }
    __syncthreads();
}

__device__ __forceinline__ bf16_t* kvb_ptr(unsigned char* ws, int bh) { return (bf16_t*)(bh < 29 ? ws + WS_LA + (size_t)bh * 524288 : ws + WS_WIN + 17301504 + (size_t)(bh - 29) * 524288); }
constexpr int RS = 136, BUFE = 128 * RS;

template <bool WITH_K>
__device__ __forceinline__ void ret_load_qk(PR P, LAS bf16_t* QP, LAS bf16_t* KB, unsigned (&kth)[4][4], const int tidv, const int row0, const int n, const int h, const float kd0, const float g32) {
    const bf16_t* PS = (const bf16_t*)(P.ws + WS_BIG); const float* rc = (const float*)(P.ws + WS_ROPE); const float* rs = rc + 2052 * 64;
    float kd = kd0;
#pragma unroll
    for (int it = 0; it < 4; ++it) { const int idx = it * 512 + tidv, i = idx >> 4, f = (idx & 15) * 4;
        const bf16_t* src = PS + (size_t)(row0 + i) * NCOLS + 1792 + h * 128;
        const u32x2 q1 = *(const u32x2*)(src + f), q2 = *(const u32x2*)(src + 64 + f);
        u32x2 k1 = (u32x2){0u, 0u}, k2 = k1; if (WITH_K) { k1 = *(const u32x2*)(src + 512 + f); k2 = *(const u32x2*)(src + 576 + f); }
        const float4 cs = *(const float4*)(rc + (size_t)(n * 128 + i) * 64 + f), sn = *(const float4*)(rs + (size_t)(n * 128 + i) * 64 + f);
        const float c4[4] = {cs.x, cs.y, cs.z, cs.w}, s4[4] = {sn.x, sn.y, sn.z, sn.w};
        const float qa[4] = {lo_bf(q1.x), hi_bf(q1.x), lo_bf(q1.y), hi_bf(q1.y)}, qb[4] = {lo_bf(q2.x), hi_bf(q2.x), lo_bf(q2.y), hi_bf(q2.y)};
        float qo1[4], qo2[4];
#pragma unroll
        for (int x = 0; x < 4; ++x) { qo1[x] = qa[x] * c4[x] - qb[x] * s4[x]; qo2[x] = qa[x] * s4[x] + qb[x] * c4[x]; }
        u32x2 w; w.x = pg8::cvt_pk_bf16(qo1[0], qo1[1]); w.y = pg8::cvt_pk_bf16(qo1[2], qo1[3]); *(LAS u32x2*)(QP + i * RS + f) = w;
        w.x = pg8::cvt_pk_bf16(qo2[0], qo2[1]); w.y = pg8::cvt_pk_bf16(qo2[2], qo2[3]); *(LAS u32x2*)(QP + i * RS + 64 + f) = w;
        if (WITH_K) {
            const float ka[4] = {lo_bf(k1.x), hi_bf(k1.x), lo_bf(k1.y), hi_bf(k1.y)}, kb[4] = {lo_bf(k2.x), hi_bf(k2.x), lo_bf(k2.y), hi_bf(k2.y)};
            float ko1[4], ko2[4];
#pragma unroll
            for (int x = 0; x < 4; ++x) { ko1[x] = (ka[x] * c4[x] - kb[x] * s4[x]) * 0.08838834764831845f; ko2[x] = (ka[x] * s4[x] + kb[x] * c4[x]) * 0.08838834764831845f; }
            w.x = pg8::cvt_pk_bf16(ko1[0], ko1[1]); w.y = pg8::cvt_pk_bf16(ko1[2], ko1[3]); *(LAS u32x2*)(KB + i * RS + f) = w;
            w.x = pg8::cvt_pk_bf16(ko2[0], ko2[1]); w.y = pg8::cvt_pk_bf16(ko2[2], ko2[3]); *(LAS u32x2*)(KB + i * RS + 64 + f) = w;
            kth[it][0] = pg8::cvt_pk_bf16(ko1[0] * kd, ko1[1] * kd); kth[it][1] = pg8::cvt_pk_bf16(ko1[2] * kd, ko1[3] * kd);
            kth[it][2] = pg8::cvt_pk_bf16(ko2[0] * kd, ko2[1] * kd); kth[it][3] = pg8::cvt_pk_bf16(ko2[2] * kd, ko2[3] * kd); kd *= g32; }
        if (it & 1) __builtin_amdgcn_sched_barrier(0); }
}

__device__ __forceinline__ void ret_unit_a(PR P, LAS unsigned char* lds, const int bh, const int n, const int wv) {
    LAS bf16_t* QP = (LAS bf16_t*)lds; LAS bf16_t* KB = QP + BUFE; LAS bf16_t* VT = KB + BUFE;
    const int tid = fresh_tid(wv), lane = tid & 63, wid = tid >> 6, wr = wid >> 1, wc = wid & 1, fr = lane & 15, fq = lane >> 4;
    const int b = bh >> 2, h = bh & 3;
    const bf16_t* PS = (const bf16_t*)(P.ws + WS_BIG); bf16_t* Y = (bf16_t*)(P.ws + WS_XN); bf16_t* KVB = kvb_ptr(P.ws, bh) + (size_t)n * 16384;
    const float lg2 = log2f(1.0f - exp2f(-5.0f - (float)h));
    const float kd0 = exp2f(lg2 * (float)(127 - (tid >> 4))), g32 = exp2f(-32.0f * lg2);
    const int row0 = b * 2048 + n * 128;
    unsigned kth[4][4];
    ret_load_qk<true>(P, QP, KB, kth, tid, row0, n, h, kd0, g32);
#pragma unroll
    for (int it = 0; it < 4; ++it) { const int idx = it * 512 + tid, j = idx >> 4, e = (idx & 15) * 8;
        const u32x4 vv = *(const u32x4*)(PS + (size_t)(row0 + j) * NCOLS + 1792 + 1024 + h * 128 + e);
        LAS bf16_t* d = VT + e * RS + j;
        d[0] = (bf16_t)(vv.x & 0xffffu); d[RS] = (bf16_t)(vv.x >> 16); d[2 * RS] = (bf16_t)(vv.y & 0xffffu); d[3 * RS] = (bf16_t)(vv.y >> 16);
        d[4 * RS] = (bf16_t)(vv.z & 0xffffu); d[5 * RS] = (bf16_t)(vv.z >> 16); d[6 * RS] = (bf16_t)(vv.w & 0xffffu); d[7 * RS] = (bf16_t)(vv.w >> 16); }
    __syncthreads();
    f32x4 accP[2][4];
#pragma unroll
    for (int mt = 0; mt < 2; ++mt)
#pragma unroll
        for (int nt = 0; nt < 4; ++nt) accP[mt][nt] = (f32x4){0.f, 0.f, 0.f, 0.f};
#pragma unroll
    for (int ks = 0; ks < 4; ++ks) { bf16x8 aq[2];
#pragma unroll
        for (int mt = 0; mt < 2; ++mt) aq[mt] = *(const LAS bf16x8*)(QP + (wr * 32 + mt * 16 + fr) * RS + ks * 32 + fq * 8);
#pragma unroll
        for (int nt = 0; nt < 4; ++nt) { const bf16x8 bk = *(const LAS bf16x8*)(KB + (wc * 64 + nt * 16 + fr) * RS + ks * 32 + fq * 8);
#pragma unroll
            for (int mt = 0; mt < 2; ++mt) accP[mt][nt] = __builtin_amdgcn_mfma_f32_16x16x32_bf16(aq[mt], bk, accP[mt][nt], 0, 0, 0); }
        __builtin_amdgcn_sched_barrier(0); }
    __syncthreads();
    { float ri[2][4], cj[4];
#pragma unroll
      for (int mt = 0; mt < 2; ++mt)
#pragma unroll
          for (int j = 0; j < 4; ++j) ri[mt][j] = exp2f(lg2 * (float)(wr * 32 + mt * 16 + fq * 4 + j));
#pragma unroll
      for (int nt = 0; nt < 4; ++nt) cj[nt] = exp2f(-lg2 * (float)(wc * 64 + nt * 16 + fr));
#pragma unroll
      for (int mt = 0; mt < 2; ++mt)
#pragma unroll
          for (int nt = 0; nt < 4; ++nt)
#pragma unroll
              for (int j = 0; j < 4; ++j) { const int i = wr * 32 + mt * 16 + fq * 4 + j, jj = wc * 64 + nt * 16 + fr;
                  const float val = i >= jj ? accP[mt][nt][j] * ri[mt][j] * cj[nt] : 0.f; QP[i * RS + jj] = f2bf(val); } }
#pragma unroll
    for (int it = 0; it < 4; ++it) { const int idx = it * 512 + tid, j = idx >> 4, f = (idx & 15) * 4; LAS bf16_t* d = KB + f * RS + j;
        d[0] = (bf16_t)(kth[it][0] & 0xffffu); d[RS] = (bf16_t)(kth[it][0] >> 16); d[2 * RS] = (bf16_t)(kth[it][1] & 0xffffu); d[3 * RS] = (bf16_t)(kth[it][1] >> 16);
        LAS bf16_t* d2 = d + 64 * RS;
        d2[0] = (bf16_t)(kth[it][2] & 0xffffu); d2[RS] = (bf16_t)(kth[it][2] >> 16); d2[2 * RS] = (bf16_t)(kth[it][3] & 0xffffu); d2[3 * RS] = (bf16_t)(kth[it][3] >> 16); }
    __syncthreads();
    f32x4 accY[2][4], accS[2][4];
#pragma unroll
    for (int mt = 0; mt < 2; ++mt)
#pragma unroll
        for (int nt = 0; nt < 4; ++nt) { accY[mt][nt] = (f32x4){0.f, 0.f, 0.f, 0.f}; accS[mt][nt] = (f32x4){0.f, 0.f, 0.f, 0.f}; }
#pragma unroll
    for (int ks = 0; ks < 4; ++ks) { bf16x8 ap[2], av[2];
#pragma unroll
        for (int mt = 0; mt < 2; ++mt) { ap[mt] = *(const LAS bf16x8*)(QP + (wr * 32 + mt * 16 + fr) * RS + ks * 32 + fq * 8); av[mt] = *(const LAS bf16x8*)(VT + (wr * 32 + mt * 16 + fr) * RS + ks * 32 + fq * 8); }
#pragma unroll
        for (int nt = 0; nt < 4; ++nt) { const bf16x8 bv = *(const LAS bf16x8*)(VT + (wc * 64 + nt * 16 + fr) * RS + ks * 32 + fq * 8), bkt = *(const LAS bf16x8*)(KB + (wc * 64 + nt * 16 + fr) * RS + ks * 32 + fq * 8);
#pragma unroll
            for (int mt = 0; mt < 2; ++mt) { accY[mt][nt] = __builtin_amdgcn_mfma_f32_16x16x32_bf16(ap[mt], bv, accY[mt][nt], 0, 0, 0); accS[mt][nt] = __builtin_amdgcn_mfma_f32_16x16x32_bf16(av[mt], bkt, accS[mt][nt], 0, 0, 0); } }
        __builtin_amdgcn_sched_barrier(0); }
#pragma unroll
    for (int mt = 0; mt < 2; ++mt)
#pragma unroll
        for (int nt = 0; nt < 4; ++nt)
#pragma unroll
            for (int j = 0; j < 4; ++j) { const int r = wr * 32 + mt * 16 + fq * 4 + j, c = wc * 64 + nt * 16 + fr;
                Y[(size_t)(row0 + r) * 1024 + 512 + h * 128 + c] = f2bf(accY[mt][nt][j]); KVB[r * 128 + c] = f2bf(accS[mt][nt][j]); }
    __syncthreads();
}

__device__ __forceinline__ void ret_prefix(PR P, const int item) {
    const int bh = item >> 11, i8 = (item & 2047) * 8; const int h = bh & 3;
    bf16_t* KVB = kvb_ptr(P.ws, bh) + i8;
    const float lg2 = log2f(1.0f - exp2f(-5.0f - (float)h)); const float c_dec = exp2f(lg2 * 128.0f);
    u32x4 kv[16];
#pragma unroll
    for (int n = 0; n < 16; ++n) kv[n] = *(const u32x4*)(KVB + (size_t)n * 16384);
    float S[8];
#pragma unroll
    for (int x = 0; x < 8; ++x) S[x] = 0.f;
#pragma unroll
    for (int n = 0; n < 16; ++n) { u32x4 w; w.x = pg8::cvt_pk_bf16(S[0], S[1]); w.y = pg8::cvt_pk_bf16(S[2], S[3]); w.z = pg8::cvt_pk_bf16(S[4], S[5]); w.w = pg8::cvt_pk_bf16(S[6], S[7]);
        *(u32x4*)(KVB + (size_t)n * 16384) = w;
        const float k8[8] = {lo_bf(kv[n].x), hi_bf(kv[n].x), lo_bf(kv[n].y), hi_bf(kv[n].y), lo_bf(kv[n].z), hi_bf(kv[n].z), lo_bf(kv[n].w), hi_bf(kv[n].w)};
#pragma unroll
        for (int x = 0; x < 8; ++x) S[x] = S[x] * c_dec + k8[x]; }
    const int e = i8 >> 7, d0 = i8 & 127;
#pragma unroll
    for (int x = 0; x < 8; ++x) P.out[O_RTP + ((size_t)bh * 128 + d0 + x) * 128 + e] = S[x];
}

__device__ __forceinline__ void ret_unit_c(PR P, LAS unsigned char* lds, const int bh, const int n, const int wv) {
    LAS bf16_t* QP = (LAS bf16_t*)lds; LAS bf16_t* ST = QP + 3 * BUFE; LAS float* YST = (LAS float*)(QP + BUFE);
    const int tid = fresh_tid(wv), lane = tid & 63, wid = tid >> 6, wr = wid >> 1, wc = wid & 1, fr = lane & 15, fq = lane >> 4;
    const int b = bh >> 2, h = bh & 3;
    const bf16_t* PS = (const bf16_t*)(P.ws + WS_BIG); bf16_t* Y = (bf16_t*)(P.ws + WS_XN); const bf16_t* KVB = kvb_ptr(P.ws, bh) + (size_t)n * 16384;
    const float lg2 = log2f(1.0f - exp2f(-5.0f - (float)h));
    const int row0 = b * 2048 + n * 128;
    unsigned kth[4][4];
    ret_load_qk<false>(P, QP, QP, kth, tid, row0, n, h, 0.f, 0.f);
#pragma unroll
    for (int it = 0; it < 4; ++it) { const int idx = it * 512 + tid, e = idx >> 4, d8 = (idx & 15) * 8;
        *(LAS u32x4*)(ST + e * RS + d8) = *(const u32x4*)(KVB + e * 128 + d8); }
    __syncthreads();
    f32x4 accY[2][4];
#pragma unroll
    for (int mt = 0; mt < 2; ++mt)
#pragma unroll
        for (int nt = 0; nt < 4; ++nt) accY[mt][nt] = (f32x4){0.f, 0.f, 0.f, 0.f};
#pragma unroll
    for (int ks = 0; ks < 4; ++ks) { bf16x8 aq[2];
#pragma unroll
        for (int mt = 0; mt < 2; ++mt) aq[mt] = *(const LAS bf16x8*)(QP + (wr * 32 + mt * 16 + fr) * RS + ks * 32 + fq * 8);
#pragma unroll
        for (int nt = 0; nt < 4; ++nt) { const bf16x8 bs = *(const LAS bf16x8*)(ST + (wc * 64 + nt * 16 + fr) * RS + ks * 32 + fq * 8);
#pragma unroll
            for (int mt = 0; mt < 2; ++mt) accY[mt][nt] = __builtin_amdgcn_mfma_f32_16x16x32_bf16(aq[mt], bs, accY[mt][nt], 0, 0, 0); }
        __builtin_amdgcn_sched_barrier(0); }
#pragma unroll
    for (int mt = 0; mt < 2; ++mt)
#pragma unroll
        for (int j = 0; j < 4; ++j) { const int r = wr * 32 + mt * 16 + fq * 4 + j; const float qd = exp2f(lg2 * (float)(r + 1));
#pragma unroll
            for (int nt = 0; nt < 4; ++nt) YST[r * 132 + wc * 64 + nt * 16 + fr] = accY[mt][nt][j] * qd; }
    __syncthreads();
    { const int i = tid >> 2, part = tid & 3; float yv[32]; float s = 0.f;
      bf16_t* yo = Y + (size_t)(row0 + i) * 1024 + 512 + h * 128 + part * 32;
#pragma unroll
      for (int x = 0; x < 4; ++x) { const u32x4 y1 = *(const u32x4*)(yo + x * 8); const f32x4 ta = *(const LAS f32x4*)(YST + i * 132 + part * 32 + x * 8), tb = *(const LAS f32x4*)(YST + i * 132 + part * 32 + x * 8 + 4);
          yv[x * 8 + 0] = ta[0] + lo_bf(y1.x); yv[x * 8 + 1] = ta[1] + hi_bf(y1.x); yv[x * 8 + 2] = ta[2] + lo_bf(y1.y); yv[x * 8 + 3] = ta[3] + hi_bf(y1.y);
          yv[x * 8 + 4] = tb[0] + lo_bf(y1.z); yv[x * 8 + 5] = tb[1] + hi_bf(y1.z); yv[x * 8 + 6] = tb[2] + lo_bf(y1.w); yv[x * 8 + 7] = tb[3] + hi_bf(y1.w); }
#pragma unroll
      for (int x = 0; x < 32; ++x) s += yv[x];
      s = quad_sum(s); const float mean = s * (1.0f / 128.0f); float s2 = 0.f;
#pragma unroll
      for (int x = 0; x < 32; ++x) { yv[x] -= mean; s2 += yv[x] * yv[x]; }
      s2 = quad_sum(s2); const float rstd = rsqrtf(s2 * (1.0f / 128.0f) + 1e-5f);
      const bf16_t* gp = PS + (size_t)(row0 + i) * NCOLS + 1792 + 1536 + h * 128 + part * 32; const float* gw = P.gn_w + h * 128 + part * 32;
#pragma unroll
      for (int x = 0; x < 4; ++x) { const u32x4 g4 = *(const u32x4*)(gp + x * 8); const float4 w0 = *(const float4*)(gw + x * 8), w1 = *(const float4*)(gw + x * 8 + 4);
          const float gg[8] = {lo_bf(g4.x), hi_bf(g4.x), lo_bf(g4.y), hi_bf(g4.y), lo_bf(g4.z), hi_bf(g4.z), lo_bf(g4.w), hi_bf(g4.w)}; const float ww[8] = {w0.x, w0.y, w0.z, w0.w, w1.x, w1.y, w1.z, w1.w};
          float o[8];
#pragma unroll
          for (int z = 0; z < 8; ++z) o[z] = yv[x * 8 + z] * rstd * ww[z] * (gg[z] * __builtin_amdgcn_rcpf(1.0f + __expf(-gg[z])));
          u32x4 w; w.x = pg8::cvt_pk_bf16(o[0], o[1]); w.y = pg8::cvt_pk_bf16(o[2], o[3]); w.z = pg8::cvt_pk_bf16(o[4], o[5]); w.w = pg8::cvt_pk_bf16(o[6], o[7]);
          *(u32x4*)(yo + x * 8) = w; } }
    __syncthreads();
}

__device__ __forceinline__ void sub_barrier(unsigned* cnt, const unsigned target, const int wv) {
    asm volatile("s_waitcnt vmcnt(0)" ::: "memory");
    __syncthreads();
    if (fresh_tid(wv) == 0) {
        __builtin_amdgcn_fence(__ATOMIC_RELEASE, "agent");
        asm volatile("s_waitcnt vmcnt(0)" ::: "memory");
        (void)xb_add(cnt, 1u);
        unsigned sp = 0u;
        while (xb_ld(cnt) < target) { __builtin_amdgcn_s_sleep(2); if (++sp > (1u << 20)) break; }
        __builtin_amdgcn_fence(__ATOMIC_ACQUIRE, "agent");
        asm volatile("s_waitcnt vmcnt(0)" ::: "memory");
    }
    __syncthreads();
}

struct PostRegs { u32x2 yr, c_r, c_k, c_v, p_r, p_k, p_v, ar, gr; };
__device__ __forceinline__ void post_load(PR P, PostRegs& R, const int row, const int ch) {
    const bf16_t* PS = (const bf16_t*)(P.ws + WS_BIG); const bf16_t* ASIG = (const bf16_t*)(P.ws + WS_ASIG); const bf16_t* YS = (const bf16_t*)(P.ws + WS_YS); const bf16_t* G = (const bf16_t*)(P.ws + WS_WIN);
    R.yr = *(const u32x2*)(YS + (size_t)row * 512 + ch);
    const bf16_t* cp = PS + (size_t)row * NCOLS + ch; const int pr = prev_row(row);
    R.c_r = *(const u32x2*)cp; R.c_k = *(const u32x2*)(cp + 512); R.c_v = *(const u32x2*)(cp + 1024);
    { const bf16_t* pp = PS + (size_t)(pr >= 0 ? pr : row) * NCOLS + ch; R.p_r = *(const u32x2*)pp; R.p_k = *(const u32x2*)(pp + 512); R.p_v = *(const u32x2*)(pp + 1024); }
    R.ar = *(const u32x2*)(ASIG + (size_t)row * 512 + ch); R.gr = *(const u32x2*)(G + (size_t)row * 512 + ch);
}
__device__ __forceinline__ void rwkv_post(PR P, const int wv) {
    const int tid = fresh_tid(wv); const int lane = tid & 63; const int gw = blockIdx.x * 8 + (tid >> 6), nw = gridDim.x * 8;
    const int sub = lane >> 4, cg4 = (lane & 15) * 4;
    bf16_t* Y = (bf16_t*)(P.ws + WS_XN);
    const int h = (gw * 4 + sub) & 7, ch = h * 64 + cg4;
    const float4 mr = *(const float4*)(P.mu + ch), mk = *(const float4*)(P.mu + 512 + ch), mv = *(const float4*)(P.mu + 1024 + ch);
    const float4 ka = *(const float4*)(P.k_a + ch), rk = *(const float4*)(P.r_k + ch), lw = *(const float4*)(P.lnx_w + ch), lb = *(const float4*)(P.lnx_b + ch);
    const float m_r[4] = {mr.x, mr.y, mr.z, mr.w}, m_k[4] = {mk.x, mk.y, mk.z, mk.w}, m_v[4] = {mv.x, mv.y, mv.z, mv.w};
    const float kaa[4] = {ka.x, ka.y, ka.z, ka.w}, rkk[4] = {rk.x, rk.y, rk.z, rk.w}, lww[4] = {lw.x, lw.y, lw.z, lw.w}, lbb[4] = {lb.x, lb.y, lb.z, lb.w};
    PostRegs R, N;
    if (gw < MT * 2) post_load(P, R, (gw * 4 + sub) >> 3, ch);
    for (int task = gw; task < MT * 2; task += nw) {
        const int row = (task * 4 + sub) >> 3;
        { const int nt_ = task + nw < MT * 2 ? task + nw : task; post_load(P, N, (nt_ * 4 + sub) >> 3, ch); }
        if (prev_row(row) < 0) { R.p_r = (u32x2){0u, 0u}; R.p_k = R.p_r; R.p_v = R.p_r; }
        const float ys[4] = {lo_bf(R.yr.x), hi_bf(R.yr.x), lo_bf(R.yr.y), hi_bf(R.yr.y)};
        const float mean = row16_sum(ys[0] + ys[1] + ys[2] + ys[3]) * (1.0f / 64.0f);
        float dl[4], s2 = 0.f;
#pragma unroll
        for (int j = 0; j < 4; ++j) { dl[j] = ys[j] - mean; s2 += dl[j] * dl[j]; }
        const float rstd = rsqrtf(row16_sum(s2) * (1.0f / 64.0f) + 64e-5f);
        const float cr[4] = {lo_bf(R.c_r.x), hi_bf(R.c_r.x), lo_bf(R.c_r.y), hi_bf(R.c_r.y)}, ck[4] = {lo_bf(R.c_k.x), hi_bf(R.c_k.x), lo_bf(R.c_k.y), hi_bf(R.c_k.y)}, cv[4] = {lo_bf(R.c_v.x), hi_bf(R.c_v.x), lo_bf(R.c_v.y), hi_bf(R.c_v.y)};
        const float qr[4] = {lo_bf(R.p_r.x), hi_bf(R.p_r.x), lo_bf(R.p_r.y), hi_bf(R.p_r.y)}, qk[4] = {lo_bf(R.p_k.x), hi_bf(R.p_k.x), lo_bf(R.p_k.y), hi_bf(R.p_k.y)}, qv[4] = {lo_bf(R.p_v.x), hi_bf(R.p_v.x), lo_bf(R.p_v.y), hi_bf(R.p_v.y)};
        const float aa[4] = {lo_bf(R.ar.x), hi_bf(R.ar.x), lo_bf(R.ar.y), hi_bf(R.ar.y)}, gg[4] = {lo_bf(R.gr.x), hi_bf(R.gr.x), lo_bf(R.gr.y), hi_bf(R.gr.y)};
        float v[4], bp = 0.f;
#pragma unroll
        for (int j = 0; j < 4; ++j) { const float r = cr[j] + (qr[j] - cr[j]) * m_r[j], k = ck[j] + (qk[j] - ck[j]) * m_k[j]; v[j] = cv[j] + (qv[j] - cv[j]) * m_v[j];
            const float kn = k * (1.0f + (aa[j] - 1.0f) * kaa[j]); bp += r * kn * rkk[j]; }
        const float bonus = row16_sum(bp);
        float o[4];
#pragma unroll
        for (int j = 0; j < 4; ++j) o[j] = (dl[j] * rstd * lww[j] + lbb[j] + bonus * v[j]) * gg[j];
        u32x2 w; w.x = pg8::cvt_pk_bf16(o[0], o[1]); w.y = pg8::cvt_pk_bf16(o[2], o[3]);
        *(u32x2*)(Y + (size_t)row * 1024 + ch) = w;
        R = N;
    }
}

__global__ void __launch_bounds__(512, 2) hymba_mega(Params P_unused) {
    extern __shared__ __attribute__((aligned(16))) unsigned char shm[];
    cg::grid_group grid = cg::this_grid();
    LAS unsigned char* lds = (LAS unsigned char*)shm; LAS float* ldsf = (LAS float*)shm;
    const int G = gridDim.x, bx = blockIdx.x;
    const int wv = __builtin_amdgcn_readfirstlane(threadIdx.x >> 6);
    const CAS Params* kp = (const CAS Params*)__builtin_amdgcn_kernarg_segment_ptr();
#define P (*kp)
#define FRESH() asm volatile("" : "+s"(kp))
#ifndef REP_SYNC
#define REP_SYNC 1
#endif
#ifndef REP_P7
#define REP_P7 1
#endif
#ifndef REP_FFN1
#define REP_FFN1 1
#endif
#ifndef REP_P0
#define REP_P0 1
#endif
#ifndef REP_P3
#define REP_P3 1
#endif
#ifndef REP_RW
#define REP_RW 1
#endif
#ifndef REP_OTH
#define REP_OTH 1
#endif
#ifndef REP_RETP
#define REP_RETP 1
#endif
#ifndef REP_SAMP
#define REP_SAMP 1
#endif
#ifndef REP_P8
#define REP_P8 1
#endif
#define GSYNC() do { for (int r_ = 0; r_ < REP_SYNC; ++r_) xcd_barrier((unsigned*)ws, (volatile LAS unsigned*)(lds + LDS_BYTES - 16), wv); FRESH(); } while (0)
#define ws (kp->ws)
#define XN ((bf16_t*)(ws + WS_XN))
#define ACT ((bf16_t*)(ws + WS_BIG))
#define FO ((float*)(ws + WS_FO))
#define PS ((bf16_t*)(ws + WS_BIG))
    pg8::StaticOrder S;
    { const int t0 = fresh_tid(wv); if (t0 < 4) ((LAS unsigned*)(lds + LDS_BYTES - 16))[t0] = 0u;
      if (t0 == 0) (void)xb_add(&((unsigned*)ws)[XB_XCNT(xb_xcc_id())], 1u); }
    if (G == 0x7fffffff) grid.sync();
#ifndef PHM
#define PHM 0xFFFF
#endif
#define PH(k) if ((PHM >> (k)) & 1)
    for (int r0 = 0; r0 < REP_P0; ++r0) PH(0) p0_prologue(P, ldsf, wv);
    GSYNC();
    for (int rep1 = 0; rep1 < REP_FFN1; ++rep1) {
    PH(1) { pg8::Gemm g{XN, (const bf16_t*)(ws + WS_WGU), MT, NGU, 1024}; S.init(MT, NGU, G, bx, 1024); pg8::EpiSwiGLU E{ACT, DFF}; pg8::gemm_phase(lds, g, S, E, wv); }
    GSYNC();
    PH(2) { pg8::Gemm g{ACT, (const bf16_t*)(ws + WS_WD), MT, 1024, DFF}; pg8::SplitOrder S2; S2.init2(G, bx, DFF, 8); pg8::EpiFO E{(bf16_t*)FO, 1024, (float*)(ws + WS_OMD)}; pg8::gemm_phase(lds, g, S2, E, wv); }
    GSYNC();
    }
    for (int r3 = 0; r3 < REP_P3; ++r3) PH(3) rows_phase(P, 1, ldsf, wv);
    GSYNC();
    PH(4) { pg8::Gemm g{XN, (const bf16_t*)(ws + WS_WIN), MIN_, NCOLS, 1024}; S.init(MIN_, NCOLS, G, bx, 1024); pg8::EpiBf16 E{PS, NCOLS}; pg8::gemm_phase(lds, g, S, E, wv); }
    GSYNC();
    PH(5) lora_prep(P, wv);
    GSYNC();
    PH(6) { pg8::Gemm g{(const bf16_t*)(ws + WS_LA), (const bf16_t*)(ws + WS_WL), MT, 1536, 256}; pg8::LoraMainOrder SM; SM.init(MP, 1024, G, bx, 256);
      pg8::EpiLora E{(bf16_t*)(ws + WS_OMD), (bf16_t*)(ws + WS_ASIG), (bf16_t*)(ws + WS_WIN), P.w0, P.a0}; pg8::gemm_phase(lds, g, SM, E, wv); }
    GSYNC();
    {
    if (bx < 128) { for (int rw = 0; rw < REP_RW; ++rw) rwkv_unit<false>(P, ldsf, bx >> 4, (bx >> 1) & 7, bx & 1, wv); }
    else {
        { pg8::Gemm g{(const bf16_t*)(ws + WS_LA), (const bf16_t*)(ws + WS_WL), MT, 1536, 256}; pg8::LoraRestOrder SL; SL.ob = bx - 128;
          pg8::EpiLora E{(bf16_t*)(ws + WS_OMD), (bf16_t*)(ws + WS_ASIG), (bf16_t*)(ws + WS_WIN), P.w0, P.a0}; pg8::gemm_phase(lds, g, SL, E, wv); }
        FRESH();
        const int rep7 = 0; const int ob = bx - 128; unsigned* sbc = (unsigned*)ws + XCD_BAR_WORDS + 64;
        for (int k = 0; k < 4; ++k) { const int u = ob + k * 128; ret_unit_a(P, lds, u >> 4, u & 15, wv); }
        sub_barrier(sbc, 128u * (2u * rep7 + 1u), wv);
        ret_prefix(P, ob * 512 + fresh_tid(wv));
        sub_barrier(sbc, 128u * (2u * rep7 + 2u), wv);
        for (int k = 0; k < 4; ++k) { const int u = ob + k * 128; ret_unit_c(P, lds, u >> 4, u & 15, wv); }
        for (int u = ob; u < 2560; u += 128) { if (u < 2048) rwkv_unit<true>(P, ldsf, u >> 4, (u >> 1) & 7, u & 1, wv); else ret_sample_unit(P, ldsf, (u - 2048) >> 2, (u - 2048) & 3, wv); }
    }
    }
    GSYNC();
    for (int rep8 = 0; rep8 < REP_P8; ++rep8) PH(8) rwkv_post(P, wv);
    GSYNC();
    PH(9) { pg8::Gemm g{XN, (const bf16_t*)(ws + WS_WOUT), MT, 1024, 1024}; pg8::SplitOrder S2; S2.init2(G, bx, 1024, 4); pg8::EpiFO E{(bf16_t*)FO, 1024, (float*)(ws + WS_OMD)}; pg8::gemm_phase(lds, g, S2, E, wv); }
    GSYNC();
    PH(10) { tconv_list(P.f2g, P.f2u, P.f2d, nullptr, nullptr, ws, 2112, ldsf, wv);
    rows_phase(P, 2, ldsf, wv); }
    GSYNC();
    PH(11) { pg8::Gemm g{XN, (const bf16_t*)(ws + WS_WGU), MT, NGU, 1024}; S.init(MT, NGU, G, bx, 1024); pg8::EpiSwiGLU E{ACT, DFF}; pg8::gemm_phase(lds, g, S, E, wv); }
    GSYNC();
    PH(12) { pg8::Gemm g{ACT, (const bf16_t*)(ws + WS_WD), MT, 1024, DFF}; pg8::SplitOrder S2; S2.init2(G, bx, DFF, 8); pg8::EpiFO E{(bf16_t*)FO, 1024, (float*)(ws + WS_OMD)}; pg8::gemm_phase(lds, g, S2, E, wv); }
    GSYNC();
    PH(13) rows_phase(P, 3, ldsf, wv);
}

#undef ws
#undef XN
#undef ACT
#undef FO
#undef PS
#undef P
extern "C" void kernel_launch(void* const* d_in, const int* in_sizes, int n_in, void* d_out, int out_size, void* d_ws, size_t ws_size, hipStream_t stream) {
    static int grid = 0;
    if (grid == 0) {
        if (n_in != 26 || ws_size < WS_END) { fprintf(stderr, "kernel_launch: unexpected n_in %d or ws_size %zu (< %zu)\n", n_in, ws_size, (size_t)WS_END); grid = -1; return; }
        int dev = 0, cus = 0, per_cu = 0;
        hipGetDevice(&dev); hipDeviceGetAttribute(&cus, hipDeviceAttributeMultiprocessorCount, dev);
        hipFuncSetAttribute((const void*)hymba_mega, hipFuncAttributeMaxDynamicSharedMemorySize, LDS_BYTES);
        hipOccupancyMaxActiveBlocksPerMultiprocessor(&per_cu, (const void*)hymba_mega, 512, LDS_BYTES);
        if (per_cu < 1) { fprintf(stderr, "kernel_launch: occupancy query says %d blocks/CU\n", per_cu); per_cu = 1; }
        grid = cus * per_cu; if (grid > 256) grid = 256;
        if (grid != 256) { fprintf(stderr, "kernel_launch: this kernel needs 256 co-resident workgroups, got %d\n", grid); grid = -1; return; }
        fprintf(stderr, "kernel_launch: cus %d per_cu %d grid %d ws %zu\n", cus, per_cu, grid, ws_size);
    }
    if (grid < 0) return;
    if (hipMemsetAsync(d_ws, 0, 16384, stream) != hipSuccess) { fprintf(stderr, "kernel_launch: hipMemsetAsync failed\n"); return; }
    Params p{};
    const float** pp = (const float**)&p;
    for (int i = 0; i < 26; ++i) pp[i] = (const float*)d_in[i];
    p.out = (float*)d_out; p.ws = (unsigned char*)d_ws;
    void* args[] = {&p};
    hipError_t e = hipLaunchCooperativeKernel((const void*)hymba_mega, dim3(grid), dim3(512), args, LDS_BYTES, stream);
    if (e != hipSuccess) fprintf(stderr, "cooperative launch failed: %s (grid %d)\n", hipGetErrorString(e), grid);
}
```
